# Optimizing an MI355X kernel written in HIP

```python
import jax, jax.numpy as jnp
from jax import lax
import numpy as np

D_MODEL = 1024
BATCH = 4
SEQ = 8192
DEPTH = 1

F32 = jnp.float32
N_META = 16
EPS = 1e-5
ROPE_THETA = 500000.0
ATT_HEADS = 8
ATT_KV_HEADS = 2
ATT_HEAD_DIM = 64
ATT_WIDTH = ATT_HEADS * ATT_HEAD_DIM
IDX_HEADS = 8
IDX_DIM = 32
IDX_SCALE = (IDX_DIM ** -0.5) * (IDX_HEADS ** -0.5)
TOPK_MAX = 256
Q_BLOCK = 128
HG_HEADS = 4
HG_DK = 128
HG_DV = 128
HG_KWIDTH = HG_HEADS * HG_DK
HG_WIDTH = HG_HEADS * HG_DV
HG_CHUNK = 64
N_EXPERTS = 32
TOP_K = 4
D_FF = 1024
SWIGLU_LIMIT = 7.0
SWIGLU_ALPHA = 1.702
MOE_BLOCK = 128
IN_SPLITS = (ATT_WIDTH, ATT_KV_HEADS * ATT_HEAD_DIM, ATT_KV_HEADS * ATT_HEAD_DIM,
             IDX_HEADS * IDX_DIM, IDX_DIM, IDX_HEADS,
             HG_KWIDTH, HG_KWIDTH, HG_WIDTH, HG_WIDTH, D_MODEL, D_MODEL)
IN_COLS = sum(IN_SPLITS)

kernel_name = "hybrid_dsa_hgrn2_moe_meta"


def rmsnorm(x, g):
    xf = x.astype(F32)
    y = xf * lax.rsqrt(jnp.mean(xf * xf, axis=-1, keepdims=True) + EPS)
    return (y * g.astype(F32)).astype(x.dtype)


def partial_rope(x, pos):
    d = x.shape[-1]
    rot = d // 4
    half = rot // 2
    inv = ROPE_THETA ** (-jnp.arange(half, dtype=F32) * 2.0 / rot)
    ang = pos.astype(F32)[:, None] * inv[None, :]
    c = jnp.cos(ang)[:, None, :]
    s = jnp.sin(ang)[:, None, :]
    xf = x.astype(F32)
    x1 = xf[..., :half]
    x2 = xf[..., half:rot]
    out = jnp.concatenate([x1 * c - x2 * s, x2 * c + x1 * s, xf[..., rot:]], axis=-1)
    return out.astype(x.dtype)


def dsa_attention(q, k, v, iq, ik, iw, n_valid):
    B, Lp = q.shape[0], q.shape[1]
    nqb = Lp // Q_BLOCK
    k_sel = min(TOPK_MAX, n_valid // 4)
    groups = ATT_HEADS // ATT_KV_HEADS
    scale = ATT_HEAD_DIM ** -0.5
    key_pos = jnp.arange(Lp)
    ikf = ik.astype(F32)
    bidx = jnp.arange(B)[:, None, None]

    def to_blocks(a):
        return jnp.moveaxis(a.reshape((B, nqb, Q_BLOCK) + a.shape[2:]), 1, 0)

    def block(args):
        qb, iqb, iwb, qpos = args
        rel = jax.nn.relu(jnp.einsum('bqhd,bkd->bqhk', iqb.astype(F32), ikf))
        score = jnp.einsum('bqhk,bqh->bqk', rel, iwb.astype(F32)) * IDX_SCALE
        causal = key_pos[None, :] <= qpos[:, None]
        score = jnp.where(causal[None], score, -jnp.inf)
        _, sel = lax.top_k(score, k_sel)
        valid = sel <= qpos[None, :, None]
        kg = k[bidx, sel].astype(F32)
        vg = v[bidx, sel].astype(F32)
        qg = qb.reshape(B, Q_BLOCK, ATT_KV_HEADS, groups, ATT_HEAD_DIM).astype(F32)
        logits = jnp.einsum('bqgrd,bqkgd->bqgrk', qg, kg) * scale
        logits = jnp.where(valid[:, :, None, None, :], logits, -jnp.inf)
        p = jax.nn.softmax(logits, axis=-1)
        o = jnp.einsum('bqgrk,bqkgd->bqgrd', p, vg)
        return o.reshape(B, Q_BLOCK, ATT_WIDTH).astype(q.dtype)

    out = lax.map(block, (to_blocks(q), to_blocks(iq), to_blocks(iw), key_pos.reshape(nqb, Q_BLOCK)))
    return jnp.moveaxis(out, 0, 1).reshape(B, Lp, ATT_WIDTH)


def hgrn2_chunk(state, inp):
    q, kk, v, logf = inp
    C = q.shape[2]
    b = jnp.cumsum(logf, axis=2)
    mask = jnp.tril(jnp.ones((C, C), dtype=bool))
    diff = b[:, :, :, None, :] - b[:, :, None, :, :]
    decay = jnp.exp(jnp.where(mask[None, None, :, :, None], diff, -jnp.inf))
    scores = jnp.einsum('bhtd,bhtsd,bhsd->bhts', q, decay, kk)
    o = jnp.einsum('bhts,bhse->bhte', scores, v) + jnp.einsum('bhtd,bhde->bhte', q * jnp.exp(b), state)
    b_last = b[:, :, -1:, :]
    new_state = (jnp.exp(b_last[:, :, 0, :])[..., None] * state
                 + jnp.einsum('bhsd,bhse->bhde', kk * jnp.exp(b_last - b), v))
    return new_state, o


def hgrn2(q, f_pre, i, lb):
    B, L = q.shape[0], q.shape[1]

    def heads(a, d):
        return a.reshape(B, L, HG_HEADS, d).transpose(0, 2, 1, 3).astype(F32)

    lbh = lb.reshape(HG_HEADS, 1, HG_DK).astype(F32)
    f = lbh + (1.0 - lbh) * jax.nn.sigmoid(heads(f_pre, HG_DK))
    logf = jnp.log(f)
    kk = 1.0 - f
    qh = heads(q, HG_DK) * (HG_DK ** -0.5)
    vh = heads(i, HG_DV)
    state0 = jnp.zeros((B, HG_HEADS, HG_DK, HG_DV), F32)
    state, o_meta = hgrn2_chunk(state0, (qh[:, :, :N_META], kk[:, :, :N_META],
                                         vh[:, :, :N_META], logf[:, :, :N_META]))
    n_chunks = (L - N_META) // HG_CHUNK

    def chunks(a):
        return jnp.moveaxis(a[:, :, N_META:].reshape(B, HG_HEADS, n_chunks, HG_CHUNK, a.shape[-1]), 2, 0)

    _, o_real = lax.scan(hgrn2_chunk, state, (chunks(qh), chunks(kk), chunks(vh), chunks(logf)))
    o_real = jnp.moveaxis(o_real, 0, 2).reshape(B, HG_HEADS, L - N_META, HG_DV)
    o = jnp.concatenate([o_meta, o_real], axis=2)
    return o.transpose(0, 2, 1, 3)


def moe(x, router_w, router_b, w_gate, b_gate, w_up, b_up, w_down, b_down):
    B, L, D = x.shape
    T = B * L
    xt = x.reshape(T, D)
    logits = (xt @ router_w + router_b).astype(F32)
    top_vals, top_idx = lax.top_k(logits, TOP_K)
    gates = jax.nn.softmax(top_vals, axis=-1)
    n_assign = T * TOP_K
    expert = top_idx.reshape(-1)
    token = jnp.repeat(jnp.arange(T, dtype=jnp.int32), TOP_K)
    weight = gates.reshape(-1)
    order = jnp.argsort(expert)
    e_sorted = expert[order]
    t_sorted = token[order]
    w_sorted = weight[order]
    counts = jnp.bincount(expert, length=N_EXPERTS)
    starts = jnp.cumsum(counts) - counts
    padded = (counts + MOE_BLOCK - 1) // MOE_BLOCK * MOE_BLOCK
    pad_ends = jnp.cumsum(padded)
    pad_starts = pad_ends - padded
    dest = pad_starts[e_sorted] + (jnp.arange(n_assign) - starts[e_sorted])
    n_blocks = -(-n_assign // MOE_BLOCK) + N_EXPERTS
    cap = n_blocks * MOE_BLOCK
    slot_token = jnp.full((cap,), T, jnp.int32).at[dest].set(t_sorted)
    slot_weight = jnp.zeros((cap,), F32).at[dest].set(w_sorted)
    block_expert = jnp.minimum(
        jnp.searchsorted(pad_ends, jnp.arange(n_blocks) * MOE_BLOCK, side='right'), N_EXPERTS - 1)
    x_pad = jnp.concatenate([xt, jnp.zeros((1, D), xt.dtype)], axis=0)

    def expert_block(args):
        tok, e = args
        xb = x_pad[tok]
        g = xb @ w_gate[e] + b_gate[e]
        u = xb @ w_up[e] + b_up[e]
        g = jnp.minimum(g, SWIGLU_LIMIT)
        u = jnp.clip(u, -SWIGLU_LIMIT, SWIGLU_LIMIT)
        act = (u + 1.0) * (g * jax.nn.sigmoid(SWIGLU_ALPHA * g))
        return act @ w_down[e] + b_down[e]

    out = lax.map(expert_block, (slot_token.reshape(n_blocks, MOE_BLOCK), block_expert))
    out = out.reshape(cap, D) * slot_weight[:, None].astype(out.dtype)
    y = jnp.zeros((T + 1, D), out.dtype).at[slot_token].add(out)[:T]
    return y.reshape(B, L, D).astype(x.dtype)


def hybrid_layer(h, attn_norm_g, w_in, hgrn_norm_g, w_up_attn, w_up_hgrn, w_out, lb,
                 ffn_norm_g, router_w, router_b, w_gate, b_gate, w_up, b_up, w_down, b_down):
    B, L, _ = h.shape
    Lp = -(-L // Q_BLOCK) * Q_BLOCK
    pos = jnp.arange(Lp)
    xn = rmsnorm(h, attn_norm_g)
    proj = xn @ w_in
    (q, k, v, iq, ik, iw, hq, hf, hi, hg, ga, gh) = jnp.split(
        proj, [int(c) for c in np.cumsum(IN_SPLITS)[:-1]], axis=-1)

    def pad(a):
        return jnp.pad(a, ((0, 0), (0, Lp - L)) + ((0, 0),) * (a.ndim - 2))

    qa = partial_rope(pad(q).reshape(B, Lp, ATT_HEADS, ATT_HEAD_DIM), pos)
    ka = partial_rope(pad(k).reshape(B, Lp, ATT_KV_HEADS, ATT_HEAD_DIM), pos)
    va = pad(v).reshape(B, Lp, ATT_KV_HEADS, ATT_HEAD_DIM)
    iqa = partial_rope(pad(iq).reshape(B, Lp, IDX_HEADS, IDX_DIM), pos)
    ika = partial_rope(pad(ik)[:, :, None, :], pos)[:, :, 0, :]
    att = dsa_attention(qa, ka, va, iqa, ika, pad(iw), L)[:, :L]

    o = hgrn2(hq, hf, hi, lb)
    o = o * lax.rsqrt(jnp.mean(o * o, axis=-1, keepdims=True) + EPS)
    o = o * hgrn_norm_g.reshape(HG_HEADS, HG_DV).astype(F32)
    o = o.reshape(B, L, HG_WIDTH) * jax.nn.silu(hg.astype(F32))
    hgr = o.astype(h.dtype)

    mix = jax.nn.sigmoid(ga) * (att @ w_up_attn) + jax.nn.sigmoid(gh) * (hgr @ w_up_hgrn)
    h = h + mix @ w_out

    h = h + moe(rmsnorm(h, ffn_norm_g), router_w, router_b, w_gate, b_gate, w_up, b_up, w_down, b_down)
    return h


def setup_inputs(seed: int = 0) -> dict:
    key = jax.random.key(seed)
    ks = jax.random.split(key, 20)
    D = D_MODEL

    def nrm(k, shape, scale):
        return jax.random.normal(k, shape, F32) * scale

    return {
        "x": nrm(ks[0], (BATCH, SEQ, D), 1.0),
        "meta_tokens": nrm(ks[1], (N_META, D), 1.0),
        "attn_norm_g": 1.0 + nrm(ks[2], (DEPTH, D), 0.01),
        "w_in": nrm(ks[3], (DEPTH, D, IN_COLS), D ** -0.5),
        "hgrn_norm_g": 1.0 + nrm(ks[4], (DEPTH, HG_WIDTH), 0.01),
        "w_up_attn": nrm(ks[5], (DEPTH, ATT_WIDTH, D), ATT_WIDTH ** -0.5),
        "w_up_hgrn": nrm(ks[6], (DEPTH, HG_WIDTH, D), HG_WIDTH ** -0.5),
        "w_out": nrm(ks[7], (DEPTH, D, D), D ** -0.5),
        "hgrn_lb_logits": nrm(ks[8], (DEPTH + 1, HG_KWIDTH), 0.5),
        "ffn_norm_g": 1.0 + nrm(ks[9], (DEPTH, D), 0.01),
        "router_w": nrm(ks[10], (DEPTH, D, N_EXPERTS), D ** -0.5),
        "router_b": nrm(ks[11], (DEPTH, N_EXPERTS), 0.01),
        "w_gate": nrm(ks[12], (DEPTH, N_EXPERTS, D, D_FF), D ** -0.5),
        "b_gate": nrm(ks[13], (DEPTH, N_EXPERTS, D_FF), 0.01),
        "w_up": nrm(ks[14], (DEPTH, N_EXPERTS, D, D_FF), D ** -0.5),
        "b_up": nrm(ks[15], (DEPTH, N_EXPERTS, D_FF), 0.01),
        "w_down": nrm(ks[16], (DEPTH, N_EXPERTS, D_FF, D), D_FF ** -0.5),
        "b_down": nrm(ks[17], (DEPTH, N_EXPERTS, D), 0.01),
        "final_norm_g": 1.0 + nrm(ks[18], (D,), 0.01),
    }


def reference(x, meta_tokens, attn_norm_g, w_in, hgrn_norm_g, w_up_attn, w_up_hgrn, w_out,
              hgrn_lb_logits, ffn_norm_g, router_w, router_b, w_gate, b_gate, w_up, b_up,
              w_down, b_down, final_norm_g):
    B = x.shape[0]
    meta = jnp.broadcast_to(meta_tokens[None].astype(x.dtype), (B, N_META, D_MODEL))
    h = jnp.concatenate([meta, x], axis=1)
    lb_all = jnp.cumsum(jax.nn.softmax(hgrn_lb_logits.astype(F32), axis=0), axis=0)
    for l in range(DEPTH):
        h = hybrid_layer(h, attn_norm_g[l], w_in[l], hgrn_norm_g[l], w_up_attn[l], w_up_hgrn[l],
                         w_out[l], lb_all[l], ffn_norm_g[l], router_w[l], router_b[l],
                         w_gate[l], b_gate[l], w_up[l], b_up[l], w_down[l], b_down[l])
    return rmsnorm(h[:, N_META:], final_norm_g)
```

```cpp
#include <hip/hip_runtime.h>
#include <hip/hip_cooperative_groups.h>
#include <stdint.h>
#include <cstdio>
namespace cg = cooperative_groups;

#ifndef MEGA
#define MEGA 0
#endif

typedef unsigned short bf16_t;
typedef short bf16x8 __attribute__((ext_vector_type(8)));
typedef float f32x4 __attribute__((ext_vector_type(4)));

constexpr int D = 1024, NB = 4, SEQ = 8192, NMETA = 16, L = SEQ + NMETA  , LP = 8320, T = NB * LP  ;
constexpr int NTOK = NB * SEQ;
constexpr int IN_COLS = 5160;
constexpr int NE = 32, TOPK = 4, DFF = 1024;
constexpr int CAP_BLOCKS = (NTOK * TOPK) / 128 + NE;
constexpr int CAP = CAP_BLOCKS * 128;
constexpr float EPS = 1e-5f;
constexpr int NTHREADS = 512;
constexpr int LDS_BYTES = 57344;

__device__ __forceinline__ bf16_t f2bf(float f) {
    uint32_t u = __float_as_uint(f);
    u += 0x7fffu + ((u >> 16) & 1u);
    return (bf16_t)(u >> 16);
}
__device__ __forceinline__ float bf2f(bf16_t h) { return __uint_as_float(((uint32_t)h) << 16); }
__device__ __forceinline__ uint32_t pack2(float a, float b) { return (uint32_t)f2bf(a) | ((uint32_t)f2bf(b) << 16); }
__device__ __forceinline__ float sigmoidf_(float x) { return 1.0f / (1.0f + __expf(-x)); }
__device__ __forceinline__ float wave_sum(float v) {
#pragma unroll
    for (int o = 32; o >= 1; o >>= 1) v += __shfl_xor(v, o);
    return v;
}
__device__ __forceinline__ float wave_max(float v) {
#pragma unroll
    for (int o = 32; o >= 1; o >>= 1) v = fmaxf(v, __shfl_xor(v, o));
    return v;
}

struct P {
    const float *x, *meta, *attn_g, *w_in, *hgrn_g, *w_ua, *w_uh, *w_out, *lb_logits, *ffn_g, *router_w, *router_b,
        *w_gate, *b_gate, *w_up, *b_up, *w_down, *b_down, *final_g;
    float* out;
    bf16_t *xn, *q, *k, *v, *iq, *ik, *hq, *hf, *hi, *hg, *ga, *gh, *att, *hgr, *mix, *xn2, *act, *y;
    float *iw, *rope, *lb, *tok_gate;
    int *ctr;
    int *block_expert, *slot_token, *tok_slot, *tok_exp;
};

__device__ void ph_prep(const P& p, unsigned char* lds) {
    const int tid = threadIdx.x, lane = tid & 63, wid = tid >> 6;
    const int gw = blockIdx.x * 8 + wid, nw = gridDim.x * 8;
    for (int r = gw; r < T; r += nw) {
        const int b = r / LP, pos = r % LP;
        bf16_t* dst = p.xn + (size_t)r * D;
        if (pos >= L) {
#pragma unroll
            for (int i = 0; i < 4; ++i) *(uint2*)(dst + lane * 4 + 256 * i) = make_uint2(0u, 0u);
            continue;
        }
        const float* src = pos < NMETA ? p.meta + (size_t)pos * D : p.x + ((size_t)b * SEQ + (pos - NMETA)) * D;
        f32x4 v[4]; float ss = 0.f;
#pragma unroll
        for (int i = 0; i < 4; ++i) { v[i] = *(const f32x4*)(src + lane * 4 + 256 * i); ss += v[i][0] * v[i][0] + v[i][1] * v[i][1] + v[i][2] * v[i][2] + v[i][3] * v[i][3]; }
        ss = wave_sum(ss);
        const float rs = rsqrtf(ss * (1.0f / D) + EPS);
#pragma unroll
        for (int i = 0; i < 4; ++i) {
            const f32x4 g = *(const f32x4*)(p.attn_g + lane * 4 + 256 * i);
            uint2 o; o.x = pack2(v[i][0] * rs * g[0], v[i][1] * rs * g[1]); o.y = pack2(v[i][2] * rs * g[2], v[i][3] * rs * g[3]);
            *(uint2*)(dst + lane * 4 + 256 * i) = o;
        }
    }
    const int gt = blockIdx.x * NTHREADS + tid, nt = gridDim.x * NTHREADS;
    for (int i = gt; i < LP * 12; i += nt) {
        const int pos = i / 12, f = i % 12;
        const double ex = f < 8 ? -(double)f / 8.0 : -(double)(f - 8) / 4.0;
        const double inv = exp(ex * log(500000.0));
        const double ang = (double)pos * inv;
        const double twopi = 6.283185307179586476925286766559;
        const double r = ang - twopi * rint(ang / twopi);
        const float rf = (float)r;
        const float c = cosf(rf), s = sinf(rf);
        float* row = p.rope + (size_t)pos * 24;
        if (f < 8) { row[f] = c; row[8 + f] = s; } else { row[16 + f - 8] = c; row[20 + f - 8] = s; }
    }
    for (int i = gt; i < 512; i += nt) {
        const float a = p.lb_logits[i], b2 = p.lb_logits[512 + i];
        p.lb[i] = 1.0f / (1.0f + expf(b2 - a));
    }
    for (int i = gt; i < 128; i += nt) p.ctr[i] = 0;
}

constexpr int LDS_ROW = 144;
constexpr int SA_BYTES = 128 * LDS_ROW, SB_BYTES = 256 * LDS_ROW;

template <class Epi>
__device__ __forceinline__ void gemm_tile(unsigned char* lds, const bf16_t* A, int lda, const int* rowidx, int m0,
                                          const float* W, int ldw, int nvalid, int K, const Epi& epi) {
    const int tid = threadIdx.x, lane = tid & 63, wid = tid >> 6, wr = wid >> 2, wc = wid & 3, fr = lane & 15, fq = lane >> 4;
    unsigned char* sA = lds; unsigned char* sB = lds + SA_BYTES;
    const bf16_t* pa[2]; bool va[2]; int offA[2];
#pragma unroll
    for (int i = 0; i < 2; ++i) {
        const int pc = tid + i * 512, row = pc >> 3, c8 = pc & 7;
        int gr = m0 + row; bool ok = true;
        if (rowidx) { gr = rowidx[m0 + row]; ok = gr >= 0; if (!ok) gr = 0; }
        pa[i] = A + (size_t)gr * lda + c8 * 8; va[i] = ok; offA[i] = row * LDS_ROW + c8 * 16;
    }
    const float* pb[2]; bool vb[2]; int offB[2];
#pragma unroll
    for (int i = 0; i < 2; ++i) {
        const int blk = tid + i * 512, nb = blk & 63, kb = blk >> 6;
        vb[i] = nb * 4 < nvalid;
        pb[i] = W + (size_t)(kb * 4) * ldw + (vb[i] ? nb * 4 : 0);
        offB[i] = (nb * 4) * LDS_ROW + kb * 8;
    }
    f32x4 acc[4][4];
#pragma unroll
    for (int a = 0; a < 4; ++a)
#pragma unroll
        for (int b = 0; b < 4; ++b) acc[a][b] = (f32x4){0.f, 0.f, 0.f, 0.f};
    uint4 ra[2]; f32x4 rb[2][4];
    auto gload = [&](int k0) {
#pragma unroll
        for (int i = 0; i < 2; ++i) ra[i] = va[i] ? *(const uint4*)(pa[i] + k0) : make_uint4(0u, 0u, 0u, 0u);
#pragma unroll
        for (int i = 0; i < 2; ++i)
#pragma unroll
            for (int kk = 0; kk < 4; ++kk) rb[i][kk] = vb[i] ? *(const f32x4*)(pb[i] + (size_t)(k0 + kk) * ldw) : (f32x4){0.f, 0.f, 0.f, 0.f};
    };
    const int nk = K / 64;
    gload(0);
    for (int it = 0; it < nk; ++it) {
        __syncthreads();
#pragma unroll
        for (int i = 0; i < 2; ++i) *(uint4*)(sA + offA[i]) = ra[i];
#pragma unroll
        for (int i = 0; i < 2; ++i)
#pragma unroll
            for (int j = 0; j < 4; ++j) {
                uint2 w; w.x = pack2(rb[i][0][j], rb[i][1][j]); w.y = pack2(rb[i][2][j], rb[i][3][j]);
                *(uint2*)(sB + offB[i] + j * LDS_ROW) = w;
            }
        __syncthreads();
        if (it + 1 < nk) gload((it + 1) * 64);
#pragma unroll
        for (int ks = 0; ks < 2; ++ks) {
            bf16x8 af[4], bfr[4];
#pragma unroll
            for (int ms = 0; ms < 4; ++ms) af[ms] = *(const bf16x8*)(sA + (wr * 64 + ms * 16 + fr) * LDS_ROW + (ks * 32 + fq * 8) * 2);
#pragma unroll
            for (int ns = 0; ns < 4; ++ns) bfr[ns] = *(const bf16x8*)(sB + (wc * 64 + ns * 16 + fr) * LDS_ROW + (ks * 32 + fq * 8) * 2);
#pragma unroll
            for (int ms = 0; ms < 4; ++ms)
#pragma unroll
                for (int ns = 0; ns < 4; ++ns) acc[ms][ns] = __builtin_amdgcn_mfma_f32_16x16x32_bf16(bfr[ns], af[ms], acc[ms][ns], 0, 0, 0);
        }
    }
#pragma unroll
    for (int ms = 0; ms < 4; ++ms)
#pragma unroll
        for (int ns = 0; ns < 4; ++ns) epi(m0 + wr * 64 + ms * 16 + fr, wc * 64 + ns * 16 + fq * 4, ns, fq, acc[ms][ns]);
    __syncthreads();
}

__device__ __forceinline__ void st_bf4(bf16_t* dst, f32x4 v) {
    uint2 o; o.x = pack2(v[0], v[1]); o.y = pack2(v[2], v[3]); *(uint2*)dst = o;
}

struct EpiInproj {
    const P* p; int nt;
    __device__ __forceinline__ void operator()(int m, int n, int ns, int fq, f32x4 v) const {
        const P& P_ = *p;
        const int pos = m % LP;
        const float* rp = P_.rope + (size_t)pos * 24;
        if (nt <= 2) {
            const bool isv = (nt == 2) && (n >= 128);
            if (!isv && ns == 0) {
                f32x4 pr;
#pragma unroll
                for (int j = 0; j < 4; ++j) pr[j] = __shfl_xor(v[j], 32);
                const int i0 = (fq & 1) * 4;
#pragma unroll
                for (int j = 0; j < 4; ++j) {
                    const float c = rp[i0 + j], s = rp[8 + i0 + j];
                    v[j] = fq < 2 ? v[j] * c - pr[j] * s : v[j] * c + pr[j] * s;
                }
            }
            if (nt < 2) { st_bf4(P_.q + (size_t)m * 512 + nt * 256 + n, v * 0.125f); }
            else if (n < 128) st_bf4(P_.k + (size_t)m * 128 + n, v);
            else st_bf4(P_.v + (size_t)m * 128 + (n - 128), v);
        } else if (nt == 3 || nt == 4) {
            const bool ropeable = (nt == 3) ? ((ns & 1) == 0) : (n < 16);
            if (ropeable) {
                f32x4 pr;
#pragma unroll
                for (int j = 0; j < 4; ++j) pr[j] = __shfl_xor(v[j], 16);
                if (fq < 2) {
#pragma unroll
                    for (int j = 0; j < 4; ++j) {
                        const float c = rp[16 + j], s = rp[20 + j];
                        v[j] = fq == 0 ? v[j] * c - pr[j] * s : v[j] * c + pr[j] * s;
                    }
                }
            }
            if (nt == 3) st_bf4(P_.iq + (size_t)m * 256 + n, v);
            else if (n < 32) st_bf4(P_.ik + (size_t)m * 32 + n, v);
            else if (n < 40) *(f32x4*)(P_.iw + (size_t)m * 8 + (n - 32)) = v;
        } else if (nt <= 6) { st_bf4(P_.hq + (size_t)m * 512 + (nt - 5) * 256 + n, v * 0.08838834764831845f); }
        else if (nt <= 8) { st_bf4(P_.hf + (size_t)m * 512 + (nt - 7) * 256 + n, v); }
        else if (nt <= 10) { st_bf4(P_.hi + (size_t)m * 512 + (nt - 9) * 256 + n, v); }
        else if (nt <= 12) {
            f32x4 o;
#pragma unroll
            for (int j = 0; j < 4; ++j) o[j] = v[j] * sigmoidf_(v[j]);
            st_bf4(P_.hg + (size_t)m * 512 + (nt - 11) * 256 + n, o);
        } else {
            f32x4 o;
#pragma unroll
            for (int j = 0; j < 4; ++j) o[j] = sigmoidf_(v[j]);
            if (nt <= 16) st_bf4(P_.ga + (size_t)m * 1024 + (nt - 13) * 256 + n, o);
            else st_bf4(P_.gh + (size_t)m * 1024 + (nt - 17) * 256 + n, o);
        }
    }
};

__device__ void ph_inproj(const P& p, unsigned char* lds) {
    const int nunits = (T / 128) * 21;
    for (int u = blockIdx.x; u < nunits; u += gridDim.x) {
        const int nt = u % 21, mt = u / 21;
        int oc, nvalid = 256;
        if (nt <= 3) oc = nt * 256; else if (nt == 4) { oc = 1024; nvalid = 40; } else oc = nt * 256 - 216;
        EpiInproj epi{&p, nt};
        gemm_tile(lds, p.xn, D, nullptr, mt * 128, p.w_in + oc, IN_COLS, nvalid, D, epi);
    }
}

__device__ void hgrn_unit(const P& p, unsigned char* lds, int u) {
    const int tid = threadIdx.x, lane = tid & 63, wid = tid >> 6;
    const int b = u >> 2, h = u & 3;
    float* fqv = (float*)lds;
    float* ffv = fqv + 2048;
    float* fvv = ffv + 2048;
    float* fov = fvv + 2048;
    const int e = tid >> 2, dp = tid & 3;
    float S[32];
#pragma unroll
    for (int i = 0; i < 32; ++i) S[i] = 0.f;
    for (int t0 = 0; t0 < L; t0 += 16) {
#pragma unroll
        for (int i = 0; i < 4; ++i) {
            const int idx = tid + 512 * i, tt = idx >> 7, d = idx & 127;
            const size_t g = (size_t)(b * LP + t0 + tt) * 512 + h * 128 + d;
            const float lbv = p.lb[h * 128 + d];
            fqv[idx] = bf2f(p.hq[g]);
            ffv[idx] = lbv + (1.0f - lbv) * sigmoidf_(bf2f(p.hf[g]));
            fvv[idx] = bf2f(p.hi[g]);
        }
        __syncthreads();
        for (int tt = 0; tt < 16; ++tt) {
            const float ve = fvv[tt * 128 + e];
            float part = 0.f;
#pragma unroll
            for (int d4 = 0; d4 < 8; ++d4) {
                const f32x4 f = *(const f32x4*)(ffv + tt * 128 + dp * 32 + d4 * 4);
                const f32x4 qv = *(const f32x4*)(fqv + tt * 128 + dp * 32 + d4 * 4);
#pragma unroll
                for (int j = 0; j < 4; ++j) {
                    const float s = f[j] * S[d4 * 4 + j] + (1.0f - f[j]) * ve;
                    S[d4 * 4 + j] = s; part += qv[j] * s;
                }
            }
            part += __shfl_xor(part, 1); part += __shfl_xor(part, 2);
            if (dp == 0) fov[tt * 128 + e] = part;
        }
        __syncthreads();
#pragma unroll
        for (int r = 0; r < 2; ++r) {
            const int tt = wid * 2 + r;
            const float o0 = fov[tt * 128 + lane], o1 = fov[tt * 128 + 64 + lane];
            const float ss = wave_sum(o0 * o0 + o1 * o1);
            const float rs = rsqrtf(ss * (1.0f / 128.0f) + EPS);
            const size_t g = (size_t)(b * LP + t0 + tt) * 512 + h * 128;
            p.hgr[g + lane] = f2bf(o0 * rs * p.hgrn_g[h * 128 + lane] * bf2f(p.hg[g + lane]));
            p.hgr[g + 64 + lane] = f2bf(o1 * rs * p.hgrn_g[h * 128 + 64 + lane] * bf2f(p.hg[g + 64 + lane]));
        }
        __syncthreads();
    }
}

__device__ __forceinline__ int block_excl_scan(int v, int* wsum, int tid) {
    const int lane = tid & 63, w = tid >> 6;
    int inc = v;
#pragma unroll
    for (int o = 1; o < 64; o <<= 1) { const int t = __shfl_up(inc, o); if (lane >= o) inc += t; }
    if (lane == 63) wsum[w] = inc;
    __syncthreads();
    int base = 0;
    for (int i = 0; i < w; ++i) base += wsum[i];
    __syncthreads();
    return base + inc - v;
}

__device__ void attn_unit(const P& p, unsigned char* lds, int u) {
    const int tid = threadIdx.x, lane = tid & 63, wid = tid >> 6;
    uint32_t* keys = (uint32_t*)lds;
    int* hist = (int*)(lds + 33280);
    int* sel = hist + 256;
    float* iqf = (float*)(sel + 256);
    float* qf = iqf + 256;
    float* probs = qf + 512;
    float* wq = probs + 2048;
    int* wsum = (int*)(wq + 16);
    int* misc = wsum + 16;
    const int b = u / SEQ, t = NMETA + (u % SEQ);
    const int row = b * LP + t, n = t + 1;
    int nsel;
    qf[tid] = bf2f(p.q[(size_t)row * 512 + tid]);
    if (tid < 256) iqf[tid] = bf2f(p.iq[(size_t)row * 256 + tid]);
    if (tid < 8) wq[tid] = p.iw[(size_t)row * 8 + tid];
    __syncthreads();
    if (n > 256) {
        nsel = 256;
        for (int s = tid; s < n; s += NTHREADS) {
            const uint4* kp = (const uint4*)(p.ik + (size_t)(b * LP + s) * 32);
            float kf[32];
#pragma unroll
            for (int i = 0; i < 4; ++i) {
                const uint4 w = kp[i];
                kf[i * 8 + 0] = __uint_as_float(w.x << 16); kf[i * 8 + 1] = __uint_as_float(w.x & 0xffff0000u);
                kf[i * 8 + 2] = __uint_as_float(w.y << 16); kf[i * 8 + 3] = __uint_as_float(w.y & 0xffff0000u);
                kf[i * 8 + 4] = __uint_as_float(w.z << 16); kf[i * 8 + 5] = __uint_as_float(w.z & 0xffff0000u);
                kf[i * 8 + 6] = __uint_as_float(w.w << 16); kf[i * 8 + 7] = __uint_as_float(w.w & 0xffff0000u);
            }
            float score = 0.f;
#pragma unroll
            for (int h = 0; h < 8; ++h) {
                float dot = 0.f;
#pragma unroll
                for (int d4 = 0; d4 < 8; ++d4) {
                    const f32x4 a = *(const f32x4*)(iqf + h * 32 + d4 * 4);
                    dot += a[0] * kf[d4 * 4] + a[1] * kf[d4 * 4 + 1] + a[2] * kf[d4 * 4 + 2] + a[3] * kf[d4 * 4 + 3];
                }
                score += wq[h] * fmaxf(dot, 0.f);
            }
            uint32_t kb = __float_as_uint(score);
            kb = (kb & 0x80000000u) ? ~kb : (kb | 0x80000000u);
            keys[s] = kb;
        }
        __syncthreads();
        uint32_t prefix = 0; int need = 256;
        for (int pass = 0; pass < 4; ++pass) {
            const int shift = 24 - 8 * pass;
            if (tid < 256) hist[tid] = 0;
            __syncthreads();
            for (int s = tid; s < n; s += NTHREADS) {
                const uint32_t kb = keys[s];
                if (pass == 0 || (kb >> (shift + 8)) == prefix) atomicAdd(&hist[(kb >> shift) & 255u], 1);
            }
            __syncthreads();
            if (tid < 256) {
                int above = 0;
                for (int d2 = tid + 1; d2 < 256; ++d2) above += hist[d2];
                const int here = hist[tid];
                if (above < need && need <= above + here) { misc[0] = tid; misc[1] = need - above; }
            }
            __syncthreads();
            prefix = (prefix << 8) | (uint32_t)misc[0]; need = misc[1];
            __syncthreads();
        }
        const uint32_t kth = prefix; const int need_eq = need, ngt = 256 - need_eq;
        const int c = (n + NTHREADS - 1) / NTHREADS;
        const int s0 = tid * c, s1 = min(n, s0 + c);
        int cg_ = 0, ce = 0;
        for (int s = s0; s < s1; ++s) { const uint32_t kb = keys[s]; cg_ += kb > kth; ce += kb == kth; }
        int og = block_excl_scan(cg_, wsum, tid);
        int oe = block_excl_scan(ce, wsum, tid);
        for (int s = s0; s < s1; ++s) {
            const uint32_t kb = keys[s];
            if (kb > kth) { sel[og++] = s; }
            else if (kb == kth) { if (oe < need_eq) sel[ngt + oe] = s; ++oe; }
        }
    } else {
        nsel = n;
        if (tid < n) sel[tid] = tid;
    }
    __syncthreads();
    {
        const int h = wid, kvh = h >> 2;
        float lg[4];
#pragma unroll
        for (int jj = 0; jj < 4; ++jj) {
            const int j = lane + 64 * jj;
            float dot = -INFINITY;
            if (j < nsel) {
                const uint4* kp = (const uint4*)(p.k + (size_t)(b * LP + sel[j]) * 128 + kvh * 64);
                dot = 0.f;
#pragma unroll
                for (int i = 0; i < 8; ++i) {
                    const uint4 w = kp[i];
                    const f32x4 a0 = *(const f32x4*)(qf + h * 64 + i * 8), a1 = *(const f32x4*)(qf + h * 64 + i * 8 + 4);
                    dot += a0[0] * __uint_as_float(w.x << 16) + a0[1] * __uint_as_float(w.x & 0xffff0000u)
                         + a0[2] * __uint_as_float(w.y << 16) + a0[3] * __uint_as_float(w.y & 0xffff0000u)
                         + a1[0] * __uint_as_float(w.z << 16) + a1[1] * __uint_as_float(w.z & 0xffff0000u)
                         + a1[2] * __uint_as_float(w.w << 16) + a1[3] * __uint_as_float(w.w & 0xffff0000u);
                }
            }
            lg[jj] = dot;
        }
        const float mx = wave_max(fmaxf(fmaxf(lg[0], lg[1]), fmaxf(lg[2], lg[3])));
        float ex[4], sm = 0.f;
#pragma unroll
        for (int jj = 0; jj < 4; ++jj) { ex[jj] = (lane + 64 * jj < nsel) ? __expf(lg[jj] - mx) : 0.f; sm += ex[jj]; }
        sm = wave_sum(sm);
        const float inv = 1.0f / sm;
#pragma unroll
        for (int jj = 0; jj < 4; ++jj) probs[h * 256 + lane + 64 * jj] = ex[jj] * inv;
    }
    __syncthreads();
    {
        const int h = wid, kvh = h >> 2;
        float acc = 0.f;
        const bf16_t* vb = p.v + (size_t)b * LP * 128 + kvh * 64 + lane;
        for (int j = 0; j < nsel; ++j) acc += probs[h * 256 + j] * bf2f(vb[(size_t)sel[j] * 128]);
        p.att[(size_t)row * 512 + h * 64 + lane] = f2bf(acc);
    }
    __syncthreads();
}

__device__ void ph_mixer(const P& p, unsigned char* lds) {
    int* bc = (int*)(lds + LDS_BYTES - 16);
    if (blockIdx.x < 16) {
        for (int u = blockIdx.x; u < 16; u += gridDim.x) hgrn_unit(p, lds, u);
    }
    for (;;) {
        __syncthreads();
        if (threadIdx.x == 0) bc[0] = atomicAdd(&p.ctr[97], 1);
        __syncthreads();
        const int u = bc[0];
        if (u >= NTOK) break;
        const int uu = NTOK - 1 - u;
        const int b = uu & 3, tq = uu >> 2;
        attn_unit(p, lds, b * SEQ + tq);
    }
}

struct EpiMix1 { const P* p; int nt;
    __device__ __forceinline__ void operator()(int m, int n, int ns, int fq, f32x4 v) const {
        const size_t o = (size_t)m * 1024 + nt * 256 + n;
        const uint2 g = *(const uint2*)(p->ga + o);
        f32x4 r; r[0] = v[0] * __uint_as_float(g.x << 16); r[1] = v[1] * __uint_as_float(g.x & 0xffff0000u);
        r[2] = v[2] * __uint_as_float(g.y << 16); r[3] = v[3] * __uint_as_float(g.y & 0xffff0000u);
        *(f32x4*)((float*)p->act + o) = r;
    } };
struct EpiMix2 { const P* p; int nt;
    __device__ __forceinline__ void operator()(int m, int n, int ns, int fq, f32x4 v) const {
        const size_t o = (size_t)m * 1024 + nt * 256 + n;
        const uint2 g = *(const uint2*)(p->gh + o);
        const f32x4 a = *(const f32x4*)((float*)p->act + o);
        f32x4 r; r[0] = a[0] + v[0] * __uint_as_float(g.x << 16); r[1] = a[1] + v[1] * __uint_as_float(g.x & 0xffff0000u);
        r[2] = a[2] + v[2] * __uint_as_float(g.y << 16); r[3] = a[3] + v[3] * __uint_as_float(g.y & 0xffff0000u);
        st_bf4(p->mix + o, r);
    } };
__device__ void ph_mix(const P& p, unsigned char* lds) {
    const int nunits = (T / 128) * 4;
    for (int u = blockIdx.x; u < nunits; u += gridDim.x) {
        const int nt = u & 3, mt = u >> 2;
        gemm_tile(lds, p.att, 512, nullptr, mt * 128, p.w_ua + nt * 256, 1024, 256, 512, EpiMix1{&p, nt});
        gemm_tile(lds, p.hgr, 512, nullptr, mt * 128, p.w_uh + nt * 256, 1024, 256, 512, EpiMix2{&p, nt});
    }
}

struct EpiOut { const P* p; int nt;
    __device__ __forceinline__ void operator()(int m, int n, int ns, int fq, f32x4 v) const {
        const int b = m / LP, pos = m % LP;
        if (pos < NMETA || pos >= L) return;
        const size_t o = ((size_t)b * SEQ + (pos - NMETA)) * D + nt * 256 + n;
        const f32x4 h0 = *(const f32x4*)(p->x + o);
        *(f32x4*)(p->out + o) = h0 + v;
    } };
__device__ void ph_out(const P& p, unsigned char* lds) {
    const int nunits = (T / 128) * 4;
    for (int u = blockIdx.x; u < nunits; u += gridDim.x) {
        const int nt = u & 3, mt = u >> 2;
        gemm_tile(lds, p.mix, 1024, nullptr, mt * 128, p.w_out + nt * 256, 1024, 256, 1024, EpiOut{&p, nt});
    }
}

__device__ void ph_route(const P& p, unsigned char* lds) {
    const int tid = threadIdx.x, lane = tid & 63, wid = tid >> 6;
    const int gw = blockIdx.x * 8 + wid, nw = gridDim.x * 8;
    const int gt = blockIdx.x * NTHREADS + tid, ntot = gridDim.x * NTHREADS;
    for (int i = gt; i < CAP; i += ntot) p.slot_token[i] = -1;
    for (int tok = gw; tok < NTOK; tok += nw) {
        const float* src = p.out + (size_t)tok * D;
        f32x4 v[4]; float ss = 0.f;
#pragma unroll
        for (int i = 0; i < 4; ++i) { v[i] = *(const f32x4*)(src + lane * 4 + 256 * i); ss += v[i][0] * v[i][0] + v[i][1] * v[i][1] + v[i][2] * v[i][2] + v[i][3] * v[i][3]; }
        ss = wave_sum(ss);
        const float rs = rsqrtf(ss * (1.0f / D) + EPS);
        float lg[32];
#pragma unroll
        for (int e = 0; e < 32; ++e) lg[e] = 0.f;
#pragma unroll
        for (int i = 0; i < 4; ++i) {
            const f32x4 g = *(const f32x4*)(p.ffn_g + lane * 4 + 256 * i);
            f32x4 xn; xn[0] = v[i][0] * rs * g[0]; xn[1] = v[i][1] * rs * g[1]; xn[2] = v[i][2] * rs * g[2]; xn[3] = v[i][3] * rs * g[3];
            st_bf4(p.xn2 + (size_t)tok * D + lane * 4 + 256 * i, xn);
#pragma unroll
            for (int c = 0; c < 4; ++c) {
                const float* wr_ = p.router_w + (size_t)(lane * 4 + 256 * i + c) * 32;
#pragma unroll
                for (int e4 = 0; e4 < 8; ++e4) {
                    const f32x4 w = *(const f32x4*)(wr_ + e4 * 4);
                    lg[e4 * 4 + 0] += xn[c] * w[0]; lg[e4 * 4 + 1] += xn[c] * w[1]; lg[e4 * 4 + 2] += xn[c] * w[2]; lg[e4 * 4 + 3] += xn[c] * w[3];
                }
            }
        }
#pragma unroll
        for (int e = 0; e < 32; ++e) lg[e] = wave_sum(lg[e]) + p.router_b[e];
        float bv[4]; int bi[4];
#pragma unroll
        for (int k = 0; k < 4; ++k) {
            float best = -INFINITY; int idx = 0;
#pragma unroll
            for (int e = 0; e < 32; ++e) if (lg[e] > best) { best = lg[e]; idx = e; }
            bv[k] = best; bi[k] = idx;
#pragma unroll
            for (int e = 0; e < 32; ++e) lg[e] = (e == idx) ? -INFINITY : lg[e];
        }
        const float e1 = __expf(bv[1] - bv[0]), e2 = __expf(bv[2] - bv[0]), e3 = __expf(bv[3] - bv[0]);
        const float inv = 1.0f / (1.0f + e1 + e2 + e3);
        if (lane == 0) {
            p.tok_exp[tok * 4 + 0] = bi[0]; p.tok_exp[tok * 4 + 1] = bi[1]; p.tok_exp[tok * 4 + 2] = bi[2]; p.tok_exp[tok * 4 + 3] = bi[3];
            p.tok_gate[tok * 4 + 0] = inv; p.tok_gate[tok * 4 + 1] = e1 * inv; p.tok_gate[tok * 4 + 2] = e2 * inv; p.tok_gate[tok * 4 + 3] = e3 * inv;
            atomicAdd(&p.ctr[bi[0]], 1); atomicAdd(&p.ctr[bi[1]], 1); atomicAdd(&p.ctr[bi[2]], 1); atomicAdd(&p.ctr[bi[3]], 1);
        }
    }
}

__device__ void ph_scan(const P& p, unsigned char* lds) {
    if (blockIdx.x == 0 && threadIdx.x == 0) {
        int acc = 0;
        for (int e = 0; e < NE; ++e) {
            p.ctr[64 + e] = acc;
            const int nb = (p.ctr[e] + 127) >> 7;
            for (int i = 0; i < nb; ++i) p.block_expert[(acc >> 7) + i] = e;
            acc += nb * 128;
        }
        p.ctr[96] = acc >> 7;
    }
}

__device__ void ph_fill(const P& p, unsigned char* lds) {
    const int gt = blockIdx.x * NTHREADS + threadIdx.x, ntot = gridDim.x * NTHREADS;
    for (int i = gt; i < NTOK * 4; i += ntot) {
        const int e = p.tok_exp[i];
        const int dest = p.ctr[64 + e] + atomicAdd(&p.ctr[32 + e], 1);
        p.slot_token[dest] = i >> 2;
        p.tok_slot[i] = dest;
    }
}

struct EpiGate { const P* p; int e, nt;
    __device__ __forceinline__ void operator()(int m, int n, int ns, int fq, f32x4 v) const {
        const f32x4 bg = *(const f32x4*)(p->b_gate + (size_t)e * DFF + nt * 256 + n);
        f32x4 g;
#pragma unroll
        for (int j = 0; j < 4; ++j) g[j] = fminf(v[j] + bg[j], 7.0f);
        st_bf4(p->act + (size_t)m * DFF + nt * 256 + n, g);
    } };
struct EpiUp { const P* p; int e, nt;
    __device__ __forceinline__ void operator()(int m, int n, int ns, int fq, f32x4 v) const {
        const f32x4 bu = *(const f32x4*)(p->b_up + (size_t)e * DFF + nt * 256 + n);
        bf16_t* dst = p->act + (size_t)m * DFF + nt * 256 + n;
        const uint2 gw = *(const uint2*)dst;
        float g[4] = {__uint_as_float(gw.x << 16), __uint_as_float(gw.x & 0xffff0000u), __uint_as_float(gw.y << 16), __uint_as_float(gw.y & 0xffff0000u)};
        f32x4 a;
#pragma unroll
        for (int j = 0; j < 4; ++j) {
            const float uu = fminf(fmaxf(v[j] + bu[j], -7.0f), 7.0f);
            a[j] = (uu + 1.0f) * (g[j] * sigmoidf_(1.702f * g[j]));
        }
        st_bf4(dst, a);
    } };
struct EpiDown { const P* p; int e, nt;
    __device__ __forceinline__ void operator()(int m, int n, int ns, int fq, f32x4 v) const {
        const f32x4 bd = *(const f32x4*)(p->b_down + (size_t)e * D + nt * 256 + n);
        st_bf4(p->y + (size_t)m * D + nt * 256 + n, v + bd);
    } };
__device__ void ph_moe1(const P& p, unsigned char* lds) {
    const int nunits = p.ctr[96] * 4;
    for (int u = blockIdx.x; u < nunits; u += gridDim.x) {
        const int nt = u & 3, rb = u >> 2, e = p.block_expert[rb];
        gemm_tile(lds, p.xn2, D, p.slot_token, rb * 128, p.w_gate + (size_t)e * D * DFF + nt * 256, DFF, 256, D, EpiGate{&p, e, nt});
        gemm_tile(lds, p.xn2, D, p.slot_token, rb * 128, p.w_up + (size_t)e * D * DFF + nt * 256, DFF, 256, D, EpiUp{&p, e, nt});
    }
}
__device__ void ph_moe2(const P& p, unsigned char* lds) {
    const int nunits = p.ctr[96] * 4;
    for (int u = blockIdx.x; u < nunits; u += gridDim.x) {
        const int nt = u & 3, rb = u >> 2, e = p.block_expert[rb];
        gemm_tile(lds, p.act, DFF, nullptr, rb * 128, p.w_down + (size_t)e * DFF * D + nt * 256, D, 256, DFF, EpiDown{&p, e, nt});
    }
}

__device__ void ph_final(const P& p, unsigned char* lds) {
    const int tid = threadIdx.x, lane = tid & 63, wid = tid >> 6;
    const int gw = blockIdx.x * 8 + wid, nw = gridDim.x * 8;
    for (int tok = gw; tok < NTOK; tok += nw) {
        float* dst = p.out + (size_t)tok * D;
        f32x4 v[4];
#pragma unroll
        for (int i = 0; i < 4; ++i) v[i] = *(const f32x4*)(dst + lane * 4 + 256 * i);
#pragma unroll
        for (int j = 0; j < 4; ++j) {
            const float g = p.tok_gate[tok * 4 + j];
            const bf16_t* yr = p.y + (size_t)p.tok_slot[tok * 4 + j] * D;
#pragma unroll
            for (int i = 0; i < 4; ++i) {
                const uint2 w = *(const uint2*)(yr + lane * 4 + 256 * i);
                v[i][0] += g * __uint_as_float(w.x << 16); v[i][1] += g * __uint_as_float(w.x & 0xffff0000u);
                v[i][2] += g * __uint_as_float(w.y << 16); v[i][3] += g * __uint_as_float(w.y & 0xffff0000u);
            }
        }
        float ss = 0.f;
#pragma unroll
        for (int i = 0; i < 4; ++i) ss += v[i][0] * v[i][0] + v[i][1] * v[i][1] + v[i][2] * v[i][2] + v[i][3] * v[i][3];
        ss = wave_sum(ss);
        const float rs = rsqrtf(ss * (1.0f / D) + EPS);
#pragma unroll
        for (int i = 0; i < 4; ++i) {
            const f32x4 g = *(const f32x4*)(p.final_g + lane * 4 + 256 * i);
            *(f32x4*)(dst + lane * 4 + 256 * i) = v[i] * rs * g;
        }
    }
}

template <int PH>
__global__ void __launch_bounds__(NTHREADS) k_phase(P p) {
    __shared__ __attribute__((aligned(16))) unsigned char lds[LDS_BYTES];
    if (PH == 0) ph_prep(p, lds);
    if (PH == 1) ph_inproj(p, lds);
    if (PH == 2) ph_mixer(p, lds);
    if (PH == 3) ph_mix(p, lds);
    if (PH == 4) ph_out(p, lds);
    if (PH == 5) ph_route(p, lds);
    if (PH == 6) ph_scan(p, lds);
    if (PH == 7) ph_fill(p, lds);
    if (PH == 8) ph_moe1(p, lds);
    if (PH == 9) ph_moe2(p, lds);
    if (PH == 10) ph_final(p, lds);
}

#if MEGA
__global__ void __launch_bounds__(NTHREADS) k_mega(P p) {
    __shared__ __attribute__((aligned(16))) unsigned char lds[LDS_BYTES];
    cg::grid_group grid = cg::this_grid();
    ph_prep(p, lds); grid.sync();
    ph_inproj(p, lds); grid.sync();
    ph_mixer(p, lds); grid.sync();
    ph_mix(p, lds); grid.sync();
    ph_out(p, lds); grid.sync();
    ph_route(p, lds); grid.sync();
    ph_scan(p, lds); grid.sync();
    ph_fill(p, lds); grid.sync();
    ph_moe1(p, lds); grid.sync();
    ph_moe2(p, lds); grid.sync();
    ph_final(p, lds);
}
#endif

extern "C" void kernel_launch(void* const* d_in, const int* in_sizes, int n_in, void* d_out, int out_size, void* d_ws, size_t ws_size,
                              hipStream_t stream) {
    P p{};
    p.x = (const float*)d_in[0]; p.meta = (const float*)d_in[1]; p.attn_g = (const float*)d_in[2]; p.w_in = (const float*)d_in[3];
    p.hgrn_g = (const float*)d_in[4]; p.w_ua = (const float*)d_in[5]; p.w_uh = (const float*)d_in[6]; p.w_out = (const float*)d_in[7];
    p.lb_logits = (const float*)d_in[8]; p.ffn_g = (const float*)d_in[9]; p.router_w = (const float*)d_in[10]; p.router_b = (const float*)d_in[11];
    p.w_gate = (const float*)d_in[12]; p.b_gate = (const float*)d_in[13]; p.w_up = (const float*)d_in[14]; p.b_up = (const float*)d_in[15];
    p.w_down = (const float*)d_in[16]; p.b_down = (const float*)d_in[17]; p.final_g = (const float*)d_in[18];
    p.out = (float*)d_out;
    unsigned char* ws = (unsigned char*)d_ws;
    size_t off = 0;
    auto take = [&](size_t bytes) { unsigned char* r = ws + off; off += (bytes + 255) & ~(size_t)255; return r; };
    const size_t ACT_B = (size_t)CAP * DFF * 2, Y_B = (size_t)CAP * D * 2;
    p.act = (bf16_t*)take(ACT_B);
    p.y = (bf16_t*)take(Y_B);
    p.rope = (float*)take((size_t)LP * 24 * 4);
    p.lb = (float*)take(512 * 4);
    p.ctr = (int*)take(128 * 4);
    p.block_expert = (int*)take((size_t)CAP_BLOCKS * 4);
    p.slot_token = (int*)take((size_t)CAP * 4);
    p.tok_slot = (int*)take((size_t)NTOK * 4 * 4);
    p.tok_exp = (int*)take((size_t)NTOK * 4 * 4);
    p.tok_gate = (float*)take((size_t)NTOK * 4 * 4);
    if (off > ws_size) { fprintf(stderr, "workspace too small: need %zu have %zu\n", off, ws_size); return; }
    p.xn2 = p.y;
    {
        unsigned char* base = (unsigned char*)p.act; size_t o2 = 0;
        auto tk = [&](size_t bytes) { unsigned char* r = base + o2; o2 += (bytes + 255) & ~(size_t)255; return r; };
        tk((size_t)T * 1024 * 4);
        p.att = (bf16_t*)tk((size_t)T * 512 * 2); p.hgr = (bf16_t*)tk((size_t)T * 512 * 2);
        p.ga = (bf16_t*)tk((size_t)T * 1024 * 2); p.gh = (bf16_t*)tk((size_t)T * 1024 * 2);
        p.mix = (bf16_t*)tk((size_t)T * 1024 * 2);
        o2 = 0;
        p.xn = (bf16_t*)tk((size_t)T * 1024 * 2);
        p.q = (bf16_t*)tk((size_t)T * 512 * 2);
        p.k = (bf16_t*)tk((size_t)T * 128 * 2); p.v = (bf16_t*)tk((size_t)T * 128 * 2);
        p.iq = (bf16_t*)tk((size_t)T * 256 * 2);
        if (o2 > (size_t)T * 1024 * 4) { fprintf(stderr, "overlay A too large\n"); return; }
        o2 = (size_t)T * 1024 * 4 + 2 * (((size_t)T * 512 * 2 + 255) & ~(size_t)255) + 3 * (((size_t)T * 1024 * 2 + 255) & ~(size_t)255);
        p.hq = (bf16_t*)tk((size_t)T * 512 * 2); p.hf = (bf16_t*)tk((size_t)T * 512 * 2);
        p.hi = (bf16_t*)tk((size_t)T * 512 * 2); p.hg = (bf16_t*)tk((size_t)T * 512 * 2);
        p.ik = (bf16_t*)tk((size_t)T * 32 * 2); p.iw = (float*)tk((size_t)T * 8 * 4);
        if (o2 > ACT_B + Y_B) { fprintf(stderr, "overlay too large\n"); return; }
    }
#if MEGA
    static int grid_blocks = 0;
    if (!grid_blocks) {
        int dev = 0, cus = 0, per_cu = 0;
        hipGetDevice(&dev);
        hipDeviceGetAttribute(&cus, hipDeviceAttributeMultiprocessorCount, dev);
        hipOccupancyMaxActiveBlocksPerMultiprocessor(&per_cu, k_mega, NTHREADS, 0);
        if (per_cu > 1) per_cu = 1;
        grid_blocks = cus * per_cu;
    }
    void* args[] = {&p};
    hipError_t e = hipLaunchCooperativeKernel((void*)k_mega, dim3(grid_blocks), dim3(NTHREADS), args, 0, stream);
    if (e != hipSuccess) fprintf(stderr, "cooperative launch failed: %s (grid %d)\n", hipGetErrorString(e), grid_blocks);
#else
    const int G = 512;
    k_phase<0><<<G, NTHREADS, 0, stream>>>(p);
    k_phase<1><<<G, NTHREADS, 0, stream>>>(p);
    k_phase<2><<<G, NTHREADS, 0, stream>>>(p);
    k_phase<3><<<G, NTHREADS, 0, stream>>>(p);
    k_phase<4><<<G, NTHREADS, 0, stream>>>(p);
    k_phase<5><<<G, NTHREADS, 0, stream>>>(p);
    k_phase<6><<<1, NTHREADS, 0, stream>>>(p);
    k_phase<7><<<G, NTHREADS, 0, stream>>>(p);
    k_phase<8><<<G, NTHREADS, 0, stream>>>(p);
    k_phase<9><<<G, NTHREADS, 0, stream>>>(p);
    k_phase<10><<<G, NTHREADS, 0, stream>>>(p);
#endif
}
```

```cpp
#include <hip/hip_runtime.h>
#include <hip/hip_cooperative_groups.h>
#include <stdint.h>
#include <cstdio>
namespace cg = cooperative_groups;

#ifndef MEGA
#define MEGA 1
#endif

typedef unsigned short bf16_t;
typedef short bf16x8 __attribute__((ext_vector_type(8)));
typedef float f32x4 __attribute__((ext_vector_type(4)));

constexpr int D = 1024, NB = 4, SEQ = 8192, NMETA = 16, L = SEQ + NMETA  , LP = 8320, T = NB * LP  ;
constexpr int NTOK = NB * SEQ;
constexpr int IN_COLS = 5160;
constexpr int NE = 32, TOPK = 4, DFF = 1024;
constexpr int CAP_BLOCKS = (NTOK * TOPK) / 128 + NE;
constexpr int CAP = CAP_BLOCKS * 128;
constexpr float EPS = 1e-5f;
constexpr int NTHREADS = 512;
constexpr int LDS_BYTES = 57344;

__device__ __forceinline__ bf16_t f2bf(float f) {
    uint32_t u = __float_as_uint(f);
    u += 0x7fffu + ((u >> 16) & 1u);
    return (bf16_t)(u >> 16);
}
__device__ __forceinline__ float bf2f(bf16_t h) { return __uint_as_float(((uint32_t)h) << 16); }
__device__ __forceinline__ uint32_t pack2(float a, float b) { return (uint32_t)f2bf(a) | ((uint32_t)f2bf(b) << 16); }
__device__ __forceinline__ float sigmoidf_(float x) { return 1.0f / (1.0f + __expf(-x)); }
__device__ __forceinline__ float wave_sum(float v) {
#pragma unroll
    for (int o = 32; o >= 1; o >>= 1) v += __shfl_xor(v, o);
    return v;
}
__device__ __forceinline__ float wave_max(float v) {
#pragma unroll
    for (int o = 32; o >= 1; o >>= 1) v = fmaxf(v, __shfl_xor(v, o));
    return v;
}

constexpr size_t al256(size_t x) { return (x + 255) & ~(size_t)255; }
constexpr size_t TT = (size_t)T;
constexpr size_t ACT_B = (size_t)CAP * DFF * 2, Y_B = (size_t)CAP * D * 2;
constexpr size_t OFF_ACT = 0, OFF_Y = al256(ACT_B), OFF_TAB = OFF_Y + al256(Y_B);
constexpr size_t OFF_ROPE = OFF_TAB, OFF_LB = OFF_ROPE + al256((size_t)LP * 24 * 4), OFF_CTR = OFF_LB + al256(512 * 4),
                 OFF_BEXP = OFF_CTR + al256(128 * 4), OFF_SLOT = OFF_BEXP + al256((size_t)CAP_BLOCKS * 4), OFF_TSLOT = OFF_SLOT + al256((size_t)CAP * 4),
                 OFF_TEXP = OFF_TSLOT + al256((size_t)NTOK * 16), OFF_TGATE = OFF_TEXP + al256((size_t)NTOK * 16), WS_NEED = OFF_TGATE + al256((size_t)NTOK * 16);
constexpr size_t OFF_XN2 = OFF_Y;
constexpr size_t OFF_XN = 0, OFF_Q = TT * 2048, OFF_K = OFF_Q + TT * 1024, OFF_V = OFF_K + TT * 256, OFF_IQ = OFF_V + TT * 256;
constexpr size_t OFF_TMP = 0, OFF_ATT = TT * 4096, OFF_HGR = OFF_ATT + TT * 1024, OFF_GA = OFF_HGR + TT * 1024, OFF_GH = OFF_GA + TT * 2048,
                 OFF_MIX = OFF_GH + TT * 2048, OFF_HQ = OFF_MIX + TT * 2048, OFF_HF = OFF_HQ + TT * 1024, OFF_HI = OFF_HF + TT * 1024, OFF_HG = OFF_HI + TT * 1024,
                 OFF_IK = OFF_HG + TT * 1024, OFF_IW = OFF_IK + TT * 64, OFF_MIXER_END = OFF_IW + TT * 32;
static_assert(OFF_IQ + TT * 512 <= OFF_ATT, "overlay A");
static_assert(OFF_MIXER_END <= OFF_TAB, "overlay B");

__device__ __forceinline__ int tid_() { int t = threadIdx.x; asm volatile("" : "+v"(t)); return t; }

struct P {
    const float *x, *meta, *attn_g, *w_in, *hgrn_g, *w_ua, *w_uh, *w_out, *lb_logits, *ffn_g, *router_w, *router_b,
        *w_gate, *b_gate, *w_up, *b_up, *w_down, *b_down, *final_g;
    float* out;
    unsigned char* ws;
#define WSF(type, name, off) __device__ __forceinline__ type* name() const { return (type*)(ws + (off)); }
    WSF(bf16_t, xn, OFF_XN) WSF(bf16_t, q, OFF_Q) WSF(bf16_t, k, OFF_K) WSF(bf16_t, v, OFF_V) WSF(bf16_t, iq, OFF_IQ) WSF(bf16_t, ik, OFF_IK)
    WSF(bf16_t, hq, OFF_HQ) WSF(bf16_t, hf, OFF_HF) WSF(bf16_t, hi, OFF_HI) WSF(bf16_t, hg, OFF_HG) WSF(bf16_t, ga, OFF_GA) WSF(bf16_t, gh, OFF_GH)
    WSF(bf16_t, att, OFF_ATT) WSF(bf16_t, hgr, OFF_HGR) WSF(bf16_t, mix, OFF_MIX) WSF(bf16_t, xn2, OFF_XN2) WSF(bf16_t, act, OFF_ACT) WSF(bf16_t, y, OFF_Y)
    WSF(float, iw, OFF_IW) WSF(float, rope, OFF_ROPE) WSF(float, lb, OFF_LB) WSF(float, tok_gate, OFF_TGATE)
    WSF(int, ctr, OFF_CTR)
    WSF(int, block_expert, OFF_BEXP) WSF(int, slot_token, OFF_SLOT) WSF(int, tok_slot, OFF_TSLOT) WSF(int, tok_exp, OFF_TEXP)
};

__device__ void ph_prep(const P& p, unsigned char* lds) {
    const int tid = tid_(), lane = tid & 63, wid = tid >> 6;
    const int gw = blockIdx.x * 8 + wid, nw = gridDim.x * 8;
    for (int r = gw; r < T; r += nw) {
        const int b = r / LP, pos = r % LP;
        bf16_t* dst = p.xn() + (size_t)r * D;
        if (pos >= L) {
#pragma unroll
            for (int i = 0; i < 4; ++i) *(uint2*)(dst + lane * 4 + 256 * i) = make_uint2(0u, 0u);
            continue;
        }
        const float* src = pos < NMETA ? p.meta + (size_t)pos * D : p.x + ((size_t)b * SEQ + (pos - NMETA)) * D;
        f32x4 v[4]; float ss = 0.f;
#pragma unroll
        for (int i = 0; i < 4; ++i) { v[i] = *(const f32x4*)(src + lane * 4 + 256 * i); ss += v[i][0] * v[i][0] + v[i][1] * v[i][1] + v[i][2] * v[i][2] + v[i][3] * v[i][3]; }
        ss = wave_sum(ss);
        const float rs = rsqrtf(ss * (1.0f / D) + EPS);
#pragma unroll
        for (int i = 0; i < 4; ++i) {
            const f32x4 g = *(const f32x4*)(p.attn_g + lane * 4 + 256 * i);
            uint2 o; o.x = pack2(v[i][0] * rs * g[0], v[i][1] * rs * g[1]); o.y = pack2(v[i][2] * rs * g[2], v[i][3] * rs * g[3]);
            *(uint2*)(dst + lane * 4 + 256 * i) = o;
        }
    }
    const int gt = blockIdx.x * NTHREADS + tid, nt = gridDim.x * NTHREADS;
    for (int i = gt; i < LP * 12; i += nt) {
        const int pos = i / 12, f = i % 12;
        const double ex = f < 8 ? -(double)f / 8.0 : -(double)(f - 8) / 4.0;
        const double inv = exp(ex * log(500000.0));
        const double ang = (double)pos * inv;
        const double twopi = 6.283185307179586476925286766559;
        const double r = ang - twopi * rint(ang / twopi);
        const float rf = (float)r;
        const float c = cosf(rf), s = sinf(rf);
        float* row = p.rope() + (size_t)pos * 24;
        if (f < 8) { row[f] = c; row[8 + f] = s; } else { row[16 + f - 8] = c; row[20 + f - 8] = s; }
    }
    for (int i = gt; i < 512; i += nt) {
        const float a = p.lb_logits[i], b2 = p.lb_logits[512 + i];
        p.lb()[i] = 1.0f / (1.0f + expf(b2 - a));
    }
    for (int i = gt; i < 128; i += nt) p.ctr()[i] = 0;
}

constexpr int LDS_ROW = 144;
constexpr int SA_BYTES = 128 * LDS_ROW, SB_BYTES = 256 * LDS_ROW;

template <class Epi>
__device__ __forceinline__ void gemm_tile(unsigned char* lds, const bf16_t* A, int lda, const int* rowidx, int m0,
                                          const float* W, int ldw, int nvalid, int K, const Epi& epi) {
    const int tid = tid_(), lane = tid & 63, wid = tid >> 6, wr = wid >> 2, wc = wid & 3, fr = lane & 15, fq = lane >> 4;
    unsigned char* sA = lds; unsigned char* sB = lds + SA_BYTES;
    const bf16_t* pa[2]; bool va[2]; int offA[2];
#pragma unroll
    for (int i = 0; i < 2; ++i) {
        const int pc = tid + i * 512, row = pc >> 3, c8 = pc & 7;
        int gr = m0 + row; bool ok = true;
        if (rowidx) { gr = rowidx[m0 + row]; ok = gr >= 0; if (!ok) gr = 0; }
        pa[i] = A + (size_t)gr * lda + c8 * 8; va[i] = ok; offA[i] = row * LDS_ROW + c8 * 16;
    }
    const float* pb[2]; bool vb[2]; int offB[2];
#pragma unroll
    for (int i = 0; i < 2; ++i) {
        const int blk = tid + i * 512, nb = blk & 63, kb = blk >> 6;
        vb[i] = nb * 4 < nvalid;
        pb[i] = W + (size_t)(kb * 4) * ldw + (vb[i] ? nb * 4 : 0);
        offB[i] = (nb * 4) * LDS_ROW + kb * 8;
    }
    f32x4 acc[4][4];
#pragma unroll
    for (int a = 0; a < 4; ++a)
#pragma unroll
        for (int b = 0; b < 4; ++b) acc[a][b] = (f32x4){0.f, 0.f, 0.f, 0.f};
    uint4 ra[2]; f32x4 rb[2][4];
    auto gload = [&](int k0) {
#pragma unroll
        for (int i = 0; i < 2; ++i) ra[i] = va[i] ? *(const uint4*)(pa[i] + k0) : make_uint4(0u, 0u, 0u, 0u);
#pragma unroll
        for (int i = 0; i < 2; ++i)
#pragma unroll
            for (int kk = 0; kk < 4; ++kk) rb[i][kk] = vb[i] ? *(const f32x4*)(pb[i] + (size_t)(k0 + kk) * ldw) : (f32x4){0.f, 0.f, 0.f, 0.f};
    };
    const int nk = K / 64;
    gload(0);
    for (int it = 0; it < nk; ++it) {
        __syncthreads();
#pragma unroll
        for (int i = 0; i < 2; ++i) *(uint4*)(sA + offA[i]) = ra[i];
#pragma unroll
        for (int i = 0; i < 2; ++i)
#pragma unroll
            for (int j = 0; j < 4; ++j) {
                uint2 w; w.x = pack2(rb[i][0][j], rb[i][1][j]); w.y = pack2(rb[i][2][j], rb[i][3][j]);
                *(uint2*)(sB + offB[i] + j * LDS_ROW) = w;
            }
        __syncthreads();
        if (it + 1 < nk) gload((it + 1) * 64);
#pragma unroll
        for (int ks = 0; ks < 2; ++ks) {
            bf16x8 af[4], bfr[4];
#pragma unroll
            for (int ms = 0; ms < 4; ++ms) af[ms] = *(const bf16x8*)(sA + (wr * 64 + ms * 16 + fr) * LDS_ROW + (ks * 32 + fq * 8) * 2);
#pragma unroll
            for (int ns = 0; ns < 4; ++ns) bfr[ns] = *(const bf16x8*)(sB + (wc * 64 + ns * 16 + fr) * LDS_ROW + (ks * 32 + fq * 8) * 2);
#pragma unroll
            for (int ms = 0; ms < 4; ++ms)
#pragma unroll
                for (int ns = 0; ns < 4; ++ns) acc[ms][ns] = __builtin_amdgcn_mfma_f32_16x16x32_bf16(bfr[ns], af[ms], acc[ms][ns], 0, 0, 0);
        }
    }
#pragma unroll
    for (int ms = 0; ms < 4; ++ms)
#pragma unroll
        for (int ns = 0; ns < 4; ++ns) epi(m0 + wr * 64 + ms * 16 + fr, wc * 64 + ns * 16 + fq * 4, ns, fq, acc[ms][ns]);
    __syncthreads();
}

__device__ __forceinline__ void st_bf4(bf16_t* dst, f32x4 v) {
    uint2 o; o.x = pack2(v[0], v[1]); o.y = pack2(v[2], v[3]); *(uint2*)dst = o;
}

struct EpiInproj {
    const P* p; int nt;
    __device__ __forceinline__ void operator()(int m, int n, int ns, int fq, f32x4 v) const {
        const P& P_ = *p;
        const int pos = m % LP;
        const float* rp = P_.rope() + (size_t)pos * 24;
        if (nt <= 2) {
            const bool isv = (nt == 2) && (n >= 128);
            if (!isv && ns == 0) {
                f32x4 pr;
#pragma unroll
                for (int j = 0; j < 4; ++j) pr[j] = __shfl_xor(v[j], 32);
                const int i0 = (fq & 1) * 4;
#pragma unroll
                for (int j = 0; j < 4; ++j) {
                    const float c = rp[i0 + j], s = rp[8 + i0 + j];
                    v[j] = fq < 2 ? v[j] * c - pr[j] * s : v[j] * c + pr[j] * s;
                }
            }
            if (nt < 2) { st_bf4(P_.q() + (size_t)m * 512 + nt * 256 + n, v * 0.125f); }
            else if (n < 128) st_bf4(P_.k() + (size_t)m * 128 + n, v);
            else st_bf4(P_.v() + (size_t)m * 128 + (n - 128), v);
        } else if (nt == 3 || nt == 4) {
            const bool ropeable = (nt == 3) ? ((ns & 1) == 0) : (n < 16);
            if (ropeable) {
                f32x4 pr;
#pragma unroll
                for (int j = 0; j < 4; ++j) pr[j] = __shfl_xor(v[j], 16);
                if (fq < 2) {
#pragma unroll
                    for (int j = 0; j < 4; ++j) {
                        const float c = rp[16 + j], s = rp[20 + j];
                        v[j] = fq == 0 ? v[j] * c - pr[j] * s : v[j] * c + pr[j] * s;
                    }
                }
            }
            if (nt == 3) st_bf4(P_.iq() + (size_t)m * 256 + n, v);
            else if (n < 32) st_bf4(P_.ik() + (size_t)m * 32 + n, v);
            else if (n < 40) *(f32x4*)(P_.iw() + (size_t)m * 8 + (n - 32)) = v;
        } else if (nt <= 6) { st_bf4(P_.hq() + (size_t)m * 512 + (nt - 5) * 256 + n, v * 0.08838834764831845f); }
        else if (nt <= 8) { st_bf4(P_.hf() + (size_t)m * 512 + (nt - 7) * 256 + n, v); }
        else if (nt <= 10) { st_bf4(P_.hi() + (size_t)m * 512 + (nt - 9) * 256 + n, v); }
        else if (nt <= 12) {
            f32x4 o;
#pragma unroll
            for (int j = 0; j < 4; ++j) o[j] = v[j] * sigmoidf_(v[j]);
            st_bf4(P_.hg() + (size_t)m * 512 + (nt - 11) * 256 + n, o);
        } else {
            f32x4 o;
#pragma unroll
            for (int j = 0; j < 4; ++j) o[j] = sigmoidf_(v[j]);
            if (nt <= 16) st_bf4(P_.ga() + (size_t)m * 1024 + (nt - 13) * 256 + n, o);
            else st_bf4(P_.gh() + (size_t)m * 1024 + (nt - 17) * 256 + n, o);
        }
    }
};

__device__ void ph_inproj(const P& p, unsigned char* lds) {
    const int nunits = (T / 128) * 21;
    for (int u = blockIdx.x; u < nunits; u += gridDim.x) {
        const int nt = u % 21, mt = u / 21;
        int oc, nvalid = 256;
        if (nt <= 3) oc = nt * 256; else if (nt == 4) { oc = 1024; nvalid = 40; } else oc = nt * 256 - 216;
        EpiInproj epi{&p, nt};
        gemm_tile(lds, p.xn(), D, nullptr, mt * 128, p.w_in + oc, IN_COLS, nvalid, D, epi);
    }
}

__device__ void hgrn_unit(const P& p, unsigned char* lds, int u) {
    const int tid = tid_(), lane = tid & 63, wid = tid >> 6;
    const int b = u >> 2, h = u & 3;
    float* fqv = (float*)lds;
    float* ffv = fqv + 2048;
    float* fvv = ffv + 2048;
    float* fov = fvv + 2048;
    const int e = tid >> 2, dp = tid & 3;
    float S[32];
#pragma unroll
    for (int i = 0; i < 32; ++i) S[i] = 0.f;
    for (int t0 = 0; t0 < L; t0 += 16) {
#pragma unroll
        for (int i = 0; i < 4; ++i) {
            const int idx = tid + 512 * i, tt = idx >> 7, d = idx & 127;
            const size_t g = (size_t)(b * LP + t0 + tt) * 512 + h * 128 + d;
            const float lbv = p.lb()[h * 128 + d];
            fqv[idx] = bf2f(p.hq()[g]);
            ffv[idx] = lbv + (1.0f - lbv) * sigmoidf_(bf2f(p.hf()[g]));
            fvv[idx] = bf2f(p.hi()[g]);
        }
        __syncthreads();
        for (int tt = 0; tt < 16; ++tt) {
            const float ve = fvv[tt * 128 + e];
            float part = 0.f;
#pragma unroll
            for (int d4 = 0; d4 < 8; ++d4) {
                const f32x4 f = *(const f32x4*)(ffv + tt * 128 + dp * 32 + d4 * 4);
                const f32x4 qv = *(const f32x4*)(fqv + tt * 128 + dp * 32 + d4 * 4);
#pragma unroll
                for (int j = 0; j < 4; ++j) {
                    const float s = f[j] * S[d4 * 4 + j] + (1.0f - f[j]) * ve;
                    S[d4 * 4 + j] = s; part += qv[j] * s;
                }
            }
            part += __shfl_xor(part, 1); part += __shfl_xor(part, 2);
            if (dp == 0) fov[tt * 128 + e] = part;
        }
        __syncthreads();
#pragma unroll
        for (int r = 0; r < 2; ++r) {
            const int tt = wid * 2 + r;
            const float o0 = fov[tt * 128 + lane], o1 = fov[tt * 128 + 64 + lane];
            const float ss = wave_sum(o0 * o0 + o1 * o1);
            const float rs = rsqrtf(ss * (1.0f / 128.0f) + EPS);
            const size_t g = (size_t)(b * LP + t0 + tt) * 512 + h * 128;
            p.hgr()[g + lane] = f2bf(o0 * rs * p.hgrn_g[h * 128 + lane] * bf2f(p.hg()[g + lane]));
            p.hgr()[g + 64 + lane] = f2bf(o1 * rs * p.hgrn_g[h * 128 + 64 + lane] * bf2f(p.hg()[g + 64 + lane]));
        }
        __syncthreads();
    }
}

__device__ __forceinline__ int block_excl_scan(int v, int* wsum, int tid) {
    const int lane = tid & 63, w = tid >> 6;
    int inc = v;
#pragma unroll
    for (int o = 1; o < 64; o <<= 1) { const int t = __shfl_up(inc, o); if (lane >= o) inc += t; }
    if (lane == 63) wsum[w] = inc;
    __syncthreads();
    int base = 0;
    for (int i = 0; i < w; ++i) base += wsum[i];
    __syncthreads();
    return base + inc - v;
}

__device__ void attn_unit(const P& p, unsigned char* lds, int u) {
    const int tid = tid_(), lane = tid & 63, wid = tid >> 6;
    uint32_t* keys = (uint32_t*)lds;
    int* hist = (int*)(lds + 33280);
    int* sel = hist + 256;
    float* iqf = (float*)(sel + 256);
    float* qf = iqf + 256;
    float* probs = qf + 512;
    float* wq = probs + 2048;
    int* wsum = (int*)(wq + 16);
    int* misc = wsum + 16;
    const int b = u / SEQ, t = NMETA + (u % SEQ);
    const int row = b * LP + t, n = t + 1;
    int nsel;
    qf[tid] = bf2f(p.q()[(size_t)row * 512 + tid]);
    if (tid < 256) iqf[tid] = bf2f(p.iq()[(size_t)row * 256 + tid]);
    if (tid < 8) wq[tid] = p.iw()[(size_t)row * 8 + tid];
    __syncthreads();
    if (n > 256) {
        nsel = 256;
        for (int s = tid; s < n; s += NTHREADS) {
            const uint4* kp = (const uint4*)(p.ik() + (size_t)(b * LP + s) * 32);
            float kf[32];
#pragma unroll
            for (int i = 0; i < 4; ++i) {
                const uint4 w = kp[i];
                kf[i * 8 + 0] = __uint_as_float(w.x << 16); kf[i * 8 + 1] = __uint_as_float(w.x & 0xffff0000u);
                kf[i * 8 + 2] = __uint_as_float(w.y << 16); kf[i * 8 + 3] = __uint_as_float(w.y & 0xffff0000u);
                kf[i * 8 + 4] = __uint_as_float(w.z << 16); kf[i * 8 + 5] = __uint_as_float(w.z & 0xffff0000u);
                kf[i * 8 + 6] = __uint_as_float(w.w << 16); kf[i * 8 + 7] = __uint_as_float(w.w & 0xffff0000u);
            }
            float score = 0.f;
#pragma unroll 1
            for (int h = 0; h < 8; ++h) {
                float dot = 0.f;
#pragma unroll
                for (int d4 = 0; d4 < 8; ++d4) {
                    const f32x4 a = *(const f32x4*)(iqf + h * 32 + d4 * 4);
                    dot += a[0] * kf[d4 * 4] + a[1] * kf[d4 * 4 + 1] + a[2] * kf[d4 * 4 + 2] + a[3] * kf[d4 * 4 + 3];
                }
                score += wq[h] * fmaxf(dot, 0.f);
            }
            uint32_t kb = __float_as_uint(score);
            kb = (kb & 0x80000000u) ? ~kb : (kb | 0x80000000u);
            keys[s] = kb;
        }
        __syncthreads();
        uint32_t prefix = 0; int need = 256;
        for (int pass = 0; pass < 4; ++pass) {
            const int shift = 24 - 8 * pass;
            if (tid < 256) hist[tid] = 0;
            __syncthreads();
            for (int s = tid; s < n; s += NTHREADS) {
                const uint32_t kb = keys[s];
                if (pass == 0 || (kb >> (shift + 8)) == prefix) atomicAdd(&hist[(kb >> shift) & 255u], 1);
            }
            __syncthreads();
            if (tid < 256) {
                int above = 0;
                for (int d2 = tid + 1; d2 < 256; ++d2) above += hist[d2];
                const int here = hist[tid];
                if (above < need && need <= above + here) { misc[0] = tid; misc[1] = need - above; }
            }
            __syncthreads();
            prefix = (prefix << 8) | (uint32_t)misc[0]; need = misc[1];
            __syncthreads();
        }
        const uint32_t kth = prefix; const int need_eq = need, ngt = 256 - need_eq;
        const int c = (n + NTHREADS - 1) / NTHREADS;
        const int s0 = tid * c, s1 = min(n, s0 + c);
        int cg_ = 0, ce = 0;
        for (int s = s0; s < s1; ++s) { const uint32_t kb = keys[s]; cg_ += kb > kth; ce += kb == kth; }
        int og = block_excl_scan(cg_, wsum, tid);
        int oe = block_excl_scan(ce, wsum, tid);
        for (int s = s0; s < s1; ++s) {
            const uint32_t kb = keys[s];
            if (kb > kth) { sel[og++] = s; }
            else if (kb == kth) { if (oe < need_eq) sel[ngt + oe] = s; ++oe; }
        }
    } else {
        nsel = n;
        if (tid < n) sel[tid] = tid;
    }
    __syncthreads();
    {
        const int h = wid, kvh = h >> 2;
        float lg[4];
#pragma unroll
        for (int jj = 0; jj < 4; ++jj) {
            const int j = lane + 64 * jj;
            float dot = -INFINITY;
            if (j < nsel) {
                const uint4* kp = (const uint4*)(p.k() + (size_t)(b * LP + sel[j]) * 128 + kvh * 64);
                dot = 0.f;
#pragma unroll
                for (int i = 0; i < 8; ++i) {
                    const uint4 w = kp[i];
                    const f32x4 a0 = *(const f32x4*)(qf + h * 64 + i * 8), a1 = *(const f32x4*)(qf + h * 64 + i * 8 + 4);
                    dot += a0[0] * __uint_as_float(w.x << 16) + a0[1] * __uint_as_float(w.x & 0xffff0000u)
                         + a0[2] * __uint_as_float(w.y << 16) + a0[3] * __uint_as_float(w.y & 0xffff0000u)
                         + a1[0] * __uint_as_float(w.z << 16) + a1[1] * __uint_as_float(w.z & 0xffff0000u)
                         + a1[2] * __uint_as_float(w.w << 16) + a1[3] * __uint_as_float(w.w & 0xffff0000u);
                }
            }
            lg[jj] = dot;
        }
        const float mx = wave_max(fmaxf(fmaxf(lg[0], lg[1]), fmaxf(lg[2], lg[3])));
        float ex[4], sm = 0.f;
#pragma unroll
        for (int jj = 0; jj < 4; ++jj) { ex[jj] = (lane + 64 * jj < nsel) ? __expf(lg[jj] - mx) : 0.f; sm += ex[jj]; }
        sm = wave_sum(sm);
        const float inv = 1.0f / sm;
#pragma unroll
        for (int jj = 0; jj < 4; ++jj) probs[h * 256 + lane + 64 * jj] = ex[jj] * inv;
    }
    __syncthreads();
    {
        const int h = wid, kvh = h >> 2;
        float acc = 0.f;
        const bf16_t* vb = p.v() + (size_t)b * LP * 128 + kvh * 64 + lane;
        for (int j = 0; j < nsel; ++j) acc += probs[h * 256 + j] * bf2f(vb[(size_t)sel[j] * 128]);
        p.att()[(size_t)row * 512 + h * 64 + lane] = f2bf(acc);
    }
    __syncthreads();
}

__device__ void ph_mixer(const P& p, unsigned char* lds) {
    int* bc = (int*)(lds + LDS_BYTES - 16);
    if (blockIdx.x < 16) {
        for (int u = blockIdx.x; u < 16; u += gridDim.x) hgrn_unit(p, lds, u);
    }
    for (;;) {
        __syncthreads();
        if (tid_() == 0) bc[0] = atomicAdd(&p.ctr()[97], 1);
        __syncthreads();
        const int u = bc[0];
        if (u >= NTOK) break;
        const int uu = NTOK - 1 - u;
        const int b = uu & 3, tq = uu >> 2;
        attn_unit(p, lds, b * SEQ + tq);
    }
}

struct EpiMix1 { const P* p; int nt;
    __device__ __forceinline__ void operator()(int m, int n, int ns, int fq, f32x4 v) const {
        const size_t o = (size_t)m * 1024 + nt * 256 + n;
        const uint2 g = *(const uint2*)(p->ga() + o);
        f32x4 r; r[0] = v[0] * __uint_as_float(g.x << 16); r[1] = v[1] * __uint_as_float(g.x & 0xffff0000u);
        r[2] = v[2] * __uint_as_float(g.y << 16); r[3] = v[3] * __uint_as_float(g.y & 0xffff0000u);
        *(f32x4*)((float*)p->act() + o) = r;
    } };
struct EpiMix2 { const P* p; int nt;
    __device__ __forceinline__ void operator()(int m, int n, int ns, int fq, f32x4 v) const {
        const size_t o = (size_t)m * 1024 + nt * 256 + n;
        const uint2 g = *(const uint2*)(p->gh() + o);
        const f32x4 a = *(const f32x4*)((float*)p->act() + o);
        f32x4 r; r[0] = a[0] + v[0] * __uint_as_float(g.x << 16); r[1] = a[1] + v[1] * __uint_as_float(g.x & 0xffff0000u);
        r[2] = a[2] + v[2] * __uint_as_float(g.y << 16); r[3] = a[3] + v[3] * __uint_as_float(g.y & 0xffff0000u);
        st_bf4(p->mix() + o, r);
    } };
__device__ void ph_mix(const P& p, unsigned char* lds) {
    const int nunits = (T / 128) * 4;
    for (int u = blockIdx.x; u < nunits; u += gridDim.x) {
        const int nt = u & 3, mt = u >> 2;
        gemm_tile(lds, p.att(), 512, nullptr, mt * 128, p.w_ua + nt * 256, 1024, 256, 512, EpiMix1{&p, nt});
        gemm_tile(lds, p.hgr(), 512, nullptr, mt * 128, p.w_uh + nt * 256, 1024, 256, 512, EpiMix2{&p, nt});
    }
}

struct EpiOut { const P* p; int nt;
    __device__ __forceinline__ void operator()(int m, int n, int ns, int fq, f32x4 v) const {
        const int b = m / LP, pos = m % LP;
        if (pos < NMETA || pos >= L) return;
        const size_t o = ((size_t)b * SEQ + (pos - NMETA)) * D + nt * 256 + n;
        const f32x4 h0 = *(const f32x4*)(p->x + o);
        *(f32x4*)(p->out + o) = h0 + v;
    } };
__device__ void ph_out(const P& p, unsigned char* lds) {
    const int nunits = (T / 128) * 4;
    for (int u = blockIdx.x; u < nunits; u += gridDim.x) {
        const int nt = u & 3, mt = u >> 2;
        gemm_tile(lds, p.mix(), 1024, nullptr, mt * 128, p.w_out + nt * 256, 1024, 256, 1024, EpiOut{&p, nt});
    }
}

__device__ void ph_route(const P& p, unsigned char* lds) {
    const int tid = tid_(), lane = tid & 63, wid = tid >> 6;
    const int gw = blockIdx.x * 8 + wid, nw = gridDim.x * 8;
    const int gt = blockIdx.x * NTHREADS + tid, ntot = gridDim.x * NTHREADS;
    for (int i = gt; i < CAP; i += ntot) p.slot_token()[i] = -1;
    for (int tok = gw; tok < NTOK; tok += nw) {
        const float* src = p.out + (size_t)tok * D;
        f32x4 v[4]; float ss = 0.f;
#pragma unroll
        for (int i = 0; i < 4; ++i) { v[i] = *(const f32x4*)(src + lane * 4 + 256 * i); ss += v[i][0] * v[i][0] + v[i][1] * v[i][1] + v[i][2] * v[i][2] + v[i][3] * v[i][3]; }
        ss = wave_sum(ss);
        const float rs = rsqrtf(ss * (1.0f / D) + EPS);
        float lg[32];
#pragma unroll
        for (int e = 0; e < 32; ++e) lg[e] = 0.f;
#pragma unroll
        for (int i = 0; i < 4; ++i) {
            const f32x4 g = *(const f32x4*)(p.ffn_g + lane * 4 + 256 * i);
            f32x4 xn; xn[0] = v[i][0] * rs * g[0]; xn[1] = v[i][1] * rs * g[1]; xn[2] = v[i][2] * rs * g[2]; xn[3] = v[i][3] * rs * g[3];
            st_bf4(p.xn2() + (size_t)tok * D + lane * 4 + 256 * i, xn);
#pragma unroll
            for (int c = 0; c < 4; ++c) {
                const float* wr_ = p.router_w + (size_t)(lane * 4 + 256 * i + c) * 32;
#pragma unroll
                for (int e4 = 0; e4 < 8; ++e4) {
                    const f32x4 w = *(const f32x4*)(wr_ + e4 * 4);
                    lg[e4 * 4 + 0] += xn[c] * w[0]; lg[e4 * 4 + 1] += xn[c] * w[1]; lg[e4 * 4 + 2] += xn[c] * w[2]; lg[e4 * 4 + 3] += xn[c] * w[3];
                }
            }
        }
#pragma unroll
        for (int e = 0; e < 32; ++e) lg[e] = wave_sum(lg[e]) + p.router_b[e];
        float bv[4]; int bi[4];
#pragma unroll
        for (int k = 0; k < 4; ++k) {
            float best = -INFINITY; int idx = 0;
#pragma unroll
            for (int e = 0; e < 32; ++e) if (lg[e] > best) { best = lg[e]; idx = e; }
            bv[k] = best; bi[k] = idx;
#pragma unroll
            for (int e = 0; e < 32; ++e) lg[e] = (e == idx) ? -INFINITY : lg[e];
        }
        const float e1 = __expf(bv[1] - bv[0]), e2 = __expf(bv[2] - bv[0]), e3 = __expf(bv[3] - bv[0]);
        const float inv = 1.0f / (1.0f + e1 + e2 + e3);
        if (lane == 0) {
            p.tok_exp()[tok * 4 + 0] = bi[0]; p.tok_exp()[tok * 4 + 1] = bi[1]; p.tok_exp()[tok * 4 + 2] = bi[2]; p.tok_exp()[tok * 4 + 3] = bi[3];
            p.tok_gate()[tok * 4 + 0] = inv; p.tok_gate()[tok * 4 + 1] = e1 * inv; p.tok_gate()[tok * 4 + 2] = e2 * inv; p.tok_gate()[tok * 4 + 3] = e3 * inv;
            atomicAdd(&p.ctr()[bi[0]], 1); atomicAdd(&p.ctr()[bi[1]], 1); atomicAdd(&p.ctr()[bi[2]], 1); atomicAdd(&p.ctr()[bi[3]], 1);
        }
    }
}

__device__ void ph_scan(const P& p, unsigned char* lds) {
    if (blockIdx.x == 0 && tid_() == 0) {
        int acc = 0;
        for (int e = 0; e < NE; ++e) {
            p.ctr()[64 + e] = acc;
            const int nb = (p.ctr()[e] + 127) >> 7;
            for (int i = 0; i < nb; ++i) p.block_expert()[(acc >> 7) + i] = e;
            acc += nb * 128;
        }
        p.ctr()[96] = acc >> 7;
    }
}

__device__ void ph_fill(const P& p, unsigned char* lds) {
    const int gt = blockIdx.x * NTHREADS + tid_(), ntot = gridDim.x * NTHREADS;
    for (int i = gt; i < NTOK * 4; i += ntot) {
        const int e = p.tok_exp()[i];
        const int dest = p.ctr()[64 + e] + atomicAdd(&p.ctr()[32 + e], 1);
        p.slot_token()[dest] = i >> 2;
        p.tok_slot()[i] = dest;
    }
}

struct EpiGate { const P* p; int e, nt;
    __device__ __forceinline__ void operator()(int m, int n, int ns, int fq, f32x4 v) const {
        const f32x4 bg = *(const f32x4*)(p->b_gate + (size_t)e * DFF + nt * 256 + n);
        f32x4 g;
#pragma unroll
        for (int j = 0; j < 4; ++j) g[j] = fminf(v[j] + bg[j], 7.0f);
        st_bf4(p->act() + (size_t)m * DFF + nt * 256 + n, g);
    } };
struct EpiUp { const P* p; int e, nt;
    __device__ __forceinline__ void operator()(int m, int n, int ns, int fq, f32x4 v) const {
        const f32x4 bu = *(const f32x4*)(p->b_up + (size_t)e * DFF + nt * 256 + n);
        bf16_t* dst = p->act() + (size_t)m * DFF + nt * 256 + n;
        const uint2 gw = *(const uint2*)dst;
        float g[4] = {__uint_as_float(gw.x << 16), __uint_as_float(gw.x & 0xffff0000u), __uint_as_float(gw.y << 16), __uint_as_float(gw.y & 0xffff0000u)};
        f32x4 a;
#pragma unroll
        for (int j = 0; j < 4; ++j) {
            const float uu = fminf(fmaxf(v[j] + bu[j], -7.0f), 7.0f);
            a[j] = (uu + 1.0f) * (g[j] * sigmoidf_(1.702f * g[j]));
        }
        st_bf4(dst, a);
    } };
struct EpiDown { const P* p; int e, nt;
    __device__ __forceinline__ void operator()(int m, int n, int ns, int fq, f32x4 v) const {
        const f32x4 bd = *(const f32x4*)(p->b_down + (size_t)e * D + nt * 256 + n);
        st_bf4(p->y() + (size_t)m * D + nt * 256 + n, v + bd);
    } };
__device__ void ph_moe1(const P& p, unsigned char* lds) {
    const int nunits = p.ctr()[96] * 4;
    for (int u = blockIdx.x; u < nunits; u += gridDim.x) {
        const int nt = u & 3, rb = u >> 2, e = p.block_expert()[rb];
        gemm_tile(lds, p.xn2(), D, p.slot_token(), rb * 128, p.w_gate + (size_t)e * D * DFF + nt * 256, DFF, 256, D, EpiGate{&p, e, nt});
        gemm_tile(lds, p.xn2(), D, p.slot_token(), rb * 128, p.w_up + (size_t)e * D * DFF + nt * 256, DFF, 256, D, EpiUp{&p, e, nt});
    }
}
__device__ void ph_moe2(const P& p, unsigned char* lds) {
    const int nunits = p.ctr()[96] * 4;
    for (int u = blockIdx.x; u < nunits; u += gridDim.x) {
        const int nt = u & 3, rb = u >> 2, e = p.block_expert()[rb];
        gemm_tile(lds, p.act(), DFF, nullptr, rb * 128, p.w_down + (size_t)e * DFF * D + nt * 256, D, 256, DFF, EpiDown{&p, e, nt});
    }
}

__device__ void ph_final(const P& p, unsigned char* lds) {
    const int tid = tid_(), lane = tid & 63, wid = tid >> 6;
    const int gw = blockIdx.x * 8 + wid, nw = gridDim.x * 8;
    for (int tok = gw; tok < NTOK; tok += nw) {
        float* dst = p.out + (size_t)tok * D;
        f32x4 v[4];
#pragma unroll
        for (int i = 0; i < 4; ++i) v[i] = *(const f32x4*)(dst + lane * 4 + 256 * i);
#pragma unroll
        for (int j = 0; j < 4; ++j) {
            const float g = p.tok_gate()[tok * 4 + j];
            const bf16_t* yr = p.y() + (size_t)p.tok_slot()[tok * 4 + j] * D;
#pragma unroll
            for (int i = 0; i < 4; ++i) {
                const uint2 w = *(const uint2*)(yr + lane * 4 + 256 * i);
                v[i][0] += g * __uint_as_float(w.x << 16); v[i][1] += g * __uint_as_float(w.x & 0xffff0000u);
                v[i][2] += g * __uint_as_float(w.y << 16); v[i][3] += g * __uint_as_float(w.y & 0xffff0000u);
            }
        }
        float ss = 0.f;
#pragma unroll
        for (int i = 0; i < 4; ++i) ss += v[i][0] * v[i][0] + v[i][1] * v[i][1] + v[i][2] * v[i][2] + v[i][3] * v[i][3];
        ss = wave_sum(ss);
        const float rs = rsqrtf(ss * (1.0f / D) + EPS);
#pragma unroll
        for (int i = 0; i < 4; ++i) {
            const f32x4 g = *(const f32x4*)(p.final_g + lane * 4 + 256 * i);
            *(f32x4*)(dst + lane * 4 + 256 * i) = v[i] * rs * g;
        }
    }
}

template <int PH>
__global__ void __launch_bounds__(NTHREADS) k_phase(P p) {
    __shared__ __attribute__((aligned(16))) unsigned char lds[LDS_BYTES];
    if (PH == 0) ph_prep(p, lds);
    if (PH == 1) ph_inproj(p, lds);
    if (PH == 2) ph_mixer(p, lds);
    if (PH == 3) ph_mix(p, lds);
    if (PH == 4) ph_out(p, lds);
    if (PH == 5) ph_route(p, lds);
    if (PH == 6) ph_scan(p, lds);
    if (PH == 7) ph_fill(p, lds);
    if (PH == 8) ph_moe1(p, lds);
    if (PH == 9) ph_moe2(p, lds);
    if (PH == 10) ph_final(p, lds);
}

#if MEGA
__global__ void __launch_bounds__(NTHREADS) k_mega(P p) {
    __shared__ __attribute__((aligned(16))) unsigned char lds[LDS_BYTES];
    cg::grid_group grid = cg::this_grid();
    ph_prep(p, lds); grid.sync();
    ph_inproj(p, lds); grid.sync();
    ph_mixer(p, lds); grid.sync();
    ph_mix(p, lds); grid.sync();
    ph_out(p, lds); grid.sync();
    ph_route(p, lds); grid.sync();
    ph_scan(p, lds); grid.sync();
    ph_fill(p, lds); grid.sync();
    ph_moe1(p, lds); grid.sync();
    ph_moe2(p, lds); grid.sync();
    ph_final(p, lds);
}
#endif

extern "C" void kernel_launch(void* const* d_in, const int* in_sizes, int n_in, void* d_out, int out_size, void* d_ws, size_t ws_size,
                              hipStream_t stream) {
    P p{};
    p.x = (const float*)d_in[0]; p.meta = (const float*)d_in[1]; p.attn_g = (const float*)d_in[2]; p.w_in = (const float*)d_in[3];
    p.hgrn_g = (const float*)d_in[4]; p.w_ua = (const float*)d_in[5]; p.w_uh = (const float*)d_in[6]; p.w_out = (const float*)d_in[7];
    p.lb_logits = (const float*)d_in[8]; p.ffn_g = (const float*)d_in[9]; p.router_w = (const float*)d_in[10]; p.router_b = (const float*)d_in[11];
    p.w_gate = (const float*)d_in[12]; p.b_gate = (const float*)d_in[13]; p.w_up = (const float*)d_in[14]; p.b_up = (const float*)d_in[15];
    p.w_down = (const float*)d_in[16]; p.b_down = (const float*)d_in[17]; p.final_g = (const float*)d_in[18];
    p.out = (float*)d_out;
    p.ws = (unsigned char*)d_ws;
    if (WS_NEED > ws_size) { fprintf(stderr, "workspace too small: need %zu have %zu\n", (size_t)WS_NEED, ws_size); return; }
#if MEGA
    static int grid_blocks = 0;
    if (!grid_blocks) {
        int dev = 0, cus = 0, per_cu = 0;
        hipGetDevice(&dev);
        hipDeviceGetAttribute(&cus, hipDeviceAttributeMultiprocessorCount, dev);
        hipOccupancyMaxActiveBlocksPerMultiprocessor(&per_cu, k_mega, NTHREADS, 0);
        if (per_cu > 1) per_cu = 1;
        grid_blocks = cus * per_cu;
    }
    void* args[] = {&p};
    hipError_t e = hipLaunchCooperativeKernel((void*)k_mega, dim3(grid_blocks), dim3(NTHREADS), args, 0, stream);
    if (e != hipSuccess) fprintf(stderr, "cooperative launch failed: %s (grid %d)\n", hipGetErrorString(e), grid_blocks);
#else
    const int G = 512;
    k_phase<0><<<G, NTHREADS, 0, stream>>>(p);
    k_phase<1><<<G, NTHREADS, 0, stream>>>(p);
    k_phase<2><<<G, NTHREADS, 0, stream>>>(p);
    k_phase<3><<<G, NTHREADS, 0, stream>>>(p);
    k_phase<4><<<G, NTHREADS, 0, stream>>>(p);
    k_phase<5><<<G, NTHREADS, 0, stream>>>(p);
    k_phase<6><<<1, NTHREADS, 0, stream>>>(p);
    k_phase<7><<<G, NTHREADS, 0, stream>>>(p);
    k_phase<8><<<G, NTHREADS, 0, stream>>>(p);
    k_phase<9><<<G, NTHREADS, 0, stream>>>(p);
    k_phase<10><<<G, NTHREADS, 0, stream>>>(p);
#endif
}
```

```cpp
#include <hip/hip_runtime.h>
#include <hip/hip_cooperative_groups.h>
#include <stdint.h>
#include <cstdio>
namespace cg = cooperative_groups;

#ifndef MEGA
#define MEGA 1
#endif

typedef unsigned short bf16_t;
typedef short bf16x8 __attribute__((ext_vector_type(8)));
typedef float f32x4 __attribute__((ext_vector_type(4)));

constexpr int D = 1024, NB = 4, SEQ = 8192, NMETA = 16, L = SEQ + NMETA  , LP = 8320, T = NB * LP  ;
constexpr int NTOK = NB * SEQ;
constexpr int IN_COLS = 5160;
constexpr int NE = 32, TOPK = 4, DFF = 1024;
constexpr int CAP_BLOCKS = (NTOK * TOPK) / 256 + NE;
constexpr int CAP = CAP_BLOCKS * 256;
constexpr float EPS = 1e-5f;
constexpr int NTHREADS = 512;
constexpr int LDS_BYTES = 147456;
constexpr int NVC = 5376;
#define LAS __attribute__((address_space(3)))

__device__ __forceinline__ bf16_t f2bf(float f) {
    uint32_t u = __float_as_uint(f);
    u += 0x7fffu + ((u >> 16) & 1u);
    return (bf16_t)(u >> 16);
}
__device__ __forceinline__ float bf2f(bf16_t h) { return __uint_as_float(((uint32_t)h) << 16); }
__device__ __forceinline__ uint32_t pack2(float a, float b) { return (uint32_t)f2bf(a) | ((uint32_t)f2bf(b) << 16); }
__device__ __forceinline__ float sigmoidf_(float x) { return 1.0f / (1.0f + __expf(-x)); }
__device__ __forceinline__ float wave_sum(float v) {
#pragma unroll
    for (int o = 32; o >= 1; o >>= 1) v += __shfl_xor(v, o);
    return v;
}
__device__ __forceinline__ float wave_max(float v) {
#pragma unroll
    for (int o = 32; o >= 1; o >>= 1) v = fmaxf(v, __shfl_xor(v, o));
    return v;
}

constexpr size_t al256(size_t x) { return (x + 255) & ~(size_t)255; }
constexpr size_t TT = (size_t)T;
constexpr size_t MB1 = 1024 * 1024;
constexpr size_t WE_B = (size_t)NE * 1024 * 1024 * 2;
constexpr size_t OFF_WGT = 0, OFF_WUT = WE_B, OFF_WDT = 2 * WE_B, OFF_XN2 = 3 * WE_B, OFF_ACT = OFF_XN2 + (size_t)NTOK * D * 2,
                 OFF_TAB = OFF_ACT + (size_t)CAP * DFF * 2;
constexpr size_t OFF_Y1 = OFF_XN2, OFF_Y2 = OFF_WGT, OFF_Y3 = OFF_WUT;
constexpr size_t OFF_ROPE = OFF_TAB, OFF_LB = OFF_ROPE + al256((size_t)LP * 24 * 4), OFF_CTR = OFF_LB + al256(512 * 4),
                 OFF_BEXP = OFF_CTR + al256(128 * 4), OFF_SLOT = OFF_BEXP + al256((size_t)CAP_BLOCKS * 4), OFF_SRANK = OFF_SLOT + al256((size_t)CAP * 4),
                 OFF_SGATE = OFF_SRANK + al256((size_t)CAP * 4), OFF_TEXP = OFF_SGATE + al256((size_t)CAP * 4), OFF_TGATE = OFF_TEXP + al256((size_t)NTOK * 16),
                 WS_NEED = OFF_TGATE + al256((size_t)NTOK * 16);
constexpr size_t OFF_WIN = 0, OFF_WUA = OFF_WIN + (size_t)NVC * 1024 * 2, OFF_WUH = OFF_WUA + MB1, OFF_WO = OFF_WUH + MB1, OFF_XN = OFF_WO + 2 * MB1,
                 OFF_Q = OFF_XN + TT * 2048, OFF_K = OFF_Q + TT * 1024, OFF_V = OFF_K + TT * 256, OFF_IQ = OFF_V + TT * 256, OFF_IK = OFF_IQ + TT * 512,
                 OFF_IW = OFF_IK + TT * 64, OFF_HQ = OFF_IW + TT * 32, OFF_HF = OFF_HQ + TT * 1024, OFF_HI = OFF_HF + TT * 1024, OFF_HG = OFF_HI + TT * 1024,
                 OFF_GA = OFF_HG + TT * 1024, OFF_GH = OFF_GA + TT * 2048, OFF_ATT = OFF_GH + TT * 2048, OFF_HGR = OFF_ATT + TT * 1024,
                 OFF_S1_END = OFF_HGR + TT * 1024;
constexpr size_t OFF_MIX = OFF_XN;
static_assert(OFF_S1_END <= OFF_TAB, "stage-1 layout overflows");

__device__ __forceinline__ int tid_() { int t = threadIdx.x; asm volatile("" : "+v"(t)); return t; }

struct P {
    const float *x, *meta, *attn_g, *w_in, *hgrn_g, *w_ua, *w_uh, *w_out, *lb_logits, *ffn_g, *router_w, *router_b,
        *w_gate, *b_gate, *w_up, *b_up, *w_down, *b_down, *final_g;
    float* out;
    unsigned char* ws;
#define WSF(type, name, off) __device__ __forceinline__ type* name() const { return (type*)(ws + (off)); }
    WSF(bf16_t, xn, OFF_XN) WSF(bf16_t, q, OFF_Q) WSF(bf16_t, k, OFF_K) WSF(bf16_t, v, OFF_V) WSF(bf16_t, iq, OFF_IQ) WSF(bf16_t, ik, OFF_IK)
    WSF(bf16_t, hq, OFF_HQ) WSF(bf16_t, hf, OFF_HF) WSF(bf16_t, hi, OFF_HI) WSF(bf16_t, hg, OFF_HG) WSF(bf16_t, ga, OFF_GA) WSF(bf16_t, gh, OFF_GH)
    WSF(bf16_t, att, OFF_ATT) WSF(bf16_t, hgr, OFF_HGR) WSF(bf16_t, mix, OFF_MIX) WSF(bf16_t, xn2, OFF_XN2) WSF(bf16_t, act, OFF_ACT)
    WSF(bf16_t, y1, OFF_Y1) WSF(bf16_t, y2, OFF_Y2) WSF(bf16_t, y3, OFF_Y3)
    WSF(bf16_t, winT, OFF_WIN) WSF(bf16_t, wuaT, OFF_WUA) WSF(bf16_t, wuhT, OFF_WUH) WSF(bf16_t, woT, OFF_WO)
    WSF(bf16_t, wgT, OFF_WGT) WSF(bf16_t, wuT, OFF_WUT) WSF(bf16_t, wdT, OFF_WDT)
    WSF(float, iw, OFF_IW) WSF(float, rope, OFF_ROPE) WSF(float, lb, OFF_LB) WSF(float, tok_gate, OFF_TGATE) WSF(float, slot_gate, OFF_SGATE)
    WSF(int, ctr, OFF_CTR)
    WSF(int, block_expert, OFF_BEXP) WSF(int, slot_token, OFF_SLOT) WSF(int, slot_rank, OFF_SRANK) WSF(int, tok_exp, OFF_TEXP)
};

template <class ColMap>
__device__ __forceinline__ void convert_T(const float* W, int ldw, bf16_t* out, int K, int N, const ColMap& cmap, int gt, int ntot) {
    const int kb = K / 64; const long ntask = (long)N * kb;
    for (long task = gt; task < ntask; task += ntot) {
        const int kq = (int)(task / N), n = (int)(task % N);
        const int c = cmap(n);
        uint32_t w[32];
        if (c >= 0) {
            const float* src = W + (size_t)(kq * 64) * ldw + c;
            float v[64];
#pragma unroll
            for (int i = 0; i < 64; ++i) v[i] = src[(size_t)i * ldw];
#pragma unroll
            for (int i = 0; i < 32; ++i) w[i] = pack2(v[2 * i], v[2 * i + 1]);
        } else {
#pragma unroll
            for (int i = 0; i < 32; ++i) w[i] = 0u;
        }
        uint4* dst = (uint4*)(out + (size_t)n * K + kq * 64);
#pragma unroll
        for (int i = 0; i < 8; ++i) dst[i] = make_uint4(w[4 * i], w[4 * i + 1], w[4 * i + 2], w[4 * i + 3]);
    }
}
struct IdMap { __device__ __forceinline__ int operator()(int n) const { return n; } };
struct WinMap { __device__ __forceinline__ int operator()(int n) const { return n < 1064 ? n : (n < 1280 ? -1 : n - 216); } };

__device__ void ph_prep(const P& p, unsigned char* lds) {
    const int tid = tid_(), lane = tid & 63, wid = tid >> 6;
    const int gw = blockIdx.x * 8 + wid, nw = gridDim.x * 8;
    for (int r = gw; r < T; r += nw) {
        const int b = r / LP, pos = r % LP;
        bf16_t* dst = p.xn() + (size_t)r * D;
        if (pos >= L) {
#pragma unroll
            for (int i = 0; i < 4; ++i) *(uint2*)(dst + lane * 4 + 256 * i) = make_uint2(0u, 0u);
            continue;
        }
        const float* src = pos < NMETA ? p.meta + (size_t)pos * D : p.x + ((size_t)b * SEQ + (pos - NMETA)) * D;
        f32x4 v[4]; float ss = 0.f;
#pragma unroll
        for (int i = 0; i < 4; ++i) { v[i] = *(const f32x4*)(src + lane * 4 + 256 * i); ss += v[i][0] * v[i][0] + v[i][1] * v[i][1] + v[i][2] * v[i][2] + v[i][3] * v[i][3]; }
        ss = wave_sum(ss);
        const float rs = rsqrtf(ss * (1.0f / D) + EPS);
#pragma unroll
        for (int i = 0; i < 4; ++i) {
            const f32x4 g = *(const f32x4*)(p.attn_g + lane * 4 + 256 * i);
            uint2 o; o.x = pack2(v[i][0] * rs * g[0], v[i][1] * rs * g[1]); o.y = pack2(v[i][2] * rs * g[2], v[i][3] * rs * g[3]);
            *(uint2*)(dst + lane * 4 + 256 * i) = o;
        }
    }
    const int gt = blockIdx.x * NTHREADS + tid, nt = gridDim.x * NTHREADS;
    for (int i = gt; i < LP * 12; i += nt) {
        const int pos = i / 12, f = i % 12;
        const double ex = f < 8 ? -(double)f / 8.0 : -(double)(f - 8) / 4.0;
        const double inv = exp(ex * log(500000.0));
        const double ang = (double)pos * inv;
        const double twopi = 6.283185307179586476925286766559;
        const double r = ang - twopi * rint(ang / twopi);
        const float rf = (float)r;
        const float c = cosf(rf), s = sinf(rf);
        float* row = p.rope() + (size_t)pos * 24;
        if (f < 8) { row[f] = c; row[8 + f] = s; } else { row[16 + f - 8] = c; row[20 + f - 8] = s; }
    }
    for (int i = gt; i < 512; i += nt) {
        const float a = p.lb_logits[i], b2 = p.lb_logits[512 + i];
        p.lb()[i] = 1.0f / (1.0f + expf(b2 - a));
    }
    for (int i = gt; i < 128; i += nt) p.ctr()[i] = 0;
    convert_T(p.w_in, IN_COLS, p.winT(), 1024, NVC, WinMap{}, gt, nt);
    convert_T(p.w_ua, 1024, p.wuaT(), 512, 1024, IdMap{}, gt, nt);
    convert_T(p.w_uh, 1024, p.wuhT(), 512, 1024, IdMap{}, gt, nt);
    convert_T(p.w_out, 1024, p.woT(), 1024, 1024, IdMap{}, gt, nt);
}
constexpr int G_TILE_B = 256 * 64 * 2, G_STAGE_B = 2 * G_TILE_B;
__device__ __forceinline__ int g_lds_byte(int r, int c) { const int st = (r >> 4) * 2 + (c >> 5), ob = (r & 15) * 64 + (c & 31) * 2; return st * 1024 + (ob ^ (((ob >> 9) & 1) << 5)); }
__device__ __forceinline__ void g_stage_rc(int b, int& R, int& C) { const int st = b >> 10, sb = b & 1023, swz = sb ^ (((sb >> 9) & 1) << 5); R = (st >> 1) * 16 + swz / 64; C = (st & 1) * 32 + (swz % 64) / 2; }

template <class AOff, class BOff>
__device__ __forceinline__ void gemm256(unsigned char* lds_, const bf16_t* Abase, const AOff& aoff, const bf16_t* Bbase, const BOff& boff, int K, f32x4 (&acc)[8][4]) {
    LAS unsigned char* lds = (LAS unsigned char*)lds_;
    const int tid = tid_(), lane = tid & 63, wid = __builtin_amdgcn_readfirstlane(tid >> 6), wr = wid >> 2, wc = wid & 3, fr = lane & 15, fq = lane >> 4;
    const bf16_t* pa[4]; const bf16_t* pb[4];
#pragma unroll
    for (int i = 0; i < 4; ++i) { int R, C; g_stage_rc(wid * 1024 + i * 8192 + lane * 16, R, C); pa[i] = Abase + aoff(R) + C; pb[i] = Bbase + boff(R) + C; }
#pragma unroll
    for (int m = 0; m < 8; ++m)
#pragma unroll
        for (int n = 0; n < 4; ++n) acc[m][n] = (f32x4){0.f, 0.f, 0.f, 0.f};
    const int nt = K / 64;
#define G_STAGE(buf, kt) do { _Pragma("unroll") for (int i_ = 0; i_ < 4; ++i_) { \
        __builtin_amdgcn_global_load_lds((const unsigned*)(pa[i_] + (kt) * 64), (LAS unsigned*)(lds + (buf) * G_STAGE_B + wid * 1024 + i_ * 8192), 16, 0, 0); \
        __builtin_amdgcn_global_load_lds((const unsigned*)(pb[i_] + (kt) * 64), (LAS unsigned*)(lds + (buf) * G_STAGE_B + G_TILE_B + wid * 1024 + i_ * 8192), 16, 0, 0); } } while (0)
    const int aoffs = g_lds_byte(wr * 128 + fr, fq * 8), boffs = g_lds_byte(wc * 64 + fr, fq * 8);
    G_STAGE(0, 0);
    asm volatile("s_waitcnt vmcnt(0)" ::: "memory");
    __syncthreads();
    for (int t = 0; t < nt; ++t) {
        const int cur = t & 1;
        if (t + 1 < nt) G_STAGE(cur ^ 1, t + 1);
#pragma unroll
        for (int ks = 0; ks < 2; ++ks) {
            bf16x8 At[8], Bf[4];
#pragma unroll
            for (int m = 0; m < 8; ++m) At[m] = *(const LAS bf16x8*)(lds + cur * G_STAGE_B + aoffs + m * 2048 + ks * 1024);
#pragma unroll
            for (int n = 0; n < 4; ++n) Bf[n] = *(const LAS bf16x8*)(lds + cur * G_STAGE_B + G_TILE_B + boffs + n * 2048 + ks * 1024);
#pragma unroll
            for (int m = 0; m < 8; ++m)
#pragma unroll
                for (int n = 0; n < 4; ++n) acc[m][n] = __builtin_amdgcn_mfma_f32_16x16x32_bf16(Bf[n], At[m], acc[m][n], 0, 0, 0);
            __builtin_amdgcn_sched_barrier(0);
        }
        asm volatile("s_waitcnt vmcnt(0)" ::: "memory");
        __syncthreads();
    }
#undef G_STAGE
}
struct RowLin { size_t base; int ld; __device__ __forceinline__ size_t operator()(int R) const { return base + (size_t)R * ld; } };

__device__ __forceinline__ void st_bf4(bf16_t* dst, f32x4 v) {
    uint2 o; o.x = pack2(v[0], v[1]); o.y = pack2(v[2], v[3]); *(uint2*)dst = o;
}
#define EPI_LOOP(...) do { const int tid_e = tid_(), lane_e = tid_e & 63, wid_e = tid_e >> 6, wr = wid_e >> 2, wc = wid_e & 3, fr = lane_e & 15, fq = lane_e >> 4; \
    _Pragma("unroll") for (int m = 0; m < 8; ++m) _Pragma("unroll") for (int n = 0; n < 4; ++n) { const int row = wr * 128 + m * 16 + fr, col = wc * 64 + n * 16 + fq * 4; __VA_ARGS__ } } while (0)

struct EpiInproj {
    const P* p; int nt;
    __device__ __forceinline__ void operator()(int m, int n, int ns, int fq, f32x4 v) const {
        const P& P_ = *p;
        const int pos = m % LP;
        const float* rp = P_.rope() + (size_t)pos * 24;
        if (nt <= 2) {
            const bool isv = (nt == 2) && (n >= 128);
            if (!isv && ns == 0) {
                f32x4 pr;
#pragma unroll
                for (int j = 0; j < 4; ++j) pr[j] = __shfl_xor(v[j], 32);
                const int i0 = (fq & 1) * 4;
#pragma unroll
                for (int j = 0; j < 4; ++j) {
                    const float c = rp[i0 + j], s = rp[8 + i0 + j];
                    v[j] = fq < 2 ? v[j] * c - pr[j] * s : v[j] * c + pr[j] * s;
                }
            }
            if (nt < 2) { st_bf4(P_.q() + (size_t)m * 512 + nt * 256 + n, v * (0.125f * 1.4426950408889634f)); }
            else if (n < 128) st_bf4(P_.k() + (size_t)m * 128 + n, v);
            else st_bf4(P_.v() + (size_t)m * 128 + (n - 128), v);
        } else if (nt == 3 || nt == 4) {
            const bool ropeable = (nt == 3) ? ((ns & 1) == 0) : (n < 16);
            if (ropeable) {
                f32x4 pr;
#pragma unroll
                for (int j = 0; j < 4; ++j) pr[j] = __shfl_xor(v[j], 16);
                if (fq < 2) {
#pragma unroll
                    for (int j = 0; j < 4; ++j) {
                        const float c = rp[16 + j], s = rp[20 + j];
                        v[j] = fq == 0 ? v[j] * c - pr[j] * s : v[j] * c + pr[j] * s;
                    }
                }
            }
            if (nt == 3) st_bf4(P_.iq() + (size_t)m * 256 + n, v);
            else if (n < 32) st_bf4(P_.ik() + (size_t)m * 32 + n, v);
            else if (n < 40) *(f32x4*)(P_.iw() + (size_t)m * 8 + (n - 32)) = v;
        } else if (nt <= 6) { st_bf4(P_.hq() + (size_t)m * 512 + (nt - 5) * 256 + n, v * 0.08838834764831845f); }
        else if (nt <= 8) { st_bf4(P_.hf() + (size_t)m * 512 + (nt - 7) * 256 + n, v); }
        else if (nt <= 10) { st_bf4(P_.hi() + (size_t)m * 512 + (nt - 9) * 256 + n, v); }
        else if (nt <= 12) {
            f32x4 o;
#pragma unroll
            for (int j = 0; j < 4; ++j) o[j] = v[j] * sigmoidf_(v[j]);
            st_bf4(P_.hg() + (size_t)m * 512 + (nt - 11) * 256 + n, o);
        } else {
            f32x4 o;
#pragma unroll
            for (int j = 0; j < 4; ++j) o[j] = sigmoidf_(v[j]);
            if (nt <= 16) st_bf4(P_.ga() + (size_t)m * 1024 + (nt - 13) * 256 + n, o);
            else st_bf4(P_.gh() + (size_t)m * 1024 + (nt - 17) * 256 + n, o);
        }
    }
};

__device__ void ph_inproj(const P& p, unsigned char* lds) {
    const int nunits = (T / 256) * 21;
    for (int u = blockIdx.x; u < nunits; u += gridDim.x) {
        const int nt = u % 21, mt = u / 21;
        f32x4 acc[8][4];
        gemm256(lds, p.xn(), RowLin{(size_t)mt * 256 * D, D}, p.winT(), RowLin{(size_t)nt * 256 * D, D}, D, acc);
        const EpiInproj epi{&p, nt};
        EPI_LOOP( epi(mt * 256 + row, col, n, fq, acc[m][n]); );
    }
}

constexpr int NCH = 129, NXU = 16 * NCH;
constexpr int X_QT = 0, X_KT = X_QT + 64 * 272, X_KH = X_KT + 64 * 272, X_VT = X_KH + 128 * 144, X_AS = X_VT + 128 * 144, X_SEG = X_AS + 64 * 144;
__device__ __forceinline__ bf16_t* hg_ds(const P& p) { return (bf16_t*)p.out; }
__device__ __forceinline__ float* hg_g(const P& p) { return (float*)((unsigned char*)p.out + (size_t)NXU * 32768); }

__device__ void hgx_unit(const P& p, unsigned char* lds, int u) {
    const int tid = tid_(), lane = tid & 63, wid = tid >> 6, fr = lane & 15, fq = lane >> 4;
    const int c = u % NCH, bh = u / NCH, b = bh >> 2, h = bh & 3;
    const int d = tid & 127, seg = tid >> 7;
    const size_t rowbase = (size_t)(b * LP + c * 64 + seg * 16) * 512 + h * 128 + d;
    bf16_t* hqp = p.hq() + rowbase; const bf16_t* hfp = p.hf() + rowbase; const bf16_t* hip = p.hi() + rowbase;
    const float lbv = p.lb()[h * 128 + d];
    float bb[16], qv[16], kk[16], vv[16];
    float cs = 0.f;
#pragma unroll
    for (int i = 0; i < 16; ++i) {
        const float f = lbv + (1.0f - lbv) * sigmoidf_(bf2f(hfp[(size_t)i * 512]));
        kk[i] = 1.0f - f; cs += __logf(f); bb[i] = cs;
        qv[i] = bf2f(hqp[(size_t)i * 512]); vv[i] = bf2f(hip[(size_t)i * 512]);
    }
    float* segs = (float*)(lds + X_SEG);
    segs[seg * 128 + d] = cs;
    __syncthreads();
    const float s0 = segs[d], s1 = segs[128 + d], s2 = segs[256 + d], s3 = segs[384 + d];
    const float off = seg == 0 ? 0.f : (seg == 1 ? s0 : (seg == 2 ? s0 + s1 : s0 + s1 + s2));
    const float rref = s0 + s1, blast = (s0 + s1) + (s2 + s3);
    uint32_t khp[8], vtp[8];
#pragma unroll
    for (int i = 0; i < 16; i += 2) {
        float khv[2];
#pragma unroll
        for (int j = 0; j < 2; ++j) {
            const float bt = bb[i + j] + off;
            const float eq = __expf(fminf(bt - rref, 80.f)), ek = __expf(fminf(rref - bt, 80.f));
            const int t = seg * 16 + i + j;
            *(bf16_t*)(lds + X_QT + t * 272 + d * 2) = f2bf(qv[i + j] * eq);
            *(bf16_t*)(lds + X_KT + t * 272 + d * 2) = f2bf(kk[i + j] * ek);
            hqp[(size_t)(i + j) * 512] = f2bf(qv[i + j] * __expf(bt));
            khv[j] = kk[i + j] * __expf(blast - bt);
        }
        khp[i >> 1] = pack2(khv[0], khv[1]); vtp[i >> 1] = pack2(vv[i], vv[i + 1]);
    }
    *(uint4*)(lds + X_KH + d * 144 + seg * 32) = make_uint4(khp[0], khp[1], khp[2], khp[3]);
    *(uint4*)(lds + X_KH + d * 144 + seg * 32 + 16) = make_uint4(khp[4], khp[5], khp[6], khp[7]);
    *(uint4*)(lds + X_VT + d * 144 + seg * 32) = make_uint4(vtp[0], vtp[1], vtp[2], vtp[3]);
    *(uint4*)(lds + X_VT + d * 144 + seg * 32 + 16) = make_uint4(vtp[4], vtp[5], vtp[6], vtp[7]);
    if (seg == 0) hg_g(p)[(size_t)u * 128 + d] = __expf(blast);
    __syncthreads();
    {
        const int tm = wid >> 1, tn0 = (wid & 1) * 2;
        f32x4 a1[2] = {(f32x4){0.f, 0.f, 0.f, 0.f}, (f32x4){0.f, 0.f, 0.f, 0.f}};
#pragma unroll
        for (int ks = 0; ks < 4; ++ks) {
            const bf16x8 aq = *(const bf16x8*)(lds + X_QT + (tm * 16 + fr) * 272 + (ks * 32 + fq * 8) * 2);
#pragma unroll
            for (int j = 0; j < 2; ++j) {
                const bf16x8 bk = *(const bf16x8*)(lds + X_KT + ((tn0 + j) * 16 + fr) * 272 + (ks * 32 + fq * 8) * 2);
                a1[j] = __builtin_amdgcn_mfma_f32_16x16x32_bf16(bk, aq, a1[j], 0, 0, 0);
            }
        }
#pragma unroll
        for (int j = 0; j < 2; ++j) {
            const int t = tm * 16 + fr, sb = (tn0 + j) * 16 + fq * 4;
            f32x4 v = a1[j];
#pragma unroll
            for (int jj = 0; jj < 4; ++jj) v[jj] = (sb + jj <= t) ? v[jj] : 0.f;
            uint2 o; o.x = pack2(v[0], v[1]); o.y = pack2(v[2], v[3]);
            *(uint2*)(lds + X_AS + t * 144 + sb * 2) = o;
        }
    }
    __syncthreads();
    {
        const int tm = wid >> 1, en0 = (wid & 1) * 4;
        f32x4 o2[4];
#pragma unroll
        for (int j = 0; j < 4; ++j) o2[j] = (f32x4){0.f, 0.f, 0.f, 0.f};
#pragma unroll
        for (int ks = 0; ks < 2; ++ks) {
            const bf16x8 aa = *(const bf16x8*)(lds + X_AS + (tm * 16 + fr) * 144 + (ks * 32 + fq * 8) * 2);
#pragma unroll
            for (int j = 0; j < 4; ++j) {
                const bf16x8 bv = *(const bf16x8*)(lds + X_VT + ((en0 + j) * 16 + fr) * 144 + (ks * 32 + fq * 8) * 2);
                o2[j] = __builtin_amdgcn_mfma_f32_16x16x32_bf16(bv, aa, o2[j], 0, 0, 0);
            }
        }
        bf16_t* orow = p.hf() + (size_t)(b * LP + c * 64 + tm * 16 + fr) * 512 + h * 128;
#pragma unroll
        for (int j = 0; j < 4; ++j) st_bf4(orow + (en0 + j) * 16 + fq * 4, o2[j]);
    }
    {
        f32x4 s3[8];
#pragma unroll
        for (int j = 0; j < 8; ++j) s3[j] = (f32x4){0.f, 0.f, 0.f, 0.f};
#pragma unroll
        for (int ks = 0; ks < 2; ++ks) {
            const bf16x8 ak = *(const bf16x8*)(lds + X_KH + (wid * 16 + fr) * 144 + (ks * 32 + fq * 8) * 2);
#pragma unroll
            for (int j = 0; j < 8; ++j) {
                const bf16x8 bv = *(const bf16x8*)(lds + X_VT + (j * 16 + fr) * 144 + (ks * 32 + fq * 8) * 2);
                s3[j] = __builtin_amdgcn_mfma_f32_16x16x32_bf16(ak, bv, s3[j], 0, 0, 0);
            }
        }
        bf16_t* dsb = hg_ds(p) + (size_t)u * 16384;
#pragma unroll
        for (int j = 0; j < 8; ++j) st_bf4(dsb + (size_t)(j * 16 + fr) * 128 + wid * 16 + fq * 4, s3[j]);
    }
    __syncthreads();
}

__device__ void hgchain_unit(const P& p, int bh) {
    const int tid = tid_(), e = tid & 127, dr = tid >> 7;
    float S[32];
#pragma unroll
    for (int i = 0; i < 32; ++i) S[i] = 0.f;
    uint4* ptr = (uint4*)(hg_ds(p) + ((size_t)(bh * NCH) * 128 + e) * 128 + dr * 32);
    const f32x4* gp = (const f32x4*)(hg_g(p) + (size_t)(bh * NCH) * 128 + dr * 32);
    uint4 w[4]; f32x4 g[8];
#pragma unroll
    for (int i = 0; i < 4; ++i) w[i] = ptr[i];
#pragma unroll
    for (int i = 0; i < 8; ++i) g[i] = gp[i];
    for (int c = 0; c < NCH; ++c) {
        uint4 wn[4]; f32x4 gn[8];
        uint4* pn = ptr + 16384 * 2 / 16;
        const f32x4* gpn = gp + 32;
        if (c + 1 < NCH) {
#pragma unroll
            for (int i = 0; i < 4; ++i) wn[i] = pn[i];
#pragma unroll
            for (int i = 0; i < 8; ++i) gn[i] = gpn[i];
        }
#pragma unroll
        for (int i = 0; i < 4; ++i)
            ptr[i] = make_uint4(pack2(S[8 * i], S[8 * i + 1]), pack2(S[8 * i + 2], S[8 * i + 3]), pack2(S[8 * i + 4], S[8 * i + 5]), pack2(S[8 * i + 6], S[8 * i + 7]));
#pragma unroll
        for (int i = 0; i < 4; ++i) {
            const uint32_t ww[4] = {w[i].x, w[i].y, w[i].z, w[i].w};
#pragma unroll
            for (int j = 0; j < 4; ++j) {
                const float lo = __uint_as_float(ww[j] << 16), hi = __uint_as_float(ww[j] & 0xffff0000u);
                S[8 * i + 2 * j] = g[2 * i + (j >> 1)][(2 * j) & 3] * S[8 * i + 2 * j] + lo;
                S[8 * i + 2 * j + 1] = g[2 * i + (j >> 1)][(2 * j + 1) & 3] * S[8 * i + 2 * j + 1] + hi;
            }
        }
        if (c + 1 < NCH) {
#pragma unroll
            for (int i = 0; i < 4; ++i) w[i] = wn[i];
#pragma unroll
            for (int i = 0; i < 8; ++i) g[i] = gn[i];
        }
        ptr = pn; gp = gpn;
    }
}

__device__ void hgz_unit(const P& p, unsigned char* lds, int u) {
    const int tid = tid_(), lane = tid & 63, wid = tid >> 6, fr = lane & 15, fq = lane >> 4;
    const int c = u % NCH, bh = u / NCH, b = bh >> 2, h = bh & 3;
    const int tm = wid >> 1, en0 = (wid & 1) * 4;
    const size_t row = (size_t)(b * LP + c * 64 + tm * 16 + fr);
    const bf16_t* qrow = p.hq() + row * 512 + h * 128;
    const bf16_t* sT = hg_ds(p) + (size_t)u * 16384;
    f32x4 o[4];
#pragma unroll
    for (int j = 0; j < 4; ++j) o[j] = (f32x4){0.f, 0.f, 0.f, 0.f};
#pragma unroll
    for (int ks = 0; ks < 4; ++ks) {
        const bf16x8 aq = *(const bf16x8*)(qrow + ks * 32 + fq * 8);
#pragma unroll
        for (int j = 0; j < 4; ++j) {
            const bf16x8 bs = *(const bf16x8*)(sT + (size_t)((en0 + j) * 16 + fr) * 128 + ks * 32 + fq * 8);
            o[j] = __builtin_amdgcn_mfma_f32_16x16x32_bf16(bs, aq, o[j], 0, 0, 0);
        }
    }
    const bf16_t* oi = p.hf() + row * 512 + h * 128;
    float ss = 0.f;
#pragma unroll
    for (int j = 0; j < 4; ++j) {
        const uint2 w = *(const uint2*)(oi + (en0 + j) * 16 + fq * 4);
        o[j][0] += __uint_as_float(w.x << 16); o[j][1] += __uint_as_float(w.x & 0xffff0000u);
        o[j][2] += __uint_as_float(w.y << 16); o[j][3] += __uint_as_float(w.y & 0xffff0000u);
        ss += o[j][0] * o[j][0] + o[j][1] * o[j][1] + o[j][2] * o[j][2] + o[j][3] * o[j][3];
    }
    ss += __shfl_xor(ss, 16); ss += __shfl_xor(ss, 32);
    float* part = (float*)lds;
    if (fq == 0) part[(tm * 16 + fr) * 2 + (wid & 1)] = ss;
    __syncthreads();
    const float tot = part[(tm * 16 + fr) * 2] + part[(tm * 16 + fr) * 2 + 1];
    const float rs = rsqrtf(tot * (1.0f / 128.0f) + EPS);
    const bf16_t* hgp = p.hg() + row * 512 + h * 128;
    bf16_t* outp = p.hgr() + row * 512 + h * 128;
#pragma unroll
    for (int j = 0; j < 4; ++j) {
        const int e0 = (en0 + j) * 16 + fq * 4;
        const f32x4 gn = *(const f32x4*)(p.hgrn_g + h * 128 + e0);
        const uint2 w = *(const uint2*)(hgp + e0);
        f32x4 r;
        r[0] = o[j][0] * rs * gn[0] * __uint_as_float(w.x << 16); r[1] = o[j][1] * rs * gn[1] * __uint_as_float(w.x & 0xffff0000u);
        r[2] = o[j][2] * rs * gn[2] * __uint_as_float(w.y << 16); r[3] = o[j][3] * rs * gn[3] * __uint_as_float(w.y & 0xffff0000u);
        st_bf4(outp + e0, r);
    }
    __syncthreads();
}

typedef float f32x16 __attribute__((ext_vector_type(16)));
typedef short s16x4 __attribute__((ext_vector_type(4)));
constexpr int NKMAX = 8224;
constexpr int A_SC = 0, A_H1 = A_SC + 4 * NKMAX * 4, A_H2 = A_H1 + 4096, A_SEL = A_H2 + 4096, A_CAND = A_SEL + 2048, A_META = A_CAND + 1024, A_END = A_META + 256;
static_assert(A_END <= LDS_BYTES - 16, "attention LDS");
__device__ __forceinline__ uint32_t skey(float f) { const uint32_t u = __float_as_uint(f); return (u & 0x80000000u) ? ~u : (u | 0x80000000u); }
__device__ __forceinline__ float skey_inv(uint32_t k) { return __uint_as_float((k & 0x80000000u) ? (k & 0x7fffffffu) : ~k); }
__device__ __forceinline__ void bins12(float s, float lo, float scale, int& b1, int& b2) {
    const float x = (s - lo) * scale;
    b1 = min(255, max(0, (int)x));
    const float fr = x - (float)b1;
    b2 = min(255, max(0, (int)(fr * 256.0f)));
}
template <int OFF> __device__ __forceinline__ s16x4 tr_read(unsigned addr) {
    s16x4 r; asm volatile("ds_read_b64_tr_b16 %0, %1 offset:%2" : "=&v"(r) : "v"(addr), "i"(OFF) : "memory"); return r;
}
__device__ __forceinline__ void scan_top(const int* hist, int K, int* m, int lane) {
    const int c0 = hist[4 * lane], c1 = hist[4 * lane + 1], c2 = hist[4 * lane + 2], c3 = hist[4 * lane + 3];
    const int tot = c0 + c1 + c2 + c3;
    int suf = tot;
#pragma unroll
    for (int o = 1; o < 64; o <<= 1) { const int t = __shfl_down(suf, o); if (lane + o < 64) suf += t; }
    const int a3 = suf - tot, a2 = a3 + c3, a1 = a2 + c2, a0 = a1 + c1;
    if (a3 < K && K <= a3 + c3) { m[0] = 4 * lane + 3; m[1] = a3; m[2] = c3; }
    if (a2 < K && K <= a2 + c2) { m[0] = 4 * lane + 2; m[1] = a2; m[2] = c2; }
    if (a1 < K && K <= a1 + c1) { m[0] = 4 * lane + 1; m[1] = a1; m[2] = c1; }
    if (a0 < K && K <= a0 + c0) { m[0] = 4 * lane + 0; m[1] = a0; m[2] = c0; }
}

__device__ void attn4_unit(const P& p, unsigned char* lds, int b, int grp) {
    const int tid = tid_(), lane = tid & 63, wid = __builtin_amdgcn_readfirstlane(tid >> 6);
    const int t0 = NMETA + 4 * grp;
    const int brow = b * LP, row0 = brow + t0;
    float* sc = (float*)(lds + A_SC);
    int* h1 = (int*)(lds + A_H1); int* h2 = (int*)(lds + A_H2);
    unsigned short* sel = (unsigned short*)(lds + A_SEL); unsigned short* cand = (unsigned short*)(lds + A_CAND);
    int* meta = (int*)(lds + A_META);
    const bool big = t0 + 1 > 256;
    for (int i = tid; i < 2048; i += NTHREADS) h1[i] = 0;
    if (tid < 64) { const int w = tid & 15; meta[tid] = (w == 0) ? -1 : 0; }
    if (!big) { for (int i = tid; i < 1024; i += NTHREADS) { const int q = i >> 8, j = i & 255; sel[i] = (unsigned short)(j <= t0 + q ? j : 0); } }
    __syncthreads();
    if (big) {
        {
            const int hh = lane >> 5, c32 = lane & 31;
            const int g = c32 >> 3, h2a = (c32 >> 2) & 1, bq = c32 & 3, aq = 2 * h2a + (g >> 1), ah = 4 * (g & 1) + bq;
            const bf16_t* ap = p.iq() + (size_t)(row0 + aq) * 256 + ah * 32 + 8 * hh;
            const bf16x8 a0 = *(const bf16x8*)ap, a1 = *(const bf16x8*)(ap + 16);
            const f32x4 w00 = *(const f32x4*)(p.iw() + (size_t)(row0 + 2 * hh) * 8), w01 = *(const f32x4*)(p.iw() + (size_t)(row0 + 2 * hh) * 8 + 4);
            const f32x4 w10 = *(const f32x4*)(p.iw() + (size_t)(row0 + 2 * hh + 1) * 8), w11 = *(const f32x4*)(p.iw() + (size_t)(row0 + 2 * hh + 1) * 8 + 4);
            const int ntiles = (t0 + 4 + 31) >> 5;
            const int tq0 = t0 + 2 * hh;
            float mx0 = -INFINITY, mn0 = INFINITY, mx1 = -INFINITY, mn1 = INFINITY;
            const bf16_t* kbase = p.ik() + (size_t)brow * 32 + 8 * hh;
            for (int tile = wid; tile < ntiles; tile += 8) {
                const int key = tile * 32 + c32;
                const bf16_t* kp = kbase + (size_t)key * 32;
                const bf16x8 b0 = *(const bf16x8*)kp, b1 = *(const bf16x8*)(kp + 16);
                f32x16 acc;
#pragma unroll
                for (int i = 0; i < 16; ++i) acc[i] = 0.f;
                acc = __builtin_amdgcn_mfma_f32_32x32x16_bf16(a0, b0, acc, 0, 0, 0);
                acc = __builtin_amdgcn_mfma_f32_32x32x16_bf16(a1, b1, acc, 0, 0, 0);
                float s0 = 0.f, s1 = 0.f;
#pragma unroll
                for (int i = 0; i < 4; ++i) {
                    s0 += w00[i] * fmaxf(acc[i], 0.f) + w01[i] * fmaxf(acc[4 + i], 0.f);
                    s1 += w10[i] * fmaxf(acc[8 + i], 0.f) + w11[i] * fmaxf(acc[12 + i], 0.f);
                }
                sc[(2 * hh) * NKMAX + key] = s0; sc[(2 * hh + 1) * NKMAX + key] = s1;
                if (key <= tq0) { mx0 = fmaxf(mx0, s0); mn0 = fminf(mn0, s0); }
                if (key <= tq0 + 1) { mx1 = fmaxf(mx1, s1); mn1 = fminf(mn1, s1); }
            }
#pragma unroll
            for (int o = 16; o >= 1; o >>= 1) {
                mx0 = fmaxf(mx0, __shfl_xor(mx0, o)); mn0 = fminf(mn0, __shfl_xor(mn0, o));
                mx1 = fmaxf(mx1, __shfl_xor(mx1, o)); mn1 = fminf(mn1, __shfl_xor(mn1, o));
            }
            if (c32 == 0) {
                if (mx0 >= mn0) { atomicMin((unsigned*)&meta[(2 * hh) * 16 + 0], skey(mn0)); atomicMax((unsigned*)&meta[(2 * hh) * 16 + 1], skey(mx0)); }
                if (mx1 >= mn1) { atomicMin((unsigned*)&meta[(2 * hh + 1) * 16 + 0], skey(mn1)); atomicMax((unsigned*)&meta[(2 * hh + 1) * 16 + 1], skey(mx1)); }
            }
        }
        __syncthreads();
        const int q = wid & 3, part = wid >> 2, n = t0 + q + 1;
        const float lo = skey_inv((unsigned)meta[q * 16 + 0]), hi = skey_inv((unsigned)meta[q * 16 + 1]);
        const float scale = hi > lo ? 256.0f / (hi - lo) : 0.f;
        const float* scq = sc + q * NKMAX;
        for (int idx = part * 64 + lane; idx < n; idx += 128) {
            int b1, b2; bins12(scq[idx], lo, scale, b1, b2);
            atomicAdd(&h1[q * 256 + b1], 1);
        }
        __syncthreads();
        if (wid < 4) scan_top(h1 + wid * 256, 256, meta + wid * 16 + 4, lane);
        __syncthreads();
        const int B1 = meta[q * 16 + 4], K2 = 256 - meta[q * 16 + 5];
        for (int idx = part * 64 + lane; idx < n; idx += 128) {
            int b1, b2; bins12(scq[idx], lo, scale, b1, b2);
            if (b1 == B1) atomicAdd(&h2[q * 256 + b2], 1);
        }
        __syncthreads();
        if (wid < 4) scan_top(h2 + wid * 256, 256 - meta[wid * 16 + 5], meta + wid * 16 + 7, lane);
        __syncthreads();
        const int B2 = meta[q * 16 + 7], rr = K2 - meta[q * 16 + 8], cnt2 = meta[q * 16 + 9];
        for (int base = part * 64; base < n; base += 128) {
            const int idx = base + lane;
            bool issel = false, iscand = false;
            if (idx < n) { int b1, b2; bins12(scq[idx], lo, scale, b1, b2); issel = b1 > B1 || (b1 == B1 && b2 > B2); iscand = (b1 == B1 && b2 == B2); }
            const unsigned long long ms = __ballot(issel), mc = __ballot(iscand);
            const unsigned long long lt = (1ull << lane) - 1ull;
            if (ms) {
                int bs = 0; if (lane == 0) bs = atomicAdd(&meta[q * 16 + 2], __popcll(ms));
                bs = __shfl(bs, 0);
                if (issel) sel[q * 256 + bs + __popcll(ms & lt)] = (unsigned short)idx;
            }
            if (mc) {
                int bs = 0; if (lane == 0) bs = atomicAdd(&meta[q * 16 + 3], __popcll(mc));
                bs = __shfl(bs, 0);
                const int pos = bs + __popcll(mc & lt);
                if (iscand && pos < 128) cand[q * 128 + pos] = (unsigned short)idx;
            }
        }
        __syncthreads();
        if (wid < 4) {
            const int qq = wid; const float* scr = sc + qq * NKMAX;
            const int rq = (256 - meta[qq * 16 + 5]) - meta[qq * 16 + 8], cq = meta[qq * 16 + 9], sbase = 256 - rq, nn = t0 + qq + 1;
            if (cq <= 128) {
                int taken = 0;
#pragma unroll
                for (int half = 0; half < 2; ++half) {
                    const int i = lane + 64 * half;
                    bool take = false; int myidx = 0;
                    if (i < cq) {
                        myidx = cand[qq * 128 + i]; const float mv = scr[myidx];
                        int rank = 0;
                        for (int j = 0; j < cq; ++j) { const int oj = cand[qq * 128 + j]; const float ov = scr[oj]; rank += (ov > mv) || (ov == mv && oj < myidx); }
                        take = rank < rq;
                    }
                    const unsigned long long mt = __ballot(take);
                    if (take) sel[qq * 256 + sbase + taken + __popcll(mt & ((1ull << lane) - 1ull))] = (unsigned short)myidx;
                    taken += __popcll(mt);
                }
            } else {
                const float lo_ = skey_inv((unsigned)meta[qq * 16 + 0]), hi_ = skey_inv((unsigned)meta[qq * 16 + 1]);
                const float sc_ = hi_ > lo_ ? 256.0f / (hi_ - lo_) : 0.f;
                const int B1_ = meta[qq * 16 + 4], B2_ = meta[qq * 16 + 7];
                int taken = 0;
                for (int base = 0; base < nn && taken < rq; base += 64) {
                    const int idx = base + lane; bool isc = false;
                    if (idx < nn) { int b1, b2; bins12(scr[idx], lo_, sc_, b1, b2); isc = (b1 == B1_ && b2 == B2_); }
                    const unsigned long long mc = __ballot(isc);
                    const int pos = taken + __popcll(mc & ((1ull << lane) - 1ull));
                    if (isc && pos < rq) sel[qq * 256 + sbase + pos] = (unsigned short)idx;
                    taken += __popcll(mc);
                }
            }
        }
        __syncthreads();
    }
    {
        const int q = wid >> 1, kvh = wid & 1, tq = t0 + q, nsel = min(tq + 1, 256);
        const int col = lane & 15, g4 = lane >> 4;
        const unsigned short* selq = sel + q * 256;
        bf16x8 qf0, qf1;
        {
            const bf16_t* qp = p.q() + (size_t)(row0 + q) * 512 + (kvh * 4 + (col & 3)) * 64 + g4 * 8;
            qf0 = *(const bf16x8*)qp; qf1 = *(const bf16x8*)(qp + 32);
            if (col >= 4) {
#pragma unroll
                for (int i = 0; i < 8; ++i) { qf0[i] = 0; qf1[i] = 0; }
            }
        }
        const bf16_t* kb = p.k() + (size_t)brow * 128 + kvh * 64 + g4 * 8;
        f32x4 lg[16];
#pragma unroll
        for (int t = 0; t < 16; ++t) {
            const int key = selq[t * 16 + col];
            const bf16_t* kp = kb + (size_t)key * 128;
            const bf16x8 k0 = *(const bf16x8*)kp, k1 = *(const bf16x8*)(kp + 32);
            f32x4 a = (f32x4){0.f, 0.f, 0.f, 0.f};
            a = __builtin_amdgcn_mfma_f32_16x16x32_bf16(k0, qf0, a, 0, 0, 0);
            a = __builtin_amdgcn_mfma_f32_16x16x32_bf16(k1, qf1, a, 0, 0, 0);
            lg[t] = a;
        }
        float mx = -INFINITY;
#pragma unroll
        for (int t = 0; t < 16; ++t)
#pragma unroll
            for (int j = 0; j < 4; ++j) { if (t * 16 + g4 * 4 + j >= nsel) lg[t][j] = -INFINITY; mx = fmaxf(mx, lg[t][j]); }
        mx = fmaxf(mx, __shfl_xor(mx, 16)); mx = fmaxf(mx, __shfl_xor(mx, 32));
        float sm = 0.f;
#pragma unroll
        for (int t = 0; t < 16; ++t)
#pragma unroll
            for (int j = 0; j < 4; ++j) { const float e = exp2f(lg[t][j] - mx); lg[t][j] = e; sm += e; }
        sm += __shfl_xor(sm, 16); sm += __shfl_xor(sm, 32);
        const float inv = 1.0f / sm;
        f32x4 o[4];
#pragma unroll
        for (int d = 0; d < 4; ++d) o[d] = (f32x4){0.f, 0.f, 0.f, 0.f};
        LAS unsigned char* vst = (LAS unsigned char*)lds + A_SC + wid * 8192;
        const bf16_t* vb = p.v() + (size_t)brow * 128 + kvh * 64 + (lane & 7) * 8;
        const unsigned rdbase = (unsigned)(uintptr_t)((LAS unsigned char*)lds + A_SC) + wid * 8192 + (4 * g4 + (col >> 2)) * 128 + (col & 3) * 8;
#define V_STAGE(s_, buf_) do { _Pragma("unroll") for (int i_ = 0; i_ < 4; ++i_) { \
            const int ksl_ = (s_) * 32 + i_ * 8 + (lane >> 3); const int key_ = selq[ksl_]; \
            __builtin_amdgcn_global_load_lds((const unsigned*)(vb + (size_t)key_ * 128), (LAS unsigned*)(vst + (buf_) * 4096 + i_ * 1024), 16, 0, 0); } } while (0)
        V_STAGE(0, 0);
#pragma unroll
        for (int s = 0; s < 8; ++s) {
            if (s + 1 < 8) { V_STAGE(s + 1, (s + 1) & 1); asm volatile("s_waitcnt vmcnt(4)" ::: "memory"); }
            else asm volatile("s_waitcnt vmcnt(0)" ::: "memory");
            const unsigned rb = rdbase + (s & 1) * 4096;
            const s16x4 l0 = tr_read<0>(rb), h0 = tr_read<2048>(rb), l1 = tr_read<32>(rb), h1_ = tr_read<2048 + 32>(rb);
            const s16x4 l2 = tr_read<64>(rb), h2_ = tr_read<2048 + 64>(rb), l3 = tr_read<96>(rb), h3 = tr_read<2048 + 96>(rb);
            asm volatile("s_waitcnt lgkmcnt(0)" ::: "memory");
            __builtin_amdgcn_sched_barrier(0);
            bf16x8 pa;
            {
                const uint32_t w0 = pack2(lg[2 * s][0], lg[2 * s][1]), w1 = pack2(lg[2 * s][2], lg[2 * s][3]);
                const uint32_t w2 = pack2(lg[2 * s + 1][0], lg[2 * s + 1][1]), w3 = pack2(lg[2 * s + 1][2], lg[2 * s + 1][3]);
                pa[0] = (short)(w0 & 0xffff); pa[1] = (short)(w0 >> 16); pa[2] = (short)(w1 & 0xffff); pa[3] = (short)(w1 >> 16);
                pa[4] = (short)(w2 & 0xffff); pa[5] = (short)(w2 >> 16); pa[6] = (short)(w3 & 0xffff); pa[7] = (short)(w3 >> 16);
            }
#define PKV(L, H) (bf16x8){L[0], L[1], L[2], L[3], H[0], H[1], H[2], H[3]}
            o[0] = __builtin_amdgcn_mfma_f32_16x16x32_bf16(pa, PKV(l0, h0), o[0], 0, 0, 0);
            o[1] = __builtin_amdgcn_mfma_f32_16x16x32_bf16(pa, PKV(l1, h1_), o[1], 0, 0, 0);
            o[2] = __builtin_amdgcn_mfma_f32_16x16x32_bf16(pa, PKV(l2, h2_), o[2], 0, 0, 0);
            o[3] = __builtin_amdgcn_mfma_f32_16x16x32_bf16(pa, PKV(l3, h3), o[3], 0, 0, 0);
#undef PKV
        }
#undef V_STAGE
        const float i0 = __shfl(inv, 0), i1 = __shfl(inv, 1), i2 = __shfl(inv, 2), i3 = __shfl(inv, 3);
        if (g4 == 0) {
            bf16_t* op = p.att() + (size_t)(row0 + q) * 512 + kvh * 256 + col;
#pragma unroll
            for (int d = 0; d < 4; ++d) {
                op[0 * 64 + d * 16] = f2bf(o[d][0] * i0); op[1 * 64 + d * 16] = f2bf(o[d][1] * i1);
                op[2 * 64 + d * 16] = f2bf(o[d][2] * i2); op[3 * 64 + d * 16] = f2bf(o[d][3] * i3);
            }
        }
    }
    __syncthreads();
}

constexpr int NAU = NTOK / 4, ATT_P1 = NAU / 8, ATT_P2 = NAU / 2;
template <int SUB>
__device__ void ph_mixer(const P& p, unsigned char* lds) {
    int* bc = (int*)(lds + LDS_BYTES - 16);
    constexpr int nh = SUB == 1 ? 16 : NXU;
    constexpr int a0 = SUB == 0 ? 0 : (SUB == 1 ? ATT_P1 : ATT_P2), a1 = SUB == 0 ? ATT_P1 : (SUB == 1 ? ATT_P2 : NAU);
    for (;;) {
        __syncthreads();
        if (tid_() == 0) bc[0] = atomicAdd(&p.ctr()[97 + SUB], 1);
        __syncthreads();
        const int it = bc[0];
        if (it >= nh + (a1 - a0)) break;
        if (it < nh) {
            if (SUB == 0) hgx_unit(p, lds, it);
            else if (SUB == 1) hgchain_unit(p, it);
            else hgz_unit(p, lds, it);
        } else {
            const int uu = NAU - 1 - (a0 + it - nh);
            attn4_unit(p, lds, uu & 3, uu >> 2);
        }
    }
}

__device__ void ph_mix(const P& p, unsigned char* lds) {
    const int nunits = (T / 256) * 4;
    for (int u = blockIdx.x; u < nunits; u += gridDim.x) {
        const int nt = u & 3, mt = u >> 2;
        f32x4 acc[8][4];
        gemm256(lds, p.att(), RowLin{(size_t)mt * 256 * 512, 512}, p.wuaT(), RowLin{(size_t)nt * 256 * 512, 512}, 512, acc);
        EPI_LOOP(
            const size_t o = (size_t)(mt * 256 + row) * 1024 + nt * 256 + col;
            const uint2 g = *(const uint2*)(p.ga() + o);
            f32x4 r; const f32x4 v = acc[m][n];
            r[0] = v[0] * __uint_as_float(g.x << 16); r[1] = v[1] * __uint_as_float(g.x & 0xffff0000u);
            r[2] = v[2] * __uint_as_float(g.y << 16); r[3] = v[3] * __uint_as_float(g.y & 0xffff0000u);
            st_bf4(p.mix() + o, r);
        );
        gemm256(lds, p.hgr(), RowLin{(size_t)mt * 256 * 512, 512}, p.wuhT(), RowLin{(size_t)nt * 256 * 512, 512}, 512, acc);
        EPI_LOOP(
            const size_t o = (size_t)(mt * 256 + row) * 1024 + nt * 256 + col;
            const uint2 g = *(const uint2*)(p.gh() + o);
            const uint2 a = *(const uint2*)(p.mix() + o);
            f32x4 r; const f32x4 v = acc[m][n];
            r[0] = __uint_as_float(a.x << 16) + v[0] * __uint_as_float(g.x << 16); r[1] = __uint_as_float(a.x & 0xffff0000u) + v[1] * __uint_as_float(g.x & 0xffff0000u);
            r[2] = __uint_as_float(a.y << 16) + v[2] * __uint_as_float(g.y << 16); r[3] = __uint_as_float(a.y & 0xffff0000u) + v[3] * __uint_as_float(g.y & 0xffff0000u);
            st_bf4(p.mix() + o, r);
        );
    }
}

__device__ void ph_out(const P& p, unsigned char* lds) {
    const int nunits = (T / 256) * 4;
    for (int u = blockIdx.x; u < nunits; u += gridDim.x) {
        const int nt = u & 3, mt = u >> 2;
        f32x4 acc[8][4];
        gemm256(lds, p.mix(), RowLin{(size_t)mt * 256 * D, D}, p.woT(), RowLin{(size_t)nt * 256 * D, D}, D, acc);
        EPI_LOOP(
            const int gm = mt * 256 + row, b = gm / LP, pos = gm % LP;
            if (pos >= NMETA && pos < L) {
                const size_t o = ((size_t)b * SEQ + (pos - NMETA)) * D + nt * 256 + col;
                const f32x4 h0 = *(const f32x4*)(p.x + o);
                *(f32x4*)(p.out + o) = h0 + acc[m][n];
            }
        );
    }
}

__device__ void ph_route(const P& p, unsigned char* lds) {
    const int tid = tid_(), lane = tid & 63, wid = tid >> 6;
    const int gw = blockIdx.x * 8 + wid, nw = gridDim.x * 8;
    const int gt = blockIdx.x * NTHREADS + tid, ntot = gridDim.x * NTHREADS;
    for (int i = gt; i < CAP; i += ntot) p.slot_token()[i] = -1;
    for (int tok = gw; tok < NTOK; tok += nw) {
        const float* src = p.out + (size_t)tok * D;
        f32x4 v[4]; float ss = 0.f;
#pragma unroll
        for (int i = 0; i < 4; ++i) { v[i] = *(const f32x4*)(src + lane * 4 + 256 * i); ss += v[i][0] * v[i][0] + v[i][1] * v[i][1] + v[i][2] * v[i][2] + v[i][3] * v[i][3]; }
        ss = wave_sum(ss);
        const float rs = rsqrtf(ss * (1.0f / D) + EPS);
        float lg[32];
#pragma unroll
        for (int e = 0; e < 32; ++e) lg[e] = 0.f;
#pragma unroll
        for (int i = 0; i < 4; ++i) {
            const f32x4 g = *(const f32x4*)(p.ffn_g + lane * 4 + 256 * i);
            f32x4 xn; xn[0] = v[i][0] * rs * g[0]; xn[1] = v[i][1] * rs * g[1]; xn[2] = v[i][2] * rs * g[2]; xn[3] = v[i][3] * rs * g[3];
            st_bf4(p.xn2() + (size_t)tok * D + lane * 4 + 256 * i, xn);
#pragma unroll
            for (int c = 0; c < 4; ++c) {
                const float* wr_ = p.router_w + (size_t)(lane * 4 + 256 * i + c) * 32;
#pragma unroll
                for (int e4 = 0; e4 < 8; ++e4) {
                    const f32x4 w = *(const f32x4*)(wr_ + e4 * 4);
                    lg[e4 * 4 + 0] += xn[c] * w[0]; lg[e4 * 4 + 1] += xn[c] * w[1]; lg[e4 * 4 + 2] += xn[c] * w[2]; lg[e4 * 4 + 3] += xn[c] * w[3];
                }
            }
        }
#pragma unroll
        for (int e = 0; e < 32; ++e) lg[e] = wave_sum(lg[e]) + p.router_b[e];
        float bv[4]; int bi[4];
#pragma unroll
        for (int k = 0; k < 4; ++k) {
            float best = -INFINITY; int idx = 0;
#pragma unroll
            for (int e = 0; e < 32; ++e) if (lg[e] > best) { best = lg[e]; idx = e; }
            bv[k] = best; bi[k] = idx;
#pragma unroll
            for (int e = 0; e < 32; ++e) lg[e] = (e == idx) ? -INFINITY : lg[e];
        }
        const float e1 = __expf(bv[1] - bv[0]), e2 = __expf(bv[2] - bv[0]), e3 = __expf(bv[3] - bv[0]);
        const float inv = 1.0f / (1.0f + e1 + e2 + e3);
        if (lane == 0) {
            p.tok_exp()[tok * 4 + 0] = bi[0]; p.tok_exp()[tok * 4 + 1] = bi[1]; p.tok_exp()[tok * 4 + 2] = bi[2]; p.tok_exp()[tok * 4 + 3] = bi[3];
            p.tok_gate()[tok * 4 + 0] = inv; p.tok_gate()[tok * 4 + 1] = e1 * inv; p.tok_gate()[tok * 4 + 2] = e2 * inv; p.tok_gate()[tok * 4 + 3] = e3 * inv;
            atomicAdd(&p.ctr()[bi[0]], 1); atomicAdd(&p.ctr()[bi[1]], 1); atomicAdd(&p.ctr()[bi[2]], 1); atomicAdd(&p.ctr()[bi[3]], 1);
        }
    }
    for (long task = gt; task < 96L * 16384; task += ntot) {
        const int mat = (int)(task >> 14), r = (int)(task & 16383), kq = r >> 10, n = r & 1023;
        const int which = mat >> 5, e = mat & 31;
        const float* W = (which == 0 ? p.w_gate : which == 1 ? p.w_up : p.w_down) + (size_t)e * 1048576 + (size_t)(kq * 64) * 1024 + n;
        bf16_t* outp = (which == 0 ? p.wgT() : which == 1 ? p.wuT() : p.wdT()) + (size_t)e * 1048576 + (size_t)n * 1024 + kq * 64;
        float v[64];
#pragma unroll
        for (int i = 0; i < 64; ++i) v[i] = W[(size_t)i * 1024];
        uint4* dst = (uint4*)outp;
#pragma unroll
        for (int i = 0; i < 8; ++i) dst[i] = make_uint4(pack2(v[8 * i], v[8 * i + 1]), pack2(v[8 * i + 2], v[8 * i + 3]), pack2(v[8 * i + 4], v[8 * i + 5]), pack2(v[8 * i + 6], v[8 * i + 7]));
    }
}

__device__ void ph_scan(const P& p, unsigned char* lds) {
    if (blockIdx.x == 0 && tid_() == 0) {
        int acc = 0;
        for (int e = 0; e < NE; ++e) {
            p.ctr()[64 + e] = acc;
            const int nb = (p.ctr()[e] + 255) >> 8;
            for (int i = 0; i < nb; ++i) p.block_expert()[(acc >> 8) + i] = e;
            acc += nb * 256;
        }
        p.ctr()[96] = acc >> 8;
    }
}

__device__ void ph_fill(const P& p, unsigned char* lds) {
    const int gt = blockIdx.x * NTHREADS + tid_(), ntot = gridDim.x * NTHREADS;
    for (int i = gt; i < NTOK * 4; i += ntot) {
        const int e = p.tok_exp()[i];
        const int dest = p.ctr()[64 + e] + atomicAdd(&p.ctr()[32 + e], 1);
        p.slot_token()[dest] = i >> 2;
        p.slot_rank()[dest] = i & 3;
        p.slot_gate()[dest] = p.tok_gate()[i];
    }
}

struct GUOff { int ct; __device__ __forceinline__ size_t operator()(int R) const {
    const int wcB = R >> 6, nB = (R >> 4) & 3, c = ct * 128 + wcB * 32 + (nB & 1) * 16 + (R & 15);
    return (size_t)(nB >> 1) * (WE_B / 2) + (size_t)c * 1024; } };
struct GatherOff { const int* st; __device__ __forceinline__ size_t operator()(int R) const { const int t = st[R]; return (size_t)(t < 0 ? 0 : t) * 1024; } };
__device__ void ph_moe1(const P& p, unsigned char* lds) {
    const int nunits = p.ctr()[96] * 8;
    for (int u = blockIdx.x; u < nunits; u += gridDim.x) {
        const int ct = u & 7, rb = u >> 3, e = p.block_expert()[rb];
        f32x4 acc[8][4];
        gemm256(lds, p.xn2(), GatherOff{p.slot_token() + rb * 256}, p.wgT() + (size_t)e * 1048576, GUOff{ct}, D, acc);
        {
            const int tid_e = tid_(), lane_e = tid_e & 63, wid_e = tid_e >> 6, wr = wid_e >> 2, wc = wid_e & 3, fr = lane_e & 15, fq = lane_e >> 4;
#pragma unroll
            for (int hh = 0; hh < 2; ++hh) {
                const int c = ct * 128 + wc * 32 + hh * 16 + fq * 4;
                const f32x4 bg = *(const f32x4*)(p.b_gate + (size_t)e * DFF + c), bu = *(const f32x4*)(p.b_up + (size_t)e * DFF + c);
#pragma unroll
                for (int m = 0; m < 8; ++m) {
                    const int row = rb * 256 + wr * 128 + m * 16 + fr;
                    f32x4 a;
#pragma unroll
                    for (int j = 0; j < 4; ++j) {
                        const float g = fminf(acc[m][hh][j] + bg[j], 7.0f);
                        const float uu = fminf(fmaxf(acc[m][2 + hh][j] + bu[j], -7.0f), 7.0f);
                        a[j] = (uu + 1.0f) * (g * sigmoidf_(1.702f * g));
                    }
                    st_bf4(p.act() + (size_t)row * DFF + c, a);
                }
            }
        }
    }
}
__device__ void ph_moe2(const P& p, unsigned char* lds) {
    const int nunits = p.ctr()[96] * 4;
    for (int u = blockIdx.x; u < nunits; u += gridDim.x) {
        const int nt = u & 3, rb = u >> 2, e = p.block_expert()[rb];
        f32x4 acc[8][4];
        gemm256(lds, p.act(), RowLin{(size_t)rb * 256 * DFF, DFF}, p.wdT() + (size_t)e * 1048576, RowLin{(size_t)nt * 256 * DFF, DFF}, DFF, acc);
        {
            const int tid_e = tid_(), lane_e = tid_e & 63, wid_e = tid_e >> 6, wr = wid_e >> 2, wc = wid_e & 3, fr = lane_e & 15, fq = lane_e >> 4;
            f32x4 bd[4];
#pragma unroll
            for (int n = 0; n < 4; ++n) bd[n] = *(const f32x4*)(p.b_down + (size_t)e * D + nt * 256 + wc * 64 + n * 16 + fq * 4);
#pragma unroll
            for (int m = 0; m < 8; ++m) {
                const int slot = rb * 256 + wr * 128 + m * 16 + fr;
                const int tok = p.slot_token()[slot];
                if (tok < 0) continue;
                const int rank = p.slot_rank()[slot]; const float gate = p.slot_gate()[slot];
                const size_t o = (size_t)tok * D + nt * 256 + wc * 64 + fq * 4;
                if (rank == 0) {
#pragma unroll
                    for (int n = 0; n < 4; ++n) { float* d = p.out + o + n * 16; *(f32x4*)d = *(const f32x4*)d + (acc[m][n] + bd[n]) * gate; }
                } else {
                    bf16_t* yb = rank == 1 ? p.y1() : (rank == 2 ? p.y2() : p.y3());
#pragma unroll
                    for (int n = 0; n < 4; ++n) st_bf4(yb + o + n * 16, (acc[m][n] + bd[n]) * gate);
                }
            }
        }
    }
}

__device__ void ph_final(const P& p, unsigned char* lds) {
    const int tid = tid_(), lane = tid & 63, wid = tid >> 6;
    const int gw = blockIdx.x * 8 + wid, nw = gridDim.x * 8;
    for (int tok = gw; tok < NTOK; tok += nw) {
        float* dst = p.out + (size_t)tok * D;
        f32x4 v[4];
#pragma unroll
        for (int i = 0; i < 4; ++i) v[i] = *(const f32x4*)(dst + lane * 4 + 256 * i);
#pragma unroll
        for (int j = 0; j < 3; ++j) {
            const bf16_t* yr = (j == 0 ? p.y1() : j == 1 ? p.y2() : p.y3()) + (size_t)tok * D;
#pragma unroll
            for (int i = 0; i < 4; ++i) {
                const uint2 w = *(const uint2*)(yr + lane * 4 + 256 * i);
                v[i][0] += __uint_as_float(w.x << 16); v[i][1] += __uint_as_float(w.x & 0xffff0000u);
                v[i][2] += __uint_as_float(w.y << 16); v[i][3] += __uint_as_float(w.y & 0xffff0000u);
            }
        }
        float ss = 0.f;
#pragma unroll
        for (int i = 0; i < 4; ++i) ss += v[i][0] * v[i][0] + v[i][1] * v[i][1] + v[i][2] * v[i][2] + v[i][3] * v[i][3];
        ss = wave_sum(ss);
        const float rs = rsqrtf(ss * (1.0f / D) + EPS);
#pragma unroll
        for (int i = 0; i < 4; ++i) {
            const f32x4 g = *(const f32x4*)(p.final_g + lane * 4 + 256 * i);
            *(f32x4*)(dst + lane * 4 + 256 * i) = v[i] * rs * g;
        }
    }
}

template <int PH>
__global__ void __launch_bounds__(NTHREADS) k_phase(P p) {
    __shared__ __attribute__((aligned(16))) unsigned char lds[LDS_BYTES];
    if (PH == 0) ph_prep(p, lds);
    if (PH == 1) ph_inproj(p, lds);
    if (PH == 2) ph_mixer<0>(p, lds);
    if (PH == 11) ph_mixer<1>(p, lds);
    if (PH == 12) ph_mixer<2>(p, lds);
    if (PH == 3) ph_mix(p, lds);
    if (PH == 4) ph_out(p, lds);
    if (PH == 5) ph_route(p, lds);
    if (PH == 6) ph_scan(p, lds);
    if (PH == 7) ph_fill(p, lds);
    if (PH == 8) ph_moe1(p, lds);
    if (PH == 9) ph_moe2(p, lds);
    if (PH == 10) ph_final(p, lds);
}

#if MEGA
__global__ void __launch_bounds__(NTHREADS) k_mega(P p) {
    __shared__ __attribute__((aligned(16))) unsigned char lds[LDS_BYTES];
    cg::grid_group grid = cg::this_grid();
    ph_prep(p, lds); grid.sync();
    ph_inproj(p, lds); grid.sync();
    ph_mixer<0>(p, lds); grid.sync();
    ph_mixer<1>(p, lds); grid.sync();
    ph_mixer<2>(p, lds); grid.sync();
    ph_mix(p, lds); grid.sync();
    ph_out(p, lds); grid.sync();
    ph_route(p, lds); grid.sync();
    ph_scan(p, lds); grid.sync();
    ph_fill(p, lds); grid.sync();
    ph_moe1(p, lds); grid.sync();
    ph_moe2(p, lds); grid.sync();
    ph_final(p, lds);
}
#endif

extern "C" void kernel_launch(void* const* d_in, const int* in_sizes, int n_in, void* d_out, int out_size, void* d_ws, size_t ws_size,
                              hipStream_t stream) {
    P p{};
    p.x = (const float*)d_in[0]; p.meta = (const float*)d_in[1]; p.attn_g = (const float*)d_in[2]; p.w_in = (const float*)d_in[3];
    p.hgrn_g = (const float*)d_in[4]; p.w_ua = (const float*)d_in[5]; p.w_uh = (const float*)d_in[6]; p.w_out = (const float*)d_in[7];
    p.lb_logits = (const float*)d_in[8]; p.ffn_g = (const float*)d_in[9]; p.router_w = (const float*)d_in[10]; p.router_b = (const float*)d_in[11];
    p.w_gate = (const float*)d_in[12]; p.b_gate = (const float*)d_in[13]; p.w_up = (const float*)d_in[14]; p.b_up = (const float*)d_in[15];
    p.w_down = (const float*)d_in[16]; p.b_down = (const float*)d_in[17]; p.final_g = (const float*)d_in[18];
    p.out = (float*)d_out;
    p.ws = (unsigned char*)d_ws;
    if (WS_NEED > ws_size) { fprintf(stderr, "workspace too small: need %zu have %zu\n", (size_t)WS_NEED, ws_size); return; }
#if MEGA
    static int grid_blocks = 0;
    if (!grid_blocks) {
        int dev = 0, cus = 0, per_cu = 0;
        hipGetDevice(&dev);
        hipDeviceGetAttribute(&cus, hipDeviceAttributeMultiprocessorCount, dev);
        hipOccupancyMaxActiveBlocksPerMultiprocessor(&per_cu, k_mega, NTHREADS, 0);
        if (per_cu > 1) per_cu = 1;
        grid_blocks = cus * per_cu;
    }
    void* args[] = {&p};
    hipError_t e = hipLaunchCooperativeKernel((void*)k_mega, dim3(grid_blocks), dim3(NTHREADS), args, 0, stream);
    if (e != hipSuccess) fprintf(stderr, "cooperative launch failed: %s (grid %d)\n", hipGetErrorString(e), grid_blocks);
#else
    const int G = 512;
    k_phase<0><<<G, NTHREADS, 0, stream>>>(p);
    k_phase<1><<<G, NTHREADS, 0, stream>>>(p);
    k_phase<2><<<G, NTHREADS, 0, stream>>>(p);
    k_phase<11><<<G, NTHREADS, 0, stream>>>(p);
    k_phase<12><<<G, NTHREADS, 0, stream>>>(p);
    k_phase<3><<<G, NTHREADS, 0, stream>>>(p);
    k_phase<4><<<G, NTHREADS, 0, stream>>>(p);
    k_phase<5><<<G, NTHREADS, 0, stream>>>(p);
    k_phase<6><<<1, NTHREADS, 0, stream>>>(p);
    k_phase<7><<<G, NTHREADS, 0, stream>>>(p);
    k_phase<8><<<G, NTHREADS, 0, stream>>>(p);
    k_phase<9><<<G, NTHREADS, 0, stream>>>(p);
    k_phase<10><<<G, NTHREADS, 0, stream>>>(p);
#endif
}
```

```cpp
#include <hip/hip_runtime.h>
#include <hip/hip_cooperative_groups.h>
#include <stdint.h>
#include <cstdio>
namespace cg = cooperative_groups;

#ifndef MEGA
#define MEGA 1
#endif

typedef unsigned short bf16_t;
typedef short bf16x8 __attribute__((ext_vector_type(8)));
typedef float f32x4 __attribute__((ext_vector_type(4)));

constexpr int D = 1024, NB = 4, SEQ = 8192, NMETA = 16, L = SEQ + NMETA  , LP = 8320, T = NB * LP  ;
constexpr int NTOK = NB * SEQ;
constexpr int IN_COLS = 5160;
constexpr int NE = 32, TOPK = 4, DFF = 1024;
constexpr int CAP_BLOCKS = (NTOK * TOPK) / 256 + NE;
constexpr int CAP = CAP_BLOCKS * 256;
constexpr float EPS = 1e-5f;
constexpr int NTHREADS = 512;
constexpr int LDS_BYTES = 147456;
constexpr int NVC = 5376;
#define LAS __attribute__((address_space(3)))

__device__ __forceinline__ bf16_t f2bf(float f) {
    uint32_t u = __float_as_uint(f);
    u += 0x7fffu + ((u >> 16) & 1u);
    return (bf16_t)(u >> 16);
}
__device__ __forceinline__ float bf2f(bf16_t h) { return __uint_as_float(((uint32_t)h) << 16); }
__device__ __forceinline__ uint32_t pack2(float a, float b) { return (uint32_t)f2bf(a) | ((uint32_t)f2bf(b) << 16); }
__device__ __forceinline__ float sigmoidf_(float x) { return 1.0f / (1.0f + __expf(-x)); }
__device__ __forceinline__ float wave_sum(float v) {
#pragma unroll
    for (int o = 32; o >= 1; o >>= 1) v += __shfl_xor(v, o);
    return v;
}
__device__ __forceinline__ float wave_max(float v) {
#pragma unroll
    for (int o = 32; o >= 1; o >>= 1) v = fmaxf(v, __shfl_xor(v, o));
    return v;
}

constexpr size_t al256(size_t x) { return (x + 255) & ~(size_t)255; }
constexpr size_t TT = (size_t)T;
constexpr size_t MB1 = 1024 * 1024;
constexpr size_t WE_B = (size_t)NE * 1024 * 1024 * 2;
constexpr size_t OFF_WGT = 0, OFF_WUT = WE_B, OFF_WDT = 2 * WE_B, OFF_XN2 = 3 * WE_B, OFF_ACT = OFF_XN2 + (size_t)NTOK * D * 2,
                 OFF_TAB = OFF_ACT + (size_t)CAP * DFF * 2;
constexpr size_t OFF_Y1 = OFF_XN2, OFF_Y2 = OFF_WGT, OFF_Y3 = OFF_WUT;
constexpr size_t OFF_ROPE = OFF_TAB, OFF_LB = OFF_ROPE + al256((size_t)LP * 24 * 4), OFF_CTR = OFF_LB + al256(512 * 4),
                 OFF_BEXP = OFF_CTR + al256(128 * 4), OFF_SLOT = OFF_BEXP + al256((size_t)CAP_BLOCKS * 4), OFF_SRANK = OFF_SLOT + al256((size_t)CAP * 4),
                 OFF_SGATE = OFF_SRANK + al256((size_t)CAP * 4), OFF_TEXP = OFF_SGATE + al256((size_t)CAP * 4), OFF_TGATE = OFF_TEXP + al256((size_t)NTOK * 16),
                 OFF_BAR = OFF_TGATE + al256((size_t)NTOK * 16), OFF_WGC = OFF_BAR + al256(3456 * 4), WS_NEED = OFF_WGC + al256(256 * 32 * 4);
constexpr size_t OFF_WIN = 0, OFF_WUA = OFF_WIN + (size_t)NVC * 1024 * 2, OFF_WUH = OFF_WUA + MB1, OFF_WO = OFF_WUH + MB1, OFF_XN = OFF_WO + 2 * MB1,
                 OFF_Q = OFF_XN + TT * 2048, OFF_K = OFF_Q + TT * 1024, OFF_V = OFF_K + TT * 256, OFF_IQ = OFF_V + TT * 256, OFF_IK = OFF_IQ + TT * 512,
                 OFF_IW = OFF_IK + TT * 64, OFF_HQ = OFF_IW + TT * 32, OFF_HF = OFF_HQ + TT * 1024, OFF_HI = OFF_HF + TT * 1024, OFF_HG = OFF_HI + TT * 1024,
                 OFF_GA = OFF_HG + TT * 1024, OFF_GH = OFF_GA + TT * 2048, OFF_ATT = OFF_GH + TT * 2048, OFF_HGR = OFF_ATT + TT * 1024,
                 OFF_S1_END = OFF_HGR + TT * 1024;
constexpr size_t OFF_MIX = OFF_XN;
static_assert(OFF_S1_END <= OFF_TAB, "stage-1 layout overflows");

__device__ __forceinline__ int tid_() { int t = threadIdx.x; asm volatile("" : "+v"(t)); return t; }

struct P {
    const float *x, *meta, *attn_g, *w_in, *hgrn_g, *w_ua, *w_uh, *w_out, *lb_logits, *ffn_g, *router_w, *router_b,
        *w_gate, *b_gate, *w_up, *b_up, *w_down, *b_down, *final_g;
    float* out;
    unsigned char* ws;
#define WSF(type, name, off) __device__ __forceinline__ type* name() const { return (type*)(ws + (off)); }
    WSF(bf16_t, xn, OFF_XN) WSF(bf16_t, q, OFF_Q) WSF(bf16_t, k, OFF_K) WSF(bf16_t, v, OFF_V) WSF(bf16_t, iq, OFF_IQ) WSF(bf16_t, ik, OFF_IK)
    WSF(bf16_t, hq, OFF_HQ) WSF(bf16_t, hf, OFF_HF) WSF(bf16_t, hi, OFF_HI) WSF(bf16_t, hg, OFF_HG) WSF(bf16_t, ga, OFF_GA) WSF(bf16_t, gh, OFF_GH)
    WSF(bf16_t, att, OFF_ATT) WSF(bf16_t, hgr, OFF_HGR) WSF(bf16_t, mix, OFF_MIX) WSF(bf16_t, xn2, OFF_XN2) WSF(bf16_t, act, OFF_ACT)
    WSF(bf16_t, y1, OFF_Y1) WSF(bf16_t, y2, OFF_Y2) WSF(bf16_t, y3, OFF_Y3)
    WSF(bf16_t, winT, OFF_WIN) WSF(bf16_t, wuaT, OFF_WUA) WSF(bf16_t, wuhT, OFF_WUH) WSF(bf16_t, woT, OFF_WO)
    WSF(bf16_t, wgT, OFF_WGT) WSF(bf16_t, wuT, OFF_WUT) WSF(bf16_t, wdT, OFF_WDT)
    WSF(float, iw, OFF_IW) WSF(float, rope, OFF_ROPE) WSF(float, lb, OFF_LB) WSF(float, tok_gate, OFF_TGATE) WSF(float, slot_gate, OFF_SGATE)
    WSF(int, ctr, OFF_CTR)
    WSF(int, wg_cnt, OFF_WGC) WSF(int, block_expert, OFF_BEXP) WSF(int, slot_token, OFF_SLOT) WSF(int, slot_rank, OFF_SRANK) WSF(int, tok_exp, OFF_TEXP)
};

template <class ColMap>
__device__ __forceinline__ void convert_T(const float* W, int ldw, bf16_t* out, int K, int N, const ColMap& cmap, int gt, int ntot) {
    const int kb = K / 64; const long ntask = (long)N * kb;
    for (long task = gt; task < ntask; task += ntot) {
        const int kq = (int)(task / N), n = (int)(task % N);
        const int c = cmap(n);
        uint32_t w[32];
        if (c >= 0) {
            const float* src = W + (size_t)(kq * 64) * ldw + c;
            float v[64];
#pragma unroll
            for (int i = 0; i < 64; ++i) v[i] = src[(size_t)i * ldw];
#pragma unroll
            for (int i = 0; i < 32; ++i) w[i] = pack2(v[2 * i], v[2 * i + 1]);
        } else {
#pragma unroll
            for (int i = 0; i < 32; ++i) w[i] = 0u;
        }
        uint4* dst = (uint4*)(out + (size_t)n * K + kq * 64);
#pragma unroll
        for (int i = 0; i < 8; ++i) dst[i] = make_uint4(w[4 * i], w[4 * i + 1], w[4 * i + 2], w[4 * i + 3]);
    }
}
struct IdMap { __device__ __forceinline__ int operator()(int n) const { return n; } };
struct WinMap { __device__ __forceinline__ int operator()(int n) const { return n < 1064 ? n : (n < 1280 ? -1 : n - 216); } };

#define XB_TMO      128
#define XB_XCNT(j)  (256  + 64 * (j))
#define XB_XSUB(j)  (1280 + 64 * (j))
#define XB_XGEN(j)  (2304 + 64 * (j))
#define XB_TOP      3328
#define XB_TOPGEN   3392
#define XCD_BAR_WORDS 3456
#define XB_SPIN_CAP (1u << 22)
__device__ __forceinline__ unsigned xb_ld(unsigned* p)              { return __hip_atomic_load(p, __ATOMIC_RELAXED, __HIP_MEMORY_SCOPE_AGENT); }
__device__ __forceinline__ unsigned xb_add(unsigned* p, unsigned v) { return __hip_atomic_fetch_add(p, v, __ATOMIC_RELAXED, __HIP_MEMORY_SCOPE_AGENT); }
__device__ __forceinline__ unsigned xb_xcc_id() { return (unsigned)__builtin_amdgcn_s_getreg((3 << 11) | 20) & 0xFu; }
#define XB_SPIN(cond, bar) do { unsigned _sp = 0; while (cond) { __builtin_amdgcn_s_sleep(1); \
    if ((++_sp & 255u) == 0u) { if (xb_ld(&(bar)[XB_TMO])) break; if (_sp > XB_SPIN_CAP) { atomicAdd(&(bar)[XB_TMO], 1u); break; } } } } while (0)
struct XcdBarrier { unsigned* bar; unsigned x; volatile LAS unsigned* st; };
__device__ __forceinline__ XcdBarrier xcd_barrier_post(unsigned* bar, volatile LAS unsigned* st) {
    XcdBarrier b; b.bar = bar; b.x = xb_xcc_id(); b.st = st;
    if (threadIdx.x == 0) (void)xb_add(&bar[XB_XCNT(b.x)], 1u);
    return b;
}
__device__ __forceinline__ void xcd_barrier_complete(unsigned* bar, unsigned x, unsigned& nloc, unsigned& nx) {
    const unsigned G = gridDim.x * gridDim.y * gridDim.z;
    unsigned sum, cnt, mine, sp = 0u;
    for (;;) {
        sum = 0u; cnt = 0u; mine = 0u;
#pragma unroll
        for (unsigned j = 0; j < 16; ++j) { const unsigned c = xb_ld(&bar[XB_XCNT(j)]); sum += c; cnt += (c > 0u) ? 1u : 0u; mine = (j == x) ? c : mine; }
        if (sum == G) break;
        __builtin_amdgcn_s_sleep(1);
        if ((++sp & 255u) == 0u) { if (xb_ld(&bar[XB_TMO])) break; if (sp > XB_SPIN_CAP) { atomicAdd(&bar[XB_TMO], 1u); break; } }
    }
    nloc = mine > 0u ? mine : 1u; nx = cnt > 0u ? cnt : 1u;
}
__device__ __forceinline__ void xcd_barrier(const XcdBarrier& b) {
    asm volatile("s_waitcnt vmcnt(0)" ::: "memory");
    __syncthreads();
    if (threadIdx.x == 0) {
        unsigned* bar = b.bar;
        __builtin_amdgcn_s_waitcnt(0);
        unsigned nloc = b.st[0], nx = b.st[1];
        if (nloc == 0u) { xcd_barrier_complete(bar, b.x, nloc, nx); b.st[0] = nloc; b.st[1] = nx; }
        const unsigned old = xb_add(&bar[XB_XSUB(b.x)], 1u);
        const unsigned gen = old / nloc;
        if (old + 1u == (gen + 1u) * nloc) {
            __builtin_amdgcn_fence(__ATOMIC_RELEASE, "agent");
            asm volatile("s_waitcnt vmcnt(0)" ::: "memory");
            const unsigned og = xb_add(&bar[XB_TOP], 1u);
            const unsigned tg = og / nx;
            if (og + 1u == (tg + 1u) * nx) xb_add(&bar[XB_TOPGEN], 1u);
            else XB_SPIN(xb_ld(&bar[XB_TOPGEN]) == tg, bar);
            __builtin_amdgcn_fence(__ATOMIC_ACQUIRE, "agent");
            xb_add(&bar[XB_XGEN(b.x)], 1u);
            asm volatile("s_waitcnt vmcnt(0)" ::: "memory");
        } else {
            XB_SPIN(xb_ld(&bar[XB_XGEN(b.x)]) == gen, bar);
            __builtin_amdgcn_fence(__ATOMIC_ACQUIRE, "agent");
            asm volatile("s_waitcnt vmcnt(0)" ::: "memory");
        }
    }
    __syncthreads();
}

__device__ void ph_prep(const P& p, unsigned char* lds) {
    const int tid = tid_(), lane = tid & 63, wid = tid >> 6;
    const int gw = blockIdx.x * 8 + wid, nw = gridDim.x * 8;
    for (int r = gw; r < T; r += nw) {
        const int b = r / LP, pos = r % LP;
        bf16_t* dst = p.xn() + (size_t)r * D;
        if (pos >= L) {
#pragma unroll
            for (int i = 0; i < 4; ++i) *(uint2*)(dst + lane * 4 + 256 * i) = make_uint2(0u, 0u);
            continue;
        }
        const float* src = pos < NMETA ? p.meta + (size_t)pos * D : p.x + ((size_t)b * SEQ + (pos - NMETA)) * D;
        f32x4 v[4]; float ss = 0.f;
#pragma unroll
        for (int i = 0; i < 4; ++i) { v[i] = *(const f32x4*)(src + lane * 4 + 256 * i); ss += v[i][0] * v[i][0] + v[i][1] * v[i][1] + v[i][2] * v[i][2] + v[i][3] * v[i][3]; }
        ss = wave_sum(ss);
        const float rs = rsqrtf(ss * (1.0f / D) + EPS);
#pragma unroll
        for (int i = 0; i < 4; ++i) {
            const f32x4 g = *(const f32x4*)(p.attn_g + lane * 4 + 256 * i);
            uint2 o; o.x = pack2(v[i][0] * rs * g[0], v[i][1] * rs * g[1]); o.y = pack2(v[i][2] * rs * g[2], v[i][3] * rs * g[3]);
            *(uint2*)(dst + lane * 4 + 256 * i) = o;
        }
    }
    const int gt = blockIdx.x * NTHREADS + tid, nt = gridDim.x * NTHREADS;
    for (int i = gt; i < LP * 12; i += nt) {
        const int pos = i / 12, f = i % 12;
        const double ex = f < 8 ? -(double)f / 8.0 : -(double)(f - 8) / 4.0;
        const double inv = exp(ex * log(500000.0));
        const double ang = (double)pos * inv;
        const double twopi = 6.283185307179586476925286766559;
        const double r = ang - twopi * rint(ang / twopi);
        const float rf = (float)r;
        const float c = cosf(rf), s = sinf(rf);
        float* row = p.rope() + (size_t)pos * 24;
        if (f < 8) { row[f] = c; row[8 + f] = s; } else { row[16 + f - 8] = c; row[20 + f - 8] = s; }
    }
    for (int i = gt; i < 512; i += nt) {
        const float a = p.lb_logits[i], b2 = p.lb_logits[512 + i];
        p.lb()[i] = 1.0f / (1.0f + expf(b2 - a));
    }
    for (int i = gt; i < 128; i += nt) p.ctr()[i] = 0;
    convert_T(p.w_in, IN_COLS, p.winT(), 1024, NVC, WinMap{}, gt, nt);
    convert_T(p.w_ua, 1024, p.wuaT(), 512, 1024, IdMap{}, gt, nt);
    convert_T(p.w_uh, 1024, p.wuhT(), 512, 1024, IdMap{}, gt, nt);
    convert_T(p.w_out, 1024, p.woT(), 1024, 1024, IdMap{}, gt, nt);
}
constexpr int G_TILE_B = 256 * 64 * 2, G_STAGE_B = 2 * G_TILE_B;
__device__ __forceinline__ int g_lds_byte(int r, int c) { const int st = (r >> 4) * 2 + (c >> 5), ob = (r & 15) * 64 + (c & 31) * 2; return st * 1024 + (ob ^ (((ob >> 9) & 1) << 5)); }
__device__ __forceinline__ void g_stage_rc(int b, int& R, int& C) { const int st = b >> 10, sb = b & 1023, swz = sb ^ (((sb >> 9) & 1) << 5); R = (st >> 1) * 16 + swz / 64; C = (st & 1) * 32 + (swz % 64) / 2; }

struct GemmJob { const bf16_t* pa[4]; const bf16_t* pb[4]; };
template <class AOff, class BOff>
__device__ __forceinline__ void gemm_setup(GemmJob& j, const bf16_t* Abase, const AOff& aoff, const bf16_t* Bbase, const BOff& boff) {
    const int tid = tid_(), lane = tid & 63, wid = tid >> 6;
#pragma unroll
    for (int i = 0; i < 4; ++i) { int R, C; g_stage_rc(wid * 1024 + i * 8192 + lane * 16, R, C); j.pa[i] = Abase + aoff(R) + C; j.pb[i] = Bbase + boff(R) + C; }
}
#define G_STAGE(job, buf, kt) do { _Pragma("unroll") for (int i_ = 0; i_ < 4; ++i_) { \
        __builtin_amdgcn_global_load_lds((const unsigned*)((job).pa[i_] + (kt) * 64), (LAS unsigned*)(lds + (buf) * G_STAGE_B + wid * 1024 + i_ * 8192), 16, 0, 0); \
        __builtin_amdgcn_global_load_lds((const unsigned*)((job).pb[i_] + (kt) * 64), (LAS unsigned*)(lds + (buf) * G_STAGE_B + G_TILE_B + wid * 1024 + i_ * 8192), 16, 0, 0); } } while (0)
__device__ __forceinline__ void gemm_prefetch(unsigned char* lds_, const GemmJob& j) {
    LAS unsigned char* lds = (LAS unsigned char*)lds_;
    const int wid = __builtin_amdgcn_readfirstlane(tid_() >> 6);
    G_STAGE(j, 0, 0);
}
__device__ __forceinline__ void gemm_run(unsigned char* lds_, const GemmJob& job, int K, f32x4 (&acc)[8][4], bool has_next, const GemmJob& next) {
    LAS unsigned char* lds = (LAS unsigned char*)lds_;
    const int tid = tid_(), lane = tid & 63, wid = __builtin_amdgcn_readfirstlane(tid >> 6), wr = wid >> 2, wc = wid & 3, fr = lane & 15, fq = lane >> 4;
#pragma unroll
    for (int m = 0; m < 8; ++m)
#pragma unroll
        for (int n = 0; n < 4; ++n) acc[m][n] = (f32x4){0.f, 0.f, 0.f, 0.f};
    const int nt = K / 64;
    const int aoffs = g_lds_byte(wr * 128 + fr, fq * 8), boffs = g_lds_byte(wc * 64 + fr, fq * 8);
    asm volatile("s_waitcnt vmcnt(0)" ::: "memory");
    __syncthreads();
    for (int t = 0; t < nt; ++t) {
        const int cur = t & 1;
        if (t + 1 < nt) G_STAGE(job, cur ^ 1, t + 1);
        else if (has_next) G_STAGE(next, 0, 0);
#pragma unroll
        for (int ks = 0; ks < 2; ++ks) {
            bf16x8 At[8], Bf[4];
#pragma unroll
            for (int m = 0; m < 8; ++m) At[m] = *(const LAS bf16x8*)(lds + cur * G_STAGE_B + aoffs + m * 2048 + ks * 1024);
#pragma unroll
            for (int n = 0; n < 4; ++n) Bf[n] = *(const LAS bf16x8*)(lds + cur * G_STAGE_B + G_TILE_B + boffs + n * 2048 + ks * 1024);
#pragma unroll
            for (int m = 0; m < 8; ++m)
#pragma unroll
                for (int n = 0; n < 4; ++n) acc[m][n] = __builtin_amdgcn_mfma_f32_16x16x32_bf16(Bf[n], At[m], acc[m][n], 0, 0, 0);
            __builtin_amdgcn_sched_barrier(0);
        }
        if (t + 1 < nt) { asm volatile("s_waitcnt vmcnt(0)" ::: "memory"); __syncthreads(); }
    }
}
struct RowLin { size_t base; int ld; __device__ __forceinline__ size_t operator()(int R) const { return base + (size_t)R * ld; } };

__device__ __forceinline__ void st_bf4(bf16_t* dst, f32x4 v) {
    uint2 o; o.x = pack2(v[0], v[1]); o.y = pack2(v[2], v[3]); *(uint2*)dst = o;
}
#define EPI_LOOP(...) do { const int tid_e = tid_(), lane_e = tid_e & 63, wid_e = tid_e >> 6, wr = wid_e >> 2, wc = wid_e & 3, fr = lane_e & 15, fq = lane_e >> 4; \
    _Pragma("unroll") for (int m = 0; m < 8; ++m) _Pragma("unroll") for (int n = 0; n < 4; ++n) { const int row = wr * 128 + m * 16 + fr, col = wc * 64 + n * 16 + fq * 4; __VA_ARGS__ } } while (0)

struct EpiInproj {
    const P* p; int nt;
    __device__ __forceinline__ void operator()(int m, int n, int ns, int fq, f32x4 v) const {
        const P& P_ = *p;
        const int pos = m % LP;
        const float* rp = P_.rope() + (size_t)pos * 24;
        if (nt <= 2) {
            const bool isv = (nt == 2) && (n >= 128);
            if (!isv && ns == 0) {
                f32x4 pr;
#pragma unroll
                for (int j = 0; j < 4; ++j) pr[j] = __shfl_xor(v[j], 32);
                const int i0 = (fq & 1) * 4;
#pragma unroll
                for (int j = 0; j < 4; ++j) {
                    const float c = rp[i0 + j], s = rp[8 + i0 + j];
                    v[j] = fq < 2 ? v[j] * c - pr[j] * s : v[j] * c + pr[j] * s;
                }
            }
            if (nt < 2) { st_bf4(P_.q() + (size_t)m * 512 + nt * 256 + n, v * (0.125f * 1.4426950408889634f)); }
            else if (n < 128) st_bf4(P_.k() + (size_t)m * 128 + n, v);
            else st_bf4(P_.v() + (size_t)m * 128 + (n - 128), v);
        } else if (nt == 3 || nt == 4) {
            const bool ropeable = (nt == 3) ? ((ns & 1) == 0) : (n < 16);
            if (ropeable) {
                f32x4 pr;
#pragma unroll
                for (int j = 0; j < 4; ++j) pr[j] = __shfl_xor(v[j], 16);
                if (fq < 2) {
#pragma unroll
                    for (int j = 0; j < 4; ++j) {
                        const float c = rp[16 + j], s = rp[20 + j];
                        v[j] = fq == 0 ? v[j] * c - pr[j] * s : v[j] * c + pr[j] * s;
                    }
                }
            }
            if (nt == 3) st_bf4(P_.iq() + (size_t)m * 256 + n, v);
            else if (n < 32) st_bf4(P_.ik() + (size_t)m * 32 + n, v);
            else if (n < 40) *(f32x4*)(P_.iw() + (size_t)m * 8 + (n - 32)) = v;
        } else if (nt <= 6) { st_bf4(P_.hq() + (size_t)m * 512 + (nt - 5) * 256 + n, v * 0.08838834764831845f); }
        else if (nt <= 8) { st_bf4(P_.hf() + (size_t)m * 512 + (nt - 7) * 256 + n, v); }
        else if (nt <= 10) { st_bf4(P_.hi() + (size_t)m * 512 + (nt - 9) * 256 + n, v); }
        else if (nt <= 12) {
            f32x4 o;
#pragma unroll
            for (int j = 0; j < 4; ++j) o[j] = v[j] * sigmoidf_(v[j]);
            st_bf4(P_.hg() + (size_t)m * 512 + (nt - 11) * 256 + n, o);
        } else {
            f32x4 o;
#pragma unroll
            for (int j = 0; j < 4; ++j) o[j] = sigmoidf_(v[j]);
            if (nt <= 16) st_bf4(P_.ga() + (size_t)m * 1024 + (nt - 13) * 256 + n, o);
            else st_bf4(P_.gh() + (size_t)m * 1024 + (nt - 17) * 256 + n, o);
        }
    }
};

__device__ void ph_inproj(const P& p, unsigned char* lds) {
    const int nunits = (T / 256) * 21, G = gridDim.x;
    auto mk = [&](GemmJob& j, int u) { const int nt = u % 21, mt = u / 21; gemm_setup(j, p.xn(), RowLin{(size_t)mt * 256 * D, D}, p.winT(), RowLin{(size_t)nt * 256 * D, D}); };
    int u = blockIdx.x;
    if (u >= nunits) return;
    GemmJob cur, nxt;
    mk(cur, u); gemm_prefetch(lds, cur);
    for (; u < nunits; u += G) {
        const bool hn = u + G < nunits;
        if (hn) mk(nxt, u + G);
        f32x4 acc[8][4];
        gemm_run(lds, cur, D, acc, hn, nxt);
        const int nt = u % 21, mt = u / 21;
        const EpiInproj epi{&p, nt};
        EPI_LOOP( epi(mt * 256 + row, col, n, fq, acc[m][n]); );
        cur = nxt;
    }
}

constexpr int NCH = 129, NXU = 16 * NCH;
constexpr int X_QT = 0, X_KT = X_QT + 64 * 272, X_KH = X_KT + 64 * 272, X_VT = X_KH + 128 * 144, X_AS = X_VT + 128 * 144, X_SEG = X_AS + 64 * 144;
__device__ __forceinline__ bf16_t* hg_ds(const P& p) { return (bf16_t*)p.out; }
__device__ __forceinline__ float* hg_g(const P& p) { return (float*)((unsigned char*)p.out + (size_t)NXU * 32768); }

__device__ void hgx_unit(const P& p, unsigned char* lds, int u) {
    const int tid = tid_(), lane = tid & 63, wid = tid >> 6, fr = lane & 15, fq = lane >> 4;
    const int c = u % NCH, bh = u / NCH, b = bh >> 2, h = bh & 3;
    const int d = tid & 127, seg = tid >> 7;
    const size_t rowbase = (size_t)(b * LP + c * 64 + seg * 16) * 512 + h * 128 + d;
    bf16_t* hqp = p.hq() + rowbase; const bf16_t* hfp = p.hf() + rowbase; const bf16_t* hip = p.hi() + rowbase;
    const float lbv = p.lb()[h * 128 + d];
    float bb[16], qv[16], kk[16], vv[16];
    float cs = 0.f;
#pragma unroll
    for (int i = 0; i < 16; ++i) {
        const float f = lbv + (1.0f - lbv) * sigmoidf_(bf2f(hfp[(size_t)i * 512]));
        kk[i] = 1.0f - f; cs += __logf(f); bb[i] = cs;
        qv[i] = bf2f(hqp[(size_t)i * 512]); vv[i] = bf2f(hip[(size_t)i * 512]);
    }
    float* segs = (float*)(lds + X_SEG);
    segs[seg * 128 + d] = cs;
    __syncthreads();
    const float s0 = segs[d], s1 = segs[128 + d], s2 = segs[256 + d], s3 = segs[384 + d];
    const float off = seg == 0 ? 0.f : (seg == 1 ? s0 : (seg == 2 ? s0 + s1 : s0 + s1 + s2));
    const float rref = s0 + s1, blast = (s0 + s1) + (s2 + s3);
    uint32_t khp[8], vtp[8];
#pragma unroll
    for (int i = 0; i < 16; i += 2) {
        float khv[2];
#pragma unroll
        for (int j = 0; j < 2; ++j) {
            const float bt = bb[i + j] + off;
            const float eq = __expf(fminf(bt - rref, 80.f)), ek = __expf(fminf(rref - bt, 80.f));
            const int t = seg * 16 + i + j;
            *(bf16_t*)(lds + X_QT + t * 272 + d * 2) = f2bf(qv[i + j] * eq);
            *(bf16_t*)(lds + X_KT + t * 272 + d * 2) = f2bf(kk[i + j] * ek);
            hqp[(size_t)(i + j) * 512] = f2bf(qv[i + j] * __expf(bt));
            khv[j] = kk[i + j] * __expf(blast - bt);
        }
        khp[i >> 1] = pack2(khv[0], khv[1]); vtp[i >> 1] = pack2(vv[i], vv[i + 1]);
    }
    *(uint4*)(lds + X_KH + d * 144 + seg * 32) = make_uint4(khp[0], khp[1], khp[2], khp[3]);
    *(uint4*)(lds + X_KH + d * 144 + seg * 32 + 16) = make_uint4(khp[4], khp[5], khp[6], khp[7]);
    *(uint4*)(lds + X_VT + d * 144 + seg * 32) = make_uint4(vtp[0], vtp[1], vtp[2], vtp[3]);
    *(uint4*)(lds + X_VT + d * 144 + seg * 32 + 16) = make_uint4(vtp[4], vtp[5], vtp[6], vtp[7]);
    if (seg == 0) hg_g(p)[(size_t)u * 128 + d] = __expf(blast);
    __syncthreads();
    {
        const int tm = wid >> 1, tn0 = (wid & 1) * 2;
        f32x4 a1[2] = {(f32x4){0.f, 0.f, 0.f, 0.f}, (f32x4){0.f, 0.f, 0.f, 0.f}};
#pragma unroll
        for (int ks = 0; ks < 4; ++ks) {
            const bf16x8 aq = *(const bf16x8*)(lds + X_QT + (tm * 16 + fr) * 272 + (ks * 32 + fq * 8) * 2);
#pragma unroll
            for (int j = 0; j < 2; ++j) {
                const bf16x8 bk = *(const bf16x8*)(lds + X_KT + ((tn0 + j) * 16 + fr) * 272 + (ks * 32 + fq * 8) * 2);
                a1[j] = __builtin_amdgcn_mfma_f32_16x16x32_bf16(bk, aq, a1[j], 0, 0, 0);
            }
        }
#pragma unroll
        for (int j = 0; j < 2; ++j) {
            const int t = tm * 16 + fr, sb = (tn0 + j) * 16 + fq * 4;
            f32x4 v = a1[j];
#pragma unroll
            for (int jj = 0; jj < 4; ++jj) v[jj] = (sb + jj <= t) ? v[jj] : 0.f;
            uint2 o; o.x = pack2(v[0], v[1]); o.y = pack2(v[2], v[3]);
            *(uint2*)(lds + X_AS + t * 144 + sb * 2) = o;
        }
    }
    __syncthreads();
    {
        const int tm = wid >> 1, en0 = (wid & 1) * 4;
        f32x4 o2[4];
#pragma unroll
        for (int j = 0; j < 4; ++j) o2[j] = (f32x4){0.f, 0.f, 0.f, 0.f};
#pragma unroll
        for (int ks = 0; ks < 2; ++ks) {
            const bf16x8 aa = *(const bf16x8*)(lds + X_AS + (tm * 16 + fr) * 144 + (ks * 32 + fq * 8) * 2);
#pragma unroll
            for (int j = 0; j < 4; ++j) {
                const bf16x8 bv = *(const bf16x8*)(lds + X_VT + ((en0 + j) * 16 + fr) * 144 + (ks * 32 + fq * 8) * 2);
                o2[j] = __builtin_amdgcn_mfma_f32_16x16x32_bf16(bv, aa, o2[j], 0, 0, 0);
            }
        }
        bf16_t* orow = p.hf() + (size_t)(b * LP + c * 64 + tm * 16 + fr) * 512 + h * 128;
#pragma unroll
        for (int j = 0; j < 4; ++j) st_bf4(orow + (en0 + j) * 16 + fq * 4, o2[j]);
    }
    {
        f32x4 s3[8];
#pragma unroll
        for (int j = 0; j < 8; ++j) s3[j] = (f32x4){0.f, 0.f, 0.f, 0.f};
#pragma unroll
        for (int ks = 0; ks < 2; ++ks) {
            const bf16x8 ak = *(const bf16x8*)(lds + X_KH + (wid * 16 + fr) * 144 + (ks * 32 + fq * 8) * 2);
#pragma unroll
            for (int j = 0; j < 8; ++j) {
                const bf16x8 bv = *(const bf16x8*)(lds + X_VT + (j * 16 + fr) * 144 + (ks * 32 + fq * 8) * 2);
                s3[j] = __builtin_amdgcn_mfma_f32_16x16x32_bf16(ak, bv, s3[j], 0, 0, 0);
            }
        }
        bf16_t* dsb = hg_ds(p) + (size_t)u * 16384;
#pragma unroll
        for (int j = 0; j < 8; ++j) st_bf4(dsb + (size_t)(j * 16 + fr) * 128 + wid * 16 + fq * 4, s3[j]);
    }
    __syncthreads();
}

__device__ void hgchain_unit(const P& p, int bh) {
    const int tid = tid_(), e = tid & 127, dr = tid >> 7;
    float S[32];
#pragma unroll
    for (int i = 0; i < 32; ++i) S[i] = 0.f;
    uint4* ptr = (uint4*)(hg_ds(p) + ((size_t)(bh * NCH) * 128 + e) * 128 + dr * 32);
    const f32x4* gp = (const f32x4*)(hg_g(p) + (size_t)(bh * NCH) * 128 + dr * 32);
    uint4 w[4]; f32x4 g[8];
#pragma unroll
    for (int i = 0; i < 4; ++i) w[i] = ptr[i];
#pragma unroll
    for (int i = 0; i < 8; ++i) g[i] = gp[i];
    for (int c = 0; c < NCH; ++c) {
        uint4 wn[4]; f32x4 gn[8];
        uint4* pn = ptr + 16384 * 2 / 16;
        const f32x4* gpn = gp + 32;
        if (c + 1 < NCH) {
#pragma unroll
            for (int i = 0; i < 4; ++i) wn[i] = pn[i];
#pragma unroll
            for (int i = 0; i < 8; ++i) gn[i] = gpn[i];
        }
#pragma unroll
        for (int i = 0; i < 4; ++i)
            ptr[i] = make_uint4(pack2(S[8 * i], S[8 * i + 1]), pack2(S[8 * i + 2], S[8 * i + 3]), pack2(S[8 * i + 4], S[8 * i + 5]), pack2(S[8 * i + 6], S[8 * i + 7]));
#pragma unroll
        for (int i = 0; i < 4; ++i) {
            const uint32_t ww[4] = {w[i].x, w[i].y, w[i].z, w[i].w};
#pragma unroll
            for (int j = 0; j < 4; ++j) {
                const float lo = __uint_as_float(ww[j] << 16), hi = __uint_as_float(ww[j] & 0xffff0000u);
                S[8 * i + 2 * j] = g[2 * i + (j >> 1)][(2 * j) & 3] * S[8 * i + 2 * j] + lo;
                S[8 * i + 2 * j + 1] = g[2 * i + (j >> 1)][(2 * j + 1) & 3] * S[8 * i + 2 * j + 1] + hi;
            }
        }
        if (c + 1 < NCH) {
#pragma unroll
            for (int i = 0; i < 4; ++i) w[i] = wn[i];
#pragma unroll
            for (int i = 0; i < 8; ++i) g[i] = gn[i];
        }
        ptr = pn; gp = gpn;
    }
}

__device__ void hgz_unit(const P& p, unsigned char* lds, int u) {
    const int tid = tid_(), lane = tid & 63, wid = tid >> 6, fr = lane & 15, fq = lane >> 4;
    const int c = u % NCH, bh = u / NCH, b = bh >> 2, h = bh & 3;
    const int tm = wid >> 1, en0 = (wid & 1) * 4;
    const size_t row = (size_t)(b * LP + c * 64 + tm * 16 + fr);
    const bf16_t* qrow = p.hq() + row * 512 + h * 128;
    const bf16_t* sT = hg_ds(p) + (size_t)u * 16384;
    f32x4 o[4];
#pragma unroll
    for (int j = 0; j < 4; ++j) o[j] = (f32x4){0.f, 0.f, 0.f, 0.f};
#pragma unroll
    for (int ks = 0; ks < 4; ++ks) {
        const bf16x8 aq = *(const bf16x8*)(qrow + ks * 32 + fq * 8);
#pragma unroll
        for (int j = 0; j < 4; ++j) {
            const bf16x8 bs = *(const bf16x8*)(sT + (size_t)((en0 + j) * 16 + fr) * 128 + ks * 32 + fq * 8);
            o[j] = __builtin_amdgcn_mfma_f32_16x16x32_bf16(bs, aq, o[j], 0, 0, 0);
        }
    }
    const bf16_t* oi = p.hf() + row * 512 + h * 128;
    float ss = 0.f;
#pragma unroll
    for (int j = 0; j < 4; ++j) {
        const uint2 w = *(const uint2*)(oi + (en0 + j) * 16 + fq * 4);
        o[j][0] += __uint_as_float(w.x << 16); o[j][1] += __uint_as_float(w.x & 0xffff0000u);
        o[j][2] += __uint_as_float(w.y << 16); o[j][3] += __uint_as_float(w.y & 0xffff0000u);
        ss += o[j][0] * o[j][0] + o[j][1] * o[j][1] + o[j][2] * o[j][2] + o[j][3] * o[j][3];
    }
    ss += __shfl_xor(ss, 16); ss += __shfl_xor(ss, 32);
    float* part = (float*)lds;
    if (fq == 0) part[(tm * 16 + fr) * 2 + (wid & 1)] = ss;
    __syncthreads();
    const float tot = part[(tm * 16 + fr) * 2] + part[(tm * 16 + fr) * 2 + 1];
    const float rs = rsqrtf(tot * (1.0f / 128.0f) + EPS);
    const bf16_t* hgp = p.hg() + row * 512 + h * 128;
    bf16_t* outp = p.hgr() + row * 512 + h * 128;
#pragma unroll
    for (int j = 0; j < 4; ++j) {
        const int e0 = (en0 + j) * 16 + fq * 4;
        const f32x4 gn = *(const f32x4*)(p.hgrn_g + h * 128 + e0);
        const uint2 w = *(const uint2*)(hgp + e0);
        f32x4 r;
        r[0] = o[j][0] * rs * gn[0] * __uint_as_float(w.x << 16); r[1] = o[j][1] * rs * gn[1] * __uint_as_float(w.x & 0xffff0000u);
        r[2] = o[j][2] * rs * gn[2] * __uint_as_float(w.y << 16); r[3] = o[j][3] * rs * gn[3] * __uint_as_float(w.y & 0xffff0000u);
        st_bf4(outp + e0, r);
    }
    __syncthreads();
}

typedef float f32x16 __attribute__((ext_vector_type(16)));
typedef short s16x4 __attribute__((ext_vector_type(4)));
constexpr int NKMAX = 8224;
constexpr int A_SC = 0, A_H1 = A_SC + 4 * NKMAX * 4, A_H2 = A_H1 + 4096, A_SEL = A_H2 + 4096, A_CAND = A_SEL + 2048, A_META = A_CAND + 1024, A_END = A_META + 256;
static_assert(A_END <= LDS_BYTES - 16, "attention LDS");
__device__ __forceinline__ uint32_t skey(float f) { const uint32_t u = __float_as_uint(f); return (u & 0x80000000u) ? ~u : (u | 0x80000000u); }
__device__ __forceinline__ float skey_inv(uint32_t k) { return __uint_as_float((k & 0x80000000u) ? (k & 0x7fffffffu) : ~k); }
__device__ __forceinline__ void bins12(float s, float lo, float scale, int& b1, int& b2) {
    const float x = (s - lo) * scale;
    b1 = min(255, max(0, (int)x));
    const float fr = x - (float)b1;
    b2 = min(255, max(0, (int)(fr * 256.0f)));
}
template <int OFF> __device__ __forceinline__ s16x4 tr_read(unsigned addr) {
    s16x4 r; asm volatile("ds_read_b64_tr_b16 %0, %1 offset:%2" : "=&v"(r) : "v"(addr), "i"(OFF) : "memory"); return r;
}
__device__ __forceinline__ void scan_top(const int* hist, int K, int* m, int lane) {
    const int c0 = hist[4 * lane], c1 = hist[4 * lane + 1], c2 = hist[4 * lane + 2], c3 = hist[4 * lane + 3];
    const int tot = c0 + c1 + c2 + c3;
    int suf = tot;
#pragma unroll
    for (int o = 1; o < 64; o <<= 1) { const int t = __shfl_down(suf, o); if (lane + o < 64) suf += t; }
    const int a3 = suf - tot, a2 = a3 + c3, a1 = a2 + c2, a0 = a1 + c1;
    if (a3 < K && K <= a3 + c3) { m[0] = 4 * lane + 3; m[1] = a3; m[2] = c3; }
    if (a2 < K && K <= a2 + c2) { m[0] = 4 * lane + 2; m[1] = a2; m[2] = c2; }
    if (a1 < K && K <= a1 + c1) { m[0] = 4 * lane + 1; m[1] = a1; m[2] = c1; }
    if (a0 < K && K <= a0 + c0) { m[0] = 4 * lane + 0; m[1] = a0; m[2] = c0; }
}

__device__ void attn4_unit(const P& p, unsigned char* lds, int b, int grp) {
    const int tid = tid_(), lane = tid & 63, wid = __builtin_amdgcn_readfirstlane(tid >> 6);
    const int t0 = NMETA + 4 * grp;
    const int brow = b * LP, row0 = brow + t0;
    float* sc = (float*)(lds + A_SC);
    int* h1 = (int*)(lds + A_H1); int* h2 = (int*)(lds + A_H2);
    unsigned short* sel = (unsigned short*)(lds + A_SEL); unsigned short* cand = (unsigned short*)(lds + A_CAND);
    int* meta = (int*)(lds + A_META);
    const bool big = t0 + 1 > 256;
    for (int i = tid; i < 2048; i += NTHREADS) h1[i] = 0;
    if (tid < 64) { const int w = tid & 15; meta[tid] = (w == 0) ? -1 : 0; }
    if (!big) { for (int i = tid; i < 1024; i += NTHREADS) { const int q = i >> 8, j = i & 255; sel[i] = (unsigned short)(j <= t0 + q ? j : 0); } }
    __syncthreads();
    if (big) {
        {
            const int hh = lane >> 5, c32 = lane & 31;
            const int g = c32 >> 3, h2a = (c32 >> 2) & 1, bq = c32 & 3, aq = 2 * h2a + (g >> 1), ah = 4 * (g & 1) + bq;
            const bf16_t* ap = p.iq() + (size_t)(row0 + aq) * 256 + ah * 32 + 8 * hh;
            const bf16x8 a0 = *(const bf16x8*)ap, a1 = *(const bf16x8*)(ap + 16);
            const f32x4 w00 = *(const f32x4*)(p.iw() + (size_t)(row0 + 2 * hh) * 8), w01 = *(const f32x4*)(p.iw() + (size_t)(row0 + 2 * hh) * 8 + 4);
            const f32x4 w10 = *(const f32x4*)(p.iw() + (size_t)(row0 + 2 * hh + 1) * 8), w11 = *(const f32x4*)(p.iw() + (size_t)(row0 + 2 * hh + 1) * 8 + 4);
            const int ntiles = (t0 + 4 + 31) >> 5;
            const int tq0 = t0 + 2 * hh;
            float mx0 = -INFINITY, mn0 = INFINITY, mx1 = -INFINITY, mn1 = INFINITY;
            const bf16_t* kbase = p.ik() + (size_t)brow * 32 + 8 * hh;
            for (int tile = wid; tile < ntiles; tile += 8) {
                const int key = tile * 32 + c32;
                const bf16_t* kp = kbase + (size_t)key * 32;
                const bf16x8 b0 = *(const bf16x8*)kp, b1 = *(const bf16x8*)(kp + 16);
                f32x16 acc;
#pragma unroll
                for (int i = 0; i < 16; ++i) acc[i] = 0.f;
                acc = __builtin_amdgcn_mfma_f32_32x32x16_bf16(a0, b0, acc, 0, 0, 0);
                acc = __builtin_amdgcn_mfma_f32_32x32x16_bf16(a1, b1, acc, 0, 0, 0);
                float s0 = 0.f, s1 = 0.f;
#pragma unroll
                for (int i = 0; i < 4; ++i) {
                    s0 += w00[i] * fmaxf(acc[i], 0.f) + w01[i] * fmaxf(acc[4 + i], 0.f);
                    s1 += w10[i] * fmaxf(acc[8 + i], 0.f) + w11[i] * fmaxf(acc[12 + i], 0.f);
                }
                sc[(2 * hh) * NKMAX + key] = s0; sc[(2 * hh + 1) * NKMAX + key] = s1;
                if (key <= tq0) { mx0 = fmaxf(mx0, s0); mn0 = fminf(mn0, s0); }
                if (key <= tq0 + 1) { mx1 = fmaxf(mx1, s1); mn1 = fminf(mn1, s1); }
            }
#pragma unroll
            for (int o = 16; o >= 1; o >>= 1) {
                mx0 = fmaxf(mx0, __shfl_xor(mx0, o)); mn0 = fminf(mn0, __shfl_xor(mn0, o));
                mx1 = fmaxf(mx1, __shfl_xor(mx1, o)); mn1 = fminf(mn1, __shfl_xor(mn1, o));
            }
            if (c32 == 0) {
                if (mx0 >= mn0) { atomicMin((unsigned*)&meta[(2 * hh) * 16 + 0], skey(mn0)); atomicMax((unsigned*)&meta[(2 * hh) * 16 + 1], skey(mx0)); }
                if (mx1 >= mn1) { atomicMin((unsigned*)&meta[(2 * hh + 1) * 16 + 0], skey(mn1)); atomicMax((unsigned*)&meta[(2 * hh + 1) * 16 + 1], skey(mx1)); }
            }
        }
        __syncthreads();
        const int q = wid & 3, part = wid >> 2, n = t0 + q + 1;
        const float lo = skey_inv((unsigned)meta[q * 16 + 0]), hi = skey_inv((unsigned)meta[q * 16 + 1]);
        const float scale = hi > lo ? 256.0f / (hi - lo) : 0.f;
        const float* scq = sc + q * NKMAX;
        for (int idx = part * 64 + lane; idx < n; idx += 128) {
            int b1, b2; bins12(scq[idx], lo, scale, b1, b2);
            atomicAdd(&h1[q * 256 + b1], 1);
        }
        __syncthreads();
        if (wid < 4) scan_top(h1 + wid * 256, 256, meta + wid * 16 + 4, lane);
        __syncthreads();
        const int B1 = meta[q * 16 + 4], K2 = 256 - meta[q * 16 + 5];
        for (int idx = part * 64 + lane; idx < n; idx += 128) {
            int b1, b2; bins12(scq[idx], lo, scale, b1, b2);
            if (b1 == B1) atomicAdd(&h2[q * 256 + b2], 1);
        }
        __syncthreads();
        if (wid < 4) scan_top(h2 + wid * 256, 256 - meta[wid * 16 + 5], meta + wid * 16 + 7, lane);
        __syncthreads();
        const int B2 = meta[q * 16 + 7], rr = K2 - meta[q * 16 + 8], cnt2 = meta[q * 16 + 9];
        for (int base = part * 64; base < n; base += 128) {
            const int idx = base + lane;
            bool issel = false, iscand = false;
            if (idx < n) { int b1, b2; bins12(scq[idx], lo, scale, b1, b2); issel = b1 > B1 || (b1 == B1 && b2 > B2); iscand = (b1 == B1 && b2 == B2); }
            const unsigned long long ms = __ballot(issel), mc = __ballot(iscand);
            const unsigned long long lt = (1ull << lane) - 1ull;
            if (ms) {
                int bs = 0; if (lane == 0) bs = atomicAdd(&meta[q * 16 + 2], __popcll(ms));
                bs = __shfl(bs, 0);
                if (issel) sel[q * 256 + bs + __popcll(ms & lt)] = (unsigned short)idx;
            }
            if (mc) {
                int bs = 0; if (lane == 0) bs = atomicAdd(&meta[q * 16 + 3], __popcll(mc));
                bs = __shfl(bs, 0);
                const int pos = bs + __popcll(mc & lt);
                if (iscand && pos < 128) cand[q * 128 + pos] = (unsigned short)idx;
            }
        }
        __syncthreads();
        if (wid < 4) {
            const int qq = wid; const float* scr = sc + qq * NKMAX;
            const int rq = (256 - meta[qq * 16 + 5]) - meta[qq * 16 + 8], cq = meta[qq * 16 + 9], sbase = 256 - rq, nn = t0 + qq + 1;
            if (cq <= 128) {
                int taken = 0;
#pragma unroll
                for (int half = 0; half < 2; ++half) {
                    const int i = lane + 64 * half;
                    bool take = false; int myidx = 0;
                    if (i < cq) {
                        myidx = cand[qq * 128 + i]; const float mv = scr[myidx];
                        int rank = 0;
                        for (int j = 0; j < cq; ++j) { const int oj = cand[qq * 128 + j]; const float ov = scr[oj]; rank += (ov > mv) || (ov == mv && oj < myidx); }
                        take = rank < rq;
                    }
                    const unsigned long long mt = __ballot(take);
                    if (take) sel[qq * 256 + sbase + taken + __popcll(mt & ((1ull << lane) - 1ull))] = (unsigned short)myidx;
                    taken += __popcll(mt);
                }
            } else {
                const float lo_ = skey_inv((unsigned)meta[qq * 16 + 0]), hi_ = skey_inv((unsigned)meta[qq * 16 + 1]);
                const float sc_ = hi_ > lo_ ? 256.0f / (hi_ - lo_) : 0.f;
                const int B1_ = meta[qq * 16 + 4], B2_ = meta[qq * 16 + 7];
                int taken = 0;
                for (int base = 0; base < nn && taken < rq; base += 64) {
                    const int idx = base + lane; bool isc = false;
                    if (idx < nn) { int b1, b2; bins12(scr[idx], lo_, sc_, b1, b2); isc = (b1 == B1_ && b2 == B2_); }
                    const unsigned long long mc = __ballot(isc);
                    const int pos = taken + __popcll(mc & ((1ull << lane) - 1ull));
                    if (isc && pos < rq) sel[qq * 256 + sbase + pos] = (unsigned short)idx;
                    taken += __popcll(mc);
                }
            }
        }
        __syncthreads();
    }
    {
        const int q = wid >> 1, kvh = wid & 1, tq = t0 + q, nsel = min(tq + 1, 256);
        const int col = lane & 15, g4 = lane >> 4;
        const unsigned short* selq = sel + q * 256;
        bf16x8 qf0, qf1;
        {
            const bf16_t* qp = p.q() + (size_t)(row0 + q) * 512 + (kvh * 4 + (col & 3)) * 64 + g4 * 8;
            qf0 = *(const bf16x8*)qp; qf1 = *(const bf16x8*)(qp + 32);
            if (col >= 4) {
#pragma unroll
                for (int i = 0; i < 8; ++i) { qf0[i] = 0; qf1[i] = 0; }
            }
        }
        const bf16_t* kb = p.k() + (size_t)brow * 128 + kvh * 64 + g4 * 8;
        f32x4 lg[16];
#pragma unroll
        for (int t = 0; t < 16; ++t) {
            const int key = selq[t * 16 + col];
            const bf16_t* kp = kb + (size_t)key * 128;
            const bf16x8 k0 = *(const bf16x8*)kp, k1 = *(const bf16x8*)(kp + 32);
            f32x4 a = (f32x4){0.f, 0.f, 0.f, 0.f};
            a = __builtin_amdgcn_mfma_f32_16x16x32_bf16(k0, qf0, a, 0, 0, 0);
            a = __builtin_amdgcn_mfma_f32_16x16x32_bf16(k1, qf1, a, 0, 0, 0);
            lg[t] = a;
        }
        float mx = -INFINITY;
#pragma unroll
        for (int t = 0; t < 16; ++t)
#pragma unroll
            for (int j = 0; j < 4; ++j) { if (t * 16 + g4 * 4 + j >= nsel) lg[t][j] = -INFINITY; mx = fmaxf(mx, lg[t][j]); }
        mx = fmaxf(mx, __shfl_xor(mx, 16)); mx = fmaxf(mx, __shfl_xor(mx, 32));
        float sm = 0.f;
#pragma unroll
        for (int t = 0; t < 16; ++t)
#pragma unroll
            for (int j = 0; j < 4; ++j) { const float e = exp2f(lg[t][j] - mx); lg[t][j] = e; sm += e; }
        sm += __shfl_xor(sm, 16); sm += __shfl_xor(sm, 32);
        const float inv = 1.0f / sm;
        f32x4 o[4];
#pragma unroll
        for (int d = 0; d < 4; ++d) o[d] = (f32x4){0.f, 0.f, 0.f, 0.f};
        LAS unsigned char* vst = (LAS unsigned char*)lds + A_SC + wid * 8192;
        const bf16_t* vb = p.v() + (size_t)brow * 128 + kvh * 64 + (lane & 7) * 8;
        const unsigned rdbase = (unsigned)(uintptr_t)((LAS unsigned char*)lds + A_SC) + wid * 8192 + (4 * g4 + (col >> 2)) * 128 + (col & 3) * 8;
#define V_STAGE(s_, buf_) do { _Pragma("unroll") for (int i_ = 0; i_ < 4; ++i_) { \
            const int ksl_ = (s_) * 32 + i_ * 8 + (lane >> 3); const int key_ = selq[ksl_]; \
            __builtin_amdgcn_global_load_lds((const unsigned*)(vb + (size_t)key_ * 128), (LAS unsigned*)(vst + (buf_) * 4096 + i_ * 1024), 16, 0, 0); } } while (0)
        V_STAGE(0, 0);
#pragma unroll
        for (int s = 0; s < 8; ++s) {
            if (s + 1 < 8) { V_STAGE(s + 1, (s + 1) & 1); asm volatile("s_waitcnt vmcnt(4)" ::: "memory"); }
            else asm volatile("s_waitcnt vmcnt(0)" ::: "memory");
            const unsigned rb = rdbase + (s & 1) * 4096;
            const s16x4 l0 = tr_read<0>(rb), h0 = tr_read<2048>(rb), l1 = tr_read<32>(rb), h1_ = tr_read<2048 + 32>(rb);
            const s16x4 l2 = tr_read<64>(rb), h2_ = tr_read<2048 + 64>(rb), l3 = tr_read<96>(rb), h3 = tr_read<2048 + 96>(rb);
            asm volatile("s_waitcnt lgkmcnt(0)" ::: "memory");
            __builtin_amdgcn_sched_barrier(0);
            bf16x8 pa;
            {
                const uint32_t w0 = pack2(lg[2 * s][0], lg[2 * s][1]), w1 = pack2(lg[2 * s][2], lg[2 * s][3]);
                const uint32_t w2 = pack2(lg[2 * s + 1][0], lg[2 * s + 1][1]), w3 = pack2(lg[2 * s + 1][2], lg[2 * s + 1][3]);
                pa[0] = (short)(w0 & 0xffff); pa[1] = (short)(w0 >> 16); pa[2] = (short)(w1 & 0xffff); pa[3] = (short)(w1 >> 16);
                pa[4] = (short)(w2 & 0xffff); pa[5] = (short)(w2 >> 16); pa[6] = (short)(w3 & 0xffff); pa[7] = (short)(w3 >> 16);
            }
#define PKV(L, H) (bf16x8){L[0], L[1], L[2], L[3], H[0], H[1], H[2], H[3]}
            o[0] = __builtin_amdgcn_mfma_f32_16x16x32_bf16(pa, PKV(l0, h0), o[0], 0, 0, 0);
            o[1] = __builtin_amdgcn_mfma_f32_16x16x32_bf16(pa, PKV(l1, h1_), o[1], 0, 0, 0);
            o[2] = __builtin_amdgcn_mfma_f32_16x16x32_bf16(pa, PKV(l2, h2_), o[2], 0, 0, 0);
            o[3] = __builtin_amdgcn_mfma_f32_16x16x32_bf16(pa, PKV(l3, h3), o[3], 0, 0, 0);
#undef PKV
        }
#undef V_STAGE
        const float i0 = __shfl(inv, 0), i1 = __shfl(inv, 1), i2 = __shfl(inv, 2), i3 = __shfl(inv, 3);
        if (g4 == 0) {
            bf16_t* op = p.att() + (size_t)(row0 + q) * 512 + kvh * 256 + col;
#pragma unroll
            for (int d = 0; d < 4; ++d) {
                op[0 * 64 + d * 16] = f2bf(o[d][0] * i0); op[1 * 64 + d * 16] = f2bf(o[d][1] * i1);
                op[2 * 64 + d * 16] = f2bf(o[d][2] * i2); op[3 * 64 + d * 16] = f2bf(o[d][3] * i3);
            }
        }
    }
    __syncthreads();
}

constexpr int NAU = NTOK / 4, ATT_P1 = NAU / 8, ATT_P2 = NAU / 2;
template <int SUB>
__device__ void ph_mixer(const P& p, unsigned char* lds) {
    int* bc = (int*)(lds + LDS_BYTES - 16);
    constexpr int nh = SUB == 1 ? 16 : NXU;
    constexpr int a0 = SUB == 0 ? 0 : (SUB == 1 ? ATT_P1 : ATT_P2), a1 = SUB == 0 ? ATT_P1 : (SUB == 1 ? ATT_P2 : NAU);
    for (;;) {
        __syncthreads();
        if (tid_() == 0) bc[0] = atomicAdd(&p.ctr()[97 + SUB], 1);
        __syncthreads();
        const int it = bc[0];
        if (it >= nh + (a1 - a0)) break;
        if (it < nh) {
            if (SUB == 0) hgx_unit(p, lds, it);
            else if (SUB == 1) hgchain_unit(p, it);
            else hgz_unit(p, lds, it);
        } else {
            const int uu = NAU - 1 - (a0 + it - nh);
            attn4_unit(p, lds, uu & 3, uu >> 2);
        }
    }
}

__device__ __forceinline__ int tok_row(int tok) { return (tok >> 13) * LP + NMETA + (tok & 8191); }
__device__ void ph_mix(const P& p, unsigned char* lds) {
    const int njobs = (NTOK / 256) * 4 * 2, G = gridDim.x;
    auto mk = [&](GemmJob& j, int jb) { const int which = jb & 1, u = jb >> 1, nt = u & 3, mt = u >> 2; const size_t r0 = (size_t)tok_row(mt * 256);
        gemm_setup(j, which ? p.hgr() : p.att(), RowLin{r0 * 512, 512}, which ? p.wuhT() : p.wuaT(), RowLin{(size_t)nt * 256 * 512, 512}); };
    int jb = blockIdx.x * 2;
    if (jb >= njobs) return;
    GemmJob cur, nxt;
    mk(cur, jb); gemm_prefetch(lds, cur);
    for (; jb < njobs; jb = (jb & 1) ? jb + 2 * G - 1 : jb + 1) {
        const int jn = (jb & 1) ? jb + 2 * G - 1 : jb + 1;
        const bool hn = jn < njobs;
        if (hn) mk(nxt, jn);
        f32x4 acc[8][4];
        gemm_run(lds, cur, 512, acc, hn, nxt);
        const int which = jb & 1, u = jb >> 1, nt = u & 3, mt = u >> 2; const size_t r0 = (size_t)tok_row(mt * 256);
        if (which == 0) {
            EPI_LOOP(
                const size_t og = (r0 + row) * 1024 + nt * 256 + col, om = (size_t)(mt * 256 + row) * 1024 + nt * 256 + col;
                const uint2 g = *(const uint2*)(p.ga() + og);
                f32x4 r; const f32x4 v = acc[m][n];
                r[0] = v[0] * __uint_as_float(g.x << 16); r[1] = v[1] * __uint_as_float(g.x & 0xffff0000u);
                r[2] = v[2] * __uint_as_float(g.y << 16); r[3] = v[3] * __uint_as_float(g.y & 0xffff0000u);
                st_bf4(p.mix() + om, r);
            );
        } else {
            EPI_LOOP(
                const size_t og = (r0 + row) * 1024 + nt * 256 + col, om = (size_t)(mt * 256 + row) * 1024 + nt * 256 + col;
                const uint2 g = *(const uint2*)(p.gh() + og);
                const uint2 a = *(const uint2*)(p.mix() + om);
                f32x4 r; const f32x4 v = acc[m][n];
                r[0] = __uint_as_float(a.x << 16) + v[0] * __uint_as_float(g.x << 16); r[1] = __uint_as_float(a.x & 0xffff0000u) + v[1] * __uint_as_float(g.x & 0xffff0000u);
                r[2] = __uint_as_float(a.y << 16) + v[2] * __uint_as_float(g.y << 16); r[3] = __uint_as_float(a.y & 0xffff0000u) + v[3] * __uint_as_float(g.y & 0xffff0000u);
                st_bf4(p.mix() + om, r);
            );
        }
        cur = nxt;
    }
}

__device__ void ph_out(const P& p, unsigned char* lds) {
    const int nunits = (NTOK / 256) * 4, G = gridDim.x;
    auto mk = [&](GemmJob& j, int u) { const int nt = u & 3, mt = u >> 2; gemm_setup(j, p.mix(), RowLin{(size_t)mt * 256 * D, D}, p.woT(), RowLin{(size_t)nt * 256 * D, D}); };
    int u = blockIdx.x;
    if (u >= nunits) return;
    GemmJob cur, nxt;
    mk(cur, u); gemm_prefetch(lds, cur);
    for (; u < nunits; u += G) {
        const bool hn = u + G < nunits;
        if (hn) mk(nxt, u + G);
        f32x4 acc[8][4];
        gemm_run(lds, cur, D, acc, hn, nxt);
        const int nt = u & 3, mt = u >> 2;
        EPI_LOOP(
            const size_t o = (size_t)(mt * 256 + row) * D + nt * 256 + col;
            const f32x4 h0 = *(const f32x4*)(p.x + o);
            *(f32x4*)(p.out + o) = h0 + acc[m][n];
        );
        cur = nxt;
    }
}

constexpr int XS_LD = 1025;
__device__ void ph_route(const P& p, unsigned char* lds) {
    const int tid = tid_(), lane = tid & 63, wid = __builtin_amdgcn_readfirstlane(tid >> 6);
    const int gt = blockIdx.x * NTHREADS + tid, ntot = gridDim.x * NTHREADS;
    for (int i = gt; i < CAP; i += ntot) p.slot_token()[i] = -1;
    float* xs = (float*)lds;
    int* lhist = (int*)(lds + 32 * XS_LD * 4);
    for (int tb = blockIdx.x; tb < NTOK / 128; tb += gridDim.x) {
        if (tid < 32) lhist[tid] = 0;
        for (int tile = 0; tile < 4; ++tile) {
            const int tokt = tb * 128 + tile * 32;
            __syncthreads();
#pragma unroll
            for (int t = 0; t < 4; ++t) {
                const int tl = wid * 4 + t, tok = tokt + tl;
                const float* src = p.out + (size_t)tok * D;
                f32x4 v[4]; float ss = 0.f;
#pragma unroll
                for (int i = 0; i < 4; ++i) { v[i] = *(const f32x4*)(src + lane * 4 + 256 * i); ss += v[i][0] * v[i][0] + v[i][1] * v[i][1] + v[i][2] * v[i][2] + v[i][3] * v[i][3]; }
                ss = wave_sum(ss);
                const float rs = rsqrtf(ss * (1.0f / D) + EPS);
#pragma unroll
                for (int i = 0; i < 4; ++i) {
                    const f32x4 g = *(const f32x4*)(p.ffn_g + lane * 4 + 256 * i);
                    f32x4 xn; xn[0] = v[i][0] * rs * g[0]; xn[1] = v[i][1] * rs * g[1]; xn[2] = v[i][2] * rs * g[2]; xn[3] = v[i][3] * rs * g[3];
                    st_bf4(p.xn2() + (size_t)tok * D + lane * 4 + 256 * i, xn);
#pragma unroll
                    for (int c = 0; c < 4; ++c) xs[tl * XS_LD + lane * 4 + 256 * i + c] = xn[c];
                }
            }
            __syncthreads();
            f32x16 acc;
#pragma unroll
            for (int i = 0; i < 16; ++i) acc[i] = 0.f;
            {
                const float* xr = xs + (lane & 31) * XS_LD + wid * 128 + (lane >> 5);
                const float* wp = p.router_w + (size_t)(wid * 128 + (lane >> 5)) * 32 + (lane & 31);
#pragma unroll 16
                for (int i = 0; i < 64; ++i) acc = __builtin_amdgcn_mfma_f32_32x32x2f32(xr[2 * i], wp[(size_t)(2 * i) * 32], acc, 0, 0, 0);
            }
            __syncthreads();
#pragma unroll
            for (int r = 0; r < 16; ++r) xs[wid * 1024 + ((r & 3) + 8 * (r >> 2) + 4 * (lane >> 5)) * 32 + (lane & 31)] = acc[r];
            __syncthreads();
            const int e = lane & 31, hh = lane >> 5;
            const float be = p.router_b[e];
#pragma unroll
            for (int it = 0; it < 2; ++it) {
                const int tl = wid * 4 + it * 2 + hh;
                float l = be;
#pragma unroll
                for (int w = 0; w < 8; ++w) l += xs[w * 1024 + tl * 32 + e];
                float bv[4]; int bi[4];
#pragma unroll
                for (int k = 0; k < 4; ++k) {
                    float m = l;
#pragma unroll
                    for (int o = 16; o >= 1; o >>= 1) m = fmaxf(m, __shfl_xor(m, o));
                    const unsigned long long bal = __ballot(l == m);
                    const unsigned half = hh ? (unsigned)(bal >> 32) : (unsigned)bal;
                    const int idx = __builtin_ctz(half);
                    bv[k] = m; bi[k] = idx;
                    if (e == idx) l = -INFINITY;
                }
                const float e1 = __expf(bv[1] - bv[0]), e2 = __expf(bv[2] - bv[0]), e3 = __expf(bv[3] - bv[0]);
                const float inv = 1.0f / (1.0f + e1 + e2 + e3);
                if (e == 0) {
                    const int tok = tokt + tl;
                    p.tok_exp()[tok * 4 + 0] = bi[0]; p.tok_exp()[tok * 4 + 1] = bi[1]; p.tok_exp()[tok * 4 + 2] = bi[2]; p.tok_exp()[tok * 4 + 3] = bi[3];
                    p.tok_gate()[tok * 4 + 0] = inv; p.tok_gate()[tok * 4 + 1] = e1 * inv; p.tok_gate()[tok * 4 + 2] = e2 * inv; p.tok_gate()[tok * 4 + 3] = e3 * inv;
                    atomicAdd(&lhist[bi[0]], 1); atomicAdd(&lhist[bi[1]], 1); atomicAdd(&lhist[bi[2]], 1); atomicAdd(&lhist[bi[3]], 1);
                }
            }
        }
        __syncthreads();
        if (tid < 32) p.wg_cnt()[tb * 32 + tid] = lhist[tid];
        __syncthreads();
    }
    for (long task = gt; task < 96L * 16384; task += ntot) {
        const int mat = (int)(task >> 14), r = (int)(task & 16383), kq = r >> 10, n = r & 1023;
        const int which = mat >> 5, e = mat & 31;
        const float* W = (which == 0 ? p.w_gate : which == 1 ? p.w_up : p.w_down) + (size_t)e * 1048576 + (size_t)(kq * 64) * 1024 + n;
        bf16_t* outp = (which == 0 ? p.wgT() : which == 1 ? p.wuT() : p.wdT()) + (size_t)e * 1048576 + (size_t)n * 1024 + kq * 64;
        float v[64];
#pragma unroll
        for (int i = 0; i < 64; ++i) v[i] = W[(size_t)i * 1024];
        uint4* dst = (uint4*)outp;
#pragma unroll
        for (int i = 0; i < 8; ++i) dst[i] = make_uint4(pack2(v[8 * i], v[8 * i + 1]), pack2(v[8 * i + 2], v[8 * i + 3]), pack2(v[8 * i + 4], v[8 * i + 5]), pack2(v[8 * i + 6], v[8 * i + 7]));
    }
}

__device__ void ph_fill(const P& p, unsigned char* lds) {
    const int tid = tid_();
    int* tot = (int*)lds;
    int* pre = tot + 512;
    int* ps = pre + 512;
    int* lc = ps + 32;
    for (int tb = blockIdx.x; tb < NTOK / 128; tb += gridDim.x) {
        {
            const int e = tid & 31, part = tid >> 5;
            int t = 0, q = 0;
            for (int b2 = part; b2 < NTOK / 128; b2 += 16) { const int c = p.wg_cnt()[b2 * 32 + e]; t += c; if (b2 < tb) q += c; }
            tot[part * 32 + e] = t; pre[part * 32 + e] = q;
        }
        __syncthreads();
        if (tid == 0) {
            int acc = 0;
            for (int e = 0; e < NE; ++e) {
                int t = 0, q = 0;
                for (int i = 0; i < 16; ++i) { t += tot[i * 32 + e]; q += pre[i * 32 + e]; }
                ps[e] = acc + q; lc[e] = 0;
                const int nb = (t + 255) >> 8;
                if (tb == 0) for (int i = 0; i < nb; ++i) p.block_expert()[(acc >> 8) + i] = e;
                acc += nb * 256;
            }
            if (tb == 0) p.ctr()[96] = acc >> 8;
        }
        __syncthreads();
        {
            const int i = tb * 512 + tid;
            const int e = p.tok_exp()[i];
            const int dest = ps[e] + atomicAdd(&lc[e], 1);
            p.slot_token()[dest] = i >> 2;
            p.slot_rank()[dest] = i & 3;
            p.slot_gate()[dest] = p.tok_gate()[i];
        }
        __syncthreads();
    }
}

struct GUOff { int ct; __device__ __forceinline__ size_t operator()(int R) const {
    const int wcB = R >> 6, nB = (R >> 4) & 3, c = ct * 128 + wcB * 32 + (nB & 1) * 16 + (R & 15);
    return (size_t)(nB >> 1) * (WE_B / 2) + (size_t)c * 1024; } };
struct GatherOff { const int* st; __device__ __forceinline__ size_t operator()(int R) const { const int t = st[R]; return (size_t)(t < 0 ? 0 : t) * 1024; } };
__device__ void ph_moe1(const P& p, unsigned char* lds) {
    const int nunits = p.ctr()[96] * 8, G = gridDim.x;
    auto mk = [&](GemmJob& j, int u) { const int ct = u & 7, rb = u >> 3, e = p.block_expert()[rb];
        gemm_setup(j, p.xn2(), GatherOff{p.slot_token() + rb * 256}, p.wgT() + (size_t)e * 1048576, GUOff{ct}); };
    int u = blockIdx.x;
    if (u >= nunits) return;
    GemmJob cur, nxt;
    mk(cur, u); gemm_prefetch(lds, cur);
    for (; u < nunits; u += G) {
        const bool hn = u + G < nunits;
        if (hn) mk(nxt, u + G);
        f32x4 acc[8][4];
        gemm_run(lds, cur, D, acc, hn, nxt);
        const int ct = u & 7, rb = u >> 3, e = p.block_expert()[rb];
        {
            const int tid_e = tid_(), lane_e = tid_e & 63, wid_e = tid_e >> 6, wr = wid_e >> 2, wc = wid_e & 3, fr = lane_e & 15, fq = lane_e >> 4;
#pragma unroll
            for (int hh = 0; hh < 2; ++hh) {
                const int c = ct * 128 + wc * 32 + hh * 16 + fq * 4;
                const f32x4 bg = *(const f32x4*)(p.b_gate + (size_t)e * DFF + c), bu = *(const f32x4*)(p.b_up + (size_t)e * DFF + c);
#pragma unroll
                for (int m = 0; m < 8; ++m) {
                    const int row = rb * 256 + wr * 128 + m * 16 + fr;
                    f32x4 a;
#pragma unroll
                    for (int j = 0; j < 4; ++j) {
                        const float g = fminf(acc[m][hh][j] + bg[j], 7.0f);
                        const float uu = fminf(fmaxf(acc[m][2 + hh][j] + bu[j], -7.0f), 7.0f);
                        a[j] = (uu + 1.0f) * (g * sigmoidf_(1.702f * g));
                    }
                    st_bf4(p.act() + (size_t)row * DFF + c, a);
                }
            }
        }
        cur = nxt;
    }
}
__device__ void ph_moe2(const P& p, unsigned char* lds) {
    const int nunits = p.ctr()[96] * 4, G = gridDim.x;
    auto mk = [&](GemmJob& j, int u) { const int nt = u & 3, rb = u >> 2, e = p.block_expert()[rb];
        gemm_setup(j, p.act(), RowLin{(size_t)rb * 256 * DFF, DFF}, p.wdT() + (size_t)e * 1048576, RowLin{(size_t)nt * 256 * DFF, DFF}); };
    int u = blockIdx.x;
    if (u >= nunits) return;
    GemmJob cur, nxt;
    mk(cur, u); gemm_prefetch(lds, cur);
    for (; u < nunits; u += G) {
        const bool hn = u + G < nunits;
        if (hn) mk(nxt, u + G);
        f32x4 acc[8][4];
        gemm_run(lds, cur, DFF, acc, hn, nxt);
        const int nt = u & 3, rb = u >> 2, e = p.block_expert()[rb];
        {
            const int tid_e = tid_(), lane_e = tid_e & 63, wid_e = tid_e >> 6, wr = wid_e >> 2, wc = wid_e & 3, fr = lane_e & 15, fq = lane_e >> 4;
            f32x4 bd[4];
#pragma unroll
            for (int n = 0; n < 4; ++n) bd[n] = *(const f32x4*)(p.b_down + (size_t)e * D + nt * 256 + wc * 64 + n * 16 + fq * 4);
#pragma unroll
            for (int m = 0; m < 8; ++m) {
                const int slot = rb * 256 + wr * 128 + m * 16 + fr;
                const int tok = p.slot_token()[slot];
                if (tok < 0) continue;
                const int rank = p.slot_rank()[slot]; const float gate = p.slot_gate()[slot];
                const size_t o = (size_t)tok * D + nt * 256 + wc * 64 + fq * 4;
                if (rank == 0) {
#pragma unroll
                    for (int n = 0; n < 4; ++n) { float* d = p.out + o + n * 16; *(f32x4*)d = *(const f32x4*)d + (acc[m][n] + bd[n]) * gate; }
                } else {
                    bf16_t* yb = rank == 1 ? p.y1() : (rank == 2 ? p.y2() : p.y3());
#pragma unroll
                    for (int n = 0; n < 4; ++n) st_bf4(yb + o + n * 16, (acc[m][n] + bd[n]) * gate);
                }
            }
        }
        cur = nxt;
    }
}

__device__ void ph_final(const P& p, unsigned char* lds) {
    const int tid = tid_(), lane = tid & 63, wid = tid >> 6;
    const int gw = blockIdx.x * 8 + wid, nw = gridDim.x * 8;
    for (int tok = gw; tok < NTOK; tok += nw) {
        float* dst = p.out + (size_t)tok * D;
        f32x4 v[4];
#pragma unroll
        for (int i = 0; i < 4; ++i) v[i] = *(const f32x4*)(dst + lane * 4 + 256 * i);
#pragma unroll
        for (int j = 0; j < 3; ++j) {
            const bf16_t* yr = (j == 0 ? p.y1() : j == 1 ? p.y2() : p.y3()) + (size_t)tok * D;
#pragma unroll
            for (int i = 0; i < 4; ++i) {
                const uint2 w = *(const uint2*)(yr + lane * 4 + 256 * i);
                v[i][0] += __uint_as_float(w.x << 16); v[i][1] += __uint_as_float(w.x & 0xffff0000u);
                v[i][2] += __uint_as_float(w.y << 16); v[i][3] += __uint_as_float(w.y & 0xffff0000u);
            }
        }
        float ss = 0.f;
#pragma unroll
        for (int i = 0; i < 4; ++i) ss += v[i][0] * v[i][0] + v[i][1] * v[i][1] + v[i][2] * v[i][2] + v[i][3] * v[i][3];
        ss = wave_sum(ss);
        const float rs = rsqrtf(ss * (1.0f / D) + EPS);
#pragma unroll
        for (int i = 0; i < 4; ++i) {
            const f32x4 g = *(const f32x4*)(p.final_g + lane * 4 + 256 * i);
            *(f32x4*)(dst + lane * 4 + 256 * i) = v[i] * rs * g;
        }
    }
}

__global__ void __launch_bounds__(NTHREADS) k_mega(P p) {
    __shared__ __attribute__((aligned(16))) unsigned char lds[LDS_BYTES];
    cg::grid_group grid = cg::this_grid();
    if (tid_() < 4) ((unsigned*)(lds + LDS_BYTES - 32))[tid_()] = 0u;
    __syncthreads();
    const XcdBarrier xb = xcd_barrier_post((unsigned*)(p.ws + OFF_BAR), (volatile LAS unsigned*)(lds + LDS_BYTES - 32));
    ph_prep(p, lds); grid.sync();
    ph_inproj(p, lds); xcd_barrier(xb);
    ph_mixer<0>(p, lds); xcd_barrier(xb);
    ph_mixer<1>(p, lds); xcd_barrier(xb);
    ph_mixer<2>(p, lds); xcd_barrier(xb);
    ph_mix(p, lds); xcd_barrier(xb);
    ph_out(p, lds); xcd_barrier(xb);
    ph_route(p, lds); xcd_barrier(xb);
    ph_fill(p, lds); xcd_barrier(xb);
    ph_moe1(p, lds); xcd_barrier(xb);
    ph_moe2(p, lds); xcd_barrier(xb);
    ph_final(p, lds);
}

extern "C" void kernel_launch(void* const* d_in, const int* in_sizes, int n_in, void* d_out, int out_size, void* d_ws, size_t ws_size,
                              hipStream_t stream) {
    P p{};
    p.x = (const float*)d_in[0]; p.meta = (const float*)d_in[1]; p.attn_g = (const float*)d_in[2]; p.w_in = (const float*)d_in[3];
    p.hgrn_g = (const float*)d_in[4]; p.w_ua = (const float*)d_in[5]; p.w_uh = (const float*)d_in[6]; p.w_out = (const float*)d_in[7];
    p.lb_logits = (const float*)d_in[8]; p.ffn_g = (const float*)d_in[9]; p.router_w = (const float*)d_in[10]; p.router_b = (const float*)d_in[11];
    p.w_gate = (const float*)d_in[12]; p.b_gate = (const float*)d_in[13]; p.w_up = (const float*)d_in[14]; p.b_up = (const float*)d_in[15];
    p.w_down = (const float*)d_in[16]; p.b_down = (const float*)d_in[17]; p.final_g = (const float*)d_in[18];
    p.out = (float*)d_out;
    p.ws = (unsigned char*)d_ws;
    if (WS_NEED > ws_size) { fprintf(stderr, "workspace too small: need %zu have %zu\n", (size_t)WS_NEED, ws_size); return; }
    static int grid_blocks = 0;
    if (!grid_blocks) {
        int dev = 0, cus = 0, per_cu = 0;
        hipGetDevice(&dev);
        hipDeviceGetAttribute(&cus, hipDeviceAttributeMultiprocessorCount, dev);
        hipOccupancyMaxActiveBlocksPerMultiprocessor(&per_cu, k_mega, NTHREADS, 0);
        if (per_cu > 1) per_cu = 1;
        grid_blocks = cus * per_cu;
    }
    hipMemsetAsync(p.ws + OFF_BAR, 0, XCD_BAR_WORDS * 4, stream);
    void* args[] = {&p};
    hipError_t e = hipLaunchCooperativeKernel((void*)k_mega, dim3(grid_blocks), dim3(NTHREADS), args, 0, stream);
    if (e != hipSuccess) fprintf(stderr, "cooperative launch failed: %s (grid %d)\n", hipGetErrorString(e), grid_blocks);
}
```

```cpp
#include <hip/hip_runtime.h>
#include <hip/hip_cooperative_groups.h>
#include <stdint.h>
#include <cstdio>
namespace cg = cooperative_groups;

#ifndef MEGA
#define MEGA 1
#endif

typedef unsigned short bf16_t;
typedef short bf16x8 __attribute__((ext_vector_type(8)));
typedef float f32x4 __attribute__((ext_vector_type(4)));

constexpr int D = 1024, NB = 4, SEQ = 8192, NMETA = 16, L = SEQ + NMETA  , LP = 8320, T = NB * LP  ;
constexpr int NTOK = NB * SEQ;
constexpr int IN_COLS = 5160;
constexpr int NE = 32, TOPK = 4, DFF = 1024;
constexpr int CAP_BLOCKS = (NTOK * TOPK) / 256 + NE;
constexpr int CAP = CAP_BLOCKS * 256;
constexpr float EPS = 1e-5f;
constexpr int NTHREADS = 512;
constexpr int LDS_BYTES = 155648;
constexpr int NVC = 5376;
#define LAS __attribute__((address_space(3)))

__device__ __forceinline__ bf16_t f2bf(float f) {
    uint32_t u = __float_as_uint(f);
    u += 0x7fffu + ((u >> 16) & 1u);
    return (bf16_t)(u >> 16);
}
__device__ __forceinline__ float bf2f(bf16_t h) { return __uint_as_float(((uint32_t)h) << 16); }
__device__ __forceinline__ uint32_t pack2(float a, float b) { return (uint32_t)f2bf(a) | ((uint32_t)f2bf(b) << 16); }
__device__ __forceinline__ float sigmoidf_(float x) { return 1.0f / (1.0f + __expf(-x)); }
__device__ __forceinline__ float wave_sum(float v) {
#pragma unroll
    for (int o = 32; o >= 1; o >>= 1) v += __shfl_xor(v, o);
    return v;
}
__device__ __forceinline__ float wave_max(float v) {
#pragma unroll
    for (int o = 32; o >= 1; o >>= 1) v = fmaxf(v, __shfl_xor(v, o));
    return v;
}

constexpr size_t al256(size_t x) { return (x + 255) & ~(size_t)255; }
constexpr size_t TT = (size_t)T;
constexpr size_t MB1 = 1024 * 1024;
constexpr size_t WE_B = (size_t)NE * 1024 * 1024 * 2;
constexpr size_t OFF_WGT = 0, OFF_WUT = WE_B, OFF_WDT = 2 * WE_B, OFF_XN2 = 3 * WE_B, OFF_ACT = OFF_XN2 + (size_t)NTOK * D * 2,
                 OFF_TAB = OFF_ACT + (size_t)CAP * DFF * 2;
constexpr size_t OFF_Y1 = OFF_XN2, OFF_Y2 = OFF_WGT, OFF_Y3 = OFF_WUT;
constexpr size_t OFF_ROPE = OFF_TAB, OFF_LB = OFF_ROPE + al256((size_t)LP * 24 * 4), OFF_CTR = OFF_LB + al256(512 * 4),
                 OFF_BEXP = OFF_CTR + al256(128 * 4), OFF_SLOT = OFF_BEXP + al256((size_t)CAP_BLOCKS * 4), OFF_SRANK = OFF_SLOT + al256((size_t)CAP * 4),
                 OFF_SGATE = OFF_SRANK + al256((size_t)CAP * 4), OFF_TEXP = OFF_SGATE + al256((size_t)CAP * 4), OFF_TGATE = OFF_TEXP + al256((size_t)NTOK * 16),
                 OFF_BAR = OFF_TGATE + al256((size_t)NTOK * 16), OFF_WGC = OFF_BAR + al256(3456 * 4), WS_NEED = OFF_WGC + al256(256 * 32 * 4);
constexpr size_t OFF_WIN = 0, OFF_WUA = OFF_WIN + (size_t)NVC * 1024 * 2, OFF_WUH = OFF_WUA + MB1, OFF_WO = OFF_WUH + MB1, OFF_XN = OFF_WO + 2 * MB1,
                 OFF_Q = OFF_XN + TT * 2048, OFF_K = OFF_Q + TT * 1024, OFF_V = OFF_K + TT * 256, OFF_IQ = OFF_V + TT * 256, OFF_IK = OFF_IQ + TT * 512,
                 OFF_IW = OFF_IK + TT * 64, OFF_HQ = OFF_IW + TT * 32, OFF_HF = OFF_HQ + TT * 1024, OFF_HI = OFF_HF + TT * 1024, OFF_HG = OFF_HI + TT * 1024,
                 OFF_GA = OFF_HG + TT * 1024, OFF_GH = OFF_GA + TT * 2048, OFF_ATT = OFF_GH + TT * 2048, OFF_HGR = OFF_ATT + TT * 1024,
                 OFF_S1_END = OFF_HGR + TT * 1024;
constexpr size_t OFF_MIX = OFF_XN;
static_assert(OFF_S1_END <= OFF_TAB, "stage-1 layout overflows");

__device__ __forceinline__ int tid_() { int t = threadIdx.x; asm volatile("" : "+v"(t)); return t; }

struct P {
    const float *x, *meta, *attn_g, *w_in, *hgrn_g, *w_ua, *w_uh, *w_out, *lb_logits, *ffn_g, *router_w, *router_b,
        *w_gate, *b_gate, *w_up, *b_up, *w_down, *b_down, *final_g;
    float* out;
    unsigned char* ws;
#define WSF(type, name, off) __device__ __forceinline__ type* name() const { return (type*)(ws + (off)); }
    WSF(bf16_t, xn, OFF_XN) WSF(bf16_t, q, OFF_Q) WSF(bf16_t, k, OFF_K) WSF(bf16_t, v, OFF_V) WSF(bf16_t, iq, OFF_IQ) WSF(bf16_t, ik, OFF_IK)
    WSF(bf16_t, hq, OFF_HQ) WSF(bf16_t, hf, OFF_HF) WSF(bf16_t, hi, OFF_HI) WSF(bf16_t, hg, OFF_HG) WSF(bf16_t, ga, OFF_GA) WSF(bf16_t, gh, OFF_GH)
    WSF(bf16_t, att, OFF_ATT) WSF(bf16_t, hgr, OFF_HGR) WSF(bf16_t, mix, OFF_MIX) WSF(bf16_t, xn2, OFF_XN2) WSF(bf16_t, act, OFF_ACT)
    WSF(bf16_t, y1, OFF_Y1) WSF(bf16_t, y2, OFF_Y2) WSF(bf16_t, y3, OFF_Y3)
    WSF(bf16_t, winT, OFF_WIN) WSF(bf16_t, wuaT, OFF_WUA) WSF(bf16_t, wuhT, OFF_WUH) WSF(bf16_t, woT, OFF_WO)
    WSF(bf16_t, wgT, OFF_WGT) WSF(bf16_t, wuT, OFF_WUT) WSF(bf16_t, wdT, OFF_WDT)
    WSF(float, iw, OFF_IW) WSF(float, rope, OFF_ROPE) WSF(float, lb, OFF_LB) WSF(float, tok_gate, OFF_TGATE) WSF(float, slot_gate, OFF_SGATE)
    WSF(int, ctr, OFF_CTR)
    WSF(int, wg_cnt, OFF_WGC) WSF(int, block_expert, OFF_BEXP) WSF(int, slot_token, OFF_SLOT) WSF(int, slot_rank, OFF_SRANK) WSF(int, tok_exp, OFF_TEXP)
};

template <class ColMap>
__device__ __forceinline__ void convert_T(const float* W, int ldw, bf16_t* out, int K, int N, const ColMap& cmap, int gt, int ntot) {
    const int kb = K / 64; const long ntask = (long)N * kb;
    for (long task = gt; task < ntask; task += ntot) {
        const int kq = (int)(task / N), n = (int)(task % N);
        const int c = cmap(n);
        uint32_t w[32];
        if (c >= 0) {
            const float* src = W + (size_t)(kq * 64) * ldw + c;
            float v[64];
#pragma unroll
            for (int i = 0; i < 64; ++i) v[i] = src[(size_t)i * ldw];
#pragma unroll
            for (int i = 0; i < 32; ++i) w[i] = pack2(v[2 * i], v[2 * i + 1]);
        } else {
#pragma unroll
            for (int i = 0; i < 32; ++i) w[i] = 0u;
        }
        uint4* dst = (uint4*)(out + (size_t)n * K + kq * 64);
#pragma unroll
        for (int i = 0; i < 8; ++i) dst[i] = make_uint4(w[4 * i], w[4 * i + 1], w[4 * i + 2], w[4 * i + 3]);
    }
}
struct IdMap { __device__ __forceinline__ int operator()(int n) const { return n; } };
struct WinMap { __device__ __forceinline__ int operator()(int n) const { return n < 1064 ? n : (n < 1280 ? -1 : n - 216); } };

#define XB_TMO      128
#define XB_XCNT(j)  (256  + 64 * (j))
#define XB_XSUB(j)  (1280 + 64 * (j))
#define XB_XGEN(j)  (2304 + 64 * (j))
#define XB_TOP      3328
#define XB_TOPGEN   3392
#define XCD_BAR_WORDS 3456
#define XB_SPIN_CAP (1u << 22)
__device__ __forceinline__ unsigned xb_ld(unsigned* p)              { return __hip_atomic_load(p, __ATOMIC_RELAXED, __HIP_MEMORY_SCOPE_AGENT); }
__device__ __forceinline__ unsigned xb_add(unsigned* p, unsigned v) { return __hip_atomic_fetch_add(p, v, __ATOMIC_RELAXED, __HIP_MEMORY_SCOPE_AGENT); }
__device__ __forceinline__ unsigned xb_xcc_id() { return (unsigned)__builtin_amdgcn_s_getreg((3 << 11) | 20) & 0xFu; }
#define XB_SPIN(cond, bar) do { unsigned _sp = 0; while (cond) { __builtin_amdgcn_s_sleep(1); \
    if ((++_sp & 255u) == 0u) { if (xb_ld(&(bar)[XB_TMO])) break; if (_sp > XB_SPIN_CAP) { atomicAdd(&(bar)[XB_TMO], 1u); break; } } } } while (0)
struct XcdBarrier { unsigned* bar; unsigned x; volatile LAS unsigned* st; };
__device__ __forceinline__ XcdBarrier xcd_barrier_post(unsigned* bar, volatile LAS unsigned* st) {
    XcdBarrier b; b.bar = bar; b.x = xb_xcc_id(); b.st = st;
    if (threadIdx.x == 0) (void)xb_add(&bar[XB_XCNT(b.x)], 1u);
    return b;
}
__device__ __forceinline__ void xcd_barrier_complete(unsigned* bar, unsigned x, unsigned& nloc, unsigned& nx) {
    const unsigned G = gridDim.x * gridDim.y * gridDim.z;
    unsigned sum, cnt, mine, sp = 0u;
    for (;;) {
        sum = 0u; cnt = 0u; mine = 0u;
#pragma unroll
        for (unsigned j = 0; j < 16; ++j) { const unsigned c = xb_ld(&bar[XB_XCNT(j)]); sum += c; cnt += (c > 0u) ? 1u : 0u; mine = (j == x) ? c : mine; }
        if (sum == G) break;
        __builtin_amdgcn_s_sleep(1);
        if ((++sp & 255u) == 0u) { if (xb_ld(&bar[XB_TMO])) break; if (sp > XB_SPIN_CAP) { atomicAdd(&bar[XB_TMO], 1u); break; } }
    }
    nloc = mine > 0u ? mine : 1u; nx = cnt > 0u ? cnt : 1u;
}
__device__ __forceinline__ void xcd_barrier(const XcdBarrier& b) {
    asm volatile("s_waitcnt vmcnt(0)" ::: "memory");
    __syncthreads();
    if (threadIdx.x == 0) {
        unsigned* bar = b.bar;
        __builtin_amdgcn_s_waitcnt(0);
        unsigned nloc = b.st[0], nx = b.st[1];
        if (nloc == 0u) { xcd_barrier_complete(bar, b.x, nloc, nx); b.st[0] = nloc; b.st[1] = nx; }
        const unsigned old = xb_add(&bar[XB_XSUB(b.x)], 1u);
        const unsigned gen = old / nloc;
        if (old + 1u == (gen + 1u) * nloc) {
            __builtin_amdgcn_fence(__ATOMIC_RELEASE, "agent");
            asm volatile("s_waitcnt vmcnt(0)" ::: "memory");
            const unsigned og = xb_add(&bar[XB_TOP], 1u);
            const unsigned tg = og / nx;
            if (og + 1u == (tg + 1u) * nx) xb_add(&bar[XB_TOPGEN], 1u);
            else XB_SPIN(xb_ld(&bar[XB_TOPGEN]) == tg, bar);
            __builtin_amdgcn_fence(__ATOMIC_ACQUIRE, "agent");
            xb_add(&bar[XB_XGEN(b.x)], 1u);
            asm volatile("s_waitcnt vmcnt(0)" ::: "memory");
        } else {
            XB_SPIN(xb_ld(&bar[XB_XGEN(b.x)]) == gen, bar);
            __builtin_amdgcn_fence(__ATOMIC_ACQUIRE, "agent");
            asm volatile("s_waitcnt vmcnt(0)" ::: "memory");
        }
    }
    __syncthreads();
}

__device__ void ph_prep(const P& p, unsigned char* lds) {
    const int tid = tid_(), lane = tid & 63, wid = tid >> 6;
    const int gw = blockIdx.x * 8 + wid, nw = gridDim.x * 8;
    for (int r = gw; r < T; r += nw) {
        const int b = r / LP, pos = r % LP;
        bf16_t* dst = p.xn() + (size_t)r * D;
        if (pos >= L) {
#pragma unroll
            for (int i = 0; i < 4; ++i) *(uint2*)(dst + lane * 4 + 256 * i) = make_uint2(0u, 0u);
            continue;
        }
        const float* src = pos < NMETA ? p.meta + (size_t)pos * D : p.x + ((size_t)b * SEQ + (pos - NMETA)) * D;
        f32x4 v[4]; float ss = 0.f;
#pragma unroll
        for (int i = 0; i < 4; ++i) { v[i] = *(const f32x4*)(src + lane * 4 + 256 * i); ss += v[i][0] * v[i][0] + v[i][1] * v[i][1] + v[i][2] * v[i][2] + v[i][3] * v[i][3]; }
        ss = wave_sum(ss);
        const float rs = rsqrtf(ss * (1.0f / D) + EPS);
#pragma unroll
        for (int i = 0; i < 4; ++i) {
            const f32x4 g = *(const f32x4*)(p.attn_g + lane * 4 + 256 * i);
            uint2 o; o.x = pack2(v[i][0] * rs * g[0], v[i][1] * rs * g[1]); o.y = pack2(v[i][2] * rs * g[2], v[i][3] * rs * g[3]);
            *(uint2*)(dst + lane * 4 + 256 * i) = o;
        }
    }
    const int gt = blockIdx.x * NTHREADS + tid, nt = gridDim.x * NTHREADS;
    for (int i = gt; i < LP * 12; i += nt) {
        const int pos = i / 12, f = i % 12;
        const double ex = f < 8 ? -(double)f / 8.0 : -(double)(f - 8) / 4.0;
        const double inv = exp(ex * log(500000.0));
        const double ang = (double)pos * inv;
        const double twopi = 6.283185307179586476925286766559;
        const double r = ang - twopi * rint(ang / twopi);
        const float rf = (float)r;
        const float c = cosf(rf), s = sinf(rf);
        float* row = p.rope() + (size_t)pos * 24;
        if (f < 8) { row[f] = c; row[8 + f] = s; } else { row[16 + f - 8] = c; row[20 + f - 8] = s; }
    }
    for (int i = gt; i < 512; i += nt) {
        const float a = p.lb_logits[i], b2 = p.lb_logits[512 + i];
        p.lb()[i] = 1.0f / (1.0f + expf(b2 - a));
    }
    for (int i = gt; i < 128; i += nt) p.ctr()[i] = 0;
    convert_T(p.w_in, IN_COLS, p.winT(), 1024, NVC, WinMap{}, gt, nt);
    convert_T(p.w_ua, 1024, p.wuaT(), 512, 1024, IdMap{}, gt, nt);
    convert_T(p.w_uh, 1024, p.wuhT(), 512, 1024, IdMap{}, gt, nt);
    convert_T(p.w_out, 1024, p.woT(), 1024, 1024, IdMap{}, gt, nt);
}
constexpr int G_TILE_B = 256 * 64 * 2, G_STAGE_B = 2 * G_TILE_B;
__device__ __forceinline__ int g_lds_byte(int r, int c) { const int st = (r >> 4) * 2 + (c >> 5), ob = (r & 15) * 64 + (c & 31) * 2; return st * 1024 + (ob ^ (((ob >> 9) & 1) << 5)); }
__device__ __forceinline__ void g_stage_rc(int b, int& R, int& C) { const int st = b >> 10, sb = b & 1023, swz = sb ^ (((sb >> 9) & 1) << 5); R = (st >> 1) * 16 + swz / 64; C = (st & 1) * 32 + (swz % 64) / 2; }

struct GemmJob { const bf16_t* pa[4]; const bf16_t* pb[4]; };
template <class AOff, class BOff>
__device__ __forceinline__ void gemm_setup(GemmJob& j, const bf16_t* Abase, const AOff& aoff, const bf16_t* Bbase, const BOff& boff) {
    const int tid = tid_(), lane = tid & 63, wid = tid >> 6;
#pragma unroll
    for (int i = 0; i < 4; ++i) { int R, C; g_stage_rc(wid * 1024 + i * 8192 + lane * 16, R, C); j.pa[i] = Abase + aoff(R) + C; j.pb[i] = Bbase + boff(R) + C; }
}
#define G_STAGE(job, buf, kt) do { _Pragma("unroll") for (int i_ = 0; i_ < 4; ++i_) { \
        __builtin_amdgcn_global_load_lds((const unsigned*)((job).pa[i_] + (kt) * 64), (LAS unsigned*)(lds + (buf) * G_STAGE_B + wid * 1024 + i_ * 8192), 16, 0, 0); \
        __builtin_amdgcn_global_load_lds((const unsigned*)((job).pb[i_] + (kt) * 64), (LAS unsigned*)(lds + (buf) * G_STAGE_B + G_TILE_B + wid * 1024 + i_ * 8192), 16, 0, 0); } } while (0)
__device__ __forceinline__ void gemm_prefetch(unsigned char* lds_, const GemmJob& j) {
    LAS unsigned char* lds = (LAS unsigned char*)lds_;
    const int wid = __builtin_amdgcn_readfirstlane(tid_() >> 6);
    G_STAGE(j, 0, 0);
}
__device__ __forceinline__ void gemm_run(unsigned char* lds_, const GemmJob& job, int K, f32x4 (&acc)[8][4], bool has_next, const GemmJob& next) {
    LAS unsigned char* lds = (LAS unsigned char*)lds_;
    const int tid = tid_(), lane = tid & 63, wid = __builtin_amdgcn_readfirstlane(tid >> 6), wr = wid >> 2, wc = wid & 3, fr = lane & 15, fq = lane >> 4;
#pragma unroll
    for (int m = 0; m < 8; ++m)
#pragma unroll
        for (int n = 0; n < 4; ++n) acc[m][n] = (f32x4){0.f, 0.f, 0.f, 0.f};
    const int nt = K / 64;
    const int aoffs = g_lds_byte(wr * 128 + fr, fq * 8), boffs = g_lds_byte(wc * 64 + fr, fq * 8);
    asm volatile("s_waitcnt vmcnt(0)" ::: "memory");
    __syncthreads();
    for (int t = 0; t < nt; ++t) {
        const int cur = t & 1;
        if (t + 1 < nt) G_STAGE(job, cur ^ 1, t + 1);
        else if (has_next) G_STAGE(next, 0, 0);
#pragma unroll
        for (int ks = 0; ks < 2; ++ks) {
            bf16x8 At[8], Bf[4];
#pragma unroll
            for (int m = 0; m < 8; ++m) At[m] = *(const LAS bf16x8*)(lds + cur * G_STAGE_B + aoffs + m * 2048 + ks * 1024);
#pragma unroll
            for (int n = 0; n < 4; ++n) Bf[n] = *(const LAS bf16x8*)(lds + cur * G_STAGE_B + G_TILE_B + boffs + n * 2048 + ks * 1024);
#pragma unroll
            for (int m = 0; m < 8; ++m)
#pragma unroll
                for (int n = 0; n < 4; ++n) acc[m][n] = __builtin_amdgcn_mfma_f32_16x16x32_bf16(Bf[n], At[m], acc[m][n], 0, 0, 0);
            __builtin_amdgcn_sched_barrier(0);
        }
        if (t + 1 < nt) { asm volatile("s_waitcnt vmcnt(0)" ::: "memory"); __syncthreads(); }
    }
}
struct RowLin { size_t base; int ld; __device__ __forceinline__ size_t operator()(int R) const { return base + (size_t)R * ld; } };

__device__ __forceinline__ void st_bf4(bf16_t* dst, f32x4 v) {
    uint2 o; o.x = pack2(v[0], v[1]); o.y = pack2(v[2], v[3]); *(uint2*)dst = o;
}
#define EPI_LOOP(...) do { const int tid_e = tid_(), lane_e = tid_e & 63, wid_e = tid_e >> 6, wr = wid_e >> 2, wc = wid_e & 3, fr = lane_e & 15, fq = lane_e >> 4; \
    _Pragma("unroll") for (int m = 0; m < 8; ++m) _Pragma("unroll") for (int n = 0; n < 4; ++n) { const int row = wr * 128 + m * 16 + fr, col = wc * 64 + n * 16 + fq * 4; __VA_ARGS__ } } while (0)

struct EpiInproj {
    const P* p; int nt;
    __device__ __forceinline__ void operator()(int m, int n, int ns, int fq, f32x4 v) const {
        const P& P_ = *p;
        const int pos = m % LP;
        const float* rp = P_.rope() + (size_t)pos * 24;
        if (nt <= 2) {
            const bool isv = (nt == 2) && (n >= 128);
            if (!isv && ns == 0) {
                f32x4 pr;
#pragma unroll
                for (int j = 0; j < 4; ++j) pr[j] = __shfl_xor(v[j], 32);
                const int i0 = (fq & 1) * 4;
#pragma unroll
                for (int j = 0; j < 4; ++j) {
                    const float c = rp[i0 + j], s = rp[8 + i0 + j];
                    v[j] = fq < 2 ? v[j] * c - pr[j] * s : v[j] * c + pr[j] * s;
                }
            }
            if (nt < 2) { st_bf4(P_.q() + (size_t)m * 512 + nt * 256 + n, v * (0.125f * 1.4426950408889634f)); }
            else if (n < 128) st_bf4(P_.k() + (size_t)m * 128 + n, v);
            else st_bf4(P_.v() + (size_t)m * 128 + (n - 128), v);
        } else if (nt == 3 || nt == 4) {
            const bool ropeable = (nt == 3) ? ((ns & 1) == 0) : (n < 16);
            if (ropeable) {
                f32x4 pr;
#pragma unroll
                for (int j = 0; j < 4; ++j) pr[j] = __shfl_xor(v[j], 16);
                if (fq < 2) {
#pragma unroll
                    for (int j = 0; j < 4; ++j) {
                        const float c = rp[16 + j], s = rp[20 + j];
                        v[j] = fq == 0 ? v[j] * c - pr[j] * s : v[j] * c + pr[j] * s;
                    }
                }
            }
            if (nt == 3) st_bf4(P_.iq() + (size_t)m * 256 + n, v);
            else if (n < 32) st_bf4(P_.ik() + (size_t)m * 32 + n, v);
            else if (n < 40) *(f32x4*)(P_.iw() + (size_t)m * 8 + (n - 32)) = v;
        } else if (nt <= 6) { st_bf4(P_.hq() + (size_t)m * 512 + (nt - 5) * 256 + n, v * 0.08838834764831845f); }
        else if (nt <= 8) { st_bf4(P_.hf() + (size_t)m * 512 + (nt - 7) * 256 + n, v); }
        else if (nt <= 10) { st_bf4(P_.hi() + (size_t)m * 512 + (nt - 9) * 256 + n, v); }
        else if (nt <= 12) {
            f32x4 o;
#pragma unroll
            for (int j = 0; j < 4; ++j) o[j] = v[j] * sigmoidf_(v[j]);
            st_bf4(P_.hg() + (size_t)m * 512 + (nt - 11) * 256 + n, o);
        } else {
            f32x4 o;
#pragma unroll
            for (int j = 0; j < 4; ++j) o[j] = sigmoidf_(v[j]);
            if (nt <= 16) st_bf4(P_.ga() + (size_t)m * 1024 + (nt - 13) * 256 + n, o);
            else st_bf4(P_.gh() + (size_t)m * 1024 + (nt - 17) * 256 + n, o);
        }
    }
};

__device__ void ph_inproj(const P& p, unsigned char* lds) {
    const int nunits = (T / 256) * 21, G = gridDim.x;
    auto mk = [&](GemmJob& j, int u) { const int nt = u % 21, mt = u / 21; gemm_setup(j, p.xn(), RowLin{(size_t)mt * 256 * D, D}, p.winT(), RowLin{(size_t)nt * 256 * D, D}); };
    int u = blockIdx.x;
    if (u >= nunits) return;
    GemmJob cur, nxt;
    mk(cur, u); gemm_prefetch(lds, cur);
    for (; u < nunits; u += G) {
        const bool hn = u + G < nunits;
        if (hn) mk(nxt, u + G);
        f32x4 acc[8][4];
        gemm_run(lds, cur, D, acc, hn, nxt);
        const int nt = u % 21, mt = u / 21;
        const EpiInproj epi{&p, nt};
        EPI_LOOP( epi(mt * 256 + row, col, n, fq, acc[m][n]); );
        cur = nxt;
    }
}

constexpr int NCH = 129, NXU = 16 * NCH;
constexpr int X_QT = 0, X_KT = X_QT + 64 * 272, X_KH = X_KT + 64 * 272, X_VT = X_KH + 128 * 144, X_AS = X_VT + 128 * 144, X_SEG = X_AS + 64 * 144;
__device__ __forceinline__ bf16_t* hg_ds(const P& p) { return (bf16_t*)p.out; }
__device__ __forceinline__ float* hg_g(const P& p) { return (float*)((unsigned char*)p.out + (size_t)NXU * 32768); }

__device__ __forceinline__ void hgx_unit(const P& p, unsigned char* lds, int u) {
    const int tid = tid_(), lane = tid & 63, wid = tid >> 6, fr = lane & 15, fq = lane >> 4;
    const int c = u % NCH, bh = u / NCH, b = bh >> 2, h = bh & 3;
    const int d = tid & 127, seg = tid >> 7;
    const size_t rowbase = (size_t)(b * LP + c * 64 + seg * 16) * 512 + h * 128 + d;
    bf16_t* hqp = p.hq() + rowbase; const bf16_t* hfp = p.hf() + rowbase; const bf16_t* hip = p.hi() + rowbase;
    const float lbv = p.lb()[h * 128 + d];
    float bb[16], qv[16], kk[16], vv[16];
    float cs = 0.f;
#pragma unroll
    for (int i = 0; i < 16; ++i) {
        const float f = lbv + (1.0f - lbv) * sigmoidf_(bf2f(hfp[(size_t)i * 512]));
        kk[i] = 1.0f - f; cs += __logf(f); bb[i] = cs;
        qv[i] = bf2f(hqp[(size_t)i * 512]); vv[i] = bf2f(hip[(size_t)i * 512]);
    }
    float* segs = (float*)(lds + X_SEG);
    segs[seg * 128 + d] = cs;
    __syncthreads();
    const float s0 = segs[d], s1 = segs[128 + d], s2 = segs[256 + d], s3 = segs[384 + d];
    const float off = seg == 0 ? 0.f : (seg == 1 ? s0 : (seg == 2 ? s0 + s1 : s0 + s1 + s2));
    const float rref = s0 + s1, blast = (s0 + s1) + (s2 + s3);
    uint32_t khp[8], vtp[8];
#pragma unroll
    for (int i = 0; i < 16; i += 2) {
        float khv[2];
#pragma unroll
        for (int j = 0; j < 2; ++j) {
            const float bt = bb[i + j] + off;
            const float eq = __expf(fminf(bt - rref, 80.f)), ek = __expf(fminf(rref - bt, 80.f));
            const int t = seg * 16 + i + j;
            *(bf16_t*)(lds + X_QT + t * 272 + d * 2) = f2bf(qv[i + j] * eq);
            *(bf16_t*)(lds + X_KT + t * 272 + d * 2) = f2bf(kk[i + j] * ek);
            hqp[(size_t)(i + j) * 512] = f2bf(qv[i + j] * __expf(bt));
            khv[j] = kk[i + j] * __expf(blast - bt);
        }
        khp[i >> 1] = pack2(khv[0], khv[1]); vtp[i >> 1] = pack2(vv[i], vv[i + 1]);
    }
    *(uint4*)(lds + X_KH + d * 144 + seg * 32) = make_uint4(khp[0], khp[1], khp[2], khp[3]);
    *(uint4*)(lds + X_KH + d * 144 + seg * 32 + 16) = make_uint4(khp[4], khp[5], khp[6], khp[7]);
    *(uint4*)(lds + X_VT + d * 144 + seg * 32) = make_uint4(vtp[0], vtp[1], vtp[2], vtp[3]);
    *(uint4*)(lds + X_VT + d * 144 + seg * 32 + 16) = make_uint4(vtp[4], vtp[5], vtp[6], vtp[7]);
    if (seg == 0) hg_g(p)[(size_t)u * 128 + d] = __expf(blast);
    __syncthreads();
    {
        const int tm = wid >> 1, tn0 = (wid & 1) * 2;
        f32x4 a1[2] = {(f32x4){0.f, 0.f, 0.f, 0.f}, (f32x4){0.f, 0.f, 0.f, 0.f}};
#pragma unroll
        for (int ks = 0; ks < 4; ++ks) {
            const bf16x8 aq = *(const bf16x8*)(lds + X_QT + (tm * 16 + fr) * 272 + (ks * 32 + fq * 8) * 2);
#pragma unroll
            for (int j = 0; j < 2; ++j) {
                const bf16x8 bk = *(const bf16x8*)(lds + X_KT + ((tn0 + j) * 16 + fr) * 272 + (ks * 32 + fq * 8) * 2);
                a1[j] = __builtin_amdgcn_mfma_f32_16x16x32_bf16(bk, aq, a1[j], 0, 0, 0);
            }
        }
#pragma unroll
        for (int j = 0; j < 2; ++j) {
            const int t = tm * 16 + fr, sb = (tn0 + j) * 16 + fq * 4;
            f32x4 v = a1[j];
#pragma unroll
            for (int jj = 0; jj < 4; ++jj) v[jj] = (sb + jj <= t) ? v[jj] : 0.f;
            uint2 o; o.x = pack2(v[0], v[1]); o.y = pack2(v[2], v[3]);
            *(uint2*)(lds + X_AS + t * 144 + sb * 2) = o;
        }
    }
    __syncthreads();
    {
        const int tm = wid >> 1, en0 = (wid & 1) * 4;
        f32x4 o2[4];
#pragma unroll
        for (int j = 0; j < 4; ++j) o2[j] = (f32x4){0.f, 0.f, 0.f, 0.f};
#pragma unroll
        for (int ks = 0; ks < 2; ++ks) {
            const bf16x8 aa = *(const bf16x8*)(lds + X_AS + (tm * 16 + fr) * 144 + (ks * 32 + fq * 8) * 2);
#pragma unroll
            for (int j = 0; j < 4; ++j) {
                const bf16x8 bv = *(const bf16x8*)(lds + X_VT + ((en0 + j) * 16 + fr) * 144 + (ks * 32 + fq * 8) * 2);
                o2[j] = __builtin_amdgcn_mfma_f32_16x16x32_bf16(bv, aa, o2[j], 0, 0, 0);
            }
        }
        bf16_t* orow = p.hf() + (size_t)(b * LP + c * 64 + tm * 16 + fr) * 512 + h * 128;
#pragma unroll
        for (int j = 0; j < 4; ++j) st_bf4(orow + (en0 + j) * 16 + fq * 4, o2[j]);
    }
    {
        f32x4 s3[8];
#pragma unroll
        for (int j = 0; j < 8; ++j) s3[j] = (f32x4){0.f, 0.f, 0.f, 0.f};
#pragma unroll
        for (int ks = 0; ks < 2; ++ks) {
            const bf16x8 ak = *(const bf16x8*)(lds + X_KH + (wid * 16 + fr) * 144 + (ks * 32 + fq * 8) * 2);
#pragma unroll
            for (int j = 0; j < 8; ++j) {
                const bf16x8 bv = *(const bf16x8*)(lds + X_VT + (j * 16 + fr) * 144 + (ks * 32 + fq * 8) * 2);
                s3[j] = __builtin_amdgcn_mfma_f32_16x16x32_bf16(ak, bv, s3[j], 0, 0, 0);
            }
        }
        bf16_t* dsb = hg_ds(p) + (size_t)u * 16384;
#pragma unroll
        for (int j = 0; j < 8; ++j) st_bf4(dsb + (size_t)(j * 16 + fr) * 128 + wid * 16 + fq * 4, s3[j]);
    }
    __syncthreads();
}

__device__ __forceinline__ void hgchain_unit(const P& p, int bh) {
    const int tid = tid_(), e = tid & 127, dr = tid >> 7;
    float S[32];
#pragma unroll
    for (int i = 0; i < 32; ++i) S[i] = 0.f;
    uint4* ptr = (uint4*)(hg_ds(p) + ((size_t)(bh * NCH) * 128 + e) * 128 + dr * 32);
    const f32x4* gp = (const f32x4*)(hg_g(p) + (size_t)(bh * NCH) * 128 + dr * 32);
    uint4 w[4]; f32x4 g[8];
#pragma unroll
    for (int i = 0; i < 4; ++i) w[i] = ptr[i];
#pragma unroll
    for (int i = 0; i < 8; ++i) g[i] = gp[i];
    for (int c = 0; c < NCH; ++c) {
        uint4 wn[4]; f32x4 gn[8];
        uint4* pn = ptr + 16384 * 2 / 16;
        const f32x4* gpn = gp + 32;
        if (c + 1 < NCH) {
#pragma unroll
            for (int i = 0; i < 4; ++i) wn[i] = pn[i];
#pragma unroll
            for (int i = 0; i < 8; ++i) gn[i] = gpn[i];
        }
#pragma unroll
        for (int i = 0; i < 4; ++i)
            ptr[i] = make_uint4(pack2(S[8 * i], S[8 * i + 1]), pack2(S[8 * i + 2], S[8 * i + 3]), pack2(S[8 * i + 4], S[8 * i + 5]), pack2(S[8 * i + 6], S[8 * i + 7]));
#pragma unroll
        for (int i = 0; i < 4; ++i) {
            const uint32_t ww[4] = {w[i].x, w[i].y, w[i].z, w[i].w};
#pragma unroll
            for (int j = 0; j < 4; ++j) {
                const float lo = __uint_as_float(ww[j] << 16), hi = __uint_as_float(ww[j] & 0xffff0000u);
                S[8 * i + 2 * j] = g[2 * i + (j >> 1)][(2 * j) & 3] * S[8 * i + 2 * j] + lo;
                S[8 * i + 2 * j + 1] = g[2 * i + (j >> 1)][(2 * j + 1) & 3] * S[8 * i + 2 * j + 1] + hi;
            }
        }
        if (c + 1 < NCH) {
#pragma unroll
            for (int i = 0; i < 4; ++i) w[i] = wn[i];
#pragma unroll
            for (int i = 0; i < 8; ++i) g[i] = gn[i];
        }
        ptr = pn; gp = gpn;
    }
}

__device__ __forceinline__ void hgz_unit(const P& p, unsigned char* lds, int u) {
    const int tid = tid_(), lane = tid & 63, wid = tid >> 6, fr = lane & 15, fq = lane >> 4;
    const int c = u % NCH, bh = u / NCH, b = bh >> 2, h = bh & 3;
    const int tm = wid >> 1, en0 = (wid & 1) * 4;
    const size_t row = (size_t)(b * LP + c * 64 + tm * 16 + fr);
    const bf16_t* qrow = p.hq() + row * 512 + h * 128;
    const bf16_t* sT = hg_ds(p) + (size_t)u * 16384;
    f32x4 o[4];
#pragma unroll
    for (int j = 0; j < 4; ++j) o[j] = (f32x4){0.f, 0.f, 0.f, 0.f};
#pragma unroll
    for (int ks = 0; ks < 4; ++ks) {
        const bf16x8 aq = *(const bf16x8*)(qrow + ks * 32 + fq * 8);
#pragma unroll
        for (int j = 0; j < 4; ++j) {
            const bf16x8 bs = *(const bf16x8*)(sT + (size_t)((en0 + j) * 16 + fr) * 128 + ks * 32 + fq * 8);
            o[j] = __builtin_amdgcn_mfma_f32_16x16x32_bf16(bs, aq, o[j], 0, 0, 0);
        }
    }
    const bf16_t* oi = p.hf() + row * 512 + h * 128;
    float ss = 0.f;
#pragma unroll
    for (int j = 0; j < 4; ++j) {
        const uint2 w = *(const uint2*)(oi + (en0 + j) * 16 + fq * 4);
        o[j][0] += __uint_as_float(w.x << 16); o[j][1] += __uint_as_float(w.x & 0xffff0000u);
        o[j][2] += __uint_as_float(w.y << 16); o[j][3] += __uint_as_float(w.y & 0xffff0000u);
        ss += o[j][0] * o[j][0] + o[j][1] * o[j][1] + o[j][2] * o[j][2] + o[j][3] * o[j][3];
    }
    ss += __shfl_xor(ss, 16); ss += __shfl_xor(ss, 32);
    float* part = (float*)lds;
    if (fq == 0) part[(tm * 16 + fr) * 2 + (wid & 1)] = ss;
    __syncthreads();
    const float tot = part[(tm * 16 + fr) * 2] + part[(tm * 16 + fr) * 2 + 1];
    const float rs = rsqrtf(tot * (1.0f / 128.0f) + EPS);
    const bf16_t* hgp = p.hg() + row * 512 + h * 128;
    bf16_t* outp = p.hgr() + row * 512 + h * 128;
#pragma unroll
    for (int j = 0; j < 4; ++j) {
        const int e0 = (en0 + j) * 16 + fq * 4;
        const f32x4 gn = *(const f32x4*)(p.hgrn_g + h * 128 + e0);
        const uint2 w = *(const uint2*)(hgp + e0);
        f32x4 r;
        r[0] = o[j][0] * rs * gn[0] * __uint_as_float(w.x << 16); r[1] = o[j][1] * rs * gn[1] * __uint_as_float(w.x & 0xffff0000u);
        r[2] = o[j][2] * rs * gn[2] * __uint_as_float(w.y << 16); r[3] = o[j][3] * rs * gn[3] * __uint_as_float(w.y & 0xffff0000u);
        st_bf4(outp + e0, r);
    }
    __syncthreads();
}

typedef float f32x16 __attribute__((ext_vector_type(16)));
typedef short s16x4 __attribute__((ext_vector_type(4)));
constexpr int NKMAX = 8224;
constexpr int NBIN = 1024;
constexpr int A_SC = 0, A_H1 = A_SC + 4 * NKMAX * 4, A_SEL = A_H1 + 4 * NBIN * 4, A_CAND = A_SEL + 2048, A_META = A_CAND + 1024, A_END = A_META + 256;
static_assert(A_END <= LDS_BYTES - 16, "attention LDS");
__device__ __forceinline__ uint32_t skey(float f) { const uint32_t u = __float_as_uint(f); return (u & 0x80000000u) ? ~u : (u | 0x80000000u); }
__device__ __forceinline__ float skey_inv(uint32_t k) { return __uint_as_float((k & 0x80000000u) ? (k & 0x7fffffffu) : ~k); }
__device__ __forceinline__ int bin1(float s, float lo, float scale) { return min(NBIN - 1, max(0, (int)((s - lo) * scale))); }
template <int OFF> __device__ __forceinline__ s16x4 tr_read(unsigned addr) {
    s16x4 r; asm volatile("ds_read_b64_tr_b16 %0, %1 offset:%2" : "=&v"(r) : "v"(addr), "i"(OFF) : "memory"); return r;
}
__device__ __forceinline__ void scan_top(const int* hist, int K, int* m, int lane) {
    int c[16];
#pragma unroll
    for (int i = 0; i < 4; ++i) { const int4 v = *(const int4*)(hist + 16 * lane + 4 * i); c[4 * i] = v.x; c[4 * i + 1] = v.y; c[4 * i + 2] = v.z; c[4 * i + 3] = v.w; }
    int tot = 0;
#pragma unroll
    for (int i = 0; i < 16; ++i) tot += c[i];
    int suf = tot;
#pragma unroll
    for (int o = 1; o < 64; o <<= 1) { const int t = __shfl_down(suf, o); if (lane + o < 64) suf += t; }
    int above = suf - tot;
#pragma unroll
    for (int i = 15; i >= 0; --i) {
        if (above < K && K <= above + c[i]) { m[0] = 16 * lane + i; m[1] = above; m[2] = c[i]; }
        above += c[i];
    }
}

__device__ __forceinline__ void attn4_unit(const P& p, unsigned char* lds, int b, int grp) {
    const int tid = tid_(), lane = tid & 63, wid = __builtin_amdgcn_readfirstlane(tid >> 6);
    const int t0 = NMETA + 4 * grp;
    const int brow = b * LP, row0 = brow + t0;
    float* sc = (float*)(lds + A_SC);
    int* h1 = (int*)(lds + A_H1);
    unsigned short* sel = (unsigned short*)(lds + A_SEL); unsigned short* cand = (unsigned short*)(lds + A_CAND);
    int* meta = (int*)(lds + A_META);
    const bool big = t0 + 1 > 256;
    for (int i = tid; i < 4 * NBIN; i += NTHREADS) h1[i] = 0;
    if (tid < 64) { const int w = tid & 15; meta[tid] = (w == 0) ? -1 : 0; }
    if (!big) { for (int i = tid; i < 1024; i += NTHREADS) { const int q = i >> 8, j = i & 255; sel[i] = (unsigned short)(j <= t0 + q ? j : 0); } }
    __syncthreads();
    if (big) {
        {
            const int hh = lane >> 5, c32 = lane & 31;
            const int g = c32 >> 3, h2a = (c32 >> 2) & 1, bq = c32 & 3, aq = 2 * h2a + (g >> 1), ah = 4 * (g & 1) + bq;
            const bf16_t* ap = p.iq() + (size_t)(row0 + aq) * 256 + ah * 32 + 8 * hh;
            const bf16x8 a0 = *(const bf16x8*)ap, a1 = *(const bf16x8*)(ap + 16);
            const f32x4 w00 = *(const f32x4*)(p.iw() + (size_t)(row0 + 2 * hh) * 8), w01 = *(const f32x4*)(p.iw() + (size_t)(row0 + 2 * hh) * 8 + 4);
            const f32x4 w10 = *(const f32x4*)(p.iw() + (size_t)(row0 + 2 * hh + 1) * 8), w11 = *(const f32x4*)(p.iw() + (size_t)(row0 + 2 * hh + 1) * 8 + 4);
            const int ntiles = (t0 + 4 + 31) >> 5;
            const int tq0 = t0 + 2 * hh;
            float mx0 = -INFINITY, mn0 = INFINITY, mx1 = -INFINITY, mn1 = INFINITY;
            const bf16_t* kbase = p.ik() + (size_t)brow * 32 + 8 * hh;
            for (int tile0 = wid; tile0 < ntiles; tile0 += 64) {
                bf16x8 b0[8], b1[8];
#pragma unroll
                for (int j = 0; j < 8; ++j) {
                    const int tile = min(tile0 + 8 * j, ntiles - 1);
                    const bf16_t* kp = kbase + (size_t)(tile * 32 + c32) * 32;
                    b0[j] = *(const bf16x8*)kp; b1[j] = *(const bf16x8*)(kp + 16);
                }
#pragma unroll
                for (int j = 0; j < 8; ++j) {
                    const int tile = tile0 + 8 * j;
                    if (tile < ntiles) {
                        const int key = tile * 32 + c32;
                        f32x16 acc;
#pragma unroll
                        for (int i = 0; i < 16; ++i) acc[i] = 0.f;
                        acc = __builtin_amdgcn_mfma_f32_32x32x16_bf16(a0, b0[j], acc, 0, 0, 0);
                        acc = __builtin_amdgcn_mfma_f32_32x32x16_bf16(a1, b1[j], acc, 0, 0, 0);
                        float s0 = 0.f, s1 = 0.f;
#pragma unroll
                        for (int i = 0; i < 4; ++i) {
                            s0 += w00[i] * fmaxf(acc[i], 0.f) + w01[i] * fmaxf(acc[4 + i], 0.f);
                            s1 += w10[i] * fmaxf(acc[8 + i], 0.f) + w11[i] * fmaxf(acc[12 + i], 0.f);
                        }
                        sc[(2 * hh) * NKMAX + key] = s0; sc[(2 * hh + 1) * NKMAX + key] = s1;
                        if (key <= tq0) { mx0 = fmaxf(mx0, s0); mn0 = fminf(mn0, s0); }
                        if (key <= tq0 + 1) { mx1 = fmaxf(mx1, s1); mn1 = fminf(mn1, s1); }
                    }
                }
            }
#pragma unroll
            for (int o = 16; o >= 1; o >>= 1) {
                mx0 = fmaxf(mx0, __shfl_xor(mx0, o)); mn0 = fminf(mn0, __shfl_xor(mn0, o));
                mx1 = fmaxf(mx1, __shfl_xor(mx1, o)); mn1 = fminf(mn1, __shfl_xor(mn1, o));
            }
            if (c32 == 0) {
                if (mx0 >= mn0) { atomicMin((unsigned*)&meta[(2 * hh) * 16 + 0], skey(mn0)); atomicMax((unsigned*)&meta[(2 * hh) * 16 + 1], skey(mx0)); }
                if (mx1 >= mn1) { atomicMin((unsigned*)&meta[(2 * hh + 1) * 16 + 0], skey(mn1)); atomicMax((unsigned*)&meta[(2 * hh + 1) * 16 + 1], skey(mx1)); }
            }
        }
        __syncthreads();
        const int q = wid & 3, part = wid >> 2, n = t0 + q + 1;
        const float lo = skey_inv((unsigned)meta[q * 16 + 0]), hi = skey_inv((unsigned)meta[q * 16 + 1]);
        const float scale = hi > lo ? (float)NBIN / (hi - lo) : 0.f;
        const float* scq = sc + q * NKMAX;
        for (int base = part * 256; base < n; base += 512) {
            const int idx0 = base + lane * 4;
            if (idx0 < n) {
                const f32x4 v = *(const f32x4*)(scq + idx0);
#pragma unroll
                for (int j = 0; j < 4; ++j) if (idx0 + j < n) atomicAdd(&h1[q * NBIN + bin1(v[j], lo, scale)], 1);
            }
        }
        __syncthreads();
        if (wid < 4) scan_top(h1 + wid * NBIN, 256, meta + wid * 16 + 4, lane);
        __syncthreads();
        const int B1 = meta[q * 16 + 4];
        for (int base = part * 256; base < n; base += 512) {
            const int idx0 = base + lane * 4;
            f32x4 v = (f32x4){0.f, 0.f, 0.f, 0.f};
            if (idx0 < n) v = *(const f32x4*)(scq + idx0);
            const unsigned long long lt = (1ull << lane) - 1ull;
#pragma unroll
            for (int j = 0; j < 4; ++j) {
                const int idx = idx0 + j;
                bool issel = false, iscand = false;
                if (idx < n) { const int b1 = bin1(v[j], lo, scale); issel = b1 > B1; iscand = b1 == B1; }
                const unsigned long long ms = __ballot(issel), mc = __ballot(iscand);
                if (ms) {
                    int bs = 0; if (lane == 0) bs = atomicAdd(&meta[q * 16 + 2], __popcll(ms));
                    bs = __shfl(bs, 0);
                    if (issel) sel[q * 256 + bs + __popcll(ms & lt)] = (unsigned short)idx;
                }
                if (mc) {
                    int bs = 0; if (lane == 0) bs = atomicAdd(&meta[q * 16 + 3], __popcll(mc));
                    bs = __shfl(bs, 0);
                    const int pos = bs + __popcll(mc & lt);
                    if (iscand && pos < 128) cand[q * 128 + pos] = (unsigned short)idx;
                }
            }
        }
        __syncthreads();
        if (wid < 4) {
            const int qq = wid; const float* scr = sc + qq * NKMAX;
            const int rq = 256 - meta[qq * 16 + 5], cq = meta[qq * 16 + 6], sbase = 256 - rq, nn = t0 + qq + 1;
            if (cq <= 128) {
                int taken = 0;
#pragma unroll
                for (int half = 0; half < 2; ++half) {
                    const int i = lane + 64 * half;
                    bool take = false; int myidx = 0;
                    if (i < cq) {
                        myidx = cand[qq * 128 + i]; const float mv = scr[myidx];
                        int rank = 0;
                        for (int j = 0; j < cq; ++j) { const int oj = cand[qq * 128 + j]; const float ov = scr[oj]; rank += (ov > mv) || (ov == mv && oj < myidx); }
                        take = rank < rq;
                    }
                    const unsigned long long mt = __ballot(take);
                    if (take) sel[qq * 256 + sbase + taken + __popcll(mt & ((1ull << lane) - 1ull))] = (unsigned short)myidx;
                    taken += __popcll(mt);
                }
            } else {
                const float lo_ = skey_inv((unsigned)meta[qq * 16 + 0]), hi_ = skey_inv((unsigned)meta[qq * 16 + 1]);
                const float sc_ = hi_ > lo_ ? (float)NBIN / (hi_ - lo_) : 0.f;
                const int B1_ = meta[qq * 16 + 4];
                int taken = 0;
                for (int base = 0; base < nn && taken < rq; base += 64) {
                    const int idx = base + lane; bool isc = false;
                    if (idx < nn) isc = bin1(scr[idx], lo_, sc_) == B1_;
                    const unsigned long long mc = __ballot(isc);
                    const int pos = taken + __popcll(mc & ((1ull << lane) - 1ull));
                    if (isc && pos < rq) sel[qq * 256 + sbase + pos] = (unsigned short)idx;
                    taken += __popcll(mc);
                }
            }
        }
        __syncthreads();
    }
    {
        const int q = wid >> 1, kvh = wid & 1, tq = t0 + q, nsel = min(tq + 1, 256);
        const int col = lane & 15, g4 = lane >> 4;
        const unsigned short* selq = sel + q * 256;
        bf16x8 qf0, qf1;
        {
            const bf16_t* qp = p.q() + (size_t)(row0 + q) * 512 + (kvh * 4 + (col & 3)) * 64 + g4 * 8;
            qf0 = *(const bf16x8*)qp; qf1 = *(const bf16x8*)(qp + 32);
            if (col >= 4) {
#pragma unroll
                for (int i = 0; i < 8; ++i) { qf0[i] = 0; qf1[i] = 0; }
            }
        }
        LAS unsigned char* vst = (LAS unsigned char*)lds + A_SC + wid * 16384;
        const bf16_t* vb = p.v() + (size_t)brow * 128 + kvh * 64 + (lane & 7) * 8;
        const unsigned rdbase = (unsigned)(uintptr_t)((LAS unsigned char*)lds + A_SC) + wid * 16384 + (4 * g4 + (col >> 2)) * 128 + (col & 3) * 8;
#define V_STAGE(s_, buf_) do { _Pragma("unroll") for (int i_ = 0; i_ < 4; ++i_) { \
            const int ksl_ = (s_) * 32 + i_ * 8 + (lane >> 3); const int key_ = selq[ksl_]; \
            __builtin_amdgcn_global_load_lds((const unsigned*)(vb + (size_t)key_ * 128), (LAS unsigned*)(vst + (buf_) * 4096 + i_ * 1024), 16, 0, 0); } } while (0)
        const bf16_t* kb = p.k() + (size_t)brow * 128 + kvh * 64 + g4 * 8;
        f32x4 lg[16];
#pragma unroll
        for (int hb = 0; hb < 2; ++hb) {
            bf16x8 k0[8], k1[8];
#pragma unroll
            for (int t = 0; t < 8; ++t) {
                const int key = selq[(hb * 8 + t) * 16 + col];
                const bf16_t* kp = kb + (size_t)key * 128;
                k0[t] = *(const bf16x8*)kp; k1[t] = *(const bf16x8*)(kp + 32);
            }
            __builtin_amdgcn_sched_barrier(0);
#pragma unroll
            for (int t = 0; t < 8; ++t) {
                f32x4 a = (f32x4){0.f, 0.f, 0.f, 0.f};
                a = __builtin_amdgcn_mfma_f32_16x16x32_bf16(k0[t], qf0, a, 0, 0, 0);
                a = __builtin_amdgcn_mfma_f32_16x16x32_bf16(k1[t], qf1, a, 0, 0, 0);
                lg[hb * 8 + t] = a;
            }
            __builtin_amdgcn_sched_barrier(0);
        }
        V_STAGE(0, 0); V_STAGE(1, 1); V_STAGE(2, 2); V_STAGE(3, 3);
        float mx = -INFINITY;
#pragma unroll
        for (int t = 0; t < 16; ++t)
#pragma unroll
            for (int j = 0; j < 4; ++j) { if (t * 16 + g4 * 4 + j >= nsel) lg[t][j] = -INFINITY; mx = fmaxf(mx, lg[t][j]); }
        mx = fmaxf(mx, __shfl_xor(mx, 16)); mx = fmaxf(mx, __shfl_xor(mx, 32));
        float sm = 0.f;
#pragma unroll
        for (int t = 0; t < 16; ++t)
#pragma unroll
            for (int j = 0; j < 4; ++j) { const float e = __builtin_amdgcn_exp2f(lg[t][j] - mx); lg[t][j] = e; sm += e; }
        sm += __shfl_xor(sm, 16); sm += __shfl_xor(sm, 32);
        const float inv = 1.0f / sm;
        f32x4 o[4];
#pragma unroll
        for (int d = 0; d < 4; ++d) o[d] = (f32x4){0.f, 0.f, 0.f, 0.f};
#pragma unroll
        for (int s = 0; s < 8; ++s) {
            if (s <= 4) asm volatile("s_waitcnt vmcnt(12)" ::: "memory");
            else if (s == 5) asm volatile("s_waitcnt vmcnt(8)" ::: "memory");
            else if (s == 6) asm volatile("s_waitcnt vmcnt(4)" ::: "memory");
            else asm volatile("s_waitcnt vmcnt(0)" ::: "memory");
            const unsigned rb = rdbase + (s & 3) * 4096;
            const s16x4 l0 = tr_read<0>(rb), h0 = tr_read<2048>(rb), l1 = tr_read<32>(rb), h1_ = tr_read<2048 + 32>(rb);
            const s16x4 l2 = tr_read<64>(rb), h2_ = tr_read<2048 + 64>(rb), l3 = tr_read<96>(rb), h3 = tr_read<2048 + 96>(rb);
            asm volatile("s_waitcnt lgkmcnt(0)" ::: "memory");
            __builtin_amdgcn_sched_barrier(0);
            if (s + 4 < 8) V_STAGE(s + 4, s & 3);
            bf16x8 pa;
            {
                const uint32_t w0 = pack2(lg[2 * s][0], lg[2 * s][1]), w1 = pack2(lg[2 * s][2], lg[2 * s][3]);
                const uint32_t w2 = pack2(lg[2 * s + 1][0], lg[2 * s + 1][1]), w3 = pack2(lg[2 * s + 1][2], lg[2 * s + 1][3]);
                pa[0] = (short)(w0 & 0xffff); pa[1] = (short)(w0 >> 16); pa[2] = (short)(w1 & 0xffff); pa[3] = (short)(w1 >> 16);
                pa[4] = (short)(w2 & 0xffff); pa[5] = (short)(w2 >> 16); pa[6] = (short)(w3 & 0xffff); pa[7] = (short)(w3 >> 16);
            }
#define PKV(L, H) (bf16x8){L[0], L[1], L[2], L[3], H[0], H[1], H[2], H[3]}
            o[0] = __builtin_amdgcn_mfma_f32_16x16x32_bf16(pa, PKV(l0, h0), o[0], 0, 0, 0);
            o[1] = __builtin_amdgcn_mfma_f32_16x16x32_bf16(pa, PKV(l1, h1_), o[1], 0, 0, 0);
            o[2] = __builtin_amdgcn_mfma_f32_16x16x32_bf16(pa, PKV(l2, h2_), o[2], 0, 0, 0);
            o[3] = __builtin_amdgcn_mfma_f32_16x16x32_bf16(pa, PKV(l3, h3), o[3], 0, 0, 0);
#undef PKV
        }
#undef V_STAGE
        const float i0 = __shfl(inv, 0), i1 = __shfl(inv, 1), i2 = __shfl(inv, 2), i3 = __shfl(inv, 3);
        if (g4 == 0) {
            bf16_t* op = p.att() + (size_t)(row0 + q) * 512 + kvh * 256 + col;
#pragma unroll
            for (int d = 0; d < 4; ++d) {
                op[0 * 64 + d * 16] = f2bf(o[d][0] * i0); op[1 * 64 + d * 16] = f2bf(o[d][1] * i1);
                op[2 * 64 + d * 16] = f2bf(o[d][2] * i2); op[3 * 64 + d * 16] = f2bf(o[d][3] * i3);
            }
        }
    }
    __syncthreads();
}

constexpr int NGRP = SEQ / 4, ATT_P1 = NGRP / 8, ATT_P2 = NGRP / 2;
template <int SUB>
__device__ void ph_mixer(const P& p, unsigned char* lds) {
    int* bc = (int*)(lds + LDS_BYTES - 16);
    constexpr int nh = SUB == 1 ? 16 : NXU;
    constexpr int a0 = SUB == 0 ? 0 : (SUB == 1 ? ATT_P1 : ATT_P2), a1 = SUB == 0 ? ATT_P1 : (SUB == 1 ? ATT_P2 : NGRP);
    for (;;) {
        __syncthreads();
        if (tid_() == 0) bc[0] = atomicAdd(&p.ctr()[97 + SUB], 1);
        __syncthreads();
        const int it = bc[0];
        if (it >= nh) break;
        if (SUB == 0) hgx_unit(p, lds, it);
        else if (SUB == 1) hgchain_unit(p, it);
        else hgz_unit(p, lds, it);
    }
    const int b0 = (int)(xb_xcc_id() & 3u);
#pragma unroll 1
    for (int k = 0; k < 4; ++k) {
        const int b = (b0 + k) & 3;
        for (;;) {
            __syncthreads();
            if (tid_() == 0) bc[0] = atomicAdd(&p.ctr()[104 + SUB * 4 + b], 1);
            __syncthreads();
            const int it = bc[0];
            if (it >= a1 - a0) break;
            attn4_unit(p, lds, b, NGRP - 1 - (a0 + it));
        }
    }
}

__device__ __forceinline__ int tok_row(int tok) { return (tok >> 13) * LP + NMETA + (tok & 8191); }
__device__ void ph_mix(const P& p, unsigned char* lds) {
    const int njobs = (NTOK / 256) * 4 * 2, G = gridDim.x;
    auto mk = [&](GemmJob& j, int jb) { const int which = jb & 1, u = jb >> 1, nt = u & 3, mt = u >> 2; const size_t r0 = (size_t)tok_row(mt * 256);
        gemm_setup(j, which ? p.hgr() : p.att(), RowLin{r0 * 512, 512}, which ? p.wuhT() : p.wuaT(), RowLin{(size_t)nt * 256 * 512, 512}); };
    int jb = blockIdx.x * 2;
    if (jb >= njobs) return;
    GemmJob cur, nxt;
    mk(cur, jb); gemm_prefetch(lds, cur);
    for (; jb < njobs; jb = (jb & 1) ? jb + 2 * G - 1 : jb + 1) {
        const int jn = (jb & 1) ? jb + 2 * G - 1 : jb + 1;
        const bool hn = jn < njobs;
        if (hn) mk(nxt, jn);
        f32x4 acc[8][4];
        gemm_run(lds, cur, 512, acc, hn, nxt);
        const int which = jb & 1, u = jb >> 1, nt = u & 3, mt = u >> 2; const size_t r0 = (size_t)tok_row(mt * 256);
        if (which == 0) {
            EPI_LOOP(
                const size_t og = (r0 + row) * 1024 + nt * 256 + col, om = (size_t)(mt * 256 + row) * 1024 + nt * 256 + col;
                const uint2 g = *(const uint2*)(p.ga() + og);
                f32x4 r; const f32x4 v = acc[m][n];
                r[0] = v[0] * __uint_as_float(g.x << 16); r[1] = v[1] * __uint_as_float(g.x & 0xffff0000u);
                r[2] = v[2] * __uint_as_float(g.y << 16); r[3] = v[3] * __uint_as_float(g.y & 0xffff0000u);
                st_bf4(p.mix() + om, r);
            );
        } else {
            EPI_LOOP(
                const size_t og = (r0 + row) * 1024 + nt * 256 + col, om = (size_t)(mt * 256 + row) * 1024 + nt * 256 + col;
                const uint2 g = *(const uint2*)(p.gh() + og);
                const uint2 a = *(const uint2*)(p.mix() + om);
                f32x4 r; const f32x4 v = acc[m][n];
                r[0] = __uint_as_float(a.x << 16) + v[0] * __uint_as_float(g.x << 16); r[1] = __uint_as_float(a.x & 0xffff0000u) + v[1] * __uint_as_float(g.x & 0xffff0000u);
                r[2] = __uint_as_float(a.y << 16) + v[2] * __uint_as_float(g.y << 16); r[3] = __uint_as_float(a.y & 0xffff0000u) + v[3] * __uint_as_float(g.y & 0xffff0000u);
                st_bf4(p.mix() + om, r);
            );
        }
        cur = nxt;
    }
}

__device__ void ph_out(const P& p, unsigned char* lds) {
    const int nunits = (NTOK / 256) * 4, G = gridDim.x;
    auto mk = [&](GemmJob& j, int u) { const int nt = u & 3, mt = u >> 2; gemm_setup(j, p.mix(), RowLin{(size_t)mt * 256 * D, D}, p.woT(), RowLin{(size_t)nt * 256 * D, D}); };
    int u = blockIdx.x;
    if (u >= nunits) return;
    GemmJob cur, nxt;
    mk(cur, u); gemm_prefetch(lds, cur);
    for (; u < nunits; u += G) {
        const bool hn = u + G < nunits;
        if (hn) mk(nxt, u + G);
        f32x4 acc[8][4];
        gemm_run(lds, cur, D, acc, hn, nxt);
        const int nt = u & 3, mt = u >> 2;
        EPI_LOOP(
            const size_t o = (size_t)(mt * 256 + row) * D + nt * 256 + col;
            const f32x4 h0 = *(const f32x4*)(p.x + o);
            *(f32x4*)(p.out + o) = h0 + acc[m][n];
        );
        cur = nxt;
    }
}

constexpr int XS_LD = 1025;
__device__ void ph_route(const P& p, unsigned char* lds) {
    const int tid = tid_(), lane = tid & 63, wid = __builtin_amdgcn_readfirstlane(tid >> 6);
    const int gt = blockIdx.x * NTHREADS + tid, ntot = gridDim.x * NTHREADS;
    for (int i = gt; i < CAP; i += ntot) p.slot_token()[i] = -1;
    float* xs = (float*)lds;
    int* lhist = (int*)(lds + 32 * XS_LD * 4);
    for (int tb = blockIdx.x; tb < NTOK / 128; tb += gridDim.x) {
        if (tid < 32) lhist[tid] = 0;
        for (int tile = 0; tile < 4; ++tile) {
            const int tokt = tb * 128 + tile * 32;
            __syncthreads();
#pragma unroll
            for (int t = 0; t < 4; ++t) {
                const int tl = wid * 4 + t, tok = tokt + tl;
                const float* src = p.out + (size_t)tok * D;
                f32x4 v[4]; float ss = 0.f;
#pragma unroll
                for (int i = 0; i < 4; ++i) { v[i] = *(const f32x4*)(src + lane * 4 + 256 * i); ss += v[i][0] * v[i][0] + v[i][1] * v[i][1] + v[i][2] * v[i][2] + v[i][3] * v[i][3]; }
                ss = wave_sum(ss);
                const float rs = rsqrtf(ss * (1.0f / D) + EPS);
#pragma unroll
                for (int i = 0; i < 4; ++i) {
                    const f32x4 g = *(const f32x4*)(p.ffn_g + lane * 4 + 256 * i);
                    f32x4 xn; xn[0] = v[i][0] * rs * g[0]; xn[1] = v[i][1] * rs * g[1]; xn[2] = v[i][2] * rs * g[2]; xn[3] = v[i][3] * rs * g[3];
                    st_bf4(p.xn2() + (size_t)tok * D + lane * 4 + 256 * i, xn);
#pragma unroll
                    for (int c = 0; c < 4; ++c) xs[tl * XS_LD + lane * 4 + 256 * i + c] = xn[c];
                }
            }
            __syncthreads();
            f32x16 acc;
#pragma unroll
            for (int i = 0; i < 16; ++i) acc[i] = 0.f;
            {
                const float* xr = xs + (lane & 31) * XS_LD + wid * 128 + (lane >> 5);
                const float* wp = p.router_w + (size_t)(wid * 128 + (lane >> 5)) * 32 + (lane & 31);
#pragma unroll 16
                for (int i = 0; i < 64; ++i) acc = __builtin_amdgcn_mfma_f32_32x32x2f32(xr[2 * i], wp[(size_t)(2 * i) * 32], acc, 0, 0, 0);
            }
            __syncthreads();
#pragma unroll
            for (int r = 0; r < 16; ++r) xs[wid * 1024 + ((r & 3) + 8 * (r >> 2) + 4 * (lane >> 5)) * 32 + (lane & 31)] = acc[r];
            __syncthreads();
            const int e = lane & 31, hh = lane >> 5;
            const float be = p.router_b[e];
#pragma unroll
            for (int it = 0; it < 2; ++it) {
                const int tl = wid * 4 + it * 2 + hh;
                float l = be;
#pragma unroll
                for (int w = 0; w < 8; ++w) l += xs[w * 1024 + tl * 32 + e];
                float bv[4]; int bi[4];
#pragma unroll
                for (int k = 0; k < 4; ++k) {
                    float m = l;
#pragma unroll
                    for (int o = 16; o >= 1; o >>= 1) m = fmaxf(m, __shfl_xor(m, o));
                    const unsigned long long bal = __ballot(l == m);
                    const unsigned half = hh ? (unsigned)(bal >> 32) : (unsigned)bal;
                    const int idx = __builtin_ctz(half);
                    bv[k] = m; bi[k] = idx;
                    if (e == idx) l = -INFINITY;
                }
                const float e1 = __expf(bv[1] - bv[0]), e2 = __expf(bv[2] - bv[0]), e3 = __expf(bv[3] - bv[0]);
                const float inv = 1.0f / (1.0f + e1 + e2 + e3);
                if (e == 0) {
                    const int tok = tokt + tl;
                    p.tok_exp()[tok * 4 + 0] = bi[0]; p.tok_exp()[tok * 4 + 1] = bi[1]; p.tok_exp()[tok * 4 + 2] = bi[2]; p.tok_exp()[tok * 4 + 3] = bi[3];
                    p.tok_gate()[tok * 4 + 0] = inv; p.tok_gate()[tok * 4 + 1] = e1 * inv; p.tok_gate()[tok * 4 + 2] = e2 * inv; p.tok_gate()[tok * 4 + 3] = e3 * inv;
                    atomicAdd(&lhist[bi[0]], 1); atomicAdd(&lhist[bi[1]], 1); atomicAdd(&lhist[bi[2]], 1); atomicAdd(&lhist[bi[3]], 1);
                }
            }
        }
        __syncthreads();
        if (tid < 32) p.wg_cnt()[tb * 32 + tid] = lhist[tid];
        __syncthreads();
    }
    for (long task = gt; task < 96L * 16384; task += ntot) {
        const int mat = (int)(task >> 14), r = (int)(task & 16383), kq = r >> 10, n = r & 1023;
        const int which = mat >> 5, e = mat & 31;
        const float* W = (which == 0 ? p.w_gate : which == 1 ? p.w_up : p.w_down) + (size_t)e * 1048576 + (size_t)(kq * 64) * 1024 + n;
        bf16_t* outp = (which == 0 ? p.wgT() : which == 1 ? p.wuT() : p.wdT()) + (size_t)e * 1048576 + (size_t)n * 1024 + kq * 64;
        float v[64];
#pragma unroll
        for (int i = 0; i < 64; ++i) v[i] = W[(size_t)i * 1024];
        uint4* dst = (uint4*)outp;
#pragma unroll
        for (int i = 0; i < 8; ++i) dst[i] = make_uint4(pack2(v[8 * i], v[8 * i + 1]), pack2(v[8 * i + 2], v[8 * i + 3]), pack2(v[8 * i + 4], v[8 * i + 5]), pack2(v[8 * i + 6], v[8 * i + 7]));
    }
}

__device__ void ph_fill(const P& p, unsigned char* lds) {
    const int tid = tid_();
    int* tot = (int*)lds;
    int* pre = tot + 512;
    int* ps = pre + 512;
    int* lc = ps + 32;
    for (int tb = blockIdx.x; tb < NTOK / 128; tb += gridDim.x) {
        {
            const int e = tid & 31, part = tid >> 5;
            int t = 0, q = 0;
            for (int b2 = part; b2 < NTOK / 128; b2 += 16) { const int c = p.wg_cnt()[b2 * 32 + e]; t += c; if (b2 < tb) q += c; }
            tot[part * 32 + e] = t; pre[part * 32 + e] = q;
        }
        __syncthreads();
        if (tid == 0) {
            int acc = 0;
            for (int e = 0; e < NE; ++e) {
                int t = 0, q = 0;
                for (int i = 0; i < 16; ++i) { t += tot[i * 32 + e]; q += pre[i * 32 + e]; }
                ps[e] = acc + q; lc[e] = 0;
                const int nb = (t + 255) >> 8;
                if (tb == 0) for (int i = 0; i < nb; ++i) p.block_expert()[(acc >> 8) + i] = e;
                acc += nb * 256;
            }
            if (tb == 0) p.ctr()[96] = acc >> 8;
        }
        __syncthreads();
        {
            const int i = tb * 512 + tid;
            const int e = p.tok_exp()[i];
            const int dest = ps[e] + atomicAdd(&lc[e], 1);
            p.slot_token()[dest] = i >> 2;
            p.slot_rank()[dest] = i & 3;
            p.slot_gate()[dest] = p.tok_gate()[i];
        }
        __syncthreads();
    }
}

struct GUOff { int ct; __device__ __forceinline__ size_t operator()(int R) const {
    const int wcB = R >> 6, nB = (R >> 4) & 3, c = ct * 128 + wcB * 32 + (nB & 1) * 16 + (R & 15);
    return (size_t)(nB >> 1) * (WE_B / 2) + (size_t)c * 1024; } };
struct GatherOff { const int* st; __device__ __forceinline__ size_t operator()(int R) const { const int t = st[R]; return (size_t)(t < 0 ? 0 : t) * 1024; } };
__device__ void ph_moe1(const P& p, unsigned char* lds) {
    const int nunits = p.ctr()[96] * 8, G = gridDim.x;
    auto mk = [&](GemmJob& j, int u) { const int ct = u & 7, rb = u >> 3, e = p.block_expert()[rb];
        gemm_setup(j, p.xn2(), GatherOff{p.slot_token() + rb * 256}, p.wgT() + (size_t)e * 1048576, GUOff{ct}); };
    int u = blockIdx.x;
    if (u >= nunits) return;
    GemmJob cur, nxt;
    mk(cur, u); gemm_prefetch(lds, cur);
    for (; u < nunits; u += G) {
        const bool hn = u + G < nunits;
        if (hn) mk(nxt, u + G);
        f32x4 acc[8][4];
        gemm_run(lds, cur, D, acc, hn, nxt);
        const int ct = u & 7, rb = u >> 3, e = p.block_expert()[rb];
        {
            const int tid_e = tid_(), lane_e = tid_e & 63, wid_e = tid_e >> 6, wr = wid_e >> 2, wc = wid_e & 3, fr = lane_e & 15, fq = lane_e >> 4;
#pragma unroll
            for (int hh = 0; hh < 2; ++hh) {
                const int c = ct * 128 + wc * 32 + hh * 16 + fq * 4;
                const f32x4 bg = *(const f32x4*)(p.b_gate + (size_t)e * DFF + c), bu = *(const f32x4*)(p.b_up + (size_t)e * DFF + c);
#pragma unroll
                for (int m = 0; m < 8; ++m) {
                    const int row = rb * 256 + wr * 128 + m * 16 + fr;
                    f32x4 a;
#pragma unroll
                    for (int j = 0; j < 4; ++j) {
                        const float g = fminf(acc[m][hh][j] + bg[j], 7.0f);
                        const float uu = fminf(fmaxf(acc[m][2 + hh][j] + bu[j], -7.0f), 7.0f);
                        a[j] = (uu + 1.0f) * (g * sigmoidf_(1.702f * g));
                    }
                    st_bf4(p.act() + (size_t)row * DFF + c, a);
                }
            }
        }
        cur = nxt;
    }
}
__device__ void ph_moe2(const P& p, unsigned char* lds) {
    const int nunits = p.ctr()[96] * 4, G = gridDim.x;
    auto mk = [&](GemmJob& j, int u) { const int nt = u & 3, rb = u >> 2, e = p.block_expert()[rb];
        gemm_setup(j, p.act(), RowLin{(size_t)rb * 256 * DFF, DFF}, p.wdT() + (size_t)e * 1048576, RowLin{(size_t)nt * 256 * DFF, DFF}); };
    int u = blockIdx.x;
    if (u >= nunits) return;
    GemmJob cur, nxt;
    mk(cur, u); gemm_prefetch(lds, cur);
    for (; u < nunits; u += G) {
        const bool hn = u + G < nunits;
        if (hn) mk(nxt, u + G);
        f32x4 acc[8][4];
        gemm_run(lds, cur, DFF, acc, hn, nxt);
        const int nt = u & 3, rb = u >> 2, e = p.block_expert()[rb];
        {
            const int tid_e = tid_(), lane_e = tid_e & 63, wid_e = tid_e >> 6, wr = wid_e >> 2, wc = wid_e & 3, fr = lane_e & 15, fq = lane_e >> 4;
            f32x4 bd[4];
#pragma unroll
            for (int n = 0; n < 4; ++n) bd[n] = *(const f32x4*)(p.b_down + (size_t)e * D + nt * 256 + wc * 64 + n * 16 + fq * 4);
#pragma unroll
            for (int m = 0; m < 8; ++m) {
                const int slot = rb * 256 + wr * 128 + m * 16 + fr;
                const int tok = p.slot_token()[slot];
                if (tok < 0) continue;
                const int rank = p.slot_rank()[slot]; const float gate = p.slot_gate()[slot];
                const size_t o = (size_t)tok * D + nt * 256 + wc * 64 + fq * 4;
                if (rank == 0) {
#pragma unroll
                    for (int n = 0; n < 4; ++n) { float* d = p.out + o + n * 16; *(f32x4*)d = *(const f32x4*)d + (acc[m][n] + bd[n]) * gate; }
                } else {
                    bf16_t* yb = rank == 1 ? p.y1() : (rank == 2 ? p.y2() : p.y3());
#pragma unroll
                    for (int n = 0; n < 4; ++n) st_bf4(yb + o + n * 16, (acc[m][n] + bd[n]) * gate);
                }
            }
        }
        cur = nxt;
    }
}

__device__ void ph_final(const P& p, unsigned char* lds) {
    const int tid = tid_(), lane = tid & 63, wid = tid >> 6;
    const int gw = blockIdx.x * 8 + wid, nw = gridDim.x * 8;
    for (int tok = gw; tok < NTOK; tok += nw) {
        float* dst = p.out + (size_t)tok * D;
        f32x4 v[4];
#pragma unroll
        for (int i = 0; i < 4; ++i) v[i] = *(const f32x4*)(dst + lane * 4 + 256 * i);
#pragma unroll
        for (int j = 0; j < 3; ++j) {
            const bf16_t* yr = (j == 0 ? p.y1() : j == 1 ? p.y2() : p.y3()) + (size_t)tok * D;
#pragma unroll
            for (int i = 0; i < 4; ++i) {
                const uint2 w = *(const uint2*)(yr + lane * 4 + 256 * i);
                v[i][0] += __uint_as_float(w.x << 16); v[i][1] += __uint_as_float(w.x & 0xffff0000u);
                v[i][2] += __uint_as_float(w.y << 16); v[i][3] += __uint_as_float(w.y & 0xffff0000u);
            }
        }
        float ss = 0.f;
#pragma unroll
        for (int i = 0; i < 4; ++i) ss += v[i][0] * v[i][0] + v[i][1] * v[i][1] + v[i][2] * v[i][2] + v[i][3] * v[i][3];
        ss = wave_sum(ss);
        const float rs = rsqrtf(ss * (1.0f / D) + EPS);
#pragma unroll
        for (int i = 0; i < 4; ++i) {
            const f32x4 g = *(const f32x4*)(p.final_g + lane * 4 + 256 * i);
            *(f32x4*)(dst + lane * 4 + 256 * i) = v[i] * rs * g;
        }
    }
}

__global__ void __launch_bounds__(NTHREADS) k_mega(P p) {
    __shared__ __attribute__((aligned(16))) unsigned char lds[LDS_BYTES];
    cg::grid_group grid = cg::this_grid();
    if (tid_() < 4) ((unsigned*)(lds + LDS_BYTES - 32))[tid_()] = 0u;
    __syncthreads();
    const XcdBarrier xb = xcd_barrier_post((unsigned*)(p.ws + OFF_BAR), (volatile LAS unsigned*)(lds + LDS_BYTES - 32));
    ph_prep(p, lds); grid.sync();
    ph_inproj(p, lds); xcd_barrier(xb);
    ph_mixer<0>(p, lds); xcd_barrier(xb);
    ph_mixer<1>(p, lds); xcd_barrier(xb);
    ph_mixer<2>(p, lds); xcd_barrier(xb);
    ph_mix(p, lds); xcd_barrier(xb);
    ph_out(p, lds); xcd_barrier(xb);
    ph_route(p, lds); xcd_barrier(xb);
    ph_fill(p, lds); xcd_barrier(xb);
    ph_moe1(p, lds); xcd_barrier(xb);
    ph_moe2(p, lds); xcd_barrier(xb);
    ph_final(p, lds);
}

extern "C" void kernel_launch(void* const* d_in, const int* in_sizes, int n_in, void* d_out, int out_size, void* d_ws, size_t ws_size,
                              hipStream_t stream) {
    P p{};
    p.x = (const float*)d_in[0]; p.meta = (const float*)d_in[1]; p.attn_g = (const float*)d_in[2]; p.w_in = (const float*)d_in[3];
    p.hgrn_g = (const float*)d_in[4]; p.w_ua = (const float*)d_in[5]; p.w_uh = (const float*)d_in[6]; p.w_out = (const float*)d_in[7];
    p.lb_logits = (const float*)d_in[8]; p.ffn_g = (const float*)d_in[9]; p.router_w = (const float*)d_in[10]; p.router_b = (const float*)d_in[11];
    p.w_gate = (const float*)d_in[12]; p.b_gate = (const float*)d_in[13]; p.w_up = (const float*)d_in[14]; p.b_up = (const float*)d_in[15];
    p.w_down = (const float*)d_in[16]; p.b_down = (const float*)d_in[17]; p.final_g = (const float*)d_in[18];
    p.out = (float*)d_out;
    p.ws = (unsigned char*)d_ws;
    if (WS_NEED > ws_size) { fprintf(stderr, "workspace too small: need %zu have %zu\n", (size_t)WS_NEED, ws_size); return; }
    static int grid_blocks = 0;
    if (!grid_blocks) {
        int dev = 0, cus = 0, per_cu = 0;
        hipGetDevice(&dev);
        hipDeviceGetAttribute(&cus, hipDeviceAttributeMultiprocessorCount, dev);
        hipOccupancyMaxActiveBlocksPerMultiprocessor(&per_cu, k_mega, NTHREADS, 0);
        if (per_cu > 1) per_cu = 1;
        grid_blocks = cus * per_cu;
    }
    hipMemsetAsync(p.ws + OFF_BAR, 0, XCD_BAR_WORDS * 4, stream);
    void* args[] = {&p};
    hipError_t e = hipLaunchCooperativeKernel((void*)k_mega, dim3(grid_blocks), dim3(NTHREADS), args, 0, stream);
    if (e != hipSuccess) fprintf(stderr, "cooperative launch failed: %s (grid %d)\n", hipGetErrorString(e), grid_blocks);
}
```

```cpp
#include <hip/hip_runtime.h>
#include <hip/hip_cooperative_groups.h>
#include <stdint.h>
#include <cstdio>
namespace cg = cooperative_groups;

#ifndef MEGA
#define MEGA 1
#endif

typedef unsigned short bf16_t;
typedef short bf16x8 __attribute__((ext_vector_type(8)));
typedef float f32x4 __attribute__((ext_vector_type(4)));

constexpr int D = 1024, NB = 4, SEQ = 8192, NMETA = 16, L = SEQ + NMETA  , LP = 8320, T = NB * LP  ;
constexpr int NTOK = NB * SEQ;
constexpr int IN_COLS = 5160;
constexpr int NE = 32, TOPK = 4, DFF = 1024;
constexpr int CAP_BLOCKS = (NTOK * TOPK) / 256 + NE;
constexpr int CAP = CAP_BLOCKS * 256;
constexpr float EPS = 1e-5f;
constexpr int NTHREADS = 512;
constexpr int LDS_BYTES = 155648;
constexpr int NVC = 5376;
#define LAS __attribute__((address_space(3)))

__device__ __forceinline__ bf16_t f2bf(float f) {
    uint32_t u = __float_as_uint(f);
    u += 0x7fffu + ((u >> 16) & 1u);
    return (bf16_t)(u >> 16);
}
__device__ __forceinline__ float bf2f(bf16_t h) { return __uint_as_float(((uint32_t)h) << 16); }
__device__ __forceinline__ uint32_t pack2(float a, float b) { return (uint32_t)f2bf(a) | ((uint32_t)f2bf(b) << 16); }
__device__ __forceinline__ float sigmoidf_(float x) { return __builtin_amdgcn_rcpf(1.0f + __builtin_amdgcn_exp2f(-1.4426950408889634f * x)); }
__device__ __forceinline__ float wave_sum(float v) {
#pragma unroll
    for (int o = 32; o >= 1; o >>= 1) v += __shfl_xor(v, o);
    return v;
}
__device__ __forceinline__ float wave_max(float v) {
#pragma unroll
    for (int o = 32; o >= 1; o >>= 1) v = fmaxf(v, __shfl_xor(v, o));
    return v;
}

constexpr size_t al256(size_t x) { return (x + 255) & ~(size_t)255; }
constexpr size_t TT = (size_t)T;
constexpr size_t MB1 = 1024 * 1024;
constexpr size_t WE_B = (size_t)NE * 1024 * 1024 * 2;
constexpr size_t OFF_WGT = 0, OFF_WUT = WE_B, OFF_WDT = 2 * WE_B, OFF_XN2 = 3 * WE_B, OFF_ACT = OFF_XN2 + (size_t)NTOK * D * 2,
                 OFF_TAB = OFF_ACT + (size_t)CAP * DFF * 2;
constexpr size_t OFF_Y1 = OFF_XN2, OFF_Y2 = OFF_WGT, OFF_Y3 = OFF_WUT;
constexpr size_t OFF_ROPE = OFF_TAB, OFF_LB = OFF_ROPE + al256((size_t)LP * 24 * 4), OFF_CTR = OFF_LB + al256(512 * 4),
                 OFF_BEXP = OFF_CTR + al256(128 * 4), OFF_SLOT = OFF_BEXP + al256((size_t)CAP_BLOCKS * 4), OFF_SRANK = OFF_SLOT + al256((size_t)CAP * 4),
                 OFF_SGATE = OFF_SRANK + al256((size_t)CAP * 4), OFF_TEXP = OFF_SGATE + al256((size_t)CAP * 4), OFF_TGATE = OFF_TEXP + al256((size_t)NTOK * 16),
                 OFF_BAR = OFF_TGATE + al256((size_t)NTOK * 16), OFF_WGC = OFF_BAR + al256(3456 * 4), WS_NEED = OFF_WGC + al256(256 * 32 * 4);
constexpr size_t OFF_WIN = 0, OFF_WUA = OFF_WIN + (size_t)NVC * 1024 * 2, OFF_WUH = OFF_WUA + MB1, OFF_WO = OFF_WUH + MB1, OFF_XN = OFF_WO + 2 * MB1,
                 OFF_Q = OFF_XN + TT * 2048, OFF_K = OFF_Q + TT * 1024, OFF_V = OFF_K + TT * 256, OFF_IQ = OFF_V + TT * 256, OFF_IK = OFF_IQ + TT * 512,
                 OFF_IW = OFF_IK + TT * 64, OFF_HQ = OFF_IW + TT * 32, OFF_HF = OFF_HQ + TT * 1024, OFF_HI = OFF_HF + TT * 1024, OFF_HG = OFF_HI + TT * 1024,
                 OFF_GA = OFF_HG + TT * 1024, OFF_GH = OFF_GA + TT * 2048, OFF_ATT = OFF_GH + TT * 2048, OFF_HGR = OFF_ATT + TT * 1024,
                 OFF_S1_END = OFF_HGR + TT * 1024;
constexpr size_t OFF_MIX = OFF_XN;
static_assert(OFF_S1_END <= OFF_TAB, "stage-1 layout overflows");

__device__ __forceinline__ int tid_() { int t = threadIdx.x; asm volatile("" : "+v"(t)); return t; }

struct P {
    const float *x, *meta, *attn_g, *w_in, *hgrn_g, *w_ua, *w_uh, *w_out, *lb_logits, *ffn_g, *router_w, *router_b,
        *w_gate, *b_gate, *w_up, *b_up, *w_down, *b_down, *final_g;
    float* out;
    unsigned char* ws;
#define WSF(type, name, off) __device__ __forceinline__ type* name() const { return (type*)(ws + (off)); }
    WSF(bf16_t, xn, OFF_XN) WSF(bf16_t, q, OFF_Q) WSF(bf16_t, k, OFF_K) WSF(bf16_t, v, OFF_V) WSF(bf16_t, iq, OFF_IQ) WSF(bf16_t, ik, OFF_IK)
    WSF(bf16_t, hq, OFF_HQ) WSF(bf16_t, hf, OFF_HF) WSF(bf16_t, hi, OFF_HI) WSF(bf16_t, hg, OFF_HG) WSF(bf16_t, ga, OFF_GA) WSF(bf16_t, gh, OFF_GH)
    WSF(bf16_t, att, OFF_ATT) WSF(bf16_t, hgr, OFF_HGR) WSF(bf16_t, mix, OFF_MIX) WSF(bf16_t, xn2, OFF_XN2) WSF(bf16_t, act, OFF_ACT)
    WSF(bf16_t, y1, OFF_Y1) WSF(bf16_t, y2, OFF_Y2) WSF(bf16_t, y3, OFF_Y3)
    WSF(bf16_t, winT, OFF_WIN) WSF(bf16_t, wuaT, OFF_WUA) WSF(bf16_t, wuhT, OFF_WUH) WSF(bf16_t, woT, OFF_WO)
    WSF(bf16_t, wgT, OFF_WGT) WSF(bf16_t, wuT, OFF_WUT) WSF(bf16_t, wdT, OFF_WDT)
    WSF(float, iw, OFF_IW) WSF(float, rope, OFF_ROPE) WSF(float, lb, OFF_LB) WSF(float, tok_gate, OFF_TGATE) WSF(float, slot_gate, OFF_SGATE)
    WSF(int, ctr, OFF_CTR)
    WSF(int, wg_cnt, OFF_WGC) WSF(int, block_expert, OFF_BEXP) WSF(int, slot_token, OFF_SLOT) WSF(int, slot_rank, OFF_SRANK) WSF(int, tok_exp, OFF_TEXP)
};

template <class ColMap>
__device__ __forceinline__ void convert_T(const float* W, int ldw, bf16_t* out, int K, int N, const ColMap& cmap, int gt, int ntot) {
    const int kb = K / 64; const long ntask = (long)N * kb;
    for (long task = gt; task < ntask; task += ntot) {
        const int kq = (int)(task / N), n = (int)(task % N);
        const int c = cmap(n);
        uint32_t w[32];
        if (c >= 0) {
            const float* src = W + (size_t)(kq * 64) * ldw + c;
            float v[64];
#pragma unroll
            for (int i = 0; i < 64; ++i) v[i] = src[(size_t)i * ldw];
#pragma unroll
            for (int i = 0; i < 32; ++i) w[i] = pack2(v[2 * i], v[2 * i + 1]);
        } else {
#pragma unroll
            for (int i = 0; i < 32; ++i) w[i] = 0u;
        }
        uint4* dst = (uint4*)(out + (size_t)n * K + kq * 64);
#pragma unroll
        for (int i = 0; i < 8; ++i) dst[i] = make_uint4(w[4 * i], w[4 * i + 1], w[4 * i + 2], w[4 * i + 3]);
    }
}
struct IdMap { __device__ __forceinline__ int operator()(int n) const { return n; } };
struct WinMap { __device__ __forceinline__ int operator()(int n) const { return n < 1064 ? n : (n < 1280 ? -1 : n - 216); } };

#define XB_TMO      128
#define XB_XCNT(j)  (256  + 64 * (j))
#define XB_XSUB(j)  (1280 + 64 * (j))
#define XB_XGEN(j)  (2304 + 64 * (j))
#define XB_TOP      3328
#define XB_TOPGEN   3392
#define XCD_BAR_WORDS 3456
#define XB_SPIN_CAP (1u << 22)
__device__ __forceinline__ unsigned xb_ld(unsigned* p)              { return __hip_atomic_load(p, __ATOMIC_RELAXED, __HIP_MEMORY_SCOPE_AGENT); }
__device__ __forceinline__ unsigned xb_add(unsigned* p, unsigned v) { return __hip_atomic_fetch_add(p, v, __ATOMIC_RELAXED, __HIP_MEMORY_SCOPE_AGENT); }
__device__ __forceinline__ unsigned xb_xcc_id() { return (unsigned)__builtin_amdgcn_s_getreg((3 << 11) | 20) & 0xFu; }
#define XB_SPIN(cond, bar) do { unsigned _sp = 0; while (cond) { __builtin_amdgcn_s_sleep(1); \
    if ((++_sp & 255u) == 0u) { if (xb_ld(&(bar)[XB_TMO])) break; if (_sp > XB_SPIN_CAP) { atomicAdd(&(bar)[XB_TMO], 1u); break; } } } } while (0)
struct XcdBarrier { unsigned* bar; unsigned x; volatile LAS unsigned* st; };
__device__ __forceinline__ XcdBarrier xcd_barrier_post(unsigned* bar, volatile LAS unsigned* st) {
    XcdBarrier b; b.bar = bar; b.x = xb_xcc_id(); b.st = st;
    if (threadIdx.x == 0) (void)xb_add(&bar[XB_XCNT(b.x)], 1u);
    return b;
}
__device__ __forceinline__ void xcd_barrier_complete(unsigned* bar, unsigned x, unsigned& nloc, unsigned& nx) {
    const unsigned G = gridDim.x * gridDim.y * gridDim.z;
    unsigned sum, cnt, mine, sp = 0u;
    for (;;) {
        sum = 0u; cnt = 0u; mine = 0u;
#pragma unroll
        for (unsigned j = 0; j < 16; ++j) { const unsigned c = xb_ld(&bar[XB_XCNT(j)]); sum += c; cnt += (c > 0u) ? 1u : 0u; mine = (j == x) ? c : mine; }
        if (sum == G) break;
        __builtin_amdgcn_s_sleep(1);
        if ((++sp & 255u) == 0u) { if (xb_ld(&bar[XB_TMO])) break; if (sp > XB_SPIN_CAP) { atomicAdd(&bar[XB_TMO], 1u); break; } }
    }
    nloc = mine > 0u ? mine : 1u; nx = cnt > 0u ? cnt : 1u;
}
__device__ __forceinline__ void xcd_barrier(const XcdBarrier& b) {
    asm volatile("s_waitcnt vmcnt(0)" ::: "memory");
    __syncthreads();
    if (threadIdx.x == 0) {
        unsigned* bar = b.bar;
        __builtin_amdgcn_s_waitcnt(0);
        unsigned nloc = b.st[0], nx = b.st[1];
        if (nloc == 0u) { xcd_barrier_complete(bar, b.x, nloc, nx); b.st[0] = nloc; b.st[1] = nx; }
        const unsigned old = xb_add(&bar[XB_XSUB(b.x)], 1u);
        const unsigned gen = old / nloc;
        if (old + 1u == (gen + 1u) * nloc) {
            __builtin_amdgcn_fence(__ATOMIC_RELEASE, "agent");
            asm volatile("s_waitcnt vmcnt(0)" ::: "memory");
            const unsigned og = xb_add(&bar[XB_TOP], 1u);
            const unsigned tg = og / nx;
            if (og + 1u == (tg + 1u) * nx) xb_add(&bar[XB_TOPGEN], 1u);
            else XB_SPIN(xb_ld(&bar[XB_TOPGEN]) == tg, bar);
            __builtin_amdgcn_fence(__ATOMIC_ACQUIRE, "agent");
            xb_add(&bar[XB_XGEN(b.x)], 1u);
            asm volatile("s_waitcnt vmcnt(0)" ::: "memory");
        } else {
            XB_SPIN(xb_ld(&bar[XB_XGEN(b.x)]) == gen, bar);
            __builtin_amdgcn_fence(__ATOMIC_ACQUIRE, "agent");
            asm volatile("s_waitcnt vmcnt(0)" ::: "memory");
        }
    }
    __syncthreads();
}

__device__ __forceinline__ void ph_prep(const P& p, unsigned char* lds) {
    const int tid = tid_(), lane = tid & 63, wid = tid >> 6;
    const int gw = blockIdx.x * 8 + wid, nw = gridDim.x * 8;
    for (int r = gw; r < T; r += nw) {
        const int b = r / LP, pos = r % LP;
        bf16_t* dst = p.xn() + (size_t)r * D;
        if (pos >= L) {
#pragma unroll
            for (int i = 0; i < 4; ++i) *(uint2*)(dst + lane * 4 + 256 * i) = make_uint2(0u, 0u);
            continue;
        }
        const float* src = pos < NMETA ? p.meta + (size_t)pos * D : p.x + ((size_t)b * SEQ + (pos - NMETA)) * D;
        f32x4 v[4]; float ss = 0.f;
#pragma unroll
        for (int i = 0; i < 4; ++i) { v[i] = *(const f32x4*)(src + lane * 4 + 256 * i); ss += v[i][0] * v[i][0] + v[i][1] * v[i][1] + v[i][2] * v[i][2] + v[i][3] * v[i][3]; }
        ss = wave_sum(ss);
        const float rs = rsqrtf(ss * (1.0f / D) + EPS);
#pragma unroll
        for (int i = 0; i < 4; ++i) {
            const f32x4 g = *(const f32x4*)(p.attn_g + lane * 4 + 256 * i);
            uint2 o; o.x = pack2(v[i][0] * rs * g[0], v[i][1] * rs * g[1]); o.y = pack2(v[i][2] * rs * g[2], v[i][3] * rs * g[3]);
            *(uint2*)(dst + lane * 4 + 256 * i) = o;
        }
    }
    const int gt = blockIdx.x * NTHREADS + tid, nt = gridDim.x * NTHREADS;
    for (int i = gt; i < LP * 12; i += nt) {
        const int pos = i / 12, f = i % 12;
        const double ex = f < 8 ? -(double)f / 8.0 : -(double)(f - 8) / 4.0;
        const double inv = exp(ex * log(500000.0));
        const double ang = (double)pos * inv;
        const double twopi = 6.283185307179586476925286766559;
        const double r = ang - twopi * rint(ang / twopi);
        const float rf = (float)r;
        const float c = cosf(rf), s = sinf(rf);
        float* row = p.rope() + (size_t)pos * 24;
        if (f < 8) { row[f] = c; row[8 + f] = s; } else { row[16 + f - 8] = c; row[20 + f - 8] = s; }
    }
    for (int i = gt; i < 512; i += nt) {
        const float a = p.lb_logits[i], b2 = p.lb_logits[512 + i];
        p.lb()[i] = 1.0f / (1.0f + expf(b2 - a));
    }
    for (int i = gt; i < 128; i += nt) p.ctr()[i] = 0;
    convert_T(p.w_in, IN_COLS, p.winT(), 1024, NVC, WinMap{}, gt, nt);
    convert_T(p.w_ua, 1024, p.wuaT(), 512, 1024, IdMap{}, gt, nt);
    convert_T(p.w_uh, 1024, p.wuhT(), 512, 1024, IdMap{}, gt, nt);
    convert_T(p.w_out, 1024, p.woT(), 1024, 1024, IdMap{}, gt, nt);
}
constexpr int G_TILE_B = 256 * 64 * 2, G_STAGE_B = 2 * G_TILE_B;
__device__ __forceinline__ int g_lds_byte(int r, int c) { const int st = (r >> 4) * 2 + (c >> 5), ob = (r & 15) * 64 + (c & 31) * 2; return st * 1024 + (ob ^ (((ob >> 9) & 1) << 5)); }
__device__ __forceinline__ void g_stage_rc(int b, int& R, int& C) { const int st = b >> 10, sb = b & 1023, swz = sb ^ (((sb >> 9) & 1) << 5); R = (st >> 1) * 16 + swz / 64; C = (st & 1) * 32 + (swz % 64) / 2; }

constexpr int HTB = 128 * 64 * 2;
struct GJob { const char* A; const char* B; unsigned va00, va01, va10, va11; };
__device__ __forceinline__ void gj_lin(unsigned (&v)[2][2], int ld) {
#pragma unroll
    for (int h = 0; h < 2; ++h)
#pragma unroll
        for (int i = 0; i < 2; ++i) { int R, C; g_stage_rc(tid_() * 16 + i * 8192, R, C); v[h][i] = (unsigned)(((h * 128 + R) * ld + C) * 2); }
}
template <class AOff>
__device__ __forceinline__ void gj_gather(unsigned (&v)[2][2], const AOff& aoff) {
#pragma unroll
    for (int h = 0; h < 2; ++h)
#pragma unroll
        for (int i = 0; i < 2; ++i) { int R, C; g_stage_rc(tid_() * 16 + i * 8192, R, C); v[h][i] = (unsigned)((aoff(h * 128 + R) + C) * 2); }
}
template <class AOff>
__device__ __forceinline__ void gj_gather_job(GJob& j, const AOff& aoff) {
    unsigned v[2][2]; gj_gather(v, aoff); j.va00 = v[0][0]; j.va01 = v[0][1]; j.va10 = v[1][0]; j.va11 = v[1][1];
}
template <bool GATHER, class JobFn, class Epi>
__device__ __forceinline__ void gemm_stream(unsigned char* lds_, int K, const unsigned (&vaU)[2][2], const unsigned (&vbU)[2][2], const JobFn& jobfn, const Epi& epi) {
    LAS unsigned char* lds = (LAS unsigned char*)lds_;
    const int tid = tid_(), wid = __builtin_amdgcn_readfirstlane(tid >> 6), lane = tid & 63, wr = wid >> 2, wc = wid & 3, fr = lane & 15, fq = lane >> 4;
    const int nt = K / 64;
    const size_t kstep = 128;
    const unsigned ldsw = (unsigned)wid * 1024u;
    const int aoff = g_lds_byte(wr * 64 + fr, fq * 8), boff = g_lds_byte(wc * 32 + fr, fq * 8);
#define PG8_SA(b, h) (((b) * 2 + (h)) * HTB)
#define PG8_SB(b, h) ((4 + (b) * 2 + (h)) * HTB)
#define PG8_STAGE(bufoff, gbase, voff) do { _Pragma("unroll") for (int _i = 0; _i < 2; ++_i) \
        __builtin_amdgcn_global_load_lds((const unsigned*)((const char*)(gbase) + (voff)[_i]), (LAS unsigned*)(lds + (bufoff) + ldsw + _i * 8192), 16, 0, 0); } while (0)
#define PG8_LDA(dst, b, h) do { _Pragma("unroll") for (int m = 0; m < 4; ++m) _Pragma("unroll") for (int k = 0; k < 2; ++k) dst[m][k] = *(const LAS bf16x8*)(lds + PG8_SA(b, h) + aoff + m * 2048 + k * 1024); } while (0)
#define PG8_LDB(dst, b, h) do { _Pragma("unroll") for (int n = 0; n < 2; ++n) _Pragma("unroll") for (int k = 0; k < 2; ++k) dst[n][k] = *(const LAS bf16x8*)(lds + PG8_SB(b, h) + boff + n * 2048 + k * 1024); } while (0)
#define PG8_MMA(ai, bj, At, Bt) do { __builtin_amdgcn_s_setprio(1); _Pragma("unroll") for (int m = 0; m < 4; ++m) _Pragma("unroll") for (int n = 0; n < 2; ++n) _Pragma("unroll") for (int k = 0; k < 2; ++k) \
        acc[ai][bj][m][n] = __builtin_amdgcn_mfma_f32_16x16x32_bf16(Bt[n][k], At[m][k], acc[ai][bj][m][n], 0, 0, 0); __builtin_amdgcn_s_setprio(0); } while (0)
#define PG8_WAIT_V(n) asm volatile("s_waitcnt vmcnt(" #n ")" ::: "memory")
#define PG8_WAIT_L(n) asm volatile("s_waitcnt lgkmcnt(" #n ")" ::: "memory")
#define PG8_BAR __builtin_amdgcn_s_barrier()
#define PG8_SCHED __builtin_amdgcn_sched_barrier(0)
    GJob cur, nxt; int ui = 0;
    cur.A = nullptr; cur.B = nullptr; cur.va00 = cur.va01 = cur.va10 = cur.va11 = 0u; nxt = cur;
    if (!jobfn(0, cur)) return;
    f32x4 acc[2][2][4][2];
#pragma unroll
    for (int a = 0; a < 2; ++a)
#pragma unroll
        for (int b = 0; b < 2; ++b)
#pragma unroll
            for (int m = 0; m < 4; ++m)
#pragma unroll
                for (int n = 0; n < 2; ++n) acc[a][b][m][n] = (f32x4){0.f, 0.f, 0.f, 0.f};
    bf16x8 At[4][2], B0[2][2], B1[2][2];
    unsigned ca0[2], ca1[2];
    { ca0[0] = GATHER ? cur.va00 : vaU[0][0]; ca0[1] = GATHER ? cur.va01 : vaU[0][1]; ca1[0] = GATHER ? cur.va10 : vaU[1][0]; ca1[1] = GATHER ? cur.va11 : vaU[1][1]; }
    PG8_STAGE(PG8_SB(0, 0), cur.B, vbU[0]); PG8_STAGE(PG8_SB(0, 1), cur.B, vbU[1]); PG8_STAGE(PG8_SA(0, 0), cur.A, ca0); PG8_STAGE(PG8_SA(0, 1), cur.A, ca1);
    if (wr == 1) PG8_BAR;
    PG8_WAIT_V(2); PG8_BAR;
    PG8_STAGE(PG8_SB(1, 0), cur.B + kstep, vbU[0]); PG8_STAGE(PG8_SA(1, 0), cur.A + kstep, ca0); PG8_STAGE(PG8_SB(1, 1), cur.B + kstep, vbU[1]);
    PG8_WAIT_V(6); PG8_BAR;
    for (;;) {
        bool has_next = false;
        for (int t = 0; t < nt; t += 2) {
            const bool last = (t == nt - 2);
            if (last) { has_next = jobfn(ui + 1, nxt); if (!has_next) nxt = cur; }
            const char* a1 = cur.A + (size_t)(t + 1) * kstep;
            const char* a2 = last ? nxt.A : cur.A + (size_t)(t + 2) * kstep; const char* b2 = last ? nxt.B : cur.B + (size_t)(t + 2) * kstep;
            const char* a3 = a2 + kstep; const char* b3 = b2 + kstep;
            unsigned xa0[2], xa1[2];
            { const bool sw = GATHER && last; xa0[0] = sw ? nxt.va00 : ca0[0]; xa0[1] = sw ? nxt.va01 : ca0[1]; xa1[0] = sw ? nxt.va10 : ca1[0]; xa1[1] = sw ? nxt.va11 : ca1[1]; }
            PG8_LDB(B0, 0, 0); PG8_LDB(B1, 0, 1); PG8_SCHED; PG8_LDA(At, 0, 0); PG8_STAGE(PG8_SA(1, 1), a1, ca1);
            PG8_WAIT_V(8); PG8_WAIT_L(0); PG8_BAR; PG8_MMA(0, 0, At, B0); PG8_MMA(0, 1, At, B1); PG8_BAR; PG8_SCHED;
            PG8_LDA(At, 0, 1); PG8_STAGE(PG8_SB(0, 0), b2, vbU[0]); PG8_STAGE(PG8_SB(0, 1), b2, vbU[1]); PG8_STAGE(PG8_SA(0, 0), a2, xa0);
            PG8_WAIT_V(8); PG8_WAIT_L(0); PG8_BAR; PG8_MMA(1, 0, At, B0); PG8_MMA(1, 1, At, B1); PG8_BAR; PG8_SCHED;
            PG8_LDB(B0, 1, 0); PG8_LDB(B1, 1, 1); PG8_SCHED; PG8_LDA(At, 1, 0); PG8_STAGE(PG8_SA(0, 1), a2, xa1);
            PG8_WAIT_V(8); PG8_WAIT_L(0); PG8_BAR; PG8_MMA(0, 0, At, B0); PG8_MMA(0, 1, At, B1); PG8_BAR; PG8_SCHED;
            PG8_LDA(At, 1, 1); PG8_STAGE(PG8_SB(1, 0), b3, vbU[0]); PG8_STAGE(PG8_SB(1, 1), b3, vbU[1]); PG8_STAGE(PG8_SA(1, 0), a3, xa0);
            PG8_WAIT_V(8); PG8_WAIT_L(0); PG8_BAR; PG8_MMA(1, 0, At, B0); PG8_MMA(1, 1, At, B1); PG8_BAR; PG8_SCHED;
        }
        if (wr == 0) PG8_BAR;
        epi(acc, ui);
        if (!has_next) break;
#pragma unroll
        for (int a = 0; a < 2; ++a)
#pragma unroll
            for (int b = 0; b < 2; ++b)
#pragma unroll
                for (int m = 0; m < 4; ++m)
#pragma unroll
                    for (int n = 0; n < 2; ++n) acc[a][b][m][n] = (f32x4){0.f, 0.f, 0.f, 0.f};
        cur = nxt; ++ui;
        { ca0[0] = GATHER ? cur.va00 : vaU[0][0]; ca0[1] = GATHER ? cur.va01 : vaU[0][1]; ca1[0] = GATHER ? cur.va10 : vaU[1][0]; ca1[1] = GATHER ? cur.va11 : vaU[1][1]; }
        if (wr == 1) PG8_BAR;
    }
    PG8_WAIT_V(0);
    PG8_BAR;
#undef PG8_SA
#undef PG8_SB
#undef PG8_STAGE
#undef PG8_LDA
#undef PG8_LDB
#undef PG8_MMA
#undef PG8_WAIT_V
#undef PG8_WAIT_L
#undef PG8_BAR
#undef PG8_SCHED
}
struct RowLin { size_t base; int ld; __device__ __forceinline__ size_t operator()(int R) const { return base + (size_t)R * ld; } };

__device__ __forceinline__ void st_bf4(bf16_t* dst, f32x4 v) {
    uint2 o; o.x = pack2(v[0], v[1]); o.y = pack2(v[2], v[3]); *(uint2*)dst = o;
}
#define EPI8(...) do { const int tid_e = tid_(), lane_e = tid_e & 63, wid_e = tid_e >> 6, wr = wid_e >> 2, wc = wid_e & 3, fr = lane_e & 15, fq = lane_e >> 4; \
    _Pragma("unroll") for (int ai = 0; ai < 2; ++ai) _Pragma("unroll") for (int m = 0; m < 4; ++m) _Pragma("unroll") for (int bj = 0; bj < 2; ++bj) _Pragma("unroll") for (int n = 0; n < 2; ++n) { \
        const int row = ai * 128 + wr * 64 + m * 16 + fr, col = bj * 128 + wc * 32 + n * 16 + fq * 4; const f32x4 v = acc[ai][bj][m][n]; __VA_ARGS__ } } while (0)

struct EpiInproj {
    const P* p; int nt;
    __device__ __forceinline__ void operator()(int m, int n, int fq, f32x4 v) const {
        const P& P_ = *p;
        const int pos = m % LP;
        const float* rp = P_.rope() + (size_t)pos * 24;
        if (nt <= 2) {
            const bool isv = (nt == 2) && (n >= 128);
            if (!isv && (n & 48) == 0) {
                f32x4 pr;
#pragma unroll
                for (int j = 0; j < 4; ++j) pr[j] = __shfl_xor(v[j], 32);
                const int i0 = (fq & 1) * 4;
#pragma unroll
                for (int j = 0; j < 4; ++j) {
                    const float c = rp[i0 + j], s = rp[8 + i0 + j];
                    v[j] = fq < 2 ? v[j] * c - pr[j] * s : v[j] * c + pr[j] * s;
                }
            }
            if (nt < 2) { st_bf4(P_.q() + (size_t)m * 512 + nt * 256 + n, v * (0.125f * 1.4426950408889634f)); }
            else if (n < 128) st_bf4(P_.k() + (size_t)m * 128 + n, v);
            else st_bf4(P_.v() + (size_t)m * 128 + (n - 128), v);
        } else if (nt == 3 || nt == 4) {
            const bool ropeable = (nt == 3) ? ((n & 16) == 0) : (n < 16);
            if (ropeable) {
                f32x4 pr;
#pragma unroll
                for (int j = 0; j < 4; ++j) pr[j] = __shfl_xor(v[j], 16);
                if (fq < 2) {
#pragma unroll
                    for (int j = 0; j < 4; ++j) {
                        const float c = rp[16 + j], s = rp[20 + j];
                        v[j] = fq == 0 ? v[j] * c - pr[j] * s : v[j] * c + pr[j] * s;
                    }
                }
            }
            if (nt == 3) st_bf4(P_.iq() + (size_t)m * 256 + n, v);
            else if (n < 32) st_bf4(P_.ik() + (size_t)m * 32 + n, v);
            else if (n < 40) *(f32x4*)(P_.iw() + (size_t)m * 8 + (n - 32)) = v;
        } else if (nt <= 6) { st_bf4(P_.hq() + (size_t)m * 512 + (nt - 5) * 256 + n, v * 0.08838834764831845f); }
        else if (nt <= 8) { st_bf4(P_.hf() + (size_t)m * 512 + (nt - 7) * 256 + n, v); }
        else if (nt <= 10) { st_bf4(P_.hi() + (size_t)m * 512 + (nt - 9) * 256 + n, v); }
        else if (nt <= 12) {
            f32x4 o;
#pragma unroll
            for (int j = 0; j < 4; ++j) o[j] = v[j] * sigmoidf_(v[j]);
            st_bf4(P_.hg() + (size_t)m * 512 + (nt - 11) * 256 + n, o);
        } else {
            f32x4 o;
#pragma unroll
            for (int j = 0; j < 4; ++j) o[j] = sigmoidf_(v[j]);
            if (nt <= 16) st_bf4(P_.ga() + (size_t)m * 1024 + (nt - 13) * 256 + n, o);
            else st_bf4(P_.gh() + (size_t)m * 1024 + (nt - 17) * 256 + n, o);
        }
    }
};

__device__ __forceinline__ void ph_inproj(const P& p, unsigned char* lds) {
    const int nunits = (T / 256) * 21, G = gridDim.x, b0 = blockIdx.x;
    auto jobfn = [&](int i, GJob& j) __attribute__((always_inline)) -> bool {
        const int u = b0 + i * G; if (u >= nunits) return false;
        const int nt = u % 21, mt = u / 21;
        j.A = (const char*)(p.xn() + (size_t)mt * 256 * D); j.B = (const char*)(p.winT() + (size_t)nt * 256 * D); return true; };
    auto epi = [&](f32x4 (&acc)[2][2][4][2], int i) __attribute__((always_inline)) {
        const int u = b0 + i * G, nt = u % 21, mt = u / 21;
        const EpiInproj e{&p, nt};
        EPI8( e(mt * 256 + row, col, fq, v); );
    };
    unsigned vaU[2][2], vbU[2][2]; gj_lin(vaU, D); gj_lin(vbU, D);
    gemm_stream<false>(lds, D, vaU, vbU, jobfn, epi);
}

constexpr int NCH = 129, NXU = 16 * NCH;
constexpr int X_QT = 0, X_KT = X_QT + 64 * 272, X_KH = X_KT + 64 * 272, X_VT = X_KH + 128 * 144, X_AS = X_VT + 128 * 144, X_SEG = X_AS + 64 * 144;
__device__ __forceinline__ bf16_t* hg_ds(const P& p) { return (bf16_t*)p.out; }
__device__ __forceinline__ float* hg_g(const P& p) { return (float*)((unsigned char*)p.out + (size_t)NXU * 32768); }

__device__ __forceinline__ void hgx_unit(const P& p, unsigned char* lds, int u) {
    const int tid = tid_(), lane = tid & 63, wid = tid >> 6, fr = lane & 15, fq = lane >> 4;
    const int c = u % NCH, bh = u / NCH, b = bh >> 2, h = bh & 3;
    const int d = tid & 127, seg = tid >> 7;
    const size_t rowbase = (size_t)(b * LP + c * 64 + seg * 16) * 512 + h * 128 + d;
    bf16_t* hqp = p.hq() + rowbase; const bf16_t* hfp = p.hf() + rowbase; const bf16_t* hip = p.hi() + rowbase;
    const float lbv = p.lb()[h * 128 + d];
    float bb[16], qv[16], kk[16], vv[16];
    float cs = 0.f;
#pragma unroll
    for (int i = 0; i < 16; ++i) {
        const float f = lbv + (1.0f - lbv) * sigmoidf_(bf2f(hfp[(size_t)i * 512]));
        kk[i] = 1.0f - f; cs += __logf(f); bb[i] = cs;
        qv[i] = bf2f(hqp[(size_t)i * 512]); vv[i] = bf2f(hip[(size_t)i * 512]);
    }
    float* segs = (float*)(lds + X_SEG);
    segs[seg * 128 + d] = cs;
    __syncthreads();
    const float s0 = segs[d], s1 = segs[128 + d], s2 = segs[256 + d], s3 = segs[384 + d];
    const float off = seg == 0 ? 0.f : (seg == 1 ? s0 : (seg == 2 ? s0 + s1 : s0 + s1 + s2));
    const float rref = s0 + s1, blast = (s0 + s1) + (s2 + s3);
    uint32_t khp[8], vtp[8];
#pragma unroll
    for (int i = 0; i < 16; i += 2) {
        float khv[2];
#pragma unroll
        for (int j = 0; j < 2; ++j) {
            const float bt = bb[i + j] + off;
            const float eq = __expf(fminf(bt - rref, 80.f)), ek = __expf(fminf(rref - bt, 80.f));
            const int t = seg * 16 + i + j;
            *(bf16_t*)(lds + X_QT + t * 272 + d * 2) = f2bf(qv[i + j] * eq);
            *(bf16_t*)(lds + X_KT + t * 272 + d * 2) = f2bf(kk[i + j] * ek);
            hqp[(size_t)(i + j) * 512] = f2bf(qv[i + j] * __expf(bt));
            khv[j] = kk[i + j] * __expf(blast - bt);
        }
        khp[i >> 1] = pack2(khv[0], khv[1]); vtp[i >> 1] = pack2(vv[i], vv[i + 1]);
    }
    *(uint4*)(lds + X_KH + d * 144 + seg * 32) = make_uint4(khp[0], khp[1], khp[2], khp[3]);
    *(uint4*)(lds + X_KH + d * 144 + seg * 32 + 16) = make_uint4(khp[4], khp[5], khp[6], khp[7]);
    *(uint4*)(lds + X_VT + d * 144 + seg * 32) = make_uint4(vtp[0], vtp[1], vtp[2], vtp[3]);
    *(uint4*)(lds + X_VT + d * 144 + seg * 32 + 16) = make_uint4(vtp[4], vtp[5], vtp[6], vtp[7]);
    if (seg == 0) hg_g(p)[(size_t)u * 128 + d] = __expf(blast);
    __syncthreads();
    {
        const int tm = wid >> 1, tn0 = (wid & 1) * 2;
        f32x4 a1[2] = {(f32x4){0.f, 0.f, 0.f, 0.f}, (f32x4){0.f, 0.f, 0.f, 0.f}};
#pragma unroll
        for (int ks = 0; ks < 4; ++ks) {
            const bf16x8 aq = *(const bf16x8*)(lds + X_QT + (tm * 16 + fr) * 272 + (ks * 32 + fq * 8) * 2);
#pragma unroll
            for (int j = 0; j < 2; ++j) {
                const bf16x8 bk = *(const bf16x8*)(lds + X_KT + ((tn0 + j) * 16 + fr) * 272 + (ks * 32 + fq * 8) * 2);
                a1[j] = __builtin_amdgcn_mfma_f32_16x16x32_bf16(bk, aq, a1[j], 0, 0, 0);
            }
        }
#pragma unroll
        for (int j = 0; j < 2; ++j) {
            const int t = tm * 16 + fr, sb = (tn0 + j) * 16 + fq * 4;
            f32x4 v = a1[j];
#pragma unroll
            for (int jj = 0; jj < 4; ++jj) v[jj] = (sb + jj <= t) ? v[jj] : 0.f;
            uint2 o; o.x = pack2(v[0], v[1]); o.y = pack2(v[2], v[3]);
            *(uint2*)(lds + X_AS + t * 144 + sb * 2) = o;
        }
    }
    __syncthreads();
    {
        const int tm = wid >> 1, en0 = (wid & 1) * 4;
        f32x4 o2[4];
#pragma unroll
        for (int j = 0; j < 4; ++j) o2[j] = (f32x4){0.f, 0.f, 0.f, 0.f};
#pragma unroll
        for (int ks = 0; ks < 2; ++ks) {
            const bf16x8 aa = *(const bf16x8*)(lds + X_AS + (tm * 16 + fr) * 144 + (ks * 32 + fq * 8) * 2);
#pragma unroll
            for (int j = 0; j < 4; ++j) {
                const bf16x8 bv = *(const bf16x8*)(lds + X_VT + ((en0 + j) * 16 + fr) * 144 + (ks * 32 + fq * 8) * 2);
                o2[j] = __builtin_amdgcn_mfma_f32_16x16x32_bf16(bv, aa, o2[j], 0, 0, 0);
            }
        }
        bf16_t* orow = p.hf() + (size_t)(b * LP + c * 64 + tm * 16 + fr) * 512 + h * 128;
#pragma unroll
        for (int j = 0; j < 4; ++j) st_bf4(orow + (en0 + j) * 16 + fq * 4, o2[j]);
    }
    {
        f32x4 s3[8];
#pragma unroll
        for (int j = 0; j < 8; ++j) s3[j] = (f32x4){0.f, 0.f, 0.f, 0.f};
#pragma unroll
        for (int ks = 0; ks < 2; ++ks) {
            const bf16x8 ak = *(const bf16x8*)(lds + X_KH + (wid * 16 + fr) * 144 + (ks * 32 + fq * 8) * 2);
#pragma unroll
            for (int j = 0; j < 8; ++j) {
                const bf16x8 bv = *(const bf16x8*)(lds + X_VT + (j * 16 + fr) * 144 + (ks * 32 + fq * 8) * 2);
                s3[j] = __builtin_amdgcn_mfma_f32_16x16x32_bf16(ak, bv, s3[j], 0, 0, 0);
            }
        }
        bf16_t* dsb = hg_ds(p) + (size_t)u * 16384;
#pragma unroll
        for (int j = 0; j < 8; ++j) st_bf4(dsb + (size_t)(j * 16 + fr) * 128 + wid * 16 + fq * 4, s3[j]);
    }
    __syncthreads();
}

__device__ __forceinline__ void hgchain_unit(const P& p, int bh) {
    const int tid = tid_(), e = tid & 127, dr = tid >> 7;
    float S[32];
#pragma unroll
    for (int i = 0; i < 32; ++i) S[i] = 0.f;
    uint4* ptr = (uint4*)(hg_ds(p) + ((size_t)(bh * NCH) * 128 + e) * 128 + dr * 32);
    const f32x4* gp = (const f32x4*)(hg_g(p) + (size_t)(bh * NCH) * 128 + dr * 32);
    uint4 w[4]; f32x4 g[8];
#pragma unroll
    for (int i = 0; i < 4; ++i) w[i] = ptr[i];
#pragma unroll
    for (int i = 0; i < 8; ++i) g[i] = gp[i];
    for (int c = 0; c < NCH; ++c) {
        uint4 wn[4]; f32x4 gn[8];
        uint4* pn = ptr + 16384 * 2 / 16;
        const f32x4* gpn = gp + 32;
        if (c + 1 < NCH) {
#pragma unroll
            for (int i = 0; i < 4; ++i) wn[i] = pn[i];
#pragma unroll
            for (int i = 0; i < 8; ++i) gn[i] = gpn[i];
        }
#pragma unroll
        for (int i = 0; i < 4; ++i)
            ptr[i] = make_uint4(pack2(S[8 * i], S[8 * i + 1]), pack2(S[8 * i + 2], S[8 * i + 3]), pack2(S[8 * i + 4], S[8 * i + 5]), pack2(S[8 * i + 6], S[8 * i + 7]));
#pragma unroll
        for (int i = 0; i < 4; ++i) {
            const uint32_t ww[4] = {w[i].x, w[i].y, w[i].z, w[i].w};
#pragma unroll
            for (int j = 0; j < 4; ++j) {
                const float lo = __uint_as_float(ww[j] << 16), hi = __uint_as_float(ww[j] & 0xffff0000u);
                S[8 * i + 2 * j] = g[2 * i + (j >> 1)][(2 * j) & 3] * S[8 * i + 2 * j] + lo;
                S[8 * i + 2 * j + 1] = g[2 * i + (j >> 1)][(2 * j + 1) & 3] * S[8 * i + 2 * j + 1] + hi;
            }
        }
        if (c + 1 < NCH) {
#pragma unroll
            for (int i = 0; i < 4; ++i) w[i] = wn[i];
#pragma unroll
            for (int i = 0; i < 8; ++i) g[i] = gn[i];
        }
        ptr = pn; gp = gpn;
    }
}

__device__ __forceinline__ void hgz_unit(const P& p, unsigned char* lds, int u) {
    const int tid = tid_(), lane = tid & 63, wid = tid >> 6, fr = lane & 15, fq = lane >> 4;
    const int c = u % NCH, bh = u / NCH, b = bh >> 2, h = bh & 3;
    const int tm = wid >> 1, en0 = (wid & 1) * 4;
    const size_t row = (size_t)(b * LP + c * 64 + tm * 16 + fr);
    const bf16_t* qrow = p.hq() + row * 512 + h * 128;
    const bf16_t* sT = hg_ds(p) + (size_t)u * 16384;
    f32x4 o[4];
#pragma unroll
    for (int j = 0; j < 4; ++j) o[j] = (f32x4){0.f, 0.f, 0.f, 0.f};
#pragma unroll
    for (int ks = 0; ks < 4; ++ks) {
        const bf16x8 aq = *(const bf16x8*)(qrow + ks * 32 + fq * 8);
#pragma unroll
        for (int j = 0; j < 4; ++j) {
            const bf16x8 bs = *(const bf16x8*)(sT + (size_t)((en0 + j) * 16 + fr) * 128 + ks * 32 + fq * 8);
            o[j] = __builtin_amdgcn_mfma_f32_16x16x32_bf16(bs, aq, o[j], 0, 0, 0);
        }
    }
    const bf16_t* oi = p.hf() + row * 512 + h * 128;
    float ss = 0.f;
#pragma unroll
    for (int j = 0; j < 4; ++j) {
        const uint2 w = *(const uint2*)(oi + (en0 + j) * 16 + fq * 4);
        o[j][0] += __uint_as_float(w.x << 16); o[j][1] += __uint_as_float(w.x & 0xffff0000u);
        o[j][2] += __uint_as_float(w.y << 16); o[j][3] += __uint_as_float(w.y & 0xffff0000u);
        ss += o[j][0] * o[j][0] + o[j][1] * o[j][1] + o[j][2] * o[j][2] + o[j][3] * o[j][3];
    }
    ss += __shfl_xor(ss, 16); ss += __shfl_xor(ss, 32);
    float* part = (float*)lds;
    if (fq == 0) part[(tm * 16 + fr) * 2 + (wid & 1)] = ss;
    __syncthreads();
    const float tot = part[(tm * 16 + fr) * 2] + part[(tm * 16 + fr) * 2 + 1];
    const float rs = rsqrtf(tot * (1.0f / 128.0f) + EPS);
    const bf16_t* hgp = p.hg() + row * 512 + h * 128;
    bf16_t* outp = p.hgr() + row * 512 + h * 128;
#pragma unroll
    for (int j = 0; j < 4; ++j) {
        const int e0 = (en0 + j) * 16 + fq * 4;
        const f32x4 gn = *(const f32x4*)(p.hgrn_g + h * 128 + e0);
        const uint2 w = *(const uint2*)(hgp + e0);
        f32x4 r;
        r[0] = o[j][0] * rs * gn[0] * __uint_as_float(w.x << 16); r[1] = o[j][1] * rs * gn[1] * __uint_as_float(w.x & 0xffff0000u);
        r[2] = o[j][2] * rs * gn[2] * __uint_as_float(w.y << 16); r[3] = o[j][3] * rs * gn[3] * __uint_as_float(w.y & 0xffff0000u);
        st_bf4(outp + e0, r);
    }
    __syncthreads();
}

typedef float f32x16 __attribute__((ext_vector_type(16)));
typedef short s16x4 __attribute__((ext_vector_type(4)));
typedef unsigned u32x4 __attribute__((ext_vector_type(4)));
constexpr int NKMAX = 8224;
constexpr int NBIN = 1024;
constexpr int A_SC = 0, A_H1 = A_SC + 4 * NKMAX * 4, A_SEL = A_H1 + 4 * NBIN * 4, A_CAND = A_SEL + 2048, A_META = A_CAND + 1024, A_END = A_META + 256;
static_assert(A_END <= LDS_BYTES - 16, "attention LDS");
__device__ __forceinline__ uint32_t skey(float f) { const uint32_t u = __float_as_uint(f); return (u & 0x80000000u) ? ~u : (u | 0x80000000u); }
__device__ __forceinline__ float skey_inv(uint32_t k) { return __uint_as_float((k & 0x80000000u) ? (k & 0x7fffffffu) : ~k); }
__device__ __forceinline__ int bin1(float s, float lo, float scale) { return min(NBIN - 1, max(0, (int)((s - lo) * scale))); }
template <int OFF> __device__ __forceinline__ s16x4 tr_read(unsigned addr) {
    s16x4 r; asm volatile("ds_read_b64_tr_b16 %0, %1 offset:%2" : "=&v"(r) : "v"(addr), "i"(OFF) : "memory"); return r;
}
__device__ __forceinline__ void scan_top(const int* hist, int K, int* m, int lane) {
    int c[16];
#pragma unroll
    for (int i = 0; i < 4; ++i) { const int4 v = *(const int4*)(hist + 16 * lane + 4 * i); c[4 * i] = v.x; c[4 * i + 1] = v.y; c[4 * i + 2] = v.z; c[4 * i + 3] = v.w; }
    int tot = 0;
#pragma unroll
    for (int i = 0; i < 16; ++i) tot += c[i];
    int suf = tot;
#pragma unroll
    for (int o = 1; o < 64; o <<= 1) { const int t = __shfl_down(suf, o); if (lane + o < 64) suf += t; }
    int above = suf - tot;
#pragma unroll
    for (int i = 15; i >= 0; --i) {
        if (above < K && K <= above + c[i]) { m[0] = 16 * lane + i; m[1] = above; m[2] = c[i]; }
        above += c[i];
    }
}

__device__ __forceinline__ void attn4_unit(const P& p, unsigned char* lds, int b, int grp) {
    const int tid = tid_(), lane = tid & 63, wid = __builtin_amdgcn_readfirstlane(tid >> 6);
    const int t0 = NMETA + 4 * grp;
    const int brow = b * LP, row0 = brow + t0;
    float* sc = (float*)(lds + A_SC);
    int* h1 = (int*)(lds + A_H1);
    unsigned short* sel = (unsigned short*)(lds + A_SEL); unsigned short* cand = (unsigned short*)(lds + A_CAND);
    int* meta = (int*)(lds + A_META);
    const bool big = t0 + 1 > 256;
    for (int i = tid; i < 4 * NBIN; i += NTHREADS) h1[i] = 0;
    if (tid < 64) { const int w = tid & 15; meta[tid] = (w == 0) ? -1 : 0; }
    if (!big) { for (int i = tid; i < 1024; i += NTHREADS) { const int q = i >> 8, j = i & 255; sel[i] = (unsigned short)(j <= t0 + q ? j : 0); } }
    __syncthreads();
    if (big) {
        {
            const int hh = lane >> 5, c32 = lane & 31;
            const int g = c32 >> 3, h2a = (c32 >> 2) & 1, bq = c32 & 3, aq = 2 * h2a + (g >> 1), ah = 4 * (g & 1) + bq;
            const bf16_t* ap = p.iq() + (size_t)(row0 + aq) * 256 + ah * 32 + 8 * hh;
            const bf16x8 a0 = *(const bf16x8*)ap, a1 = *(const bf16x8*)(ap + 16);
            const f32x4 w00 = *(const f32x4*)(p.iw() + (size_t)(row0 + 2 * hh) * 8), w01 = *(const f32x4*)(p.iw() + (size_t)(row0 + 2 * hh) * 8 + 4);
            const f32x4 w10 = *(const f32x4*)(p.iw() + (size_t)(row0 + 2 * hh + 1) * 8), w11 = *(const f32x4*)(p.iw() + (size_t)(row0 + 2 * hh + 1) * 8 + 4);
            const int ntiles = (t0 + 4 + 31) >> 5;
            const int tq0 = t0 + 2 * hh;
            float mx0 = -INFINITY, mn0 = INFINITY, mx1 = -INFINITY, mn1 = INFINITY;
            const bf16_t* kbase = p.ik() + (size_t)brow * 32 + 8 * hh;
            for (int tile0 = wid; tile0 < ntiles; tile0 += 128) {
                bf16x8 b0[16], b1[16];
#pragma unroll
                for (int j = 0; j < 16; ++j) {
                    const int tile = min(tile0 + 8 * j, ntiles - 1);
                    const bf16_t* kp = kbase + (size_t)(tile * 32 + c32) * 32;
                    b0[j] = *(const bf16x8*)kp; b1[j] = *(const bf16x8*)(kp + 16);
                }
                __builtin_amdgcn_sched_barrier(0);
#pragma unroll
                for (int j = 0; j < 16; ++j) {
                    const int tile = tile0 + 8 * j;
                    if (tile < ntiles) {
                        const int key = tile * 32 + c32;
                        f32x16 acc;
#pragma unroll
                        for (int i = 0; i < 16; ++i) acc[i] = 0.f;
                        acc = __builtin_amdgcn_mfma_f32_32x32x16_bf16(a0, b0[j], acc, 0, 0, 0);
                        acc = __builtin_amdgcn_mfma_f32_32x32x16_bf16(a1, b1[j], acc, 0, 0, 0);
                        float s0 = 0.f, s1 = 0.f;
#pragma unroll
                        for (int i = 0; i < 4; ++i) {
                            s0 += w00[i] * fmaxf(acc[i], 0.f) + w01[i] * fmaxf(acc[4 + i], 0.f);
                            s1 += w10[i] * fmaxf(acc[8 + i], 0.f) + w11[i] * fmaxf(acc[12 + i], 0.f);
                        }
                        sc[(2 * hh) * NKMAX + key] = s0; sc[(2 * hh + 1) * NKMAX + key] = s1;
                        if (key <= tq0) { mx0 = fmaxf(mx0, s0); mn0 = fminf(mn0, s0); }
                        if (key <= tq0 + 1) { mx1 = fmaxf(mx1, s1); mn1 = fminf(mn1, s1); }
                    }
                }
            }
#pragma unroll
            for (int o = 16; o >= 1; o >>= 1) {
                mx0 = fmaxf(mx0, __shfl_xor(mx0, o)); mn0 = fminf(mn0, __shfl_xor(mn0, o));
                mx1 = fmaxf(mx1, __shfl_xor(mx1, o)); mn1 = fminf(mn1, __shfl_xor(mn1, o));
            }
            if (c32 == 0) {
                if (mx0 >= mn0) { atomicMin((unsigned*)&meta[(2 * hh) * 16 + 0], skey(mn0)); atomicMax((unsigned*)&meta[(2 * hh) * 16 + 1], skey(mx0)); }
                if (mx1 >= mn1) { atomicMin((unsigned*)&meta[(2 * hh + 1) * 16 + 0], skey(mn1)); atomicMax((unsigned*)&meta[(2 * hh + 1) * 16 + 1], skey(mx1)); }
            }
        }
        __syncthreads();
        const int q = wid & 3, part = wid >> 2, n = t0 + q + 1;
        const float lo = skey_inv((unsigned)meta[q * 16 + 0]), hi = skey_inv((unsigned)meta[q * 16 + 1]);
        const float scale = hi > lo ? (float)NBIN / (hi - lo) : 0.f;
        const float* scq = sc + q * NKMAX;
        for (int base = part * 256; base < n; base += 512) {
            const int idx0 = base + lane * 4;
            if (idx0 < n) {
                const f32x4 v = *(const f32x4*)(scq + idx0);
#pragma unroll
                for (int j = 0; j < 4; ++j) if (idx0 + j < n) atomicAdd(&h1[q * NBIN + bin1(v[j], lo, scale)], 1);
            }
        }
        __syncthreads();
        if (wid < 4) scan_top(h1 + wid * NBIN, 256, meta + wid * 16 + 4, lane);
        __syncthreads();
        const int B1 = meta[q * 16 + 4];
        for (int base = part * 256; base < n; base += 512) {
            const int idx0 = base + lane * 4;
            f32x4 v = (f32x4){0.f, 0.f, 0.f, 0.f};
            if (idx0 < n) v = *(const f32x4*)(scq + idx0);
            const unsigned long long lt = (1ull << lane) - 1ull;
#pragma unroll
            for (int j = 0; j < 4; ++j) {
                const int idx = idx0 + j;
                bool issel = false, iscand = false;
                if (idx < n) { const int b1 = bin1(v[j], lo, scale); issel = b1 > B1; iscand = b1 == B1; }
                const unsigned long long ms = __ballot(issel), mc = __ballot(iscand);
                if (ms) {
                    int bs = 0; if (lane == 0) bs = atomicAdd(&meta[q * 16 + 2], __popcll(ms));
                    bs = __shfl(bs, 0);
                    if (issel) sel[q * 256 + bs + __popcll(ms & lt)] = (unsigned short)idx;
                }
                if (mc) {
                    int bs = 0; if (lane == 0) bs = atomicAdd(&meta[q * 16 + 3], __popcll(mc));
                    bs = __shfl(bs, 0);
                    const int pos = bs + __popcll(mc & lt);
                    if (iscand && pos < 128) cand[q * 128 + pos] = (unsigned short)idx;
                }
            }
        }
        __syncthreads();
        if (wid < 4) {
            const int qq = wid; const float* scr = sc + qq * NKMAX;
            const int rq = 256 - meta[qq * 16 + 5], cq = meta[qq * 16 + 6], sbase = 256 - rq, nn = t0 + qq + 1;
            if (cq <= 128) {
                int taken = 0;
#pragma unroll
                for (int half = 0; half < 2; ++half) {
                    const int i = lane + 64 * half;
                    bool take = false; int myidx = 0;
                    if (i < cq) {
                        myidx = cand[qq * 128 + i]; const float mv = scr[myidx];
                        int rank = 0;
                        for (int j = 0; j < cq; ++j) { const int oj = cand[qq * 128 + j]; const float ov = scr[oj]; rank += (ov > mv) || (ov == mv && oj < myidx); }
                        take = rank < rq;
                    }
                    const unsigned long long mt = __ballot(take);
                    if (take) sel[qq * 256 + sbase + taken + __popcll(mt & ((1ull << lane) - 1ull))] = (unsigned short)myidx;
                    taken += __popcll(mt);
                }
            } else {
                const float lo_ = skey_inv((unsigned)meta[qq * 16 + 0]), hi_ = skey_inv((unsigned)meta[qq * 16 + 1]);
                const float sc_ = hi_ > lo_ ? (float)NBIN / (hi_ - lo_) : 0.f;
                const int B1_ = meta[qq * 16 + 4];
                int taken = 0;
                for (int base = 0; base < nn && taken < rq; base += 64) {
                    const int idx = base + lane; bool isc = false;
                    if (idx < nn) isc = bin1(scr[idx], lo_, sc_) == B1_;
                    const unsigned long long mc = __ballot(isc);
                    const int pos = taken + __popcll(mc & ((1ull << lane) - 1ull));
                    if (isc && pos < rq) sel[qq * 256 + sbase + pos] = (unsigned short)idx;
                    taken += __popcll(mc);
                }
            }
        }
        __syncthreads();
    }
    {
        const int q = wid >> 1, kvh = wid & 1, tq = t0 + q, nsel = min(tq + 1, 256);
        const int col = lane & 15, g4 = lane >> 4;
        const unsigned short* selq = sel + q * 256;
        bf16x8 qf0, qf1;
        {
            const bf16_t* qp = p.q() + (size_t)(row0 + q) * 512 + (kvh * 4 + (col & 3)) * 64 + g4 * 8;
            qf0 = *(const bf16x8*)qp; qf1 = *(const bf16x8*)(qp + 32);
            if (col >= 4) {
#pragma unroll
                for (int i = 0; i < 8; ++i) { qf0[i] = 0; qf1[i] = 0; }
            }
        }
        LAS unsigned char* vst = (LAS unsigned char*)lds + A_SC + wid * 16384;
        const bf16_t* vb = p.v() + (size_t)brow * 128 + kvh * 64 + (lane & 7) * 8;
        const unsigned rdbase = (unsigned)(uintptr_t)((LAS unsigned char*)lds + A_SC) + wid * 16384 + (4 * g4 + (col >> 2)) * 128 + (col & 3) * 8;
#define V_STAGE(s_, buf_) do { _Pragma("unroll") for (int i_ = 0; i_ < 4; ++i_) { \
            const int ksl_ = (s_) * 32 + i_ * 8 + (lane >> 3); const int key_ = selq[ksl_]; \
            __builtin_amdgcn_global_load_lds((const unsigned*)(vb + (size_t)key_ * 128), (LAS unsigned*)(vst + (buf_) * 4096 + i_ * 1024), 16, 0, 0); } } while (0)
        const bf16_t* kb = p.k() + (size_t)brow * 128 + kvh * 64 + g4 * 8;
        f32x4 lg[16];
        u32x4 vr[16];
        {
            bf16x8 k0[16], k1[16];
#pragma unroll
            for (int t = 0; t < 16; ++t) {
                const int key = selq[t * 16 + col];
                const bf16_t* kp = kb + (size_t)key * 128;
                k0[t] = *(const bf16x8*)kp; k1[t] = *(const bf16x8*)(kp + 32);
            }
#pragma unroll
            for (int s = 4; s < 8; ++s)
#pragma unroll
                for (int i = 0; i < 4; ++i) { const int key = selq[s * 32 + i * 8 + (lane >> 3)]; vr[(s - 4) * 4 + i] = *(const u32x4*)(vb + (size_t)key * 128); }
            V_STAGE(0, 0); V_STAGE(1, 1); V_STAGE(2, 2); V_STAGE(3, 3);
            __builtin_amdgcn_sched_barrier(0);
#pragma unroll
            for (int t = 0; t < 16; ++t) {
                f32x4 a = (f32x4){0.f, 0.f, 0.f, 0.f};
                a = __builtin_amdgcn_mfma_f32_16x16x32_bf16(k0[t], qf0, a, 0, 0, 0);
                a = __builtin_amdgcn_mfma_f32_16x16x32_bf16(k1[t], qf1, a, 0, 0, 0);
                lg[t] = a;
            }
            __builtin_amdgcn_sched_barrier(0);
        }
        float mx = -INFINITY;
#pragma unroll
        for (int t = 0; t < 16; ++t)
#pragma unroll
            for (int j = 0; j < 4; ++j) { if (t * 16 + g4 * 4 + j >= nsel) lg[t][j] = -INFINITY; mx = fmaxf(mx, lg[t][j]); }
        mx = fmaxf(mx, __shfl_xor(mx, 16)); mx = fmaxf(mx, __shfl_xor(mx, 32));
        float sm = 0.f;
#pragma unroll
        for (int t = 0; t < 16; ++t)
#pragma unroll
            for (int j = 0; j < 4; ++j) { const float e = __builtin_amdgcn_exp2f(lg[t][j] - mx); lg[t][j] = e; sm += e; }
        sm += __shfl_xor(sm, 16); sm += __shfl_xor(sm, 32);
        const float inv = 1.0f / sm;
        f32x4 o[4];
#pragma unroll
        for (int d = 0; d < 4; ++d) o[d] = (f32x4){0.f, 0.f, 0.f, 0.f};
        asm volatile("s_waitcnt vmcnt(0)" ::: "memory");
#pragma unroll
        for (int s = 0; s < 8; ++s) {
            if (s >= 4) {
#pragma unroll
                for (int i = 0; i < 4; ++i) *(LAS u32x4*)(vst + (s & 3) * 4096 + i * 1024 + lane * 16) = vr[(s - 4) * 4 + i];
                asm volatile("s_waitcnt lgkmcnt(0)" ::: "memory");
            }
            const unsigned rb = rdbase + (s & 3) * 4096;
            const s16x4 l0 = tr_read<0>(rb), h0 = tr_read<2048>(rb), l1 = tr_read<32>(rb), h1_ = tr_read<2048 + 32>(rb);
            const s16x4 l2 = tr_read<64>(rb), h2_ = tr_read<2048 + 64>(rb), l3 = tr_read<96>(rb), h3 = tr_read<2048 + 96>(rb);
            asm volatile("s_waitcnt lgkmcnt(0)" ::: "memory");
            __builtin_amdgcn_sched_barrier(0);
            bf16x8 pa;
            {
                const uint32_t w0 = pack2(lg[2 * s][0], lg[2 * s][1]), w1 = pack2(lg[2 * s][2], lg[2 * s][3]);
                const uint32_t w2 = pack2(lg[2 * s + 1][0], lg[2 * s + 1][1]), w3 = pack2(lg[2 * s + 1][2], lg[2 * s + 1][3]);
                pa[0] = (short)(w0 & 0xffff); pa[1] = (short)(w0 >> 16); pa[2] = (short)(w1 & 0xffff); pa[3] = (short)(w1 >> 16);
                pa[4] = (short)(w2 & 0xffff); pa[5] = (short)(w2 >> 16); pa[6] = (short)(w3 & 0xffff); pa[7] = (short)(w3 >> 16);
            }
#define PKV(L, H) (bf16x8){L[0], L[1], L[2], L[3], H[0], H[1], H[2], H[3]}
            o[0] = __builtin_amdgcn_mfma_f32_16x16x32_bf16(pa, PKV(l0, h0), o[0], 0, 0, 0);
            o[1] = __builtin_amdgcn_mfma_f32_16x16x32_bf16(pa, PKV(l1, h1_), o[1], 0, 0, 0);
            o[2] = __builtin_amdgcn_mfma_f32_16x16x32_bf16(pa, PKV(l2, h2_), o[2], 0, 0, 0);
            o[3] = __builtin_amdgcn_mfma_f32_16x16x32_bf16(pa, PKV(l3, h3), o[3], 0, 0, 0);
#undef PKV
        }
#undef V_STAGE
        const float i0 = __shfl(inv, 0), i1 = __shfl(inv, 1), i2 = __shfl(inv, 2), i3 = __shfl(inv, 3);
        if (g4 == 0) {
            bf16_t* op = p.att() + (size_t)(row0 + q) * 512 + kvh * 256 + col;
#pragma unroll
            for (int d = 0; d < 4; ++d) {
                op[0 * 64 + d * 16] = f2bf(o[d][0] * i0); op[1 * 64 + d * 16] = f2bf(o[d][1] * i1);
                op[2 * 64 + d * 16] = f2bf(o[d][2] * i2); op[3 * 64 + d * 16] = f2bf(o[d][3] * i3);
            }
        }
    }
    __syncthreads();
}

constexpr int NGRP = SEQ / 4, ATT_P1 = NGRP / 8, ATT_P2 = NGRP / 2;
template <int SUB>
__device__ __forceinline__ void ph_mixer(const P& p, unsigned char* lds) {
    int* bc = (int*)(lds + LDS_BYTES - 16);
    constexpr int nh = SUB == 1 ? 16 : NXU;
    constexpr int a0 = SUB == 0 ? 0 : (SUB == 1 ? ATT_P1 : ATT_P2), a1 = SUB == 0 ? ATT_P1 : (SUB == 1 ? ATT_P2 : NGRP);
    for (;;) {
        __syncthreads();
        if (tid_() == 0) bc[0] = atomicAdd(&p.ctr()[97 + SUB], 1);
        __syncthreads();
        const int it = bc[0];
        if (it >= nh) break;
        if (SUB == 0) hgx_unit(p, lds, it);
        else if (SUB == 1) hgchain_unit(p, it);
        else hgz_unit(p, lds, it);
    }
    const int b0 = (int)(xb_xcc_id() & 3u);
#pragma unroll 1
    for (int k = 0; k < 4; ++k) {
        const int b = (b0 + k) & 3;
        for (;;) {
            __syncthreads();
            if (tid_() == 0) bc[0] = atomicAdd(&p.ctr()[104 + SUB * 4 + b], 1);
            __syncthreads();
            const int it = bc[0];
            if (it >= a1 - a0) break;
            attn4_unit(p, lds, b, NGRP - 1 - (a0 + it));
        }
    }
}

__device__ __forceinline__ int tok_row(int tok) { return (tok >> 13) * LP + NMETA + (tok & 8191); }
__device__ __forceinline__ void ph_mix(const P& p, unsigned char* lds) {
    const int njobs = (NTOK / 256) * 4 * 2, G = gridDim.x, b0 = blockIdx.x;
    auto jobidx = [&](int i) __attribute__((always_inline)) { return (b0 + (i >> 1) * G) * 2 + (i & 1); };
    auto jobfn = [&](int i, GJob& j) __attribute__((always_inline)) -> bool {
        const int jb = jobidx(i); if (jb >= njobs) return false;
        const int which = jb & 1, u = jb >> 1, nt = u & 3, mt = u >> 2; const size_t r0 = (size_t)tok_row(mt * 256);
        j.A = (const char*)((which ? p.hgr() : p.att()) + r0 * 512); j.B = (const char*)((which ? p.wuhT() : p.wuaT()) + (size_t)nt * 256 * 512); return true; };
    auto epi = [&](f32x4 (&acc)[2][2][4][2], int i) __attribute__((always_inline)) {
        const int jb = jobidx(i), which = jb & 1, u = jb >> 1, nt = u & 3, mt = u >> 2; const size_t r0 = (size_t)tok_row(mt * 256);
        if (which == 0) {
            EPI8(
                const size_t og = (r0 + row) * 1024 + nt * 256 + col, om = (size_t)(mt * 256 + row) * 1024 + nt * 256 + col;
                const uint2 g = *(const uint2*)(p.ga() + og);
                f32x4 r;
                r[0] = v[0] * __uint_as_float(g.x << 16); r[1] = v[1] * __uint_as_float(g.x & 0xffff0000u);
                r[2] = v[2] * __uint_as_float(g.y << 16); r[3] = v[3] * __uint_as_float(g.y & 0xffff0000u);
                st_bf4(p.mix() + om, r);
            );
        } else {
            EPI8(
                const size_t og = (r0 + row) * 1024 + nt * 256 + col, om = (size_t)(mt * 256 + row) * 1024 + nt * 256 + col;
                const uint2 g = *(const uint2*)(p.gh() + og);
                const uint2 a = *(const uint2*)(p.mix() + om);
                f32x4 r;
                r[0] = __uint_as_float(a.x << 16) + v[0] * __uint_as_float(g.x << 16); r[1] = __uint_as_float(a.x & 0xffff0000u) + v[1] * __uint_as_float(g.x & 0xffff0000u);
                r[2] = __uint_as_float(a.y << 16) + v[2] * __uint_as_float(g.y << 16); r[3] = __uint_as_float(a.y & 0xffff0000u) + v[3] * __uint_as_float(g.y & 0xffff0000u);
                st_bf4(p.mix() + om, r);
            );
        }
    };
    unsigned vaU[2][2], vbU[2][2]; gj_lin(vaU, 512); gj_lin(vbU, 512);
    gemm_stream<false>(lds, 512, vaU, vbU, jobfn, epi);
}

__device__ __forceinline__ void ph_out(const P& p, unsigned char* lds) {
    const int nunits = (NTOK / 256) * 4, G = gridDim.x, b0 = blockIdx.x;
    auto jobfn = [&](int i, GJob& j) __attribute__((always_inline)) -> bool {
        const int u = b0 + i * G; if (u >= nunits) return false;
        const int nt = u & 3, mt = u >> 2;
        j.A = (const char*)(p.mix() + (size_t)mt * 256 * D); j.B = (const char*)(p.woT() + (size_t)nt * 256 * D); return true; };
    auto epi = [&](f32x4 (&acc)[2][2][4][2], int i) __attribute__((always_inline)) {
        const int u = b0 + i * G, nt = u & 3, mt = u >> 2;
        EPI8(
            const size_t o = (size_t)(mt * 256 + row) * D + nt * 256 + col;
            const f32x4 h0 = *(const f32x4*)(p.x + o);
            *(f32x4*)(p.out + o) = h0 + v;
        );
    };
    unsigned vaU[2][2], vbU[2][2]; gj_lin(vaU, D); gj_lin(vbU, D);
    gemm_stream<false>(lds, D, vaU, vbU, jobfn, epi);
}

constexpr int XS_LD = 1025;
__device__ __forceinline__ void ph_route(const P& p, unsigned char* lds) {
    const int tid = tid_(), lane = tid & 63, wid = __builtin_amdgcn_readfirstlane(tid >> 6);
    const int gt = blockIdx.x * NTHREADS + tid, ntot = gridDim.x * NTHREADS;
    for (int i = gt; i < CAP; i += ntot) p.slot_token()[i] = -1;
    float* xs = (float*)lds;
    int* lhist = (int*)(lds + 32 * XS_LD * 4);
    for (int tb = blockIdx.x; tb < NTOK / 128; tb += gridDim.x) {
        if (tid < 32) lhist[tid] = 0;
        for (int tile = 0; tile < 4; ++tile) {
            const int tokt = tb * 128 + tile * 32;
            __syncthreads();
#pragma unroll
            for (int t = 0; t < 4; ++t) {
                const int tl = wid * 4 + t, tok = tokt + tl;
                const float* src = p.out + (size_t)tok * D;
                f32x4 v[4]; float ss = 0.f;
#pragma unroll
                for (int i = 0; i < 4; ++i) { v[i] = *(const f32x4*)(src + lane * 4 + 256 * i); ss += v[i][0] * v[i][0] + v[i][1] * v[i][1] + v[i][2] * v[i][2] + v[i][3] * v[i][3]; }
                ss = wave_sum(ss);
                const float rs = rsqrtf(ss * (1.0f / D) + EPS);
#pragma unroll
                for (int i = 0; i < 4; ++i) {
                    const f32x4 g = *(const f32x4*)(p.ffn_g + lane * 4 + 256 * i);
                    f32x4 xn; xn[0] = v[i][0] * rs * g[0]; xn[1] = v[i][1] * rs * g[1]; xn[2] = v[i][2] * rs * g[2]; xn[3] = v[i][3] * rs * g[3];
                    st_bf4(p.xn2() + (size_t)tok * D + lane * 4 + 256 * i, xn);
#pragma unroll
                    for (int c = 0; c < 4; ++c) xs[tl * XS_LD + lane * 4 + 256 * i + c] = xn[c];
                }
            }
            __syncthreads();
            f32x16 acc;
#pragma unroll
            for (int i = 0; i < 16; ++i) acc[i] = 0.f;
            {
                const float* xr = xs + (lane & 31) * XS_LD + wid * 128 + (lane >> 5);
                const float* wp = p.router_w + (size_t)(wid * 128 + (lane >> 5)) * 32 + (lane & 31);
#pragma unroll 16
                for (int i = 0; i < 64; ++i) acc = __builtin_amdgcn_mfma_f32_32x32x2f32(xr[2 * i], wp[(size_t)(2 * i) * 32], acc, 0, 0, 0);
            }
            __syncthreads();
#pragma unroll
            for (int r = 0; r < 16; ++r) xs[wid * 1024 + ((r & 3) + 8 * (r >> 2) + 4 * (lane >> 5)) * 32 + (lane & 31)] = acc[r];
            __syncthreads();
            const int e = lane & 31, hh = lane >> 5;
            const float be = p.router_b[e];
#pragma unroll
            for (int it = 0; it < 2; ++it) {
                const int tl = wid * 4 + it * 2 + hh;
                float l = be;
#pragma unroll
                for (int w = 0; w < 8; ++w) l += xs[w * 1024 + tl * 32 + e];
                float bv[4]; int bi[4];
#pragma unroll
                for (int k = 0; k < 4; ++k) {
                    float m = l;
#pragma unroll
                    for (int o = 16; o >= 1; o >>= 1) m = fmaxf(m, __shfl_xor(m, o));
                    const unsigned long long bal = __ballot(l == m);
                    const unsigned half = hh ? (unsigned)(bal >> 32) : (unsigned)bal;
                    const int idx = __builtin_ctz(half);
                    bv[k] = m; bi[k] = idx;
                    if (e == idx) l = -INFINITY;
                }
                const float e1 = __expf(bv[1] - bv[0]), e2 = __expf(bv[2] - bv[0]), e3 = __expf(bv[3] - bv[0]);
                const float inv = 1.0f / (1.0f + e1 + e2 + e3);
                if (e == 0) {
                    const int tok = tokt + tl;
                    p.tok_exp()[tok * 4 + 0] = bi[0]; p.tok_exp()[tok * 4 + 1] = bi[1]; p.tok_exp()[tok * 4 + 2] = bi[2]; p.tok_exp()[tok * 4 + 3] = bi[3];
                    p.tok_gate()[tok * 4 + 0] = inv; p.tok_gate()[tok * 4 + 1] = e1 * inv; p.tok_gate()[tok * 4 + 2] = e2 * inv; p.tok_gate()[tok * 4 + 3] = e3 * inv;
                    atomicAdd(&lhist[bi[0]], 1); atomicAdd(&lhist[bi[1]], 1); atomicAdd(&lhist[bi[2]], 1); atomicAdd(&lhist[bi[3]], 1);
                }
            }
        }
        __syncthreads();
        if (tid < 32) p.wg_cnt()[tb * 32 + tid] = lhist[tid];
        __syncthreads();
    }
    for (long task = gt; task < 96L * 16384; task += ntot) {
        const int mat = (int)(task >> 14), r = (int)(task & 16383), kq = r >> 10, n = r & 1023;
        const int which = mat >> 5, e = mat & 31;
        const float* W = (which == 0 ? p.w_gate : which == 1 ? p.w_up : p.w_down) + (size_t)e * 1048576 + (size_t)(kq * 64) * 1024 + n;
        bf16_t* outp = (which == 0 ? p.wgT() : which == 1 ? p.wuT() : p.wdT()) + (size_t)e * 1048576 + (size_t)n * 1024 + kq * 64;
        float v[64];
#pragma unroll
        for (int i = 0; i < 64; ++i) v[i] = W[(size_t)i * 1024];
        uint4* dst = (uint4*)outp;
#pragma unroll
        for (int i = 0; i < 8; ++i) dst[i] = make_uint4(pack2(v[8 * i], v[8 * i + 1]), pack2(v[8 * i + 2], v[8 * i + 3]), pack2(v[8 * i + 4], v[8 * i + 5]), pack2(v[8 * i + 6], v[8 * i + 7]));
    }
}

__device__ __forceinline__ void ph_fill(const P& p, unsigned char* lds) {
    const int tid = tid_();
    int* tot = (int*)lds;
    int* pre = tot + 512;
    int* ps = pre + 512;
    int* lc = ps + 32;
    for (int tb = blockIdx.x; tb < NTOK / 128; tb += gridDim.x) {
        {
            const int e = tid & 31, part = tid >> 5;
            int t = 0, q = 0;
            for (int b2 = part; b2 < NTOK / 128; b2 += 16) { const int c = p.wg_cnt()[b2 * 32 + e]; t += c; if (b2 < tb) q += c; }
            tot[part * 32 + e] = t; pre[part * 32 + e] = q;
        }
        __syncthreads();
        if (tid == 0) {
            int acc = 0;
            for (int e = 0; e < NE; ++e) {
                int t = 0, q = 0;
                for (int i = 0; i < 16; ++i) { t += tot[i * 32 + e]; q += pre[i * 32 + e]; }
                ps[e] = acc + q; lc[e] = 0;
                const int nb = (t + 255) >> 8;
                if (tb == 0) for (int i = 0; i < nb; ++i) p.block_expert()[(acc >> 8) + i] = e;
                acc += nb * 256;
            }
            if (tb == 0) p.ctr()[96] = acc >> 8;
        }
        __syncthreads();
        {
            const int i = tb * 512 + tid;
            const int e = p.tok_exp()[i];
            const int dest = ps[e] + atomicAdd(&lc[e], 1);
            p.slot_token()[dest] = i >> 2;
            p.slot_rank()[dest] = i & 3;
            p.slot_gate()[dest] = p.tok_gate()[i];
        }
        __syncthreads();
    }
}

struct GUOff { __device__ __forceinline__ size_t operator()(int R) const { return (size_t)(R >> 7) * (WE_B / 2) + (size_t)(R & 127) * 1024; } };
struct GatherOff { const int* st; __device__ __forceinline__ size_t operator()(int R) const { const int t = st[R]; return (size_t)(t < 0 ? 0 : t) * 1024; } };
__device__ __forceinline__ void ph_moe1(const P& p, unsigned char* lds) {
    const int nunits = p.ctr()[96] * 8, G = gridDim.x, b0 = blockIdx.x;
    auto jobfn = [&](int i, GJob& j) __attribute__((always_inline)) -> bool {
        const int u = b0 + i * G; if (u >= nunits) return false;
        const int ct = u & 7, rb = u >> 3, e = p.block_expert()[rb];
        j.A = (const char*)p.xn2(); j.B = (const char*)(p.wgT() + (size_t)e * 1048576 + (size_t)ct * 128 * 1024); gj_gather_job(j, GatherOff{p.slot_token() + rb * 256}); return true; };
    auto epi = [&](f32x4 (&acc)[2][2][4][2], int i) __attribute__((always_inline)) {
        const int u = b0 + i * G, ct = u & 7, rb = u >> 3, e = p.block_expert()[rb];
        const int tid_e = tid_(), lane_e = tid_e & 63, wid_e = tid_e >> 6, wr = wid_e >> 2, wc = wid_e & 3, fr = lane_e & 15, fq = lane_e >> 4;
#pragma unroll
        for (int n = 0; n < 2; ++n) {
            const int c = ct * 128 + wc * 32 + n * 16 + fq * 4;
            const f32x4 bg = *(const f32x4*)(p.b_gate + (size_t)e * DFF + c), bu = *(const f32x4*)(p.b_up + (size_t)e * DFF + c);
#pragma unroll
            for (int ai = 0; ai < 2; ++ai)
#pragma unroll
                for (int m = 0; m < 4; ++m) {
                    const int row = rb * 256 + ai * 128 + wr * 64 + m * 16 + fr;
                    f32x4 a;
#pragma unroll
                    for (int j = 0; j < 4; ++j) {
                        const float g = fminf(acc[ai][0][m][n][j] + bg[j], 7.0f);
                        const float uu = fminf(fmaxf(acc[ai][1][m][n][j] + bu[j], -7.0f), 7.0f);
                        a[j] = (uu + 1.0f) * (g * sigmoidf_(1.702f * g));
                    }
                    st_bf4(p.act() + (size_t)row * DFF + c, a);
                }
        }
    };
    unsigned vaU[2][2], vbU[2][2]; gj_lin(vaU, D); gj_gather(vbU, GUOff{});
    gemm_stream<true>(lds, D, vaU, vbU, jobfn, epi);
}
__device__ __forceinline__ void ph_moe2(const P& p, unsigned char* lds) {
    const int nunits = p.ctr()[96] * 4, G = gridDim.x, b0 = blockIdx.x;
    auto jobfn = [&](int i, GJob& j) __attribute__((always_inline)) -> bool {
        const int u = b0 + i * G; if (u >= nunits) return false;
        const int nt = u & 3, rb = u >> 2, e = p.block_expert()[rb];
        j.A = (const char*)(p.act() + (size_t)rb * 256 * DFF); j.B = (const char*)(p.wdT() + (size_t)e * 1048576 + (size_t)nt * 256 * DFF); return true; };
    auto epi = [&](f32x4 (&acc)[2][2][4][2], int i) __attribute__((always_inline)) {
        const int u = b0 + i * G, nt = u & 3, rb = u >> 2, e = p.block_expert()[rb];
        const int tid_e = tid_(), lane_e = tid_e & 63, wid_e = tid_e >> 6, wr = wid_e >> 2, wc = wid_e & 3, fr = lane_e & 15, fq = lane_e >> 4;
        f32x4 bd[2][2];
#pragma unroll
        for (int bj = 0; bj < 2; ++bj)
#pragma unroll
            for (int n = 0; n < 2; ++n) bd[bj][n] = *(const f32x4*)(p.b_down + (size_t)e * D + nt * 256 + bj * 128 + wc * 32 + n * 16 + fq * 4);
#pragma unroll
        for (int ai = 0; ai < 2; ++ai)
#pragma unroll
            for (int m = 0; m < 4; ++m) {
                const int slot = rb * 256 + ai * 128 + wr * 64 + m * 16 + fr;
                const int tok = p.slot_token()[slot];
                if (tok < 0) continue;
                const int rank = p.slot_rank()[slot]; const float gate = p.slot_gate()[slot];
                const size_t o = (size_t)tok * D + nt * 256 + wc * 32 + fq * 4;
                if (rank == 0) {
#pragma unroll
                    for (int bj = 0; bj < 2; ++bj)
#pragma unroll
                        for (int n = 0; n < 2; ++n) { float* d = p.out + o + bj * 128 + n * 16; *(f32x4*)d = *(const f32x4*)d + (acc[ai][bj][m][n] + bd[bj][n]) * gate; }
                } else {
                    bf16_t* yb = rank == 1 ? p.y1() : (rank == 2 ? p.y2() : p.y3());
#pragma unroll
                    for (int bj = 0; bj < 2; ++bj)
#pragma unroll
                        for (int n = 0; n < 2; ++n) st_bf4(yb + o + bj * 128 + n * 16, (acc[ai][bj][m][n] + bd[bj][n]) * gate);
                }
            }
    };
    unsigned vaU[2][2], vbU[2][2]; gj_lin(vaU, DFF); gj_lin(vbU, DFF);
    gemm_stream<false>(lds, DFF, vaU, vbU, jobfn, epi);
}

__device__ __forceinline__ void ph_final(const P& p, unsigned char* lds) {
    const int tid = tid_(), lane = tid & 63, wid = tid >> 6;
    const int gw = blockIdx.x * 8 + wid, nw = gridDim.x * 8;
    for (int tok = gw; tok < NTOK; tok += nw) {
        float* dst = p.out + (size_t)tok * D;
        f32x4 v[4];
#pragma unroll
        for (int i = 0; i < 4; ++i) v[i] = *(const f32x4*)(dst + lane * 4 + 256 * i);
#pragma unroll
        for (int j = 0; j < 3; ++j) {
            const bf16_t* yr = (j == 0 ? p.y1() : j == 1 ? p.y2() : p.y3()) + (size_t)tok * D;
#pragma unroll
            for (int i = 0; i < 4; ++i) {
                const uint2 w = *(const uint2*)(yr + lane * 4 + 256 * i);
                v[i][0] += __uint_as_float(w.x << 16); v[i][1] += __uint_as_float(w.x & 0xffff0000u);
                v[i][2] += __uint_as_float(w.y << 16); v[i][3] += __uint_as_float(w.y & 0xffff0000u);
            }
        }
        float ss = 0.f;
#pragma unroll
        for (int i = 0; i < 4; ++i) ss += v[i][0] * v[i][0] + v[i][1] * v[i][1] + v[i][2] * v[i][2] + v[i][3] * v[i][3];
        ss = wave_sum(ss);
        const float rs = rsqrtf(ss * (1.0f / D) + EPS);
#pragma unroll
        for (int i = 0; i < 4; ++i) {
            const f32x4 g = *(const f32x4*)(p.final_g + lane * 4 + 256 * i);
            *(f32x4*)(dst + lane * 4 + 256 * i) = v[i] * rs * g;
        }
    }
}

__global__ void __launch_bounds__(NTHREADS) k_mega(P p) {
    __shared__ __attribute__((aligned(16))) unsigned char lds[LDS_BYTES];
    cg::grid_group grid = cg::this_grid();
    if (tid_() < 4) ((unsigned*)(lds + LDS_BYTES - 32))[tid_()] = 0u;
    __syncthreads();
    const XcdBarrier xb = xcd_barrier_post((unsigned*)(p.ws + OFF_BAR), (volatile LAS unsigned*)(lds + LDS_BYTES - 32));
    ph_prep(p, lds); grid.sync();
    ph_inproj(p, lds); xcd_barrier(xb);
    ph_mixer<0>(p, lds); xcd_barrier(xb);
    ph_mixer<1>(p, lds); xcd_barrier(xb);
    ph_mixer<2>(p, lds); xcd_barrier(xb);
    ph_mix(p, lds); xcd_barrier(xb);
    ph_out(p, lds); xcd_barrier(xb);
    ph_route(p, lds); xcd_barrier(xb);
    ph_fill(p, lds); xcd_barrier(xb);
    ph_moe1(p, lds); xcd_barrier(xb);
    ph_moe2(p, lds); xcd_barrier(xb);
    ph_final(p, lds);
}

extern "C" void kernel_launch(void* const* d_in, const int* in_sizes, int n_in, void* d_out, int out_size, void* d_ws, size_t ws_size,
                              hipStream_t stream) {
    P p{};
    p.x = (const float*)d_in[0]; p.meta = (const float*)d_in[1]; p.attn_g = (const float*)d_in[2]; p.w_in = (const float*)d_in[3];
    p.hgrn_g = (const float*)d_in[4]; p.w_ua = (const float*)d_in[5]; p.w_uh = (const float*)d_in[6]; p.w_out = (const float*)d_in[7];
    p.lb_logits = (const float*)d_in[8]; p.ffn_g = (const float*)d_in[9]; p.router_w = (const float*)d_in[10]; p.router_b = (const float*)d_in[11];
    p.w_gate = (const float*)d_in[12]; p.b_gate = (const float*)d_in[13]; p.w_up = (const float*)d_in[14]; p.b_up = (const float*)d_in[15];
    p.w_down = (const float*)d_in[16]; p.b_down = (const float*)d_in[17]; p.final_g = (const float*)d_in[18];
    p.out = (float*)d_out;
    p.ws = (unsigned char*)d_ws;
    if (WS_NEED > ws_size) { fprintf(stderr, "workspace too small: need %zu have %zu\n", (size_t)WS_NEED, ws_size); return; }
    static int grid_blocks = 0;
    if (!grid_blocks) {
        int dev = 0, cus = 0, per_cu = 0;
        hipGetDevice(&dev);
        hipDeviceGetAttribute(&cus, hipDeviceAttributeMultiprocessorCount, dev);
        hipOccupancyMaxActiveBlocksPerMultiprocessor(&per_cu, k_mega, NTHREADS, 0);
        if (per_cu > 1) per_cu = 1;
        grid_blocks = cus * per_cu;
    }
    hipMemsetAsync(p.ws + OFF_BAR, 0, XCD_BAR_WORDS * 4, stream);
    void* args[] = {&p};
    hipError_t e = hipLaunchCooperativeKernel((void*)k_mega, dim3(grid_blocks), dim3(NTHREADS), args, 0, stream);
    if (e != hipSuccess) fprintf(stderr, "cooperative launch failed: %s (grid %d)\n", hipGetErrorString(e), grid_blocks);
}
```

```cpp
#include <hip/hip_runtime.h>
#include <hip/hip_cooperative_groups.h>
#include <stdint.h>
#include <cstdio>
namespace cg = cooperative_groups;

#ifndef MEGA
#define MEGA 1
#endif

typedef unsigned short bf16_t;
typedef short bf16x8 __attribute__((ext_vector_type(8)));
typedef float f32x4 __attribute__((ext_vector_type(4)));

constexpr int D = 1024, NB = 4, SEQ = 8192, NMETA = 16, L = SEQ + NMETA  , LP = 8320, T = NB * LP  ;
constexpr int NTOK = NB * SEQ;
constexpr int IN_COLS = 5160;
constexpr int NE = 32, TOPK = 4, DFF = 1024;
constexpr int CAP_BLOCKS = (NTOK * TOPK) / 256 + NE;
constexpr int CAP = CAP_BLOCKS * 256;
constexpr float EPS = 1e-5f;
constexpr int NTHREADS = 512;
constexpr int LDS_BYTES = 155648;
constexpr int NVC = 5376;
#define LAS __attribute__((address_space(3)))

__device__ __forceinline__ bf16_t f2bf(float f) {
    uint32_t u = __float_as_uint(f);
    u += 0x7fffu + ((u >> 16) & 1u);
    return (bf16_t)(u >> 16);
}
__device__ __forceinline__ float bf2f(bf16_t h) { return __uint_as_float(((uint32_t)h) << 16); }
__device__ __forceinline__ uint32_t pack2(float a, float b) { return (uint32_t)f2bf(a) | ((uint32_t)f2bf(b) << 16); }
__device__ __forceinline__ float sigmoidf_(float x) { return __builtin_amdgcn_rcpf(1.0f + __builtin_amdgcn_exp2f(-1.4426950408889634f * x)); }
__device__ __forceinline__ float wave_sum(float v) {
#pragma unroll
    for (int o = 32; o >= 1; o >>= 1) v += __shfl_xor(v, o);
    return v;
}
__device__ __forceinline__ float wave_max(float v) {
#pragma unroll
    for (int o = 32; o >= 1; o >>= 1) v = fmaxf(v, __shfl_xor(v, o));
    return v;
}

constexpr size_t al256(size_t x) { return (x + 255) & ~(size_t)255; }
constexpr size_t TT = (size_t)T;
constexpr size_t MB1 = 1024 * 1024;
constexpr size_t WE_B = (size_t)NE * 1024 * 1024 * 2;
constexpr size_t OFF_WGT = 0, OFF_WUT = WE_B, OFF_WDT = 2 * WE_B, OFF_XN2 = 3 * WE_B, OFF_ACT = OFF_XN2 + (size_t)NTOK * D * 2,
                 OFF_TAB = OFF_ACT + (size_t)CAP * DFF * 2;
constexpr size_t OFF_Y1 = OFF_XN2, OFF_Y2 = OFF_WGT, OFF_Y3 = OFF_WUT;
constexpr size_t OFF_ROPE = OFF_TAB, OFF_LB = OFF_ROPE + al256((size_t)LP * 24 * 4), OFF_CTR = OFF_LB + al256(512 * 4),
                 OFF_BEXP = OFF_CTR + al256(128 * 4), OFF_SLOT = OFF_BEXP + al256((size_t)CAP_BLOCKS * 4), OFF_SRANK = OFF_SLOT + al256((size_t)CAP * 4),
                 OFF_SGATE = OFF_SRANK + al256((size_t)CAP * 4), OFF_TEXP = OFF_SGATE + al256((size_t)CAP * 4), OFF_TGATE = OFF_TEXP + al256((size_t)NTOK * 16),
                 OFF_BAR = OFF_TGATE + al256((size_t)NTOK * 16), OFF_WGC = OFF_BAR + al256(3456 * 4), WS_NEED = OFF_WGC + al256(256 * 32 * 4);
constexpr size_t OFF_WIN = 0, OFF_WUA = OFF_WIN + (size_t)NVC * 1024 * 2, OFF_WUH = OFF_WUA + MB1, OFF_WO = OFF_WUH + MB1, OFF_XN = OFF_WO + 2 * MB1,
                 OFF_Q = OFF_XN + TT * 2048, OFF_K = OFF_Q + TT * 1024, OFF_V = OFF_K + TT * 256, OFF_IQ = OFF_V + TT * 256, OFF_IK = OFF_IQ + TT * 512,
                 OFF_IW = OFF_IK + TT * 64, OFF_HQ = OFF_IW + TT * 32, OFF_HF = OFF_HQ + TT * 1024, OFF_HI = OFF_HF + TT * 1024, OFF_HG = OFF_HI + TT * 1024,
                 OFF_GA = OFF_HG + TT * 1024, OFF_GH = OFF_GA + TT * 2048, OFF_ATT = OFF_GH + TT * 2048, OFF_HGR = OFF_ATT + TT * 1024,
                 OFF_S1_END = OFF_HGR + TT * 1024;
constexpr size_t OFF_MIX = OFF_XN;
static_assert(OFF_S1_END <= OFF_TAB, "stage-1 layout overflows");

__device__ __forceinline__ int tid_() { int t = threadIdx.x; asm volatile("" : "+v"(t)); return t; }

struct P {
    const float *x, *meta, *attn_g, *w_in, *hgrn_g, *w_ua, *w_uh, *w_out, *lb_logits, *ffn_g, *router_w, *router_b,
        *w_gate, *b_gate, *w_up, *b_up, *w_down, *b_down, *final_g;
    float* out;
    unsigned char* ws;
#define WSF(type, name, off) __device__ __forceinline__ type* name() const { return (type*)(ws + (off)); }
    WSF(bf16_t, xn, OFF_XN) WSF(bf16_t, q, OFF_Q) WSF(bf16_t, k, OFF_K) WSF(bf16_t, v, OFF_V) WSF(bf16_t, iq, OFF_IQ) WSF(bf16_t, ik, OFF_IK)
    WSF(bf16_t, hq, OFF_HQ) WSF(bf16_t, hf, OFF_HF) WSF(bf16_t, hi, OFF_HI) WSF(bf16_t, hg, OFF_HG) WSF(bf16_t, ga, OFF_GA) WSF(bf16_t, gh, OFF_GH)
    WSF(bf16_t, att, OFF_ATT) WSF(bf16_t, hgr, OFF_HGR) WSF(bf16_t, mix, OFF_MIX) WSF(bf16_t, xn2, OFF_XN2) WSF(bf16_t, act, OFF_ACT)
    WSF(bf16_t, y1, OFF_Y1) WSF(bf16_t, y2, OFF_Y2) WSF(bf16_t, y3, OFF_Y3)
    WSF(bf16_t, winT, OFF_WIN) WSF(bf16_t, wuaT, OFF_WUA) WSF(bf16_t, wuhT, OFF_WUH) WSF(bf16_t, woT, OFF_WO)
    WSF(bf16_t, wgT, OFF_WGT) WSF(bf16_t, wuT, OFF_WUT) WSF(bf16_t, wdT, OFF_WDT)
    WSF(float, iw, OFF_IW) WSF(float, rope, OFF_ROPE) WSF(float, lb, OFF_LB) WSF(float, tok_gate, OFF_TGATE) WSF(float, slot_gate, OFF_SGATE)
    WSF(int, ctr, OFF_CTR)
    WSF(int, wg_cnt, OFF_WGC) WSF(int, block_expert, OFF_BEXP) WSF(int, slot_token, OFF_SLOT) WSF(int, slot_rank, OFF_SRANK) WSF(int, tok_exp, OFF_TEXP)
};

template <class ColMap>
__device__ __forceinline__ void convert_T(const float* W, int ldw, bf16_t* out, int K, int N, const ColMap& cmap, int gt, int ntot) {
    const int kb = K / 64; const long ntask = (long)N * kb;
    for (long task = gt; task < ntask; task += ntot) {
        const int kq = (int)(task / N), n = (int)(task % N);
        const int c = cmap(n);
        uint32_t w[32];
        if (c >= 0) {
            const float* src = W + (size_t)(kq * 64) * ldw + c;
            float v[64];
#pragma unroll
            for (int i = 0; i < 64; ++i) v[i] = src[(size_t)i * ldw];
#pragma unroll
            for (int i = 0; i < 32; ++i) w[i] = pack2(v[2 * i], v[2 * i + 1]);
        } else {
#pragma unroll
            for (int i = 0; i < 32; ++i) w[i] = 0u;
        }
        uint4* dst = (uint4*)(out + (size_t)n * K + kq * 64);
#pragma unroll
        for (int i = 0; i < 8; ++i) dst[i] = make_uint4(w[4 * i], w[4 * i + 1], w[4 * i + 2], w[4 * i + 3]);
    }
}
struct IdMap { __device__ __forceinline__ int operator()(int n) const { return n; } };
struct WinMap { __device__ __forceinline__ int operator()(int n) const { return n < 1064 ? n : (n < 1280 ? -1 : n - 216); } };

#define XB_TMO      128
#define XB_XCNT(j)  (256  + 64 * (j))
#define XB_XSUB(j)  (1280 + 64 * (j))
#define XB_XGEN(j)  (2304 + 64 * (j))
#define XB_TOP      3328
#define XB_TOPGEN   3392
#define XCD_BAR_WORDS 3456
#define XB_SPIN_CAP (1u << 22)
__device__ __forceinline__ unsigned xb_ld(unsigned* p)              { return __hip_atomic_load(p, __ATOMIC_RELAXED, __HIP_MEMORY_SCOPE_AGENT); }
__device__ __forceinline__ unsigned xb_add(unsigned* p, unsigned v) { return __hip_atomic_fetch_add(p, v, __ATOMIC_RELAXED, __HIP_MEMORY_SCOPE_AGENT); }
__device__ __forceinline__ unsigned xb_xcc_id() { return (unsigned)__builtin_amdgcn_s_getreg((3 << 11) | 20) & 0xFu; }
#define XB_SPIN(cond, bar) do { unsigned _sp = 0; while (cond) { __builtin_amdgcn_s_sleep(1); \
    if ((++_sp & 255u) == 0u) { if (xb_ld(&(bar)[XB_TMO])) break; if (_sp > XB_SPIN_CAP) { atomicAdd(&(bar)[XB_TMO], 1u); break; } } } } while (0)
struct XcdBarrier { unsigned* bar; unsigned x; volatile LAS unsigned* st; };
__device__ __forceinline__ XcdBarrier xcd_barrier_post(unsigned* bar, volatile LAS unsigned* st) {
    XcdBarrier b; b.bar = bar; b.x = xb_xcc_id(); b.st = st;
    if (threadIdx.x == 0) (void)xb_add(&bar[XB_XCNT(b.x)], 1u);
    return b;
}
__device__ __forceinline__ void xcd_barrier_complete(unsigned* bar, unsigned x, unsigned& nloc, unsigned& nx) {
    const unsigned G = gridDim.x * gridDim.y * gridDim.z;
    unsigned sum, cnt, mine, sp = 0u;
    for (;;) {
        sum = 0u; cnt = 0u; mine = 0u;
#pragma unroll
        for (unsigned j = 0; j < 16; ++j) { const unsigned c = xb_ld(&bar[XB_XCNT(j)]); sum += c; cnt += (c > 0u) ? 1u : 0u; mine = (j == x) ? c : mine; }
        if (sum == G) break;
        __builtin_amdgcn_s_sleep(1);
        if ((++sp & 255u) == 0u) { if (xb_ld(&bar[XB_TMO])) break; if (sp > XB_SPIN_CAP) { atomicAdd(&bar[XB_TMO], 1u); break; } }
    }
    nloc = mine > 0u ? mine : 1u; nx = cnt > 0u ? cnt : 1u;
}
__device__ __forceinline__ void xcd_barrier(const XcdBarrier& b) {
    asm volatile("s_waitcnt vmcnt(0)" ::: "memory");
    __syncthreads();
    if (threadIdx.x == 0) {
        unsigned* bar = b.bar;
        __builtin_amdgcn_s_waitcnt(0);
        unsigned nloc = b.st[0], nx = b.st[1];
        if (nloc == 0u) { xcd_barrier_complete(bar, b.x, nloc, nx); b.st[0] = nloc; b.st[1] = nx; }
        const unsigned old = xb_add(&bar[XB_XSUB(b.x)], 1u);
        const unsigned gen = old / nloc;
        if (old + 1u == (gen + 1u) * nloc) {
            __builtin_amdgcn_fence(__ATOMIC_RELEASE, "agent");
            asm volatile("s_waitcnt vmcnt(0)" ::: "memory");
            const unsigned og = xb_add(&bar[XB_TOP], 1u);
            const unsigned tg = og / nx;
            if (og + 1u == (tg + 1u) * nx) xb_add(&bar[XB_TOPGEN], 1u);
            else XB_SPIN(xb_ld(&bar[XB_TOPGEN]) == tg, bar);
            __builtin_amdgcn_fence(__ATOMIC_ACQUIRE, "agent");
            xb_add(&bar[XB_XGEN(b.x)], 1u);
            asm volatile("s_waitcnt vmcnt(0)" ::: "memory");
        } else {
            XB_SPIN(xb_ld(&bar[XB_XGEN(b.x)]) == gen, bar);
            __builtin_amdgcn_fence(__ATOMIC_ACQUIRE, "agent");
            asm volatile("s_waitcnt vmcnt(0)" ::: "memory");
        }
    }
    __syncthreads();
}

__device__ __forceinline__ void ph_prep(const P& p, unsigned char* lds) {
    const int tid = tid_(), lane = tid & 63, wid = tid >> 6;
    const int gw = blockIdx.x * 8 + wid, nw = gridDim.x * 8;
    for (int r = gw; r < T; r += nw) {
        const int b = r / LP, pos = r % LP;
        bf16_t* dst = p.xn() + (size_t)r * D;
        if (pos >= L) {
#pragma unroll
            for (int i = 0; i < 4; ++i) *(uint2*)(dst + lane * 4 + 256 * i) = make_uint2(0u, 0u);
            continue;
        }
        const float* src = pos < NMETA ? p.meta + (size_t)pos * D : p.x + ((size_t)b * SEQ + (pos - NMETA)) * D;
        f32x4 v[4]; float ss = 0.f;
#pragma unroll
        for (int i = 0; i < 4; ++i) { v[i] = *(const f32x4*)(src + lane * 4 + 256 * i); ss += v[i][0] * v[i][0] + v[i][1] * v[i][1] + v[i][2] * v[i][2] + v[i][3] * v[i][3]; }
        ss = wave_sum(ss);
        const float rs = rsqrtf(ss * (1.0f / D) + EPS);
#pragma unroll
        for (int i = 0; i < 4; ++i) {
            const f32x4 g = *(const f32x4*)(p.attn_g + lane * 4 + 256 * i);
            uint2 o; o.x = pack2(v[i][0] * rs * g[0], v[i][1] * rs * g[1]); o.y = pack2(v[i][2] * rs * g[2], v[i][3] * rs * g[3]);
            *(uint2*)(dst + lane * 4 + 256 * i) = o;
        }
    }
    const int gt = blockIdx.x * NTHREADS + tid, nt = gridDim.x * NTHREADS;
    for (int i = gt; i < LP * 12; i += nt) {
        const int pos = i / 12, f = i % 12;
        const double ex = f < 8 ? -(double)f / 8.0 : -(double)(f - 8) / 4.0;
        const double inv = exp(ex * log(500000.0));
        const double ang = (double)pos * inv;
        const double twopi = 6.283185307179586476925286766559;
        const double r = ang - twopi * rint(ang / twopi);
        const float rf = (float)r;
        const float c = cosf(rf), s = sinf(rf);
        float* row = p.rope() + (size_t)pos * 24;
        if (f < 8) { row[f] = c; row[8 + f] = s; } else { row[16 + f - 8] = c; row[20 + f - 8] = s; }
    }
    for (int i = gt; i < 512; i += nt) {
        const float a = p.lb_logits[i], b2 = p.lb_logits[512 + i];
        p.lb()[i] = 1.0f / (1.0f + expf(b2 - a));
    }
    for (int i = gt; i < 128; i += nt) p.ctr()[i] = 0;
    convert_T(p.w_in, IN_COLS, p.winT(), 1024, NVC, WinMap{}, gt, nt);
    convert_T(p.w_ua, 1024, p.wuaT(), 512, 1024, IdMap{}, gt, nt);
    convert_T(p.w_uh, 1024, p.wuhT(), 512, 1024, IdMap{}, gt, nt);
    convert_T(p.w_out, 1024, p.woT(), 1024, 1024, IdMap{}, gt, nt);
}
constexpr int G_TILE_B = 256 * 64 * 2, G_STAGE_B = 2 * G_TILE_B;
__device__ __forceinline__ int g_lds_byte(int r, int c) { const int st = (r >> 4) * 2 + (c >> 5), ob = (r & 15) * 64 + (c & 31) * 2; return st * 1024 + (ob ^ (((ob >> 9) & 1) << 5)); }
__device__ __forceinline__ void g_stage_rc(int b, int& R, int& C) { const int st = b >> 10, sb = b & 1023, swz = sb ^ (((sb >> 9) & 1) << 5); R = (st >> 1) * 16 + swz / 64; C = (st & 1) * 32 + (swz % 64) / 2; }

constexpr int HTB = 128 * 64 * 2;
struct GJob { const char* A; const char* B; unsigned va00, va01, va10, va11; };
__device__ __forceinline__ void gj_lin(unsigned (&v)[2][2], int ld) {
#pragma unroll
    for (int h = 0; h < 2; ++h)
#pragma unroll
        for (int i = 0; i < 2; ++i) { int R, C; g_stage_rc(tid_() * 16 + i * 8192, R, C); v[h][i] = (unsigned)(((h * 128 + R) * ld + C) * 2); }
}
template <class AOff>
__device__ __forceinline__ void gj_gather(unsigned (&v)[2][2], const AOff& aoff) {
#pragma unroll
    for (int h = 0; h < 2; ++h)
#pragma unroll
        for (int i = 0; i < 2; ++i) { int R, C; g_stage_rc(tid_() * 16 + i * 8192, R, C); v[h][i] = (unsigned)((aoff(h * 128 + R) + C) * 2); }
}
template <class AOff>
__device__ __forceinline__ void gj_gather_job(GJob& j, const AOff& aoff) {
    unsigned v[2][2]; gj_gather(v, aoff); j.va00 = v[0][0]; j.va01 = v[0][1]; j.va10 = v[1][0]; j.va11 = v[1][1];
}
template <bool GATHER, class JobFn, class Epi>
__device__ __forceinline__ void gemm_stream(unsigned char* lds_, int K, int lda, size_t hstepB, const unsigned (&vbU)[2], const JobFn& jobfn, const Epi& epi) {
    LAS unsigned char* lds = (LAS unsigned char*)lds_;
    const int tid = tid_(), wid = __builtin_amdgcn_readfirstlane(tid >> 6), lane = tid & 63, wr = wid >> 2, wc = wid & 3, fr = lane & 15, fq = lane >> 4;
    const int nt = K / 64;
    const size_t kstep = 128;
    const size_t hstepA = GATHER ? 0 : (size_t)128 * lda * 2;
    const unsigned ldsw = (unsigned)wid * 1024u;
    const int aoff = g_lds_byte(wr * 64 + fr, fq * 8), boff = g_lds_byte(wc * 32 + fr, fq * 8);
    unsigned vaU[2];
#pragma unroll
    for (int i = 0; i < 2; ++i) { int R, C; g_stage_rc(tid * 16 + i * 8192, R, C); vaU[i] = (unsigned)((R * lda + C) * 2); }
#define PG8_SA(b, h) (((b) * 2 + (h)) * HTB)
#define PG8_SB(b, h) ((4 + (b) * 2 + (h)) * HTB)
#define PG8_STAGE2(bufoff, gbase, v0, v1) do { \
        __builtin_amdgcn_global_load_lds((const unsigned*)((const char*)(gbase) + (v0)), (LAS unsigned*)(lds + (bufoff) + ldsw), 16, 0, 0); \
        __builtin_amdgcn_global_load_lds((const unsigned*)((const char*)(gbase) + (v1)), (LAS unsigned*)(lds + (bufoff) + ldsw + 8192), 16, 0, 0); } while (0)
#define STB(bufoff, gbase, h) PG8_STAGE2(bufoff, (gbase) + ((h) ? hstepB : 0), vbU[0], vbU[1])
#define STA_CUR(bufoff, gbase, h) do { if (GATHER) PG8_STAGE2(bufoff, gbase, (h) ? cur.va10 : cur.va00, (h) ? cur.va11 : cur.va01); else PG8_STAGE2(bufoff, (gbase) + ((h) ? hstepA : 0), vaU[0], vaU[1]); } while (0)
#define STA_SEL(bufoff, gbase, h) do { if (GATHER) PG8_STAGE2(bufoff, gbase, last ? ((h) ? nxt.va10 : nxt.va00) : ((h) ? cur.va10 : cur.va00), last ? ((h) ? nxt.va11 : nxt.va01) : ((h) ? cur.va11 : cur.va01)); \
        else PG8_STAGE2(bufoff, (gbase) + ((h) ? hstepA : 0), vaU[0], vaU[1]); } while (0)
#define PG8_LDA(dst, b, h) do { _Pragma("unroll") for (int m = 0; m < 4; ++m) _Pragma("unroll") for (int k = 0; k < 2; ++k) dst[m][k] = *(const LAS bf16x8*)(lds + PG8_SA(b, h) + aoff + m * 2048 + k * 1024); } while (0)
#define PG8_LDB(dst, b, h) do { _Pragma("unroll") for (int n = 0; n < 2; ++n) _Pragma("unroll") for (int k = 0; k < 2; ++k) dst[n][k] = *(const LAS bf16x8*)(lds + PG8_SB(b, h) + boff + n * 2048 + k * 1024); } while (0)
#define PG8_MMA(ai, bj, At, Bt) do { __builtin_amdgcn_s_setprio(1); _Pragma("unroll") for (int m = 0; m < 4; ++m) _Pragma("unroll") for (int n = 0; n < 2; ++n) _Pragma("unroll") for (int k = 0; k < 2; ++k) \
        acc[ai][bj][m][n] = __builtin_amdgcn_mfma_f32_16x16x32_bf16(Bt[n][k], At[m][k], acc[ai][bj][m][n], 0, 0, 0); __builtin_amdgcn_s_setprio(0); } while (0)
#define PG8_WAIT_V(n) asm volatile("s_waitcnt vmcnt(" #n ")" ::: "memory")
#define PG8_WAIT_L(n) asm volatile("s_waitcnt lgkmcnt(" #n ")" ::: "memory")
#define PG8_BAR __builtin_amdgcn_s_barrier()
#define PG8_SCHED __builtin_amdgcn_sched_barrier(0)
    GJob cur, nxt; int ui = 0;
    cur.A = nullptr; cur.B = nullptr; cur.va00 = cur.va01 = cur.va10 = cur.va11 = 0u; nxt = cur;
    if (!jobfn(0, cur)) return;
    f32x4 acc[2][2][4][2];
#pragma unroll
    for (int a = 0; a < 2; ++a)
#pragma unroll
        for (int b = 0; b < 2; ++b)
#pragma unroll
            for (int m = 0; m < 4; ++m)
#pragma unroll
                for (int n = 0; n < 2; ++n) acc[a][b][m][n] = (f32x4){0.f, 0.f, 0.f, 0.f};
    bf16x8 At[4][2], B0[2][2], B1[2][2];
    STB(PG8_SB(0, 0), cur.B, 0); STB(PG8_SB(0, 1), cur.B, 1); STA_CUR(PG8_SA(0, 0), cur.A, 0); STA_CUR(PG8_SA(0, 1), cur.A, 1);
    if (wr == 1) PG8_BAR;
    PG8_WAIT_V(2); PG8_BAR;
    STB(PG8_SB(1, 0), cur.B + kstep, 0); STA_CUR(PG8_SA(1, 0), cur.A + kstep, 0); STB(PG8_SB(1, 1), cur.B + kstep, 1);
    PG8_WAIT_V(6); PG8_BAR;
    for (;;) {
        bool has_next = false;
        for (int t = 0; t < nt; t += 2) {
            const bool last = (t == nt - 2);
            if (last) { has_next = jobfn(ui + 1, nxt); if (!has_next) nxt = cur; }
            const char* a1 = cur.A + (size_t)(t + 1) * kstep;
            const char* a2 = last ? nxt.A : cur.A + (size_t)(t + 2) * kstep; const char* b2 = last ? nxt.B : cur.B + (size_t)(t + 2) * kstep;
            const char* a3 = a2 + kstep; const char* b3 = b2 + kstep;
            PG8_LDB(B0, 0, 0); PG8_LDB(B1, 0, 1); PG8_SCHED; PG8_LDA(At, 0, 0); STA_CUR(PG8_SA(1, 1), a1, 1);
            PG8_WAIT_V(8); PG8_WAIT_L(0); PG8_BAR; PG8_MMA(0, 0, At, B0); PG8_MMA(0, 1, At, B1); PG8_BAR; PG8_SCHED;
            PG8_LDA(At, 0, 1); STB(PG8_SB(0, 0), b2, 0); STB(PG8_SB(0, 1), b2, 1); STA_SEL(PG8_SA(0, 0), a2, 0);
            PG8_WAIT_V(8); PG8_WAIT_L(0); PG8_BAR; PG8_MMA(1, 0, At, B0); PG8_MMA(1, 1, At, B1); PG8_BAR; PG8_SCHED;
            PG8_LDB(B0, 1, 0); PG8_LDB(B1, 1, 1); PG8_SCHED; PG8_LDA(At, 1, 0); STA_SEL(PG8_SA(0, 1), a2, 1);
            PG8_WAIT_V(8); PG8_WAIT_L(0); PG8_BAR; PG8_MMA(0, 0, At, B0); PG8_MMA(0, 1, At, B1); PG8_BAR; PG8_SCHED;
            PG8_LDA(At, 1, 1); STB(PG8_SB(1, 0), b3, 0); STB(PG8_SB(1, 1), b3, 1); STA_SEL(PG8_SA(1, 0), a3, 0);
            PG8_WAIT_V(8); PG8_WAIT_L(0); PG8_BAR; PG8_MMA(1, 0, At, B0); PG8_MMA(1, 1, At, B1); PG8_BAR; PG8_SCHED;
        }
        if (wr == 0) PG8_BAR;
        epi(acc, ui);
        if (!has_next) break;
#pragma unroll
        for (int a = 0; a < 2; ++a)
#pragma unroll
            for (int b = 0; b < 2; ++b)
#pragma unroll
                for (int m = 0; m < 4; ++m)
#pragma unroll
                    for (int n = 0; n < 2; ++n) acc[a][b][m][n] = (f32x4){0.f, 0.f, 0.f, 0.f};
        cur = nxt; ++ui;
        if (wr == 1) PG8_BAR;
    }
    PG8_WAIT_V(0);
    PG8_BAR;
#undef PG8_SA
#undef PG8_SB
#undef PG8_STAGE2
#undef STB
#undef STA_CUR
#undef STA_SEL
#undef PG8_LDA
#undef PG8_LDB
#undef PG8_MMA
#undef PG8_WAIT_V
#undef PG8_WAIT_L
#undef PG8_BAR
#undef PG8_SCHED
}
__device__ __forceinline__ void gj_lin2(unsigned (&v)[2], int ld) {
#pragma unroll
    for (int i = 0; i < 2; ++i) { int R, C; g_stage_rc(tid_() * 16 + i * 8192, R, C); v[i] = (unsigned)((R * ld + C) * 2); }
}
struct RowLin { size_t base; int ld; __device__ __forceinline__ size_t operator()(int R) const { return base + (size_t)R * ld; } };

__device__ __forceinline__ void st_bf4(bf16_t* dst, f32x4 v) {
    uint2 o; o.x = pack2(v[0], v[1]); o.y = pack2(v[2], v[3]); *(uint2*)dst = o;
}
#define EPI8(...) do { const int tid_e = tid_(), lane_e = tid_e & 63, wid_e = tid_e >> 6, wr = wid_e >> 2, wc = wid_e & 3, fr = lane_e & 15, fq = lane_e >> 4; \
    _Pragma("unroll") for (int ai = 0; ai < 2; ++ai) _Pragma("unroll") for (int m = 0; m < 4; ++m) _Pragma("unroll") for (int bj = 0; bj < 2; ++bj) _Pragma("unroll") for (int n = 0; n < 2; ++n) { \
        const int row = ai * 128 + wr * 64 + m * 16 + fr, col = bj * 128 + wc * 32 + n * 16 + fq * 4; const f32x4 v = acc[ai][bj][m][n]; __VA_ARGS__ } } while (0)

struct EpiInproj {
    const P* p; int nt;
    __device__ __forceinline__ void operator()(int m, int n, int fq, f32x4 v) const {
        const P& P_ = *p;
        const int pos = m % LP;
        const float* rp = P_.rope() + (size_t)pos * 24;
        if (nt <= 2) {
            const bool isv = (nt == 2) && (n >= 128);
            if (!isv && (n & 48) == 0) {
                f32x4 pr;
#pragma unroll
                for (int j = 0; j < 4; ++j) pr[j] = __shfl_xor(v[j], 32);
                const int i0 = (fq & 1) * 4;
#pragma unroll
                for (int j = 0; j < 4; ++j) {
                    const float c = rp[i0 + j], s = rp[8 + i0 + j];
                    v[j] = fq < 2 ? v[j] * c - pr[j] * s : v[j] * c + pr[j] * s;
                }
            }
            if (nt < 2) { st_bf4(P_.q() + (size_t)m * 512 + nt * 256 + n, v * (0.125f * 1.4426950408889634f)); }
            else if (n < 128) st_bf4(P_.k() + (size_t)m * 128 + n, v);
            else st_bf4(P_.v() + (size_t)m * 128 + (n - 128), v);
        } else if (nt == 3 || nt == 4) {
            const bool ropeable = (nt == 3) ? ((n & 16) == 0) : (n < 16);
            if (ropeable) {
                f32x4 pr;
#pragma unroll
                for (int j = 0; j < 4; ++j) pr[j] = __shfl_xor(v[j], 16);
                if (fq < 2) {
#pragma unroll
                    for (int j = 0; j < 4; ++j) {
                        const float c = rp[16 + j], s = rp[20 + j];
                        v[j] = fq == 0 ? v[j] * c - pr[j] * s : v[j] * c + pr[j] * s;
                    }
                }
            }
            if (nt == 3) st_bf4(P_.iq() + (size_t)m * 256 + n, v);
            else if (n < 32) st_bf4(P_.ik() + (size_t)m * 32 + n, v);
            else if (n < 40) *(f32x4*)(P_.iw() + (size_t)m * 8 + (n - 32)) = v;
        } else if (nt <= 6) { st_bf4(P_.hq() + (size_t)m * 512 + (nt - 5) * 256 + n, v * 0.08838834764831845f); }
        else if (nt <= 8) { st_bf4(P_.hf() + (size_t)m * 512 + (nt - 7) * 256 + n, v); }
        else if (nt <= 10) { st_bf4(P_.hi() + (size_t)m * 512 + (nt - 9) * 256 + n, v); }
        else if (nt <= 12) {
            f32x4 o;
#pragma unroll
            for (int j = 0; j < 4; ++j) o[j] = v[j] * sigmoidf_(v[j]);
            st_bf4(P_.hg() + (size_t)m * 512 + (nt - 11) * 256 + n, o);
        } else {
            f32x4 o;
#pragma unroll
            for (int j = 0; j < 4; ++j) o[j] = sigmoidf_(v[j]);
            if (nt <= 16) st_bf4(P_.ga() + (size_t)m * 1024 + (nt - 13) * 256 + n, o);
            else st_bf4(P_.gh() + (size_t)m * 1024 + (nt - 17) * 256 + n, o);
        }
    }
};

__device__ __forceinline__ void ph_inproj(const P& p, unsigned char* lds) {
    const int nunits = (T / 256) * 21, G = gridDim.x, b0 = blockIdx.x;
    auto jobfn = [&](int i, GJob& j) __attribute__((always_inline)) -> bool {
        const int u = b0 + i * G; if (u >= nunits) return false;
        const int nt = u % 21, mt = u / 21;
        j.A = (const char*)(p.xn() + (size_t)mt * 256 * D); j.B = (const char*)(p.winT() + (size_t)nt * 256 * D); return true; };
    auto epi = [&](f32x4 (&acc)[2][2][4][2], int i) __attribute__((always_inline)) {
        const int u = b0 + i * G, nt = u % 21, mt = u / 21;
        const EpiInproj e{&p, nt};
        EPI8( e(mt * 256 + row, col, fq, v); );
    };
    unsigned vbU[2]; gj_lin2(vbU, D);
    gemm_stream<false>(lds, D, D, (size_t)128 * D * 2, vbU, jobfn, epi);
}

constexpr int NCH = 129, NXU = 16 * NCH;
constexpr int X_QT = 0, X_KT = X_QT + 64 * 272, X_KH = X_KT + 64 * 272, X_VT = X_KH + 128 * 144, X_AS = X_VT + 128 * 144, X_SEG = X_AS + 64 * 144;
__device__ __forceinline__ bf16_t* hg_ds(const P& p) { return (bf16_t*)p.out; }
__device__ __forceinline__ float* hg_g(const P& p) { return (float*)((unsigned char*)p.out + (size_t)NXU * 32768); }

__device__ __forceinline__ void hgx_unit(const P& p, unsigned char* lds, int u) {
    const int tid = tid_(), lane = tid & 63, wid = tid >> 6, fr = lane & 15, fq = lane >> 4;
    const int c = u % NCH, bh = u / NCH, b = bh >> 2, h = bh & 3;
    const int d = tid & 127, seg = tid >> 7;
    const size_t rowbase = (size_t)(b * LP + c * 64 + seg * 16) * 512 + h * 128 + d;
    bf16_t* hqp = p.hq() + rowbase; const bf16_t* hfp = p.hf() + rowbase; const bf16_t* hip = p.hi() + rowbase;
    const float lbv = p.lb()[h * 128 + d];
    float bb[16], qv[16], kk[16], vv[16];
    float cs = 0.f;
#pragma unroll
    for (int i = 0; i < 16; ++i) {
        const float f = lbv + (1.0f - lbv) * sigmoidf_(bf2f(hfp[(size_t)i * 512]));
        kk[i] = 1.0f - f; cs += __logf(f); bb[i] = cs;
        qv[i] = bf2f(hqp[(size_t)i * 512]); vv[i] = bf2f(hip[(size_t)i * 512]);
    }
    float* segs = (float*)(lds + X_SEG);
    segs[seg * 128 + d] = cs;
    __syncthreads();
    const float s0 = segs[d], s1 = segs[128 + d], s2 = segs[256 + d], s3 = segs[384 + d];
    const float off = seg == 0 ? 0.f : (seg == 1 ? s0 : (seg == 2 ? s0 + s1 : s0 + s1 + s2));
    const float rref = s0 + s1, blast = (s0 + s1) + (s2 + s3);
    uint32_t khp[8], vtp[8];
#pragma unroll
    for (int i = 0; i < 16; i += 2) {
        float khv[2];
#pragma unroll
        for (int j = 0; j < 2; ++j) {
            const float bt = bb[i + j] + off;
            const float eq = __expf(fminf(bt - rref, 80.f)), ek = __expf(fminf(rref - bt, 80.f));
            const int t = seg * 16 + i + j;
            *(bf16_t*)(lds + X_QT + t * 272 + d * 2) = f2bf(qv[i + j] * eq);
            *(bf16_t*)(lds + X_KT + t * 272 + d * 2) = f2bf(kk[i + j] * ek);
            hqp[(size_t)(i + j) * 512] = f2bf(qv[i + j] * __expf(bt));
            khv[j] = kk[i + j] * __expf(blast - bt);
        }
        khp[i >> 1] = pack2(khv[0], khv[1]); vtp[i >> 1] = pack2(vv[i], vv[i + 1]);
    }
    *(uint4*)(lds + X_KH + d * 144 + seg * 32) = make_uint4(khp[0], khp[1], khp[2], khp[3]);
    *(uint4*)(lds + X_KH + d * 144 + seg * 32 + 16) = make_uint4(khp[4], khp[5], khp[6], khp[7]);
    *(uint4*)(lds + X_VT + d * 144 + seg * 32) = make_uint4(vtp[0], vtp[1], vtp[2], vtp[3]);
    *(uint4*)(lds + X_VT + d * 144 + seg * 32 + 16) = make_uint4(vtp[4], vtp[5], vtp[6], vtp[7]);
    if (seg == 0) hg_g(p)[(size_t)u * 128 + d] = __expf(blast);
    __syncthreads();
    {
        const int tm = wid >> 1, tn0 = (wid & 1) * 2;
        f32x4 a1[2] = {(f32x4){0.f, 0.f, 0.f, 0.f}, (f32x4){0.f, 0.f, 0.f, 0.f}};
#pragma unroll
        for (int ks = 0; ks < 4; ++ks) {
            const bf16x8 aq = *(const bf16x8*)(lds + X_QT + (tm * 16 + fr) * 272 + (ks * 32 + fq * 8) * 2);
#pragma unroll
            for (int j = 0; j < 2; ++j) {
                const bf16x8 bk = *(const bf16x8*)(lds + X_KT + ((tn0 + j) * 16 + fr) * 272 + (ks * 32 + fq * 8) * 2);
                a1[j] = __builtin_amdgcn_mfma_f32_16x16x32_bf16(bk, aq, a1[j], 0, 0, 0);
            }
        }
#pragma unroll
        for (int j = 0; j < 2; ++j) {
            const int t = tm * 16 + fr, sb = (tn0 + j) * 16 + fq * 4;
            f32x4 v = a1[j];
#pragma unroll
            for (int jj = 0; jj < 4; ++jj) v[jj] = (sb + jj <= t) ? v[jj] : 0.f;
            uint2 o; o.x = pack2(v[0], v[1]); o.y = pack2(v[2], v[3]);
            *(uint2*)(lds + X_AS + t * 144 + sb * 2) = o;
        }
    }
    __syncthreads();
    {
        const int tm = wid >> 1, en0 = (wid & 1) * 4;
        f32x4 o2[4];
#pragma unroll
        for (int j = 0; j < 4; ++j) o2[j] = (f32x4){0.f, 0.f, 0.f, 0.f};
#pragma unroll
        for (int ks = 0; ks < 2; ++ks) {
            const bf16x8 aa = *(const bf16x8*)(lds + X_AS + (tm * 16 + fr) * 144 + (ks * 32 + fq * 8) * 2);
#pragma unroll
            for (int j = 0; j < 4; ++j) {
                const bf16x8 bv = *(const bf16x8*)(lds + X_VT + ((en0 + j) * 16 + fr) * 144 + (ks * 32 + fq * 8) * 2);
                o2[j] = __builtin_amdgcn_mfma_f32_16x16x32_bf16(bv, aa, o2[j], 0, 0, 0);
            }
        }
        bf16_t* orow = p.hf() + (size_t)(b * LP + c * 64 + tm * 16 + fr) * 512 + h * 128;
#pragma unroll
        for (int j = 0; j < 4; ++j) st_bf4(orow + (en0 + j) * 16 + fq * 4, o2[j]);
    }
    {
        f32x4 s3[8];
#pragma unroll
        for (int j = 0; j < 8; ++j) s3[j] = (f32x4){0.f, 0.f, 0.f, 0.f};
#pragma unroll
        for (int ks = 0; ks < 2; ++ks) {
            const bf16x8 ak = *(const bf16x8*)(lds + X_KH + (wid * 16 + fr) * 144 + (ks * 32 + fq * 8) * 2);
#pragma unroll
            for (int j = 0; j < 8; ++j) {
                const bf16x8 bv = *(const bf16x8*)(lds + X_VT + (j * 16 + fr) * 144 + (ks * 32 + fq * 8) * 2);
                s3[j] = __builtin_amdgcn_mfma_f32_16x16x32_bf16(ak, bv, s3[j], 0, 0, 0);
            }
        }
        bf16_t* dsb = hg_ds(p) + (size_t)u * 16384;
#pragma unroll
        for (int j = 0; j < 8; ++j) st_bf4(dsb + (size_t)(j * 16 + fr) * 128 + wid * 16 + fq * 4, s3[j]);
    }
    __syncthreads();
}

__device__ __forceinline__ void hgchain_unit(const P& p, int bh) {
    const int tid = tid_(), e = tid & 127, dr = tid >> 7;
    float S[32];
#pragma unroll
    for (int i = 0; i < 32; ++i) S[i] = 0.f;
    uint4* ptr = (uint4*)(hg_ds(p) + ((size_t)(bh * NCH) * 128 + e) * 128 + dr * 32);
    const f32x4* gp = (const f32x4*)(hg_g(p) + (size_t)(bh * NCH) * 128 + dr * 32);
    uint4 w[4]; f32x4 g[8];
#pragma unroll
    for (int i = 0; i < 4; ++i) w[i] = ptr[i];
#pragma unroll
    for (int i = 0; i < 8; ++i) g[i] = gp[i];
    for (int c = 0; c < NCH; ++c) {
        uint4 wn[4]; f32x4 gn[8];
        uint4* pn = ptr + 16384 * 2 / 16;
        const f32x4* gpn = gp + 32;
        if (c + 1 < NCH) {
#pragma unroll
            for (int i = 0; i < 4; ++i) wn[i] = pn[i];
#pragma unroll
            for (int i = 0; i < 8; ++i) gn[i] = gpn[i];
        }
#pragma unroll
        for (int i = 0; i < 4; ++i)
            ptr[i] = make_uint4(pack2(S[8 * i], S[8 * i + 1]), pack2(S[8 * i + 2], S[8 * i + 3]), pack2(S[8 * i + 4], S[8 * i + 5]), pack2(S[8 * i + 6], S[8 * i + 7]));
#pragma unroll
        for (int i = 0; i < 4; ++i) {
            const uint32_t ww[4] = {w[i].x, w[i].y, w[i].z, w[i].w};
#pragma unroll
            for (int j = 0; j < 4; ++j) {
                const float lo = __uint_as_float(ww[j] << 16), hi = __uint_as_float(ww[j] & 0xffff0000u);
                S[8 * i + 2 * j] = g[2 * i + (j >> 1)][(2 * j) & 3] * S[8 * i + 2 * j] + lo;
                S[8 * i + 2 * j + 1] = g[2 * i + (j >> 1)][(2 * j + 1) & 3] * S[8 * i + 2 * j + 1] + hi;
            }
        }
        if (c + 1 < NCH) {
#pragma unroll
            for (int i = 0; i < 4; ++i) w[i] = wn[i];
#pragma unroll
            for (int i = 0; i < 8; ++i) g[i] = gn[i];
        }
        ptr = pn; gp = gpn;
    }
}

__device__ __forceinline__ void hgz_unit(const P& p, unsigned char* lds, int u) {
    const int tid = tid_(), lane = tid & 63, wid = tid >> 6, fr = lane & 15, fq = lane >> 4;
    const int c = u % NCH, bh = u / NCH, b = bh >> 2, h = bh & 3;
    const int tm = wid >> 1, en0 = (wid & 1) * 4;
    const size_t row = (size_t)(b * LP + c * 64 + tm * 16 + fr);
    const bf16_t* qrow = p.hq() + row * 512 + h * 128;
    const bf16_t* sT = hg_ds(p) + (size_t)u * 16384;
    f32x4 o[4];
#pragma unroll
    for (int j = 0; j < 4; ++j) o[j] = (f32x4){0.f, 0.f, 0.f, 0.f};
#pragma unroll
    for (int ks = 0; ks < 4; ++ks) {
        const bf16x8 aq = *(const bf16x8*)(qrow + ks * 32 + fq * 8);
#pragma unroll
        for (int j = 0; j < 4; ++j) {
            const bf16x8 bs = *(const bf16x8*)(sT + (size_t)((en0 + j) * 16 + fr) * 128 + ks * 32 + fq * 8);
            o[j] = __builtin_amdgcn_mfma_f32_16x16x32_bf16(bs, aq, o[j], 0, 0, 0);
        }
    }
    const bf16_t* oi = p.hf() + row * 512 + h * 128;
    float ss = 0.f;
#pragma unroll
    for (int j = 0; j < 4; ++j) {
        const uint2 w = *(const uint2*)(oi + (en0 + j) * 16 + fq * 4);
        o[j][0] += __uint_as_float(w.x << 16); o[j][1] += __uint_as_float(w.x & 0xffff0000u);
        o[j][2] += __uint_as_float(w.y << 16); o[j][3] += __uint_as_float(w.y & 0xffff0000u);
        ss += o[j][0] * o[j][0] + o[j][1] * o[j][1] + o[j][2] * o[j][2] + o[j][3] * o[j][3];
    }
    ss += __shfl_xor(ss, 16); ss += __shfl_xor(ss, 32);
    float* part = (float*)lds;
    if (fq == 0) part[(tm * 16 + fr) * 2 + (wid & 1)] = ss;
    __syncthreads();
    const float tot = part[(tm * 16 + fr) * 2] + part[(tm * 16 + fr) * 2 + 1];
    const float rs = rsqrtf(tot * (1.0f / 128.0f) + EPS);
    const bf16_t* hgp = p.hg() + row * 512 + h * 128;
    bf16_t* outp = p.hgr() + row * 512 + h * 128;
#pragma unroll
    for (int j = 0; j < 4; ++j) {
        const int e0 = (en0 + j) * 16 + fq * 4;
        const f32x4 gn = *(const f32x4*)(p.hgrn_g + h * 128 + e0);
        const uint2 w = *(const uint2*)(hgp + e0);
        f32x4 r;
        r[0] = o[j][0] * rs * gn[0] * __uint_as_float(w.x << 16); r[1] = o[j][1] * rs * gn[1] * __uint_as_float(w.x & 0xffff0000u);
        r[2] = o[j][2] * rs * gn[2] * __uint_as_float(w.y << 16); r[3] = o[j][3] * rs * gn[3] * __uint_as_float(w.y & 0xffff0000u);
        st_bf4(outp + e0, r);
    }
    __syncthreads();
}

typedef float f32x16 __attribute__((ext_vector_type(16)));
typedef short s16x4 __attribute__((ext_vector_type(4)));
typedef unsigned u32x4 __attribute__((ext_vector_type(4)));
constexpr int NKMAX = 8224;
constexpr int NBIN = 1024;
constexpr int A_SC = 0, A_H1 = A_SC + 4 * NKMAX * 4, A_SEL = A_H1 + 4 * NBIN * 4, A_CAND = A_SEL + 2048, A_META = A_CAND + 1024, A_END = A_META + 256;
static_assert(A_END <= LDS_BYTES - 16, "attention LDS");
__device__ __forceinline__ uint32_t skey(float f) { const uint32_t u = __float_as_uint(f); return (u & 0x80000000u) ? ~u : (u | 0x80000000u); }
__device__ __forceinline__ float skey_inv(uint32_t k) { return __uint_as_float((k & 0x80000000u) ? (k & 0x7fffffffu) : ~k); }
__device__ __forceinline__ int bin1(float s, float lo, float scale) { return min(NBIN - 1, max(0, (int)((s - lo) * scale))); }
template <int OFF> __device__ __forceinline__ s16x4 tr_read(unsigned addr) {
    s16x4 r; asm volatile("ds_read_b64_tr_b16 %0, %1 offset:%2" : "=&v"(r) : "v"(addr), "i"(OFF) : "memory"); return r;
}
__device__ __forceinline__ void scan_top(const int* hist, int K, int* m, int lane) {
    int c[16];
#pragma unroll
    for (int i = 0; i < 4; ++i) { const int4 v = *(const int4*)(hist + 16 * lane + 4 * i); c[4 * i] = v.x; c[4 * i + 1] = v.y; c[4 * i + 2] = v.z; c[4 * i + 3] = v.w; }
    int tot = 0;
#pragma unroll
    for (int i = 0; i < 16; ++i) tot += c[i];
    int suf = tot;
#pragma unroll
    for (int o = 1; o < 64; o <<= 1) { const int t = __shfl_down(suf, o); if (lane + o < 64) suf += t; }
    int above = suf - tot;
#pragma unroll
    for (int i = 15; i >= 0; --i) {
        if (above < K && K <= above + c[i]) { m[0] = 16 * lane + i; m[1] = above; m[2] = c[i]; }
        above += c[i];
    }
}

__device__ __forceinline__ void attn4_unit(const P& p, unsigned char* lds, int b, int grp) {
    const int tid = tid_(), lane = tid & 63, wid = __builtin_amdgcn_readfirstlane(tid >> 6);
    const int t0 = NMETA + 4 * grp;
    const int brow = b * LP, row0 = brow + t0;
    float* sc = (float*)(lds + A_SC);
    int* h1 = (int*)(lds + A_H1);
    unsigned short* sel = (unsigned short*)(lds + A_SEL); unsigned short* cand = (unsigned short*)(lds + A_CAND);
    int* meta = (int*)(lds + A_META);
    const bool big = t0 + 1 > 256;
    for (int i = tid; i < 4 * NBIN; i += NTHREADS) h1[i] = 0;
    if (tid < 64) { const int w = tid & 15; meta[tid] = (w == 0) ? -1 : 0; }
    if (!big) { for (int i = tid; i < 1024; i += NTHREADS) { const int q = i >> 8, j = i & 255; sel[i] = (unsigned short)(j <= t0 + q ? j : 0); } }
    __syncthreads();
    if (big) {
        {
            const int hh = lane >> 5, c32 = lane & 31;
            const int g = c32 >> 3, h2a = (c32 >> 2) & 1, bq = c32 & 3, aq = 2 * h2a + (g >> 1), ah = 4 * (g & 1) + bq;
            const bf16_t* ap = p.iq() + (size_t)(row0 + aq) * 256 + ah * 32 + 8 * hh;
            const bf16x8 a0 = *(const bf16x8*)ap, a1 = *(const bf16x8*)(ap + 16);
            const f32x4 w00 = *(const f32x4*)(p.iw() + (size_t)(row0 + 2 * hh) * 8), w01 = *(const f32x4*)(p.iw() + (size_t)(row0 + 2 * hh) * 8 + 4);
            const f32x4 w10 = *(const f32x4*)(p.iw() + (size_t)(row0 + 2 * hh + 1) * 8), w11 = *(const f32x4*)(p.iw() + (size_t)(row0 + 2 * hh + 1) * 8 + 4);
            const int ntiles = (t0 + 4 + 31) >> 5;
            const int tq0 = t0 + 2 * hh;
            float mx0 = -INFINITY, mn0 = INFINITY, mx1 = -INFINITY, mn1 = INFINITY;
            const bf16_t* kbase = p.ik() + (size_t)brow * 32 + 8 * hh;
            for (int tile0 = wid; tile0 < ntiles; tile0 += 128) {
                bf16x8 b0[16], b1[16];
#pragma unroll
                for (int j = 0; j < 16; ++j) {
                    const int tile = min(tile0 + 8 * j, ntiles - 1);
                    const bf16_t* kp = kbase + (size_t)(tile * 32 + c32) * 32;
                    b0[j] = *(const bf16x8*)kp; b1[j] = *(const bf16x8*)(kp + 16);
                }
                __builtin_amdgcn_sched_barrier(0);
#pragma unroll
                for (int j = 0; j < 16; ++j) {
                    const int tile = tile0 + 8 * j;
                    if (tile < ntiles) {
                        const int key = tile * 32 + c32;
                        f32x16 acc;
#pragma unroll
                        for (int i = 0; i < 16; ++i) acc[i] = 0.f;
                        acc = __builtin_amdgcn_mfma_f32_32x32x16_bf16(a0, b0[j], acc, 0, 0, 0);
                        acc = __builtin_amdgcn_mfma_f32_32x32x16_bf16(a1, b1[j], acc, 0, 0, 0);
                        float s0 = 0.f, s1 = 0.f;
#pragma unroll
                        for (int i = 0; i < 4; ++i) {
                            s0 += w00[i] * fmaxf(acc[i], 0.f) + w01[i] * fmaxf(acc[4 + i], 0.f);
                            s1 += w10[i] * fmaxf(acc[8 + i], 0.f) + w11[i] * fmaxf(acc[12 + i], 0.f);
                        }
                        sc[(2 * hh) * NKMAX + key] = s0; sc[(2 * hh + 1) * NKMAX + key] = s1;
                        if (key <= tq0) { mx0 = fmaxf(mx0, s0); mn0 = fminf(mn0, s0); }
                        if (key <= tq0 + 1) { mx1 = fmaxf(mx1, s1); mn1 = fminf(mn1, s1); }
                    }
                }
            }
#pragma unroll
            for (int o = 16; o >= 1; o >>= 1) {
                mx0 = fmaxf(mx0, __shfl_xor(mx0, o)); mn0 = fminf(mn0, __shfl_xor(mn0, o));
                mx1 = fmaxf(mx1, __shfl_xor(mx1, o)); mn1 = fminf(mn1, __shfl_xor(mn1, o));
            }
            if (c32 == 0) {
                if (mx0 >= mn0) { atomicMin((unsigned*)&meta[(2 * hh) * 16 + 0], skey(mn0)); atomicMax((unsigned*)&meta[(2 * hh) * 16 + 1], skey(mx0)); }
                if (mx1 >= mn1) { atomicMin((unsigned*)&meta[(2 * hh + 1) * 16 + 0], skey(mn1)); atomicMax((unsigned*)&meta[(2 * hh + 1) * 16 + 1], skey(mx1)); }
            }
        }
        __syncthreads();
        const int q = wid & 3, part = wid >> 2, n = t0 + q + 1;
        const float lo = skey_inv((unsigned)meta[q * 16 + 0]), hi = skey_inv((unsigned)meta[q * 16 + 1]);
        const float scale = hi > lo ? (float)NBIN / (hi - lo) : 0.f;
        const float* scq = sc + q * NKMAX;
        for (int base = part * 256; base < n; base += 512) {
            const int idx0 = base + lane * 4;
            if (idx0 < n) {
                const f32x4 v = *(const f32x4*)(scq + idx0);
#pragma unroll
                for (int j = 0; j < 4; ++j) if (idx0 + j < n) atomicAdd(&h1[q * NBIN + bin1(v[j], lo, scale)], 1);
            }
        }
        __syncthreads();
        if (wid < 4) scan_top(h1 + wid * NBIN, 256, meta + wid * 16 + 4, lane);
        __syncthreads();
        const int B1 = meta[q * 16 + 4];
        for (int base = part * 256; base < n; base += 512) {
            const int idx0 = base + lane * 4;
            f32x4 v = (f32x4){0.f, 0.f, 0.f, 0.f};
            if (idx0 < n) v = *(const f32x4*)(scq + idx0);
            const unsigned long long lt = (1ull << lane) - 1ull;
#pragma unroll
            for (int j = 0; j < 4; ++j) {
                const int idx = idx0 + j;
                bool issel = false, iscand = false;
                if (idx < n) { const int b1 = bin1(v[j], lo, scale); issel = b1 > B1; iscand = b1 == B1; }
                const unsigned long long ms = __ballot(issel), mc = __ballot(iscand);
                if (ms) {
                    int bs = 0; if (lane == 0) bs = atomicAdd(&meta[q * 16 + 2], __popcll(ms));
                    bs = __shfl(bs, 0);
                    if (issel) sel[q * 256 + bs + __popcll(ms & lt)] = (unsigned short)idx;
                }
                if (mc) {
                    int bs = 0; if (lane == 0) bs = atomicAdd(&meta[q * 16 + 3], __popcll(mc));
                    bs = __shfl(bs, 0);
                    const int pos = bs + __popcll(mc & lt);
                    if (iscand && pos < 128) cand[q * 128 + pos] = (unsigned short)idx;
                }
            }
        }
        __syncthreads();
        if (wid < 4) {
            const int qq = wid; const float* scr = sc + qq * NKMAX;
            const int rq = 256 - meta[qq * 16 + 5], cq = meta[qq * 16 + 6], sbase = 256 - rq, nn = t0 + qq + 1;
            if (cq <= 128) {
                int taken = 0;
#pragma unroll
                for (int half = 0; half < 2; ++half) {
                    const int i = lane + 64 * half;
                    bool take = false; int myidx = 0;
                    if (i < cq) {
                        myidx = cand[qq * 128 + i]; const float mv = scr[myidx];
                        int rank = 0;
                        for (int j = 0; j < cq; ++j) { const int oj = cand[qq * 128 + j]; const float ov = scr[oj]; rank += (ov > mv) || (ov == mv && oj < myidx); }
                        take = rank < rq;
                    }
                    const unsigned long long mt = __ballot(take);
                    if (take) sel[qq * 256 + sbase + taken + __popcll(mt & ((1ull << lane) - 1ull))] = (unsigned short)myidx;
                    taken += __popcll(mt);
                }
            } else {
                const float lo_ = skey_inv((unsigned)meta[qq * 16 + 0]), hi_ = skey_inv((unsigned)meta[qq * 16 + 1]);
                const float sc_ = hi_ > lo_ ? (float)NBIN / (hi_ - lo_) : 0.f;
                const int B1_ = meta[qq * 16 + 4];
                int taken = 0;
                for (int base = 0; base < nn && taken < rq; base += 64) {
                    const int idx = base + lane; bool isc = false;
                    if (idx < nn) isc = bin1(scr[idx], lo_, sc_) == B1_;
                    const unsigned long long mc = __ballot(isc);
                    const int pos = taken + __popcll(mc & ((1ull << lane) - 1ull));
                    if (isc && pos < rq) sel[qq * 256 + sbase + pos] = (unsigned short)idx;
                    taken += __popcll(mc);
                }
            }
        }
        __syncthreads();
    }
    {
        const int q = wid >> 1, kvh = wid & 1, tq = t0 + q, nsel = min(tq + 1, 256);
        const int col = lane & 15, g4 = lane >> 4;
        const unsigned short* selq = sel + q * 256;
        bf16x8 qf0, qf1;
        {
            const bf16_t* qp = p.q() + (size_t)(row0 + q) * 512 + (kvh * 4 + (col & 3)) * 64 + g4 * 8;
            qf0 = *(const bf16x8*)qp; qf1 = *(const bf16x8*)(qp + 32);
            if (col >= 4) {
#pragma unroll
                for (int i = 0; i < 8; ++i) { qf0[i] = 0; qf1[i] = 0; }
            }
        }
        LAS unsigned char* vst = (LAS unsigned char*)lds + A_SC + wid * 16384;
        const bf16_t* vb = p.v() + (size_t)brow * 128 + kvh * 64 + (lane & 7) * 8;
        const unsigned rdbase = (unsigned)(uintptr_t)((LAS unsigned char*)lds + A_SC) + wid * 16384 + (4 * g4 + (col >> 2)) * 128 + (col & 3) * 8;
#define V_STAGE(s_, buf_) do { _Pragma("unroll") for (int i_ = 0; i_ < 4; ++i_) { \
            const int ksl_ = (s_) * 32 + i_ * 8 + (lane >> 3); const int key_ = selq[ksl_]; \
            __builtin_amdgcn_global_load_lds((const unsigned*)(vb + (size_t)key_ * 128), (LAS unsigned*)(vst + (buf_) * 4096 + i_ * 1024), 16, 0, 0); } } while (0)
        const bf16_t* kb = p.k() + (size_t)brow * 128 + kvh * 64 + g4 * 8;
        f32x4 lg[16];
        u32x4 vr[16];
        {
            bf16x8 k0[16], k1[16];
#pragma unroll
            for (int t = 0; t < 16; ++t) {
                const int key = selq[t * 16 + col];
                const bf16_t* kp = kb + (size_t)key * 128;
                k0[t] = *(const bf16x8*)kp; k1[t] = *(const bf16x8*)(kp + 32);
            }
#pragma unroll
            for (int s = 4; s < 8; ++s)
#pragma unroll
                for (int i = 0; i < 4; ++i) { const int key = selq[s * 32 + i * 8 + (lane >> 3)]; vr[(s - 4) * 4 + i] = *(const u32x4*)(vb + (size_t)key * 128); }
            V_STAGE(0, 0); V_STAGE(1, 1); V_STAGE(2, 2); V_STAGE(3, 3);
            __builtin_amdgcn_sched_barrier(0);
#pragma unroll
            for (int t = 0; t < 16; ++t) {
                f32x4 a = (f32x4){0.f, 0.f, 0.f, 0.f};
                a = __builtin_amdgcn_mfma_f32_16x16x32_bf16(k0[t], qf0, a, 0, 0, 0);
                a = __builtin_amdgcn_mfma_f32_16x16x32_bf16(k1[t], qf1, a, 0, 0, 0);
                lg[t] = a;
            }
            __builtin_amdgcn_sched_barrier(0);
        }
        float mx = -INFINITY;
#pragma unroll
        for (int t = 0; t < 16; ++t)
#pragma unroll
            for (int j = 0; j < 4; ++j) { if (t * 16 + g4 * 4 + j >= nsel) lg[t][j] = -INFINITY; mx = fmaxf(mx, lg[t][j]); }
        mx = fmaxf(mx, __shfl_xor(mx, 16)); mx = fmaxf(mx, __shfl_xor(mx, 32));
        float sm = 0.f;
#pragma unroll
        for (int t = 0; t < 16; ++t)
#pragma unroll
            for (int j = 0; j < 4; ++j) { const float e = __builtin_amdgcn_exp2f(lg[t][j] - mx); lg[t][j] = e; sm += e; }
        sm += __shfl_xor(sm, 16); sm += __shfl_xor(sm, 32);
        const float inv = 1.0f / sm;
        f32x4 o[4];
#pragma unroll
        for (int d = 0; d < 4; ++d) o[d] = (f32x4){0.f, 0.f, 0.f, 0.f};
        asm volatile("s_waitcnt vmcnt(0)" ::: "memory");
#pragma unroll
        for (int s = 0; s < 8; ++s) {
            if (s >= 4) {
#pragma unroll
                for (int i = 0; i < 4; ++i) *(LAS u32x4*)(vst + (s & 3) * 4096 + i * 1024 + lane * 16) = vr[(s - 4) * 4 + i];
                asm volatile("s_waitcnt lgkmcnt(0)" ::: "memory");
            }
            const unsigned rb = rdbase + (s & 3) * 4096;
            const s16x4 l0 = tr_read<0>(rb), h0 = tr_read<2048>(rb), l1 = tr_read<32>(rb), h1_ = tr_read<2048 + 32>(rb);
            const s16x4 l2 = tr_read<64>(rb), h2_ = tr_read<2048 + 64>(rb), l3 = tr_read<96>(rb), h3 = tr_read<2048 + 96>(rb);
            asm volatile("s_waitcnt lgkmcnt(0)" ::: "memory");
            __builtin_amdgcn_sched_barrier(0);
            bf16x8 pa;
            {
                const uint32_t w0 = pack2(lg[2 * s][0], lg[2 * s][1]), w1 = pack2(lg[2 * s][2], lg[2 * s][3]);
                const uint32_t w2 = pack2(lg[2 * s + 1][0], lg[2 * s + 1][1]), w3 = pack2(lg[2 * s + 1][2], lg[2 * s + 1][3]);
                pa[0] = (short)(w0 & 0xffff); pa[1] = (short)(w0 >> 16); pa[2] = (short)(w1 & 0xffff); pa[3] = (short)(w1 >> 16);
                pa[4] = (short)(w2 & 0xffff); pa[5] = (short)(w2 >> 16); pa[6] = (short)(w3 & 0xffff); pa[7] = (short)(w3 >> 16);
            }
#define PKV(L, H) (bf16x8){L[0], L[1], L[2], L[3], H[0], H[1], H[2], H[3]}
            o[0] = __builtin_amdgcn_mfma_f32_16x16x32_bf16(pa, PKV(l0, h0), o[0], 0, 0, 0);
            o[1] = __builtin_amdgcn_mfma_f32_16x16x32_bf16(pa, PKV(l1, h1_), o[1], 0, 0, 0);
            o[2] = __builtin_amdgcn_mfma_f32_16x16x32_bf16(pa, PKV(l2, h2_), o[2], 0, 0, 0);
            o[3] = __builtin_amdgcn_mfma_f32_16x16x32_bf16(pa, PKV(l3, h3), o[3], 0, 0, 0);
#undef PKV
        }
#undef V_STAGE
        const float i0 = __shfl(inv, 0), i1 = __shfl(inv, 1), i2 = __shfl(inv, 2), i3 = __shfl(inv, 3);
        if (g4 == 0) {
            bf16_t* op = p.att() + (size_t)(row0 + q) * 512 + kvh * 256 + col;
#pragma unroll
            for (int d = 0; d < 4; ++d) {
                op[0 * 64 + d * 16] = f2bf(o[d][0] * i0); op[1 * 64 + d * 16] = f2bf(o[d][1] * i1);
                op[2 * 64 + d * 16] = f2bf(o[d][2] * i2); op[3 * 64 + d * 16] = f2bf(o[d][3] * i3);
            }
        }
    }
    __syncthreads();
}

constexpr int NBW = 512;
constexpr int W_SC = 0, W_H = W_SC + NKMAX * 2, W_SEL = W_H + NBW * 4, W_CAND = W_SEL + 512, W_SZ = W_CAND + 256;
static_assert(8 * W_SZ <= LDS_BYTES - 32, "wave attention LDS");
__device__ __forceinline__ int binw(float s, float lo, float scale) { return min(NBW - 1, max(0, (int)((s - lo) * scale))); }

__device__ __forceinline__ void attn_wave(const P& p, unsigned char* lds, int wid, int lane, int b, int t, float mn, float mx) {
    unsigned char* wl = lds + wid * W_SZ;
    _Float16* sc = (_Float16*)(wl + W_SC);
    int* hist = (int*)(wl + W_H);
    unsigned short* sel = (unsigned short*)(wl + W_SEL);
    unsigned short* cand = (unsigned short*)(wl + W_CAND);
    const int brow = b * LP, row = brow + t, n = t + 1;
    const int col = lane & 15, g4 = lane >> 4;
    const unsigned long long lt = (1ull << lane) - 1ull;
    int nsel = 256;
    if (n > 256) {
        const float lo = mn, scale = mx > mn ? (float)NBW / (mx - mn) : 0.f;
        for (int idx0 = lane * 4; idx0 < n; idx0 += 256) {
            const uint2 raw = *(const uint2*)(sc + idx0);
            const unsigned short hv[4] = {(unsigned short)(raw.x & 0xffff), (unsigned short)(raw.x >> 16), (unsigned short)(raw.y & 0xffff), (unsigned short)(raw.y >> 16)};
#pragma unroll
            for (int j = 0; j < 4; ++j) if (idx0 + j < n) atomicAdd(&hist[binw((float)__builtin_bit_cast(_Float16, hv[j]), lo, scale)], 1);
        }
        int B1, above1, cnt1;
        {
            int c[8];
            const int4 v0 = *(const int4*)(hist + 8 * lane), v1 = *(const int4*)(hist + 8 * lane + 4);
            c[0] = v0.x; c[1] = v0.y; c[2] = v0.z; c[3] = v0.w; c[4] = v1.x; c[5] = v1.y; c[6] = v1.z; c[7] = v1.w;
            int tot = 0;
#pragma unroll
            for (int i = 0; i < 8; ++i) tot += c[i];
            int suf = tot;
#pragma unroll
            for (int o = 1; o < 64; o <<= 1) { const int tt = __shfl_down(suf, o); if (lane + o < 64) suf += tt; }
            int above = suf - tot;
            const bool mine = above < 256 && 256 <= above + tot;
            int bb = 0, ab = 0, cb = 0;
#pragma unroll
            for (int i = 7; i >= 0; --i) { if (above < 256 && 256 <= above + c[i]) { bb = 8 * lane + i; ab = above; cb = c[i]; } above += c[i]; }
            const int src = (int)__builtin_ctzll(__ballot(mine));
            B1 = __shfl(bb, src); above1 = __shfl(ab, src); cnt1 = __shfl(cb, src);
        }
        int selcnt = 0, candcnt = 0;
        for (int base = 0; base < n; base += 256) {
            const int idx0 = base + lane * 4;
            uint2 raw = make_uint2(0u, 0u);
            if (idx0 < n) raw = *(const uint2*)(sc + idx0);
            const unsigned short hv[4] = {(unsigned short)(raw.x & 0xffff), (unsigned short)(raw.x >> 16), (unsigned short)(raw.y & 0xffff), (unsigned short)(raw.y >> 16)};
#pragma unroll
            for (int j = 0; j < 4; ++j) {
                const int idx = idx0 + j;
                bool issel = false, iscand = false;
                if (idx < n) { const int b1 = binw((float)__builtin_bit_cast(_Float16, hv[j]), lo, scale); issel = b1 > B1; iscand = b1 == B1; }
                const unsigned long long ms = __ballot(issel), mc = __ballot(iscand);
                if (issel) sel[selcnt + __popcll(ms & lt)] = (unsigned short)idx;
                selcnt += __popcll(ms);
                const int pos = candcnt + __popcll(mc & lt);
                if (iscand && pos < 128) cand[pos] = (unsigned short)idx;
                candcnt += __popcll(mc);
            }
        }
        {
            const int rq = 256 - above1, cq = cnt1, sbase = 256 - rq;
            if (cq <= 128) {
                int taken = 0;
#pragma unroll
                for (int half = 0; half < 2; ++half) {
                    const int i = lane + 64 * half;
                    bool take = false; int myidx = 0;
                    if (i < cq) {
                        myidx = cand[i]; const float mv = (float)sc[myidx];
                        int rank = 0;
                        for (int j = 0; j < cq; ++j) { const int oj = cand[j]; const float ov = (float)sc[oj]; rank += (ov > mv) || (ov == mv && oj < myidx); }
                        take = rank < rq;
                    }
                    const unsigned long long mt = __ballot(take);
                    if (take) sel[sbase + taken + __popcll(mt & lt)] = (unsigned short)myidx;
                    taken += __popcll(mt);
                }
            } else {
                int taken = 0;
                for (int base = 0; base < n && taken < rq; base += 64) {
                    const int idx = base + lane; bool isc = false;
                    if (idx < n) isc = binw((float)sc[idx], lo, scale) == B1;
                    const unsigned long long mc = __ballot(isc);
                    const int pos = taken + __popcll(mc & lt);
                    if (isc && pos < rq) sel[sbase + pos] = (unsigned short)idx;
                    taken += __popcll(mc);
                }
            }
        }
    } else {
        nsel = n;
#pragma unroll
        for (int i = 0; i < 4; ++i) { const int j = lane + 64 * i; sel[j] = (unsigned short)(j < n ? j : 0); }
    }
    LAS unsigned char* vst = (LAS unsigned char*)wl + W_SC;
    const unsigned rdbase = (unsigned)(uintptr_t)((LAS unsigned char*)wl + W_SC) + (4 * g4 + (col >> 2)) * 128 + (col & 3) * 8;
#pragma unroll 1
    for (int kvh = 0; kvh < 2; ++kvh) {
        bf16x8 qf0, qf1;
        {
            const bf16_t* qp = p.q() + (size_t)row * 512 + (kvh * 4 + (col & 3)) * 64 + g4 * 8;
            qf0 = *(const bf16x8*)qp; qf1 = *(const bf16x8*)(qp + 32);
            if (col >= 4) {
#pragma unroll
                for (int i = 0; i < 8; ++i) { qf0[i] = 0; qf1[i] = 0; }
            }
        }
        const bf16_t* vb = p.v() + (size_t)brow * 128 + kvh * 64 + (lane & 7) * 8;
        const bf16_t* kb = p.k() + (size_t)brow * 128 + kvh * 64 + g4 * 8;
#define V_STAGE(s_, buf_) do { _Pragma("unroll") for (int i_ = 0; i_ < 4; ++i_) { \
            const int key_ = sel[(s_) * 32 + i_ * 8 + (lane >> 3)]; \
            __builtin_amdgcn_global_load_lds((const unsigned*)(vb + (size_t)key_ * 128), (LAS unsigned*)(vst + (buf_) * 4096 + i_ * 1024), 16, 0, 0); } } while (0)
        f32x4 lg[16];
#pragma unroll
        for (int hb = 0; hb < 2; ++hb) {
            bf16x8 k0[8], k1[8];
#pragma unroll
            for (int tt = 0; tt < 8; ++tt) {
                const int key = sel[(hb * 8 + tt) * 16 + col];
                const bf16_t* kp = kb + (size_t)key * 128;
                k0[tt] = *(const bf16x8*)kp; k1[tt] = *(const bf16x8*)(kp + 32);
            }
            __builtin_amdgcn_sched_barrier(0);
#pragma unroll
            for (int tt = 0; tt < 8; ++tt) {
                f32x4 a = (f32x4){0.f, 0.f, 0.f, 0.f};
                a = __builtin_amdgcn_mfma_f32_16x16x32_bf16(k0[tt], qf0, a, 0, 0, 0);
                a = __builtin_amdgcn_mfma_f32_16x16x32_bf16(k1[tt], qf1, a, 0, 0, 0);
                lg[hb * 8 + tt] = a;
            }
            __builtin_amdgcn_sched_barrier(0);
        }
        V_STAGE(0, 0); V_STAGE(1, 1); V_STAGE(2, 2); V_STAGE(3, 3);
        float mxl = -INFINITY;
#pragma unroll
        for (int tt = 0; tt < 16; ++tt)
#pragma unroll
            for (int j = 0; j < 4; ++j) { if (tt * 16 + g4 * 4 + j >= nsel) lg[tt][j] = -INFINITY; mxl = fmaxf(mxl, lg[tt][j]); }
        mxl = fmaxf(mxl, __shfl_xor(mxl, 16)); mxl = fmaxf(mxl, __shfl_xor(mxl, 32));
        float sm = 0.f;
#pragma unroll
        for (int tt = 0; tt < 16; ++tt)
#pragma unroll
            for (int j = 0; j < 4; ++j) { const float e = __builtin_amdgcn_exp2f(lg[tt][j] - mxl); lg[tt][j] = e; sm += e; }
        sm += __shfl_xor(sm, 16); sm += __shfl_xor(sm, 32);
        const float inv = 1.0f / sm;
        f32x4 o[4];
#pragma unroll
        for (int d = 0; d < 4; ++d) o[d] = (f32x4){0.f, 0.f, 0.f, 0.f};
#pragma unroll
        for (int s = 0; s < 8; ++s) {
            if (s <= 4) asm volatile("s_waitcnt vmcnt(12)" ::: "memory");
            else if (s == 5) asm volatile("s_waitcnt vmcnt(8)" ::: "memory");
            else if (s == 6) asm volatile("s_waitcnt vmcnt(4)" ::: "memory");
            else asm volatile("s_waitcnt vmcnt(0)" ::: "memory");
            const unsigned rb = rdbase + (s & 3) * 4096;
            const s16x4 l0 = tr_read<0>(rb), h0 = tr_read<2048>(rb), l1 = tr_read<32>(rb), h1_ = tr_read<2048 + 32>(rb);
            const s16x4 l2 = tr_read<64>(rb), h2_ = tr_read<2048 + 64>(rb), l3 = tr_read<96>(rb), h3 = tr_read<2048 + 96>(rb);
            asm volatile("s_waitcnt lgkmcnt(0)" ::: "memory");
            __builtin_amdgcn_sched_barrier(0);
            if (s + 4 < 8) V_STAGE(s + 4, s & 3);
            bf16x8 pa;
            {
                const uint32_t w0 = pack2(lg[2 * s][0], lg[2 * s][1]), w1 = pack2(lg[2 * s][2], lg[2 * s][3]);
                const uint32_t w2 = pack2(lg[2 * s + 1][0], lg[2 * s + 1][1]), w3 = pack2(lg[2 * s + 1][2], lg[2 * s + 1][3]);
                pa[0] = (short)(w0 & 0xffff); pa[1] = (short)(w0 >> 16); pa[2] = (short)(w1 & 0xffff); pa[3] = (short)(w1 >> 16);
                pa[4] = (short)(w2 & 0xffff); pa[5] = (short)(w2 >> 16); pa[6] = (short)(w3 & 0xffff); pa[7] = (short)(w3 >> 16);
            }
#define PKV(L, H) (bf16x8){L[0], L[1], L[2], L[3], H[0], H[1], H[2], H[3]}
            o[0] = __builtin_amdgcn_mfma_f32_16x16x32_bf16(pa, PKV(l0, h0), o[0], 0, 0, 0);
            o[1] = __builtin_amdgcn_mfma_f32_16x16x32_bf16(pa, PKV(l1, h1_), o[1], 0, 0, 0);
            o[2] = __builtin_amdgcn_mfma_f32_16x16x32_bf16(pa, PKV(l2, h2_), o[2], 0, 0, 0);
            o[3] = __builtin_amdgcn_mfma_f32_16x16x32_bf16(pa, PKV(l3, h3), o[3], 0, 0, 0);
#undef PKV
        }
#undef V_STAGE
        const float i0 = __shfl(inv, 0), i1 = __shfl(inv, 1), i2 = __shfl(inv, 2), i3 = __shfl(inv, 3);
        if (g4 == 0) {
            bf16_t* op = p.att() + (size_t)row * 512 + kvh * 256 + col;
#pragma unroll
            for (int d = 0; d < 4; ++d) {
                op[0 * 64 + d * 16] = f2bf(o[d][0] * i0); op[1 * 64 + d * 16] = f2bf(o[d][1] * i1);
                op[2 * 64 + d * 16] = f2bf(o[d][2] * i2); op[3 * 64 + d * 16] = f2bf(o[d][3] * i3);
            }
        }
    }
}

constexpr int A8_META = 8 * W_SZ;
static_assert(A8_META + 64 <= LDS_BYTES - 32, "attn8 meta");
__device__ __forceinline__ void attn8_unit(const P& p, unsigned char* lds, int b, int grp) {
    const int tid = tid_(), lane = tid & 63, wid = __builtin_amdgcn_readfirstlane(tid >> 6);
    const int t0 = NMETA + 8 * grp, brow = b * LP, row0 = brow + t0;
    unsigned* meta = (unsigned*)(lds + A8_META);
    const bool big = t0 + 1 > 256;
    if (tid < 16) meta[tid] = (tid & 1) ? 0u : 0xffffffffu;
    for (int i = tid; i < 8 * NBW; i += NTHREADS) ((int*)(lds + (i / NBW) * W_SZ + W_H))[i % NBW] = 0;
    __syncthreads();
    if (big) {
        const int hh = lane >> 5, c32 = lane & 31;
        const int g = c32 >> 3, h2a = (c32 >> 2) & 1, bq = c32 & 3, aq = 2 * h2a + (g >> 1), ah = 4 * (g & 1) + bq;
        bf16x8 a0[2], a1[2]; f32x4 w[2][2][2];
#pragma unroll
        for (int r = 0; r < 2; ++r) {
            const bf16_t* ap = p.iq() + (size_t)(row0 + 4 * r + aq) * 256 + ah * 32 + 8 * hh;
            a0[r] = *(const bf16x8*)ap; a1[r] = *(const bf16x8*)(ap + 16);
#pragma unroll
            for (int qi = 0; qi < 2; ++qi) {
                const float* wp = p.iw() + (size_t)(row0 + 4 * r + 2 * hh + qi) * 8;
                w[r][qi][0] = *(const f32x4*)wp; w[r][qi][1] = *(const f32x4*)(wp + 4);
            }
        }
        const int ntiles = (t0 + 8 + 31) >> 5;
        float mx[2][2], mn[2][2];
#pragma unroll
        for (int r = 0; r < 2; ++r)
#pragma unroll
            for (int qi = 0; qi < 2; ++qi) { mx[r][qi] = -INFINITY; mn[r][qi] = INFINITY; }
        const bf16_t* kbase = p.ik() + (size_t)brow * 32 + 8 * hh;
        for (int tile0 = wid; tile0 < ntiles; tile0 += 64) {
            bf16x8 b0[8], b1[8];
#pragma unroll
            for (int j = 0; j < 8; ++j) {
                const int tile = min(tile0 + 8 * j, ntiles - 1);
                const bf16_t* kp = kbase + (size_t)(tile * 32 + c32) * 32;
                b0[j] = *(const bf16x8*)kp; b1[j] = *(const bf16x8*)(kp + 16);
            }
            __builtin_amdgcn_sched_barrier(0);
#pragma unroll
            for (int j = 0; j < 8; ++j) {
                const int tile = tile0 + 8 * j;
                if (tile < ntiles) {
                    const int key = tile * 32 + c32;
#pragma unroll
                    for (int r = 0; r < 2; ++r) {
                        f32x16 acc;
#pragma unroll
                        for (int i = 0; i < 16; ++i) acc[i] = 0.f;
                        acc = __builtin_amdgcn_mfma_f32_32x32x16_bf16(a0[r], b0[j], acc, 0, 0, 0);
                        acc = __builtin_amdgcn_mfma_f32_32x32x16_bf16(a1[r], b1[j], acc, 0, 0, 0);
#pragma unroll
                        for (int qi = 0; qi < 2; ++qi) {
                            float s = 0.f;
#pragma unroll
                            for (int i = 0; i < 4; ++i) s += w[r][qi][0][i] * fmaxf(acc[8 * qi + i], 0.f) + w[r][qi][1][i] * fmaxf(acc[8 * qi + 4 + i], 0.f);
                            const int q = 4 * r + 2 * hh + qi;
                            const _Float16 hs = (_Float16)fminf(fmaxf(s, -60000.f), 60000.f);
                            ((_Float16*)(lds + q * W_SZ + W_SC))[key] = hs;
                            if (key <= t0 + q) { const float f = (float)hs; mx[r][qi] = fmaxf(mx[r][qi], f); mn[r][qi] = fminf(mn[r][qi], f); }
                        }
                    }
                }
            }
        }
#pragma unroll
        for (int r = 0; r < 2; ++r)
#pragma unroll
            for (int qi = 0; qi < 2; ++qi) {
                float a = mx[r][qi], c = mn[r][qi];
#pragma unroll
                for (int o = 16; o >= 1; o >>= 1) { a = fmaxf(a, __shfl_xor(a, o)); c = fminf(c, __shfl_xor(c, o)); }
                if (c32 == 0 && a >= c) { const int q = 4 * r + 2 * hh + qi; atomicMin(&meta[q * 2], skey(c)); atomicMax(&meta[q * 2 + 1], skey(a)); }
            }
    }
    __syncthreads();
    const float mnq = big ? skey_inv(meta[wid * 2]) : 0.f, mxq = big ? skey_inv(meta[wid * 2 + 1]) : 0.f;
    attn_wave(p, lds, wid, lane, b, t0 + wid, mnq, mxq);
    __syncthreads();
}

constexpr int NGRP8 = SEQ / 8, ATT_P1 = NGRP8 / 8, ATT_P2 = NGRP8 / 2;
template <int SUB>
__device__ __forceinline__ void ph_mixer(const P& p, unsigned char* lds) {
    int* bc = (int*)(lds + LDS_BYTES - 16);
    constexpr int nh = SUB == 1 ? 16 : NXU;
    constexpr int a0 = SUB == 0 ? 0 : (SUB == 1 ? ATT_P1 : ATT_P2), a1 = SUB == 0 ? ATT_P1 : (SUB == 1 ? ATT_P2 : NGRP8);
    for (;;) {
        __syncthreads();
        if (tid_() == 0) bc[0] = atomicAdd(&p.ctr()[97 + SUB], 1);
        __syncthreads();
        const int it = bc[0];
        if (it >= nh) break;
        if (SUB == 0) hgx_unit(p, lds, it);
        else if (SUB == 1) hgchain_unit(p, it);
        else hgz_unit(p, lds, it);
    }
    const int b0 = (int)(xb_xcc_id() & 3u);
#pragma unroll 1
    for (int k = 0; k < 4; ++k) {
        const int b = (b0 + k) & 3;
        for (;;) {
            __syncthreads();
            if (tid_() == 0) bc[0] = atomicAdd(&p.ctr()[104 + SUB * 4 + b], 1);
            __syncthreads();
            const int it = bc[0];
            if (it >= a1 - a0) break;
            attn8_unit(p, lds, b, NGRP8 - 1 - (a0 + it));
        }
    }
}

__device__ __forceinline__ int tok_row(int tok) { return (tok >> 13) * LP + NMETA + (tok & 8191); }
__device__ __forceinline__ void ph_mix(const P& p, unsigned char* lds) {
    const int njobs = (NTOK / 256) * 4 * 2, G = gridDim.x, b0 = blockIdx.x;
    auto jobidx = [&](int i) __attribute__((always_inline)) { return (b0 + (i >> 1) * G) * 2 + (i & 1); };
    auto jobfn = [&](int i, GJob& j) __attribute__((always_inline)) -> bool {
        const int jb = jobidx(i); if (jb >= njobs) return false;
        const int which = jb & 1, u = jb >> 1, nt = u & 3, mt = u >> 2; const size_t r0 = (size_t)tok_row(mt * 256);
        j.A = (const char*)((which ? p.hgr() : p.att()) + r0 * 512); j.B = (const char*)((which ? p.wuhT() : p.wuaT()) + (size_t)nt * 256 * 512); return true; };
    auto epi = [&](f32x4 (&acc)[2][2][4][2], int i) __attribute__((always_inline)) {
        const int jb = jobidx(i), which = jb & 1, u = jb >> 1, nt = u & 3, mt = u >> 2; const size_t r0 = (size_t)tok_row(mt * 256);
        if (which == 0) {
            EPI8(
                const size_t og = (r0 + row) * 1024 + nt * 256 + col, om = (size_t)(mt * 256 + row) * 1024 + nt * 256 + col;
                const uint2 g = *(const uint2*)(p.ga() + og);
                f32x4 r;
                r[0] = v[0] * __uint_as_float(g.x << 16); r[1] = v[1] * __uint_as_float(g.x & 0xffff0000u);
                r[2] = v[2] * __uint_as_float(g.y << 16); r[3] = v[3] * __uint_as_float(g.y & 0xffff0000u);
                st_bf4(p.mix() + om, r);
            );
        } else {
            EPI8(
                const size_t og = (r0 + row) * 1024 + nt * 256 + col, om = (size_t)(mt * 256 + row) * 1024 + nt * 256 + col;
                const uint2 g = *(const uint2*)(p.gh() + og);
                const uint2 a = *(const uint2*)(p.mix() + om);
                f32x4 r;
                r[0] = __uint_as_float(a.x << 16) + v[0] * __uint_as_float(g.x << 16); r[1] = __uint_as_float(a.x & 0xffff0000u) + v[1] * __uint_as_float(g.x & 0xffff0000u);
                r[2] = __uint_as_float(a.y << 16) + v[2] * __uint_as_float(g.y << 16); r[3] = __uint_as_float(a.y & 0xffff0000u) + v[3] * __uint_as_float(g.y & 0xffff0000u);
                st_bf4(p.mix() + om, r);
            );
        }
    };
    unsigned vbU[2]; gj_lin2(vbU, 512);
    gemm_stream<false>(lds, 512, 512, (size_t)128 * 512 * 2, vbU, jobfn, epi);
}

__device__ __forceinline__ void ph_out(const P& p, unsigned char* lds) {
    const int nunits = (NTOK / 256) * 4, G = gridDim.x, b0 = blockIdx.x;
    auto jobfn = [&](int i, GJob& j) __attribute__((always_inline)) -> bool {
        const int u = b0 + i * G; if (u >= nunits) return false;
        const int nt = u & 3, mt = u >> 2;
        j.A = (const char*)(p.mix() + (size_t)mt * 256 * D); j.B = (const char*)(p.woT() + (size_t)nt * 256 * D); return true; };
    auto epi = [&](f32x4 (&acc)[2][2][4][2], int i) __attribute__((always_inline)) {
        const int u = b0 + i * G, nt = u & 3, mt = u >> 2;
        EPI8(
            const size_t o = (size_t)(mt * 256 + row) * D + nt * 256 + col;
            const f32x4 h0 = *(const f32x4*)(p.x + o);
            *(f32x4*)(p.out + o) = h0 + v;
        );
    };
    unsigned vbU[2]; gj_lin2(vbU, D);
    gemm_stream<false>(lds, D, D, (size_t)128 * D * 2, vbU, jobfn, epi);
}

constexpr int XS_LD = 1025;
__device__ __forceinline__ void ph_route(const P& p, unsigned char* lds) {
    const int tid = tid_(), lane = tid & 63, wid = __builtin_amdgcn_readfirstlane(tid >> 6);
    const int gt = blockIdx.x * NTHREADS + tid, ntot = gridDim.x * NTHREADS;
    for (int i = gt; i < CAP; i += ntot) p.slot_token()[i] = -1;
    float* xs = (float*)lds;
    int* lhist = (int*)(lds + 32 * XS_LD * 4);
    for (int tb = blockIdx.x; tb < NTOK / 128; tb += gridDim.x) {
        if (tid < 32) lhist[tid] = 0;
        for (int tile = 0; tile < 4; ++tile) {
            const int tokt = tb * 128 + tile * 32;
            __syncthreads();
#pragma unroll
            for (int t = 0; t < 4; ++t) {
                const int tl = wid * 4 + t, tok = tokt + tl;
                const float* src = p.out + (size_t)tok * D;
                f32x4 v[4]; float ss = 0.f;
#pragma unroll
                for (int i = 0; i < 4; ++i) { v[i] = *(const f32x4*)(src + lane * 4 + 256 * i); ss += v[i][0] * v[i][0] + v[i][1] * v[i][1] + v[i][2] * v[i][2] + v[i][3] * v[i][3]; }
                ss = wave_sum(ss);
                const float rs = rsqrtf(ss * (1.0f / D) + EPS);
#pragma unroll
                for (int i = 0; i < 4; ++i) {
                    const f32x4 g = *(const f32x4*)(p.ffn_g + lane * 4 + 256 * i);
                    f32x4 xn; xn[0] = v[i][0] * rs * g[0]; xn[1] = v[i][1] * rs * g[1]; xn[2] = v[i][2] * rs * g[2]; xn[3] = v[i][3] * rs * g[3];
                    st_bf4(p.xn2() + (size_t)tok * D + lane * 4 + 256 * i, xn);
#pragma unroll
                    for (int c = 0; c < 4; ++c) xs[tl * XS_LD + lane * 4 + 256 * i + c] = xn[c];
                }
            }
            __syncthreads();
            f32x16 acc;
#pragma unroll
            for (int i = 0; i < 16; ++i) acc[i] = 0.f;
            {
                const float* xr = xs + (lane & 31) * XS_LD + wid * 128 + (lane >> 5);
                const float* wp = p.router_w + (size_t)(wid * 128 + (lane >> 5)) * 32 + (lane & 31);
#pragma unroll 16
                for (int i = 0; i < 64; ++i) acc = __builtin_amdgcn_mfma_f32_32x32x2f32(xr[2 * i], wp[(size_t)(2 * i) * 32], acc, 0, 0, 0);
            }
            __syncthreads();
#pragma unroll
            for (int r = 0; r < 16; ++r) xs[wid * 1024 + ((r & 3) + 8 * (r >> 2) + 4 * (lane >> 5)) * 32 + (lane & 31)] = acc[r];
            __syncthreads();
            const int e = lane & 31, hh = lane >> 5;
            const float be = p.router_b[e];
#pragma unroll
            for (int it = 0; it < 2; ++it) {
                const int tl = wid * 4 + it * 2 + hh;
                float l = be;
#pragma unroll
                for (int w = 0; w < 8; ++w) l += xs[w * 1024 + tl * 32 + e];
                float bv[4]; int bi[4];
#pragma unroll
                for (int k = 0; k < 4; ++k) {
                    float m = l;
#pragma unroll
                    for (int o = 16; o >= 1; o >>= 1) m = fmaxf(m, __shfl_xor(m, o));
                    const unsigned long long bal = __ballot(l == m);
                    const unsigned half = hh ? (unsigned)(bal >> 32) : (unsigned)bal;
                    const int idx = __builtin_ctz(half);
                    bv[k] = m; bi[k] = idx;
                    if (e == idx) l = -INFINITY;
                }
                const float e1 = __expf(bv[1] - bv[0]), e2 = __expf(bv[2] - bv[0]), e3 = __expf(bv[3] - bv[0]);
                const float inv = 1.0f / (1.0f + e1 + e2 + e3);
                if (e == 0) {
                    const int tok = tokt + tl;
                    p.tok_exp()[tok * 4 + 0] = bi[0]; p.tok_exp()[tok * 4 + 1] = bi[1]; p.tok_exp()[tok * 4 + 2] = bi[2]; p.tok_exp()[tok * 4 + 3] = bi[3];
                    p.tok_gate()[tok * 4 + 0] = inv; p.tok_gate()[tok * 4 + 1] = e1 * inv; p.tok_gate()[tok * 4 + 2] = e2 * inv; p.tok_gate()[tok * 4 + 3] = e3 * inv;
                    atomicAdd(&lhist[bi[0]], 1); atomicAdd(&lhist[bi[1]], 1); atomicAdd(&lhist[bi[2]], 1); atomicAdd(&lhist[bi[3]], 1);
                }
            }
        }
        __syncthreads();
        if (tid < 32) p.wg_cnt()[tb * 32 + tid] = lhist[tid];
        __syncthreads();
    }
    for (long task = gt; task < 96L * 16384; task += ntot) {
        const int mat = (int)(task >> 14), r = (int)(task & 16383), kq = r >> 10, n = r & 1023;
        const int which = mat >> 5, e = mat & 31;
        const float* W = (which == 0 ? p.w_gate : which == 1 ? p.w_up : p.w_down) + (size_t)e * 1048576 + (size_t)(kq * 64) * 1024 + n;
        bf16_t* outp = (which == 0 ? p.wgT() : which == 1 ? p.wuT() : p.wdT()) + (size_t)e * 1048576 + (size_t)n * 1024 + kq * 64;
        float v[64];
#pragma unroll
        for (int i = 0; i < 64; ++i) v[i] = W[(size_t)i * 1024];
        uint4* dst = (uint4*)outp;
#pragma unroll
        for (int i = 0; i < 8; ++i) dst[i] = make_uint4(pack2(v[8 * i], v[8 * i + 1]), pack2(v[8 * i + 2], v[8 * i + 3]), pack2(v[8 * i + 4], v[8 * i + 5]), pack2(v[8 * i + 6], v[8 * i + 7]));
    }
}

__device__ __forceinline__ void ph_fill(const P& p, unsigned char* lds) {
    const int tid = tid_();
    int* tot = (int*)lds;
    int* pre = tot + 512;
    int* ps = pre + 512;
    int* lc = ps + 32;
    for (int tb = blockIdx.x; tb < NTOK / 128; tb += gridDim.x) {
        {
            const int e = tid & 31, part = tid >> 5;
            int t = 0, q = 0;
            for (int b2 = part; b2 < NTOK / 128; b2 += 16) { const int c = p.wg_cnt()[b2 * 32 + e]; t += c; if (b2 < tb) q += c; }
            tot[part * 32 + e] = t; pre[part * 32 + e] = q;
        }
        __syncthreads();
        if (tid == 0) {
            int acc = 0;
            for (int e = 0; e < NE; ++e) {
                int t = 0, q = 0;
                for (int i = 0; i < 16; ++i) { t += tot[i * 32 + e]; q += pre[i * 32 + e]; }
                ps[e] = acc + q; lc[e] = 0;
                const int nb = (t + 255) >> 8;
                if (tb == 0) for (int i = 0; i < nb; ++i) p.block_expert()[(acc >> 8) + i] = e;
                acc += nb * 256;
            }
            if (tb == 0) p.ctr()[96] = acc >> 8;
        }
        __syncthreads();
        {
            const int i = tb * 512 + tid;
            const int e = p.tok_exp()[i];
            const int dest = ps[e] + atomicAdd(&lc[e], 1);
            p.slot_token()[dest] = i >> 2;
            p.slot_rank()[dest] = i & 3;
            p.slot_gate()[dest] = p.tok_gate()[i];
        }
        __syncthreads();
    }
}

struct GUOff { __device__ __forceinline__ size_t operator()(int R) const { return (size_t)(R >> 7) * (WE_B / 2) + (size_t)(R & 127) * 1024; } };
struct GatherOff { const int* st; __device__ __forceinline__ size_t operator()(int R) const { const int t = st[R]; return (size_t)(t < 0 ? 0 : t) * 1024; } };
__device__ __forceinline__ void ph_moe1(const P& p, unsigned char* lds) {
    const int nunits = p.ctr()[96] * 8, G = gridDim.x, b0 = blockIdx.x;
    auto jobfn = [&](int i, GJob& j) __attribute__((always_inline)) -> bool {
        const int u = b0 + i * G; if (u >= nunits) return false;
        const int ct = u & 7, rb = u >> 3, e = p.block_expert()[rb];
        j.A = (const char*)p.xn2(); j.B = (const char*)(p.wgT() + (size_t)e * 1048576 + (size_t)ct * 128 * 1024); gj_gather_job(j, GatherOff{p.slot_token() + rb * 256}); return true; };
    auto epi = [&](f32x4 (&acc)[2][2][4][2], int i) __attribute__((always_inline)) {
        const int u = b0 + i * G, ct = u & 7, rb = u >> 3, e = p.block_expert()[rb];
        const int tid_e = tid_(), lane_e = tid_e & 63, wid_e = tid_e >> 6, wr = wid_e >> 2, wc = wid_e & 3, fr = lane_e & 15, fq = lane_e >> 4;
#pragma unroll
        for (int n = 0; n < 2; ++n) {
            const int c = ct * 128 + wc * 32 + n * 16 + fq * 4;
            const f32x4 bg = *(const f32x4*)(p.b_gate + (size_t)e * DFF + c), bu = *(const f32x4*)(p.b_up + (size_t)e * DFF + c);
#pragma unroll
            for (int ai = 0; ai < 2; ++ai)
#pragma unroll
                for (int m = 0; m < 4; ++m) {
                    const int row = rb * 256 + ai * 128 + wr * 64 + m * 16 + fr;
                    f32x4 a;
#pragma unroll
                    for (int j = 0; j < 4; ++j) {
                        const float g = fminf(acc[ai][0][m][n][j] + bg[j], 7.0f);
                        const float uu = fminf(fmaxf(acc[ai][1][m][n][j] + bu[j], -7.0f), 7.0f);
                        a[j] = (uu + 1.0f) * (g * sigmoidf_(1.702f * g));
                    }
                    st_bf4(p.act() + (size_t)row * DFF + c, a);
                }
        }
    };
    unsigned vbU[2]; gj_lin2(vbU, D);
    gemm_stream<true>(lds, D, D, (size_t)WE_B, vbU, jobfn, epi);
}
__device__ __forceinline__ void ph_moe2(const P& p, unsigned char* lds) {
    const int nunits = p.ctr()[96] * 4, G = gridDim.x, b0 = blockIdx.x;
    auto jobfn = [&](int i, GJob& j) __attribute__((always_inline)) -> bool {
        const int u = b0 + i * G; if (u >= nunits) return false;
        const int nt = u & 3, rb = u >> 2, e = p.block_expert()[rb];
        j.A = (const char*)(p.act() + (size_t)rb * 256 * DFF); j.B = (const char*)(p.wdT() + (size_t)e * 1048576 + (size_t)nt * 256 * DFF); return true; };
    auto epi = [&](f32x4 (&acc)[2][2][4][2], int i) __attribute__((always_inline)) {
        const int u = b0 + i * G, nt = u & 3, rb = u >> 2, e = p.block_expert()[rb];
        const int tid_e = tid_(), lane_e = tid_e & 63, wid_e = tid_e >> 6, wr = wid_e >> 2, wc = wid_e & 3, fr = lane_e & 15, fq = lane_e >> 4;
        f32x4 bd[2][2];
#pragma unroll
        for (int bj = 0; bj < 2; ++bj)
#pragma unroll
            for (int n = 0; n < 2; ++n) bd[bj][n] = *(const f32x4*)(p.b_down + (size_t)e * D + nt * 256 + bj * 128 + wc * 32 + n * 16 + fq * 4);
#pragma unroll
        for (int ai = 0; ai < 2; ++ai)
#pragma unroll
            for (int m = 0; m < 4; ++m) {
                const int slot = rb * 256 + ai * 128 + wr * 64 + m * 16 + fr;
                const int tok = p.slot_token()[slot];
                if (tok < 0) continue;
                const int rank = p.slot_rank()[slot]; const float gate = p.slot_gate()[slot];
                const size_t o = (size_t)tok * D + nt * 256 + wc * 32 + fq * 4;
                if (rank == 0) {
#pragma unroll
                    for (int bj = 0; bj < 2; ++bj)
#pragma unroll
                        for (int n = 0; n < 2; ++n) { float* d = p.out + o + bj * 128 + n * 16; *(f32x4*)d = *(const f32x4*)d + (acc[ai][bj][m][n] + bd[bj][n]) * gate; }
                } else {
                    bf16_t* yb = rank == 1 ? p.y1() : (rank == 2 ? p.y2() : p.y3());
#pragma unroll
                    for (int bj = 0; bj < 2; ++bj)
#pragma unroll
                        for (int n = 0; n < 2; ++n) st_bf4(yb + o + bj * 128 + n * 16, (acc[ai][bj][m][n] + bd[bj][n]) * gate);
                }
            }
    };
    unsigned vbU[2]; gj_lin2(vbU, DFF);
    gemm_stream<false>(lds, DFF, DFF, (size_t)128 * DFF * 2, vbU, jobfn, epi);
}

__device__ __forceinline__ void ph_final(const P& p, unsigned char* lds) {
    const int tid = tid_(), lane = tid & 63, wid = tid >> 6;
    const int gw = blockIdx.x * 8 + wid, nw = gridDim.x * 8;
    for (int tok = gw; tok < NTOK; tok += nw) {
        float* dst = p.out + (size_t)tok * D;
        f32x4 v[4];
#pragma unroll
        for (int i = 0; i < 4; ++i) v[i] = *(const f32x4*)(dst + lane * 4 + 256 * i);
#pragma unroll
        for (int j = 0; j < 3; ++j) {
            const bf16_t* yr = (j == 0 ? p.y1() : j == 1 ? p.y2() : p.y3()) + (size_t)tok * D;
#pragma unroll
            for (int i = 0; i < 4; ++i) {
                const uint2 w = *(const uint2*)(yr + lane * 4 + 256 * i);
                v[i][0] += __uint_as_float(w.x << 16); v[i][1] += __uint_as_float(w.x & 0xffff0000u);
                v[i][2] += __uint_as_float(w.y << 16); v[i][3] += __uint_as_float(w.y & 0xffff0000u);
            }
        }
        float ss = 0.f;
#pragma unroll
        for (int i = 0; i < 4; ++i) ss += v[i][0] * v[i][0] + v[i][1] * v[i][1] + v[i][2] * v[i][2] + v[i][3] * v[i][3];
        ss = wave_sum(ss);
        const float rs = rsqrtf(ss * (1.0f / D) + EPS);
#pragma unroll
        for (int i = 0; i < 4; ++i) {
            const f32x4 g = *(const f32x4*)(p.final_g + lane * 4 + 256 * i);
            *(f32x4*)(dst + lane * 4 + 256 * i) = v[i] * rs * g;
        }
    }
}

typedef const __attribute__((address_space(4))) P* PK;
#define PHASE(call) do { PK q_ = pk; asm volatile("" : "+s"(q_)); const P& p = *(const P*)q_; call; } while (0)
__global__ void __launch_bounds__(NTHREADS) k_mega(P p_unused) {
    __shared__ __attribute__((aligned(16))) unsigned char lds[LDS_BYTES];
    cg::grid_group grid = cg::this_grid();
    const PK pk = (PK)__builtin_amdgcn_kernarg_segment_ptr();
    if (tid_() < 4) ((unsigned*)(lds + LDS_BYTES - 32))[tid_()] = 0u;
    __syncthreads();
    XcdBarrier xb;
    PHASE(xb = xcd_barrier_post((unsigned*)(p.ws + OFF_BAR), (volatile LAS unsigned*)(lds + LDS_BYTES - 32)));
    PHASE(ph_prep(p, lds)); grid.sync();
    PHASE(ph_inproj(p, lds)); xcd_barrier(xb);
    PHASE(ph_mixer<0>(p, lds)); xcd_barrier(xb);
    PHASE(ph_mixer<1>(p, lds)); xcd_barrier(xb);
    PHASE(ph_mixer<2>(p, lds)); xcd_barrier(xb);
    PHASE(ph_mix(p, lds)); xcd_barrier(xb);
    PHASE(ph_out(p, lds)); xcd_barrier(xb);
    PHASE(ph_route(p, lds)); xcd_barrier(xb);
    PHASE(ph_fill(p, lds)); xcd_barrier(xb);
    PHASE(ph_moe1(p, lds)); xcd_barrier(xb);
    PHASE(ph_moe2(p, lds)); xcd_barrier(xb);
    PHASE(ph_final(p, lds));
}

extern "C" void kernel_launch(void* const* d_in, const int* in_sizes, int n_in, void* d_out, int out_size, void* d_ws, size_t ws_size,
                              hipStream_t stream) {
    P p{};
    p.x = (const float*)d_in[0]; p.meta = (const float*)d_in[1]; p.attn_g = (const float*)d_in[2]; p.w_in = (const float*)d_in[3];
    p.hgrn_g = (const float*)d_in[4]; p.w_ua = (const float*)d_in[5]; p.w_uh = (const float*)d_in[6]; p.w_out = (const float*)d_in[7];
    p.lb_logits = (const float*)d_in[8]; p.ffn_g = (const float*)d_in[9]; p.router_w = (const float*)d_in[10]; p.router_b = (const float*)d_in[11];
    p.w_gate = (const float*)d_in[12]; p.b_gate = (const float*)d_in[13]; p.w_up = (const float*)d_in[14]; p.b_up = (const float*)d_in[15];
    p.w_down = (const float*)d_in[16]; p.b_down = (const float*)d_in[17]; p.final_g = (const float*)d_in[18];
    p.out = (float*)d_out;
    p.ws = (unsigned char*)d_ws;
    if (WS_NEED > ws_size) { fprintf(stderr, "workspace too small: need %zu have %zu\n", (size_t)WS_NEED, ws_size); return; }
    static int grid_blocks = 0;
    if (!grid_blocks) {
        int dev = 0, cus = 0, per_cu = 0;
        hipGetDevice(&dev);
        hipDeviceGetAttribute(&cus, hipDeviceAttributeMultiprocessorCount, dev);
        hipOccupancyMaxActiveBlocksPerMultiprocessor(&per_cu, k_mega, NTHREADS, 0);
        if (per_cu > 1) per_cu = 1;
        grid_blocks = cus * per_cu;
    }
    hipMemsetAsync(p.ws + OFF_BAR, 0, XCD_BAR_WORDS * 4, stream);
    void* args[] = {&p};
    hipError_t e = hipLaunchCooperativeKernel((void*)k_mega, dim3(grid_blocks), dim3(NTHREADS), args, 0, stream);
    if (e != hipSuccess) fprintf(stderr, "cooperative launch failed: %s (grid %d)\n", hipGetErrorString(e), grid_blocks);
}
```

```cpp
#include <hip/hip_runtime.h>
#include <hip/hip_cooperative_groups.h>
#include <stdint.h>
#include <cstdio>
namespace cg = cooperative_groups;

#ifndef MEGA
#define MEGA 1
#endif

typedef unsigned short bf16_t;
typedef short bf16x8 __attribute__((ext_vector_type(8)));
typedef float f32x4 __attribute__((ext_vector_type(4)));

constexpr int D = 1024, NB = 4, SEQ = 8192, NMETA = 16, L = SEQ + NMETA  , LP = 8320, T = NB * LP  ;
constexpr int NTOK = NB * SEQ;
constexpr int IN_COLS = 5160;
constexpr int NE = 32, TOPK = 4, DFF = 1024;
constexpr int CAP_BLOCKS = (NTOK * TOPK) / 256 + NE;
constexpr int CAP = CAP_BLOCKS * 256;
constexpr float EPS = 1e-5f;
constexpr int NTHREADS = 512;
constexpr int LDS_BYTES = 155648;
constexpr int NVC = 5376;
#define LAS __attribute__((address_space(3)))

__device__ __forceinline__ bf16_t f2bf(float f) {
    uint32_t u = __float_as_uint(f);
    u += 0x7fffu + ((u >> 16) & 1u);
    return (bf16_t)(u >> 16);
}
__device__ __forceinline__ float bf2f(bf16_t h) { return __uint_as_float(((uint32_t)h) << 16); }
__device__ __forceinline__ uint32_t pack2(float a, float b) { return (uint32_t)f2bf(a) | ((uint32_t)f2bf(b) << 16); }
__device__ __forceinline__ float sigmoidf_(float x) { return __builtin_amdgcn_rcpf(1.0f + __builtin_amdgcn_exp2f(-1.4426950408889634f * x)); }
__device__ __forceinline__ float wave_sum(float v) {
#pragma unroll
    for (int o = 32; o >= 1; o >>= 1) v += __shfl_xor(v, o);
    return v;
}
__device__ __forceinline__ float wave_max(float v) {
#pragma unroll
    for (int o = 32; o >= 1; o >>= 1) v = fmaxf(v, __shfl_xor(v, o));
    return v;
}

constexpr size_t al256(size_t x) { return (x + 255) & ~(size_t)255; }
constexpr size_t TT = (size_t)T;
constexpr size_t MB1 = 1024 * 1024;
constexpr size_t WE_B = (size_t)NE * 1024 * 1024 * 2;
constexpr size_t OFF_WGT = 0, OFF_WUT = WE_B, OFF_WDT = 2 * WE_B, OFF_XN2 = 3 * WE_B, OFF_ACT = OFF_XN2 + (size_t)NTOK * D * 2,
                 OFF_TAB = OFF_ACT + (size_t)CAP * DFF * 2;
constexpr size_t OFF_Y1 = OFF_XN2, OFF_Y2 = OFF_WGT, OFF_Y3 = OFF_WUT;
constexpr size_t OFF_ROPE = OFF_TAB, OFF_LB = OFF_ROPE + al256((size_t)LP * 24 * 4), OFF_CTR = OFF_LB + al256(512 * 4),
                 OFF_BEXP = OFF_CTR + al256(128 * 4), OFF_SLOT = OFF_BEXP + al256((size_t)CAP_BLOCKS * 4), OFF_SRANK = OFF_SLOT + al256((size_t)CAP * 4),
                 OFF_SGATE = OFF_SRANK + al256((size_t)CAP * 4), OFF_TEXP = OFF_SGATE + al256((size_t)CAP * 4), OFF_TGATE = OFF_TEXP + al256((size_t)NTOK * 16),
                 OFF_BAR = OFF_TGATE + al256((size_t)NTOK * 16), OFF_WGC = OFF_BAR + al256(3456 * 4), OFF_SINFO = OFF_WGC + al256(256 * 32 * 4), WS_NEED = OFF_SINFO + al256((size_t)CAP * 8);
constexpr size_t OFF_WIN = 0, OFF_WUA = OFF_WIN + (size_t)NVC * 1024 * 2, OFF_WUH = OFF_WUA + MB1, OFF_WO = OFF_WUH + MB1, OFF_XN = OFF_WO + 2 * MB1,
                 OFF_Q = OFF_XN + TT * 2048, OFF_K = OFF_Q + TT * 1024, OFF_V = OFF_K + TT * 256, OFF_IQ = OFF_V + TT * 256, OFF_IK = OFF_IQ + TT * 512,
                 OFF_IW = OFF_IK + TT * 64, OFF_HQ = OFF_IW + TT * 32, OFF_HF = OFF_HQ + TT * 1024, OFF_HI = OFF_HF + TT * 1024, OFF_HG = OFF_HI + TT * 1024,
                 OFF_GA = OFF_HG + TT * 1024, OFF_GH = OFF_GA + TT * 2048, OFF_ATT = OFF_GH + TT * 2048, OFF_HGR = OFF_ATT + TT * 1024,
                 OFF_S1_END = OFF_HGR + TT * 1024;
constexpr size_t OFF_MIX = OFF_XN;
static_assert(OFF_S1_END <= OFF_TAB, "stage-1 layout overflows");

__device__ __forceinline__ int tid_() { int t = threadIdx.x; asm volatile("" : "+v"(t)); return t; }

struct P {
    const float *x, *meta, *attn_g, *w_in, *hgrn_g, *w_ua, *w_uh, *w_out, *lb_logits, *ffn_g, *router_w, *router_b,
        *w_gate, *b_gate, *w_up, *b_up, *w_down, *b_down, *final_g;
    float* out;
    unsigned char* ws;
#define WSF(type, name, off) __device__ __forceinline__ type* name() const { return (type*)(ws + (off)); }
    WSF(bf16_t, xn, OFF_XN) WSF(bf16_t, q, OFF_Q) WSF(bf16_t, k, OFF_K) WSF(bf16_t, v, OFF_V) WSF(bf16_t, iq, OFF_IQ) WSF(bf16_t, ik, OFF_IK)
    WSF(bf16_t, hq, OFF_HQ) WSF(bf16_t, hf, OFF_HF) WSF(bf16_t, hi, OFF_HI) WSF(bf16_t, hg, OFF_HG) WSF(bf16_t, ga, OFF_GA) WSF(bf16_t, gh, OFF_GH)
    WSF(bf16_t, att, OFF_ATT) WSF(bf16_t, hgr, OFF_HGR) WSF(bf16_t, mix, OFF_MIX) WSF(bf16_t, xn2, OFF_XN2) WSF(bf16_t, act, OFF_ACT)
    WSF(bf16_t, y1, OFF_Y1) WSF(bf16_t, y2, OFF_Y2) WSF(bf16_t, y3, OFF_Y3)
    WSF(bf16_t, winT, OFF_WIN) WSF(bf16_t, wuaT, OFF_WUA) WSF(bf16_t, wuhT, OFF_WUH) WSF(bf16_t, woT, OFF_WO)
    WSF(bf16_t, wgT, OFF_WGT) WSF(bf16_t, wuT, OFF_WUT) WSF(bf16_t, wdT, OFF_WDT)
    WSF(float, iw, OFF_IW) WSF(float, rope, OFF_ROPE) WSF(float, lb, OFF_LB) WSF(float, tok_gate, OFF_TGATE) WSF(float, slot_gate, OFF_SGATE)
    WSF(int, ctr, OFF_CTR)
    WSF(int, wg_cnt, OFF_WGC) WSF(int2, slot_info, OFF_SINFO) WSF(int, block_expert, OFF_BEXP) WSF(int, slot_token, OFF_SLOT) WSF(int, slot_rank, OFF_SRANK) WSF(int, tok_exp, OFF_TEXP)
};

template <class ColMap>
__device__ __forceinline__ void convert_T(const float* W, int ldw, bf16_t* out, int K, int N, const ColMap& cmap, int gt, int ntot) {
    const int kb = K / 64; const long ntask = (long)N * kb;
    for (long task = gt; task < ntask; task += ntot) {
        const int kq = (int)(task / N), n = (int)(task % N);
        const int c = cmap(n);
        uint32_t w[32];
        if (c >= 0) {
            const float* src = W + (size_t)(kq * 64) * ldw + c;
            float v[64];
#pragma unroll
            for (int i = 0; i < 64; ++i) v[i] = src[(size_t)i * ldw];
#pragma unroll
            for (int i = 0; i < 32; ++i) w[i] = pack2(v[2 * i], v[2 * i + 1]);
        } else {
#pragma unroll
            for (int i = 0; i < 32; ++i) w[i] = 0u;
        }
        uint4* dst = (uint4*)(out + (size_t)n * K + kq * 64);
#pragma unroll
        for (int i = 0; i < 8; ++i) dst[i] = make_uint4(w[4 * i], w[4 * i + 1], w[4 * i + 2], w[4 * i + 3]);
    }
}
struct IdMap { __device__ __forceinline__ int operator()(int n) const { return n; } };
struct WinMap { __device__ __forceinline__ int operator()(int n) const { return n < 1064 ? n : (n < 1280 ? -1 : n - 216); } };

#define XB_TMO      128
#define XB_XCNT(j)  (256  + 64 * (j))
#define XB_XSUB(j)  (1280 + 64 * (j))
#define XB_XGEN(j)  (2304 + 64 * (j))
#define XB_TOP      3328
#define XB_TOPGEN   3392
#define XCD_BAR_WORDS 3456
#define XB_SPIN_CAP (1u << 22)
__device__ __forceinline__ unsigned xb_ld(unsigned* p)              { return __hip_atomic_load(p, __ATOMIC_RELAXED, __HIP_MEMORY_SCOPE_AGENT); }
__device__ __forceinline__ unsigned xb_add(unsigned* p, unsigned v) { return __hip_atomic_fetch_add(p, v, __ATOMIC_RELAXED, __HIP_MEMORY_SCOPE_AGENT); }
__device__ __forceinline__ unsigned xb_xcc_id() { return (unsigned)__builtin_amdgcn_s_getreg((3 << 11) | 20) & 0xFu; }
#define XB_SPIN(cond, bar) do { unsigned _sp = 0; while (cond) { __builtin_amdgcn_s_sleep(1); \
    if ((++_sp & 255u) == 0u) { if (xb_ld(&(bar)[XB_TMO])) break; if (_sp > XB_SPIN_CAP) { atomicAdd(&(bar)[XB_TMO], 1u); break; } } } } while (0)
struct XcdBarrier { unsigned* bar; unsigned x; volatile LAS unsigned* st; };
__device__ __forceinline__ XcdBarrier xcd_barrier_post(unsigned* bar, volatile LAS unsigned* st) {
    XcdBarrier b; b.bar = bar; b.x = xb_xcc_id(); b.st = st;
    if (threadIdx.x == 0) (void)xb_add(&bar[XB_XCNT(b.x)], 1u);
    return b;
}
__device__ __forceinline__ void xcd_barrier_complete(unsigned* bar, unsigned x, unsigned& nloc, unsigned& nx) {
    const unsigned G = gridDim.x * gridDim.y * gridDim.z;
    unsigned sum, cnt, mine, sp = 0u;
    for (;;) {
        sum = 0u; cnt = 0u; mine = 0u;
#pragma unroll
        for (unsigned j = 0; j < 16; ++j) { const unsigned c = xb_ld(&bar[XB_XCNT(j)]); sum += c; cnt += (c > 0u) ? 1u : 0u; mine = (j == x) ? c : mine; }
        if (sum == G) break;
        __builtin_amdgcn_s_sleep(1);
        if ((++sp & 255u) == 0u) { if (xb_ld(&bar[XB_TMO])) break; if (sp > XB_SPIN_CAP) { atomicAdd(&bar[XB_TMO], 1u); break; } }
    }
    nloc = mine > 0u ? mine : 1u; nx = cnt > 0u ? cnt : 1u;
}
__device__ __forceinline__ void xcd_barrier(const XcdBarrier& b) {
    asm volatile("s_waitcnt vmcnt(0)" ::: "memory");
    __syncthreads();
    if (threadIdx.x == 0) {
        unsigned* bar = b.bar;
        __builtin_amdgcn_s_waitcnt(0);
        unsigned nloc = b.st[0], nx = b.st[1];
        if (nloc == 0u) { xcd_barrier_complete(bar, b.x, nloc, nx); b.st[0] = nloc; b.st[1] = nx; }
        const unsigned old = xb_add(&bar[XB_XSUB(b.x)], 1u);
        const unsigned gen = old / nloc;
        if (old + 1u == (gen + 1u) * nloc) {
            __builtin_amdgcn_fence(__ATOMIC_RELEASE, "agent");
            asm volatile("s_waitcnt vmcnt(0)" ::: "memory");
            const unsigned og = xb_add(&bar[XB_TOP], 1u);
            const unsigned tg = og / nx;
            if (og + 1u == (tg + 1u) * nx) xb_add(&bar[XB_TOPGEN], 1u);
            else XB_SPIN(xb_ld(&bar[XB_TOPGEN]) == tg, bar);
            __builtin_amdgcn_fence(__ATOMIC_ACQUIRE, "agent");
            xb_add(&bar[XB_XGEN(b.x)], 1u);
            asm volatile("s_waitcnt vmcnt(0)" ::: "memory");
        } else {
            XB_SPIN(xb_ld(&bar[XB_XGEN(b.x)]) == gen, bar);
            __builtin_amdgcn_fence(__ATOMIC_ACQUIRE, "agent");
            asm volatile("s_waitcnt vmcnt(0)" ::: "memory");
        }
    }
    __syncthreads();
}

__device__ __forceinline__ void ph_prep(const P& p, unsigned char* lds) {
    const int tid = tid_(), lane = tid & 63, wid = tid >> 6;
    const int gw = blockIdx.x * 8 + wid, nw = gridDim.x * 8;
    for (int r = gw; r < T; r += nw) {
        const int b = r / LP, pos = r % LP;
        bf16_t* dst = p.xn() + (size_t)r * D;
        if (pos >= L) {
#pragma unroll
            for (int i = 0; i < 4; ++i) *(uint2*)(dst + lane * 4 + 256 * i) = make_uint2(0u, 0u);
            continue;
        }
        const float* src = pos < NMETA ? p.meta + (size_t)pos * D : p.x + ((size_t)b * SEQ + (pos - NMETA)) * D;
        f32x4 v[4]; float ss = 0.f;
#pragma unroll
        for (int i = 0; i < 4; ++i) { v[i] = *(const f32x4*)(src + lane * 4 + 256 * i); ss += v[i][0] * v[i][0] + v[i][1] * v[i][1] + v[i][2] * v[i][2] + v[i][3] * v[i][3]; }
        ss = wave_sum(ss);
        const float rs = rsqrtf(ss * (1.0f / D) + EPS);
#pragma unroll
        for (int i = 0; i < 4; ++i) {
            const f32x4 g = *(const f32x4*)(p.attn_g + lane * 4 + 256 * i);
            uint2 o; o.x = pack2(v[i][0] * rs * g[0], v[i][1] * rs * g[1]); o.y = pack2(v[i][2] * rs * g[2], v[i][3] * rs * g[3]);
            *(uint2*)(dst + lane * 4 + 256 * i) = o;
        }
    }
    const int gt = blockIdx.x * NTHREADS + tid, nt = gridDim.x * NTHREADS;
    for (int i = gt; i < LP * 12; i += nt) {
        const int pos = i / 12, f = i % 12;
        const double ex = f < 8 ? -(double)f / 8.0 : -(double)(f - 8) / 4.0;
        const double inv = exp(ex * log(500000.0));
        const double ang = (double)pos * inv;
        const double twopi = 6.283185307179586476925286766559;
        const double r = ang - twopi * rint(ang / twopi);
        const float rf = (float)r;
        const float c = cosf(rf), s = sinf(rf);
        float* row = p.rope() + (size_t)pos * 24;
        if (f < 8) { row[f] = c; row[8 + f] = s; } else { row[16 + f - 8] = c; row[20 + f - 8] = s; }
    }
    for (int i = gt; i < 512; i += nt) {
        const float a = p.lb_logits[i], b2 = p.lb_logits[512 + i];
        p.lb()[i] = 1.0f / (1.0f + expf(b2 - a));
    }
    for (int i = gt; i < 128; i += nt) p.ctr()[i] = 0;
    convert_T(p.w_in, IN_COLS, p.winT(), 1024, NVC, WinMap{}, gt, nt);
    convert_T(p.w_ua, 1024, p.wuaT(), 512, 1024, IdMap{}, gt, nt);
    convert_T(p.w_uh, 1024, p.wuhT(), 512, 1024, IdMap{}, gt, nt);
    convert_T(p.w_out, 1024, p.woT(), 1024, 1024, IdMap{}, gt, nt);
}
constexpr int G_TILE_B = 256 * 64 * 2, G_STAGE_B = 2 * G_TILE_B;
__device__ __forceinline__ int g_lds_byte(int r, int c) { const int st = (r >> 4) * 2 + (c >> 5), ob = (r & 15) * 64 + (c & 31) * 2; return st * 1024 + (ob ^ (((ob >> 9) & 1) << 5)); }
__device__ __forceinline__ void g_stage_rc(int b, int& R, int& C) { const int st = b >> 10, sb = b & 1023, swz = sb ^ (((sb >> 9) & 1) << 5); R = (st >> 1) * 16 + swz / 64; C = (st & 1) * 32 + (swz % 64) / 2; }

constexpr int HTB = 128 * 64 * 2;
struct GJob { const char* A; const char* B; unsigned va00, va01, va10, va11; };
__device__ __forceinline__ void gj_lin(unsigned (&v)[2][2], int ld) {
#pragma unroll
    for (int h = 0; h < 2; ++h)
#pragma unroll
        for (int i = 0; i < 2; ++i) { int R, C; g_stage_rc(tid_() * 16 + i * 8192, R, C); v[h][i] = (unsigned)(((h * 128 + R) * ld + C) * 2); }
}
template <class AOff>
__device__ __forceinline__ void gj_gather(unsigned (&v)[2][2], const AOff& aoff) {
#pragma unroll
    for (int h = 0; h < 2; ++h)
#pragma unroll
        for (int i = 0; i < 2; ++i) { int R, C; g_stage_rc(tid_() * 16 + i * 8192, R, C); v[h][i] = (unsigned)((aoff(h * 128 + R) + C) * 2); }
}
template <class AOff>
__device__ __forceinline__ void gj_gather_job(GJob& j, const AOff& aoff) {
    unsigned v[2][2]; gj_gather(v, aoff); j.va00 = v[0][0]; j.va01 = v[0][1]; j.va10 = v[1][0]; j.va11 = v[1][1];
}
template <bool GATHER, class JobFn, class Epi>
__device__ __forceinline__ void gemm_stream(unsigned char* lds_, int K, int lda, size_t hstepB, const unsigned (&vbU)[2], const JobFn& jobfn, const Epi& epi) {
    LAS unsigned char* lds = (LAS unsigned char*)lds_;
    const int tid = tid_(), wid = __builtin_amdgcn_readfirstlane(tid >> 6), lane = tid & 63, wr = wid >> 2, wc = wid & 3, fr = lane & 15, fq = lane >> 4;
    const int nt = K / 64;
    const size_t kstep = 128;
    const size_t hstepA = GATHER ? 0 : (size_t)128 * lda * 2;
    const unsigned ldsw = (unsigned)wid * 1024u;
    const int aoff = g_lds_byte(wr * 64 + fr, fq * 8), boff = g_lds_byte(wc * 32 + fr, fq * 8);
    unsigned vaU[2];
#pragma unroll
    for (int i = 0; i < 2; ++i) { int R, C; g_stage_rc(tid * 16 + i * 8192, R, C); vaU[i] = (unsigned)((R * lda + C) * 2); }
#define PG8_SA(b, h) (((b) * 2 + (h)) * HTB)
#define PG8_SB(b, h) ((4 + (b) * 2 + (h)) * HTB)
#define PG8_STAGE2(bufoff, gbase, v0, v1) do { \
        __builtin_amdgcn_global_load_lds((const unsigned*)((const char*)(gbase) + (v0)), (LAS unsigned*)(lds + (bufoff) + ldsw), 16, 0, 0); \
        __builtin_amdgcn_global_load_lds((const unsigned*)((const char*)(gbase) + (v1)), (LAS unsigned*)(lds + (bufoff) + ldsw + 8192), 16, 0, 0); } while (0)
#define STB(bufoff, gbase, h) PG8_STAGE2(bufoff, (gbase) + ((h) ? hstepB : 0), vbU[0], vbU[1])
#define STA_CUR(bufoff, gbase, h) do { if (GATHER) PG8_STAGE2(bufoff, gbase, (h) ? cur.va10 : cur.va00, (h) ? cur.va11 : cur.va01); else PG8_STAGE2(bufoff, (gbase) + ((h) ? hstepA : 0), vaU[0], vaU[1]); } while (0)
#define STA_SEL(bufoff, gbase, h) do { if (GATHER) PG8_STAGE2(bufoff, gbase, last ? ((h) ? nxt.va10 : nxt.va00) : ((h) ? cur.va10 : cur.va00), last ? ((h) ? nxt.va11 : nxt.va01) : ((h) ? cur.va11 : cur.va01)); \
        else PG8_STAGE2(bufoff, (gbase) + ((h) ? hstepA : 0), vaU[0], vaU[1]); } while (0)
#define PG8_LDA(dst, b, h) do { _Pragma("unroll") for (int m = 0; m < 4; ++m) _Pragma("unroll") for (int k = 0; k < 2; ++k) dst[m][k] = *(const LAS bf16x8*)(lds + PG8_SA(b, h) + aoff + m * 2048 + k * 1024); } while (0)
#define PG8_LDB(dst, b, h) do { _Pragma("unroll") for (int n = 0; n < 2; ++n) _Pragma("unroll") for (int k = 0; k < 2; ++k) dst[n][k] = *(const LAS bf16x8*)(lds + PG8_SB(b, h) + boff + n * 2048 + k * 1024); } while (0)
#define PG8_MMA(ai, bj, At, Bt) do { __builtin_amdgcn_s_setprio(1); _Pragma("unroll") for (int m = 0; m < 4; ++m) _Pragma("unroll") for (int n = 0; n < 2; ++n) _Pragma("unroll") for (int k = 0; k < 2; ++k) \
        acc[ai][bj][m][n] = __builtin_amdgcn_mfma_f32_16x16x32_bf16(Bt[n][k], At[m][k], acc[ai][bj][m][n], 0, 0, 0); __builtin_amdgcn_s_setprio(0); } while (0)
#define PG8_WAIT_V(n) asm volatile("s_waitcnt vmcnt(" #n ")" ::: "memory")
#define PG8_WAIT_L(n) asm volatile("s_waitcnt lgkmcnt(" #n ")" ::: "memory")
#define PG8_BAR __builtin_amdgcn_s_barrier()
#define PG8_SCHED __builtin_amdgcn_sched_barrier(0)
    GJob cur, nxt; int ui = 0;
    cur.A = nullptr; cur.B = nullptr; cur.va00 = cur.va01 = cur.va10 = cur.va11 = 0u; nxt = cur;
    if (!jobfn(0, cur)) return;
    f32x4 acc[2][2][4][2];
#pragma unroll
    for (int a = 0; a < 2; ++a)
#pragma unroll
        for (int b = 0; b < 2; ++b)
#pragma unroll
            for (int m = 0; m < 4; ++m)
#pragma unroll
                for (int n = 0; n < 2; ++n) acc[a][b][m][n] = (f32x4){0.f, 0.f, 0.f, 0.f};
    bf16x8 At[4][2], B0[2][2], B1[2][2];
    STB(PG8_SB(0, 0), cur.B, 0); STB(PG8_SB(0, 1), cur.B, 1); STA_CUR(PG8_SA(0, 0), cur.A, 0); STA_CUR(PG8_SA(0, 1), cur.A, 1);
    if (wr == 1) PG8_BAR;
    PG8_WAIT_V(2); PG8_BAR;
    STB(PG8_SB(1, 0), cur.B + kstep, 0); STA_CUR(PG8_SA(1, 0), cur.A + kstep, 0); STB(PG8_SB(1, 1), cur.B + kstep, 1);
    PG8_WAIT_V(6); PG8_BAR;
    for (;;) {
        bool has_next = false;
        for (int t = 0; t < nt; t += 2) {
            const bool last = (t == nt - 2);
            if (last) { has_next = jobfn(ui + 1, nxt); if (!has_next) nxt = cur; }
            const char* a1 = cur.A + (size_t)(t + 1) * kstep;
            const char* a2 = last ? nxt.A : cur.A + (size_t)(t + 2) * kstep; const char* b2 = last ? nxt.B : cur.B + (size_t)(t + 2) * kstep;
            const char* a3 = a2 + kstep; const char* b3 = b2 + kstep;
            PG8_LDB(B0, 0, 0); PG8_LDB(B1, 0, 1); PG8_SCHED; PG8_LDA(At, 0, 0); STA_CUR(PG8_SA(1, 1), a1, 1);
            PG8_WAIT_V(8); PG8_WAIT_L(0); PG8_BAR; PG8_MMA(0, 0, At, B0); PG8_MMA(0, 1, At, B1); PG8_BAR; PG8_SCHED;
            PG8_LDA(At, 0, 1); STB(PG8_SB(0, 0), b2, 0); STB(PG8_SB(0, 1), b2, 1); STA_SEL(PG8_SA(0, 0), a2, 0);
            PG8_WAIT_V(8); PG8_WAIT_L(0); PG8_BAR; PG8_MMA(1, 0, At, B0); PG8_MMA(1, 1, At, B1); PG8_BAR; PG8_SCHED;
            PG8_LDB(B0, 1, 0); PG8_LDB(B1, 1, 1); PG8_SCHED; PG8_LDA(At, 1, 0); STA_SEL(PG8_SA(0, 1), a2, 1);
            PG8_WAIT_V(8); PG8_WAIT_L(0); PG8_BAR; PG8_MMA(0, 0, At, B0); PG8_MMA(0, 1, At, B1); PG8_BAR; PG8_SCHED;
            PG8_LDA(At, 1, 1); STB(PG8_SB(1, 0), b3, 0); STB(PG8_SB(1, 1), b3, 1); STA_SEL(PG8_SA(1, 0), a3, 0);
            PG8_WAIT_V(8); PG8_WAIT_L(0); PG8_BAR; PG8_MMA(1, 0, At, B0); PG8_MMA(1, 1, At, B1); PG8_BAR; PG8_SCHED;
        }
        if (wr == 0) PG8_BAR;
        epi(acc, ui);
        if (!has_next) break;
#pragma unroll
        for (int a = 0; a < 2; ++a)
#pragma unroll
            for (int b = 0; b < 2; ++b)
#pragma unroll
                for (int m = 0; m < 4; ++m)
#pragma unroll
                    for (int n = 0; n < 2; ++n) acc[a][b][m][n] = (f32x4){0.f, 0.f, 0.f, 0.f};
        cur = nxt; ++ui;
        if (wr == 1) PG8_BAR;
    }
    PG8_WAIT_V(0);
    PG8_BAR;
#undef PG8_SA
#undef PG8_SB
#undef PG8_STAGE2
#undef STB
#undef STA_CUR
#undef STA_SEL
#undef PG8_LDA
#undef PG8_LDB
#undef PG8_MMA
#undef PG8_WAIT_V
#undef PG8_WAIT_L
#undef PG8_BAR
#undef PG8_SCHED
}
__device__ __forceinline__ void gj_lin2(unsigned (&v)[2], int ld) {
#pragma unroll
    for (int i = 0; i < 2; ++i) { int R, C; g_stage_rc(tid_() * 16 + i * 8192, R, C); v[i] = (unsigned)((R * ld + C) * 2); }
}
struct RowLin { size_t base; int ld; __device__ __forceinline__ size_t operator()(int R) const { return base + (size_t)R * ld; } };

__device__ __forceinline__ void st_bf4(bf16_t* dst, f32x4 v) {
    uint2 o; o.x = pack2(v[0], v[1]); o.y = pack2(v[2], v[3]); *(uint2*)dst = o;
}
#define EPI8(...) do { const int tid_e = tid_(), lane_e = tid_e & 63, wid_e = tid_e >> 6, wr = wid_e >> 2, wc = wid_e & 3, fr = lane_e & 15, fq = lane_e >> 4; \
    _Pragma("unroll") for (int ai = 0; ai < 2; ++ai) _Pragma("unroll") for (int m = 0; m < 4; ++m) _Pragma("unroll") for (int bj = 0; bj < 2; ++bj) _Pragma("unroll") for (int n = 0; n < 2; ++n) { \
        const int row = ai * 128 + wr * 64 + m * 16 + fr, col = bj * 128 + wc * 32 + n * 16 + fq * 4; const f32x4 v = acc[ai][bj][m][n]; __VA_ARGS__ } } while (0)

struct EpiInproj {
    const P* p; int nt;
    __device__ __forceinline__ void operator()(int m, int n, int fq, f32x4 v) const {
        const P& P_ = *p;
        const int pos = m % LP;
        const float* rp = P_.rope() + (size_t)pos * 24;
        if (nt <= 2) {
            const bool isv = (nt == 2) && (n >= 128);
            if (!isv && (n & 48) == 0) {
                f32x4 pr;
#pragma unroll
                for (int j = 0; j < 4; ++j) pr[j] = __shfl_xor(v[j], 32);
                const int i0 = (fq & 1) * 4;
#pragma unroll
                for (int j = 0; j < 4; ++j) {
                    const float c = rp[i0 + j], s = rp[8 + i0 + j];
                    v[j] = fq < 2 ? v[j] * c - pr[j] * s : v[j] * c + pr[j] * s;
                }
            }
            if (nt < 2) { st_bf4(P_.q() + (size_t)m * 512 + nt * 256 + n, v * (0.125f * 1.4426950408889634f)); }
            else if (n < 128) st_bf4(P_.k() + (size_t)m * 128 + n, v);
            else st_bf4(P_.v() + (size_t)m * 128 + (n - 128), v);
        } else if (nt == 3 || nt == 4) {
            const bool ropeable = (nt == 3) ? ((n & 16) == 0) : (n < 16);
            if (ropeable) {
                f32x4 pr;
#pragma unroll
                for (int j = 0; j < 4; ++j) pr[j] = __shfl_xor(v[j], 16);
                if (fq < 2) {
#pragma unroll
                    for (int j = 0; j < 4; ++j) {
                        const float c = rp[16 + j], s = rp[20 + j];
                        v[j] = fq == 0 ? v[j] * c - pr[j] * s : v[j] * c + pr[j] * s;
                    }
                }
            }
            if (nt == 3) st_bf4(P_.iq() + (size_t)m * 256 + n, v);
            else if (n < 32) st_bf4(P_.ik() + (size_t)m * 32 + n, v);
            else if (n < 40) *(f32x4*)(P_.iw() + (size_t)m * 8 + (n - 32)) = v;
        } else if (nt <= 6) { st_bf4(P_.hq() + (size_t)m * 512 + (nt - 5) * 256 + n, v * 0.08838834764831845f); }
        else if (nt <= 8) { st_bf4(P_.hf() + (size_t)m * 512 + (nt - 7) * 256 + n, v); }
        else if (nt <= 10) { st_bf4(P_.hi() + (size_t)m * 512 + (nt - 9) * 256 + n, v); }
        else if (nt <= 12) {
            f32x4 o;
#pragma unroll
            for (int j = 0; j < 4; ++j) o[j] = v[j] * sigmoidf_(v[j]);
            st_bf4(P_.hg() + (size_t)m * 512 + (nt - 11) * 256 + n, o);
        } else {
            f32x4 o;
#pragma unroll
            for (int j = 0; j < 4; ++j) o[j] = sigmoidf_(v[j]);
            if (nt <= 16) st_bf4(P_.ga() + (size_t)m * 1024 + (nt - 13) * 256 + n, o);
            else st_bf4(P_.gh() + (size_t)m * 1024 + (nt - 17) * 256 + n, o);
        }
    }
};

__device__ __forceinline__ void ph_inproj(const P& p, unsigned char* lds) {
    const int nunits = (T / 256) * 21, G = gridDim.x, b0 = blockIdx.x;
    auto jobfn = [&](int i, GJob& j) __attribute__((always_inline)) -> bool {
        const int u = b0 + i * G; if (u >= nunits) return false;
        const int nt = u % 21, mt = u / 21;
        j.A = (const char*)(p.xn() + (size_t)mt * 256 * D); j.B = (const char*)(p.winT() + (size_t)nt * 256 * D); return true; };
    auto epi = [&](f32x4 (&acc)[2][2][4][2], int i) __attribute__((always_inline)) {
        const int u = b0 + i * G, nt = u % 21, mt = u / 21;
        const EpiInproj e{&p, nt};
        EPI8( e(mt * 256 + row, col, fq, v); );
    };
    unsigned vbU[2]; gj_lin2(vbU, D);
    gemm_stream<false>(lds, D, D, (size_t)128 * D * 2, vbU, jobfn, epi);
}

constexpr int NCH = 129, NXU = 16 * NCH;
constexpr int X_QT = 0, X_KT = X_QT + 64 * 272, X_KH = X_KT + 64 * 272, X_VT = X_KH + 128 * 144, X_AS = X_VT + 128 * 144, X_SEG = X_AS + 64 * 144;
__device__ __forceinline__ bf16_t* hg_ds(const P& p) { return (bf16_t*)p.out; }
__device__ __forceinline__ float* hg_g(const P& p) { return (float*)((unsigned char*)p.out + (size_t)NXU * 32768); }

__device__ __forceinline__ void hgx_unit(const P& p, unsigned char* lds, int u) {
    const int tid = tid_(), lane = tid & 63, wid = tid >> 6, fr = lane & 15, fq = lane >> 4;
    const int c = u % NCH, bh = u / NCH, b = bh >> 2, h = bh & 3;
    const int d = tid & 127, seg = tid >> 7;
    const size_t rowbase = (size_t)(b * LP + c * 64 + seg * 16) * 512 + h * 128 + d;
    bf16_t* hqp = p.hq() + rowbase; const bf16_t* hfp = p.hf() + rowbase; const bf16_t* hip = p.hi() + rowbase;
    const float lbv = p.lb()[h * 128 + d];
    float bb[16], qv[16], kk[16], vv[16];
    float cs = 0.f;
#pragma unroll
    for (int i = 0; i < 16; ++i) {
        const float f = lbv + (1.0f - lbv) * sigmoidf_(bf2f(hfp[(size_t)i * 512]));
        kk[i] = 1.0f - f; cs += __logf(f); bb[i] = cs;
        qv[i] = bf2f(hqp[(size_t)i * 512]); vv[i] = bf2f(hip[(size_t)i * 512]);
    }
    float* segs = (float*)(lds + X_SEG);
    segs[seg * 128 + d] = cs;
    __syncthreads();
    const float s0 = segs[d], s1 = segs[128 + d], s2 = segs[256 + d], s3 = segs[384 + d];
    const float off = seg == 0 ? 0.f : (seg == 1 ? s0 : (seg == 2 ? s0 + s1 : s0 + s1 + s2));
    const float rref = s0 + s1, blast = (s0 + s1) + (s2 + s3);
    uint32_t khp[8], vtp[8];
#pragma unroll
    for (int i = 0; i < 16; i += 2) {
        float khv[2];
#pragma unroll
        for (int j = 0; j < 2; ++j) {
            const float bt = bb[i + j] + off;
            const float eq = __expf(fminf(bt - rref, 80.f)), ek = __expf(fminf(rref - bt, 80.f));
            const int t = seg * 16 + i + j;
            *(bf16_t*)(lds + X_QT + t * 272 + d * 2) = f2bf(qv[i + j] * eq);
            *(bf16_t*)(lds + X_KT + t * 272 + d * 2) = f2bf(kk[i + j] * ek);
            hqp[(size_t)(i + j) * 512] = f2bf(qv[i + j] * __expf(bt));
            khv[j] = kk[i + j] * __expf(blast - bt);
        }
        khp[i >> 1] = pack2(khv[0], khv[1]); vtp[i >> 1] = pack2(vv[i], vv[i + 1]);
    }
    *(uint4*)(lds + X_KH + d * 144 + seg * 32) = make_uint4(khp[0], khp[1], khp[2], khp[3]);
    *(uint4*)(lds + X_KH + d * 144 + seg * 32 + 16) = make_uint4(khp[4], khp[5], khp[6], khp[7]);
    *(uint4*)(lds + X_VT + d * 144 + seg * 32) = make_uint4(vtp[0], vtp[1], vtp[2], vtp[3]);
    *(uint4*)(lds + X_VT + d * 144 + seg * 32 + 16) = make_uint4(vtp[4], vtp[5], vtp[6], vtp[7]);
    if (seg == 0) hg_g(p)[(size_t)u * 128 + d] = __expf(blast);
    __syncthreads();
    {
        const int tm = wid >> 1, tn0 = (wid & 1) * 2;
        f32x4 a1[2] = {(f32x4){0.f, 0.f, 0.f, 0.f}, (f32x4){0.f, 0.f, 0.f, 0.f}};
#pragma unroll
        for (int ks = 0; ks < 4; ++ks) {
            const bf16x8 aq = *(const bf16x8*)(lds + X_QT + (tm * 16 + fr) * 272 + (ks * 32 + fq * 8) * 2);
#pragma unroll
            for (int j = 0; j < 2; ++j) {
                const bf16x8 bk = *(const bf16x8*)(lds + X_KT + ((tn0 + j) * 16 + fr) * 272 + (ks * 32 + fq * 8) * 2);
                a1[j] = __builtin_amdgcn_mfma_f32_16x16x32_bf16(bk, aq, a1[j], 0, 0, 0);
            }
        }
#pragma unroll
        for (int j = 0; j < 2; ++j) {
            const int t = tm * 16 + fr, sb = (tn0 + j) * 16 + fq * 4;
            f32x4 v = a1[j];
#pragma unroll
            for (int jj = 0; jj < 4; ++jj) v[jj] = (sb + jj <= t) ? v[jj] : 0.f;
            uint2 o; o.x = pack2(v[0], v[1]); o.y = pack2(v[2], v[3]);
            *(uint2*)(lds + X_AS + t * 144 + sb * 2) = o;
        }
    }
    __syncthreads();
    {
        const int tm = wid >> 1, en0 = (wid & 1) * 4;
        f32x4 o2[4];
#pragma unroll
        for (int j = 0; j < 4; ++j) o2[j] = (f32x4){0.f, 0.f, 0.f, 0.f};
#pragma unroll
        for (int ks = 0; ks < 2; ++ks) {
            const bf16x8 aa = *(const bf16x8*)(lds + X_AS + (tm * 16 + fr) * 144 + (ks * 32 + fq * 8) * 2);
#pragma unroll
            for (int j = 0; j < 4; ++j) {
                const bf16x8 bv = *(const bf16x8*)(lds + X_VT + ((en0 + j) * 16 + fr) * 144 + (ks * 32 + fq * 8) * 2);
                o2[j] = __builtin_amdgcn_mfma_f32_16x16x32_bf16(bv, aa, o2[j], 0, 0, 0);
            }
        }
        bf16_t* orow = p.hf() + (size_t)(b * LP + c * 64 + tm * 16 + fr) * 512 + h * 128;
#pragma unroll
        for (int j = 0; j < 4; ++j) st_bf4(orow + (en0 + j) * 16 + fq * 4, o2[j]);
    }
    {
        f32x4 s3[8];
#pragma unroll
        for (int j = 0; j < 8; ++j) s3[j] = (f32x4){0.f, 0.f, 0.f, 0.f};
#pragma unroll
        for (int ks = 0; ks < 2; ++ks) {
            const bf16x8 ak = *(const bf16x8*)(lds + X_KH + (wid * 16 + fr) * 144 + (ks * 32 + fq * 8) * 2);
#pragma unroll
            for (int j = 0; j < 8; ++j) {
                const bf16x8 bv = *(const bf16x8*)(lds + X_VT + (j * 16 + fr) * 144 + (ks * 32 + fq * 8) * 2);
                s3[j] = __builtin_amdgcn_mfma_f32_16x16x32_bf16(ak, bv, s3[j], 0, 0, 0);
            }
        }
        bf16_t* dsb = hg_ds(p) + (size_t)u * 16384;
#pragma unroll
        for (int j = 0; j < 8; ++j) st_bf4(dsb + (size_t)(j * 16 + fr) * 128 + wid * 16 + fq * 4, s3[j]);
    }
    __syncthreads();
}

__device__ __forceinline__ void hgchain_unit(const P& p, int bh) {
    const int tid = tid_(), e = tid & 127, dr = tid >> 7;
    float S[32];
#pragma unroll
    for (int i = 0; i < 32; ++i) S[i] = 0.f;
    uint4* ptr = (uint4*)(hg_ds(p) + ((size_t)(bh * NCH) * 128 + e) * 128 + dr * 32);
    const f32x4* gp = (const f32x4*)(hg_g(p) + (size_t)(bh * NCH) * 128 + dr * 32);
    uint4 w[4]; f32x4 g[8];
#pragma unroll
    for (int i = 0; i < 4; ++i) w[i] = ptr[i];
#pragma unroll
    for (int i = 0; i < 8; ++i) g[i] = gp[i];
    for (int c = 0; c < NCH; ++c) {
        uint4 wn[4]; f32x4 gn[8];
        uint4* pn = ptr + 16384 * 2 / 16;
        const f32x4* gpn = gp + 32;
        if (c + 1 < NCH) {
#pragma unroll
            for (int i = 0; i < 4; ++i) wn[i] = pn[i];
#pragma unroll
            for (int i = 0; i < 8; ++i) gn[i] = gpn[i];
        }
#pragma unroll
        for (int i = 0; i < 4; ++i)
            ptr[i] = make_uint4(pack2(S[8 * i], S[8 * i + 1]), pack2(S[8 * i + 2], S[8 * i + 3]), pack2(S[8 * i + 4], S[8 * i + 5]), pack2(S[8 * i + 6], S[8 * i + 7]));
#pragma unroll
        for (int i = 0; i < 4; ++i) {
            const uint32_t ww[4] = {w[i].x, w[i].y, w[i].z, w[i].w};
#pragma unroll
            for (int j = 0; j < 4; ++j) {
                const float lo = __uint_as_float(ww[j] << 16), hi = __uint_as_float(ww[j] & 0xffff0000u);
                S[8 * i + 2 * j] = g[2 * i + (j >> 1)][(2 * j) & 3] * S[8 * i + 2 * j] + lo;
                S[8 * i + 2 * j + 1] = g[2 * i + (j >> 1)][(2 * j + 1) & 3] * S[8 * i + 2 * j + 1] + hi;
            }
        }
        if (c + 1 < NCH) {
#pragma unroll
            for (int i = 0; i < 4; ++i) w[i] = wn[i];
#pragma unroll
            for (int i = 0; i < 8; ++i) g[i] = gn[i];
        }
        ptr = pn; gp = gpn;
    }
}

__device__ __forceinline__ void hgz_unit(const P& p, unsigned char* lds, int u) {
    const int tid = tid_(), lane = tid & 63, wid = tid >> 6, fr = lane & 15, fq = lane >> 4;
    const int c = u % NCH, bh = u / NCH, b = bh >> 2, h = bh & 3;
    const int tm = wid >> 1, en0 = (wid & 1) * 4;
    const size_t row = (size_t)(b * LP + c * 64 + tm * 16 + fr);
    const bf16_t* qrow = p.hq() + row * 512 + h * 128;
    const bf16_t* sT = hg_ds(p) + (size_t)u * 16384;
    f32x4 o[4];
#pragma unroll
    for (int j = 0; j < 4; ++j) o[j] = (f32x4){0.f, 0.f, 0.f, 0.f};
#pragma unroll
    for (int ks = 0; ks < 4; ++ks) {
        const bf16x8 aq = *(const bf16x8*)(qrow + ks * 32 + fq * 8);
#pragma unroll
        for (int j = 0; j < 4; ++j) {
            const bf16x8 bs = *(const bf16x8*)(sT + (size_t)((en0 + j) * 16 + fr) * 128 + ks * 32 + fq * 8);
            o[j] = __builtin_amdgcn_mfma_f32_16x16x32_bf16(bs, aq, o[j], 0, 0, 0);
        }
    }
    const bf16_t* oi = p.hf() + row * 512 + h * 128;
    float ss = 0.f;
#pragma unroll
    for (int j = 0; j < 4; ++j) {
        const uint2 w = *(const uint2*)(oi + (en0 + j) * 16 + fq * 4);
        o[j][0] += __uint_as_float(w.x << 16); o[j][1] += __uint_as_float(w.x & 0xffff0000u);
        o[j][2] += __uint_as_float(w.y << 16); o[j][3] += __uint_as_float(w.y & 0xffff0000u);
        ss += o[j][0] * o[j][0] + o[j][1] * o[j][1] + o[j][2] * o[j][2] + o[j][3] * o[j][3];
    }
    ss += __shfl_xor(ss, 16); ss += __shfl_xor(ss, 32);
    float* part = (float*)lds;
    if (fq == 0) part[(tm * 16 + fr) * 2 + (wid & 1)] = ss;
    __syncthreads();
    const float tot = part[(tm * 16 + fr) * 2] + part[(tm * 16 + fr) * 2 + 1];
    const float rs = rsqrtf(tot * (1.0f / 128.0f) + EPS);
    const bf16_t* hgp = p.hg() + row * 512 + h * 128;
    bf16_t* outp = p.hgr() + row * 512 + h * 128;
#pragma unroll
    for (int j = 0; j < 4; ++j) {
        const int e0 = (en0 + j) * 16 + fq * 4;
        const f32x4 gn = *(const f32x4*)(p.hgrn_g + h * 128 + e0);
        const uint2 w = *(const uint2*)(hgp + e0);
        f32x4 r;
        r[0] = o[j][0] * rs * gn[0] * __uint_as_float(w.x << 16); r[1] = o[j][1] * rs * gn[1] * __uint_as_float(w.x & 0xffff0000u);
        r[2] = o[j][2] * rs * gn[2] * __uint_as_float(w.y << 16); r[3] = o[j][3] * rs * gn[3] * __uint_as_float(w.y & 0xffff0000u);
        st_bf4(outp + e0, r);
    }
    __syncthreads();
}

typedef float f32x16 __attribute__((ext_vector_type(16)));
typedef short s16x4 __attribute__((ext_vector_type(4)));
typedef unsigned u32x4 __attribute__((ext_vector_type(4)));
constexpr int NKMAX = 8224;
constexpr int NBIN = 1024;
constexpr int A_SC = 0, A_H1 = A_SC + 4 * NKMAX * 4, A_SEL = A_H1 + 4 * NBIN * 4, A_CAND = A_SEL + 2048, A_META = A_CAND + 1024, A_END = A_META + 256;
static_assert(A_END <= LDS_BYTES - 16, "attention LDS");
__device__ __forceinline__ uint32_t skey(float f) { const uint32_t u = __float_as_uint(f); return (u & 0x80000000u) ? ~u : (u | 0x80000000u); }
__device__ __forceinline__ float skey_inv(uint32_t k) { return __uint_as_float((k & 0x80000000u) ? (k & 0x7fffffffu) : ~k); }
__device__ __forceinline__ int bin1(float s, float lo, float scale) { return min(NBIN - 1, max(0, (int)((s - lo) * scale))); }
template <int OFF> __device__ __forceinline__ s16x4 tr_read(unsigned addr) {
    s16x4 r; asm volatile("ds_read_b64_tr_b16 %0, %1 offset:%2" : "=&v"(r) : "v"(addr), "i"(OFF) : "memory"); return r;
}
__device__ __forceinline__ void scan_top(const int* hist, int K, int* m, int lane) {
    int c[16];
#pragma unroll
    for (int i = 0; i < 4; ++i) { const int4 v = *(const int4*)(hist + 16 * lane + 4 * i); c[4 * i] = v.x; c[4 * i + 1] = v.y; c[4 * i + 2] = v.z; c[4 * i + 3] = v.w; }
    int tot = 0;
#pragma unroll
    for (int i = 0; i < 16; ++i) tot += c[i];
    int suf = tot;
#pragma unroll
    for (int o = 1; o < 64; o <<= 1) { const int t = __shfl_down(suf, o); if (lane + o < 64) suf += t; }
    int above = suf - tot;
#pragma unroll
    for (int i = 15; i >= 0; --i) {
        if (above < K && K <= above + c[i]) { m[0] = 16 * lane + i; m[1] = above; m[2] = c[i]; }
        above += c[i];
    }
}

__device__ __forceinline__ void attn4_unit(const P& p, unsigned char* lds, int b, int grp) {
    const int tid = tid_(), lane = tid & 63, wid = __builtin_amdgcn_readfirstlane(tid >> 6);
    const int t0 = NMETA + 4 * grp;
    const int brow = b * LP, row0 = brow + t0;
    float* sc = (float*)(lds + A_SC);
    int* h1 = (int*)(lds + A_H1);
    unsigned short* sel = (unsigned short*)(lds + A_SEL); unsigned short* cand = (unsigned short*)(lds + A_CAND);
    int* meta = (int*)(lds + A_META);
    const bool big = t0 + 1 > 256;
    for (int i = tid; i < 4 * NBIN; i += NTHREADS) h1[i] = 0;
    if (tid < 64) { const int w = tid & 15; meta[tid] = (w == 0) ? -1 : 0; }
    if (!big) { for (int i = tid; i < 1024; i += NTHREADS) { const int q = i >> 8, j = i & 255; sel[i] = (unsigned short)(j <= t0 + q ? j : 0); } }
    __syncthreads();
    if (big) {
        {
            const int hh = lane >> 5, c32 = lane & 31;
            const int g = c32 >> 3, h2a = (c32 >> 2) & 1, bq = c32 & 3, aq = 2 * h2a + (g >> 1), ah = 4 * (g & 1) + bq;
            const bf16_t* ap = p.iq() + (size_t)(row0 + aq) * 256 + ah * 32 + 8 * hh;
            const bf16x8 a0 = *(const bf16x8*)ap, a1 = *(const bf16x8*)(ap + 16);
            const f32x4 w00 = *(const f32x4*)(p.iw() + (size_t)(row0 + 2 * hh) * 8), w01 = *(const f32x4*)(p.iw() + (size_t)(row0 + 2 * hh) * 8 + 4);
            const f32x4 w10 = *(const f32x4*)(p.iw() + (size_t)(row0 + 2 * hh + 1) * 8), w11 = *(const f32x4*)(p.iw() + (size_t)(row0 + 2 * hh + 1) * 8 + 4);
            const int ntiles = (t0 + 4 + 31) >> 5;
            const int tq0 = t0 + 2 * hh;
            float mx0 = -INFINITY, mn0 = INFINITY, mx1 = -INFINITY, mn1 = INFINITY;
            const bf16_t* kbase = p.ik() + (size_t)brow * 32 + 8 * hh;
            for (int tile0 = wid; tile0 < ntiles; tile0 += 128) {
                bf16x8 b0[16], b1[16];
#pragma unroll
                for (int j = 0; j < 16; ++j) {
                    const int tile = min(tile0 + 8 * j, ntiles - 1);
                    const bf16_t* kp = kbase + (size_t)(tile * 32 + c32) * 32;
                    b0[j] = *(const bf16x8*)kp; b1[j] = *(const bf16x8*)(kp + 16);
                }
                __builtin_amdgcn_sched_barrier(0);
#pragma unroll
                for (int j = 0; j < 16; ++j) {
                    const int tile = tile0 + 8 * j;
                    if (tile < ntiles) {
                        const int key = tile * 32 + c32;
                        f32x16 acc;
#pragma unroll
                        for (int i = 0; i < 16; ++i) acc[i] = 0.f;
                        acc = __builtin_amdgcn_mfma_f32_32x32x16_bf16(a0, b0[j], acc, 0, 0, 0);
                        acc = __builtin_amdgcn_mfma_f32_32x32x16_bf16(a1, b1[j], acc, 0, 0, 0);
                        float s0 = 0.f, s1 = 0.f;
#pragma unroll
                        for (int i = 0; i < 4; ++i) {
                            s0 += w00[i] * fmaxf(acc[i], 0.f) + w01[i] * fmaxf(acc[4 + i], 0.f);
                            s1 += w10[i] * fmaxf(acc[8 + i], 0.f) + w11[i] * fmaxf(acc[12 + i], 0.f);
                        }
                        sc[(2 * hh) * NKMAX + key] = s0; sc[(2 * hh + 1) * NKMAX + key] = s1;
                        if (key <= tq0) { mx0 = fmaxf(mx0, s0); mn0 = fminf(mn0, s0); }
                        if (key <= tq0 + 1) { mx1 = fmaxf(mx1, s1); mn1 = fminf(mn1, s1); }
                    }
                }
            }
#pragma unroll
            for (int o = 16; o >= 1; o >>= 1) {
                mx0 = fmaxf(mx0, __shfl_xor(mx0, o)); mn0 = fminf(mn0, __shfl_xor(mn0, o));
                mx1 = fmaxf(mx1, __shfl_xor(mx1, o)); mn1 = fminf(mn1, __shfl_xor(mn1, o));
            }
            if (c32 == 0) {
                if (mx0 >= mn0) { atomicMin((unsigned*)&meta[(2 * hh) * 16 + 0], skey(mn0)); atomicMax((unsigned*)&meta[(2 * hh) * 16 + 1], skey(mx0)); }
                if (mx1 >= mn1) { atomicMin((unsigned*)&meta[(2 * hh + 1) * 16 + 0], skey(mn1)); atomicMax((unsigned*)&meta[(2 * hh + 1) * 16 + 1], skey(mx1)); }
            }
        }
        __syncthreads();
        const int q = wid & 3, part = wid >> 2, n = t0 + q + 1;
        const float lo = skey_inv((unsigned)meta[q * 16 + 0]), hi = skey_inv((unsigned)meta[q * 16 + 1]);
        const float scale = hi > lo ? (float)NBIN / (hi - lo) : 0.f;
        const float* scq = sc + q * NKMAX;
        for (int base = part * 256; base < n; base += 512) {
            const int idx0 = base + lane * 4;
            if (idx0 < n) {
                const f32x4 v = *(const f32x4*)(scq + idx0);
#pragma unroll
                for (int j = 0; j < 4; ++j) if (idx0 + j < n) atomicAdd(&h1[q * NBIN + bin1(v[j], lo, scale)], 1);
            }
        }
        __syncthreads();
        if (wid < 4) scan_top(h1 + wid * NBIN, 256, meta + wid * 16 + 4, lane);
        __syncthreads();
        const int B1 = meta[q * 16 + 4];
        for (int base = part * 256; base < n; base += 512) {
            const int idx0 = base + lane * 4;
            f32x4 v = (f32x4){0.f, 0.f, 0.f, 0.f};
            if (idx0 < n) v = *(const f32x4*)(scq + idx0);
            const unsigned long long lt = (1ull << lane) - 1ull;
#pragma unroll
            for (int j = 0; j < 4; ++j) {
                const int idx = idx0 + j;
                bool issel = false, iscand = false;
                if (idx < n) { const int b1 = bin1(v[j], lo, scale); issel = b1 > B1; iscand = b1 == B1; }
                const unsigned long long ms = __ballot(issel), mc = __ballot(iscand);
                if (ms) {
                    int bs = 0; if (lane == 0) bs = atomicAdd(&meta[q * 16 + 2], __popcll(ms));
                    bs = __shfl(bs, 0);
                    if (issel) sel[q * 256 + bs + __popcll(ms & lt)] = (unsigned short)idx;
                }
                if (mc) {
                    int bs = 0; if (lane == 0) bs = atomicAdd(&meta[q * 16 + 3], __popcll(mc));
                    bs = __shfl(bs, 0);
                    const int pos = bs + __popcll(mc & lt);
                    if (iscand && pos < 128) cand[q * 128 + pos] = (unsigned short)idx;
                }
            }
        }
        __syncthreads();
        if (wid < 4) {
            const int qq = wid; const float* scr = sc + qq * NKMAX;
            const int rq = 256 - meta[qq * 16 + 5], cq = meta[qq * 16 + 6], sbase = 256 - rq, nn = t0 + qq + 1;
            if (cq <= 128) {
                int taken = 0;
#pragma unroll
                for (int half = 0; half < 2; ++half) {
                    const int i = lane + 64 * half;
                    bool take = false; int myidx = 0;
                    if (i < cq) {
                        myidx = cand[qq * 128 + i]; const float mv = scr[myidx];
                        int rank = 0;
                        for (int j = 0; j < cq; ++j) { const int oj = cand[qq * 128 + j]; const float ov = scr[oj]; rank += (ov > mv) || (ov == mv && oj < myidx); }
                        take = rank < rq;
                    }
                    const unsigned long long mt = __ballot(take);
                    if (take) sel[qq * 256 + sbase + taken + __popcll(mt & ((1ull << lane) - 1ull))] = (unsigned short)myidx;
                    taken += __popcll(mt);
                }
            } else {
                const float lo_ = skey_inv((unsigned)meta[qq * 16 + 0]), hi_ = skey_inv((unsigned)meta[qq * 16 + 1]);
                const float sc_ = hi_ > lo_ ? (float)NBIN / (hi_ - lo_) : 0.f;
                const int B1_ = meta[qq * 16 + 4];
                int taken = 0;
                for (int base = 0; base < nn && taken < rq; base += 64) {
                    const int idx = base + lane; bool isc = false;
                    if (idx < nn) isc = bin1(scr[idx], lo_, sc_) == B1_;
                    const unsigned long long mc = __ballot(isc);
                    const int pos = taken + __popcll(mc & ((1ull << lane) - 1ull));
                    if (isc && pos < rq) sel[qq * 256 + sbase + pos] = (unsigned short)idx;
                    taken += __popcll(mc);
                }
            }
        }
        __syncthreads();
    }
    {
        const int q = wid >> 1, kvh = wid & 1, tq = t0 + q, nsel = min(tq + 1, 256);
        const int col = lane & 15, g4 = lane >> 4;
        const unsigned short* selq = sel + q * 256;
        bf16x8 qf0, qf1;
        {
            const bf16_t* qp = p.q() + (size_t)(row0 + q) * 512 + (kvh * 4 + (col & 3)) * 64 + g4 * 8;
            qf0 = *(const bf16x8*)qp; qf1 = *(const bf16x8*)(qp + 32);
            if (col >= 4) {
#pragma unroll
                for (int i = 0; i < 8; ++i) { qf0[i] = 0; qf1[i] = 0; }
            }
        }
        LAS unsigned char* vst = (LAS unsigned char*)lds + A_SC + wid * 16384;
        const bf16_t* vb = p.v() + (size_t)brow * 128 + kvh * 64 + (lane & 7) * 8;
        const unsigned rdbase = (unsigned)(uintptr_t)((LAS unsigned char*)lds + A_SC) + wid * 16384 + (4 * g4 + (col >> 2)) * 128 + (col & 3) * 8;
#define V_STAGE(s_, buf_) do { _Pragma("unroll") for (int i_ = 0; i_ < 4; ++i_) { \
            const int ksl_ = (s_) * 32 + i_ * 8 + (lane >> 3); const int key_ = selq[ksl_]; \
            __builtin_amdgcn_global_load_lds((const unsigned*)(vb + (size_t)key_ * 128), (LAS unsigned*)(vst + (buf_) * 4096 + i_ * 1024), 16, 0, 0); } } while (0)
        const bf16_t* kb = p.k() + (size_t)brow * 128 + kvh * 64 + g4 * 8;
        f32x4 lg[16];
        u32x4 vr[16];
        {
            bf16x8 k0[16], k1[16];
#pragma unroll
            for (int t = 0; t < 16; ++t) {
                const int key = selq[t * 16 + col];
                const bf16_t* kp = kb + (size_t)key * 128;
                k0[t] = *(const bf16x8*)kp; k1[t] = *(const bf16x8*)(kp + 32);
            }
#pragma unroll
            for (int s = 4; s < 8; ++s)
#pragma unroll
                for (int i = 0; i < 4; ++i) { const int key = selq[s * 32 + i * 8 + (lane >> 3)]; vr[(s - 4) * 4 + i] = *(const u32x4*)(vb + (size_t)key * 128); }
            V_STAGE(0, 0); V_STAGE(1, 1); V_STAGE(2, 2); V_STAGE(3, 3);
            __builtin_amdgcn_sched_barrier(0);
#pragma unroll
            for (int t = 0; t < 16; ++t) {
                f32x4 a = (f32x4){0.f, 0.f, 0.f, 0.f};
                a = __builtin_amdgcn_mfma_f32_16x16x32_bf16(k0[t], qf0, a, 0, 0, 0);
                a = __builtin_amdgcn_mfma_f32_16x16x32_bf16(k1[t], qf1, a, 0, 0, 0);
                lg[t] = a;
            }
            __builtin_amdgcn_sched_barrier(0);
        }
        float mx = -INFINITY;
#pragma unroll
        for (int t = 0; t < 16; ++t)
#pragma unroll
            for (int j = 0; j < 4; ++j) { if (t * 16 + g4 * 4 + j >= nsel) lg[t][j] = -INFINITY; mx = fmaxf(mx, lg[t][j]); }
        mx = fmaxf(mx, __shfl_xor(mx, 16)); mx = fmaxf(mx, __shfl_xor(mx, 32));
        float sm = 0.f;
#pragma unroll
        for (int t = 0; t < 16; ++t)
#pragma unroll
            for (int j = 0; j < 4; ++j) { const float e = __builtin_amdgcn_exp2f(lg[t][j] - mx); lg[t][j] = e; sm += e; }
        sm += __shfl_xor(sm, 16); sm += __shfl_xor(sm, 32);
        const float inv = 1.0f / sm;
        f32x4 o[4];
#pragma unroll
        for (int d = 0; d < 4; ++d) o[d] = (f32x4){0.f, 0.f, 0.f, 0.f};
        asm volatile("s_waitcnt vmcnt(0)" ::: "memory");
#pragma unroll
        for (int s = 0; s < 8; ++s) {
            if (s >= 4) {
#pragma unroll
                for (int i = 0; i < 4; ++i) *(LAS u32x4*)(vst + (s & 3) * 4096 + i * 1024 + lane * 16) = vr[(s - 4) * 4 + i];
                asm volatile("s_waitcnt lgkmcnt(0)" ::: "memory");
            }
            const unsigned rb = rdbase + (s & 3) * 4096;
            const s16x4 l0 = tr_read<0>(rb), h0 = tr_read<2048>(rb), l1 = tr_read<32>(rb), h1_ = tr_read<2048 + 32>(rb);
            const s16x4 l2 = tr_read<64>(rb), h2_ = tr_read<2048 + 64>(rb), l3 = tr_read<96>(rb), h3 = tr_read<2048 + 96>(rb);
            asm volatile("s_waitcnt lgkmcnt(0)" ::: "memory");
            __builtin_amdgcn_sched_barrier(0);
            bf16x8 pa;
            {
                const uint32_t w0 = pack2(lg[2 * s][0], lg[2 * s][1]), w1 = pack2(lg[2 * s][2], lg[2 * s][3]);
                const uint32_t w2 = pack2(lg[2 * s + 1][0], lg[2 * s + 1][1]), w3 = pack2(lg[2 * s + 1][2], lg[2 * s + 1][3]);
                pa[0] = (short)(w0 & 0xffff); pa[1] = (short)(w0 >> 16); pa[2] = (short)(w1 & 0xffff); pa[3] = (short)(w1 >> 16);
                pa[4] = (short)(w2 & 0xffff); pa[5] = (short)(w2 >> 16); pa[6] = (short)(w3 & 0xffff); pa[7] = (short)(w3 >> 16);
            }
#define PKV(L, H) (bf16x8){L[0], L[1], L[2], L[3], H[0], H[1], H[2], H[3]}
            o[0] = __builtin_amdgcn_mfma_f32_16x16x32_bf16(pa, PKV(l0, h0), o[0], 0, 0, 0);
            o[1] = __builtin_amdgcn_mfma_f32_16x16x32_bf16(pa, PKV(l1, h1_), o[1], 0, 0, 0);
            o[2] = __builtin_amdgcn_mfma_f32_16x16x32_bf16(pa, PKV(l2, h2_), o[2], 0, 0, 0);
            o[3] = __builtin_amdgcn_mfma_f32_16x16x32_bf16(pa, PKV(l3, h3), o[3], 0, 0, 0);
#undef PKV
        }
#undef V_STAGE
        const float i0 = __shfl(inv, 0), i1 = __shfl(inv, 1), i2 = __shfl(inv, 2), i3 = __shfl(inv, 3);
        if (g4 == 0) {
            bf16_t* op = p.att() + (size_t)(row0 + q) * 512 + kvh * 256 + col;
#pragma unroll
            for (int d = 0; d < 4; ++d) {
                op[0 * 64 + d * 16] = f2bf(o[d][0] * i0); op[1 * 64 + d * 16] = f2bf(o[d][1] * i1);
                op[2 * 64 + d * 16] = f2bf(o[d][2] * i2); op[3 * 64 + d * 16] = f2bf(o[d][3] * i3);
            }
        }
    }
    __syncthreads();
}

constexpr int NBW = 512;
constexpr int W_SC = 0, W_H = W_SC + NKMAX * 2, W_SEL = W_H + NBW * 4, W_CAND = W_SEL + 512, W_SZ = W_CAND + 256;
static_assert(8 * W_SZ <= LDS_BYTES - 32, "wave attention LDS");
__device__ __forceinline__ int binw(float s, float lo, float scale) { return min(NBW - 1, max(0, (int)((s - lo) * scale))); }

__device__ __forceinline__ void attn_wave(const P& p, unsigned char* lds, int wid, int lane, int b, int t, float mn, float mx) {
    unsigned char* wl = lds + wid * W_SZ;
    _Float16* sc = (_Float16*)(wl + W_SC);
    int* hist = (int*)(wl + W_H);
    unsigned short* sel = (unsigned short*)(wl + W_SEL);
    unsigned short* cand = (unsigned short*)(wl + W_CAND);
    const int brow = b * LP, row = brow + t, n = t + 1;
    const int col = lane & 15, g4 = lane >> 4;
    const unsigned long long lt = (1ull << lane) - 1ull;
    int nsel = 256;
    if (n > 256) {
        const float scale = mx > mn ? (float)NBW / (mx - mn) : 0.f, nls = -mn * scale;
#define BINF(x) min(NBW - 1, max(0, (int)__builtin_fmaf((x), scale, nls)))
#define H2F(u16) ((float)__builtin_bit_cast(_Float16, (unsigned short)(u16)))
        for (int base = 0; base < n; base += 512) {
            const int ia = base + lane * 4, ib = ia + 256;
            uint2 ra = make_uint2(0u, 0u), rb2 = make_uint2(0u, 0u);
            if (ia < n) ra = *(const uint2*)(sc + ia);
            if (ib < n) rb2 = *(const uint2*)(sc + ib);
            const unsigned wa[4] = {ra.x & 0xffffu, ra.x >> 16, ra.y & 0xffffu, ra.y >> 16}, wb[4] = {rb2.x & 0xffffu, rb2.x >> 16, rb2.y & 0xffffu, rb2.y >> 16};
#pragma unroll
            for (int j = 0; j < 4; ++j) {
                if (ia + j < n) atomicAdd(&hist[BINF(H2F(wa[j]))], 1);
                if (ib + j < n) atomicAdd(&hist[BINF(H2F(wb[j]))], 1);
            }
        }
        int B1, above1, cnt1;
        {
            int c[8];
            const int4 v0 = *(const int4*)(hist + 8 * lane), v1 = *(const int4*)(hist + 8 * lane + 4);
            c[0] = v0.x; c[1] = v0.y; c[2] = v0.z; c[3] = v0.w; c[4] = v1.x; c[5] = v1.y; c[6] = v1.z; c[7] = v1.w;
            int tot = 0;
#pragma unroll
            for (int i = 0; i < 8; ++i) tot += c[i];
            int suf = tot;
#pragma unroll
            for (int o = 1; o < 64; o <<= 1) { const int tt = __shfl_down(suf, o); if (lane + o < 64) suf += tt; }
            int above = suf - tot;
            const bool mine = above < 256 && 256 <= above + tot;
            int bb = 0, ab = 0, cb = 0;
#pragma unroll
            for (int i = 7; i >= 0; --i) { if (above < 256 && 256 <= above + c[i]) { bb = 8 * lane + i; ab = above; cb = c[i]; } above += c[i]; }
            const int src = (int)__builtin_ctzll(__ballot(mine));
            B1 = __shfl(bb, src); above1 = __shfl(ab, src); cnt1 = __shfl(cb, src);
        }
        int selcnt = 0, candcnt = 0;
        for (int base = 0; base < n; base += 512) {
            const int ia = base + lane * 4, ib = ia + 256;
            uint2 ra = make_uint2(0u, 0u), rb2 = make_uint2(0u, 0u);
            if (ia < n) ra = *(const uint2*)(sc + ia);
            if (ib < n) rb2 = *(const uint2*)(sc + ib);
            const unsigned wv[8] = {ra.x & 0xffffu, ra.x >> 16, ra.y & 0xffffu, ra.y >> 16, rb2.x & 0xffffu, rb2.x >> 16, rb2.y & 0xffffu, rb2.y >> 16};
#pragma unroll
            for (int j = 0; j < 8; ++j) {
                const int idx = (j < 4 ? ia : ib) + (j & 3);
                int b1 = -1;
                if (idx < n) b1 = BINF(H2F(wv[j]));
                const bool issel = b1 > B1;
                const unsigned long long ms = __ballot(issel), mc = __ballot(b1 == B1);
                if (issel) sel[selcnt + __popcll(ms & lt)] = (unsigned short)idx;
                selcnt += __popcll(ms);
                if (mc) {
                    const int pos = candcnt + __popcll(mc & lt);
                    if (b1 == B1 && pos < 128) cand[pos] = (unsigned short)idx;
                    candcnt += __popcll(mc);
                }
            }
        }
        {
            const int rq = 256 - above1, cq = cnt1, sbase = 256 - rq;
            if (cq <= 128) {
                int taken = 0;
#pragma unroll
                for (int half = 0; half < 2; ++half) {
                    const int i = lane + 64 * half;
                    bool take = false; int myidx = 0;
                    if (i < cq) {
                        myidx = cand[i]; const float mv = (float)sc[myidx];
                        int rank = 0;
                        for (int j = 0; j < cq; ++j) { const int oj = cand[j]; const float ov = (float)sc[oj]; rank += (ov > mv) || (ov == mv && oj < myidx); }
                        take = rank < rq;
                    }
                    const unsigned long long mt = __ballot(take);
                    if (take) sel[sbase + taken + __popcll(mt & lt)] = (unsigned short)myidx;
                    taken += __popcll(mt);
                }
            } else {
                int taken = 0;
                for (int base = 0; base < n && taken < rq; base += 64) {
                    const int idx = base + lane; bool isc = false;
                    if (idx < n) isc = BINF((float)sc[idx]) == B1;
                    const unsigned long long mc = __ballot(isc);
                    const int pos = taken + __popcll(mc & lt);
                    if (isc && pos < rq) sel[sbase + pos] = (unsigned short)idx;
                    taken += __popcll(mc);
                }
            }
        }
#undef BINF
#undef H2F
    } else {
        nsel = n;
#pragma unroll
        for (int i = 0; i < 4; ++i) { const int j = lane + 64 * i; sel[j] = (unsigned short)(j < n ? j : 0); }
    }
    LAS unsigned char* vst = (LAS unsigned char*)wl + W_SC;
    const unsigned rdbase = (unsigned)(uintptr_t)((LAS unsigned char*)wl + W_SC) + (4 * g4 + (col >> 2)) * 128 + (col & 3) * 8;
#pragma unroll 1
    for (int kvh = 0; kvh < 2; ++kvh) {
        bf16x8 qf0, qf1;
        {
            const bf16_t* qp = p.q() + (size_t)row * 512 + (kvh * 4 + (col & 3)) * 64 + g4 * 8;
            qf0 = *(const bf16x8*)qp; qf1 = *(const bf16x8*)(qp + 32);
            if (col >= 4) {
#pragma unroll
                for (int i = 0; i < 8; ++i) { qf0[i] = 0; qf1[i] = 0; }
            }
        }
        const bf16_t* vb = p.v() + (size_t)brow * 128 + kvh * 64 + (lane & 7) * 8;
        const bf16_t* kb = p.k() + (size_t)brow * 128 + kvh * 64 + g4 * 8;
#define V_STAGE(s_, buf_) do { _Pragma("unroll") for (int i_ = 0; i_ < 4; ++i_) { \
            const int key_ = sel[(s_) * 32 + i_ * 8 + (lane >> 3)]; \
            __builtin_amdgcn_global_load_lds((const unsigned*)(vb + (size_t)key_ * 128), (LAS unsigned*)(vst + (buf_) * 4096 + i_ * 1024), 16, 0, 0); } } while (0)
        f32x4 lg[16];
#pragma unroll
        for (int hb = 0; hb < 2; ++hb) {
            bf16x8 k0[8], k1[8];
#pragma unroll
            for (int tt = 0; tt < 8; ++tt) {
                const int key = sel[(hb * 8 + tt) * 16 + col];
                const bf16_t* kp = kb + (size_t)key * 128;
                k0[tt] = *(const bf16x8*)kp; k1[tt] = *(const bf16x8*)(kp + 32);
            }
            __builtin_amdgcn_sched_barrier(0);
#pragma unroll
            for (int tt = 0; tt < 8; ++tt) {
                f32x4 a = (f32x4){0.f, 0.f, 0.f, 0.f};
                a = __builtin_amdgcn_mfma_f32_16x16x32_bf16(k0[tt], qf0, a, 0, 0, 0);
                a = __builtin_amdgcn_mfma_f32_16x16x32_bf16(k1[tt], qf1, a, 0, 0, 0);
                lg[hb * 8 + tt] = a;
            }
            __builtin_amdgcn_sched_barrier(0);
        }
        V_STAGE(0, 0); V_STAGE(1, 1); V_STAGE(2, 2); V_STAGE(3, 3);
        float mxl = -INFINITY;
#pragma unroll
        for (int tt = 0; tt < 16; ++tt)
#pragma unroll
            for (int j = 0; j < 4; ++j) { if (tt * 16 + g4 * 4 + j >= nsel) lg[tt][j] = -INFINITY; mxl = fmaxf(mxl, lg[tt][j]); }
        mxl = fmaxf(mxl, __shfl_xor(mxl, 16)); mxl = fmaxf(mxl, __shfl_xor(mxl, 32));
        float sm = 0.f;
#pragma unroll
        for (int tt = 0; tt < 16; ++tt)
#pragma unroll
            for (int j = 0; j < 4; ++j) { const float e = __builtin_amdgcn_exp2f(lg[tt][j] - mxl); lg[tt][j] = e; sm += e; }
        sm += __shfl_xor(sm, 16); sm += __shfl_xor(sm, 32);
        const float inv = 1.0f / sm;
        f32x4 o[4];
#pragma unroll
        for (int d = 0; d < 4; ++d) o[d] = (f32x4){0.f, 0.f, 0.f, 0.f};
#pragma unroll
        for (int s = 0; s < 8; ++s) {
            if (s <= 4) asm volatile("s_waitcnt vmcnt(12)" ::: "memory");
            else if (s == 5) asm volatile("s_waitcnt vmcnt(8)" ::: "memory");
            else if (s == 6) asm volatile("s_waitcnt vmcnt(4)" ::: "memory");
            else asm volatile("s_waitcnt vmcnt(0)" ::: "memory");
            const unsigned rb = rdbase + (s & 3) * 4096;
            const s16x4 l0 = tr_read<0>(rb), h0 = tr_read<2048>(rb), l1 = tr_read<32>(rb), h1_ = tr_read<2048 + 32>(rb);
            const s16x4 l2 = tr_read<64>(rb), h2_ = tr_read<2048 + 64>(rb), l3 = tr_read<96>(rb), h3 = tr_read<2048 + 96>(rb);
            asm volatile("s_waitcnt lgkmcnt(0)" ::: "memory");
            __builtin_amdgcn_sched_barrier(0);
            if (s + 4 < 8) V_STAGE(s + 4, s & 3);
            bf16x8 pa;
            {
                const uint32_t w0 = pack2(lg[2 * s][0], lg[2 * s][1]), w1 = pack2(lg[2 * s][2], lg[2 * s][3]);
                const uint32_t w2 = pack2(lg[2 * s + 1][0], lg[2 * s + 1][1]), w3 = pack2(lg[2 * s + 1][2], lg[2 * s + 1][3]);
                pa[0] = (short)(w0 & 0xffff); pa[1] = (short)(w0 >> 16); pa[2] = (short)(w1 & 0xffff); pa[3] = (short)(w1 >> 16);
                pa[4] = (short)(w2 & 0xffff); pa[5] = (short)(w2 >> 16); pa[6] = (short)(w3 & 0xffff); pa[7] = (short)(w3 >> 16);
            }
#define PKV(L, H) (bf16x8){L[0], L[1], L[2], L[3], H[0], H[1], H[2], H[3]}
            o[0] = __builtin_amdgcn_mfma_f32_16x16x32_bf16(pa, PKV(l0, h0), o[0], 0, 0, 0);
            o[1] = __builtin_amdgcn_mfma_f32_16x16x32_bf16(pa, PKV(l1, h1_), o[1], 0, 0, 0);
            o[2] = __builtin_amdgcn_mfma_f32_16x16x32_bf16(pa, PKV(l2, h2_), o[2], 0, 0, 0);
            o[3] = __builtin_amdgcn_mfma_f32_16x16x32_bf16(pa, PKV(l3, h3), o[3], 0, 0, 0);
#undef PKV
        }
#undef V_STAGE
        const float i0 = __shfl(inv, 0), i1 = __shfl(inv, 1), i2 = __shfl(inv, 2), i3 = __shfl(inv, 3);
        if (g4 == 0) {
            bf16_t* op = p.att() + (size_t)row * 512 + kvh * 256 + col;
#pragma unroll
            for (int d = 0; d < 4; ++d) {
                op[0 * 64 + d * 16] = f2bf(o[d][0] * i0); op[1 * 64 + d * 16] = f2bf(o[d][1] * i1);
                op[2 * 64 + d * 16] = f2bf(o[d][2] * i2); op[3 * 64 + d * 16] = f2bf(o[d][3] * i3);
            }
        }
    }
}

constexpr int A8_META = 8 * W_SZ;
static_assert(A8_META + 64 <= LDS_BYTES - 32, "attn8 meta");
__device__ __forceinline__ void attn8_unit(const P& p, unsigned char* lds, int b, int grp) {
    const int tid = tid_(), lane = tid & 63, wid = __builtin_amdgcn_readfirstlane(tid >> 6);
    const int t0 = NMETA + 8 * grp, brow = b * LP, row0 = brow + t0;
    unsigned* meta = (unsigned*)(lds + A8_META);
    const bool big = t0 + 1 > 256;
    if (tid < 16) meta[tid] = (tid & 1) ? 0u : 0xffffffffu;
    for (int i = tid; i < 8 * NBW; i += NTHREADS) ((int*)(lds + (i / NBW) * W_SZ + W_H))[i % NBW] = 0;
    __syncthreads();
    if (big) {
        const int hh = lane >> 5, c32 = lane & 31;
        const int g = c32 >> 3, h2a = (c32 >> 2) & 1, bq = c32 & 3, aq = 2 * h2a + (g >> 1), ah = 4 * (g & 1) + bq;
        bf16x8 a0[2], a1[2]; f32x4 w[2][2][2];
#pragma unroll
        for (int r = 0; r < 2; ++r) {
            const bf16_t* ap = p.iq() + (size_t)(row0 + 4 * r + aq) * 256 + ah * 32 + 8 * hh;
            a0[r] = *(const bf16x8*)ap; a1[r] = *(const bf16x8*)(ap + 16);
#pragma unroll
            for (int qi = 0; qi < 2; ++qi) {
                const float* wp = p.iw() + (size_t)(row0 + 4 * r + 2 * hh + qi) * 8;
                w[r][qi][0] = *(const f32x4*)wp; w[r][qi][1] = *(const f32x4*)(wp + 4);
            }
        }
        const int ntiles = (t0 + 8 + 31) >> 5;
        float mx[2][2], mn[2][2];
#pragma unroll
        for (int r = 0; r < 2; ++r)
#pragma unroll
            for (int qi = 0; qi < 2; ++qi) { mx[r][qi] = -INFINITY; mn[r][qi] = INFINITY; }
        const bf16_t* kbase = p.ik() + (size_t)brow * 32 + 8 * hh;
        bf16x8 b0[8], b1[8], c0[8], c1[8];
#define S_LOAD(B0, B1, T0) do { _Pragma("unroll") for (int j = 0; j < 8; ++j) { const int tile_ = min((T0) + 8 * j, ntiles - 1); \
            const bf16_t* kp_ = kbase + (size_t)(tile_ * 32 + c32) * 32; B0[j] = *(const bf16x8*)kp_; B1[j] = *(const bf16x8*)(kp_ + 16); } } while (0)
#define S_COMP(B0, B1, T0) do { _Pragma("unroll") for (int j = 0; j < 8; ++j) { const int tile = (T0) + 8 * j; if (tile < ntiles) { const int key = tile * 32 + c32; \
            _Pragma("unroll") for (int r = 0; r < 2; ++r) { f32x16 acc; _Pragma("unroll") for (int i = 0; i < 16; ++i) acc[i] = 0.f; \
                acc = __builtin_amdgcn_mfma_f32_32x32x16_bf16(a0[r], B0[j], acc, 0, 0, 0); acc = __builtin_amdgcn_mfma_f32_32x32x16_bf16(a1[r], B1[j], acc, 0, 0, 0); \
                _Pragma("unroll") for (int qi = 0; qi < 2; ++qi) { float s = 0.f; \
                    _Pragma("unroll") for (int i = 0; i < 4; ++i) s += w[r][qi][0][i] * fmaxf(acc[8 * qi + i], 0.f) + w[r][qi][1][i] * fmaxf(acc[8 * qi + 4 + i], 0.f); \
                    const int q = 4 * r + 2 * hh + qi; const _Float16 hs = (_Float16)fminf(fmaxf(s, -60000.f), 60000.f); \
                    ((_Float16*)(lds + q * W_SZ + W_SC))[key] = hs; \
                    if (key <= t0 + q) { const float f = (float)hs; mx[r][qi] = fmaxf(mx[r][qi], f); mn[r][qi] = fminf(mn[r][qi], f); } } } } } } while (0)
        S_LOAD(b0, b1, wid);
        for (int tile0 = wid; tile0 < ntiles; tile0 += 128) {
            if (tile0 + 64 < ntiles) S_LOAD(c0, c1, tile0 + 64);
            __builtin_amdgcn_sched_barrier(0);
            S_COMP(b0, b1, tile0);
            __builtin_amdgcn_sched_barrier(0);
            if (tile0 + 128 < ntiles) S_LOAD(b0, b1, tile0 + 128);
            __builtin_amdgcn_sched_barrier(0);
            if (tile0 + 64 < ntiles) S_COMP(c0, c1, tile0 + 64);
            __builtin_amdgcn_sched_barrier(0);
        }
#undef S_LOAD
#undef S_COMP
#pragma unroll
        for (int r = 0; r < 2; ++r)
#pragma unroll
            for (int qi = 0; qi < 2; ++qi) {
                float a = mx[r][qi], c = mn[r][qi];
#pragma unroll
                for (int o = 16; o >= 1; o >>= 1) { a = fmaxf(a, __shfl_xor(a, o)); c = fminf(c, __shfl_xor(c, o)); }
                if (c32 == 0 && a >= c) { const int q = 4 * r + 2 * hh + qi; atomicMin(&meta[q * 2], skey(c)); atomicMax(&meta[q * 2 + 1], skey(a)); }
            }
    }
    __syncthreads();
    const float mnq = big ? skey_inv(meta[wid * 2]) : 0.f, mxq = big ? skey_inv(meta[wid * 2 + 1]) : 0.f;
    attn_wave(p, lds, wid, lane, b, t0 + wid, mnq, mxq);
    __syncthreads();
}

constexpr int NGRP8 = SEQ / 8, ATT_P1 = NGRP8 / 8, ATT_P2 = NGRP8 / 2;
template <int SUB>
__device__ __forceinline__ void ph_mixer(const P& p, unsigned char* lds) {
    int* bc = (int*)(lds + LDS_BYTES - 16);
    constexpr int nh = SUB == 1 ? 16 : NXU;
    constexpr int a0 = SUB == 0 ? 0 : (SUB == 1 ? ATT_P1 : ATT_P2), a1 = SUB == 0 ? ATT_P1 : (SUB == 1 ? ATT_P2 : NGRP8);
    for (;;) {
        __syncthreads();
        if (tid_() == 0) bc[0] = atomicAdd(&p.ctr()[97 + SUB], 1);
        __syncthreads();
        const int it = bc[0];
        if (it >= nh) break;
        if (SUB == 0) hgx_unit(p, lds, it);
        else if (SUB == 1) hgchain_unit(p, it);
        else hgz_unit(p, lds, it);
    }
    const int b0 = (int)(xb_xcc_id() & 3u);
#pragma unroll 1
    for (int k = 0; k < 4; ++k) {
        const int b = (b0 + k) & 3;
        for (;;) {
            __syncthreads();
            if (tid_() == 0) bc[0] = atomicAdd(&p.ctr()[104 + SUB * 4 + b], 1);
            __syncthreads();
            const int it = bc[0];
            if (it >= a1 - a0) break;
            attn8_unit(p, lds, b, NGRP8 - 1 - (a0 + it));
        }
    }
}

__device__ __forceinline__ int tok_row(int tok) { return (tok >> 13) * LP + NMETA + (tok & 8191); }
__device__ __forceinline__ void ph_mix(const P& p, unsigned char* lds) {
    const int njobs = (NTOK / 256) * 4 * 2, G = gridDim.x, b0 = blockIdx.x;
    auto jobidx = [&](int i) __attribute__((always_inline)) { return (b0 + (i >> 1) * G) * 2 + (i & 1); };
    auto jobfn = [&](int i, GJob& j) __attribute__((always_inline)) -> bool {
        const int jb = jobidx(i); if (jb >= njobs) return false;
        const int which = jb & 1, u = jb >> 1, nt = u & 3, mt = u >> 2; const size_t r0 = (size_t)tok_row(mt * 256);
        j.A = (const char*)((which ? p.hgr() : p.att()) + r0 * 512); j.B = (const char*)((which ? p.wuhT() : p.wuaT()) + (size_t)nt * 256 * 512); return true; };
    auto epi = [&](f32x4 (&acc)[2][2][4][2], int i) __attribute__((always_inline)) {
        const int jb = jobidx(i), which = jb & 1, u = jb >> 1, nt = u & 3, mt = u >> 2; const size_t r0 = (size_t)tok_row(mt * 256);
        if (which == 0) {
            EPI8(
                const size_t og = (r0 + row) * 1024 + nt * 256 + col, om = (size_t)(mt * 256 + row) * 1024 + nt * 256 + col;
                const uint2 g = *(const uint2*)(p.ga() + og);
                f32x4 r;
                r[0] = v[0] * __uint_as_float(g.x << 16); r[1] = v[1] * __uint_as_float(g.x & 0xffff0000u);
                r[2] = v[2] * __uint_as_float(g.y << 16); r[3] = v[3] * __uint_as_float(g.y & 0xffff0000u);
                st_bf4(p.mix() + om, r);
            );
        } else {
            EPI8(
                const size_t og = (r0 + row) * 1024 + nt * 256 + col, om = (size_t)(mt * 256 + row) * 1024 + nt * 256 + col;
                const uint2 g = *(const uint2*)(p.gh() + og);
                const uint2 a = *(const uint2*)(p.mix() + om);
                f32x4 r;
                r[0] = __uint_as_float(a.x << 16) + v[0] * __uint_as_float(g.x << 16); r[1] = __uint_as_float(a.x & 0xffff0000u) + v[1] * __uint_as_float(g.x & 0xffff0000u);
                r[2] = __uint_as_float(a.y << 16) + v[2] * __uint_as_float(g.y << 16); r[3] = __uint_as_float(a.y & 0xffff0000u) + v[3] * __uint_as_float(g.y & 0xffff0000u);
                st_bf4(p.mix() + om, r);
            );
        }
    };
    unsigned vbU[2]; gj_lin2(vbU, 512);
    gemm_stream<false>(lds, 512, 512, (size_t)128 * 512 * 2, vbU, jobfn, epi);
}

__device__ __forceinline__ void ph_out(const P& p, unsigned char* lds) {
    const int nunits = (NTOK / 256) * 4, G = gridDim.x, b0 = blockIdx.x;
    auto jobfn = [&](int i, GJob& j) __attribute__((always_inline)) -> bool {
        const int u = b0 + i * G; if (u >= nunits) return false;
        const int nt = u & 3, mt = u >> 2;
        j.A = (const char*)(p.mix() + (size_t)mt * 256 * D); j.B = (const char*)(p.woT() + (size_t)nt * 256 * D); return true; };
    auto epi = [&](f32x4 (&acc)[2][2][4][2], int i) __attribute__((always_inline)) {
        const int u = b0 + i * G, nt = u & 3, mt = u >> 2;
        EPI8(
            const size_t o = (size_t)(mt * 256 + row) * D + nt * 256 + col;
            const f32x4 h0 = *(const f32x4*)(p.x + o);
            *(f32x4*)(p.out + o) = h0 + v;
        );
    };
    unsigned vbU[2]; gj_lin2(vbU, D);
    gemm_stream<false>(lds, D, D, (size_t)128 * D * 2, vbU, jobfn, epi);
}

constexpr int XS_LD = 1025;
__device__ __forceinline__ void ph_route(const P& p, unsigned char* lds) {
    const int tid = tid_(), lane = tid & 63, wid = __builtin_amdgcn_readfirstlane(tid >> 6);
    const int gt = blockIdx.x * NTHREADS + tid, ntot = gridDim.x * NTHREADS;
    for (int i = gt; i < CAP; i += ntot) { p.slot_token()[i] = -1; p.slot_info()[i] = make_int2(-1, 0); }
    float* xs = (float*)lds;
    int* lhist = (int*)(lds + 32 * XS_LD * 4);
    for (int tb = blockIdx.x; tb < NTOK / 128; tb += gridDim.x) {
        if (tid < 32) lhist[tid] = 0;
        for (int tile = 0; tile < 4; ++tile) {
            const int tokt = tb * 128 + tile * 32;
            __syncthreads();
#pragma unroll
            for (int t = 0; t < 4; ++t) {
                const int tl = wid * 4 + t, tok = tokt + tl;
                const float* src = p.out + (size_t)tok * D;
                f32x4 v[4]; float ss = 0.f;
#pragma unroll
                for (int i = 0; i < 4; ++i) { v[i] = *(const f32x4*)(src + lane * 4 + 256 * i); ss += v[i][0] * v[i][0] + v[i][1] * v[i][1] + v[i][2] * v[i][2] + v[i][3] * v[i][3]; }
                ss = wave_sum(ss);
                const float rs = rsqrtf(ss * (1.0f / D) + EPS);
#pragma unroll
                for (int i = 0; i < 4; ++i) {
                    const f32x4 g = *(const f32x4*)(p.ffn_g + lane * 4 + 256 * i);
                    f32x4 xn; xn[0] = v[i][0] * rs * g[0]; xn[1] = v[i][1] * rs * g[1]; xn[2] = v[i][2] * rs * g[2]; xn[3] = v[i][3] * rs * g[3];
                    st_bf4(p.xn2() + (size_t)tok * D + lane * 4 + 256 * i, xn);
#pragma unroll
                    for (int c = 0; c < 4; ++c) xs[tl * XS_LD + lane * 4 + 256 * i + c] = xn[c];
                }
            }
            __syncthreads();
            f32x16 acc;
#pragma unroll
            for (int i = 0; i < 16; ++i) acc[i] = 0.f;
            {
                const float* xr = xs + (lane & 31) * XS_LD + wid * 128 + (lane >> 5);
                const float* wp = p.router_w + (size_t)(wid * 128 + (lane >> 5)) * 32 + (lane & 31);
#pragma unroll 16
                for (int i = 0; i < 64; ++i) acc = __builtin_amdgcn_mfma_f32_32x32x2f32(xr[2 * i], wp[(size_t)(2 * i) * 32], acc, 0, 0, 0);
            }
            __syncthreads();
#pragma unroll
            for (int r = 0; r < 16; ++r) xs[wid * 1024 + ((r & 3) + 8 * (r >> 2) + 4 * (lane >> 5)) * 32 + (lane & 31)] = acc[r];
            __syncthreads();
            const int e = lane & 31, hh = lane >> 5;
            const float be = p.router_b[e];
#pragma unroll
            for (int it = 0; it < 2; ++it) {
                const int tl = wid * 4 + it * 2 + hh;
                float l = be;
#pragma unroll
                for (int w = 0; w < 8; ++w) l += xs[w * 1024 + tl * 32 + e];
                float bv[4]; int bi[4];
#pragma unroll
                for (int k = 0; k < 4; ++k) {
                    float m = l;
#pragma unroll
                    for (int o = 16; o >= 1; o >>= 1) m = fmaxf(m, __shfl_xor(m, o));
                    const unsigned long long bal = __ballot(l == m);
                    const unsigned half = hh ? (unsigned)(bal >> 32) : (unsigned)bal;
                    const int idx = __builtin_ctz(half);
                    bv[k] = m; bi[k] = idx;
                    if (e == idx) l = -INFINITY;
                }
                const float e1 = __expf(bv[1] - bv[0]), e2 = __expf(bv[2] - bv[0]), e3 = __expf(bv[3] - bv[0]);
                const float inv = 1.0f / (1.0f + e1 + e2 + e3);
                if (e == 0) {
                    const int tok = tokt + tl;
                    p.tok_exp()[tok * 4 + 0] = bi[0]; p.tok_exp()[tok * 4 + 1] = bi[1]; p.tok_exp()[tok * 4 + 2] = bi[2]; p.tok_exp()[tok * 4 + 3] = bi[3];
                    p.tok_gate()[tok * 4 + 0] = inv; p.tok_gate()[tok * 4 + 1] = e1 * inv; p.tok_gate()[tok * 4 + 2] = e2 * inv; p.tok_gate()[tok * 4 + 3] = e3 * inv;
                    atomicAdd(&lhist[bi[0]], 1); atomicAdd(&lhist[bi[1]], 1); atomicAdd(&lhist[bi[2]], 1); atomicAdd(&lhist[bi[3]], 1);
                }
            }
        }
        __syncthreads();
        if (tid < 32) p.wg_cnt()[tb * 32 + tid] = lhist[tid];
        __syncthreads();
    }
    for (long task = gt; task < 96L * 16384; task += ntot) {
        const int mat = (int)(task >> 14), r = (int)(task & 16383), kq = r >> 10, n = r & 1023;
        const int which = mat >> 5, e = mat & 31;
        const float* W = (which == 0 ? p.w_gate : which == 1 ? p.w_up : p.w_down) + (size_t)e * 1048576 + (size_t)(kq * 64) * 1024 + n;
        bf16_t* outp = (which == 0 ? p.wgT() : which == 1 ? p.wuT() : p.wdT()) + (size_t)e * 1048576 + (size_t)n * 1024 + kq * 64;
        float v[64];
#pragma unroll
        for (int i = 0; i < 64; ++i) v[i] = W[(size_t)i * 1024];
        uint4* dst = (uint4*)outp;
#pragma unroll
        for (int i = 0; i < 8; ++i) dst[i] = make_uint4(pack2(v[8 * i], v[8 * i + 1]), pack2(v[8 * i + 2], v[8 * i + 3]), pack2(v[8 * i + 4], v[8 * i + 5]), pack2(v[8 * i + 6], v[8 * i + 7]));
    }
}

__device__ __forceinline__ void ph_fill(const P& p, unsigned char* lds) {
    const int tid = tid_();
    int* tot = (int*)lds;
    int* pre = tot + 512;
    int* ps = pre + 512;
    int* lc = ps + 32;
    for (int tb = blockIdx.x; tb < NTOK / 128; tb += gridDim.x) {
        {
            const int e = tid & 31, part = tid >> 5;
            int t = 0, q = 0;
            for (int b2 = part; b2 < NTOK / 128; b2 += 16) { const int c = p.wg_cnt()[b2 * 32 + e]; t += c; if (b2 < tb) q += c; }
            tot[part * 32 + e] = t; pre[part * 32 + e] = q;
        }
        __syncthreads();
        if (tid == 0) {
            int acc = 0;
            for (int e = 0; e < NE; ++e) {
                int t = 0, q = 0;
                for (int i = 0; i < 16; ++i) { t += tot[i * 32 + e]; q += pre[i * 32 + e]; }
                ps[e] = acc + q; lc[e] = 0;
                const int nb = (t + 255) >> 8;
                if (tb == 0) for (int i = 0; i < nb; ++i) p.block_expert()[(acc >> 8) + i] = e;
                acc += nb * 256;
            }
            if (tb == 0) p.ctr()[96] = acc >> 8;
        }
        __syncthreads();
        {
            const int i = tb * 512 + tid;
            const int e = p.tok_exp()[i];
            const int dest = ps[e] + atomicAdd(&lc[e], 1);
            p.slot_token()[dest] = i >> 2;
            p.slot_rank()[dest] = i & 3;
            p.slot_gate()[dest] = p.tok_gate()[i];
            p.slot_info()[dest] = make_int2((i >> 2) | ((i & 3) << 16), __float_as_int(p.tok_gate()[i]));
        }
        __syncthreads();
    }
}

struct GUOff { __device__ __forceinline__ size_t operator()(int R) const { return (size_t)(R >> 7) * (WE_B / 2) + (size_t)(R & 127) * 1024; } };
struct GatherOff { const int* st; __device__ __forceinline__ size_t operator()(int R) const { const int t = st[R]; return (size_t)(t < 0 ? 0 : t) * 1024; } };
__device__ __forceinline__ void ph_moe1(const P& p, unsigned char* lds) {
    const int nunits = p.ctr()[96] * 8, G = gridDim.x, b0 = blockIdx.x;
    auto jobfn = [&](int i, GJob& j) __attribute__((always_inline)) -> bool {
        const int u = b0 + i * G; if (u >= nunits) return false;
        const int ct = u & 7, rb = u >> 3, e = p.block_expert()[rb];
        j.A = (const char*)p.xn2(); j.B = (const char*)(p.wgT() + (size_t)e * 1048576 + (size_t)ct * 128 * 1024); gj_gather_job(j, GatherOff{p.slot_token() + rb * 256}); return true; };
    auto epi = [&](f32x4 (&acc)[2][2][4][2], int i) __attribute__((always_inline)) {
        const int u = b0 + i * G, ct = u & 7, rb = u >> 3, e = p.block_expert()[rb];
        const int tid_e = tid_(), lane_e = tid_e & 63, wid_e = tid_e >> 6, wr = wid_e >> 2, wc = wid_e & 3, fr = lane_e & 15, fq = lane_e >> 4;
#pragma unroll
        for (int n = 0; n < 2; ++n) {
            const int c = ct * 128 + wc * 32 + n * 16 + fq * 4;
            const f32x4 bg = *(const f32x4*)(p.b_gate + (size_t)e * DFF + c), bu = *(const f32x4*)(p.b_up + (size_t)e * DFF + c);
#pragma unroll
            for (int ai = 0; ai < 2; ++ai)
#pragma unroll
                for (int m = 0; m < 4; ++m) {
                    const int row = rb * 256 + ai * 128 + wr * 64 + m * 16 + fr;
                    f32x4 a;
#pragma unroll
                    for (int j = 0; j < 4; ++j) {
                        const float g = fminf(acc[ai][0][m][n][j] + bg[j], 7.0f);
                        const float uu = fminf(fmaxf(acc[ai][1][m][n][j] + bu[j], -7.0f), 7.0f);
                        a[j] = (uu + 1.0f) * (g * sigmoidf_(1.702f * g));
                    }
                    st_bf4(p.act() + (size_t)row * DFF + c, a);
                }
        }
    };
    unsigned vbU[2]; gj_lin2(vbU, D);
    gemm_stream<true>(lds, D, D, (size_t)WE_B, vbU, jobfn, epi);
}
__device__ __forceinline__ void ph_moe2(const P& p, unsigned char* lds) {
    const int nunits = p.ctr()[96] * 4, G = gridDim.x, b0 = blockIdx.x;
    auto jobfn = [&](int i, GJob& j) __attribute__((always_inline)) -> bool {
        const int u = b0 + i * G; if (u >= nunits) return false;
        const int nt = u & 3, rb = u >> 2, e = p.block_expert()[rb];
        j.A = (const char*)(p.act() + (size_t)rb * 256 * DFF); j.B = (const char*)(p.wdT() + (size_t)e * 1048576 + (size_t)nt * 256 * DFF); return true; };
    auto epi = [&](f32x4 (&acc)[2][2][4][2], int i) __attribute__((always_inline)) {
        const int u = b0 + i * G, nt = u & 3, rb = u >> 2, e = p.block_expert()[rb];
        const int tid_e = tid_(), lane_e = tid_e & 63, wid_e = tid_e >> 6, wr = wid_e >> 2, wc = wid_e & 3, fr = lane_e & 15, fq = lane_e >> 4;
        f32x4 bd[2][2];
#pragma unroll
        for (int bj = 0; bj < 2; ++bj)
#pragma unroll
            for (int n = 0; n < 2; ++n) bd[bj][n] = *(const f32x4*)(p.b_down + (size_t)e * D + nt * 256 + bj * 128 + wc * 32 + n * 16 + fq * 4);
        int2 info[2][4];
#pragma unroll
        for (int ai = 0; ai < 2; ++ai)
#pragma unroll
            for (int m = 0; m < 4; ++m) info[ai][m] = p.slot_info()[rb * 256 + ai * 128 + wr * 64 + m * 16 + fr];
#pragma unroll
        for (int ai = 0; ai < 2; ++ai)
#pragma unroll
        for (int mp = 0; mp < 2; ++mp) {
            f32x4 old[2][2][2];
#pragma unroll
            for (int mm = 0; mm < 2; ++mm) {
                const int ix = info[ai][mp * 2 + mm].x;
                const size_t o = (size_t)(ix & 0xffff) * D + nt * 256 + wc * 32 + fq * 4;
#pragma unroll
                for (int bj = 0; bj < 2; ++bj)
#pragma unroll
                    for (int n = 0; n < 2; ++n) old[mm][bj][n] = (ix >= 0 && (ix >> 16) == 0) ? *(const f32x4*)(p.out + o + bj * 128 + n * 16) : (f32x4){0.f, 0.f, 0.f, 0.f};
            }
#pragma unroll
            for (int mm = 0; mm < 2; ++mm) {
                const int m = mp * 2 + mm;
                const int ix = info[ai][m].x;
                if (ix < 0) continue;
                const int rank = ix >> 16; const float gate = __int_as_float(info[ai][m].y);
                const size_t o = (size_t)(ix & 0xffff) * D + nt * 256 + wc * 32 + fq * 4;
                if (rank == 0) {
#pragma unroll
                    for (int bj = 0; bj < 2; ++bj)
#pragma unroll
                        for (int n = 0; n < 2; ++n) *(f32x4*)(p.out + o + bj * 128 + n * 16) = old[mm][bj][n] + (acc[ai][bj][m][n] + bd[bj][n]) * gate;
                } else {
                    bf16_t* yb = rank == 1 ? p.y1() : (rank == 2 ? p.y2() : p.y3());
#pragma unroll
                    for (int bj = 0; bj < 2; ++bj)
#pragma unroll
                        for (int n = 0; n < 2; ++n) st_bf4(yb + o + bj * 128 + n * 16, (acc[ai][bj][m][n] + bd[bj][n]) * gate);
                }
            }
        }
    };
    unsigned vbU[2]; gj_lin2(vbU, DFF);
    gemm_stream<false>(lds, DFF, DFF, (size_t)128 * DFF * 2, vbU, jobfn, epi);
}

__device__ __forceinline__ void ph_final(const P& p, unsigned char* lds) {
    const int tid = tid_(), lane = tid & 63, wid = tid >> 6;
    const int gw = blockIdx.x * 8 + wid, nw = gridDim.x * 8;
    for (int tok = gw; tok < NTOK; tok += nw) {
        float* dst = p.out + (size_t)tok * D;
        f32x4 v[4];
#pragma unroll
        for (int i = 0; i < 4; ++i) v[i] = *(const f32x4*)(dst + lane * 4 + 256 * i);
#pragma unroll
        for (int j = 0; j < 3; ++j) {
            const bf16_t* yr = (j == 0 ? p.y1() : j == 1 ? p.y2() : p.y3()) + (size_t)tok * D;
#pragma unroll
            for (int i = 0; i < 4; ++i) {
                const uint2 w = *(const uint2*)(yr + lane * 4 + 256 * i);
                v[i][0] += __uint_as_float(w.x << 16); v[i][1] += __uint_as_float(w.x & 0xffff0000u);
                v[i][2] += __uint_as_float(w.y << 16); v[i][3] += __uint_as_float(w.y & 0xffff0000u);
            }
        }
        float ss = 0.f;
#pragma unroll
        for (int i = 0; i < 4; ++i) ss += v[i][0] * v[i][0] + v[i][1] * v[i][1] + v[i][2] * v[i][2] + v[i][3] * v[i][3];
        ss = wave_sum(ss);
        const float rs = rsqrtf(ss * (1.0f / D) + EPS);
#pragma unroll
        for (int i = 0; i < 4; ++i) {
            const f32x4 g = *(const f32x4*)(p.final_g + lane * 4 + 256 * i);
            *(f32x4*)(dst + lane * 4 + 256 * i) = v[i] * rs * g;
        }
    }
}

typedef const __attribute__((address_space(4))) P* PK;
#define PHASE(call) do { PK q_ = pk; asm volatile("" : "+s"(q_)); const P& p = *(const P*)q_; call; } while (0)
__global__ void __launch_bounds__(NTHREADS) k_mega(P p_unused) {
    __shared__ __attribute__((aligned(16))) unsigned char lds[LDS_BYTES];
    cg::grid_group grid = cg::this_grid();
    const PK pk = (PK)__builtin_amdgcn_kernarg_segment_ptr();
    if (tid_() < 4) ((unsigned*)(lds + LDS_BYTES - 32))[tid_()] = 0u;
    __syncthreads();
    XcdBarrier xb;
    PHASE(xb = xcd_barrier_post((unsigned*)(p.ws + OFF_BAR), (volatile LAS unsigned*)(lds + LDS_BYTES - 32)));
    PHASE(ph_prep(p, lds)); grid.sync();
    PHASE(ph_inproj(p, lds)); xcd_barrier(xb);
    PHASE(ph_mixer<0>(p, lds)); xcd_barrier(xb);
    PHASE(ph_mixer<1>(p, lds)); xcd_barrier(xb);
    PHASE(ph_mixer<2>(p, lds)); xcd_barrier(xb);
    PHASE(ph_mix(p, lds)); xcd_barrier(xb);
    PHASE(ph_out(p, lds)); xcd_barrier(xb);
    PHASE(ph_route(p, lds)); xcd_barrier(xb);
    PHASE(ph_fill(p, lds)); xcd_barrier(xb);
    PHASE(ph_moe1(p, lds)); xcd_barrier(xb);
    PHASE(ph_moe2(p, lds)); xcd_barrier(xb);
    PHASE(ph_final(p, lds));
}

extern "C" void kernel_launch(void* const* d_in, const int* in_sizes, int n_in, void* d_out, int out_size, void* d_ws, size_t ws_size,
                              hipStream_t stream) {
    P p{};
    p.x = (const float*)d_in[0]; p.meta = (const float*)d_in[1]; p.attn_g = (const float*)d_in[2]; p.w_in = (const float*)d_in[3];
    p.hgrn_g = (const float*)d_in[4]; p.w_ua = (const float*)d_in[5]; p.w_uh = (const float*)d_in[6]; p.w_out = (const float*)d_in[7];
    p.lb_logits = (const float*)d_in[8]; p.ffn_g = (const float*)d_in[9]; p.router_w = (const float*)d_in[10]; p.router_b = (const float*)d_in[11];
    p.w_gate = (const float*)d_in[12]; p.b_gate = (const float*)d_in[13]; p.w_up = (const float*)d_in[14]; p.b_up = (const float*)d_in[15];
    p.w_down = (const float*)d_in[16]; p.b_down = (const float*)d_in[17]; p.final_g = (const float*)d_in[18];
    p.out = (float*)d_out;
    p.ws = (unsigned char*)d_ws;
    if (WS_NEED > ws_size) { fprintf(stderr, "workspace too small: need %zu have %zu\n", (size_t)WS_NEED, ws_size); return; }
    static int grid_blocks = 0;
    if (!grid_blocks) {
        int dev = 0, cus = 0, per_cu = 0;
        hipGetDevice(&dev);
        hipDeviceGetAttribute(&cus, hipDeviceAttributeMultiprocessorCount, dev);
        hipOccupancyMaxActiveBlocksPerMultiprocessor(&per_cu, k_mega, NTHREADS, 0);
        if (per_cu > 1) per_cu = 1;
        grid_blocks = cus * per_cu;
    }
    hipMemsetAsync(p.ws + OFF_BAR, 0, XCD_BAR_WORDS * 4, stream);
    void* args[] = {&p};
    hipError_t e = hipLaunchCooperativeKernel((void*)k_mega, dim3(grid_blocks), dim3(NTHREADS), args, 0, stream);
    if (e != hipSuccess) fprintf(stderr, "cooperative launch failed: %s (grid %d)\n", hipGetErrorString(e), grid_blocks);
}
```

```cpp
#include <hip/hip_runtime.h>
#include <hip/hip_cooperative_groups.h>
#include <stdint.h>
#include <cstdio>
namespace cg = cooperative_groups;

#ifndef MEGA
#define MEGA 1
#endif

typedef unsigned short bf16_t;
typedef short bf16x8 __attribute__((ext_vector_type(8)));
typedef float f32x4 __attribute__((ext_vector_type(4)));

constexpr int D = 1024, NB = 4, SEQ = 8192, NMETA = 16, L = SEQ + NMETA  , LP = 8320, T = NB * LP  ;
constexpr int NTOK = NB * SEQ;
constexpr int IN_COLS = 5160;
constexpr int NE = 32, TOPK = 4, DFF = 1024;
constexpr int CAP_BLOCKS = (NTOK * TOPK) / 256 + NE;
constexpr int CAP = CAP_BLOCKS * 256;
constexpr float EPS = 1e-5f;
constexpr int NTHREADS = 512;
constexpr int LDS_BYTES = 155648;
constexpr int NVC = 5376;
#define LAS __attribute__((address_space(3)))

__device__ __forceinline__ bf16_t f2bf(float f) {
    uint32_t u = __float_as_uint(f);
    u += 0x7fffu + ((u >> 16) & 1u);
    return (bf16_t)(u >> 16);
}
__device__ __forceinline__ float bf2f(bf16_t h) { return __uint_as_float(((uint32_t)h) << 16); }
__device__ __forceinline__ uint32_t pack2(float a, float b) { return (uint32_t)f2bf(a) | ((uint32_t)f2bf(b) << 16); }
__device__ __forceinline__ float sigmoidf_(float x) { return __builtin_amdgcn_rcpf(1.0f + __builtin_amdgcn_exp2f(-1.4426950408889634f * x)); }
__device__ __forceinline__ float wave_sum(float v) {
#pragma unroll
    for (int o = 32; o >= 1; o >>= 1) v += __shfl_xor(v, o);
    return v;
}
__device__ __forceinline__ float wave_max(float v) {
#pragma unroll
    for (int o = 32; o >= 1; o >>= 1) v = fmaxf(v, __shfl_xor(v, o));
    return v;
}

constexpr size_t al256(size_t x) { return (x + 255) & ~(size_t)255; }
constexpr size_t TT = (size_t)T;
constexpr size_t MB1 = 1024 * 1024;
constexpr size_t WE_B = (size_t)NE * 1024 * 1024 * 2;
constexpr size_t OFF_WGT = 0, OFF_WUT = WE_B, OFF_WDT = 2 * WE_B, OFF_XN2 = 3 * WE_B, OFF_ACT = OFF_XN2 + (size_t)NTOK * D * 2,
                 OFF_TAB = OFF_ACT + (size_t)CAP * DFF * 2;
constexpr size_t OFF_Y1 = OFF_XN2, OFF_Y2 = OFF_WGT, OFF_Y3 = OFF_WUT;
constexpr size_t OFF_ROPE = OFF_TAB, OFF_LB = OFF_ROPE + al256((size_t)LP * 24 * 4), OFF_CTR = OFF_LB + al256(512 * 4),
                 OFF_BEXP = OFF_CTR + al256(128 * 4), OFF_SLOT = OFF_BEXP + al256((size_t)CAP_BLOCKS * 4), OFF_SRANK = OFF_SLOT + al256((size_t)CAP * 4),
                 OFF_SGATE = OFF_SRANK + al256((size_t)CAP * 4), OFF_TEXP = OFF_SGATE + al256((size_t)CAP * 4), OFF_TGATE = OFF_TEXP + al256((size_t)NTOK * 16),
                 OFF_BAR = OFF_TGATE + al256((size_t)NTOK * 16), OFF_WGC = OFF_BAR + al256(3456 * 4), OFF_SINFO = OFF_WGC + al256(256 * 32 * 4), WS_NEED = OFF_SINFO + al256((size_t)CAP * 8);
constexpr size_t OFF_WIN = 0, OFF_WUA = OFF_WIN + (size_t)NVC * 1024 * 2, OFF_WUH = OFF_WUA + MB1, OFF_WO = OFF_WUH + MB1, OFF_XN = OFF_WO + 2 * MB1,
                 OFF_Q = OFF_XN + TT * 2048, OFF_K = OFF_Q + TT * 1024, OFF_V = OFF_K + TT * 256, OFF_IQ = OFF_V + TT * 256, OFF_IK = OFF_IQ + TT * 512,
                 OFF_IW = OFF_IK + TT * 64, OFF_HQ = OFF_IW + TT * 32, OFF_HF = OFF_HQ + TT * 1024, OFF_HI = OFF_HF + TT * 1024, OFF_HG = OFF_HI + TT * 1024,
                 OFF_GA = OFF_HG + TT * 1024, OFF_GH = OFF_GA + TT * 2048, OFF_ATT = OFF_GH + TT * 2048, OFF_HGR = OFF_ATT + TT * 1024,
                 OFF_S1_END = OFF_HGR + TT * 1024;
constexpr size_t OFF_MIX = OFF_XN;
static_assert(OFF_S1_END <= OFF_TAB, "stage-1 layout overflows");

__device__ __forceinline__ int tid_() { int t = threadIdx.x; asm volatile("" : "+v"(t)); return t; }

struct P {
    const float *x, *meta, *attn_g, *w_in, *hgrn_g, *w_ua, *w_uh, *w_out, *lb_logits, *ffn_g, *router_w, *router_b,
        *w_gate, *b_gate, *w_up, *b_up, *w_down, *b_down, *final_g;
    float* out;
    unsigned char* ws;
#define WSF(type, name, off) __device__ __forceinline__ type* name() const { return (type*)(ws + (off)); }
    WSF(bf16_t, xn, OFF_XN) WSF(bf16_t, q, OFF_Q) WSF(bf16_t, k, OFF_K) WSF(bf16_t, v, OFF_V) WSF(bf16_t, iq, OFF_IQ) WSF(bf16_t, ik, OFF_IK)
    WSF(bf16_t, hq, OFF_HQ) WSF(bf16_t, hf, OFF_HF) WSF(bf16_t, hi, OFF_HI) WSF(bf16_t, hg, OFF_HG) WSF(bf16_t, ga, OFF_GA) WSF(bf16_t, gh, OFF_GH)
    WSF(bf16_t, att, OFF_ATT) WSF(bf16_t, hgr, OFF_HGR) WSF(bf16_t, mix, OFF_MIX) WSF(bf16_t, xn2, OFF_XN2) WSF(bf16_t, act, OFF_ACT)
    WSF(bf16_t, y1, OFF_Y1) WSF(bf16_t, y2, OFF_Y2) WSF(bf16_t, y3, OFF_Y3)
    WSF(bf16_t, winT, OFF_WIN) WSF(bf16_t, wuaT, OFF_WUA) WSF(bf16_t, wuhT, OFF_WUH) WSF(bf16_t, woT, OFF_WO)
    WSF(bf16_t, wgT, OFF_WGT) WSF(bf16_t, wuT, OFF_WUT) WSF(bf16_t, wdT, OFF_WDT)
    WSF(float, iw, OFF_IW) WSF(float, rope, OFF_ROPE) WSF(float, lb, OFF_LB) WSF(float, tok_gate, OFF_TGATE) WSF(float, slot_gate, OFF_SGATE)
    WSF(int, ctr, OFF_CTR)
    WSF(int, wg_cnt, OFF_WGC) WSF(int2, slot_info, OFF_SINFO) WSF(int, block_expert, OFF_BEXP) WSF(int, slot_token, OFF_SLOT) WSF(int, slot_rank, OFF_SRANK) WSF(int, tok_exp, OFF_TEXP)
};

template <class ColMap>
__device__ __forceinline__ void convert_T(const float* W, int ldw, bf16_t* out, int K, int N, const ColMap& cmap, int gt, int ntot) {
    const int kb = K / 64; const long ntask = (long)N * kb;
    for (long task = gt; task < ntask; task += ntot) {
        const int kq = (int)(task / N), n = (int)(task % N);
        const int c = cmap(n);
        uint32_t w[32];
        if (c >= 0) {
            const float* src = W + (size_t)(kq * 64) * ldw + c;
            float v[64];
#pragma unroll
            for (int i = 0; i < 64; ++i) v[i] = src[(size_t)i * ldw];
#pragma unroll
            for (int i = 0; i < 32; ++i) w[i] = pack2(v[2 * i], v[2 * i + 1]);
        } else {
#pragma unroll
            for (int i = 0; i < 32; ++i) w[i] = 0u;
        }
        uint4* dst = (uint4*)(out + (size_t)n * K + kq * 64);
#pragma unroll
        for (int i = 0; i < 8; ++i) dst[i] = make_uint4(w[4 * i], w[4 * i + 1], w[4 * i + 2], w[4 * i + 3]);
    }
}
struct IdMap { __device__ __forceinline__ int operator()(int n) const { return n; } };
struct WinMap { __device__ __forceinline__ int operator()(int n) const { return n < 1064 ? n : (n < 1280 ? -1 : n - 216); } };

#define XB_TMO      128
#define XB_XCNT(j)  (256  + 64 * (j))
#define XB_XSUB(j)  (1280 + 64 * (j))
#define XB_XGEN(j)  (2304 + 64 * (j))
#define XB_TOP      3328
#define XB_TOPGEN   3392
#define XCD_BAR_WORDS 3456
#define XB_SPIN_CAP (1u << 22)
__device__ __forceinline__ unsigned xb_ld(unsigned* p)              { return __hip_atomic_load(p, __ATOMIC_RELAXED, __HIP_MEMORY_SCOPE_AGENT); }
__device__ __forceinline__ unsigned xb_add(unsigned* p, unsigned v) { return __hip_atomic_fetch_add(p, v, __ATOMIC_RELAXED, __HIP_MEMORY_SCOPE_AGENT); }
__device__ __forceinline__ unsigned xb_xcc_id() { return (unsigned)__builtin_amdgcn_s_getreg((3 << 11) | 20) & 0xFu; }
#define XB_SPIN(cond, bar) do { unsigned _sp = 0; while (cond) { __builtin_amdgcn_s_sleep(1); \
    if ((++_sp & 255u) == 0u) { if (xb_ld(&(bar)[XB_TMO])) break; if (_sp > XB_SPIN_CAP) { atomicAdd(&(bar)[XB_TMO], 1u); break; } } } } while (0)
struct XcdBarrier { unsigned* bar; unsigned x; volatile LAS unsigned* st; };
__device__ __forceinline__ XcdBarrier xcd_barrier_post(unsigned* bar, volatile LAS unsigned* st) {
    XcdBarrier b; b.bar = bar; b.x = xb_xcc_id(); b.st = st;
    if (threadIdx.x == 0) (void)xb_add(&bar[XB_XCNT(b.x)], 1u);
    return b;
}
__device__ __forceinline__ void xcd_barrier_complete(unsigned* bar, unsigned x, unsigned& nloc, unsigned& nx) {
    const unsigned G = gridDim.x * gridDim.y * gridDim.z;
    unsigned sum, cnt, mine, sp = 0u;
    for (;;) {
        sum = 0u; cnt = 0u; mine = 0u;
#pragma unroll
        for (unsigned j = 0; j < 16; ++j) { const unsigned c = xb_ld(&bar[XB_XCNT(j)]); sum += c; cnt += (c > 0u) ? 1u : 0u; mine = (j == x) ? c : mine; }
        if (sum == G) break;
        __builtin_amdgcn_s_sleep(1);
        if ((++sp & 255u) == 0u) { if (xb_ld(&bar[XB_TMO])) break; if (sp > XB_SPIN_CAP) { atomicAdd(&bar[XB_TMO], 1u); break; } }
    }
    nloc = mine > 0u ? mine : 1u; nx = cnt > 0u ? cnt : 1u;
}
__device__ __forceinline__ void xcd_barrier(const XcdBarrier& b) {
    asm volatile("s_waitcnt vmcnt(0)" ::: "memory");
    __syncthreads();
    if (threadIdx.x == 0) {
        unsigned* bar = b.bar;
        __builtin_amdgcn_s_waitcnt(0);
        unsigned nloc = b.st[0], nx = b.st[1];
        if (nloc == 0u) { xcd_barrier_complete(bar, b.x, nloc, nx); b.st[0] = nloc; b.st[1] = nx; }
        const unsigned old = xb_add(&bar[XB_XSUB(b.x)], 1u);
        const unsigned gen = old / nloc;
        if (old + 1u == (gen + 1u) * nloc) {
            __builtin_amdgcn_fence(__ATOMIC_RELEASE, "agent");
            asm volatile("s_waitcnt vmcnt(0)" ::: "memory");
            const unsigned og = xb_add(&bar[XB_TOP], 1u);
            const unsigned tg = og / nx;
            if (og + 1u == (tg + 1u) * nx) xb_add(&bar[XB_TOPGEN], 1u);
            else XB_SPIN(xb_ld(&bar[XB_TOPGEN]) == tg, bar);
            __builtin_amdgcn_fence(__ATOMIC_ACQUIRE, "agent");
            xb_add(&bar[XB_XGEN(b.x)], 1u);
            asm volatile("s_waitcnt vmcnt(0)" ::: "memory");
        } else {
            XB_SPIN(xb_ld(&bar[XB_XGEN(b.x)]) == gen, bar);
            __builtin_amdgcn_fence(__ATOMIC_ACQUIRE, "agent");
            asm volatile("s_waitcnt vmcnt(0)" ::: "memory");
        }
    }
    __syncthreads();
}

__device__ __forceinline__ void ph_prep(const P& p, unsigned char* lds) {
    const int tid = tid_(), lane = tid & 63, wid = tid >> 6;
    const int gw = blockIdx.x * 8 + wid, nw = gridDim.x * 8;
    for (int r = gw; r < T; r += nw) {
        const int b = r / LP, pos = r % LP;
        bf16_t* dst = p.xn() + (size_t)r * D;
        if (pos >= L) {
#pragma unroll
            for (int i = 0; i < 4; ++i) *(uint2*)(dst + lane * 4 + 256 * i) = make_uint2(0u, 0u);
            continue;
        }
        const float* src = pos < NMETA ? p.meta + (size_t)pos * D : p.x + ((size_t)b * SEQ + (pos - NMETA)) * D;
        f32x4 v[4]; float ss = 0.f;
#pragma unroll
        for (int i = 0; i < 4; ++i) { v[i] = *(const f32x4*)(src + lane * 4 + 256 * i); ss += v[i][0] * v[i][0] + v[i][1] * v[i][1] + v[i][2] * v[i][2] + v[i][3] * v[i][3]; }
        ss = wave_sum(ss);
        const float rs = rsqrtf(ss * (1.0f / D) + EPS);
#pragma unroll
        for (int i = 0; i < 4; ++i) {
            const f32x4 g = *(const f32x4*)(p.attn_g + lane * 4 + 256 * i);
            uint2 o; o.x = pack2(v[i][0] * rs * g[0], v[i][1] * rs * g[1]); o.y = pack2(v[i][2] * rs * g[2], v[i][3] * rs * g[3]);
            *(uint2*)(dst + lane * 4 + 256 * i) = o;
        }
    }
    const int gt = blockIdx.x * NTHREADS + tid, nt = gridDim.x * NTHREADS;
    for (int i = gt; i < LP * 12; i += nt) {
        const int pos = i / 12, f = i % 12;
        const double ex = f < 8 ? -(double)f / 8.0 : -(double)(f - 8) / 4.0;
        const double inv = exp(ex * log(500000.0));
        const double ang = (double)pos * inv;
        const double twopi = 6.283185307179586476925286766559;
        const double r = ang - twopi * rint(ang / twopi);
        const float rf = (float)r;
        const float c = cosf(rf), s = sinf(rf);
        float* row = p.rope() + (size_t)pos * 24;
        if (f < 8) { row[f] = c; row[8 + f] = s; } else { row[16 + f - 8] = c; row[20 + f - 8] = s; }
    }
    for (int i = gt; i < 512; i += nt) {
        const float a = p.lb_logits[i], b2 = p.lb_logits[512 + i];
        p.lb()[i] = 1.0f / (1.0f + expf(b2 - a));
    }
    for (int i = gt; i < 128; i += nt) p.ctr()[i] = 0;
    convert_T(p.w_in, IN_COLS, p.winT(), 1024, NVC, WinMap{}, gt, nt);
    convert_T(p.w_ua, 1024, p.wuaT(), 512, 1024, IdMap{}, gt, nt);
    convert_T(p.w_uh, 1024, p.wuhT(), 512, 1024, IdMap{}, gt, nt);
    convert_T(p.w_out, 1024, p.woT(), 1024, 1024, IdMap{}, gt, nt);
}
constexpr int G_TILE_B = 256 * 64 * 2, G_STAGE_B = 2 * G_TILE_B;
__device__ __forceinline__ int g_lds_byte(int r, int c) { const int st = (r >> 4) * 2 + (c >> 5), ob = (r & 15) * 64 + (c & 31) * 2; return st * 1024 + (ob ^ (((ob >> 9) & 1) << 5)); }
__device__ __forceinline__ void g_stage_rc(int b, int& R, int& C) { const int st = b >> 10, sb = b & 1023, swz = sb ^ (((sb >> 9) & 1) << 5); R = (st >> 1) * 16 + swz / 64; C = (st & 1) * 32 + (swz % 64) / 2; }

constexpr int HTB = 128 * 64 * 2;
struct GJob { const char* A; const char* B; unsigned va00, va01, va10, va11; };
__device__ __forceinline__ void gj_lin(unsigned (&v)[2][2], int ld) {
#pragma unroll
    for (int h = 0; h < 2; ++h)
#pragma unroll
        for (int i = 0; i < 2; ++i) { int R, C; g_stage_rc(tid_() * 16 + i * 8192, R, C); v[h][i] = (unsigned)(((h * 128 + R) * ld + C) * 2); }
}
template <class AOff>
__device__ __forceinline__ void gj_gather(unsigned (&v)[2][2], const AOff& aoff) {
#pragma unroll
    for (int h = 0; h < 2; ++h)
#pragma unroll
        for (int i = 0; i < 2; ++i) { int R, C; g_stage_rc(tid_() * 16 + i * 8192, R, C); v[h][i] = (unsigned)((aoff(h * 128 + R) + C) * 2); }
}
template <class AOff>
__device__ __forceinline__ void gj_gather_job(GJob& j, const AOff& aoff) {
    unsigned v[2][2]; gj_gather(v, aoff); j.va00 = v[0][0]; j.va01 = v[0][1]; j.va10 = v[1][0]; j.va11 = v[1][1];
}
template <bool GATHER, class JobFn, class Epi>
__device__ __forceinline__ void gemm_stream(unsigned char* lds_, int K, int lda, size_t hstepB, const unsigned (&vbU)[2], const JobFn& jobfn, const Epi& epi) {
    LAS unsigned char* lds = (LAS unsigned char*)lds_;
    const int tid = tid_(), wid = __builtin_amdgcn_readfirstlane(tid >> 6), lane = tid & 63, wr = wid >> 2, wc = wid & 3, fr = lane & 15, fq = lane >> 4;
    const int nt = K / 64;
    const size_t kstep = 128;
    const size_t hstepA = GATHER ? 0 : (size_t)128 * lda * 2;
    const unsigned ldsw = (unsigned)wid * 1024u;
    const int aoff = g_lds_byte(wr * 64 + fr, fq * 8), boff = g_lds_byte(wc * 32 + fr, fq * 8);
    unsigned vaU[2];
#pragma unroll
    for (int i = 0; i < 2; ++i) { int R, C; g_stage_rc(tid * 16 + i * 8192, R, C); vaU[i] = (unsigned)((R * lda + C) * 2); }
#define PG8_SA(b, h) (((b) * 2 + (h)) * HTB)
#define PG8_SB(b, h) ((4 + (b) * 2 + (h)) * HTB)
#define PG8_STAGE2(bufoff, gbase, v0, v1) do { \
        __builtin_amdgcn_global_load_lds((const unsigned*)((const char*)(gbase) + (v0)), (LAS unsigned*)(lds + (bufoff) + ldsw), 16, 0, 0); \
        __builtin_amdgcn_global_load_lds((const unsigned*)((const char*)(gbase) + (v1)), (LAS unsigned*)(lds + (bufoff) + ldsw + 8192), 16, 0, 0); } while (0)
#define STB(bufoff, gbase, h) PG8_STAGE2(bufoff, (gbase) + ((h) ? hstepB : 0), vbU[0], vbU[1])
#define STA_CUR(bufoff, gbase, h) do { if (GATHER) PG8_STAGE2(bufoff, gbase, (h) ? cur.va10 : cur.va00, (h) ? cur.va11 : cur.va01); else PG8_STAGE2(bufoff, (gbase) + ((h) ? hstepA : 0), vaU[0], vaU[1]); } while (0)
#define STA_SEL(bufoff, gbase, h) do { if (GATHER) PG8_STAGE2(bufoff, gbase, last ? ((h) ? nxt.va10 : nxt.va00) : ((h) ? cur.va10 : cur.va00), last ? ((h) ? nxt.va11 : nxt.va01) : ((h) ? cur.va11 : cur.va01)); \
        else PG8_STAGE2(bufoff, (gbase) + ((h) ? hstepA : 0), vaU[0], vaU[1]); } while (0)
#define PG8_LDA(dst, b, h) do { _Pragma("unroll") for (int m = 0; m < 4; ++m) _Pragma("unroll") for (int k = 0; k < 2; ++k) dst[m][k] = *(const LAS bf16x8*)(lds + PG8_SA(b, h) + aoff + m * 2048 + k * 1024); } while (0)
#define PG8_LDB(dst, b, h) do { _Pragma("unroll") for (int n = 0; n < 2; ++n) _Pragma("unroll") for (int k = 0; k < 2; ++k) dst[n][k] = *(const LAS bf16x8*)(lds + PG8_SB(b, h) + boff + n * 2048 + k * 1024); } while (0)
#define PG8_MMA(ai, bj, At, Bt) do { __builtin_amdgcn_s_setprio(1); _Pragma("unroll") for (int m = 0; m < 4; ++m) _Pragma("unroll") for (int n = 0; n < 2; ++n) _Pragma("unroll") for (int k = 0; k < 2; ++k) \
        acc[ai][bj][m][n] = __builtin_amdgcn_mfma_f32_16x16x32_bf16(Bt[n][k], At[m][k], acc[ai][bj][m][n], 0, 0, 0); __builtin_amdgcn_s_setprio(0); } while (0)
#define PG8_WAIT_V(n) asm volatile("s_waitcnt vmcnt(" #n ")" ::: "memory")
#define PG8_WAIT_L(n) asm volatile("s_waitcnt lgkmcnt(" #n ")" ::: "memory")
#define PG8_BAR __builtin_amdgcn_s_barrier()
#define PG8_SCHED __builtin_amdgcn_sched_barrier(0)
    GJob cur, nxt; int ui = 0;
    cur.A = nullptr; cur.B = nullptr; cur.va00 = cur.va01 = cur.va10 = cur.va11 = 0u; nxt = cur;
    if (!jobfn(0, cur)) return;
    f32x4 acc[2][2][4][2];
#pragma unroll
    for (int a = 0; a < 2; ++a)
#pragma unroll
        for (int b = 0; b < 2; ++b)
#pragma unroll
            for (int m = 0; m < 4; ++m)
#pragma unroll
                for (int n = 0; n < 2; ++n) acc[a][b][m][n] = (f32x4){0.f, 0.f, 0.f, 0.f};
    bf16x8 At[4][2], B0[2][2], B1[2][2];
    STB(PG8_SB(0, 0), cur.B, 0); STB(PG8_SB(0, 1), cur.B, 1); STA_CUR(PG8_SA(0, 0), cur.A, 0); STA_CUR(PG8_SA(0, 1), cur.A, 1);
    if (wr == 1) PG8_BAR;
    PG8_WAIT_V(2); PG8_BAR;
    STB(PG8_SB(1, 0), cur.B + kstep, 0); STA_CUR(PG8_SA(1, 0), cur.A + kstep, 0); STB(PG8_SB(1, 1), cur.B + kstep, 1);
    PG8_WAIT_V(6); PG8_BAR;
    for (;;) {
        bool has_next = false;
        for (int t = 0; t < nt; t += 2) {
            const bool last = (t == nt - 2);
            if (last) { has_next = jobfn(ui + 1, nxt); if (!has_next) nxt = cur; }
            const char* a1 = cur.A + (size_t)(t + 1) * kstep;
            const char* a2 = last ? nxt.A : cur.A + (size_t)(t + 2) * kstep; const char* b2 = last ? nxt.B : cur.B + (size_t)(t + 2) * kstep;
            const char* a3 = a2 + kstep; const char* b3 = b2 + kstep;
            PG8_LDB(B0, 0, 0); PG8_LDB(B1, 0, 1); PG8_SCHED; PG8_LDA(At, 0, 0); STA_CUR(PG8_SA(1, 1), a1, 1);
            PG8_WAIT_V(8); PG8_WAIT_L(0); PG8_BAR; PG8_MMA(0, 0, At, B0); PG8_MMA(0, 1, At, B1); PG8_BAR; PG8_SCHED;
            PG8_LDA(At, 0, 1); STB(PG8_SB(0, 0), b2, 0); STB(PG8_SB(0, 1), b2, 1); STA_SEL(PG8_SA(0, 0), a2, 0);
            PG8_WAIT_V(8); PG8_WAIT_L(0); PG8_BAR; PG8_MMA(1, 0, At, B0); PG8_MMA(1, 1, At, B1); PG8_BAR; PG8_SCHED;
            PG8_LDB(B0, 1, 0); PG8_LDB(B1, 1, 1); PG8_SCHED; PG8_LDA(At, 1, 0); STA_SEL(PG8_SA(0, 1), a2, 1);
            PG8_WAIT_V(8); PG8_WAIT_L(0); PG8_BAR; PG8_MMA(0, 0, At, B0); PG8_MMA(0, 1, At, B1); PG8_BAR; PG8_SCHED;
            PG8_LDA(At, 1, 1); STB(PG8_SB(1, 0), b3, 0); STB(PG8_SB(1, 1), b3, 1); STA_SEL(PG8_SA(1, 0), a3, 0);
            PG8_WAIT_V(8); PG8_WAIT_L(0); PG8_BAR; PG8_MMA(1, 0, At, B0); PG8_MMA(1, 1, At, B1); PG8_BAR; PG8_SCHED;
        }
        if (wr == 0) PG8_BAR;
        epi(acc, ui);
        if (!has_next) break;
#pragma unroll
        for (int a = 0; a < 2; ++a)
#pragma unroll
            for (int b = 0; b < 2; ++b)
#pragma unroll
                for (int m = 0; m < 4; ++m)
#pragma unroll
                    for (int n = 0; n < 2; ++n) acc[a][b][m][n] = (f32x4){0.f, 0.f, 0.f, 0.f};
        cur = nxt; ++ui;
        if (wr == 1) PG8_BAR;
    }
    PG8_WAIT_V(0);
    PG8_BAR;
#undef PG8_SA
#undef PG8_SB
#undef PG8_STAGE2
#undef STB
#undef STA_CUR
#undef STA_SEL
#undef PG8_LDA
#undef PG8_LDB
#undef PG8_MMA
#undef PG8_WAIT_V
#undef PG8_WAIT_L
#undef PG8_BAR
#undef PG8_SCHED
}
__device__ __forceinline__ void gj_lin2(unsigned (&v)[2], int ld) {
#pragma unroll
    for (int i = 0; i < 2; ++i) { int R, C; g_stage_rc(tid_() * 16 + i * 8192, R, C); v[i] = (unsigned)((R * ld + C) * 2); }
}
struct RowLin { size_t base; int ld; __device__ __forceinline__ size_t operator()(int R) const { return base + (size_t)R * ld; } };

__device__ __forceinline__ void st_bf4(bf16_t* dst, f32x4 v) {
    uint2 o; o.x = pack2(v[0], v[1]); o.y = pack2(v[2], v[3]); *(uint2*)dst = o;
}
#define EPI8(...) do { const int tid_e = tid_(), lane_e = tid_e & 63, wid_e = tid_e >> 6, wr = wid_e >> 2, wc = wid_e & 3, fr = lane_e & 15, fq = lane_e >> 4; \
    _Pragma("unroll") for (int ai = 0; ai < 2; ++ai) _Pragma("unroll") for (int m = 0; m < 4; ++m) _Pragma("unroll") for (int bj = 0; bj < 2; ++bj) _Pragma("unroll") for (int n = 0; n < 2; ++n) { \
        const int row = ai * 128 + wr * 64 + m * 16 + fr, col = bj * 128 + wc * 32 + n * 16 + fq * 4; const f32x4 v = acc[ai][bj][m][n]; __VA_ARGS__ } } while (0)

struct EpiInproj {
    const P* p; int nt;
    __device__ __forceinline__ void operator()(int m, int n, int fq, f32x4 v) const {
        const P& P_ = *p;
        const int pos = m % LP;
        const float* rp = P_.rope() + (size_t)pos * 24;
        if (nt <= 2) {
            const bool isv = (nt == 2) && (n >= 128);
            if (!isv && (n & 48) == 0) {
                f32x4 pr;
#pragma unroll
                for (int j = 0; j < 4; ++j) pr[j] = __shfl_xor(v[j], 32);
                const int i0 = (fq & 1) * 4;
#pragma unroll
                for (int j = 0; j < 4; ++j) {
                    const float c = rp[i0 + j], s = rp[8 + i0 + j];
                    v[j] = fq < 2 ? v[j] * c - pr[j] * s : v[j] * c + pr[j] * s;
                }
            }
            if (nt < 2) { st_bf4(P_.q() + (size_t)m * 512 + nt * 256 + n, v * (0.125f * 1.4426950408889634f)); }
            else if (n < 128) st_bf4(P_.k() + (size_t)m * 128 + n, v);
            else st_bf4(P_.v() + (size_t)m * 128 + (n - 128), v);
        } else if (nt == 3 || nt == 4) {
            const bool ropeable = (nt == 3) ? ((n & 16) == 0) : (n < 16);
            if (ropeable) {
                f32x4 pr;
#pragma unroll
                for (int j = 0; j < 4; ++j) pr[j] = __shfl_xor(v[j], 16);
                if (fq < 2) {
#pragma unroll
                    for (int j = 0; j < 4; ++j) {
                        const float c = rp[16 + j], s = rp[20 + j];
                        v[j] = fq == 0 ? v[j] * c - pr[j] * s : v[j] * c + pr[j] * s;
                    }
                }
            }
            if (nt == 3) st_bf4(P_.iq() + (size_t)m * 256 + n, v);
            else if (n < 32) st_bf4(P_.ik() + (size_t)m * 32 + n, v);
            else if (n < 40) *(f32x4*)(P_.iw() + (size_t)m * 8 + (n - 32)) = v;
        } else if (nt <= 6) { st_bf4(P_.hq() + (size_t)m * 512 + (nt - 5) * 256 + n, v * 0.08838834764831845f); }
        else if (nt <= 8) { st_bf4(P_.hf() + (size_t)m * 512 + (nt - 7) * 256 + n, v); }
        else if (nt <= 10) { st_bf4(P_.hi() + (size_t)m * 512 + (nt - 9) * 256 + n, v); }
        else if (nt <= 12) {
            f32x4 o;
#pragma unroll
            for (int j = 0; j < 4; ++j) o[j] = v[j] * sigmoidf_(v[j]);
            st_bf4(P_.hg() + (size_t)m * 512 + (nt - 11) * 256 + n, o);
        } else {
            f32x4 o;
#pragma unroll
            for (int j = 0; j < 4; ++j) o[j] = sigmoidf_(v[j]);
            if (nt <= 16) st_bf4(P_.ga() + (size_t)m * 1024 + (nt - 13) * 256 + n, o);
            else st_bf4(P_.gh() + (size_t)m * 1024 + (nt - 17) * 256 + n, o);
        }
    }
};

__device__ __forceinline__ void ph_inproj(const P& p, unsigned char* lds) {
    const int nunits = (T / 256) * 21, G = gridDim.x, b0 = blockIdx.x;
    auto jobfn = [&](int i, GJob& j) __attribute__((always_inline)) -> bool {
        const int u = b0 + i * G; if (u >= nunits) return false;
        const int nt = u % 21, mt = u / 21;
        j.A = (const char*)(p.xn() + (size_t)mt * 256 * D); j.B = (const char*)(p.winT() + (size_t)nt * 256 * D); return true; };
    auto epi = [&](f32x4 (&acc)[2][2][4][2], int i) __attribute__((always_inline)) {
        const int u = b0 + i * G, nt = u % 21, mt = u / 21;
        const EpiInproj e{&p, nt};
        EPI8( e(mt * 256 + row, col, fq, v); );
    };
    unsigned vbU[2]; gj_lin2(vbU, D);
    gemm_stream<false>(lds, D, D, (size_t)128 * D * 2, vbU, jobfn, epi);
}

constexpr int NCH = 129, NXU = 16 * NCH;
constexpr int X_QT = 0, X_KT = X_QT + 64 * 272, X_KH = X_KT + 64 * 272, X_VT = X_KH + 128 * 144, X_AS = X_VT + 128 * 144, X_SEG = X_AS + 64 * 144;
__device__ __forceinline__ bf16_t* hg_ds(const P& p) { return (bf16_t*)p.out; }
__device__ __forceinline__ float* hg_g(const P& p) { return (float*)((unsigned char*)p.out + (size_t)NXU * 32768); }

__device__ __forceinline__ void hgx_unit(const P& p, unsigned char* lds, int u) {
    const int tid = tid_(), lane = tid & 63, wid = tid >> 6, fr = lane & 15, fq = lane >> 4;
    const int c = u % NCH, bh = u / NCH, b = bh >> 2, h = bh & 3;
    const int d = tid & 127, seg = tid >> 7;
    const size_t rowbase = (size_t)(b * LP + c * 64 + seg * 16) * 512 + h * 128 + d;
    bf16_t* hqp = p.hq() + rowbase; const bf16_t* hfp = p.hf() + rowbase; const bf16_t* hip = p.hi() + rowbase;
    const float lbv = p.lb()[h * 128 + d];
    float bb[16], qv[16], kk[16], vv[16];
    float cs = 0.f;
#pragma unroll
    for (int i = 0; i < 16; ++i) {
        const float f = lbv + (1.0f - lbv) * sigmoidf_(bf2f(hfp[(size_t)i * 512]));
        kk[i] = 1.0f - f; cs += __logf(f); bb[i] = cs;
        qv[i] = bf2f(hqp[(size_t)i * 512]); vv[i] = bf2f(hip[(size_t)i * 512]);
    }
    float* segs = (float*)(lds + X_SEG);
    segs[seg * 128 + d] = cs;
    __syncthreads();
    const float s0 = segs[d], s1 = segs[128 + d], s2 = segs[256 + d], s3 = segs[384 + d];
    const float off = seg == 0 ? 0.f : (seg == 1 ? s0 : (seg == 2 ? s0 + s1 : s0 + s1 + s2));
    const float rref = s0 + s1, blast = (s0 + s1) + (s2 + s3);
    uint32_t khp[8], vtp[8];
#pragma unroll
    for (int i = 0; i < 16; i += 2) {
        float khv[2];
#pragma unroll
        for (int j = 0; j < 2; ++j) {
            const float bt = bb[i + j] + off;
            const float eq = __expf(fminf(bt - rref, 80.f)), ek = __expf(fminf(rref - bt, 80.f));
            const int t = seg * 16 + i + j;
            *(bf16_t*)(lds + X_QT + t * 272 + d * 2) = f2bf(qv[i + j] * eq);
            *(bf16_t*)(lds + X_KT + t * 272 + d * 2) = f2bf(kk[i + j] * ek);
            hqp[(size_t)(i + j) * 512] = f2bf(qv[i + j] * __expf(bt));
            khv[j] = kk[i + j] * __expf(blast - bt);
        }
        khp[i >> 1] = pack2(khv[0], khv[1]); vtp[i >> 1] = pack2(vv[i], vv[i + 1]);
    }
    *(uint4*)(lds + X_KH + d * 144 + seg * 32) = make_uint4(khp[0], khp[1], khp[2], khp[3]);
    *(uint4*)(lds + X_KH + d * 144 + seg * 32 + 16) = make_uint4(khp[4], khp[5], khp[6], khp[7]);
    *(uint4*)(lds + X_VT + d * 144 + seg * 32) = make_uint4(vtp[0], vtp[1], vtp[2], vtp[3]);
    *(uint4*)(lds + X_VT + d * 144 + seg * 32 + 16) = make_uint4(vtp[4], vtp[5], vtp[6], vtp[7]);
    if (seg == 0) hg_g(p)[(size_t)u * 128 + d] = __expf(blast);
    __syncthreads();
    {
        const int tm = wid >> 1, tn0 = (wid & 1) * 2;
        f32x4 a1[2] = {(f32x4){0.f, 0.f, 0.f, 0.f}, (f32x4){0.f, 0.f, 0.f, 0.f}};
#pragma unroll
        for (int ks = 0; ks < 4; ++ks) {
            const bf16x8 aq = *(const bf16x8*)(lds + X_QT + (tm * 16 + fr) * 272 + (ks * 32 + fq * 8) * 2);
#pragma unroll
            for (int j = 0; j < 2; ++j) {
                const bf16x8 bk = *(const bf16x8*)(lds + X_KT + ((tn0 + j) * 16 + fr) * 272 + (ks * 32 + fq * 8) * 2);
                a1[j] = __builtin_amdgcn_mfma_f32_16x16x32_bf16(bk, aq, a1[j], 0, 0, 0);
            }
        }
#pragma unroll
        for (int j = 0; j < 2; ++j) {
            const int t = tm * 16 + fr, sb = (tn0 + j) * 16 + fq * 4;
            f32x4 v = a1[j];
#pragma unroll
            for (int jj = 0; jj < 4; ++jj) v[jj] = (sb + jj <= t) ? v[jj] : 0.f;
            uint2 o; o.x = pack2(v[0], v[1]); o.y = pack2(v[2], v[3]);
            *(uint2*)(lds + X_AS + t * 144 + sb * 2) = o;
        }
    }
    __syncthreads();
    {
        const int tm = wid >> 1, en0 = (wid & 1) * 4;
        f32x4 o2[4];
#pragma unroll
        for (int j = 0; j < 4; ++j) o2[j] = (f32x4){0.f, 0.f, 0.f, 0.f};
#pragma unroll
        for (int ks = 0; ks < 2; ++ks) {
            const bf16x8 aa = *(const bf16x8*)(lds + X_AS + (tm * 16 + fr) * 144 + (ks * 32 + fq * 8) * 2);
#pragma unroll
            for (int j = 0; j < 4; ++j) {
                const bf16x8 bv = *(const bf16x8*)(lds + X_VT + ((en0 + j) * 16 + fr) * 144 + (ks * 32 + fq * 8) * 2);
                o2[j] = __builtin_amdgcn_mfma_f32_16x16x32_bf16(bv, aa, o2[j], 0, 0, 0);
            }
        }
        bf16_t* orow = p.hf() + (size_t)(b * LP + c * 64 + tm * 16 + fr) * 512 + h * 128;
#pragma unroll
        for (int j = 0; j < 4; ++j) st_bf4(orow + (en0 + j) * 16 + fq * 4, o2[j]);
    }
    {
        f32x4 s3[8];
#pragma unroll
        for (int j = 0; j < 8; ++j) s3[j] = (f32x4){0.f, 0.f, 0.f, 0.f};
#pragma unroll
        for (int ks = 0; ks < 2; ++ks) {
            const bf16x8 ak = *(const bf16x8*)(lds + X_KH + (wid * 16 + fr) * 144 + (ks * 32 + fq * 8) * 2);
#pragma unroll
            for (int j = 0; j < 8; ++j) {
                const bf16x8 bv = *(const bf16x8*)(lds + X_VT + (j * 16 + fr) * 144 + (ks * 32 + fq * 8) * 2);
                s3[j] = __builtin_amdgcn_mfma_f32_16x16x32_bf16(ak, bv, s3[j], 0, 0, 0);
            }
        }
        bf16_t* dsb = hg_ds(p) + (size_t)u * 16384;
#pragma unroll
        for (int j = 0; j < 8; ++j) st_bf4(dsb + (size_t)(j * 16 + fr) * 128 + wid * 16 + fq * 4, s3[j]);
    }
    __syncthreads();
}

__device__ __forceinline__ void hgchain_unit(const P& p, int item) {
    const int tid = tid_(), bh = item >> 2, eq = item & 3;
    const int e = eq * 32 + (tid >> 4), d0 = (tid & 15) * 8;
    float S[8];
#pragma unroll
    for (int i = 0; i < 8; ++i) S[i] = 0.f;
    uint4* ptr = (uint4*)(hg_ds(p) + ((size_t)(bh * NCH) * 128 + e) * 128 + d0);
    const f32x4* gp = (const f32x4*)(hg_g(p) + (size_t)(bh * NCH) * 128 + d0);
    uint4 wq[8]; f32x4 g0[8], g1[8];
#pragma unroll
    for (int k = 0; k < 8; ++k) { wq[k] = ptr[(size_t)k * 2048]; g0[k] = gp[k * 32]; g1[k] = gp[k * 32 + 1]; }
    for (int c0 = 0; c0 < NCH; c0 += 8) {
#pragma unroll
        for (int k = 0; k < 8; ++k) {
            const int c = c0 + k;
            if (c < NCH) {
                const uint4 w = wq[k]; const f32x4 ga = g0[k], gb = g1[k];
                if (c + 8 < NCH) { wq[k] = ptr[(size_t)(c + 8) * 2048]; g0[k] = gp[(c + 8) * 32]; g1[k] = gp[(c + 8) * 32 + 1]; }
                ptr[(size_t)c * 2048] = make_uint4(pack2(S[0], S[1]), pack2(S[2], S[3]), pack2(S[4], S[5]), pack2(S[6], S[7]));
                S[0] = ga[0] * S[0] + __uint_as_float(w.x << 16); S[1] = ga[1] * S[1] + __uint_as_float(w.x & 0xffff0000u);
                S[2] = ga[2] * S[2] + __uint_as_float(w.y << 16); S[3] = ga[3] * S[3] + __uint_as_float(w.y & 0xffff0000u);
                S[4] = gb[0] * S[4] + __uint_as_float(w.z << 16); S[5] = gb[1] * S[5] + __uint_as_float(w.z & 0xffff0000u);
                S[6] = gb[2] * S[6] + __uint_as_float(w.w << 16); S[7] = gb[3] * S[7] + __uint_as_float(w.w & 0xffff0000u);
            }
        }
    }
}

__device__ __forceinline__ void hgz_unit(const P& p, unsigned char* lds, int u) {
    const int tid = tid_(), lane = tid & 63, wid = tid >> 6, fr = lane & 15, fq = lane >> 4;
    const int c = u % NCH, bh = u / NCH, b = bh >> 2, h = bh & 3;
    const int tm = wid >> 1, en0 = (wid & 1) * 4;
    const size_t row = (size_t)(b * LP + c * 64 + tm * 16 + fr);
    const bf16_t* qrow = p.hq() + row * 512 + h * 128;
    const bf16_t* sT = hg_ds(p) + (size_t)u * 16384;
    f32x4 o[4];
#pragma unroll
    for (int j = 0; j < 4; ++j) o[j] = (f32x4){0.f, 0.f, 0.f, 0.f};
#pragma unroll
    for (int ks = 0; ks < 4; ++ks) {
        const bf16x8 aq = *(const bf16x8*)(qrow + ks * 32 + fq * 8);
#pragma unroll
        for (int j = 0; j < 4; ++j) {
            const bf16x8 bs = *(const bf16x8*)(sT + (size_t)((en0 + j) * 16 + fr) * 128 + ks * 32 + fq * 8);
            o[j] = __builtin_amdgcn_mfma_f32_16x16x32_bf16(bs, aq, o[j], 0, 0, 0);
        }
    }
    const bf16_t* oi = p.hf() + row * 512 + h * 128;
    float ss = 0.f;
#pragma unroll
    for (int j = 0; j < 4; ++j) {
        const uint2 w = *(const uint2*)(oi + (en0 + j) * 16 + fq * 4);
        o[j][0] += __uint_as_float(w.x << 16); o[j][1] += __uint_as_float(w.x & 0xffff0000u);
        o[j][2] += __uint_as_float(w.y << 16); o[j][3] += __uint_as_float(w.y & 0xffff0000u);
        ss += o[j][0] * o[j][0] + o[j][1] * o[j][1] + o[j][2] * o[j][2] + o[j][3] * o[j][3];
    }
    ss += __shfl_xor(ss, 16); ss += __shfl_xor(ss, 32);
    float* part = (float*)lds;
    if (fq == 0) part[(tm * 16 + fr) * 2 + (wid & 1)] = ss;
    __syncthreads();
    const float tot = part[(tm * 16 + fr) * 2] + part[(tm * 16 + fr) * 2 + 1];
    const float rs = rsqrtf(tot * (1.0f / 128.0f) + EPS);
    const bf16_t* hgp = p.hg() + row * 512 + h * 128;
    bf16_t* outp = p.hgr() + row * 512 + h * 128;
#pragma unroll
    for (int j = 0; j < 4; ++j) {
        const int e0 = (en0 + j) * 16 + fq * 4;
        const f32x4 gn = *(const f32x4*)(p.hgrn_g + h * 128 + e0);
        const uint2 w = *(const uint2*)(hgp + e0);
        f32x4 r;
        r[0] = o[j][0] * rs * gn[0] * __uint_as_float(w.x << 16); r[1] = o[j][1] * rs * gn[1] * __uint_as_float(w.x & 0xffff0000u);
        r[2] = o[j][2] * rs * gn[2] * __uint_as_float(w.y << 16); r[3] = o[j][3] * rs * gn[3] * __uint_as_float(w.y & 0xffff0000u);
        st_bf4(outp + e0, r);
    }
    __syncthreads();
}

typedef float f32x16 __attribute__((ext_vector_type(16)));
typedef short s16x4 __attribute__((ext_vector_type(4)));
typedef unsigned u32x4 __attribute__((ext_vector_type(4)));
constexpr int NKMAX = 8224;
constexpr int NBIN = 1024;
constexpr int A_SC = 0, A_H1 = A_SC + 4 * NKMAX * 4, A_SEL = A_H1 + 4 * NBIN * 4, A_CAND = A_SEL + 2048, A_META = A_CAND + 1024, A_END = A_META + 256;
static_assert(A_END <= LDS_BYTES - 16, "attention LDS");
__device__ __forceinline__ uint32_t skey(float f) { const uint32_t u = __float_as_uint(f); return (u & 0x80000000u) ? ~u : (u | 0x80000000u); }
__device__ __forceinline__ float skey_inv(uint32_t k) { return __uint_as_float((k & 0x80000000u) ? (k & 0x7fffffffu) : ~k); }
__device__ __forceinline__ int bin1(float s, float lo, float scale) { return min(NBIN - 1, max(0, (int)((s - lo) * scale))); }
template <int OFF> __device__ __forceinline__ s16x4 tr_read(unsigned addr) {
    s16x4 r; asm volatile("ds_read_b64_tr_b16 %0, %1 offset:%2" : "=&v"(r) : "v"(addr), "i"(OFF) : "memory"); return r;
}
__device__ __forceinline__ void scan_top(const int* hist, int K, int* m, int lane) {
    int c[16];
#pragma unroll
    for (int i = 0; i < 4; ++i) { const int4 v = *(const int4*)(hist + 16 * lane + 4 * i); c[4 * i] = v.x; c[4 * i + 1] = v.y; c[4 * i + 2] = v.z; c[4 * i + 3] = v.w; }
    int tot = 0;
#pragma unroll
    for (int i = 0; i < 16; ++i) tot += c[i];
    int suf = tot;
#pragma unroll
    for (int o = 1; o < 64; o <<= 1) { const int t = __shfl_down(suf, o); if (lane + o < 64) suf += t; }
    int above = suf - tot;
#pragma unroll
    for (int i = 15; i >= 0; --i) {
        if (above < K && K <= above + c[i]) { m[0] = 16 * lane + i; m[1] = above; m[2] = c[i]; }
        above += c[i];
    }
}

__device__ __forceinline__ void attn4_unit(const P& p, unsigned char* lds, int b, int grp) {
    const int tid = tid_(), lane = tid & 63, wid = __builtin_amdgcn_readfirstlane(tid >> 6);
    const int t0 = NMETA + 4 * grp;
    const int brow = b * LP, row0 = brow + t0;
    float* sc = (float*)(lds + A_SC);
    int* h1 = (int*)(lds + A_H1);
    unsigned short* sel = (unsigned short*)(lds + A_SEL); unsigned short* cand = (unsigned short*)(lds + A_CAND);
    int* meta = (int*)(lds + A_META);
    const bool big = t0 + 1 > 256;
    for (int i = tid; i < 4 * NBIN; i += NTHREADS) h1[i] = 0;
    if (tid < 64) { const int w = tid & 15; meta[tid] = (w == 0) ? -1 : 0; }
    if (!big) { for (int i = tid; i < 1024; i += NTHREADS) { const int q = i >> 8, j = i & 255; sel[i] = (unsigned short)(j <= t0 + q ? j : 0); } }
    __syncthreads();
    if (big) {
        {
            const int hh = lane >> 5, c32 = lane & 31;
            const int g = c32 >> 3, h2a = (c32 >> 2) & 1, bq = c32 & 3, aq = 2 * h2a + (g >> 1), ah = 4 * (g & 1) + bq;
            const bf16_t* ap = p.iq() + (size_t)(row0 + aq) * 256 + ah * 32 + 8 * hh;
            const bf16x8 a0 = *(const bf16x8*)ap, a1 = *(const bf16x8*)(ap + 16);
            const f32x4 w00 = *(const f32x4*)(p.iw() + (size_t)(row0 + 2 * hh) * 8), w01 = *(const f32x4*)(p.iw() + (size_t)(row0 + 2 * hh) * 8 + 4);
            const f32x4 w10 = *(const f32x4*)(p.iw() + (size_t)(row0 + 2 * hh + 1) * 8), w11 = *(const f32x4*)(p.iw() + (size_t)(row0 + 2 * hh + 1) * 8 + 4);
            const int ntiles = (t0 + 4 + 31) >> 5;
            const int tq0 = t0 + 2 * hh;
            float mx0 = -INFINITY, mn0 = INFINITY, mx1 = -INFINITY, mn1 = INFINITY;
            const bf16_t* kbase = p.ik() + (size_t)brow * 32 + 8 * hh;
            for (int tile0 = wid; tile0 < ntiles; tile0 += 128) {
                bf16x8 b0[16], b1[16];
#pragma unroll
                for (int j = 0; j < 16; ++j) {
                    const int tile = min(tile0 + 8 * j, ntiles - 1);
                    const bf16_t* kp = kbase + (size_t)(tile * 32 + c32) * 32;
                    b0[j] = *(const bf16x8*)kp; b1[j] = *(const bf16x8*)(kp + 16);
                }
                __builtin_amdgcn_sched_barrier(0);
#pragma unroll
                for (int j = 0; j < 16; ++j) {
                    const int tile = tile0 + 8 * j;
                    if (tile < ntiles) {
                        const int key = tile * 32 + c32;
                        f32x16 acc;
#pragma unroll
                        for (int i = 0; i < 16; ++i) acc[i] = 0.f;
                        acc = __builtin_amdgcn_mfma_f32_32x32x16_bf16(a0, b0[j], acc, 0, 0, 0);
                        acc = __builtin_amdgcn_mfma_f32_32x32x16_bf16(a1, b1[j], acc, 0, 0, 0);
                        float s0 = 0.f, s1 = 0.f;
#pragma unroll
                        for (int i = 0; i < 4; ++i) {
                            s0 += w00[i] * fmaxf(acc[i], 0.f) + w01[i] * fmaxf(acc[4 + i], 0.f);
                            s1 += w10[i] * fmaxf(acc[8 + i], 0.f) + w11[i] * fmaxf(acc[12 + i], 0.f);
                        }
                        sc[(2 * hh) * NKMAX + key] = s0; sc[(2 * hh + 1) * NKMAX + key] = s1;
                        if (key <= tq0) { mx0 = fmaxf(mx0, s0); mn0 = fminf(mn0, s0); }
                        if (key <= tq0 + 1) { mx1 = fmaxf(mx1, s1); mn1 = fminf(mn1, s1); }
                    }
                }
            }
#pragma unroll
            for (int o = 16; o >= 1; o >>= 1) {
                mx0 = fmaxf(mx0, __shfl_xor(mx0, o)); mn0 = fminf(mn0, __shfl_xor(mn0, o));
                mx1 = fmaxf(mx1, __shfl_xor(mx1, o)); mn1 = fminf(mn1, __shfl_xor(mn1, o));
            }
            if (c32 == 0) {
                if (mx0 >= mn0) { atomicMin((unsigned*)&meta[(2 * hh) * 16 + 0], skey(mn0)); atomicMax((unsigned*)&meta[(2 * hh) * 16 + 1], skey(mx0)); }
                if (mx1 >= mn1) { atomicMin((unsigned*)&meta[(2 * hh + 1) * 16 + 0], skey(mn1)); atomicMax((unsigned*)&meta[(2 * hh + 1) * 16 + 1], skey(mx1)); }
            }
        }
        __syncthreads();
        const int q = wid & 3, part = wid >> 2, n = t0 + q + 1;
        const float lo = skey_inv((unsigned)meta[q * 16 + 0]), hi = skey_inv((unsigned)meta[q * 16 + 1]);
        const float scale = hi > lo ? (float)NBIN / (hi - lo) : 0.f;
        const float* scq = sc + q * NKMAX;
        for (int base = part * 256; base < n; base += 512) {
            const int idx0 = base + lane * 4;
            if (idx0 < n) {
                const f32x4 v = *(const f32x4*)(scq + idx0);
#pragma unroll
                for (int j = 0; j < 4; ++j) if (idx0 + j < n) atomicAdd(&h1[q * NBIN + bin1(v[j], lo, scale)], 1);
            }
        }
        __syncthreads();
        if (wid < 4) scan_top(h1 + wid * NBIN, 256, meta + wid * 16 + 4, lane);
        __syncthreads();
        const int B1 = meta[q * 16 + 4];
        for (int base = part * 256; base < n; base += 512) {
            const int idx0 = base + lane * 4;
            f32x4 v = (f32x4){0.f, 0.f, 0.f, 0.f};
            if (idx0 < n) v = *(const f32x4*)(scq + idx0);
            const unsigned long long lt = (1ull << lane) - 1ull;
#pragma unroll
            for (int j = 0; j < 4; ++j) {
                const int idx = idx0 + j;
                bool issel = false, iscand = false;
                if (idx < n) { const int b1 = bin1(v[j], lo, scale); issel = b1 > B1; iscand = b1 == B1; }
                const unsigned long long ms = __ballot(issel), mc = __ballot(iscand);
                if (ms) {
                    int bs = 0; if (lane == 0) bs = atomicAdd(&meta[q * 16 + 2], __popcll(ms));
                    bs = __shfl(bs, 0);
                    if (issel) sel[q * 256 + bs + __popcll(ms & lt)] = (unsigned short)idx;
                }
                if (mc) {
                    int bs = 0; if (lane == 0) bs = atomicAdd(&meta[q * 16 + 3], __popcll(mc));
                    bs = __shfl(bs, 0);
                    const int pos = bs + __popcll(mc & lt);
                    if (iscand && pos < 128) cand[q * 128 + pos] = (unsigned short)idx;
                }
            }
        }
        __syncthreads();
        if (wid < 4) {
            const int qq = wid; const float* scr = sc + qq * NKMAX;
            const int rq = 256 - meta[qq * 16 + 5], cq = meta[qq * 16 + 6], sbase = 256 - rq, nn = t0 + qq + 1;
            if (cq <= 128) {
                int taken = 0;
#pragma unroll
                for (int half = 0; half < 2; ++half) {
                    const int i = lane + 64 * half;
                    bool take = false; int myidx = 0;
                    if (i < cq) {
                        myidx = cand[qq * 128 + i]; const float mv = scr[myidx];
                        int rank = 0;
                        for (int j = 0; j < cq; ++j) { const int oj = cand[qq * 128 + j]; const float ov = scr[oj]; rank += (ov > mv) || (ov == mv && oj < myidx); }
                        take = rank < rq;
                    }
                    const unsigned long long mt = __ballot(take);
                    if (take) sel[qq * 256 + sbase + taken + __popcll(mt & ((1ull << lane) - 1ull))] = (unsigned short)myidx;
                    taken += __popcll(mt);
                }
            } else {
                const float lo_ = skey_inv((unsigned)meta[qq * 16 + 0]), hi_ = skey_inv((unsigned)meta[qq * 16 + 1]);
                const float sc_ = hi_ > lo_ ? (float)NBIN / (hi_ - lo_) : 0.f;
                const int B1_ = meta[qq * 16 + 4];
                int taken = 0;
                for (int base = 0; base < nn && taken < rq; base += 64) {
                    const int idx = base + lane; bool isc = false;
                    if (idx < nn) isc = bin1(scr[idx], lo_, sc_) == B1_;
                    const unsigned long long mc = __ballot(isc);
                    const int pos = taken + __popcll(mc & ((1ull << lane) - 1ull));
                    if (isc && pos < rq) sel[qq * 256 + sbase + pos] = (unsigned short)idx;
                    taken += __popcll(mc);
                }
            }
        }
        __syncthreads();
    }
    {
        const int q = wid >> 1, kvh = wid & 1, tq = t0 + q, nsel = min(tq + 1, 256);
        const int col = lane & 15, g4 = lane >> 4;
        const unsigned short* selq = sel + q * 256;
        bf16x8 qf0, qf1;
        {
            const bf16_t* qp = p.q() + (size_t)(row0 + q) * 512 + (kvh * 4 + (col & 3)) * 64 + g4 * 8;
            qf0 = *(const bf16x8*)qp; qf1 = *(const bf16x8*)(qp + 32);
            if (col >= 4) {
#pragma unroll
                for (int i = 0; i < 8; ++i) { qf0[i] = 0; qf1[i] = 0; }
            }
        }
        LAS unsigned char* vst = (LAS unsigned char*)lds + A_SC + wid * 16384;
        const bf16_t* vb = p.v() + (size_t)brow * 128 + kvh * 64 + (lane & 7) * 8;
        const unsigned rdbase = (unsigned)(uintptr_t)((LAS unsigned char*)lds + A_SC) + wid * 16384 + (4 * g4 + (col >> 2)) * 128 + (col & 3) * 8;
#define V_STAGE(s_, buf_) do { _Pragma("unroll") for (int i_ = 0; i_ < 4; ++i_) { \
            const int ksl_ = (s_) * 32 + i_ * 8 + (lane >> 3); const int key_ = selq[ksl_]; \
            __builtin_amdgcn_global_load_lds((const unsigned*)(vb + (size_t)key_ * 128), (LAS unsigned*)(vst + (buf_) * 4096 + i_ * 1024), 16, 0, 0); } } while (0)
        const bf16_t* kb = p.k() + (size_t)brow * 128 + kvh * 64 + g4 * 8;
        f32x4 lg[16];
        u32x4 vr[16];
        {
            bf16x8 k0[16], k1[16];
#pragma unroll
            for (int t = 0; t < 16; ++t) {
                const int key = selq[t * 16 + col];
                const bf16_t* kp = kb + (size_t)key * 128;
                k0[t] = *(const bf16x8*)kp; k1[t] = *(const bf16x8*)(kp + 32);
            }
#pragma unroll
            for (int s = 4; s < 8; ++s)
#pragma unroll
                for (int i = 0; i < 4; ++i) { const int key = selq[s * 32 + i * 8 + (lane >> 3)]; vr[(s - 4) * 4 + i] = *(const u32x4*)(vb + (size_t)key * 128); }
            V_STAGE(0, 0); V_STAGE(1, 1); V_STAGE(2, 2); V_STAGE(3, 3);
            __builtin_amdgcn_sched_barrier(0);
#pragma unroll
            for (int t = 0; t < 16; ++t) {
                f32x4 a = (f32x4){0.f, 0.f, 0.f, 0.f};
                a = __builtin_amdgcn_mfma_f32_16x16x32_bf16(k0[t], qf0, a, 0, 0, 0);
                a = __builtin_amdgcn_mfma_f32_16x16x32_bf16(k1[t], qf1, a, 0, 0, 0);
                lg[t] = a;
            }
            __builtin_amdgcn_sched_barrier(0);
        }
        float mx = -INFINITY;
#pragma unroll
        for (int t = 0; t < 16; ++t)
#pragma unroll
            for (int j = 0; j < 4; ++j) { if (t * 16 + g4 * 4 + j >= nsel) lg[t][j] = -INFINITY; mx = fmaxf(mx, lg[t][j]); }
        mx = fmaxf(mx, __shfl_xor(mx, 16)); mx = fmaxf(mx, __shfl_xor(mx, 32));
        float sm = 0.f;
#pragma unroll
        for (int t = 0; t < 16; ++t)
#pragma unroll
            for (int j = 0; j < 4; ++j) { const float e = __builtin_amdgcn_exp2f(lg[t][j] - mx); lg[t][j] = e; sm += e; }
        sm += __shfl_xor(sm, 16); sm += __shfl_xor(sm, 32);
        const float inv = 1.0f / sm;
        f32x4 o[4];
#pragma unroll
        for (int d = 0; d < 4; ++d) o[d] = (f32x4){0.f, 0.f, 0.f, 0.f};
        asm volatile("s_waitcnt vmcnt(0)" ::: "memory");
#pragma unroll
        for (int s = 0; s < 8; ++s) {
            if (s >= 4) {
#pragma unroll
                for (int i = 0; i < 4; ++i) *(LAS u32x4*)(vst + (s & 3) * 4096 + i * 1024 + lane * 16) = vr[(s - 4) * 4 + i];
                asm volatile("s_waitcnt lgkmcnt(0)" ::: "memory");
            }
            const unsigned rb = rdbase + (s & 3) * 4096;
            const s16x4 l0 = tr_read<0>(rb), h0 = tr_read<2048>(rb), l1 = tr_read<32>(rb), h1_ = tr_read<2048 + 32>(rb);
            const s16x4 l2 = tr_read<64>(rb), h2_ = tr_read<2048 + 64>(rb), l3 = tr_read<96>(rb), h3 = tr_read<2048 + 96>(rb);
            asm volatile("s_waitcnt lgkmcnt(0)" ::: "memory");
            __builtin_amdgcn_sched_barrier(0);
            bf16x8 pa;
            {
                const uint32_t w0 = pack2(lg[2 * s][0], lg[2 * s][1]), w1 = pack2(lg[2 * s][2], lg[2 * s][3]);
                const uint32_t w2 = pack2(lg[2 * s + 1][0], lg[2 * s + 1][1]), w3 = pack2(lg[2 * s + 1][2], lg[2 * s + 1][3]);
                pa[0] = (short)(w0 & 0xffff); pa[1] = (short)(w0 >> 16); pa[2] = (short)(w1 & 0xffff); pa[3] = (short)(w1 >> 16);
                pa[4] = (short)(w2 & 0xffff); pa[5] = (short)(w2 >> 16); pa[6] = (short)(w3 & 0xffff); pa[7] = (short)(w3 >> 16);
            }
#define PKV(L, H) (bf16x8){L[0], L[1], L[2], L[3], H[0], H[1], H[2], H[3]}
            o[0] = __builtin_amdgcn_mfma_f32_16x16x32_bf16(pa, PKV(l0, h0), o[0], 0, 0, 0);
            o[1] = __builtin_amdgcn_mfma_f32_16x16x32_bf16(pa, PKV(l1, h1_), o[1], 0, 0, 0);
            o[2] = __builtin_amdgcn_mfma_f32_16x16x32_bf16(pa, PKV(l2, h2_), o[2], 0, 0, 0);
            o[3] = __builtin_amdgcn_mfma_f32_16x16x32_bf16(pa, PKV(l3, h3), o[3], 0, 0, 0);
#undef PKV
        }
#undef V_STAGE
        const float i0 = __shfl(inv, 0), i1 = __shfl(inv, 1), i2 = __shfl(inv, 2), i3 = __shfl(inv, 3);
        if (g4 == 0) {
            bf16_t* op = p.att() + (size_t)(row0 + q) * 512 + kvh * 256 + col;
#pragma unroll
            for (int d = 0; d < 4; ++d) {
                op[0 * 64 + d * 16] = f2bf(o[d][0] * i0); op[1 * 64 + d * 16] = f2bf(o[d][1] * i1);
                op[2 * 64 + d * 16] = f2bf(o[d][2] * i2); op[3 * 64 + d * 16] = f2bf(o[d][3] * i3);
            }
        }
    }
    __syncthreads();
}

constexpr int NBW = 512;
constexpr int W_SC = 0, W_H = W_SC + NKMAX * 2, W_SEL = W_H + NBW * 4, W_CAND = W_SEL + 512, W_SZ = W_CAND + 256;
static_assert(8 * W_SZ <= LDS_BYTES - 32, "wave attention LDS");
__device__ __forceinline__ int binw(float s, float lo, float scale) { return min(NBW - 1, max(0, (int)((s - lo) * scale))); }

__device__ __forceinline__ void attn_wave(const P& p, unsigned char* lds, int wid, int lane, int b, int t, float mn, float mx) {
    unsigned char* wl = lds + wid * W_SZ;
    _Float16* sc = (_Float16*)(wl + W_SC);
    int* hist = (int*)(wl + W_H);
    unsigned short* sel = (unsigned short*)(wl + W_SEL);
    unsigned short* cand = (unsigned short*)(wl + W_CAND);
    const int brow = b * LP, row = brow + t, n = t + 1;
    const int col = lane & 15, g4 = lane >> 4;
    const unsigned long long lt = (1ull << lane) - 1ull;
    int nsel = 256;
    if (n > 256) {
        const float scale = mx > mn ? (float)NBW / (mx - mn) : 0.f, nls = -mn * scale;
#define BINF(x) min(NBW - 1, max(0, (int)__builtin_fmaf((x), scale, nls)))
#define H2F(u16) ((float)__builtin_bit_cast(_Float16, (unsigned short)(u16)))
        for (int base = 0; base < n; base += 512) {
            const int ia = base + lane * 4, ib = ia + 256;
            uint2 ra = make_uint2(0u, 0u), rb2 = make_uint2(0u, 0u);
            if (ia < n) ra = *(const uint2*)(sc + ia);
            if (ib < n) rb2 = *(const uint2*)(sc + ib);
            const unsigned wa[4] = {ra.x & 0xffffu, ra.x >> 16, ra.y & 0xffffu, ra.y >> 16}, wb[4] = {rb2.x & 0xffffu, rb2.x >> 16, rb2.y & 0xffffu, rb2.y >> 16};
#pragma unroll
            for (int j = 0; j < 4; ++j) {
                if (ia + j < n) atomicAdd(&hist[BINF(H2F(wa[j]))], 1);
                if (ib + j < n) atomicAdd(&hist[BINF(H2F(wb[j]))], 1);
            }
        }
        int B1, above1, cnt1;
        {
            int c[8];
            const int4 v0 = *(const int4*)(hist + 8 * lane), v1 = *(const int4*)(hist + 8 * lane + 4);
            c[0] = v0.x; c[1] = v0.y; c[2] = v0.z; c[3] = v0.w; c[4] = v1.x; c[5] = v1.y; c[6] = v1.z; c[7] = v1.w;
            int tot = 0;
#pragma unroll
            for (int i = 0; i < 8; ++i) tot += c[i];
            int suf = tot;
#pragma unroll
            for (int o = 1; o < 64; o <<= 1) { const int tt = __shfl_down(suf, o); if (lane + o < 64) suf += tt; }
            int above = suf - tot;
            const bool mine = above < 256 && 256 <= above + tot;
            int bb = 0, ab = 0, cb = 0;
#pragma unroll
            for (int i = 7; i >= 0; --i) { if (above < 256 && 256 <= above + c[i]) { bb = 8 * lane + i; ab = above; cb = c[i]; } above += c[i]; }
            const int src = (int)__builtin_ctzll(__ballot(mine));
            B1 = __shfl(bb, src); above1 = __shfl(ab, src); cnt1 = __shfl(cb, src);
        }
        int selcnt = 0, candcnt = 0;
        for (int base = 0; base < n; base += 512) {
            const int ia = base + lane * 4, ib = ia + 256;
            uint2 ra = make_uint2(0u, 0u), rb2 = make_uint2(0u, 0u);
            if (ia < n) ra = *(const uint2*)(sc + ia);
            if (ib < n) rb2 = *(const uint2*)(sc + ib);
            const unsigned wv[8] = {ra.x & 0xffffu, ra.x >> 16, ra.y & 0xffffu, ra.y >> 16, rb2.x & 0xffffu, rb2.x >> 16, rb2.y & 0xffffu, rb2.y >> 16};
            unsigned smask = 0u, cmask = 0u;
#pragma unroll
            for (int j = 0; j < 8; ++j) {
                const int idx = (j < 4 ? ia : ib) + (j & 3);
                const int b1 = idx < n ? BINF(H2F(wv[j])) : -1;
                smask |= (b1 > B1 ? 1u : 0u) << j; cmask |= (b1 == B1 ? 1u : 0u) << j;
            }
            const int cnt = __popc(smask);
            int inc = cnt;
#pragma unroll
            for (int o = 1; o < 64; o <<= 1) { const int tt = __shfl_up(inc, o); if (lane >= o) inc += tt; }
            int pos = selcnt + inc - cnt;
#pragma unroll
            for (int j = 0; j < 8; ++j) if ((smask >> j) & 1u) { sel[pos] = (unsigned short)((j < 4 ? ia : ib) + (j & 3)); ++pos; }
            selcnt += __shfl(inc, 63);
            if (__ballot(cmask != 0u)) {
#pragma unroll
                for (int j = 0; j < 8; ++j) {
                    const bool isc = (cmask >> j) & 1u;
                    const unsigned long long mc = __ballot(isc);
                    const int cp = candcnt + __popcll(mc & lt);
                    if (isc && cp < 128) cand[cp] = (unsigned short)((j < 4 ? ia : ib) + (j & 3));
                    candcnt += __popcll(mc);
                }
            }
        }
        {
            const int rq = 256 - above1, cq = cnt1, sbase = 256 - rq;
            if (cq <= 128) {
                int taken = 0;
#pragma unroll
                for (int half = 0; half < 2; ++half) {
                    const int i = lane + 64 * half;
                    bool take = false; int myidx = 0;
                    if (i < cq) {
                        myidx = cand[i]; const float mv = (float)sc[myidx];
                        int rank = 0;
                        for (int j = 0; j < cq; ++j) { const int oj = cand[j]; const float ov = (float)sc[oj]; rank += (ov > mv) || (ov == mv && oj < myidx); }
                        take = rank < rq;
                    }
                    const unsigned long long mt = __ballot(take);
                    if (take) sel[sbase + taken + __popcll(mt & lt)] = (unsigned short)myidx;
                    taken += __popcll(mt);
                }
            } else {
                int taken = 0;
                for (int base = 0; base < n && taken < rq; base += 64) {
                    const int idx = base + lane; bool isc = false;
                    if (idx < n) isc = BINF((float)sc[idx]) == B1;
                    const unsigned long long mc = __ballot(isc);
                    const int pos = taken + __popcll(mc & lt);
                    if (isc && pos < rq) sel[sbase + pos] = (unsigned short)idx;
                    taken += __popcll(mc);
                }
            }
        }
#undef BINF
#undef H2F
    } else {
        nsel = n;
#pragma unroll
        for (int i = 0; i < 4; ++i) { const int j = lane + 64 * i; sel[j] = (unsigned short)(j < n ? j : 0); }
    }
    LAS unsigned char* vst = (LAS unsigned char*)wl + W_SC;
    const unsigned rdbase = (unsigned)(uintptr_t)((LAS unsigned char*)wl + W_SC) + (4 * g4 + (col >> 2)) * 256 + (col & 3) * 8;
    {
        bf16x8 qf[4];
        {
            const bf16_t* qp = p.q() + (size_t)row * 512 + (col & 7) * 64 + g4 * 8;
            const bf16x8 q0 = *(const bf16x8*)qp, q1 = *(const bf16x8*)(qp + 32);
            const bool lo_grp = col < 4, hi_grp = col >= 4 && col < 8;
#pragma unroll
            for (int i = 0; i < 8; ++i) { qf[0][i] = lo_grp ? q0[i] : (short)0; qf[1][i] = lo_grp ? q1[i] : (short)0; qf[2][i] = hi_grp ? q0[i] : (short)0; qf[3][i] = hi_grp ? q1[i] : (short)0; }
        }
        const bf16_t* vb = p.v() + (size_t)brow * 128 + (lane & 15) * 8;
#define V_STAGE(s_, buf_) do { _Pragma("unroll") for (int i_ = 0; i_ < 4; ++i_) { \
            const int key_ = sel[(s_) * 16 + i_ * 4 + (lane >> 4)]; \
            __builtin_amdgcn_global_load_lds((const unsigned*)(vb + (size_t)key_ * 128), (LAS unsigned*)(vst + (buf_) * 4096 + i_ * 1024), 16, 0, 0); } } while (0)
        const bf16_t* kg = p.k() + (size_t)brow * 128;
#define K_STAGE(s_, buf_) do { _Pragma("unroll") for (int i_ = 0; i_ < 4; ++i_) { \
            const int kl_ = i_ * 4 + (lane >> 4); const int key_ = sel[(s_) * 16 + kl_]; \
            __builtin_amdgcn_global_load_lds((const unsigned*)(kg + (size_t)key_ * 128 + (((lane & 15) ^ kl_) & 15) * 8), (LAS unsigned*)(vst + (buf_) * 4096 + i_ * 1024), 16, 0, 0); } } while (0)
        f32x4 lg[16];
        K_STAGE(0, 0); K_STAGE(1, 1); K_STAGE(2, 2);
#pragma unroll
        for (int s = 0; s < 16; ++s) {
            if (s + 3 < 16) { K_STAGE(s + 3, (s + 3) & 3); asm volatile("s_waitcnt vmcnt(12)" ::: "memory"); }
            else if (s == 13) asm volatile("s_waitcnt vmcnt(8)" ::: "memory");
            else if (s == 14) asm volatile("s_waitcnt vmcnt(4)" ::: "memory");
            else asm volatile("s_waitcnt vmcnt(0)" ::: "memory");
            bf16x8 kf[4];
#pragma unroll
            for (int ks = 0; ks < 4; ++ks) kf[ks] = *(const LAS bf16x8*)(vst + (s & 3) * 4096 + col * 256 + (((ks * 4 + g4) ^ col) & 15) * 16);
            asm volatile("s_waitcnt lgkmcnt(0)" ::: "memory");
            __builtin_amdgcn_sched_barrier(0);
            f32x4 a = (f32x4){0.f, 0.f, 0.f, 0.f};
#pragma unroll
            for (int ks = 0; ks < 4; ++ks) a = __builtin_amdgcn_mfma_f32_16x16x32_bf16(kf[ks], qf[ks], a, 0, 0, 0);
            lg[s] = a;
        }
#undef K_STAGE
        V_STAGE(0, 0); V_STAGE(1, 1); V_STAGE(2, 2);
        float mxl = -INFINITY;
#pragma unroll
        for (int tt = 0; tt < 16; ++tt)
#pragma unroll
            for (int j = 0; j < 4; ++j) { if (tt * 16 + g4 * 4 + j >= nsel) lg[tt][j] = -INFINITY; mxl = fmaxf(mxl, lg[tt][j]); }
        mxl = fmaxf(mxl, __shfl_xor(mxl, 16)); mxl = fmaxf(mxl, __shfl_xor(mxl, 32));
        float sm = 0.f;
#pragma unroll
        for (int tt = 0; tt < 16; ++tt)
#pragma unroll
            for (int j = 0; j < 4; ++j) { const float e = __builtin_amdgcn_exp2f(lg[tt][j] - mxl); lg[tt][j] = e; sm += e; }
        sm += __shfl_xor(sm, 16); sm += __shfl_xor(sm, 32);
        const float inv = 1.0f / sm;
        f32x4 o[8];
#pragma unroll
        for (int d = 0; d < 8; ++d) o[d] = (f32x4){0.f, 0.f, 0.f, 0.f};
#pragma unroll
        for (int s = 0; s < 16; ++s) {
            if (s + 3 < 16) { V_STAGE(s + 3, (s + 3) & 3); asm volatile("s_waitcnt vmcnt(12)" ::: "memory"); }
            else if (s == 13) asm volatile("s_waitcnt vmcnt(8)" ::: "memory");
            else if (s == 14) asm volatile("s_waitcnt vmcnt(4)" ::: "memory");
            else asm volatile("s_waitcnt vmcnt(0)" ::: "memory");
            const unsigned rb = rdbase + (s & 3) * 4096;
            s16x4 pa;
            {
                const uint32_t w0 = pack2(lg[s][0], lg[s][1]), w1 = pack2(lg[s][2], lg[s][3]);
                pa[0] = (short)(w0 & 0xffff); pa[1] = (short)(w0 >> 16); pa[2] = (short)(w1 & 0xffff); pa[3] = (short)(w1 >> 16);
            }
            const s16x4 v0 = tr_read<0>(rb), v1 = tr_read<32>(rb), v2 = tr_read<64>(rb), v3 = tr_read<96>(rb);
            const s16x4 v4 = tr_read<128>(rb), v5 = tr_read<160>(rb), v6 = tr_read<192>(rb), v7 = tr_read<224>(rb);
            asm volatile("s_waitcnt lgkmcnt(0)" ::: "memory");
            __builtin_amdgcn_sched_barrier(0);
            o[0] = __builtin_amdgcn_mfma_f32_16x16x16bf16_1k(pa, v0, o[0], 0, 0, 0); o[1] = __builtin_amdgcn_mfma_f32_16x16x16bf16_1k(pa, v1, o[1], 0, 0, 0);
            o[2] = __builtin_amdgcn_mfma_f32_16x16x16bf16_1k(pa, v2, o[2], 0, 0, 0); o[3] = __builtin_amdgcn_mfma_f32_16x16x16bf16_1k(pa, v3, o[3], 0, 0, 0);
            o[4] = __builtin_amdgcn_mfma_f32_16x16x16bf16_1k(pa, v4, o[4], 0, 0, 0); o[5] = __builtin_amdgcn_mfma_f32_16x16x16bf16_1k(pa, v5, o[5], 0, 0, 0);
            o[6] = __builtin_amdgcn_mfma_f32_16x16x16bf16_1k(pa, v6, o[6], 0, 0, 0); o[7] = __builtin_amdgcn_mfma_f32_16x16x16bf16_1k(pa, v7, o[7], 0, 0, 0);
        }
#undef V_STAGE
        float ih[4];
#pragma unroll
        for (int jj = 0; jj < 4; ++jj) ih[jj] = __shfl(inv, 4 * (g4 & 1) + jj);
        if (g4 < 2) {
            bf16_t* op = p.att() + (size_t)row * 512 + (g4 * 4) * 64 + col;
#pragma unroll
            for (int d = 0; d < 4; ++d) {
                const f32x4 oa_ = o[d], ob_ = o[4 + d]; f32x4 ov;
#pragma unroll
                for (int kk = 0; kk < 4; ++kk) ov[kk] = g4 == 0 ? oa_[kk] : ob_[kk];
                op[0 * 64 + d * 16] = f2bf(ov[0] * ih[0]); op[1 * 64 + d * 16] = f2bf(ov[1] * ih[1]);
                op[2 * 64 + d * 16] = f2bf(ov[2] * ih[2]); op[3 * 64 + d * 16] = f2bf(ov[3] * ih[3]);
            }
        }
    }
}

constexpr int A8_META = 8 * W_SZ;
static_assert(A8_META + 64 <= LDS_BYTES - 32, "attn8 meta");
__device__ __forceinline__ void attn8_unit(const P& p, unsigned char* lds, int b, int grp) {
    const int tid = tid_(), lane = tid & 63, wid = __builtin_amdgcn_readfirstlane(tid >> 6);
    const int t0 = NMETA + 8 * grp, brow = b * LP, row0 = brow + t0;
    unsigned* meta = (unsigned*)(lds + A8_META);
    const bool big = t0 + 1 > 256;
    if (tid < 16) meta[tid] = (tid & 1) ? 0u : 0xffffffffu;
    for (int i = tid; i < 8 * NBW; i += NTHREADS) ((int*)(lds + (i / NBW) * W_SZ + W_H))[i % NBW] = 0;
    __syncthreads();
    if (big) {
        const int hh = lane >> 5, c32 = lane & 31;
        const int g = c32 >> 3, h2a = (c32 >> 2) & 1, bq = c32 & 3, aq = 2 * h2a + (g >> 1), ah = 4 * (g & 1) + bq;
        bf16x8 a0[2], a1[2]; f32x4 w[2][2][2];
#pragma unroll
        for (int r = 0; r < 2; ++r) {
            const bf16_t* ap = p.iq() + (size_t)(row0 + 4 * r + aq) * 256 + ah * 32 + 8 * hh;
            a0[r] = *(const bf16x8*)ap; a1[r] = *(const bf16x8*)(ap + 16);
#pragma unroll
            for (int qi = 0; qi < 2; ++qi) {
                const float* wp = p.iw() + (size_t)(row0 + 4 * r + 2 * hh + qi) * 8;
                w[r][qi][0] = *(const f32x4*)wp; w[r][qi][1] = *(const f32x4*)(wp + 4);
            }
        }
        const int ntiles = (t0 + 8 + 31) >> 5;
        float mx[2][2], mn[2][2];
#pragma unroll
        for (int r = 0; r < 2; ++r)
#pragma unroll
            for (int qi = 0; qi < 2; ++qi) { mx[r][qi] = -INFINITY; mn[r][qi] = INFINITY; }
        const bf16_t* kbase = p.ik() + (size_t)brow * 32 + 8 * hh;
        bf16x8 b0[8], b1[8], c0[8], c1[8];
#define S_LOAD(B0, B1, T0) do { _Pragma("unroll") for (int j = 0; j < 8; ++j) { const int tile_ = min((T0) + 8 * j, ntiles - 1); \
            const bf16_t* kp_ = kbase + (size_t)(tile_ * 32 + c32) * 32; B0[j] = *(const bf16x8*)kp_; B1[j] = *(const bf16x8*)(kp_ + 16); } } while (0)
#define S_COMP(B0, B1, T0) do { _Pragma("unroll") for (int j = 0; j < 8; ++j) { const int tile = (T0) + 8 * j; if (tile < ntiles) { const int key = tile * 32 + c32; \
            _Pragma("unroll") for (int r = 0; r < 2; ++r) { f32x16 acc; _Pragma("unroll") for (int i = 0; i < 16; ++i) acc[i] = 0.f; \
                acc = __builtin_amdgcn_mfma_f32_32x32x16_bf16(a0[r], B0[j], acc, 0, 0, 0); acc = __builtin_amdgcn_mfma_f32_32x32x16_bf16(a1[r], B1[j], acc, 0, 0, 0); \
                _Pragma("unroll") for (int qi = 0; qi < 2; ++qi) { float s = 0.f; \
                    _Pragma("unroll") for (int i = 0; i < 4; ++i) s += w[r][qi][0][i] * fmaxf(acc[8 * qi + i], 0.f) + w[r][qi][1][i] * fmaxf(acc[8 * qi + 4 + i], 0.f); \
                    const int q = 4 * r + 2 * hh + qi; const _Float16 hs = (_Float16)fminf(fmaxf(s, -60000.f), 60000.f); \
                    ((_Float16*)(lds + q * W_SZ + W_SC))[key] = hs; \
                    if (key <= t0 + q) { const float f = (float)hs; mx[r][qi] = fmaxf(mx[r][qi], f); mn[r][qi] = fminf(mn[r][qi], f); } } } } } } while (0)
        S_LOAD(b0, b1, wid);
        for (int tile0 = wid; tile0 < ntiles; tile0 += 128) {
            if (tile0 + 64 < ntiles) S_LOAD(c0, c1, tile0 + 64);
            __builtin_amdgcn_sched_barrier(0);
            S_COMP(b0, b1, tile0);
            __builtin_amdgcn_sched_barrier(0);
            if (tile0 + 128 < ntiles) S_LOAD(b0, b1, tile0 + 128);
            __builtin_amdgcn_sched_barrier(0);
            if (tile0 + 64 < ntiles) S_COMP(c0, c1, tile0 + 64);
            __builtin_amdgcn_sched_barrier(0);
        }
#undef S_LOAD
#undef S_COMP
#pragma unroll
        for (int r = 0; r < 2; ++r)
#pragma unroll
            for (int qi = 0; qi < 2; ++qi) {
                float a = mx[r][qi], c = mn[r][qi];
#pragma unroll
                for (int o = 16; o >= 1; o >>= 1) { a = fmaxf(a, __shfl_xor(a, o)); c = fminf(c, __shfl_xor(c, o)); }
                if (c32 == 0 && a >= c) { const int q = 4 * r + 2 * hh + qi; atomicMin(&meta[q * 2], skey(c)); atomicMax(&meta[q * 2 + 1], skey(a)); }
            }
    }
    __syncthreads();
    const float mnq = big ? skey_inv(meta[wid * 2]) : 0.f, mxq = big ? skey_inv(meta[wid * 2 + 1]) : 0.f;
    attn_wave(p, lds, wid, lane, b, t0 + wid, mnq, mxq);
    __syncthreads();
}

constexpr int NGRP8 = SEQ / 8, ATT_P1 = NGRP8 / 8, ATT_P2 = NGRP8 / 2;
template <int SUB>
__device__ __forceinline__ void ph_mixer(const P& p, unsigned char* lds) {
    int* bc = (int*)(lds + LDS_BYTES - 16);
    constexpr int nh = SUB == 1 ? 64 : NXU;
    constexpr int a0 = SUB == 0 ? 0 : (SUB == 1 ? ATT_P1 : ATT_P2), a1 = SUB == 0 ? ATT_P1 : (SUB == 1 ? ATT_P2 : NGRP8);
    for (;;) {
        __syncthreads();
        if (tid_() == 0) bc[0] = atomicAdd(&p.ctr()[97 + SUB], 1);
        __syncthreads();
        const int it = bc[0];
        if (it >= nh) break;
        if (SUB == 0) hgx_unit(p, lds, it);
        else if (SUB == 1) hgchain_unit(p, it);
        else hgz_unit(p, lds, it);
    }
    const int b0 = (int)(xb_xcc_id() & 3u);
#pragma unroll 1
    for (int k = 0; k < 4; ++k) {
        const int b = (b0 + k) & 3;
        for (;;) {
            __syncthreads();
            if (tid_() == 0) bc[0] = atomicAdd(&p.ctr()[104 + SUB * 4 + b], 1);
            __syncthreads();
            const int it = bc[0];
            if (it >= a1 - a0) break;
            attn8_unit(p, lds, b, NGRP8 - 1 - (a0 + it));
        }
    }
}

__device__ __forceinline__ int tok_row(int tok) { return (tok >> 13) * LP + NMETA + (tok & 8191); }
__device__ __forceinline__ void ph_mix(const P& p, unsigned char* lds) {
    const int njobs = (NTOK / 256) * 4 * 2, G = gridDim.x, b0 = blockIdx.x;
    auto jobidx = [&](int i) __attribute__((always_inline)) { return (b0 + (i >> 1) * G) * 2 + (i & 1); };
    auto jobfn = [&](int i, GJob& j) __attribute__((always_inline)) -> bool {
        const int jb = jobidx(i); if (jb >= njobs) return false;
        const int which = jb & 1, u = jb >> 1, nt = u & 3, mt = u >> 2; const size_t r0 = (size_t)tok_row(mt * 256);
        j.A = (const char*)((which ? p.hgr() : p.att()) + r0 * 512); j.B = (const char*)((which ? p.wuhT() : p.wuaT()) + (size_t)nt * 256 * 512); return true; };
    auto epi = [&](f32x4 (&acc)[2][2][4][2], int i) __attribute__((always_inline)) {
        const int jb = jobidx(i), which = jb & 1, u = jb >> 1, nt = u & 3, mt = u >> 2; const size_t r0 = (size_t)tok_row(mt * 256);
        if (which == 0) {
            EPI8(
                const size_t og = (r0 + row) * 1024 + nt * 256 + col, om = (size_t)(mt * 256 + row) * 1024 + nt * 256 + col;
                const uint2 g = *(const uint2*)(p.ga() + og);
                f32x4 r;
                r[0] = v[0] * __uint_as_float(g.x << 16); r[1] = v[1] * __uint_as_float(g.x & 0xffff0000u);
                r[2] = v[2] * __uint_as_float(g.y << 16); r[3] = v[3] * __uint_as_float(g.y & 0xffff0000u);
                st_bf4(p.mix() + om, r);
            );
        } else {
            EPI8(
                const size_t og = (r0 + row) * 1024 + nt * 256 + col, om = (size_t)(mt * 256 + row) * 1024 + nt * 256 + col;
                const uint2 g = *(const uint2*)(p.gh() + og);
                const uint2 a = *(const uint2*)(p.mix() + om);
                f32x4 r;
                r[0] = __uint_as_float(a.x << 16) + v[0] * __uint_as_float(g.x << 16); r[1] = __uint_as_float(a.x & 0xffff0000u) + v[1] * __uint_as_float(g.x & 0xffff0000u);
                r[2] = __uint_as_float(a.y << 16) + v[2] * __uint_as_float(g.y << 16); r[3] = __uint_as_float(a.y & 0xffff0000u) + v[3] * __uint_as_float(g.y & 0xffff0000u);
                st_bf4(p.mix() + om, r);
            );
        }
    };
    unsigned vbU[2]; gj_lin2(vbU, 512);
    gemm_stream<false>(lds, 512, 512, (size_t)128 * 512 * 2, vbU, jobfn, epi);
}

__device__ __forceinline__ void ph_out(const P& p, unsigned char* lds) {
    const int nunits = (NTOK / 256) * 4, G = gridDim.x, b0 = blockIdx.x;
    auto jobfn = [&](int i, GJob& j) __attribute__((always_inline)) -> bool {
        const int u = b0 + i * G; if (u >= nunits) return false;
        const int nt = u & 3, mt = u >> 2;
        j.A = (const char*)(p.mix() + (size_t)mt * 256 * D); j.B = (const char*)(p.woT() + (size_t)nt * 256 * D); return true; };
    auto epi = [&](f32x4 (&acc)[2][2][4][2], int i) __attribute__((always_inline)) {
        const int u = b0 + i * G, nt = u & 3, mt = u >> 2;
        EPI8(
            const size_t o = (size_t)(mt * 256 + row) * D + nt * 256 + col;
            const f32x4 h0 = *(const f32x4*)(p.x + o);
            *(f32x4*)(p.out + o) = h0 + v;
        );
    };
    unsigned vbU[2]; gj_lin2(vbU, D);
    gemm_stream<false>(lds, D, D, (size_t)128 * D * 2, vbU, jobfn, epi);
}

constexpr int XS_LD = 1025;
__device__ __forceinline__ void ph_route(const P& p, unsigned char* lds) {
    const int tid = tid_(), lane = tid & 63, wid = __builtin_amdgcn_readfirstlane(tid >> 6);
    const int gt = blockIdx.x * NTHREADS + tid, ntot = gridDim.x * NTHREADS;
    for (int i = gt; i < CAP; i += ntot) { p.slot_token()[i] = -1; p.slot_info()[i] = make_int2(-1, 0); }
    float* xs = (float*)lds;
    int* lhist = (int*)(lds + 32 * XS_LD * 4);
    for (int tb = blockIdx.x; tb < NTOK / 128; tb += gridDim.x) {
        if (tid < 32) lhist[tid] = 0;
        for (int tile = 0; tile < 4; ++tile) {
            const int tokt = tb * 128 + tile * 32;
            __syncthreads();
#pragma unroll
            for (int t = 0; t < 4; ++t) {
                const int tl = wid * 4 + t, tok = tokt + tl;
                const float* src = p.out + (size_t)tok * D;
                f32x4 v[4]; float ss = 0.f;
#pragma unroll
                for (int i = 0; i < 4; ++i) { v[i] = *(const f32x4*)(src + lane * 4 + 256 * i); ss += v[i][0] * v[i][0] + v[i][1] * v[i][1] + v[i][2] * v[i][2] + v[i][3] * v[i][3]; }
                ss = wave_sum(ss);
                const float rs = rsqrtf(ss * (1.0f / D) + EPS);
#pragma unroll
                for (int i = 0; i < 4; ++i) {
                    const f32x4 g = *(const f32x4*)(p.ffn_g + lane * 4 + 256 * i);
                    f32x4 xn; xn[0] = v[i][0] * rs * g[0]; xn[1] = v[i][1] * rs * g[1]; xn[2] = v[i][2] * rs * g[2]; xn[3] = v[i][3] * rs * g[3];
                    st_bf4(p.xn2() + (size_t)tok * D + lane * 4 + 256 * i, xn);
#pragma unroll
                    for (int c = 0; c < 4; ++c) xs[tl * XS_LD + lane * 4 + 256 * i + c] = xn[c];
                }
            }
            __syncthreads();
            f32x16 acc;
#pragma unroll
            for (int i = 0; i < 16; ++i) acc[i] = 0.f;
            {
                const float* xr = xs + (lane & 31) * XS_LD + wid * 128 + (lane >> 5);
                const float* wp = p.router_w + (size_t)(wid * 128 + (lane >> 5)) * 32 + (lane & 31);
#pragma unroll 16
                for (int i = 0; i < 64; ++i) acc = __builtin_amdgcn_mfma_f32_32x32x2f32(xr[2 * i], wp[(size_t)(2 * i) * 32], acc, 0, 0, 0);
            }
            __syncthreads();
#pragma unroll
            for (int r = 0; r < 16; ++r) xs[wid * 1024 + ((r & 3) + 8 * (r >> 2) + 4 * (lane >> 5)) * 32 + (lane & 31)] = acc[r];
            __syncthreads();
            const int e = lane & 31, hh = lane >> 5;
            const float be = p.router_b[e];
#pragma unroll
            for (int it = 0; it < 2; ++it) {
                const int tl = wid * 4 + it * 2 + hh;
                float l = be;
#pragma unroll
                for (int w = 0; w < 8; ++w) l += xs[w * 1024 + tl * 32 + e];
                float bv[4]; int bi[4];
#pragma unroll
                for (int k = 0; k < 4; ++k) {
                    float m = l;
#pragma unroll
                    for (int o = 16; o >= 1; o >>= 1) m = fmaxf(m, __shfl_xor(m, o));
                    const unsigned long long bal = __ballot(l == m);
                    const unsigned half = hh ? (unsigned)(bal >> 32) : (unsigned)bal;
                    const int idx = __builtin_ctz(half);
                    bv[k] = m; bi[k] = idx;
                    if (e == idx) l = -INFINITY;
                }
                const float e1 = __expf(bv[1] - bv[0]), e2 = __expf(bv[2] - bv[0]), e3 = __expf(bv[3] - bv[0]);
                const float inv = 1.0f / (1.0f + e1 + e2 + e3);
                if (e == 0) {
                    const int tok = tokt + tl;
                    p.tok_exp()[tok * 4 + 0] = bi[0]; p.tok_exp()[tok * 4 + 1] = bi[1]; p.tok_exp()[tok * 4 + 2] = bi[2]; p.tok_exp()[tok * 4 + 3] = bi[3];
                    p.tok_gate()[tok * 4 + 0] = inv; p.tok_gate()[tok * 4 + 1] = e1 * inv; p.tok_gate()[tok * 4 + 2] = e2 * inv; p.tok_gate()[tok * 4 + 3] = e3 * inv;
                    atomicAdd(&lhist[bi[0]], 1); atomicAdd(&lhist[bi[1]], 1); atomicAdd(&lhist[bi[2]], 1); atomicAdd(&lhist[bi[3]], 1);
                }
            }
        }
        __syncthreads();
        if (tid < 32) p.wg_cnt()[tb * 32 + tid] = lhist[tid];
        __syncthreads();
    }
    for (long task = gt; task < 96L * 16384; task += ntot) {
        const int mat = (int)(task >> 14), r = (int)(task & 16383), kq = r >> 10, n = r & 1023;
        const int which = mat >> 5, e = mat & 31;
        const float* W = (which == 0 ? p.w_gate : which == 1 ? p.w_up : p.w_down) + (size_t)e * 1048576 + (size_t)(kq * 64) * 1024 + n;
        bf16_t* outp = (which == 0 ? p.wgT() : which == 1 ? p.wuT() : p.wdT()) + (size_t)e * 1048576 + (size_t)n * 1024 + kq * 64;
        float v[64];
#pragma unroll
        for (int i = 0; i < 64; ++i) v[i] = W[(size_t)i * 1024];
        uint4* dst = (uint4*)outp;
#pragma unroll
        for (int i = 0; i < 8; ++i) dst[i] = make_uint4(pack2(v[8 * i], v[8 * i + 1]), pack2(v[8 * i + 2], v[8 * i + 3]), pack2(v[8 * i + 4], v[8 * i + 5]), pack2(v[8 * i + 6], v[8 * i + 7]));
    }
}

__device__ __forceinline__ void ph_fill(const P& p, unsigned char* lds) {
    const int tid = tid_();
    int* tot = (int*)lds;
    int* pre = tot + 512;
    int* ps = pre + 512;
    int* lc = ps + 32;
    for (int tb = blockIdx.x; tb < NTOK / 128; tb += gridDim.x) {
        {
            const int e = tid & 31, part = tid >> 5;
            int t = 0, q = 0;
            for (int b2 = part; b2 < NTOK / 128; b2 += 16) { const int c = p.wg_cnt()[b2 * 32 + e]; t += c; if (b2 < tb) q += c; }
            tot[part * 32 + e] = t; pre[part * 32 + e] = q;
        }
        __syncthreads();
        if (tid == 0) {
            int acc = 0;
            for (int e = 0; e < NE; ++e) {
                int t = 0, q = 0;
                for (int i = 0; i < 16; ++i) { t += tot[i * 32 + e]; q += pre[i * 32 + e]; }
                ps[e] = acc + q; lc[e] = 0;
                const int nb = (t + 255) >> 8;
                if (tb == 0) for (int i = 0; i < nb; ++i) p.block_expert()[(acc >> 8) + i] = e;
                acc += nb * 256;
            }
            if (tb == 0) p.ctr()[96] = acc >> 8;
        }
        __syncthreads();
        {
            const int i = tb * 512 + tid;
            const int e = p.tok_exp()[i];
            const int dest = ps[e] + atomicAdd(&lc[e], 1);
            p.slot_token()[dest] = i >> 2;
            p.slot_rank()[dest] = i & 3;
            p.slot_gate()[dest] = p.tok_gate()[i];
            p.slot_info()[dest] = make_int2((i >> 2) | ((i & 3) << 16), __float_as_int(p.tok_gate()[i]));
        }
        __syncthreads();
    }
}

struct GUOff { __device__ __forceinline__ size_t operator()(int R) const { return (size_t)(R >> 7) * (WE_B / 2) + (size_t)(R & 127) * 1024; } };
struct GatherOff { const int* st; __device__ __forceinline__ size_t operator()(int R) const { const int t = st[R]; return (size_t)(t < 0 ? 0 : t) * 1024; } };
__device__ __forceinline__ void ph_moe1(const P& p, unsigned char* lds) {
    const int nunits = p.ctr()[96] * 8, G = gridDim.x, b0 = blockIdx.x;
    auto jobfn = [&](int i, GJob& j) __attribute__((always_inline)) -> bool {
        const int u = b0 + i * G; if (u >= nunits) return false;
        const int ct = u & 7, rb = u >> 3, e = p.block_expert()[rb];
        j.A = (const char*)p.xn2(); j.B = (const char*)(p.wgT() + (size_t)e * 1048576 + (size_t)ct * 128 * 1024); gj_gather_job(j, GatherOff{p.slot_token() + rb * 256}); return true; };
    auto epi = [&](f32x4 (&acc)[2][2][4][2], int i) __attribute__((always_inline)) {
        const int u = b0 + i * G, ct = u & 7, rb = u >> 3, e = p.block_expert()[rb];
        const int tid_e = tid_(), lane_e = tid_e & 63, wid_e = tid_e >> 6, wr = wid_e >> 2, wc = wid_e & 3, fr = lane_e & 15, fq = lane_e >> 4;
#pragma unroll
        for (int n = 0; n < 2; ++n) {
            const int c = ct * 128 + wc * 32 + n * 16 + fq * 4;
            const f32x4 bg = *(const f32x4*)(p.b_gate + (size_t)e * DFF + c), bu = *(const f32x4*)(p.b_up + (size_t)e * DFF + c);
#pragma unroll
            for (int ai = 0; ai < 2; ++ai)
#pragma unroll
                for (int m = 0; m < 4; ++m) {
                    const int row = rb * 256 + ai * 128 + wr * 64 + m * 16 + fr;
                    f32x4 a;
#pragma unroll
                    for (int j = 0; j < 4; ++j) {
                        const float g = fminf(acc[ai][0][m][n][j] + bg[j], 7.0f);
                        const float uu = fminf(fmaxf(acc[ai][1][m][n][j] + bu[j], -7.0f), 7.0f);
                        a[j] = (uu + 1.0f) * (g * sigmoidf_(1.702f * g));
                    }
                    st_bf4(p.act() + (size_t)row * DFF + c, a);
                }
        }
    };
    unsigned vbU[2]; gj_lin2(vbU, D);
    gemm_stream<true>(lds, D, D, (size_t)WE_B, vbU, jobfn, epi);
}
__device__ __forceinline__ void ph_moe2(const P& p, unsigned char* lds) {
    const int nunits = p.ctr()[96] * 4, G = gridDim.x, b0 = blockIdx.x;
    auto jobfn = [&](int i, GJob& j) __attribute__((always_inline)) -> bool {
        const int u = b0 + i * G; if (u >= nunits) return false;
        const int nt = u & 3, rb = u >> 2, e = p.block_expert()[rb];
        j.A = (const char*)(p.act() + (size_t)rb * 256 * DFF); j.B = (const char*)(p.wdT() + (size_t)e * 1048576 + (size_t)nt * 256 * DFF); return true; };
    auto epi = [&](f32x4 (&acc)[2][2][4][2], int i) __attribute__((always_inline)) {
        const int u = b0 + i * G, nt = u & 3, rb = u >> 2, e = p.block_expert()[rb];
        const int tid_e = tid_(), lane_e = tid_e & 63, wid_e = tid_e >> 6, wr = wid_e >> 2, wc = wid_e & 3, fr = lane_e & 15, fq = lane_e >> 4;
        f32x4 bd[2][2];
#pragma unroll
        for (int bj = 0; bj < 2; ++bj)
#pragma unroll
            for (int n = 0; n < 2; ++n) bd[bj][n] = *(const f32x4*)(p.b_down + (size_t)e * D + nt * 256 + bj * 128 + wc * 32 + n * 16 + fq * 4);
        int2 info[2][4];
#pragma unroll
        for (int ai = 0; ai < 2; ++ai)
#pragma unroll
            for (int m = 0; m < 4; ++m) info[ai][m] = p.slot_info()[rb * 256 + ai * 128 + wr * 64 + m * 16 + fr];
#pragma unroll
        for (int ai = 0; ai < 2; ++ai)
#pragma unroll
        for (int mp = 0; mp < 2; ++mp) {
            f32x4 old[2][2][2];
#pragma unroll
            for (int mm = 0; mm < 2; ++mm) {
                const int ix = info[ai][mp * 2 + mm].x;
                const size_t o = (size_t)(ix & 0xffff) * D + nt * 256 + wc * 32 + fq * 4;
#pragma unroll
                for (int bj = 0; bj < 2; ++bj)
#pragma unroll
                    for (int n = 0; n < 2; ++n) old[mm][bj][n] = (ix >= 0 && (ix >> 16) == 0) ? *(const f32x4*)(p.out + o + bj * 128 + n * 16) : (f32x4){0.f, 0.f, 0.f, 0.f};
            }
#pragma unroll
            for (int mm = 0; mm < 2; ++mm) {
                const int m = mp * 2 + mm;
                const int ix = info[ai][m].x;
                if (ix < 0) continue;
                const int rank = ix >> 16; const float gate = __int_as_float(info[ai][m].y);
                const size_t o = (size_t)(ix & 0xffff) * D + nt * 256 + wc * 32 + fq * 4;
                if (rank == 0) {
#pragma unroll
                    for (int bj = 0; bj < 2; ++bj)
#pragma unroll
                        for (int n = 0; n < 2; ++n) *(f32x4*)(p.out + o + bj * 128 + n * 16) = old[mm][bj][n] + (acc[ai][bj][m][n] + bd[bj][n]) * gate;
                } else {
                    bf16_t* yb = rank == 1 ? p.y1() : (rank == 2 ? p.y2() : p.y3());
#pragma unroll
                    for (int bj = 0; bj < 2; ++bj)
#pragma unroll
                        for (int n = 0; n < 2; ++n) st_bf4(yb + o + bj * 128 + n * 16, (acc[ai][bj][m][n] + bd[bj][n]) * gate);
                }
            }
        }
    };
    unsigned vbU[2]; gj_lin2(vbU, DFF);
    gemm_stream<false>(lds, DFF, DFF, (size_t)128 * DFF * 2, vbU, jobfn, epi);
}

__device__ __forceinline__ void ph_final(const P& p, unsigned char* lds) {
    const int tid = tid_(), lane = tid & 63, wid = tid >> 6;
    const int gw = blockIdx.x * 8 + wid, nw = gridDim.x * 8;
    for (int tok = gw; tok < NTOK; tok += nw) {
        float* dst = p.out + (size_t)tok * D;
        f32x4 v[4];
#pragma unroll
        for (int i = 0; i < 4; ++i) v[i] = *(const f32x4*)(dst + lane * 4 + 256 * i);
#pragma unroll
        for (int j = 0; j < 3; ++j) {
            const bf16_t* yr = (j == 0 ? p.y1() : j == 1 ? p.y2() : p.y3()) + (size_t)tok * D;
#pragma unroll
            for (int i = 0; i < 4; ++i) {
                const uint2 w = *(const uint2*)(yr + lane * 4 + 256 * i);
                v[i][0] += __uint_as_float(w.x << 16); v[i][1] += __uint_as_float(w.x & 0xffff0000u);
                v[i][2] += __uint_as_float(w.y << 16); v[i][3] += __uint_as_float(w.y & 0xffff0000u);
            }
        }
        float ss = 0.f;
#pragma unroll
        for (int i = 0; i < 4; ++i) ss += v[i][0] * v[i][0] + v[i][1] * v[i][1] + v[i][2] * v[i][2] + v[i][3] * v[i][3];
        ss = wave_sum(ss);
        const float rs = rsqrtf(ss * (1.0f / D) + EPS);
#pragma unroll
        for (int i = 0; i < 4; ++i) {
            const f32x4 g = *(const f32x4*)(p.final_g + lane * 4 + 256 * i);
            *(f32x4*)(dst + lane * 4 + 256 * i) = v[i] * rs * g;
        }
    }
}

typedef const __attribute__((address_space(4))) P* PK;
#define PHASE(call) do { PK q_ = pk; asm volatile("" : "+s"(q_)); const P& p = *(const P*)q_; call; } while (0)
__global__ void __launch_bounds__(NTHREADS) k_mega(P p_unused) {
    __shared__ __attribute__((aligned(16))) unsigned char lds[LDS_BYTES];
    cg::grid_group grid = cg::this_grid();
    const PK pk = (PK)__builtin_amdgcn_kernarg_segment_ptr();
    if (tid_() < 4) ((unsigned*)(lds + LDS_BYTES - 32))[tid_()] = 0u;
    __syncthreads();
    XcdBarrier xb;
    PHASE(xb = xcd_barrier_post((unsigned*)(p.ws + OFF_BAR), (volatile LAS unsigned*)(lds + LDS_BYTES - 32)));
    PHASE(ph_prep(p, lds)); grid.sync();
    PHASE(ph_inproj(p, lds)); xcd_barrier(xb);
    PHASE(ph_mixer<0>(p, lds)); xcd_barrier(xb);
    PHASE(ph_mixer<1>(p, lds)); xcd_barrier(xb);
    PHASE(ph_mixer<2>(p, lds)); xcd_barrier(xb);
    PHASE(ph_mix(p, lds)); xcd_barrier(xb);
    PHASE(ph_out(p, lds)); xcd_barrier(xb);
    PHASE(ph_route(p, lds)); xcd_barrier(xb);
    PHASE(ph_fill(p, lds)); xcd_barrier(xb);
    PHASE(ph_moe1(p, lds)); xcd_barrier(xb);
    PHASE(ph_moe2(p, lds)); xcd_barrier(xb);
    PHASE(ph_final(p, lds));
}

extern "C" void kernel_launch(void* const* d_in, const int* in_sizes, int n_in, void* d_out, int out_size, void* d_ws, size_t ws_size,
                              hipStream_t stream) {
    P p{};
    p.x = (const float*)d_in[0]; p.meta = (const float*)d_in[1]; p.attn_g = (const float*)d_in[2]; p.w_in = (const float*)d_in[3];
    p.hgrn_g = (const float*)d_in[4]; p.w_ua = (const float*)d_in[5]; p.w_uh = (const float*)d_in[6]; p.w_out = (const float*)d_in[7];
    p.lb_logits = (const float*)d_in[8]; p.ffn_g = (const float*)d_in[9]; p.router_w = (const float*)d_in[10]; p.router_b = (const float*)d_in[11];
    p.w_gate = (const float*)d_in[12]; p.b_gate = (const float*)d_in[13]; p.w_up = (const float*)d_in[14]; p.b_up = (const float*)d_in[15];
    p.w_down = (const float*)d_in[16]; p.b_down = (const float*)d_in[17]; p.final_g = (const float*)d_in[18];
    p.out = (float*)d_out;
    p.ws = (unsigned char*)d_ws;
    if (WS_NEED > ws_size) { fprintf(stderr, "workspace too small: need %zu have %zu\n", (size_t)WS_NEED, ws_size); return; }
    static int grid_blocks = 0;
    if (!grid_blocks) {
        int dev = 0, cus = 0, per_cu = 0;
        hipGetDevice(&dev);
        hipDeviceGetAttribute(&cus, hipDeviceAttributeMultiprocessorCount, dev);
        hipOccupancyMaxActiveBlocksPerMultiprocessor(&per_cu, k_mega, NTHREADS, 0);
        if (per_cu > 1) per_cu = 1;
        grid_blocks = cus * per_cu;
    }
    hipMemsetAsync(p.ws + OFF_BAR, 0, XCD_BAR_WORDS * 4, stream);
    void* args[] = {&p};
    hipError_t e = hipLaunchCooperativeKernel((void*)k_mega, dim3(grid_blocks), dim3(NTHREADS), args, 0, stream);
    if (e != hipSuccess) fprintf(stderr, "cooperative launch failed: %s (grid %d)\n", hipGetErrorString(e), grid_blocks);
}
```

```cpp
#include <hip/hip_runtime.h>
#include <hip/hip_cooperative_groups.h>
#include <stdint.h>
#include <cstdio>
namespace cg = cooperative_groups;

#ifndef MEGA
#define MEGA 1
#endif

typedef unsigned short bf16_t;
typedef short bf16x8 __attribute__((ext_vector_type(8)));
typedef float f32x4 __attribute__((ext_vector_type(4)));

constexpr int D = 1024, NB = 4, SEQ = 8192, NMETA = 16, L = SEQ + NMETA  , LP = 8320, T = NB * LP  ;
constexpr int NTOK = NB * SEQ;
constexpr int IN_COLS = 5160;
constexpr int NE = 32, TOPK = 4, DFF = 1024;
constexpr int CAP_BLOCKS = (NTOK * TOPK) / 256 + NE;
constexpr int CAP = CAP_BLOCKS * 256;
constexpr float EPS = 1e-5f;
constexpr int NTHREADS = 512;
constexpr int LDS_BYTES = 155648;
constexpr int NVC = 5376;
#define LAS __attribute__((address_space(3)))

__device__ __forceinline__ bf16_t f2bf(float f) {
    uint32_t u = __float_as_uint(f);
    u += 0x7fffu + ((u >> 16) & 1u);
    return (bf16_t)(u >> 16);
}
__device__ __forceinline__ float bf2f(bf16_t h) { return __uint_as_float(((uint32_t)h) << 16); }
__device__ __forceinline__ uint32_t pack2(float a, float b) { return (uint32_t)f2bf(a) | ((uint32_t)f2bf(b) << 16); }
__device__ __forceinline__ float sigmoidf_(float x) { return __builtin_amdgcn_rcpf(1.0f + __builtin_amdgcn_exp2f(-1.4426950408889634f * x)); }
__device__ __forceinline__ float wave_sum(float v) {
#pragma unroll
    for (int o = 32; o >= 1; o >>= 1) v += __shfl_xor(v, o);
    return v;
}
__device__ __forceinline__ float wave_max(float v) {
#pragma unroll
    for (int o = 32; o >= 1; o >>= 1) v = fmaxf(v, __shfl_xor(v, o));
    return v;
}

constexpr size_t al256(size_t x) { return (x + 255) & ~(size_t)255; }
constexpr size_t TT = (size_t)T;
constexpr size_t MB1 = 1024 * 1024;
constexpr size_t WE_B = (size_t)NE * 1024 * 1024 * 2;
constexpr size_t OFF_WGT = 0, OFF_WUT = WE_B, OFF_WDT = 2 * WE_B, OFF_XN2 = 3 * WE_B, OFF_ACT = OFF_XN2 + (size_t)NTOK * D * 2,
                 OFF_TAB = OFF_ACT + (size_t)CAP * DFF * 2;
constexpr size_t OFF_Y1 = OFF_XN2, OFF_Y2 = OFF_WGT, OFF_Y3 = OFF_WUT;
constexpr size_t OFF_ROPE = OFF_TAB, OFF_LB = OFF_ROPE + al256((size_t)LP * 24 * 4), OFF_CTR = OFF_LB + al256(512 * 4),
                 OFF_BEXP = OFF_CTR + al256(128 * 4), OFF_SLOT = OFF_BEXP + al256((size_t)CAP_BLOCKS * 4), OFF_SRANK = OFF_SLOT + al256((size_t)CAP * 4),
                 OFF_SGATE = OFF_SRANK + al256((size_t)CAP * 4), OFF_TEXP = OFF_SGATE + al256((size_t)CAP * 4), OFF_TGATE = OFF_TEXP + al256((size_t)NTOK * 16),
                 OFF_BAR = OFF_TGATE + al256((size_t)NTOK * 16), OFF_WGC = OFF_BAR + al256(3456 * 4), OFF_SINFO = OFF_WGC + al256(256 * 32 * 4), WS_NEED = OFF_SINFO + al256((size_t)CAP * 8);
constexpr size_t OFF_WIN = 0, OFF_WUA = OFF_WIN + (size_t)NVC * 1024 * 2, OFF_WUH = OFF_WUA + MB1, OFF_WO = OFF_WUH + MB1, OFF_XN = OFF_WO + 2 * MB1,
                 OFF_Q = OFF_XN + TT * 2048, OFF_K = OFF_Q + TT * 1024, OFF_V = OFF_K + TT * 256, OFF_IQ = OFF_V + TT * 256, OFF_IK = OFF_IQ + TT * 512,
                 OFF_IW = OFF_IK + TT * 64, OFF_HQ = OFF_IW + TT * 32, OFF_HF = OFF_HQ + TT * 1024, OFF_HI = OFF_HF + TT * 1024, OFF_HG = OFF_HI + TT * 1024,
                 OFF_GA = OFF_HG + TT * 1024, OFF_GH = OFF_GA + TT * 2048, OFF_ATT = OFF_GH + TT * 2048, OFF_HGR = OFF_ATT + TT * 1024,
                 OFF_S1_END = OFF_HGR + TT * 1024;
constexpr size_t OFF_MIX = OFF_XN;
static_assert(OFF_S1_END <= OFF_TAB, "stage-1 layout overflows");

__device__ __forceinline__ int tid_() { int t = threadIdx.x; asm volatile("" : "+v"(t)); return t; }

struct P {
    const float *x, *meta, *attn_g, *w_in, *hgrn_g, *w_ua, *w_uh, *w_out, *lb_logits, *ffn_g, *router_w, *router_b,
        *w_gate, *b_gate, *w_up, *b_up, *w_down, *b_down, *final_g;
    float* out;
    unsigned char* ws;
#define WSF(type, name, off) __device__ __forceinline__ type* name() const { return (type*)(ws + (off)); }
    WSF(bf16_t, xn, OFF_XN) WSF(bf16_t, q, OFF_Q) WSF(bf16_t, k, OFF_K) WSF(bf16_t, v, OFF_V) WSF(bf16_t, iq, OFF_IQ) WSF(bf16_t, ik, OFF_IK)
    WSF(bf16_t, hq, OFF_HQ) WSF(bf16_t, hf, OFF_HF) WSF(bf16_t, hi, OFF_HI) WSF(bf16_t, hg, OFF_HG) WSF(bf16_t, ga, OFF_GA) WSF(bf16_t, gh, OFF_GH)
    WSF(bf16_t, att, OFF_ATT) WSF(bf16_t, hgr, OFF_HGR) WSF(bf16_t, mix, OFF_MIX) WSF(bf16_t, xn2, OFF_XN2) WSF(bf16_t, act, OFF_ACT)
    WSF(bf16_t, y1, OFF_Y1) WSF(bf16_t, y2, OFF_Y2) WSF(bf16_t, y3, OFF_Y3)
    WSF(bf16_t, winT, OFF_WIN) WSF(bf16_t, wuaT, OFF_WUA) WSF(bf16_t, wuhT, OFF_WUH) WSF(bf16_t, woT, OFF_WO)
    WSF(bf16_t, wgT, OFF_WGT) WSF(bf16_t, wuT, OFF_WUT) WSF(bf16_t, wdT, OFF_WDT)
    WSF(float, iw, OFF_IW) WSF(float, rope, OFF_ROPE) WSF(float, lb, OFF_LB) WSF(float, tok_gate, OFF_TGATE) WSF(float, slot_gate, OFF_SGATE)
    WSF(int, ctr, OFF_CTR)
    WSF(int, wg_cnt, OFF_WGC) WSF(int2, slot_info, OFF_SINFO) WSF(int, block_expert, OFF_BEXP) WSF(int, slot_token, OFF_SLOT) WSF(int, slot_rank, OFF_SRANK) WSF(int, tok_exp, OFF_TEXP)
};

template <class ColMap>
__device__ __forceinline__ void convert_T(const float* W, int ldw, bf16_t* out, int K, int N, const ColMap& cmap, int gt, int ntot) {
    const int kb = K / 64; const long ntask = (long)N * kb;
    for (long task = gt; task < ntask; task += ntot) {
        const int kq = (int)(task / N), n = (int)(task % N);
        const int c = cmap(n);
        uint32_t w[32];
        if (c >= 0) {
            const float* src = W + (size_t)(kq * 64) * ldw + c;
            float v[64];
#pragma unroll
            for (int i = 0; i < 64; ++i) v[i] = src[(size_t)i * ldw];
#pragma unroll
            for (int i = 0; i < 32; ++i) w[i] = pack2(v[2 * i], v[2 * i + 1]);
        } else {
#pragma unroll
            for (int i = 0; i < 32; ++i) w[i] = 0u;
        }
        uint4* dst = (uint4*)(out + (size_t)n * K + kq * 64);
#pragma unroll
        for (int i = 0; i < 8; ++i) dst[i] = make_uint4(w[4 * i], w[4 * i + 1], w[4 * i + 2], w[4 * i + 3]);
    }
}
struct IdMap { __device__ __forceinline__ int operator()(int n) const { return n; } };
struct WinMap { __device__ __forceinline__ int operator()(int n) const { return n < 1064 ? n : (n < 1280 ? -1 : n - 216); } };

#define XB_TMO      128
#define XB_XCNT(j)  (256  + 64 * (j))
#define XB_XSUB(j)  (1280 + 64 * (j))
#define XB_XGEN(j)  (2304 + 64 * (j))
#define XB_TOP      3328
#define XB_TOPGEN   3392
#define XCD_BAR_WORDS 3456
#define XB_SPIN_CAP (1u << 22)
__device__ __forceinline__ unsigned xb_ld(unsigned* p)              { return __hip_atomic_load(p, __ATOMIC_RELAXED, __HIP_MEMORY_SCOPE_AGENT); }
__device__ __forceinline__ unsigned xb_add(unsigned* p, unsigned v) { return __hip_atomic_fetch_add(p, v, __ATOMIC_RELAXED, __HIP_MEMORY_SCOPE_AGENT); }
__device__ __forceinline__ unsigned xb_xcc_id() { return (unsigned)__builtin_amdgcn_s_getreg((3 << 11) | 20) & 0xFu; }
#define XB_SPIN(cond, bar) do { unsigned _sp = 0; while (cond) { __builtin_amdgcn_s_sleep(1); \
    if ((++_sp & 255u) == 0u) { if (xb_ld(&(bar)[XB_TMO])) break; if (_sp > XB_SPIN_CAP) { atomicAdd(&(bar)[XB_TMO], 1u); break; } } } } while (0)
struct XcdBarrier { unsigned* bar; unsigned x; volatile LAS unsigned* st; };
__device__ __forceinline__ XcdBarrier xcd_barrier_post(unsigned* bar, volatile LAS unsigned* st) {
    XcdBarrier b; b.bar = bar; b.x = xb_xcc_id(); b.st = st;
    if (threadIdx.x == 0) (void)xb_add(&bar[XB_XCNT(b.x)], 1u);
    return b;
}
__device__ __forceinline__ void xcd_barrier_complete(unsigned* bar, unsigned x, unsigned& nloc, unsigned& nx) {
    const unsigned G = gridDim.x * gridDim.y * gridDim.z;
    unsigned sum, cnt, mine, sp = 0u;
    for (;;) {
        sum = 0u; cnt = 0u; mine = 0u;
#pragma unroll
        for (unsigned j = 0; j < 16; ++j) { const unsigned c = xb_ld(&bar[XB_XCNT(j)]); sum += c; cnt += (c > 0u) ? 1u : 0u; mine = (j == x) ? c : mine; }
        if (sum == G) break;
        __builtin_amdgcn_s_sleep(1);
        if ((++sp & 255u) == 0u) { if (xb_ld(&bar[XB_TMO])) break; if (sp > XB_SPIN_CAP) { atomicAdd(&bar[XB_TMO], 1u); break; } }
    }
    nloc = mine > 0u ? mine : 1u; nx = cnt > 0u ? cnt : 1u;
}
__device__ __forceinline__ void xcd_barrier(const XcdBarrier& b) {
    asm volatile("s_waitcnt vmcnt(0)" ::: "memory");
    __syncthreads();
    if (threadIdx.x == 0) {
        unsigned* bar = b.bar;
        __builtin_amdgcn_s_waitcnt(0);
        unsigned nloc = b.st[0], nx = b.st[1];
        if (nloc == 0u) { xcd_barrier_complete(bar, b.x, nloc, nx); b.st[0] = nloc; b.st[1] = nx; }
        const unsigned old = xb_add(&bar[XB_XSUB(b.x)], 1u);
        const unsigned gen = old / nloc;
        if (old + 1u == (gen + 1u) * nloc) {
            __builtin_amdgcn_fence(__ATOMIC_RELEASE, "agent");
            asm volatile("s_waitcnt vmcnt(0)" ::: "memory");
            const unsigned og = xb_add(&bar[XB_TOP], 1u);
            const unsigned tg = og / nx;
            if (og + 1u == (tg + 1u) * nx) xb_add(&bar[XB_TOPGEN], 1u);
            else XB_SPIN(xb_ld(&bar[XB_TOPGEN]) == tg, bar);
            __builtin_amdgcn_fence(__ATOMIC_ACQUIRE, "agent");
            xb_add(&bar[XB_XGEN(b.x)], 1u);
            asm volatile("s_waitcnt vmcnt(0)" ::: "memory");
        } else {
            XB_SPIN(xb_ld(&bar[XB_XGEN(b.x)]) == gen, bar);
            __builtin_amdgcn_fence(__ATOMIC_ACQUIRE, "agent");
            asm volatile("s_waitcnt vmcnt(0)" ::: "memory");
        }
    }
    __syncthreads();
}

__device__ __forceinline__ void ph_prep(const P& p, unsigned char* lds) {
    const int tid = tid_(), lane = tid & 63, wid = tid >> 6;
    const int gw = blockIdx.x * 8 + wid, nw = gridDim.x * 8;
    for (int r = gw; r < T; r += nw) {
        const int b = r / LP, pos = r % LP;
        bf16_t* dst = p.xn() + (size_t)r * D;
        if (pos >= L) {
#pragma unroll
            for (int i = 0; i < 4; ++i) *(uint2*)(dst + lane * 4 + 256 * i) = make_uint2(0u, 0u);
            continue;
        }
        const float* src = pos < NMETA ? p.meta + (size_t)pos * D : p.x + ((size_t)b * SEQ + (pos - NMETA)) * D;
        f32x4 v[4]; float ss = 0.f;
#pragma unroll
        for (int i = 0; i < 4; ++i) { v[i] = *(const f32x4*)(src + lane * 4 + 256 * i); ss += v[i][0] * v[i][0] + v[i][1] * v[i][1] + v[i][2] * v[i][2] + v[i][3] * v[i][3]; }
        ss = wave_sum(ss);
        const float rs = rsqrtf(ss * (1.0f / D) + EPS);
#pragma unroll
        for (int i = 0; i < 4; ++i) {
            const f32x4 g = *(const f32x4*)(p.attn_g + lane * 4 + 256 * i);
            uint2 o; o.x = pack2(v[i][0] * rs * g[0], v[i][1] * rs * g[1]); o.y = pack2(v[i][2] * rs * g[2], v[i][3] * rs * g[3]);
            *(uint2*)(dst + lane * 4 + 256 * i) = o;
        }
    }
    const int gt = blockIdx.x * NTHREADS + tid, nt = gridDim.x * NTHREADS;
    for (int i = gt; i < LP * 12; i += nt) {
        const int pos = i / 12, f = i % 12;
        const double ex = f < 8 ? -(double)f / 8.0 : -(double)(f - 8) / 4.0;
        const double inv = exp(ex * log(500000.0));
        const double ang = (double)pos * inv;
        const double twopi = 6.283185307179586476925286766559;
        const double r = ang - twopi * rint(ang / twopi);
        const float rf = (float)r;
        const float c = cosf(rf), s = sinf(rf);
        float* row = p.rope() + (size_t)pos * 24;
        if (f < 8) { row[f] = c; row[8 + f] = s; } else { row[16 + f - 8] = c; row[20 + f - 8] = s; }
    }
    for (int i = gt; i < 512; i += nt) {
        const float a = p.lb_logits[i], b2 = p.lb_logits[512 + i];
        p.lb()[i] = 1.0f / (1.0f + expf(b2 - a));
    }
    for (int i = gt; i < 128; i += nt) p.ctr()[i] = 0;
    convert_T(p.w_in, IN_COLS, p.winT(), 1024, NVC, WinMap{}, gt, nt);
    convert_T(p.w_ua, 1024, p.wuaT(), 512, 1024, IdMap{}, gt, nt);
    convert_T(p.w_uh, 1024, p.wuhT(), 512, 1024, IdMap{}, gt, nt);
    convert_T(p.w_out, 1024, p.woT(), 1024, 1024, IdMap{}, gt, nt);
}
constexpr int G_TILE_B = 256 * 64 * 2, G_STAGE_B = 2 * G_TILE_B;
__device__ __forceinline__ int g_lds_byte(int r, int c) { const int st = (r >> 4) * 2 + (c >> 5), ob = (r & 15) * 64 + (c & 31) * 2; return st * 1024 + (ob ^ (((ob >> 9) & 1) << 5)); }
__device__ __forceinline__ void g_stage_rc(int b, int& R, int& C) { const int st = b >> 10, sb = b & 1023, swz = sb ^ (((sb >> 9) & 1) << 5); R = (st >> 1) * 16 + swz / 64; C = (st & 1) * 32 + (swz % 64) / 2; }

constexpr int HTB = 128 * 64 * 2;
struct GJob { const char* A; const char* B; unsigned va00, va01, va10, va11; };
__device__ __forceinline__ void gj_lin(unsigned (&v)[2][2], int ld) {
#pragma unroll
    for (int h = 0; h < 2; ++h)
#pragma unroll
        for (int i = 0; i < 2; ++i) { int R, C; g_stage_rc(tid_() * 16 + i * 8192, R, C); v[h][i] = (unsigned)(((h * 128 + R) * ld + C) * 2); }
}
template <class AOff>
__device__ __forceinline__ void gj_gather(unsigned (&v)[2][2], const AOff& aoff) {
#pragma unroll
    for (int h = 0; h < 2; ++h)
#pragma unroll
        for (int i = 0; i < 2; ++i) { int R, C; g_stage_rc(tid_() * 16 + i * 8192, R, C); v[h][i] = (unsigned)((aoff(h * 128 + R) + C) * 2); }
}
template <class AOff>
__device__ __forceinline__ void gj_gather_job(GJob& j, const AOff& aoff) {
    unsigned v[2][2]; gj_gather(v, aoff); j.va00 = v[0][0]; j.va01 = v[0][1]; j.va10 = v[1][0]; j.va11 = v[1][1];
}
template <bool GATHER, class JobFn, class Epi>
__device__ __forceinline__ void gemm_stream(unsigned char* lds_, int K, int lda, size_t hstepB, const unsigned (&vbU)[2], const JobFn& jobfn, const Epi& epi) {
    LAS unsigned char* lds = (LAS unsigned char*)lds_;
    const int tid = tid_(), wid = __builtin_amdgcn_readfirstlane(tid >> 6), lane = tid & 63, wr = wid >> 2, wc = wid & 3, fr = lane & 15, fq = lane >> 4;
    const int nt = K / 64;
    const size_t kstep = 128;
    const size_t hstepA = GATHER ? 0 : (size_t)128 * lda * 2;
    const unsigned ldsw = (unsigned)wid * 1024u;
    const int aoff = g_lds_byte(wr * 64 + fr, fq * 8), boff = g_lds_byte(wc * 32 + fr, fq * 8);
    unsigned vaU[2];
#pragma unroll
    for (int i = 0; i < 2; ++i) { int R, C; g_stage_rc(tid * 16 + i * 8192, R, C); vaU[i] = (unsigned)((R * lda + C) * 2); }
#define PG8_SA(b, h) (((b) * 2 + (h)) * HTB)
#define PG8_SB(b, h) ((4 + (b) * 2 + (h)) * HTB)
#define PG8_STAGE2(bufoff, gbase, v0, v1) do { \
        __builtin_amdgcn_global_load_lds((const unsigned*)((const char*)(gbase) + (v0)), (LAS unsigned*)(lds + (bufoff) + ldsw), 16, 0, 0); \
        __builtin_amdgcn_global_load_lds((const unsigned*)((const char*)(gbase) + (v1)), (LAS unsigned*)(lds + (bufoff) + ldsw + 8192), 16, 0, 0); } while (0)
#define STB(bufoff, gbase, h) PG8_STAGE2(bufoff, (gbase) + ((h) ? hstepB : 0), vbU[0], vbU[1])
#define STA_CUR(bufoff, gbase, h) do { if (GATHER) PG8_STAGE2(bufoff, gbase, (h) ? cur.va10 : cur.va00, (h) ? cur.va11 : cur.va01); else PG8_STAGE2(bufoff, (gbase) + ((h) ? hstepA : 0), vaU[0], vaU[1]); } while (0)
#define STA_SEL(bufoff, gbase, h) do { if (GATHER) PG8_STAGE2(bufoff, gbase, last ? ((h) ? nxt.va10 : nxt.va00) : ((h) ? cur.va10 : cur.va00), last ? ((h) ? nxt.va11 : nxt.va01) : ((h) ? cur.va11 : cur.va01)); \
        else PG8_STAGE2(bufoff, (gbase) + ((h) ? hstepA : 0), vaU[0], vaU[1]); } while (0)
#define PG8_LDA(dst, b, h) do { _Pragma("unroll") for (int m = 0; m < 4; ++m) _Pragma("unroll") for (int k = 0; k < 2; ++k) dst[m][k] = *(const LAS bf16x8*)(lds + PG8_SA(b, h) + aoff + m * 2048 + k * 1024); } while (0)
#define PG8_LDB(dst, b, h) do { _Pragma("unroll") for (int n = 0; n < 2; ++n) _Pragma("unroll") for (int k = 0; k < 2; ++k) dst[n][k] = *(const LAS bf16x8*)(lds + PG8_SB(b, h) + boff + n * 2048 + k * 1024); } while (0)
#define PG8_MMA(ai, bj, At, Bt) do { __builtin_amdgcn_s_setprio(1); _Pragma("unroll") for (int m = 0; m < 4; ++m) _Pragma("unroll") for (int n = 0; n < 2; ++n) _Pragma("unroll") for (int k = 0; k < 2; ++k) \
        acc[ai][bj][m][n] = __builtin_amdgcn_mfma_f32_16x16x32_bf16(Bt[n][k], At[m][k], acc[ai][bj][m][n], 0, 0, 0); __builtin_amdgcn_s_setprio(0); } while (0)
#define PG8_WAIT_V(n) asm volatile("s_waitcnt vmcnt(" #n ")" ::: "memory")
#define PG8_WAIT_L(n) asm volatile("s_waitcnt lgkmcnt(" #n ")" ::: "memory")
#define PG8_BAR __builtin_amdgcn_s_barrier()
#define PG8_SCHED __builtin_amdgcn_sched_barrier(0)
    GJob cur, nxt; int ui = 0;
    cur.A = nullptr; cur.B = nullptr; cur.va00 = cur.va01 = cur.va10 = cur.va11 = 0u; nxt = cur;
    if (!jobfn(0, cur)) return;
    f32x4 acc[2][2][4][2];
#pragma unroll
    for (int a = 0; a < 2; ++a)
#pragma unroll
        for (int b = 0; b < 2; ++b)
#pragma unroll
            for (int m = 0; m < 4; ++m)
#pragma unroll
                for (int n = 0; n < 2; ++n) acc[a][b][m][n] = (f32x4){0.f, 0.f, 0.f, 0.f};
    bf16x8 At[4][2], B0[2][2], B1[2][2];
    STB(PG8_SB(0, 0), cur.B, 0); STB(PG8_SB(0, 1), cur.B, 1); STA_CUR(PG8_SA(0, 0), cur.A, 0); STA_CUR(PG8_SA(0, 1), cur.A, 1);
    if (wr == 1) PG8_BAR;
    PG8_WAIT_V(2); PG8_BAR;
    STB(PG8_SB(1, 0), cur.B + kstep, 0); STA_CUR(PG8_SA(1, 0), cur.A + kstep, 0); STB(PG8_SB(1, 1), cur.B + kstep, 1);
    PG8_WAIT_V(6); PG8_BAR;
    for (;;) {
        bool has_next = false;
        for (int t = 0; t < nt; t += 2) {
            const bool last = (t == nt - 2);
            if (last) { has_next = jobfn(ui + 1, nxt); if (!has_next) nxt = cur; }
            const char* a1 = cur.A + (size_t)(t + 1) * kstep;
            const char* a2 = last ? nxt.A : cur.A + (size_t)(t + 2) * kstep; const char* b2 = last ? nxt.B : cur.B + (size_t)(t + 2) * kstep;
            const char* a3 = a2 + kstep; const char* b3 = b2 + kstep;
            PG8_LDB(B0, 0, 0); PG8_LDB(B1, 0, 1); PG8_SCHED; PG8_LDA(At, 0, 0); STA_CUR(PG8_SA(1, 1), a1, 1);
            PG8_WAIT_V(8); PG8_WAIT_L(0); PG8_BAR; PG8_MMA(0, 0, At, B0); PG8_MMA(0, 1, At, B1); PG8_BAR; PG8_SCHED;
            PG8_LDA(At, 0, 1); STB(PG8_SB(0, 0), b2, 0); STB(PG8_SB(0, 1), b2, 1); STA_SEL(PG8_SA(0, 0), a2, 0);
            PG8_WAIT_V(8); PG8_WAIT_L(0); PG8_BAR; PG8_MMA(1, 0, At, B0); PG8_MMA(1, 1, At, B1); PG8_BAR; PG8_SCHED;
            PG8_LDB(B0, 1, 0); PG8_LDB(B1, 1, 1); PG8_SCHED; PG8_LDA(At, 1, 0); STA_SEL(PG8_SA(0, 1), a2, 1);
            PG8_WAIT_V(8); PG8_WAIT_L(0); PG8_BAR; PG8_MMA(0, 0, At, B0); PG8_MMA(0, 1, At, B1); PG8_BAR; PG8_SCHED;
            PG8_LDA(At, 1, 1); STB(PG8_SB(1, 0), b3, 0); STB(PG8_SB(1, 1), b3, 1); STA_SEL(PG8_SA(1, 0), a3, 0);
            PG8_WAIT_V(8); PG8_WAIT_L(0); PG8_BAR; PG8_MMA(1, 0, At, B0); PG8_MMA(1, 1, At, B1); PG8_BAR; PG8_SCHED;
        }
        if (wr == 0) PG8_BAR;
        epi(acc, ui);
        if (!has_next) break;
#pragma unroll
        for (int a = 0; a < 2; ++a)
#pragma unroll
            for (int b = 0; b < 2; ++b)
#pragma unroll
                for (int m = 0; m < 4; ++m)
#pragma unroll
                    for (int n = 0; n < 2; ++n) acc[a][b][m][n] = (f32x4){0.f, 0.f, 0.f, 0.f};
        cur = nxt; ++ui;
        if (wr == 1) PG8_BAR;
    }
    PG8_WAIT_V(0);
    PG8_BAR;
#undef PG8_SA
#undef PG8_SB
#undef PG8_STAGE2
#undef STB
#undef STA_CUR
#undef STA_SEL
#undef PG8_LDA
#undef PG8_LDB
#undef PG8_MMA
#undef PG8_WAIT_V
#undef PG8_WAIT_L
#undef PG8_BAR
#undef PG8_SCHED
}
__device__ __forceinline__ void gj_lin2(unsigned (&v)[2], int ld) {
#pragma unroll
    for (int i = 0; i < 2; ++i) { int R, C; g_stage_rc(tid_() * 16 + i * 8192, R, C); v[i] = (unsigned)((R * ld + C) * 2); }
}
struct RowLin { size_t base; int ld; __device__ __forceinline__ size_t operator()(int R) const { return base + (size_t)R * ld; } };

__device__ __forceinline__ void st_bf4(bf16_t* dst, f32x4 v) {
    uint2 o; o.x = pack2(v[0], v[1]); o.y = pack2(v[2], v[3]); *(uint2*)dst = o;
}
#define EPI8(...) do { const int tid_e = tid_(), lane_e = tid_e & 63, wid_e = tid_e >> 6, wr = wid_e >> 2, wc = wid_e & 3, fr = lane_e & 15, fq = lane_e >> 4; \
    _Pragma("unroll") for (int ai = 0; ai < 2; ++ai) _Pragma("unroll") for (int m = 0; m < 4; ++m) _Pragma("unroll") for (int bj = 0; bj < 2; ++bj) _Pragma("unroll") for (int n = 0; n < 2; ++n) { \
        const int row = ai * 128 + wr * 64 + m * 16 + fr, col = bj * 128 + wc * 32 + n * 16 + fq * 4; const f32x4 v = acc[ai][bj][m][n]; __VA_ARGS__ } } while (0)

struct EpiInproj {
    const P* p; int nt;
    __device__ __forceinline__ void operator()(int m, int n, int fq, f32x4 v) const {
        const P& P_ = *p;
        const int pos = m % LP;
        const float* rp = P_.rope() + (size_t)pos * 24;
        if (nt <= 2) {
            const bool isv = (nt == 2) && (n >= 128);
            if (!isv && (n & 48) == 0) {
                f32x4 pr;
#pragma unroll
                for (int j = 0; j < 4; ++j) pr[j] = __shfl_xor(v[j], 32);
                const int i0 = (fq & 1) * 4;
#pragma unroll
                for (int j = 0; j < 4; ++j) {
                    const float c = rp[i0 + j], s = rp[8 + i0 + j];
                    v[j] = fq < 2 ? v[j] * c - pr[j] * s : v[j] * c + pr[j] * s;
                }
            }
            if (nt < 2) { st_bf4(P_.q() + (size_t)m * 512 + nt * 256 + n, v * (0.125f * 1.4426950408889634f)); }
            else if (n < 128) st_bf4(P_.k() + (size_t)m * 128 + n, v);
            else st_bf4(P_.v() + (size_t)m * 128 + (n - 128), v);
        } else if (nt == 3 || nt == 4) {
            const bool ropeable = (nt == 3) ? ((n & 16) == 0) : (n < 16);
            if (ropeable) {
                f32x4 pr;
#pragma unroll
                for (int j = 0; j < 4; ++j) pr[j] = __shfl_xor(v[j], 16);
                if (fq < 2) {
#pragma unroll
                    for (int j = 0; j < 4; ++j) {
                        const float c = rp[16 + j], s = rp[20 + j];
                        v[j] = fq == 0 ? v[j] * c - pr[j] * s : v[j] * c + pr[j] * s;
                    }
                }
            }
            if (nt == 3) st_bf4(P_.iq() + (size_t)m * 256 + n, v);
            else if (n < 32) st_bf4(P_.ik() + (size_t)m * 32 + n, v);
            else if (n < 40) *(f32x4*)(P_.iw() + (size_t)m * 8 + (n - 32)) = v;
        } else if (nt <= 6) { st_bf4(P_.hq() + (size_t)m * 512 + (nt - 5) * 256 + n, v * 0.08838834764831845f); }
        else if (nt <= 8) { st_bf4(P_.hf() + (size_t)m * 512 + (nt - 7) * 256 + n, v); }
        else if (nt <= 10) { st_bf4(P_.hi() + (size_t)m * 512 + (nt - 9) * 256 + n, v); }
        else if (nt <= 12) {
            f32x4 o;
#pragma unroll
            for (int j = 0; j < 4; ++j) o[j] = v[j] * sigmoidf_(v[j]);
            st_bf4(P_.hg() + (size_t)m * 512 + (nt - 11) * 256 + n, o);
        } else {
            f32x4 o;
#pragma unroll
            for (int j = 0; j < 4; ++j) o[j] = sigmoidf_(v[j]);
            if (nt <= 16) st_bf4(P_.ga() + (size_t)m * 1024 + (nt - 13) * 256 + n, o);
            else st_bf4(P_.gh() + (size_t)m * 1024 + (nt - 17) * 256 + n, o);
        }
    }
};

__device__ __forceinline__ void ph_inproj(const P& p, unsigned char* lds) {
    const int nunits = (T / 256) * 21, G = gridDim.x, b0 = blockIdx.x;
    auto jobfn = [&](int i, GJob& j) __attribute__((always_inline)) -> bool {
        const int u = b0 + i * G; if (u >= nunits) return false;
        const int nt = u % 21, mt = u / 21;
        j.A = (const char*)(p.xn() + (size_t)mt * 256 * D); j.B = (const char*)(p.winT() + (size_t)nt * 256 * D); return true; };
    auto epi = [&](f32x4 (&acc)[2][2][4][2], int i) __attribute__((always_inline)) {
        const int u = b0 + i * G, nt = u % 21, mt = u / 21;
        const EpiInproj e{&p, nt};
        EPI8( e(mt * 256 + row, col, fq, v); );
    };
    unsigned vbU[2]; gj_lin2(vbU, D);
    gemm_stream<false>(lds, D, D, (size_t)128 * D * 2, vbU, jobfn, epi);
}

constexpr int NCH = 129, NXU = 16 * NCH;
constexpr int X_QT = 0, X_KT = X_QT + 64 * 272, X_KH = X_KT + 64 * 272, X_VT = X_KH + 128 * 144, X_AS = X_VT + 128 * 144, X_SEG = X_AS + 64 * 144;
__device__ __forceinline__ bf16_t* hg_ds(const P& p) { return (bf16_t*)p.out; }
__device__ __forceinline__ float* hg_g(const P& p) { return (float*)((unsigned char*)p.out + (size_t)NXU * 32768); }

__device__ __forceinline__ void hgx_unit(const P& p, unsigned char* lds, int u) {
    const int tid = tid_(), lane = tid & 63, wid = tid >> 6, fr = lane & 15, fq = lane >> 4;
    const int c = u % NCH, bh = u / NCH, b = bh >> 2, h = bh & 3;
    const int d = tid & 127, seg = tid >> 7;
    const size_t rowbase = (size_t)(b * LP + c * 64 + seg * 16) * 512 + h * 128 + d;
    bf16_t* hqp = p.hq() + rowbase; const bf16_t* hfp = p.hf() + rowbase; const bf16_t* hip = p.hi() + rowbase;
    const float lbv = p.lb()[h * 128 + d];
    float bb[16], qv[16], kk[16], vv[16];
    float cs = 0.f;
#pragma unroll
    for (int i = 0; i < 16; ++i) {
        const float f = lbv + (1.0f - lbv) * sigmoidf_(bf2f(hfp[(size_t)i * 512]));
        kk[i] = 1.0f - f; cs += __logf(f); bb[i] = cs;
        qv[i] = bf2f(hqp[(size_t)i * 512]); vv[i] = bf2f(hip[(size_t)i * 512]);
    }
    float* segs = (float*)(lds + X_SEG);
    segs[seg * 128 + d] = cs;
    __syncthreads();
    const float s0 = segs[d], s1 = segs[128 + d], s2 = segs[256 + d], s3 = segs[384 + d];
    const float off = seg == 0 ? 0.f : (seg == 1 ? s0 : (seg == 2 ? s0 + s1 : s0 + s1 + s2));
    const float rref = s0 + s1, blast = (s0 + s1) + (s2 + s3);
    uint32_t khp[8], vtp[8];
#pragma unroll
    for (int i = 0; i < 16; i += 2) {
        float khv[2];
#pragma unroll
        for (int j = 0; j < 2; ++j) {
            const float bt = bb[i + j] + off;
            const float eq = __expf(fminf(bt - rref, 80.f)), ek = __expf(fminf(rref - bt, 80.f));
            const int t = seg * 16 + i + j;
            *(bf16_t*)(lds + X_QT + t * 272 + d * 2) = f2bf(qv[i + j] * eq);
            *(bf16_t*)(lds + X_KT + t * 272 + d * 2) = f2bf(kk[i + j] * ek);
            hqp[(size_t)(i + j) * 512] = f2bf(qv[i + j] * __expf(bt));
            khv[j] = kk[i + j] * __expf(blast - bt);
        }
        khp[i >> 1] = pack2(khv[0], khv[1]); vtp[i >> 1] = pack2(vv[i], vv[i + 1]);
    }
    *(uint4*)(lds + X_KH + d * 144 + seg * 32) = make_uint4(khp[0], khp[1], khp[2], khp[3]);
    *(uint4*)(lds + X_KH + d * 144 + seg * 32 + 16) = make_uint4(khp[4], khp[5], khp[6], khp[7]);
    *(uint4*)(lds + X_VT + d * 144 + seg * 32) = make_uint4(vtp[0], vtp[1], vtp[2], vtp[3]);
    *(uint4*)(lds + X_VT + d * 144 + seg * 32 + 16) = make_uint4(vtp[4], vtp[5], vtp[6], vtp[7]);
    if (seg == 0) hg_g(p)[(size_t)u * 128 + d] = __expf(blast);
    __syncthreads();
    {
        const int tm = wid >> 1, tn0 = (wid & 1) * 2;
        f32x4 a1[2] = {(f32x4){0.f, 0.f, 0.f, 0.f}, (f32x4){0.f, 0.f, 0.f, 0.f}};
#pragma unroll
        for (int ks = 0; ks < 4; ++ks) {
            const bf16x8 aq = *(const bf16x8*)(lds + X_QT + (tm * 16 + fr) * 272 + (ks * 32 + fq * 8) * 2);
#pragma unroll
            for (int j = 0; j < 2; ++j) {
                const bf16x8 bk = *(const bf16x8*)(lds + X_KT + ((tn0 + j) * 16 + fr) * 272 + (ks * 32 + fq * 8) * 2);
                a1[j] = __builtin_amdgcn_mfma_f32_16x16x32_bf16(bk, aq, a1[j], 0, 0, 0);
            }
        }
#pragma unroll
        for (int j = 0; j < 2; ++j) {
            const int t = tm * 16 + fr, sb = (tn0 + j) * 16 + fq * 4;
            f32x4 v = a1[j];
#pragma unroll
            for (int jj = 0; jj < 4; ++jj) v[jj] = (sb + jj <= t) ? v[jj] : 0.f;
            uint2 o; o.x = pack2(v[0], v[1]); o.y = pack2(v[2], v[3]);
            *(uint2*)(lds + X_AS + t * 144 + sb * 2) = o;
        }
    }
    __syncthreads();
    {
        const int tm = wid >> 1, en0 = (wid & 1) * 4;
        f32x4 o2[4];
#pragma unroll
        for (int j = 0; j < 4; ++j) o2[j] = (f32x4){0.f, 0.f, 0.f, 0.f};
#pragma unroll
        for (int ks = 0; ks < 2; ++ks) {
            const bf16x8 aa = *(const bf16x8*)(lds + X_AS + (tm * 16 + fr) * 144 + (ks * 32 + fq * 8) * 2);
#pragma unroll
            for (int j = 0; j < 4; ++j) {
                const bf16x8 bv = *(const bf16x8*)(lds + X_VT + ((en0 + j) * 16 + fr) * 144 + (ks * 32 + fq * 8) * 2);
                o2[j] = __builtin_amdgcn_mfma_f32_16x16x32_bf16(bv, aa, o2[j], 0, 0, 0);
            }
        }
        bf16_t* orow = p.hf() + (size_t)(b * LP + c * 64 + tm * 16 + fr) * 512 + h * 128;
#pragma unroll
        for (int j = 0; j < 4; ++j) st_bf4(orow + (en0 + j) * 16 + fq * 4, o2[j]);
    }
    {
        f32x4 s3[8];
#pragma unroll
        for (int j = 0; j < 8; ++j) s3[j] = (f32x4){0.f, 0.f, 0.f, 0.f};
#pragma unroll
        for (int ks = 0; ks < 2; ++ks) {
            const bf16x8 ak = *(const bf16x8*)(lds + X_KH + (wid * 16 + fr) * 144 + (ks * 32 + fq * 8) * 2);
#pragma unroll
            for (int j = 0; j < 8; ++j) {
                const bf16x8 bv = *(const bf16x8*)(lds + X_VT + (j * 16 + fr) * 144 + (ks * 32 + fq * 8) * 2);
                s3[j] = __builtin_amdgcn_mfma_f32_16x16x32_bf16(ak, bv, s3[j], 0, 0, 0);
            }
        }
        bf16_t* dsb = hg_ds(p) + (size_t)u * 16384;
#pragma unroll
        for (int j = 0; j < 8; ++j) st_bf4(dsb + (size_t)(j * 16 + fr) * 128 + wid * 16 + fq * 4, s3[j]);
    }
    __syncthreads();
}

__device__ __forceinline__ void hgchain_unit(const P& p, int item) {
    const int tid = tid_(), bh = item >> 2, eq = item & 3;
    const int e = eq * 32 + (tid >> 4), d0 = (tid & 15) * 8;
    float S[8];
#pragma unroll
    for (int i = 0; i < 8; ++i) S[i] = 0.f;
    uint4* ptr = (uint4*)(hg_ds(p) + ((size_t)(bh * NCH) * 128 + e) * 128 + d0);
    const f32x4* gp = (const f32x4*)(hg_g(p) + (size_t)(bh * NCH) * 128 + d0);
    uint4 wq[8]; f32x4 g0[8], g1[8];
#pragma unroll
    for (int k = 0; k < 8; ++k) { wq[k] = ptr[(size_t)k * 2048]; g0[k] = gp[k * 32]; g1[k] = gp[k * 32 + 1]; }
    for (int c0 = 0; c0 < NCH; c0 += 8) {
#pragma unroll
        for (int k = 0; k < 8; ++k) {
            const int c = c0 + k;
            if (c < NCH) {
                const uint4 w = wq[k]; const f32x4 ga = g0[k], gb = g1[k];
                if (c + 8 < NCH) { wq[k] = ptr[(size_t)(c + 8) * 2048]; g0[k] = gp[(c + 8) * 32]; g1[k] = gp[(c + 8) * 32 + 1]; }
                ptr[(size_t)c * 2048] = make_uint4(pack2(S[0], S[1]), pack2(S[2], S[3]), pack2(S[4], S[5]), pack2(S[6], S[7]));
                S[0] = ga[0] * S[0] + __uint_as_float(w.x << 16); S[1] = ga[1] * S[1] + __uint_as_float(w.x & 0xffff0000u);
                S[2] = ga[2] * S[2] + __uint_as_float(w.y << 16); S[3] = ga[3] * S[3] + __uint_as_float(w.y & 0xffff0000u);
                S[4] = gb[0] * S[4] + __uint_as_float(w.z << 16); S[5] = gb[1] * S[5] + __uint_as_float(w.z & 0xffff0000u);
                S[6] = gb[2] * S[6] + __uint_as_float(w.w << 16); S[7] = gb[3] * S[7] + __uint_as_float(w.w & 0xffff0000u);
            }
        }
    }
}

__device__ __forceinline__ void hgz_unit(const P& p, unsigned char* lds, int u) {
    const int tid = tid_(), lane = tid & 63, wid = tid >> 6, fr = lane & 15, fq = lane >> 4;
    const int c = u % NCH, bh = u / NCH, b = bh >> 2, h = bh & 3;
    const int tm = wid >> 1, en0 = (wid & 1) * 4;
    const size_t row = (size_t)(b * LP + c * 64 + tm * 16 + fr);
    const bf16_t* qrow = p.hq() + row * 512 + h * 128;
    const bf16_t* sT = hg_ds(p) + (size_t)u * 16384;
    f32x4 o[4];
#pragma unroll
    for (int j = 0; j < 4; ++j) o[j] = (f32x4){0.f, 0.f, 0.f, 0.f};
#pragma unroll
    for (int ks = 0; ks < 4; ++ks) {
        const bf16x8 aq = *(const bf16x8*)(qrow + ks * 32 + fq * 8);
#pragma unroll
        for (int j = 0; j < 4; ++j) {
            const bf16x8 bs = *(const bf16x8*)(sT + (size_t)((en0 + j) * 16 + fr) * 128 + ks * 32 + fq * 8);
            o[j] = __builtin_amdgcn_mfma_f32_16x16x32_bf16(bs, aq, o[j], 0, 0, 0);
        }
    }
    const bf16_t* oi = p.hf() + row * 512 + h * 128;
    float ss = 0.f;
#pragma unroll
    for (int j = 0; j < 4; ++j) {
        const uint2 w = *(const uint2*)(oi + (en0 + j) * 16 + fq * 4);
        o[j][0] += __uint_as_float(w.x << 16); o[j][1] += __uint_as_float(w.x & 0xffff0000u);
        o[j][2] += __uint_as_float(w.y << 16); o[j][3] += __uint_as_float(w.y & 0xffff0000u);
        ss += o[j][0] * o[j][0] + o[j][1] * o[j][1] + o[j][2] * o[j][2] + o[j][3] * o[j][3];
    }
    ss += __shfl_xor(ss, 16); ss += __shfl_xor(ss, 32);
    float* part = (float*)lds;
    if (fq == 0) part[(tm * 16 + fr) * 2 + (wid & 1)] = ss;
    __syncthreads();
    const float tot = part[(tm * 16 + fr) * 2] + part[(tm * 16 + fr) * 2 + 1];
    const float rs = rsqrtf(tot * (1.0f / 128.0f) + EPS);
    const bf16_t* hgp = p.hg() + row * 512 + h * 128;
    bf16_t* outp = p.hgr() + row * 512 + h * 128;
#pragma unroll
    for (int j = 0; j < 4; ++j) {
        const int e0 = (en0 + j) * 16 + fq * 4;
        const f32x4 gn = *(const f32x4*)(p.hgrn_g + h * 128 + e0);
        const uint2 w = *(const uint2*)(hgp + e0);
        f32x4 r;
        r[0] = o[j][0] * rs * gn[0] * __uint_as_float(w.x << 16); r[1] = o[j][1] * rs * gn[1] * __uint_as_float(w.x & 0xffff0000u);
        r[2] = o[j][2] * rs * gn[2] * __uint_as_float(w.y << 16); r[3] = o[j][3] * rs * gn[3] * __uint_as_float(w.y & 0xffff0000u);
        st_bf4(outp + e0, r);
    }
    __syncthreads();
}

typedef float f32x16 __attribute__((ext_vector_type(16)));
typedef short s16x4 __attribute__((ext_vector_type(4)));
typedef unsigned u32x4 __attribute__((ext_vector_type(4)));
constexpr int NKMAX = 8224;
constexpr int NBIN = 1024;
constexpr int A_SC = 0, A_H1 = A_SC + 4 * NKMAX * 4, A_SEL = A_H1 + 4 * NBIN * 4, A_CAND = A_SEL + 2048, A_META = A_CAND + 1024, A_END = A_META + 256;
static_assert(A_END <= LDS_BYTES - 16, "attention LDS");
__device__ __forceinline__ uint32_t skey(float f) { const uint32_t u = __float_as_uint(f); return (u & 0x80000000u) ? ~u : (u | 0x80000000u); }
__device__ __forceinline__ float skey_inv(uint32_t k) { return __uint_as_float((k & 0x80000000u) ? (k & 0x7fffffffu) : ~k); }
__device__ __forceinline__ int bin1(float s, float lo, float scale) { return min(NBIN - 1, max(0, (int)((s - lo) * scale))); }
template <int OFF> __device__ __forceinline__ s16x4 tr_read(unsigned addr) {
    s16x4 r; asm volatile("ds_read_b64_tr_b16 %0, %1 offset:%2" : "=&v"(r) : "v"(addr), "i"(OFF) : "memory"); return r;
}
__device__ __forceinline__ void scan_top(const int* hist, int K, int* m, int lane) {
    int c[16];
#pragma unroll
    for (int i = 0; i < 4; ++i) { const int4 v = *(const int4*)(hist + 16 * lane + 4 * i); c[4 * i] = v.x; c[4 * i + 1] = v.y; c[4 * i + 2] = v.z; c[4 * i + 3] = v.w; }
    int tot = 0;
#pragma unroll
    for (int i = 0; i < 16; ++i) tot += c[i];
    int suf = tot;
#pragma unroll
    for (int o = 1; o < 64; o <<= 1) { const int t = __shfl_down(suf, o); if (lane + o < 64) suf += t; }
    int above = suf - tot;
#pragma unroll
    for (int i = 15; i >= 0; --i) {
        if (above < K && K <= above + c[i]) { m[0] = 16 * lane + i; m[1] = above; m[2] = c[i]; }
        above += c[i];
    }
}

__device__ __forceinline__ void attn4_unit(const P& p, unsigned char* lds, int b, int grp) {
    const int tid = tid_(), lane = tid & 63, wid = __builtin_amdgcn_readfirstlane(tid >> 6);
    const int t0 = NMETA + 4 * grp;
    const int brow = b * LP, row0 = brow + t0;
    float* sc = (float*)(lds + A_SC);
    int* h1 = (int*)(lds + A_H1);
    unsigned short* sel = (unsigned short*)(lds + A_SEL); unsigned short* cand = (unsigned short*)(lds + A_CAND);
    int* meta = (int*)(lds + A_META);
    const bool big = t0 + 1 > 256;
    for (int i = tid; i < 4 * NBIN; i += NTHREADS) h1[i] = 0;
    if (tid < 64) { const int w = tid & 15; meta[tid] = (w == 0) ? -1 : 0; }
    if (!big) { for (int i = tid; i < 1024; i += NTHREADS) { const int q = i >> 8, j = i & 255; sel[i] = (unsigned short)(j <= t0 + q ? j : 0); } }
    __syncthreads();
    if (big) {
        {
            const int hh = lane >> 5, c32 = lane & 31;
            const int g = c32 >> 3, h2a = (c32 >> 2) & 1, bq = c32 & 3, aq = 2 * h2a + (g >> 1), ah = 4 * (g & 1) + bq;
            const bf16_t* ap = p.iq() + (size_t)(row0 + aq) * 256 + ah * 32 + 8 * hh;
            const bf16x8 a0 = *(const bf16x8*)ap, a1 = *(const bf16x8*)(ap + 16);
            const f32x4 w00 = *(const f32x4*)(p.iw() + (size_t)(row0 + 2 * hh) * 8), w01 = *(const f32x4*)(p.iw() + (size_t)(row0 + 2 * hh) * 8 + 4);
            const f32x4 w10 = *(const f32x4*)(p.iw() + (size_t)(row0 + 2 * hh + 1) * 8), w11 = *(const f32x4*)(p.iw() + (size_t)(row0 + 2 * hh + 1) * 8 + 4);
            const int ntiles = (t0 + 4 + 31) >> 5;
            const int tq0 = t0 + 2 * hh;
            float mx0 = -INFINITY, mn0 = INFINITY, mx1 = -INFINITY, mn1 = INFINITY;
            const bf16_t* kbase = p.ik() + (size_t)brow * 32 + 8 * hh;
            for (int tile0 = wid; tile0 < ntiles; tile0 += 128) {
                bf16x8 b0[16], b1[16];
#pragma unroll
                for (int j = 0; j < 16; ++j) {
                    const int tile = min(tile0 + 8 * j, ntiles - 1);
                    const bf16_t* kp = kbase + (size_t)(tile * 32 + c32) * 32;
                    b0[j] = *(const bf16x8*)kp; b1[j] = *(const bf16x8*)(kp + 16);
                }
                __builtin_amdgcn_sched_barrier(0);
#pragma unroll
                for (int j = 0; j < 16; ++j) {
                    const int tile = tile0 + 8 * j;
                    if (tile < ntiles) {
                        const int key = tile * 32 + c32;
                        f32x16 acc;
#pragma unroll
                        for (int i = 0; i < 16; ++i) acc[i] = 0.f;
                        acc = __builtin_amdgcn_mfma_f32_32x32x16_bf16(a0, b0[j], acc, 0, 0, 0);
                        acc = __builtin_amdgcn_mfma_f32_32x32x16_bf16(a1, b1[j], acc, 0, 0, 0);
                        float s0 = 0.f, s1 = 0.f;
#pragma unroll
                        for (int i = 0; i < 4; ++i) {
                            s0 += w00[i] * fmaxf(acc[i], 0.f) + w01[i] * fmaxf(acc[4 + i], 0.f);
                            s1 += w10[i] * fmaxf(acc[8 + i], 0.f) + w11[i] * fmaxf(acc[12 + i], 0.f);
                        }
                        sc[(2 * hh) * NKMAX + key] = s0; sc[(2 * hh + 1) * NKMAX + key] = s1;
                        if (key <= tq0) { mx0 = fmaxf(mx0, s0); mn0 = fminf(mn0, s0); }
                        if (key <= tq0 + 1) { mx1 = fmaxf(mx1, s1); mn1 = fminf(mn1, s1); }
                    }
                }
            }
#pragma unroll
            for (int o = 16; o >= 1; o >>= 1) {
                mx0 = fmaxf(mx0, __shfl_xor(mx0, o)); mn0 = fminf(mn0, __shfl_xor(mn0, o));
                mx1 = fmaxf(mx1, __shfl_xor(mx1, o)); mn1 = fminf(mn1, __shfl_xor(mn1, o));
            }
            if (c32 == 0) {
                if (mx0 >= mn0) { atomicMin((unsigned*)&meta[(2 * hh) * 16 + 0], skey(mn0)); atomicMax((unsigned*)&meta[(2 * hh) * 16 + 1], skey(mx0)); }
                if (mx1 >= mn1) { atomicMin((unsigned*)&meta[(2 * hh + 1) * 16 + 0], skey(mn1)); atomicMax((unsigned*)&meta[(2 * hh + 1) * 16 + 1], skey(mx1)); }
            }
        }
        __syncthreads();
        const int q = wid & 3, part = wid >> 2, n = t0 + q + 1;
        const float lo = skey_inv((unsigned)meta[q * 16 + 0]), hi = skey_inv((unsigned)meta[q * 16 + 1]);
        const float scale = hi > lo ? (float)NBIN / (hi - lo) : 0.f;
        const float* scq = sc + q * NKMAX;
        for (int base = part * 256; base < n; base += 512) {
            const int idx0 = base + lane * 4;
            if (idx0 < n) {
                const f32x4 v = *(const f32x4*)(scq + idx0);
#pragma unroll
                for (int j = 0; j < 4; ++j) if (idx0 + j < n) atomicAdd(&h1[q * NBIN + bin1(v[j], lo, scale)], 1);
            }
        }
        __syncthreads();
        if (wid < 4) scan_top(h1 + wid * NBIN, 256, meta + wid * 16 + 4, lane);
        __syncthreads();
        const int B1 = meta[q * 16 + 4];
        for (int base = part * 256; base < n; base += 512) {
            const int idx0 = base + lane * 4;
            f32x4 v = (f32x4){0.f, 0.f, 0.f, 0.f};
            if (idx0 < n) v = *(const f32x4*)(scq + idx0);
            const unsigned long long lt = (1ull << lane) - 1ull;
#pragma unroll
            for (int j = 0; j < 4; ++j) {
                const int idx = idx0 + j;
                bool issel = false, iscand = false;
                if (idx < n) { const int b1 = bin1(v[j], lo, scale); issel = b1 > B1; iscand = b1 == B1; }
                const unsigned long long ms = __ballot(issel), mc = __ballot(iscand);
                if (ms) {
                    int bs = 0; if (lane == 0) bs = atomicAdd(&meta[q * 16 + 2], __popcll(ms));
                    bs = __shfl(bs, 0);
                    if (issel) sel[q * 256 + bs + __popcll(ms & lt)] = (unsigned short)idx;
                }
                if (mc) {
                    int bs = 0; if (lane == 0) bs = atomicAdd(&meta[q * 16 + 3], __popcll(mc));
                    bs = __shfl(bs, 0);
                    const int pos = bs + __popcll(mc & lt);
                    if (iscand && pos < 128) cand[q * 128 + pos] = (unsigned short)idx;
                }
            }
        }
        __syncthreads();
        if (wid < 4) {
            const int qq = wid; const float* scr = sc + qq * NKMAX;
            const int rq = 256 - meta[qq * 16 + 5], cq = meta[qq * 16 + 6], sbase = 256 - rq, nn = t0 + qq + 1;
            if (cq <= 128) {
                int taken = 0;
#pragma unroll
                for (int half = 0; half < 2; ++half) {
                    const int i = lane + 64 * half;
                    bool take = false; int myidx = 0;
                    if (i < cq) {
                        myidx = cand[qq * 128 + i]; const float mv = scr[myidx];
                        int rank = 0;
                        for (int j = 0; j < cq; ++j) { const int oj = cand[qq * 128 + j]; const float ov = scr[oj]; rank += (ov > mv) || (ov == mv && oj < myidx); }
                        take = rank < rq;
                    }
                    const unsigned long long mt = __ballot(take);
                    if (take) sel[qq * 256 + sbase + taken + __popcll(mt & ((1ull << lane) - 1ull))] = (unsigned short)myidx;
                    taken += __popcll(mt);
                }
            } else {
                const float lo_ = skey_inv((unsigned)meta[qq * 16 + 0]), hi_ = skey_inv((unsigned)meta[qq * 16 + 1]);
                const float sc_ = hi_ > lo_ ? (float)NBIN / (hi_ - lo_) : 0.f;
                const int B1_ = meta[qq * 16 + 4];
                int taken = 0;
                for (int base = 0; base < nn && taken < rq; base += 64) {
                    const int idx = base + lane; bool isc = false;
                    if (idx < nn) isc = bin1(scr[idx], lo_, sc_) == B1_;
                    const unsigned long long mc = __ballot(isc);
                    const int pos = taken + __popcll(mc & ((1ull << lane) - 1ull));
                    if (isc && pos < rq) sel[qq * 256 + sbase + pos] = (unsigned short)idx;
                    taken += __popcll(mc);
                }
            }
        }
        __syncthreads();
    }
    {
        const int q = wid >> 1, kvh = wid & 1, tq = t0 + q, nsel = min(tq + 1, 256);
        const int col = lane & 15, g4 = lane >> 4;
        const unsigned short* selq = sel + q * 256;
        bf16x8 qf0, qf1;
        {
            const bf16_t* qp = p.q() + (size_t)(row0 + q) * 512 + (kvh * 4 + (col & 3)) * 64 + g4 * 8;
            qf0 = *(const bf16x8*)qp; qf1 = *(const bf16x8*)(qp + 32);
            if (col >= 4) {
#pragma unroll
                for (int i = 0; i < 8; ++i) { qf0[i] = 0; qf1[i] = 0; }
            }
        }
        LAS unsigned char* vst = (LAS unsigned char*)lds + A_SC + wid * 16384;
        const bf16_t* vb = p.v() + (size_t)brow * 128 + kvh * 64 + (lane & 7) * 8;
        const unsigned rdbase = (unsigned)(uintptr_t)((LAS unsigned char*)lds + A_SC) + wid * 16384 + (4 * g4 + (col >> 2)) * 128 + (col & 3) * 8;
#define V_STAGE(s_, buf_) do { _Pragma("unroll") for (int i_ = 0; i_ < 4; ++i_) { \
            const int ksl_ = (s_) * 32 + i_ * 8 + (lane >> 3); const int key_ = selq[ksl_]; \
            __builtin_amdgcn_global_load_lds((const unsigned*)(vb + (size_t)key_ * 128), (LAS unsigned*)(vst + (buf_) * 4096 + i_ * 1024), 16, 0, 0); } } while (0)
        const bf16_t* kb = p.k() + (size_t)brow * 128 + kvh * 64 + g4 * 8;
        f32x4 lg[16];
        u32x4 vr[16];
        {
            bf16x8 k0[16], k1[16];
#pragma unroll
            for (int t = 0; t < 16; ++t) {
                const int key = selq[t * 16 + col];
                const bf16_t* kp = kb + (size_t)key * 128;
                k0[t] = *(const bf16x8*)kp; k1[t] = *(const bf16x8*)(kp + 32);
            }
#pragma unroll
            for (int s = 4; s < 8; ++s)
#pragma unroll
                for (int i = 0; i < 4; ++i) { const int key = selq[s * 32 + i * 8 + (lane >> 3)]; vr[(s - 4) * 4 + i] = *(const u32x4*)(vb + (size_t)key * 128); }
            V_STAGE(0, 0); V_STAGE(1, 1); V_STAGE(2, 2); V_STAGE(3, 3);
            __builtin_amdgcn_sched_barrier(0);
#pragma unroll
            for (int t = 0; t < 16; ++t) {
                f32x4 a = (f32x4){0.f, 0.f, 0.f, 0.f};
                a = __builtin_amdgcn_mfma_f32_16x16x32_bf16(k0[t], qf0, a, 0, 0, 0);
                a = __builtin_amdgcn_mfma_f32_16x16x32_bf16(k1[t], qf1, a, 0, 0, 0);
                lg[t] = a;
            }
            __builtin_amdgcn_sched_barrier(0);
        }
        float mx = -INFINITY;
#pragma unroll
        for (int t = 0; t < 16; ++t)
#pragma unroll
            for (int j = 0; j < 4; ++j) { if (t * 16 + g4 * 4 + j >= nsel) lg[t][j] = -INFINITY; mx = fmaxf(mx, lg[t][j]); }
        mx = fmaxf(mx, __shfl_xor(mx, 16)); mx = fmaxf(mx, __shfl_xor(mx, 32));
        float sm = 0.f;
#pragma unroll
        for (int t = 0; t < 16; ++t)
#pragma unroll
            for (int j = 0; j < 4; ++j) { const float e = __builtin_amdgcn_exp2f(lg[t][j] - mx); lg[t][j] = e; sm += e; }
        sm += __shfl_xor(sm, 16); sm += __shfl_xor(sm, 32);
        const float inv = 1.0f / sm;
        f32x4 o[4];
#pragma unroll
        for (int d = 0; d < 4; ++d) o[d] = (f32x4){0.f, 0.f, 0.f, 0.f};
        asm volatile("s_waitcnt vmcnt(0)" ::: "memory");
#pragma unroll
        for (int s = 0; s < 8; ++s) {
            if (s >= 4) {
#pragma unroll
                for (int i = 0; i < 4; ++i) *(LAS u32x4*)(vst + (s & 3) * 4096 + i * 1024 + lane * 16) = vr[(s - 4) * 4 + i];
                asm volatile("s_waitcnt lgkmcnt(0)" ::: "memory");
            }
            const unsigned rb = rdbase + (s & 3) * 4096;
            const s16x4 l0 = tr_read<0>(rb), h0 = tr_read<2048>(rb), l1 = tr_read<32>(rb), h1_ = tr_read<2048 + 32>(rb);
            const s16x4 l2 = tr_read<64>(rb), h2_ = tr_read<2048 + 64>(rb), l3 = tr_read<96>(rb), h3 = tr_read<2048 + 96>(rb);
            asm volatile("s_waitcnt lgkmcnt(0)" ::: "memory");
            __builtin_amdgcn_sched_barrier(0);
            bf16x8 pa;
            {
                const uint32_t w0 = pack2(lg[2 * s][0], lg[2 * s][1]), w1 = pack2(lg[2 * s][2], lg[2 * s][3]);
                const uint32_t w2 = pack2(lg[2 * s + 1][0], lg[2 * s + 1][1]), w3 = pack2(lg[2 * s + 1][2], lg[2 * s + 1][3]);
                pa[0] = (short)(w0 & 0xffff); pa[1] = (short)(w0 >> 16); pa[2] = (short)(w1 & 0xffff); pa[3] = (short)(w1 >> 16);
                pa[4] = (short)(w2 & 0xffff); pa[5] = (short)(w2 >> 16); pa[6] = (short)(w3 & 0xffff); pa[7] = (short)(w3 >> 16);
            }
#define PKV(L, H) (bf16x8){L[0], L[1], L[2], L[3], H[0], H[1], H[2], H[3]}
            o[0] = __builtin_amdgcn_mfma_f32_16x16x32_bf16(pa, PKV(l0, h0), o[0], 0, 0, 0);
            o[1] = __builtin_amdgcn_mfma_f32_16x16x32_bf16(pa, PKV(l1, h1_), o[1], 0, 0, 0);
            o[2] = __builtin_amdgcn_mfma_f32_16x16x32_bf16(pa, PKV(l2, h2_), o[2], 0, 0, 0);
            o[3] = __builtin_amdgcn_mfma_f32_16x16x32_bf16(pa, PKV(l3, h3), o[3], 0, 0, 0);
#undef PKV
        }
#undef V_STAGE
        const float i0 = __shfl(inv, 0), i1 = __shfl(inv, 1), i2 = __shfl(inv, 2), i3 = __shfl(inv, 3);
        if (g4 == 0) {
            bf16_t* op = p.att() + (size_t)(row0 + q) * 512 + kvh * 256 + col;
#pragma unroll
            for (int d = 0; d < 4; ++d) {
                op[0 * 64 + d * 16] = f2bf(o[d][0] * i0); op[1 * 64 + d * 16] = f2bf(o[d][1] * i1);
                op[2 * 64 + d * 16] = f2bf(o[d][2] * i2); op[3 * 64 + d * 16] = f2bf(o[d][3] * i3);
            }
        }
    }
    __syncthreads();
}

constexpr int NBW = 512;
constexpr int W_SC = 0, W_H = W_SC + NKMAX * 2, W_SEL = W_H + NBW * 4, W_CAND = W_SEL + 512, W_SZ = W_CAND + 256;
static_assert(8 * W_SZ <= LDS_BYTES - 32, "wave attention LDS");
__device__ __forceinline__ int binw(float s, float lo, float scale) { return min(NBW - 1, max(0, (int)((s - lo) * scale))); }

__device__ __forceinline__ void attn_wave(const P& p, unsigned char* lds, int wid, int lane, int b, int t, float mn, float mx) {
    unsigned char* wl = lds + wid * W_SZ;
    _Float16* sc = (_Float16*)(wl + W_SC);
    int* hist = (int*)(wl + W_H);
    unsigned short* sel = (unsigned short*)(wl + W_SEL);
    unsigned short* cand = (unsigned short*)(wl + W_CAND);
    const int brow = b * LP, row = brow + t, n = t + 1;
    const int col = lane & 15, g4 = lane >> 4;
    const unsigned long long lt = (1ull << lane) - 1ull;
    int nsel = 256;
    if (n > 256) {
        const float scale = mx > mn ? (float)NBW / (mx - mn) : 0.f, nls = -mn * scale;
#define BINF(x) min(NBW - 1, max(0, (int)__builtin_fmaf((x), scale, nls)))
#define H2F(u16) ((float)__builtin_bit_cast(_Float16, (unsigned short)(u16)))
        for (int base = 0; base < n; base += 512) {
            const int ia = base + lane * 4, ib = ia + 256;
            uint2 ra = make_uint2(0u, 0u), rb2 = make_uint2(0u, 0u);
            if (ia < n) ra = *(const uint2*)(sc + ia);
            if (ib < n) rb2 = *(const uint2*)(sc + ib);
            const unsigned wa[4] = {ra.x & 0xffffu, ra.x >> 16, ra.y & 0xffffu, ra.y >> 16}, wb[4] = {rb2.x & 0xffffu, rb2.x >> 16, rb2.y & 0xffffu, rb2.y >> 16};
#pragma unroll
            for (int j = 0; j < 4; ++j) {
                if (ia + j < n) atomicAdd(&hist[BINF(H2F(wa[j]))], 1);
                if (ib + j < n) atomicAdd(&hist[BINF(H2F(wb[j]))], 1);
            }
        }
        int B1, above1, cnt1;
        {
            int c[8];
            const int4 v0 = *(const int4*)(hist + 8 * lane), v1 = *(const int4*)(hist + 8 * lane + 4);
            c[0] = v0.x; c[1] = v0.y; c[2] = v0.z; c[3] = v0.w; c[4] = v1.x; c[5] = v1.y; c[6] = v1.z; c[7] = v1.w;
            int tot = 0;
#pragma unroll
            for (int i = 0; i < 8; ++i) tot += c[i];
            int suf = tot;
#pragma unroll
            for (int o = 1; o < 64; o <<= 1) { const int tt = __shfl_down(suf, o); if (lane + o < 64) suf += tt; }
            int above = suf - tot;
            const bool mine = above < 256 && 256 <= above + tot;
            int bb = 0, ab = 0, cb = 0;
#pragma unroll
            for (int i = 7; i >= 0; --i) { if (above < 256 && 256 <= above + c[i]) { bb = 8 * lane + i; ab = above; cb = c[i]; } above += c[i]; }
            const int src = (int)__builtin_ctzll(__ballot(mine));
            B1 = __shfl(bb, src); above1 = __shfl(ab, src); cnt1 = __shfl(cb, src);
        }
        int selcnt = 0, candcnt = 0;
        for (int base = 0; base < n; base += 512) {
            const int ia = base + lane * 4, ib = ia + 256;
            uint2 ra = make_uint2(0u, 0u), rb2 = make_uint2(0u, 0u);
            if (ia < n) ra = *(const uint2*)(sc + ia);
            if (ib < n) rb2 = *(const uint2*)(sc + ib);
            const unsigned wv[8] = {ra.x & 0xffffu, ra.x >> 16, ra.y & 0xffffu, ra.y >> 16, rb2.x & 0xffffu, rb2.x >> 16, rb2.y & 0xffffu, rb2.y >> 16};
            unsigned smask = 0u, cmask = 0u;
#pragma unroll
            for (int j = 0; j < 8; ++j) {
                const int idx = (j < 4 ? ia : ib) + (j & 3);
                const int b1 = idx < n ? BINF(H2F(wv[j])) : -1;
                smask |= (b1 > B1 ? 1u : 0u) << j; cmask |= (b1 == B1 ? 1u : 0u) << j;
            }
            const int cnt = __popc(smask);
            int inc = cnt;
#pragma unroll
            for (int o = 1; o < 64; o <<= 1) { const int tt = __shfl_up(inc, o); if (lane >= o) inc += tt; }
            int pos = selcnt + inc - cnt;
#pragma unroll
            for (int j = 0; j < 8; ++j) if ((smask >> j) & 1u) { sel[pos] = (unsigned short)((j < 4 ? ia : ib) + (j & 3)); ++pos; }
            selcnt += __shfl(inc, 63);
            if (__ballot(cmask != 0u)) {
#pragma unroll
                for (int j = 0; j < 8; ++j) {
                    const bool isc = (cmask >> j) & 1u;
                    const unsigned long long mc = __ballot(isc);
                    const int cp = candcnt + __popcll(mc & lt);
                    if (isc && cp < 128) cand[cp] = (unsigned short)((j < 4 ? ia : ib) + (j & 3));
                    candcnt += __popcll(mc);
                }
            }
        }
        {
            const int rq = 256 - above1, cq = cnt1, sbase = 256 - rq;
            if (cq <= 128) {
                int taken = 0;
#pragma unroll
                for (int half = 0; half < 2; ++half) {
                    const int i = lane + 64 * half;
                    bool take = false; int myidx = 0;
                    if (i < cq) {
                        myidx = cand[i]; const float mv = (float)sc[myidx];
                        int rank = 0;
                        for (int j = 0; j < cq; ++j) { const int oj = cand[j]; const float ov = (float)sc[oj]; rank += (ov > mv) || (ov == mv && oj < myidx); }
                        take = rank < rq;
                    }
                    const unsigned long long mt = __ballot(take);
                    if (take) sel[sbase + taken + __popcll(mt & lt)] = (unsigned short)myidx;
                    taken += __popcll(mt);
                }
            } else {
                int taken = 0;
                for (int base = 0; base < n && taken < rq; base += 64) {
                    const int idx = base + lane; bool isc = false;
                    if (idx < n) isc = BINF((float)sc[idx]) == B1;
                    const unsigned long long mc = __ballot(isc);
                    const int pos = taken + __popcll(mc & lt);
                    if (isc && pos < rq) sel[sbase + pos] = (unsigned short)idx;
                    taken += __popcll(mc);
                }
            }
        }
#undef BINF
#undef H2F
    } else {
        nsel = n;
#pragma unroll
        for (int i = 0; i < 4; ++i) { const int j = lane + 64 * i; sel[j] = (unsigned short)(j < n ? j : 0); }
    }
    LAS unsigned char* vst = (LAS unsigned char*)wl + W_SC;
    const unsigned rdbase = (unsigned)(uintptr_t)((LAS unsigned char*)wl + W_SC) + (4 * g4 + (col >> 2)) * 256 + (col & 3) * 8;
    {
        bf16x8 qf[4];
        {
            const bf16_t* qp = p.q() + (size_t)row * 512 + (col & 7) * 64 + g4 * 8;
            const bf16x8 q0 = *(const bf16x8*)qp, q1 = *(const bf16x8*)(qp + 32);
            const bool lo_grp = col < 4, hi_grp = col >= 4 && col < 8;
#pragma unroll
            for (int i = 0; i < 8; ++i) { qf[0][i] = lo_grp ? q0[i] : (short)0; qf[1][i] = lo_grp ? q1[i] : (short)0; qf[2][i] = hi_grp ? q0[i] : (short)0; qf[3][i] = hi_grp ? q1[i] : (short)0; }
        }
        const bf16_t* vb = p.v() + (size_t)brow * 128 + (lane & 15) * 8;
#define V_STAGE(s_, buf_) do { _Pragma("unroll") for (int i_ = 0; i_ < 4; ++i_) { \
            const int key_ = sel[(s_) * 16 + i_ * 4 + (lane >> 4)]; \
            __builtin_amdgcn_global_load_lds((const unsigned*)(vb + (size_t)key_ * 128), (LAS unsigned*)(vst + (buf_) * 4096 + i_ * 1024), 16, 0, 0); } } while (0)
        const bf16_t* kg = p.k() + (size_t)brow * 128;
#define K_STAGE(s_, buf_) do { _Pragma("unroll") for (int i_ = 0; i_ < 4; ++i_) { \
            const int kl_ = i_ * 4 + (lane >> 4); const int key_ = sel[(s_) * 16 + kl_]; \
            __builtin_amdgcn_global_load_lds((const unsigned*)(kg + (size_t)key_ * 128 + (((lane & 15) ^ kl_) & 15) * 8), (LAS unsigned*)(vst + (buf_) * 4096 + i_ * 1024), 16, 0, 0); } } while (0)
        f32x4 lg[16];
        K_STAGE(0, 0); K_STAGE(1, 1); K_STAGE(2, 2);
#pragma unroll
        for (int s = 0; s < 16; ++s) {
            if (s + 3 < 16) { K_STAGE(s + 3, (s + 3) & 3); asm volatile("s_waitcnt vmcnt(12)" ::: "memory"); }
            else if (s == 13) asm volatile("s_waitcnt vmcnt(8)" ::: "memory");
            else if (s == 14) asm volatile("s_waitcnt vmcnt(4)" ::: "memory");
            else asm volatile("s_waitcnt vmcnt(0)" ::: "memory");
            bf16x8 kf[4];
#pragma unroll
            for (int ks = 0; ks < 4; ++ks) kf[ks] = *(const LAS bf16x8*)(vst + (s & 3) * 4096 + col * 256 + (((ks * 4 + g4) ^ col) & 15) * 16);
            asm volatile("s_waitcnt lgkmcnt(0)" ::: "memory");
            __builtin_amdgcn_sched_barrier(0);
            f32x4 a = (f32x4){0.f, 0.f, 0.f, 0.f};
#pragma unroll
            for (int ks = 0; ks < 4; ++ks) a = __builtin_amdgcn_mfma_f32_16x16x32_bf16(kf[ks], qf[ks], a, 0, 0, 0);
            lg[s] = a;
        }
#undef K_STAGE
        V_STAGE(0, 0); V_STAGE(1, 1); V_STAGE(2, 2);
        float mxl = -INFINITY;
#pragma unroll
        for (int tt = 0; tt < 16; ++tt)
#pragma unroll
            for (int j = 0; j < 4; ++j) { if (tt * 16 + g4 * 4 + j >= nsel) lg[tt][j] = -INFINITY; mxl = fmaxf(mxl, lg[tt][j]); }
        mxl = fmaxf(mxl, __shfl_xor(mxl, 16)); mxl = fmaxf(mxl, __shfl_xor(mxl, 32));
        float sm = 0.f;
#pragma unroll
        for (int tt = 0; tt < 16; ++tt)
#pragma unroll
            for (int j = 0; j < 4; ++j) { const float e = __builtin_amdgcn_exp2f(lg[tt][j] - mxl); lg[tt][j] = e; sm += e; }
        sm += __shfl_xor(sm, 16); sm += __shfl_xor(sm, 32);
        const float inv = 1.0f / sm;
        f32x4 o[8];
#pragma unroll
        for (int d = 0; d < 8; ++d) o[d] = (f32x4){0.f, 0.f, 0.f, 0.f};
#pragma unroll
        for (int s = 0; s < 16; ++s) {
            if (s + 3 < 16) { V_STAGE(s + 3, (s + 3) & 3); asm volatile("s_waitcnt vmcnt(12)" ::: "memory"); }
            else if (s == 13) asm volatile("s_waitcnt vmcnt(8)" ::: "memory");
            else if (s == 14) asm volatile("s_waitcnt vmcnt(4)" ::: "memory");
            else asm volatile("s_waitcnt vmcnt(0)" ::: "memory");
            const unsigned rb = rdbase + (s & 3) * 4096;
            s16x4 pa;
            {
                const uint32_t w0 = pack2(lg[s][0], lg[s][1]), w1 = pack2(lg[s][2], lg[s][3]);
                pa[0] = (short)(w0 & 0xffff); pa[1] = (short)(w0 >> 16); pa[2] = (short)(w1 & 0xffff); pa[3] = (short)(w1 >> 16);
            }
            const s16x4 v0 = tr_read<0>(rb), v1 = tr_read<32>(rb), v2 = tr_read<64>(rb), v3 = tr_read<96>(rb);
            const s16x4 v4 = tr_read<128>(rb), v5 = tr_read<160>(rb), v6 = tr_read<192>(rb), v7 = tr_read<224>(rb);
            asm volatile("s_waitcnt lgkmcnt(0)" ::: "memory");
            __builtin_amdgcn_sched_barrier(0);
            o[0] = __builtin_amdgcn_mfma_f32_16x16x16bf16_1k(pa, v0, o[0], 0, 0, 0); o[1] = __builtin_amdgcn_mfma_f32_16x16x16bf16_1k(pa, v1, o[1], 0, 0, 0);
            o[2] = __builtin_amdgcn_mfma_f32_16x16x16bf16_1k(pa, v2, o[2], 0, 0, 0); o[3] = __builtin_amdgcn_mfma_f32_16x16x16bf16_1k(pa, v3, o[3], 0, 0, 0);
            o[4] = __builtin_amdgcn_mfma_f32_16x16x16bf16_1k(pa, v4, o[4], 0, 0, 0); o[5] = __builtin_amdgcn_mfma_f32_16x16x16bf16_1k(pa, v5, o[5], 0, 0, 0);
            o[6] = __builtin_amdgcn_mfma_f32_16x16x16bf16_1k(pa, v6, o[6], 0, 0, 0); o[7] = __builtin_amdgcn_mfma_f32_16x16x16bf16_1k(pa, v7, o[7], 0, 0, 0);
        }
#undef V_STAGE
        float ih[4];
#pragma unroll
        for (int jj = 0; jj < 4; ++jj) ih[jj] = __shfl(inv, 4 * (g4 & 1) + jj);
        if (g4 < 2) {
            bf16_t* op = p.att() + (size_t)row * 512 + (g4 * 4) * 64 + col;
#pragma unroll
            for (int d = 0; d < 4; ++d) {
                const f32x4 oa_ = o[d], ob_ = o[4 + d]; f32x4 ov;
#pragma unroll
                for (int kk = 0; kk < 4; ++kk) ov[kk] = g4 == 0 ? oa_[kk] : ob_[kk];
                op[0 * 64 + d * 16] = f2bf(ov[0] * ih[0]); op[1 * 64 + d * 16] = f2bf(ov[1] * ih[1]);
                op[2 * 64 + d * 16] = f2bf(ov[2] * ih[2]); op[3 * 64 + d * 16] = f2bf(ov[3] * ih[3]);
            }
        }
    }
}

constexpr int A8_META = 8 * W_SZ;
static_assert(A8_META + 64 + 512 <= LDS_BYTES - 32, "attn8 meta");
__device__ __forceinline__ void attn8_unit(const P& p, unsigned char* lds, int b, int grp) {
    const int tid = tid_(), lane = tid & 63, wid = __builtin_amdgcn_readfirstlane(tid >> 6);
    const int t0 = NMETA + 8 * grp, brow = b * LP, row0 = brow + t0;
    unsigned* meta = (unsigned*)(lds + A8_META);
    const bool big = t0 + 1 > 256;
    if (tid < 16) meta[tid] = (tid & 1) ? 0u : 0xffffffffu;
    bf16_t* uvec = (bf16_t*)(lds + A8_META + 64);
    if (big && tid < 256) {
        const int q = tid >> 5, d = tid & 31;
        const bf16_t* ip = p.iq() + (size_t)(row0 + q) * 256 + d; const float* wp = p.iw() + (size_t)(row0 + q) * 8;
        float u = 0.f;
#pragma unroll
        for (int h = 0; h < 8; ++h) u += wp[h] * bf2f(ip[h * 32]);
        uvec[q * 32 + d] = f2bf(u);
    }
    for (int i = tid; i < 8 * NBW; i += NTHREADS) ((int*)(lds + (i / NBW) * W_SZ + W_H))[i % NBW] = 0;
    __syncthreads();
    if (big) {
        const int hh = lane >> 5, c32 = lane & 31;
        const int g = c32 >> 3, h2a = (c32 >> 2) & 1, bq = c32 & 3, aq = 2 * h2a + (g >> 1), ah = 4 * (g & 1) + bq;
        bf16x8 a0[2], a1[2]; f32x4 w[2][2][2];
#pragma unroll
        for (int r = 0; r < 2; ++r) {
            const bf16_t* ap = p.iq() + (size_t)(row0 + 4 * r + aq) * 256 + ah * 32 + 8 * hh;
            a0[r] = *(const bf16x8*)ap; a1[r] = *(const bf16x8*)(ap + 16);
#pragma unroll
            for (int qi = 0; qi < 2; ++qi) {
                const float* wp = p.iw() + (size_t)(row0 + 4 * r + 2 * hh + qi) * 8;
                w[r][qi][0] = *(const f32x4*)wp; w[r][qi][1] = *(const f32x4*)(wp + 4);
            }
        }
        bf16x8 au0, au1;
        {
            const int uq = 4 * ((c32 & 3) >> 1) + 2 * ((c32 >> 2) & 1) + (c32 & 1);
            const bf16x8 v0 = *(const bf16x8*)(uvec + uq * 32 + 8 * hh), v1 = *(const bf16x8*)(uvec + uq * 32 + 8 * hh + 16);
#pragma unroll
            for (int i = 0; i < 8; ++i) { au0[i] = c32 < 8 ? v0[i] : (short)0; au1[i] = c32 < 8 ? v1[i] : (short)0; }
        }
        const int ntiles = (t0 + 8 + 31) >> 5;
        float mx[2][2], mn[2][2];
#pragma unroll
        for (int r = 0; r < 2; ++r)
#pragma unroll
            for (int qi = 0; qi < 2; ++qi) { mx[r][qi] = -INFINITY; mn[r][qi] = INFINITY; }
        const bf16_t* kbase = p.ik() + (size_t)brow * 32 + 8 * hh;
        bf16x8 b0[8], b1[8], c0[8], c1[8];
#define S_LOAD(B0, B1, T0) do { _Pragma("unroll") for (int j = 0; j < 8; ++j) { const int tile_ = min((T0) + 8 * j, ntiles - 1); \
            const bf16_t* kp_ = kbase + (size_t)(tile_ * 32 + c32) * 32; B0[j] = *(const bf16x8*)kp_; B1[j] = *(const bf16x8*)(kp_ + 16); } } while (0)
#define S_COMP(B0, B1, T0) do { _Pragma("unroll") for (int j = 0; j < 8; ++j) { const int tile = (T0) + 8 * j; if (tile < ntiles) { const int key = tile * 32 + c32; \
            f32x16 acu; _Pragma("unroll") for (int i = 0; i < 16; ++i) acu[i] = 0.f; \
            acu = __builtin_amdgcn_mfma_f32_32x32x16_bf16(au0, B0[j], acu, 0, 0, 0); acu = __builtin_amdgcn_mfma_f32_32x32x16_bf16(au1, B1[j], acu, 0, 0, 0); \
            _Pragma("unroll") for (int r = 0; r < 2; ++r) { f32x16 acc; _Pragma("unroll") for (int i = 0; i < 16; ++i) acc[i] = 0.f; \
                acc = __builtin_amdgcn_mfma_f32_32x32x16_bf16(a0[r], B0[j], acc, 0, 0, 0); acc = __builtin_amdgcn_mfma_f32_32x32x16_bf16(a1[r], B1[j], acc, 0, 0, 0); \
                _Pragma("unroll") for (int qi = 0; qi < 2; ++qi) { float s = acu[2 * r + qi]; \
                    _Pragma("unroll") for (int i = 0; i < 4; ++i) s += w[r][qi][0][i] * __builtin_fabsf(acc[8 * qi + i]) + w[r][qi][1][i] * __builtin_fabsf(acc[8 * qi + 4 + i]); \
                    const int q = 4 * r + 2 * hh + qi; const _Float16 hs = (_Float16)fminf(fmaxf(s, -60000.f), 60000.f); \
                    ((_Float16*)(lds + q * W_SZ + W_SC))[key] = hs; \
                    if (key <= t0 + q) { const float f = (float)hs; mx[r][qi] = fmaxf(mx[r][qi], f); mn[r][qi] = fminf(mn[r][qi], f); } } } } } } while (0)
        S_LOAD(b0, b1, wid);
        for (int tile0 = wid; tile0 < ntiles; tile0 += 128) {
            if (tile0 + 64 < ntiles) S_LOAD(c0, c1, tile0 + 64);
            __builtin_amdgcn_sched_barrier(0);
            S_COMP(b0, b1, tile0);
            __builtin_amdgcn_sched_barrier(0);
            if (tile0 + 128 < ntiles) S_LOAD(b0, b1, tile0 + 128);
            __builtin_amdgcn_sched_barrier(0);
            if (tile0 + 64 < ntiles) S_COMP(c0, c1, tile0 + 64);
            __builtin_amdgcn_sched_barrier(0);
        }
#undef S_LOAD
#undef S_COMP
#pragma unroll
        for (int r = 0; r < 2; ++r)
#pragma unroll
            for (int qi = 0; qi < 2; ++qi) {
                float a = mx[r][qi], c = mn[r][qi];
#pragma unroll
                for (int o = 16; o >= 1; o >>= 1) { a = fmaxf(a, __shfl_xor(a, o)); c = fminf(c, __shfl_xor(c, o)); }
                if (c32 == 0 && a >= c) { const int q = 4 * r + 2 * hh + qi; atomicMin(&meta[q * 2], skey(c)); atomicMax(&meta[q * 2 + 1], skey(a)); }
            }
    }
    __syncthreads();
    const float mnq = big ? skey_inv(meta[wid * 2]) : 0.f, mxq = big ? skey_inv(meta[wid * 2 + 1]) : 0.f;
    attn_wave(p, lds, wid, lane, b, t0 + wid, mnq, mxq);
    __syncthreads();
}

constexpr int NGRP8 = SEQ / 8, ATT_P1 = NGRP8 / 8, ATT_P2 = NGRP8 / 2;
template <int SUB>
__device__ __forceinline__ void ph_mixer(const P& p, unsigned char* lds) {
    int* bc = (int*)(lds + LDS_BYTES - 16);
    constexpr int nh = SUB == 1 ? 64 : NXU;
    constexpr int a0 = SUB == 0 ? 0 : (SUB == 1 ? ATT_P1 : ATT_P2), a1 = SUB == 0 ? ATT_P1 : (SUB == 1 ? ATT_P2 : NGRP8);
    for (;;) {
        __syncthreads();
        if (tid_() == 0) bc[0] = atomicAdd(&p.ctr()[97 + SUB], 1);
        __syncthreads();
        const int it = bc[0];
        if (it >= nh) break;
        if (SUB == 0) hgx_unit(p, lds, it);
        else if (SUB == 1) hgchain_unit(p, it);
        else hgz_unit(p, lds, it);
    }
    const int b0 = (int)(xb_xcc_id() & 3u);
#pragma unroll 1
    for (int k = 0; k < 4; ++k) {
        const int b = (b0 + k) & 3;
        for (;;) {
            __syncthreads();
            if (tid_() == 0) bc[0] = atomicAdd(&p.ctr()[104 + SUB * 4 + b], 1);
            __syncthreads();
            const int it = bc[0];
            if (it >= a1 - a0) break;
            attn8_unit(p, lds, b, NGRP8 - 1 - (a0 + it));
        }
    }
}

__device__ __forceinline__ int tok_row(int tok) { return (tok >> 13) * LP + NMETA + (tok & 8191); }
__device__ __forceinline__ void ph_mix(const P& p, unsigned char* lds) {
    const int njobs = (NTOK / 256) * 4 * 2, G = gridDim.x, b0 = blockIdx.x;
    auto jobidx = [&](int i) __attribute__((always_inline)) { return (b0 + (i >> 1) * G) * 2 + (i & 1); };
    auto jobfn = [&](int i, GJob& j) __attribute__((always_inline)) -> bool {
        const int jb = jobidx(i); if (jb >= njobs) return false;
        const int which = jb & 1, u = jb >> 1, nt = u & 3, mt = u >> 2; const size_t r0 = (size_t)tok_row(mt * 256);
        j.A = (const char*)((which ? p.hgr() : p.att()) + r0 * 512); j.B = (const char*)((which ? p.wuhT() : p.wuaT()) + (size_t)nt * 256 * 512); return true; };
    auto epi = [&](f32x4 (&acc)[2][2][4][2], int i) __attribute__((always_inline)) {
        const int jb = jobidx(i), which = jb & 1, u = jb >> 1, nt = u & 3, mt = u >> 2; const size_t r0 = (size_t)tok_row(mt * 256);
        if (which == 0) {
            EPI8(
                const size_t og = (r0 + row) * 1024 + nt * 256 + col, om = (size_t)(mt * 256 + row) * 1024 + nt * 256 + col;
                const uint2 g = *(const uint2*)(p.ga() + og);
                f32x4 r;
                r[0] = v[0] * __uint_as_float(g.x << 16); r[1] = v[1] * __uint_as_float(g.x & 0xffff0000u);
                r[2] = v[2] * __uint_as_float(g.y << 16); r[3] = v[3] * __uint_as_float(g.y & 0xffff0000u);
                st_bf4(p.mix() + om, r);
            );
        } else {
            EPI8(
                const size_t og = (r0 + row) * 1024 + nt * 256 + col, om = (size_t)(mt * 256 + row) * 1024 + nt * 256 + col;
                const uint2 g = *(const uint2*)(p.gh() + og);
                const uint2 a = *(const uint2*)(p.mix() + om);
                f32x4 r;
                r[0] = __uint_as_float(a.x << 16) + v[0] * __uint_as_float(g.x << 16); r[1] = __uint_as_float(a.x & 0xffff0000u) + v[1] * __uint_as_float(g.x & 0xffff0000u);
                r[2] = __uint_as_float(a.y << 16) + v[2] * __uint_as_float(g.y << 16); r[3] = __uint_as_float(a.y & 0xffff0000u) + v[3] * __uint_as_float(g.y & 0xffff0000u);
                st_bf4(p.mix() + om, r);
            );
        }
    };
    unsigned vbU[2]; gj_lin2(vbU, 512);
    gemm_stream<false>(lds, 512, 512, (size_t)128 * 512 * 2, vbU, jobfn, epi);
}

__device__ __forceinline__ void ph_out(const P& p, unsigned char* lds) {
    const int nunits = (NTOK / 256) * 4, G = gridDim.x, b0 = blockIdx.x;
    auto jobfn = [&](int i, GJob& j) __attribute__((always_inline)) -> bool {
        const int u = b0 + i * G; if (u >= nunits) return false;
        const int nt = u & 3, mt = u >> 2;
        j.A = (const char*)(p.mix() + (size_t)mt * 256 * D); j.B = (const char*)(p.woT() + (size_t)nt * 256 * D); return true; };
    auto epi = [&](f32x4 (&acc)[2][2][4][2], int i) __attribute__((always_inline)) {
        const int u = b0 + i * G, nt = u & 3, mt = u >> 2;
        EPI8(
            const size_t o = (size_t)(mt * 256 + row) * D + nt * 256 + col;
            const f32x4 h0 = *(const f32x4*)(p.x + o);
            *(f32x4*)(p.out + o) = h0 + v;
        );
    };
    unsigned vbU[2]; gj_lin2(vbU, D);
    gemm_stream<false>(lds, D, D, (size_t)128 * D * 2, vbU, jobfn, epi);
}

constexpr int XS_LD = 1025;
__device__ __forceinline__ void ph_route(const P& p, unsigned char* lds) {
    const int tid = tid_(), lane = tid & 63, wid = __builtin_amdgcn_readfirstlane(tid >> 6);
    const int gt = blockIdx.x * NTHREADS + tid, ntot = gridDim.x * NTHREADS;
    for (int i = gt; i < CAP; i += ntot) { p.slot_token()[i] = -1; p.slot_info()[i] = make_int2(-1, 0); }
    float* xs = (float*)lds;
    int* lhist = (int*)(lds + 32 * XS_LD * 4);
    for (int tb = blockIdx.x; tb < NTOK / 128; tb += gridDim.x) {
        if (tid < 32) lhist[tid] = 0;
        for (int tile = 0; tile < 4; ++tile) {
            const int tokt = tb * 128 + tile * 32;
            __syncthreads();
#pragma unroll
            for (int t = 0; t < 4; ++t) {
                const int tl = wid * 4 + t, tok = tokt + tl;
                const float* src = p.out + (size_t)tok * D;
                f32x4 v[4]; float ss = 0.f;
#pragma unroll
                for (int i = 0; i < 4; ++i) { v[i] = *(const f32x4*)(src + lane * 4 + 256 * i); ss += v[i][0] * v[i][0] + v[i][1] * v[i][1] + v[i][2] * v[i][2] + v[i][3] * v[i][3]; }
                ss = wave_sum(ss);
                const float rs = rsqrtf(ss * (1.0f / D) + EPS);
#pragma unroll
                for (int i = 0; i < 4; ++i) {
                    const f32x4 g = *(const f32x4*)(p.ffn_g + lane * 4 + 256 * i);
                    f32x4 xn; xn[0] = v[i][0] * rs * g[0]; xn[1] = v[i][1] * rs * g[1]; xn[2] = v[i][2] * rs * g[2]; xn[3] = v[i][3] * rs * g[3];
                    st_bf4(p.xn2() + (size_t)tok * D + lane * 4 + 256 * i, xn);
#pragma unroll
                    for (int c = 0; c < 4; ++c) xs[tl * XS_LD + lane * 4 + 256 * i + c] = xn[c];
                }
            }
            __syncthreads();
            f32x16 acc;
#pragma unroll
            for (int i = 0; i < 16; ++i) acc[i] = 0.f;
            {
                const float* xr = xs + (lane & 31) * XS_LD + wid * 128 + (lane >> 5);
                const float* wp = p.router_w + (size_t)(wid * 128 + (lane >> 5)) * 32 + (lane & 31);
#pragma unroll 16
                for (int i = 0; i < 64; ++i) acc = __builtin_amdgcn_mfma_f32_32x32x2f32(xr[2 * i], wp[(size_t)(2 * i) * 32], acc, 0, 0, 0);
            }
            __syncthreads();
#pragma unroll
            for (int r = 0; r < 16; ++r) xs[wid * 1024 + ((r & 3) + 8 * (r >> 2) + 4 * (lane >> 5)) * 32 + (lane & 31)] = acc[r];
            __syncthreads();
            const int e = lane & 31, hh = lane >> 5;
            const float be = p.router_b[e];
#pragma unroll
            for (int it = 0; it < 2; ++it) {
                const int tl = wid * 4 + it * 2 + hh;
                float l = be;
#pragma unroll
                for (int w = 0; w < 8; ++w) l += xs[w * 1024 + tl * 32 + e];
                float bv[4]; int bi[4];
#pragma unroll
                for (int k = 0; k < 4; ++k) {
                    float m = l;
#pragma unroll
                    for (int o = 16; o >= 1; o >>= 1) m = fmaxf(m, __shfl_xor(m, o));
                    const unsigned long long bal = __ballot(l == m);
                    const unsigned half = hh ? (unsigned)(bal >> 32) : (unsigned)bal;
                    const int idx = __builtin_ctz(half);
                    bv[k] = m; bi[k] = idx;
                    if (e == idx) l = -INFINITY;
                }
                const float e1 = __expf(bv[1] - bv[0]), e2 = __expf(bv[2] - bv[0]), e3 = __expf(bv[3] - bv[0]);
                const float inv = 1.0f / (1.0f + e1 + e2 + e3);
                if (e == 0) {
                    const int tok = tokt + tl;
                    p.tok_exp()[tok * 4 + 0] = bi[0]; p.tok_exp()[tok * 4 + 1] = bi[1]; p.tok_exp()[tok * 4 + 2] = bi[2]; p.tok_exp()[tok * 4 + 3] = bi[3];
                    p.tok_gate()[tok * 4 + 0] = inv; p.tok_gate()[tok * 4 + 1] = e1 * inv; p.tok_gate()[tok * 4 + 2] = e2 * inv; p.tok_gate()[tok * 4 + 3] = e3 * inv;
                    atomicAdd(&lhist[bi[0]], 1); atomicAdd(&lhist[bi[1]], 1); atomicAdd(&lhist[bi[2]], 1); atomicAdd(&lhist[bi[3]], 1);
                }
            }
        }
        __syncthreads();
        if (tid < 32) p.wg_cnt()[tb * 32 + tid] = lhist[tid];
        __syncthreads();
    }
    for (long task = gt; task < 96L * 16384; task += ntot) {
        const int mat = (int)(task >> 14), r = (int)(task & 16383), kq = r >> 10, n = r & 1023;
        const int which = mat >> 5, e = mat & 31;
        const float* W = (which == 0 ? p.w_gate : which == 1 ? p.w_up : p.w_down) + (size_t)e * 1048576 + (size_t)(kq * 64) * 1024 + n;
        bf16_t* outp = (which == 0 ? p.wgT() : which == 1 ? p.wuT() : p.wdT()) + (size_t)e * 1048576 + (size_t)n * 1024 + kq * 64;
        float v[64];
#pragma unroll
        for (int i = 0; i < 64; ++i) v[i] = W[(size_t)i * 1024];
        uint4* dst = (uint4*)outp;
#pragma unroll
        for (int i = 0; i < 8; ++i) dst[i] = make_uint4(pack2(v[8 * i], v[8 * i + 1]), pack2(v[8 * i + 2], v[8 * i + 3]), pack2(v[8 * i + 4], v[8 * i + 5]), pack2(v[8 * i + 6], v[8 * i + 7]));
    }
}

__device__ __forceinline__ void ph_fill(const P& p, unsigned char* lds) {
    const int tid = tid_();
    int* tot = (int*)lds;
    int* pre = tot + 512;
    int* ps = pre + 512;
    int* lc = ps + 32;
    for (int tb = blockIdx.x; tb < NTOK / 128; tb += gridDim.x) {
        {
            const int e = tid & 31, part = tid >> 5;
            int t = 0, q = 0;
            for (int b2 = part; b2 < NTOK / 128; b2 += 16) { const int c = p.wg_cnt()[b2 * 32 + e]; t += c; if (b2 < tb) q += c; }
            tot[part * 32 + e] = t; pre[part * 32 + e] = q;
        }
        __syncthreads();
        if (tid == 0) {
            int acc = 0;
            for (int e = 0; e < NE; ++e) {
                int t = 0, q = 0;
                for (int i = 0; i < 16; ++i) { t += tot[i * 32 + e]; q += pre[i * 32 + e]; }
                ps[e] = acc + q; lc[e] = 0;
                const int nb = (t + 255) >> 8;
                if (tb == 0) for (int i = 0; i < nb; ++i) p.block_expert()[(acc >> 8) + i] = e;
                acc += nb * 256;
            }
            if (tb == 0) p.ctr()[96] = acc >> 8;
        }
        __syncthreads();
        {
            const int i = tb * 512 + tid;
            const int e = p.tok_exp()[i];
            const int dest = ps[e] + atomicAdd(&lc[e], 1);
            p.slot_token()[dest] = i >> 2;
            p.slot_rank()[dest] = i & 3;
            p.slot_gate()[dest] = p.tok_gate()[i];
            p.slot_info()[dest] = make_int2((i >> 2) | ((i & 3) << 16), __float_as_int(p.tok_gate()[i]));
        }
        __syncthreads();
    }
}

struct GUOff { __device__ __forceinline__ size_t operator()(int R) const { return (size_t)(R >> 7) * (WE_B / 2) + (size_t)(R & 127) * 1024; } };
struct GatherOff { const int* st; __device__ __forceinline__ size_t operator()(int R) const { const int t = st[R]; return (size_t)(t < 0 ? 0 : t) * 1024; } };
__device__ __forceinline__ void ph_moe1(const P& p, unsigned char* lds) {
    const int nunits = p.ctr()[96] * 8, G = gridDim.x, b0 = blockIdx.x;
    auto jobfn = [&](int i, GJob& j) __attribute__((always_inline)) -> bool {
        const int u = b0 + i * G; if (u >= nunits) return false;
        const int ct = u & 7, rb = u >> 3, e = p.block_expert()[rb];
        j.A = (const char*)p.xn2(); j.B = (const char*)(p.wgT() + (size_t)e * 1048576 + (size_t)ct * 128 * 1024); gj_gather_job(j, GatherOff{p.slot_token() + rb * 256}); return true; };
    auto epi = [&](f32x4 (&acc)[2][2][4][2], int i) __attribute__((always_inline)) {
        const int u = b0 + i * G, ct = u & 7, rb = u >> 3, e = p.block_expert()[rb];
        const int tid_e = tid_(), lane_e = tid_e & 63, wid_e = tid_e >> 6, wr = wid_e >> 2, wc = wid_e & 3, fr = lane_e & 15, fq = lane_e >> 4;
#pragma unroll
        for (int n = 0; n < 2; ++n) {
            const int c = ct * 128 + wc * 32 + n * 16 + fq * 4;
            const f32x4 bg = *(const f32x4*)(p.b_gate + (size_t)e * DFF + c), bu = *(const f32x4*)(p.b_up + (size_t)e * DFF + c);
#pragma unroll
            for (int ai = 0; ai < 2; ++ai)
#pragma unroll
                for (int m = 0; m < 4; ++m) {
                    const int row = rb * 256 + ai * 128 + wr * 64 + m * 16 + fr;
                    f32x4 a;
#pragma unroll
                    for (int j = 0; j < 4; ++j) {
                        const float g = fminf(acc[ai][0][m][n][j] + bg[j], 7.0f);
                        const float uu = fminf(fmaxf(acc[ai][1][m][n][j] + bu[j], -7.0f), 7.0f);
                        a[j] = (uu + 1.0f) * (g * sigmoidf_(1.702f * g));
                    }
                    st_bf4(p.act() + (size_t)row * DFF + c, a);
                }
        }
    };
    unsigned vbU[2]; gj_lin2(vbU, D);
    gemm_stream<true>(lds, D, D, (size_t)WE_B, vbU, jobfn, epi);
}
__device__ __forceinline__ void ph_moe2(const P& p, unsigned char* lds) {
    const int nunits = p.ctr()[96] * 4, G = gridDim.x, b0 = blockIdx.x;
    auto jobfn = [&](int i, GJob& j) __attribute__((always_inline)) -> bool {
        const int u = b0 + i * G; if (u >= nunits) return false;
        const int nt = u & 3, rb = u >> 2, e = p.block_expert()[rb];
        j.A = (const char*)(p.act() + (size_t)rb * 256 * DFF); j.B = (const char*)(p.wdT() + (size_t)e * 1048576 + (size_t)nt * 256 * DFF); return true; };
    auto epi = [&](f32x4 (&acc)[2][2][4][2], int i) __attribute__((always_inline)) {
        const int u = b0 + i * G, nt = u & 3, rb = u >> 2, e = p.block_expert()[rb];
        const int tid_e = tid_(), lane_e = tid_e & 63, wid_e = tid_e >> 6, wr = wid_e >> 2, wc = wid_e & 3, fr = lane_e & 15, fq = lane_e >> 4;
        f32x4 bd[2][2];
#pragma unroll
        for (int bj = 0; bj < 2; ++bj)
#pragma unroll
            for (int n = 0; n < 2; ++n) bd[bj][n] = *(const f32x4*)(p.b_down + (size_t)e * D + nt * 256 + bj * 128 + wc * 32 + n * 16 + fq * 4);
        int2 info[2][4];
#pragma unroll
        for (int ai = 0; ai < 2; ++ai)
#pragma unroll
            for (int m = 0; m < 4; ++m) info[ai][m] = p.slot_info()[rb * 256 + ai * 128 + wr * 64 + m * 16 + fr];
#pragma unroll
        for (int ai = 0; ai < 2; ++ai)
#pragma unroll
        for (int mp = 0; mp < 2; ++mp) {
            f32x4 old[2][2][2];
#pragma unroll
            for (int mm = 0; mm < 2; ++mm) {
                const int ix = info[ai][mp * 2 + mm].x;
                const size_t o = (size_t)(ix & 0xffff) * D + nt * 256 + wc * 32 + fq * 4;
#pragma unroll
                for (int bj = 0; bj < 2; ++bj)
#pragma unroll
                    for (int n = 0; n < 2; ++n) old[mm][bj][n] = (ix >= 0 && (ix >> 16) == 0) ? *(const f32x4*)(p.out + o + bj * 128 + n * 16) : (f32x4){0.f, 0.f, 0.f, 0.f};
            }
#pragma unroll
            for (int mm = 0; mm < 2; ++mm) {
                const int m = mp * 2 + mm;
                const int ix = info[ai][m].x;
                if (ix < 0) continue;
                const int rank = ix >> 16; const float gate = __int_as_float(info[ai][m].y);
                const size_t o = (size_t)(ix & 0xffff) * D + nt * 256 + wc * 32 + fq * 4;
                if (rank == 0) {
#pragma unroll
                    for (int bj = 0; bj < 2; ++bj)
#pragma unroll
                        for (int n = 0; n < 2; ++n) *(f32x4*)(p.out + o + bj * 128 + n * 16) = old[mm][bj][n] + (acc[ai][bj][m][n] + bd[bj][n]) * gate;
                } else {
                    bf16_t* yb = rank == 1 ? p.y1() : (rank == 2 ? p.y2() : p.y3());
#pragma unroll
                    for (int bj = 0; bj < 2; ++bj)
#pragma unroll
                        for (int n = 0; n < 2; ++n) st_bf4(yb + o + bj * 128 + n * 16, (acc[ai][bj][m][n] + bd[bj][n]) * gate);
                }
            }
        }
    };
    unsigned vbU[2]; gj_lin2(vbU, DFF);
    gemm_stream<false>(lds, DFF, DFF, (size_t)128 * DFF * 2, vbU, jobfn, epi);
}

__device__ __forceinline__ void ph_final(const P& p, unsigned char* lds) {
    const int tid = tid_(), lane = tid & 63, wid = tid >> 6;
    const int gw = blockIdx.x * 8 + wid, nw = gridDim.x * 8;
    for (int tok = gw; tok < NTOK; tok += nw) {
        float* dst = p.out + (size_t)tok * D;
        f32x4 v[4];
#pragma unroll
        for (int i = 0; i < 4; ++i) v[i] = *(const f32x4*)(dst + lane * 4 + 256 * i);
#pragma unroll
        for (int j = 0; j < 3; ++j) {
            const bf16_t* yr = (j == 0 ? p.y1() : j == 1 ? p.y2() : p.y3()) + (size_t)tok * D;
#pragma unroll
            for (int i = 0; i < 4; ++i) {
                const uint2 w = *(const uint2*)(yr + lane * 4 + 256 * i);
                v[i][0] += __uint_as_float(w.x << 16); v[i][1] += __uint_as_float(w.x & 0xffff0000u);
                v[i][2] += __uint_as_float(w.y << 16); v[i][3] += __uint_as_float(w.y & 0xffff0000u);
            }
        }
        float ss = 0.f;
#pragma unroll
        for (int i = 0; i < 4; ++i) ss += v[i][0] * v[i][0] + v[i][1] * v[i][1] + v[i][2] * v[i][2] + v[i][3] * v[i][3];
        ss = wave_sum(ss);
        const float rs = rsqrtf(ss * (1.0f / D) + EPS);
#pragma unroll
        for (int i = 0; i < 4; ++i) {
            const f32x4 g = *(const f32x4*)(p.final_g + lane * 4 + 256 * i);
            *(f32x4*)(dst + lane * 4 + 256 * i) = v[i] * rs * g;
        }
    }
}

typedef const __attribute__((address_space(4))) P* PK;
#define PHASE(call) do { PK q_ = pk; asm volatile("" : "+s"(q_)); const P& p = *(const P*)q_; call; } while (0)
__global__ void __launch_bounds__(NTHREADS) k_mega(P p_unused) {
    __shared__ __attribute__((aligned(16))) unsigned char lds[LDS_BYTES];
    cg::grid_group grid = cg::this_grid();
    const PK pk = (PK)__builtin_amdgcn_kernarg_segment_ptr();
    if (tid_() < 4) ((unsigned*)(lds + LDS_BYTES - 32))[tid_()] = 0u;
    __syncthreads();
    XcdBarrier xb;
    PHASE(xb = xcd_barrier_post((unsigned*)(p.ws + OFF_BAR), (volatile LAS unsigned*)(lds + LDS_BYTES - 32)));
    PHASE(if (p.ws == nullptr) grid.sync());
    PHASE(ph_prep(p, lds)); xcd_barrier(xb);
    PHASE(ph_inproj(p, lds)); xcd_barrier(xb);
    PHASE(ph_mixer<0>(p, lds)); xcd_barrier(xb);
    PHASE(ph_mixer<1>(p, lds)); xcd_barrier(xb);
    PHASE(ph_mixer<2>(p, lds)); xcd_barrier(xb);
    PHASE(ph_mix(p, lds)); xcd_barrier(xb);
    PHASE(ph_out(p, lds)); xcd_barrier(xb);
    PHASE(ph_route(p, lds)); xcd_barrier(xb);
    PHASE(ph_fill(p, lds)); xcd_barrier(xb);
    PHASE(ph_moe1(p, lds)); xcd_barrier(xb);
    PHASE(ph_moe2(p, lds)); xcd_barrier(xb);
    PHASE(ph_final(p, lds));
}

extern "C" void kernel_launch(void* const* d_in, const int* in_sizes, int n_in, void* d_out, int out_size, void* d_ws, size_t ws_size,
                              hipStream_t stream) {
    P p{};
    p.x = (const float*)d_in[0]; p.meta = (const float*)d_in[1]; p.attn_g = (const float*)d_in[2]; p.w_in = (const float*)d_in[3];
    p.hgrn_g = (const float*)d_in[4]; p.w_ua = (const float*)d_in[5]; p.w_uh = (const float*)d_in[6]; p.w_out = (const float*)d_in[7];
    p.lb_logits = (const float*)d_in[8]; p.ffn_g = (const float*)d_in[9]; p.router_w = (const float*)d_in[10]; p.router_b = (const float*)d_in[11];
    p.w_gate = (const float*)d_in[12]; p.b_gate = (const float*)d_in[13]; p.w_up = (const float*)d_in[14]; p.b_up = (const float*)d_in[15];
    p.w_down = (const float*)d_in[16]; p.b_down = (const float*)d_in[17]; p.final_g = (const float*)d_in[18];
    p.out = (float*)d_out;
    p.ws = (unsigned char*)d_ws;
    if (WS_NEED > ws_size) { fprintf(stderr, "workspace too small: need %zu have %zu\n", (size_t)WS_NEED, ws_size); return; }
    static int grid_blocks = 0;
    if (!grid_blocks) {
        int dev = 0, cus = 0, per_cu = 0;
        hipGetDevice(&dev);
        hipDeviceGetAttribute(&cus, hipDeviceAttributeMultiprocessorCount, dev);
        hipOccupancyMaxActiveBlocksPerMultiprocessor(&per_cu, k_mega, NTHREADS, 0);
        if (per_cu > 1) per_cu = 1;
        grid_blocks = cus * per_cu;
    }
    hipMemsetAsync(p.ws + OFF_BAR, 0, XCD_BAR_WORDS * 4, stream);
    void* args[] = {&p};
    hipError_t e = hipLaunchCooperativeKernel((void*)k_mega, dim3(grid_blocks), dim3(NTHREADS), args, 0, stream);
    if (e != hipSuccess) fprintf(stderr, "cooperative launch failed: %s (grid %d)\n", hipGetErrorString(e), grid_blocks);
}
```

```cpp
#include <hip/hip_runtime.h>
#include <hip/hip_cooperative_groups.h>
#include <stdint.h>
#include <cstdio>
namespace cg = cooperative_groups;

#ifndef MEGA
#define MEGA 1
#endif

typedef unsigned short bf16_t;
typedef short bf16x8 __attribute__((ext_vector_type(8)));
typedef float f32x4 __attribute__((ext_vector_type(4)));

constexpr int D = 1024, NB = 4, SEQ = 8192, NMETA = 16, L = SEQ + NMETA  , LP = 8320, T = NB * LP  ;
constexpr int NTOK = NB * SEQ;
constexpr int IN_COLS = 5160;
constexpr int NE = 32, TOPK = 4, DFF = 1024;
constexpr int CAP_BLOCKS = (NTOK * TOPK) / 256 + NE;
constexpr int CAP = CAP_BLOCKS * 256;
constexpr float EPS = 1e-5f;
constexpr int NTHREADS = 512;
constexpr int LDS_BYTES = 155648;
constexpr int NVC = 5376;
#define LAS __attribute__((address_space(3)))

__device__ __forceinline__ bf16_t f2bf(float f) {
    uint32_t u = __float_as_uint(f);
    u += 0x7fffu + ((u >> 16) & 1u);
    return (bf16_t)(u >> 16);
}
__device__ __forceinline__ float bf2f(bf16_t h) { return __uint_as_float(((uint32_t)h) << 16); }
__device__ __forceinline__ uint32_t pack2(float a, float b) { return (uint32_t)f2bf(a) | ((uint32_t)f2bf(b) << 16); }
__device__ __forceinline__ uint32_t pk4_fp8(float a, float b, float c, float d) {
    a = fminf(fmaxf(a, -448.f), 448.f); b = fminf(fmaxf(b, -448.f), 448.f); c = fminf(fmaxf(c, -448.f), 448.f); d = fminf(fmaxf(d, -448.f), 448.f);
    int w = __builtin_amdgcn_cvt_pk_fp8_f32(a, b, 0, false); w = __builtin_amdgcn_cvt_pk_fp8_f32(c, d, w, true); return (uint32_t)w;
}
__device__ __forceinline__ float sigmoidf_(float x) { return __builtin_amdgcn_rcpf(1.0f + __builtin_amdgcn_exp2f(-1.4426950408889634f * x)); }
__device__ __forceinline__ float wave_sum(float v) {
#pragma unroll
    for (int o = 32; o >= 1; o >>= 1) v += __shfl_xor(v, o);
    return v;
}
__device__ __forceinline__ float wave_max(float v) {
#pragma unroll
    for (int o = 32; o >= 1; o >>= 1) v = fmaxf(v, __shfl_xor(v, o));
    return v;
}

constexpr size_t al256(size_t x) { return (x + 255) & ~(size_t)255; }
constexpr size_t TT = (size_t)T;
constexpr size_t MB1 = 1024 * 1024;
constexpr size_t WE8_B = (size_t)NE * 1024 * 1024;
constexpr size_t OFF_WGT = 0, OFF_WUT = WE8_B, OFF_WDT = 2 * WE8_B, OFF_XN2 = 3 * WE8_B, OFF_ACT = OFF_XN2 + (size_t)NTOK * D,
                 OFF_Y1 = OFF_ACT + (size_t)CAP * DFF, OFF_Y2 = OFF_Y1 + (size_t)NTOK * D * 2, OFF_Y3 = OFF_Y2 + (size_t)NTOK * D * 2,
                 OFF_S2_END = OFF_Y3 + (size_t)NTOK * D * 2;
constexpr size_t OFF_WIN = 0, OFF_WUA = OFF_WIN + (size_t)NVC * 1024 * 2, OFF_WUH = OFF_WUA + MB1, OFF_WO = OFF_WUH + MB1, OFF_XN = OFF_WO + 2 * MB1,
                 OFF_Q = OFF_XN + TT * 2048, OFF_K = OFF_Q + TT * 1024, OFF_V = OFF_K + TT * 256, OFF_IQ = OFF_V + TT * 256, OFF_IK = OFF_IQ + TT * 512,
                 OFF_IW = OFF_IK + TT * 64, OFF_HQ = OFF_IW + TT * 32, OFF_HF = OFF_HQ + TT * 1024, OFF_HI = OFF_HF + TT * 1024, OFF_HG = OFF_HI + TT * 1024,
                 OFF_GA = OFF_HG + TT * 1024, OFF_GH = OFF_GA + TT * 2048, OFF_ATT = OFF_GH + TT * 2048, OFF_HGR = OFF_ATT + TT * 1024,
                 OFF_S1_END = OFF_HGR + TT * 1024;
constexpr size_t OFF_MIX = OFF_XN;
constexpr size_t OFF_TAB = OFF_S1_END > OFF_S2_END ? OFF_S1_END : OFF_S2_END;
constexpr size_t OFF_ROPE = OFF_TAB, OFF_LB = OFF_ROPE + al256((size_t)LP * 24 * 4), OFF_CTR = OFF_LB + al256(512 * 4),
                 OFF_BEXP = OFF_CTR + al256(128 * 4), OFF_SLOT = OFF_BEXP + al256((size_t)CAP_BLOCKS * 4), OFF_SRANK = OFF_SLOT + al256((size_t)CAP * 4),
                 OFF_SGATE = OFF_SRANK + al256((size_t)CAP * 4), OFF_TEXP = OFF_SGATE + al256((size_t)CAP * 4), OFF_TGATE = OFF_TEXP + al256((size_t)NTOK * 16),
                 OFF_BAR = OFF_TGATE + al256((size_t)NTOK * 16), OFF_WGC = OFF_BAR + al256(3456 * 4), OFF_SINFO = OFF_WGC + al256(256 * 32 * 4), WS_NEED = OFF_SINFO + al256((size_t)CAP * 8);


__device__ __forceinline__ int tid_() { int t = threadIdx.x; asm volatile("" : "+v"(t)); return t; }

struct P {
    const float *x, *meta, *attn_g, *w_in, *hgrn_g, *w_ua, *w_uh, *w_out, *lb_logits, *ffn_g, *router_w, *router_b,
        *w_gate, *b_gate, *w_up, *b_up, *w_down, *b_down, *final_g;
    float* out;
    unsigned char* ws;
#define WSF(type, name, off) __device__ __forceinline__ type* name() const { return (type*)(ws + (off)); }
    WSF(bf16_t, xn, OFF_XN) WSF(bf16_t, q, OFF_Q) WSF(bf16_t, k, OFF_K) WSF(bf16_t, v, OFF_V) WSF(bf16_t, iq, OFF_IQ) WSF(bf16_t, ik, OFF_IK)
    WSF(bf16_t, hq, OFF_HQ) WSF(bf16_t, hf, OFF_HF) WSF(bf16_t, hi, OFF_HI) WSF(bf16_t, hg, OFF_HG) WSF(bf16_t, ga, OFF_GA) WSF(bf16_t, gh, OFF_GH)
    WSF(bf16_t, att, OFF_ATT) WSF(bf16_t, hgr, OFF_HGR) WSF(bf16_t, mix, OFF_MIX) WSF(unsigned char, xn2, OFF_XN2) WSF(unsigned char, act, OFF_ACT)
    WSF(bf16_t, y1, OFF_Y1) WSF(bf16_t, y2, OFF_Y2) WSF(bf16_t, y3, OFF_Y3)
    WSF(bf16_t, winT, OFF_WIN) WSF(bf16_t, wuaT, OFF_WUA) WSF(bf16_t, wuhT, OFF_WUH) WSF(bf16_t, woT, OFF_WO)
    WSF(unsigned char, wgT, OFF_WGT) WSF(unsigned char, wuT, OFF_WUT) WSF(unsigned char, wdT, OFF_WDT)
    WSF(float, iw, OFF_IW) WSF(float, rope, OFF_ROPE) WSF(float, lb, OFF_LB) WSF(float, tok_gate, OFF_TGATE) WSF(float, slot_gate, OFF_SGATE)
    WSF(int, ctr, OFF_CTR)
    WSF(int, wg_cnt, OFF_WGC) WSF(int2, slot_info, OFF_SINFO) WSF(int, block_expert, OFF_BEXP) WSF(int, slot_token, OFF_SLOT) WSF(int, slot_rank, OFF_SRANK) WSF(int, tok_exp, OFF_TEXP)
};

template <class ColMap>
__device__ __forceinline__ void convert_T(const float* W, int ldw, bf16_t* out, int K, int N, const ColMap& cmap, int gt, int ntot) {
    const int kb = K / 64; const long ntask = (long)N * kb;
    for (long task = gt; task < ntask; task += ntot) {
        const int kq = (int)(task / N), n = (int)(task % N);
        const int c = cmap(n);
        uint32_t w[32];
        if (c >= 0) {
            const float* src = W + (size_t)(kq * 64) * ldw + c;
            float v[64];
#pragma unroll
            for (int i = 0; i < 64; ++i) v[i] = src[(size_t)i * ldw];
#pragma unroll
            for (int i = 0; i < 32; ++i) w[i] = pack2(v[2 * i], v[2 * i + 1]);
        } else {
#pragma unroll
            for (int i = 0; i < 32; ++i) w[i] = 0u;
        }
        uint4* dst = (uint4*)(out + (size_t)n * K + kq * 64);
#pragma unroll
        for (int i = 0; i < 8; ++i) dst[i] = make_uint4(w[4 * i], w[4 * i + 1], w[4 * i + 2], w[4 * i + 3]);
    }
}
struct IdMap { __device__ __forceinline__ int operator()(int n) const { return n; } };
struct WinMap { __device__ __forceinline__ int operator()(int n) const { return n < 1064 ? n : (n < 1280 ? -1 : n - 216); } };

#define XB_TMO      128
#define XB_XCNT(j)  (256  + 64 * (j))
#define XB_XSUB(j)  (1280 + 64 * (j))
#define XB_XGEN(j)  (2304 + 64 * (j))
#define XB_TOP      3328
#define XB_TOPGEN   3392
#define XCD_BAR_WORDS 3456
#define XB_SPIN_CAP (1u << 22)
__device__ __forceinline__ unsigned xb_ld(unsigned* p)              { return __hip_atomic_load(p, __ATOMIC_RELAXED, __HIP_MEMORY_SCOPE_AGENT); }
__device__ __forceinline__ unsigned xb_add(unsigned* p, unsigned v) { return __hip_atomic_fetch_add(p, v, __ATOMIC_RELAXED, __HIP_MEMORY_SCOPE_AGENT); }
__device__ __forceinline__ unsigned xb_xcc_id() { return (unsigned)__builtin_amdgcn_s_getreg((3 << 11) | 20) & 0xFu; }
#define XB_SPIN(cond, bar) do { unsigned _sp = 0; while (cond) { __builtin_amdgcn_s_sleep(1); \
    if ((++_sp & 255u) == 0u) { if (xb_ld(&(bar)[XB_TMO])) break; if (_sp > XB_SPIN_CAP) { atomicAdd(&(bar)[XB_TMO], 1u); break; } } } } while (0)
struct XcdBarrier { unsigned* bar; unsigned x; volatile LAS unsigned* st; };
__device__ __forceinline__ XcdBarrier xcd_barrier_post(unsigned* bar, volatile LAS unsigned* st) {
    XcdBarrier b; b.bar = bar; b.x = xb_xcc_id(); b.st = st;
    if (threadIdx.x == 0) (void)xb_add(&bar[XB_XCNT(b.x)], 1u);
    return b;
}
__device__ __forceinline__ void xcd_barrier_complete(unsigned* bar, unsigned x, unsigned& nloc, unsigned& nx) {
    const unsigned G = gridDim.x * gridDim.y * gridDim.z;
    unsigned sum, cnt, mine, sp = 0u;
    for (;;) {
        sum = 0u; cnt = 0u; mine = 0u;
#pragma unroll
        for (unsigned j = 0; j < 16; ++j) { const unsigned c = xb_ld(&bar[XB_XCNT(j)]); sum += c; cnt += (c > 0u) ? 1u : 0u; mine = (j == x) ? c : mine; }
        if (sum == G) break;
        __builtin_amdgcn_s_sleep(1);
        if ((++sp & 255u) == 0u) { if (xb_ld(&bar[XB_TMO])) break; if (sp > XB_SPIN_CAP) { atomicAdd(&bar[XB_TMO], 1u); break; } }
    }
    nloc = mine > 0u ? mine : 1u; nx = cnt > 0u ? cnt : 1u;
}
__device__ __forceinline__ void xcd_barrier(const XcdBarrier& b) {
    asm volatile("s_waitcnt vmcnt(0)" ::: "memory");
    __syncthreads();
    if (threadIdx.x == 0) {
        unsigned* bar = b.bar;
        __builtin_amdgcn_s_waitcnt(0);
        unsigned nloc = b.st[0], nx = b.st[1];
        if (nloc == 0u) { xcd_barrier_complete(bar, b.x, nloc, nx); b.st[0] = nloc; b.st[1] = nx; }
        const unsigned old = xb_add(&bar[XB_XSUB(b.x)], 1u);
        const unsigned gen = old / nloc;
        if (old + 1u == (gen + 1u) * nloc) {
            __builtin_amdgcn_fence(__ATOMIC_RELEASE, "agent");
            asm volatile("s_waitcnt vmcnt(0)" ::: "memory");
            const unsigned og = xb_add(&bar[XB_TOP], 1u);
            const unsigned tg = og / nx;
            if (og + 1u == (tg + 1u) * nx) xb_add(&bar[XB_TOPGEN], 1u);
            else XB_SPIN(xb_ld(&bar[XB_TOPGEN]) == tg, bar);
            __builtin_amdgcn_fence(__ATOMIC_ACQUIRE, "agent");
            xb_add(&bar[XB_XGEN(b.x)], 1u);
            asm volatile("s_waitcnt vmcnt(0)" ::: "memory");
        } else {
            XB_SPIN(xb_ld(&bar[XB_XGEN(b.x)]) == gen, bar);
            __builtin_amdgcn_fence(__ATOMIC_ACQUIRE, "agent");
            asm volatile("s_waitcnt vmcnt(0)" ::: "memory");
        }
    }
    __syncthreads();
}

__device__ __forceinline__ void ph_prep(const P& p, unsigned char* lds) {
    const int tid = tid_(), lane = tid & 63, wid = tid >> 6;
    const int gw = blockIdx.x * 8 + wid, nw = gridDim.x * 8;
    for (int r = gw; r < T; r += nw) {
        const int b = r / LP, pos = r % LP;
        bf16_t* dst = p.xn() + (size_t)r * D;
        if (pos >= L) {
#pragma unroll
            for (int i = 0; i < 4; ++i) *(uint2*)(dst + lane * 4 + 256 * i) = make_uint2(0u, 0u);
            continue;
        }
        const float* src = pos < NMETA ? p.meta + (size_t)pos * D : p.x + ((size_t)b * SEQ + (pos - NMETA)) * D;
        f32x4 v[4]; float ss = 0.f;
#pragma unroll
        for (int i = 0; i < 4; ++i) { v[i] = *(const f32x4*)(src + lane * 4 + 256 * i); ss += v[i][0] * v[i][0] + v[i][1] * v[i][1] + v[i][2] * v[i][2] + v[i][3] * v[i][3]; }
        ss = wave_sum(ss);
        const float rs = rsqrtf(ss * (1.0f / D) + EPS);
#pragma unroll
        for (int i = 0; i < 4; ++i) {
            const f32x4 g = *(const f32x4*)(p.attn_g + lane * 4 + 256 * i);
            uint2 o; o.x = pack2(v[i][0] * rs * g[0], v[i][1] * rs * g[1]); o.y = pack2(v[i][2] * rs * g[2], v[i][3] * rs * g[3]);
            *(uint2*)(dst + lane * 4 + 256 * i) = o;
        }
    }
    const int gt = blockIdx.x * NTHREADS + tid, nt = gridDim.x * NTHREADS;
    for (int i = gt; i < LP * 12; i += nt) {
        const int pos = i / 12, f = i % 12;
        const double ex = f < 8 ? -(double)f / 8.0 : -(double)(f - 8) / 4.0;
        const double inv = exp(ex * log(500000.0));
        const double ang = (double)pos * inv;
        const double twopi = 6.283185307179586476925286766559;
        const double r = ang - twopi * rint(ang / twopi);
        const float rf = (float)r;
        const float c = cosf(rf), s = sinf(rf);
        float* row = p.rope() + (size_t)pos * 24;
        if (f < 8) { row[f] = c; row[8 + f] = s; } else { row[16 + f - 8] = c; row[20 + f - 8] = s; }
    }
    for (int i = gt; i < 512; i += nt) {
        const float a = p.lb_logits[i], b2 = p.lb_logits[512 + i];
        p.lb()[i] = 1.0f / (1.0f + expf(b2 - a));
    }
    for (int i = gt; i < 128; i += nt) p.ctr()[i] = 0;
    convert_T(p.w_in, IN_COLS, p.winT(), 1024, NVC, WinMap{}, gt, nt);
    convert_T(p.w_ua, 1024, p.wuaT(), 512, 1024, IdMap{}, gt, nt);
    convert_T(p.w_uh, 1024, p.wuhT(), 512, 1024, IdMap{}, gt, nt);
    convert_T(p.w_out, 1024, p.woT(), 1024, 1024, IdMap{}, gt, nt);
}
constexpr int G_TILE_B = 256 * 64 * 2, G_STAGE_B = 2 * G_TILE_B;
__device__ __forceinline__ int g_lds_byte(int r, int c) { const int st = (r >> 4) * 2 + (c >> 5), ob = (r & 15) * 64 + (c & 31) * 2; return st * 1024 + (ob ^ (((ob >> 9) & 1) << 5)); }
__device__ __forceinline__ void g_stage_rc(int b, int& R, int& C) { const int st = b >> 10, sb = b & 1023, swz = sb ^ (((sb >> 9) & 1) << 5); R = (st >> 1) * 16 + swz / 64; C = (st & 1) * 32 + (swz % 64) / 2; }

constexpr int HTB = 128 * 64 * 2;
struct GJob { const char* A; const char* B; unsigned va00, va01, va10, va11; };
__device__ __forceinline__ void gj_lin(unsigned (&v)[2][2], int ld) {
#pragma unroll
    for (int h = 0; h < 2; ++h)
#pragma unroll
        for (int i = 0; i < 2; ++i) { int R, C; g_stage_rc(tid_() * 16 + i * 8192, R, C); v[h][i] = (unsigned)(((h * 128 + R) * ld + C) * 2); }
}
template <class AOff>
__device__ __forceinline__ void gj_gather(unsigned (&v)[2][2], const AOff& aoff) {
#pragma unroll
    for (int h = 0; h < 2; ++h)
#pragma unroll
        for (int i = 0; i < 2; ++i) { int R, C; g_stage_rc(tid_() * 16 + i * 8192, R, C); v[h][i] = (unsigned)((aoff(h * 128 + R) + C) * 2); }
}
template <class AOff>
__device__ __forceinline__ void gj_gather_job(GJob& j, const AOff& aoff) {
    unsigned v[2][2]; gj_gather(v, aoff); j.va00 = v[0][0]; j.va01 = v[0][1]; j.va10 = v[1][0]; j.va11 = v[1][1];
}
template <bool GATHER, class JobFn, class Epi>
__device__ __forceinline__ void gemm_stream(unsigned char* lds_, int K, int lda, size_t hstepB, const unsigned (&vbU)[2], const JobFn& jobfn, const Epi& epi) {
    LAS unsigned char* lds = (LAS unsigned char*)lds_;
    const int tid = tid_(), wid = __builtin_amdgcn_readfirstlane(tid >> 6), lane = tid & 63, wr = wid >> 2, wc = wid & 3, fr = lane & 15, fq = lane >> 4;
    const int nt = K / 64;
    const size_t kstep = 128;
    const size_t hstepA = GATHER ? 0 : (size_t)128 * lda * 2;
    const unsigned ldsw = (unsigned)wid * 1024u;
    const int aoff = g_lds_byte(wr * 64 + fr, fq * 8), boff = g_lds_byte(wc * 32 + fr, fq * 8);
    unsigned vaU[2];
#pragma unroll
    for (int i = 0; i < 2; ++i) { int R, C; g_stage_rc(tid * 16 + i * 8192, R, C); vaU[i] = (unsigned)((R * lda + C) * 2); }
#define PG8_SA(b, h) (((b) * 2 + (h)) * HTB)
#define PG8_SB(b, h) ((4 + (b) * 2 + (h)) * HTB)
#define PG8_STAGE2(bufoff, gbase, v0, v1) do { \
        __builtin_amdgcn_global_load_lds((const unsigned*)((const char*)(gbase) + (v0)), (LAS unsigned*)(lds + (bufoff) + ldsw), 16, 0, 0); \
        __builtin_amdgcn_global_load_lds((const unsigned*)((const char*)(gbase) + (v1)), (LAS unsigned*)(lds + (bufoff) + ldsw + 8192), 16, 0, 0); } while (0)
#define STB(bufoff, gbase, h) PG8_STAGE2(bufoff, (gbase) + ((h) ? hstepB : 0), vbU[0], vbU[1])
#define STA_CUR(bufoff, gbase, h) do { if (GATHER) PG8_STAGE2(bufoff, gbase, (h) ? cur.va10 : cur.va00, (h) ? cur.va11 : cur.va01); else PG8_STAGE2(bufoff, (gbase) + ((h) ? hstepA : 0), vaU[0], vaU[1]); } while (0)
#define STA_SEL(bufoff, gbase, h) do { if (GATHER) PG8_STAGE2(bufoff, gbase, last ? ((h) ? nxt.va10 : nxt.va00) : ((h) ? cur.va10 : cur.va00), last ? ((h) ? nxt.va11 : nxt.va01) : ((h) ? cur.va11 : cur.va01)); \
        else PG8_STAGE2(bufoff, (gbase) + ((h) ? hstepA : 0), vaU[0], vaU[1]); } while (0)
#define PG8_LDA(dst, b, h) do { _Pragma("unroll") for (int m = 0; m < 4; ++m) _Pragma("unroll") for (int k = 0; k < 2; ++k) dst[m][k] = *(const LAS bf16x8*)(lds + PG8_SA(b, h) + aoff + m * 2048 + k * 1024); } while (0)
#define PG8_LDB(dst, b, h) do { _Pragma("unroll") for (int n = 0; n < 2; ++n) _Pragma("unroll") for (int k = 0; k < 2; ++k) dst[n][k] = *(const LAS bf16x8*)(lds + PG8_SB(b, h) + boff + n * 2048 + k * 1024); } while (0)
#define PG8_MMA(ai, bj, At, Bt) do { __builtin_amdgcn_s_setprio(1); _Pragma("unroll") for (int m = 0; m < 4; ++m) _Pragma("unroll") for (int n = 0; n < 2; ++n) _Pragma("unroll") for (int k = 0; k < 2; ++k) \
        acc[ai][bj][m][n] = __builtin_amdgcn_mfma_f32_16x16x32_bf16(Bt[n][k], At[m][k], acc[ai][bj][m][n], 0, 0, 0); __builtin_amdgcn_s_setprio(0); } while (0)
#define PG8_WAIT_V(n) asm volatile("s_waitcnt vmcnt(" #n ")" ::: "memory")
#define PG8_WAIT_L(n) asm volatile("s_waitcnt lgkmcnt(" #n ")" ::: "memory")
#define PG8_BAR __builtin_amdgcn_s_barrier()
#define PG8_SCHED __builtin_amdgcn_sched_barrier(0)
    GJob cur, nxt; int ui = 0;
    cur.A = nullptr; cur.B = nullptr; cur.va00 = cur.va01 = cur.va10 = cur.va11 = 0u; nxt = cur;
    if (!jobfn(0, cur)) return;
    f32x4 acc[2][2][4][2];
#pragma unroll
    for (int a = 0; a < 2; ++a)
#pragma unroll
        for (int b = 0; b < 2; ++b)
#pragma unroll
            for (int m = 0; m < 4; ++m)
#pragma unroll
                for (int n = 0; n < 2; ++n) acc[a][b][m][n] = (f32x4){0.f, 0.f, 0.f, 0.f};
    bf16x8 At[4][2], B0[2][2], B1[2][2];
    STB(PG8_SB(0, 0), cur.B, 0); STB(PG8_SB(0, 1), cur.B, 1); STA_CUR(PG8_SA(0, 0), cur.A, 0); STA_CUR(PG8_SA(0, 1), cur.A, 1);
    if (wr == 1) PG8_BAR;
    PG8_WAIT_V(2); PG8_BAR;
    STB(PG8_SB(1, 0), cur.B + kstep, 0); STA_CUR(PG8_SA(1, 0), cur.A + kstep, 0); STB(PG8_SB(1, 1), cur.B + kstep, 1);
    PG8_WAIT_V(6); PG8_BAR;
    for (;;) {
        bool has_next = false;
        for (int t = 0; t < nt; t += 2) {
            const bool last = (t == nt - 2);
            if (last) { has_next = jobfn(ui + 1, nxt); if (!has_next) nxt = cur; }
            const char* a1 = cur.A + (size_t)(t + 1) * kstep;
            const char* a2 = last ? nxt.A : cur.A + (size_t)(t + 2) * kstep; const char* b2 = last ? nxt.B : cur.B + (size_t)(t + 2) * kstep;
            const char* a3 = a2 + kstep; const char* b3 = b2 + kstep;
            PG8_LDB(B0, 0, 0); PG8_LDB(B1, 0, 1); PG8_SCHED; PG8_LDA(At, 0, 0); STA_CUR(PG8_SA(1, 1), a1, 1);
            PG8_WAIT_V(8); PG8_WAIT_L(0); PG8_BAR; PG8_MMA(0, 0, At, B0); PG8_MMA(0, 1, At, B1); PG8_BAR; PG8_SCHED;
            PG8_LDA(At, 0, 1); STB(PG8_SB(0, 0), b2, 0); STB(PG8_SB(0, 1), b2, 1); STA_SEL(PG8_SA(0, 0), a2, 0);
            PG8_WAIT_V(8); PG8_WAIT_L(0); PG8_BAR; PG8_MMA(1, 0, At, B0); PG8_MMA(1, 1, At, B1); PG8_BAR; PG8_SCHED;
            PG8_LDB(B0, 1, 0); PG8_LDB(B1, 1, 1); PG8_SCHED; PG8_LDA(At, 1, 0); STA_SEL(PG8_SA(0, 1), a2, 1);
            PG8_WAIT_V(8); PG8_WAIT_L(0); PG8_BAR; PG8_MMA(0, 0, At, B0); PG8_MMA(0, 1, At, B1); PG8_BAR; PG8_SCHED;
            PG8_LDA(At, 1, 1); STB(PG8_SB(1, 0), b3, 0); STB(PG8_SB(1, 1), b3, 1); STA_SEL(PG8_SA(1, 0), a3, 0);
            PG8_WAIT_V(8); PG8_WAIT_L(0); PG8_BAR; PG8_MMA(1, 0, At, B0); PG8_MMA(1, 1, At, B1); PG8_BAR; PG8_SCHED;
        }
        if (wr == 0) PG8_BAR;
        epi(acc, ui);
        if (!has_next) break;
#pragma unroll
        for (int a = 0; a < 2; ++a)
#pragma unroll
            for (int b = 0; b < 2; ++b)
#pragma unroll
                for (int m = 0; m < 4; ++m)
#pragma unroll
                    for (int n = 0; n < 2; ++n) acc[a][b][m][n] = (f32x4){0.f, 0.f, 0.f, 0.f};
        cur = nxt; ++ui;
        if (wr == 1) PG8_BAR;
    }
    PG8_WAIT_V(0);
    PG8_BAR;
#undef PG8_SA
#undef PG8_SB
#undef PG8_STAGE2
#undef STB
#undef STA_CUR
#undef STA_SEL
#undef PG8_LDA
#undef PG8_LDB
#undef PG8_MMA
#undef PG8_WAIT_V
#undef PG8_WAIT_L
#undef PG8_BAR
#undef PG8_SCHED
}
__device__ __forceinline__ void gj_lin2(unsigned (&v)[2], int ld) {
#pragma unroll
    for (int i = 0; i < 2; ++i) { int R, C; g_stage_rc(tid_() * 16 + i * 8192, R, C); v[i] = (unsigned)((R * ld + C) * 2); }
}
typedef int i32x8 __attribute__((ext_vector_type(8)));
typedef unsigned u32x4 __attribute__((ext_vector_type(4)));
struct G8Job { const char* A; const char* B; unsigned va0, va1, va2, va3; };
__device__ __forceinline__ void g8_rc(int i, int& R, int& Cb) { int C; g_stage_rc(tid_() * 16 + i * 8192, R, C); Cb = C * 2; }
__device__ __forceinline__ const char* uni_ptr8(const char* p) {
    const unsigned long long v = (unsigned long long)p;
    const unsigned lo = __builtin_amdgcn_readfirstlane((unsigned)v), hi = __builtin_amdgcn_readfirstlane((unsigned)(v >> 32));
    return (const char*)(((unsigned long long)hi << 32) | lo);
}
template <bool GATHER, class JobFn, class Epi>
__device__ __forceinline__ void gemm8_stream(unsigned char* lds_, const unsigned (&vbU)[4], const JobFn& jobfn, const Epi& epi) {
    LAS unsigned char* lds = (LAS unsigned char*)lds_;
    const int tid = tid_(), wid = __builtin_amdgcn_readfirstlane(tid >> 6), lane = tid & 63, wr = wid >> 2, wc = wid & 3, fr = lane & 15, fq = lane >> 4;
    LAS unsigned char* a0p = lds + g_lds_byte(wr * 64 + fr, fq * 8); LAS unsigned char* a1p = a0p + 65536;
    LAS unsigned char* b0p = lds + 32768 + g_lds_byte(wc * 32 + fr, fq * 8); LAS unsigned char* b1p = b0p + 65536;
    LAS unsigned char* const ldsw = lds + wid * 1024;
#define G8_DMA(JA, JB, v0, v1, v2, v3, buf, kt) do { \
        const char* pa_ = uni_ptr8(JA) + (kt) * 128; const char* pb_ = uni_ptr8(JB) + (kt) * 128; LAS unsigned char* d_ = ldsw + (buf) * 65536; \
        __builtin_amdgcn_global_load_lds((const unsigned*)(pa_ + (GATHER ? v0 : vb0)), (LAS unsigned*)(d_), 16, 0, 0); \
        __builtin_amdgcn_global_load_lds((const unsigned*)(pa_ + (GATHER ? v1 : vb1)), (LAS unsigned*)(d_ + 8192), 16, 0, 0); \
        __builtin_amdgcn_global_load_lds((const unsigned*)(pa_ + (GATHER ? v2 : vb2)), (LAS unsigned*)(d_ + 16384), 16, 0, 0); \
        __builtin_amdgcn_global_load_lds((const unsigned*)(pa_ + (GATHER ? v3 : vb3)), (LAS unsigned*)(d_ + 24576), 16, 0, 0); \
        __builtin_amdgcn_global_load_lds((const unsigned*)(pb_ + vb0), (LAS unsigned*)(d_ + 32768), 16, 0, 0); \
        __builtin_amdgcn_global_load_lds((const unsigned*)(pb_ + vb1), (LAS unsigned*)(d_ + 32768 + 8192), 16, 0, 0); \
        __builtin_amdgcn_global_load_lds((const unsigned*)(pb_ + vb2), (LAS unsigned*)(d_ + 32768 + 16384), 16, 0, 0); \
        __builtin_amdgcn_global_load_lds((const unsigned*)(pb_ + vb3), (LAS unsigned*)(d_ + 32768 + 24576), 16, 0, 0); } while (0)
#define G8_LD(dst, ptr) do { const u32x4 x0_ = *(const LAS u32x4*)(ptr), x1_ = *(const LAS u32x4*)((ptr) + 1024); \
        dst = (i32x8){(int)x0_.x, (int)x0_.y, (int)x0_.z, (int)x0_.w, (int)x1_.x, (int)x1_.y, (int)x1_.z, (int)x1_.w}; } while (0)
#define G8_LDA(dst, ap, ai, m0, m1) do { _Pragma("unroll") for (int m = m0; m < m1; ++m) G8_LD(dst[m], (ap) + (ai) * 16384 + m * 2048); } while (0)
#define G8_LDB(dst, bp, bj) do { _Pragma("unroll") for (int n = 0; n < 2; ++n) G8_LD(dst[n], (bp) + (bj) * 16384 + n * 2048); } while (0)
#define G8_MMA(ai, bj, At, Bt) do { __builtin_amdgcn_sched_barrier(0); __builtin_amdgcn_s_setprio(1); _Pragma("unroll") for (int m = 0; m < 4; ++m) _Pragma("unroll") for (int n = 0; n < 2; ++n) \
        asm("v_mfma_scale_f32_16x16x128_f8f6f4 %0, %1, %2, %0, %3, %3 op_sel_hi:[0,0,0]" : "+v"(acc[ai][bj][m][n]) : "v"(Bt[n]), "v"(At[m]), "v"(unit_scale)); \
        __builtin_amdgcn_s_setprio(0); __builtin_amdgcn_sched_barrier(0); } while (0)
#define G8_PF 2
#define G8_TILE(buf, ap, bp, apn, bpn, X, Y, kt) do { \
        G8_LDA(P, ap, 0, G8_PF, 4); G8_LDB(Y, bp, 1); G8_MMA(0, 0, P, X); \
        G8_LDA(Q, ap, 1, 0, 2);                       G8_MMA(0, 1, P, Y); \
        G8_LDA(Q, ap, 1, 2, 4); G8_LDB(X, bp, 0);     G8_MMA(1, 1, Q, Y); \
        asm volatile("" ::: "memory"); __builtin_amdgcn_s_waitcnt(0x0070); __builtin_amdgcn_s_barrier(); asm volatile("" ::: "memory"); \
        asm volatile("" : "+v"(vb0), "+v"(vb1), "+v"(vb2), "+v"(vb3), "+v"(cur.va0), "+v"(cur.va1), "+v"(cur.va2), "+v"(cur.va3)); \
        G8_DMA(selA, selB, cur.va0, cur.va1, cur.va2, cur.va3, buf, kt); \
        G8_LDA(P, apn, 0, 0, G8_PF); G8_LDB(Y, bpn, 0); \
        G8_MMA(1, 0, Q, X); } while (0)
    G8Job cur, nxt;
    cur.A = nullptr; cur.B = nullptr; cur.va0 = cur.va1 = cur.va2 = cur.va3 = 0u; nxt = cur;
    if (!jobfn(0, cur)) return;
    cur.A = uni_ptr8(cur.A); cur.B = uni_ptr8(cur.B);
    unsigned vb0 = vbU[0], vb1 = vbU[1], vb2 = vbU[2], vb3 = vbU[3];
    G8_DMA(cur.A, cur.B, cur.va0, cur.va1, cur.va2, cur.va3, 0, 0); G8_DMA(cur.A, cur.B, cur.va0, cur.va1, cur.va2, cur.va3, 1, 1);
    asm volatile("s_waitcnt vmcnt(0)" ::: "memory");
    __syncthreads();
    int ui = 0;
    for (;;) {
        f32x4 acc[2][2][4][2];
#pragma unroll
        for (int a = 0; a < 2; ++a)
#pragma unroll
            for (int b = 0; b < 2; ++b)
#pragma unroll
                for (int m = 0; m < 4; ++m)
#pragma unroll
                    for (int n = 0; n < 2; ++n) acc[a][b][m][n] = (f32x4){0.f, 0.f, 0.f, 0.f};
        const bool has_next = jobfn(ui + 1, nxt);
        nxt.A = uni_ptr8(nxt.A); nxt.B = uni_ptr8(nxt.B);
        if (!has_next) nxt = cur;
        i32x8 P[4], Q[4], X[2], Y[2];
        const int unit_scale = 0x7f7f7f7f;
        G8_LDA(P, a0p, 0, 0, G8_PF); G8_LDB(X, b0p, 0);
#pragma unroll 1
        for (int t2 = 0; t2 < 4; ++t2) {
            const bool lastp = t2 == 3;
            const char* selA = lastp ? nxt.A : cur.A; const char* selB = lastp ? nxt.B : cur.B;
            if (GATHER) { cur.va0 = lastp ? nxt.va0 : cur.va0; cur.va1 = lastp ? nxt.va1 : cur.va1; cur.va2 = lastp ? nxt.va2 : cur.va2; cur.va3 = lastp ? nxt.va3 : cur.va3; }
            const int kt0 = lastp ? 0 : 2 * t2 + 2;
            asm volatile("" : "+v"(a0p), "+v"(a1p), "+v"(b0p), "+v"(b1p));
            G8_TILE(0, a0p, b0p, a1p, b1p, X, Y, kt0);
            G8_TILE(1, a1p, b1p, a0p, b0p, Y, X, kt0 + 1);
        }
        asm volatile("s_nop 15\n\ts_nop 15" ::: "memory");
        epi(acc, ui);
        if (!has_next) break;
        cur.A = nxt.A; cur.B = nxt.B; ++ui;
    }
#undef G8_TILE
#undef G8_PF
#undef G8_MMA
#undef G8_LDB
#undef G8_LDA
#undef G8_LD
#undef G8_DMA
    __syncthreads();
}
struct RowLin { size_t base; int ld; __device__ __forceinline__ size_t operator()(int R) const { return base + (size_t)R * ld; } };

__device__ __forceinline__ void st_bf4(bf16_t* dst, f32x4 v) {
    uint2 o; o.x = pack2(v[0], v[1]); o.y = pack2(v[2], v[3]); *(uint2*)dst = o;
}
#define EPI8(...) do { const int tid_e = tid_(), lane_e = tid_e & 63, wid_e = tid_e >> 6, wr = wid_e >> 2, wc = wid_e & 3, fr = lane_e & 15, fq = lane_e >> 4; \
    _Pragma("unroll") for (int ai = 0; ai < 2; ++ai) _Pragma("unroll") for (int m = 0; m < 4; ++m) _Pragma("unroll") for (int bj = 0; bj < 2; ++bj) _Pragma("unroll") for (int n = 0; n < 2; ++n) { \
        const int row = ai * 128 + wr * 64 + m * 16 + fr, col = bj * 128 + wc * 32 + n * 16 + fq * 4; const f32x4 v = acc[ai][bj][m][n]; __VA_ARGS__ } } while (0)

struct EpiInproj {
    const P* p; int nt;
    __device__ __forceinline__ void operator()(int m, int n, int fq, f32x4 v) const {
        const P& P_ = *p;
        const int pos = m % LP;
        const float* rp = P_.rope() + (size_t)pos * 24;
        if (nt <= 2) {
            const bool isv = (nt == 2) && (n >= 128);
            if (!isv && (n & 48) == 0) {
                f32x4 pr;
#pragma unroll
                for (int j = 0; j < 4; ++j) pr[j] = __shfl_xor(v[j], 32);
                const int i0 = (fq & 1) * 4;
#pragma unroll
                for (int j = 0; j < 4; ++j) {
                    const float c = rp[i0 + j], s = rp[8 + i0 + j];
                    v[j] = fq < 2 ? v[j] * c - pr[j] * s : v[j] * c + pr[j] * s;
                }
            }
            if (nt < 2) { st_bf4(P_.q() + (size_t)m * 512 + nt * 256 + n, v * (0.125f * 1.4426950408889634f)); }
            else if (n < 128) st_bf4(P_.k() + (size_t)m * 128 + n, v);
            else st_bf4(P_.v() + (size_t)m * 128 + (n - 128), v);
        } else if (nt == 3 || nt == 4) {
            const bool ropeable = (nt == 3) ? ((n & 16) == 0) : (n < 16);
            if (ropeable) {
                f32x4 pr;
#pragma unroll
                for (int j = 0; j < 4; ++j) pr[j] = __shfl_xor(v[j], 16);
                if (fq < 2) {
#pragma unroll
                    for (int j = 0; j < 4; ++j) {
                        const float c = rp[16 + j], s = rp[20 + j];
                        v[j] = fq == 0 ? v[j] * c - pr[j] * s : v[j] * c + pr[j] * s;
                    }
                }
            }
            if (nt == 3) st_bf4(P_.iq() + (size_t)m * 256 + n, v);
            else if (n < 32) st_bf4(P_.ik() + (size_t)m * 32 + n, v);
            else if (n < 40) *(f32x4*)(P_.iw() + (size_t)m * 8 + (n - 32)) = v;
        } else if (nt <= 6) { st_bf4(P_.hq() + (size_t)m * 512 + (nt - 5) * 256 + n, v * 0.08838834764831845f); }
        else if (nt <= 8) { st_bf4(P_.hf() + (size_t)m * 512 + (nt - 7) * 256 + n, v); }
        else if (nt <= 10) { st_bf4(P_.hi() + (size_t)m * 512 + (nt - 9) * 256 + n, v); }
        else if (nt <= 12) {
            f32x4 o;
#pragma unroll
            for (int j = 0; j < 4; ++j) o[j] = v[j] * sigmoidf_(v[j]);
            st_bf4(P_.hg() + (size_t)m * 512 + (nt - 11) * 256 + n, o);
        } else {
            f32x4 o;
#pragma unroll
            for (int j = 0; j < 4; ++j) o[j] = sigmoidf_(v[j]);
            if (nt <= 16) st_bf4(P_.ga() + (size_t)m * 1024 + (nt - 13) * 256 + n, o);
            else st_bf4(P_.gh() + (size_t)m * 1024 + (nt - 17) * 256 + n, o);
        }
    }
};

__device__ __forceinline__ void ph_inproj(const P& p, unsigned char* lds) {
    const int nunits = (T / 256) * 21, G = gridDim.x, b0 = blockIdx.x;
    auto jobfn = [&](int i, GJob& j) __attribute__((always_inline)) -> bool {
        const int u = b0 + i * G; if (u >= nunits) return false;
        const int nt = u % 21, mt = u / 21;
        j.A = (const char*)(p.xn() + (size_t)mt * 256 * D); j.B = (const char*)(p.winT() + (size_t)nt * 256 * D); return true; };
    auto epi = [&](f32x4 (&acc)[2][2][4][2], int i) __attribute__((always_inline)) {
        const int u = b0 + i * G, nt = u % 21, mt = u / 21;
        const EpiInproj e{&p, nt};
        EPI8( e(mt * 256 + row, col, fq, v); );
    };
    unsigned vbU[2]; gj_lin2(vbU, D);
    gemm_stream<false>(lds, D, D, (size_t)128 * D * 2, vbU, jobfn, epi);
}

constexpr int NCH = 129, NXU = 16 * NCH;
constexpr int X_QT = 0, X_KT = X_QT + 64 * 272, X_KH = X_KT + 64 * 272, X_VT = X_KH + 128 * 144, X_AS = X_VT + 128 * 144, X_SEG = X_AS + 64 * 144;
__device__ __forceinline__ bf16_t* hg_ds(const P& p) { return (bf16_t*)p.out; }
__device__ __forceinline__ float* hg_g(const P& p) { return (float*)((unsigned char*)p.out + (size_t)NXU * 32768); }

__device__ __forceinline__ void hgx_unit(const P& p, unsigned char* lds, int u) {
    const int tid = tid_(), lane = tid & 63, wid = tid >> 6, fr = lane & 15, fq = lane >> 4;
    const int c = u % NCH, bh = u / NCH, b = bh >> 2, h = bh & 3;
    const int d = tid & 127, seg = tid >> 7;
    const size_t rowbase = (size_t)(b * LP + c * 64 + seg * 16) * 512 + h * 128 + d;
    bf16_t* hqp = p.hq() + rowbase; const bf16_t* hfp = p.hf() + rowbase; const bf16_t* hip = p.hi() + rowbase;
    const float lbv = p.lb()[h * 128 + d];
    float bb[16], qv[16], kk[16], vv[16];
    float cs = 0.f;
#pragma unroll
    for (int i = 0; i < 16; ++i) {
        const float f = lbv + (1.0f - lbv) * sigmoidf_(bf2f(hfp[(size_t)i * 512]));
        kk[i] = 1.0f - f; cs += __logf(f); bb[i] = cs;
        qv[i] = bf2f(hqp[(size_t)i * 512]); vv[i] = bf2f(hip[(size_t)i * 512]);
    }
    float* segs = (float*)(lds + X_SEG);
    segs[seg * 128 + d] = cs;
    __syncthreads();
    const float s0 = segs[d], s1 = segs[128 + d], s2 = segs[256 + d], s3 = segs[384 + d];
    const float off = seg == 0 ? 0.f : (seg == 1 ? s0 : (seg == 2 ? s0 + s1 : s0 + s1 + s2));
    const float rref = s0 + s1, blast = (s0 + s1) + (s2 + s3);
    uint32_t khp[8], vtp[8];
#pragma unroll
    for (int i = 0; i < 16; i += 2) {
        float khv[2];
#pragma unroll
        for (int j = 0; j < 2; ++j) {
            const float bt = bb[i + j] + off;
            const float eq = __expf(fminf(bt - rref, 80.f)), ek = __expf(fminf(rref - bt, 80.f));
            const int t = seg * 16 + i + j;
            *(bf16_t*)(lds + X_QT + t * 272 + d * 2) = f2bf(qv[i + j] * eq);
            *(bf16_t*)(lds + X_KT + t * 272 + d * 2) = f2bf(kk[i + j] * ek);
            hqp[(size_t)(i + j) * 512] = f2bf(qv[i + j] * __expf(bt));
            khv[j] = kk[i + j] * __expf(blast - bt);
        }
        khp[i >> 1] = pack2(khv[0], khv[1]); vtp[i >> 1] = pack2(vv[i], vv[i + 1]);
    }
    *(uint4*)(lds + X_KH + d * 144 + seg * 32) = make_uint4(khp[0], khp[1], khp[2], khp[3]);
    *(uint4*)(lds + X_KH + d * 144 + seg * 32 + 16) = make_uint4(khp[4], khp[5], khp[6], khp[7]);
    *(uint4*)(lds + X_VT + d * 144 + seg * 32) = make_uint4(vtp[0], vtp[1], vtp[2], vtp[3]);
    *(uint4*)(lds + X_VT + d * 144 + seg * 32 + 16) = make_uint4(vtp[4], vtp[5], vtp[6], vtp[7]);
    if (seg == 0) hg_g(p)[(size_t)u * 128 + d] = __expf(blast);
    __syncthreads();
    {
        const int tm = wid >> 1, tn0 = (wid & 1) * 2;
        f32x4 a1[2] = {(f32x4){0.f, 0.f, 0.f, 0.f}, (f32x4){0.f, 0.f, 0.f, 0.f}};
#pragma unroll
        for (int ks = 0; ks < 4; ++ks) {
            const bf16x8 aq = *(const bf16x8*)(lds + X_QT + (tm * 16 + fr) * 272 + (ks * 32 + fq * 8) * 2);
#pragma unroll
            for (int j = 0; j < 2; ++j) {
                const bf16x8 bk = *(const bf16x8*)(lds + X_KT + ((tn0 + j) * 16 + fr) * 272 + (ks * 32 + fq * 8) * 2);
                a1[j] = __builtin_amdgcn_mfma_f32_16x16x32_bf16(bk, aq, a1[j], 0, 0, 0);
            }
        }
#pragma unroll
        for (int j = 0; j < 2; ++j) {
            const int t = tm * 16 + fr, sb = (tn0 + j) * 16 + fq * 4;
            f32x4 v = a1[j];
#pragma unroll
            for (int jj = 0; jj < 4; ++jj) v[jj] = (sb + jj <= t) ? v[jj] : 0.f;
            uint2 o; o.x = pack2(v[0], v[1]); o.y = pack2(v[2], v[3]);
            *(uint2*)(lds + X_AS + t * 144 + sb * 2) = o;
        }
    }
    __syncthreads();
    {
        const int tm = wid >> 1, en0 = (wid & 1) * 4;
        f32x4 o2[4];
#pragma unroll
        for (int j = 0; j < 4; ++j) o2[j] = (f32x4){0.f, 0.f, 0.f, 0.f};
#pragma unroll
        for (int ks = 0; ks < 2; ++ks) {
            const bf16x8 aa = *(const bf16x8*)(lds + X_AS + (tm * 16 + fr) * 144 + (ks * 32 + fq * 8) * 2);
#pragma unroll
            for (int j = 0; j < 4; ++j) {
                const bf16x8 bv = *(const bf16x8*)(lds + X_VT + ((en0 + j) * 16 + fr) * 144 + (ks * 32 + fq * 8) * 2);
                o2[j] = __builtin_amdgcn_mfma_f32_16x16x32_bf16(bv, aa, o2[j], 0, 0, 0);
            }
        }
        bf16_t* orow = p.hf() + (size_t)(b * LP + c * 64 + tm * 16 + fr) * 512 + h * 128;
#pragma unroll
        for (int j = 0; j < 4; ++j) st_bf4(orow + (en0 + j) * 16 + fq * 4, o2[j]);
    }
    {
        f32x4 s3[8];
#pragma unroll
        for (int j = 0; j < 8; ++j) s3[j] = (f32x4){0.f, 0.f, 0.f, 0.f};
#pragma unroll
        for (int ks = 0; ks < 2; ++ks) {
            const bf16x8 ak = *(const bf16x8*)(lds + X_KH + (wid * 16 + fr) * 144 + (ks * 32 + fq * 8) * 2);
#pragma unroll
            for (int j = 0; j < 8; ++j) {
                const bf16x8 bv = *(const bf16x8*)(lds + X_VT + (j * 16 + fr) * 144 + (ks * 32 + fq * 8) * 2);
                s3[j] = __builtin_amdgcn_mfma_f32_16x16x32_bf16(ak, bv, s3[j], 0, 0, 0);
            }
        }
        bf16_t* dsb = hg_ds(p) + (size_t)u * 16384;
#pragma unroll
        for (int j = 0; j < 8; ++j) st_bf4(dsb + (size_t)(j * 16 + fr) * 128 + wid * 16 + fq * 4, s3[j]);
    }
    __syncthreads();
}

__device__ __forceinline__ void hgchain_unit(const P& p, int item) {
    const int tid = tid_(), bh = item >> 2, eq = item & 3;
    const int e = eq * 32 + (tid >> 4), d0 = (tid & 15) * 8;
    float S[8];
#pragma unroll
    for (int i = 0; i < 8; ++i) S[i] = 0.f;
    uint4* ptr = (uint4*)(hg_ds(p) + ((size_t)(bh * NCH) * 128 + e) * 128 + d0);
    const f32x4* gp = (const f32x4*)(hg_g(p) + (size_t)(bh * NCH) * 128 + d0);
    uint4 wq[8]; f32x4 g0[8], g1[8];
#pragma unroll
    for (int k = 0; k < 8; ++k) { wq[k] = ptr[(size_t)k * 2048]; g0[k] = gp[k * 32]; g1[k] = gp[k * 32 + 1]; }
    for (int c0 = 0; c0 < NCH; c0 += 8) {
#pragma unroll
        for (int k = 0; k < 8; ++k) {
            const int c = c0 + k;
            if (c < NCH) {
                const uint4 w = wq[k]; const f32x4 ga = g0[k], gb = g1[k];
                if (c + 8 < NCH) { wq[k] = ptr[(size_t)(c + 8) * 2048]; g0[k] = gp[(c + 8) * 32]; g1[k] = gp[(c + 8) * 32 + 1]; }
                ptr[(size_t)c * 2048] = make_uint4(pack2(S[0], S[1]), pack2(S[2], S[3]), pack2(S[4], S[5]), pack2(S[6], S[7]));
                S[0] = ga[0] * S[0] + __uint_as_float(w.x << 16); S[1] = ga[1] * S[1] + __uint_as_float(w.x & 0xffff0000u);
                S[2] = ga[2] * S[2] + __uint_as_float(w.y << 16); S[3] = ga[3] * S[3] + __uint_as_float(w.y & 0xffff0000u);
                S[4] = gb[0] * S[4] + __uint_as_float(w.z << 16); S[5] = gb[1] * S[5] + __uint_as_float(w.z & 0xffff0000u);
                S[6] = gb[2] * S[6] + __uint_as_float(w.w << 16); S[7] = gb[3] * S[7] + __uint_as_float(w.w & 0xffff0000u);
            }
        }
    }
}

__device__ __forceinline__ void hgz_unit(const P& p, unsigned char* lds, int u) {
    const int tid = tid_(), lane = tid & 63, wid = tid >> 6, fr = lane & 15, fq = lane >> 4;
    const int c = u % NCH, bh = u / NCH, b = bh >> 2, h = bh & 3;
    const int tm = wid >> 1, en0 = (wid & 1) * 4;
    const size_t row = (size_t)(b * LP + c * 64 + tm * 16 + fr);
    const bf16_t* qrow = p.hq() + row * 512 + h * 128;
    const bf16_t* sT = hg_ds(p) + (size_t)u * 16384;
    f32x4 o[4];
#pragma unroll
    for (int j = 0; j < 4; ++j) o[j] = (f32x4){0.f, 0.f, 0.f, 0.f};
#pragma unroll
    for (int ks = 0; ks < 4; ++ks) {
        const bf16x8 aq = *(const bf16x8*)(qrow + ks * 32 + fq * 8);
#pragma unroll
        for (int j = 0; j < 4; ++j) {
            const bf16x8 bs = *(const bf16x8*)(sT + (size_t)((en0 + j) * 16 + fr) * 128 + ks * 32 + fq * 8);
            o[j] = __builtin_amdgcn_mfma_f32_16x16x32_bf16(bs, aq, o[j], 0, 0, 0);
        }
    }
    const bf16_t* oi = p.hf() + row * 512 + h * 128;
    float ss = 0.f;
#pragma unroll
    for (int j = 0; j < 4; ++j) {
        const uint2 w = *(const uint2*)(oi + (en0 + j) * 16 + fq * 4);
        o[j][0] += __uint_as_float(w.x << 16); o[j][1] += __uint_as_float(w.x & 0xffff0000u);
        o[j][2] += __uint_as_float(w.y << 16); o[j][3] += __uint_as_float(w.y & 0xffff0000u);
        ss += o[j][0] * o[j][0] + o[j][1] * o[j][1] + o[j][2] * o[j][2] + o[j][3] * o[j][3];
    }
    ss += __shfl_xor(ss, 16); ss += __shfl_xor(ss, 32);
    float* part = (float*)lds;
    if (fq == 0) part[(tm * 16 + fr) * 2 + (wid & 1)] = ss;
    __syncthreads();
    const float tot = part[(tm * 16 + fr) * 2] + part[(tm * 16 + fr) * 2 + 1];
    const float rs = rsqrtf(tot * (1.0f / 128.0f) + EPS);
    const bf16_t* hgp = p.hg() + row * 512 + h * 128;
    bf16_t* outp = p.hgr() + row * 512 + h * 128;
#pragma unroll
    for (int j = 0; j < 4; ++j) {
        const int e0 = (en0 + j) * 16 + fq * 4;
        const f32x4 gn = *(const f32x4*)(p.hgrn_g + h * 128 + e0);
        const uint2 w = *(const uint2*)(hgp + e0);
        f32x4 r;
        r[0] = o[j][0] * rs * gn[0] * __uint_as_float(w.x << 16); r[1] = o[j][1] * rs * gn[1] * __uint_as_float(w.x & 0xffff0000u);
        r[2] = o[j][2] * rs * gn[2] * __uint_as_float(w.y << 16); r[3] = o[j][3] * rs * gn[3] * __uint_as_float(w.y & 0xffff0000u);
        st_bf4(outp + e0, r);
    }
    __syncthreads();
}

typedef float f32x16 __attribute__((ext_vector_type(16)));
typedef short s16x4 __attribute__((ext_vector_type(4)));

constexpr int NKMAX = 8224;
constexpr int NBIN = 1024;
constexpr int A_SC = 0, A_H1 = A_SC + 4 * NKMAX * 4, A_SEL = A_H1 + 4 * NBIN * 4, A_CAND = A_SEL + 2048, A_META = A_CAND + 1024, A_END = A_META + 256;
static_assert(A_END <= LDS_BYTES - 16, "attention LDS");
__device__ __forceinline__ uint32_t skey(float f) { const uint32_t u = __float_as_uint(f); return (u & 0x80000000u) ? ~u : (u | 0x80000000u); }
__device__ __forceinline__ float skey_inv(uint32_t k) { return __uint_as_float((k & 0x80000000u) ? (k & 0x7fffffffu) : ~k); }
__device__ __forceinline__ int bin1(float s, float lo, float scale) { return min(NBIN - 1, max(0, (int)((s - lo) * scale))); }
template <int OFF> __device__ __forceinline__ s16x4 tr_read(unsigned addr) {
    s16x4 r; asm volatile("ds_read_b64_tr_b16 %0, %1 offset:%2" : "=&v"(r) : "v"(addr), "i"(OFF) : "memory"); return r;
}
__device__ __forceinline__ void scan_top(const int* hist, int K, int* m, int lane) {
    int c[16];
#pragma unroll
    for (int i = 0; i < 4; ++i) { const int4 v = *(const int4*)(hist + 16 * lane + 4 * i); c[4 * i] = v.x; c[4 * i + 1] = v.y; c[4 * i + 2] = v.z; c[4 * i + 3] = v.w; }
    int tot = 0;
#pragma unroll
    for (int i = 0; i < 16; ++i) tot += c[i];
    int suf = tot;
#pragma unroll
    for (int o = 1; o < 64; o <<= 1) { const int t = __shfl_down(suf, o); if (lane + o < 64) suf += t; }
    int above = suf - tot;
#pragma unroll
    for (int i = 15; i >= 0; --i) {
        if (above < K && K <= above + c[i]) { m[0] = 16 * lane + i; m[1] = above; m[2] = c[i]; }
        above += c[i];
    }
}

__device__ __forceinline__ void attn4_unit(const P& p, unsigned char* lds, int b, int grp) {
    const int tid = tid_(), lane = tid & 63, wid = __builtin_amdgcn_readfirstlane(tid >> 6);
    const int t0 = NMETA + 4 * grp;
    const int brow = b * LP, row0 = brow + t0;
    float* sc = (float*)(lds + A_SC);
    int* h1 = (int*)(lds + A_H1);
    unsigned short* sel = (unsigned short*)(lds + A_SEL); unsigned short* cand = (unsigned short*)(lds + A_CAND);
    int* meta = (int*)(lds + A_META);
    const bool big = t0 + 1 > 256;
    for (int i = tid; i < 4 * NBIN; i += NTHREADS) h1[i] = 0;
    if (tid < 64) { const int w = tid & 15; meta[tid] = (w == 0) ? -1 : 0; }
    if (!big) { for (int i = tid; i < 1024; i += NTHREADS) { const int q = i >> 8, j = i & 255; sel[i] = (unsigned short)(j <= t0 + q ? j : 0); } }
    __syncthreads();
    if (big) {
        {
            const int hh = lane >> 5, c32 = lane & 31;
            const int g = c32 >> 3, h2a = (c32 >> 2) & 1, bq = c32 & 3, aq = 2 * h2a + (g >> 1), ah = 4 * (g & 1) + bq;
            const bf16_t* ap = p.iq() + (size_t)(row0 + aq) * 256 + ah * 32 + 8 * hh;
            const bf16x8 a0 = *(const bf16x8*)ap, a1 = *(const bf16x8*)(ap + 16);
            const f32x4 w00 = *(const f32x4*)(p.iw() + (size_t)(row0 + 2 * hh) * 8), w01 = *(const f32x4*)(p.iw() + (size_t)(row0 + 2 * hh) * 8 + 4);
            const f32x4 w10 = *(const f32x4*)(p.iw() + (size_t)(row0 + 2 * hh + 1) * 8), w11 = *(const f32x4*)(p.iw() + (size_t)(row0 + 2 * hh + 1) * 8 + 4);
            const int ntiles = (t0 + 4 + 31) >> 5;
            const int tq0 = t0 + 2 * hh;
            float mx0 = -INFINITY, mn0 = INFINITY, mx1 = -INFINITY, mn1 = INFINITY;
            const bf16_t* kbase = p.ik() + (size_t)brow * 32 + 8 * hh;
            for (int tile0 = wid; tile0 < ntiles; tile0 += 128) {
                bf16x8 b0[16], b1[16];
#pragma unroll
                for (int j = 0; j < 16; ++j) {
                    const int tile = min(tile0 + 8 * j, ntiles - 1);
                    const bf16_t* kp = kbase + (size_t)(tile * 32 + c32) * 32;
                    b0[j] = *(const bf16x8*)kp; b1[j] = *(const bf16x8*)(kp + 16);
                }
                __builtin_amdgcn_sched_barrier(0);
#pragma unroll
                for (int j = 0; j < 16; ++j) {
                    const int tile = tile0 + 8 * j;
                    if (tile < ntiles) {
                        const int key = tile * 32 + c32;
                        f32x16 acc;
#pragma unroll
                        for (int i = 0; i < 16; ++i) acc[i] = 0.f;
                        acc = __builtin_amdgcn_mfma_f32_32x32x16_bf16(a0, b0[j], acc, 0, 0, 0);
                        acc = __builtin_amdgcn_mfma_f32_32x32x16_bf16(a1, b1[j], acc, 0, 0, 0);
                        float s0 = 0.f, s1 = 0.f;
#pragma unroll
                        for (int i = 0; i < 4; ++i) {
                            s0 += w00[i] * fmaxf(acc[i], 0.f) + w01[i] * fmaxf(acc[4 + i], 0.f);
                            s1 += w10[i] * fmaxf(acc[8 + i], 0.f) + w11[i] * fmaxf(acc[12 + i], 0.f);
                        }
                        sc[(2 * hh) * NKMAX + key] = s0; sc[(2 * hh + 1) * NKMAX + key] = s1;
                        if (key <= tq0) { mx0 = fmaxf(mx0, s0); mn0 = fminf(mn0, s0); }
                        if (key <= tq0 + 1) { mx1 = fmaxf(mx1, s1); mn1 = fminf(mn1, s1); }
                    }
                }
            }
#pragma unroll
            for (int o = 16; o >= 1; o >>= 1) {
                mx0 = fmaxf(mx0, __shfl_xor(mx0, o)); mn0 = fminf(mn0, __shfl_xor(mn0, o));
                mx1 = fmaxf(mx1, __shfl_xor(mx1, o)); mn1 = fminf(mn1, __shfl_xor(mn1, o));
            }
            if (c32 == 0) {
                if (mx0 >= mn0) { atomicMin((unsigned*)&meta[(2 * hh) * 16 + 0], skey(mn0)); atomicMax((unsigned*)&meta[(2 * hh) * 16 + 1], skey(mx0)); }
                if (mx1 >= mn1) { atomicMin((unsigned*)&meta[(2 * hh + 1) * 16 + 0], skey(mn1)); atomicMax((unsigned*)&meta[(2 * hh + 1) * 16 + 1], skey(mx1)); }
            }
        }
        __syncthreads();
        const int q = wid & 3, part = wid >> 2, n = t0 + q + 1;
        const float lo = skey_inv((unsigned)meta[q * 16 + 0]), hi = skey_inv((unsigned)meta[q * 16 + 1]);
        const float scale = hi > lo ? (float)NBIN / (hi - lo) : 0.f;
        const float* scq = sc + q * NKMAX;
        for (int base = part * 256; base < n; base += 512) {
            const int idx0 = base + lane * 4;
            if (idx0 < n) {
                const f32x4 v = *(const f32x4*)(scq + idx0);
#pragma unroll
                for (int j = 0; j < 4; ++j) if (idx0 + j < n) atomicAdd(&h1[q * NBIN + bin1(v[j], lo, scale)], 1);
            }
        }
        __syncthreads();
        if (wid < 4) scan_top(h1 + wid * NBIN, 256, meta + wid * 16 + 4, lane);
        __syncthreads();
        const int B1 = meta[q * 16 + 4];
        for (int base = part * 256; base < n; base += 512) {
            const int idx0 = base + lane * 4;
            f32x4 v = (f32x4){0.f, 0.f, 0.f, 0.f};
            if (idx0 < n) v = *(const f32x4*)(scq + idx0);
            const unsigned long long lt = (1ull << lane) - 1ull;
#pragma unroll
            for (int j = 0; j < 4; ++j) {
                const int idx = idx0 + j;
                bool issel = false, iscand = false;
                if (idx < n) { const int b1 = bin1(v[j], lo, scale); issel = b1 > B1; iscand = b1 == B1; }
                const unsigned long long ms = __ballot(issel), mc = __ballot(iscand);
                if (ms) {
                    int bs = 0; if (lane == 0) bs = atomicAdd(&meta[q * 16 + 2], __popcll(ms));
                    bs = __shfl(bs, 0);
                    if (issel) sel[q * 256 + bs + __popcll(ms & lt)] = (unsigned short)idx;
                }
                if (mc) {
                    int bs = 0; if (lane == 0) bs = atomicAdd(&meta[q * 16 + 3], __popcll(mc));
                    bs = __shfl(bs, 0);
                    const int pos = bs + __popcll(mc & lt);
                    if (iscand && pos < 128) cand[q * 128 + pos] = (unsigned short)idx;
                }
            }
        }
        __syncthreads();
        if (wid < 4) {
            const int qq = wid; const float* scr = sc + qq * NKMAX;
            const int rq = 256 - meta[qq * 16 + 5], cq = meta[qq * 16 + 6], sbase = 256 - rq, nn = t0 + qq + 1;
            if (cq <= 128) {
                int taken = 0;
#pragma unroll
                for (int half = 0; half < 2; ++half) {
                    const int i = lane + 64 * half;
                    bool take = false; int myidx = 0;
                    if (i < cq) {
                        myidx = cand[qq * 128 + i]; const float mv = scr[myidx];
                        int rank = 0;
                        for (int j = 0; j < cq; ++j) { const int oj = cand[qq * 128 + j]; const float ov = scr[oj]; rank += (ov > mv) || (ov == mv && oj < myidx); }
                        take = rank < rq;
                    }
                    const unsigned long long mt = __ballot(take);
                    if (take) sel[qq * 256 + sbase + taken + __popcll(mt & ((1ull << lane) - 1ull))] = (unsigned short)myidx;
                    taken += __popcll(mt);
                }
            } else {
                const float lo_ = skey_inv((unsigned)meta[qq * 16 + 0]), hi_ = skey_inv((unsigned)meta[qq * 16 + 1]);
                const float sc_ = hi_ > lo_ ? (float)NBIN / (hi_ - lo_) : 0.f;
                const int B1_ = meta[qq * 16 + 4];
                int taken = 0;
                for (int base = 0; base < nn && taken < rq; base += 64) {
                    const int idx = base + lane; bool isc = false;
                    if (idx < nn) isc = bin1(scr[idx], lo_, sc_) == B1_;
                    const unsigned long long mc = __ballot(isc);
                    const int pos = taken + __popcll(mc & ((1ull << lane) - 1ull));
                    if (isc && pos < rq) sel[qq * 256 + sbase + pos] = (unsigned short)idx;
                    taken += __popcll(mc);
                }
            }
        }
        __syncthreads();
    }
    {
        const int q = wid >> 1, kvh = wid & 1, tq = t0 + q, nsel = min(tq + 1, 256);
        const int col = lane & 15, g4 = lane >> 4;
        const unsigned short* selq = sel + q * 256;
        bf16x8 qf0, qf1;
        {
            const bf16_t* qp = p.q() + (size_t)(row0 + q) * 512 + (kvh * 4 + (col & 3)) * 64 + g4 * 8;
            qf0 = *(const bf16x8*)qp; qf1 = *(const bf16x8*)(qp + 32);
            if (col >= 4) {
#pragma unroll
                for (int i = 0; i < 8; ++i) { qf0[i] = 0; qf1[i] = 0; }
            }
        }
        LAS unsigned char* vst = (LAS unsigned char*)lds + A_SC + wid * 16384;
        const bf16_t* vb = p.v() + (size_t)brow * 128 + kvh * 64 + (lane & 7) * 8;
        const unsigned rdbase = (unsigned)(uintptr_t)((LAS unsigned char*)lds + A_SC) + wid * 16384 + (4 * g4 + (col >> 2)) * 128 + (col & 3) * 8;
#define V_STAGE(s_, buf_) do { _Pragma("unroll") for (int i_ = 0; i_ < 4; ++i_) { \
            const int ksl_ = (s_) * 32 + i_ * 8 + (lane >> 3); const int key_ = selq[ksl_]; \
            __builtin_amdgcn_global_load_lds((const unsigned*)(vb + (size_t)key_ * 128), (LAS unsigned*)(vst + (buf_) * 4096 + i_ * 1024), 16, 0, 0); } } while (0)
        const bf16_t* kb = p.k() + (size_t)brow * 128 + kvh * 64 + g4 * 8;
        f32x4 lg[16];
        u32x4 vr[16];
        {
            bf16x8 k0[16], k1[16];
#pragma unroll
            for (int t = 0; t < 16; ++t) {
                const int key = selq[t * 16 + col];
                const bf16_t* kp = kb + (size_t)key * 128;
                k0[t] = *(const bf16x8*)kp; k1[t] = *(const bf16x8*)(kp + 32);
            }
#pragma unroll
            for (int s = 4; s < 8; ++s)
#pragma unroll
                for (int i = 0; i < 4; ++i) { const int key = selq[s * 32 + i * 8 + (lane >> 3)]; vr[(s - 4) * 4 + i] = *(const u32x4*)(vb + (size_t)key * 128); }
            V_STAGE(0, 0); V_STAGE(1, 1); V_STAGE(2, 2); V_STAGE(3, 3);
            __builtin_amdgcn_sched_barrier(0);
#pragma unroll
            for (int t = 0; t < 16; ++t) {
                f32x4 a = (f32x4){0.f, 0.f, 0.f, 0.f};
                a = __builtin_amdgcn_mfma_f32_16x16x32_bf16(k0[t], qf0, a, 0, 0, 0);
                a = __builtin_amdgcn_mfma_f32_16x16x32_bf16(k1[t], qf1, a, 0, 0, 0);
                lg[t] = a;
            }
            __builtin_amdgcn_sched_barrier(0);
        }
        float mx = -INFINITY;
#pragma unroll
        for (int t = 0; t < 16; ++t)
#pragma unroll
            for (int j = 0; j < 4; ++j) { if (t * 16 + g4 * 4 + j >= nsel) lg[t][j] = -INFINITY; mx = fmaxf(mx, lg[t][j]); }
        mx = fmaxf(mx, __shfl_xor(mx, 16)); mx = fmaxf(mx, __shfl_xor(mx, 32));
        float sm = 0.f;
#pragma unroll
        for (int t = 0; t < 16; ++t)
#pragma unroll
            for (int j = 0; j < 4; ++j) { const float e = __builtin_amdgcn_exp2f(lg[t][j] - mx); lg[t][j] = e; sm += e; }
        sm += __shfl_xor(sm, 16); sm += __shfl_xor(sm, 32);
        const float inv = 1.0f / sm;
        f32x4 o[4];
#pragma unroll
        for (int d = 0; d < 4; ++d) o[d] = (f32x4){0.f, 0.f, 0.f, 0.f};
        asm volatile("s_waitcnt vmcnt(0)" ::: "memory");
#pragma unroll
        for (int s = 0; s < 8; ++s) {
            if (s >= 4) {
#pragma unroll
                for (int i = 0; i < 4; ++i) *(LAS u32x4*)(vst + (s & 3) * 4096 + i * 1024 + lane * 16) = vr[(s - 4) * 4 + i];
                asm volatile("s_waitcnt lgkmcnt(0)" ::: "memory");
            }
            const unsigned rb = rdbase + (s & 3) * 4096;
            const s16x4 l0 = tr_read<0>(rb), h0 = tr_read<2048>(rb), l1 = tr_read<32>(rb), h1_ = tr_read<2048 + 32>(rb);
            const s16x4 l2 = tr_read<64>(rb), h2_ = tr_read<2048 + 64>(rb), l3 = tr_read<96>(rb), h3 = tr_read<2048 + 96>(rb);
            asm volatile("s_waitcnt lgkmcnt(0)" ::: "memory");
            __builtin_amdgcn_sched_barrier(0);
            bf16x8 pa;
            {
                const uint32_t w0 = pack2(lg[2 * s][0], lg[2 * s][1]), w1 = pack2(lg[2 * s][2], lg[2 * s][3]);
                const uint32_t w2 = pack2(lg[2 * s + 1][0], lg[2 * s + 1][1]), w3 = pack2(lg[2 * s + 1][2], lg[2 * s + 1][3]);
                pa[0] = (short)(w0 & 0xffff); pa[1] = (short)(w0 >> 16); pa[2] = (short)(w1 & 0xffff); pa[3] = (short)(w1 >> 16);
                pa[4] = (short)(w2 & 0xffff); pa[5] = (short)(w2 >> 16); pa[6] = (short)(w3 & 0xffff); pa[7] = (short)(w3 >> 16);
            }
#define PKV(L, H) (bf16x8){L[0], L[1], L[2], L[3], H[0], H[1], H[2], H[3]}
            o[0] = __builtin_amdgcn_mfma_f32_16x16x32_bf16(pa, PKV(l0, h0), o[0], 0, 0, 0);
            o[1] = __builtin_amdgcn_mfma_f32_16x16x32_bf16(pa, PKV(l1, h1_), o[1], 0, 0, 0);
            o[2] = __builtin_amdgcn_mfma_f32_16x16x32_bf16(pa, PKV(l2, h2_), o[2], 0, 0, 0);
            o[3] = __builtin_amdgcn_mfma_f32_16x16x32_bf16(pa, PKV(l3, h3), o[3], 0, 0, 0);
#undef PKV
        }
#undef V_STAGE
        const float i0 = __shfl(inv, 0), i1 = __shfl(inv, 1), i2 = __shfl(inv, 2), i3 = __shfl(inv, 3);
        if (g4 == 0) {
            bf16_t* op = p.att() + (size_t)(row0 + q) * 512 + kvh * 256 + col;
#pragma unroll
            for (int d = 0; d < 4; ++d) {
                op[0 * 64 + d * 16] = f2bf(o[d][0] * i0); op[1 * 64 + d * 16] = f2bf(o[d][1] * i1);
                op[2 * 64 + d * 16] = f2bf(o[d][2] * i2); op[3 * 64 + d * 16] = f2bf(o[d][3] * i3);
            }
        }
    }
    __syncthreads();
}

constexpr int NBW = 512;
constexpr int W_SC = 0, W_H = W_SC + NKMAX * 2, W_SEL = W_H + NBW * 4, W_CAND = W_SEL + 512, W_SZ = W_CAND + 256;
static_assert(8 * W_SZ <= LDS_BYTES - 32, "wave attention LDS");
__device__ __forceinline__ int binw(float s, float lo, float scale) { return min(NBW - 1, max(0, (int)((s - lo) * scale))); }

__device__ __forceinline__ void attn_wave(const P& p, unsigned char* lds, int wid, int lane, int b, int t, float mn, float mx) {
    unsigned char* wl = lds + wid * W_SZ;
    _Float16* sc = (_Float16*)(wl + W_SC);
    int* hist = (int*)(wl + W_H);
    unsigned short* sel = (unsigned short*)(wl + W_SEL);
    unsigned short* cand = (unsigned short*)(wl + W_CAND);
    const int brow = b * LP, row = brow + t, n = t + 1;
    const int col = lane & 15, g4 = lane >> 4;
    const unsigned long long lt = (1ull << lane) - 1ull;
    int nsel = 256;
    if (n > 256) {
        const float scale = mx > mn ? (float)NBW / (mx - mn) : 0.f, nls = -mn * scale;
#define BINF(x) min(NBW - 1, max(0, (int)__builtin_fmaf((x), scale, nls)))
#define H2F(u16) ((float)__builtin_bit_cast(_Float16, (unsigned short)(u16)))
        for (int base = 0; base < n; base += 512) {
            const int ia = base + lane * 4, ib = ia + 256;
            uint2 ra = make_uint2(0u, 0u), rb2 = make_uint2(0u, 0u);
            if (ia < n) ra = *(const uint2*)(sc + ia);
            if (ib < n) rb2 = *(const uint2*)(sc + ib);
            const unsigned wa[4] = {ra.x & 0xffffu, ra.x >> 16, ra.y & 0xffffu, ra.y >> 16}, wb[4] = {rb2.x & 0xffffu, rb2.x >> 16, rb2.y & 0xffffu, rb2.y >> 16};
#pragma unroll
            for (int j = 0; j < 4; ++j) {
                if (ia + j < n) atomicAdd(&hist[BINF(H2F(wa[j]))], 1);
                if (ib + j < n) atomicAdd(&hist[BINF(H2F(wb[j]))], 1);
            }
        }
        int B1, above1, cnt1;
        {
            int c[8];
            const int4 v0 = *(const int4*)(hist + 8 * lane), v1 = *(const int4*)(hist + 8 * lane + 4);
            c[0] = v0.x; c[1] = v0.y; c[2] = v0.z; c[3] = v0.w; c[4] = v1.x; c[5] = v1.y; c[6] = v1.z; c[7] = v1.w;
            int tot = 0;
#pragma unroll
            for (int i = 0; i < 8; ++i) tot += c[i];
            int suf = tot;
#pragma unroll
            for (int o = 1; o < 64; o <<= 1) { const int tt = __shfl_down(suf, o); if (lane + o < 64) suf += tt; }
            int above = suf - tot;
            const bool mine = above < 256 && 256 <= above + tot;
            int bb = 0, ab = 0, cb = 0;
#pragma unroll
            for (int i = 7; i >= 0; --i) { if (above < 256 && 256 <= above + c[i]) { bb = 8 * lane + i; ab = above; cb = c[i]; } above += c[i]; }
            const int src = (int)__builtin_ctzll(__ballot(mine));
            B1 = __shfl(bb, src); above1 = __shfl(ab, src); cnt1 = __shfl(cb, src);
        }
        int selcnt = 0, candcnt = 0;
        for (int base = 0; base < n; base += 512) {
            const int ia = base + lane * 4, ib = ia + 256;
            uint2 ra = make_uint2(0u, 0u), rb2 = make_uint2(0u, 0u);
            if (ia < n) ra = *(const uint2*)(sc + ia);
            if (ib < n) rb2 = *(const uint2*)(sc + ib);
            const unsigned wv[8] = {ra.x & 0xffffu, ra.x >> 16, ra.y & 0xffffu, ra.y >> 16, rb2.x & 0xffffu, rb2.x >> 16, rb2.y & 0xffffu, rb2.y >> 16};
            unsigned smask = 0u, cmask = 0u;
#pragma unroll
            for (int j = 0; j < 8; ++j) {
                const int idx = (j < 4 ? ia : ib) + (j & 3);
                const int b1 = idx < n ? BINF(H2F(wv[j])) : -1;
                smask |= (b1 > B1 ? 1u : 0u) << j; cmask |= (b1 == B1 ? 1u : 0u) << j;
            }
            const int cnt = __popc(smask);
            int inc = cnt;
#pragma unroll
            for (int o = 1; o < 64; o <<= 1) { const int tt = __shfl_up(inc, o); if (lane >= o) inc += tt; }
            int pos = selcnt + inc - cnt;
#pragma unroll
            for (int j = 0; j < 8; ++j) if ((smask >> j) & 1u) { sel[pos] = (unsigned short)((j < 4 ? ia : ib) + (j & 3)); ++pos; }
            selcnt += __shfl(inc, 63);
            if (__ballot(cmask != 0u)) {
#pragma unroll
                for (int j = 0; j < 8; ++j) {
                    const bool isc = (cmask >> j) & 1u;
                    const unsigned long long mc = __ballot(isc);
                    const int cp = candcnt + __popcll(mc & lt);
                    if (isc && cp < 128) cand[cp] = (unsigned short)((j < 4 ? ia : ib) + (j & 3));
                    candcnt += __popcll(mc);
                }
            }
        }
        {
            const int rq = 256 - above1, cq = cnt1, sbase = 256 - rq;
            if (cq <= 128) {
                int taken = 0;
#pragma unroll
                for (int half = 0; half < 2; ++half) {
                    const int i = lane + 64 * half;
                    bool take = false; int myidx = 0;
                    if (i < cq) {
                        myidx = cand[i]; const float mv = (float)sc[myidx];
                        int rank = 0;
                        for (int j = 0; j < cq; ++j) { const int oj = cand[j]; const float ov = (float)sc[oj]; rank += (ov > mv) || (ov == mv && oj < myidx); }
                        take = rank < rq;
                    }
                    const unsigned long long mt = __ballot(take);
                    if (take) sel[sbase + taken + __popcll(mt & lt)] = (unsigned short)myidx;
                    taken += __popcll(mt);
                }
            } else {
                int taken = 0;
                for (int base = 0; base < n && taken < rq; base += 64) {
                    const int idx = base + lane; bool isc = false;
                    if (idx < n) isc = BINF((float)sc[idx]) == B1;
                    const unsigned long long mc = __ballot(isc);
                    const int pos = taken + __popcll(mc & lt);
                    if (isc && pos < rq) sel[sbase + pos] = (unsigned short)idx;
                    taken += __popcll(mc);
                }
            }
        }
#undef BINF
#undef H2F
    } else {
        nsel = n;
#pragma unroll
        for (int i = 0; i < 4; ++i) { const int j = lane + 64 * i; sel[j] = (unsigned short)(j < n ? j : 0); }
    }
    LAS unsigned char* vst = (LAS unsigned char*)wl + W_SC;
    const unsigned rdbase = (unsigned)(uintptr_t)((LAS unsigned char*)wl + W_SC) + (4 * g4 + (col >> 2)) * 256 + (col & 3) * 8;
    {
        bf16x8 qf[4];
        {
            const bf16_t* qp = p.q() + (size_t)row * 512 + (col & 7) * 64 + g4 * 8;
            const bf16x8 q0 = *(const bf16x8*)qp, q1 = *(const bf16x8*)(qp + 32);
            const bool lo_grp = col < 4, hi_grp = col >= 4 && col < 8;
#pragma unroll
            for (int i = 0; i < 8; ++i) { qf[0][i] = lo_grp ? q0[i] : (short)0; qf[1][i] = lo_grp ? q1[i] : (short)0; qf[2][i] = hi_grp ? q0[i] : (short)0; qf[3][i] = hi_grp ? q1[i] : (short)0; }
        }
        const bf16_t* vb = p.v() + (size_t)brow * 128 + (lane & 15) * 8;
#define V_STAGE(s_, buf_) do { _Pragma("unroll") for (int i_ = 0; i_ < 4; ++i_) { \
            const int key_ = sel[(s_) * 16 + i_ * 4 + (lane >> 4)]; \
            __builtin_amdgcn_global_load_lds((const unsigned*)(vb + (size_t)key_ * 128), (LAS unsigned*)(vst + (buf_) * 4096 + i_ * 1024), 16, 0, 0); } } while (0)
        const bf16_t* kg = p.k() + (size_t)brow * 128;
#define K_STAGE(s_, buf_) do { _Pragma("unroll") for (int i_ = 0; i_ < 4; ++i_) { \
            const int kl_ = i_ * 4 + (lane >> 4); const int key_ = sel[(s_) * 16 + kl_]; \
            __builtin_amdgcn_global_load_lds((const unsigned*)(kg + (size_t)key_ * 128 + (((lane & 15) ^ kl_) & 15) * 8), (LAS unsigned*)(vst + (buf_) * 4096 + i_ * 1024), 16, 0, 0); } } while (0)
        f32x4 lg[16];
        K_STAGE(0, 0); K_STAGE(1, 1); K_STAGE(2, 2);
#pragma unroll
        for (int s = 0; s < 16; ++s) {
            if (s + 3 < 16) { K_STAGE(s + 3, (s + 3) & 3); asm volatile("s_waitcnt vmcnt(12)" ::: "memory"); }
            else if (s == 13) asm volatile("s_waitcnt vmcnt(8)" ::: "memory");
            else if (s == 14) asm volatile("s_waitcnt vmcnt(4)" ::: "memory");
            else asm volatile("s_waitcnt vmcnt(0)" ::: "memory");
            bf16x8 kf[4];
#pragma unroll
            for (int ks = 0; ks < 4; ++ks) kf[ks] = *(const LAS bf16x8*)(vst + (s & 3) * 4096 + col * 256 + (((ks * 4 + g4) ^ col) & 15) * 16);
            asm volatile("s_waitcnt lgkmcnt(0)" ::: "memory");
            __builtin_amdgcn_sched_barrier(0);
            f32x4 a = (f32x4){0.f, 0.f, 0.f, 0.f};
#pragma unroll
            for (int ks = 0; ks < 4; ++ks) a = __builtin_amdgcn_mfma_f32_16x16x32_bf16(kf[ks], qf[ks], a, 0, 0, 0);
            lg[s] = a;
        }
#undef K_STAGE
        V_STAGE(0, 0); V_STAGE(1, 1); V_STAGE(2, 2);
        float mxl = -INFINITY;
#pragma unroll
        for (int tt = 0; tt < 16; ++tt)
#pragma unroll
            for (int j = 0; j < 4; ++j) { if (tt * 16 + g4 * 4 + j >= nsel) lg[tt][j] = -INFINITY; mxl = fmaxf(mxl, lg[tt][j]); }
        mxl = fmaxf(mxl, __shfl_xor(mxl, 16)); mxl = fmaxf(mxl, __shfl_xor(mxl, 32));
        float sm = 0.f;
#pragma unroll
        for (int tt = 0; tt < 16; ++tt)
#pragma unroll
            for (int j = 0; j < 4; ++j) { const float e = __builtin_amdgcn_exp2f(lg[tt][j] - mxl); lg[tt][j] = e; sm += e; }
        sm += __shfl_xor(sm, 16); sm += __shfl_xor(sm, 32);
        const float inv = 1.0f / sm;
        f32x4 o[8];
#pragma unroll
        for (int d = 0; d < 8; ++d) o[d] = (f32x4){0.f, 0.f, 0.f, 0.f};
#pragma unroll
        for (int s = 0; s < 16; ++s) {
            if (s + 3 < 16) { V_STAGE(s + 3, (s + 3) & 3); asm volatile("s_waitcnt vmcnt(12)" ::: "memory"); }
            else if (s == 13) asm volatile("s_waitcnt vmcnt(8)" ::: "memory");
            else if (s == 14) asm volatile("s_waitcnt vmcnt(4)" ::: "memory");
            else asm volatile("s_waitcnt vmcnt(0)" ::: "memory");
            const unsigned rb = rdbase + (s & 3) * 4096;
            s16x4 pa;
            {
                const uint32_t w0 = pack2(lg[s][0], lg[s][1]), w1 = pack2(lg[s][2], lg[s][3]);
                pa[0] = (short)(w0 & 0xffff); pa[1] = (short)(w0 >> 16); pa[2] = (short)(w1 & 0xffff); pa[3] = (short)(w1 >> 16);
            }
            const s16x4 v0 = tr_read<0>(rb), v1 = tr_read<32>(rb), v2 = tr_read<64>(rb), v3 = tr_read<96>(rb);
            const s16x4 v4 = tr_read<128>(rb), v5 = tr_read<160>(rb), v6 = tr_read<192>(rb), v7 = tr_read<224>(rb);
            asm volatile("s_waitcnt lgkmcnt(0)" ::: "memory");
            __builtin_amdgcn_sched_barrier(0);
            o[0] = __builtin_amdgcn_mfma_f32_16x16x16bf16_1k(pa, v0, o[0], 0, 0, 0); o[1] = __builtin_amdgcn_mfma_f32_16x16x16bf16_1k(pa, v1, o[1], 0, 0, 0);
            o[2] = __builtin_amdgcn_mfma_f32_16x16x16bf16_1k(pa, v2, o[2], 0, 0, 0); o[3] = __builtin_amdgcn_mfma_f32_16x16x16bf16_1k(pa, v3, o[3], 0, 0, 0);
            o[4] = __builtin_amdgcn_mfma_f32_16x16x16bf16_1k(pa, v4, o[4], 0, 0, 0); o[5] = __builtin_amdgcn_mfma_f32_16x16x16bf16_1k(pa, v5, o[5], 0, 0, 0);
            o[6] = __builtin_amdgcn_mfma_f32_16x16x16bf16_1k(pa, v6, o[6], 0, 0, 0); o[7] = __builtin_amdgcn_mfma_f32_16x16x16bf16_1k(pa, v7, o[7], 0, 0, 0);
        }
#undef V_STAGE
        float ih[4];
#pragma unroll
        for (int jj = 0; jj < 4; ++jj) ih[jj] = __shfl(inv, 4 * (g4 & 1) + jj);
        if (g4 < 2) {
            bf16_t* op = p.att() + (size_t)row * 512 + (g4 * 4) * 64 + col;
#pragma unroll
            for (int d = 0; d < 4; ++d) {
                const f32x4 oa_ = o[d], ob_ = o[4 + d]; f32x4 ov;
#pragma unroll
                for (int kk = 0; kk < 4; ++kk) ov[kk] = g4 == 0 ? oa_[kk] : ob_[kk];
                op[0 * 64 + d * 16] = f2bf(ov[0] * ih[0]); op[1 * 64 + d * 16] = f2bf(ov[1] * ih[1]);
                op[2 * 64 + d * 16] = f2bf(ov[2] * ih[2]); op[3 * 64 + d * 16] = f2bf(ov[3] * ih[3]);
            }
        }
    }
}

constexpr int A8_META = 8 * W_SZ;
static_assert(A8_META + 64 + 512 <= LDS_BYTES - 32, "attn8 meta");
__device__ __forceinline__ void attn8_unit(const P& p, unsigned char* lds, int b, int grp) {
    const int tid = tid_(), lane = tid & 63, wid = __builtin_amdgcn_readfirstlane(tid >> 6);
    const int t0 = NMETA + 8 * grp, brow = b * LP, row0 = brow + t0;
    unsigned* meta = (unsigned*)(lds + A8_META);
    const bool big = t0 + 1 > 256;
    if (tid < 16) meta[tid] = (tid & 1) ? 0u : 0xffffffffu;
    bf16_t* uvec = (bf16_t*)(lds + A8_META + 64);
    if (big && tid < 256) {
        const int q = tid >> 5, d = tid & 31;
        const bf16_t* ip = p.iq() + (size_t)(row0 + q) * 256 + d; const float* wp = p.iw() + (size_t)(row0 + q) * 8;
        float u = 0.f;
#pragma unroll
        for (int h = 0; h < 8; ++h) u += wp[h] * bf2f(ip[h * 32]);
        uvec[q * 32 + d] = f2bf(u);
    }
    for (int i = tid; i < 8 * NBW; i += NTHREADS) ((int*)(lds + (i / NBW) * W_SZ + W_H))[i % NBW] = 0;
    __syncthreads();
    if (big) {
        const int hh = lane >> 5, c32 = lane & 31;
        const int g = c32 >> 3, h2a = (c32 >> 2) & 1, bq = c32 & 3, aq = 2 * h2a + (g >> 1), ah = 4 * (g & 1) + bq;
        bf16x8 a0[2], a1[2]; f32x4 w[2][2][2];
#pragma unroll
        for (int r = 0; r < 2; ++r) {
            const bf16_t* ap = p.iq() + (size_t)(row0 + 4 * r + aq) * 256 + ah * 32 + 8 * hh;
            a0[r] = *(const bf16x8*)ap; a1[r] = *(const bf16x8*)(ap + 16);
#pragma unroll
            for (int qi = 0; qi < 2; ++qi) {
                const float* wp = p.iw() + (size_t)(row0 + 4 * r + 2 * hh + qi) * 8;
                w[r][qi][0] = *(const f32x4*)wp; w[r][qi][1] = *(const f32x4*)(wp + 4);
            }
        }
        bf16x8 au0, au1;
        {
            const int uq = 4 * ((c32 & 3) >> 1) + 2 * ((c32 >> 2) & 1) + (c32 & 1);
            const bf16x8 v0 = *(const bf16x8*)(uvec + uq * 32 + 8 * hh), v1 = *(const bf16x8*)(uvec + uq * 32 + 8 * hh + 16);
#pragma unroll
            for (int i = 0; i < 8; ++i) { au0[i] = c32 < 8 ? v0[i] : (short)0; au1[i] = c32 < 8 ? v1[i] : (short)0; }
        }
        const int ntiles = (t0 + 8 + 31) >> 5;
        float mx[2][2], mn[2][2];
#pragma unroll
        for (int r = 0; r < 2; ++r)
#pragma unroll
            for (int qi = 0; qi < 2; ++qi) { mx[r][qi] = -INFINITY; mn[r][qi] = INFINITY; }
        const bf16_t* kbase = p.ik() + (size_t)brow * 32 + 8 * hh;
        bf16x8 b0[8], b1[8], c0[8], c1[8];
#define S_LOAD(B0, B1, T0) do { _Pragma("unroll") for (int j = 0; j < 8; ++j) { const int tile_ = min((T0) + 8 * j, ntiles - 1); \
            const bf16_t* kp_ = kbase + (size_t)(tile_ * 32 + c32) * 32; B0[j] = *(const bf16x8*)kp_; B1[j] = *(const bf16x8*)(kp_ + 16); } } while (0)
#define S_COMP(B0, B1, T0) do { _Pragma("unroll") for (int j = 0; j < 8; ++j) { const int tile = (T0) + 8 * j; if (tile < ntiles) { const int key = tile * 32 + c32; \
            f32x16 acu; _Pragma("unroll") for (int i = 0; i < 16; ++i) acu[i] = 0.f; \
            acu = __builtin_amdgcn_mfma_f32_32x32x16_bf16(au0, B0[j], acu, 0, 0, 0); acu = __builtin_amdgcn_mfma_f32_32x32x16_bf16(au1, B1[j], acu, 0, 0, 0); \
            _Pragma("unroll") for (int r = 0; r < 2; ++r) { f32x16 acc; _Pragma("unroll") for (int i = 0; i < 16; ++i) acc[i] = 0.f; \
                acc = __builtin_amdgcn_mfma_f32_32x32x16_bf16(a0[r], B0[j], acc, 0, 0, 0); acc = __builtin_amdgcn_mfma_f32_32x32x16_bf16(a1[r], B1[j], acc, 0, 0, 0); \
                _Pragma("unroll") for (int qi = 0; qi < 2; ++qi) { float s = acu[2 * r + qi]; \
                    _Pragma("unroll") for (int i = 0; i < 4; ++i) s += w[r][qi][0][i] * __builtin_fabsf(acc[8 * qi + i]) + w[r][qi][1][i] * __builtin_fabsf(acc[8 * qi + 4 + i]); \
                    const int q = 4 * r + 2 * hh + qi; const _Float16 hs = (_Float16)fminf(fmaxf(s, -60000.f), 60000.f); \
                    ((_Float16*)(lds + q * W_SZ + W_SC))[key] = hs; \
                    if (key <= t0 + q) { const float f = (float)hs; mx[r][qi] = fmaxf(mx[r][qi], f); mn[r][qi] = fminf(mn[r][qi], f); } } } } } } while (0)
        S_LOAD(b0, b1, wid);
        for (int tile0 = wid; tile0 < ntiles; tile0 += 128) {
            if (tile0 + 64 < ntiles) S_LOAD(c0, c1, tile0 + 64);
            __builtin_amdgcn_sched_barrier(0);
            S_COMP(b0, b1, tile0);
            __builtin_amdgcn_sched_barrier(0);
            if (tile0 + 128 < ntiles) S_LOAD(b0, b1, tile0 + 128);
            __builtin_amdgcn_sched_barrier(0);
            if (tile0 + 64 < ntiles) S_COMP(c0, c1, tile0 + 64);
            __builtin_amdgcn_sched_barrier(0);
        }
#undef S_LOAD
#undef S_COMP
#pragma unroll
        for (int r = 0; r < 2; ++r)
#pragma unroll
            for (int qi = 0; qi < 2; ++qi) {
                float a = mx[r][qi], c = mn[r][qi];
#pragma unroll
                for (int o = 16; o >= 1; o >>= 1) { a = fmaxf(a, __shfl_xor(a, o)); c = fminf(c, __shfl_xor(c, o)); }
                if (c32 == 0 && a >= c) { const int q = 4 * r + 2 * hh + qi; atomicMin(&meta[q * 2], skey(c)); atomicMax(&meta[q * 2 + 1], skey(a)); }
            }
    }
    __syncthreads();
    const float mnq = big ? skey_inv(meta[wid * 2]) : 0.f, mxq = big ? skey_inv(meta[wid * 2 + 1]) : 0.f;
    attn_wave(p, lds, wid, lane, b, t0 + wid, mnq, mxq);
    __syncthreads();
}

constexpr int NGRP8 = SEQ / 8, ATT_P1 = NGRP8 / 8, ATT_P2 = NGRP8 / 2;
template <int SUB>
__device__ __forceinline__ void ph_mixer(const P& p, unsigned char* lds) {
    int* bc = (int*)(lds + LDS_BYTES - 16);
    constexpr int nh = SUB == 1 ? 64 : NXU;
    constexpr int a0 = SUB == 0 ? 0 : (SUB == 1 ? ATT_P1 : ATT_P2), a1 = SUB == 0 ? ATT_P1 : (SUB == 1 ? ATT_P2 : NGRP8);
    for (;;) {
        __syncthreads();
        if (tid_() == 0) bc[0] = atomicAdd(&p.ctr()[97 + SUB], 1);
        __syncthreads();
        const int it = bc[0];
        if (it >= nh) break;
        if (SUB == 0) hgx_unit(p, lds, it);
        else if (SUB == 1) hgchain_unit(p, it);
        else hgz_unit(p, lds, it);
    }
    const int b0 = (int)(xb_xcc_id() & 3u);
#pragma unroll 1
    for (int k = 0; k < 4; ++k) {
        const int b = (b0 + k) & 3;
        for (;;) {
            __syncthreads();
            if (tid_() == 0) bc[0] = atomicAdd(&p.ctr()[104 + SUB * 4 + b], 1);
            __syncthreads();
            const int it = bc[0];
            if (it >= a1 - a0) break;
            attn8_unit(p, lds, b, NGRP8 - 1 - (a0 + it));
        }
    }
}

__device__ __forceinline__ int tok_row(int tok) { return (tok >> 13) * LP + NMETA + (tok & 8191); }
__device__ __forceinline__ void ph_mix(const P& p, unsigned char* lds) {
    const int njobs = (NTOK / 256) * 4 * 2, G = gridDim.x, b0 = blockIdx.x;
    auto jobidx = [&](int i) __attribute__((always_inline)) { return (b0 + (i >> 1) * G) * 2 + (i & 1); };
    auto jobfn = [&](int i, GJob& j) __attribute__((always_inline)) -> bool {
        const int jb = jobidx(i); if (jb >= njobs) return false;
        const int which = jb & 1, u = jb >> 1, nt = u & 3, mt = u >> 2; const size_t r0 = (size_t)tok_row(mt * 256);
        j.A = (const char*)((which ? p.hgr() : p.att()) + r0 * 512); j.B = (const char*)((which ? p.wuhT() : p.wuaT()) + (size_t)nt * 256 * 512); return true; };
    auto epi = [&](f32x4 (&acc)[2][2][4][2], int i) __attribute__((always_inline)) {
        const int jb = jobidx(i), which = jb & 1, u = jb >> 1, nt = u & 3, mt = u >> 2; const size_t r0 = (size_t)tok_row(mt * 256);
        if (which == 0) {
            EPI8(
                const size_t og = (r0 + row) * 1024 + nt * 256 + col, om = (size_t)(mt * 256 + row) * 1024 + nt * 256 + col;
                const uint2 g = *(const uint2*)(p.ga() + og);
                f32x4 r;
                r[0] = v[0] * __uint_as_float(g.x << 16); r[1] = v[1] * __uint_as_float(g.x & 0xffff0000u);
                r[2] = v[2] * __uint_as_float(g.y << 16); r[3] = v[3] * __uint_as_float(g.y & 0xffff0000u);
                st_bf4(p.mix() + om, r);
            );
        } else {
            EPI8(
                const size_t og = (r0 + row) * 1024 + nt * 256 + col, om = (size_t)(mt * 256 + row) * 1024 + nt * 256 + col;
                const uint2 g = *(const uint2*)(p.gh() + og);
                const uint2 a = *(const uint2*)(p.mix() + om);
                f32x4 r;
                r[0] = __uint_as_float(a.x << 16) + v[0] * __uint_as_float(g.x << 16); r[1] = __uint_as_float(a.x & 0xffff0000u) + v[1] * __uint_as_float(g.x & 0xffff0000u);
                r[2] = __uint_as_float(a.y << 16) + v[2] * __uint_as_float(g.y << 16); r[3] = __uint_as_float(a.y & 0xffff0000u) + v[3] * __uint_as_float(g.y & 0xffff0000u);
                st_bf4(p.mix() + om, r);
            );
        }
    };
    unsigned vbU[2]; gj_lin2(vbU, 512);
    gemm_stream<false>(lds, 512, 512, (size_t)128 * 512 * 2, vbU, jobfn, epi);
}

__device__ __forceinline__ void ph_out(const P& p, unsigned char* lds) {
    const int nunits = (NTOK / 256) * 4, G = gridDim.x, b0 = blockIdx.x;
    auto jobfn = [&](int i, GJob& j) __attribute__((always_inline)) -> bool {
        const int u = b0 + i * G; if (u >= nunits) return false;
        const int nt = u & 3, mt = u >> 2;
        j.A = (const char*)(p.mix() + (size_t)mt * 256 * D); j.B = (const char*)(p.woT() + (size_t)nt * 256 * D); return true; };
    auto epi = [&](f32x4 (&acc)[2][2][4][2], int i) __attribute__((always_inline)) {
        const int u = b0 + i * G, nt = u & 3, mt = u >> 2;
        EPI8(
            const size_t o = (size_t)(mt * 256 + row) * D + nt * 256 + col;
            const f32x4 h0 = *(const f32x4*)(p.x + o);
            *(f32x4*)(p.out + o) = h0 + v;
        );
    };
    unsigned vbU[2]; gj_lin2(vbU, D);
    gemm_stream<false>(lds, D, D, (size_t)128 * D * 2, vbU, jobfn, epi);
}

constexpr int XS_LD = 1025;
__device__ __forceinline__ void ph_route(const P& p, unsigned char* lds) {
    const int tid = tid_(), lane = tid & 63, wid = __builtin_amdgcn_readfirstlane(tid >> 6);
    const int gt = blockIdx.x * NTHREADS + tid, ntot = gridDim.x * NTHREADS;
    for (int i = gt; i < CAP; i += ntot) { p.slot_token()[i] = -1; p.slot_info()[i] = make_int2(-1, 0); }
    float* xs = (float*)lds;
    int* lhist = (int*)(lds + 32 * XS_LD * 4);
    for (int tb = blockIdx.x; tb < NTOK / 128; tb += gridDim.x) {
        if (tid < 32) lhist[tid] = 0;
        for (int tile = 0; tile < 4; ++tile) {
            const int tokt = tb * 128 + tile * 32;
            __syncthreads();
#pragma unroll
            for (int t = 0; t < 4; ++t) {
                const int tl = wid * 4 + t, tok = tokt + tl;
                const float* src = p.out + (size_t)tok * D;
                f32x4 v[4]; float ss = 0.f;
#pragma unroll
                for (int i = 0; i < 4; ++i) { v[i] = *(const f32x4*)(src + lane * 4 + 256 * i); ss += v[i][0] * v[i][0] + v[i][1] * v[i][1] + v[i][2] * v[i][2] + v[i][3] * v[i][3]; }
                ss = wave_sum(ss);
                const float rs = rsqrtf(ss * (1.0f / D) + EPS);
#pragma unroll
                for (int i = 0; i < 4; ++i) {
                    const f32x4 g = *(const f32x4*)(p.ffn_g + lane * 4 + 256 * i);
                    f32x4 xn; xn[0] = v[i][0] * rs * g[0]; xn[1] = v[i][1] * rs * g[1]; xn[2] = v[i][2] * rs * g[2]; xn[3] = v[i][3] * rs * g[3];
                    *(uint32_t*)(p.xn2() + (size_t)tok * D + lane * 4 + 256 * i) = pk4_fp8(xn[0], xn[1], xn[2], xn[3]);
#pragma unroll
                    for (int c = 0; c < 4; ++c) xs[tl * XS_LD + lane * 4 + 256 * i + c] = xn[c];
                }
            }
            __syncthreads();
            f32x16 acc;
#pragma unroll
            for (int i = 0; i < 16; ++i) acc[i] = 0.f;
            {
                const float* xr = xs + (lane & 31) * XS_LD + wid * 128 + (lane >> 5);
                const float* wp = p.router_w + (size_t)(wid * 128 + (lane >> 5)) * 32 + (lane & 31);
#pragma unroll 16
                for (int i = 0; i < 64; ++i) acc = __builtin_amdgcn_mfma_f32_32x32x2f32(xr[2 * i], wp[(size_t)(2 * i) * 32], acc, 0, 0, 0);
            }
            __syncthreads();
#pragma unroll
            for (int r = 0; r < 16; ++r) xs[wid * 1024 + ((r & 3) + 8 * (r >> 2) + 4 * (lane >> 5)) * 32 + (lane & 31)] = acc[r];
            __syncthreads();
            const int e = lane & 31, hh = lane >> 5;
            const float be = p.router_b[e];
#pragma unroll
            for (int it = 0; it < 2; ++it) {
                const int tl = wid * 4 + it * 2 + hh;
                float l = be;
#pragma unroll
                for (int w = 0; w < 8; ++w) l += xs[w * 1024 + tl * 32 + e];
                float bv[4]; int bi[4];
#pragma unroll
                for (int k = 0; k < 4; ++k) {
                    float m = l;
#pragma unroll
                    for (int o = 16; o >= 1; o >>= 1) m = fmaxf(m, __shfl_xor(m, o));
                    const unsigned long long bal = __ballot(l == m);
                    const unsigned half = hh ? (unsigned)(bal >> 32) : (unsigned)bal;
                    const int idx = __builtin_ctz(half);
                    bv[k] = m; bi[k] = idx;
                    if (e == idx) l = -INFINITY;
                }
                const float e1 = __expf(bv[1] - bv[0]), e2 = __expf(bv[2] - bv[0]), e3 = __expf(bv[3] - bv[0]);
                const float inv = 1.0f / (1.0f + e1 + e2 + e3);
                if (e == 0) {
                    const int tok = tokt + tl;
                    p.tok_exp()[tok * 4 + 0] = bi[0]; p.tok_exp()[tok * 4 + 1] = bi[1]; p.tok_exp()[tok * 4 + 2] = bi[2]; p.tok_exp()[tok * 4 + 3] = bi[3];
                    p.tok_gate()[tok * 4 + 0] = inv; p.tok_gate()[tok * 4 + 1] = e1 * inv; p.tok_gate()[tok * 4 + 2] = e2 * inv; p.tok_gate()[tok * 4 + 3] = e3 * inv;
                    atomicAdd(&lhist[bi[0]], 1); atomicAdd(&lhist[bi[1]], 1); atomicAdd(&lhist[bi[2]], 1); atomicAdd(&lhist[bi[3]], 1);
                }
            }
        }
        __syncthreads();
        if (tid < 32) p.wg_cnt()[tb * 32 + tid] = lhist[tid];
        __syncthreads();
    }
    for (long task = gt; task < 96L * 16384; task += ntot) {
        const int mat = (int)(task >> 14), r = (int)(task & 16383), kq = r >> 10, n = r & 1023;
        const int which = mat >> 5, e = mat & 31;
        const float* W = (which == 0 ? p.w_gate : which == 1 ? p.w_up : p.w_down) + (size_t)e * 1048576 + (size_t)(kq * 64) * 1024 + n;
        unsigned char* outp = (which == 0 ? p.wgT() : which == 1 ? p.wuT() : p.wdT()) + (size_t)e * 1048576 + (size_t)n * 1024 + kq * 64;
        float v[64];
#pragma unroll
        for (int i = 0; i < 64; ++i) v[i] = W[(size_t)i * 1024] * 32.0f;
        uint4* dst = (uint4*)outp;
#pragma unroll
        for (int i = 0; i < 4; ++i) dst[i] = make_uint4(pk4_fp8(v[16 * i], v[16 * i + 1], v[16 * i + 2], v[16 * i + 3]), pk4_fp8(v[16 * i + 4], v[16 * i + 5], v[16 * i + 6], v[16 * i + 7]),
                                                        pk4_fp8(v[16 * i + 8], v[16 * i + 9], v[16 * i + 10], v[16 * i + 11]), pk4_fp8(v[16 * i + 12], v[16 * i + 13], v[16 * i + 14], v[16 * i + 15]));
    }
}

__device__ __forceinline__ void ph_fill(const P& p, unsigned char* lds) {
    const int tid = tid_();
    int* tot = (int*)lds;
    int* pre = tot + 512;
    int* ps = pre + 512;
    int* lc = ps + 32;
    for (int tb = blockIdx.x; tb < NTOK / 128; tb += gridDim.x) {
        {
            const int e = tid & 31, part = tid >> 5;
            int t = 0, q = 0;
            for (int b2 = part; b2 < NTOK / 128; b2 += 16) { const int c = p.wg_cnt()[b2 * 32 + e]; t += c; if (b2 < tb) q += c; }
            tot[part * 32 + e] = t; pre[part * 32 + e] = q;
        }
        __syncthreads();
        if (tid == 0) {
            int acc = 0;
            for (int e = 0; e < NE; ++e) {
                int t = 0, q = 0;
                for (int i = 0; i < 16; ++i) { t += tot[i * 32 + e]; q += pre[i * 32 + e]; }
                ps[e] = acc + q; lc[e] = 0;
                const int nb = (t + 255) >> 8;
                if (tb == 0) for (int i = 0; i < nb; ++i) p.block_expert()[(acc >> 8) + i] = e;
                acc += nb * 256;
            }
            if (tb == 0) p.ctr()[96] = acc >> 8;
        }
        __syncthreads();
        {
            const int i = tb * 512 + tid;
            const int e = p.tok_exp()[i];
            const int dest = ps[e] + atomicAdd(&lc[e], 1);
            p.slot_token()[dest] = i >> 2;
            p.slot_rank()[dest] = i & 3;
            p.slot_gate()[dest] = p.tok_gate()[i];
            p.slot_info()[dest] = make_int2((i >> 2) | ((i & 3) << 16), __float_as_int(p.tok_gate()[i]));
        }
        __syncthreads();
    }
}

__device__ __forceinline__ void ph_moe1(const P& p, unsigned char* lds) {
    const int nunits = p.ctr()[96] * 8, G = gridDim.x, b0 = blockIdx.x;
    auto jobfn = [&](int i, G8Job& j) __attribute__((always_inline)) -> bool {
        const int u = b0 + i * G; if (u >= nunits) return false;
        const int ct = u & 7, rb = u >> 3, e = p.block_expert()[rb];
        j.A = (const char*)p.xn2(); j.B = (const char*)(p.wgT() + (size_t)e * 1048576 + (size_t)ct * 128 * 1024);
        const int* st = p.slot_token() + rb * 256; unsigned v[4];
#pragma unroll
        for (int q = 0; q < 4; ++q) { int R, Cb; g8_rc(q, R, Cb); const int t = st[R]; v[q] = (unsigned)((t < 0 ? 0 : t) * 1024 + Cb); }
        j.va0 = v[0]; j.va1 = v[1]; j.va2 = v[2]; j.va3 = v[3]; return true; };
    auto epi = [&](f32x4 (&acc)[2][2][4][2], int i) __attribute__((always_inline)) {
        const int u = b0 + i * G, ct = u & 7, rb = u >> 3, e = p.block_expert()[rb];
        const int tid_e = tid_(), lane_e = tid_e & 63, wid_e = tid_e >> 6, wr = wid_e >> 2, wc = wid_e & 3, fr = lane_e & 15, fq = lane_e >> 4;
#pragma unroll
        for (int n = 0; n < 2; ++n) {
            const int c = ct * 128 + wc * 32 + n * 16 + fq * 4;
            const f32x4 bg = *(const f32x4*)(p.b_gate + (size_t)e * DFF + c), bu = *(const f32x4*)(p.b_up + (size_t)e * DFF + c);
#pragma unroll
            for (int ai = 0; ai < 2; ++ai)
#pragma unroll
                for (int m = 0; m < 4; ++m) {
                    const int row = rb * 256 + ai * 128 + wr * 64 + m * 16 + fr;
                    f32x4 a;
#pragma unroll
                    for (int j = 0; j < 4; ++j) {
                        const float g = fminf(acc[ai][0][m][n][j] * 0.03125f + bg[j], 7.0f);
                        const float uu = fminf(fmaxf(acc[ai][1][m][n][j] * 0.03125f + bu[j], -7.0f), 7.0f);
                        a[j] = (uu + 1.0f) * (g * sigmoidf_(1.702f * g));
                    }
                    *(uint32_t*)(p.act() + (size_t)row * DFF + c) = pk4_fp8(a[0], a[1], a[2], a[3]);
                }
        }
    };
    unsigned vbU[4];
#pragma unroll
    for (int q = 0; q < 4; ++q) { int R, Cb; g8_rc(q, R, Cb); vbU[q] = (unsigned)((size_t)(R >> 7) * WE8_B + (size_t)(R & 127) * 1024 + Cb); }
    gemm8_stream<true>(lds, vbU, jobfn, epi);
}
__device__ __forceinline__ void ph_moe2(const P& p, unsigned char* lds) {
    const int nunits = p.ctr()[96] * 4, G = gridDim.x, b0 = blockIdx.x;
    unsigned vbU[4];
#pragma unroll
    for (int q = 0; q < 4; ++q) { int R, Cb; g8_rc(q, R, Cb); vbU[q] = (unsigned)(R * DFF + Cb); }
    auto jobfn = [&](int i, G8Job& j) __attribute__((always_inline)) -> bool {
        const int u = b0 + i * G; if (u >= nunits) return false;
        const int nt = u & 3, rb = u >> 2, e = p.block_expert()[rb];
        j.A = (const char*)(p.act() + (size_t)rb * 256 * DFF); j.B = (const char*)(p.wdT() + (size_t)e * 1048576 + (size_t)nt * 256 * DFF); return true; };
    auto epi = [&](f32x4 (&acc)[2][2][4][2], int i) __attribute__((always_inline)) {
        const int u = b0 + i * G, nt = u & 3, rb = u >> 2, e = p.block_expert()[rb];
        const int tid_e = tid_(), lane_e = tid_e & 63, wid_e = tid_e >> 6, wr = wid_e >> 2, wc = wid_e & 3, fr = lane_e & 15, fq = lane_e >> 4;
        f32x4 bd[2][2];
#pragma unroll
        for (int bj = 0; bj < 2; ++bj)
#pragma unroll
            for (int n = 0; n < 2; ++n) bd[bj][n] = *(const f32x4*)(p.b_down + (size_t)e * D + nt * 256 + bj * 128 + wc * 32 + n * 16 + fq * 4);
        int2 info[2][4];
#pragma unroll
        for (int ai = 0; ai < 2; ++ai)
#pragma unroll
            for (int m = 0; m < 4; ++m) info[ai][m] = p.slot_info()[rb * 256 + ai * 128 + wr * 64 + m * 16 + fr];
#pragma unroll
        for (int ai = 0; ai < 2; ++ai)
#pragma unroll
        for (int mp = 0; mp < 2; ++mp) {
            f32x4 old[2][2][2];
#pragma unroll
            for (int mm = 0; mm < 2; ++mm) {
                const int ix = info[ai][mp * 2 + mm].x;
                const size_t o = (size_t)(ix & 0xffff) * D + nt * 256 + wc * 32 + fq * 4;
#pragma unroll
                for (int bj = 0; bj < 2; ++bj)
#pragma unroll
                    for (int n = 0; n < 2; ++n) old[mm][bj][n] = (ix >= 0 && (ix >> 16) == 0) ? *(const f32x4*)(p.out + o + bj * 128 + n * 16) : (f32x4){0.f, 0.f, 0.f, 0.f};
            }
#pragma unroll
            for (int mm = 0; mm < 2; ++mm) {
                const int m = mp * 2 + mm;
                const int ix = info[ai][m].x;
                if (ix < 0) continue;
                const int rank = ix >> 16; const float gate = __int_as_float(info[ai][m].y);
                const size_t o = (size_t)(ix & 0xffff) * D + nt * 256 + wc * 32 + fq * 4;
                if (rank == 0) {
#pragma unroll
                    for (int bj = 0; bj < 2; ++bj)
#pragma unroll
                        for (int n = 0; n < 2; ++n) *(f32x4*)(p.out + o + bj * 128 + n * 16) = old[mm][bj][n] + (acc[ai][bj][m][n] * 0.03125f + bd[bj][n]) * gate;
                } else {
                    bf16_t* yb = rank == 1 ? p.y1() : (rank == 2 ? p.y2() : p.y3());
#pragma unroll
                    for (int bj = 0; bj < 2; ++bj)
#pragma unroll
                        for (int n = 0; n < 2; ++n) st_bf4(yb + o + bj * 128 + n * 16, (acc[ai][bj][m][n] * 0.03125f + bd[bj][n]) * gate);
                }
            }
        }
    };
    gemm8_stream<false>(lds, vbU, jobfn, epi);
}

__device__ __forceinline__ void ph_final(const P& p, unsigned char* lds) {
    const int tid = tid_(), lane = tid & 63, wid = tid >> 6;
    const int gw = blockIdx.x * 8 + wid, nw = gridDim.x * 8;
    for (int tok = gw; tok < NTOK; tok += nw) {
        float* dst = p.out + (size_t)tok * D;
        f32x4 v[4];
#pragma unroll
        for (int i = 0; i < 4; ++i) v[i] = *(const f32x4*)(dst + lane * 4 + 256 * i);
#pragma unroll
        for (int j = 0; j < 3; ++j) {
            const bf16_t* yr = (j == 0 ? p.y1() : j == 1 ? p.y2() : p.y3()) + (size_t)tok * D;
#pragma unroll
            for (int i = 0; i < 4; ++i) {
                const uint2 w = *(const uint2*)(yr + lane * 4 + 256 * i);
                v[i][0] += __uint_as_float(w.x << 16); v[i][1] += __uint_as_float(w.x & 0xffff0000u);
                v[i][2] += __uint_as_float(w.y << 16); v[i][3] += __uint_as_float(w.y & 0xffff0000u);
            }
        }
        float ss = 0.f;
#pragma unroll
        for (int i = 0; i < 4; ++i) ss += v[i][0] * v[i][0] + v[i][1] * v[i][1] + v[i][2] * v[i][2] + v[i][3] * v[i][3];
        ss = wave_sum(ss);
        const float rs = rsqrtf(ss * (1.0f / D) + EPS);
#pragma unroll
        for (int i = 0; i < 4; ++i) {
            const f32x4 g = *(const f32x4*)(p.final_g + lane * 4 + 256 * i);
            *(f32x4*)(dst + lane * 4 + 256 * i) = v[i] * rs * g;
        }
    }
}

typedef const __attribute__((address_space(4))) P* PK;
#define PHASE(call) do { PK q_ = pk; asm volatile("" : "+s"(q_)); const P& p = *(const P*)q_; call; } while (0)
__global__ void __launch_bounds__(NTHREADS) k_mega(P p_unused) {
    __shared__ __attribute__((aligned(16))) unsigned char lds[LDS_BYTES];
    cg::grid_group grid = cg::this_grid();
    const PK pk = (PK)__builtin_amdgcn_kernarg_segment_ptr();
    if (tid_() < 4) ((unsigned*)(lds + LDS_BYTES - 32))[tid_()] = 0u;
    __syncthreads();
    XcdBarrier xb;
    PHASE(xb = xcd_barrier_post((unsigned*)(p.ws + OFF_BAR), (volatile LAS unsigned*)(lds + LDS_BYTES - 32)));
    PHASE(if (p.ws == nullptr) grid.sync());
    PHASE(ph_prep(p, lds)); xcd_barrier(xb);
    PHASE(ph_inproj(p, lds)); xcd_barrier(xb);
    PHASE(ph_mixer<0>(p, lds)); xcd_barrier(xb);
    PHASE(ph_mixer<1>(p, lds)); xcd_barrier(xb);
    PHASE(ph_mixer<2>(p, lds)); xcd_barrier(xb);
    PHASE(ph_mix(p, lds)); xcd_barrier(xb);
    PHASE(ph_out(p, lds)); xcd_barrier(xb);
    PHASE(ph_route(p, lds)); xcd_barrier(xb);
    PHASE(ph_fill(p, lds)); xcd_barrier(xb);
    PHASE(ph_moe1(p, lds)); xcd_barrier(xb);
    PHASE(ph_moe2(p, lds)); xcd_barrier(xb);
    PHASE(ph_final(p, lds));
}

extern "C" void kernel_launch(void* const* d_in, const int* in_sizes, int n_in, void* d_out, int out_size, void* d_ws, size_t ws_size,
                              hipStream_t stream) {
    P p{};
    p.x = (const float*)d_in[0]; p.meta = (const float*)d_in[1]; p.attn_g = (const float*)d_in[2]; p.w_in = (const float*)d_in[3];
    p.hgrn_g = (const float*)d_in[4]; p.w_ua = (const float*)d_in[5]; p.w_uh = (const float*)d_in[6]; p.w_out = (const float*)d_in[7];
    p.lb_logits = (const float*)d_in[8]; p.ffn_g = (const float*)d_in[9]; p.router_w = (const float*)d_in[10]; p.router_b = (const float*)d_in[11];
    p.w_gate = (const float*)d_in[12]; p.b_gate = (const float*)d_in[13]; p.w_up = (const float*)d_in[14]; p.b_up = (const float*)d_in[15];
    p.w_down = (const float*)d_in[16]; p.b_down = (const float*)d_in[17]; p.final_g = (const float*)d_in[18];
    p.out = (float*)d_out;
    p.ws = (unsigned char*)d_ws;
    if (WS_NEED > ws_size) { fprintf(stderr, "workspace too small: need %zu have %zu\n", (size_t)WS_NEED, ws_size); return; }
    static int grid_blocks = 0;
    if (!grid_blocks) {
        int dev = 0, cus = 0, per_cu = 0;
        hipGetDevice(&dev);
        hipDeviceGetAttribute(&cus, hipDeviceAttributeMultiprocessorCount, dev);
        hipOccupancyMaxActiveBlocksPerMultiprocessor(&per_cu, k_mega, NTHREADS, 0);
        if (per_cu > 1) per_cu = 1;
        grid_blocks = cus * per_cu;
    }
    hipMemsetAsync(p.ws + OFF_BAR, 0, XCD_BAR_WORDS * 4, stream);
    void* args[] = {&p};
    hipError_t e = hipLaunchCooperativeKernel((void*)k_mega, dim3(grid_blocks), dim3(NTHREADS), args, 0, stream);
    if (e != hipSuccess) fprintf(stderr, "cooperative launch failed: %s (grid %d)\n", hipGetErrorString(e), grid_blocks);
}
```

```cpp
#include <hip/hip_runtime.h>
#include <hip/hip_cooperative_groups.h>
#include <stdint.h>
#include <cstdio>
namespace cg = cooperative_groups;

#ifndef MEGA
#define MEGA 1
#endif

typedef unsigned short bf16_t;
typedef short bf16x8 __attribute__((ext_vector_type(8)));
typedef float f32x4 __attribute__((ext_vector_type(4)));

constexpr int D = 1024, NB = 4, SEQ = 8192, NMETA = 16, L = SEQ + NMETA  , LP = 8320, T = NB * LP  ;
constexpr int NTOK = NB * SEQ;
constexpr int IN_COLS = 5160;
constexpr int NE = 32, TOPK = 4, DFF = 1024;
constexpr int CAP_BLOCKS = (NTOK * TOPK) / 256 + NE;
constexpr int CAP = CAP_BLOCKS * 256;
constexpr float EPS = 1e-5f;
constexpr int NTHREADS = 512;
constexpr int LDS_BYTES = 155648;
constexpr int NVC = 5376;
#define LAS __attribute__((address_space(3)))

__device__ __forceinline__ bf16_t f2bf(float f) {
    uint32_t u = __float_as_uint(f);
    u += 0x7fffu + ((u >> 16) & 1u);
    return (bf16_t)(u >> 16);
}
__device__ __forceinline__ float bf2f(bf16_t h) { return __uint_as_float(((uint32_t)h) << 16); }
__device__ __forceinline__ uint32_t pack2(float a, float b) { return (uint32_t)f2bf(a) | ((uint32_t)f2bf(b) << 16); }
__device__ __forceinline__ uint32_t pk4_fp8(float a, float b, float c, float d) {
    a = fminf(fmaxf(a, -448.f), 448.f); b = fminf(fmaxf(b, -448.f), 448.f); c = fminf(fmaxf(c, -448.f), 448.f); d = fminf(fmaxf(d, -448.f), 448.f);
    int w = __builtin_amdgcn_cvt_pk_fp8_f32(a, b, 0, false); w = __builtin_amdgcn_cvt_pk_fp8_f32(c, d, w, true); return (uint32_t)w;
}
__device__ __forceinline__ float sigmoidf_(float x) { return __builtin_amdgcn_rcpf(1.0f + __builtin_amdgcn_exp2f(-1.4426950408889634f * x)); }
__device__ __forceinline__ float wave_sum(float v) {
#pragma unroll
    for (int o = 32; o >= 1; o >>= 1) v += __shfl_xor(v, o);
    return v;
}
__device__ __forceinline__ float wave_max(float v) {
#pragma unroll
    for (int o = 32; o >= 1; o >>= 1) v = fmaxf(v, __shfl_xor(v, o));
    return v;
}

constexpr size_t al256(size_t x) { return (x + 255) & ~(size_t)255; }
constexpr size_t TT = (size_t)T;
constexpr size_t MB1 = 1024 * 1024;
constexpr size_t WE8_B = (size_t)NE * 1024 * 1024;
constexpr size_t OFF_WGT = 0, OFF_WUT = WE8_B, OFF_WDT = 2 * WE8_B, OFF_XN2 = 3 * WE8_B, OFF_ACT = OFF_XN2 + (size_t)NTOK * D,
                 OFF_Y1 = OFF_ACT + (size_t)CAP * DFF, OFF_Y2 = OFF_Y1 + (size_t)NTOK * D * 2, OFF_Y3 = OFF_Y2 + (size_t)NTOK * D * 2,
                 OFF_S2_END = OFF_Y3 + (size_t)NTOK * D * 2;
constexpr size_t OFF_WIN = 0, OFF_WUA = OFF_WIN + (size_t)NVC * 1024 * 2, OFF_WUH = OFF_WUA + MB1, OFF_WO = OFF_WUH + MB1, OFF_XN = OFF_WO + 2 * MB1,
                 OFF_Q = OFF_XN + TT * 2048, OFF_K = OFF_Q + TT * 1024, OFF_V = OFF_K + TT * 256, OFF_IQ = OFF_V + TT * 256, OFF_IK = OFF_IQ + TT * 512,
                 OFF_IW = OFF_IK + TT * 64, OFF_HQ = OFF_IW + TT * 32, OFF_HF = OFF_HQ + TT * 1024, OFF_HI = OFF_HF + TT * 1024, OFF_HG = OFF_HI + TT * 1024,
                 OFF_GA = OFF_HG + TT * 1024, OFF_GH = OFF_GA + TT * 2048, OFF_ATT = OFF_GH + TT * 2048, OFF_HGR = OFF_ATT + TT * 1024,
                 OFF_S1_END = OFF_HGR + TT * 1024;
constexpr size_t OFF_MIX = OFF_XN;
constexpr size_t OFF_TAB = OFF_S1_END > OFF_S2_END ? OFF_S1_END : OFF_S2_END;
constexpr size_t OFF_ROPE = OFF_TAB, OFF_LB = OFF_ROPE + al256((size_t)LP * 24 * 4), OFF_CTR = OFF_LB + al256(512 * 4),
                 OFF_BEXP = OFF_CTR + al256(128 * 4), OFF_SLOT = OFF_BEXP + al256((size_t)CAP_BLOCKS * 4), OFF_SRANK = OFF_SLOT + al256((size_t)CAP * 4),
                 OFF_SGATE = OFF_SRANK + al256((size_t)CAP * 4), OFF_TEXP = OFF_SGATE + al256((size_t)CAP * 4), OFF_TGATE = OFF_TEXP + al256((size_t)NTOK * 16),
                 OFF_BAR = OFF_TGATE + al256((size_t)NTOK * 16), OFF_WGC = OFF_BAR + al256(3456 * 4), OFF_SINFO = OFF_WGC + al256(256 * 32 * 4), WS_NEED = OFF_SINFO + al256((size_t)CAP * 8);


__device__ __forceinline__ int tid_() { int t = threadIdx.x; asm volatile("" : "+v"(t)); return t; }

struct P {
    const float *x, *meta, *attn_g, *w_in, *hgrn_g, *w_ua, *w_uh, *w_out, *lb_logits, *ffn_g, *router_w, *router_b,
        *w_gate, *b_gate, *w_up, *b_up, *w_down, *b_down, *final_g;
    float* out;
    unsigned char* ws;
#define WSF(type, name, off) __device__ __forceinline__ type* name() const { return (type*)(ws + (off)); }
    WSF(bf16_t, xn, OFF_XN) WSF(bf16_t, q, OFF_Q) WSF(bf16_t, k, OFF_K) WSF(bf16_t, v, OFF_V) WSF(bf16_t, iq, OFF_IQ) WSF(bf16_t, ik, OFF_IK)
    WSF(bf16_t, hq, OFF_HQ) WSF(bf16_t, hf, OFF_HF) WSF(bf16_t, hi, OFF_HI) WSF(bf16_t, hg, OFF_HG) WSF(bf16_t, ga, OFF_GA) WSF(bf16_t, gh, OFF_GH)
    WSF(bf16_t, att, OFF_ATT) WSF(bf16_t, hgr, OFF_HGR) WSF(bf16_t, mix, OFF_MIX) WSF(unsigned char, xn2, OFF_XN2) WSF(unsigned char, act, OFF_ACT)
    WSF(bf16_t, y1, OFF_Y1) WSF(bf16_t, y2, OFF_Y2) WSF(bf16_t, y3, OFF_Y3)
    WSF(bf16_t, winT, OFF_WIN) WSF(bf16_t, wuaT, OFF_WUA) WSF(bf16_t, wuhT, OFF_WUH) WSF(bf16_t, woT, OFF_WO)
    WSF(unsigned char, wgT, OFF_WGT) WSF(unsigned char, wuT, OFF_WUT) WSF(unsigned char, wdT, OFF_WDT)
    WSF(float, iw, OFF_IW) WSF(float, rope, OFF_ROPE) WSF(float, lb, OFF_LB) WSF(float, tok_gate, OFF_TGATE) WSF(float, slot_gate, OFF_SGATE)
    WSF(int, ctr, OFF_CTR)
    WSF(int, wg_cnt, OFF_WGC) WSF(int2, slot_info, OFF_SINFO) WSF(int, block_expert, OFF_BEXP) WSF(int, slot_token, OFF_SLOT) WSF(int, slot_rank, OFF_SRANK) WSF(int, tok_exp, OFF_TEXP)
};

template <class ColMap>
__device__ __forceinline__ void convert_T(const float* W, int ldw, bf16_t* out, int K, int N, const ColMap& cmap, int gt, int ntot) {
    const int kb = K / 64; const long ntask = (long)N * kb;
    for (long task = gt; task < ntask; task += ntot) {
        const int kq = (int)(task / N), n = (int)(task % N);
        const int c = cmap(n);
        uint32_t w[32];
        if (c >= 0) {
            const float* src = W + (size_t)(kq * 64) * ldw + c;
            float v[64];
#pragma unroll
            for (int i = 0; i < 64; ++i) v[i] = src[(size_t)i * ldw];
#pragma unroll
            for (int i = 0; i < 32; ++i) w[i] = pack2(v[2 * i], v[2 * i + 1]);
        } else {
#pragma unroll
            for (int i = 0; i < 32; ++i) w[i] = 0u;
        }
        uint4* dst = (uint4*)(out + (size_t)n * K + kq * 64);
#pragma unroll
        for (int i = 0; i < 8; ++i) dst[i] = make_uint4(w[4 * i], w[4 * i + 1], w[4 * i + 2], w[4 * i + 3]);
    }
}
struct IdMap { __device__ __forceinline__ int operator()(int n) const { return n; } };
struct WinMap { __device__ __forceinline__ int operator()(int n) const { return n < 1064 ? n : (n < 1280 ? -1 : n - 216); } };

#define XB_TMO      128
#define XB_XCNT(j)  (256  + 64 * (j))
#define XB_XSUB(j)  (1280 + 64 * (j))
#define XB_XGEN(j)  (2304 + 64 * (j))
#define XB_TOP      3328
#define XB_TOPGEN   3392
#define XCD_BAR_WORDS 3456
#define XB_SPIN_CAP (1u << 22)
__device__ __forceinline__ unsigned xb_ld(unsigned* p)              { return __hip_atomic_load(p, __ATOMIC_RELAXED, __HIP_MEMORY_SCOPE_AGENT); }
__device__ __forceinline__ unsigned xb_add(unsigned* p, unsigned v) { return __hip_atomic_fetch_add(p, v, __ATOMIC_RELAXED, __HIP_MEMORY_SCOPE_AGENT); }
__device__ __forceinline__ unsigned xb_xcc_id() { return (unsigned)__builtin_amdgcn_s_getreg((3 << 11) | 20) & 0xFu; }
#define XB_SPIN(cond, bar) do { unsigned _sp = 0; while (cond) { __builtin_amdgcn_s_sleep(1); \
    if ((++_sp & 255u) == 0u) { if (xb_ld(&(bar)[XB_TMO])) break; if (_sp > XB_SPIN_CAP) { atomicAdd(&(bar)[XB_TMO], 1u); break; } } } } while (0)
struct XcdBarrier { unsigned* bar; unsigned x; volatile LAS unsigned* st; };
__device__ __forceinline__ XcdBarrier xcd_barrier_post(unsigned* bar, volatile LAS unsigned* st) {
    XcdBarrier b; b.bar = bar; b.x = xb_xcc_id(); b.st = st;
    if (threadIdx.x == 0) (void)xb_add(&bar[XB_XCNT(b.x)], 1u);
    return b;
}
__device__ __forceinline__ void xcd_barrier_complete(unsigned* bar, unsigned x, unsigned& nloc, unsigned& nx) {
    const unsigned G = gridDim.x * gridDim.y * gridDim.z;
    unsigned sum, cnt, mine, sp = 0u;
    for (;;) {
        sum = 0u; cnt = 0u; mine = 0u;
#pragma unroll
        for (unsigned j = 0; j < 16; ++j) { const unsigned c = xb_ld(&bar[XB_XCNT(j)]); sum += c; cnt += (c > 0u) ? 1u : 0u; mine = (j == x) ? c : mine; }
        if (sum == G) break;
        __builtin_amdgcn_s_sleep(1);
        if ((++sp & 255u) == 0u) { if (xb_ld(&bar[XB_TMO])) break; if (sp > XB_SPIN_CAP) { atomicAdd(&bar[XB_TMO], 1u); break; } }
    }
    nloc = mine > 0u ? mine : 1u; nx = cnt > 0u ? cnt : 1u;
}
__device__ __forceinline__ void xcd_barrier(const XcdBarrier& b) {
    asm volatile("s_waitcnt vmcnt(0)" ::: "memory");
    __syncthreads();
    if (threadIdx.x == 0) {
        unsigned* bar = b.bar;
        __builtin_amdgcn_s_waitcnt(0);
        unsigned nloc = b.st[0], nx = b.st[1];
        if (nloc == 0u) { xcd_barrier_complete(bar, b.x, nloc, nx); b.st[0] = nloc; b.st[1] = nx; }
        const unsigned old = xb_add(&bar[XB_XSUB(b.x)], 1u);
        const unsigned gen = old / nloc;
        if (old + 1u == (gen + 1u) * nloc) {
            __builtin_amdgcn_fence(__ATOMIC_RELEASE, "agent");
            asm volatile("s_waitcnt vmcnt(0)" ::: "memory");
            const unsigned og = xb_add(&bar[XB_TOP], 1u);
            const unsigned tg = og / nx;
            if (og + 1u == (tg + 1u) * nx) xb_add(&bar[XB_TOPGEN], 1u);
            else XB_SPIN(xb_ld(&bar[XB_TOPGEN]) == tg, bar);
            __builtin_amdgcn_fence(__ATOMIC_ACQUIRE, "agent");
            xb_add(&bar[XB_XGEN(b.x)], 1u);
            asm volatile("s_waitcnt vmcnt(0)" ::: "memory");
        } else {
            XB_SPIN(xb_ld(&bar[XB_XGEN(b.x)]) == gen, bar);
            __builtin_amdgcn_fence(__ATOMIC_ACQUIRE, "agent");
            asm volatile("s_waitcnt vmcnt(0)" ::: "memory");
        }
    }
    __syncthreads();
}

__device__ __forceinline__ void ph_prep(const P& p, unsigned char* lds) {
    const int tid = tid_(), lane = tid & 63, wid = tid >> 6;
    const int gw = blockIdx.x * 8 + wid, nw = gridDim.x * 8;
    for (int r = gw; r < T; r += nw) {
        const int b = r / LP, pos = r % LP;
        bf16_t* dst = p.xn() + (size_t)r * D;
        if (pos >= L) {
#pragma unroll
            for (int i = 0; i < 4; ++i) *(uint2*)(dst + lane * 4 + 256 * i) = make_uint2(0u, 0u);
            continue;
        }
        const float* src = pos < NMETA ? p.meta + (size_t)pos * D : p.x + ((size_t)b * SEQ + (pos - NMETA)) * D;
        f32x4 v[4]; float ss = 0.f;
#pragma unroll
        for (int i = 0; i < 4; ++i) { v[i] = *(const f32x4*)(src + lane * 4 + 256 * i); ss += v[i][0] * v[i][0] + v[i][1] * v[i][1] + v[i][2] * v[i][2] + v[i][3] * v[i][3]; }
        ss = wave_sum(ss);
        const float rs = rsqrtf(ss * (1.0f / D) + EPS);
#pragma unroll
        for (int i = 0; i < 4; ++i) {
            const f32x4 g = *(const f32x4*)(p.attn_g + lane * 4 + 256 * i);
            uint2 o; o.x = pack2(v[i][0] * rs * g[0], v[i][1] * rs * g[1]); o.y = pack2(v[i][2] * rs * g[2], v[i][3] * rs * g[3]);
            *(uint2*)(dst + lane * 4 + 256 * i) = o;
        }
    }
    const int gt = blockIdx.x * NTHREADS + tid, nt = gridDim.x * NTHREADS;
    for (int i = gt; i < LP * 12; i += nt) {
        const int pos = i / 12, f = i % 12;
        const double ex = f < 8 ? -(double)f / 8.0 : -(double)(f - 8) / 4.0;
        const double inv = exp(ex * log(500000.0));
        const double ang = (double)pos * inv;
        const double twopi = 6.283185307179586476925286766559;
        const double r = ang - twopi * rint(ang / twopi);
        const float rf = (float)r;
        const float c = cosf(rf), s = sinf(rf);
        float* row = p.rope() + (size_t)pos * 24;
        if (f < 8) { row[f] = c; row[8 + f] = s; } else { row[16 + f - 8] = c; row[20 + f - 8] = s; }
    }
    for (int i = gt; i < 512; i += nt) {
        const float a = p.lb_logits[i], b2 = p.lb_logits[512 + i];
        p.lb()[i] = 1.0f / (1.0f + expf(b2 - a));
    }
    for (int i = gt; i < 128; i += nt) p.ctr()[i] = 0;
    convert_T(p.w_in, IN_COLS, p.winT(), 1024, NVC, WinMap{}, gt, nt);
    convert_T(p.w_ua, 1024, p.wuaT(), 512, 1024, IdMap{}, gt, nt);
    convert_T(p.w_uh, 1024, p.wuhT(), 512, 1024, IdMap{}, gt, nt);
    convert_T(p.w_out, 1024, p.woT(), 1024, 1024, IdMap{}, gt, nt);
}
constexpr int G_TILE_B = 256 * 64 * 2, G_STAGE_B = 2 * G_TILE_B;
__device__ __forceinline__ int g_lds_byte(int r, int c) { const int st = (r >> 4) * 2 + (c >> 5), ob = (r & 15) * 64 + (c & 31) * 2; return st * 1024 + (ob ^ (((ob >> 9) & 1) << 5)); }
__device__ __forceinline__ void g_stage_rc(int b, int& R, int& C) { const int st = b >> 10, sb = b & 1023, swz = sb ^ (((sb >> 9) & 1) << 5); R = (st >> 1) * 16 + swz / 64; C = (st & 1) * 32 + (swz % 64) / 2; }

constexpr int HTB = 128 * 64 * 2;
struct GJob { const char* A; const char* B; unsigned va00, va01, va10, va11; };
__device__ __forceinline__ void gj_lin(unsigned (&v)[2][2], int ld) {
#pragma unroll
    for (int h = 0; h < 2; ++h)
#pragma unroll
        for (int i = 0; i < 2; ++i) { int R, C; g_stage_rc(tid_() * 16 + i * 8192, R, C); v[h][i] = (unsigned)(((h * 128 + R) * ld + C) * 2); }
}
template <class AOff>
__device__ __forceinline__ void gj_gather(unsigned (&v)[2][2], const AOff& aoff) {
#pragma unroll
    for (int h = 0; h < 2; ++h)
#pragma unroll
        for (int i = 0; i < 2; ++i) { int R, C; g_stage_rc(tid_() * 16 + i * 8192, R, C); v[h][i] = (unsigned)((aoff(h * 128 + R) + C) * 2); }
}
template <class AOff>
__device__ __forceinline__ void gj_gather_job(GJob& j, const AOff& aoff) {
    unsigned v[2][2]; gj_gather(v, aoff); j.va00 = v[0][0]; j.va01 = v[0][1]; j.va10 = v[1][0]; j.va11 = v[1][1];
}
template <bool GATHER, class JobFn, class Epi>
__device__ __forceinline__ void gemm_stream(unsigned char* lds_, int K, int lda, size_t hstepB, const unsigned (&vbU)[2], const JobFn& jobfn, const Epi& epi) {
    LAS unsigned char* lds = (LAS unsigned char*)lds_;
    const int tid = tid_(), wid = __builtin_amdgcn_readfirstlane(tid >> 6), lane = tid & 63, wr = wid >> 2, wc = wid & 3, fr = lane & 15, fq = lane >> 4;
    const int nt = K / 64;
    const size_t kstep = 128;
    const size_t hstepA = GATHER ? 0 : (size_t)128 * lda * 2;
    const unsigned ldsw = (unsigned)wid * 1024u;
    const int aoff = g_lds_byte(wr * 64 + fr, fq * 8), boff = g_lds_byte(wc * 32 + fr, fq * 8);
    unsigned vaU[2];
#pragma unroll
    for (int i = 0; i < 2; ++i) { int R, C; g_stage_rc(tid * 16 + i * 8192, R, C); vaU[i] = (unsigned)((R * lda + C) * 2); }
#define PG8_SA(b, h) (((b) * 2 + (h)) * HTB)
#define PG8_SB(b, h) ((4 + (b) * 2 + (h)) * HTB)
#define PG8_STAGE2(bufoff, gbase, v0, v1) do { \
        __builtin_amdgcn_global_load_lds((const unsigned*)((const char*)(gbase) + (v0)), (LAS unsigned*)(lds + (bufoff) + ldsw), 16, 0, 0); \
        __builtin_amdgcn_global_load_lds((const unsigned*)((const char*)(gbase) + (v1)), (LAS unsigned*)(lds + (bufoff) + ldsw + 8192), 16, 0, 0); } while (0)
#define STB(bufoff, gbase, h) PG8_STAGE2(bufoff, (gbase) + ((h) ? hstepB : 0), vbU[0], vbU[1])
#define STA_CUR(bufoff, gbase, h) do { if (GATHER) PG8_STAGE2(bufoff, gbase, (h) ? cur.va10 : cur.va00, (h) ? cur.va11 : cur.va01); else PG8_STAGE2(bufoff, (gbase) + ((h) ? hstepA : 0), vaU[0], vaU[1]); } while (0)
#define STA_SEL(bufoff, gbase, h) do { if (GATHER) PG8_STAGE2(bufoff, gbase, last ? ((h) ? nxt.va10 : nxt.va00) : ((h) ? cur.va10 : cur.va00), last ? ((h) ? nxt.va11 : nxt.va01) : ((h) ? cur.va11 : cur.va01)); \
        else PG8_STAGE2(bufoff, (gbase) + ((h) ? hstepA : 0), vaU[0], vaU[1]); } while (0)
#define PG8_LDA(dst, b, h) do { _Pragma("unroll") for (int m = 0; m < 4; ++m) _Pragma("unroll") for (int k = 0; k < 2; ++k) dst[m][k] = *(const LAS bf16x8*)(lds + PG8_SA(b, h) + aoff + m * 2048 + k * 1024); } while (0)
#define PG8_LDB(dst, b, h) do { _Pragma("unroll") for (int n = 0; n < 2; ++n) _Pragma("unroll") for (int k = 0; k < 2; ++k) dst[n][k] = *(const LAS bf16x8*)(lds + PG8_SB(b, h) + boff + n * 2048 + k * 1024); } while (0)
#define PG8_MMA(ai, bj, At, Bt) do { __builtin_amdgcn_s_setprio(1); _Pragma("unroll") for (int m = 0; m < 4; ++m) _Pragma("unroll") for (int n = 0; n < 2; ++n) _Pragma("unroll") for (int k = 0; k < 2; ++k) \
        acc[ai][bj][m][n] = __builtin_amdgcn_mfma_f32_16x16x32_bf16(Bt[n][k], At[m][k], acc[ai][bj][m][n], 0, 0, 0); __builtin_amdgcn_s_setprio(0); } while (0)
#define PG8_WAIT_V(n) asm volatile("s_waitcnt vmcnt(" #n ")" ::: "memory")
#define PG8_WAIT_L(n) asm volatile("s_waitcnt lgkmcnt(" #n ")" ::: "memory")
#define PG8_BAR __builtin_amdgcn_s_barrier()
#define PG8_SCHED __builtin_amdgcn_sched_barrier(0)
    GJob cur, nxt; int ui = 0;
    cur.A = nullptr; cur.B = nullptr; cur.va00 = cur.va01 = cur.va10 = cur.va11 = 0u; nxt = cur;
    if (!jobfn(0, cur)) return;
    f32x4 acc[2][2][4][2];
#pragma unroll
    for (int a = 0; a < 2; ++a)
#pragma unroll
        for (int b = 0; b < 2; ++b)
#pragma unroll
            for (int m = 0; m < 4; ++m)
#pragma unroll
                for (int n = 0; n < 2; ++n) acc[a][b][m][n] = (f32x4){0.f, 0.f, 0.f, 0.f};
    bf16x8 At[4][2], B0[2][2], B1[2][2];
    STB(PG8_SB(0, 0), cur.B, 0); STB(PG8_SB(0, 1), cur.B, 1); STA_CUR(PG8_SA(0, 0), cur.A, 0); STA_CUR(PG8_SA(0, 1), cur.A, 1);
    if (wr == 1) PG8_BAR;
    PG8_WAIT_V(2); PG8_BAR;
    STB(PG8_SB(1, 0), cur.B + kstep, 0); STA_CUR(PG8_SA(1, 0), cur.A + kstep, 0); STB(PG8_SB(1, 1), cur.B + kstep, 1);
    PG8_WAIT_V(6); PG8_BAR;
    for (;;) {
        bool has_next = false;
        for (int t = 0; t < nt; t += 2) {
            const bool last = (t == nt - 2);
            if (last) { has_next = jobfn(ui + 1, nxt); if (!has_next) nxt = cur; }
            const char* a1 = cur.A + (size_t)(t + 1) * kstep;
            const char* a2 = last ? nxt.A : cur.A + (size_t)(t + 2) * kstep; const char* b2 = last ? nxt.B : cur.B + (size_t)(t + 2) * kstep;
            const char* a3 = a2 + kstep; const char* b3 = b2 + kstep;
            PG8_LDB(B0, 0, 0); PG8_LDB(B1, 0, 1); PG8_SCHED; PG8_LDA(At, 0, 0); STA_CUR(PG8_SA(1, 1), a1, 1);
            PG8_WAIT_V(8); PG8_WAIT_L(0); PG8_BAR; PG8_MMA(0, 0, At, B0); PG8_MMA(0, 1, At, B1); PG8_BAR; PG8_SCHED;
            PG8_LDA(At, 0, 1); STB(PG8_SB(0, 0), b2, 0); STB(PG8_SB(0, 1), b2, 1); STA_SEL(PG8_SA(0, 0), a2, 0);
            PG8_WAIT_V(8); PG8_WAIT_L(0); PG8_BAR; PG8_MMA(1, 0, At, B0); PG8_MMA(1, 1, At, B1); PG8_BAR; PG8_SCHED;
            PG8_LDB(B0, 1, 0); PG8_LDB(B1, 1, 1); PG8_SCHED; PG8_LDA(At, 1, 0); STA_SEL(PG8_SA(0, 1), a2, 1);
            PG8_WAIT_V(8); PG8_WAIT_L(0); PG8_BAR; PG8_MMA(0, 0, At, B0); PG8_MMA(0, 1, At, B1); PG8_BAR; PG8_SCHED;
            PG8_LDA(At, 1, 1); STB(PG8_SB(1, 0), b3, 0); STB(PG8_SB(1, 1), b3, 1); STA_SEL(PG8_SA(1, 0), a3, 0);
            PG8_WAIT_V(8); PG8_WAIT_L(0); PG8_BAR; PG8_MMA(1, 0, At, B0); PG8_MMA(1, 1, At, B1); PG8_BAR; PG8_SCHED;
        }
        if (wr == 0) PG8_BAR;
        epi(acc, ui);
        if (!has_next) break;
#pragma unroll
        for (int a = 0; a < 2; ++a)
#pragma unroll
            for (int b = 0; b < 2; ++b)
#pragma unroll
                for (int m = 0; m < 4; ++m)
#pragma unroll
                    for (int n = 0; n < 2; ++n) acc[a][b][m][n] = (f32x4){0.f, 0.f, 0.f, 0.f};
        cur = nxt; ++ui;
        if (wr == 1) PG8_BAR;
    }
    PG8_WAIT_V(0);
    PG8_BAR;
#undef PG8_SA
#undef PG8_SB
#undef PG8_STAGE2
#undef STB
#undef STA_CUR
#undef STA_SEL
#undef PG8_LDA
#undef PG8_LDB
#undef PG8_MMA
#undef PG8_WAIT_V
#undef PG8_WAIT_L
#undef PG8_BAR
#undef PG8_SCHED
}
__device__ __forceinline__ void gj_lin2(unsigned (&v)[2], int ld) {
#pragma unroll
    for (int i = 0; i < 2; ++i) { int R, C; g_stage_rc(tid_() * 16 + i * 8192, R, C); v[i] = (unsigned)((R * ld + C) * 2); }
}
typedef int i32x8 __attribute__((ext_vector_type(8)));
typedef unsigned u32x4 __attribute__((ext_vector_type(4)));
struct G8Job { const char* A; const char* B; unsigned va0, va1, va2, va3; };
__device__ __forceinline__ void g8_rc(int i, int& R, int& Cb) { int C; g_stage_rc(tid_() * 16 + i * 8192, R, C); Cb = C * 2; }
__device__ __forceinline__ const char* uni_ptr8(const char* p) {
    const unsigned long long v = (unsigned long long)p;
    const unsigned lo = __builtin_amdgcn_readfirstlane((unsigned)v), hi = __builtin_amdgcn_readfirstlane((unsigned)(v >> 32));
    return (const char*)(((unsigned long long)hi << 32) | lo);
}
template <bool GATHER, class JobFn, class Epi>
__device__ __forceinline__ void gemm8_stream(unsigned char* lds_, const unsigned (&vbU)[4], const JobFn& jobfn, const Epi& epi) {
    LAS unsigned char* lds = (LAS unsigned char*)lds_;
    const int tid = tid_(), wid = __builtin_amdgcn_readfirstlane(tid >> 6), lane = tid & 63, wr = wid >> 2, wc = wid & 3, fr = lane & 15, fq = lane >> 4;
    LAS unsigned char* a0p = lds + g_lds_byte(wr * 64 + fr, fq * 8); LAS unsigned char* a1p = a0p + 65536;
    LAS unsigned char* b0p = lds + 32768 + g_lds_byte(wc * 32 + fr, fq * 8); LAS unsigned char* b1p = b0p + 65536;
    const unsigned ldsw_u = __builtin_amdgcn_readfirstlane((unsigned)(size_t)(lds + wid * 1024));
#define G8_GLDS(base, voff, ldsaddr) asm volatile("s_mov_b32 m0, %2\n\ts_nop 0\n\tglobal_load_lds_dwordx4 %0, %1" :: "v"(voff), "s"(base), "s"(ldsaddr) : "memory", "m0")
#define G8_DMA(JA, JB, v0, v1, v2, v3, buf, kt) do { \
        const char* pa_ = uni_ptr8(JA) + (kt) * 128; const char* pb_ = uni_ptr8(JB) + (kt) * 128; const unsigned d_ = ldsw_u + (buf) * 65536; \
        G8_GLDS(pa_, (GATHER ? v0 : vb0), d_); \
        G8_GLDS(pa_, (GATHER ? v1 : vb1), d_ + 8192); \
        G8_GLDS(pa_, (GATHER ? v2 : vb2), d_ + 16384); \
        G8_GLDS(pa_, (GATHER ? v3 : vb3), d_ + 24576); \
        G8_GLDS(pb_, vb0, d_ + 32768); \
        G8_GLDS(pb_, vb1, d_ + 32768 + 8192); \
        G8_GLDS(pb_, vb2, d_ + 32768 + 16384); \
        G8_GLDS(pb_, vb3, d_ + 32768 + 24576); } while (0)
#define G8_LD(dst, ptr) do { const u32x4 x0_ = *(const LAS u32x4*)(ptr), x1_ = *(const LAS u32x4*)((ptr) + 1024); \
        dst = (i32x8){(int)x0_.x, (int)x0_.y, (int)x0_.z, (int)x0_.w, (int)x1_.x, (int)x1_.y, (int)x1_.z, (int)x1_.w}; } while (0)
#define G8_LDA(dst, ap, ai, m0, m1) do { _Pragma("unroll") for (int m = m0; m < m1; ++m) G8_LD(dst[m], (ap) + (ai) * 16384 + m * 2048); } while (0)
#define G8_LDB(dst, bp, bj) do { _Pragma("unroll") for (int n = 0; n < 2; ++n) G8_LD(dst[n], (bp) + (bj) * 16384 + n * 2048); } while (0)
#define G8_MMA(ai, bj, At, Bt) do { __builtin_amdgcn_sched_barrier(0); __builtin_amdgcn_s_setprio(1); _Pragma("unroll") for (int m = 0; m < 4; ++m) _Pragma("unroll") for (int n = 0; n < 2; ++n) \
        asm("v_mfma_scale_f32_16x16x128_f8f6f4 %0, %1, %2, %0, %3, %3 op_sel_hi:[0,0,0]" : "+v"(acc[ai][bj][m][n]) : "v"(Bt[n]), "v"(At[m]), "v"(unit_scale)); \
        __builtin_amdgcn_s_setprio(0); __builtin_amdgcn_sched_barrier(0); } while (0)
#define G8_PF 2
#define G8_TILE(buf, ap, bp, apn, bpn, X, Y, kt) do { \
        G8_LDA(P, ap, 0, G8_PF, 4); G8_LDB(Y, bp, 1); G8_MMA(0, 0, P, X); \
        G8_LDA(Q, ap, 1, 0, 2);                       G8_MMA(0, 1, P, Y); \
        G8_LDA(Q, ap, 1, 2, 4); G8_LDB(X, bp, 0);     G8_MMA(1, 1, Q, Y); \
        asm volatile("" ::: "memory"); __builtin_amdgcn_s_waitcnt(0x0070); __builtin_amdgcn_s_barrier(); asm volatile("" ::: "memory"); \
        asm volatile("" : "+v"(vb0), "+v"(vb1), "+v"(vb2), "+v"(vb3), "+v"(cur.va0), "+v"(cur.va1), "+v"(cur.va2), "+v"(cur.va3)); \
        G8_DMA(selA, selB, cur.va0, cur.va1, cur.va2, cur.va3, buf, kt); \
        G8_LDA(P, apn, 0, 0, G8_PF); G8_LDB(Y, bpn, 0); \
        G8_MMA(1, 0, Q, X); } while (0)
    G8Job cur, nxt;
    cur.A = nullptr; cur.B = nullptr; cur.va0 = cur.va1 = cur.va2 = cur.va3 = 0u; nxt = cur;
    if (!jobfn(0, cur)) return;
    cur.A = uni_ptr8(cur.A); cur.B = uni_ptr8(cur.B);
    unsigned vb0 = vbU[0], vb1 = vbU[1], vb2 = vbU[2], vb3 = vbU[3];
    G8_DMA(cur.A, cur.B, cur.va0, cur.va1, cur.va2, cur.va3, 0, 0); G8_DMA(cur.A, cur.B, cur.va0, cur.va1, cur.va2, cur.va3, 1, 1);
    asm volatile("s_waitcnt vmcnt(0)" ::: "memory");
    __syncthreads();
    int ui = 0;
    for (;;) {
        f32x4 acc[2][2][4][2];
#pragma unroll
        for (int a = 0; a < 2; ++a)
#pragma unroll
            for (int b = 0; b < 2; ++b)
#pragma unroll
                for (int m = 0; m < 4; ++m)
#pragma unroll
                    for (int n = 0; n < 2; ++n) acc[a][b][m][n] = (f32x4){0.f, 0.f, 0.f, 0.f};
        const bool has_next = jobfn(ui + 1, nxt);
        nxt.A = uni_ptr8(nxt.A); nxt.B = uni_ptr8(nxt.B);
        if (!has_next) nxt = cur;
        i32x8 P[4], Q[4], X[2], Y[2];
        const int unit_scale = 0x7f7f7f7f;
        G8_LDA(P, a0p, 0, 0, G8_PF); G8_LDB(X, b0p, 0);
#pragma unroll 1
        for (int t2 = 0; t2 < 4; ++t2) {
            const bool lastp = t2 == 3;
            const char* selA = lastp ? nxt.A : cur.A; const char* selB = lastp ? nxt.B : cur.B;
            if (GATHER) { cur.va0 = lastp ? nxt.va0 : cur.va0; cur.va1 = lastp ? nxt.va1 : cur.va1; cur.va2 = lastp ? nxt.va2 : cur.va2; cur.va3 = lastp ? nxt.va3 : cur.va3; }
            const int kt0 = lastp ? 0 : 2 * t2 + 2;
            asm volatile("" : "+v"(a0p), "+v"(a1p), "+v"(b0p), "+v"(b1p));
            G8_TILE(0, a0p, b0p, a1p, b1p, X, Y, kt0);
            G8_TILE(1, a1p, b1p, a0p, b0p, Y, X, kt0 + 1);
        }
        asm volatile("s_nop 15\n\ts_nop 15" ::: "memory");
        epi(acc, ui);
        if (!has_next) break;
        cur.A = nxt.A; cur.B = nxt.B; ++ui;
    }
#undef G8_TILE
#undef G8_PF
#undef G8_MMA
#undef G8_LDB
#undef G8_LDA
#undef G8_LD
#undef G8_DMA
#undef G8_GLDS
    __syncthreads();
}
struct RowLin { size_t base; int ld; __device__ __forceinline__ size_t operator()(int R) const { return base + (size_t)R * ld; } };

__device__ __forceinline__ void st_bf4(bf16_t* dst, f32x4 v) {
    uint2 o; o.x = pack2(v[0], v[1]); o.y = pack2(v[2], v[3]); *(uint2*)dst = o;
}
#define EPI8(...) do { const int tid_e = tid_(), lane_e = tid_e & 63, wid_e = tid_e >> 6, wr = wid_e >> 2, wc = wid_e & 3, fr = lane_e & 15, fq = lane_e >> 4; \
    _Pragma("unroll") for (int ai = 0; ai < 2; ++ai) _Pragma("unroll") for (int m = 0; m < 4; ++m) _Pragma("unroll") for (int bj = 0; bj < 2; ++bj) _Pragma("unroll") for (int n = 0; n < 2; ++n) { \
        const int row = ai * 128 + wr * 64 + m * 16 + fr, col = bj * 128 + wc * 32 + n * 16 + fq * 4; const f32x4 v = acc[ai][bj][m][n]; __VA_ARGS__ } } while (0)

struct EpiInproj {
    const P* p; int nt;
    __device__ __forceinline__ void operator()(int m, int n, int fq, f32x4 v) const {
        const P& P_ = *p;
        const int pos = m % LP;
        const float* rp = P_.rope() + (size_t)pos * 24;
        if (nt <= 2) {
            const bool isv = (nt == 2) && (n >= 128);
            if (!isv && (n & 48) == 0) {
                f32x4 pr;
#pragma unroll
                for (int j = 0; j < 4; ++j) pr[j] = __shfl_xor(v[j], 32);
                const int i0 = (fq & 1) * 4;
#pragma unroll
                for (int j = 0; j < 4; ++j) {
                    const float c = rp[i0 + j], s = rp[8 + i0 + j];
                    v[j] = fq < 2 ? v[j] * c - pr[j] * s : v[j] * c + pr[j] * s;
                }
            }
            if (nt < 2) { st_bf4(P_.q() + (size_t)m * 512 + nt * 256 + n, v * (0.125f * 1.4426950408889634f)); }
            else if (n < 128) st_bf4(P_.k() + (size_t)m * 128 + n, v);
            else st_bf4(P_.v() + (size_t)m * 128 + (n - 128), v);
        } else if (nt == 3 || nt == 4) {
            const bool ropeable = (nt == 3) ? ((n & 16) == 0) : (n < 16);
            if (ropeable) {
                f32x4 pr;
#pragma unroll
                for (int j = 0; j < 4; ++j) pr[j] = __shfl_xor(v[j], 16);
                if (fq < 2) {
#pragma unroll
                    for (int j = 0; j < 4; ++j) {
                        const float c = rp[16 + j], s = rp[20 + j];
                        v[j] = fq == 0 ? v[j] * c - pr[j] * s : v[j] * c + pr[j] * s;
                    }
                }
            }
            if (nt == 3) st_bf4(P_.iq() + (size_t)m * 256 + n, v);
            else if (n < 32) st_bf4(P_.ik() + (size_t)m * 32 + n, v);
            else if (n < 40) *(f32x4*)(P_.iw() + (size_t)m * 8 + (n - 32)) = v;
        } else if (nt <= 6) { st_bf4(P_.hq() + (size_t)m * 512 + (nt - 5) * 256 + n, v * 0.08838834764831845f); }
        else if (nt <= 8) { st_bf4(P_.hf() + (size_t)m * 512 + (nt - 7) * 256 + n, v); }
        else if (nt <= 10) { st_bf4(P_.hi() + (size_t)m * 512 + (nt - 9) * 256 + n, v); }
        else if (nt <= 12) {
            f32x4 o;
#pragma unroll
            for (int j = 0; j < 4; ++j) o[j] = v[j] * sigmoidf_(v[j]);
            st_bf4(P_.hg() + (size_t)m * 512 + (nt - 11) * 256 + n, o);
        } else {
            f32x4 o;
#pragma unroll
            for (int j = 0; j < 4; ++j) o[j] = sigmoidf_(v[j]);
            if (nt <= 16) st_bf4(P_.ga() + (size_t)m * 1024 + (nt - 13) * 256 + n, o);
            else st_bf4(P_.gh() + (size_t)m * 1024 + (nt - 17) * 256 + n, o);
        }
    }
};

__device__ __forceinline__ void ph_inproj(const P& p, unsigned char* lds) {
    const int nunits = (T / 256) * 21, G = gridDim.x, b0 = blockIdx.x;
    auto jobfn = [&](int i, GJob& j) __attribute__((always_inline)) -> bool {
        const int u = b0 + i * G; if (u >= nunits) return false;
        const int nt = u % 21, mt = u / 21;
        j.A = (const char*)(p.xn() + (size_t)mt * 256 * D); j.B = (const char*)(p.winT() + (size_t)nt * 256 * D); return true; };
    auto epi = [&](f32x4 (&acc)[2][2][4][2], int i) __attribute__((always_inline)) {
        const int u = b0 + i * G, nt = u % 21, mt = u / 21;
        const EpiInproj e{&p, nt};
        EPI8( e(mt * 256 + row, col, fq, v); );
    };
    unsigned vbU[2]; gj_lin2(vbU, D);
    gemm_stream<false>(lds, D, D, (size_t)128 * D * 2, vbU, jobfn, epi);
}

constexpr int NCH = 129, NXU = 16 * NCH;
constexpr int X_QT = 0, X_KT = X_QT + 64 * 272, X_KH = X_KT + 64 * 272, X_VT = X_KH + 128 * 144, X_AS = X_VT + 128 * 144, X_SEG = X_AS + 64 * 144;
__device__ __forceinline__ bf16_t* hg_ds(const P& p) { return (bf16_t*)p.out; }
__device__ __forceinline__ float* hg_g(const P& p) { return (float*)((unsigned char*)p.out + (size_t)NXU * 32768); }

__device__ __forceinline__ void hgx_unit(const P& p, unsigned char* lds, int u) {
    const int tid = tid_(), lane = tid & 63, wid = tid >> 6, fr = lane & 15, fq = lane >> 4;
    const int c = u % NCH, bh = u / NCH, b = bh >> 2, h = bh & 3;
    const int d = tid & 127, seg = tid >> 7;
    const size_t rowbase = (size_t)(b * LP + c * 64 + seg * 16) * 512 + h * 128 + d;
    bf16_t* hqp = p.hq() + rowbase; const bf16_t* hfp = p.hf() + rowbase; const bf16_t* hip = p.hi() + rowbase;
    const float lbv = p.lb()[h * 128 + d];
    float bb[16], qv[16], kk[16], vv[16];
    float cs = 0.f;
#pragma unroll
    for (int i = 0; i < 16; ++i) {
        const float f = lbv + (1.0f - lbv) * sigmoidf_(bf2f(hfp[(size_t)i * 512]));
        kk[i] = 1.0f - f; cs += __logf(f); bb[i] = cs;
        qv[i] = bf2f(hqp[(size_t)i * 512]); vv[i] = bf2f(hip[(size_t)i * 512]);
    }
    float* segs = (float*)(lds + X_SEG);
    segs[seg * 128 + d] = cs;
    __syncthreads();
    const float s0 = segs[d], s1 = segs[128 + d], s2 = segs[256 + d], s3 = segs[384 + d];
    const float off = seg == 0 ? 0.f : (seg == 1 ? s0 : (seg == 2 ? s0 + s1 : s0 + s1 + s2));
    const float rref = s0 + s1, blast = (s0 + s1) + (s2 + s3);
    uint32_t khp[8], vtp[8];
#pragma unroll
    for (int i = 0; i < 16; i += 2) {
        float khv[2];
#pragma unroll
        for (int j = 0; j < 2; ++j) {
            const float bt = bb[i + j] + off;
            const float eq = __expf(fminf(bt - rref, 80.f)), ek = __expf(fminf(rref - bt, 80.f));
            const int t = seg * 16 + i + j;
            *(bf16_t*)(lds + X_QT + t * 272 + d * 2) = f2bf(qv[i + j] * eq);
            *(bf16_t*)(lds + X_KT + t * 272 + d * 2) = f2bf(kk[i + j] * ek);
            hqp[(size_t)(i + j) * 512] = f2bf(qv[i + j] * __expf(bt));
            khv[j] = kk[i + j] * __expf(blast - bt);
        }
        khp[i >> 1] = pack2(khv[0], khv[1]); vtp[i >> 1] = pack2(vv[i], vv[i + 1]);
    }
    *(uint4*)(lds + X_KH + d * 144 + seg * 32) = make_uint4(khp[0], khp[1], khp[2], khp[3]);
    *(uint4*)(lds + X_KH + d * 144 + seg * 32 + 16) = make_uint4(khp[4], khp[5], khp[6], khp[7]);
    *(uint4*)(lds + X_VT + d * 144 + seg * 32) = make_uint4(vtp[0], vtp[1], vtp[2], vtp[3]);
    *(uint4*)(lds + X_VT + d * 144 + seg * 32 + 16) = make_uint4(vtp[4], vtp[5], vtp[6], vtp[7]);
    if (seg == 0) hg_g(p)[(size_t)u * 128 + d] = __expf(blast);
    __syncthreads();
    {
        const int tm = wid >> 1, tn0 = (wid & 1) * 2;
        f32x4 a1[2] = {(f32x4){0.f, 0.f, 0.f, 0.f}, (f32x4){0.f, 0.f, 0.f, 0.f}};
#pragma unroll
        for (int ks = 0; ks < 4; ++ks) {
            const bf16x8 aq = *(const bf16x8*)(lds + X_QT + (tm * 16 + fr) * 272 + (ks * 32 + fq * 8) * 2);
#pragma unroll
            for (int j = 0; j < 2; ++j) {
                const bf16x8 bk = *(const bf16x8*)(lds + X_KT + ((tn0 + j) * 16 + fr) * 272 + (ks * 32 + fq * 8) * 2);
                a1[j] = __builtin_amdgcn_mfma_f32_16x16x32_bf16(bk, aq, a1[j], 0, 0, 0);
            }
        }
#pragma unroll
        for (int j = 0; j < 2; ++j) {
            const int t = tm * 16 + fr, sb = (tn0 + j) * 16 + fq * 4;
            f32x4 v = a1[j];
#pragma unroll
            for (int jj = 0; jj < 4; ++jj) v[jj] = (sb + jj <= t) ? v[jj] : 0.f;
            uint2 o; o.x = pack2(v[0], v[1]); o.y = pack2(v[2], v[3]);
            *(uint2*)(lds + X_AS + t * 144 + sb * 2) = o;
        }
    }
    __syncthreads();
    {
        const int tm = wid >> 1, en0 = (wid & 1) * 4;
        f32x4 o2[4];
#pragma unroll
        for (int j = 0; j < 4; ++j) o2[j] = (f32x4){0.f, 0.f, 0.f, 0.f};
#pragma unroll
        for (int ks = 0; ks < 2; ++ks) {
            const bf16x8 aa = *(const bf16x8*)(lds + X_AS + (tm * 16 + fr) * 144 + (ks * 32 + fq * 8) * 2);
#pragma unroll
            for (int j = 0; j < 4; ++j) {
                const bf16x8 bv = *(const bf16x8*)(lds + X_VT + ((en0 + j) * 16 + fr) * 144 + (ks * 32 + fq * 8) * 2);
                o2[j] = __builtin_amdgcn_mfma_f32_16x16x32_bf16(bv, aa, o2[j], 0, 0, 0);
            }
        }
        bf16_t* orow = p.hf() + (size_t)(b * LP + c * 64 + tm * 16 + fr) * 512 + h * 128;
#pragma unroll
        for (int j = 0; j < 4; ++j) st_bf4(orow + (en0 + j) * 16 + fq * 4, o2[j]);
    }
    {
        f32x4 s3[8];
#pragma unroll
        for (int j = 0; j < 8; ++j) s3[j] = (f32x4){0.f, 0.f, 0.f, 0.f};
#pragma unroll
        for (int ks = 0; ks < 2; ++ks) {
            const bf16x8 ak = *(const bf16x8*)(lds + X_KH + (wid * 16 + fr) * 144 + (ks * 32 + fq * 8) * 2);
#pragma unroll
            for (int j = 0; j < 8; ++j) {
                const bf16x8 bv = *(const bf16x8*)(lds + X_VT + (j * 16 + fr) * 144 + (ks * 32 + fq * 8) * 2);
                s3[j] = __builtin_amdgcn_mfma_f32_16x16x32_bf16(ak, bv, s3[j], 0, 0, 0);
            }
        }
        bf16_t* dsb = hg_ds(p) + (size_t)u * 16384;
#pragma unroll
        for (int j = 0; j < 8; ++j) st_bf4(dsb + (size_t)(j * 16 + fr) * 128 + wid * 16 + fq * 4, s3[j]);
    }
    __syncthreads();
}

__device__ __forceinline__ void hgchain_unit(const P& p, int item) {
    const int tid = tid_(), bh = item >> 2, eq = item & 3;
    const int e = eq * 32 + (tid >> 4), d0 = (tid & 15) * 8;
    float S[8];
#pragma unroll
    for (int i = 0; i < 8; ++i) S[i] = 0.f;
    uint4* ptr = (uint4*)(hg_ds(p) + ((size_t)(bh * NCH) * 128 + e) * 128 + d0);
    const f32x4* gp = (const f32x4*)(hg_g(p) + (size_t)(bh * NCH) * 128 + d0);
    uint4 wq[8]; f32x4 g0[8], g1[8];
#pragma unroll
    for (int k = 0; k < 8; ++k) { wq[k] = ptr[(size_t)k * 2048]; g0[k] = gp[k * 32]; g1[k] = gp[k * 32 + 1]; }
    for (int c0 = 0; c0 < NCH; c0 += 8) {
#pragma unroll
        for (int k = 0; k < 8; ++k) {
            const int c = c0 + k;
            if (c < NCH) {
                const uint4 w = wq[k]; const f32x4 ga = g0[k], gb = g1[k];
                if (c + 8 < NCH) { wq[k] = ptr[(size_t)(c + 8) * 2048]; g0[k] = gp[(c + 8) * 32]; g1[k] = gp[(c + 8) * 32 + 1]; }
                ptr[(size_t)c * 2048] = make_uint4(pack2(S[0], S[1]), pack2(S[2], S[3]), pack2(S[4], S[5]), pack2(S[6], S[7]));
                S[0] = ga[0] * S[0] + __uint_as_float(w.x << 16); S[1] = ga[1] * S[1] + __uint_as_float(w.x & 0xffff0000u);
                S[2] = ga[2] * S[2] + __uint_as_float(w.y << 16); S[3] = ga[3] * S[3] + __uint_as_float(w.y & 0xffff0000u);
                S[4] = gb[0] * S[4] + __uint_as_float(w.z << 16); S[5] = gb[1] * S[5] + __uint_as_float(w.z & 0xffff0000u);
                S[6] = gb[2] * S[6] + __uint_as_float(w.w << 16); S[7] = gb[3] * S[7] + __uint_as_float(w.w & 0xffff0000u);
            }
        }
    }
}

__device__ __forceinline__ void hgz_unit(const P& p, unsigned char* lds, int u) {
    const int tid = tid_(), lane = tid & 63, wid = tid >> 6, fr = lane & 15, fq = lane >> 4;
    const int c = u % NCH, bh = u / NCH, b = bh >> 2, h = bh & 3;
    const int tm = wid >> 1, en0 = (wid & 1) * 4;
    const size_t row = (size_t)(b * LP + c * 64 + tm * 16 + fr);
    const bf16_t* qrow = p.hq() + row * 512 + h * 128;
    const bf16_t* sT = hg_ds(p) + (size_t)u * 16384;
    f32x4 o[4];
#pragma unroll
    for (int j = 0; j < 4; ++j) o[j] = (f32x4){0.f, 0.f, 0.f, 0.f};
#pragma unroll
    for (int ks = 0; ks < 4; ++ks) {
        const bf16x8 aq = *(const bf16x8*)(qrow + ks * 32 + fq * 8);
#pragma unroll
        for (int j = 0; j < 4; ++j) {
            const bf16x8 bs = *(const bf16x8*)(sT + (size_t)((en0 + j) * 16 + fr) * 128 + ks * 32 + fq * 8);
            o[j] = __builtin_amdgcn_mfma_f32_16x16x32_bf16(bs, aq, o[j], 0, 0, 0);
        }
    }
    const bf16_t* oi = p.hf() + row * 512 + h * 128;
    float ss = 0.f;
#pragma unroll
    for (int j = 0; j < 4; ++j) {
        const uint2 w = *(const uint2*)(oi + (en0 + j) * 16 + fq * 4);
        o[j][0] += __uint_as_float(w.x << 16); o[j][1] += __uint_as_float(w.x & 0xffff0000u);
        o[j][2] += __uint_as_float(w.y << 16); o[j][3] += __uint_as_float(w.y & 0xffff0000u);
        ss += o[j][0] * o[j][0] + o[j][1] * o[j][1] + o[j][2] * o[j][2] + o[j][3] * o[j][3];
    }
    ss += __shfl_xor(ss, 16); ss += __shfl_xor(ss, 32);
    float* part = (float*)lds;
    if (fq == 0) part[(tm * 16 + fr) * 2 + (wid & 1)] = ss;
    __syncthreads();
    const float tot = part[(tm * 16 + fr) * 2] + part[(tm * 16 + fr) * 2 + 1];
    const float rs = rsqrtf(tot * (1.0f / 128.0f) + EPS);
    const bf16_t* hgp = p.hg() + row * 512 + h * 128;
    bf16_t* outp = p.hgr() + row * 512 + h * 128;
#pragma unroll
    for (int j = 0; j < 4; ++j) {
        const int e0 = (en0 + j) * 16 + fq * 4;
        const f32x4 gn = *(const f32x4*)(p.hgrn_g + h * 128 + e0);
        const uint2 w = *(const uint2*)(hgp + e0);
        f32x4 r;
        r[0] = o[j][0] * rs * gn[0] * __uint_as_float(w.x << 16); r[1] = o[j][1] * rs * gn[1] * __uint_as_float(w.x & 0xffff0000u);
        r[2] = o[j][2] * rs * gn[2] * __uint_as_float(w.y << 16); r[3] = o[j][3] * rs * gn[3] * __uint_as_float(w.y & 0xffff0000u);
        st_bf4(outp + e0, r);
    }
    __syncthreads();
}

typedef float f32x16 __attribute__((ext_vector_type(16)));
typedef short s16x4 __attribute__((ext_vector_type(4)));

constexpr int NKMAX = 8224;
constexpr int NBIN = 1024;
constexpr int A_SC = 0, A_H1 = A_SC + 4 * NKMAX * 4, A_SEL = A_H1 + 4 * NBIN * 4, A_CAND = A_SEL + 2048, A_META = A_CAND + 1024, A_END = A_META + 256;
static_assert(A_END <= LDS_BYTES - 16, "attention LDS");
__device__ __forceinline__ uint32_t skey(float f) { const uint32_t u = __float_as_uint(f); return (u & 0x80000000u) ? ~u : (u | 0x80000000u); }
__device__ __forceinline__ float skey_inv(uint32_t k) { return __uint_as_float((k & 0x80000000u) ? (k & 0x7fffffffu) : ~k); }
__device__ __forceinline__ int bin1(float s, float lo, float scale) { return min(NBIN - 1, max(0, (int)((s - lo) * scale))); }
template <int OFF> __device__ __forceinline__ s16x4 tr_read(unsigned addr) {
    s16x4 r; asm volatile("ds_read_b64_tr_b16 %0, %1 offset:%2" : "=&v"(r) : "v"(addr), "i"(OFF) : "memory"); return r;
}
__device__ __forceinline__ void scan_top(const int* hist, int K, int* m, int lane) {
    int c[16];
#pragma unroll
    for (int i = 0; i < 4; ++i) { const int4 v = *(const int4*)(hist + 16 * lane + 4 * i); c[4 * i] = v.x; c[4 * i + 1] = v.y; c[4 * i + 2] = v.z; c[4 * i + 3] = v.w; }
    int tot = 0;
#pragma unroll
    for (int i = 0; i < 16; ++i) tot += c[i];
    int suf = tot;
#pragma unroll
    for (int o = 1; o < 64; o <<= 1) { const int t = __shfl_down(suf, o); if (lane + o < 64) suf += t; }
    int above = suf - tot;
#pragma unroll
    for (int i = 15; i >= 0; --i) {
        if (above < K && K <= above + c[i]) { m[0] = 16 * lane + i; m[1] = above; m[2] = c[i]; }
        above += c[i];
    }
}

__device__ __forceinline__ void attn4_unit(const P& p, unsigned char* lds, int b, int grp) {
    const int tid = tid_(), lane = tid & 63, wid = __builtin_amdgcn_readfirstlane(tid >> 6);
    const int t0 = NMETA + 4 * grp;
    const int brow = b * LP, row0 = brow + t0;
    float* sc = (float*)(lds + A_SC);
    int* h1 = (int*)(lds + A_H1);
    unsigned short* sel = (unsigned short*)(lds + A_SEL); unsigned short* cand = (unsigned short*)(lds + A_CAND);
    int* meta = (int*)(lds + A_META);
    const bool big = t0 + 1 > 256;
    for (int i = tid; i < 4 * NBIN; i += NTHREADS) h1[i] = 0;
    if (tid < 64) { const int w = tid & 15; meta[tid] = (w == 0) ? -1 : 0; }
    if (!big) { for (int i = tid; i < 1024; i += NTHREADS) { const int q = i >> 8, j = i & 255; sel[i] = (unsigned short)(j <= t0 + q ? j : 0); } }
    __syncthreads();
    if (big) {
        {
            const int hh = lane >> 5, c32 = lane & 31;
            const int g = c32 >> 3, h2a = (c32 >> 2) & 1, bq = c32 & 3, aq = 2 * h2a + (g >> 1), ah = 4 * (g & 1) + bq;
            const bf16_t* ap = p.iq() + (size_t)(row0 + aq) * 256 + ah * 32 + 8 * hh;
            const bf16x8 a0 = *(const bf16x8*)ap, a1 = *(const bf16x8*)(ap + 16);
            const f32x4 w00 = *(const f32x4*)(p.iw() + (size_t)(row0 + 2 * hh) * 8), w01 = *(const f32x4*)(p.iw() + (size_t)(row0 + 2 * hh) * 8 + 4);
            const f32x4 w10 = *(const f32x4*)(p.iw() + (size_t)(row0 + 2 * hh + 1) * 8), w11 = *(const f32x4*)(p.iw() + (size_t)(row0 + 2 * hh + 1) * 8 + 4);
            const int ntiles = (t0 + 4 + 31) >> 5;
            const int tq0 = t0 + 2 * hh;
            float mx0 = -INFINITY, mn0 = INFINITY, mx1 = -INFINITY, mn1 = INFINITY;
            const bf16_t* kbase = p.ik() + (size_t)brow * 32 + 8 * hh;
            for (int tile0 = wid; tile0 < ntiles; tile0 += 128) {
                bf16x8 b0[16], b1[16];
#pragma unroll
                for (int j = 0; j < 16; ++j) {
                    const int tile = min(tile0 + 8 * j, ntiles - 1);
                    const bf16_t* kp = kbase + (size_t)(tile * 32 + c32) * 32;
                    b0[j] = *(const bf16x8*)kp; b1[j] = *(const bf16x8*)(kp + 16);
                }
                __builtin_amdgcn_sched_barrier(0);
#pragma unroll
                for (int j = 0; j < 16; ++j) {
                    const int tile = tile0 + 8 * j;
                    if (tile < ntiles) {
                        const int key = tile * 32 + c32;
                        f32x16 acc;
#pragma unroll
                        for (int i = 0; i < 16; ++i) acc[i] = 0.f;
                        acc = __builtin_amdgcn_mfma_f32_32x32x16_bf16(a0, b0[j], acc, 0, 0, 0);
                        acc = __builtin_amdgcn_mfma_f32_32x32x16_bf16(a1, b1[j], acc, 0, 0, 0);
                        float s0 = 0.f, s1 = 0.f;
#pragma unroll
                        for (int i = 0; i < 4; ++i) {
                            s0 += w00[i] * fmaxf(acc[i], 0.f) + w01[i] * fmaxf(acc[4 + i], 0.f);
                            s1 += w10[i] * fmaxf(acc[8 + i], 0.f) + w11[i] * fmaxf(acc[12 + i], 0.f);
                        }
                        sc[(2 * hh) * NKMAX + key] = s0; sc[(2 * hh + 1) * NKMAX + key] = s1;
                        if (key <= tq0) { mx0 = fmaxf(mx0, s0); mn0 = fminf(mn0, s0); }
                        if (key <= tq0 + 1) { mx1 = fmaxf(mx1, s1); mn1 = fminf(mn1, s1); }
                    }
                }
            }
#pragma unroll
            for (int o = 16; o >= 1; o >>= 1) {
                mx0 = fmaxf(mx0, __shfl_xor(mx0, o)); mn0 = fminf(mn0, __shfl_xor(mn0, o));
                mx1 = fmaxf(mx1, __shfl_xor(mx1, o)); mn1 = fminf(mn1, __shfl_xor(mn1, o));
            }
            if (c32 == 0) {
                if (mx0 >= mn0) { atomicMin((unsigned*)&meta[(2 * hh) * 16 + 0], skey(mn0)); atomicMax((unsigned*)&meta[(2 * hh) * 16 + 1], skey(mx0)); }
                if (mx1 >= mn1) { atomicMin((unsigned*)&meta[(2 * hh + 1) * 16 + 0], skey(mn1)); atomicMax((unsigned*)&meta[(2 * hh + 1) * 16 + 1], skey(mx1)); }
            }
        }
        __syncthreads();
        const int q = wid & 3, part = wid >> 2, n = t0 + q + 1;
        const float lo = skey_inv((unsigned)meta[q * 16 + 0]), hi = skey_inv((unsigned)meta[q * 16 + 1]);
        const float scale = hi > lo ? (float)NBIN / (hi - lo) : 0.f;
        const float* scq = sc + q * NKMAX;
        for (int base = part * 256; base < n; base += 512) {
            const int idx0 = base + lane * 4;
            if (idx0 < n) {
                const f32x4 v = *(const f32x4*)(scq + idx0);
#pragma unroll
                for (int j = 0; j < 4; ++j) if (idx0 + j < n) atomicAdd(&h1[q * NBIN + bin1(v[j], lo, scale)], 1);
            }
        }
        __syncthreads();
        if (wid < 4) scan_top(h1 + wid * NBIN, 256, meta + wid * 16 + 4, lane);
        __syncthreads();
        const int B1 = meta[q * 16 + 4];
        for (int base = part * 256; base < n; base += 512) {
            const int idx0 = base + lane * 4;
            f32x4 v = (f32x4){0.f, 0.f, 0.f, 0.f};
            if (idx0 < n) v = *(const f32x4*)(scq + idx0);
            const unsigned long long lt = (1ull << lane) - 1ull;
#pragma unroll
            for (int j = 0; j < 4; ++j) {
                const int idx = idx0 + j;
                bool issel = false, iscand = false;
                if (idx < n) { const int b1 = bin1(v[j], lo, scale); issel = b1 > B1; iscand = b1 == B1; }
                const unsigned long long ms = __ballot(issel), mc = __ballot(iscand);
                if (ms) {
                    int bs = 0; if (lane == 0) bs = atomicAdd(&meta[q * 16 + 2], __popcll(ms));
                    bs = __shfl(bs, 0);
                    if (issel) sel[q * 256 + bs + __popcll(ms & lt)] = (unsigned short)idx;
                }
                if (mc) {
                    int bs = 0; if (lane == 0) bs = atomicAdd(&meta[q * 16 + 3], __popcll(mc));
                    bs = __shfl(bs, 0);
                    const int pos = bs + __popcll(mc & lt);
                    if (iscand && pos < 128) cand[q * 128 + pos] = (unsigned short)idx;
                }
            }
        }
        __syncthreads();
        if (wid < 4) {
            const int qq = wid; const float* scr = sc + qq * NKMAX;
            const int rq = 256 - meta[qq * 16 + 5], cq = meta[qq * 16 + 6], sbase = 256 - rq, nn = t0 + qq + 1;
            if (cq <= 128) {
                int taken = 0;
#pragma unroll
                for (int half = 0; half < 2; ++half) {
                    const int i = lane + 64 * half;
                    bool take = false; int myidx = 0;
                    if (i < cq) {
                        myidx = cand[qq * 128 + i]; const float mv = scr[myidx];
                        int rank = 0;
                        for (int j = 0; j < cq; ++j) { const int oj = cand[qq * 128 + j]; const float ov = scr[oj]; rank += (ov > mv) || (ov == mv && oj < myidx); }
                        take = rank < rq;
                    }
                    const unsigned long long mt = __ballot(take);
                    if (take) sel[qq * 256 + sbase + taken + __popcll(mt & ((1ull << lane) - 1ull))] = (unsigned short)myidx;
                    taken += __popcll(mt);
                }
            } else {
                const float lo_ = skey_inv((unsigned)meta[qq * 16 + 0]), hi_ = skey_inv((unsigned)meta[qq * 16 + 1]);
                const float sc_ = hi_ > lo_ ? (float)NBIN / (hi_ - lo_) : 0.f;
                const int B1_ = meta[qq * 16 + 4];
                int taken = 0;
                for (int base = 0; base < nn && taken < rq; base += 64) {
                    const int idx = base + lane; bool isc = false;
                    if (idx < nn) isc = bin1(scr[idx], lo_, sc_) == B1_;
                    const unsigned long long mc = __ballot(isc);
                    const int pos = taken + __popcll(mc & ((1ull << lane) - 1ull));
                    if (isc && pos < rq) sel[qq * 256 + sbase + pos] = (unsigned short)idx;
                    taken += __popcll(mc);
                }
            }
        }
        __syncthreads();
    }
    {
        const int q = wid >> 1, kvh = wid & 1, tq = t0 + q, nsel = min(tq + 1, 256);
        const int col = lane & 15, g4 = lane >> 4;
        const unsigned short* selq = sel + q * 256;
        bf16x8 qf0, qf1;
        {
            const bf16_t* qp = p.q() + (size_t)(row0 + q) * 512 + (kvh * 4 + (col & 3)) * 64 + g4 * 8;
            qf0 = *(const bf16x8*)qp; qf1 = *(const bf16x8*)(qp + 32);
            if (col >= 4) {
#pragma unroll
                for (int i = 0; i < 8; ++i) { qf0[i] = 0; qf1[i] = 0; }
            }
        }
        LAS unsigned char* vst = (LAS unsigned char*)lds + A_SC + wid * 16384;
        const bf16_t* vb = p.v() + (size_t)brow * 128 + kvh * 64 + (lane & 7) * 8;
        const unsigned rdbase = (unsigned)(uintptr_t)((LAS unsigned char*)lds + A_SC) + wid * 16384 + (4 * g4 + (col >> 2)) * 128 + (col & 3) * 8;
#define V_STAGE(s_, buf_) do { _Pragma("unroll") for (int i_ = 0; i_ < 4; ++i_) { \
            const int ksl_ = (s_) * 32 + i_ * 8 + (lane >> 3); const int key_ = selq[ksl_]; \
            __builtin_amdgcn_global_load_lds((const unsigned*)(vb + (size_t)key_ * 128), (LAS unsigned*)(vst + (buf_) * 4096 + i_ * 1024), 16, 0, 0); } } while (0)
        const bf16_t* kb = p.k() + (size_t)brow * 128 + kvh * 64 + g4 * 8;
        f32x4 lg[16];
        u32x4 vr[16];
        {
            bf16x8 k0[16], k1[16];
#pragma unroll
            for (int t = 0; t < 16; ++t) {
                const int key = selq[t * 16 + col];
                const bf16_t* kp = kb + (size_t)key * 128;
                k0[t] = *(const bf16x8*)kp; k1[t] = *(const bf16x8*)(kp + 32);
            }
#pragma unroll
            for (int s = 4; s < 8; ++s)
#pragma unroll
                for (int i = 0; i < 4; ++i) { const int key = selq[s * 32 + i * 8 + (lane >> 3)]; vr[(s - 4) * 4 + i] = *(const u32x4*)(vb + (size_t)key * 128); }
            V_STAGE(0, 0); V_STAGE(1, 1); V_STAGE(2, 2); V_STAGE(3, 3);
            __builtin_amdgcn_sched_barrier(0);
#pragma unroll
            for (int t = 0; t < 16; ++t) {
                f32x4 a = (f32x4){0.f, 0.f, 0.f, 0.f};
                a = __builtin_amdgcn_mfma_f32_16x16x32_bf16(k0[t], qf0, a, 0, 0, 0);
                a = __builtin_amdgcn_mfma_f32_16x16x32_bf16(k1[t], qf1, a, 0, 0, 0);
                lg[t] = a;
            }
            __builtin_amdgcn_sched_barrier(0);
        }
        float mx = -INFINITY;
#pragma unroll
        for (int t = 0; t < 16; ++t)
#pragma unroll
            for (int j = 0; j < 4; ++j) { if (t * 16 + g4 * 4 + j >= nsel) lg[t][j] = -INFINITY; mx = fmaxf(mx, lg[t][j]); }
        mx = fmaxf(mx, __shfl_xor(mx, 16)); mx = fmaxf(mx, __shfl_xor(mx, 32));
        float sm = 0.f;
#pragma unroll
        for (int t = 0; t < 16; ++t)
#pragma unroll
            for (int j = 0; j < 4; ++j) { const float e = __builtin_amdgcn_exp2f(lg[t][j] - mx); lg[t][j] = e; sm += e; }
        sm += __shfl_xor(sm, 16); sm += __shfl_xor(sm, 32);
        const float inv = 1.0f / sm;
        f32x4 o[4];
#pragma unroll
        for (int d = 0; d < 4; ++d) o[d] = (f32x4){0.f, 0.f, 0.f, 0.f};
        asm volatile("s_waitcnt vmcnt(0)" ::: "memory");
#pragma unroll
        for (int s = 0; s < 8; ++s) {
            if (s >= 4) {
#pragma unroll
                for (int i = 0; i < 4; ++i) *(LAS u32x4*)(vst + (s & 3) * 4096 + i * 1024 + lane * 16) = vr[(s - 4) * 4 + i];
                asm volatile("s_waitcnt lgkmcnt(0)" ::: "memory");
            }
            const unsigned rb = rdbase + (s & 3) * 4096;
            const s16x4 l0 = tr_read<0>(rb), h0 = tr_read<2048>(rb), l1 = tr_read<32>(rb), h1_ = tr_read<2048 + 32>(rb);
            const s16x4 l2 = tr_read<64>(rb), h2_ = tr_read<2048 + 64>(rb), l3 = tr_read<96>(rb), h3 = tr_read<2048 + 96>(rb);
            asm volatile("s_waitcnt lgkmcnt(0)" ::: "memory");
            __builtin_amdgcn_sched_barrier(0);
            bf16x8 pa;
            {
                const uint32_t w0 = pack2(lg[2 * s][0], lg[2 * s][1]), w1 = pack2(lg[2 * s][2], lg[2 * s][3]);
                const uint32_t w2 = pack2(lg[2 * s + 1][0], lg[2 * s + 1][1]), w3 = pack2(lg[2 * s + 1][2], lg[2 * s + 1][3]);
                pa[0] = (short)(w0 & 0xffff); pa[1] = (short)(w0 >> 16); pa[2] = (short)(w1 & 0xffff); pa[3] = (short)(w1 >> 16);
                pa[4] = (short)(w2 & 0xffff); pa[5] = (short)(w2 >> 16); pa[6] = (short)(w3 & 0xffff); pa[7] = (short)(w3 >> 16);
            }
#define PKV(L, H) (bf16x8){L[0], L[1], L[2], L[3], H[0], H[1], H[2], H[3]}
            o[0] = __builtin_amdgcn_mfma_f32_16x16x32_bf16(pa, PKV(l0, h0), o[0], 0, 0, 0);
            o[1] = __builtin_amdgcn_mfma_f32_16x16x32_bf16(pa, PKV(l1, h1_), o[1], 0, 0, 0);
            o[2] = __builtin_amdgcn_mfma_f32_16x16x32_bf16(pa, PKV(l2, h2_), o[2], 0, 0, 0);
            o[3] = __builtin_amdgcn_mfma_f32_16x16x32_bf16(pa, PKV(l3, h3), o[3], 0, 0, 0);
#undef PKV
        }
#undef V_STAGE
        const float i0 = __shfl(inv, 0), i1 = __shfl(inv, 1), i2 = __shfl(inv, 2), i3 = __shfl(inv, 3);
        if (g4 == 0) {
            bf16_t* op = p.att() + (size_t)(row0 + q) * 512 + kvh * 256 + col;
#pragma unroll
            for (int d = 0; d < 4; ++d) {
                op[0 * 64 + d * 16] = f2bf(o[d][0] * i0); op[1 * 64 + d * 16] = f2bf(o[d][1] * i1);
                op[2 * 64 + d * 16] = f2bf(o[d][2] * i2); op[3 * 64 + d * 16] = f2bf(o[d][3] * i3);
            }
        }
    }
    __syncthreads();
}

constexpr int NBW = 512;
constexpr int W_SC = 0, W_H = W_SC + NKMAX * 2, W_SEL = W_H + NBW * 4, W_CAND = W_SEL + 512, W_SZ = W_CAND + 256;
static_assert(8 * W_SZ <= LDS_BYTES - 32, "wave attention LDS");
__device__ __forceinline__ int binw(float s, float lo, float scale) { return min(NBW - 1, max(0, (int)((s - lo) * scale))); }

__device__ __forceinline__ void attn_wave(const P& p, unsigned char* lds, int wid, int lane, int b, int t, float mn, float mx) {
    unsigned char* wl = lds + wid * W_SZ;
    _Float16* sc = (_Float16*)(wl + W_SC);
    int* hist = (int*)(wl + W_H);
    unsigned short* sel = (unsigned short*)(wl + W_SEL);
    unsigned short* cand = (unsigned short*)(wl + W_CAND);
    const int brow = b * LP, row = brow + t, n = t + 1;
    const int col = lane & 15, g4 = lane >> 4;
    const unsigned long long lt = (1ull << lane) - 1ull;
    int nsel = 256;
    if (n > 256) {
        const float scale = mx > mn ? (float)NBW / (mx - mn) : 0.f, nls = -mn * scale;
#define BINF(x) min(NBW - 1, max(0, (int)__builtin_fmaf((x), scale, nls)))
#define H2F(u16) ((float)__builtin_bit_cast(_Float16, (unsigned short)(u16)))
        for (int base = 0; base < n; base += 512) {
            const int ia = base + lane * 4, ib = ia + 256;
            uint2 ra = make_uint2(0u, 0u), rb2 = make_uint2(0u, 0u);
            if (ia < n) ra = *(const uint2*)(sc + ia);
            if (ib < n) rb2 = *(const uint2*)(sc + ib);
            const unsigned wa[4] = {ra.x & 0xffffu, ra.x >> 16, ra.y & 0xffffu, ra.y >> 16}, wb[4] = {rb2.x & 0xffffu, rb2.x >> 16, rb2.y & 0xffffu, rb2.y >> 16};
#pragma unroll
            for (int j = 0; j < 4; ++j) {
                if (ia + j < n) atomicAdd(&hist[BINF(H2F(wa[j]))], 1);
                if (ib + j < n) atomicAdd(&hist[BINF(H2F(wb[j]))], 1);
            }
        }
        int B1, above1, cnt1;
        {
            int c[8];
            const int4 v0 = *(const int4*)(hist + 8 * lane), v1 = *(const int4*)(hist + 8 * lane + 4);
            c[0] = v0.x; c[1] = v0.y; c[2] = v0.z; c[3] = v0.w; c[4] = v1.x; c[5] = v1.y; c[6] = v1.z; c[7] = v1.w;
            int tot = 0;
#pragma unroll
            for (int i = 0; i < 8; ++i) tot += c[i];
            int suf = tot;
#pragma unroll
            for (int o = 1; o < 64; o <<= 1) { const int tt = __shfl_down(suf, o); if (lane + o < 64) suf += tt; }
            int above = suf - tot;
            const bool mine = above < 256 && 256 <= above + tot;
            int bb = 0, ab = 0, cb = 0;
#pragma unroll
            for (int i = 7; i >= 0; --i) { if (above < 256 && 256 <= above + c[i]) { bb = 8 * lane + i; ab = above; cb = c[i]; } above += c[i]; }
            const int src = (int)__builtin_ctzll(__ballot(mine));
            B1 = __shfl(bb, src); above1 = __shfl(ab, src); cnt1 = __shfl(cb, src);
        }
        int selcnt = 0, candcnt = 0;
        for (int base = 0; base < n; base += 512) {
            const int ia = base + lane * 4, ib = ia + 256;
            uint2 ra = make_uint2(0u, 0u), rb2 = make_uint2(0u, 0u);
            if (ia < n) ra = *(const uint2*)(sc + ia);
            if (ib < n) rb2 = *(const uint2*)(sc + ib);
            const unsigned wv[8] = {ra.x & 0xffffu, ra.x >> 16, ra.y & 0xffffu, ra.y >> 16, rb2.x & 0xffffu, rb2.x >> 16, rb2.y & 0xffffu, rb2.y >> 16};
            unsigned smask = 0u, cmask = 0u;
#pragma unroll
            for (int j = 0; j < 8; ++j) {
                const int idx = (j < 4 ? ia : ib) + (j & 3);
                const int b1 = idx < n ? BINF(H2F(wv[j])) : -1;
                smask |= (b1 > B1 ? 1u : 0u) << j; cmask |= (b1 == B1 ? 1u : 0u) << j;
            }
            const int cnt = __popc(smask);
            int inc = cnt;
#pragma unroll
            for (int o = 1; o < 64; o <<= 1) { const int tt = __shfl_up(inc, o); if (lane >= o) inc += tt; }
            int pos = selcnt + inc - cnt;
#pragma unroll
            for (int j = 0; j < 8; ++j) if ((smask >> j) & 1u) { sel[pos] = (unsigned short)((j < 4 ? ia : ib) + (j & 3)); ++pos; }
            selcnt += __shfl(inc, 63);
            if (__ballot(cmask != 0u)) {
#pragma unroll
                for (int j = 0; j < 8; ++j) {
                    const bool isc = (cmask >> j) & 1u;
                    const unsigned long long mc = __ballot(isc);
                    const int cp = candcnt + __popcll(mc & lt);
                    if (isc && cp < 128) cand[cp] = (unsigned short)((j < 4 ? ia : ib) + (j & 3));
                    candcnt += __popcll(mc);
                }
            }
        }
        {
            const int rq = 256 - above1, cq = cnt1, sbase = 256 - rq;
            if (cq <= 128) {
                int taken = 0;
#pragma unroll
                for (int half = 0; half < 2; ++half) {
                    const int i = lane + 64 * half;
                    bool take = false; int myidx = 0;
                    if (i < cq) {
                        myidx = cand[i]; const float mv = (float)sc[myidx];
                        int rank = 0;
                        for (int j = 0; j < cq; ++j) { const int oj = cand[j]; const float ov = (float)sc[oj]; rank += (ov > mv) || (ov == mv && oj < myidx); }
                        take = rank < rq;
                    }
                    const unsigned long long mt = __ballot(take);
                    if (take) sel[sbase + taken + __popcll(mt & lt)] = (unsigned short)myidx;
                    taken += __popcll(mt);
                }
            } else {
                int taken = 0;
                for (int base = 0; base < n && taken < rq; base += 64) {
                    const int idx = base + lane; bool isc = false;
                    if (idx < n) isc = BINF((float)sc[idx]) == B1;
                    const unsigned long long mc = __ballot(isc);
                    const int pos = taken + __popcll(mc & lt);
                    if (isc && pos < rq) sel[sbase + pos] = (unsigned short)idx;
                    taken += __popcll(mc);
                }
            }
        }
#undef BINF
#undef H2F
    } else {
        nsel = n;
#pragma unroll
        for (int i = 0; i < 4; ++i) { const int j = lane + 64 * i; sel[j] = (unsigned short)(j < n ? j : 0); }
    }
    LAS unsigned char* vst = (LAS unsigned char*)wl + W_SC;
    const unsigned rdbase = (unsigned)(uintptr_t)((LAS unsigned char*)wl + W_SC) + (4 * g4 + (col >> 2)) * 256 + (col & 3) * 8;
    {
        bf16x8 qf[4];
        {
            const bf16_t* qp = p.q() + (size_t)row * 512 + (col & 7) * 64 + g4 * 8;
            const bf16x8 q0 = *(const bf16x8*)qp, q1 = *(const bf16x8*)(qp + 32);
            const bool lo_grp = col < 4, hi_grp = col >= 4 && col < 8;
#pragma unroll
            for (int i = 0; i < 8; ++i) { qf[0][i] = lo_grp ? q0[i] : (short)0; qf[1][i] = lo_grp ? q1[i] : (short)0; qf[2][i] = hi_grp ? q0[i] : (short)0; qf[3][i] = hi_grp ? q1[i] : (short)0; }
        }
        const bf16_t* vb = p.v() + (size_t)brow * 128 + (lane & 15) * 8;
#define V_STAGE(s_, buf_) do { _Pragma("unroll") for (int i_ = 0; i_ < 4; ++i_) { \
            const int key_ = sel[(s_) * 16 + i_ * 4 + (lane >> 4)]; \
            __builtin_amdgcn_global_load_lds((const unsigned*)(vb + (size_t)key_ * 128), (LAS unsigned*)(vst + (buf_) * 4096 + i_ * 1024), 16, 0, 0); } } while (0)
        const bf16_t* kg = p.k() + (size_t)brow * 128;
#define K_STAGE(s_, buf_) do { _Pragma("unroll") for (int i_ = 0; i_ < 4; ++i_) { \
            const int kl_ = i_ * 4 + (lane >> 4); const int key_ = sel[(s_) * 16 + kl_]; \
            __builtin_amdgcn_global_load_lds((const unsigned*)(kg + (size_t)key_ * 128 + (((lane & 15) ^ kl_) & 15) * 8), (LAS unsigned*)(vst + (buf_) * 4096 + i_ * 1024), 16, 0, 0); } } while (0)
        f32x4 lg[16];
        K_STAGE(0, 0); K_STAGE(1, 1); K_STAGE(2, 2);
#pragma unroll
        for (int s = 0; s < 16; ++s) {
            if (s + 3 < 16) { K_STAGE(s + 3, (s + 3) & 3); asm volatile("s_waitcnt vmcnt(12)" ::: "memory"); }
            else if (s == 13) asm volatile("s_waitcnt vmcnt(8)" ::: "memory");
            else if (s == 14) asm volatile("s_waitcnt vmcnt(4)" ::: "memory");
            else asm volatile("s_waitcnt vmcnt(0)" ::: "memory");
            bf16x8 kf[4];
#pragma unroll
            for (int ks = 0; ks < 4; ++ks) kf[ks] = *(const LAS bf16x8*)(vst + (s & 3) * 4096 + col * 256 + (((ks * 4 + g4) ^ col) & 15) * 16);
            asm volatile("s_waitcnt lgkmcnt(0)" ::: "memory");
            __builtin_amdgcn_sched_barrier(0);
            f32x4 a = (f32x4){0.f, 0.f, 0.f, 0.f};
#pragma unroll
            for (int ks = 0; ks < 4; ++ks) a = __builtin_amdgcn_mfma_f32_16x16x32_bf16(kf[ks], qf[ks], a, 0, 0, 0);
            lg[s] = a;
        }
#undef K_STAGE
        V_STAGE(0, 0); V_STAGE(1, 1); V_STAGE(2, 2);
        float mxl = -INFINITY;
#pragma unroll
        for (int tt = 0; tt < 16; ++tt)
#pragma unroll
            for (int j = 0; j < 4; ++j) { if (tt * 16 + g4 * 4 + j >= nsel) lg[tt][j] = -INFINITY; mxl = fmaxf(mxl, lg[tt][j]); }
        mxl = fmaxf(mxl, __shfl_xor(mxl, 16)); mxl = fmaxf(mxl, __shfl_xor(mxl, 32));
        float sm = 0.f;
#pragma unroll
        for (int tt = 0; tt < 16; ++tt)
#pragma unroll
            for (int j = 0; j < 4; ++j) { const float e = __builtin_amdgcn_exp2f(lg[tt][j] - mxl); lg[tt][j] = e; sm += e; }
        sm += __shfl_xor(sm, 16); sm += __shfl_xor(sm, 32);
        const float inv = 1.0f / sm;
        f32x4 o[8];
#pragma unroll
        for (int d = 0; d < 8; ++d) o[d] = (f32x4){0.f, 0.f, 0.f, 0.f};
#pragma unroll
        for (int s = 0; s < 16; ++s) {
            if (s + 3 < 16) { V_STAGE(s + 3, (s + 3) & 3); asm volatile("s_waitcnt vmcnt(12)" ::: "memory"); }
            else if (s == 13) asm volatile("s_waitcnt vmcnt(8)" ::: "memory");
            else if (s == 14) asm volatile("s_waitcnt vmcnt(4)" ::: "memory");
            else asm volatile("s_waitcnt vmcnt(0)" ::: "memory");
            const unsigned rb = rdbase + (s & 3) * 4096;
            s16x4 pa;
            {
                const uint32_t w0 = pack2(lg[s][0], lg[s][1]), w1 = pack2(lg[s][2], lg[s][3]);
                pa[0] = (short)(w0 & 0xffff); pa[1] = (short)(w0 >> 16); pa[2] = (short)(w1 & 0xffff); pa[3] = (short)(w1 >> 16);
            }
            const s16x4 v0 = tr_read<0>(rb), v1 = tr_read<32>(rb), v2 = tr_read<64>(rb), v3 = tr_read<96>(rb);
            const s16x4 v4 = tr_read<128>(rb), v5 = tr_read<160>(rb), v6 = tr_read<192>(rb), v7 = tr_read<224>(rb);
            asm volatile("s_waitcnt lgkmcnt(0)" ::: "memory");
            __builtin_amdgcn_sched_barrier(0);
            o[0] = __builtin_amdgcn_mfma_f32_16x16x16bf16_1k(pa, v0, o[0], 0, 0, 0); o[1] = __builtin_amdgcn_mfma_f32_16x16x16bf16_1k(pa, v1, o[1], 0, 0, 0);
            o[2] = __builtin_amdgcn_mfma_f32_16x16x16bf16_1k(pa, v2, o[2], 0, 0, 0); o[3] = __builtin_amdgcn_mfma_f32_16x16x16bf16_1k(pa, v3, o[3], 0, 0, 0);
            o[4] = __builtin_amdgcn_mfma_f32_16x16x16bf16_1k(pa, v4, o[4], 0, 0, 0); o[5] = __builtin_amdgcn_mfma_f32_16x16x16bf16_1k(pa, v5, o[5], 0, 0, 0);
            o[6] = __builtin_amdgcn_mfma_f32_16x16x16bf16_1k(pa, v6, o[6], 0, 0, 0); o[7] = __builtin_amdgcn_mfma_f32_16x16x16bf16_1k(pa, v7, o[7], 0, 0, 0);
        }
#undef V_STAGE
        float ih[4];
#pragma unroll
        for (int jj = 0; jj < 4; ++jj) ih[jj] = __shfl(inv, 4 * (g4 & 1) + jj);
        if (g4 < 2) {
            bf16_t* op = p.att() + (size_t)row * 512 + (g4 * 4) * 64 + col;
#pragma unroll
            for (int d = 0; d < 4; ++d) {
                const f32x4 oa_ = o[d], ob_ = o[4 + d]; f32x4 ov;
#pragma unroll
                for (int kk = 0; kk < 4; ++kk) ov[kk] = g4 == 0 ? oa_[kk] : ob_[kk];
                op[0 * 64 + d * 16] = f2bf(ov[0] * ih[0]); op[1 * 64 + d * 16] = f2bf(ov[1] * ih[1]);
                op[2 * 64 + d * 16] = f2bf(ov[2] * ih[2]); op[3 * 64 + d * 16] = f2bf(ov[3] * ih[3]);
            }
        }
    }
}

constexpr int A8_META = 8 * W_SZ;
static_assert(A8_META + 64 + 512 <= LDS_BYTES - 32, "attn8 meta");
__device__ __forceinline__ void attn8_unit(const P& p, unsigned char* lds, int b, int grp) {
    const int tid = tid_(), lane = tid & 63, wid = __builtin_amdgcn_readfirstlane(tid >> 6);
    const int t0 = NMETA + 8 * grp, brow = b * LP, row0 = brow + t0;
    unsigned* meta = (unsigned*)(lds + A8_META);
    const bool big = t0 + 1 > 256;
    if (tid < 16) meta[tid] = (tid & 1) ? 0u : 0xffffffffu;
    bf16_t* uvec = (bf16_t*)(lds + A8_META + 64);
    if (big && tid < 256) {
        const int q = tid >> 5, d = tid & 31;
        const bf16_t* ip = p.iq() + (size_t)(row0 + q) * 256 + d; const float* wp = p.iw() + (size_t)(row0 + q) * 8;
        float u = 0.f;
#pragma unroll
        for (int h = 0; h < 8; ++h) u += wp[h] * bf2f(ip[h * 32]);
        uvec[q * 32 + d] = f2bf(u);
    }
    for (int i = tid; i < 8 * NBW; i += NTHREADS) ((int*)(lds + (i / NBW) * W_SZ + W_H))[i % NBW] = 0;
    __syncthreads();
    if (big) {
        const int hh = lane >> 5, c32 = lane & 31;
        const int g = c32 >> 3, h2a = (c32 >> 2) & 1, bq = c32 & 3, aq = 2 * h2a + (g >> 1), ah = 4 * (g & 1) + bq;
        bf16x8 a0[2], a1[2]; f32x4 w[2][2][2];
#pragma unroll
        for (int r = 0; r < 2; ++r) {
            const bf16_t* ap = p.iq() + (size_t)(row0 + 4 * r + aq) * 256 + ah * 32 + 8 * hh;
            a0[r] = *(const bf16x8*)ap; a1[r] = *(const bf16x8*)(ap + 16);
#pragma unroll
            for (int qi = 0; qi < 2; ++qi) {
                const float* wp = p.iw() + (size_t)(row0 + 4 * r + 2 * hh + qi) * 8;
                w[r][qi][0] = *(const f32x4*)wp; w[r][qi][1] = *(const f32x4*)(wp + 4);
            }
        }
        bf16x8 au0, au1;
        {
            const int uq = 4 * ((c32 & 3) >> 1) + 2 * ((c32 >> 2) & 1) + (c32 & 1);
            const bf16x8 v0 = *(const bf16x8*)(uvec + uq * 32 + 8 * hh), v1 = *(const bf16x8*)(uvec + uq * 32 + 8 * hh + 16);
#pragma unroll
            for (int i = 0; i < 8; ++i) { au0[i] = c32 < 8 ? v0[i] : (short)0; au1[i] = c32 < 8 ? v1[i] : (short)0; }
        }
        const int ntiles = (t0 + 8 + 31) >> 5;
        float mx[2][2], mn[2][2];
#pragma unroll
        for (int r = 0; r < 2; ++r)
#pragma unroll
            for (int qi = 0; qi < 2; ++qi) { mx[r][qi] = -INFINITY; mn[r][qi] = INFINITY; }
        const bf16_t* kbase = p.ik() + (size_t)brow * 32 + 8 * hh;
        bf16x8 b0[8], b1[8], c0[8], c1[8];
#define S_LOAD(B0, B1, T0) do { _Pragma("unroll") for (int j = 0; j < 8; ++j) { const int tile_ = min((T0) + 8 * j, ntiles - 1); \
            const bf16_t* kp_ = kbase + (size_t)(tile_ * 32 + c32) * 32; B0[j] = *(const bf16x8*)kp_; B1[j] = *(const bf16x8*)(kp_ + 16); } } while (0)
#define S_COMP(B0, B1, T0) do { _Pragma("unroll") for (int j = 0; j < 8; ++j) { const int tile = (T0) + 8 * j; if (tile < ntiles) { const int key = tile * 32 + c32; \
            f32x16 acu; _Pragma("unroll") for (int i = 0; i < 16; ++i) acu[i] = 0.f; \
            acu = __builtin_amdgcn_mfma_f32_32x32x16_bf16(au0, B0[j], acu, 0, 0, 0); acu = __builtin_amdgcn_mfma_f32_32x32x16_bf16(au1, B1[j], acu, 0, 0, 0); \
            _Pragma("unroll") for (int r = 0; r < 2; ++r) { f32x16 acc; _Pragma("unroll") for (int i = 0; i < 16; ++i) acc[i] = 0.f; \
                acc = __builtin_amdgcn_mfma_f32_32x32x16_bf16(a0[r], B0[j], acc, 0, 0, 0); acc = __builtin_amdgcn_mfma_f32_32x32x16_bf16(a1[r], B1[j], acc, 0, 0, 0); \
                _Pragma("unroll") for (int qi = 0; qi < 2; ++qi) { float s = acu[2 * r + qi]; \
                    _Pragma("unroll") for (int i = 0; i < 4; ++i) s += w[r][qi][0][i] * __builtin_fabsf(acc[8 * qi + i]) + w[r][qi][1][i] * __builtin_fabsf(acc[8 * qi + 4 + i]); \
                    const int q = 4 * r + 2 * hh + qi; const _Float16 hs = (_Float16)fminf(fmaxf(s, -60000.f), 60000.f); \
                    ((_Float16*)(lds + q * W_SZ + W_SC))[key] = hs; \
                    if (key <= t0 + q) { const float f = (float)hs; mx[r][qi] = fmaxf(mx[r][qi], f); mn[r][qi] = fminf(mn[r][qi], f); } } } } } } while (0)
        S_LOAD(b0, b1, wid);
        for (int tile0 = wid; tile0 < ntiles; tile0 += 128) {
            if (tile0 + 64 < ntiles) S_LOAD(c0, c1, tile0 + 64);
            __builtin_amdgcn_sched_barrier(0);
            S_COMP(b0, b1, tile0);
            __builtin_amdgcn_sched_barrier(0);
            if (tile0 + 128 < ntiles) S_LOAD(b0, b1, tile0 + 128);
            __builtin_amdgcn_sched_barrier(0);
            if (tile0 + 64 < ntiles) S_COMP(c0, c1, tile0 + 64);
            __builtin_amdgcn_sched_barrier(0);
        }
#undef S_LOAD
#undef S_COMP
#pragma unroll
        for (int r = 0; r < 2; ++r)
#pragma unroll
            for (int qi = 0; qi < 2; ++qi) {
                float a = mx[r][qi], c = mn[r][qi];
#pragma unroll
                for (int o = 16; o >= 1; o >>= 1) { a = fmaxf(a, __shfl_xor(a, o)); c = fminf(c, __shfl_xor(c, o)); }
                if (c32 == 0 && a >= c) { const int q = 4 * r + 2 * hh + qi; atomicMin(&meta[q * 2], skey(c)); atomicMax(&meta[q * 2 + 1], skey(a)); }
            }
    }
    __syncthreads();
    const float mnq = big ? skey_inv(meta[wid * 2]) : 0.f, mxq = big ? skey_inv(meta[wid * 2 + 1]) : 0.f;
    attn_wave(p, lds, wid, lane, b, t0 + wid, mnq, mxq);
    __syncthreads();
}

constexpr int NGRP8 = SEQ / 8, ATT_P1 = NGRP8 / 8, ATT_P2 = NGRP8 / 2;
template <int SUB>
__device__ __forceinline__ void ph_mixer(const P& p, unsigned char* lds) {
    int* bc = (int*)(lds + LDS_BYTES - 16);
    constexpr int nh = SUB == 1 ? 64 : NXU;
    constexpr int a0 = SUB == 0 ? 0 : (SUB == 1 ? ATT_P1 : ATT_P2), a1 = SUB == 0 ? ATT_P1 : (SUB == 1 ? ATT_P2 : NGRP8);
    for (;;) {
        __syncthreads();
        if (tid_() == 0) bc[0] = atomicAdd(&p.ctr()[97 + SUB], 1);
        __syncthreads();
        const int it = bc[0];
        if (it >= nh) break;
        if (SUB == 0) hgx_unit(p, lds, it);
        else if (SUB == 1) hgchain_unit(p, it);
        else hgz_unit(p, lds, it);
    }
    const int b0 = (int)(xb_xcc_id() & 3u);
#pragma unroll 1
    for (int k = 0; k < 4; ++k) {
        const int b = (b0 + k) & 3;
        for (;;) {
            __syncthreads();
            if (tid_() == 0) bc[0] = atomicAdd(&p.ctr()[104 + SUB * 4 + b], 1);
            __syncthreads();
            const int it = bc[0];
            if (it >= a1 - a0) break;
            attn8_unit(p, lds, b, NGRP8 - 1 - (a0 + it));
        }
    }
}

__device__ __forceinline__ int tok_row(int tok) { return (tok >> 13) * LP + NMETA + (tok & 8191); }
__device__ __forceinline__ void ph_mix(const P& p, unsigned char* lds) {
    const int njobs = (NTOK / 256) * 4 * 2, G = gridDim.x, b0 = blockIdx.x;
    auto jobidx = [&](int i) __attribute__((always_inline)) { return (b0 + (i >> 1) * G) * 2 + (i & 1); };
    auto jobfn = [&](int i, GJob& j) __attribute__((always_inline)) -> bool {
        const int jb = jobidx(i); if (jb >= njobs) return false;
        const int which = jb & 1, u = jb >> 1, nt = u & 3, mt = u >> 2; const size_t r0 = (size_t)tok_row(mt * 256);
        j.A = (const char*)((which ? p.hgr() : p.att()) + r0 * 512); j.B = (const char*)((which ? p.wuhT() : p.wuaT()) + (size_t)nt * 256 * 512); return true; };
    auto epi = [&](f32x4 (&acc)[2][2][4][2], int i) __attribute__((always_inline)) {
        const int jb = jobidx(i), which = jb & 1, u = jb >> 1, nt = u & 3, mt = u >> 2; const size_t r0 = (size_t)tok_row(mt * 256);
        if (which == 0) {
            EPI8(
                const size_t og = (r0 + row) * 1024 + nt * 256 + col, om = (size_t)(mt * 256 + row) * 1024 + nt * 256 + col;
                const uint2 g = *(const uint2*)(p.ga() + og);
                f32x4 r;
                r[0] = v[0] * __uint_as_float(g.x << 16); r[1] = v[1] * __uint_as_float(g.x & 0xffff0000u);
                r[2] = v[2] * __uint_as_float(g.y << 16); r[3] = v[3] * __uint_as_float(g.y & 0xffff0000u);
                st_bf4(p.mix() + om, r);
            );
        } else {
            EPI8(
                const size_t og = (r0 + row) * 1024 + nt * 256 + col, om = (size_t)(mt * 256 + row) * 1024 + nt * 256 + col;
                const uint2 g = *(const uint2*)(p.gh() + og);
                const uint2 a = *(const uint2*)(p.mix() + om);
                f32x4 r;
                r[0] = __uint_as_float(a.x << 16) + v[0] * __uint_as_float(g.x << 16); r[1] = __uint_as_float(a.x & 0xffff0000u) + v[1] * __uint_as_float(g.x & 0xffff0000u);
                r[2] = __uint_as_float(a.y << 16) + v[2] * __uint_as_float(g.y << 16); r[3] = __uint_as_float(a.y & 0xffff0000u) + v[3] * __uint_as_float(g.y & 0xffff0000u);
                st_bf4(p.mix() + om, r);
            );
        }
    };
    unsigned vbU[2]; gj_lin2(vbU, 512);
    gemm_stream<false>(lds, 512, 512, (size_t)128 * 512 * 2, vbU, jobfn, epi);
}

__device__ __forceinline__ void ph_out(const P& p, unsigned char* lds) {
    const int nunits = (NTOK / 256) * 4, G = gridDim.x, b0 = blockIdx.x;
    auto jobfn = [&](int i, GJob& j) __attribute__((always_inline)) -> bool {
        const int u = b0 + i * G; if (u >= nunits) return false;
        const int nt = u & 3, mt = u >> 2;
        j.A = (const char*)(p.mix() + (size_t)mt * 256 * D); j.B = (const char*)(p.woT() + (size_t)nt * 256 * D); return true; };
    auto epi = [&](f32x4 (&acc)[2][2][4][2], int i) __attribute__((always_inline)) {
        const int u = b0 + i * G, nt = u & 3, mt = u >> 2;
        EPI8(
            const size_t o = (size_t)(mt * 256 + row) * D + nt * 256 + col;
            const f32x4 h0 = *(const f32x4*)(p.x + o);
            *(f32x4*)(p.out + o) = h0 + v;
        );
    };
    unsigned vbU[2]; gj_lin2(vbU, D);
    gemm_stream<false>(lds, D, D, (size_t)128 * D * 2, vbU, jobfn, epi);
}

constexpr int XS_LD = 1025;
__device__ __forceinline__ void ph_route(const P& p, unsigned char* lds) {
    const int tid = tid_(), lane = tid & 63, wid = __builtin_amdgcn_readfirstlane(tid >> 6);
    const int gt = blockIdx.x * NTHREADS + tid, ntot = gridDim.x * NTHREADS;
    for (int i = gt; i < CAP; i += ntot) { p.slot_token()[i] = -1; p.slot_info()[i] = make_int2(-1, 0); }
    float* xs = (float*)lds;
    int* lhist = (int*)(lds + 32 * XS_LD * 4);
    for (int tb = blockIdx.x; tb < NTOK / 128; tb += gridDim.x) {
        if (tid < 32) lhist[tid] = 0;
        for (int tile = 0; tile < 4; ++tile) {
            const int tokt = tb * 128 + tile * 32;
            __syncthreads();
#pragma unroll
            for (int t = 0; t < 4; ++t) {
                const int tl = wid * 4 + t, tok = tokt + tl;
                const float* src = p.out + (size_t)tok * D;
                f32x4 v[4]; float ss = 0.f;
#pragma unroll
                for (int i = 0; i < 4; ++i) { v[i] = *(const f32x4*)(src + lane * 4 + 256 * i); ss += v[i][0] * v[i][0] + v[i][1] * v[i][1] + v[i][2] * v[i][2] + v[i][3] * v[i][3]; }
                ss = wave_sum(ss);
                const float rs = rsqrtf(ss * (1.0f / D) + EPS);
#pragma unroll
                for (int i = 0; i < 4; ++i) {
                    const f32x4 g = *(const f32x4*)(p.ffn_g + lane * 4 + 256 * i);
                    f32x4 xn; xn[0] = v[i][0] * rs * g[0]; xn[1] = v[i][1] * rs * g[1]; xn[2] = v[i][2] * rs * g[2]; xn[3] = v[i][3] * rs * g[3];
                    *(uint32_t*)(p.xn2() + (size_t)tok * D + lane * 4 + 256 * i) = pk4_fp8(xn[0], xn[1], xn[2], xn[3]);
#pragma unroll
                    for (int c = 0; c < 4; ++c) xs[tl * XS_LD + lane * 4 + 256 * i + c] = xn[c];
                }
            }
            __syncthreads();
            f32x16 acc;
#pragma unroll
            for (int i = 0; i < 16; ++i) acc[i] = 0.f;
            {
                const float* xr = xs + (lane & 31) * XS_LD + wid * 128 + (lane >> 5);
                const float* wp = p.router_w + (size_t)(wid * 128 + (lane >> 5)) * 32 + (lane & 31);
#pragma unroll 16
                for (int i = 0; i < 64; ++i) acc = __builtin_amdgcn_mfma_f32_32x32x2f32(xr[2 * i], wp[(size_t)(2 * i) * 32], acc, 0, 0, 0);
            }
            __syncthreads();
#pragma unroll
            for (int r = 0; r < 16; ++r) xs[wid * 1024 + ((r & 3) + 8 * (r >> 2) + 4 * (lane >> 5)) * 32 + (lane & 31)] = acc[r];
            __syncthreads();
            const int e = lane & 31, hh = lane >> 5;
            const float be = p.router_b[e];
#pragma unroll
            for (int it = 0; it < 2; ++it) {
                const int tl = wid * 4 + it * 2 + hh;
                float l = be;
#pragma unroll
                for (int w = 0; w < 8; ++w) l += xs[w * 1024 + tl * 32 + e];
                float bv[4]; int bi[4];
#pragma unroll
                for (int k = 0; k < 4; ++k) {
                    float m = l;
#pragma unroll
                    for (int o = 16; o >= 1; o >>= 1) m = fmaxf(m, __shfl_xor(m, o));
                    const unsigned long long bal = __ballot(l == m);
                    const unsigned half = hh ? (unsigned)(bal >> 32) : (unsigned)bal;
                    const int idx = __builtin_ctz(half);
                    bv[k] = m; bi[k] = idx;
                    if (e == idx) l = -INFINITY;
                }
                const float e1 = __expf(bv[1] - bv[0]), e2 = __expf(bv[2] - bv[0]), e3 = __expf(bv[3] - bv[0]);
                const float inv = 1.0f / (1.0f + e1 + e2 + e3);
                if (e == 0) {
                    const int tok = tokt + tl;
                    p.tok_exp()[tok * 4 + 0] = bi[0]; p.tok_exp()[tok * 4 + 1] = bi[1]; p.tok_exp()[tok * 4 + 2] = bi[2]; p.tok_exp()[tok * 4 + 3] = bi[3];
                    p.tok_gate()[tok * 4 + 0] = inv; p.tok_gate()[tok * 4 + 1] = e1 * inv; p.tok_gate()[tok * 4 + 2] = e2 * inv; p.tok_gate()[tok * 4 + 3] = e3 * inv;
                    atomicAdd(&lhist[bi[0]], 1); atomicAdd(&lhist[bi[1]], 1); atomicAdd(&lhist[bi[2]], 1); atomicAdd(&lhist[bi[3]], 1);
                }
            }
        }
        __syncthreads();
        if (tid < 32) p.wg_cnt()[tb * 32 + tid] = lhist[tid];
        __syncthreads();
    }
    for (long task = gt; task < 96L * 16384; task += ntot) {
        const int mat = (int)(task >> 14), r = (int)(task & 16383), kq = r >> 10, n = r & 1023;
        const int which = mat >> 5, e = mat & 31;
        const float* W = (which == 0 ? p.w_gate : which == 1 ? p.w_up : p.w_down) + (size_t)e * 1048576 + (size_t)(kq * 64) * 1024 + n;
        unsigned char* outp = (which == 0 ? p.wgT() : which == 1 ? p.wuT() : p.wdT()) + (size_t)e * 1048576 + (size_t)n * 1024 + kq * 64;
        float v[64];
#pragma unroll
        for (int i = 0; i < 64; ++i) v[i] = W[(size_t)i * 1024] * 32.0f;
        uint4* dst = (uint4*)outp;
#pragma unroll
        for (int i = 0; i < 4; ++i) dst[i] = make_uint4(pk4_fp8(v[16 * i], v[16 * i + 1], v[16 * i + 2], v[16 * i + 3]), pk4_fp8(v[16 * i + 4], v[16 * i + 5], v[16 * i + 6], v[16 * i + 7]),
                                                        pk4_fp8(v[16 * i + 8], v[16 * i + 9], v[16 * i + 10], v[16 * i + 11]), pk4_fp8(v[16 * i + 12], v[16 * i + 13], v[16 * i + 14], v[16 * i + 15]));
    }
}

__device__ __forceinline__ void ph_fill(const P& p, unsigned char* lds) {
    const int tid = tid_();
    int* tot = (int*)lds;
    int* pre = tot + 512;
    int* ps = pre + 512;
    int* lc = ps + 32;
    for (int tb = blockIdx.x; tb < NTOK / 128; tb += gridDim.x) {
        {
            const int e = tid & 31, part = tid >> 5;
            int t = 0, q = 0;
            for (int b2 = part; b2 < NTOK / 128; b2 += 16) { const int c = p.wg_cnt()[b2 * 32 + e]; t += c; if (b2 < tb) q += c; }
            tot[part * 32 + e] = t; pre[part * 32 + e] = q;
        }
        __syncthreads();
        if (tid == 0) {
            int acc = 0;
            for (int e = 0; e < NE; ++e) {
                int t = 0, q = 0;
                for (int i = 0; i < 16; ++i) { t += tot[i * 32 + e]; q += pre[i * 32 + e]; }
                ps[e] = acc + q; lc[e] = 0;
                const int nb = (t + 255) >> 8;
                if (tb == 0) for (int i = 0; i < nb; ++i) p.block_expert()[(acc >> 8) + i] = e;
                acc += nb * 256;
            }
            if (tb == 0) p.ctr()[96] = acc >> 8;
        }
        __syncthreads();
        {
            const int i = tb * 512 + tid;
            const int e = p.tok_exp()[i];
            const int dest = ps[e] + atomicAdd(&lc[e], 1);
            p.slot_token()[dest] = i >> 2;
            p.slot_rank()[dest] = i & 3;
            p.slot_gate()[dest] = p.tok_gate()[i];
            p.slot_info()[dest] = make_int2((i >> 2) | ((i & 3) << 16), __float_as_int(p.tok_gate()[i]));
        }
        __syncthreads();
    }
}

__device__ __forceinline__ void ph_moe1(const P& p, unsigned char* lds) {
    const int nblocks = p.ctr()[96], G = gridDim.x, b0 = blockIdx.x, bpx = (nblocks + 7) >> 3, bpi = G >> 6, xl = b0 >> 3, xbase = (b0 & 7) * bpx;
    auto unit = [&](int i, int& rb, int& ct) __attribute__((always_inline)) -> bool {
        const int k = i * bpi + (xl >> 3); rb = xbase + k; ct = xl & 7; return k < bpx && rb < nblocks && (xl >> 3) < bpi; };
    auto jobfn = [&](int i, G8Job& j) __attribute__((always_inline)) -> bool {
        int rb, ct; if (!unit(i, rb, ct)) return false;
        const int e = p.block_expert()[rb];
        j.A = (const char*)p.xn2(); j.B = (const char*)(p.wgT() + (size_t)e * 1048576 + (size_t)ct * 128 * 1024);
        const int* st = p.slot_token() + rb * 256; unsigned v[4];
#pragma unroll
        for (int q = 0; q < 4; ++q) { int R, Cb; g8_rc(q, R, Cb); const int t = st[R]; v[q] = (unsigned)((t < 0 ? 0 : t) * 1024 + Cb); }
        j.va0 = v[0]; j.va1 = v[1]; j.va2 = v[2]; j.va3 = v[3]; return true; };
    auto epi = [&](f32x4 (&acc)[2][2][4][2], int i) __attribute__((always_inline)) {
        int rb, ct; unit(i, rb, ct);
        const int e = p.block_expert()[rb];
        const int tid_e = tid_(), lane_e = tid_e & 63, wid_e = tid_e >> 6, wr = wid_e >> 2, wc = wid_e & 3, fr = lane_e & 15, fq = lane_e >> 4;
#pragma unroll
        for (int n = 0; n < 2; ++n) {
            const int c = ct * 128 + wc * 32 + n * 16 + fq * 4;
            const f32x4 bg = *(const f32x4*)(p.b_gate + (size_t)e * DFF + c), bu = *(const f32x4*)(p.b_up + (size_t)e * DFF + c);
#pragma unroll
            for (int ai = 0; ai < 2; ++ai)
#pragma unroll
                for (int m = 0; m < 4; ++m) {
                    const int row = rb * 256 + ai * 128 + wr * 64 + m * 16 + fr;
                    f32x4 a;
#pragma unroll
                    for (int j = 0; j < 4; ++j) {
                        const float g = fminf(acc[ai][0][m][n][j] * 0.03125f + bg[j], 7.0f);
                        const float uu = fminf(fmaxf(acc[ai][1][m][n][j] * 0.03125f + bu[j], -7.0f), 7.0f);
                        a[j] = (uu + 1.0f) * (g * sigmoidf_(1.702f * g));
                    }
                    *(uint32_t*)(p.act() + (size_t)row * DFF + c) = pk4_fp8(a[0], a[1], a[2], a[3]);
                }
        }
    };
    unsigned vbU[4];
#pragma unroll
    for (int q = 0; q < 4; ++q) { int R, Cb; g8_rc(q, R, Cb); vbU[q] = (unsigned)((size_t)(R >> 7) * WE8_B + (size_t)(R & 127) * 1024 + Cb); }
    gemm8_stream<true>(lds, vbU, jobfn, epi);
}
__device__ __forceinline__ void ph_moe2(const P& p, unsigned char* lds) {
    const int nblocks = p.ctr()[96], G = gridDim.x, b0 = blockIdx.x, bpx = (nblocks + 7) >> 3, bpi = G >> 5, xl = b0 >> 3, xbase = (b0 & 7) * bpx;
    auto unit = [&](int i, int& rb, int& nt) __attribute__((always_inline)) -> bool {
        const int k = i * bpi + (xl >> 2); rb = xbase + k; nt = xl & 3; return k < bpx && rb < nblocks && (xl >> 2) < bpi; };
    unsigned vbU[4];
#pragma unroll
    for (int q = 0; q < 4; ++q) { int R, Cb; g8_rc(q, R, Cb); vbU[q] = (unsigned)(R * DFF + Cb); }
    auto jobfn = [&](int i, G8Job& j) __attribute__((always_inline)) -> bool {
        int rb, nt; if (!unit(i, rb, nt)) return false;
        const int e = p.block_expert()[rb];
        j.A = (const char*)(p.act() + (size_t)rb * 256 * DFF); j.B = (const char*)(p.wdT() + (size_t)e * 1048576 + (size_t)nt * 256 * DFF); return true; };
    auto epi = [&](f32x4 (&acc)[2][2][4][2], int i) __attribute__((always_inline)) {
        int rb, nt; unit(i, rb, nt);
        const int e = p.block_expert()[rb];
        const int tid_e = tid_(), lane_e = tid_e & 63, wid_e = tid_e >> 6, wr = wid_e >> 2, wc = wid_e & 3, fr = lane_e & 15, fq = lane_e >> 4;
        f32x4 bd[2][2];
#pragma unroll
        for (int bj = 0; bj < 2; ++bj)
#pragma unroll
            for (int n = 0; n < 2; ++n) bd[bj][n] = *(const f32x4*)(p.b_down + (size_t)e * D + nt * 256 + bj * 128 + wc * 32 + n * 16 + fq * 4);
        int2 info[2][4];
#pragma unroll
        for (int ai = 0; ai < 2; ++ai)
#pragma unroll
            for (int m = 0; m < 4; ++m) info[ai][m] = p.slot_info()[rb * 256 + ai * 128 + wr * 64 + m * 16 + fr];
#pragma unroll
        for (int ai = 0; ai < 2; ++ai)
#pragma unroll
        for (int mp = 0; mp < 2; ++mp) {
            f32x4 old[2][2][2];
#pragma unroll
            for (int mm = 0; mm < 2; ++mm) {
                const int ix = info[ai][mp * 2 + mm].x;
                const size_t o = (size_t)(ix & 0xffff) * D + nt * 256 + wc * 32 + fq * 4;
#pragma unroll
                for (int bj = 0; bj < 2; ++bj)
#pragma unroll
                    for (int n = 0; n < 2; ++n) old[mm][bj][n] = (ix >= 0 && (ix >> 16) == 0) ? *(const f32x4*)(p.out + o + bj * 128 + n * 16) : (f32x4){0.f, 0.f, 0.f, 0.f};
            }
#pragma unroll
            for (int mm = 0; mm < 2; ++mm) {
                const int m = mp * 2 + mm;
                const int ix = info[ai][m].x;
                if (ix < 0) continue;
                const int rank = ix >> 16; const float gate = __int_as_float(info[ai][m].y);
                const size_t o = (size_t)(ix & 0xffff) * D + nt * 256 + wc * 32 + fq * 4;
                if (rank == 0) {
#pragma unroll
                    for (int bj = 0; bj < 2; ++bj)
#pragma unroll
                        for (int n = 0; n < 2; ++n) *(f32x4*)(p.out + o + bj * 128 + n * 16) = old[mm][bj][n] + (acc[ai][bj][m][n] * 0.03125f + bd[bj][n]) * gate;
                } else {
                    bf16_t* yb = rank == 1 ? p.y1() : (rank == 2 ? p.y2() : p.y3());
#pragma unroll
                    for (int bj = 0; bj < 2; ++bj)
#pragma unroll
                        for (int n = 0; n < 2; ++n) st_bf4(yb + o + bj * 128 + n * 16, (acc[ai][bj][m][n] * 0.03125f + bd[bj][n]) * gate);
                }
            }
        }
    };
    gemm8_stream<false>(lds, vbU, jobfn, epi);
}

__device__ __forceinline__ void ph_final(const P& p, unsigned char* lds) {
    const int tid = tid_(), lane = tid & 63, wid = tid >> 6;
    const int gw = blockIdx.x * 8 + wid, nw = gridDim.x * 8;
    for (int tok = gw; tok < NTOK; tok += nw) {
        float* dst = p.out + (size_t)tok * D;
        f32x4 v[4];
#pragma unroll
        for (int i = 0; i < 4; ++i) v[i] = *(const f32x4*)(dst + lane * 4 + 256 * i);
#pragma unroll
        for (int j = 0; j < 3; ++j) {
            const bf16_t* yr = (j == 0 ? p.y1() : j == 1 ? p.y2() : p.y3()) + (size_t)tok * D;
#pragma unroll
            for (int i = 0; i < 4; ++i) {
                const uint2 w = *(const uint2*)(yr + lane * 4 + 256 * i);
                v[i][0] += __uint_as_float(w.x << 16); v[i][1] += __uint_as_float(w.x & 0xffff0000u);
                v[i][2] += __uint_as_float(w.y << 16); v[i][3] += __uint_as_float(w.y & 0xffff0000u);
            }
        }
        float ss = 0.f;
#pragma unroll
        for (int i = 0; i < 4; ++i) ss += v[i][0] * v[i][0] + v[i][1] * v[i][1] + v[i][2] * v[i][2] + v[i][3] * v[i][3];
        ss = wave_sum(ss);
        const float rs = rsqrtf(ss * (1.0f / D) + EPS);
#pragma unroll
        for (int i = 0; i < 4; ++i) {
            const f32x4 g = *(const f32x4*)(p.final_g + lane * 4 + 256 * i);
            *(f32x4*)(dst + lane * 4 + 256 * i) = v[i] * rs * g;
        }
    }
}

typedef const __attribute__((address_space(4))) P* PK;
#define PHASE(call) do { PK q_ = pk; asm volatile("" : "+s"(q_)); const P& p = *(const P*)q_; call; } while (0)
__global__ void __launch_bounds__(NTHREADS) k_mega(P p_unused) {
    __shared__ __attribute__((aligned(16))) unsigned char lds[LDS_BYTES];
    cg::grid_group grid = cg::this_grid();
    const PK pk = (PK)__builtin_amdgcn_kernarg_segment_ptr();
    if (tid_() < 4) ((unsigned*)(lds + LDS_BYTES - 32))[tid_()] = 0u;
    __syncthreads();
    XcdBarrier xb;
    PHASE(xb = xcd_barrier_post((unsigned*)(p.ws + OFF_BAR), (volatile LAS unsigned*)(lds + LDS_BYTES - 32)));
    PHASE(if (p.ws == nullptr) grid.sync());
    PHASE(ph_prep(p, lds)); xcd_barrier(xb);
    PHASE(ph_inproj(p, lds)); xcd_barrier(xb);
    PHASE(ph_mixer<0>(p, lds)); xcd_barrier(xb);
    PHASE(ph_mixer<1>(p, lds)); xcd_barrier(xb);
    PHASE(ph_mixer<2>(p, lds)); xcd_barrier(xb);
    PHASE(ph_mix(p, lds)); xcd_barrier(xb);
    PHASE(ph_out(p, lds)); xcd_barrier(xb);
    PHASE(ph_route(p, lds)); xcd_barrier(xb);
    PHASE(ph_fill(p, lds)); xcd_barrier(xb);
    PHASE(ph_moe1(p, lds)); xcd_barrier(xb);
    PHASE(ph_moe2(p, lds)); xcd_barrier(xb);
    PHASE(ph_final(p, lds));
}

extern "C" void kernel_launch(void* const* d_in, const int* in_sizes, int n_in, void* d_out, int out_size, void* d_ws, size_t ws_size,
                              hipStream_t stream) {
    P p{};
    p.x = (const float*)d_in[0]; p.meta = (const float*)d_in[1]; p.attn_g = (const float*)d_in[2]; p.w_in = (const float*)d_in[3];
    p.hgrn_g = (const float*)d_in[4]; p.w_ua = (const float*)d_in[5]; p.w_uh = (const float*)d_in[6]; p.w_out = (const float*)d_in[7];
    p.lb_logits = (const float*)d_in[8]; p.ffn_g = (const float*)d_in[9]; p.router_w = (const float*)d_in[10]; p.router_b = (const float*)d_in[11];
    p.w_gate = (const float*)d_in[12]; p.b_gate = (const float*)d_in[13]; p.w_up = (const float*)d_in[14]; p.b_up = (const float*)d_in[15];
    p.w_down = (const float*)d_in[16]; p.b_down = (const float*)d_in[17]; p.final_g = (const float*)d_in[18];
    p.out = (float*)d_out;
    p.ws = (unsigned char*)d_ws;
    if (WS_NEED > ws_size) { fprintf(stderr, "workspace too small: need %zu have %zu\n", (size_t)WS_NEED, ws_size); return; }
    static int grid_blocks = 0;
    if (!grid_blocks) {
        int dev = 0, cus = 0, per_cu = 0;
        hipGetDevice(&dev);
        hipDeviceGetAttribute(&cus, hipDeviceAttributeMultiprocessorCount, dev);
        hipOccupancyMaxActiveBlocksPerMultiprocessor(&per_cu, k_mega, NTHREADS, 0);
        if (per_cu > 1) per_cu = 1;
        grid_blocks = cus * per_cu;
    }
    hipMemsetAsync(p.ws + OFF_BAR, 0, XCD_BAR_WORDS * 4, stream);
    void* args[] = {&p};
    hipError_t e = hipLaunchCooperativeKernel((void*)k_mega, dim3(grid_blocks), dim3(NTHREADS), args, 0, stream);
    if (e != hipSuccess) fprintf(stderr, "cooperative launch failed: %s (grid %d)\n", hipGetErrorString(e), grid_blocks);
}
```

```cpp
#include <hip/hip_runtime.h>
#include <hip/hip_cooperative_groups.h>
#include <stdint.h>
#include <cstdio>
namespace cg = cooperative_groups;

#ifndef MEGA
#define MEGA 1
#endif

typedef unsigned short bf16_t;
typedef short bf16x8 __attribute__((ext_vector_type(8)));
typedef float f32x4 __attribute__((ext_vector_type(4)));

constexpr int D = 1024, NB = 4, SEQ = 8192, NMETA = 16, L = SEQ + NMETA  , LP = 8320, T = NB * LP  ;
constexpr int NTOK = NB * SEQ;
constexpr int IN_COLS = 5160;
constexpr int NE = 32, TOPK = 4, DFF = 1024;
constexpr int CAP_BLOCKS = (NTOK * TOPK) / 256 + NE;
constexpr int CAP = CAP_BLOCKS * 256;
constexpr float EPS = 1e-5f;
constexpr int NTHREADS = 512;
constexpr int LDS_BYTES = 155648;
constexpr int NVC = 5376;
#define LAS __attribute__((address_space(3)))

__device__ __forceinline__ bf16_t f2bf(float f) {
    uint32_t u = __float_as_uint(f);
    u += 0x7fffu + ((u >> 16) & 1u);
    return (bf16_t)(u >> 16);
}
__device__ __forceinline__ float bf2f(bf16_t h) { return __uint_as_float(((uint32_t)h) << 16); }
__device__ __forceinline__ uint32_t pack2(float a, float b) { return (uint32_t)f2bf(a) | ((uint32_t)f2bf(b) << 16); }
__device__ __forceinline__ uint32_t pk4_fp8(float a, float b, float c, float d) {
    a = fminf(fmaxf(a, -448.f), 448.f); b = fminf(fmaxf(b, -448.f), 448.f); c = fminf(fmaxf(c, -448.f), 448.f); d = fminf(fmaxf(d, -448.f), 448.f);
    int w = __builtin_amdgcn_cvt_pk_fp8_f32(a, b, 0, false); w = __builtin_amdgcn_cvt_pk_fp8_f32(c, d, w, true); return (uint32_t)w;
}
__device__ __forceinline__ float sigmoidf_(float x) { return __builtin_amdgcn_rcpf(1.0f + __builtin_amdgcn_exp2f(-1.4426950408889634f * x)); }
__device__ __forceinline__ float wave_sum(float v) {
#pragma unroll
    for (int o = 32; o >= 1; o >>= 1) v += __shfl_xor(v, o);
    return v;
}
__device__ __forceinline__ float wave_max(float v) {
#pragma unroll
    for (int o = 32; o >= 1; o >>= 1) v = fmaxf(v, __shfl_xor(v, o));
    return v;
}

constexpr size_t al256(size_t x) { return (x + 255) & ~(size_t)255; }
constexpr size_t TT = (size_t)T;
constexpr size_t MB1 = 1024 * 1024;
constexpr size_t WE8_B = (size_t)NE * 1024 * 1024;
constexpr size_t OFF_WGT = 0, OFF_WUT = WE8_B, OFF_WDT = 2 * WE8_B, OFF_XN2 = 3 * WE8_B, OFF_ACT = OFF_XN2 + (size_t)NTOK * D,
                 OFF_Y1 = OFF_ACT + (size_t)CAP * DFF, OFF_Y2 = OFF_Y1 + (size_t)NTOK * D * 2, OFF_Y3 = OFF_Y2 + (size_t)NTOK * D * 2,
                 OFF_S2_END = OFF_Y3 + (size_t)NTOK * D * 2;
constexpr size_t OFF_WIN = 0, OFF_WUA = OFF_WIN + (size_t)NVC * 1024 * 2, OFF_WUH = OFF_WUA + MB1, OFF_WO = OFF_WUH + MB1, OFF_XN = OFF_WO + 2 * MB1,
                 OFF_Q = OFF_XN + TT * 2048, OFF_K = OFF_Q + TT * 1024, OFF_V = OFF_K + TT * 256, OFF_IQ = OFF_V + TT * 256, OFF_IK = OFF_IQ + TT * 512,
                 OFF_IW = OFF_IK + TT * 64, OFF_HQ = OFF_IW + TT * 32, OFF_HF = OFF_HQ + TT * 1024, OFF_HI = OFF_HF + TT * 1024, OFF_HG = OFF_HI + TT * 1024,
                 OFF_GA = OFF_HG + TT * 1024, OFF_GH = OFF_GA + TT * 2048, OFF_ATT = OFF_GH + TT * 2048, OFF_HGR = OFF_ATT + TT * 1024,
                 OFF_S1_END = OFF_HGR + TT * 1024;
constexpr size_t OFF_MIX = OFF_XN;
constexpr size_t OFF_TAB = OFF_S1_END > OFF_S2_END ? OFF_S1_END : OFF_S2_END;
constexpr size_t OFF_ROPE = OFF_TAB, OFF_LB = OFF_ROPE + al256((size_t)LP * 24 * 4), OFF_CTR = OFF_LB + al256(512 * 4),
                 OFF_BEXP = OFF_CTR + al256(128 * 4), OFF_SLOT = OFF_BEXP + al256((size_t)CAP_BLOCKS * 4), OFF_SRANK = OFF_SLOT + al256((size_t)CAP * 4),
                 OFF_SGATE = OFF_SRANK + al256((size_t)CAP * 4), OFF_TEXP = OFF_SGATE + al256((size_t)CAP * 4), OFF_TGATE = OFF_TEXP + al256((size_t)NTOK * 16),
                 OFF_BAR = OFF_TGATE + al256((size_t)NTOK * 16), OFF_WGC = OFF_BAR + al256(3456 * 4), OFF_SINFO = OFF_WGC + al256(256 * 32 * 4), WS_NEED = OFF_SINFO + al256((size_t)CAP * 8);


__device__ __forceinline__ int tid_() { int t = threadIdx.x; asm volatile("" : "+v"(t)); return t; }

struct P {
    const float *x, *meta, *attn_g, *w_in, *hgrn_g, *w_ua, *w_uh, *w_out, *lb_logits, *ffn_g, *router_w, *router_b,
        *w_gate, *b_gate, *w_up, *b_up, *w_down, *b_down, *final_g;
    float* out;
    unsigned char* ws;
#define WSF(type, name, off) __device__ __forceinline__ type* name() const { return (type*)(ws + (off)); }
    WSF(bf16_t, xn, OFF_XN) WSF(unsigned char, xn8, OFF_ATT) WSF(unsigned char, winT8, OFF_WIN) WSF(bf16_t, winTb, OFF_WIN + 6 * MB1) WSF(bf16_t, q, OFF_Q) WSF(bf16_t, k, OFF_K) WSF(bf16_t, v, OFF_V) WSF(bf16_t, iq, OFF_IQ) WSF(bf16_t, ik, OFF_IK)
    WSF(bf16_t, hq, OFF_HQ) WSF(bf16_t, hf, OFF_HF) WSF(bf16_t, hi, OFF_HI) WSF(bf16_t, hg, OFF_HG) WSF(bf16_t, ga, OFF_GA) WSF(bf16_t, gh, OFF_GH)
    WSF(bf16_t, att, OFF_ATT) WSF(bf16_t, hgr, OFF_HGR) WSF(bf16_t, mix, OFF_MIX) WSF(unsigned char, xn2, OFF_XN2) WSF(unsigned char, act, OFF_ACT)
    WSF(bf16_t, y1, OFF_Y1) WSF(bf16_t, y2, OFF_Y2) WSF(bf16_t, y3, OFF_Y3)
    WSF(bf16_t, winT, OFF_WIN) WSF(bf16_t, wuaT, OFF_WUA) WSF(bf16_t, wuhT, OFF_WUH) WSF(bf16_t, woT, OFF_WO)
    WSF(unsigned char, wgT, OFF_WGT) WSF(unsigned char, wuT, OFF_WUT) WSF(unsigned char, wdT, OFF_WDT)
    WSF(float, iw, OFF_IW) WSF(float, rope, OFF_ROPE) WSF(float, lb, OFF_LB) WSF(float, tok_gate, OFF_TGATE) WSF(float, slot_gate, OFF_SGATE)
    WSF(int, ctr, OFF_CTR)
    WSF(int, wg_cnt, OFF_WGC) WSF(int2, slot_info, OFF_SINFO) WSF(int, block_expert, OFF_BEXP) WSF(int, slot_token, OFF_SLOT) WSF(int, slot_rank, OFF_SRANK) WSF(int, tok_exp, OFF_TEXP)
};

template <class ColMap>
__device__ __forceinline__ void convert_T8(const float* W, int ldw, unsigned char* out, int K, int N, const ColMap& cmap, float scale, int gt, int ntot) {
    const int kb = K / 64; const long ntask = (long)N * kb;
    for (long task = gt; task < ntask; task += ntot) {
        const int kq = (int)(task / N), n = (int)(task % N);
        const int c = cmap(n);
        uint32_t w[16];
        if (c >= 0) {
            const float* src = W + (size_t)(kq * 64) * ldw + c;
            float v[64];
#pragma unroll
            for (int i = 0; i < 64; ++i) v[i] = src[(size_t)i * ldw] * scale;
#pragma unroll
            for (int i = 0; i < 16; ++i) w[i] = pk4_fp8(v[4 * i], v[4 * i + 1], v[4 * i + 2], v[4 * i + 3]);
        } else {
#pragma unroll
            for (int i = 0; i < 16; ++i) w[i] = 0u;
        }
        uint4* dst = (uint4*)(out + (size_t)n * K + kq * 64);
#pragma unroll
        for (int i = 0; i < 4; ++i) dst[i] = make_uint4(w[4 * i], w[4 * i + 1], w[4 * i + 2], w[4 * i + 3]);
    }
}
template <class ColMap>
__device__ __forceinline__ void convert_T(const float* W, int ldw, bf16_t* out, int K, int N, const ColMap& cmap, int gt, int ntot) {
    const int kb = K / 64; const long ntask = (long)N * kb;
    for (long task = gt; task < ntask; task += ntot) {
        const int kq = (int)(task / N), n = (int)(task % N);
        const int c = cmap(n);
        uint32_t w[32];
        if (c >= 0) {
            const float* src = W + (size_t)(kq * 64) * ldw + c;
            float v[64];
#pragma unroll
            for (int i = 0; i < 64; ++i) v[i] = src[(size_t)i * ldw];
#pragma unroll
            for (int i = 0; i < 32; ++i) w[i] = pack2(v[2 * i], v[2 * i + 1]);
        } else {
#pragma unroll
            for (int i = 0; i < 32; ++i) w[i] = 0u;
        }
        uint4* dst = (uint4*)(out + (size_t)n * K + kq * 64);
#pragma unroll
        for (int i = 0; i < 8; ++i) dst[i] = make_uint4(w[4 * i], w[4 * i + 1], w[4 * i + 2], w[4 * i + 3]);
    }
}
struct IdMap { __device__ __forceinline__ int operator()(int n) const { return n; } };
struct WinMap { __device__ __forceinline__ int operator()(int n) const { return n < 1064 ? n : (n < 1280 ? -1 : n - 216); } };
struct WinMapIdx { __device__ __forceinline__ int operator()(int n) const { return WinMap{}(768 + n); } };

#define XB_TMO      128
#define XB_XCNT(j)  (256  + 64 * (j))
#define XB_XSUB(j)  (1280 + 64 * (j))
#define XB_XGEN(j)  (2304 + 64 * (j))
#define XB_TOP      3328
#define XB_TOPGEN   3392
#define XCD_BAR_WORDS 3456
#define XB_SPIN_CAP (1u << 22)
__device__ __forceinline__ unsigned xb_ld(unsigned* p)              { return __hip_atomic_load(p, __ATOMIC_RELAXED, __HIP_MEMORY_SCOPE_AGENT); }
__device__ __forceinline__ unsigned xb_add(unsigned* p, unsigned v) { return __hip_atomic_fetch_add(p, v, __ATOMIC_RELAXED, __HIP_MEMORY_SCOPE_AGENT); }
__device__ __forceinline__ unsigned xb_xcc_id() { return (unsigned)__builtin_amdgcn_s_getreg((3 << 11) | 20) & 0xFu; }
#define XB_SPIN(cond, bar) do { unsigned _sp = 0; while (cond) { __builtin_amdgcn_s_sleep(1); \
    if ((++_sp & 255u) == 0u) { if (xb_ld(&(bar)[XB_TMO])) break; if (_sp > XB_SPIN_CAP) { atomicAdd(&(bar)[XB_TMO], 1u); break; } } } } while (0)
struct XcdBarrier { unsigned* bar; unsigned x; volatile LAS unsigned* st; };
__device__ __forceinline__ XcdBarrier xcd_barrier_post(unsigned* bar, volatile LAS unsigned* st) {
    XcdBarrier b; b.bar = bar; b.x = xb_xcc_id(); b.st = st;
    if (threadIdx.x == 0) (void)xb_add(&bar[XB_XCNT(b.x)], 1u);
    return b;
}
__device__ __forceinline__ void xcd_barrier_complete(unsigned* bar, unsigned x, unsigned& nloc, unsigned& nx) {
    const unsigned G = gridDim.x * gridDim.y * gridDim.z;
    unsigned sum, cnt, mine, sp = 0u;
    for (;;) {
        sum = 0u; cnt = 0u; mine = 0u;
#pragma unroll
        for (unsigned j = 0; j < 16; ++j) { const unsigned c = xb_ld(&bar[XB_XCNT(j)]); sum += c; cnt += (c > 0u) ? 1u : 0u; mine = (j == x) ? c : mine; }
        if (sum == G) break;
        __builtin_amdgcn_s_sleep(1);
        if ((++sp & 255u) == 0u) { if (xb_ld(&bar[XB_TMO])) break; if (sp > XB_SPIN_CAP) { atomicAdd(&bar[XB_TMO], 1u); break; } }
    }
    nloc = mine > 0u ? mine : 1u; nx = cnt > 0u ? cnt : 1u;
}
__device__ __forceinline__ void xcd_barrier(const XcdBarrier& b) {
    asm volatile("s_waitcnt vmcnt(0)" ::: "memory");
    __syncthreads();
    if (threadIdx.x == 0) {
        unsigned* bar = b.bar;
        __builtin_amdgcn_s_waitcnt(0);
        unsigned nloc = b.st[0], nx = b.st[1];
        if (nloc == 0u) { xcd_barrier_complete(bar, b.x, nloc, nx); b.st[0] = nloc; b.st[1] = nx; }
        const unsigned old = xb_add(&bar[XB_XSUB(b.x)], 1u);
        const unsigned gen = old / nloc;
        if (old + 1u == (gen + 1u) * nloc) {
            __builtin_amdgcn_fence(__ATOMIC_RELEASE, "agent");
            asm volatile("s_waitcnt vmcnt(0)" ::: "memory");
            const unsigned og = xb_add(&bar[XB_TOP], 1u);
            const unsigned tg = og / nx;
            if (og + 1u == (tg + 1u) * nx) xb_add(&bar[XB_TOPGEN], 1u);
            else XB_SPIN(xb_ld(&bar[XB_TOPGEN]) == tg, bar);
            __builtin_amdgcn_fence(__ATOMIC_ACQUIRE, "agent");
            xb_add(&bar[XB_XGEN(b.x)], 1u);
            asm volatile("s_waitcnt vmcnt(0)" ::: "memory");
        } else {
            XB_SPIN(xb_ld(&bar[XB_XGEN(b.x)]) == gen, bar);
            __builtin_amdgcn_fence(__ATOMIC_ACQUIRE, "agent");
            asm volatile("s_waitcnt vmcnt(0)" ::: "memory");
        }
    }
    __syncthreads();
}

__device__ __forceinline__ void ph_prep(const P& p, unsigned char* lds) {
    const int tid = tid_(), lane = tid & 63, wid = tid >> 6;
    const int gw = blockIdx.x * 8 + wid, nw = gridDim.x * 8;
    for (int r = gw; r < T; r += nw) {
        const int b = r / LP, pos = r % LP;
        unsigned char* dst = p.xn8() + (size_t)r * D; bf16_t* dstb = p.xn() + (size_t)r * D;
        if (pos >= L) {
#pragma unroll
            for (int i = 0; i < 4; ++i) { *(uint32_t*)(dst + lane * 4 + 256 * i) = 0u; *(uint2*)(dstb + lane * 4 + 256 * i) = make_uint2(0u, 0u); }
            continue;
        }
        const float* src = pos < NMETA ? p.meta + (size_t)pos * D : p.x + ((size_t)b * SEQ + (pos - NMETA)) * D;
        f32x4 v[4]; float ss = 0.f;
#pragma unroll
        for (int i = 0; i < 4; ++i) { v[i] = *(const f32x4*)(src + lane * 4 + 256 * i); ss += v[i][0] * v[i][0] + v[i][1] * v[i][1] + v[i][2] * v[i][2] + v[i][3] * v[i][3]; }
        ss = wave_sum(ss);
        const float rs = rsqrtf(ss * (1.0f / D) + EPS);
#pragma unroll
        for (int i = 0; i < 4; ++i) {
            const f32x4 g = *(const f32x4*)(p.attn_g + lane * 4 + 256 * i);
            const float y0 = v[i][0] * rs * g[0], y1 = v[i][1] * rs * g[1], y2 = v[i][2] * rs * g[2], y3 = v[i][3] * rs * g[3];
            *(uint32_t*)(dst + lane * 4 + 256 * i) = pk4_fp8(y0, y1, y2, y3);
            uint2 o; o.x = pack2(y0, y1); o.y = pack2(y2, y3);
            *(uint2*)(dstb + lane * 4 + 256 * i) = o;
        }
    }
    const int gt = blockIdx.x * NTHREADS + tid, nt = gridDim.x * NTHREADS;
    for (int i = gt; i < LP * 12; i += nt) {
        const int pos = i / 12, f = i % 12;
        const double ex = f < 8 ? -(double)f / 8.0 : -(double)(f - 8) / 4.0;
        const double inv = exp(ex * log(500000.0));
        const double ang = (double)pos * inv;
        const double twopi = 6.283185307179586476925286766559;
        const double r = ang - twopi * rint(ang / twopi);
        const float rf = (float)r;
        const float c = cosf(rf), s = sinf(rf);
        float* row = p.rope() + (size_t)pos * 24;
        if (f < 8) { row[f] = c; row[8 + f] = s; } else { row[16 + f - 8] = c; row[20 + f - 8] = s; }
    }
    for (int i = gt; i < 512; i += nt) {
        const float a = p.lb_logits[i], b2 = p.lb_logits[512 + i];
        p.lb()[i] = 1.0f / (1.0f + expf(b2 - a));
    }
    for (int i = gt; i < 128; i += nt) p.ctr()[i] = 0;
    convert_T8(p.w_in, IN_COLS, p.winT8(), 1024, NVC, WinMap{}, 32.0f, gt, nt);
    convert_T(p.w_in, IN_COLS, p.winTb(), 1024, 512, WinMapIdx{}, gt, nt);
    convert_T(p.w_ua, 1024, p.wuaT(), 512, 1024, IdMap{}, gt, nt);
    convert_T(p.w_uh, 1024, p.wuhT(), 512, 1024, IdMap{}, gt, nt);
    convert_T(p.w_out, 1024, p.woT(), 1024, 1024, IdMap{}, gt, nt);
}
constexpr int G_TILE_B = 256 * 64 * 2, G_STAGE_B = 2 * G_TILE_B;
__device__ __forceinline__ int g_lds_byte(int r, int c) { const int st = (r >> 4) * 2 + (c >> 5), ob = (r & 15) * 64 + (c & 31) * 2; return st * 1024 + (ob ^ (((ob >> 9) & 1) << 5)); }
__device__ __forceinline__ void g_stage_rc(int b, int& R, int& C) { const int st = b >> 10, sb = b & 1023, swz = sb ^ (((sb >> 9) & 1) << 5); R = (st >> 1) * 16 + swz / 64; C = (st & 1) * 32 + (swz % 64) / 2; }

constexpr int HTB = 128 * 64 * 2;
struct GJob { const char* A; const char* B; unsigned va00, va01, va10, va11; };
__device__ __forceinline__ void gj_lin(unsigned (&v)[2][2], int ld) {
#pragma unroll
    for (int h = 0; h < 2; ++h)
#pragma unroll
        for (int i = 0; i < 2; ++i) { int R, C; g_stage_rc(tid_() * 16 + i * 8192, R, C); v[h][i] = (unsigned)(((h * 128 + R) * ld + C) * 2); }
}
template <class AOff>
__device__ __forceinline__ void gj_gather(unsigned (&v)[2][2], const AOff& aoff) {
#pragma unroll
    for (int h = 0; h < 2; ++h)
#pragma unroll
        for (int i = 0; i < 2; ++i) { int R, C; g_stage_rc(tid_() * 16 + i * 8192, R, C); v[h][i] = (unsigned)((aoff(h * 128 + R) + C) * 2); }
}
template <class AOff>
__device__ __forceinline__ void gj_gather_job(GJob& j, const AOff& aoff) {
    unsigned v[2][2]; gj_gather(v, aoff); j.va00 = v[0][0]; j.va01 = v[0][1]; j.va10 = v[1][0]; j.va11 = v[1][1];
}
template <bool GATHER, class JobFn, class Epi>
__device__ __forceinline__ void gemm_stream(unsigned char* lds_, int K, int lda, size_t hstepB, const unsigned (&vbU)[2], const JobFn& jobfn, const Epi& epi) {
    LAS unsigned char* lds = (LAS unsigned char*)lds_;
    const int tid = tid_(), wid = __builtin_amdgcn_readfirstlane(tid >> 6), lane = tid & 63, wr = wid >> 2, wc = wid & 3, fr = lane & 15, fq = lane >> 4;
    const int nt = K / 64;
    const size_t kstep = 128;
    const size_t hstepA = GATHER ? 0 : (size_t)128 * lda * 2;
    const unsigned ldsw = (unsigned)wid * 1024u;
    const int aoff = g_lds_byte(wr * 64 + fr, fq * 8), boff = g_lds_byte(wc * 32 + fr, fq * 8);
    unsigned vaU[2];
#pragma unroll
    for (int i = 0; i < 2; ++i) { int R, C; g_stage_rc(tid * 16 + i * 8192, R, C); vaU[i] = (unsigned)((R * lda + C) * 2); }
#define PG8_SA(b, h) (((b) * 2 + (h)) * HTB)
#define PG8_SB(b, h) ((4 + (b) * 2 + (h)) * HTB)
#define PG8_STAGE2(bufoff, gbase, v0, v1) do { \
        __builtin_amdgcn_global_load_lds((const unsigned*)((const char*)(gbase) + (v0)), (LAS unsigned*)(lds + (bufoff) + ldsw), 16, 0, 0); \
        __builtin_amdgcn_global_load_lds((const unsigned*)((const char*)(gbase) + (v1)), (LAS unsigned*)(lds + (bufoff) + ldsw + 8192), 16, 0, 0); } while (0)
#define STB(bufoff, gbase, h) PG8_STAGE2(bufoff, (gbase) + ((h) ? hstepB : 0), vbU[0], vbU[1])
#define STA_CUR(bufoff, gbase, h) do { if (GATHER) PG8_STAGE2(bufoff, gbase, (h) ? cur.va10 : cur.va00, (h) ? cur.va11 : cur.va01); else PG8_STAGE2(bufoff, (gbase) + ((h) ? hstepA : 0), vaU[0], vaU[1]); } while (0)
#define STA_SEL(bufoff, gbase, h) do { if (GATHER) PG8_STAGE2(bufoff, gbase, last ? ((h) ? nxt.va10 : nxt.va00) : ((h) ? cur.va10 : cur.va00), last ? ((h) ? nxt.va11 : nxt.va01) : ((h) ? cur.va11 : cur.va01)); \
        else PG8_STAGE2(bufoff, (gbase) + ((h) ? hstepA : 0), vaU[0], vaU[1]); } while (0)
#define PG8_LDA(dst, b, h) do { _Pragma("unroll") for (int m = 0; m < 4; ++m) _Pragma("unroll") for (int k = 0; k < 2; ++k) dst[m][k] = *(const LAS bf16x8*)(lds + PG8_SA(b, h) + aoff + m * 2048 + k * 1024); } while (0)
#define PG8_LDB(dst, b, h) do { _Pragma("unroll") for (int n = 0; n < 2; ++n) _Pragma("unroll") for (int k = 0; k < 2; ++k) dst[n][k] = *(const LAS bf16x8*)(lds + PG8_SB(b, h) + boff + n * 2048 + k * 1024); } while (0)
#define PG8_MMA(ai, bj, At, Bt) do { __builtin_amdgcn_s_setprio(1); _Pragma("unroll") for (int m = 0; m < 4; ++m) _Pragma("unroll") for (int n = 0; n < 2; ++n) _Pragma("unroll") for (int k = 0; k < 2; ++k) \
        acc[ai][bj][m][n] = __builtin_amdgcn_mfma_f32_16x16x32_bf16(Bt[n][k], At[m][k], acc[ai][bj][m][n], 0, 0, 0); __builtin_amdgcn_s_setprio(0); } while (0)
#define PG8_WAIT_V(n) asm volatile("s_waitcnt vmcnt(" #n ")" ::: "memory")
#define PG8_WAIT_L(n) asm volatile("s_waitcnt lgkmcnt(" #n ")" ::: "memory")
#define PG8_BAR __builtin_amdgcn_s_barrier()
#define PG8_SCHED __builtin_amdgcn_sched_barrier(0)
    GJob cur, nxt; int ui = 0;
    cur.A = nullptr; cur.B = nullptr; cur.va00 = cur.va01 = cur.va10 = cur.va11 = 0u; nxt = cur;
    if (!jobfn(0, cur)) return;
    f32x4 acc[2][2][4][2];
#pragma unroll
    for (int a = 0; a < 2; ++a)
#pragma unroll
        for (int b = 0; b < 2; ++b)
#pragma unroll
            for (int m = 0; m < 4; ++m)
#pragma unroll
                for (int n = 0; n < 2; ++n) acc[a][b][m][n] = (f32x4){0.f, 0.f, 0.f, 0.f};
    bf16x8 At[4][2], B0[2][2], B1[2][2];
    STB(PG8_SB(0, 0), cur.B, 0); STB(PG8_SB(0, 1), cur.B, 1); STA_CUR(PG8_SA(0, 0), cur.A, 0); STA_CUR(PG8_SA(0, 1), cur.A, 1);
    if (wr == 1) PG8_BAR;
    PG8_WAIT_V(2); PG8_BAR;
    STB(PG8_SB(1, 0), cur.B + kstep, 0); STA_CUR(PG8_SA(1, 0), cur.A + kstep, 0); STB(PG8_SB(1, 1), cur.B + kstep, 1);
    PG8_WAIT_V(6); PG8_BAR;
    for (;;) {
        bool has_next = false;
        for (int t = 0; t < nt; t += 2) {
            const bool last = (t == nt - 2);
            if (last) { has_next = jobfn(ui + 1, nxt); if (!has_next) nxt = cur; }
            const char* a1 = cur.A + (size_t)(t + 1) * kstep;
            const char* a2 = last ? nxt.A : cur.A + (size_t)(t + 2) * kstep; const char* b2 = last ? nxt.B : cur.B + (size_t)(t + 2) * kstep;
            const char* a3 = a2 + kstep; const char* b3 = b2 + kstep;
            PG8_LDB(B0, 0, 0); PG8_LDB(B1, 0, 1); PG8_SCHED; PG8_LDA(At, 0, 0); STA_CUR(PG8_SA(1, 1), a1, 1);
            PG8_WAIT_V(8); PG8_WAIT_L(0); PG8_BAR; PG8_MMA(0, 0, At, B0); PG8_MMA(0, 1, At, B1); PG8_BAR; PG8_SCHED;
            PG8_LDA(At, 0, 1); STB(PG8_SB(0, 0), b2, 0); STB(PG8_SB(0, 1), b2, 1); STA_SEL(PG8_SA(0, 0), a2, 0);
            PG8_WAIT_V(8); PG8_WAIT_L(0); PG8_BAR; PG8_MMA(1, 0, At, B0); PG8_MMA(1, 1, At, B1); PG8_BAR; PG8_SCHED;
            PG8_LDB(B0, 1, 0); PG8_LDB(B1, 1, 1); PG8_SCHED; PG8_LDA(At, 1, 0); STA_SEL(PG8_SA(0, 1), a2, 1);
            PG8_WAIT_V(8); PG8_WAIT_L(0); PG8_BAR; PG8_MMA(0, 0, At, B0); PG8_MMA(0, 1, At, B1); PG8_BAR; PG8_SCHED;
            PG8_LDA(At, 1, 1); STB(PG8_SB(1, 0), b3, 0); STB(PG8_SB(1, 1), b3, 1); STA_SEL(PG8_SA(1, 0), a3, 0);
            PG8_WAIT_V(8); PG8_WAIT_L(0); PG8_BAR; PG8_MMA(1, 0, At, B0); PG8_MMA(1, 1, At, B1); PG8_BAR; PG8_SCHED;
        }
        if (wr == 0) PG8_BAR;
        epi(acc, ui);
        if (!has_next) break;
#pragma unroll
        for (int a = 0; a < 2; ++a)
#pragma unroll
            for (int b = 0; b < 2; ++b)
#pragma unroll
                for (int m = 0; m < 4; ++m)
#pragma unroll
                    for (int n = 0; n < 2; ++n) acc[a][b][m][n] = (f32x4){0.f, 0.f, 0.f, 0.f};
        cur = nxt; ++ui;
        if (wr == 1) PG8_BAR;
    }
    PG8_WAIT_V(0);
    PG8_BAR;
#undef PG8_SA
#undef PG8_SB
#undef PG8_STAGE2
#undef STB
#undef STA_CUR
#undef STA_SEL
#undef PG8_LDA
#undef PG8_LDB
#undef PG8_MMA
#undef PG8_WAIT_V
#undef PG8_WAIT_L
#undef PG8_BAR
#undef PG8_SCHED
}
__device__ __forceinline__ void gj_lin2(unsigned (&v)[2], int ld) {
#pragma unroll
    for (int i = 0; i < 2; ++i) { int R, C; g_stage_rc(tid_() * 16 + i * 8192, R, C); v[i] = (unsigned)((R * ld + C) * 2); }
}
typedef int i32x8 __attribute__((ext_vector_type(8)));
typedef unsigned u32x4 __attribute__((ext_vector_type(4)));
struct G8Job { const char* A; const char* B; unsigned va0, va1, va2, va3; };
__device__ __forceinline__ void g8_rc(int i, int& R, int& Cb) { int C; g_stage_rc(tid_() * 16 + i * 8192, R, C); Cb = C * 2; }
__device__ __forceinline__ const char* uni_ptr8(const char* p) {
    const unsigned long long v = (unsigned long long)p;
    const unsigned lo = __builtin_amdgcn_readfirstlane((unsigned)v), hi = __builtin_amdgcn_readfirstlane((unsigned)(v >> 32));
    return (const char*)(((unsigned long long)hi << 32) | lo);
}
template <bool GATHER, class JobFn, class Epi>
__device__ __forceinline__ void gemm8_stream(unsigned char* lds_, const unsigned (&vbU)[4], const JobFn& jobfn, const Epi& epi) {
    LAS unsigned char* lds = (LAS unsigned char*)lds_;
    const int tid = tid_(), wid = __builtin_amdgcn_readfirstlane(tid >> 6), lane = tid & 63, wr = wid >> 2, wc = wid & 3, fr = lane & 15, fq = lane >> 4;
    LAS unsigned char* a0p = lds + g_lds_byte(wr * 64 + fr, fq * 8); LAS unsigned char* a1p = a0p + 65536;
    LAS unsigned char* b0p = lds + 32768 + g_lds_byte(wc * 32 + fr, fq * 8); LAS unsigned char* b1p = b0p + 65536;
    const unsigned ldsw_u = __builtin_amdgcn_readfirstlane((unsigned)(size_t)(lds + wid * 1024));
#define G8_GLDS(base, voff, ldsaddr) asm volatile("s_mov_b32 m0, %2\n\ts_nop 0\n\tglobal_load_lds_dwordx4 %0, %1" :: "v"(voff), "s"(base), "s"(ldsaddr) : "memory", "m0")
#define G8_DMA(JA, JB, v0, v1, v2, v3, buf, kt) do { \
        const char* pa_ = uni_ptr8(JA) + (kt) * 128; const char* pb_ = uni_ptr8(JB) + (kt) * 128; const unsigned d_ = ldsw_u + (buf) * 65536; \
        G8_GLDS(pa_, (GATHER ? v0 : vb0), d_); \
        G8_GLDS(pa_, (GATHER ? v1 : vb1), d_ + 8192); \
        G8_GLDS(pa_, (GATHER ? v2 : vb2), d_ + 16384); \
        G8_GLDS(pa_, (GATHER ? v3 : vb3), d_ + 24576); \
        G8_GLDS(pb_, vb0, d_ + 32768); \
        G8_GLDS(pb_, vb1, d_ + 32768 + 8192); \
        G8_GLDS(pb_, vb2, d_ + 32768 + 16384); \
        G8_GLDS(pb_, vb3, d_ + 32768 + 24576); } while (0)
#define G8_LD(dst, ptr) do { const u32x4 x0_ = *(const LAS u32x4*)(ptr), x1_ = *(const LAS u32x4*)((ptr) + 1024); \
        dst = (i32x8){(int)x0_.x, (int)x0_.y, (int)x0_.z, (int)x0_.w, (int)x1_.x, (int)x1_.y, (int)x1_.z, (int)x1_.w}; } while (0)
#define G8_LDA(dst, ap, ai, m0, m1) do { _Pragma("unroll") for (int m = m0; m < m1; ++m) G8_LD(dst[m], (ap) + (ai) * 16384 + m * 2048); } while (0)
#define G8_LDB(dst, bp, bj) do { _Pragma("unroll") for (int n = 0; n < 2; ++n) G8_LD(dst[n], (bp) + (bj) * 16384 + n * 2048); } while (0)
#define G8_MMA(ai, bj, At, Bt) do { __builtin_amdgcn_sched_barrier(0); __builtin_amdgcn_s_setprio(1); _Pragma("unroll") for (int m = 0; m < 4; ++m) _Pragma("unroll") for (int n = 0; n < 2; ++n) \
        asm("v_mfma_scale_f32_16x16x128_f8f6f4 %0, %1, %2, %0, %3, %3 op_sel_hi:[0,0,0]" : "+v"(acc[ai][bj][m][n]) : "v"(Bt[n]), "v"(At[m]), "v"(unit_scale)); \
        __builtin_amdgcn_s_setprio(0); __builtin_amdgcn_sched_barrier(0); } while (0)
#define G8_PF 2
#define G8_TILE(buf, ap, bp, apn, bpn, X, Y, kt) do { \
        G8_LDA(P, ap, 0, G8_PF, 4); G8_LDB(Y, bp, 1); G8_MMA(0, 0, P, X); \
        G8_LDA(Q, ap, 1, 0, 2);                       G8_MMA(0, 1, P, Y); \
        G8_LDA(Q, ap, 1, 2, 4); G8_LDB(X, bp, 0);     G8_MMA(1, 1, Q, Y); \
        asm volatile("" ::: "memory"); __builtin_amdgcn_s_waitcnt(0x0070); __builtin_amdgcn_s_barrier(); asm volatile("" ::: "memory"); \
        asm volatile("" : "+v"(vb0), "+v"(vb1), "+v"(vb2), "+v"(vb3), "+v"(cur.va0), "+v"(cur.va1), "+v"(cur.va2), "+v"(cur.va3)); \
        G8_DMA(selA, selB, cur.va0, cur.va1, cur.va2, cur.va3, buf, kt); \
        G8_LDA(P, apn, 0, 0, G8_PF); G8_LDB(Y, bpn, 0); \
        G8_MMA(1, 0, Q, X); } while (0)
    G8Job cur, nxt;
    cur.A = nullptr; cur.B = nullptr; cur.va0 = cur.va1 = cur.va2 = cur.va3 = 0u; nxt = cur;
    if (!jobfn(0, cur)) return;
    cur.A = uni_ptr8(cur.A); cur.B = uni_ptr8(cur.B);
    unsigned vb0 = vbU[0], vb1 = vbU[1], vb2 = vbU[2], vb3 = vbU[3];
    G8_DMA(cur.A, cur.B, cur.va0, cur.va1, cur.va2, cur.va3, 0, 0); G8_DMA(cur.A, cur.B, cur.va0, cur.va1, cur.va2, cur.va3, 1, 1);
    asm volatile("s_waitcnt vmcnt(0)" ::: "memory");
    __syncthreads();
    int ui = 0;
    for (;;) {
        f32x4 acc[2][2][4][2];
#pragma unroll
        for (int a = 0; a < 2; ++a)
#pragma unroll
            for (int b = 0; b < 2; ++b)
#pragma unroll
                for (int m = 0; m < 4; ++m)
#pragma unroll
                    for (int n = 0; n < 2; ++n) acc[a][b][m][n] = (f32x4){0.f, 0.f, 0.f, 0.f};
        const bool has_next = jobfn(ui + 1, nxt);
        nxt.A = uni_ptr8(nxt.A); nxt.B = uni_ptr8(nxt.B);
        if (!has_next) nxt = cur;
        i32x8 P[4], Q[4], X[2], Y[2];
        const int unit_scale = 0x7f7f7f7f;
        G8_LDA(P, a0p, 0, 0, G8_PF); G8_LDB(X, b0p, 0);
#pragma unroll 1
        for (int t2 = 0; t2 < 4; ++t2) {
            const bool lastp = t2 == 3;
            const char* selA = lastp ? nxt.A : cur.A; const char* selB = lastp ? nxt.B : cur.B;
            if (GATHER) { cur.va0 = lastp ? nxt.va0 : cur.va0; cur.va1 = lastp ? nxt.va1 : cur.va1; cur.va2 = lastp ? nxt.va2 : cur.va2; cur.va3 = lastp ? nxt.va3 : cur.va3; }
            const int kt0 = lastp ? 0 : 2 * t2 + 2;
            asm volatile("" : "+v"(a0p), "+v"(a1p), "+v"(b0p), "+v"(b1p));
            G8_TILE(0, a0p, b0p, a1p, b1p, X, Y, kt0);
            G8_TILE(1, a1p, b1p, a0p, b0p, Y, X, kt0 + 1);
        }
        asm volatile("s_nop 15\n\ts_nop 15" ::: "memory");
        epi(acc, ui);
        if (!has_next) break;
        cur.A = nxt.A; cur.B = nxt.B; ++ui;
    }
#undef G8_TILE
#undef G8_PF
#undef G8_MMA
#undef G8_LDB
#undef G8_LDA
#undef G8_LD
#undef G8_DMA
#undef G8_GLDS
    __syncthreads();
}
struct RowLin { size_t base; int ld; __device__ __forceinline__ size_t operator()(int R) const { return base + (size_t)R * ld; } };

__device__ __forceinline__ void st_bf4(bf16_t* dst, f32x4 v) {
    uint2 o; o.x = pack2(v[0], v[1]); o.y = pack2(v[2], v[3]); *(uint2*)dst = o;
}
#define EPI8(...) do { const int tid_e = tid_(), lane_e = tid_e & 63, wid_e = tid_e >> 6, wr = wid_e >> 2, wc = wid_e & 3, fr = lane_e & 15, fq = lane_e >> 4; \
    _Pragma("unroll") for (int ai = 0; ai < 2; ++ai) _Pragma("unroll") for (int m = 0; m < 4; ++m) _Pragma("unroll") for (int bj = 0; bj < 2; ++bj) _Pragma("unroll") for (int n = 0; n < 2; ++n) { \
        const int row = ai * 128 + wr * 64 + m * 16 + fr, col = bj * 128 + wc * 32 + n * 16 + fq * 4; const f32x4 v = acc[ai][bj][m][n]; __VA_ARGS__ } } while (0)

struct EpiInproj {
    const P* p; int nt;
    __device__ __forceinline__ void operator()(int m, int n, int fq, f32x4 v) const {
        const P& P_ = *p;
        const int pos = m % LP;
        const float* rp = P_.rope() + (size_t)pos * 24;
        if (nt <= 2) {
            const bool isv = (nt == 2) && (n >= 128);
            if (!isv && (n & 48) == 0) {
                f32x4 pr;
#pragma unroll
                for (int j = 0; j < 4; ++j) pr[j] = __shfl_xor(v[j], 32);
                const int i0 = (fq & 1) * 4;
#pragma unroll
                for (int j = 0; j < 4; ++j) {
                    const float c = rp[i0 + j], s = rp[8 + i0 + j];
                    v[j] = fq < 2 ? v[j] * c - pr[j] * s : v[j] * c + pr[j] * s;
                }
            }
            if (nt < 2) { st_bf4(P_.q() + (size_t)m * 512 + nt * 256 + n, v * (0.125f * 1.4426950408889634f)); }
            else if (n < 128) st_bf4(P_.k() + (size_t)m * 128 + n, v);
            else st_bf4(P_.v() + (size_t)m * 128 + (n - 128), v);
        } else if (nt == 3 || nt == 4) {
            const bool ropeable = (nt == 3) ? ((n & 16) == 0) : (n < 16);
            if (ropeable) {
                f32x4 pr;
#pragma unroll
                for (int j = 0; j < 4; ++j) pr[j] = __shfl_xor(v[j], 16);
                if (fq < 2) {
#pragma unroll
                    for (int j = 0; j < 4; ++j) {
                        const float c = rp[16 + j], s = rp[20 + j];
                        v[j] = fq == 0 ? v[j] * c - pr[j] * s : v[j] * c + pr[j] * s;
                    }
                }
            }
            if (nt == 3) st_bf4(P_.iq() + (size_t)m * 256 + n, v);
            else if (n < 32) st_bf4(P_.ik() + (size_t)m * 32 + n, v);
            else if (n < 40) *(f32x4*)(P_.iw() + (size_t)m * 8 + (n - 32)) = v;
        } else if (nt <= 6) { st_bf4(P_.hq() + (size_t)m * 512 + (nt - 5) * 256 + n, v * 0.08838834764831845f); }
        else if (nt <= 8) { st_bf4(P_.hf() + (size_t)m * 512 + (nt - 7) * 256 + n, v); }
        else if (nt <= 10) { st_bf4(P_.hi() + (size_t)m * 512 + (nt - 9) * 256 + n, v); }
        else if (nt <= 12) {
            f32x4 o;
#pragma unroll
            for (int j = 0; j < 4; ++j) o[j] = v[j] * sigmoidf_(v[j]);
            st_bf4(P_.hg() + (size_t)m * 512 + (nt - 11) * 256 + n, o);
        } else {
            f32x4 o;
#pragma unroll
            for (int j = 0; j < 4; ++j) o[j] = sigmoidf_(v[j]);
            if (nt <= 16) st_bf4(P_.ga() + (size_t)m * 1024 + (nt - 13) * 256 + n, o);
            else st_bf4(P_.gh() + (size_t)m * 1024 + (nt - 17) * 256 + n, o);
        }
    }
};

__device__ __forceinline__ void ph_inproj(const P& p, unsigned char* lds) {
    const int G = gridDim.x, b0 = blockIdx.x;
    {
        const int nunits = (T / 256) * 2;
        auto jobfn = [&](int i, GJob& j) __attribute__((always_inline)) -> bool {
            const int u = b0 + i * G; if (u >= nunits) return false;
            const int nt = 3 + (u & 1), mt = u >> 1;
            j.A = (const char*)(p.xn() + (size_t)mt * 256 * D); j.B = (const char*)(p.winTb() + (size_t)(nt - 3) * 256 * D); return true; };
        auto epi = [&](f32x4 (&acc)[2][2][4][2], int i) __attribute__((always_inline)) {
            const int u = b0 + i * G, nt = 3 + (u & 1), mt = u >> 1;
            const EpiInproj e{&p, nt};
            EPI8( e(mt * 256 + row, col, fq, v); );
        };
        unsigned vbU[2]; gj_lin2(vbU, D);
        gemm_stream<false>(lds, D, D, (size_t)128 * D * 2, vbU, jobfn, epi);
    }
    {
        const int nunits = (T / 256) * 19, br = G - 1 - b0;
        auto jobfn = [&](int i, G8Job& j) __attribute__((always_inline)) -> bool {
            const int u = br + i * G; if (u >= nunits) return false;
            const int n19 = u % 19, nt = n19 < 3 ? n19 : n19 + 2, mt = u / 19;
            j.A = (const char*)(p.xn8() + (size_t)mt * 256 * D); j.B = (const char*)(p.winT8() + (size_t)nt * 256 * D); return true; };
        auto epi = [&](f32x4 (&acc)[2][2][4][2], int i) __attribute__((always_inline)) {
            const int u = br + i * G, n19 = u % 19, nt = n19 < 3 ? n19 : n19 + 2, mt = u / 19;
            const EpiInproj e{&p, nt};
            EPI8( e(mt * 256 + row, col, fq, v * 0.03125f); );
        };
        unsigned vbU[4];
#pragma unroll
        for (int q = 0; q < 4; ++q) { int R, Cb; g8_rc(q, R, Cb); vbU[q] = (unsigned)(R * D + Cb); }
        gemm8_stream<false>(lds, vbU, jobfn, epi);
    }
}
constexpr int NCH = 129, NXU = 16 * NCH;
constexpr int X_QT = 0, X_KT = X_QT + 64 * 272, X_KH = X_KT + 64 * 272, X_VT = X_KH + 128 * 144, X_AS = X_VT + 128 * 144, X_SEG = X_AS + 64 * 144;
__device__ __forceinline__ bf16_t* hg_ds(const P& p) { return (bf16_t*)p.out; }
__device__ __forceinline__ float* hg_g(const P& p) { return (float*)((unsigned char*)p.out + (size_t)NXU * 32768); }

__device__ __forceinline__ void hgx_unit(const P& p, unsigned char* lds, int u) {
    const int tid = tid_(), lane = tid & 63, wid = tid >> 6, fr = lane & 15, fq = lane >> 4;
    const int c = u % NCH, bh = u / NCH, b = bh >> 2, h = bh & 3;
    const int d = tid & 127, seg = tid >> 7;
    const size_t rowbase = (size_t)(b * LP + c * 64 + seg * 16) * 512 + h * 128 + d;
    bf16_t* hqp = p.hq() + rowbase; const bf16_t* hfp = p.hf() + rowbase; const bf16_t* hip = p.hi() + rowbase;
    const float lbv = p.lb()[h * 128 + d];
    float bb[16], qv[16], kk[16], vv[16];
    float cs = 0.f;
#pragma unroll
    for (int i = 0; i < 16; ++i) {
        const float f = lbv + (1.0f - lbv) * sigmoidf_(bf2f(hfp[(size_t)i * 512]));
        kk[i] = 1.0f - f; cs += __logf(f); bb[i] = cs;
        qv[i] = bf2f(hqp[(size_t)i * 512]); vv[i] = bf2f(hip[(size_t)i * 512]);
    }
    float* segs = (float*)(lds + X_SEG);
    segs[seg * 128 + d] = cs;
    __syncthreads();
    const float s0 = segs[d], s1 = segs[128 + d], s2 = segs[256 + d], s3 = segs[384 + d];
    const float off = seg == 0 ? 0.f : (seg == 1 ? s0 : (seg == 2 ? s0 + s1 : s0 + s1 + s2));
    const float rref = s0 + s1, blast = (s0 + s1) + (s2 + s3);
    uint32_t khp[8], vtp[8];
#pragma unroll
    for (int i = 0; i < 16; i += 2) {
        float khv[2];
#pragma unroll
        for (int j = 0; j < 2; ++j) {
            const float bt = bb[i + j] + off;
            const float eq = __expf(fminf(bt - rref, 80.f)), ek = __expf(fminf(rref - bt, 80.f));
            const int t = seg * 16 + i + j;
            *(bf16_t*)(lds + X_QT + t * 272 + d * 2) = f2bf(qv[i + j] * eq);
            *(bf16_t*)(lds + X_KT + t * 272 + d * 2) = f2bf(kk[i + j] * ek);
            hqp[(size_t)(i + j) * 512] = f2bf(qv[i + j] * __expf(bt));
            khv[j] = kk[i + j] * __expf(blast - bt);
        }
        khp[i >> 1] = pack2(khv[0], khv[1]); vtp[i >> 1] = pack2(vv[i], vv[i + 1]);
    }
    *(uint4*)(lds + X_KH + d * 144 + seg * 32) = make_uint4(khp[0], khp[1], khp[2], khp[3]);
    *(uint4*)(lds + X_KH + d * 144 + seg * 32 + 16) = make_uint4(khp[4], khp[5], khp[6], khp[7]);
    *(uint4*)(lds + X_VT + d * 144 + seg * 32) = make_uint4(vtp[0], vtp[1], vtp[2], vtp[3]);
    *(uint4*)(lds + X_VT + d * 144 + seg * 32 + 16) = make_uint4(vtp[4], vtp[5], vtp[6], vtp[7]);
    if (seg == 0) hg_g(p)[(size_t)u * 128 + d] = __expf(blast);
    __syncthreads();
    {
        const int tm = wid >> 1, tn0 = (wid & 1) * 2;
        f32x4 a1[2] = {(f32x4){0.f, 0.f, 0.f, 0.f}, (f32x4){0.f, 0.f, 0.f, 0.f}};
#pragma unroll
        for (int ks = 0; ks < 4; ++ks) {
            const bf16x8 aq = *(const bf16x8*)(lds + X_QT + (tm * 16 + fr) * 272 + (ks * 32 + fq * 8) * 2);
#pragma unroll
            for (int j = 0; j < 2; ++j) {
                const bf16x8 bk = *(const bf16x8*)(lds + X_KT + ((tn0 + j) * 16 + fr) * 272 + (ks * 32 + fq * 8) * 2);
                a1[j] = __builtin_amdgcn_mfma_f32_16x16x32_bf16(bk, aq, a1[j], 0, 0, 0);
            }
        }
#pragma unroll
        for (int j = 0; j < 2; ++j) {
            const int t = tm * 16 + fr, sb = (tn0 + j) * 16 + fq * 4;
            f32x4 v = a1[j];
#pragma unroll
            for (int jj = 0; jj < 4; ++jj) v[jj] = (sb + jj <= t) ? v[jj] : 0.f;
            uint2 o; o.x = pack2(v[0], v[1]); o.y = pack2(v[2], v[3]);
            *(uint2*)(lds + X_AS + t * 144 + sb * 2) = o;
        }
    }
    __syncthreads();
    {
        const int tm = wid >> 1, en0 = (wid & 1) * 4;
        f32x4 o2[4];
#pragma unroll
        for (int j = 0; j < 4; ++j) o2[j] = (f32x4){0.f, 0.f, 0.f, 0.f};
#pragma unroll
        for (int ks = 0; ks < 2; ++ks) {
            const bf16x8 aa = *(const bf16x8*)(lds + X_AS + (tm * 16 + fr) * 144 + (ks * 32 + fq * 8) * 2);
#pragma unroll
            for (int j = 0; j < 4; ++j) {
                const bf16x8 bv = *(const bf16x8*)(lds + X_VT + ((en0 + j) * 16 + fr) * 144 + (ks * 32 + fq * 8) * 2);
                o2[j] = __builtin_amdgcn_mfma_f32_16x16x32_bf16(bv, aa, o2[j], 0, 0, 0);
            }
        }
        bf16_t* orow = p.hf() + (size_t)(b * LP + c * 64 + tm * 16 + fr) * 512 + h * 128;
#pragma unroll
        for (int j = 0; j < 4; ++j) st_bf4(orow + (en0 + j) * 16 + fq * 4, o2[j]);
    }
    {
        f32x4 s3[8];
#pragma unroll
        for (int j = 0; j < 8; ++j) s3[j] = (f32x4){0.f, 0.f, 0.f, 0.f};
#pragma unroll
        for (int ks = 0; ks < 2; ++ks) {
            const bf16x8 ak = *(const bf16x8*)(lds + X_KH + (wid * 16 + fr) * 144 + (ks * 32 + fq * 8) * 2);
#pragma unroll
            for (int j = 0; j < 8; ++j) {
                const bf16x8 bv = *(const bf16x8*)(lds + X_VT + (j * 16 + fr) * 144 + (ks * 32 + fq * 8) * 2);
                s3[j] = __builtin_amdgcn_mfma_f32_16x16x32_bf16(ak, bv, s3[j], 0, 0, 0);
            }
        }
        bf16_t* dsb = hg_ds(p) + (size_t)u * 16384;
#pragma unroll
        for (int j = 0; j < 8; ++j) st_bf4(dsb + (size_t)(j * 16 + fr) * 128 + wid * 16 + fq * 4, s3[j]);
    }
    __syncthreads();
}

__device__ __forceinline__ void hgchain_unit(const P& p, int item) {
    const int tid = tid_(), bh = item >> 2, eq = item & 3;
    const int e = eq * 32 + (tid >> 4), d0 = (tid & 15) * 8;
    float S[8];
#pragma unroll
    for (int i = 0; i < 8; ++i) S[i] = 0.f;
    uint4* ptr = (uint4*)(hg_ds(p) + ((size_t)(bh * NCH) * 128 + e) * 128 + d0);
    const f32x4* gp = (const f32x4*)(hg_g(p) + (size_t)(bh * NCH) * 128 + d0);
    uint4 wq[8]; f32x4 g0[8], g1[8];
#pragma unroll
    for (int k = 0; k < 8; ++k) { wq[k] = ptr[(size_t)k * 2048]; g0[k] = gp[k * 32]; g1[k] = gp[k * 32 + 1]; }
    for (int c0 = 0; c0 < NCH; c0 += 8) {
#pragma unroll
        for (int k = 0; k < 8; ++k) {
            const int c = c0 + k;
            if (c < NCH) {
                const uint4 w = wq[k]; const f32x4 ga = g0[k], gb = g1[k];
                if (c + 8 < NCH) { wq[k] = ptr[(size_t)(c + 8) * 2048]; g0[k] = gp[(c + 8) * 32]; g1[k] = gp[(c + 8) * 32 + 1]; }
                ptr[(size_t)c * 2048] = make_uint4(pack2(S[0], S[1]), pack2(S[2], S[3]), pack2(S[4], S[5]), pack2(S[6], S[7]));
                S[0] = ga[0] * S[0] + __uint_as_float(w.x << 16); S[1] = ga[1] * S[1] + __uint_as_float(w.x & 0xffff0000u);
                S[2] = ga[2] * S[2] + __uint_as_float(w.y << 16); S[3] = ga[3] * S[3] + __uint_as_float(w.y & 0xffff0000u);
                S[4] = gb[0] * S[4] + __uint_as_float(w.z << 16); S[5] = gb[1] * S[5] + __uint_as_float(w.z & 0xffff0000u);
                S[6] = gb[2] * S[6] + __uint_as_float(w.w << 16); S[7] = gb[3] * S[7] + __uint_as_float(w.w & 0xffff0000u);
            }
        }
    }
}

__device__ __forceinline__ void hgz_unit(const P& p, unsigned char* lds, int u) {
    const int tid = tid_(), lane = tid & 63, wid = tid >> 6, fr = lane & 15, fq = lane >> 4;
    const int c = u % NCH, bh = u / NCH, b = bh >> 2, h = bh & 3;
    const int tm = wid >> 1, en0 = (wid & 1) * 4;
    const size_t row = (size_t)(b * LP + c * 64 + tm * 16 + fr);
    const bf16_t* qrow = p.hq() + row * 512 + h * 128;
    const bf16_t* sT = hg_ds(p) + (size_t)u * 16384;
    f32x4 o[4];
#pragma unroll
    for (int j = 0; j < 4; ++j) o[j] = (f32x4){0.f, 0.f, 0.f, 0.f};
#pragma unroll
    for (int ks = 0; ks < 4; ++ks) {
        const bf16x8 aq = *(const bf16x8*)(qrow + ks * 32 + fq * 8);
#pragma unroll
        for (int j = 0; j < 4; ++j) {
            const bf16x8 bs = *(const bf16x8*)(sT + (size_t)((en0 + j) * 16 + fr) * 128 + ks * 32 + fq * 8);
            o[j] = __builtin_amdgcn_mfma_f32_16x16x32_bf16(bs, aq, o[j], 0, 0, 0);
        }
    }
    const bf16_t* oi = p.hf() + row * 512 + h * 128;
    float ss = 0.f;
#pragma unroll
    for (int j = 0; j < 4; ++j) {
        const uint2 w = *(const uint2*)(oi + (en0 + j) * 16 + fq * 4);
        o[j][0] += __uint_as_float(w.x << 16); o[j][1] += __uint_as_float(w.x & 0xffff0000u);
        o[j][2] += __uint_as_float(w.y << 16); o[j][3] += __uint_as_float(w.y & 0xffff0000u);
        ss += o[j][0] * o[j][0] + o[j][1] * o[j][1] + o[j][2] * o[j][2] + o[j][3] * o[j][3];
    }
    ss += __shfl_xor(ss, 16); ss += __shfl_xor(ss, 32);
    float* part = (float*)lds;
    if (fq == 0) part[(tm * 16 + fr) * 2 + (wid & 1)] = ss;
    __syncthreads();
    const float tot = part[(tm * 16 + fr) * 2] + part[(tm * 16 + fr) * 2 + 1];
    const float rs = rsqrtf(tot * (1.0f / 128.0f) + EPS);
    const bf16_t* hgp = p.hg() + row * 512 + h * 128;
    bf16_t* outp = p.hgr() + row * 512 + h * 128;
#pragma unroll
    for (int j = 0; j < 4; ++j) {
        const int e0 = (en0 + j) * 16 + fq * 4;
        const f32x4 gn = *(const f32x4*)(p.hgrn_g + h * 128 + e0);
        const uint2 w = *(const uint2*)(hgp + e0);
        f32x4 r;
        r[0] = o[j][0] * rs * gn[0] * __uint_as_float(w.x << 16); r[1] = o[j][1] * rs * gn[1] * __uint_as_float(w.x & 0xffff0000u);
        r[2] = o[j][2] * rs * gn[2] * __uint_as_float(w.y << 16); r[3] = o[j][3] * rs * gn[3] * __uint_as_float(w.y & 0xffff0000u);
        st_bf4(outp + e0, r);
    }
    __syncthreads();
}

typedef float f32x16 __attribute__((ext_vector_type(16)));
typedef short s16x4 __attribute__((ext_vector_type(4)));

constexpr int NKMAX = 8224;
constexpr int NBIN = 1024;
constexpr int A_SC = 0, A_H1 = A_SC + 4 * NKMAX * 4, A_SEL = A_H1 + 4 * NBIN * 4, A_CAND = A_SEL + 2048, A_META = A_CAND + 1024, A_END = A_META + 256;
static_assert(A_END <= LDS_BYTES - 16, "attention LDS");
__device__ __forceinline__ uint32_t skey(float f) { const uint32_t u = __float_as_uint(f); return (u & 0x80000000u) ? ~u : (u | 0x80000000u); }
__device__ __forceinline__ float skey_inv(uint32_t k) { return __uint_as_float((k & 0x80000000u) ? (k & 0x7fffffffu) : ~k); }
__device__ __forceinline__ int bin1(float s, float lo, float scale) { return min(NBIN - 1, max(0, (int)((s - lo) * scale))); }
template <int OFF> __device__ __forceinline__ s16x4 tr_read(unsigned addr) {
    s16x4 r; asm volatile("ds_read_b64_tr_b16 %0, %1 offset:%2" : "=&v"(r) : "v"(addr), "i"(OFF) : "memory"); return r;
}
__device__ __forceinline__ void scan_top(const int* hist, int K, int* m, int lane) {
    int c[16];
#pragma unroll
    for (int i = 0; i < 4; ++i) { const int4 v = *(const int4*)(hist + 16 * lane + 4 * i); c[4 * i] = v.x; c[4 * i + 1] = v.y; c[4 * i + 2] = v.z; c[4 * i + 3] = v.w; }
    int tot = 0;
#pragma unroll
    for (int i = 0; i < 16; ++i) tot += c[i];
    int suf = tot;
#pragma unroll
    for (int o = 1; o < 64; o <<= 1) { const int t = __shfl_down(suf, o); if (lane + o < 64) suf += t; }
    int above = suf - tot;
#pragma unroll
    for (int i = 15; i >= 0; --i) {
        if (above < K && K <= above + c[i]) { m[0] = 16 * lane + i; m[1] = above; m[2] = c[i]; }
        above += c[i];
    }
}

__device__ __forceinline__ void attn4_unit(const P& p, unsigned char* lds, int b, int grp) {
    const int tid = tid_(), lane = tid & 63, wid = __builtin_amdgcn_readfirstlane(tid >> 6);
    const int t0 = NMETA + 4 * grp;
    const int brow = b * LP, row0 = brow + t0;
    float* sc = (float*)(lds + A_SC);
    int* h1 = (int*)(lds + A_H1);
    unsigned short* sel = (unsigned short*)(lds + A_SEL); unsigned short* cand = (unsigned short*)(lds + A_CAND);
    int* meta = (int*)(lds + A_META);
    const bool big = t0 + 1 > 256;
    for (int i = tid; i < 4 * NBIN; i += NTHREADS) h1[i] = 0;
    if (tid < 64) { const int w = tid & 15; meta[tid] = (w == 0) ? -1 : 0; }
    if (!big) { for (int i = tid; i < 1024; i += NTHREADS) { const int q = i >> 8, j = i & 255; sel[i] = (unsigned short)(j <= t0 + q ? j : 0); } }
    __syncthreads();
    if (big) {
        {
            const int hh = lane >> 5, c32 = lane & 31;
            const int g = c32 >> 3, h2a = (c32 >> 2) & 1, bq = c32 & 3, aq = 2 * h2a + (g >> 1), ah = 4 * (g & 1) + bq;
            const bf16_t* ap = p.iq() + (size_t)(row0 + aq) * 256 + ah * 32 + 8 * hh;
            const bf16x8 a0 = *(const bf16x8*)ap, a1 = *(const bf16x8*)(ap + 16);
            const f32x4 w00 = *(const f32x4*)(p.iw() + (size_t)(row0 + 2 * hh) * 8), w01 = *(const f32x4*)(p.iw() + (size_t)(row0 + 2 * hh) * 8 + 4);
            const f32x4 w10 = *(const f32x4*)(p.iw() + (size_t)(row0 + 2 * hh + 1) * 8), w11 = *(const f32x4*)(p.iw() + (size_t)(row0 + 2 * hh + 1) * 8 + 4);
            const int ntiles = (t0 + 4 + 31) >> 5;
            const int tq0 = t0 + 2 * hh;
            float mx0 = -INFINITY, mn0 = INFINITY, mx1 = -INFINITY, mn1 = INFINITY;
            const bf16_t* kbase = p.ik() + (size_t)brow * 32 + 8 * hh;
            for (int tile0 = wid; tile0 < ntiles; tile0 += 128) {
                bf16x8 b0[16], b1[16];
#pragma unroll
                for (int j = 0; j < 16; ++j) {
                    const int tile = min(tile0 + 8 * j, ntiles - 1);
                    const bf16_t* kp = kbase + (size_t)(tile * 32 + c32) * 32;
                    b0[j] = *(const bf16x8*)kp; b1[j] = *(const bf16x8*)(kp + 16);
                }
                __builtin_amdgcn_sched_barrier(0);
#pragma unroll
                for (int j = 0; j < 16; ++j) {
                    const int tile = tile0 + 8 * j;
                    if (tile < ntiles) {
                        const int key = tile * 32 + c32;
                        f32x16 acc;
#pragma unroll
                        for (int i = 0; i < 16; ++i) acc[i] = 0.f;
                        acc = __builtin_amdgcn_mfma_f32_32x32x16_bf16(a0, b0[j], acc, 0, 0, 0);
                        acc = __builtin_amdgcn_mfma_f32_32x32x16_bf16(a1, b1[j], acc, 0, 0, 0);
                        float s0 = 0.f, s1 = 0.f;
#pragma unroll
                        for (int i = 0; i < 4; ++i) {
                            s0 += w00[i] * fmaxf(acc[i], 0.f) + w01[i] * fmaxf(acc[4 + i], 0.f);
                            s1 += w10[i] * fmaxf(acc[8 + i], 0.f) + w11[i] * fmaxf(acc[12 + i], 0.f);
                        }
                        sc[(2 * hh) * NKMAX + key] = s0; sc[(2 * hh + 1) * NKMAX + key] = s1;
                        if (key <= tq0) { mx0 = fmaxf(mx0, s0); mn0 = fminf(mn0, s0); }
                        if (key <= tq0 + 1) { mx1 = fmaxf(mx1, s1); mn1 = fminf(mn1, s1); }
                    }
                }
            }
#pragma unroll
            for (int o = 16; o >= 1; o >>= 1) {
                mx0 = fmaxf(mx0, __shfl_xor(mx0, o)); mn0 = fminf(mn0, __shfl_xor(mn0, o));
                mx1 = fmaxf(mx1, __shfl_xor(mx1, o)); mn1 = fminf(mn1, __shfl_xor(mn1, o));
            }
            if (c32 == 0) {
                if (mx0 >= mn0) { atomicMin((unsigned*)&meta[(2 * hh) * 16 + 0], skey(mn0)); atomicMax((unsigned*)&meta[(2 * hh) * 16 + 1], skey(mx0)); }
                if (mx1 >= mn1) { atomicMin((unsigned*)&meta[(2 * hh + 1) * 16 + 0], skey(mn1)); atomicMax((unsigned*)&meta[(2 * hh + 1) * 16 + 1], skey(mx1)); }
            }
        }
        __syncthreads();
        const int q = wid & 3, part = wid >> 2, n = t0 + q + 1;
        const float lo = skey_inv((unsigned)meta[q * 16 + 0]), hi = skey_inv((unsigned)meta[q * 16 + 1]);
        const float scale = hi > lo ? (float)NBIN / (hi - lo) : 0.f;
        const float* scq = sc + q * NKMAX;
        for (int base = part * 256; base < n; base += 512) {
            const int idx0 = base + lane * 4;
            if (idx0 < n) {
                const f32x4 v = *(const f32x4*)(scq + idx0);
#pragma unroll
                for (int j = 0; j < 4; ++j) if (idx0 + j < n) atomicAdd(&h1[q * NBIN + bin1(v[j], lo, scale)], 1);
            }
        }
        __syncthreads();
        if (wid < 4) scan_top(h1 + wid * NBIN, 256, meta + wid * 16 + 4, lane);
        __syncthreads();
        const int B1 = meta[q * 16 + 4];
        for (int base = part * 256; base < n; base += 512) {
            const int idx0 = base + lane * 4;
            f32x4 v = (f32x4){0.f, 0.f, 0.f, 0.f};
            if (idx0 < n) v = *(const f32x4*)(scq + idx0);
            const unsigned long long lt = (1ull << lane) - 1ull;
#pragma unroll
            for (int j = 0; j < 4; ++j) {
                const int idx = idx0 + j;
                bool issel = false, iscand = false;
                if (idx < n) { const int b1 = bin1(v[j], lo, scale); issel = b1 > B1; iscand = b1 == B1; }
                const unsigned long long ms = __ballot(issel), mc = __ballot(iscand);
                if (ms) {
                    int bs = 0; if (lane == 0) bs = atomicAdd(&meta[q * 16 + 2], __popcll(ms));
                    bs = __shfl(bs, 0);
                    if (issel) sel[q * 256 + bs + __popcll(ms & lt)] = (unsigned short)idx;
                }
                if (mc) {
                    int bs = 0; if (lane == 0) bs = atomicAdd(&meta[q * 16 + 3], __popcll(mc));
                    bs = __shfl(bs, 0);
                    const int pos = bs + __popcll(mc & lt);
                    if (iscand && pos < 128) cand[q * 128 + pos] = (unsigned short)idx;
                }
            }
        }
        __syncthreads();
        if (wid < 4) {
            const int qq = wid; const float* scr = sc + qq * NKMAX;
            const int rq = 256 - meta[qq * 16 + 5], cq = meta[qq * 16 + 6], sbase = 256 - rq, nn = t0 + qq + 1;
            if (cq <= 128) {
                int taken = 0;
#pragma unroll
                for (int half = 0; half < 2; ++half) {
                    const int i = lane + 64 * half;
                    bool take = false; int myidx = 0;
                    if (i < cq) {
                        myidx = cand[qq * 128 + i]; const float mv = scr[myidx];
                        int rank = 0;
                        for (int j = 0; j < cq; ++j) { const int oj = cand[qq * 128 + j]; const float ov = scr[oj]; rank += (ov > mv) || (ov == mv && oj < myidx); }
                        take = rank < rq;
                    }
                    const unsigned long long mt = __ballot(take);
                    if (take) sel[qq * 256 + sbase + taken + __popcll(mt & ((1ull << lane) - 1ull))] = (unsigned short)myidx;
                    taken += __popcll(mt);
                }
            } else {
                const float lo_ = skey_inv((unsigned)meta[qq * 16 + 0]), hi_ = skey_inv((unsigned)meta[qq * 16 + 1]);
                const float sc_ = hi_ > lo_ ? (float)NBIN / (hi_ - lo_) : 0.f;
                const int B1_ = meta[qq * 16 + 4];
                int taken = 0;
                for (int base = 0; base < nn && taken < rq; base += 64) {
                    const int idx = base + lane; bool isc = false;
                    if (idx < nn) isc = bin1(scr[idx], lo_, sc_) == B1_;
                    const unsigned long long mc = __ballot(isc);
                    const int pos = taken + __popcll(mc & ((1ull << lane) - 1ull));
                    if (isc && pos < rq) sel[qq * 256 + sbase + pos] = (unsigned short)idx;
                    taken += __popcll(mc);
                }
            }
        }
        __syncthreads();
    }
    {
        const int q = wid >> 1, kvh = wid & 1, tq = t0 + q, nsel = min(tq + 1, 256);
        const int col = lane & 15, g4 = lane >> 4;
        const unsigned short* selq = sel + q * 256;
        bf16x8 qf0, qf1;
        {
            const bf16_t* qp = p.q() + (size_t)(row0 + q) * 512 + (kvh * 4 + (col & 3)) * 64 + g4 * 8;
            qf0 = *(const bf16x8*)qp; qf1 = *(const bf16x8*)(qp + 32);
            if (col >= 4) {
#pragma unroll
                for (int i = 0; i < 8; ++i) { qf0[i] = 0; qf1[i] = 0; }
            }
        }
        LAS unsigned char* vst = (LAS unsigned char*)lds + A_SC + wid * 16384;
        const bf16_t* vb = p.v() + (size_t)brow * 128 + kvh * 64 + (lane & 7) * 8;
        const unsigned rdbase = (unsigned)(uintptr_t)((LAS unsigned char*)lds + A_SC) + wid * 16384 + (4 * g4 + (col >> 2)) * 128 + (col & 3) * 8;
#define V_STAGE(s_, buf_) do { _Pragma("unroll") for (int i_ = 0; i_ < 4; ++i_) { \
            const int ksl_ = (s_) * 32 + i_ * 8 + (lane >> 3); const int key_ = selq[ksl_]; \
            __builtin_amdgcn_global_load_lds((const unsigned*)(vb + (size_t)key_ * 128), (LAS unsigned*)(vst + (buf_) * 4096 + i_ * 1024), 16, 0, 0); } } while (0)
        const bf16_t* kb = p.k() + (size_t)brow * 128 + kvh * 64 + g4 * 8;
        f32x4 lg[16];
        u32x4 vr[16];
        {
            bf16x8 k0[16], k1[16];
#pragma unroll
            for (int t = 0; t < 16; ++t) {
                const int key = selq[t * 16 + col];
                const bf16_t* kp = kb + (size_t)key * 128;
                k0[t] = *(const bf16x8*)kp; k1[t] = *(const bf16x8*)(kp + 32);
            }
#pragma unroll
            for (int s = 4; s < 8; ++s)
#pragma unroll
                for (int i = 0; i < 4; ++i) { const int key = selq[s * 32 + i * 8 + (lane >> 3)]; vr[(s - 4) * 4 + i] = *(const u32x4*)(vb + (size_t)key * 128); }
            V_STAGE(0, 0); V_STAGE(1, 1); V_STAGE(2, 2); V_STAGE(3, 3);
            __builtin_amdgcn_sched_barrier(0);
#pragma unroll
            for (int t = 0; t < 16; ++t) {
                f32x4 a = (f32x4){0.f, 0.f, 0.f, 0.f};
                a = __builtin_amdgcn_mfma_f32_16x16x32_bf16(k0[t], qf0, a, 0, 0, 0);
                a = __builtin_amdgcn_mfma_f32_16x16x32_bf16(k1[t], qf1, a, 0, 0, 0);
                lg[t] = a;
            }
            __builtin_amdgcn_sched_barrier(0);
        }
        float mx = -INFINITY;
#pragma unroll
        for (int t = 0; t < 16; ++t)
#pragma unroll
            for (int j = 0; j < 4; ++j) { if (t * 16 + g4 * 4 + j >= nsel) lg[t][j] = -INFINITY; mx = fmaxf(mx, lg[t][j]); }
        mx = fmaxf(mx, __shfl_xor(mx, 16)); mx = fmaxf(mx, __shfl_xor(mx, 32));
        float sm = 0.f;
#pragma unroll
        for (int t = 0; t < 16; ++t)
#pragma unroll
            for (int j = 0; j < 4; ++j) { const float e = __builtin_amdgcn_exp2f(lg[t][j] - mx); lg[t][j] = e; sm += e; }
        sm += __shfl_xor(sm, 16); sm += __shfl_xor(sm, 32);
        const float inv = 1.0f / sm;
        f32x4 o[4];
#pragma unroll
        for (int d = 0; d < 4; ++d) o[d] = (f32x4){0.f, 0.f, 0.f, 0.f};
        asm volatile("s_waitcnt vmcnt(0)" ::: "memory");
#pragma unroll
        for (int s = 0; s < 8; ++s) {
            if (s >= 4) {
#pragma unroll
                for (int i = 0; i < 4; ++i) *(LAS u32x4*)(vst + (s & 3) * 4096 + i * 1024 + lane * 16) = vr[(s - 4) * 4 + i];
                asm volatile("s_waitcnt lgkmcnt(0)" ::: "memory");
            }
            const unsigned rb = rdbase + (s & 3) * 4096;
            const s16x4 l0 = tr_read<0>(rb), h0 = tr_read<2048>(rb), l1 = tr_read<32>(rb), h1_ = tr_read<2048 + 32>(rb);
            const s16x4 l2 = tr_read<64>(rb), h2_ = tr_read<2048 + 64>(rb), l3 = tr_read<96>(rb), h3 = tr_read<2048 + 96>(rb);
            asm volatile("s_waitcnt lgkmcnt(0)" ::: "memory");
            __builtin_amdgcn_sched_barrier(0);
            bf16x8 pa;
            {
                const uint32_t w0 = pack2(lg[2 * s][0], lg[2 * s][1]), w1 = pack2(lg[2 * s][2], lg[2 * s][3]);
                const uint32_t w2 = pack2(lg[2 * s + 1][0], lg[2 * s + 1][1]), w3 = pack2(lg[2 * s + 1][2], lg[2 * s + 1][3]);
                pa[0] = (short)(w0 & 0xffff); pa[1] = (short)(w0 >> 16); pa[2] = (short)(w1 & 0xffff); pa[3] = (short)(w1 >> 16);
                pa[4] = (short)(w2 & 0xffff); pa[5] = (short)(w2 >> 16); pa[6] = (short)(w3 & 0xffff); pa[7] = (short)(w3 >> 16);
            }
#define PKV(L, H) (bf16x8){L[0], L[1], L[2], L[3], H[0], H[1], H[2], H[3]}
            o[0] = __builtin_amdgcn_mfma_f32_16x16x32_bf16(pa, PKV(l0, h0), o[0], 0, 0, 0);
            o[1] = __builtin_amdgcn_mfma_f32_16x16x32_bf16(pa, PKV(l1, h1_), o[1], 0, 0, 0);
            o[2] = __builtin_amdgcn_mfma_f32_16x16x32_bf16(pa, PKV(l2, h2_), o[2], 0, 0, 0);
            o[3] = __builtin_amdgcn_mfma_f32_16x16x32_bf16(pa, PKV(l3, h3), o[3], 0, 0, 0);
#undef PKV
        }
#undef V_STAGE
        const float i0 = __shfl(inv, 0), i1 = __shfl(inv, 1), i2 = __shfl(inv, 2), i3 = __shfl(inv, 3);
        if (g4 == 0) {
            bf16_t* op = p.att() + (size_t)(row0 + q) * 512 + kvh * 256 + col;
#pragma unroll
            for (int d = 0; d < 4; ++d) {
                op[0 * 64 + d * 16] = f2bf(o[d][0] * i0); op[1 * 64 + d * 16] = f2bf(o[d][1] * i1);
                op[2 * 64 + d * 16] = f2bf(o[d][2] * i2); op[3 * 64 + d * 16] = f2bf(o[d][3] * i3);
            }
        }
    }
    __syncthreads();
}

constexpr int NBW = 512;
constexpr int W_SC = 0, W_H = W_SC + NKMAX * 2, W_SEL = W_H + NBW * 4, W_CAND = W_SEL + 512, W_SZ = W_CAND + 256;
static_assert(8 * W_SZ <= LDS_BYTES - 32, "wave attention LDS");
__device__ __forceinline__ int binw(float s, float lo, float scale) { return min(NBW - 1, max(0, (int)((s - lo) * scale))); }

__device__ __forceinline__ void attn_wave(const P& p, unsigned char* lds, int wid, int lane, int b, int t, float mn, float mx) {
    unsigned char* wl = lds + wid * W_SZ;
    _Float16* sc = (_Float16*)(wl + W_SC);
    int* hist = (int*)(wl + W_H);
    unsigned short* sel = (unsigned short*)(wl + W_SEL);
    unsigned short* cand = (unsigned short*)(wl + W_CAND);
    const int brow = b * LP, row = brow + t, n = t + 1;
    const int col = lane & 15, g4 = lane >> 4;
    const unsigned long long lt = (1ull << lane) - 1ull;
    int nsel = 256;
    if (n > 256) {
        const float scale = mx > mn ? (float)NBW / (mx - mn) : 0.f, nls = -mn * scale;
#define BINF(x) min(NBW - 1, max(0, (int)__builtin_fmaf((x), scale, nls)))
#define H2F(u16) ((float)__builtin_bit_cast(_Float16, (unsigned short)(u16)))
        for (int base = 0; base < n; base += 512) {
            const int ia = base + lane * 4, ib = ia + 256;
            uint2 ra = make_uint2(0u, 0u), rb2 = make_uint2(0u, 0u);
            if (ia < n) ra = *(const uint2*)(sc + ia);
            if (ib < n) rb2 = *(const uint2*)(sc + ib);
            const unsigned wa[4] = {ra.x & 0xffffu, ra.x >> 16, ra.y & 0xffffu, ra.y >> 16}, wb[4] = {rb2.x & 0xffffu, rb2.x >> 16, rb2.y & 0xffffu, rb2.y >> 16};
#pragma unroll
            for (int j = 0; j < 4; ++j) {
                if (ia + j < n) atomicAdd(&hist[BINF(H2F(wa[j]))], 1);
                if (ib + j < n) atomicAdd(&hist[BINF(H2F(wb[j]))], 1);
            }
        }
        int B1, above1, cnt1;
        {
            int c[8];
            const int4 v0 = *(const int4*)(hist + 8 * lane), v1 = *(const int4*)(hist + 8 * lane + 4);
            c[0] = v0.x; c[1] = v0.y; c[2] = v0.z; c[3] = v0.w; c[4] = v1.x; c[5] = v1.y; c[6] = v1.z; c[7] = v1.w;
            int tot = 0;
#pragma unroll
            for (int i = 0; i < 8; ++i) tot += c[i];
            int suf = tot;
#pragma unroll
            for (int o = 1; o < 64; o <<= 1) { const int tt = __shfl_down(suf, o); if (lane + o < 64) suf += tt; }
            int above = suf - tot;
            const bool mine = above < 256 && 256 <= above + tot;
            int bb = 0, ab = 0, cb = 0;
#pragma unroll
            for (int i = 7; i >= 0; --i) { if (above < 256 && 256 <= above + c[i]) { bb = 8 * lane + i; ab = above; cb = c[i]; } above += c[i]; }
            const int src = (int)__builtin_ctzll(__ballot(mine));
            B1 = __shfl(bb, src); above1 = __shfl(ab, src); cnt1 = __shfl(cb, src);
        }
        int selcnt = 0, candcnt = 0;
        for (int base = 0; base < n; base += 512) {
            const int ia = base + lane * 4, ib = ia + 256;
            uint2 ra = make_uint2(0u, 0u), rb2 = make_uint2(0u, 0u);
            if (ia < n) ra = *(const uint2*)(sc + ia);
            if (ib < n) rb2 = *(const uint2*)(sc + ib);
            const unsigned wv[8] = {ra.x & 0xffffu, ra.x >> 16, ra.y & 0xffffu, ra.y >> 16, rb2.x & 0xffffu, rb2.x >> 16, rb2.y & 0xffffu, rb2.y >> 16};
            unsigned smask = 0u, cmask = 0u;
#pragma unroll
            for (int j = 0; j < 8; ++j) {
                const int idx = (j < 4 ? ia : ib) + (j & 3);
                const int b1 = idx < n ? BINF(H2F(wv[j])) : -1;
                smask |= (b1 > B1 ? 1u : 0u) << j; cmask |= (b1 == B1 ? 1u : 0u) << j;
            }
            const int cnt = __popc(smask);
            int inc = cnt;
#pragma unroll
            for (int o = 1; o < 64; o <<= 1) { const int tt = __shfl_up(inc, o); if (lane >= o) inc += tt; }
            int pos = selcnt + inc - cnt;
#pragma unroll
            for (int j = 0; j < 8; ++j) if ((smask >> j) & 1u) { sel[pos] = (unsigned short)((j < 4 ? ia : ib) + (j & 3)); ++pos; }
            selcnt += __shfl(inc, 63);
            if (__ballot(cmask != 0u)) {
#pragma unroll
                for (int j = 0; j < 8; ++j) {
                    const bool isc = (cmask >> j) & 1u;
                    const unsigned long long mc = __ballot(isc);
                    const int cp = candcnt + __popcll(mc & lt);
                    if (isc && cp < 128) cand[cp] = (unsigned short)((j < 4 ? ia : ib) + (j & 3));
                    candcnt += __popcll(mc);
                }
            }
        }
        {
            const int rq = 256 - above1, cq = cnt1, sbase = 256 - rq;
            if (cq <= 128) {
                int taken = 0;
#pragma unroll
                for (int half = 0; half < 2; ++half) {
                    const int i = lane + 64 * half;
                    bool take = false; int myidx = 0;
                    if (i < cq) {
                        myidx = cand[i]; const float mv = (float)sc[myidx];
                        int rank = 0;
                        for (int j = 0; j < cq; ++j) { const int oj = cand[j]; const float ov = (float)sc[oj]; rank += (ov > mv) || (ov == mv && oj < myidx); }
                        take = rank < rq;
                    }
                    const unsigned long long mt = __ballot(take);
                    if (take) sel[sbase + taken + __popcll(mt & lt)] = (unsigned short)myidx;
                    taken += __popcll(mt);
                }
            } else {
                int taken = 0;
                for (int base = 0; base < n && taken < rq; base += 64) {
                    const int idx = base + lane; bool isc = false;
                    if (idx < n) isc = BINF((float)sc[idx]) == B1;
                    const unsigned long long mc = __ballot(isc);
                    const int pos = taken + __popcll(mc & lt);
                    if (isc && pos < rq) sel[sbase + pos] = (unsigned short)idx;
                    taken += __popcll(mc);
                }
            }
        }
#undef BINF
#undef H2F
    } else {
        nsel = n;
#pragma unroll
        for (int i = 0; i < 4; ++i) { const int j = lane + 64 * i; sel[j] = (unsigned short)(j < n ? j : 0); }
    }
    LAS unsigned char* vst = (LAS unsigned char*)wl + W_SC;
    const unsigned rdbase = (unsigned)(uintptr_t)((LAS unsigned char*)wl + W_SC) + (4 * g4 + (col >> 2)) * 256 + (col & 3) * 8;
    {
        bf16x8 qf[4];
        {
            const bf16_t* qp = p.q() + (size_t)row * 512 + (col & 7) * 64 + g4 * 8;
            const bf16x8 q0 = *(const bf16x8*)qp, q1 = *(const bf16x8*)(qp + 32);
            const bool lo_grp = col < 4, hi_grp = col >= 4 && col < 8;
#pragma unroll
            for (int i = 0; i < 8; ++i) { qf[0][i] = lo_grp ? q0[i] : (short)0; qf[1][i] = lo_grp ? q1[i] : (short)0; qf[2][i] = hi_grp ? q0[i] : (short)0; qf[3][i] = hi_grp ? q1[i] : (short)0; }
        }
        const bf16_t* vb = p.v() + (size_t)brow * 128 + (lane & 15) * 8;
#define V_STAGE(s_, buf_) do { _Pragma("unroll") for (int i_ = 0; i_ < 4; ++i_) { \
            const int key_ = sel[(s_) * 16 + i_ * 4 + (lane >> 4)]; \
            __builtin_amdgcn_global_load_lds((const unsigned*)(vb + (size_t)key_ * 128), (LAS unsigned*)(vst + (buf_) * 4096 + i_ * 1024), 16, 0, 0); } } while (0)
        const bf16_t* kg = p.k() + (size_t)brow * 128;
#define K_STAGE(s_, buf_) do { _Pragma("unroll") for (int i_ = 0; i_ < 4; ++i_) { \
            const int kl_ = i_ * 4 + (lane >> 4); const int key_ = sel[(s_) * 16 + kl_]; \
            __builtin_amdgcn_global_load_lds((const unsigned*)(kg + (size_t)key_ * 128 + (((lane & 15) ^ kl_) & 15) * 8), (LAS unsigned*)(vst + (buf_) * 4096 + i_ * 1024), 16, 0, 0); } } while (0)
        f32x4 lg[16];
        K_STAGE(0, 0); K_STAGE(1, 1); K_STAGE(2, 2);
#pragma unroll
        for (int s = 0; s < 16; ++s) {
            if (s + 3 < 16) { K_STAGE(s + 3, (s + 3) & 3); asm volatile("s_waitcnt vmcnt(12)" ::: "memory"); }
            else if (s == 13) asm volatile("s_waitcnt vmcnt(8)" ::: "memory");
            else if (s == 14) asm volatile("s_waitcnt vmcnt(4)" ::: "memory");
            else asm volatile("s_waitcnt vmcnt(0)" ::: "memory");
            bf16x8 kf[4];
#pragma unroll
            for (int ks = 0; ks < 4; ++ks) kf[ks] = *(const LAS bf16x8*)(vst + (s & 3) * 4096 + col * 256 + (((ks * 4 + g4) ^ col) & 15) * 16);
            asm volatile("s_waitcnt lgkmcnt(0)" ::: "memory");
            __builtin_amdgcn_sched_barrier(0);
            f32x4 a = (f32x4){0.f, 0.f, 0.f, 0.f};
#pragma unroll
            for (int ks = 0; ks < 4; ++ks) a = __builtin_amdgcn_mfma_f32_16x16x32_bf16(kf[ks], qf[ks], a, 0, 0, 0);
            lg[s] = a;
        }
#undef K_STAGE
        V_STAGE(0, 0); V_STAGE(1, 1); V_STAGE(2, 2);
        float mxl = -INFINITY;
#pragma unroll
        for (int tt = 0; tt < 16; ++tt)
#pragma unroll
            for (int j = 0; j < 4; ++j) { if (tt * 16 + g4 * 4 + j >= nsel) lg[tt][j] = -INFINITY; mxl = fmaxf(mxl, lg[tt][j]); }
        mxl = fmaxf(mxl, __shfl_xor(mxl, 16)); mxl = fmaxf(mxl, __shfl_xor(mxl, 32));
        float sm = 0.f;
#pragma unroll
        for (int tt = 0; tt < 16; ++tt)
#pragma unroll
            for (int j = 0; j < 4; ++j) { const float e = __builtin_amdgcn_exp2f(lg[tt][j] - mxl); lg[tt][j] = e; sm += e; }
        sm += __shfl_xor(sm, 16); sm += __shfl_xor(sm, 32);
        const float inv = 1.0f / sm;
        f32x4 o[8];
#pragma unroll
        for (int d = 0; d < 8; ++d) o[d] = (f32x4){0.f, 0.f, 0.f, 0.f};
#pragma unroll
        for (int s = 0; s < 16; ++s) {
            if (s + 3 < 16) { V_STAGE(s + 3, (s + 3) & 3); asm volatile("s_waitcnt vmcnt(12)" ::: "memory"); }
            else if (s == 13) asm volatile("s_waitcnt vmcnt(8)" ::: "memory");
            else if (s == 14) asm volatile("s_waitcnt vmcnt(4)" ::: "memory");
            else asm volatile("s_waitcnt vmcnt(0)" ::: "memory");
            const unsigned rb = rdbase + (s & 3) * 4096;
            s16x4 pa;
            {
                const uint32_t w0 = pack2(lg[s][0], lg[s][1]), w1 = pack2(lg[s][2], lg[s][3]);
                pa[0] = (short)(w0 & 0xffff); pa[1] = (short)(w0 >> 16); pa[2] = (short)(w1 & 0xffff); pa[3] = (short)(w1 >> 16);
            }
            const s16x4 v0 = tr_read<0>(rb), v1 = tr_read<32>(rb), v2 = tr_read<64>(rb), v3 = tr_read<96>(rb);
            const s16x4 v4 = tr_read<128>(rb), v5 = tr_read<160>(rb), v6 = tr_read<192>(rb), v7 = tr_read<224>(rb);
            asm volatile("s_waitcnt lgkmcnt(0)" ::: "memory");
            __builtin_amdgcn_sched_barrier(0);
            o[0] = __builtin_amdgcn_mfma_f32_16x16x16bf16_1k(pa, v0, o[0], 0, 0, 0); o[1] = __builtin_amdgcn_mfma_f32_16x16x16bf16_1k(pa, v1, o[1], 0, 0, 0);
            o[2] = __builtin_amdgcn_mfma_f32_16x16x16bf16_1k(pa, v2, o[2], 0, 0, 0); o[3] = __builtin_amdgcn_mfma_f32_16x16x16bf16_1k(pa, v3, o[3], 0, 0, 0);
            o[4] = __builtin_amdgcn_mfma_f32_16x16x16bf16_1k(pa, v4, o[4], 0, 0, 0); o[5] = __builtin_amdgcn_mfma_f32_16x16x16bf16_1k(pa, v5, o[5], 0, 0, 0);
            o[6] = __builtin_amdgcn_mfma_f32_16x16x16bf16_1k(pa, v6, o[6], 0, 0, 0); o[7] = __builtin_amdgcn_mfma_f32_16x16x16bf16_1k(pa, v7, o[7], 0, 0, 0);
        }
#undef V_STAGE
        float ih[4];
#pragma unroll
        for (int jj = 0; jj < 4; ++jj) ih[jj] = __shfl(inv, 4 * (g4 & 1) + jj);
        if (g4 < 2) {
            bf16_t* op = p.att() + (size_t)row * 512 + (g4 * 4) * 64 + col;
#pragma unroll
            for (int d = 0; d < 4; ++d) {
                const f32x4 oa_ = o[d], ob_ = o[4 + d]; f32x4 ov;
#pragma unroll
                for (int kk = 0; kk < 4; ++kk) ov[kk] = g4 == 0 ? oa_[kk] : ob_[kk];
                op[0 * 64 + d * 16] = f2bf(ov[0] * ih[0]); op[1 * 64 + d * 16] = f2bf(ov[1] * ih[1]);
                op[2 * 64 + d * 16] = f2bf(ov[2] * ih[2]); op[3 * 64 + d * 16] = f2bf(ov[3] * ih[3]);
            }
        }
    }
}

constexpr int A8_META = 8 * W_SZ;
static_assert(A8_META + 64 + 512 <= LDS_BYTES - 32, "attn8 meta");
__device__ __forceinline__ void attn8_unit(const P& p, unsigned char* lds, int b, int grp) {
    const int tid = tid_(), lane = tid & 63, wid = __builtin_amdgcn_readfirstlane(tid >> 6);
    const int t0 = NMETA + 8 * grp, brow = b * LP, row0 = brow + t0;
    unsigned* meta = (unsigned*)(lds + A8_META);
    const bool big = t0 + 1 > 256;
    if (tid < 16) meta[tid] = (tid & 1) ? 0u : 0xffffffffu;
    bf16_t* uvec = (bf16_t*)(lds + A8_META + 64);
    if (big && tid < 256) {
        const int q = tid >> 5, d = tid & 31;
        const bf16_t* ip = p.iq() + (size_t)(row0 + q) * 256 + d; const float* wp = p.iw() + (size_t)(row0 + q) * 8;
        float u = 0.f;
#pragma unroll
        for (int h = 0; h < 8; ++h) u += wp[h] * bf2f(ip[h * 32]);
        uvec[q * 32 + d] = f2bf(u);
    }
    for (int i = tid; i < 8 * NBW; i += NTHREADS) ((int*)(lds + (i / NBW) * W_SZ + W_H))[i % NBW] = 0;
    __syncthreads();
    if (big) {
        const int hh = lane >> 5, c32 = lane & 31;
        const int g = c32 >> 3, h2a = (c32 >> 2) & 1, bq = c32 & 3, aq = 2 * h2a + (g >> 1), ah = 4 * (g & 1) + bq;
        bf16x8 a0[2], a1[2]; f32x4 w[2][2][2];
#pragma unroll
        for (int r = 0; r < 2; ++r) {
            const bf16_t* ap = p.iq() + (size_t)(row0 + 4 * r + aq) * 256 + ah * 32 + 8 * hh;
            a0[r] = *(const bf16x8*)ap; a1[r] = *(const bf16x8*)(ap + 16);
#pragma unroll
            for (int qi = 0; qi < 2; ++qi) {
                const float* wp = p.iw() + (size_t)(row0 + 4 * r + 2 * hh + qi) * 8;
                w[r][qi][0] = *(const f32x4*)wp; w[r][qi][1] = *(const f32x4*)(wp + 4);
            }
        }
        bf16x8 au0, au1;
        {
            const int uq = 4 * ((c32 & 3) >> 1) + 2 * ((c32 >> 2) & 1) + (c32 & 1);
            const bf16x8 v0 = *(const bf16x8*)(uvec + uq * 32 + 8 * hh), v1 = *(const bf16x8*)(uvec + uq * 32 + 8 * hh + 16);
#pragma unroll
            for (int i = 0; i < 8; ++i) { au0[i] = c32 < 8 ? v0[i] : (short)0; au1[i] = c32 < 8 ? v1[i] : (short)0; }
        }
        const int ntiles = (t0 + 8 + 31) >> 5;
        float mx[2][2], mn[2][2];
#pragma unroll
        for (int r = 0; r < 2; ++r)
#pragma unroll
            for (int qi = 0; qi < 2; ++qi) { mx[r][qi] = -INFINITY; mn[r][qi] = INFINITY; }
        const bf16_t* kbase = p.ik() + (size_t)brow * 32 + 8 * hh;
        bf16x8 b0[8], b1[8], c0[8], c1[8];
#define S_LOAD(B0, B1, T0) do { _Pragma("unroll") for (int j = 0; j < 8; ++j) { const int tile_ = min((T0) + 8 * j, ntiles - 1); \
            const bf16_t* kp_ = kbase + (size_t)(tile_ * 32 + c32) * 32; B0[j] = *(const bf16x8*)kp_; B1[j] = *(const bf16x8*)(kp_ + 16); } } while (0)
#define S_COMP(B0, B1, T0) do { _Pragma("unroll") for (int j = 0; j < 8; ++j) { const int tile = (T0) + 8 * j; if (tile < ntiles) { const int key = tile * 32 + c32; \
            f32x16 acu; _Pragma("unroll") for (int i = 0; i < 16; ++i) acu[i] = 0.f; \
            acu = __builtin_amdgcn_mfma_f32_32x32x16_bf16(au0, B0[j], acu, 0, 0, 0); acu = __builtin_amdgcn_mfma_f32_32x32x16_bf16(au1, B1[j], acu, 0, 0, 0); \
            _Pragma("unroll") for (int r = 0; r < 2; ++r) { f32x16 acc; _Pragma("unroll") for (int i = 0; i < 16; ++i) acc[i] = 0.f; \
                acc = __builtin_amdgcn_mfma_f32_32x32x16_bf16(a0[r], B0[j], acc, 0, 0, 0); acc = __builtin_amdgcn_mfma_f32_32x32x16_bf16(a1[r], B1[j], acc, 0, 0, 0); \
                _Pragma("unroll") for (int qi = 0; qi < 2; ++qi) { float s = acu[2 * r + qi]; \
                    _Pragma("unroll") for (int i = 0; i < 4; ++i) s += w[r][qi][0][i] * __builtin_fabsf(acc[8 * qi + i]) + w[r][qi][1][i] * __builtin_fabsf(acc[8 * qi + 4 + i]); \
                    const int q = 4 * r + 2 * hh + qi; const _Float16 hs = (_Float16)fminf(fmaxf(s, -60000.f), 60000.f); \
                    ((_Float16*)(lds + q * W_SZ + W_SC))[key] = hs; \
                    if (key <= t0 + q) { const float f = (float)hs; mx[r][qi] = fmaxf(mx[r][qi], f); mn[r][qi] = fminf(mn[r][qi], f); } } } } } } while (0)
        S_LOAD(b0, b1, wid);
        for (int tile0 = wid; tile0 < ntiles; tile0 += 128) {
            if (tile0 + 64 < ntiles) S_LOAD(c0, c1, tile0 + 64);
            __builtin_amdgcn_sched_barrier(0);
            S_COMP(b0, b1, tile0);
            __builtin_amdgcn_sched_barrier(0);
            if (tile0 + 128 < ntiles) S_LOAD(b0, b1, tile0 + 128);
            __builtin_amdgcn_sched_barrier(0);
            if (tile0 + 64 < ntiles) S_COMP(c0, c1, tile0 + 64);
            __builtin_amdgcn_sched_barrier(0);
        }
#undef S_LOAD
#undef S_COMP
#pragma unroll
        for (int r = 0; r < 2; ++r)
#pragma unroll
            for (int qi = 0; qi < 2; ++qi) {
                float a = mx[r][qi], c = mn[r][qi];
#pragma unroll
                for (int o = 16; o >= 1; o >>= 1) { a = fmaxf(a, __shfl_xor(a, o)); c = fminf(c, __shfl_xor(c, o)); }
                if (c32 == 0 && a >= c) { const int q = 4 * r + 2 * hh + qi; atomicMin(&meta[q * 2], skey(c)); atomicMax(&meta[q * 2 + 1], skey(a)); }
            }
    }
    __syncthreads();
    const float mnq = big ? skey_inv(meta[wid * 2]) : 0.f, mxq = big ? skey_inv(meta[wid * 2 + 1]) : 0.f;
    attn_wave(p, lds, wid, lane, b, t0 + wid, mnq, mxq);
    __syncthreads();
}

constexpr int NGRP8 = SEQ / 8, ATT_P1 = NGRP8 / 8, ATT_P2 = NGRP8 / 2;
template <int SUB>
__device__ __forceinline__ void ph_mixer(const P& p, unsigned char* lds) {
    int* bc = (int*)(lds + LDS_BYTES - 16);
    constexpr int nh = SUB == 1 ? 64 : NXU;
    constexpr int a0 = SUB == 0 ? 0 : (SUB == 1 ? ATT_P1 : ATT_P2), a1 = SUB == 0 ? ATT_P1 : (SUB == 1 ? ATT_P2 : NGRP8);
    for (;;) {
        __syncthreads();
        if (tid_() == 0) bc[0] = atomicAdd(&p.ctr()[97 + SUB], 1);
        __syncthreads();
        const int it = bc[0];
        if (it >= nh) break;
        if (SUB == 0) hgx_unit(p, lds, it);
        else if (SUB == 1) hgchain_unit(p, it);
        else hgz_unit(p, lds, it);
    }
    const int b0 = (int)(xb_xcc_id() & 3u);
#pragma unroll 1
    for (int k = 0; k < 4; ++k) {
        const int b = (b0 + k) & 3;
        for (;;) {
            __syncthreads();
            if (tid_() == 0) bc[0] = atomicAdd(&p.ctr()[104 + SUB * 4 + b], 1);
            __syncthreads();
            const int it = bc[0];
            if (it >= a1 - a0) break;
            attn8_unit(p, lds, b, NGRP8 - 1 - (a0 + it));
        }
    }
}

__device__ __forceinline__ int tok_row(int tok) { return (tok >> 13) * LP + NMETA + (tok & 8191); }
__device__ __forceinline__ void ph_mix(const P& p, unsigned char* lds) {
    const int njobs = (NTOK / 256) * 4 * 2, G = gridDim.x, b0 = blockIdx.x;
    auto jobidx = [&](int i) __attribute__((always_inline)) { return (b0 + (i >> 1) * G) * 2 + (i & 1); };
    auto jobfn = [&](int i, GJob& j) __attribute__((always_inline)) -> bool {
        const int jb = jobidx(i); if (jb >= njobs) return false;
        const int which = jb & 1, u = jb >> 1, nt = u & 3, mt = u >> 2; const size_t r0 = (size_t)tok_row(mt * 256);
        j.A = (const char*)((which ? p.hgr() : p.att()) + r0 * 512); j.B = (const char*)((which ? p.wuhT() : p.wuaT()) + (size_t)nt * 256 * 512); return true; };
    auto epi = [&](f32x4 (&acc)[2][2][4][2], int i) __attribute__((always_inline)) {
        const int jb = jobidx(i), which = jb & 1, u = jb >> 1, nt = u & 3, mt = u >> 2; const size_t r0 = (size_t)tok_row(mt * 256);
        if (which == 0) {
            EPI8(
                const size_t og = (r0 + row) * 1024 + nt * 256 + col, om = (size_t)(mt * 256 + row) * 1024 + nt * 256 + col;
                const uint2 g = *(const uint2*)(p.ga() + og);
                f32x4 r;
                r[0] = v[0] * __uint_as_float(g.x << 16); r[1] = v[1] * __uint_as_float(g.x & 0xffff0000u);
                r[2] = v[2] * __uint_as_float(g.y << 16); r[3] = v[3] * __uint_as_float(g.y & 0xffff0000u);
                st_bf4(p.mix() + om, r);
            );
        } else {
            EPI8(
                const size_t og = (r0 + row) * 1024 + nt * 256 + col, om = (size_t)(mt * 256 + row) * 1024 + nt * 256 + col;
                const uint2 g = *(const uint2*)(p.gh() + og);
                const uint2 a = *(const uint2*)(p.mix() + om);
                f32x4 r;
                r[0] = __uint_as_float(a.x << 16) + v[0] * __uint_as_float(g.x << 16); r[1] = __uint_as_float(a.x & 0xffff0000u) + v[1] * __uint_as_float(g.x & 0xffff0000u);
                r[2] = __uint_as_float(a.y << 16) + v[2] * __uint_as_float(g.y << 16); r[3] = __uint_as_float(a.y & 0xffff0000u) + v[3] * __uint_as_float(g.y & 0xffff0000u);
                st_bf4(p.mix() + om, r);
            );
        }
    };
    unsigned vbU[2]; gj_lin2(vbU, 512);
    gemm_stream<false>(lds, 512, 512, (size_t)128 * 512 * 2, vbU, jobfn, epi);
}

__device__ __forceinline__ void ph_out(const P& p, unsigned char* lds) {
    const int nunits = (NTOK / 256) * 4, G = gridDim.x, b0 = blockIdx.x;
    auto jobfn = [&](int i, GJob& j) __attribute__((always_inline)) -> bool {
        const int u = b0 + i * G; if (u >= nunits) return false;
        const int nt = u & 3, mt = u >> 2;
        j.A = (const char*)(p.mix() + (size_t)mt * 256 * D); j.B = (const char*)(p.woT() + (size_t)nt * 256 * D); return true; };
    auto epi = [&](f32x4 (&acc)[2][2][4][2], int i) __attribute__((always_inline)) {
        const int u = b0 + i * G, nt = u & 3, mt = u >> 2;
        EPI8(
            const size_t o = (size_t)(mt * 256 + row) * D + nt * 256 + col;
            const f32x4 h0 = *(const f32x4*)(p.x + o);
            *(f32x4*)(p.out + o) = h0 + v;
        );
    };
    unsigned vbU[2]; gj_lin2(vbU, D);
    gemm_stream<false>(lds, D, D, (size_t)128 * D * 2, vbU, jobfn, epi);
}

constexpr int XS_LD = 1025;
__device__ __forceinline__ void ph_route(const P& p, unsigned char* lds) {
    const int tid = tid_(), lane = tid & 63, wid = __builtin_amdgcn_readfirstlane(tid >> 6);
    const int gt = blockIdx.x * NTHREADS + tid, ntot = gridDim.x * NTHREADS;
    for (int i = gt; i < CAP; i += ntot) { p.slot_token()[i] = -1; p.slot_info()[i] = make_int2(-1, 0); }
    float* xs = (float*)lds;
    int* lhist = (int*)(lds + 32 * XS_LD * 4);
    for (int tb = blockIdx.x; tb < NTOK / 128; tb += gridDim.x) {
        if (tid < 32) lhist[tid] = 0;
        for (int tile = 0; tile < 4; ++tile) {
            const int tokt = tb * 128 + tile * 32;
            __syncthreads();
#pragma unroll
            for (int t = 0; t < 4; ++t) {
                const int tl = wid * 4 + t, tok = tokt + tl;
                const float* src = p.out + (size_t)tok * D;
                f32x4 v[4]; float ss = 0.f;
#pragma unroll
                for (int i = 0; i < 4; ++i) { v[i] = *(const f32x4*)(src + lane * 4 + 256 * i); ss += v[i][0] * v[i][0] + v[i][1] * v[i][1] + v[i][2] * v[i][2] + v[i][3] * v[i][3]; }
                ss = wave_sum(ss);
                const float rs = rsqrtf(ss * (1.0f / D) + EPS);
#pragma unroll
                for (int i = 0; i < 4; ++i) {
                    const f32x4 g = *(const f32x4*)(p.ffn_g + lane * 4 + 256 * i);
                    f32x4 xn; xn[0] = v[i][0] * rs * g[0]; xn[1] = v[i][1] * rs * g[1]; xn[2] = v[i][2] * rs * g[2]; xn[3] = v[i][3] * rs * g[3];
                    *(uint32_t*)(p.xn2() + (size_t)tok * D + lane * 4 + 256 * i) = pk4_fp8(xn[0], xn[1], xn[2], xn[3]);
#pragma unroll
                    for (int c = 0; c < 4; ++c) xs[tl * XS_LD + lane * 4 + 256 * i + c] = xn[c];
                }
            }
            __syncthreads();
            f32x16 acc;
#pragma unroll
            for (int i = 0; i < 16; ++i) acc[i] = 0.f;
            {
                const float* xr = xs + (lane & 31) * XS_LD + wid * 128 + (lane >> 5);
                const float* wp = p.router_w + (size_t)(wid * 128 + (lane >> 5)) * 32 + (lane & 31);
#pragma unroll 16
                for (int i = 0; i < 64; ++i) acc = __builtin_amdgcn_mfma_f32_32x32x2f32(xr[2 * i], wp[(size_t)(2 * i) * 32], acc, 0, 0, 0);
            }
            __syncthreads();
#pragma unroll
            for (int r = 0; r < 16; ++r) xs[wid * 1024 + ((r & 3) + 8 * (r >> 2) + 4 * (lane >> 5)) * 32 + (lane & 31)] = acc[r];
            __syncthreads();
            const int e = lane & 31, hh = lane >> 5;
            const float be = p.router_b[e];
#pragma unroll
            for (int it = 0; it < 2; ++it) {
                const int tl = wid * 4 + it * 2 + hh;
                float l = be;
#pragma unroll
                for (int w = 0; w < 8; ++w) l += xs[w * 1024 + tl * 32 + e];
                float bv[4]; int bi[4];
#pragma unroll
                for (int k = 0; k < 4; ++k) {
                    float m = l;
#pragma unroll
                    for (int o = 16; o >= 1; o >>= 1) m = fmaxf(m, __shfl_xor(m, o));
                    const unsigned long long bal = __ballot(l == m);
                    const unsigned half = hh ? (unsigned)(bal >> 32) : (unsigned)bal;
                    const int idx = __builtin_ctz(half);
                    bv[k] = m; bi[k] = idx;
                    if (e == idx) l = -INFINITY;
                }
                const float e1 = __expf(bv[1] - bv[0]), e2 = __expf(bv[2] - bv[0]), e3 = __expf(bv[3] - bv[0]);
                const float inv = 1.0f / (1.0f + e1 + e2 + e3);
                if (e == 0) {
                    const int tok = tokt + tl;
                    p.tok_exp()[tok * 4 + 0] = bi[0]; p.tok_exp()[tok * 4 + 1] = bi[1]; p.tok_exp()[tok * 4 + 2] = bi[2]; p.tok_exp()[tok * 4 + 3] = bi[3];
                    p.tok_gate()[tok * 4 + 0] = inv; p.tok_gate()[tok * 4 + 1] = e1 * inv; p.tok_gate()[tok * 4 + 2] = e2 * inv; p.tok_gate()[tok * 4 + 3] = e3 * inv;
                    atomicAdd(&lhist[bi[0]], 1); atomicAdd(&lhist[bi[1]], 1); atomicAdd(&lhist[bi[2]], 1); atomicAdd(&lhist[bi[3]], 1);
                }
            }
        }
        __syncthreads();
        if (tid < 32) p.wg_cnt()[tb * 32 + tid] = lhist[tid];
        __syncthreads();
    }
    for (long task = gt; task < 96L * 16384; task += ntot) {
        const int mat = (int)(task >> 14), r = (int)(task & 16383), kq = r >> 10, n = r & 1023;
        const int which = mat >> 5, e = mat & 31;
        const float* W = (which == 0 ? p.w_gate : which == 1 ? p.w_up : p.w_down) + (size_t)e * 1048576 + (size_t)(kq * 64) * 1024 + n;
        unsigned char* outp = (which == 0 ? p.wgT() : which == 1 ? p.wuT() : p.wdT()) + (size_t)e * 1048576 + (size_t)n * 1024 + kq * 64;
        float v[64];
#pragma unroll
        for (int i = 0; i < 64; ++i) v[i] = W[(size_t)i * 1024] * 32.0f;
        uint4* dst = (uint4*)outp;
#pragma unroll
        for (int i = 0; i < 4; ++i) dst[i] = make_uint4(pk4_fp8(v[16 * i], v[16 * i + 1], v[16 * i + 2], v[16 * i + 3]), pk4_fp8(v[16 * i + 4], v[16 * i + 5], v[16 * i + 6], v[16 * i + 7]),
                                                        pk4_fp8(v[16 * i + 8], v[16 * i + 9], v[16 * i + 10], v[16 * i + 11]), pk4_fp8(v[16 * i + 12], v[16 * i + 13], v[16 * i + 14], v[16 * i + 15]));
    }
}

__device__ __forceinline__ void ph_fill(const P& p, unsigned char* lds) {
    const int tid = tid_();
    int* tot = (int*)lds;
    int* pre = tot + 512;
    int* ps = pre + 512;
    int* lc = ps + 32;
    for (int tb = blockIdx.x; tb < NTOK / 128; tb += gridDim.x) {
        {
            const int e = tid & 31, part = tid >> 5;
            int t = 0, q = 0;
            for (int b2 = part; b2 < NTOK / 128; b2 += 16) { const int c = p.wg_cnt()[b2 * 32 + e]; t += c; if (b2 < tb) q += c; }
            tot[part * 32 + e] = t; pre[part * 32 + e] = q;
        }
        __syncthreads();
        if (tid == 0) {
            int acc = 0;
            for (int e = 0; e < NE; ++e) {
                int t = 0, q = 0;
                for (int i = 0; i < 16; ++i) { t += tot[i * 32 + e]; q += pre[i * 32 + e]; }
                ps[e] = acc + q; lc[e] = 0;
                const int nb = (t + 255) >> 8;
                if (tb == 0) for (int i = 0; i < nb; ++i) p.block_expert()[(acc >> 8) + i] = e;
                acc += nb * 256;
            }
            if (tb == 0) p.ctr()[96] = acc >> 8;
        }
        __syncthreads();
        {
            const int i = tb * 512 + tid;
            const int e = p.tok_exp()[i];
            const int dest = ps[e] + atomicAdd(&lc[e], 1);
            p.slot_token()[dest] = i >> 2;
            p.slot_rank()[dest] = i & 3;
            p.slot_gate()[dest] = p.tok_gate()[i];
            p.slot_info()[dest] = make_int2((i >> 2) | ((i & 3) << 16), __float_as_int(p.tok_gate()[i]));
        }
        __syncthreads();
    }
}

__device__ __forceinline__ void ph_moe1(const P& p, unsigned char* lds) {
    const int nblocks = p.ctr()[96], G = gridDim.x, b0 = blockIdx.x, bpx = (nblocks + 7) >> 3, bpi = G >> 6, xl = b0 >> 3, xbase = (b0 & 7) * bpx;
    auto unit = [&](int i, int& rb, int& ct) __attribute__((always_inline)) -> bool {
        const int k = i * bpi + (xl >> 3); rb = xbase + k; ct = xl & 7; return k < bpx && rb < nblocks && (xl >> 3) < bpi; };
    auto jobfn = [&](int i, G8Job& j) __attribute__((always_inline)) -> bool {
        int rb, ct; if (!unit(i, rb, ct)) return false;
        const int e = p.block_expert()[rb];
        j.A = (const char*)p.xn2(); j.B = (const char*)(p.wgT() + (size_t)e * 1048576 + (size_t)ct * 128 * 1024);
        const int* st = p.slot_token() + rb * 256; unsigned v[4];
#pragma unroll
        for (int q = 0; q < 4; ++q) { int R, Cb; g8_rc(q, R, Cb); const int t = st[R]; v[q] = (unsigned)((t < 0 ? 0 : t) * 1024 + Cb); }
        j.va0 = v[0]; j.va1 = v[1]; j.va2 = v[2]; j.va3 = v[3]; return true; };
    auto epi = [&](f32x4 (&acc)[2][2][4][2], int i) __attribute__((always_inline)) {
        int rb, ct; unit(i, rb, ct);
        const int e = p.block_expert()[rb];
        const int tid_e = tid_(), lane_e = tid_e & 63, wid_e = tid_e >> 6, wr = wid_e >> 2, wc = wid_e & 3, fr = lane_e & 15, fq = lane_e >> 4;
#pragma unroll
        for (int n = 0; n < 2; ++n) {
            const int c = ct * 128 + wc * 32 + n * 16 + fq * 4;
            const f32x4 bg = *(const f32x4*)(p.b_gate + (size_t)e * DFF + c), bu = *(const f32x4*)(p.b_up + (size_t)e * DFF + c);
#pragma unroll
            for (int ai = 0; ai < 2; ++ai)
#pragma unroll
                for (int m = 0; m < 4; ++m) {
                    const int row = rb * 256 + ai * 128 + wr * 64 + m * 16 + fr;
                    f32x4 a;
#pragma unroll
                    for (int j = 0; j < 4; ++j) {
                        const float g = fminf(acc[ai][0][m][n][j] * 0.03125f + bg[j], 7.0f);
                        const float uu = fminf(fmaxf(acc[ai][1][m][n][j] * 0.03125f + bu[j], -7.0f), 7.0f);
                        a[j] = (uu + 1.0f) * (g * sigmoidf_(1.702f * g));
                    }
                    *(uint32_t*)(p.act() + (size_t)row * DFF + c) = pk4_fp8(a[0], a[1], a[2], a[3]);
                }
        }
    };
    unsigned vbU[4];
#pragma unroll
    for (int q = 0; q < 4; ++q) { int R, Cb; g8_rc(q, R, Cb); vbU[q] = (unsigned)((size_t)(R >> 7) * WE8_B + (size_t)(R & 127) * 1024 + Cb); }
    gemm8_stream<true>(lds, vbU, jobfn, epi);
}
__device__ __forceinline__ void ph_moe2(const P& p, unsigned char* lds) {
    const int nblocks = p.ctr()[96], G = gridDim.x, b0 = blockIdx.x, bpx = (nblocks + 7) >> 3, bpi = G >> 5, xl = b0 >> 3, xbase = (b0 & 7) * bpx;
    auto unit = [&](int i, int& rb, int& nt) __attribute__((always_inline)) -> bool {
        const int k = i * bpi + (xl >> 2); rb = xbase + k; nt = xl & 3; return k < bpx && rb < nblocks && (xl >> 2) < bpi; };
    unsigned vbU[4];
#pragma unroll
    for (int q = 0; q < 4; ++q) { int R, Cb; g8_rc(q, R, Cb); vbU[q] = (unsigned)(R * DFF + Cb); }
    auto jobfn = [&](int i, G8Job& j) __attribute__((always_inline)) -> bool {
        int rb, nt; if (!unit(i, rb, nt)) return false;
        const int e = p.block_expert()[rb];
        j.A = (const char*)(p.act() + (size_t)rb * 256 * DFF); j.B = (const char*)(p.wdT() + (size_t)e * 1048576 + (size_t)nt * 256 * DFF); return true; };
    auto epi = [&](f32x4 (&acc)[2][2][4][2], int i) __attribute__((always_inline)) {
        int rb, nt; unit(i, rb, nt);
        const int e = p.block_expert()[rb];
        const int tid_e = tid_(), lane_e = tid_e & 63, wid_e = tid_e >> 6, wr = wid_e >> 2, wc = wid_e & 3, fr = lane_e & 15, fq = lane_e >> 4;
        f32x4 bd[2][2];
#pragma unroll
        for (int bj = 0; bj < 2; ++bj)
#pragma unroll
            for (int n = 0; n < 2; ++n) bd[bj][n] = *(const f32x4*)(p.b_down + (size_t)e * D + nt * 256 + bj * 128 + wc * 32 + n * 16 + fq * 4);
        int2 info[2][4];
#pragma unroll
        for (int ai = 0; ai < 2; ++ai)
#pragma unroll
            for (int m = 0; m < 4; ++m) info[ai][m] = p.slot_info()[rb * 256 + ai * 128 + wr * 64 + m * 16 + fr];
#pragma unroll
        for (int ai = 0; ai < 2; ++ai)
#pragma unroll
        for (int mp = 0; mp < 2; ++mp) {
            f32x4 old[2][2][2];
#pragma unroll
            for (int mm = 0; mm < 2; ++mm) {
                const int ix = info[ai][mp * 2 + mm].x;
                const size_t o = (size_t)(ix & 0xffff) * D + nt * 256 + wc * 32 + fq * 4;
#pragma unroll
                for (int bj = 0; bj < 2; ++bj)
#pragma unroll
                    for (int n = 0; n < 2; ++n) old[mm][bj][n] = (ix >= 0 && (ix >> 16) == 0) ? *(const f32x4*)(p.out + o + bj * 128 + n * 16) : (f32x4){0.f, 0.f, 0.f, 0.f};
            }
#pragma unroll
            for (int mm = 0; mm < 2; ++mm) {
                const int m = mp * 2 + mm;
                const int ix = info[ai][m].x;
                if (ix < 0) continue;
                const int rank = ix >> 16; const float gate = __int_as_float(info[ai][m].y);
                const size_t o = (size_t)(ix & 0xffff) * D + nt * 256 + wc * 32 + fq * 4;
                if (rank == 0) {
#pragma unroll
                    for (int bj = 0; bj < 2; ++bj)
#pragma unroll
                        for (int n = 0; n < 2; ++n) *(f32x4*)(p.out + o + bj * 128 + n * 16) = old[mm][bj][n] + (acc[ai][bj][m][n] * 0.03125f + bd[bj][n]) * gate;
                } else {
                    bf16_t* yb = rank == 1 ? p.y1() : (rank == 2 ? p.y2() : p.y3());
#pragma unroll
                    for (int bj = 0; bj < 2; ++bj)
#pragma unroll
                        for (int n = 0; n < 2; ++n) st_bf4(yb + o + bj * 128 + n * 16, (acc[ai][bj][m][n] * 0.03125f + bd[bj][n]) * gate);
                }
            }
        }
    };
    gemm8_stream<false>(lds, vbU, jobfn, epi);
}

__device__ __forceinline__ void ph_final(const P& p, unsigned char* lds) {
    const int tid = tid_(), lane = tid & 63, wid = tid >> 6;
    const int gw = blockIdx.x * 8 + wid, nw = gridDim.x * 8;
    for (int tok = gw; tok < NTOK; tok += nw) {
        float* dst = p.out + (size_t)tok * D;
        f32x4 v[4];
#pragma unroll
        for (int i = 0; i < 4; ++i) v[i] = *(const f32x4*)(dst + lane * 4 + 256 * i);
#pragma unroll
        for (int j = 0; j < 3; ++j) {
            const bf16_t* yr = (j == 0 ? p.y1() : j == 1 ? p.y2() : p.y3()) + (size_t)tok * D;
#pragma unroll
            for (int i = 0; i < 4; ++i) {
                const uint2 w = *(const uint2*)(yr + lane * 4 + 256 * i);
                v[i][0] += __uint_as_float(w.x << 16); v[i][1] += __uint_as_float(w.x & 0xffff0000u);
                v[i][2] += __uint_as_float(w.y << 16); v[i][3] += __uint_as_float(w.y & 0xffff0000u);
            }
        }
        float ss = 0.f;
#pragma unroll
        for (int i = 0; i < 4; ++i) ss += v[i][0] * v[i][0] + v[i][1] * v[i][1] + v[i][2] * v[i][2] + v[i][3] * v[i][3];
        ss = wave_sum(ss);
        const float rs = rsqrtf(ss * (1.0f / D) + EPS);
#pragma unroll
        for (int i = 0; i < 4; ++i) {
            const f32x4 g = *(const f32x4*)(p.final_g + lane * 4 + 256 * i);
            *(f32x4*)(dst + lane * 4 + 256 * i) = v[i] * rs * g;
        }
    }
}

typedef const __attribute__((address_space(4))) P* PK;
#define PHASE(call) do { PK q_ = pk; asm volatile("" : "+s"(q_)); const P& p = *(const P*)q_; call; } while (0)
__global__ void __launch_bounds__(NTHREADS) k_mega(P p_unused) {
    __shared__ __attribute__((aligned(16))) unsigned char lds[LDS_BYTES];
    cg::grid_group grid = cg::this_grid();
    const PK pk = (PK)__builtin_amdgcn_kernarg_segment_ptr();
    if (tid_() < 4) ((unsigned*)(lds + LDS_BYTES - 32))[tid_()] = 0u;
    __syncthreads();
    XcdBarrier xb;
    PHASE(xb = xcd_barrier_post((unsigned*)(p.ws + OFF_BAR), (volatile LAS unsigned*)(lds + LDS_BYTES - 32)));
    PHASE(if (p.ws == nullptr) grid.sync());
    PHASE(ph_prep(p, lds)); xcd_barrier(xb);
    PHASE(ph_inproj(p, lds)); xcd_barrier(xb);
    PHASE(ph_mixer<0>(p, lds)); xcd_barrier(xb);
    PHASE(ph_mixer<1>(p, lds)); xcd_barrier(xb);
    PHASE(ph_mixer<2>(p, lds)); xcd_barrier(xb);
    PHASE(ph_mix(p, lds)); xcd_barrier(xb);
    PHASE(ph_out(p, lds)); xcd_barrier(xb);
    PHASE(ph_route(p, lds)); xcd_barrier(xb);
    PHASE(ph_fill(p, lds)); xcd_barrier(xb);
    PHASE(ph_moe1(p, lds)); xcd_barrier(xb);
    PHASE(ph_moe2(p, lds)); xcd_barrier(xb);
    PHASE(ph_final(p, lds));
}

extern "C" void kernel_launch(void* const* d_in, const int* in_sizes, int n_in, void* d_out, int out_size, void* d_ws, size_t ws_size,
                              hipStream_t stream) {
    P p{};
    p.x = (const float*)d_in[0]; p.meta = (const float*)d_in[1]; p.attn_g = (const float*)d_in[2]; p.w_in = (const float*)d_in[3];
    p.hgrn_g = (const float*)d_in[4]; p.w_ua = (const float*)d_in[5]; p.w_uh = (const float*)d_in[6]; p.w_out = (const float*)d_in[7];
    p.lb_logits = (const float*)d_in[8]; p.ffn_g = (const float*)d_in[9]; p.router_w = (const float*)d_in[10]; p.router_b = (const float*)d_in[11];
    p.w_gate = (const float*)d_in[12]; p.b_gate = (const float*)d_in[13]; p.w_up = (const float*)d_in[14]; p.b_up = (const float*)d_in[15];
    p.w_down = (const float*)d_in[16]; p.b_down = (const float*)d_in[17]; p.final_g = (const float*)d_in[18];
    p.out = (float*)d_out;
    p.ws = (unsigned char*)d_ws;
    if (WS_NEED > ws_size) { fprintf(stderr, "workspace too small: need %zu have %zu\n", (size_t)WS_NEED, ws_size); return; }
    static int grid_blocks = 0;
    if (!grid_blocks) {
        int dev = 0, cus = 0, per_cu = 0;
        hipGetDevice(&dev);
        hipDeviceGetAttribute(&cus, hipDeviceAttributeMultiprocessorCount, dev);
        hipOccupancyMaxActiveBlocksPerMultiprocessor(&per_cu, k_mega, NTHREADS, 0);
        if (per_cu > 1) per_cu = 1;
        grid_blocks = cus * per_cu;
    }
    hipMemsetAsync(p.ws + OFF_BAR, 0, XCD_BAR_WORDS * 4, stream);
    void* args[] = {&p};
    hipError_t e = hipLaunchCooperativeKernel((void*)k_mega, dim3(grid_blocks), dim3(NTHREADS), args, 0, stream);
    if (e != hipSuccess) fprintf(stderr, "cooperative launch failed: %s (grid %d)\n", hipGetErrorString(e), grid_blocks);
}
```

```cpp
#include <hip/hip_runtime.h>
#include <hip/hip_cooperative_groups.h>
#include <stdint.h>
#include <cstdio>
namespace cg = cooperative_groups;

#ifndef MEGA
#define MEGA 1
#endif

typedef unsigned short bf16_t;
typedef short bf16x8 __attribute__((ext_vector_type(8)));
typedef float f32x4 __attribute__((ext_vector_type(4)));

constexpr int D = 1024, NB = 4, SEQ = 8192, NMETA = 16, L = SEQ + NMETA  , LP = 8320, T = NB * LP  ;
constexpr int NTOK = NB * SEQ;
constexpr int IN_COLS = 5160;
constexpr int NE = 32, TOPK = 4, DFF = 1024;
constexpr int CAP_BLOCKS = (NTOK * TOPK) / 256 + NE;
constexpr int CAP = CAP_BLOCKS * 256;
constexpr float EPS = 1e-5f;
constexpr int NTHREADS = 512;
constexpr int LDS_BYTES = 155648;
constexpr int NVC = 5376;
#define LAS __attribute__((address_space(3)))

__device__ __forceinline__ bf16_t f2bf(float f) {
    uint32_t u = __float_as_uint(f);
    u += 0x7fffu + ((u >> 16) & 1u);
    return (bf16_t)(u >> 16);
}
__device__ __forceinline__ float bf2f(bf16_t h) { return __uint_as_float(((uint32_t)h) << 16); }
__device__ __forceinline__ uint32_t pack2(float a, float b) { return (uint32_t)f2bf(a) | ((uint32_t)f2bf(b) << 16); }
__device__ __forceinline__ uint32_t pk4_fp8(float a, float b, float c, float d) {
    a = fminf(fmaxf(a, -448.f), 448.f); b = fminf(fmaxf(b, -448.f), 448.f); c = fminf(fmaxf(c, -448.f), 448.f); d = fminf(fmaxf(d, -448.f), 448.f);
    int w = __builtin_amdgcn_cvt_pk_fp8_f32(a, b, 0, false); w = __builtin_amdgcn_cvt_pk_fp8_f32(c, d, w, true); return (uint32_t)w;
}
__device__ __forceinline__ float sigmoidf_(float x) { return __builtin_amdgcn_rcpf(1.0f + __builtin_amdgcn_exp2f(-1.4426950408889634f * x)); }
__device__ __forceinline__ float wave_sum(float v) {
#pragma unroll
    for (int o = 32; o >= 1; o >>= 1) v += __shfl_xor(v, o);
    return v;
}
__device__ __forceinline__ float wave_max(float v) {
#pragma unroll
    for (int o = 32; o >= 1; o >>= 1) v = fmaxf(v, __shfl_xor(v, o));
    return v;
}

constexpr size_t al256(size_t x) { return (x + 255) & ~(size_t)255; }
constexpr size_t TT = (size_t)T;
constexpr size_t MB1 = 1024 * 1024;
constexpr size_t WE8_B = (size_t)NE * 1024 * 1024;
constexpr size_t OFF_WGT = 0, OFF_WUT = WE8_B, OFF_WDT = 2 * WE8_B, OFF_XN2 = 3 * WE8_B, OFF_ACT = OFF_XN2 + (size_t)NTOK * D,
                 OFF_Y1 = OFF_ACT + (size_t)CAP * DFF, OFF_Y2 = OFF_Y1 + (size_t)NTOK * D * 2, OFF_Y3 = OFF_Y2 + (size_t)NTOK * D * 2,
                 OFF_S2_END = OFF_Y3 + (size_t)NTOK * D * 2;
constexpr size_t OFF_WIN = 0, OFF_WUA = OFF_WIN + (size_t)NVC * 1024 * 2, OFF_WUH = OFF_WUA + MB1, OFF_WO = OFF_WUH + MB1, OFF_XN = OFF_WO + 2 * MB1,
                 OFF_Q = OFF_XN + TT * 2048, OFF_K = OFF_Q + TT * 1024, OFF_V = OFF_K + TT * 256, OFF_IQ = OFF_V + TT * 256, OFF_IK = OFF_IQ + TT * 512,
                 OFF_IW = OFF_IK + TT * 64, OFF_HQ = OFF_IW + TT * 32, OFF_HF = OFF_HQ + TT * 1024, OFF_HI = OFF_HF + TT * 1024, OFF_HG = OFF_HI + TT * 1024,
                 OFF_GA = OFF_HG + TT * 1024, OFF_GH = OFF_GA + TT * 2048, OFF_ATT = OFF_GH + TT * 2048, OFF_HGR = OFF_ATT + TT * 1024,
                 OFF_S1_END = OFF_HGR + TT * 1024;
static_assert(2 * WE8_B >= (size_t)NTOK * D * 2, "y0 does not fit over the gate/up weights");
constexpr size_t OFF_MIX = OFF_XN;
constexpr size_t OFF_TAB = OFF_S1_END > OFF_S2_END ? OFF_S1_END : OFF_S2_END;
constexpr size_t OFF_ROPE = OFF_TAB, OFF_LB = OFF_ROPE + al256((size_t)LP * 24 * 4), OFF_CTR = OFF_LB + al256(512 * 4),
                 OFF_BEXP = OFF_CTR + al256(128 * 4), OFF_SLOT = OFF_BEXP + al256((size_t)CAP_BLOCKS * 4), OFF_SRANK = OFF_SLOT + al256((size_t)CAP * 4),
                 OFF_SGATE = OFF_SRANK + al256((size_t)CAP * 4), OFF_TEXP = OFF_SGATE + al256((size_t)CAP * 4), OFF_TGATE = OFF_TEXP + al256((size_t)NTOK * 16),
                 OFF_BAR = OFF_TGATE + al256((size_t)NTOK * 16), OFF_WGC = OFF_BAR + al256(3456 * 4), OFF_SINFO = OFF_WGC + al256(256 * 32 * 4), WS_NEED = OFF_SINFO + al256((size_t)CAP * 8);


__device__ __forceinline__ int tid_() { int t = threadIdx.x; asm volatile("" : "+v"(t)); return t; }

struct P {
    const float *x, *meta, *attn_g, *w_in, *hgrn_g, *w_ua, *w_uh, *w_out, *lb_logits, *ffn_g, *router_w, *router_b,
        *w_gate, *b_gate, *w_up, *b_up, *w_down, *b_down, *final_g;
    float* out;
    unsigned char* ws;
#define WSF(type, name, off) __device__ __forceinline__ type* name() const { return (type*)(ws + (off)); }
    WSF(bf16_t, xn, OFF_XN) WSF(unsigned char, xn8, OFF_ATT) WSF(unsigned char, winT8, OFF_WIN) WSF(bf16_t, winTb, OFF_WIN + 6 * MB1) WSF(bf16_t, q, OFF_Q) WSF(bf16_t, k, OFF_K) WSF(bf16_t, v, OFF_V) WSF(bf16_t, iq, OFF_IQ) WSF(bf16_t, ik, OFF_IK)
    WSF(bf16_t, hq, OFF_HQ) WSF(bf16_t, hf, OFF_HF) WSF(bf16_t, hi, OFF_HI) WSF(bf16_t, hg, OFF_HG) WSF(bf16_t, ga, OFF_GA) WSF(bf16_t, gh, OFF_GH)
    WSF(bf16_t, att, OFF_ATT) WSF(bf16_t, hgr, OFF_HGR) WSF(bf16_t, mix, OFF_MIX) WSF(unsigned char, xn2, OFF_XN2) WSF(unsigned char, act, OFF_ACT)
    WSF(bf16_t, y0, OFF_WGT) WSF(bf16_t, y1, OFF_Y1) WSF(bf16_t, y2, OFF_Y2) WSF(bf16_t, y3, OFF_Y3)
    WSF(bf16_t, winT, OFF_WIN) WSF(bf16_t, wuaT, OFF_WUA) WSF(bf16_t, wuhT, OFF_WUH) WSF(bf16_t, woT, OFF_WO)
    WSF(unsigned char, wgT, OFF_WGT) WSF(unsigned char, wuT, OFF_WUT) WSF(unsigned char, wdT, OFF_WDT)
    WSF(float, iw, OFF_IW) WSF(float, rope, OFF_ROPE) WSF(float, lb, OFF_LB) WSF(float, tok_gate, OFF_TGATE) WSF(float, slot_gate, OFF_SGATE)
    WSF(int, ctr, OFF_CTR)
    WSF(int, wg_cnt, OFF_WGC) WSF(int2, slot_info, OFF_SINFO) WSF(int, block_expert, OFF_BEXP) WSF(int, slot_token, OFF_SLOT) WSF(int, slot_rank, OFF_SRANK) WSF(int, tok_exp, OFF_TEXP)
};

template <class ColMap>
__device__ __forceinline__ void convert_T8(const float* W, int ldw, unsigned char* out, int K, int N, const ColMap& cmap, float scale, int gt, int ntot) {
    const int kb = K / 64; const long ntask = (long)N * kb;
    for (long task = gt; task < ntask; task += ntot) {
        const int kq = (int)(task / N), n = (int)(task % N);
        const int c = cmap(n);
        uint32_t w[16];
        if (c >= 0) {
            const float* src = W + (size_t)(kq * 64) * ldw + c;
            float v[64];
#pragma unroll
            for (int i = 0; i < 64; ++i) v[i] = src[(size_t)i * ldw] * scale;
#pragma unroll
            for (int i = 0; i < 16; ++i) w[i] = pk4_fp8(v[4 * i], v[4 * i + 1], v[4 * i + 2], v[4 * i + 3]);
        } else {
#pragma unroll
            for (int i = 0; i < 16; ++i) w[i] = 0u;
        }
        uint4* dst = (uint4*)(out + (size_t)n * K + kq * 64);
#pragma unroll
        for (int i = 0; i < 4; ++i) dst[i] = make_uint4(w[4 * i], w[4 * i + 1], w[4 * i + 2], w[4 * i + 3]);
    }
}
template <class ColMap>
__device__ __forceinline__ void convert_T(const float* W, int ldw, bf16_t* out, int K, int N, const ColMap& cmap, int gt, int ntot) {
    const int kb = K / 64; const long ntask = (long)N * kb;
    for (long task = gt; task < ntask; task += ntot) {
        const int kq = (int)(task / N), n = (int)(task % N);
        const int c = cmap(n);
        uint32_t w[32];
        if (c >= 0) {
            const float* src = W + (size_t)(kq * 64) * ldw + c;
            float v[64];
#pragma unroll
            for (int i = 0; i < 64; ++i) v[i] = src[(size_t)i * ldw];
#pragma unroll
            for (int i = 0; i < 32; ++i) w[i] = pack2(v[2 * i], v[2 * i + 1]);
        } else {
#pragma unroll
            for (int i = 0; i < 32; ++i) w[i] = 0u;
        }
        uint4* dst = (uint4*)(out + (size_t)n * K + kq * 64);
#pragma unroll
        for (int i = 0; i < 8; ++i) dst[i] = make_uint4(w[4 * i], w[4 * i + 1], w[4 * i + 2], w[4 * i + 3]);
    }
}
struct IdMap { __device__ __forceinline__ int operator()(int n) const { return n; } };
struct WinMap { __device__ __forceinline__ int operator()(int n) const { return n < 1064 ? n : (n < 1280 ? -1 : n - 216); } };
struct WinMapIdx { __device__ __forceinline__ int operator()(int n) const { return WinMap{}(768 + n); } };

#define XB_TMO      128
#define XB_XCNT(j)  (256  + 64 * (j))
#define XB_XSUB(j)  (1280 + 64 * (j))
#define XB_XGEN(j)  (2304 + 64 * (j))
#define XB_TOP      3328
#define XB_TOPGEN   3392
#define XCD_BAR_WORDS 3456
#define XB_SPIN_CAP (1u << 22)
__device__ __forceinline__ unsigned xb_ld(unsigned* p)              { return __hip_atomic_load(p, __ATOMIC_RELAXED, __HIP_MEMORY_SCOPE_AGENT); }
__device__ __forceinline__ unsigned xb_add(unsigned* p, unsigned v) { return __hip_atomic_fetch_add(p, v, __ATOMIC_RELAXED, __HIP_MEMORY_SCOPE_AGENT); }
__device__ __forceinline__ unsigned xb_xcc_id() { return (unsigned)__builtin_amdgcn_s_getreg((3 << 11) | 20) & 0xFu; }
#define XB_SPIN(cond, bar) do { unsigned _sp = 0; while (cond) { __builtin_amdgcn_s_sleep(1); \
    if ((++_sp & 255u) == 0u) { if (xb_ld(&(bar)[XB_TMO])) break; if (_sp > XB_SPIN_CAP) { atomicAdd(&(bar)[XB_TMO], 1u); break; } } } } while (0)
struct XcdBarrier { unsigned* bar; unsigned x; volatile LAS unsigned* st; };
__device__ __forceinline__ XcdBarrier xcd_barrier_post(unsigned* bar, volatile LAS unsigned* st) {
    XcdBarrier b; b.bar = bar; b.x = xb_xcc_id(); b.st = st;
    if (threadIdx.x == 0) (void)xb_add(&bar[XB_XCNT(b.x)], 1u);
    return b;
}
__device__ __forceinline__ void xcd_barrier_complete(unsigned* bar, unsigned x, unsigned& nloc, unsigned& nx) {
    const unsigned G = gridDim.x * gridDim.y * gridDim.z;
    unsigned sum, cnt, mine, sp = 0u;
    for (;;) {
        sum = 0u; cnt = 0u; mine = 0u;
#pragma unroll
        for (unsigned j = 0; j < 16; ++j) { const unsigned c = xb_ld(&bar[XB_XCNT(j)]); sum += c; cnt += (c > 0u) ? 1u : 0u; mine = (j == x) ? c : mine; }
        if (sum == G) break;
        __builtin_amdgcn_s_sleep(1);
        if ((++sp & 255u) == 0u) { if (xb_ld(&bar[XB_TMO])) break; if (sp > XB_SPIN_CAP) { atomicAdd(&bar[XB_TMO], 1u); break; } }
    }
    nloc = mine > 0u ? mine : 1u; nx = cnt > 0u ? cnt : 1u;
}
__device__ __forceinline__ void xcd_barrier(const XcdBarrier& b) {
    asm volatile("s_waitcnt vmcnt(0)" ::: "memory");
    __syncthreads();
    if (threadIdx.x == 0) {
        unsigned* bar = b.bar;
        __builtin_amdgcn_s_waitcnt(0);
        unsigned nloc = b.st[0], nx = b.st[1];
        if (nloc == 0u) { xcd_barrier_complete(bar, b.x, nloc, nx); b.st[0] = nloc; b.st[1] = nx; }
        const unsigned old = xb_add(&bar[XB_XSUB(b.x)], 1u);
        const unsigned gen = old / nloc;
        if (old + 1u == (gen + 1u) * nloc) {
            __builtin_amdgcn_fence(__ATOMIC_RELEASE, "agent");
            asm volatile("s_waitcnt vmcnt(0)" ::: "memory");
            const unsigned og = xb_add(&bar[XB_TOP], 1u);
            const unsigned tg = og / nx;
            if (og + 1u == (tg + 1u) * nx) xb_add(&bar[XB_TOPGEN], 1u);
            else XB_SPIN(xb_ld(&bar[XB_TOPGEN]) == tg, bar);
            __builtin_amdgcn_fence(__ATOMIC_ACQUIRE, "agent");
            xb_add(&bar[XB_XGEN(b.x)], 1u);
            asm volatile("s_waitcnt vmcnt(0)" ::: "memory");
        } else {
            XB_SPIN(xb_ld(&bar[XB_XGEN(b.x)]) == gen, bar);
            __builtin_amdgcn_fence(__ATOMIC_ACQUIRE, "agent");
            asm volatile("s_waitcnt vmcnt(0)" ::: "memory");
        }
    }
    __syncthreads();
}

__device__ __forceinline__ void ph_prep(const P& p, unsigned char* lds) {
    const int tid = tid_(), lane = tid & 63, wid = tid >> 6;
    const int gw = blockIdx.x * 8 + wid, nw = gridDim.x * 8;
    for (int r = gw; r < T; r += nw) {
        const int b = r / LP, pos = r % LP;
        unsigned char* dst = p.xn8() + (size_t)r * D; bf16_t* dstb = p.xn() + (size_t)r * D;
        if (pos >= L) {
#pragma unroll
            for (int i = 0; i < 4; ++i) { *(uint32_t*)(dst + lane * 4 + 256 * i) = 0u; *(uint2*)(dstb + lane * 4 + 256 * i) = make_uint2(0u, 0u); }
            continue;
        }
        const float* src = pos < NMETA ? p.meta + (size_t)pos * D : p.x + ((size_t)b * SEQ + (pos - NMETA)) * D;
        f32x4 v[4]; float ss = 0.f;
#pragma unroll
        for (int i = 0; i < 4; ++i) { v[i] = *(const f32x4*)(src + lane * 4 + 256 * i); ss += v[i][0] * v[i][0] + v[i][1] * v[i][1] + v[i][2] * v[i][2] + v[i][3] * v[i][3]; }
        ss = wave_sum(ss);
        const float rs = rsqrtf(ss * (1.0f / D) + EPS);
#pragma unroll
        for (int i = 0; i < 4; ++i) {
            const f32x4 g = *(const f32x4*)(p.attn_g + lane * 4 + 256 * i);
            const float y0 = v[i][0] * rs * g[0], y1 = v[i][1] * rs * g[1], y2 = v[i][2] * rs * g[2], y3 = v[i][3] * rs * g[3];
            *(uint32_t*)(dst + lane * 4 + 256 * i) = pk4_fp8(y0, y1, y2, y3);
            uint2 o; o.x = pack2(y0, y1); o.y = pack2(y2, y3);
            *(uint2*)(dstb + lane * 4 + 256 * i) = o;
        }
    }
    const int gt = blockIdx.x * NTHREADS + tid, nt = gridDim.x * NTHREADS;
    for (int i = gt; i < LP * 12; i += nt) {
        const int pos = i / 12, f = i % 12;
        const double ex = f < 8 ? -(double)f / 8.0 : -(double)(f - 8) / 4.0;
        const double inv = exp(ex * log(500000.0));
        const double ang = (double)pos * inv;
        const double twopi = 6.283185307179586476925286766559;
        const double r = ang - twopi * rint(ang / twopi);
        const float rf = (float)r;
        const float c = cosf(rf), s = sinf(rf);
        float* row = p.rope() + (size_t)pos * 24;
        if (f < 8) { row[f] = c; row[8 + f] = s; } else { row[16 + f - 8] = c; row[20 + f - 8] = s; }
    }
    for (int i = gt; i < 512; i += nt) {
        const float a = p.lb_logits[i], b2 = p.lb_logits[512 + i];
        p.lb()[i] = 1.0f / (1.0f + expf(b2 - a));
    }
    for (int i = gt; i < 128; i += nt) p.ctr()[i] = 0;
    convert_T8(p.w_in, IN_COLS, p.winT8(), 1024, NVC, WinMap{}, 32.0f, gt, nt);
    convert_T(p.w_in, IN_COLS, p.winTb(), 1024, 512, WinMapIdx{}, gt, nt);
    convert_T(p.w_ua, 1024, p.wuaT(), 512, 1024, IdMap{}, gt, nt);
    convert_T(p.w_uh, 1024, p.wuhT(), 512, 1024, IdMap{}, gt, nt);
    convert_T(p.w_out, 1024, p.woT(), 1024, 1024, IdMap{}, gt, nt);
}
constexpr int G_TILE_B = 256 * 64 * 2, G_STAGE_B = 2 * G_TILE_B;
__device__ __forceinline__ int g_lds_byte(int r, int c) { const int st = (r >> 4) * 2 + (c >> 5), ob = (r & 15) * 64 + (c & 31) * 2; return st * 1024 + (ob ^ (((ob >> 9) & 1) << 5)); }
__device__ __forceinline__ void g_stage_rc(int b, int& R, int& C) { const int st = b >> 10, sb = b & 1023, swz = sb ^ (((sb >> 9) & 1) << 5); R = (st >> 1) * 16 + swz / 64; C = (st & 1) * 32 + (swz % 64) / 2; }

constexpr int HTB = 128 * 64 * 2;
struct GJob { const char* A; const char* B; unsigned va00, va01, va10, va11; };
__device__ __forceinline__ void gj_lin(unsigned (&v)[2][2], int ld) {
#pragma unroll
    for (int h = 0; h < 2; ++h)
#pragma unroll
        for (int i = 0; i < 2; ++i) { int R, C; g_stage_rc(tid_() * 16 + i * 8192, R, C); v[h][i] = (unsigned)(((h * 128 + R) * ld + C) * 2); }
}
template <class AOff>
__device__ __forceinline__ void gj_gather(unsigned (&v)[2][2], const AOff& aoff) {
#pragma unroll
    for (int h = 0; h < 2; ++h)
#pragma unroll
        for (int i = 0; i < 2; ++i) { int R, C; g_stage_rc(tid_() * 16 + i * 8192, R, C); v[h][i] = (unsigned)((aoff(h * 128 + R) + C) * 2); }
}
template <class AOff>
__device__ __forceinline__ void gj_gather_job(GJob& j, const AOff& aoff) {
    unsigned v[2][2]; gj_gather(v, aoff); j.va00 = v[0][0]; j.va01 = v[0][1]; j.va10 = v[1][0]; j.va11 = v[1][1];
}
template <bool GATHER, class JobFn, class Epi>
__device__ __forceinline__ void gemm_stream(unsigned char* lds_, int K, int lda, size_t hstepB, const unsigned (&vbU)[2], const JobFn& jobfn, const Epi& epi) {
    LAS unsigned char* lds = (LAS unsigned char*)lds_;
    const int tid = tid_(), wid = __builtin_amdgcn_readfirstlane(tid >> 6), lane = tid & 63, wr = wid >> 2, wc = wid & 3, fr = lane & 15, fq = lane >> 4;
    const int nt = K / 64;
    const size_t kstep = 128;
    const size_t hstepA = GATHER ? 0 : (size_t)128 * lda * 2;
    const unsigned ldsw = (unsigned)wid * 1024u;
    const int aoff = g_lds_byte(wr * 64 + fr, fq * 8), boff = g_lds_byte(wc * 32 + fr, fq * 8);
    unsigned vaU[2];
#pragma unroll
    for (int i = 0; i < 2; ++i) { int R, C; g_stage_rc(tid * 16 + i * 8192, R, C); vaU[i] = (unsigned)((R * lda + C) * 2); }
#define PG8_SA(b, h) (((b) * 2 + (h)) * HTB)
#define PG8_SB(b, h) ((4 + (b) * 2 + (h)) * HTB)
#define PG8_STAGE2(bufoff, gbase, v0, v1) do { \
        __builtin_amdgcn_global_load_lds((const unsigned*)((const char*)(gbase) + (v0)), (LAS unsigned*)(lds + (bufoff) + ldsw), 16, 0, 0); \
        __builtin_amdgcn_global_load_lds((const unsigned*)((const char*)(gbase) + (v1)), (LAS unsigned*)(lds + (bufoff) + ldsw + 8192), 16, 0, 0); } while (0)
#define STB(bufoff, gbase, h) PG8_STAGE2(bufoff, (gbase) + ((h) ? hstepB : 0), vbU[0], vbU[1])
#define STA_CUR(bufoff, gbase, h) do { if (GATHER) PG8_STAGE2(bufoff, gbase, (h) ? cur.va10 : cur.va00, (h) ? cur.va11 : cur.va01); else PG8_STAGE2(bufoff, (gbase) + ((h) ? hstepA : 0), vaU[0], vaU[1]); } while (0)
#define STA_SEL(bufoff, gbase, h) do { if (GATHER) PG8_STAGE2(bufoff, gbase, last ? ((h) ? nxt.va10 : nxt.va00) : ((h) ? cur.va10 : cur.va00), last ? ((h) ? nxt.va11 : nxt.va01) : ((h) ? cur.va11 : cur.va01)); \
        else PG8_STAGE2(bufoff, (gbase) + ((h) ? hstepA : 0), vaU[0], vaU[1]); } while (0)
#define PG8_LDA(dst, b, h) do { _Pragma("unroll") for (int m = 0; m < 4; ++m) _Pragma("unroll") for (int k = 0; k < 2; ++k) dst[m][k] = *(const LAS bf16x8*)(lds + PG8_SA(b, h) + aoff + m * 2048 + k * 1024); } while (0)
#define PG8_LDB(dst, b, h) do { _Pragma("unroll") for (int n = 0; n < 2; ++n) _Pragma("unroll") for (int k = 0; k < 2; ++k) dst[n][k] = *(const LAS bf16x8*)(lds + PG8_SB(b, h) + boff + n * 2048 + k * 1024); } while (0)
#define PG8_MMA(ai, bj, At, Bt) do { __builtin_amdgcn_s_setprio(1); _Pragma("unroll") for (int m = 0; m < 4; ++m) _Pragma("unroll") for (int n = 0; n < 2; ++n) _Pragma("unroll") for (int k = 0; k < 2; ++k) \
        acc[ai][bj][m][n] = __builtin_amdgcn_mfma_f32_16x16x32_bf16(Bt[n][k], At[m][k], acc[ai][bj][m][n], 0, 0, 0); __builtin_amdgcn_s_setprio(0); } while (0)
#define PG8_WAIT_V(n) asm volatile("s_waitcnt vmcnt(" #n ")" ::: "memory")
#define PG8_WAIT_L(n) asm volatile("s_waitcnt lgkmcnt(" #n ")" ::: "memory")
#define PG8_BAR __builtin_amdgcn_s_barrier()
#define PG8_SCHED __builtin_amdgcn_sched_barrier(0)
    GJob cur, nxt; int ui = 0;
    cur.A = nullptr; cur.B = nullptr; cur.va00 = cur.va01 = cur.va10 = cur.va11 = 0u; nxt = cur;
    if (!jobfn(0, cur)) return;
    f32x4 acc[2][2][4][2];
#pragma unroll
    for (int a = 0; a < 2; ++a)
#pragma unroll
        for (int b = 0; b < 2; ++b)
#pragma unroll
            for (int m = 0; m < 4; ++m)
#pragma unroll
                for (int n = 0; n < 2; ++n) acc[a][b][m][n] = (f32x4){0.f, 0.f, 0.f, 0.f};
    bf16x8 At[4][2], B0[2][2], B1[2][2];
    STB(PG8_SB(0, 0), cur.B, 0); STB(PG8_SB(0, 1), cur.B, 1); STA_CUR(PG8_SA(0, 0), cur.A, 0); STA_CUR(PG8_SA(0, 1), cur.A, 1);
    if (wr == 1) PG8_BAR;
    PG8_WAIT_V(2); PG8_BAR;
    STB(PG8_SB(1, 0), cur.B + kstep, 0); STA_CUR(PG8_SA(1, 0), cur.A + kstep, 0); STB(PG8_SB(1, 1), cur.B + kstep, 1);
    PG8_WAIT_V(6); PG8_BAR;
    for (;;) {
        bool has_next = false;
        for (int t = 0; t < nt; t += 2) {
            const bool last = (t == nt - 2);
            if (last) { has_next = jobfn(ui + 1, nxt); if (!has_next) nxt = cur; }
            const char* a1 = cur.A + (size_t)(t + 1) * kstep;
            const char* a2 = last ? nxt.A : cur.A + (size_t)(t + 2) * kstep; const char* b2 = last ? nxt.B : cur.B + (size_t)(t + 2) * kstep;
            const char* a3 = a2 + kstep; const char* b3 = b2 + kstep;
            PG8_LDB(B0, 0, 0); PG8_LDB(B1, 0, 1); PG8_SCHED; PG8_LDA(At, 0, 0); STA_CUR(PG8_SA(1, 1), a1, 1);
            PG8_WAIT_V(8); PG8_WAIT_L(0); PG8_BAR; PG8_MMA(0, 0, At, B0); PG8_MMA(0, 1, At, B1); PG8_BAR; PG8_SCHED;
            PG8_LDA(At, 0, 1); STB(PG8_SB(0, 0), b2, 0); STB(PG8_SB(0, 1), b2, 1); STA_SEL(PG8_SA(0, 0), a2, 0);
            PG8_WAIT_V(8); PG8_WAIT_L(0); PG8_BAR; PG8_MMA(1, 0, At, B0); PG8_MMA(1, 1, At, B1); PG8_BAR; PG8_SCHED;
            PG8_LDB(B0, 1, 0); PG8_LDB(B1, 1, 1); PG8_SCHED; PG8_LDA(At, 1, 0); STA_SEL(PG8_SA(0, 1), a2, 1);
            PG8_WAIT_V(8); PG8_WAIT_L(0); PG8_BAR; PG8_MMA(0, 0, At, B0); PG8_MMA(0, 1, At, B1); PG8_BAR; PG8_SCHED;
            PG8_LDA(At, 1, 1); STB(PG8_SB(1, 0), b3, 0); STB(PG8_SB(1, 1), b3, 1); STA_SEL(PG8_SA(1, 0), a3, 0);
            PG8_WAIT_V(8); PG8_WAIT_L(0); PG8_BAR; PG8_MMA(1, 0, At, B0); PG8_MMA(1, 1, At, B1); PG8_BAR; PG8_SCHED;
        }
        if (wr == 0) PG8_BAR;
        epi(acc, ui);
        if (!has_next) break;
#pragma unroll
        for (int a = 0; a < 2; ++a)
#pragma unroll
            for (int b = 0; b < 2; ++b)
#pragma unroll
                for (int m = 0; m < 4; ++m)
#pragma unroll
                    for (int n = 0; n < 2; ++n) acc[a][b][m][n] = (f32x4){0.f, 0.f, 0.f, 0.f};
        cur = nxt; ++ui;
        if (wr == 1) PG8_BAR;
    }
    PG8_WAIT_V(0);
    PG8_BAR;
#undef PG8_SA
#undef PG8_SB
#undef PG8_STAGE2
#undef STB
#undef STA_CUR
#undef STA_SEL
#undef PG8_LDA
#undef PG8_LDB
#undef PG8_MMA
#undef PG8_WAIT_V
#undef PG8_WAIT_L
#undef PG8_BAR
#undef PG8_SCHED
}
__device__ __forceinline__ void gj_lin2(unsigned (&v)[2], int ld) {
#pragma unroll
    for (int i = 0; i < 2; ++i) { int R, C; g_stage_rc(tid_() * 16 + i * 8192, R, C); v[i] = (unsigned)((R * ld + C) * 2); }
}
typedef int i32x8 __attribute__((ext_vector_type(8)));
typedef unsigned u32x4 __attribute__((ext_vector_type(4)));
struct G8Job { const char* A; const char* B; unsigned va0, va1, va2, va3; };
__device__ __forceinline__ void g8_rc(int i, int& R, int& Cb) { int C; g_stage_rc(tid_() * 16 + i * 8192, R, C); Cb = C * 2; }
__device__ __forceinline__ const char* uni_ptr8(const char* p) {
    const unsigned long long v = (unsigned long long)p;
    const unsigned lo = __builtin_amdgcn_readfirstlane((unsigned)v), hi = __builtin_amdgcn_readfirstlane((unsigned)(v >> 32));
    return (const char*)(((unsigned long long)hi << 32) | lo);
}
template <bool GATHER, class JobFn, class Epi>
__device__ __forceinline__ void gemm8_stream(unsigned char* lds_, const unsigned (&vbU)[4], const JobFn& jobfn, const Epi& epi) {
    LAS unsigned char* lds = (LAS unsigned char*)lds_;
    const int tid = tid_(), wid = __builtin_amdgcn_readfirstlane(tid >> 6), lane = tid & 63, wr = wid >> 2, wc = wid & 3, fr = lane & 15, fq = lane >> 4;
    LAS unsigned char* a0p = lds + g_lds_byte(wr * 64 + fr, fq * 8); LAS unsigned char* a1p = a0p + 65536;
    LAS unsigned char* b0p = lds + 32768 + g_lds_byte(wc * 32 + fr, fq * 8); LAS unsigned char* b1p = b0p + 65536;
    const unsigned ldsw_u = __builtin_amdgcn_readfirstlane((unsigned)(size_t)(lds + wid * 1024));
#define G8_GLDS(base, voff, ldsaddr) asm volatile("s_mov_b32 m0, %2\n\ts_nop 0\n\tglobal_load_lds_dwordx4 %0, %1" :: "v"(voff), "s"(base), "s"(ldsaddr) : "memory", "m0")
#define G8_DMA(JA, JB, v0, v1, v2, v3, buf, kt) do { \
        const char* pa_ = uni_ptr8(JA) + (kt) * 128; const char* pb_ = uni_ptr8(JB) + (kt) * 128; const unsigned d_ = ldsw_u + (buf) * 65536; \
        G8_GLDS(pa_, (GATHER ? v0 : vb0), d_); \
        G8_GLDS(pa_, (GATHER ? v1 : vb1), d_ + 8192); \
        G8_GLDS(pa_, (GATHER ? v2 : vb2), d_ + 16384); \
        G8_GLDS(pa_, (GATHER ? v3 : vb3), d_ + 24576); \
        G8_GLDS(pb_, vb0, d_ + 32768); \
        G8_GLDS(pb_, vb1, d_ + 32768 + 8192); \
        G8_GLDS(pb_, vb2, d_ + 32768 + 16384); \
        G8_GLDS(pb_, vb3, d_ + 32768 + 24576); } while (0)
#define G8_LD(dst, ptr) do { const u32x4 x0_ = *(const LAS u32x4*)(ptr), x1_ = *(const LAS u32x4*)((ptr) + 1024); \
        dst = (i32x8){(int)x0_.x, (int)x0_.y, (int)x0_.z, (int)x0_.w, (int)x1_.x, (int)x1_.y, (int)x1_.z, (int)x1_.w}; } while (0)
#define G8_LDA(dst, ap, ai, m0, m1) do { _Pragma("unroll") for (int m = m0; m < m1; ++m) G8_LD(dst[m], (ap) + (ai) * 16384 + m * 2048); } while (0)
#define G8_LDB(dst, bp, bj) do { _Pragma("unroll") for (int n = 0; n < 2; ++n) G8_LD(dst[n], (bp) + (bj) * 16384 + n * 2048); } while (0)
#define G8_MMA(ai, bj, At, Bt) do { __builtin_amdgcn_sched_barrier(0); __builtin_amdgcn_s_setprio(1); _Pragma("unroll") for (int m = 0; m < 4; ++m) _Pragma("unroll") for (int n = 0; n < 2; ++n) \
        asm("v_mfma_scale_f32_16x16x128_f8f6f4 %0, %1, %2, %0, %3, %3 op_sel_hi:[0,0,0]" : "+v"(acc[ai][bj][m][n]) : "v"(Bt[n]), "v"(At[m]), "v"(unit_scale)); \
        __builtin_amdgcn_s_setprio(0); __builtin_amdgcn_sched_barrier(0); } while (0)
#define G8_PF 2
#define G8_TILE(buf, ap, bp, apn, bpn, X, Y, kt) do { \
        G8_LDA(P, ap, 0, G8_PF, 4); G8_LDB(Y, bp, 1); G8_MMA(0, 0, P, X); \
        G8_LDA(Q, ap, 1, 0, 2);                       G8_MMA(0, 1, P, Y); \
        G8_LDA(Q, ap, 1, 2, 4);                       G8_MMA(1, 1, Q, Y); \
        asm volatile("" ::: "memory"); __builtin_amdgcn_s_waitcnt(0x0070); __builtin_amdgcn_s_barrier(); asm volatile("" ::: "memory"); \
        asm volatile("" : "+v"(vb0), "+v"(vb1), "+v"(vb2), "+v"(vb3), "+v"(cur.va0), "+v"(cur.va1), "+v"(cur.va2), "+v"(cur.va3)); \
        G8_DMA(selA, selB, cur.va0, cur.va1, cur.va2, cur.va3, buf, kt); \
        G8_LDA(P, apn, 0, 0, G8_PF); G8_LDB(Y, bpn, 0); \
        G8_MMA(1, 0, Q, X); } while (0)
    G8Job cur, nxt;
    cur.A = nullptr; cur.B = nullptr; cur.va0 = cur.va1 = cur.va2 = cur.va3 = 0u; nxt = cur;
    if (!jobfn(0, cur)) return;
    cur.A = uni_ptr8(cur.A); cur.B = uni_ptr8(cur.B);
    unsigned vb0 = vbU[0], vb1 = vbU[1], vb2 = vbU[2], vb3 = vbU[3];
    G8_DMA(cur.A, cur.B, cur.va0, cur.va1, cur.va2, cur.va3, 0, 0); G8_DMA(cur.A, cur.B, cur.va0, cur.va1, cur.va2, cur.va3, 1, 1);
    asm volatile("s_waitcnt vmcnt(0)" ::: "memory");
    __syncthreads();
    int ui = 0;
    for (;;) {
        f32x4 acc[2][2][4][2];
#pragma unroll
        for (int a = 0; a < 2; ++a)
#pragma unroll
            for (int b = 0; b < 2; ++b)
#pragma unroll
                for (int m = 0; m < 4; ++m)
#pragma unroll
                    for (int n = 0; n < 2; ++n) acc[a][b][m][n] = (f32x4){0.f, 0.f, 0.f, 0.f};
        const bool has_next = jobfn(ui + 1, nxt);
        nxt.A = uni_ptr8(nxt.A); nxt.B = uni_ptr8(nxt.B);
        if (!has_next) nxt = cur;
        i32x8 P[4], Q[4], X[2], Y[2];
        const int unit_scale = 0x7f7f7f7f;
        G8_LDA(P, a0p, 0, 0, G8_PF); G8_LDB(X, b0p, 0);
#pragma unroll 1
        for (int t2 = 0; t2 < 4; ++t2) {
            const bool lastp = t2 == 3;
            const char* selA = lastp ? nxt.A : cur.A; const char* selB = lastp ? nxt.B : cur.B;
            if (GATHER) { cur.va0 = lastp ? nxt.va0 : cur.va0; cur.va1 = lastp ? nxt.va1 : cur.va1; cur.va2 = lastp ? nxt.va2 : cur.va2; cur.va3 = lastp ? nxt.va3 : cur.va3; }
            const int kt0 = lastp ? 0 : 2 * t2 + 2;
            asm volatile("" : "+v"(a0p), "+v"(a1p), "+v"(b0p), "+v"(b1p));
            G8_TILE(0, a0p, b0p, a1p, b1p, X, Y, kt0);
            G8_TILE(1, a1p, b1p, a0p, b0p, Y, X, kt0 + 1);
        }
        asm volatile("s_nop 15\n\ts_nop 15" ::: "memory");
        epi(acc, ui);
        if (!has_next) break;
        cur.A = nxt.A; cur.B = nxt.B; ++ui;
    }
#undef G8_TILE
#undef G8_PF
#undef G8_MMA
#undef G8_LDB
#undef G8_LDA
#undef G8_LD
#undef G8_DMA
#undef G8_GLDS
    __syncthreads();
}
struct RowLin { size_t base; int ld; __device__ __forceinline__ size_t operator()(int R) const { return base + (size_t)R * ld; } };

__device__ __forceinline__ void st_bf4(bf16_t* dst, f32x4 v) {
    uint2 o; o.x = pack2(v[0], v[1]); o.y = pack2(v[2], v[3]); *(uint2*)dst = o;
}
#define EPI8(...) do { const int tid_e = tid_(), lane_e = tid_e & 63, wid_e = tid_e >> 6, wr = wid_e >> 2, wc = wid_e & 3, fr = lane_e & 15, fq = lane_e >> 4; \
    _Pragma("unroll") for (int ai = 0; ai < 2; ++ai) _Pragma("unroll") for (int m = 0; m < 4; ++m) _Pragma("unroll") for (int bj = 0; bj < 2; ++bj) _Pragma("unroll") for (int n = 0; n < 2; ++n) { \
        const int row = ai * 128 + wr * 64 + m * 16 + fr, col = bj * 128 + wc * 32 + n * 16 + fq * 4; const f32x4 v = acc[ai][bj][m][n]; __VA_ARGS__ } } while (0)

struct EpiInproj {
    const P* p; int nt;
    __device__ __forceinline__ void operator()(int m, int n, int fq, f32x4 v) const {
        const P& P_ = *p;
        const int pos = m % LP;
        const float* rp = P_.rope() + (size_t)pos * 24;
        if (nt <= 2) {
            const bool isv = (nt == 2) && (n >= 128);
            if (!isv && (n & 48) == 0) {
                f32x4 pr;
#pragma unroll
                for (int j = 0; j < 4; ++j) pr[j] = __shfl_xor(v[j], 32);
                const int i0 = (fq & 1) * 4;
#pragma unroll
                for (int j = 0; j < 4; ++j) {
                    const float c = rp[i0 + j], s = rp[8 + i0 + j];
                    v[j] = fq < 2 ? v[j] * c - pr[j] * s : v[j] * c + pr[j] * s;
                }
            }
            if (nt < 2) { st_bf4(P_.q() + (size_t)m * 512 + nt * 256 + n, v * (0.125f * 1.4426950408889634f)); }
            else if (n < 128) st_bf4(P_.k() + (size_t)m * 128 + n, v);
            else st_bf4(P_.v() + (size_t)m * 128 + (n - 128), v);
        } else if (nt == 3 || nt == 4) {
            const bool ropeable = (nt == 3) ? ((n & 16) == 0) : (n < 16);
            if (ropeable) {
                f32x4 pr;
#pragma unroll
                for (int j = 0; j < 4; ++j) pr[j] = __shfl_xor(v[j], 16);
                if (fq < 2) {
#pragma unroll
                    for (int j = 0; j < 4; ++j) {
                        const float c = rp[16 + j], s = rp[20 + j];
                        v[j] = fq == 0 ? v[j] * c - pr[j] * s : v[j] * c + pr[j] * s;
                    }
                }
            }
            if (nt == 3) st_bf4(P_.iq() + (size_t)m * 256 + n, v);
            else if (n < 32) st_bf4(P_.ik() + (size_t)m * 32 + n, v);
            else if (n < 40) *(f32x4*)(P_.iw() + (size_t)m * 8 + (n - 32)) = v;
        } else if (nt <= 6) { st_bf4(P_.hq() + (size_t)m * 512 + (nt - 5) * 256 + n, v * 0.08838834764831845f); }
        else if (nt <= 8) { st_bf4(P_.hf() + (size_t)m * 512 + (nt - 7) * 256 + n, v); }
        else if (nt <= 10) { st_bf4(P_.hi() + (size_t)m * 512 + (nt - 9) * 256 + n, v); }
        else if (nt <= 12) {
            f32x4 o;
#pragma unroll
            for (int j = 0; j < 4; ++j) o[j] = v[j] * sigmoidf_(v[j]);
            st_bf4(P_.hg() + (size_t)m * 512 + (nt - 11) * 256 + n, o);
        } else {
            f32x4 o;
#pragma unroll
            for (int j = 0; j < 4; ++j) o[j] = sigmoidf_(v[j]);
            if (nt <= 16) st_bf4(P_.ga() + (size_t)m * 1024 + (nt - 13) * 256 + n, o);
            else st_bf4(P_.gh() + (size_t)m * 1024 + (nt - 17) * 256 + n, o);
        }
    }
};

__device__ __forceinline__ void ph_inproj(const P& p, unsigned char* lds) {
    const int G = gridDim.x, b0 = blockIdx.x;
    {
        const int nunits = (T / 256) * 2;
        auto jobfn = [&](int i, GJob& j) __attribute__((always_inline)) -> bool {
            const int u = b0 + i * G; if (u >= nunits) return false;
            const int nt = 3 + (u & 1), mt = u >> 1;
            j.A = (const char*)(p.xn() + (size_t)mt * 256 * D); j.B = (const char*)(p.winTb() + (size_t)(nt - 3) * 256 * D); return true; };
        auto epi = [&](f32x4 (&acc)[2][2][4][2], int i) __attribute__((always_inline)) {
            const int u = b0 + i * G, nt = 3 + (u & 1), mt = u >> 1;
            const EpiInproj e{&p, nt};
            EPI8( e(mt * 256 + row, col, fq, v); );
        };
        unsigned vbU[2]; gj_lin2(vbU, D);
        gemm_stream<false>(lds, D, D, (size_t)128 * D * 2, vbU, jobfn, epi);
    }
    {
        const int nunits = (T / 256) * 19, br = G - 1 - b0;
        auto jobfn = [&](int i, G8Job& j) __attribute__((always_inline)) -> bool {
            const int u = br + i * G; if (u >= nunits) return false;
            const int n19 = u % 19, nt = n19 < 3 ? n19 : n19 + 2, mt = u / 19;
            j.A = (const char*)(p.xn8() + (size_t)mt * 256 * D); j.B = (const char*)(p.winT8() + (size_t)nt * 256 * D); return true; };
        auto epi = [&](f32x4 (&acc)[2][2][4][2], int i) __attribute__((always_inline)) {
            const int u = br + i * G, n19 = u % 19, nt = n19 < 3 ? n19 : n19 + 2, mt = u / 19;
            const EpiInproj e{&p, nt};
            EPI8( e(mt * 256 + row, col, fq, v * 0.03125f); );
        };
        unsigned vbU[4];
#pragma unroll
        for (int q = 0; q < 4; ++q) { int R, Cb; g8_rc(q, R, Cb); vbU[q] = (unsigned)(R * D + Cb); }
        gemm8_stream<false>(lds, vbU, jobfn, epi);
    }
}
constexpr int NCH = 129, NXU = 16 * NCH;
constexpr int X_QT = 0, X_KT = X_QT + 64 * 272, X_KH = X_KT + 64 * 272, X_VT = X_KH + 128 * 144, X_AS = X_VT + 128 * 144, X_SEG = X_AS + 64 * 144;
__device__ __forceinline__ bf16_t* hg_ds(const P& p) { return (bf16_t*)p.out; }
__device__ __forceinline__ float* hg_g(const P& p) { return (float*)((unsigned char*)p.out + (size_t)NXU * 32768); }

__device__ __forceinline__ void hgx_unit(const P& p, unsigned char* lds, int u) {
    const int tid = tid_(), lane = tid & 63, wid = tid >> 6, fr = lane & 15, fq = lane >> 4;
    const int c = u % NCH, bh = u / NCH, b = bh >> 2, h = bh & 3;
    const int d = tid & 127, seg = tid >> 7;
    const size_t rowbase = (size_t)(b * LP + c * 64 + seg * 16) * 512 + h * 128 + d;
    bf16_t* hqp = p.hq() + rowbase; const bf16_t* hfp = p.hf() + rowbase; const bf16_t* hip = p.hi() + rowbase;
    const float lbv = p.lb()[h * 128 + d];
    float bb[16], qv[16], kk[16], vv[16];
    float cs = 0.f;
#pragma unroll
    for (int i = 0; i < 16; ++i) {
        const float f = lbv + (1.0f - lbv) * sigmoidf_(bf2f(hfp[(size_t)i * 512]));
        kk[i] = 1.0f - f; cs += __logf(f); bb[i] = cs;
        qv[i] = bf2f(hqp[(size_t)i * 512]); vv[i] = bf2f(hip[(size_t)i * 512]);
    }
    float* segs = (float*)(lds + X_SEG);
    segs[seg * 128 + d] = cs;
    __syncthreads();
    const float s0 = segs[d], s1 = segs[128 + d], s2 = segs[256 + d], s3 = segs[384 + d];
    const float off = seg == 0 ? 0.f : (seg == 1 ? s0 : (seg == 2 ? s0 + s1 : s0 + s1 + s2));
    const float rref = s0 + s1, blast = (s0 + s1) + (s2 + s3);
    uint32_t khp[8], vtp[8];
#pragma unroll
    for (int i = 0; i < 16; i += 2) {
        float khv[2];
#pragma unroll
        for (int j = 0; j < 2; ++j) {
            const float bt = bb[i + j] + off;
            const float eq = __expf(fminf(bt - rref, 80.f)), ek = __expf(fminf(rref - bt, 80.f));
            const int t = seg * 16 + i + j;
            *(bf16_t*)(lds + X_QT + t * 272 + d * 2) = f2bf(qv[i + j] * eq);
            *(bf16_t*)(lds + X_KT + t * 272 + d * 2) = f2bf(kk[i + j] * ek);
            hqp[(size_t)(i + j) * 512] = f2bf(qv[i + j] * __expf(bt));
            khv[j] = kk[i + j] * __expf(blast - bt);
        }
        khp[i >> 1] = pack2(khv[0], khv[1]); vtp[i >> 1] = pack2(vv[i], vv[i + 1]);
    }
    *(uint4*)(lds + X_KH + d * 144 + seg * 32) = make_uint4(khp[0], khp[1], khp[2], khp[3]);
    *(uint4*)(lds + X_KH + d * 144 + seg * 32 + 16) = make_uint4(khp[4], khp[5], khp[6], khp[7]);
    *(uint4*)(lds + X_VT + d * 144 + seg * 32) = make_uint4(vtp[0], vtp[1], vtp[2], vtp[3]);
    *(uint4*)(lds + X_VT + d * 144 + seg * 32 + 16) = make_uint4(vtp[4], vtp[5], vtp[6], vtp[7]);
    if (seg == 0) hg_g(p)[(size_t)u * 128 + d] = __expf(blast);
    __syncthreads();
    {
        const int tm = wid >> 1, tn0 = (wid & 1) * 2;
        f32x4 a1[2] = {(f32x4){0.f, 0.f, 0.f, 0.f}, (f32x4){0.f, 0.f, 0.f, 0.f}};
#pragma unroll
        for (int ks = 0; ks < 4; ++ks) {
            const bf16x8 aq = *(const bf16x8*)(lds + X_QT + (tm * 16 + fr) * 272 + (ks * 32 + fq * 8) * 2);
#pragma unroll
            for (int j = 0; j < 2; ++j) {
                const bf16x8 bk = *(const bf16x8*)(lds + X_KT + ((tn0 + j) * 16 + fr) * 272 + (ks * 32 + fq * 8) * 2);
                a1[j] = __builtin_amdgcn_mfma_f32_16x16x32_bf16(bk, aq, a1[j], 0, 0, 0);
            }
        }
#pragma unroll
        for (int j = 0; j < 2; ++j) {
            const int t = tm * 16 + fr, sb = (tn0 + j) * 16 + fq * 4;
            f32x4 v = a1[j];
#pragma unroll
            for (int jj = 0; jj < 4; ++jj) v[jj] = (sb + jj <= t) ? v[jj] : 0.f;
            uint2 o; o.x = pack2(v[0], v[1]); o.y = pack2(v[2], v[3]);
            *(uint2*)(lds + X_AS + t * 144 + sb * 2) = o;
        }
    }
    __syncthreads();
    {
        const int tm = wid >> 1, en0 = (wid & 1) * 4;
        f32x4 o2[4];
#pragma unroll
        for (int j = 0; j < 4; ++j) o2[j] = (f32x4){0.f, 0.f, 0.f, 0.f};
#pragma unroll
        for (int ks = 0; ks < 2; ++ks) {
            const bf16x8 aa = *(const bf16x8*)(lds + X_AS + (tm * 16 + fr) * 144 + (ks * 32 + fq * 8) * 2);
#pragma unroll
            for (int j = 0; j < 4; ++j) {
                const bf16x8 bv = *(const bf16x8*)(lds + X_VT + ((en0 + j) * 16 + fr) * 144 + (ks * 32 + fq * 8) * 2);
                o2[j] = __builtin_amdgcn_mfma_f32_16x16x32_bf16(bv, aa, o2[j], 0, 0, 0);
            }
        }
        bf16_t* orow = p.hf() + (size_t)(b * LP + c * 64 + tm * 16 + fr) * 512 + h * 128;
#pragma unroll
        for (int j = 0; j < 4; ++j) st_bf4(orow + (en0 + j) * 16 + fq * 4, o2[j]);
    }
    {
        f32x4 s3[8];
#pragma unroll
        for (int j = 0; j < 8; ++j) s3[j] = (f32x4){0.f, 0.f, 0.f, 0.f};
#pragma unroll
        for (int ks = 0; ks < 2; ++ks) {
            const bf16x8 ak = *(const bf16x8*)(lds + X_KH + (wid * 16 + fr) * 144 + (ks * 32 + fq * 8) * 2);
#pragma unroll
            for (int j = 0; j < 8; ++j) {
                const bf16x8 bv = *(const bf16x8*)(lds + X_VT + (j * 16 + fr) * 144 + (ks * 32 + fq * 8) * 2);
                s3[j] = __builtin_amdgcn_mfma_f32_16x16x32_bf16(ak, bv, s3[j], 0, 0, 0);
            }
        }
        bf16_t* dsb = hg_ds(p) + (size_t)u * 16384;
#pragma unroll
        for (int j = 0; j < 8; ++j) st_bf4(dsb + (size_t)(j * 16 + fr) * 128 + wid * 16 + fq * 4, s3[j]);
    }
    __syncthreads();
}

__device__ __forceinline__ void hgchain_unit(const P& p, int item) {
    const int tid = tid_(), bh = item >> 2, eq = item & 3;
    const int e = eq * 32 + (tid >> 4), d0 = (tid & 15) * 8;
    float S[8];
#pragma unroll
    for (int i = 0; i < 8; ++i) S[i] = 0.f;
    uint4* ptr = (uint4*)(hg_ds(p) + ((size_t)(bh * NCH) * 128 + e) * 128 + d0);
    const f32x4* gp = (const f32x4*)(hg_g(p) + (size_t)(bh * NCH) * 128 + d0);
    uint4 wq[8]; f32x4 g0[8], g1[8];
#pragma unroll
    for (int k = 0; k < 8; ++k) { wq[k] = ptr[(size_t)k * 2048]; g0[k] = gp[k * 32]; g1[k] = gp[k * 32 + 1]; }
    for (int c0 = 0; c0 < NCH; c0 += 8) {
#pragma unroll
        for (int k = 0; k < 8; ++k) {
            const int c = c0 + k;
            if (c < NCH) {
                const uint4 w = wq[k]; const f32x4 ga = g0[k], gb = g1[k];
                if (c + 8 < NCH) { wq[k] = ptr[(size_t)(c + 8) * 2048]; g0[k] = gp[(c + 8) * 32]; g1[k] = gp[(c + 8) * 32 + 1]; }
                ptr[(size_t)c * 2048] = make_uint4(pack2(S[0], S[1]), pack2(S[2], S[3]), pack2(S[4], S[5]), pack2(S[6], S[7]));
                S[0] = ga[0] * S[0] + __uint_as_float(w.x << 16); S[1] = ga[1] * S[1] + __uint_as_float(w.x & 0xffff0000u);
                S[2] = ga[2] * S[2] + __uint_as_float(w.y << 16); S[3] = ga[3] * S[3] + __uint_as_float(w.y & 0xffff0000u);
                S[4] = gb[0] * S[4] + __uint_as_float(w.z << 16); S[5] = gb[1] * S[5] + __uint_as_float(w.z & 0xffff0000u);
                S[6] = gb[2] * S[6] + __uint_as_float(w.w << 16); S[7] = gb[3] * S[7] + __uint_as_float(w.w & 0xffff0000u);
            }
        }
    }
}

__device__ __forceinline__ void hgz_unit(const P& p, unsigned char* lds, int u) {
    const int tid = tid_(), lane = tid & 63, wid = tid >> 6, fr = lane & 15, fq = lane >> 4;
    const int c = u % NCH, bh = u / NCH, b = bh >> 2, h = bh & 3;
    const int tm = wid >> 1, en0 = (wid & 1) * 4;
    const size_t row = (size_t)(b * LP + c * 64 + tm * 16 + fr);
    const bf16_t* qrow = p.hq() + row * 512 + h * 128;
    const bf16_t* sT = hg_ds(p) + (size_t)u * 16384;
    f32x4 o[4];
#pragma unroll
    for (int j = 0; j < 4; ++j) o[j] = (f32x4){0.f, 0.f, 0.f, 0.f};
#pragma unroll
    for (int ks = 0; ks < 4; ++ks) {
        const bf16x8 aq = *(const bf16x8*)(qrow + ks * 32 + fq * 8);
#pragma unroll
        for (int j = 0; j < 4; ++j) {
            const bf16x8 bs = *(const bf16x8*)(sT + (size_t)((en0 + j) * 16 + fr) * 128 + ks * 32 + fq * 8);
            o[j] = __builtin_amdgcn_mfma_f32_16x16x32_bf16(bs, aq, o[j], 0, 0, 0);
        }
    }
    const bf16_t* oi = p.hf() + row * 512 + h * 128;
    float ss = 0.f;
#pragma unroll
    for (int j = 0; j < 4; ++j) {
        const uint2 w = *(const uint2*)(oi + (en0 + j) * 16 + fq * 4);
        o[j][0] += __uint_as_float(w.x << 16); o[j][1] += __uint_as_float(w.x & 0xffff0000u);
        o[j][2] += __uint_as_float(w.y << 16); o[j][3] += __uint_as_float(w.y & 0xffff0000u);
        ss += o[j][0] * o[j][0] + o[j][1] * o[j][1] + o[j][2] * o[j][2] + o[j][3] * o[j][3];
    }
    ss += __shfl_xor(ss, 16); ss += __shfl_xor(ss, 32);
    float* part = (float*)lds;
    if (fq == 0) part[(tm * 16 + fr) * 2 + (wid & 1)] = ss;
    __syncthreads();
    const float tot = part[(tm * 16 + fr) * 2] + part[(tm * 16 + fr) * 2 + 1];
    const float rs = rsqrtf(tot * (1.0f / 128.0f) + EPS);
    const bf16_t* hgp = p.hg() + row * 512 + h * 128;
    bf16_t* outp = p.hgr() + row * 512 + h * 128;
#pragma unroll
    for (int j = 0; j < 4; ++j) {
        const int e0 = (en0 + j) * 16 + fq * 4;
        const f32x4 gn = *(const f32x4*)(p.hgrn_g + h * 128 + e0);
        const uint2 w = *(const uint2*)(hgp + e0);
        f32x4 r;
        r[0] = o[j][0] * rs * gn[0] * __uint_as_float(w.x << 16); r[1] = o[j][1] * rs * gn[1] * __uint_as_float(w.x & 0xffff0000u);
        r[2] = o[j][2] * rs * gn[2] * __uint_as_float(w.y << 16); r[3] = o[j][3] * rs * gn[3] * __uint_as_float(w.y & 0xffff0000u);
        st_bf4(outp + e0, r);
    }
    __syncthreads();
}

typedef float f32x16 __attribute__((ext_vector_type(16)));
typedef short s16x4 __attribute__((ext_vector_type(4)));

constexpr int NKMAX = 8224;
constexpr int NBIN = 1024;
constexpr int A_SC = 0, A_H1 = A_SC + 4 * NKMAX * 4, A_SEL = A_H1 + 4 * NBIN * 4, A_CAND = A_SEL + 2048, A_META = A_CAND + 1024, A_END = A_META + 256;
static_assert(A_END <= LDS_BYTES - 16, "attention LDS");
__device__ __forceinline__ uint32_t skey(float f) { const uint32_t u = __float_as_uint(f); return (u & 0x80000000u) ? ~u : (u | 0x80000000u); }
__device__ __forceinline__ float skey_inv(uint32_t k) { return __uint_as_float((k & 0x80000000u) ? (k & 0x7fffffffu) : ~k); }
__device__ __forceinline__ int bin1(float s, float lo, float scale) { return min(NBIN - 1, max(0, (int)((s - lo) * scale))); }
template <int OFF> __device__ __forceinline__ s16x4 tr_read(unsigned addr) {
    s16x4 r; asm volatile("ds_read_b64_tr_b16 %0, %1 offset:%2" : "=&v"(r) : "v"(addr), "i"(OFF) : "memory"); return r;
}
__device__ __forceinline__ void scan_top(const int* hist, int K, int* m, int lane) {
    int c[16];
#pragma unroll
    for (int i = 0; i < 4; ++i) { const int4 v = *(const int4*)(hist + 16 * lane + 4 * i); c[4 * i] = v.x; c[4 * i + 1] = v.y; c[4 * i + 2] = v.z; c[4 * i + 3] = v.w; }
    int tot = 0;
#pragma unroll
    for (int i = 0; i < 16; ++i) tot += c[i];
    int suf = tot;
#pragma unroll
    for (int o = 1; o < 64; o <<= 1) { const int t = __shfl_down(suf, o); if (lane + o < 64) suf += t; }
    int above = suf - tot;
#pragma unroll
    for (int i = 15; i >= 0; --i) {
        if (above < K && K <= above + c[i]) { m[0] = 16 * lane + i; m[1] = above; m[2] = c[i]; }
        above += c[i];
    }
}

__device__ __forceinline__ void attn4_unit(const P& p, unsigned char* lds, int b, int grp) {
    const int tid = tid_(), lane = tid & 63, wid = __builtin_amdgcn_readfirstlane(tid >> 6);
    const int t0 = NMETA + 4 * grp;
    const int brow = b * LP, row0 = brow + t0;
    float* sc = (float*)(lds + A_SC);
    int* h1 = (int*)(lds + A_H1);
    unsigned short* sel = (unsigned short*)(lds + A_SEL); unsigned short* cand = (unsigned short*)(lds + A_CAND);
    int* meta = (int*)(lds + A_META);
    const bool big = t0 + 1 > 256;
    for (int i = tid; i < 4 * NBIN; i += NTHREADS) h1[i] = 0;
    if (tid < 64) { const int w = tid & 15; meta[tid] = (w == 0) ? -1 : 0; }
    if (!big) { for (int i = tid; i < 1024; i += NTHREADS) { const int q = i >> 8, j = i & 255; sel[i] = (unsigned short)(j <= t0 + q ? j : 0); } }
    __syncthreads();
    if (big) {
        {
            const int hh = lane >> 5, c32 = lane & 31;
            const int g = c32 >> 3, h2a = (c32 >> 2) & 1, bq = c32 & 3, aq = 2 * h2a + (g >> 1), ah = 4 * (g & 1) + bq;
            const bf16_t* ap = p.iq() + (size_t)(row0 + aq) * 256 + ah * 32 + 8 * hh;
            const bf16x8 a0 = *(const bf16x8*)ap, a1 = *(const bf16x8*)(ap + 16);
            const f32x4 w00 = *(const f32x4*)(p.iw() + (size_t)(row0 + 2 * hh) * 8), w01 = *(const f32x4*)(p.iw() + (size_t)(row0 + 2 * hh) * 8 + 4);
            const f32x4 w10 = *(const f32x4*)(p.iw() + (size_t)(row0 + 2 * hh + 1) * 8), w11 = *(const f32x4*)(p.iw() + (size_t)(row0 + 2 * hh + 1) * 8 + 4);
            const int ntiles = (t0 + 4 + 31) >> 5;
            const int tq0 = t0 + 2 * hh;
            float mx0 = -INFINITY, mn0 = INFINITY, mx1 = -INFINITY, mn1 = INFINITY;
            const bf16_t* kbase = p.ik() + (size_t)brow * 32 + 8 * hh;
            for (int tile0 = wid; tile0 < ntiles; tile0 += 128) {
                bf16x8 b0[16], b1[16];
#pragma unroll
                for (int j = 0; j < 16; ++j) {
                    const int tile = min(tile0 + 8 * j, ntiles - 1);
                    const bf16_t* kp = kbase + (size_t)(tile * 32 + c32) * 32;
                    b0[j] = *(const bf16x8*)kp; b1[j] = *(const bf16x8*)(kp + 16);
                }
                __builtin_amdgcn_sched_barrier(0);
#pragma unroll
                for (int j = 0; j < 16; ++j) {
                    const int tile = tile0 + 8 * j;
                    if (tile < ntiles) {
                        const int key = tile * 32 + c32;
                        f32x16 acc;
#pragma unroll
                        for (int i = 0; i < 16; ++i) acc[i] = 0.f;
                        acc = __builtin_amdgcn_mfma_f32_32x32x16_bf16(a0, b0[j], acc, 0, 0, 0);
                        acc = __builtin_amdgcn_mfma_f32_32x32x16_bf16(a1, b1[j], acc, 0, 0, 0);
                        float s0 = 0.f, s1 = 0.f;
#pragma unroll
                        for (int i = 0; i < 4; ++i) {
                            s0 += w00[i] * fmaxf(acc[i], 0.f) + w01[i] * fmaxf(acc[4 + i], 0.f);
                            s1 += w10[i] * fmaxf(acc[8 + i], 0.f) + w11[i] * fmaxf(acc[12 + i], 0.f);
                        }
                        sc[(2 * hh) * NKMAX + key] = s0; sc[(2 * hh + 1) * NKMAX + key] = s1;
                        if (key <= tq0) { mx0 = fmaxf(mx0, s0); mn0 = fminf(mn0, s0); }
                        if (key <= tq0 + 1) { mx1 = fmaxf(mx1, s1); mn1 = fminf(mn1, s1); }
                    }
                }
            }
#pragma unroll
            for (int o = 16; o >= 1; o >>= 1) {
                mx0 = fmaxf(mx0, __shfl_xor(mx0, o)); mn0 = fminf(mn0, __shfl_xor(mn0, o));
                mx1 = fmaxf(mx1, __shfl_xor(mx1, o)); mn1 = fminf(mn1, __shfl_xor(mn1, o));
            }
            if (c32 == 0) {
                if (mx0 >= mn0) { atomicMin((unsigned*)&meta[(2 * hh) * 16 + 0], skey(mn0)); atomicMax((unsigned*)&meta[(2 * hh) * 16 + 1], skey(mx0)); }
                if (mx1 >= mn1) { atomicMin((unsigned*)&meta[(2 * hh + 1) * 16 + 0], skey(mn1)); atomicMax((unsigned*)&meta[(2 * hh + 1) * 16 + 1], skey(mx1)); }
            }
        }
        __syncthreads();
        const int q = wid & 3, part = wid >> 2, n = t0 + q + 1;
        const float lo = skey_inv((unsigned)meta[q * 16 + 0]), hi = skey_inv((unsigned)meta[q * 16 + 1]);
        const float scale = hi > lo ? (float)NBIN / (hi - lo) : 0.f;
        const float* scq = sc + q * NKMAX;
        for (int base = part * 256; base < n; base += 512) {
            const int idx0 = base + lane * 4;
            if (idx0 < n) {
                const f32x4 v = *(const f32x4*)(scq + idx0);
#pragma unroll
                for (int j = 0; j < 4; ++j) if (idx0 + j < n) atomicAdd(&h1[q * NBIN + bin1(v[j], lo, scale)], 1);
            }
        }
        __syncthreads();
        if (wid < 4) scan_top(h1 + wid * NBIN, 256, meta + wid * 16 + 4, lane);
        __syncthreads();
        const int B1 = meta[q * 16 + 4];
        for (int base = part * 256; base < n; base += 512) {
            const int idx0 = base + lane * 4;
            f32x4 v = (f32x4){0.f, 0.f, 0.f, 0.f};
            if (idx0 < n) v = *(const f32x4*)(scq + idx0);
            const unsigned long long lt = (1ull << lane) - 1ull;
#pragma unroll
            for (int j = 0; j < 4; ++j) {
                const int idx = idx0 + j;
                bool issel = false, iscand = false;
                if (idx < n) { const int b1 = bin1(v[j], lo, scale); issel = b1 > B1; iscand = b1 == B1; }
                const unsigned long long ms = __ballot(issel), mc = __ballot(iscand);
                if (ms) {
                    int bs = 0; if (lane == 0) bs = atomicAdd(&meta[q * 16 + 2], __popcll(ms));
                    bs = __shfl(bs, 0);
                    if (issel) sel[q * 256 + bs + __popcll(ms & lt)] = (unsigned short)idx;
                }
                if (mc) {
                    int bs = 0; if (lane == 0) bs = atomicAdd(&meta[q * 16 + 3], __popcll(mc));
                    bs = __shfl(bs, 0);
                    const int pos = bs + __popcll(mc & lt);
                    if (iscand && pos < 128) cand[q * 128 + pos] = (unsigned short)idx;
                }
            }
        }
        __syncthreads();
        if (wid < 4) {
            const int qq = wid; const float* scr = sc + qq * NKMAX;
            const int rq = 256 - meta[qq * 16 + 5], cq = meta[qq * 16 + 6], sbase = 256 - rq, nn = t0 + qq + 1;
            if (cq <= 128) {
                int taken = 0;
#pragma unroll
                for (int half = 0; half < 2; ++half) {
                    const int i = lane + 64 * half;
                    bool take = false; int myidx = 0;
                    if (i < cq) {
                        myidx = cand[qq * 128 + i]; const float mv = scr[myidx];
                        int rank = 0;
                        for (int j = 0; j < cq; ++j) { const int oj = cand[qq * 128 + j]; const float ov = scr[oj]; rank += (ov > mv) || (ov == mv && oj < myidx); }
                        take = rank < rq;
                    }
                    const unsigned long long mt = __ballot(take);
                    if (take) sel[qq * 256 + sbase + taken + __popcll(mt & ((1ull << lane) - 1ull))] = (unsigned short)myidx;
                    taken += __popcll(mt);
                }
            } else {
                const float lo_ = skey_inv((unsigned)meta[qq * 16 + 0]), hi_ = skey_inv((unsigned)meta[qq * 16 + 1]);
                const float sc_ = hi_ > lo_ ? (float)NBIN / (hi_ - lo_) : 0.f;
                const int B1_ = meta[qq * 16 + 4];
                int taken = 0;
                for (int base = 0; base < nn && taken < rq; base += 64) {
                    const int idx = base + lane; bool isc = false;
                    if (idx < nn) isc = bin1(scr[idx], lo_, sc_) == B1_;
                    const unsigned long long mc = __ballot(isc);
                    const int pos = taken + __popcll(mc & ((1ull << lane) - 1ull));
                    if (isc && pos < rq) sel[qq * 256 + sbase + pos] = (unsigned short)idx;
                    taken += __popcll(mc);
                }
            }
        }
        __syncthreads();
    }
    {
        const int q = wid >> 1, kvh = wid & 1, tq = t0 + q, nsel = min(tq + 1, 256);
        const int col = lane & 15, g4 = lane >> 4;
        const unsigned short* selq = sel + q * 256;
        bf16x8 qf0, qf1;
        {
            const bf16_t* qp = p.q() + (size_t)(row0 + q) * 512 + (kvh * 4 + (col & 3)) * 64 + g4 * 8;
            qf0 = *(const bf16x8*)qp; qf1 = *(const bf16x8*)(qp + 32);
            if (col >= 4) {
#pragma unroll
                for (int i = 0; i < 8; ++i) { qf0[i] = 0; qf1[i] = 0; }
            }
        }
        LAS unsigned char* vst = (LAS unsigned char*)lds + A_SC + wid * 16384;
        const bf16_t* vb = p.v() + (size_t)brow * 128 + kvh * 64 + (lane & 7) * 8;
        const unsigned rdbase = (unsigned)(uintptr_t)((LAS unsigned char*)lds + A_SC) + wid * 16384 + (4 * g4 + (col >> 2)) * 128 + (col & 3) * 8;
#define V_STAGE(s_, buf_) do { _Pragma("unroll") for (int i_ = 0; i_ < 4; ++i_) { \
            const int ksl_ = (s_) * 32 + i_ * 8 + (lane >> 3); const int key_ = selq[ksl_]; \
            __builtin_amdgcn_global_load_lds((const unsigned*)(vb + (size_t)key_ * 128), (LAS unsigned*)(vst + (buf_) * 4096 + i_ * 1024), 16, 0, 0); } } while (0)
        const bf16_t* kb = p.k() + (size_t)brow * 128 + kvh * 64 + g4 * 8;
        f32x4 lg[16];
        u32x4 vr[16];
        {
            bf16x8 k0[16], k1[16];
#pragma unroll
            for (int t = 0; t < 16; ++t) {
                const int key = selq[t * 16 + col];
                const bf16_t* kp = kb + (size_t)key * 128;
                k0[t] = *(const bf16x8*)kp; k1[t] = *(const bf16x8*)(kp + 32);
            }
#pragma unroll
            for (int s = 4; s < 8; ++s)
#pragma unroll
                for (int i = 0; i < 4; ++i) { const int key = selq[s * 32 + i * 8 + (lane >> 3)]; vr[(s - 4) * 4 + i] = *(const u32x4*)(vb + (size_t)key * 128); }
            V_STAGE(0, 0); V_STAGE(1, 1); V_STAGE(2, 2); V_STAGE(3, 3);
            __builtin_amdgcn_sched_barrier(0);
#pragma unroll
            for (int t = 0; t < 16; ++t) {
                f32x4 a = (f32x4){0.f, 0.f, 0.f, 0.f};
                a = __builtin_amdgcn_mfma_f32_16x16x32_bf16(k0[t], qf0, a, 0, 0, 0);
                a = __builtin_amdgcn_mfma_f32_16x16x32_bf16(k1[t], qf1, a, 0, 0, 0);
                lg[t] = a;
            }
            __builtin_amdgcn_sched_barrier(0);
        }
        float mx = -INFINITY;
#pragma unroll
        for (int t = 0; t < 16; ++t)
#pragma unroll
            for (int j = 0; j < 4; ++j) { if (t * 16 + g4 * 4 + j >= nsel) lg[t][j] = -INFINITY; mx = fmaxf(mx, lg[t][j]); }
        mx = fmaxf(mx, __shfl_xor(mx, 16)); mx = fmaxf(mx, __shfl_xor(mx, 32));
        float sm = 0.f;
#pragma unroll
        for (int t = 0; t < 16; ++t)
#pragma unroll
            for (int j = 0; j < 4; ++j) { const float e = __builtin_amdgcn_exp2f(lg[t][j] - mx); lg[t][j] = e; sm += e; }
        sm += __shfl_xor(sm, 16); sm += __shfl_xor(sm, 32);
        const float inv = 1.0f / sm;
        f32x4 o[4];
#pragma unroll
        for (int d = 0; d < 4; ++d) o[d] = (f32x4){0.f, 0.f, 0.f, 0.f};
        asm volatile("s_waitcnt vmcnt(0)" ::: "memory");
#pragma unroll
        for (int s = 0; s < 8; ++s) {
            if (s >= 4) {
#pragma unroll
                for (int i = 0; i < 4; ++i) *(LAS u32x4*)(vst + (s & 3) * 4096 + i * 1024 + lane * 16) = vr[(s - 4) * 4 + i];
                asm volatile("s_waitcnt lgkmcnt(0)" ::: "memory");
            }
            const unsigned rb = rdbase + (s & 3) * 4096;
            const s16x4 l0 = tr_read<0>(rb), h0 = tr_read<2048>(rb), l1 = tr_read<32>(rb), h1_ = tr_read<2048 + 32>(rb);
            const s16x4 l2 = tr_read<64>(rb), h2_ = tr_read<2048 + 64>(rb), l3 = tr_read<96>(rb), h3 = tr_read<2048 + 96>(rb);
            asm volatile("s_waitcnt lgkmcnt(0)" ::: "memory");
            __builtin_amdgcn_sched_barrier(0);
            bf16x8 pa;
            {
                const uint32_t w0 = pack2(lg[2 * s][0], lg[2 * s][1]), w1 = pack2(lg[2 * s][2], lg[2 * s][3]);
                const uint32_t w2 = pack2(lg[2 * s + 1][0], lg[2 * s + 1][1]), w3 = pack2(lg[2 * s + 1][2], lg[2 * s + 1][3]);
                pa[0] = (short)(w0 & 0xffff); pa[1] = (short)(w0 >> 16); pa[2] = (short)(w1 & 0xffff); pa[3] = (short)(w1 >> 16);
                pa[4] = (short)(w2 & 0xffff); pa[5] = (short)(w2 >> 16); pa[6] = (short)(w3 & 0xffff); pa[7] = (short)(w3 >> 16);
            }
#define PKV(L, H) (bf16x8){L[0], L[1], L[2], L[3], H[0], H[1], H[2], H[3]}
            o[0] = __builtin_amdgcn_mfma_f32_16x16x32_bf16(pa, PKV(l0, h0), o[0], 0, 0, 0);
            o[1] = __builtin_amdgcn_mfma_f32_16x16x32_bf16(pa, PKV(l1, h1_), o[1], 0, 0, 0);
            o[2] = __builtin_amdgcn_mfma_f32_16x16x32_bf16(pa, PKV(l2, h2_), o[2], 0, 0, 0);
            o[3] = __builtin_amdgcn_mfma_f32_16x16x32_bf16(pa, PKV(l3, h3), o[3], 0, 0, 0);
#undef PKV
        }
#undef V_STAGE
        const float i0 = __shfl(inv, 0), i1 = __shfl(inv, 1), i2 = __shfl(inv, 2), i3 = __shfl(inv, 3);
        if (g4 == 0) {
            bf16_t* op = p.att() + (size_t)(row0 + q) * 512 + kvh * 256 + col;
#pragma unroll
            for (int d = 0; d < 4; ++d) {
                op[0 * 64 + d * 16] = f2bf(o[d][0] * i0); op[1 * 64 + d * 16] = f2bf(o[d][1] * i1);
                op[2 * 64 + d * 16] = f2bf(o[d][2] * i2); op[3 * 64 + d * 16] = f2bf(o[d][3] * i3);
            }
        }
    }
    __syncthreads();
}

constexpr int NBW = 512;
constexpr int W_SC = 0, W_H = W_SC + NKMAX * 2, W_SEL = W_H + NBW * 4, W_CAND = W_SEL + 512, W_SZ = W_CAND + 256;
static_assert(8 * W_SZ <= LDS_BYTES - 32, "wave attention LDS");
__device__ __forceinline__ int binw(float s, float lo, float scale) { return min(NBW - 1, max(0, (int)((s - lo) * scale))); }

__device__ __forceinline__ void attn_wave(const P& p, unsigned char* lds, int wid, int lane, int b, int t, float mn, float mx) {
    unsigned char* wl = lds + wid * W_SZ;
    _Float16* sc = (_Float16*)(wl + W_SC);
    int* hist = (int*)(wl + W_H);
    unsigned short* sel = (unsigned short*)(wl + W_SEL);
    unsigned short* cand = (unsigned short*)(wl + W_CAND);
    const int brow = b * LP, row = brow + t, n = t + 1;
    const int col = lane & 15, g4 = lane >> 4;
    const unsigned long long lt = (1ull << lane) - 1ull;
    int nsel = 256;
    if (n > 256) {
        const float scale = mx > mn ? (float)NBW / (mx - mn) : 0.f, nls = -mn * scale;
#define BINF(x) min(NBW - 1, max(0, (int)__builtin_fmaf((x), scale, nls)))
#define H2F(u16) ((float)__builtin_bit_cast(_Float16, (unsigned short)(u16)))
        for (int base = 0; base < n; base += 512) {
            const int ia = base + lane * 4, ib = ia + 256;
            uint2 ra = make_uint2(0u, 0u), rb2 = make_uint2(0u, 0u);
            if (ia < n) ra = *(const uint2*)(sc + ia);
            if (ib < n) rb2 = *(const uint2*)(sc + ib);
            const unsigned wa[4] = {ra.x & 0xffffu, ra.x >> 16, ra.y & 0xffffu, ra.y >> 16}, wb[4] = {rb2.x & 0xffffu, rb2.x >> 16, rb2.y & 0xffffu, rb2.y >> 16};
#pragma unroll
            for (int j = 0; j < 4; ++j) {
                if (ia + j < n) atomicAdd(&hist[BINF(H2F(wa[j]))], 1);
                if (ib + j < n) atomicAdd(&hist[BINF(H2F(wb[j]))], 1);
            }
        }
        int B1, above1, cnt1;
        {
            int c[8];
            const int4 v0 = *(const int4*)(hist + 8 * lane), v1 = *(const int4*)(hist + 8 * lane + 4);
            c[0] = v0.x; c[1] = v0.y; c[2] = v0.z; c[3] = v0.w; c[4] = v1.x; c[5] = v1.y; c[6] = v1.z; c[7] = v1.w;
            int tot = 0;
#pragma unroll
            for (int i = 0; i < 8; ++i) tot += c[i];
            int suf = tot;
#pragma unroll
            for (int o = 1; o < 64; o <<= 1) { const int tt = __shfl_down(suf, o); if (lane + o < 64) suf += tt; }
            int above = suf - tot;
            const bool mine = above < 256 && 256 <= above + tot;
            int bb = 0, ab = 0, cb = 0;
#pragma unroll
            for (int i = 7; i >= 0; --i) { if (above < 256 && 256 <= above + c[i]) { bb = 8 * lane + i; ab = above; cb = c[i]; } above += c[i]; }
            const int src = (int)__builtin_ctzll(__ballot(mine));
            B1 = __shfl(bb, src); above1 = __shfl(ab, src); cnt1 = __shfl(cb, src);
        }
        int selcnt = 0, candcnt = 0;
        for (int base = 0; base < n; base += 512) {
            const int ia = base + lane * 4, ib = ia + 256;
            uint2 ra = make_uint2(0u, 0u), rb2 = make_uint2(0u, 0u);
            if (ia < n) ra = *(const uint2*)(sc + ia);
            if (ib < n) rb2 = *(const uint2*)(sc + ib);
            const unsigned wv[8] = {ra.x & 0xffffu, ra.x >> 16, ra.y & 0xffffu, ra.y >> 16, rb2.x & 0xffffu, rb2.x >> 16, rb2.y & 0xffffu, rb2.y >> 16};
            unsigned smask = 0u, cmask = 0u;
#pragma unroll
            for (int j = 0; j < 8; ++j) {
                const int idx = (j < 4 ? ia : ib) + (j & 3);
                const int b1 = idx < n ? BINF(H2F(wv[j])) : -1;
                smask |= (b1 > B1 ? 1u : 0u) << j; cmask |= (b1 == B1 ? 1u : 0u) << j;
            }
            const int cnt = __popc(smask);
            int inc = cnt;
#pragma unroll
            for (int o = 1; o < 64; o <<= 1) { const int tt = __shfl_up(inc, o); if (lane >= o) inc += tt; }
            int pos = selcnt + inc - cnt;
#pragma unroll
            for (int j = 0; j < 8; ++j) if ((smask >> j) & 1u) { sel[pos] = (unsigned short)((j < 4 ? ia : ib) + (j & 3)); ++pos; }
            selcnt += __shfl(inc, 63);
            if (__ballot(cmask != 0u)) {
#pragma unroll
                for (int j = 0; j < 8; ++j) {
                    const bool isc = (cmask >> j) & 1u;
                    const unsigned long long mc = __ballot(isc);
                    const int cp = candcnt + __popcll(mc & lt);
                    if (isc && cp < 128) cand[cp] = (unsigned short)((j < 4 ? ia : ib) + (j & 3));
                    candcnt += __popcll(mc);
                }
            }
        }
        {
            const int rq = 256 - above1, cq = cnt1, sbase = 256 - rq;
            if (cq <= 128) {
                int taken = 0;
#pragma unroll
                for (int half = 0; half < 2; ++half) {
                    const int i = lane + 64 * half;
                    bool take = false; int myidx = 0;
                    if (i < cq) {
                        myidx = cand[i]; const float mv = (float)sc[myidx];
                        int rank = 0;
                        for (int j = 0; j < cq; ++j) { const int oj = cand[j]; const float ov = (float)sc[oj]; rank += (ov > mv) || (ov == mv && oj < myidx); }
                        take = rank < rq;
                    }
                    const unsigned long long mt = __ballot(take);
                    if (take) sel[sbase + taken + __popcll(mt & lt)] = (unsigned short)myidx;
                    taken += __popcll(mt);
                }
            } else {
                int taken = 0;
                for (int base = 0; base < n && taken < rq; base += 64) {
                    const int idx = base + lane; bool isc = false;
                    if (idx < n) isc = BINF((float)sc[idx]) == B1;
                    const unsigned long long mc = __ballot(isc);
                    const int pos = taken + __popcll(mc & lt);
                    if (isc && pos < rq) sel[sbase + pos] = (unsigned short)idx;
                    taken += __popcll(mc);
                }
            }
        }
#undef BINF
#undef H2F
    } else {
        nsel = n;
#pragma unroll
        for (int i = 0; i < 4; ++i) { const int j = lane + 64 * i; sel[j] = (unsigned short)(j < n ? j : 0); }
    }
    LAS unsigned char* vst = (LAS unsigned char*)wl + W_SC;
    const unsigned rdbase = (unsigned)(uintptr_t)((LAS unsigned char*)wl + W_SC) + (4 * g4 + (col >> 2)) * 256 + (col & 3) * 8;
    {
        bf16x8 qf[4];
        {
            const bf16_t* qp = p.q() + (size_t)row * 512 + (col & 7) * 64 + g4 * 8;
            const bf16x8 q0 = *(const bf16x8*)qp, q1 = *(const bf16x8*)(qp + 32);
            const bool lo_grp = col < 4, hi_grp = col >= 4 && col < 8;
#pragma unroll
            for (int i = 0; i < 8; ++i) { qf[0][i] = lo_grp ? q0[i] : (short)0; qf[1][i] = lo_grp ? q1[i] : (short)0; qf[2][i] = hi_grp ? q0[i] : (short)0; qf[3][i] = hi_grp ? q1[i] : (short)0; }
        }
        const bf16_t* vb = p.v() + (size_t)brow * 128 + (lane & 15) * 8;
#define V_STAGE(s_, buf_) do { _Pragma("unroll") for (int i_ = 0; i_ < 4; ++i_) { \
            const int key_ = sel[(s_) * 16 + i_ * 4 + (lane >> 4)]; \
            __builtin_amdgcn_global_load_lds((const unsigned*)(vb + (size_t)key_ * 128), (LAS unsigned*)(vst + (buf_) * 4096 + i_ * 1024), 16, 0, 0); } } while (0)
        const bf16_t* kg = p.k() + (size_t)brow * 128;
#define K_STAGE(s_, buf_) do { _Pragma("unroll") for (int i_ = 0; i_ < 4; ++i_) { \
            const int kl_ = i_ * 4 + (lane >> 4); const int key_ = sel[(s_) * 16 + kl_]; \
            __builtin_amdgcn_global_load_lds((const unsigned*)(kg + (size_t)key_ * 128 + (((lane & 15) ^ kl_) & 15) * 8), (LAS unsigned*)(vst + (buf_) * 4096 + i_ * 1024), 16, 0, 0); } } while (0)
        f32x4 lg[16];
        K_STAGE(0, 0); K_STAGE(1, 1); K_STAGE(2, 2);
#pragma unroll
        for (int s = 0; s < 16; ++s) {
            if (s + 3 < 16) { K_STAGE(s + 3, (s + 3) & 3); asm volatile("s_waitcnt vmcnt(12)" ::: "memory"); }
            else if (s == 13) asm volatile("s_waitcnt vmcnt(8)" ::: "memory");
            else if (s == 14) asm volatile("s_waitcnt vmcnt(4)" ::: "memory");
            else asm volatile("s_waitcnt vmcnt(0)" ::: "memory");
            bf16x8 kf[4];
#pragma unroll
            for (int ks = 0; ks < 4; ++ks) kf[ks] = *(const LAS bf16x8*)(vst + (s & 3) * 4096 + col * 256 + (((ks * 4 + g4) ^ col) & 15) * 16);
            asm volatile("s_waitcnt lgkmcnt(0)" ::: "memory");
            __builtin_amdgcn_sched_barrier(0);
            f32x4 a = (f32x4){0.f, 0.f, 0.f, 0.f};
#pragma unroll
            for (int ks = 0; ks < 4; ++ks) a = __builtin_amdgcn_mfma_f32_16x16x32_bf16(kf[ks], qf[ks], a, 0, 0, 0);
            lg[s] = a;
        }
#undef K_STAGE
        V_STAGE(0, 0); V_STAGE(1, 1); V_STAGE(2, 2);
        float mxl = -INFINITY;
#pragma unroll
        for (int tt = 0; tt < 16; ++tt)
#pragma unroll
            for (int j = 0; j < 4; ++j) { if (tt * 16 + g4 * 4 + j >= nsel) lg[tt][j] = -INFINITY; mxl = fmaxf(mxl, lg[tt][j]); }
        mxl = fmaxf(mxl, __shfl_xor(mxl, 16)); mxl = fmaxf(mxl, __shfl_xor(mxl, 32));
        float sm = 0.f;
#pragma unroll
        for (int tt = 0; tt < 16; ++tt)
#pragma unroll
            for (int j = 0; j < 4; ++j) { const float e = __builtin_amdgcn_exp2f(lg[tt][j] - mxl); lg[tt][j] = e; sm += e; }
        sm += __shfl_xor(sm, 16); sm += __shfl_xor(sm, 32);
        const float inv = 1.0f / sm;
        f32x4 o[8];
#pragma unroll
        for (int d = 0; d < 8; ++d) o[d] = (f32x4){0.f, 0.f, 0.f, 0.f};
#pragma unroll
        for (int s = 0; s < 16; ++s) {
            if (s + 3 < 16) { V_STAGE(s + 3, (s + 3) & 3); asm volatile("s_waitcnt vmcnt(12)" ::: "memory"); }
            else if (s == 13) asm volatile("s_waitcnt vmcnt(8)" ::: "memory");
            else if (s == 14) asm volatile("s_waitcnt vmcnt(4)" ::: "memory");
            else asm volatile("s_waitcnt vmcnt(0)" ::: "memory");
            const unsigned rb = rdbase + (s & 3) * 4096;
            s16x4 pa;
            {
                const uint32_t w0 = pack2(lg[s][0], lg[s][1]), w1 = pack2(lg[s][2], lg[s][3]);
                pa[0] = (short)(w0 & 0xffff); pa[1] = (short)(w0 >> 16); pa[2] = (short)(w1 & 0xffff); pa[3] = (short)(w1 >> 16);
            }
            const s16x4 v0 = tr_read<0>(rb), v1 = tr_read<32>(rb), v2 = tr_read<64>(rb), v3 = tr_read<96>(rb);
            const s16x4 v4 = tr_read<128>(rb), v5 = tr_read<160>(rb), v6 = tr_read<192>(rb), v7 = tr_read<224>(rb);
            asm volatile("s_waitcnt lgkmcnt(0)" ::: "memory");
            __builtin_amdgcn_sched_barrier(0);
            o[0] = __builtin_amdgcn_mfma_f32_16x16x16bf16_1k(pa, v0, o[0], 0, 0, 0); o[1] = __builtin_amdgcn_mfma_f32_16x16x16bf16_1k(pa, v1, o[1], 0, 0, 0);
            o[2] = __builtin_amdgcn_mfma_f32_16x16x16bf16_1k(pa, v2, o[2], 0, 0, 0); o[3] = __builtin_amdgcn_mfma_f32_16x16x16bf16_1k(pa, v3, o[3], 0, 0, 0);
            o[4] = __builtin_amdgcn_mfma_f32_16x16x16bf16_1k(pa, v4, o[4], 0, 0, 0); o[5] = __builtin_amdgcn_mfma_f32_16x16x16bf16_1k(pa, v5, o[5], 0, 0, 0);
            o[6] = __builtin_amdgcn_mfma_f32_16x16x16bf16_1k(pa, v6, o[6], 0, 0, 0); o[7] = __builtin_amdgcn_mfma_f32_16x16x16bf16_1k(pa, v7, o[7], 0, 0, 0);
        }
#undef V_STAGE
        float ih[4];
#pragma unroll
        for (int jj = 0; jj < 4; ++jj) ih[jj] = __shfl(inv, 4 * (g4 & 1) + jj);
        if (g4 < 2) {
            bf16_t* op = p.att() + (size_t)row * 512 + (g4 * 4) * 64 + col;
#pragma unroll
            for (int d = 0; d < 4; ++d) {
                const f32x4 oa_ = o[d], ob_ = o[4 + d]; f32x4 ov;
#pragma unroll
                for (int kk = 0; kk < 4; ++kk) ov[kk] = g4 == 0 ? oa_[kk] : ob_[kk];
                op[0 * 64 + d * 16] = f2bf(ov[0] * ih[0]); op[1 * 64 + d * 16] = f2bf(ov[1] * ih[1]);
                op[2 * 64 + d * 16] = f2bf(ov[2] * ih[2]); op[3 * 64 + d * 16] = f2bf(ov[3] * ih[3]);
            }
        }
    }
}

constexpr int A8_META = 8 * W_SZ;
static_assert(A8_META + 64 + 512 <= LDS_BYTES - 32, "attn8 meta");
__device__ __forceinline__ void attn8_unit(const P& p, unsigned char* lds, int b, int grp) {
    const int tid = tid_(), lane = tid & 63, wid = __builtin_amdgcn_readfirstlane(tid >> 6);
    const int t0 = NMETA + 8 * grp, brow = b * LP, row0 = brow + t0;
    unsigned* meta = (unsigned*)(lds + A8_META);
    const bool big = t0 + 1 > 256;
    if (tid < 16) meta[tid] = (tid & 1) ? 0u : 0xffffffffu;
    bf16_t* uvec = (bf16_t*)(lds + A8_META + 64);
    if (big && tid < 256) {
        const int q = tid >> 5, d = tid & 31;
        const bf16_t* ip = p.iq() + (size_t)(row0 + q) * 256 + d; const float* wp = p.iw() + (size_t)(row0 + q) * 8;
        float u = 0.f;
#pragma unroll
        for (int h = 0; h < 8; ++h) u += wp[h] * bf2f(ip[h * 32]);
        uvec[q * 32 + d] = f2bf(u);
    }
    for (int i = tid; i < 8 * NBW; i += NTHREADS) ((int*)(lds + (i / NBW) * W_SZ + W_H))[i % NBW] = 0;
    __syncthreads();
    if (big) {
        const int hh = lane >> 5, c32 = lane & 31;
        const int g = c32 >> 3, h2a = (c32 >> 2) & 1, bq = c32 & 3, aq = 2 * h2a + (g >> 1), ah = 4 * (g & 1) + bq;
        bf16x8 a0[2], a1[2]; f32x4 w[2][2][2];
#pragma unroll
        for (int r = 0; r < 2; ++r) {
            const bf16_t* ap = p.iq() + (size_t)(row0 + 4 * r + aq) * 256 + ah * 32 + 8 * hh;
            a0[r] = *(const bf16x8*)ap; a1[r] = *(const bf16x8*)(ap + 16);
#pragma unroll
            for (int qi = 0; qi < 2; ++qi) {
                const float* wp = p.iw() + (size_t)(row0 + 4 * r + 2 * hh + qi) * 8;
                w[r][qi][0] = *(const f32x4*)wp; w[r][qi][1] = *(const f32x4*)(wp + 4);
            }
        }
        bf16x8 au0, au1;
        {
            const int uq = 4 * ((c32 & 3) >> 1) + 2 * ((c32 >> 2) & 1) + (c32 & 1);
            const bf16x8 v0 = *(const bf16x8*)(uvec + uq * 32 + 8 * hh), v1 = *(const bf16x8*)(uvec + uq * 32 + 8 * hh + 16);
#pragma unroll
            for (int i = 0; i < 8; ++i) { au0[i] = c32 < 8 ? v0[i] : (short)0; au1[i] = c32 < 8 ? v1[i] : (short)0; }
        }
        const int ntiles = (t0 + 8 + 31) >> 5;
        float mx[2][2], mn[2][2];
#pragma unroll
        for (int r = 0; r < 2; ++r)
#pragma unroll
            for (int qi = 0; qi < 2; ++qi) { mx[r][qi] = -INFINITY; mn[r][qi] = INFINITY; }
        const bf16_t* kbase = p.ik() + (size_t)brow * 32 + 8 * hh;
        bf16x8 b0[8], b1[8], c0[8], c1[8];
#define S_LOAD(B0, B1, T0) do { _Pragma("unroll") for (int j = 0; j < 8; ++j) { const int tile_ = min((T0) + 8 * j, ntiles - 1); \
            const bf16_t* kp_ = kbase + (size_t)(tile_ * 32 + c32) * 32; B0[j] = *(const bf16x8*)kp_; B1[j] = *(const bf16x8*)(kp_ + 16); } } while (0)
#define S_COMP(B0, B1, T0) do { _Pragma("unroll") for (int j = 0; j < 8; ++j) { const int tile = (T0) + 8 * j; if (tile < ntiles) { const int key = tile * 32 + c32; \
            f32x16 acu; _Pragma("unroll") for (int i = 0; i < 16; ++i) acu[i] = 0.f; \
            acu = __builtin_amdgcn_mfma_f32_32x32x16_bf16(au0, B0[j], acu, 0, 0, 0); acu = __builtin_amdgcn_mfma_f32_32x32x16_bf16(au1, B1[j], acu, 0, 0, 0); \
            _Pragma("unroll") for (int r = 0; r < 2; ++r) { f32x16 acc; _Pragma("unroll") for (int i = 0; i < 16; ++i) acc[i] = 0.f; \
                acc = __builtin_amdgcn_mfma_f32_32x32x16_bf16(a0[r], B0[j], acc, 0, 0, 0); acc = __builtin_amdgcn_mfma_f32_32x32x16_bf16(a1[r], B1[j], acc, 0, 0, 0); \
                _Pragma("unroll") for (int qi = 0; qi < 2; ++qi) { float s = acu[2 * r + qi]; \
                    _Pragma("unroll") for (int i = 0; i < 4; ++i) s += w[r][qi][0][i] * __builtin_fabsf(acc[8 * qi + i]) + w[r][qi][1][i] * __builtin_fabsf(acc[8 * qi + 4 + i]); \
                    const int q = 4 * r + 2 * hh + qi; const _Float16 hs = (_Float16)fminf(fmaxf(s, -60000.f), 60000.f); \
                    ((_Float16*)(lds + q * W_SZ + W_SC))[key] = hs; \
                    if (key <= t0 + q) { const float f = (float)hs; mx[r][qi] = fmaxf(mx[r][qi], f); mn[r][qi] = fminf(mn[r][qi], f); } } } } } } while (0)
        S_LOAD(b0, b1, wid);
        for (int tile0 = wid; tile0 < ntiles; tile0 += 128) {
            if (tile0 + 64 < ntiles) S_LOAD(c0, c1, tile0 + 64);
            __builtin_amdgcn_sched_barrier(0);
            S_COMP(b0, b1, tile0);
            __builtin_amdgcn_sched_barrier(0);
            if (tile0 + 128 < ntiles) S_LOAD(b0, b1, tile0 + 128);
            __builtin_amdgcn_sched_barrier(0);
            if (tile0 + 64 < ntiles) S_COMP(c0, c1, tile0 + 64);
            __builtin_amdgcn_sched_barrier(0);
        }
#undef S_LOAD
#undef S_COMP
#pragma unroll
        for (int r = 0; r < 2; ++r)
#pragma unroll
            for (int qi = 0; qi < 2; ++qi) {
                float a = mx[r][qi], c = mn[r][qi];
#pragma unroll
                for (int o = 16; o >= 1; o >>= 1) { a = fmaxf(a, __shfl_xor(a, o)); c = fminf(c, __shfl_xor(c, o)); }
                if (c32 == 0 && a >= c) { const int q = 4 * r + 2 * hh + qi; atomicMin(&meta[q * 2], skey(c)); atomicMax(&meta[q * 2 + 1], skey(a)); }
            }
    }
    __syncthreads();
    const float mnq = big ? skey_inv(meta[wid * 2]) : 0.f, mxq = big ? skey_inv(meta[wid * 2 + 1]) : 0.f;
    attn_wave(p, lds, wid, lane, b, t0 + wid, mnq, mxq);
    __syncthreads();
}

constexpr int NGRP8 = SEQ / 8, ATT_P1 = NGRP8 / 8, ATT_P2 = NGRP8 / 2;
template <int SUB>
__device__ __forceinline__ void ph_mixer(const P& p, unsigned char* lds) {
    int* bc = (int*)(lds + LDS_BYTES - 16);
    constexpr int nh = SUB == 1 ? 64 : NXU;
    constexpr int a0 = SUB == 0 ? 0 : (SUB == 1 ? ATT_P1 : ATT_P2), a1 = SUB == 0 ? ATT_P1 : (SUB == 1 ? ATT_P2 : NGRP8);
    for (;;) {
        __syncthreads();
        if (tid_() == 0) bc[0] = atomicAdd(&p.ctr()[97 + SUB], 1);
        __syncthreads();
        const int it = bc[0];
        if (it >= nh) break;
        if (SUB == 0) hgx_unit(p, lds, it);
        else if (SUB == 1) hgchain_unit(p, it);
        else hgz_unit(p, lds, it);
    }
    const int b0 = (int)(xb_xcc_id() & 3u);
#pragma unroll 1
    for (int k = 0; k < 4; ++k) {
        const int b = (b0 + k) & 3;
        for (;;) {
            __syncthreads();
            if (tid_() == 0) bc[0] = atomicAdd(&p.ctr()[104 + SUB * 4 + b], 1);
            __syncthreads();
            const int it = bc[0];
            if (it >= a1 - a0) break;
            attn8_unit(p, lds, b, NGRP8 - 1 - (a0 + it));
        }
    }
}

__device__ __forceinline__ int tok_row(int tok) { return (tok >> 13) * LP + NMETA + (tok & 8191); }
__device__ __forceinline__ void ph_mix(const P& p, unsigned char* lds) {
    const int njobs = (NTOK / 256) * 4 * 2, G = gridDim.x, b0 = blockIdx.x;
    auto jobidx = [&](int i) __attribute__((always_inline)) { return (b0 + (i >> 1) * G) * 2 + (i & 1); };
    auto jobfn = [&](int i, GJob& j) __attribute__((always_inline)) -> bool {
        const int jb = jobidx(i); if (jb >= njobs) return false;
        const int which = jb & 1, u = jb >> 1, nt = u & 3, mt = u >> 2; const size_t r0 = (size_t)tok_row(mt * 256);
        j.A = (const char*)((which ? p.hgr() : p.att()) + r0 * 512); j.B = (const char*)((which ? p.wuhT() : p.wuaT()) + (size_t)nt * 256 * 512); return true; };
    auto epi = [&](f32x4 (&acc)[2][2][4][2], int i) __attribute__((always_inline)) {
        const int jb = jobidx(i), which = jb & 1, u = jb >> 1, nt = u & 3, mt = u >> 2; const size_t r0 = (size_t)tok_row(mt * 256);
        if (which == 0) {
            EPI8(
                const size_t og = (r0 + row) * 1024 + nt * 256 + col, om = (size_t)(mt * 256 + row) * 1024 + nt * 256 + col;
                const uint2 g = *(const uint2*)(p.ga() + og);
                f32x4 r;
                r[0] = v[0] * __uint_as_float(g.x << 16); r[1] = v[1] * __uint_as_float(g.x & 0xffff0000u);
                r[2] = v[2] * __uint_as_float(g.y << 16); r[3] = v[3] * __uint_as_float(g.y & 0xffff0000u);
                st_bf4(p.mix() + om, r);
            );
        } else {
            EPI8(
                const size_t og = (r0 + row) * 1024 + nt * 256 + col, om = (size_t)(mt * 256 + row) * 1024 + nt * 256 + col;
                const uint2 g = *(const uint2*)(p.gh() + og);
                const uint2 a = *(const uint2*)(p.mix() + om);
                f32x4 r;
                r[0] = __uint_as_float(a.x << 16) + v[0] * __uint_as_float(g.x << 16); r[1] = __uint_as_float(a.x & 0xffff0000u) + v[1] * __uint_as_float(g.x & 0xffff0000u);
                r[2] = __uint_as_float(a.y << 16) + v[2] * __uint_as_float(g.y << 16); r[3] = __uint_as_float(a.y & 0xffff0000u) + v[3] * __uint_as_float(g.y & 0xffff0000u);
                st_bf4(p.mix() + om, r);
            );
        }
    };
    unsigned vbU[2]; gj_lin2(vbU, 512);
    gemm_stream<false>(lds, 512, 512, (size_t)128 * 512 * 2, vbU, jobfn, epi);
}

__device__ __forceinline__ void ph_out(const P& p, unsigned char* lds) {
    const int nunits = (NTOK / 256) * 4, G = gridDim.x, b0 = blockIdx.x;
    auto jobfn = [&](int i, GJob& j) __attribute__((always_inline)) -> bool {
        const int u = b0 + i * G; if (u >= nunits) return false;
        const int nt = u & 3, mt = u >> 2;
        j.A = (const char*)(p.mix() + (size_t)mt * 256 * D); j.B = (const char*)(p.woT() + (size_t)nt * 256 * D); return true; };
    auto epi = [&](f32x4 (&acc)[2][2][4][2], int i) __attribute__((always_inline)) {
        const int u = b0 + i * G, nt = u & 3, mt = u >> 2;
        EPI8(
            const size_t o = (size_t)(mt * 256 + row) * D + nt * 256 + col;
            const f32x4 h0 = *(const f32x4*)(p.x + o);
            *(f32x4*)(p.out + o) = h0 + v;
        );
    };
    unsigned vbU[2]; gj_lin2(vbU, D);
    gemm_stream<false>(lds, D, D, (size_t)128 * D * 2, vbU, jobfn, epi);
}

constexpr int XS_LD = 1025;
__device__ __forceinline__ void ph_route(const P& p, unsigned char* lds) {
    const int tid = tid_(), lane = tid & 63, wid = __builtin_amdgcn_readfirstlane(tid >> 6);
    const int gt = blockIdx.x * NTHREADS + tid, ntot = gridDim.x * NTHREADS;
    for (int i = gt; i < CAP; i += ntot) { p.slot_token()[i] = -1; p.slot_info()[i] = make_int2(-1, 0); }
    float* xs = (float*)lds;
    int* lhist = (int*)(lds + 32 * XS_LD * 4);
    for (int tb = blockIdx.x; tb < NTOK / 128; tb += gridDim.x) {
        if (tid < 32) lhist[tid] = 0;
        for (int tile = 0; tile < 4; ++tile) {
            const int tokt = tb * 128 + tile * 32;
            __syncthreads();
#pragma unroll
            for (int t = 0; t < 4; ++t) {
                const int tl = wid * 4 + t, tok = tokt + tl;
                const float* src = p.out + (size_t)tok * D;
                f32x4 v[4]; float ss = 0.f;
#pragma unroll
                for (int i = 0; i < 4; ++i) { v[i] = *(const f32x4*)(src + lane * 4 + 256 * i); ss += v[i][0] * v[i][0] + v[i][1] * v[i][1] + v[i][2] * v[i][2] + v[i][3] * v[i][3]; }
                ss = wave_sum(ss);
                const float rs = rsqrtf(ss * (1.0f / D) + EPS);
#pragma unroll
                for (int i = 0; i < 4; ++i) {
                    const f32x4 g = *(const f32x4*)(p.ffn_g + lane * 4 + 256 * i);
                    f32x4 xn; xn[0] = v[i][0] * rs * g[0]; xn[1] = v[i][1] * rs * g[1]; xn[2] = v[i][2] * rs * g[2]; xn[3] = v[i][3] * rs * g[3];
                    *(uint32_t*)(p.xn2() + (size_t)tok * D + lane * 4 + 256 * i) = pk4_fp8(xn[0], xn[1], xn[2], xn[3]);
#pragma unroll
                    for (int c = 0; c < 4; ++c) xs[tl * XS_LD + lane * 4 + 256 * i + c] = xn[c];
                }
            }
            __syncthreads();
            f32x16 acc;
#pragma unroll
            for (int i = 0; i < 16; ++i) acc[i] = 0.f;
            {
                const float* xr = xs + (lane & 31) * XS_LD + wid * 128 + (lane >> 5);
                const float* wp = p.router_w + (size_t)(wid * 128 + (lane >> 5)) * 32 + (lane & 31);
#pragma unroll 16
                for (int i = 0; i < 64; ++i) acc = __builtin_amdgcn_mfma_f32_32x32x2f32(xr[2 * i], wp[(size_t)(2 * i) * 32], acc, 0, 0, 0);
            }
            __syncthreads();
#pragma unroll
            for (int r = 0; r < 16; ++r) xs[wid * 1024 + ((r & 3) + 8 * (r >> 2) + 4 * (lane >> 5)) * 32 + (lane & 31)] = acc[r];
            __syncthreads();
            const int e = lane & 31, hh = lane >> 5;
            const float be = p.router_b[e];
#pragma unroll
            for (int it = 0; it < 2; ++it) {
                const int tl = wid * 4 + it * 2 + hh;
                float l = be;
#pragma unroll
                for (int w = 0; w < 8; ++w) l += xs[w * 1024 + tl * 32 + e];
                float bv[4]; int bi[4];
#pragma unroll
                for (int k = 0; k < 4; ++k) {
                    float m = l;
#pragma unroll
                    for (int o = 16; o >= 1; o >>= 1) m = fmaxf(m, __shfl_xor(m, o));
                    const unsigned long long bal = __ballot(l == m);
                    const unsigned half = hh ? (unsigned)(bal >> 32) : (unsigned)bal;
                    const int idx = __builtin_ctz(half);
                    bv[k] = m; bi[k] = idx;
                    if (e == idx) l = -INFINITY;
                }
                const float e1 = __expf(bv[1] - bv[0]), e2 = __expf(bv[2] - bv[0]), e3 = __expf(bv[3] - bv[0]);
                const float inv = 1.0f / (1.0f + e1 + e2 + e3);
                if (e == 0) {
                    const int tok = tokt + tl;
                    p.tok_exp()[tok * 4 + 0] = bi[0]; p.tok_exp()[tok * 4 + 1] = bi[1]; p.tok_exp()[tok * 4 + 2] = bi[2]; p.tok_exp()[tok * 4 + 3] = bi[3];
                    p.tok_gate()[tok * 4 + 0] = inv; p.tok_gate()[tok * 4 + 1] = e1 * inv; p.tok_gate()[tok * 4 + 2] = e2 * inv; p.tok_gate()[tok * 4 + 3] = e3 * inv;
                    atomicAdd(&lhist[bi[0]], 1); atomicAdd(&lhist[bi[1]], 1); atomicAdd(&lhist[bi[2]], 1); atomicAdd(&lhist[bi[3]], 1);
                }
            }
        }
        __syncthreads();
        if (tid < 32) p.wg_cnt()[tb * 32 + tid] = lhist[tid];
        __syncthreads();
    }
    for (long task = gt; task < 96L * 16384; task += ntot) {
        const int mat = (int)(task >> 14), r = (int)(task & 16383), kq = r >> 10, n = r & 1023;
        const int which = mat >> 5, e = mat & 31;
        const float* W = (which == 0 ? p.w_gate : which == 1 ? p.w_up : p.w_down) + (size_t)e * 1048576 + (size_t)(kq * 64) * 1024 + n;
        unsigned char* outp = (which == 0 ? p.wgT() : which == 1 ? p.wuT() : p.wdT()) + (size_t)e * 1048576 + (size_t)n * 1024 + kq * 64;
        float v[64];
#pragma unroll
        for (int i = 0; i < 64; ++i) v[i] = W[(size_t)i * 1024] * 32.0f;
        uint4* dst = (uint4*)outp;
#pragma unroll
        for (int i = 0; i < 4; ++i) dst[i] = make_uint4(pk4_fp8(v[16 * i], v[16 * i + 1], v[16 * i + 2], v[16 * i + 3]), pk4_fp8(v[16 * i + 4], v[16 * i + 5], v[16 * i + 6], v[16 * i + 7]),
                                                        pk4_fp8(v[16 * i + 8], v[16 * i + 9], v[16 * i + 10], v[16 * i + 11]), pk4_fp8(v[16 * i + 12], v[16 * i + 13], v[16 * i + 14], v[16 * i + 15]));
    }
}

__device__ __forceinline__ void ph_fill(const P& p, unsigned char* lds) {
    const int tid = tid_();
    int* tot = (int*)lds;
    int* pre = tot + 512;
    int* ps = pre + 512;
    int* lc = ps + 32;
    for (int tb = blockIdx.x; tb < NTOK / 128; tb += gridDim.x) {
        {
            const int e = tid & 31, part = tid >> 5;
            int t = 0, q = 0;
            for (int b2 = part; b2 < NTOK / 128; b2 += 16) { const int c = p.wg_cnt()[b2 * 32 + e]; t += c; if (b2 < tb) q += c; }
            tot[part * 32 + e] = t; pre[part * 32 + e] = q;
        }
        __syncthreads();
        if (tid == 0) {
            int acc = 0;
            for (int e = 0; e < NE; ++e) {
                int t = 0, q = 0;
                for (int i = 0; i < 16; ++i) { t += tot[i * 32 + e]; q += pre[i * 32 + e]; }
                ps[e] = acc + q; lc[e] = 0;
                const int nb = (t + 255) >> 8;
                if (tb == 0) for (int i = 0; i < nb; ++i) p.block_expert()[(acc >> 8) + i] = e;
                acc += nb * 256;
            }
            if (tb == 0) p.ctr()[96] = acc >> 8;
        }
        __syncthreads();
        {
            const int i = tb * 512 + tid;
            const int e = p.tok_exp()[i];
            const int dest = ps[e] + atomicAdd(&lc[e], 1);
            p.slot_token()[dest] = i >> 2;
            p.slot_rank()[dest] = i & 3;
            p.slot_gate()[dest] = p.tok_gate()[i];
            p.slot_info()[dest] = make_int2((i >> 2) | ((i & 3) << 16), __float_as_int(p.tok_gate()[i]));
        }
        __syncthreads();
    }
}

__device__ __forceinline__ void ph_moe1(const P& p, unsigned char* lds) {
    const int nblocks = p.ctr()[96], G = gridDim.x, b0 = blockIdx.x, bpx = (nblocks + 7) >> 3, bpi = G >> 6, xl = b0 >> 3, xbase = (b0 & 7) * bpx;
    auto unit = [&](int i, int& rb, int& ct) __attribute__((always_inline)) -> bool {
        const int k = i * bpi + (xl >> 3); rb = xbase + k; ct = xl & 7; return k < bpx && rb < nblocks && (xl >> 3) < bpi; };
    auto jobfn = [&](int i, G8Job& j) __attribute__((always_inline)) -> bool {
        int rb, ct; if (!unit(i, rb, ct)) return false;
        const int e = p.block_expert()[rb];
        j.A = (const char*)p.xn2(); j.B = (const char*)(p.wgT() + (size_t)e * 1048576 + (size_t)ct * 128 * 1024);
        const int* st = p.slot_token() + rb * 256; unsigned v[4];
#pragma unroll
        for (int q = 0; q < 4; ++q) { int R, Cb; g8_rc(q, R, Cb); const int t = st[R]; v[q] = (unsigned)((t < 0 ? 0 : t) * 1024 + Cb); }
        j.va0 = v[0]; j.va1 = v[1]; j.va2 = v[2]; j.va3 = v[3]; return true; };
    auto epi = [&](f32x4 (&acc)[2][2][4][2], int i) __attribute__((always_inline)) {
        int rb, ct; unit(i, rb, ct);
        const int e = p.block_expert()[rb];
        const int tid_e = tid_(), lane_e = tid_e & 63, wid_e = tid_e >> 6, wr = wid_e >> 2, wc = wid_e & 3, fr = lane_e & 15, fq = lane_e >> 4;
#pragma unroll
        for (int n = 0; n < 2; ++n) {
            const int c = ct * 128 + wc * 32 + n * 16 + fq * 4;
            const f32x4 bg = *(const f32x4*)(p.b_gate + (size_t)e * DFF + c), bu = *(const f32x4*)(p.b_up + (size_t)e * DFF + c);
#pragma unroll
            for (int ai = 0; ai < 2; ++ai)
#pragma unroll
                for (int m = 0; m < 4; ++m) {
                    const int row = rb * 256 + ai * 128 + wr * 64 + m * 16 + fr;
                    f32x4 a;
#pragma unroll
                    for (int j = 0; j < 4; ++j) {
                        const float g = fminf(acc[ai][0][m][n][j] * 0.03125f + bg[j], 7.0f);
                        const float uu = fminf(fmaxf(acc[ai][1][m][n][j] * 0.03125f + bu[j], -7.0f), 7.0f);
                        a[j] = (uu + 1.0f) * (g * sigmoidf_(1.702f * g));
                    }
                    *(uint32_t*)(p.act() + (size_t)row * DFF + c) = pk4_fp8(a[0], a[1], a[2], a[3]);
                }
        }
    };
    unsigned vbU[4];
#pragma unroll
    for (int q = 0; q < 4; ++q) { int R, Cb; g8_rc(q, R, Cb); vbU[q] = (unsigned)((size_t)(R >> 7) * WE8_B + (size_t)(R & 127) * 1024 + Cb); }
    gemm8_stream<true>(lds, vbU, jobfn, epi);
}
__device__ __forceinline__ void ph_moe2(const P& p, unsigned char* lds) {
    const int nblocks = p.ctr()[96], G = gridDim.x, b0 = blockIdx.x, bpx = (nblocks + 7) >> 3, bpi = G >> 5, xl = b0 >> 3, xbase = (b0 & 7) * bpx;
    auto unit = [&](int i, int& rb, int& nt) __attribute__((always_inline)) -> bool {
        const int k = i * bpi + (xl >> 2); rb = xbase + k; nt = xl & 3; return k < bpx && rb < nblocks && (xl >> 2) < bpi; };
    unsigned vbU[4];
#pragma unroll
    for (int q = 0; q < 4; ++q) { int R, Cb; g8_rc(q, R, Cb); vbU[q] = (unsigned)(R * DFF + Cb); }
    auto jobfn = [&](int i, G8Job& j) __attribute__((always_inline)) -> bool {
        int rb, nt; if (!unit(i, rb, nt)) return false;
        const int e = p.block_expert()[rb];
        j.A = (const char*)(p.act() + (size_t)rb * 256 * DFF); j.B = (const char*)(p.wdT() + (size_t)e * 1048576 + (size_t)nt * 256 * DFF); return true; };
    auto epi = [&](f32x4 (&acc)[2][2][4][2], int i) __attribute__((always_inline)) {
        int rb, nt; unit(i, rb, nt);
        const int e = p.block_expert()[rb];
        const int tid_e = tid_(), lane_e = tid_e & 63, wid_e = tid_e >> 6, wr = wid_e >> 2, wc = wid_e & 3, fr = lane_e & 15, fq = lane_e >> 4;
        f32x4 bd[2][2];
#pragma unroll
        for (int bj = 0; bj < 2; ++bj)
#pragma unroll
            for (int n = 0; n < 2; ++n) bd[bj][n] = *(const f32x4*)(p.b_down + (size_t)e * D + nt * 256 + bj * 128 + wc * 32 + n * 16 + fq * 4);
        int2 info[2][4];
#pragma unroll
        for (int ai = 0; ai < 2; ++ai)
#pragma unroll
            for (int m = 0; m < 4; ++m) info[ai][m] = p.slot_info()[rb * 256 + ai * 128 + wr * 64 + m * 16 + fr];
#pragma unroll
        for (int ai = 0; ai < 2; ++ai)
#pragma unroll
            for (int m = 0; m < 4; ++m) {
                const int ix = info[ai][m].x;
                if (ix < 0) continue;
                const int rank = ix >> 16; const float gate = __int_as_float(info[ai][m].y) * 0.03125f;
                const size_t o = (size_t)(ix & 0xffff) * D + nt * 256 + wc * 32 + fq * 4;
                bf16_t* yb = (rank == 0 ? p.y0() : rank == 1 ? p.y1() : (rank == 2 ? p.y2() : p.y3())) + o;
#pragma unroll
                for (int bj = 0; bj < 2; ++bj)
#pragma unroll
                    for (int n = 0; n < 2; ++n) st_bf4(yb + bj * 128 + n * 16, (acc[ai][bj][m][n] + bd[bj][n] * 32.0f) * gate);
            }
    };
    gemm8_stream<false>(lds, vbU, jobfn, epi);
}

__device__ __forceinline__ void ph_final(const P& p, unsigned char* lds) {
    const int tid = tid_(), lane = tid & 63, wid = tid >> 6;
    const int gw = blockIdx.x * 8 + wid, nw = gridDim.x * 8;
    for (int tok = gw; tok < NTOK; tok += nw) {
        float* dst = p.out + (size_t)tok * D;
        f32x4 v[4];
#pragma unroll
        for (int i = 0; i < 4; ++i) v[i] = *(const f32x4*)(dst + lane * 4 + 256 * i);
#pragma unroll
        for (int j = 0; j < 4; ++j) {
            const bf16_t* yr = (j == 0 ? p.y0() : j == 1 ? p.y1() : j == 2 ? p.y2() : p.y3()) + (size_t)tok * D;
#pragma unroll
            for (int i = 0; i < 4; ++i) {
                const uint2 w = *(const uint2*)(yr + lane * 4 + 256 * i);
                v[i][0] += __uint_as_float(w.x << 16); v[i][1] += __uint_as_float(w.x & 0xffff0000u);
                v[i][2] += __uint_as_float(w.y << 16); v[i][3] += __uint_as_float(w.y & 0xffff0000u);
            }
        }
        float ss = 0.f;
#pragma unroll
        for (int i = 0; i < 4; ++i) ss += v[i][0] * v[i][0] + v[i][1] * v[i][1] + v[i][2] * v[i][2] + v[i][3] * v[i][3];
        ss = wave_sum(ss);
        const float rs = rsqrtf(ss * (1.0f / D) + EPS);
#pragma unroll
        for (int i = 0; i < 4; ++i) {
            const f32x4 g = *(const f32x4*)(p.final_g + lane * 4 + 256 * i);
            *(f32x4*)(dst + lane * 4 + 256 * i) = v[i] * rs * g;
        }
    }
}

typedef const __attribute__((address_space(4))) P* PK;
#define PHASE(call) do { PK q_ = pk; asm volatile("" : "+s"(q_)); const P& p = *(const P*)q_; call; } while (0)
__global__ void __launch_bounds__(NTHREADS) k_mega(P p_unused) {
    __shared__ __attribute__((aligned(16))) unsigned char lds[LDS_BYTES];
    cg::grid_group grid = cg::this_grid();
    const PK pk = (PK)__builtin_amdgcn_kernarg_segment_ptr();
    if (tid_() < 4) ((unsigned*)(lds + LDS_BYTES - 32))[tid_()] = 0u;
    __syncthreads();
    XcdBarrier xb;
    PHASE(xb = xcd_barrier_post((unsigned*)(p.ws + OFF_BAR), (volatile LAS unsigned*)(lds + LDS_BYTES - 32)));
    PHASE(if (p.ws == nullptr) grid.sync());
    PHASE(ph_prep(p, lds)); xcd_barrier(xb);
    PHASE(ph_inproj(p, lds)); xcd_barrier(xb);
    PHASE(ph_mixer<0>(p, lds)); xcd_barrier(xb);
    PHASE(ph_mixer<1>(p, lds)); xcd_barrier(xb);
    PHASE(ph_mixer<2>(p, lds)); xcd_barrier(xb);
    PHASE(ph_mix(p, lds)); xcd_barrier(xb);
    PHASE(ph_out(p, lds)); xcd_barrier(xb);
    PHASE(ph_route(p, lds)); xcd_barrier(xb);
    PHASE(ph_fill(p, lds)); xcd_barrier(xb);
    PHASE(ph_moe1(p, lds)); xcd_barrier(xb);
    PHASE(ph_moe2(p, lds)); xcd_barrier(xb);
    PHASE(ph_final(p, lds));
}

extern "C" void kernel_launch(void* const* d_in, const int* in_sizes, int n_in, void* d_out, int out_size, void* d_ws, size_t ws_size,
                              hipStream_t stream) {
    P p{};
    p.x = (const float*)d_in[0]; p.meta = (const float*)d_in[1]; p.attn_g = (const float*)d_in[2]; p.w_in = (const float*)d_in[3];
    p.hgrn_g = (const float*)d_in[4]; p.w_ua = (const float*)d_in[5]; p.w_uh = (const float*)d_in[6]; p.w_out = (const float*)d_in[7];
    p.lb_logits = (const float*)d_in[8]; p.ffn_g = (const float*)d_in[9]; p.router_w = (const float*)d_in[10]; p.router_b = (const float*)d_in[11];
    p.w_gate = (const float*)d_in[12]; p.b_gate = (const float*)d_in[13]; p.w_up = (const float*)d_in[14]; p.b_up = (const float*)d_in[15];
    p.w_down = (const float*)d_in[16]; p.b_down = (const float*)d_in[17]; p.final_g = (const float*)d_in[18];
    p.out = (float*)d_out;
    p.ws = (unsigned char*)d_ws;
    if (WS_NEED > ws_size) { fprintf(stderr, "workspace too small: need %zu have %zu\n", (size_t)WS_NEED, ws_size); return; }
    static int grid_blocks = 0;
    if (!grid_blocks) {
        int dev = 0, cus = 0, per_cu = 0;
        hipGetDevice(&dev);
        hipDeviceGetAttribute(&cus, hipDeviceAttributeMultiprocessorCount, dev);
        hipOccupancyMaxActiveBlocksPerMultiprocessor(&per_cu, k_mega, NTHREADS, 0);
        if (per_cu > 1) per_cu = 1;
        grid_blocks = cus * per_cu;
    }
    hipMemsetAsync(p.ws + OFF_BAR, 0, XCD_BAR_WORDS * 4, stream);
    void* args[] = {&p};
    hipError_t e = hipLaunchCooperativeKernel((void*)k_mega, dim3(grid_blocks), dim3(NTHREADS), args, 0, stream);
    if (e != hipSuccess) fprintf(stderr, "cooperative launch failed: %s (grid %d)\n", hipGetErrorString(e), grid_blocks);
}
```

```cpp
#include <hip/hip_runtime.h>
#include <hip/hip_cooperative_groups.h>
#include <stdint.h>
#include <cstdio>
namespace cg = cooperative_groups;

#ifndef MEGA
#define MEGA 1
#endif

typedef unsigned short bf16_t;
typedef short bf16x8 __attribute__((ext_vector_type(8)));
typedef float f32x4 __attribute__((ext_vector_type(4)));

constexpr int D = 1024, NB = 4, SEQ = 8192, NMETA = 16, L = SEQ + NMETA  , LP = 8320, T = NB * LP  ;
constexpr int NTOK = NB * SEQ;
constexpr int IN_COLS = 5160;
constexpr int NE = 32, TOPK = 4, DFF = 1024;
constexpr int CAP_BLOCKS = (NTOK * TOPK) / 256 + NE;
constexpr int CAP = CAP_BLOCKS * 256;
constexpr float EPS = 1e-5f;
constexpr int NTHREADS = 512;
constexpr int LDS_BYTES = 155648;
constexpr int NVC = 5376;
#define LAS __attribute__((address_space(3)))

typedef __bf16 hwbf16x2 __attribute__((ext_vector_type(2)));
typedef float f32x2 __attribute__((ext_vector_type(2)));
__device__ __forceinline__ uint32_t pack2(float a, float b) { const f32x2 v = {a, b}; return __builtin_bit_cast(uint32_t, __builtin_convertvector(v, hwbf16x2)); }
__device__ __forceinline__ bf16_t f2bf(float f) { return (bf16_t)(pack2(f, 0.f) & 0xffffu); }
__device__ __forceinline__ float bf2f(bf16_t h) { return __uint_as_float(((uint32_t)h) << 16); }
__device__ __forceinline__ uint32_t pk4_fp8(float a, float b, float c, float d) {
    a = fminf(fmaxf(a, -448.f), 448.f); b = fminf(fmaxf(b, -448.f), 448.f); c = fminf(fmaxf(c, -448.f), 448.f); d = fminf(fmaxf(d, -448.f), 448.f);
    int w = __builtin_amdgcn_cvt_pk_fp8_f32(a, b, 0, false); w = __builtin_amdgcn_cvt_pk_fp8_f32(c, d, w, true); return (uint32_t)w;
}
__device__ __forceinline__ float sigmoidf_(float x) { return __builtin_amdgcn_rcpf(1.0f + __builtin_amdgcn_exp2f(-1.4426950408889634f * x)); }
__device__ __forceinline__ float wave_sum(float v) {
#pragma unroll
    for (int o = 32; o >= 1; o >>= 1) v += __shfl_xor(v, o);
    return v;
}
__device__ __forceinline__ float wave_max(float v) {
#pragma unroll
    for (int o = 32; o >= 1; o >>= 1) v = fmaxf(v, __shfl_xor(v, o));
    return v;
}

constexpr size_t al256(size_t x) { return (x + 255) & ~(size_t)255; }
constexpr size_t TT = (size_t)T;
constexpr size_t MB1 = 1024 * 1024;
constexpr size_t WE8_B = (size_t)NE * 1024 * 1024;
constexpr size_t OFF_WGT = 0, OFF_WUT = WE8_B, OFF_WDT = 2 * WE8_B, OFF_XN2 = 3 * WE8_B, OFF_ACT = OFF_XN2 + (size_t)NTOK * D,
                 OFF_Y1 = OFF_ACT + (size_t)CAP * DFF, OFF_Y2 = OFF_Y1 + (size_t)NTOK * D * 2, OFF_Y3 = OFF_Y2 + (size_t)NTOK * D * 2,
                 OFF_S2_END = OFF_Y3 + (size_t)NTOK * D * 2;
constexpr size_t OFF_WIN = 0, OFF_WUA = OFF_WIN + (size_t)NVC * 1024 * 2, OFF_WUH = OFF_WUA + MB1, OFF_WO = OFF_WUH + MB1, OFF_XN = OFF_WO + 2 * MB1,
                 OFF_Q = OFF_XN + TT * 2048, OFF_K = OFF_Q + TT * 1024, OFF_V = OFF_K + TT * 256, OFF_IQ = OFF_V + TT * 256, OFF_IK = OFF_IQ + TT * 512,
                 OFF_IW = OFF_IK + TT * 64, OFF_HQ = OFF_IW + TT * 32, OFF_HF = OFF_HQ + TT * 1024, OFF_HI = OFF_HF + TT * 1024, OFF_HG = OFF_HI + TT * 1024,
                 OFF_GA = OFF_HG + TT * 1024, OFF_GH = OFF_GA + TT * 2048, OFF_ATT = OFF_GH + TT * 2048, OFF_HGR = OFF_ATT + TT * 1024,
                 OFF_S1_END = OFF_HGR + TT * 1024;
static_assert(2 * WE8_B >= (size_t)NTOK * D * 2, "y0 does not fit over the gate/up weights");
constexpr size_t OFF_MIX = OFF_XN;
constexpr size_t OFF_TAB = OFF_S1_END > OFF_S2_END ? OFF_S1_END : OFF_S2_END;
constexpr size_t OFF_ROPE = OFF_TAB, OFF_LB = OFF_ROPE + al256((size_t)LP * 24 * 4), OFF_CTR = OFF_LB + al256(512 * 4),
                 OFF_BEXP = OFF_CTR + al256(128 * 4), OFF_SLOT = OFF_BEXP + al256((size_t)CAP_BLOCKS * 4), OFF_SRANK = OFF_SLOT + al256((size_t)CAP * 4),
                 OFF_SGATE = OFF_SRANK + al256((size_t)CAP * 4), OFF_TEXP = OFF_SGATE + al256((size_t)CAP * 4), OFF_TGATE = OFF_TEXP + al256((size_t)NTOK * 16),
                 OFF_BAR = OFF_TGATE + al256((size_t)NTOK * 16), OFF_WGC = OFF_BAR + al256(3456 * 4), OFF_SINFO = OFF_WGC + al256(256 * 32 * 4), WS_NEED = OFF_SINFO + al256((size_t)CAP * 8);


__device__ __forceinline__ int tid_() { int t = threadIdx.x; asm volatile("" : "+v"(t)); return t; }

struct P {
    const float *x, *meta, *attn_g, *w_in, *hgrn_g, *w_ua, *w_uh, *w_out, *lb_logits, *ffn_g, *router_w, *router_b,
        *w_gate, *b_gate, *w_up, *b_up, *w_down, *b_down, *final_g;
    float* out;
    unsigned char* ws;
#define WSF(type, name, off) __device__ __forceinline__ type* name() const { return (type*)(ws + (off)); }
    WSF(bf16_t, xn, OFF_XN) WSF(unsigned char, xn8, OFF_ATT) WSF(unsigned char, winT8, OFF_WIN) WSF(bf16_t, winTb, OFF_WIN + 6 * MB1) WSF(bf16_t, q, OFF_Q) WSF(bf16_t, k, OFF_K) WSF(bf16_t, v, OFF_V) WSF(bf16_t, iq, OFF_IQ) WSF(bf16_t, ik, OFF_IK)
    WSF(bf16_t, hq, OFF_HQ) WSF(bf16_t, hf, OFF_HF) WSF(bf16_t, hi, OFF_HI) WSF(bf16_t, hg, OFF_HG) WSF(bf16_t, ga, OFF_GA) WSF(bf16_t, gh, OFF_GH)
    WSF(bf16_t, att, OFF_ATT) WSF(bf16_t, hgr, OFF_HGR) WSF(bf16_t, mix, OFF_MIX) WSF(unsigned char, xn2, OFF_XN2) WSF(unsigned char, act, OFF_ACT)
    WSF(bf16_t, y0, OFF_WGT) WSF(bf16_t, y1, OFF_Y1) WSF(bf16_t, y2, OFF_Y2) WSF(bf16_t, y3, OFF_Y3)
    WSF(bf16_t, winT, OFF_WIN) WSF(bf16_t, wuaT, OFF_WUA) WSF(bf16_t, wuhT, OFF_WUH) WSF(bf16_t, woT, OFF_WO)
    WSF(unsigned char, wgT, OFF_WGT) WSF(unsigned char, wuT, OFF_WUT) WSF(unsigned char, wdT, OFF_WDT)
    WSF(float, iw, OFF_IW) WSF(float, rope, OFF_ROPE) WSF(float, lb, OFF_LB) WSF(float, tok_gate, OFF_TGATE) WSF(float, slot_gate, OFF_SGATE)
    WSF(int, ctr, OFF_CTR)
    WSF(int, wg_cnt, OFF_WGC) WSF(int2, slot_info, OFF_SINFO) WSF(int, block_expert, OFF_BEXP) WSF(int, slot_token, OFF_SLOT) WSF(int, slot_rank, OFF_SRANK) WSF(int, tok_exp, OFF_TEXP)
};

template <class ColMap>
__device__ __forceinline__ void convert_T8(const float* W, int ldw, unsigned char* out, int K, int N, const ColMap& cmap, float scale, int gt, int ntot) {
    const int kb = K / 64; const long ntask = (long)N * kb;
    for (long task = gt; task < ntask; task += ntot) {
        const int kq = (int)(task / N), n = (int)(task % N);
        const int c = cmap(n);
        uint32_t w[16];
        if (c >= 0) {
            const float* src = W + (size_t)(kq * 64) * ldw + c;
            float v[64];
#pragma unroll
            for (int i = 0; i < 64; ++i) v[i] = src[(size_t)i * ldw] * scale;
#pragma unroll
            for (int i = 0; i < 16; ++i) w[i] = pk4_fp8(v[4 * i], v[4 * i + 1], v[4 * i + 2], v[4 * i + 3]);
        } else {
#pragma unroll
            for (int i = 0; i < 16; ++i) w[i] = 0u;
        }
        uint4* dst = (uint4*)(out + (size_t)n * K + kq * 64);
#pragma unroll
        for (int i = 0; i < 4; ++i) dst[i] = make_uint4(w[4 * i], w[4 * i + 1], w[4 * i + 2], w[4 * i + 3]);
    }
}
template <class ColMap>
__device__ __forceinline__ void convert_T(const float* W, int ldw, bf16_t* out, int K, int N, const ColMap& cmap, int gt, int ntot) {
    const int kb = K / 64; const long ntask = (long)N * kb;
    for (long task = gt; task < ntask; task += ntot) {
        const int kq = (int)(task / N), n = (int)(task % N);
        const int c = cmap(n);
        uint32_t w[32];
        if (c >= 0) {
            const float* src = W + (size_t)(kq * 64) * ldw + c;
            float v[64];
#pragma unroll
            for (int i = 0; i < 64; ++i) v[i] = src[(size_t)i * ldw];
#pragma unroll
            for (int i = 0; i < 32; ++i) w[i] = pack2(v[2 * i], v[2 * i + 1]);
        } else {
#pragma unroll
            for (int i = 0; i < 32; ++i) w[i] = 0u;
        }
        uint4* dst = (uint4*)(out + (size_t)n * K + kq * 64);
#pragma unroll
        for (int i = 0; i < 8; ++i) dst[i] = make_uint4(w[4 * i], w[4 * i + 1], w[4 * i + 2], w[4 * i + 3]);
    }
}
struct IdMap { __device__ __forceinline__ int operator()(int n) const { return n; } };
struct WinMap { __device__ __forceinline__ int operator()(int n) const { return n < 1064 ? n : (n < 1280 ? -1 : n - 216); } };
struct WinMapIdx { __device__ __forceinline__ int operator()(int n) const { return WinMap{}(768 + n); } };

#define XB_TMO      128
#define XB_XCNT(j)  (256  + 64 * (j))
#define XB_XSUB(j)  (1280 + 64 * (j))
#define XB_XGEN(j)  (2304 + 64 * (j))
#define XB_TOP      3328
#define XB_TOPGEN   3392
#define XCD_BAR_WORDS 3456
#define XB_SPIN_CAP (1u << 22)
__device__ __forceinline__ unsigned xb_ld(unsigned* p)              { return __hip_atomic_load(p, __ATOMIC_RELAXED, __HIP_MEMORY_SCOPE_AGENT); }
__device__ __forceinline__ unsigned xb_add(unsigned* p, unsigned v) { return __hip_atomic_fetch_add(p, v, __ATOMIC_RELAXED, __HIP_MEMORY_SCOPE_AGENT); }
__device__ __forceinline__ unsigned xb_xcc_id() { return (unsigned)__builtin_amdgcn_s_getreg((3 << 11) | 20) & 0xFu; }
#define XB_SPIN(cond, bar) do { unsigned _sp = 0; while (cond) { __builtin_amdgcn_s_sleep(1); \
    if ((++_sp & 255u) == 0u) { if (xb_ld(&(bar)[XB_TMO])) break; if (_sp > XB_SPIN_CAP) { atomicAdd(&(bar)[XB_TMO], 1u); break; } } } } while (0)
struct XcdBarrier { unsigned* bar; unsigned x; volatile LAS unsigned* st; };
__device__ __forceinline__ XcdBarrier xcd_barrier_post(unsigned* bar, volatile LAS unsigned* st) {
    XcdBarrier b; b.bar = bar; b.x = xb_xcc_id(); b.st = st;
    if (threadIdx.x == 0) (void)xb_add(&bar[XB_XCNT(b.x)], 1u);
    return b;
}
__device__ __forceinline__ void xcd_barrier_complete(unsigned* bar, unsigned x, unsigned& nloc, unsigned& nx) {
    const unsigned G = gridDim.x * gridDim.y * gridDim.z;
    unsigned sum, cnt, mine, sp = 0u;
    for (;;) {
        sum = 0u; cnt = 0u; mine = 0u;
#pragma unroll
        for (unsigned j = 0; j < 16; ++j) { const unsigned c = xb_ld(&bar[XB_XCNT(j)]); sum += c; cnt += (c > 0u) ? 1u : 0u; mine = (j == x) ? c : mine; }
        if (sum == G) break;
        __builtin_amdgcn_s_sleep(1);
        if ((++sp & 255u) == 0u) { if (xb_ld(&bar[XB_TMO])) break; if (sp > XB_SPIN_CAP) { atomicAdd(&bar[XB_TMO], 1u); break; } }
    }
    nloc = mine > 0u ? mine : 1u; nx = cnt > 0u ? cnt : 1u;
}
__device__ __forceinline__ void xcd_barrier(const XcdBarrier& b) {
    asm volatile("s_waitcnt vmcnt(0)" ::: "memory");
    __syncthreads();
    if (threadIdx.x == 0) {
        unsigned* bar = b.bar;
        __builtin_amdgcn_s_waitcnt(0);
        unsigned nloc = b.st[0], nx = b.st[1];
        if (nloc == 0u) { xcd_barrier_complete(bar, b.x, nloc, nx); b.st[0] = nloc; b.st[1] = nx; }
        const unsigned old = xb_add(&bar[XB_XSUB(b.x)], 1u);
        const unsigned gen = old / nloc;
        if (old + 1u == (gen + 1u) * nloc) {
            __builtin_amdgcn_fence(__ATOMIC_RELEASE, "agent");
            asm volatile("s_waitcnt vmcnt(0)" ::: "memory");
            const unsigned og = xb_add(&bar[XB_TOP], 1u);
            const unsigned tg = og / nx;
            if (og + 1u == (tg + 1u) * nx) xb_add(&bar[XB_TOPGEN], 1u);
            else XB_SPIN(xb_ld(&bar[XB_TOPGEN]) == tg, bar);
            __builtin_amdgcn_fence(__ATOMIC_ACQUIRE, "agent");
            xb_add(&bar[XB_XGEN(b.x)], 1u);
            asm volatile("s_waitcnt vmcnt(0)" ::: "memory");
        } else {
            XB_SPIN(xb_ld(&bar[XB_XGEN(b.x)]) == gen, bar);
            __builtin_amdgcn_fence(__ATOMIC_ACQUIRE, "agent");
            asm volatile("s_waitcnt vmcnt(0)" ::: "memory");
        }
    }
    __syncthreads();
}

__device__ __forceinline__ void ph_prep(const P& p, unsigned char* lds) {
    const int tid = tid_(), lane = tid & 63, wid = tid >> 6;
    const int gw = blockIdx.x * 8 + wid, nw = gridDim.x * 8;
    for (int r = gw; r < T; r += nw) {
        const int b = r / LP, pos = r % LP;
        unsigned char* dst = p.xn8() + (size_t)r * D; bf16_t* dstb = p.xn() + (size_t)r * D;
        if (pos >= L) {
#pragma unroll
            for (int i = 0; i < 4; ++i) { *(uint32_t*)(dst + lane * 4 + 256 * i) = 0u; *(uint2*)(dstb + lane * 4 + 256 * i) = make_uint2(0u, 0u); }
            continue;
        }
        const float* src = pos < NMETA ? p.meta + (size_t)pos * D : p.x + ((size_t)b * SEQ + (pos - NMETA)) * D;
        f32x4 v[4]; float ss = 0.f;
#pragma unroll
        for (int i = 0; i < 4; ++i) { v[i] = *(const f32x4*)(src + lane * 4 + 256 * i); ss += v[i][0] * v[i][0] + v[i][1] * v[i][1] + v[i][2] * v[i][2] + v[i][3] * v[i][3]; }
        ss = wave_sum(ss);
        const float rs = rsqrtf(ss * (1.0f / D) + EPS);
#pragma unroll
        for (int i = 0; i < 4; ++i) {
            const f32x4 g = *(const f32x4*)(p.attn_g + lane * 4 + 256 * i);
            const float y0 = v[i][0] * rs * g[0], y1 = v[i][1] * rs * g[1], y2 = v[i][2] * rs * g[2], y3 = v[i][3] * rs * g[3];
            *(uint32_t*)(dst + lane * 4 + 256 * i) = pk4_fp8(y0, y1, y2, y3);
            uint2 o; o.x = pack2(y0, y1); o.y = pack2(y2, y3);
            *(uint2*)(dstb + lane * 4 + 256 * i) = o;
        }
    }
    const int gt = blockIdx.x * NTHREADS + tid, nt = gridDim.x * NTHREADS;
    for (int i = gt; i < LP * 12; i += nt) {
        const int pos = i / 12, f = i % 12;
        const double ex = f < 8 ? -(double)f / 8.0 : -(double)(f - 8) / 4.0;
        const double inv = exp(ex * log(500000.0));
        const double ang = (double)pos * inv;
        const double twopi = 6.283185307179586476925286766559;
        const double r = ang - twopi * rint(ang / twopi);
        const float rf = (float)r;
        const float c = cosf(rf), s = sinf(rf);
        float* row = p.rope() + (size_t)pos * 24;
        if (f < 8) { row[f] = c; row[8 + f] = s; } else { row[16 + f - 8] = c; row[20 + f - 8] = s; }
    }
    for (int i = gt; i < 512; i += nt) {
        const float a = p.lb_logits[i], b2 = p.lb_logits[512 + i];
        p.lb()[i] = 1.0f / (1.0f + expf(b2 - a));
    }
    for (int i = gt; i < 128; i += nt) p.ctr()[i] = 0;
    convert_T8(p.w_in, IN_COLS, p.winT8(), 1024, NVC, WinMap{}, 32.0f, gt, nt);
    convert_T(p.w_in, IN_COLS, p.winTb(), 1024, 512, WinMapIdx{}, gt, nt);
    convert_T(p.w_ua, 1024, p.wuaT(), 512, 1024, IdMap{}, gt, nt);
    convert_T(p.w_uh, 1024, p.wuhT(), 512, 1024, IdMap{}, gt, nt);
    convert_T(p.w_out, 1024, p.woT(), 1024, 1024, IdMap{}, gt, nt);
}
constexpr int G_TILE_B = 256 * 64 * 2, G_STAGE_B = 2 * G_TILE_B;
__device__ __forceinline__ int g_lds_byte(int r, int c) { const int st = (r >> 4) * 2 + (c >> 5), ob = (r & 15) * 64 + (c & 31) * 2; return st * 1024 + (ob ^ (((ob >> 9) & 1) << 5)); }
__device__ __forceinline__ void g_stage_rc(int b, int& R, int& C) { const int st = b >> 10, sb = b & 1023, swz = sb ^ (((sb >> 9) & 1) << 5); R = (st >> 1) * 16 + swz / 64; C = (st & 1) * 32 + (swz % 64) / 2; }

constexpr int HTB = 128 * 64 * 2;
struct GJob { const char* A; const char* B; unsigned va00, va01, va10, va11; };
__device__ __forceinline__ void gj_lin(unsigned (&v)[2][2], int ld) {
#pragma unroll
    for (int h = 0; h < 2; ++h)
#pragma unroll
        for (int i = 0; i < 2; ++i) { int R, C; g_stage_rc(tid_() * 16 + i * 8192, R, C); v[h][i] = (unsigned)(((h * 128 + R) * ld + C) * 2); }
}
template <class AOff>
__device__ __forceinline__ void gj_gather(unsigned (&v)[2][2], const AOff& aoff) {
#pragma unroll
    for (int h = 0; h < 2; ++h)
#pragma unroll
        for (int i = 0; i < 2; ++i) { int R, C; g_stage_rc(tid_() * 16 + i * 8192, R, C); v[h][i] = (unsigned)((aoff(h * 128 + R) + C) * 2); }
}
template <class AOff>
__device__ __forceinline__ void gj_gather_job(GJob& j, const AOff& aoff) {
    unsigned v[2][2]; gj_gather(v, aoff); j.va00 = v[0][0]; j.va01 = v[0][1]; j.va10 = v[1][0]; j.va11 = v[1][1];
}
template <bool GATHER, class JobFn, class Epi>
__device__ __forceinline__ void gemm_stream(unsigned char* lds_, int K, int lda, size_t hstepB, const unsigned (&vbU)[2], const JobFn& jobfn, const Epi& epi) {
    LAS unsigned char* lds = (LAS unsigned char*)lds_;
    const int tid = tid_(), wid = __builtin_amdgcn_readfirstlane(tid >> 6), lane = tid & 63, wr = wid >> 2, wc = wid & 3, fr = lane & 15, fq = lane >> 4;
    const int nt = K / 64;
    const size_t kstep = 128;
    const size_t hstepA = GATHER ? 0 : (size_t)128 * lda * 2;
    const unsigned ldsw = (unsigned)wid * 1024u;
    const int aoff = g_lds_byte(wr * 64 + fr, fq * 8), boff = g_lds_byte(wc * 32 + fr, fq * 8);
    unsigned vaU[2];
#pragma unroll
    for (int i = 0; i < 2; ++i) { int R, C; g_stage_rc(tid * 16 + i * 8192, R, C); vaU[i] = (unsigned)((R * lda + C) * 2); }
#define PG8_SA(b, h) (((b) * 2 + (h)) * HTB)
#define PG8_SB(b, h) ((4 + (b) * 2 + (h)) * HTB)
#define PG8_STAGE2(bufoff, gbase, v0, v1) do { \
        __builtin_amdgcn_global_load_lds((const unsigned*)((const char*)(gbase) + (v0)), (LAS unsigned*)(lds + (bufoff) + ldsw), 16, 0, 0); \
        __builtin_amdgcn_global_load_lds((const unsigned*)((const char*)(gbase) + (v1)), (LAS unsigned*)(lds + (bufoff) + ldsw + 8192), 16, 0, 0); } while (0)
#define STB(bufoff, gbase, h) PG8_STAGE2(bufoff, (gbase) + ((h) ? hstepB : 0), vbU[0], vbU[1])
#define STA_CUR(bufoff, gbase, h) do { if (GATHER) PG8_STAGE2(bufoff, gbase, (h) ? cur.va10 : cur.va00, (h) ? cur.va11 : cur.va01); else PG8_STAGE2(bufoff, (gbase) + ((h) ? hstepA : 0), vaU[0], vaU[1]); } while (0)
#define STA_SEL(bufoff, gbase, h) do { if (GATHER) PG8_STAGE2(bufoff, gbase, last ? ((h) ? nxt.va10 : nxt.va00) : ((h) ? cur.va10 : cur.va00), last ? ((h) ? nxt.va11 : nxt.va01) : ((h) ? cur.va11 : cur.va01)); \
        else PG8_STAGE2(bufoff, (gbase) + ((h) ? hstepA : 0), vaU[0], vaU[1]); } while (0)
#define PG8_LDA(dst, b, h) do { _Pragma("unroll") for (int m = 0; m < 4; ++m) _Pragma("unroll") for (int k = 0; k < 2; ++k) dst[m][k] = *(const LAS bf16x8*)(lds + PG8_SA(b, h) + aoff + m * 2048 + k * 1024); } while (0)
#define PG8_LDB(dst, b, h) do { _Pragma("unroll") for (int n = 0; n < 2; ++n) _Pragma("unroll") for (int k = 0; k < 2; ++k) dst[n][k] = *(const LAS bf16x8*)(lds + PG8_SB(b, h) + boff + n * 2048 + k * 1024); } while (0)
#define PG8_MMA(ai, bj, At, Bt) do { __builtin_amdgcn_s_setprio(1); _Pragma("unroll") for (int m = 0; m < 4; ++m) _Pragma("unroll") for (int n = 0; n < 2; ++n) _Pragma("unroll") for (int k = 0; k < 2; ++k) \
        acc[ai][bj][m][n] = __builtin_amdgcn_mfma_f32_16x16x32_bf16(Bt[n][k], At[m][k], acc[ai][bj][m][n], 0, 0, 0); __builtin_amdgcn_s_setprio(0); } while (0)
#define PG8_WAIT_V(n) asm volatile("s_waitcnt vmcnt(" #n ")" ::: "memory")
#define PG8_WAIT_L(n) asm volatile("s_waitcnt lgkmcnt(" #n ")" ::: "memory")
#define PG8_BAR __builtin_amdgcn_s_barrier()
#define PG8_SCHED __builtin_amdgcn_sched_barrier(0)
    GJob cur, nxt; int ui = 0;
    cur.A = nullptr; cur.B = nullptr; cur.va00 = cur.va01 = cur.va10 = cur.va11 = 0u; nxt = cur;
    if (!jobfn(0, cur)) return;
    f32x4 acc[2][2][4][2];
#pragma unroll
    for (int a = 0; a < 2; ++a)
#pragma unroll
        for (int b = 0; b < 2; ++b)
#pragma unroll
            for (int m = 0; m < 4; ++m)
#pragma unroll
                for (int n = 0; n < 2; ++n) acc[a][b][m][n] = (f32x4){0.f, 0.f, 0.f, 0.f};
    bf16x8 At[4][2], B0[2][2], B1[2][2];
    STB(PG8_SB(0, 0), cur.B, 0); STB(PG8_SB(0, 1), cur.B, 1); STA_CUR(PG8_SA(0, 0), cur.A, 0); STA_CUR(PG8_SA(0, 1), cur.A, 1);
    if (wr == 1) PG8_BAR;
    PG8_WAIT_V(2); PG8_BAR;
    STB(PG8_SB(1, 0), cur.B + kstep, 0); STA_CUR(PG8_SA(1, 0), cur.A + kstep, 0); STB(PG8_SB(1, 1), cur.B + kstep, 1);
    PG8_WAIT_V(6); PG8_BAR;
    for (;;) {
        bool has_next = false;
        for (int t = 0; t < nt; t += 2) {
            const bool last = (t == nt - 2);
            if (last) { has_next = jobfn(ui + 1, nxt); if (!has_next) nxt = cur; }
            const char* a1 = cur.A + (size_t)(t + 1) * kstep;
            const char* a2 = last ? nxt.A : cur.A + (size_t)(t + 2) * kstep; const char* b2 = last ? nxt.B : cur.B + (size_t)(t + 2) * kstep;
            const char* a3 = a2 + kstep; const char* b3 = b2 + kstep;
            PG8_LDB(B0, 0, 0); PG8_LDB(B1, 0, 1); PG8_SCHED; PG8_LDA(At, 0, 0); STA_CUR(PG8_SA(1, 1), a1, 1);
            PG8_WAIT_V(8); PG8_WAIT_L(0); PG8_BAR; PG8_MMA(0, 0, At, B0); PG8_MMA(0, 1, At, B1); PG8_BAR; PG8_SCHED;
            PG8_LDA(At, 0, 1); STB(PG8_SB(0, 0), b2, 0); STB(PG8_SB(0, 1), b2, 1); STA_SEL(PG8_SA(0, 0), a2, 0);
            PG8_WAIT_V(8); PG8_WAIT_L(0); PG8_BAR; PG8_MMA(1, 0, At, B0); PG8_MMA(1, 1, At, B1); PG8_BAR; PG8_SCHED;
            PG8_LDB(B0, 1, 0); PG8_LDB(B1, 1, 1); PG8_SCHED; PG8_LDA(At, 1, 0); STA_SEL(PG8_SA(0, 1), a2, 1);
            PG8_WAIT_V(8); PG8_WAIT_L(0); PG8_BAR; PG8_MMA(0, 0, At, B0); PG8_MMA(0, 1, At, B1); PG8_BAR; PG8_SCHED;
            PG8_LDA(At, 1, 1); STB(PG8_SB(1, 0), b3, 0); STB(PG8_SB(1, 1), b3, 1); STA_SEL(PG8_SA(1, 0), a3, 0);
            PG8_WAIT_V(8); PG8_WAIT_L(0); PG8_BAR; PG8_MMA(1, 0, At, B0); PG8_MMA(1, 1, At, B1); PG8_BAR; PG8_SCHED;
        }
        if (wr == 0) PG8_BAR;
        epi(acc, ui);
        if (!has_next) break;
#pragma unroll
        for (int a = 0; a < 2; ++a)
#pragma unroll
            for (int b = 0; b < 2; ++b)
#pragma unroll
                for (int m = 0; m < 4; ++m)
#pragma unroll
                    for (int n = 0; n < 2; ++n) acc[a][b][m][n] = (f32x4){0.f, 0.f, 0.f, 0.f};
        cur = nxt; ++ui;
        if (wr == 1) PG8_BAR;
    }
    PG8_WAIT_V(0);
    PG8_BAR;
#undef PG8_SA
#undef PG8_SB
#undef PG8_STAGE2
#undef STB
#undef STA_CUR
#undef STA_SEL
#undef PG8_LDA
#undef PG8_LDB
#undef PG8_MMA
#undef PG8_WAIT_V
#undef PG8_WAIT_L
#undef PG8_BAR
#undef PG8_SCHED
}
__device__ __forceinline__ void gj_lin2(unsigned (&v)[2], int ld) {
#pragma unroll
    for (int i = 0; i < 2; ++i) { int R, C; g_stage_rc(tid_() * 16 + i * 8192, R, C); v[i] = (unsigned)((R * ld + C) * 2); }
}
typedef int i32x8 __attribute__((ext_vector_type(8)));
typedef unsigned u32x4 __attribute__((ext_vector_type(4)));
struct G8Job { const char* A; const char* B; unsigned va0, va1, va2, va3; };
__device__ __forceinline__ void g8_rc(int i, int& R, int& Cb) { int C; g_stage_rc(tid_() * 16 + i * 8192, R, C); Cb = C * 2; }
__device__ __forceinline__ const char* uni_ptr8(const char* p) {
    const unsigned long long v = (unsigned long long)p;
    const unsigned lo = __builtin_amdgcn_readfirstlane((unsigned)v), hi = __builtin_amdgcn_readfirstlane((unsigned)(v >> 32));
    return (const char*)(((unsigned long long)hi << 32) | lo);
}
template <bool GATHER, class JobFn, class Epi>
__device__ __forceinline__ void gemm8_stream(unsigned char* lds_, const unsigned (&vbU)[4], const JobFn& jobfn, const Epi& epi) {
    LAS unsigned char* lds = (LAS unsigned char*)lds_;
    const int tid = tid_(), wid = __builtin_amdgcn_readfirstlane(tid >> 6), lane = tid & 63, wr = wid >> 2, wc = wid & 3, fr = lane & 15, fq = lane >> 4;
    LAS unsigned char* a0p = lds + g_lds_byte(wr * 64 + fr, fq * 8); LAS unsigned char* a1p = a0p + 65536;
    LAS unsigned char* b0p = lds + 32768 + g_lds_byte(wc * 32 + fr, fq * 8); LAS unsigned char* b1p = b0p + 65536;
    const unsigned ldsw_u = __builtin_amdgcn_readfirstlane((unsigned)(size_t)(lds + wid * 1024));
#define G8_GLDS(base, voff, ldsaddr) asm volatile("s_mov_b32 m0, %2\n\ts_nop 0\n\tglobal_load_lds_dwordx4 %0, %1" :: "v"(voff), "s"(base), "s"(ldsaddr) : "memory", "m0")
#define G8_DMA(JA, JB, v0, v1, v2, v3, buf, kt) do { \
        const char* pa_ = uni_ptr8(JA) + (kt) * 128; const char* pb_ = uni_ptr8(JB) + (kt) * 128; const unsigned d_ = ldsw_u + (buf) * 65536; \
        G8_GLDS(pa_, (GATHER ? v0 : vb0), d_); \
        G8_GLDS(pa_, (GATHER ? v1 : vb1), d_ + 8192); \
        G8_GLDS(pa_, (GATHER ? v2 : vb2), d_ + 16384); \
        G8_GLDS(pa_, (GATHER ? v3 : vb3), d_ + 24576); \
        G8_GLDS(pb_, vb0, d_ + 32768); \
        G8_GLDS(pb_, vb1, d_ + 32768 + 8192); \
        G8_GLDS(pb_, vb2, d_ + 32768 + 16384); \
        G8_GLDS(pb_, vb3, d_ + 32768 + 24576); } while (0)
#define G8_LD(dst, ptr) do { const u32x4 x0_ = *(const LAS u32x4*)(ptr), x1_ = *(const LAS u32x4*)((ptr) + 1024); \
        dst = (i32x8){(int)x0_.x, (int)x0_.y, (int)x0_.z, (int)x0_.w, (int)x1_.x, (int)x1_.y, (int)x1_.z, (int)x1_.w}; } while (0)
#define G8_LDA(dst, ap, ai, m0, m1) do { _Pragma("unroll") for (int m = m0; m < m1; ++m) G8_LD(dst[m], (ap) + (ai) * 16384 + m * 2048); } while (0)
#define G8_LDB(dst, bp, bj) do { _Pragma("unroll") for (int n = 0; n < 2; ++n) G8_LD(dst[n], (bp) + (bj) * 16384 + n * 2048); } while (0)
#define G8_MMA(ai, bj, At, Bt) do { __builtin_amdgcn_sched_barrier(0); __builtin_amdgcn_s_setprio(1); _Pragma("unroll") for (int m = 0; m < 4; ++m) _Pragma("unroll") for (int n = 0; n < 2; ++n) \
        asm("v_mfma_scale_f32_16x16x128_f8f6f4 %0, %1, %2, %0, %3, %3 op_sel_hi:[0,0,0]" : "+v"(acc[ai][bj][m][n]) : "v"(Bt[n]), "v"(At[m]), "v"(unit_scale)); \
        __builtin_amdgcn_s_setprio(0); __builtin_amdgcn_sched_barrier(0); } while (0)
#define G8_PF 2
#define G8_TILE(buf, ap, bp, apn, bpn, X, Y, kt) do { \
        G8_LDA(P, ap, 0, G8_PF, 4); G8_LDB(Y, bp, 1); G8_MMA(0, 0, P, X); \
        G8_LDA(Q, ap, 1, 0, 2);                       G8_MMA(0, 1, P, Y); \
        G8_LDA(Q, ap, 1, 2, 4);                       G8_MMA(1, 1, Q, Y); \
        asm volatile("" ::: "memory"); __builtin_amdgcn_s_waitcnt(0x0070); __builtin_amdgcn_s_barrier(); asm volatile("" ::: "memory"); \
        asm volatile("" : "+v"(vb0), "+v"(vb1), "+v"(vb2), "+v"(vb3), "+v"(cur.va0), "+v"(cur.va1), "+v"(cur.va2), "+v"(cur.va3)); \
        G8_DMA(selA, selB, cur.va0, cur.va1, cur.va2, cur.va3, buf, kt); \
        G8_LDA(P, apn, 0, 0, G8_PF); G8_LDB(Y, bpn, 0); \
        G8_MMA(1, 0, Q, X); } while (0)
    G8Job cur, nxt;
    cur.A = nullptr; cur.B = nullptr; cur.va0 = cur.va1 = cur.va2 = cur.va3 = 0u; nxt = cur;
    if (!jobfn(0, cur)) return;
    cur.A = uni_ptr8(cur.A); cur.B = uni_ptr8(cur.B);
    unsigned vb0 = vbU[0], vb1 = vbU[1], vb2 = vbU[2], vb3 = vbU[3];
    G8_DMA(cur.A, cur.B, cur.va0, cur.va1, cur.va2, cur.va3, 0, 0); G8_DMA(cur.A, cur.B, cur.va0, cur.va1, cur.va2, cur.va3, 1, 1);
    asm volatile("s_waitcnt vmcnt(0)" ::: "memory");
    __syncthreads();
    int ui = 0;
    for (;;) {
        f32x4 acc[2][2][4][2];
#pragma unroll
        for (int a = 0; a < 2; ++a)
#pragma unroll
            for (int b = 0; b < 2; ++b)
#pragma unroll
                for (int m = 0; m < 4; ++m)
#pragma unroll
                    for (int n = 0; n < 2; ++n) acc[a][b][m][n] = (f32x4){0.f, 0.f, 0.f, 0.f};
        const bool has_next = jobfn(ui + 1, nxt);
        nxt.A = uni_ptr8(nxt.A); nxt.B = uni_ptr8(nxt.B);
        if (!has_next) nxt = cur;
        i32x8 P[4], Q[4], X[2], Y[2];
        const int unit_scale = 0x7f7f7f7f;
        G8_LDA(P, a0p, 0, 0, G8_PF); G8_LDB(X, b0p, 0);
#pragma unroll 1
        for (int t2 = 0; t2 < 4; ++t2) {
            const bool lastp = t2 == 3;
            const char* selA = lastp ? nxt.A : cur.A; const char* selB = lastp ? nxt.B : cur.B;
            if (GATHER) { cur.va0 = lastp ? nxt.va0 : cur.va0; cur.va1 = lastp ? nxt.va1 : cur.va1; cur.va2 = lastp ? nxt.va2 : cur.va2; cur.va3 = lastp ? nxt.va3 : cur.va3; }
            const int kt0 = lastp ? 0 : 2 * t2 + 2;
            asm volatile("" : "+v"(a0p), "+v"(a1p), "+v"(b0p), "+v"(b1p));
            G8_TILE(0, a0p, b0p, a1p, b1p, X, Y, kt0);
            G8_TILE(1, a1p, b1p, a0p, b0p, Y, X, kt0 + 1);
        }
        asm volatile("s_nop 15\n\ts_nop 15" ::: "memory");
        epi(acc, ui);
        if (!has_next) break;
        cur.A = nxt.A; cur.B = nxt.B; ++ui;
    }
#undef G8_TILE
#undef G8_PF
#undef G8_MMA
#undef G8_LDB
#undef G8_LDA
#undef G8_LD
#undef G8_DMA
#undef G8_GLDS
    __syncthreads();
}
struct RowLin { size_t base; int ld; __device__ __forceinline__ size_t operator()(int R) const { return base + (size_t)R * ld; } };

__device__ __forceinline__ void st_bf4(bf16_t* dst, f32x4 v) {
    uint2 o; o.x = pack2(v[0], v[1]); o.y = pack2(v[2], v[3]); *(uint2*)dst = o;
}
#define EPI8(...) do { const int tid_e = tid_(), lane_e = tid_e & 63, wid_e = tid_e >> 6, wr = wid_e >> 2, wc = wid_e & 3, fr = lane_e & 15, fq = lane_e >> 4; \
    _Pragma("unroll") for (int ai = 0; ai < 2; ++ai) _Pragma("unroll") for (int m = 0; m < 4; ++m) _Pragma("unroll") for (int bj = 0; bj < 2; ++bj) _Pragma("unroll") for (int n = 0; n < 2; ++n) { \
        const int row = ai * 128 + wr * 64 + m * 16 + fr, col = bj * 128 + wc * 32 + n * 16 + fq * 4; const f32x4 v = acc[ai][bj][m][n]; __VA_ARGS__ } } while (0)

struct EpiInproj {
    const P* p; int nt;
    __device__ __forceinline__ void operator()(int m, int n, int fq, f32x4 v) const {
        const P& P_ = *p;
        const int pos = m % LP;
        const float* rp = P_.rope() + (size_t)pos * 24;
        if (nt <= 2) {
            const bool isv = (nt == 2) && (n >= 128);
            if (!isv && (n & 48) == 0) {
                f32x4 pr;
#pragma unroll
                for (int j = 0; j < 4; ++j) pr[j] = __shfl_xor(v[j], 32);
                const int i0 = (fq & 1) * 4;
#pragma unroll
                for (int j = 0; j < 4; ++j) {
                    const float c = rp[i0 + j], s = rp[8 + i0 + j];
                    v[j] = fq < 2 ? v[j] * c - pr[j] * s : v[j] * c + pr[j] * s;
                }
            }
            if (nt < 2) { st_bf4(P_.q() + (size_t)m * 512 + nt * 256 + n, v * (0.125f * 1.4426950408889634f)); }
            else if (n < 128) st_bf4(P_.k() + (size_t)m * 128 + n, v);
            else st_bf4(P_.v() + (size_t)m * 128 + (n - 128), v);
        } else if (nt == 3 || nt == 4) {
            const bool ropeable = (nt == 3) ? ((n & 16) == 0) : (n < 16);
            if (ropeable) {
                f32x4 pr;
#pragma unroll
                for (int j = 0; j < 4; ++j) pr[j] = __shfl_xor(v[j], 16);
                if (fq < 2) {
#pragma unroll
                    for (int j = 0; j < 4; ++j) {
                        const float c = rp[16 + j], s = rp[20 + j];
                        v[j] = fq == 0 ? v[j] * c - pr[j] * s : v[j] * c + pr[j] * s;
                    }
                }
            }
            if (nt == 3) st_bf4(P_.iq() + (size_t)m * 256 + n, v);
            else if (n < 32) st_bf4(P_.ik() + (size_t)m * 32 + n, v);
            else if (n < 40) *(f32x4*)(P_.iw() + (size_t)m * 8 + (n - 32)) = v;
        } else if (nt <= 6) { st_bf4(P_.hq() + (size_t)m * 512 + (nt - 5) * 256 + n, v * 0.08838834764831845f); }
        else if (nt <= 8) { st_bf4(P_.hf() + (size_t)m * 512 + (nt - 7) * 256 + n, v); }
        else if (nt <= 10) { st_bf4(P_.hi() + (size_t)m * 512 + (nt - 9) * 256 + n, v); }
        else if (nt <= 12) {
            f32x4 o;
#pragma unroll
            for (int j = 0; j < 4; ++j) o[j] = v[j] * sigmoidf_(v[j]);
            st_bf4(P_.hg() + (size_t)m * 512 + (nt - 11) * 256 + n, o);
        } else {
            f32x4 o;
#pragma unroll
            for (int j = 0; j < 4; ++j) o[j] = sigmoidf_(v[j]);
            if (nt <= 16) st_bf4(P_.ga() + (size_t)m * 1024 + (nt - 13) * 256 + n, o);
            else st_bf4(P_.gh() + (size_t)m * 1024 + (nt - 17) * 256 + n, o);
        }
    }
};

__device__ __forceinline__ void ph_inproj(const P& p, unsigned char* lds) {
    const int G = gridDim.x, b0 = blockIdx.x;
    {
        const int nunits = (T / 256) * 2;
        auto jobfn = [&](int i, GJob& j) __attribute__((always_inline)) -> bool {
            const int u = b0 + i * G; if (u >= nunits) return false;
            const int nt = 3 + (u & 1), mt = u >> 1;
            j.A = (const char*)(p.xn() + (size_t)mt * 256 * D); j.B = (const char*)(p.winTb() + (size_t)(nt - 3) * 256 * D); return true; };
        auto epi = [&](f32x4 (&acc)[2][2][4][2], int i) __attribute__((always_inline)) {
            const int u = b0 + i * G, nt = 3 + (u & 1), mt = u >> 1;
            const EpiInproj e{&p, nt};
            EPI8( e(mt * 256 + row, col, fq, v); );
        };
        unsigned vbU[2]; gj_lin2(vbU, D);
        gemm_stream<false>(lds, D, D, (size_t)128 * D * 2, vbU, jobfn, epi);
    }
    {
        const int nunits = (T / 256) * 19, br = G - 1 - b0;
        auto jobfn = [&](int i, G8Job& j) __attribute__((always_inline)) -> bool {
            const int u = br + i * G; if (u >= nunits) return false;
            const int n19 = u % 19, nt = n19 < 3 ? n19 : n19 + 2, mt = u / 19;
            j.A = (const char*)(p.xn8() + (size_t)mt * 256 * D); j.B = (const char*)(p.winT8() + (size_t)nt * 256 * D); return true; };
        auto epi = [&](f32x4 (&acc)[2][2][4][2], int i) __attribute__((always_inline)) {
            const int u = br + i * G, n19 = u % 19, nt = n19 < 3 ? n19 : n19 + 2, mt = u / 19;
            const EpiInproj e{&p, nt};
            EPI8( e(mt * 256 + row, col, fq, v * 0.03125f); );
        };
        unsigned vbU[4];
#pragma unroll
        for (int q = 0; q < 4; ++q) { int R, Cb; g8_rc(q, R, Cb); vbU[q] = (unsigned)(R * D + Cb); }
        gemm8_stream<false>(lds, vbU, jobfn, epi);
    }
}
constexpr int NCH = 129, NXU = 16 * NCH;
constexpr int X_QT = 0, X_KT = X_QT + 64 * 272, X_KH = X_KT + 64 * 272, X_VT = X_KH + 128 * 144, X_AS = X_VT + 128 * 144, X_SEG = X_AS + 64 * 144;
__device__ __forceinline__ bf16_t* hg_ds(const P& p) { return (bf16_t*)p.out; }
__device__ __forceinline__ float* hg_g(const P& p) { return (float*)((unsigned char*)p.out + (size_t)NXU * 32768); }

__device__ __forceinline__ void hgx_unit(const P& p, unsigned char* lds, int u) {
    const int tid = tid_(), lane = tid & 63, wid = tid >> 6, fr = lane & 15, fq = lane >> 4;
    const int c = u % NCH, bh = u / NCH, b = bh >> 2, h = bh & 3;
    const int d = tid & 127, seg = tid >> 7;
    const size_t rowbase = (size_t)(b * LP + c * 64 + seg * 16) * 512 + h * 128 + d;
    bf16_t* hqp = p.hq() + rowbase; const bf16_t* hfp = p.hf() + rowbase; const bf16_t* hip = p.hi() + rowbase;
    const float lbv = p.lb()[h * 128 + d];
    float bb[16], qv[16], kk[16], vv[16];
    float cs = 0.f;
#pragma unroll
    for (int i = 0; i < 16; ++i) {
        const float f = lbv + (1.0f - lbv) * sigmoidf_(bf2f(hfp[(size_t)i * 512]));
        kk[i] = 1.0f - f; cs += __logf(f); bb[i] = cs;
        qv[i] = bf2f(hqp[(size_t)i * 512]); vv[i] = bf2f(hip[(size_t)i * 512]);
    }
    float* segs = (float*)(lds + X_SEG);
    segs[seg * 128 + d] = cs;
    __syncthreads();
    const float s0 = segs[d], s1 = segs[128 + d], s2 = segs[256 + d], s3 = segs[384 + d];
    const float off = seg == 0 ? 0.f : (seg == 1 ? s0 : (seg == 2 ? s0 + s1 : s0 + s1 + s2));
    const float rref = s0 + s1, blast = (s0 + s1) + (s2 + s3);
    uint32_t khp[8], vtp[8];
#pragma unroll
    for (int i = 0; i < 16; i += 2) {
        float khv[2];
#pragma unroll
        for (int j = 0; j < 2; ++j) {
            const float bt = bb[i + j] + off;
            const float eq = __expf(fminf(bt - rref, 80.f)), ek = __expf(fminf(rref - bt, 80.f));
            const int t = seg * 16 + i + j;
            *(bf16_t*)(lds + X_QT + t * 272 + d * 2) = f2bf(qv[i + j] * eq);
            *(bf16_t*)(lds + X_KT + t * 272 + d * 2) = f2bf(kk[i + j] * ek);
            hqp[(size_t)(i + j) * 512] = f2bf(qv[i + j] * __expf(bt));
            khv[j] = kk[i + j] * __expf(blast - bt);
        }
        khp[i >> 1] = pack2(khv[0], khv[1]); vtp[i >> 1] = pack2(vv[i], vv[i + 1]);
    }
    *(uint4*)(lds + X_KH + d * 144 + seg * 32) = make_uint4(khp[0], khp[1], khp[2], khp[3]);
    *(uint4*)(lds + X_KH + d * 144 + seg * 32 + 16) = make_uint4(khp[4], khp[5], khp[6], khp[7]);
    *(uint4*)(lds + X_VT + d * 144 + seg * 32) = make_uint4(vtp[0], vtp[1], vtp[2], vtp[3]);
    *(uint4*)(lds + X_VT + d * 144 + seg * 32 + 16) = make_uint4(vtp[4], vtp[5], vtp[6], vtp[7]);
    if (seg == 0) hg_g(p)[(size_t)u * 128 + d] = __expf(blast);
    __syncthreads();
    {
        const int tm = wid >> 1, tn0 = (wid & 1) * 2;
        f32x4 a1[2] = {(f32x4){0.f, 0.f, 0.f, 0.f}, (f32x4){0.f, 0.f, 0.f, 0.f}};
#pragma unroll
        for (int ks = 0; ks < 4; ++ks) {
            const bf16x8 aq = *(const bf16x8*)(lds + X_QT + (tm * 16 + fr) * 272 + (ks * 32 + fq * 8) * 2);
#pragma unroll
            for (int j = 0; j < 2; ++j) {
                const bf16x8 bk = *(const bf16x8*)(lds + X_KT + ((tn0 + j) * 16 + fr) * 272 + (ks * 32 + fq * 8) * 2);
                a1[j] = __builtin_amdgcn_mfma_f32_16x16x32_bf16(bk, aq, a1[j], 0, 0, 0);
            }
        }
#pragma unroll
        for (int j = 0; j < 2; ++j) {
            const int t = tm * 16 + fr, sb = (tn0 + j) * 16 + fq * 4;
            f32x4 v = a1[j];
#pragma unroll
            for (int jj = 0; jj < 4; ++jj) v[jj] = (sb + jj <= t) ? v[jj] : 0.f;
            uint2 o; o.x = pack2(v[0], v[1]); o.y = pack2(v[2], v[3]);
            *(uint2*)(lds + X_AS + t * 144 + sb * 2) = o;
        }
    }
    __syncthreads();
    {
        const int tm = wid >> 1, en0 = (wid & 1) * 4;
        f32x4 o2[4];
#pragma unroll
        for (int j = 0; j < 4; ++j) o2[j] = (f32x4){0.f, 0.f, 0.f, 0.f};
#pragma unroll
        for (int ks = 0; ks < 2; ++ks) {
            const bf16x8 aa = *(const bf16x8*)(lds + X_AS + (tm * 16 + fr) * 144 + (ks * 32 + fq * 8) * 2);
#pragma unroll
            for (int j = 0; j < 4; ++j) {
                const bf16x8 bv = *(const bf16x8*)(lds + X_VT + ((en0 + j) * 16 + fr) * 144 + (ks * 32 + fq * 8) * 2);
                o2[j] = __builtin_amdgcn_mfma_f32_16x16x32_bf16(bv, aa, o2[j], 0, 0, 0);
            }
        }
        bf16_t* orow = p.hf() + (size_t)(b * LP + c * 64 + tm * 16 + fr) * 512 + h * 128;
#pragma unroll
        for (int j = 0; j < 4; ++j) st_bf4(orow + (en0 + j) * 16 + fq * 4, o2[j]);
    }
    {
        f32x4 s3[8];
#pragma unroll
        for (int j = 0; j < 8; ++j) s3[j] = (f32x4){0.f, 0.f, 0.f, 0.f};
#pragma unroll
        for (int ks = 0; ks < 2; ++ks) {
            const bf16x8 ak = *(const bf16x8*)(lds + X_KH + (wid * 16 + fr) * 144 + (ks * 32 + fq * 8) * 2);
#pragma unroll
            for (int j = 0; j < 8; ++j) {
                const bf16x8 bv = *(const bf16x8*)(lds + X_VT + (j * 16 + fr) * 144 + (ks * 32 + fq * 8) * 2);
                s3[j] = __builtin_amdgcn_mfma_f32_16x16x32_bf16(ak, bv, s3[j], 0, 0, 0);
            }
        }
        bf16_t* dsb = hg_ds(p) + (size_t)u * 16384;
#pragma unroll
        for (int j = 0; j < 8; ++j) st_bf4(dsb + (size_t)(j * 16 + fr) * 128 + wid * 16 + fq * 4, s3[j]);
    }
    __syncthreads();
}

__device__ __forceinline__ void hgchain_unit(const P& p, int item) {
    const int tid = tid_(), bh = item >> 2, eq = item & 3;
    const int e = eq * 32 + (tid >> 4), d0 = (tid & 15) * 8;
    float S[8];
#pragma unroll
    for (int i = 0; i < 8; ++i) S[i] = 0.f;
    uint4* ptr = (uint4*)(hg_ds(p) + ((size_t)(bh * NCH) * 128 + e) * 128 + d0);
    const f32x4* gp = (const f32x4*)(hg_g(p) + (size_t)(bh * NCH) * 128 + d0);
    uint4 wq[8]; f32x4 g0[8], g1[8];
#pragma unroll
    for (int k = 0; k < 8; ++k) { wq[k] = ptr[(size_t)k * 2048]; g0[k] = gp[k * 32]; g1[k] = gp[k * 32 + 1]; }
    for (int c0 = 0; c0 < NCH; c0 += 8) {
#pragma unroll
        for (int k = 0; k < 8; ++k) {
            const int c = c0 + k;
            if (c < NCH) {
                const uint4 w = wq[k]; const f32x4 ga = g0[k], gb = g1[k];
                if (c + 8 < NCH) { wq[k] = ptr[(size_t)(c + 8) * 2048]; g0[k] = gp[(c + 8) * 32]; g1[k] = gp[(c + 8) * 32 + 1]; }
                ptr[(size_t)c * 2048] = make_uint4(pack2(S[0], S[1]), pack2(S[2], S[3]), pack2(S[4], S[5]), pack2(S[6], S[7]));
                S[0] = ga[0] * S[0] + __uint_as_float(w.x << 16); S[1] = ga[1] * S[1] + __uint_as_float(w.x & 0xffff0000u);
                S[2] = ga[2] * S[2] + __uint_as_float(w.y << 16); S[3] = ga[3] * S[3] + __uint_as_float(w.y & 0xffff0000u);
                S[4] = gb[0] * S[4] + __uint_as_float(w.z << 16); S[5] = gb[1] * S[5] + __uint_as_float(w.z & 0xffff0000u);
                S[6] = gb[2] * S[6] + __uint_as_float(w.w << 16); S[7] = gb[3] * S[7] + __uint_as_float(w.w & 0xffff0000u);
            }
        }
    }
}

__device__ __forceinline__ void hgz_unit(const P& p, unsigned char* lds, int u) {
    const int tid = tid_(), lane = tid & 63, wid = tid >> 6, fr = lane & 15, fq = lane >> 4;
    const int c = u % NCH, bh = u / NCH, b = bh >> 2, h = bh & 3;
    const int tm = wid >> 1, en0 = (wid & 1) * 4;
    const size_t row = (size_t)(b * LP + c * 64 + tm * 16 + fr);
    const bf16_t* qrow = p.hq() + row * 512 + h * 128;
    const bf16_t* sT = hg_ds(p) + (size_t)u * 16384;
    f32x4 o[4];
#pragma unroll
    for (int j = 0; j < 4; ++j) o[j] = (f32x4){0.f, 0.f, 0.f, 0.f};
#pragma unroll
    for (int ks = 0; ks < 4; ++ks) {
        const bf16x8 aq = *(const bf16x8*)(qrow + ks * 32 + fq * 8);
#pragma unroll
        for (int j = 0; j < 4; ++j) {
            const bf16x8 bs = *(const bf16x8*)(sT + (size_t)((en0 + j) * 16 + fr) * 128 + ks * 32 + fq * 8);
            o[j] = __builtin_amdgcn_mfma_f32_16x16x32_bf16(bs, aq, o[j], 0, 0, 0);
        }
    }
    const bf16_t* oi = p.hf() + row * 512 + h * 128;
    float ss = 0.f;
#pragma unroll
    for (int j = 0; j < 4; ++j) {
        const uint2 w = *(const uint2*)(oi + (en0 + j) * 16 + fq * 4);
        o[j][0] += __uint_as_float(w.x << 16); o[j][1] += __uint_as_float(w.x & 0xffff0000u);
        o[j][2] += __uint_as_float(w.y << 16); o[j][3] += __uint_as_float(w.y & 0xffff0000u);
        ss += o[j][0] * o[j][0] + o[j][1] * o[j][1] + o[j][2] * o[j][2] + o[j][3] * o[j][3];
    }
    ss += __shfl_xor(ss, 16); ss += __shfl_xor(ss, 32);
    float* part = (float*)lds;
    if (fq == 0) part[(tm * 16 + fr) * 2 + (wid & 1)] = ss;
    __syncthreads();
    const float tot = part[(tm * 16 + fr) * 2] + part[(tm * 16 + fr) * 2 + 1];
    const float rs = rsqrtf(tot * (1.0f / 128.0f) + EPS);
    const bf16_t* hgp = p.hg() + row * 512 + h * 128;
    bf16_t* outp = p.hgr() + row * 512 + h * 128;
#pragma unroll
    for (int j = 0; j < 4; ++j) {
        const int e0 = (en0 + j) * 16 + fq * 4;
        const f32x4 gn = *(const f32x4*)(p.hgrn_g + h * 128 + e0);
        const uint2 w = *(const uint2*)(hgp + e0);
        f32x4 r;
        r[0] = o[j][0] * rs * gn[0] * __uint_as_float(w.x << 16); r[1] = o[j][1] * rs * gn[1] * __uint_as_float(w.x & 0xffff0000u);
        r[2] = o[j][2] * rs * gn[2] * __uint_as_float(w.y << 16); r[3] = o[j][3] * rs * gn[3] * __uint_as_float(w.y & 0xffff0000u);
        st_bf4(outp + e0, r);
    }
    __syncthreads();
}

typedef float f32x16 __attribute__((ext_vector_type(16)));
typedef short s16x4 __attribute__((ext_vector_type(4)));

constexpr int NKMAX = 8224;
constexpr int NBIN = 1024;
constexpr int A_SC = 0, A_H1 = A_SC + 4 * NKMAX * 4, A_SEL = A_H1 + 4 * NBIN * 4, A_CAND = A_SEL + 2048, A_META = A_CAND + 1024, A_END = A_META + 256;
static_assert(A_END <= LDS_BYTES - 16, "attention LDS");
__device__ __forceinline__ uint32_t skey(float f) { const uint32_t u = __float_as_uint(f); return (u & 0x80000000u) ? ~u : (u | 0x80000000u); }
__device__ __forceinline__ float skey_inv(uint32_t k) { return __uint_as_float((k & 0x80000000u) ? (k & 0x7fffffffu) : ~k); }
__device__ __forceinline__ int bin1(float s, float lo, float scale) { return min(NBIN - 1, max(0, (int)((s - lo) * scale))); }
template <int OFF> __device__ __forceinline__ s16x4 tr_read(unsigned addr) {
    s16x4 r; asm volatile("ds_read_b64_tr_b16 %0, %1 offset:%2" : "=&v"(r) : "v"(addr), "i"(OFF) : "memory"); return r;
}
__device__ __forceinline__ void scan_top(const int* hist, int K, int* m, int lane) {
    int c[16];
#pragma unroll
    for (int i = 0; i < 4; ++i) { const int4 v = *(const int4*)(hist + 16 * lane + 4 * i); c[4 * i] = v.x; c[4 * i + 1] = v.y; c[4 * i + 2] = v.z; c[4 * i + 3] = v.w; }
    int tot = 0;
#pragma unroll
    for (int i = 0; i < 16; ++i) tot += c[i];
    int suf = tot;
#pragma unroll
    for (int o = 1; o < 64; o <<= 1) { const int t = __shfl_down(suf, o); if (lane + o < 64) suf += t; }
    int above = suf - tot;
#pragma unroll
    for (int i = 15; i >= 0; --i) {
        if (above < K && K <= above + c[i]) { m[0] = 16 * lane + i; m[1] = above; m[2] = c[i]; }
        above += c[i];
    }
}

__device__ __forceinline__ void attn4_unit(const P& p, unsigned char* lds, int b, int grp) {
    const int tid = tid_(), lane = tid & 63, wid = __builtin_amdgcn_readfirstlane(tid >> 6);
    const int t0 = NMETA + 4 * grp;
    const int brow = b * LP, row0 = brow + t0;
    float* sc = (float*)(lds + A_SC);
    int* h1 = (int*)(lds + A_H1);
    unsigned short* sel = (unsigned short*)(lds + A_SEL); unsigned short* cand = (unsigned short*)(lds + A_CAND);
    int* meta = (int*)(lds + A_META);
    const bool big = t0 + 1 > 256;
    for (int i = tid; i < 4 * NBIN; i += NTHREADS) h1[i] = 0;
    if (tid < 64) { const int w = tid & 15; meta[tid] = (w == 0) ? -1 : 0; }
    if (!big) { for (int i = tid; i < 1024; i += NTHREADS) { const int q = i >> 8, j = i & 255; sel[i] = (unsigned short)(j <= t0 + q ? j : 0); } }
    __syncthreads();
    if (big) {
        {
            const int hh = lane >> 5, c32 = lane & 31;
            const int g = c32 >> 3, h2a = (c32 >> 2) & 1, bq = c32 & 3, aq = 2 * h2a + (g >> 1), ah = 4 * (g & 1) + bq;
            const bf16_t* ap = p.iq() + (size_t)(row0 + aq) * 256 + ah * 32 + 8 * hh;
            const bf16x8 a0 = *(const bf16x8*)ap, a1 = *(const bf16x8*)(ap + 16);
            const f32x4 w00 = *(const f32x4*)(p.iw() + (size_t)(row0 + 2 * hh) * 8), w01 = *(const f32x4*)(p.iw() + (size_t)(row0 + 2 * hh) * 8 + 4);
            const f32x4 w10 = *(const f32x4*)(p.iw() + (size_t)(row0 + 2 * hh + 1) * 8), w11 = *(const f32x4*)(p.iw() + (size_t)(row0 + 2 * hh + 1) * 8 + 4);
            const int ntiles = (t0 + 4 + 31) >> 5;
            const int tq0 = t0 + 2 * hh;
            float mx0 = -INFINITY, mn0 = INFINITY, mx1 = -INFINITY, mn1 = INFINITY;
            const bf16_t* kbase = p.ik() + (size_t)brow * 32 + 8 * hh;
            for (int tile0 = wid; tile0 < ntiles; tile0 += 128) {
                bf16x8 b0[16], b1[16];
#pragma unroll
                for (int j = 0; j < 16; ++j) {
                    const int tile = min(tile0 + 8 * j, ntiles - 1);
                    const bf16_t* kp = kbase + (size_t)(tile * 32 + c32) * 32;
                    b0[j] = *(const bf16x8*)kp; b1[j] = *(const bf16x8*)(kp + 16);
                }
                __builtin_amdgcn_sched_barrier(0);
#pragma unroll
                for (int j = 0; j < 16; ++j) {
                    const int tile = tile0 + 8 * j;
                    if (tile < ntiles) {
                        const int key = tile * 32 + c32;
                        f32x16 acc;
#pragma unroll
                        for (int i = 0; i < 16; ++i) acc[i] = 0.f;
                        acc = __builtin_amdgcn_mfma_f32_32x32x16_bf16(a0, b0[j], acc, 0, 0, 0);
                        acc = __builtin_amdgcn_mfma_f32_32x32x16_bf16(a1, b1[j], acc, 0, 0, 0);
                        float s0 = 0.f, s1 = 0.f;
#pragma unroll
                        for (int i = 0; i < 4; ++i) {
                            s0 += w00[i] * fmaxf(acc[i], 0.f) + w01[i] * fmaxf(acc[4 + i], 0.f);
                            s1 += w10[i] * fmaxf(acc[8 + i], 0.f) + w11[i] * fmaxf(acc[12 + i], 0.f);
                        }
                        sc[(2 * hh) * NKMAX + key] = s0; sc[(2 * hh + 1) * NKMAX + key] = s1;
                        if (key <= tq0) { mx0 = fmaxf(mx0, s0); mn0 = fminf(mn0, s0); }
                        if (key <= tq0 + 1) { mx1 = fmaxf(mx1, s1); mn1 = fminf(mn1, s1); }
                    }
                }
            }
#pragma unroll
            for (int o = 16; o >= 1; o >>= 1) {
                mx0 = fmaxf(mx0, __shfl_xor(mx0, o)); mn0 = fminf(mn0, __shfl_xor(mn0, o));
                mx1 = fmaxf(mx1, __shfl_xor(mx1, o)); mn1 = fminf(mn1, __shfl_xor(mn1, o));
            }
            if (c32 == 0) {
                if (mx0 >= mn0) { atomicMin((unsigned*)&meta[(2 * hh) * 16 + 0], skey(mn0)); atomicMax((unsigned*)&meta[(2 * hh) * 16 + 1], skey(mx0)); }
                if (mx1 >= mn1) { atomicMin((unsigned*)&meta[(2 * hh + 1) * 16 + 0], skey(mn1)); atomicMax((unsigned*)&meta[(2 * hh + 1) * 16 + 1], skey(mx1)); }
            }
        }
        __syncthreads();
        const int q = wid & 3, part = wid >> 2, n = t0 + q + 1;
        const float lo = skey_inv((unsigned)meta[q * 16 + 0]), hi = skey_inv((unsigned)meta[q * 16 + 1]);
        const float scale = hi > lo ? (float)NBIN / (hi - lo) : 0.f;
        const float* scq = sc + q * NKMAX;
        for (int base = part * 256; base < n; base += 512) {
            const int idx0 = base + lane * 4;
            if (idx0 < n) {
                const f32x4 v = *(const f32x4*)(scq + idx0);
#pragma unroll
                for (int j = 0; j < 4; ++j) if (idx0 + j < n) atomicAdd(&h1[q * NBIN + bin1(v[j], lo, scale)], 1);
            }
        }
        __syncthreads();
        if (wid < 4) scan_top(h1 + wid * NBIN, 256, meta + wid * 16 + 4, lane);
        __syncthreads();
        const int B1 = meta[q * 16 + 4];
        for (int base = part * 256; base < n; base += 512) {
            const int idx0 = base + lane * 4;
            f32x4 v = (f32x4){0.f, 0.f, 0.f, 0.f};
            if (idx0 < n) v = *(const f32x4*)(scq + idx0);
            const unsigned long long lt = (1ull << lane) - 1ull;
#pragma unroll
            for (int j = 0; j < 4; ++j) {
                const int idx = idx0 + j;
                bool issel = false, iscand = false;
                if (idx < n) { const int b1 = bin1(v[j], lo, scale); issel = b1 > B1; iscand = b1 == B1; }
                const unsigned long long ms = __ballot(issel), mc = __ballot(iscand);
                if (ms) {
                    int bs = 0; if (lane == 0) bs = atomicAdd(&meta[q * 16 + 2], __popcll(ms));
                    bs = __shfl(bs, 0);
                    if (issel) sel[q * 256 + bs + __popcll(ms & lt)] = (unsigned short)idx;
                }
                if (mc) {
                    int bs = 0; if (lane == 0) bs = atomicAdd(&meta[q * 16 + 3], __popcll(mc));
                    bs = __shfl(bs, 0);
                    const int pos = bs + __popcll(mc & lt);
                    if (iscand && pos < 128) cand[q * 128 + pos] = (unsigned short)idx;
                }
            }
        }
        __syncthreads();
        if (wid < 4) {
            const int qq = wid; const float* scr = sc + qq * NKMAX;
            const int rq = 256 - meta[qq * 16 + 5], cq = meta[qq * 16 + 6], sbase = 256 - rq, nn = t0 + qq + 1;
            if (cq <= 128) {
                int taken = 0;
#pragma unroll
                for (int half = 0; half < 2; ++half) {
                    const int i = lane + 64 * half;
                    bool take = false; int myidx = 0;
                    if (i < cq) {
                        myidx = cand[qq * 128 + i]; const float mv = scr[myidx];
                        int rank = 0;
                        for (int j = 0; j < cq; ++j) { const int oj = cand[qq * 128 + j]; const float ov = scr[oj]; rank += (ov > mv) || (ov == mv && oj < myidx); }
                        take = rank < rq;
                    }
                    const unsigned long long mt = __ballot(take);
                    if (take) sel[qq * 256 + sbase + taken + __popcll(mt & ((1ull << lane) - 1ull))] = (unsigned short)myidx;
                    taken += __popcll(mt);
                }
            } else {
                const float lo_ = skey_inv((unsigned)meta[qq * 16 + 0]), hi_ = skey_inv((unsigned)meta[qq * 16 + 1]);
                const float sc_ = hi_ > lo_ ? (float)NBIN / (hi_ - lo_) : 0.f;
                const int B1_ = meta[qq * 16 + 4];
                int taken = 0;
                for (int base = 0; base < nn && taken < rq; base += 64) {
                    const int idx = base + lane; bool isc = false;
                    if (idx < nn) isc = bin1(scr[idx], lo_, sc_) == B1_;
                    const unsigned long long mc = __ballot(isc);
                    const int pos = taken + __popcll(mc & ((1ull << lane) - 1ull));
                    if (isc && pos < rq) sel[qq * 256 + sbase + pos] = (unsigned short)idx;
                    taken += __popcll(mc);
                }
            }
        }
        __syncthreads();
    }
    {
        const int q = wid >> 1, kvh = wid & 1, tq = t0 + q, nsel = min(tq + 1, 256);
        const int col = lane & 15, g4 = lane >> 4;
        const unsigned short* selq = sel + q * 256;
        bf16x8 qf0, qf1;
        {
            const bf16_t* qp = p.q() + (size_t)(row0 + q) * 512 + (kvh * 4 + (col & 3)) * 64 + g4 * 8;
            qf0 = *(const bf16x8*)qp; qf1 = *(const bf16x8*)(qp + 32);
            if (col >= 4) {
#pragma unroll
                for (int i = 0; i < 8; ++i) { qf0[i] = 0; qf1[i] = 0; }
            }
        }
        LAS unsigned char* vst = (LAS unsigned char*)lds + A_SC + wid * 16384;
        const bf16_t* vb = p.v() + (size_t)brow * 128 + kvh * 64 + (lane & 7) * 8;
        const unsigned rdbase = (unsigned)(uintptr_t)((LAS unsigned char*)lds + A_SC) + wid * 16384 + (4 * g4 + (col >> 2)) * 128 + (col & 3) * 8;
#define V_STAGE(s_, buf_) do { _Pragma("unroll") for (int i_ = 0; i_ < 4; ++i_) { \
            const int ksl_ = (s_) * 32 + i_ * 8 + (lane >> 3); const int key_ = selq[ksl_]; \
            __builtin_amdgcn_global_load_lds((const unsigned*)(vb + (size_t)key_ * 128), (LAS unsigned*)(vst + (buf_) * 4096 + i_ * 1024), 16, 0, 0); } } while (0)
        const bf16_t* kb = p.k() + (size_t)brow * 128 + kvh * 64 + g4 * 8;
        f32x4 lg[16];
        u32x4 vr[16];
        {
            bf16x8 k0[16], k1[16];
#pragma unroll
            for (int t = 0; t < 16; ++t) {
                const int key = selq[t * 16 + col];
                const bf16_t* kp = kb + (size_t)key * 128;
                k0[t] = *(const bf16x8*)kp; k1[t] = *(const bf16x8*)(kp + 32);
            }
#pragma unroll
            for (int s = 4; s < 8; ++s)
#pragma unroll
                for (int i = 0; i < 4; ++i) { const int key = selq[s * 32 + i * 8 + (lane >> 3)]; vr[(s - 4) * 4 + i] = *(const u32x4*)(vb + (size_t)key * 128); }
            V_STAGE(0, 0); V_STAGE(1, 1); V_STAGE(2, 2); V_STAGE(3, 3);
            __builtin_amdgcn_sched_barrier(0);
#pragma unroll
            for (int t = 0; t < 16; ++t) {
                f32x4 a = (f32x4){0.f, 0.f, 0.f, 0.f};
                a = __builtin_amdgcn_mfma_f32_16x16x32_bf16(k0[t], qf0, a, 0, 0, 0);
                a = __builtin_amdgcn_mfma_f32_16x16x32_bf16(k1[t], qf1, a, 0, 0, 0);
                lg[t] = a;
            }
            __builtin_amdgcn_sched_barrier(0);
        }
        float mx = -INFINITY;
#pragma unroll
        for (int t = 0; t < 16; ++t)
#pragma unroll
            for (int j = 0; j < 4; ++j) { if (t * 16 + g4 * 4 + j >= nsel) lg[t][j] = -INFINITY; mx = fmaxf(mx, lg[t][j]); }
        mx = fmaxf(mx, __shfl_xor(mx, 16)); mx = fmaxf(mx, __shfl_xor(mx, 32));
        float sm = 0.f;
#pragma unroll
        for (int t = 0; t < 16; ++t)
#pragma unroll
            for (int j = 0; j < 4; ++j) { const float e = __builtin_amdgcn_exp2f(lg[t][j] - mx); lg[t][j] = e; sm += e; }
        sm += __shfl_xor(sm, 16); sm += __shfl_xor(sm, 32);
        const float inv = 1.0f / sm;
        f32x4 o[4];
#pragma unroll
        for (int d = 0; d < 4; ++d) o[d] = (f32x4){0.f, 0.f, 0.f, 0.f};
        asm volatile("s_waitcnt vmcnt(0)" ::: "memory");
#pragma unroll
        for (int s = 0; s < 8; ++s) {
            if (s >= 4) {
#pragma unroll
                for (int i = 0; i < 4; ++i) *(LAS u32x4*)(vst + (s & 3) * 4096 + i * 1024 + lane * 16) = vr[(s - 4) * 4 + i];
                asm volatile("s_waitcnt lgkmcnt(0)" ::: "memory");
            }
            const unsigned rb = rdbase + (s & 3) * 4096;
            const s16x4 l0 = tr_read<0>(rb), h0 = tr_read<2048>(rb), l1 = tr_read<32>(rb), h1_ = tr_read<2048 + 32>(rb);
            const s16x4 l2 = tr_read<64>(rb), h2_ = tr_read<2048 + 64>(rb), l3 = tr_read<96>(rb), h3 = tr_read<2048 + 96>(rb);
            asm volatile("s_waitcnt lgkmcnt(0)" ::: "memory");
            __builtin_amdgcn_sched_barrier(0);
            bf16x8 pa;
            {
                const uint32_t w0 = pack2(lg[2 * s][0], lg[2 * s][1]), w1 = pack2(lg[2 * s][2], lg[2 * s][3]);
                const uint32_t w2 = pack2(lg[2 * s + 1][0], lg[2 * s + 1][1]), w3 = pack2(lg[2 * s + 1][2], lg[2 * s + 1][3]);
                pa[0] = (short)(w0 & 0xffff); pa[1] = (short)(w0 >> 16); pa[2] = (short)(w1 & 0xffff); pa[3] = (short)(w1 >> 16);
                pa[4] = (short)(w2 & 0xffff); pa[5] = (short)(w2 >> 16); pa[6] = (short)(w3 & 0xffff); pa[7] = (short)(w3 >> 16);
            }
#define PKV(L, H) (bf16x8){L[0], L[1], L[2], L[3], H[0], H[1], H[2], H[3]}
            o[0] = __builtin_amdgcn_mfma_f32_16x16x32_bf16(pa, PKV(l0, h0), o[0], 0, 0, 0);
            o[1] = __builtin_amdgcn_mfma_f32_16x16x32_bf16(pa, PKV(l1, h1_), o[1], 0, 0, 0);
            o[2] = __builtin_amdgcn_mfma_f32_16x16x32_bf16(pa, PKV(l2, h2_), o[2], 0, 0, 0);
            o[3] = __builtin_amdgcn_mfma_f32_16x16x32_bf16(pa, PKV(l3, h3), o[3], 0, 0, 0);
#undef PKV
        }
#undef V_STAGE
        const float i0 = __shfl(inv, 0), i1 = __shfl(inv, 1), i2 = __shfl(inv, 2), i3 = __shfl(inv, 3);
        if (g4 == 0) {
            bf16_t* op = p.att() + (size_t)(row0 + q) * 512 + kvh * 256 + col;
#pragma unroll
            for (int d = 0; d < 4; ++d) {
                op[0 * 64 + d * 16] = f2bf(o[d][0] * i0); op[1 * 64 + d * 16] = f2bf(o[d][1] * i1);
                op[2 * 64 + d * 16] = f2bf(o[d][2] * i2); op[3 * 64 + d * 16] = f2bf(o[d][3] * i3);
            }
        }
    }
    __syncthreads();
}

constexpr int NBW = 512;
constexpr int W_SC = 0, W_H = W_SC + NKMAX * 2, W_SEL = W_H + NBW * 4, W_CAND = W_SEL + 512, W_SZ = W_CAND + 256;
static_assert(8 * W_SZ <= LDS_BYTES - 32, "wave attention LDS");
__device__ __forceinline__ int binw(float s, float lo, float scale) { return min(NBW - 1, max(0, (int)((s - lo) * scale))); }

__device__ __forceinline__ void attn_wave(const P& p, unsigned char* lds, int wid, int lane, int b, int t, float mn, float mx) {
    unsigned char* wl = lds + wid * W_SZ;
    _Float16* sc = (_Float16*)(wl + W_SC);
    int* hist = (int*)(wl + W_H);
    unsigned short* sel = (unsigned short*)(wl + W_SEL);
    unsigned short* cand = (unsigned short*)(wl + W_CAND);
    const int brow = b * LP, row = brow + t, n = t + 1;
    const int col = lane & 15, g4 = lane >> 4;
    const unsigned long long lt = (1ull << lane) - 1ull;
    int nsel = 256;
    if (n > 256) {
        const float scale = mx > mn ? (float)NBW / (mx - mn) : 0.f, nls = -mn * scale;
#define BINF(x) min(NBW - 1, max(0, (int)__builtin_fmaf((x), scale, nls)))
#define H2F(u16) ((float)__builtin_bit_cast(_Float16, (unsigned short)(u16)))
        for (int base = 0; base < n; base += 512) {
            const int ia = base + lane * 4, ib = ia + 256;
            uint2 ra = make_uint2(0u, 0u), rb2 = make_uint2(0u, 0u);
            if (ia < n) ra = *(const uint2*)(sc + ia);
            if (ib < n) rb2 = *(const uint2*)(sc + ib);
            const unsigned wa[4] = {ra.x & 0xffffu, ra.x >> 16, ra.y & 0xffffu, ra.y >> 16}, wb[4] = {rb2.x & 0xffffu, rb2.x >> 16, rb2.y & 0xffffu, rb2.y >> 16};
#pragma unroll
            for (int j = 0; j < 4; ++j) {
                if (ia + j < n) atomicAdd(&hist[BINF(H2F(wa[j]))], 1);
                if (ib + j < n) atomicAdd(&hist[BINF(H2F(wb[j]))], 1);
            }
        }
        int B1, above1, cnt1;
        {
            int c[8];
            const int4 v0 = *(const int4*)(hist + 8 * lane), v1 = *(const int4*)(hist + 8 * lane + 4);
            c[0] = v0.x; c[1] = v0.y; c[2] = v0.z; c[3] = v0.w; c[4] = v1.x; c[5] = v1.y; c[6] = v1.z; c[7] = v1.w;
            int tot = 0;
#pragma unroll
            for (int i = 0; i < 8; ++i) tot += c[i];
            int suf = tot;
#pragma unroll
            for (int o = 1; o < 64; o <<= 1) { const int tt = __shfl_down(suf, o); if (lane + o < 64) suf += tt; }
            int above = suf - tot;
            const bool mine = above < 256 && 256 <= above + tot;
            int bb = 0, ab = 0, cb = 0;
#pragma unroll
            for (int i = 7; i >= 0; --i) { if (above < 256 && 256 <= above + c[i]) { bb = 8 * lane + i; ab = above; cb = c[i]; } above += c[i]; }
            const int src = (int)__builtin_ctzll(__ballot(mine));
            B1 = __shfl(bb, src); above1 = __shfl(ab, src); cnt1 = __shfl(cb, src);
        }
        int selcnt = 0, candcnt = 0;
        for (int base = 0; base < n; base += 512) {
            const int ia = base + lane * 4, ib = ia + 256;
            uint2 ra = make_uint2(0u, 0u), rb2 = make_uint2(0u, 0u);
            if (ia < n) ra = *(const uint2*)(sc + ia);
            if (ib < n) rb2 = *(const uint2*)(sc + ib);
            const unsigned wv[8] = {ra.x & 0xffffu, ra.x >> 16, ra.y & 0xffffu, ra.y >> 16, rb2.x & 0xffffu, rb2.x >> 16, rb2.y & 0xffffu, rb2.y >> 16};
            unsigned smask = 0u, cmask = 0u;
#pragma unroll
            for (int j = 0; j < 8; ++j) {
                const int idx = (j < 4 ? ia : ib) + (j & 3);
                const int b1 = idx < n ? BINF(H2F(wv[j])) : -1;
                smask |= (b1 > B1 ? 1u : 0u) << j; cmask |= (b1 == B1 ? 1u : 0u) << j;
            }
            const int cnt = __popc(smask);
            int inc = cnt;
#pragma unroll
            for (int o = 1; o < 64; o <<= 1) { const int tt = __shfl_up(inc, o); if (lane >= o) inc += tt; }
            int pos = selcnt + inc - cnt;
#pragma unroll
            for (int j = 0; j < 8; ++j) if ((smask >> j) & 1u) { sel[pos] = (unsigned short)((j < 4 ? ia : ib) + (j & 3)); ++pos; }
            selcnt += __shfl(inc, 63);
            if (__ballot(cmask != 0u)) {
#pragma unroll
                for (int j = 0; j < 8; ++j) {
                    const bool isc = (cmask >> j) & 1u;
                    const unsigned long long mc = __ballot(isc);
                    const int cp = candcnt + __popcll(mc & lt);
                    if (isc && cp < 128) cand[cp] = (unsigned short)((j < 4 ? ia : ib) + (j & 3));
                    candcnt += __popcll(mc);
                }
            }
        }
        {
            const int rq = 256 - above1, cq = cnt1, sbase = 256 - rq;
            if (cq <= 128) {
                int taken = 0;
#pragma unroll
                for (int half = 0; half < 2; ++half) {
                    const int i = lane + 64 * half;
                    bool take = false; int myidx = 0;
                    if (i < cq) {
                        myidx = cand[i]; const float mv = (float)sc[myidx];
                        int rank = 0;
                        for (int j = 0; j < cq; ++j) { const int oj = cand[j]; const float ov = (float)sc[oj]; rank += (ov > mv) || (ov == mv && oj < myidx); }
                        take = rank < rq;
                    }
                    const unsigned long long mt = __ballot(take);
                    if (take) sel[sbase + taken + __popcll(mt & lt)] = (unsigned short)myidx;
                    taken += __popcll(mt);
                }
            } else {
                int taken = 0;
                for (int base = 0; base < n && taken < rq; base += 64) {
                    const int idx = base + lane; bool isc = false;
                    if (idx < n) isc = BINF((float)sc[idx]) == B1;
                    const unsigned long long mc = __ballot(isc);
                    const int pos = taken + __popcll(mc & lt);
                    if (isc && pos < rq) sel[sbase + pos] = (unsigned short)idx;
                    taken += __popcll(mc);
                }
            }
        }
#undef BINF
#undef H2F
    } else {
        nsel = n;
#pragma unroll
        for (int i = 0; i < 4; ++i) { const int j = lane + 64 * i; sel[j] = (unsigned short)(j < n ? j : 0); }
    }
    LAS unsigned char* vst = (LAS unsigned char*)wl + W_SC;
    const unsigned rdbase = (unsigned)(uintptr_t)((LAS unsigned char*)wl + W_SC) + (4 * g4 + (col >> 2)) * 256 + (col & 3) * 8;
    {
        bf16x8 qf[4];
        {
            const bf16_t* qp = p.q() + (size_t)row * 512 + (col & 7) * 64 + g4 * 8;
            const bf16x8 q0 = *(const bf16x8*)qp, q1 = *(const bf16x8*)(qp + 32);
            const bool lo_grp = col < 4, hi_grp = col >= 4 && col < 8;
#pragma unroll
            for (int i = 0; i < 8; ++i) { qf[0][i] = lo_grp ? q0[i] : (short)0; qf[1][i] = lo_grp ? q1[i] : (short)0; qf[2][i] = hi_grp ? q0[i] : (short)0; qf[3][i] = hi_grp ? q1[i] : (short)0; }
        }
        const bf16_t* vb = p.v() + (size_t)brow * 128 + (lane & 15) * 8;
#define V_STAGE(s_, buf_) do { _Pragma("unroll") for (int i_ = 0; i_ < 4; ++i_) { \
            const int key_ = sel[(s_) * 16 + i_ * 4 + (lane >> 4)]; \
            __builtin_amdgcn_global_load_lds((const unsigned*)(vb + (size_t)key_ * 128), (LAS unsigned*)(vst + (buf_) * 4096 + i_ * 1024), 16, 0, 0); } } while (0)
        const bf16_t* kg = p.k() + (size_t)brow * 128;
#define K_STAGE(s_, buf_) do { _Pragma("unroll") for (int i_ = 0; i_ < 4; ++i_) { \
            const int kl_ = i_ * 4 + (lane >> 4); const int key_ = sel[(s_) * 16 + kl_]; \
            __builtin_amdgcn_global_load_lds((const unsigned*)(kg + (size_t)key_ * 128 + (((lane & 15) ^ kl_) & 15) * 8), (LAS unsigned*)(vst + (buf_) * 4096 + i_ * 1024), 16, 0, 0); } } while (0)
        f32x4 lg[16];
        K_STAGE(0, 0); K_STAGE(1, 1); K_STAGE(2, 2);
#pragma unroll
        for (int s = 0; s < 16; ++s) {
            if (s + 3 < 16) { K_STAGE(s + 3, (s + 3) & 3); asm volatile("s_waitcnt vmcnt(12)" ::: "memory"); }
            else if (s == 13) asm volatile("s_waitcnt vmcnt(8)" ::: "memory");
            else if (s == 14) asm volatile("s_waitcnt vmcnt(4)" ::: "memory");
            else asm volatile("s_waitcnt vmcnt(0)" ::: "memory");
            bf16x8 kf[4];
#pragma unroll
            for (int ks = 0; ks < 4; ++ks) kf[ks] = *(const LAS bf16x8*)(vst + (s & 3) * 4096 + col * 256 + (((ks * 4 + g4) ^ col) & 15) * 16);
            asm volatile("s_waitcnt lgkmcnt(0)" ::: "memory");
            __builtin_amdgcn_sched_barrier(0);
            f32x4 a = (f32x4){0.f, 0.f, 0.f, 0.f};
#pragma unroll
            for (int ks = 0; ks < 4; ++ks) a = __builtin_amdgcn_mfma_f32_16x16x32_bf16(kf[ks], qf[ks], a, 0, 0, 0);
            lg[s] = a;
        }
#undef K_STAGE
        V_STAGE(0, 0); V_STAGE(1, 1); V_STAGE(2, 2);
        float mxl = -INFINITY;
#pragma unroll
        for (int tt = 0; tt < 16; ++tt)
#pragma unroll
            for (int j = 0; j < 4; ++j) { if (tt * 16 + g4 * 4 + j >= nsel) lg[tt][j] = -INFINITY; mxl = fmaxf(mxl, lg[tt][j]); }
        mxl = fmaxf(mxl, __shfl_xor(mxl, 16)); mxl = fmaxf(mxl, __shfl_xor(mxl, 32));
        float sm = 0.f;
#pragma unroll
        for (int tt = 0; tt < 16; ++tt)
#pragma unroll
            for (int j = 0; j < 4; ++j) { const float e = __builtin_amdgcn_exp2f(lg[tt][j] - mxl); lg[tt][j] = e; sm += e; }
        sm += __shfl_xor(sm, 16); sm += __shfl_xor(sm, 32);
        const float inv = 1.0f / sm;
        f32x4 o[8];
#pragma unroll
        for (int d = 0; d < 8; ++d) o[d] = (f32x4){0.f, 0.f, 0.f, 0.f};
#pragma unroll
        for (int s = 0; s < 16; ++s) {
            if (s + 3 < 16) { V_STAGE(s + 3, (s + 3) & 3); asm volatile("s_waitcnt vmcnt(12)" ::: "memory"); }
            else if (s == 13) asm volatile("s_waitcnt vmcnt(8)" ::: "memory");
            else if (s == 14) asm volatile("s_waitcnt vmcnt(4)" ::: "memory");
            else asm volatile("s_waitcnt vmcnt(0)" ::: "memory");
            const unsigned rb = rdbase + (s & 3) * 4096;
            s16x4 pa;
            {
                const uint32_t w0 = pack2(lg[s][0], lg[s][1]), w1 = pack2(lg[s][2], lg[s][3]);
                pa[0] = (short)(w0 & 0xffff); pa[1] = (short)(w0 >> 16); pa[2] = (short)(w1 & 0xffff); pa[3] = (short)(w1 >> 16);
            }
            const s16x4 v0 = tr_read<0>(rb), v1 = tr_read<32>(rb), v2 = tr_read<64>(rb), v3 = tr_read<96>(rb);
            const s16x4 v4 = tr_read<128>(rb), v5 = tr_read<160>(rb), v6 = tr_read<192>(rb), v7 = tr_read<224>(rb);
            asm volatile("s_waitcnt lgkmcnt(0)" ::: "memory");
            __builtin_amdgcn_sched_barrier(0);
            o[0] = __builtin_amdgcn_mfma_f32_16x16x16bf16_1k(pa, v0, o[0], 0, 0, 0); o[1] = __builtin_amdgcn_mfma_f32_16x16x16bf16_1k(pa, v1, o[1], 0, 0, 0);
            o[2] = __builtin_amdgcn_mfma_f32_16x16x16bf16_1k(pa, v2, o[2], 0, 0, 0); o[3] = __builtin_amdgcn_mfma_f32_16x16x16bf16_1k(pa, v3, o[3], 0, 0, 0);
            o[4] = __builtin_amdgcn_mfma_f32_16x16x16bf16_1k(pa, v4, o[4], 0, 0, 0); o[5] = __builtin_amdgcn_mfma_f32_16x16x16bf16_1k(pa, v5, o[5], 0, 0, 0);
            o[6] = __builtin_amdgcn_mfma_f32_16x16x16bf16_1k(pa, v6, o[6], 0, 0, 0); o[7] = __builtin_amdgcn_mfma_f32_16x16x16bf16_1k(pa, v7, o[7], 0, 0, 0);
        }
#undef V_STAGE
        float ih[4];
#pragma unroll
        for (int jj = 0; jj < 4; ++jj) ih[jj] = __shfl(inv, 4 * (g4 & 1) + jj);
        if (g4 < 2) {
            bf16_t* op = p.att() + (size_t)row * 512 + (g4 * 4) * 64 + col;
#pragma unroll
            for (int d = 0; d < 4; ++d) {
                const f32x4 oa_ = o[d], ob_ = o[4 + d]; f32x4 ov;
#pragma unroll
                for (int kk = 0; kk < 4; ++kk) ov[kk] = g4 == 0 ? oa_[kk] : ob_[kk];
                op[0 * 64 + d * 16] = f2bf(ov[0] * ih[0]); op[1 * 64 + d * 16] = f2bf(ov[1] * ih[1]);
                op[2 * 64 + d * 16] = f2bf(ov[2] * ih[2]); op[3 * 64 + d * 16] = f2bf(ov[3] * ih[3]);
            }
        }
    }
}

constexpr int A8_META = 8 * W_SZ;
static_assert(A8_META + 64 + 512 <= LDS_BYTES - 32, "attn8 meta");
__device__ __forceinline__ void attn8_unit(const P& p, unsigned char* lds, int b, int grp) {
    const int tid = tid_(), lane = tid & 63, wid = __builtin_amdgcn_readfirstlane(tid >> 6);
    const int t0 = NMETA + 8 * grp, brow = b * LP, row0 = brow + t0;
    unsigned* meta = (unsigned*)(lds + A8_META);
    const bool big = t0 + 1 > 256;
    if (tid < 16) meta[tid] = (tid & 1) ? 0u : 0xffffffffu;
    bf16_t* uvec = (bf16_t*)(lds + A8_META + 64);
    if (big && tid < 256) {
        const int q = tid >> 5, d = tid & 31;
        const bf16_t* ip = p.iq() + (size_t)(row0 + q) * 256 + d; const float* wp = p.iw() + (size_t)(row0 + q) * 8;
        float u = 0.f;
#pragma unroll
        for (int h = 0; h < 8; ++h) u += wp[h] * bf2f(ip[h * 32]);
        uvec[q * 32 + d] = f2bf(u);
    }
    for (int i = tid; i < 8 * NBW; i += NTHREADS) ((int*)(lds + (i / NBW) * W_SZ + W_H))[i % NBW] = 0;
    __syncthreads();
    if (big) {
        const int hh = lane >> 5, c32 = lane & 31;
        const int g = c32 >> 3, h2a = (c32 >> 2) & 1, bq = c32 & 3, aq = 2 * h2a + (g >> 1), ah = 4 * (g & 1) + bq;
        bf16x8 a0[2], a1[2]; f32x4 w[2][2][2];
#pragma unroll
        for (int r = 0; r < 2; ++r) {
            const bf16_t* ap = p.iq() + (size_t)(row0 + 4 * r + aq) * 256 + ah * 32 + 8 * hh;
            a0[r] = *(const bf16x8*)ap; a1[r] = *(const bf16x8*)(ap + 16);
#pragma unroll
            for (int qi = 0; qi < 2; ++qi) {
                const float* wp = p.iw() + (size_t)(row0 + 4 * r + 2 * hh + qi) * 8;
                w[r][qi][0] = *(const f32x4*)wp; w[r][qi][1] = *(const f32x4*)(wp + 4);
            }
        }
        bf16x8 au0, au1;
        {
            const int uq = 4 * ((c32 & 3) >> 1) + 2 * ((c32 >> 2) & 1) + (c32 & 1);
            const bf16x8 v0 = *(const bf16x8*)(uvec + uq * 32 + 8 * hh), v1 = *(const bf16x8*)(uvec + uq * 32 + 8 * hh + 16);
#pragma unroll
            for (int i = 0; i < 8; ++i) { au0[i] = c32 < 8 ? v0[i] : (short)0; au1[i] = c32 < 8 ? v1[i] : (short)0; }
        }
        const int ntiles = (t0 + 8 + 31) >> 5;
        float mx[2][2], mn[2][2];
#pragma unroll
        for (int r = 0; r < 2; ++r)
#pragma unroll
            for (int qi = 0; qi < 2; ++qi) { mx[r][qi] = -INFINITY; mn[r][qi] = INFINITY; }
        const bf16_t* kbase = p.ik() + (size_t)brow * 32 + 8 * hh;
        bf16x8 b0[8], b1[8], c0[8], c1[8];
#define S_LOAD(B0, B1, T0) do { _Pragma("unroll") for (int j = 0; j < 8; ++j) { const int tile_ = min((T0) + 8 * j, ntiles - 1); \
            const bf16_t* kp_ = kbase + (size_t)(tile_ * 32 + c32) * 32; B0[j] = *(const bf16x8*)kp_; B1[j] = *(const bf16x8*)(kp_ + 16); } } while (0)
#define S_COMP(B0, B1, T0) do { _Pragma("unroll") for (int j = 0; j < 8; ++j) { const int tile = (T0) + 8 * j; if (tile < ntiles) { const int key = tile * 32 + c32; \
            f32x16 acu; _Pragma("unroll") for (int i = 0; i < 16; ++i) acu[i] = 0.f; \
            acu = __builtin_amdgcn_mfma_f32_32x32x16_bf16(au0, B0[j], acu, 0, 0, 0); acu = __builtin_amdgcn_mfma_f32_32x32x16_bf16(au1, B1[j], acu, 0, 0, 0); \
            _Pragma("unroll") for (int r = 0; r < 2; ++r) { f32x16 acc; _Pragma("unroll") for (int i = 0; i < 16; ++i) acc[i] = 0.f; \
                acc = __builtin_amdgcn_mfma_f32_32x32x16_bf16(a0[r], B0[j], acc, 0, 0, 0); acc = __builtin_amdgcn_mfma_f32_32x32x16_bf16(a1[r], B1[j], acc, 0, 0, 0); \
                _Pragma("unroll") for (int qi = 0; qi < 2; ++qi) { float s = acu[2 * r + qi]; \
                    _Pragma("unroll") for (int i = 0; i < 4; ++i) s += w[r][qi][0][i] * __builtin_fabsf(acc[8 * qi + i]) + w[r][qi][1][i] * __builtin_fabsf(acc[8 * qi + 4 + i]); \
                    const int q = 4 * r + 2 * hh + qi; const _Float16 hs = (_Float16)fminf(fmaxf(s, -60000.f), 60000.f); \
                    ((_Float16*)(lds + q * W_SZ + W_SC))[key] = hs; \
                    if (key <= t0 + q) { const float f = (float)hs; mx[r][qi] = fmaxf(mx[r][qi], f); mn[r][qi] = fminf(mn[r][qi], f); } } } } } } while (0)
        S_LOAD(b0, b1, wid);
        for (int tile0 = wid; tile0 < ntiles; tile0 += 128) {
            if (tile0 + 64 < ntiles) S_LOAD(c0, c1, tile0 + 64);
            __builtin_amdgcn_sched_barrier(0);
            S_COMP(b0, b1, tile0);
            __builtin_amdgcn_sched_barrier(0);
            if (tile0 + 128 < ntiles) S_LOAD(b0, b1, tile0 + 128);
            __builtin_amdgcn_sched_barrier(0);
            if (tile0 + 64 < ntiles) S_COMP(c0, c1, tile0 + 64);
            __builtin_amdgcn_sched_barrier(0);
        }
#undef S_LOAD
#undef S_COMP
#pragma unroll
        for (int r = 0; r < 2; ++r)
#pragma unroll
            for (int qi = 0; qi < 2; ++qi) {
                float a = mx[r][qi], c = mn[r][qi];
#pragma unroll
                for (int o = 16; o >= 1; o >>= 1) { a = fmaxf(a, __shfl_xor(a, o)); c = fminf(c, __shfl_xor(c, o)); }
                if (c32 == 0 && a >= c) { const int q = 4 * r + 2 * hh + qi; atomicMin(&meta[q * 2], skey(c)); atomicMax(&meta[q * 2 + 1], skey(a)); }
            }
    }
    __syncthreads();
    const float mnq = big ? skey_inv(meta[wid * 2]) : 0.f, mxq = big ? skey_inv(meta[wid * 2 + 1]) : 0.f;
    attn_wave(p, lds, wid, lane, b, t0 + wid, mnq, mxq);
    __syncthreads();
}

constexpr int NGRP8 = SEQ / 8, ATT_P1 = NGRP8 / 8, ATT_P2 = NGRP8 / 2;
template <int SUB>
__device__ __forceinline__ void ph_mixer(const P& p, unsigned char* lds) {
    int* bc = (int*)(lds + LDS_BYTES - 16);
    constexpr int nh = SUB == 1 ? 64 : NXU;
    constexpr int a0 = SUB == 0 ? 0 : (SUB == 1 ? ATT_P1 : ATT_P2), a1 = SUB == 0 ? ATT_P1 : (SUB == 1 ? ATT_P2 : NGRP8);
    for (;;) {
        __syncthreads();
        if (tid_() == 0) bc[0] = atomicAdd(&p.ctr()[97 + SUB], 1);
        __syncthreads();
        const int it = bc[0];
        if (it >= nh) break;
        if (SUB == 0) hgx_unit(p, lds, it);
        else if (SUB == 1) hgchain_unit(p, it);
        else hgz_unit(p, lds, it);
    }
    const int b0 = (int)(xb_xcc_id() & 3u);
#pragma unroll 1
    for (int k = 0; k < 4; ++k) {
        const int b = (b0 + k) & 3;
        for (;;) {
            __syncthreads();
            if (tid_() == 0) bc[0] = atomicAdd(&p.ctr()[104 + SUB * 4 + b], 1);
            __syncthreads();
            const int it = bc[0];
            if (it >= a1 - a0) break;
            attn8_unit(p, lds, b, NGRP8 - 1 - (a0 + it));
        }
    }
}

__device__ __forceinline__ int tok_row(int tok) { return (tok >> 13) * LP + NMETA + (tok & 8191); }
__device__ __forceinline__ void ph_mix(const P& p, unsigned char* lds) {
    const int njobs = (NTOK / 256) * 4 * 2, G = gridDim.x, b0 = blockIdx.x;
    auto jobidx = [&](int i) __attribute__((always_inline)) { return (b0 + (i >> 1) * G) * 2 + (i & 1); };
    auto jobfn = [&](int i, GJob& j) __attribute__((always_inline)) -> bool {
        const int jb = jobidx(i); if (jb >= njobs) return false;
        const int which = jb & 1, u = jb >> 1, nt = u & 3, mt = u >> 2; const size_t r0 = (size_t)tok_row(mt * 256);
        j.A = (const char*)((which ? p.hgr() : p.att()) + r0 * 512); j.B = (const char*)((which ? p.wuhT() : p.wuaT()) + (size_t)nt * 256 * 512); return true; };
    auto epi = [&](f32x4 (&acc)[2][2][4][2], int i) __attribute__((always_inline)) {
        const int jb = jobidx(i), which = jb & 1, u = jb >> 1, nt = u & 3, mt = u >> 2; const size_t r0 = (size_t)tok_row(mt * 256);
        if (which == 0) {
            EPI8(
                const size_t og = (r0 + row) * 1024 + nt * 256 + col, om = (size_t)(mt * 256 + row) * 1024 + nt * 256 + col;
                const uint2 g = *(const uint2*)(p.ga() + og);
                f32x4 r;
                r[0] = v[0] * __uint_as_float(g.x << 16); r[1] = v[1] * __uint_as_float(g.x & 0xffff0000u);
                r[2] = v[2] * __uint_as_float(g.y << 16); r[3] = v[3] * __uint_as_float(g.y & 0xffff0000u);
                st_bf4(p.mix() + om, r);
            );
        } else {
            EPI8(
                const size_t og = (r0 + row) * 1024 + nt * 256 + col, om = (size_t)(mt * 256 + row) * 1024 + nt * 256 + col;
                const uint2 g = *(const uint2*)(p.gh() + og);
                const uint2 a = *(const uint2*)(p.mix() + om);
                f32x4 r;
                r[0] = __uint_as_float(a.x << 16) + v[0] * __uint_as_float(g.x << 16); r[1] = __uint_as_float(a.x & 0xffff0000u) + v[1] * __uint_as_float(g.x & 0xffff0000u);
                r[2] = __uint_as_float(a.y << 16) + v[2] * __uint_as_float(g.y << 16); r[3] = __uint_as_float(a.y & 0xffff0000u) + v[3] * __uint_as_float(g.y & 0xffff0000u);
                st_bf4(p.mix() + om, r);
            );
        }
    };
    unsigned vbU[2]; gj_lin2(vbU, 512);
    gemm_stream<false>(lds, 512, 512, (size_t)128 * 512 * 2, vbU, jobfn, epi);
}

__device__ __forceinline__ void ph_out(const P& p, unsigned char* lds) {
    const int nunits = (NTOK / 256) * 4, G = gridDim.x, b0 = blockIdx.x;
    auto jobfn = [&](int i, GJob& j) __attribute__((always_inline)) -> bool {
        const int u = b0 + i * G; if (u >= nunits) return false;
        const int nt = u & 3, mt = u >> 2;
        j.A = (const char*)(p.mix() + (size_t)mt * 256 * D); j.B = (const char*)(p.woT() + (size_t)nt * 256 * D); return true; };
    auto epi = [&](f32x4 (&acc)[2][2][4][2], int i) __attribute__((always_inline)) {
        const int u = b0 + i * G, nt = u & 3, mt = u >> 2;
        EPI8(
            const size_t o = (size_t)(mt * 256 + row) * D + nt * 256 + col;
            const f32x4 h0 = *(const f32x4*)(p.x + o);
            *(f32x4*)(p.out + o) = h0 + v;
        );
    };
    unsigned vbU[2]; gj_lin2(vbU, D);
    gemm_stream<false>(lds, D, D, (size_t)128 * D * 2, vbU, jobfn, epi);
}

constexpr int XS_LD = 1025;
__device__ __forceinline__ void ph_route(const P& p, unsigned char* lds) {
    const int tid = tid_(), lane = tid & 63, wid = __builtin_amdgcn_readfirstlane(tid >> 6);
    const int gt = blockIdx.x * NTHREADS + tid, ntot = gridDim.x * NTHREADS;
    for (int i = gt; i < CAP; i += ntot) { p.slot_token()[i] = -1; p.slot_info()[i] = make_int2(-1, 0); }
    float* xs = (float*)lds;
    int* lhist = (int*)(lds + 32 * XS_LD * 4);
    for (int tb = blockIdx.x; tb < NTOK / 128; tb += gridDim.x) {
        if (tid < 32) lhist[tid] = 0;
        for (int tile = 0; tile < 4; ++tile) {
            const int tokt = tb * 128 + tile * 32;
            __syncthreads();
#pragma unroll
            for (int t = 0; t < 4; ++t) {
                const int tl = wid * 4 + t, tok = tokt + tl;
                const float* src = p.out + (size_t)tok * D;
                f32x4 v[4]; float ss = 0.f;
#pragma unroll
                for (int i = 0; i < 4; ++i) { v[i] = *(const f32x4*)(src + lane * 4 + 256 * i); ss += v[i][0] * v[i][0] + v[i][1] * v[i][1] + v[i][2] * v[i][2] + v[i][3] * v[i][3]; }
                ss = wave_sum(ss);
                const float rs = rsqrtf(ss * (1.0f / D) + EPS);
#pragma unroll
                for (int i = 0; i < 4; ++i) {
                    const f32x4 g = *(const f32x4*)(p.ffn_g + lane * 4 + 256 * i);
                    f32x4 xn; xn[0] = v[i][0] * rs * g[0]; xn[1] = v[i][1] * rs * g[1]; xn[2] = v[i][2] * rs * g[2]; xn[3] = v[i][3] * rs * g[3];
                    *(uint32_t*)(p.xn2() + (size_t)tok * D + lane * 4 + 256 * i) = pk4_fp8(xn[0], xn[1], xn[2], xn[3]);
#pragma unroll
                    for (int c = 0; c < 4; ++c) xs[tl * XS_LD + lane * 4 + 256 * i + c] = xn[c];
                }
            }
            __syncthreads();
            f32x16 acc;
#pragma unroll
            for (int i = 0; i < 16; ++i) acc[i] = 0.f;
            {
                const float* xr = xs + (lane & 31) * XS_LD + wid * 128 + (lane >> 5);
                const float* wp = p.router_w + (size_t)(wid * 128 + (lane >> 5)) * 32 + (lane & 31);
#pragma unroll 16
                for (int i = 0; i < 64; ++i) acc = __builtin_amdgcn_mfma_f32_32x32x2f32(xr[2 * i], wp[(size_t)(2 * i) * 32], acc, 0, 0, 0);
            }
            __syncthreads();
#pragma unroll
            for (int r = 0; r < 16; ++r) xs[wid * 1024 + ((r & 3) + 8 * (r >> 2) + 4 * (lane >> 5)) * 32 + (lane & 31)] = acc[r];
            __syncthreads();
            const int e = lane & 31, hh = lane >> 5;
            const float be = p.router_b[e];
#pragma unroll
            for (int it = 0; it < 2; ++it) {
                const int tl = wid * 4 + it * 2 + hh;
                float l = be;
#pragma unroll
                for (int w = 0; w < 8; ++w) l += xs[w * 1024 + tl * 32 + e];
                float bv[4]; int bi[4];
#pragma unroll
                for (int k = 0; k < 4; ++k) {
                    float m = l;
#pragma unroll
                    for (int o = 16; o >= 1; o >>= 1) m = fmaxf(m, __shfl_xor(m, o));
                    const unsigned long long bal = __ballot(l == m);
                    const unsigned half = hh ? (unsigned)(bal >> 32) : (unsigned)bal;
                    const int idx = __builtin_ctz(half);
                    bv[k] = m; bi[k] = idx;
                    if (e == idx) l = -INFINITY;
                }
                const float e1 = __expf(bv[1] - bv[0]), e2 = __expf(bv[2] - bv[0]), e3 = __expf(bv[3] - bv[0]);
                const float inv = 1.0f / (1.0f + e1 + e2 + e3);
                if (e == 0) {
                    const int tok = tokt + tl;
                    p.tok_exp()[tok * 4 + 0] = bi[0]; p.tok_exp()[tok * 4 + 1] = bi[1]; p.tok_exp()[tok * 4 + 2] = bi[2]; p.tok_exp()[tok * 4 + 3] = bi[3];
                    p.tok_gate()[tok * 4 + 0] = inv; p.tok_gate()[tok * 4 + 1] = e1 * inv; p.tok_gate()[tok * 4 + 2] = e2 * inv; p.tok_gate()[tok * 4 + 3] = e3 * inv;
                    atomicAdd(&lhist[bi[0]], 1); atomicAdd(&lhist[bi[1]], 1); atomicAdd(&lhist[bi[2]], 1); atomicAdd(&lhist[bi[3]], 1);
                }
            }
        }
        __syncthreads();
        if (tid < 32) p.wg_cnt()[tb * 32 + tid] = lhist[tid];
        __syncthreads();
    }
    for (long task = gt; task < 96L * 16384; task += ntot) {
        const int mat = (int)(task >> 14), r = (int)(task & 16383), kq = r >> 10, n = r & 1023;
        const int which = mat >> 5, e = mat & 31;
        const float* W = (which == 0 ? p.w_gate : which == 1 ? p.w_up : p.w_down) + (size_t)e * 1048576 + (size_t)(kq * 64) * 1024 + n;
        unsigned char* outp = (which == 0 ? p.wgT() : which == 1 ? p.wuT() : p.wdT()) + (size_t)e * 1048576 + (size_t)n * 1024 + kq * 64;
        float v[64];
#pragma unroll
        for (int i = 0; i < 64; ++i) v[i] = W[(size_t)i * 1024] * 32.0f;
        uint4* dst = (uint4*)outp;
#pragma unroll
        for (int i = 0; i < 4; ++i) dst[i] = make_uint4(pk4_fp8(v[16 * i], v[16 * i + 1], v[16 * i + 2], v[16 * i + 3]), pk4_fp8(v[16 * i + 4], v[16 * i + 5], v[16 * i + 6], v[16 * i + 7]),
                                                        pk4_fp8(v[16 * i + 8], v[16 * i + 9], v[16 * i + 10], v[16 * i + 11]), pk4_fp8(v[16 * i + 12], v[16 * i + 13], v[16 * i + 14], v[16 * i + 15]));
    }
}

__device__ __forceinline__ void ph_fill(const P& p, unsigned char* lds) {
    const int tid = tid_();
    int* tot = (int*)lds;
    int* pre = tot + 512;
    int* ps = pre + 512;
    int* lc = ps + 32;
    for (int tb = blockIdx.x; tb < NTOK / 128; tb += gridDim.x) {
        {
            const int e = tid & 31, part = tid >> 5;
            int t = 0, q = 0;
            for (int b2 = part; b2 < NTOK / 128; b2 += 16) { const int c = p.wg_cnt()[b2 * 32 + e]; t += c; if (b2 < tb) q += c; }
            tot[part * 32 + e] = t; pre[part * 32 + e] = q;
        }
        __syncthreads();
        if (tid == 0) {
            int acc = 0;
            for (int e = 0; e < NE; ++e) {
                int t = 0, q = 0;
                for (int i = 0; i < 16; ++i) { t += tot[i * 32 + e]; q += pre[i * 32 + e]; }
                ps[e] = acc + q; lc[e] = 0;
                const int nb = (t + 255) >> 8;
                if (tb == 0) for (int i = 0; i < nb; ++i) p.block_expert()[(acc >> 8) + i] = e;
                acc += nb * 256;
            }
            if (tb == 0) p.ctr()[96] = acc >> 8;
        }
        __syncthreads();
        {
            const int i = tb * 512 + tid;
            const int e = p.tok_exp()[i];
            const int dest = ps[e] + atomicAdd(&lc[e], 1);
            p.slot_token()[dest] = i >> 2;
            p.slot_rank()[dest] = i & 3;
            p.slot_gate()[dest] = p.tok_gate()[i];
            p.slot_info()[dest] = make_int2((i >> 2) | ((i & 3) << 16), __float_as_int(p.tok_gate()[i]));
        }
        __syncthreads();
    }
}

__device__ __forceinline__ void ph_moe1(const P& p, unsigned char* lds) {
    const int nblocks = p.ctr()[96], G = gridDim.x, b0 = blockIdx.x, bpx = (nblocks + 7) >> 3, bpi = G >> 6, xl = b0 >> 3, xbase = (b0 & 7) * bpx;
    auto unit = [&](int i, int& rb, int& ct) __attribute__((always_inline)) -> bool {
        const int k = i * bpi + (xl >> 3); rb = xbase + k; ct = xl & 7; return k < bpx && rb < nblocks && (xl >> 3) < bpi; };
    auto jobfn = [&](int i, G8Job& j) __attribute__((always_inline)) -> bool {
        int rb, ct; if (!unit(i, rb, ct)) return false;
        const int e = p.block_expert()[rb];
        j.A = (const char*)p.xn2(); j.B = (const char*)(p.wgT() + (size_t)e * 1048576 + (size_t)ct * 128 * 1024);
        const int* st = p.slot_token() + rb * 256; unsigned v[4];
#pragma unroll
        for (int q = 0; q < 4; ++q) { int R, Cb; g8_rc(q, R, Cb); const int t = st[R]; v[q] = (unsigned)((t < 0 ? 0 : t) * 1024 + Cb); }
        j.va0 = v[0]; j.va1 = v[1]; j.va2 = v[2]; j.va3 = v[3]; return true; };
    auto epi = [&](f32x4 (&acc)[2][2][4][2], int i) __attribute__((always_inline)) {
        int rb, ct; unit(i, rb, ct);
        const int e = p.block_expert()[rb];
        const int tid_e = tid_(), lane_e = tid_e & 63, wid_e = tid_e >> 6, wr = wid_e >> 2, wc = wid_e & 3, fr = lane_e & 15, fq = lane_e >> 4;
#pragma unroll
        for (int n = 0; n < 2; ++n) {
            const int c = ct * 128 + wc * 32 + n * 16 + fq * 4;
            const f32x4 bg = *(const f32x4*)(p.b_gate + (size_t)e * DFF + c), bu = *(const f32x4*)(p.b_up + (size_t)e * DFF + c);
#pragma unroll
            for (int ai = 0; ai < 2; ++ai)
#pragma unroll
                for (int m = 0; m < 4; ++m) {
                    const int row = rb * 256 + ai * 128 + wr * 64 + m * 16 + fr;
                    f32x4 a;
#pragma unroll
                    for (int j = 0; j < 4; ++j) {
                        const float g = fminf(acc[ai][0][m][n][j] * 0.03125f + bg[j], 7.0f);
                        const float uu = fminf(fmaxf(acc[ai][1][m][n][j] * 0.03125f + bu[j], -7.0f), 7.0f);
                        a[j] = (uu + 1.0f) * (g * sigmoidf_(1.702f * g));
                    }
                    *(uint32_t*)(p.act() + (size_t)row * DFF + c) = pk4_fp8(a[0], a[1], a[2], a[3]);
                }
        }
    };
    unsigned vbU[4];
#pragma unroll
    for (int q = 0; q < 4; ++q) { int R, Cb; g8_rc(q, R, Cb); vbU[q] = (unsigned)((size_t)(R >> 7) * WE8_B + (size_t)(R & 127) * 1024 + Cb); }
    gemm8_stream<true>(lds, vbU, jobfn, epi);
}
__device__ __forceinline__ void ph_moe2(const P& p, unsigned char* lds) {
    const int nblocks = p.ctr()[96], G = gridDim.x, b0 = blockIdx.x, bpx = (nblocks + 7) >> 3, bpi = G >> 5, xl = b0 >> 3, xbase = (b0 & 7) * bpx;
    auto unit = [&](int i, int& rb, int& nt) __attribute__((always_inline)) -> bool {
        const int k = i * bpi + (xl >> 2); rb = xbase + k; nt = xl & 3; return k < bpx && rb < nblocks && (xl >> 2) < bpi; };
    unsigned vbU[4];
#pragma unroll
    for (int q = 0; q < 4; ++q) { int R, Cb; g8_rc(q, R, Cb); vbU[q] = (unsigned)(R * DFF + Cb); }
    auto jobfn = [&](int i, G8Job& j) __attribute__((always_inline)) -> bool {
        int rb, nt; if (!unit(i, rb, nt)) return false;
        const int e = p.block_expert()[rb];
        j.A = (const char*)(p.act() + (size_t)rb * 256 * DFF); j.B = (const char*)(p.wdT() + (size_t)e * 1048576 + (size_t)nt * 256 * DFF); return true; };
    auto epi = [&](f32x4 (&acc)[2][2][4][2], int i) __attribute__((always_inline)) {
        int rb, nt; unit(i, rb, nt);
        const int e = p.block_expert()[rb];
        const int tid_e = tid_(), lane_e = tid_e & 63, wid_e = tid_e >> 6, wr = wid_e >> 2, wc = wid_e & 3, fr = lane_e & 15, fq = lane_e >> 4;
        f32x4 bd[2][2];
#pragma unroll
        for (int bj = 0; bj < 2; ++bj)
#pragma unroll
            for (int n = 0; n < 2; ++n) bd[bj][n] = *(const f32x4*)(p.b_down + (size_t)e * D + nt * 256 + bj * 128 + wc * 32 + n * 16 + fq * 4);
        int2 info[2][4];
#pragma unroll
        for (int ai = 0; ai < 2; ++ai)
#pragma unroll
            for (int m = 0; m < 4; ++m) info[ai][m] = p.slot_info()[rb * 256 + ai * 128 + wr * 64 + m * 16 + fr];
#pragma unroll
        for (int ai = 0; ai < 2; ++ai)
#pragma unroll
            for (int m = 0; m < 4; ++m) {
                const int ix = info[ai][m].x;
                if (ix < 0) continue;
                const int rank = ix >> 16; const float gate = __int_as_float(info[ai][m].y) * 0.03125f;
                const size_t o = (size_t)(ix & 0xffff) * D + nt * 256 + wc * 32 + fq * 4;
                bf16_t* yb = (rank == 0 ? p.y0() : rank == 1 ? p.y1() : (rank == 2 ? p.y2() : p.y3())) + o;
#pragma unroll
                for (int bj = 0; bj < 2; ++bj)
#pragma unroll
                    for (int n = 0; n < 2; ++n) st_bf4(yb + bj * 128 + n * 16, (acc[ai][bj][m][n] + bd[bj][n] * 32.0f) * gate);
            }
    };
    gemm8_stream<false>(lds, vbU, jobfn, epi);
}

__device__ __forceinline__ void ph_final(const P& p, unsigned char* lds) {
    const int tid = tid_(), lane = tid & 63, wid = tid >> 6;
    const int gw = blockIdx.x * 8 + wid, nw = gridDim.x * 8;
    for (int tok = gw; tok < NTOK; tok += nw) {
        float* dst = p.out + (size_t)tok * D;
        f32x4 v[4];
#pragma unroll
        for (int i = 0; i < 4; ++i) v[i] = *(const f32x4*)(dst + lane * 4 + 256 * i);
#pragma unroll
        for (int j = 0; j < 4; ++j) {
            const bf16_t* yr = (j == 0 ? p.y0() : j == 1 ? p.y1() : j == 2 ? p.y2() : p.y3()) + (size_t)tok * D;
#pragma unroll
            for (int i = 0; i < 4; ++i) {
                const uint2 w = *(const uint2*)(yr + lane * 4 + 256 * i);
                v[i][0] += __uint_as_float(w.x << 16); v[i][1] += __uint_as_float(w.x & 0xffff0000u);
                v[i][2] += __uint_as_float(w.y << 16); v[i][3] += __uint_as_float(w.y & 0xffff0000u);
            }
        }
        float ss = 0.f;
#pragma unroll
        for (int i = 0; i < 4; ++i) ss += v[i][0] * v[i][0] + v[i][1] * v[i][1] + v[i][2] * v[i][2] + v[i][3] * v[i][3];
        ss = wave_sum(ss);
        const float rs = rsqrtf(ss * (1.0f / D) + EPS);
#pragma unroll
        for (int i = 0; i < 4; ++i) {
            const f32x4 g = *(const f32x4*)(p.final_g + lane * 4 + 256 * i);
            *(f32x4*)(dst + lane * 4 + 256 * i) = v[i] * rs * g;
        }
    }
}

typedef const __attribute__((address_space(4))) P* PK;
#define PHASE(call) do { PK q_ = pk; asm volatile("" : "+s"(q_)); const P& p = *(const P*)q_; call; } while (0)
__global__ void __launch_bounds__(NTHREADS) k_mega(P p_unused) {
    __shared__ __attribute__((aligned(16))) unsigned char lds[LDS_BYTES];
    cg::grid_group grid = cg::this_grid();
    const PK pk = (PK)__builtin_amdgcn_kernarg_segment_ptr();
    if (tid_() < 4) ((unsigned*)(lds + LDS_BYTES - 32))[tid_()] = 0u;
    __syncthreads();
    XcdBarrier xb;
    PHASE(xb = xcd_barrier_post((unsigned*)(p.ws + OFF_BAR), (volatile LAS unsigned*)(lds + LDS_BYTES - 32)));
    PHASE(if (p.ws == nullptr) grid.sync());
    PHASE(ph_prep(p, lds)); xcd_barrier(xb);
    PHASE(ph_inproj(p, lds)); xcd_barrier(xb);
    PHASE(ph_mixer<0>(p, lds)); xcd_barrier(xb);
    PHASE(ph_mixer<1>(p, lds)); xcd_barrier(xb);
    PHASE(ph_mixer<2>(p, lds)); xcd_barrier(xb);
    PHASE(ph_mix(p, lds)); xcd_barrier(xb);
    PHASE(ph_out(p, lds)); xcd_barrier(xb);
    PHASE(ph_route(p, lds)); xcd_barrier(xb);
    PHASE(ph_fill(p, lds)); xcd_barrier(xb);
    PHASE(ph_moe1(p, lds)); xcd_barrier(xb);
    PHASE(ph_moe2(p, lds)); xcd_barrier(xb);
    PHASE(ph_final(p, lds));
}

extern "C" void kernel_launch(void* const* d_in, const int* in_sizes, int n_in, void* d_out, int out_size, void* d_ws, size_t ws_size,
                              hipStream_t stream) {
    P p{};
    p.x = (const float*)d_in[0]; p.meta = (const float*)d_in[1]; p.attn_g = (const float*)d_in[2]; p.w_in = (const float*)d_in[3];
    p.hgrn_g = (const float*)d_in[4]; p.w_ua = (const float*)d_in[5]; p.w_uh = (const float*)d_in[6]; p.w_out = (const float*)d_in[7];
    p.lb_logits = (const float*)d_in[8]; p.ffn_g = (const float*)d_in[9]; p.router_w = (const float*)d_in[10]; p.router_b = (const float*)d_in[11];
    p.w_gate = (const float*)d_in[12]; p.b_gate = (const float*)d_in[13]; p.w_up = (const float*)d_in[14]; p.b_up = (const float*)d_in[15];
    p.w_down = (const float*)d_in[16]; p.b_down = (const float*)d_in[17]; p.final_g = (const float*)d_in[18];
    p.out = (float*)d_out;
    p.ws = (unsigned char*)d_ws;
    if (WS_NEED > ws_size) { fprintf(stderr, "workspace too small: need %zu have %zu\n", (size_t)WS_NEED, ws_size); return; }
    static int grid_blocks = 0;
    if (!grid_blocks) {
        int dev = 0, cus = 0, per_cu = 0;
        hipGetDevice(&dev);
        hipDeviceGetAttribute(&cus, hipDeviceAttributeMultiprocessorCount, dev);
        hipOccupancyMaxActiveBlocksPerMultiprocessor(&per_cu, k_mega, NTHREADS, 0);
        if (per_cu > 1) per_cu = 1;
        grid_blocks = cus * per_cu;
    }
    hipMemsetAsync(p.ws + OFF_BAR, 0, XCD_BAR_WORDS * 4, stream);
    void* args[] = {&p};
    hipError_t e = hipLaunchCooperativeKernel((void*)k_mega, dim3(grid_blocks), dim3(NTHREADS), args, 0, stream);
    if (e != hipSuccess) fprintf(stderr, "cooperative launch failed: %s (grid %d)\n", hipGetErrorString(e), grid_blocks);
}
```

```cpp
#include <hip/hip_runtime.h>
#include <hip/hip_cooperative_groups.h>
#include <stdint.h>
#include <cstdio>
namespace cg = cooperative_groups;

#ifndef MEGA
#define MEGA 1
#endif

typedef unsigned short bf16_t;
typedef short bf16x8 __attribute__((ext_vector_type(8)));
typedef float f32x4 __attribute__((ext_vector_type(4)));

constexpr int D = 1024, NB = 4, SEQ = 8192, NMETA = 16, L = SEQ + NMETA  , LP = 8320, T = NB * LP  ;
constexpr int NTOK = NB * SEQ;
constexpr int IN_COLS = 5160;
constexpr int NE = 32, TOPK = 4, DFF = 1024;
constexpr int CAP_BLOCKS = (NTOK * TOPK) / 256 + NE;
constexpr int CAP = CAP_BLOCKS * 256;
constexpr float EPS = 1e-5f;
constexpr int NTHREADS = 512;
constexpr int LDS_BYTES = 155648;
constexpr int NVC = 5376;
#define LAS __attribute__((address_space(3)))

typedef __bf16 hwbf16x2 __attribute__((ext_vector_type(2)));
typedef float f32x2 __attribute__((ext_vector_type(2)));
__device__ __forceinline__ uint32_t pack2(float a, float b) { const f32x2 v = {a, b}; return __builtin_bit_cast(uint32_t, __builtin_convertvector(v, hwbf16x2)); }
__device__ __forceinline__ bf16_t f2bf(float f) { return (bf16_t)(pack2(f, 0.f) & 0xffffu); }
__device__ __forceinline__ float bf2f(bf16_t h) { return __uint_as_float(((uint32_t)h) << 16); }
__device__ __forceinline__ uint32_t pk4_fp8(float a, float b, float c, float d) {
    a = fminf(fmaxf(a, -448.f), 448.f); b = fminf(fmaxf(b, -448.f), 448.f); c = fminf(fmaxf(c, -448.f), 448.f); d = fminf(fmaxf(d, -448.f), 448.f);
    int w = __builtin_amdgcn_cvt_pk_fp8_f32(a, b, 0, false); w = __builtin_amdgcn_cvt_pk_fp8_f32(c, d, w, true); return (uint32_t)w;
}
__device__ __forceinline__ float sigmoidf_(float x) { return __builtin_amdgcn_rcpf(1.0f + __builtin_amdgcn_exp2f(-1.4426950408889634f * x)); }
template <int CTRL, int RM = 0xf, bool BC = true>
__device__ __forceinline__ int dpp_mov(int v) { return __builtin_amdgcn_update_dpp(0, v, CTRL, RM, 0xf, BC); }
template <int O> __device__ __forceinline__ int lane_xor_i(int v) {
    if (O == 1) return dpp_mov<0xB1>(v);
    if (O == 2) return dpp_mov<0x4E>(v);
    if (O == 4) return dpp_mov<0x1B>(dpp_mov<0x141>(v));
    if (O == 8) return dpp_mov<0x128>(v);
    const int lane = (int)__builtin_amdgcn_mbcnt_hi(~0u, __builtin_amdgcn_mbcnt_lo(~0u, 0u));
    if (O == 16) { const auto r = __builtin_amdgcn_permlane16_swap((unsigned)v, (unsigned)v, false, false); return (lane & 16) ? (int)r[0] : (int)r[1]; }
    const auto r = __builtin_amdgcn_permlane32_swap((unsigned)v, (unsigned)v, false, false); return (lane & 32) ? (int)r[0] : (int)r[1];
}
template <int O> __device__ __forceinline__ float lane_xor_f(float v) { return __int_as_float(lane_xor_i<O>(__float_as_int(v))); }
__device__ __forceinline__ float xsum16(float v) { const auto r = __builtin_amdgcn_permlane16_swap(__float_as_uint(v), __float_as_uint(v), false, false); return __uint_as_float(r[0]) + __uint_as_float(r[1]); }
__device__ __forceinline__ float xsum32(float v) { const auto r = __builtin_amdgcn_permlane32_swap(__float_as_uint(v), __float_as_uint(v), false, false); return __uint_as_float(r[0]) + __uint_as_float(r[1]); }
__device__ __forceinline__ float xmax16(float v) { const auto r = __builtin_amdgcn_permlane16_swap(__float_as_uint(v), __float_as_uint(v), false, false); return fmaxf(__uint_as_float(r[0]), __uint_as_float(r[1])); }
__device__ __forceinline__ float xmax32(float v) { const auto r = __builtin_amdgcn_permlane32_swap(__float_as_uint(v), __float_as_uint(v), false, false); return fmaxf(__uint_as_float(r[0]), __uint_as_float(r[1])); }
__device__ __forceinline__ float xmin16(float v) { const auto r = __builtin_amdgcn_permlane16_swap(__float_as_uint(v), __float_as_uint(v), false, false); return fminf(__uint_as_float(r[0]), __uint_as_float(r[1])); }
__device__ __forceinline__ int wave_incl_scan(int x) {
    x += dpp_mov<0x111>(x); x += dpp_mov<0x112>(x); x += dpp_mov<0x114>(x); x += dpp_mov<0x118>(x);
    x += dpp_mov<0x142, 0xa, false>(x);
    x += dpp_mov<0x143, 0xc, false>(x);
    return x;
}
__device__ __forceinline__ float readlane_f(float v, int l) { return __int_as_float(__builtin_amdgcn_readlane(__float_as_int(v), l)); }
__device__ __forceinline__ float wave_sum(float v) {
#pragma unroll
    for (int o = 32; o >= 1; o >>= 1) v += __shfl_xor(v, o);
    return v;
}
__device__ __forceinline__ float wave_max(float v) {
#pragma unroll
    for (int o = 32; o >= 1; o >>= 1) v = fmaxf(v, __shfl_xor(v, o));
    return v;
}

constexpr size_t al256(size_t x) { return (x + 255) & ~(size_t)255; }
constexpr size_t TT = (size_t)T;
constexpr size_t MB1 = 1024 * 1024;
constexpr size_t WE8_B = (size_t)NE * 1024 * 1024;
constexpr size_t OFF_WGT = 0, OFF_WUT = WE8_B, OFF_WDT = 2 * WE8_B, OFF_XN2 = 3 * WE8_B, OFF_ACT = OFF_XN2 + (size_t)NTOK * D,
                 OFF_Y1 = OFF_ACT + (size_t)CAP * DFF, OFF_Y2 = OFF_Y1 + (size_t)NTOK * D, OFF_Y3 = OFF_Y2 + (size_t)NTOK * D,
                 OFF_H1B = OFF_Y3 + (size_t)NTOK * D,
                 OFF_S2_END = OFF_H1B + (size_t)NTOK * D * 2;
constexpr size_t OFF_WIN = 0, OFF_WUA = OFF_WIN + (size_t)NVC * 1024 * 2, OFF_WUH = OFF_WUA + MB1, OFF_WO = OFF_WUH + MB1, OFF_XN = OFF_WO + 2 * MB1,
                 OFF_Q = OFF_XN + TT * 2048, OFF_K = OFF_Q + TT * 1024, OFF_V = OFF_K + TT * 256, OFF_IQ = OFF_V + TT * 256, OFF_IK = OFF_IQ + TT * 512,
                 OFF_IW = OFF_IK + TT * 64, OFF_HQ = OFF_IW + TT * 32, OFF_HF = OFF_HQ + TT * 1024, OFF_HI = OFF_HF + TT * 1024, OFF_HG = OFF_HI + TT * 1024,
                 OFF_GA = OFF_HG + TT * 1024, OFF_GH = OFF_GA + TT * 2048, OFF_ATT = OFF_GH + TT * 2048, OFF_HGR = OFF_ATT + TT * 1024,
                 OFF_S1_END = OFF_HGR + TT * 1024;
static_assert(2 * WE8_B >= (size_t)NTOK * D * 2, "y0 does not fit over the gate/up weights");
constexpr size_t OFF_MIX = OFF_XN;
static_assert(OFF_H1B >= OFF_GA, "h1b (written by ph_out) must lie in stage-1 buffers that are dead by then");
constexpr size_t OFF_TAB = OFF_S1_END > OFF_S2_END ? OFF_S1_END : OFF_S2_END;
constexpr size_t OFF_ROPE = OFF_TAB, OFF_LB = OFF_ROPE + al256((size_t)LP * 24 * 4), OFF_CTR = OFF_LB + al256(512 * 4),
                 OFF_BEXP = OFF_CTR + al256(128 * 4), OFF_SLOT = OFF_BEXP + al256((size_t)CAP_BLOCKS * 4), OFF_SRANK = OFF_SLOT + al256((size_t)CAP * 4),
                 OFF_SGATE = OFF_SRANK + al256((size_t)CAP * 4), OFF_TEXP = OFF_SGATE + al256((size_t)CAP * 4), OFF_TGATE = OFF_TEXP + al256((size_t)NTOK * 16),
                 OFF_BAR = OFF_TGATE + al256((size_t)NTOK * 16), OFF_WGC = OFF_BAR + al256(3456 * 4), OFF_SINFO = OFF_WGC + al256(256 * 32 * 4), WS_NEED = OFF_SINFO + al256((size_t)CAP * 8);


__device__ __forceinline__ int tid_() { int t = threadIdx.x; asm volatile("" : "+v"(t)); return t; }

struct P {
    const float *x, *meta, *attn_g, *w_in, *hgrn_g, *w_ua, *w_uh, *w_out, *lb_logits, *ffn_g, *router_w, *router_b,
        *w_gate, *b_gate, *w_up, *b_up, *w_down, *b_down, *final_g;
    float* out;
    unsigned char* ws;
#define WSF(type, name, off) __device__ __forceinline__ type* name() const { return (type*)(ws + (off)); }
    WSF(bf16_t, xn, OFF_XN) WSF(unsigned char, xn8, OFF_ATT) WSF(unsigned char, winT8, OFF_WIN) WSF(bf16_t, winTb, OFF_WIN + 6 * MB1) WSF(bf16_t, q, OFF_Q) WSF(bf16_t, k, OFF_K) WSF(unsigned char, q8, OFF_Q) WSF(unsigned char, k8, OFF_K) WSF(unsigned char, v8, OFF_V)        WSF(bf16_t, v, OFF_V) WSF(bf16_t, iq, OFF_IQ) WSF(bf16_t, ik, OFF_IK)
    WSF(bf16_t, hq, OFF_HQ) WSF(bf16_t, hf, OFF_HF) WSF(bf16_t, hi, OFF_HI) WSF(bf16_t, hg, OFF_HG) WSF(unsigned char, ga, OFF_GA) WSF(unsigned char, gh, OFF_GH)
    WSF(bf16_t, att, OFF_ATT) WSF(bf16_t, hgr, OFF_HGR) WSF(bf16_t, mix, OFF_MIX) WSF(unsigned char, xn2, OFF_XN2) WSF(unsigned char, act, OFF_ACT)
    WSF(bf16_t, h1b, OFF_H1B) WSF(bf16_t, y0, OFF_WGT) WSF(bf16_t, y1, OFF_Y1) WSF(bf16_t, y2, OFF_Y2) WSF(bf16_t, y3, OFF_Y3)
    WSF(bf16_t, winT, OFF_WIN) WSF(bf16_t, wuaT, OFF_WUA) WSF(bf16_t, wuhT, OFF_WUH) WSF(bf16_t, woT, OFF_WO)
    WSF(unsigned char, wgT, OFF_WGT) WSF(unsigned char, wuT, OFF_WUT) WSF(unsigned char, wdT, OFF_WDT)
    WSF(float, iw, OFF_IW) WSF(float, rope, OFF_ROPE) WSF(float, lb, OFF_LB) WSF(float, tok_gate, OFF_TGATE) WSF(float, slot_gate, OFF_SGATE)
    WSF(int, ctr, OFF_CTR)
    WSF(int, wg_cnt, OFF_WGC) WSF(int2, slot_info, OFF_SINFO) WSF(int, block_expert, OFF_BEXP) WSF(int, slot_token, OFF_SLOT) WSF(int, slot_rank, OFF_SRANK) WSF(int, tok_exp, OFF_TEXP)
};

template <class ColMap>
__device__ __forceinline__ void convert_T8(const float* W, int ldw, unsigned char* out, int K, int N, const ColMap& cmap, float scale, int gt, int ntot) {
    const int kb = K / 64; const long ntask = (long)N * kb;
    for (long task = gt; task < ntask; task += ntot) {
        const int kq = (int)(task / N), n = (int)(task % N);
        const int c = cmap(n);
        uint32_t w[16];
        if (c >= 0) {
            const float* src = W + (size_t)(kq * 64) * ldw + c;
            float v[64];
#pragma unroll
            for (int i = 0; i < 64; ++i) v[i] = src[(size_t)i * ldw] * scale;
#pragma unroll
            for (int i = 0; i < 16; ++i) w[i] = pk4_fp8(v[4 * i], v[4 * i + 1], v[4 * i + 2], v[4 * i + 3]);
        } else {
#pragma unroll
            for (int i = 0; i < 16; ++i) w[i] = 0u;
        }
        uint4* dst = (uint4*)(out + (size_t)n * K + kq * 64);
#pragma unroll
        for (int i = 0; i < 4; ++i) dst[i] = make_uint4(w[4 * i], w[4 * i + 1], w[4 * i + 2], w[4 * i + 3]);
    }
}
template <class ColMap>
__device__ __forceinline__ void convert_T(const float* W, int ldw, bf16_t* out, int K, int N, const ColMap& cmap, int gt, int ntot) {
    const int kb = K / 64; const long ntask = (long)N * kb;
    for (long task = gt; task < ntask; task += ntot) {
        const int kq = (int)(task / N), n = (int)(task % N);
        const int c = cmap(n);
        uint32_t w[32];
        if (c >= 0) {
            const float* src = W + (size_t)(kq * 64) * ldw + c;
            float v[64];
#pragma unroll
            for (int i = 0; i < 64; ++i) v[i] = src[(size_t)i * ldw];
#pragma unroll
            for (int i = 0; i < 32; ++i) w[i] = pack2(v[2 * i], v[2 * i + 1]);
        } else {
#pragma unroll
            for (int i = 0; i < 32; ++i) w[i] = 0u;
        }
        uint4* dst = (uint4*)(out + (size_t)n * K + kq * 64);
#pragma unroll
        for (int i = 0; i < 8; ++i) dst[i] = make_uint4(w[4 * i], w[4 * i + 1], w[4 * i + 2], w[4 * i + 3]);
    }
}
struct IdMap { __device__ __forceinline__ int operator()(int n) const { return n; } };
struct WinMap { __device__ __forceinline__ int operator()(int n) const { return n < 1064 ? n : (n < 1280 ? -1 : n - 216); } };
struct WinMapIdx { __device__ __forceinline__ int operator()(int n) const { return WinMap{}(768 + n); } };

#define XB_TMO      128
#define XB_XCNT(j)  (256  + 64 * (j))
#define XB_XSUB(j)  (1280 + 64 * (j))
#define XB_XGEN(j)  (2304 + 64 * (j))
#define XB_TOP      3328
#define XB_TOPGEN   3392
#define XCD_BAR_WORDS 3456
#define XB_SPIN_CAP (1u << 22)
__device__ __forceinline__ unsigned xb_ld(unsigned* p)              { return __hip_atomic_load(p, __ATOMIC_RELAXED, __HIP_MEMORY_SCOPE_AGENT); }
__device__ __forceinline__ unsigned xb_add(unsigned* p, unsigned v) { return __hip_atomic_fetch_add(p, v, __ATOMIC_RELAXED, __HIP_MEMORY_SCOPE_AGENT); }
__device__ __forceinline__ unsigned xb_xcc_id() { return (unsigned)__builtin_amdgcn_s_getreg((3 << 11) | 20) & 0xFu; }
#define XB_SPIN(cond, bar) do { unsigned _sp = 0; while (cond) { __builtin_amdgcn_s_sleep(1); \
    if ((++_sp & 255u) == 0u) { if (xb_ld(&(bar)[XB_TMO])) break; if (_sp > XB_SPIN_CAP) { atomicAdd(&(bar)[XB_TMO], 1u); break; } } } } while (0)
struct XcdBarrier { unsigned* bar; unsigned x; volatile LAS unsigned* st; };
__device__ __forceinline__ XcdBarrier xcd_barrier_post(unsigned* bar, volatile LAS unsigned* st) {
    XcdBarrier b; b.bar = bar; b.x = xb_xcc_id(); b.st = st;
    if (threadIdx.x == 0) (void)xb_add(&bar[XB_XCNT(b.x)], 1u);
    return b;
}
__device__ __forceinline__ void xcd_barrier_complete(unsigned* bar, unsigned x, unsigned& nloc, unsigned& nx) {
    const unsigned G = gridDim.x * gridDim.y * gridDim.z;
    unsigned sum, cnt, mine, sp = 0u;
    for (;;) {
        sum = 0u; cnt = 0u; mine = 0u;
#pragma unroll
        for (unsigned j = 0; j < 16; ++j) { const unsigned c = xb_ld(&bar[XB_XCNT(j)]); sum += c; cnt += (c > 0u) ? 1u : 0u; mine = (j == x) ? c : mine; }
        if (sum == G) break;
        __builtin_amdgcn_s_sleep(1);
        if ((++sp & 255u) == 0u) { if (xb_ld(&bar[XB_TMO])) break; if (sp > XB_SPIN_CAP) { atomicAdd(&bar[XB_TMO], 1u); break; } }
    }
    nloc = mine > 0u ? mine : 1u; nx = cnt > 0u ? cnt : 1u;
}
__device__ __forceinline__ void xcd_barrier(const XcdBarrier& b) {
    asm volatile("s_waitcnt vmcnt(0)" ::: "memory");
    __syncthreads();
    if (threadIdx.x == 0) {
        unsigned* bar = b.bar;
        __builtin_amdgcn_s_waitcnt(0);
        unsigned nloc = b.st[0], nx = b.st[1];
        if (nloc == 0u) { xcd_barrier_complete(bar, b.x, nloc, nx); b.st[0] = nloc; b.st[1] = nx; }
        const unsigned old = xb_add(&bar[XB_XSUB(b.x)], 1u);
        const unsigned gen = old / nloc;
        if (old + 1u == (gen + 1u) * nloc) {
            __builtin_amdgcn_fence(__ATOMIC_RELEASE, "agent");
            asm volatile("s_waitcnt vmcnt(0)" ::: "memory");
            const unsigned og = xb_add(&bar[XB_TOP], 1u);
            const unsigned tg = og / nx;
            if (og + 1u == (tg + 1u) * nx) xb_add(&bar[XB_TOPGEN], 1u);
            else XB_SPIN(xb_ld(&bar[XB_TOPGEN]) == tg, bar);
            __builtin_amdgcn_fence(__ATOMIC_ACQUIRE, "agent");
            xb_add(&bar[XB_XGEN(b.x)], 1u);
            asm volatile("s_waitcnt vmcnt(0)" ::: "memory");
        } else {
            XB_SPIN(xb_ld(&bar[XB_XGEN(b.x)]) == gen, bar);
            __builtin_amdgcn_fence(__ATOMIC_ACQUIRE, "agent");
            asm volatile("s_waitcnt vmcnt(0)" ::: "memory");
        }
    }
    __syncthreads();
}

__device__ __forceinline__ void ph_prep(const P& p, unsigned char* lds) {
    const int tid = tid_(), lane = tid & 63, wid = tid >> 6;
    const int gw = blockIdx.x * 8 + wid, nw = gridDim.x * 8;
    for (int r = gw; r < T; r += nw) {
        const int b = r / LP, pos = r % LP;
        unsigned char* dst = p.xn8() + (size_t)r * D; bf16_t* dstb = p.xn() + (size_t)r * D;
        if (pos >= L) {
#pragma unroll
            for (int i = 0; i < 4; ++i) { *(uint32_t*)(dst + lane * 4 + 256 * i) = 0u; *(uint2*)(dstb + lane * 4 + 256 * i) = make_uint2(0u, 0u); }
            continue;
        }
        const float* src = pos < NMETA ? p.meta + (size_t)pos * D : p.x + ((size_t)b * SEQ + (pos - NMETA)) * D;
        f32x4 v[4]; float ss = 0.f;
#pragma unroll
        for (int i = 0; i < 4; ++i) { v[i] = *(const f32x4*)(src + lane * 4 + 256 * i); ss += v[i][0] * v[i][0] + v[i][1] * v[i][1] + v[i][2] * v[i][2] + v[i][3] * v[i][3]; }
        ss = wave_sum(ss);
        const float rs = rsqrtf(ss * (1.0f / D) + EPS);
#pragma unroll
        for (int i = 0; i < 4; ++i) {
            const f32x4 g = *(const f32x4*)(p.attn_g + lane * 4 + 256 * i);
            const float y0 = v[i][0] * rs * g[0], y1 = v[i][1] * rs * g[1], y2 = v[i][2] * rs * g[2], y3 = v[i][3] * rs * g[3];
            *(uint32_t*)(dst + lane * 4 + 256 * i) = pk4_fp8(y0, y1, y2, y3);
            uint2 o; o.x = pack2(y0, y1); o.y = pack2(y2, y3);
            *(uint2*)(dstb + lane * 4 + 256 * i) = o;
        }
    }
    const int gt = blockIdx.x * NTHREADS + tid, nt = gridDim.x * NTHREADS;
    for (int i = gt; i < LP * 12; i += nt) {
        const int pos = i / 12, f = i % 12;
        const double ex = f < 8 ? -(double)f / 8.0 : -(double)(f - 8) / 4.0;
        const double inv = exp(ex * log(500000.0));
        const double ang = (double)pos * inv;
        const double twopi = 6.283185307179586476925286766559;
        const double r = ang - twopi * rint(ang / twopi);
        const float rf = (float)r;
        const float c = cosf(rf), s = sinf(rf);
        float* row = p.rope() + (size_t)pos * 24;
        if (f < 8) { row[f] = c; row[8 + f] = s; } else { row[16 + f - 8] = c; row[20 + f - 8] = s; }
    }
    for (int i = gt; i < 512; i += nt) {
        const float a = p.lb_logits[i], b2 = p.lb_logits[512 + i];
        p.lb()[i] = 1.0f / (1.0f + expf(b2 - a));
    }
    for (int i = gt; i < 128; i += nt) p.ctr()[i] = 0;
    convert_T8(p.w_in, IN_COLS, p.winT8(), 1024, NVC, WinMap{}, 32.0f, gt, nt);
    convert_T(p.w_in, IN_COLS, p.winTb(), 1024, 512, WinMapIdx{}, gt, nt);
    convert_T(p.w_ua, 1024, p.wuaT(), 512, 1024, IdMap{}, gt, nt);
    convert_T(p.w_uh, 1024, p.wuhT(), 512, 1024, IdMap{}, gt, nt);
    convert_T(p.w_out, 1024, p.woT(), 1024, 1024, IdMap{}, gt, nt);
}
constexpr int G_TILE_B = 256 * 64 * 2, G_STAGE_B = 2 * G_TILE_B;
__device__ __forceinline__ int g_lds_byte(int r, int c) { const int st = (r >> 4) * 2 + (c >> 5), ob = (r & 15) * 64 + (c & 31) * 2; return st * 1024 + (ob ^ (((ob >> 9) & 1) << 5)); }
__device__ __forceinline__ void g_stage_rc(int b, int& R, int& C) { const int st = b >> 10, sb = b & 1023, swz = sb ^ (((sb >> 9) & 1) << 5); R = (st >> 1) * 16 + swz / 64; C = (st & 1) * 32 + (swz % 64) / 2; }

constexpr int HTB = 128 * 64 * 2;
struct GJob { const char* A; const char* B; unsigned va00, va01, va10, va11; };
__device__ __forceinline__ void gj_lin(unsigned (&v)[2][2], int ld) {
#pragma unroll
    for (int h = 0; h < 2; ++h)
#pragma unroll
        for (int i = 0; i < 2; ++i) { int R, C; g_stage_rc(tid_() * 16 + i * 8192, R, C); v[h][i] = (unsigned)(((h * 128 + R) * ld + C) * 2); }
}
template <class AOff>
__device__ __forceinline__ void gj_gather(unsigned (&v)[2][2], const AOff& aoff) {
#pragma unroll
    for (int h = 0; h < 2; ++h)
#pragma unroll
        for (int i = 0; i < 2; ++i) { int R, C; g_stage_rc(tid_() * 16 + i * 8192, R, C); v[h][i] = (unsigned)((aoff(h * 128 + R) + C) * 2); }
}
template <class AOff>
__device__ __forceinline__ void gj_gather_job(GJob& j, const AOff& aoff) {
    unsigned v[2][2]; gj_gather(v, aoff); j.va00 = v[0][0]; j.va01 = v[0][1]; j.va10 = v[1][0]; j.va11 = v[1][1];
}
template <bool GATHER, class JobFn, class Epi>
__device__ __forceinline__ void gemm_stream(unsigned char* lds_, int K, int lda, size_t hstepB, const unsigned (&vbU)[2], const JobFn& jobfn, const Epi& epi) {
    LAS unsigned char* lds = (LAS unsigned char*)lds_;
    const int tid = tid_(), wid = __builtin_amdgcn_readfirstlane(tid >> 6), lane = tid & 63, wr = wid >> 2, wc = wid & 3, fr = lane & 15, fq = lane >> 4;
    const int nt = K / 64;
    const size_t kstep = 128;
    const size_t hstepA = GATHER ? 0 : (size_t)128 * lda * 2;
    const unsigned ldsw = (unsigned)wid * 1024u;
    const int aoff = g_lds_byte(wr * 64 + fr, fq * 8), boff = g_lds_byte(wc * 32 + fr, fq * 8);
    unsigned vaU[2];
#pragma unroll
    for (int i = 0; i < 2; ++i) { int R, C; g_stage_rc(tid * 16 + i * 8192, R, C); vaU[i] = (unsigned)((R * lda + C) * 2); }
#define PG8_SA(b, h) (((b) * 2 + (h)) * HTB)
#define PG8_SB(b, h) ((4 + (b) * 2 + (h)) * HTB)
#define PG8_STAGE2(bufoff, gbase, v0, v1) do { \
        __builtin_amdgcn_global_load_lds((const unsigned*)((const char*)(gbase) + (v0)), (LAS unsigned*)(lds + (bufoff) + ldsw), 16, 0, 0); \
        __builtin_amdgcn_global_load_lds((const unsigned*)((const char*)(gbase) + (v1)), (LAS unsigned*)(lds + (bufoff) + ldsw + 8192), 16, 0, 0); } while (0)
#define STB(bufoff, gbase, h) PG8_STAGE2(bufoff, (gbase) + ((h) ? hstepB : 0), vbU[0], vbU[1])
#define STA_CUR(bufoff, gbase, h) do { if (GATHER) PG8_STAGE2(bufoff, gbase, (h) ? cur.va10 : cur.va00, (h) ? cur.va11 : cur.va01); else PG8_STAGE2(bufoff, (gbase) + ((h) ? hstepA : 0), vaU[0], vaU[1]); } while (0)
#define STA_SEL(bufoff, gbase, h) do { if (GATHER) PG8_STAGE2(bufoff, gbase, last ? ((h) ? nxt.va10 : nxt.va00) : ((h) ? cur.va10 : cur.va00), last ? ((h) ? nxt.va11 : nxt.va01) : ((h) ? cur.va11 : cur.va01)); \
        else PG8_STAGE2(bufoff, (gbase) + ((h) ? hstepA : 0), vaU[0], vaU[1]); } while (0)
#define PG8_LDA(dst, b, h) do { _Pragma("unroll") for (int m = 0; m < 4; ++m) _Pragma("unroll") for (int k = 0; k < 2; ++k) dst[m][k] = *(const LAS bf16x8*)(lds + PG8_SA(b, h) + aoff + m * 2048 + k * 1024); } while (0)
#define PG8_LDB(dst, b, h) do { _Pragma("unroll") for (int n = 0; n < 2; ++n) _Pragma("unroll") for (int k = 0; k < 2; ++k) dst[n][k] = *(const LAS bf16x8*)(lds + PG8_SB(b, h) + boff + n * 2048 + k * 1024); } while (0)
#define PG8_MMA(ai, bj, At, Bt) do { __builtin_amdgcn_s_setprio(1); _Pragma("unroll") for (int m = 0; m < 4; ++m) _Pragma("unroll") for (int n = 0; n < 2; ++n) _Pragma("unroll") for (int k = 0; k < 2; ++k) \
        acc[ai][bj][m][n] = __builtin_amdgcn_mfma_f32_16x16x32_bf16(Bt[n][k], At[m][k], acc[ai][bj][m][n], 0, 0, 0); __builtin_amdgcn_s_setprio(0); } while (0)
#define PG8_WAIT_V(n) asm volatile("s_waitcnt vmcnt(" #n ")" ::: "memory")
#define PG8_WAIT_L(n) asm volatile("s_waitcnt lgkmcnt(" #n ")" ::: "memory")
#define PG8_BAR __builtin_amdgcn_s_barrier()
#define PG8_SCHED __builtin_amdgcn_sched_barrier(0)
    GJob cur, nxt; int ui = 0;
    cur.A = nullptr; cur.B = nullptr; cur.va00 = cur.va01 = cur.va10 = cur.va11 = 0u; nxt = cur;
    if (!jobfn(0, cur)) return;
    f32x4 acc[2][2][4][2];
#pragma unroll
    for (int a = 0; a < 2; ++a)
#pragma unroll
        for (int b = 0; b < 2; ++b)
#pragma unroll
            for (int m = 0; m < 4; ++m)
#pragma unroll
                for (int n = 0; n < 2; ++n) acc[a][b][m][n] = (f32x4){0.f, 0.f, 0.f, 0.f};
    bf16x8 At[4][2], B0[2][2], B1[2][2];
    STB(PG8_SB(0, 0), cur.B, 0); STB(PG8_SB(0, 1), cur.B, 1); STA_CUR(PG8_SA(0, 0), cur.A, 0); STA_CUR(PG8_SA(0, 1), cur.A, 1);
    if (wr == 1) PG8_BAR;
    PG8_WAIT_V(2); PG8_BAR;
    STB(PG8_SB(1, 0), cur.B + kstep, 0); STA_CUR(PG8_SA(1, 0), cur.A + kstep, 0); STB(PG8_SB(1, 1), cur.B + kstep, 1);
    PG8_WAIT_V(6); PG8_BAR;
    for (;;) {
        bool has_next = false;
        for (int t = 0; t < nt; t += 2) {
            const bool last = (t == nt - 2);
            if (last) { has_next = jobfn(ui + 1, nxt); if (!has_next) nxt = cur; }
            const char* a1 = cur.A + (size_t)(t + 1) * kstep;
            const char* a2 = last ? nxt.A : cur.A + (size_t)(t + 2) * kstep; const char* b2 = last ? nxt.B : cur.B + (size_t)(t + 2) * kstep;
            const char* a3 = a2 + kstep; const char* b3 = b2 + kstep;
            PG8_LDB(B0, 0, 0); PG8_LDB(B1, 0, 1); PG8_SCHED; PG8_LDA(At, 0, 0); STA_CUR(PG8_SA(1, 1), a1, 1);
            PG8_WAIT_V(8); PG8_WAIT_L(0); PG8_BAR; PG8_MMA(0, 0, At, B0); PG8_MMA(0, 1, At, B1); PG8_BAR; PG8_SCHED;
            PG8_LDA(At, 0, 1); STB(PG8_SB(0, 0), b2, 0); STB(PG8_SB(0, 1), b2, 1); STA_SEL(PG8_SA(0, 0), a2, 0);
            PG8_WAIT_V(8); PG8_WAIT_L(0); PG8_BAR; PG8_MMA(1, 0, At, B0); PG8_MMA(1, 1, At, B1); PG8_BAR; PG8_SCHED;
            PG8_LDB(B0, 1, 0); PG8_LDB(B1, 1, 1); PG8_SCHED; PG8_LDA(At, 1, 0); STA_SEL(PG8_SA(0, 1), a2, 1);
            PG8_WAIT_V(8); PG8_WAIT_L(0); PG8_BAR; PG8_MMA(0, 0, At, B0); PG8_MMA(0, 1, At, B1); PG8_BAR; PG8_SCHED;
            PG8_LDA(At, 1, 1); STB(PG8_SB(1, 0), b3, 0); STB(PG8_SB(1, 1), b3, 1); STA_SEL(PG8_SA(1, 0), a3, 0);
            PG8_WAIT_V(8); PG8_WAIT_L(0); PG8_BAR; PG8_MMA(1, 0, At, B0); PG8_MMA(1, 1, At, B1); PG8_BAR; PG8_SCHED;
        }
        if (wr == 0) PG8_BAR;
        epi(acc, ui);
        if (!has_next) break;
#pragma unroll
        for (int a = 0; a < 2; ++a)
#pragma unroll
            for (int b = 0; b < 2; ++b)
#pragma unroll
                for (int m = 0; m < 4; ++m)
#pragma unroll
                    for (int n = 0; n < 2; ++n) acc[a][b][m][n] = (f32x4){0.f, 0.f, 0.f, 0.f};
        cur = nxt; ++ui;
        if (wr == 1) PG8_BAR;
    }
    PG8_WAIT_V(0);
    PG8_BAR;
#undef PG8_SA
#undef PG8_SB
#undef PG8_STAGE2
#undef STB
#undef STA_CUR
#undef STA_SEL
#undef PG8_LDA
#undef PG8_LDB
#undef PG8_MMA
#undef PG8_WAIT_V
#undef PG8_WAIT_L
#undef PG8_BAR
#undef PG8_SCHED
}
__device__ __forceinline__ void gj_lin2(unsigned (&v)[2], int ld) {
#pragma unroll
    for (int i = 0; i < 2; ++i) { int R, C; g_stage_rc(tid_() * 16 + i * 8192, R, C); v[i] = (unsigned)((R * ld + C) * 2); }
}
typedef int i32x8 __attribute__((ext_vector_type(8)));
typedef unsigned u32x4 __attribute__((ext_vector_type(4)));
struct G8Job { const char* A; const char* B; unsigned va0, va1, va2, va3; int aux; };
__device__ __forceinline__ void g8_rc(int i, int& R, int& Cb) { int C; g_stage_rc(tid_() * 16 + i * 8192, R, C); Cb = C * 2; }
__device__ __forceinline__ const char* uni_ptr8(const char* p) {
    const unsigned long long v = (unsigned long long)p;
    const unsigned lo = __builtin_amdgcn_readfirstlane((unsigned)v), hi = __builtin_amdgcn_readfirstlane((unsigned)(v >> 32));
    return (const char*)(((unsigned long long)hi << 32) | lo);
}
#define G8_PRE_DMA(gptr, voff, ldsaddr) asm volatile("s_mov_b32 m0, %2\n\ts_nop 0\n\tglobal_load_lds_dword %0, %1" :: "v"(voff), "s"(gptr), "s"(ldsaddr) : "memory", "m0")
template <bool GATHER, class JobFn, class Pre, class Epi>
__device__ __forceinline__ void gemm8_stream(unsigned char* lds_, const unsigned (&vbU)[4], const JobFn& jobfn, const Pre& pre, const Epi& epi) {
    LAS unsigned char* lds = (LAS unsigned char*)lds_;
    const int tid = tid_(), wid = __builtin_amdgcn_readfirstlane(tid >> 6), lane = tid & 63, wr = wid >> 2, wc = wid & 3, fr = lane & 15, fq = lane >> 4;
    LAS unsigned char* a0p = lds + g_lds_byte(wr * 64 + fr, fq * 8); LAS unsigned char* a1p = a0p + 65536;
    LAS unsigned char* b0p = lds + 32768 + g_lds_byte(wc * 32 + fr, fq * 8); LAS unsigned char* b1p = b0p + 65536;
    const unsigned ldsw_u = __builtin_amdgcn_readfirstlane((unsigned)(size_t)(lds + wid * 1024));
#define G8_GLDS(base, voff, ldsaddr) asm volatile("s_mov_b32 m0, %2\n\ts_nop 0\n\tglobal_load_lds_dwordx4 %0, %1" :: "v"(voff), "s"(base), "s"(ldsaddr) : "memory", "m0")
#define G8_DMA(JA, JB, v0, v1, v2, v3, buf, kt) do { \
        const char* pa_ = uni_ptr8(JA) + (kt) * 128; const char* pb_ = uni_ptr8(JB) + (kt) * 128; const unsigned d_ = ldsw_u + (buf) * 65536; \
        G8_GLDS(pa_, (GATHER ? v0 : vb0), d_); \
        G8_GLDS(pa_, (GATHER ? v1 : vb1), d_ + 8192); \
        G8_GLDS(pa_, (GATHER ? v2 : vb2), d_ + 16384); \
        G8_GLDS(pa_, (GATHER ? v3 : vb3), d_ + 24576); \
        G8_GLDS(pb_, vb0, d_ + 32768); \
        G8_GLDS(pb_, vb1, d_ + 32768 + 8192); \
        G8_GLDS(pb_, vb2, d_ + 32768 + 16384); \
        G8_GLDS(pb_, vb3, d_ + 32768 + 24576); } while (0)
#define G8_LD(dst, ptr) do { const u32x4 x0_ = *(const LAS u32x4*)(ptr), x1_ = *(const LAS u32x4*)((ptr) + 1024); \
        dst = (i32x8){(int)x0_.x, (int)x0_.y, (int)x0_.z, (int)x0_.w, (int)x1_.x, (int)x1_.y, (int)x1_.z, (int)x1_.w}; } while (0)
#define G8_LDA(dst, ap, ai, m0, m1) do { _Pragma("unroll") for (int m = m0; m < m1; ++m) G8_LD(dst[m], (ap) + (ai) * 16384 + m * 2048); } while (0)
#define G8_LDB(dst, bp, bj) do { _Pragma("unroll") for (int n = 0; n < 2; ++n) G8_LD(dst[n], (bp) + (bj) * 16384 + n * 2048); } while (0)
#define G8_MMA(ai, bj, At, Bt) do { __builtin_amdgcn_sched_barrier(0); __builtin_amdgcn_s_setprio(1); _Pragma("unroll") for (int m = 0; m < 4; ++m) _Pragma("unroll") for (int n = 0; n < 2; ++n) \
        asm("v_mfma_scale_f32_16x16x128_f8f6f4 %0, %1, %2, %0, %3, %3 op_sel_hi:[0,0,0]" : "+v"(acc[ai][bj][m][n]) : "v"(Bt[n]), "v"(At[m]), "v"(unit_scale)); \
        __builtin_amdgcn_s_setprio(0); __builtin_amdgcn_sched_barrier(0); } while (0)
#define G8_PF 2
#define G8_TILE(buf, ap, bp, apn, bpn, X, Y, kt) do { \
        G8_LDA(P, ap, 0, G8_PF, 4); G8_LDB(Y, bp, 1); G8_MMA(0, 0, P, X); \
        G8_LDA(Q, ap, 1, 0, 2);                       G8_MMA(0, 1, P, Y); \
        G8_LDA(Q, ap, 1, 2, 4);                       G8_MMA(1, 1, Q, Y); \
        asm volatile("" ::: "memory"); __builtin_amdgcn_s_waitcnt(0x0070); __builtin_amdgcn_s_barrier(); asm volatile("" ::: "memory"); \
        asm volatile("" : "+v"(vb0), "+v"(vb1), "+v"(vb2), "+v"(vb3), "+v"(cur.va0), "+v"(cur.va1), "+v"(cur.va2), "+v"(cur.va3)); \
        G8_DMA(selA, selB, cur.va0, cur.va1, cur.va2, cur.va3, buf, kt); \
        G8_LDA(P, apn, 0, 0, G8_PF); G8_LDB(Y, bpn, 0); \
        G8_MMA(1, 0, Q, X); } while (0)
    G8Job cur, nxt;
    cur.A = nullptr; cur.B = nullptr; cur.va0 = cur.va1 = cur.va2 = cur.va3 = 0u; cur.aux = 0; nxt = cur;
    if (!jobfn(0, cur)) return;
    cur.A = uni_ptr8(cur.A); cur.B = uni_ptr8(cur.B);
    unsigned vb0 = vbU[0], vb1 = vbU[1], vb2 = vbU[2], vb3 = vbU[3];
    G8_DMA(cur.A, cur.B, cur.va0, cur.va1, cur.va2, cur.va3, 0, 0); G8_DMA(cur.A, cur.B, cur.va0, cur.va1, cur.va2, cur.va3, 1, 1);
    asm volatile("s_waitcnt vmcnt(0)" ::: "memory");
    __syncthreads();
    int ui = 0;
    for (;;) {
        f32x4 acc[2][2][4][2];
#pragma unroll
        for (int a = 0; a < 2; ++a)
#pragma unroll
            for (int b = 0; b < 2; ++b)
#pragma unroll
                for (int m = 0; m < 4; ++m)
#pragma unroll
                    for (int n = 0; n < 2; ++n) acc[a][b][m][n] = (f32x4){0.f, 0.f, 0.f, 0.f};
        const bool has_next = jobfn(ui + 1, nxt);
        pre(ui, __builtin_amdgcn_readfirstlane(cur.aux));
        nxt.A = uni_ptr8(nxt.A); nxt.B = uni_ptr8(nxt.B);
        if (!has_next) nxt = cur;
        i32x8 P[4], Q[4], X[2], Y[2];
        const int unit_scale = 0x7f7f7f7f;
        G8_LDA(P, a0p, 0, 0, G8_PF); G8_LDB(X, b0p, 0);
#pragma unroll 1
        for (int t2 = 0; t2 < 4; ++t2) {
            const bool lastp = t2 == 3;
            const char* selA = lastp ? nxt.A : cur.A; const char* selB = lastp ? nxt.B : cur.B;
            if (GATHER) { cur.va0 = lastp ? nxt.va0 : cur.va0; cur.va1 = lastp ? nxt.va1 : cur.va1; cur.va2 = lastp ? nxt.va2 : cur.va2; cur.va3 = lastp ? nxt.va3 : cur.va3; }
            const int kt0 = lastp ? 0 : 2 * t2 + 2;
            asm volatile("" : "+v"(a0p), "+v"(a1p), "+v"(b0p), "+v"(b1p));
            G8_TILE(0, a0p, b0p, a1p, b1p, X, Y, kt0);
            G8_TILE(1, a1p, b1p, a0p, b0p, Y, X, kt0 + 1);
        }
        asm volatile("s_nop 15\n\ts_nop 15" ::: "memory");
        epi(acc, ui);
        if (!has_next) break;
        cur.A = nxt.A; cur.B = nxt.B; cur.aux = nxt.aux; ++ui;
    }
#undef G8_TILE
#undef G8_PF
#undef G8_MMA
#undef G8_LDB
#undef G8_LDA
#undef G8_LD
#undef G8_DMA
#undef G8_GLDS
    asm volatile("s_waitcnt vmcnt(0)" ::: "memory");
    __syncthreads();
}
struct RowLin { size_t base; int ld; __device__ __forceinline__ size_t operator()(int R) const { return base + (size_t)R * ld; } };

__device__ __forceinline__ void st_bf4(bf16_t* dst, f32x4 v) {
    uint2 o; o.x = pack2(v[0], v[1]); o.y = pack2(v[2], v[3]); *(uint2*)dst = o;
}
__device__ __forceinline__ int pair_col(int fq) { return 16 * (fq & 1) + 8 * (fq >> 1); }
__device__ __forceinline__ void st_bf4_pair(bf16_t* rowp_c0, int fq, const f32x4& v0, const f32x4& v1) {
    uint32_t ax = pack2(v0[0], v0[1]), ay = pack2(v0[2], v0[3]), bx = pack2(v1[0], v1[1]), by = pack2(v1[2], v1[3]);
    auto r = __builtin_amdgcn_permlane16_swap(ax, bx, false, false); ax = r[0]; bx = r[1];
    r = __builtin_amdgcn_permlane16_swap(ay, by, false, false); ay = r[0]; by = r[1];
    *(u32x4*)(rowp_c0 + pair_col(fq)) = (u32x4){ax, ay, bx, by};
}
#define EPI8(...) do { const int tid_e = tid_(), lane_e = tid_e & 63, wid_e = tid_e >> 6, wr = wid_e >> 2, wc = wid_e & 3, fr = lane_e & 15, fq = lane_e >> 4; \
    _Pragma("unroll") for (int ai = 0; ai < 2; ++ai) _Pragma("unroll") for (int m = 0; m < 4; ++m) _Pragma("unroll") for (int bj = 0; bj < 2; ++bj) _Pragma("unroll") for (int n = 0; n < 2; ++n) { \
        const int row = ai * 128 + wr * 64 + m * 16 + fr, col = bj * 128 + wc * 32 + n * 16 + fq * 4; const f32x4 v = acc[ai][bj][m][n]; __VA_ARGS__ } } while (0)

struct EpiInproj {
    const P* p; int nt;
    __device__ __forceinline__ f32x4 xf(int m, int n, int fq, f32x4 v) const {
        const P& P_ = *p;
        const int pos = m % LP;
        const float* rp = P_.rope() + (size_t)pos * 24;
        if (nt <= 2) {
            const bool isv = (nt == 2) && (n >= 128);
            if (!isv && (n & 48) == 0) {
                f32x4 pr;
#pragma unroll
                for (int j = 0; j < 4; ++j) pr[j] = __shfl_xor(v[j], 32);
                const int i0 = (fq & 1) * 4;
#pragma unroll
                for (int j = 0; j < 4; ++j) {
                    const float c = rp[i0 + j], s = rp[8 + i0 + j];
                    v[j] = fq < 2 ? v[j] * c - pr[j] * s : v[j] * c + pr[j] * s;
                }
            }
            return nt < 2 ? v * (0.125f * 1.4426950408889634f) : v;
        } else if (nt == 3 || nt == 4) {
            const bool ropeable = (nt == 3) ? ((n & 16) == 0) : (n < 16);
            if (ropeable) {
                f32x4 pr;
#pragma unroll
                for (int j = 0; j < 4; ++j) pr[j] = __shfl_xor(v[j], 16);
                if (fq < 2) {
#pragma unroll
                    for (int j = 0; j < 4; ++j) {
                        const float c = rp[16 + j], s = rp[20 + j];
                        v[j] = fq == 0 ? v[j] * c - pr[j] * s : v[j] * c + pr[j] * s;
                    }
                }
            }
            return v;
        } else if (nt <= 6) return v * 0.08838834764831845f;
        else if (nt <= 10) return v;
        f32x4 o;
        if (nt <= 12) {
#pragma unroll
            for (int j = 0; j < 4; ++j) o[j] = v[j] * sigmoidf_(v[j]);
        } else {
#pragma unroll
            for (int j = 0; j < 4; ++j) o[j] = sigmoidf_(v[j]);
        }
        return o;
    }
    __device__ __forceinline__ bf16_t* dst(int m, int c) const {
        const P& P_ = *p;
        if (nt < 2) return P_.q() + (size_t)m * 512 + nt * 256 + c;
        if (nt == 2) return c < 128 ? P_.k() + (size_t)m * 128 + c : P_.v() + (size_t)m * 128 + (c - 128);
        if (nt == 3) return P_.iq() + (size_t)m * 256 + c;
        if (nt <= 6) return P_.hq() + (size_t)m * 512 + (nt - 5) * 256 + c;
        if (nt <= 8) return P_.hf() + (size_t)m * 512 + (nt - 7) * 256 + c;
        if (nt <= 10) return P_.hi() + (size_t)m * 512 + (nt - 9) * 256 + c;
        return P_.hg() + (size_t)m * 512 + (nt - 11) * 256 + c;
    }
    __device__ __forceinline__ void pair(int m, int c0, int fq, const f32x4& a0, const f32x4& a1) const {
        const P& P_ = *p;
        const f32x4 v0 = xf(m, c0 + fq * 4, fq, a0), v1 = xf(m, c0 + 16 + fq * 4, fq, a1);
        if (nt == 4) {
            const int n0 = c0 + fq * 4, n1 = n0 + 16;
            if (n0 < 32) st_bf4(P_.ik() + (size_t)m * 32 + n0, v0); else if (n0 < 40) *(f32x4*)(P_.iw() + (size_t)m * 8 + (n0 - 32)) = v0;
            if (n1 < 32) st_bf4(P_.ik() + (size_t)m * 32 + n1, v1);
        } else if (nt <= 2) {
            const float sc = nt < 2 ? 8.0f : 1.0f;
            uint32_t w0 = pk4_fp8(v0[0] * sc, v0[1] * sc, v0[2] * sc, v0[3] * sc), w1 = pk4_fp8(v1[0] * sc, v1[1] * sc, v1[2] * sc, v1[3] * sc);
            const auto r = __builtin_amdgcn_permlane16_swap(w0, w1, false, false); w0 = r[0]; w1 = r[1];
            unsigned char* g = (nt < 2 ? P_.q8() + (size_t)m * 512 + nt * 256 + c0 : (c0 < 128 ? P_.k8() + (size_t)m * 128 + c0 : P_.v8() + (size_t)m * 128 + (c0 - 128))) + pair_col(fq);
            *(uint2*)g = make_uint2(w0, w1);
        } else if (nt >= 13) {
            uint32_t w0 = (uint32_t)(v0[0] * 255.0f + 0.5f) | ((uint32_t)(v0[1] * 255.0f + 0.5f) << 8) | ((uint32_t)(v0[2] * 255.0f + 0.5f) << 16) | ((uint32_t)(v0[3] * 255.0f + 0.5f) << 24);
            uint32_t w1 = (uint32_t)(v1[0] * 255.0f + 0.5f) | ((uint32_t)(v1[1] * 255.0f + 0.5f) << 8) | ((uint32_t)(v1[2] * 255.0f + 0.5f) << 16) | ((uint32_t)(v1[3] * 255.0f + 0.5f) << 24);
            const auto r = __builtin_amdgcn_permlane16_swap(w0, w1, false, false); w0 = r[0]; w1 = r[1];
            unsigned char* g = (nt <= 16 ? P_.ga() + (size_t)m * 1024 + (nt - 13) * 256 : P_.gh() + (size_t)m * 1024 + (nt - 17) * 256) + c0 + pair_col(fq);
            *(uint2*)g = make_uint2(w0, w1);
        } else st_bf4_pair(dst(m, c0), fq, v0, v1);
    }
};

__device__ __forceinline__ void inproj_epilogue(const P& p, int nt, int mt, f32x4 (&acc)[2][2][4][2], float scale) {
    const EpiInproj e{&p, nt};
    const int tid_e = tid_(), lane_e = tid_e & 63, wid_e = tid_e >> 6, wr = wid_e >> 2, wc = wid_e & 3, fr = lane_e & 15, fq = lane_e >> 4;
#pragma unroll
    for (int ai = 0; ai < 2; ++ai)
#pragma unroll
        for (int m = 0; m < 4; ++m)
#pragma unroll
            for (int bj = 0; bj < 2; ++bj)
                e.pair(mt * 256 + ai * 128 + wr * 64 + m * 16 + fr, bj * 128 + wc * 32, fq, acc[ai][bj][m][0] * scale, acc[ai][bj][m][1] * scale);
}

__device__ __forceinline__ void ph_inproj(const P& p, unsigned char* lds) {
    const int G = gridDim.x, b0 = blockIdx.x;
    {
        const int nunits = (T / 256) * 2;
        auto jobfn = [&](int i, GJob& j) __attribute__((always_inline)) -> bool {
            const int u = b0 + i * G; if (u >= nunits) return false;
            const int nt = 3 + (u & 1), mt = u >> 1;
            j.A = (const char*)(p.xn() + (size_t)mt * 256 * D); j.B = (const char*)(p.winTb() + (size_t)(nt - 3) * 256 * D); return true; };
        auto epi = [&](f32x4 (&acc)[2][2][4][2], int i) __attribute__((always_inline)) {
            const int u = b0 + i * G, nt = 3 + (u & 1), mt = u >> 1;
            inproj_epilogue(p, nt, mt, acc, 1.0f);
        };
        unsigned vbU[2]; gj_lin2(vbU, D);
        gemm_stream<false>(lds, D, D, (size_t)128 * D * 2, vbU, jobfn, epi);
    }
    {
        const int nunits = (T / 256) * 19, br = G - 1 - b0;
        auto jobfn = [&](int i, G8Job& j) __attribute__((always_inline)) -> bool {
            const int u = br + i * G; if (u >= nunits) return false;
            const int n19 = u % 19, nt = n19 < 3 ? n19 : n19 + 2, mt = u / 19;
            j.A = (const char*)(p.xn8() + (size_t)mt * 256 * D); j.B = (const char*)(p.winT8() + (size_t)nt * 256 * D); return true; };
        auto epi = [&](f32x4 (&acc)[2][2][4][2], int i) __attribute__((always_inline)) {
            const int u = br + i * G, n19 = u % 19, nt = n19 < 3 ? n19 : n19 + 2, mt = u / 19;
            inproj_epilogue(p, nt, mt, acc, 0.03125f);
        };
        unsigned vbU[4];
#pragma unroll
        for (int q = 0; q < 4; ++q) { int R, Cb; g8_rc(q, R, Cb); vbU[q] = (unsigned)(R * D + Cb); }
        gemm8_stream<false>(lds, vbU, jobfn, [](int, int) __attribute__((always_inline)) {}, epi);
    }
}
constexpr int NCH = 129, NXU = 16 * NCH;
constexpr int X_QT = 0, X_KT = X_QT + 64 * 272, X_KH = X_KT + 64 * 272, X_VT = X_KH + 128 * 144, X_AS = X_VT + 128 * 144, X_SEG = X_AS + 64 * 144;
__device__ __forceinline__ bf16_t* hg_ds(const P& p) { return (bf16_t*)p.out; }
__device__ __forceinline__ float* hg_g(const P& p) { return (float*)((unsigned char*)p.out + (size_t)NXU * 32768); }

__device__ __forceinline__ void hgx_unit(const P& p, unsigned char* lds, int u) {
    const int tid = tid_(), lane = tid & 63, wid = tid >> 6, fr = lane & 15, fq = lane >> 4;
    const int c = u % NCH, bh = u / NCH, b = bh >> 2, h = bh & 3;
    const int d = tid & 127, seg = tid >> 7;
    const size_t rowbase = (size_t)(b * LP + c * 64 + seg * 16) * 512 + h * 128 + d;
    bf16_t* hqp = p.hq() + rowbase; const bf16_t* hfp = p.hf() + rowbase; const bf16_t* hip = p.hi() + rowbase;
    const float lbv = p.lb()[h * 128 + d];
    float bb[16], qv[16], kk[16], vv[16];
    float cs = 0.f;
#pragma unroll
    for (int i = 0; i < 16; ++i) {
        const float f = lbv + (1.0f - lbv) * sigmoidf_(bf2f(hfp[(size_t)i * 512]));
        kk[i] = 1.0f - f; cs += __logf(f); bb[i] = cs;
        qv[i] = bf2f(hqp[(size_t)i * 512]); vv[i] = bf2f(hip[(size_t)i * 512]);
    }
    float* segs = (float*)(lds + X_SEG);
    segs[seg * 128 + d] = cs;
    __syncthreads();
    const float s0 = segs[d], s1 = segs[128 + d], s2 = segs[256 + d], s3 = segs[384 + d];
    const float off = seg == 0 ? 0.f : (seg == 1 ? s0 : (seg == 2 ? s0 + s1 : s0 + s1 + s2));
    const float rref = s0 + s1, blast = (s0 + s1) + (s2 + s3);
    uint32_t khp[8], vtp[8];
#pragma unroll
    for (int i = 0; i < 16; i += 2) {
        float khv[2];
#pragma unroll
        for (int j = 0; j < 2; ++j) {
            const float bt = bb[i + j] + off;
            const float eq = __expf(fminf(bt - rref, 80.f)), ek = __expf(fminf(rref - bt, 80.f));
            const int t = seg * 16 + i + j;
            *(bf16_t*)(lds + X_QT + t * 272 + d * 2) = f2bf(qv[i + j] * eq);
            *(bf16_t*)(lds + X_KT + t * 272 + d * 2) = f2bf(kk[i + j] * ek);
            hqp[(size_t)(i + j) * 512] = f2bf(qv[i + j] * __expf(bt));
            khv[j] = kk[i + j] * __expf(blast - bt);
        }
        khp[i >> 1] = pack2(khv[0], khv[1]); vtp[i >> 1] = pack2(vv[i], vv[i + 1]);
    }
    *(uint4*)(lds + X_KH + d * 144 + seg * 32) = make_uint4(khp[0], khp[1], khp[2], khp[3]);
    *(uint4*)(lds + X_KH + d * 144 + seg * 32 + 16) = make_uint4(khp[4], khp[5], khp[6], khp[7]);
    *(uint4*)(lds + X_VT + d * 144 + seg * 32) = make_uint4(vtp[0], vtp[1], vtp[2], vtp[3]);
    *(uint4*)(lds + X_VT + d * 144 + seg * 32 + 16) = make_uint4(vtp[4], vtp[5], vtp[6], vtp[7]);
    if (seg == 0) hg_g(p)[(size_t)u * 128 + d] = __expf(blast);
    __syncthreads();
    {
        const int tm = wid >> 1, tn0 = (wid & 1) * 2;
        f32x4 a1[2] = {(f32x4){0.f, 0.f, 0.f, 0.f}, (f32x4){0.f, 0.f, 0.f, 0.f}};
#pragma unroll
        for (int ks = 0; ks < 4; ++ks) {
            const bf16x8 aq = *(const bf16x8*)(lds + X_QT + (tm * 16 + fr) * 272 + (ks * 32 + fq * 8) * 2);
#pragma unroll
            for (int j = 0; j < 2; ++j) {
                const bf16x8 bk = *(const bf16x8*)(lds + X_KT + ((tn0 + j) * 16 + fr) * 272 + (ks * 32 + fq * 8) * 2);
                a1[j] = __builtin_amdgcn_mfma_f32_16x16x32_bf16(bk, aq, a1[j], 0, 0, 0);
            }
        }
#pragma unroll
        for (int j = 0; j < 2; ++j) {
            const int t = tm * 16 + fr, sb = (tn0 + j) * 16 + fq * 4;
            f32x4 v = a1[j];
#pragma unroll
            for (int jj = 0; jj < 4; ++jj) v[jj] = (sb + jj <= t) ? v[jj] : 0.f;
            uint2 o; o.x = pack2(v[0], v[1]); o.y = pack2(v[2], v[3]);
            *(uint2*)(lds + X_AS + t * 144 + sb * 2) = o;
        }
    }
    __syncthreads();
    {
        const int tm = wid >> 1, en0 = (wid & 1) * 4;
        f32x4 o2[4];
#pragma unroll
        for (int j = 0; j < 4; ++j) o2[j] = (f32x4){0.f, 0.f, 0.f, 0.f};
#pragma unroll
        for (int ks = 0; ks < 2; ++ks) {
            const bf16x8 aa = *(const bf16x8*)(lds + X_AS + (tm * 16 + fr) * 144 + (ks * 32 + fq * 8) * 2);
#pragma unroll
            for (int j = 0; j < 4; ++j) {
                const bf16x8 bv = *(const bf16x8*)(lds + X_VT + ((en0 + j) * 16 + fr) * 144 + (ks * 32 + fq * 8) * 2);
                o2[j] = __builtin_amdgcn_mfma_f32_16x16x32_bf16(bv, aa, o2[j], 0, 0, 0);
            }
        }
        bf16_t* orow = p.hf() + (size_t)(b * LP + c * 64 + tm * 16 + fr) * 512 + h * 128;
#pragma unroll
        for (int j = 0; j < 4; ++j) st_bf4(orow + (en0 + j) * 16 + fq * 4, o2[j]);
    }
    {
        f32x4 s3[8];
#pragma unroll
        for (int j = 0; j < 8; ++j) s3[j] = (f32x4){0.f, 0.f, 0.f, 0.f};
#pragma unroll
        for (int ks = 0; ks < 2; ++ks) {
            const bf16x8 ak = *(const bf16x8*)(lds + X_KH + (wid * 16 + fr) * 144 + (ks * 32 + fq * 8) * 2);
#pragma unroll
            for (int j = 0; j < 8; ++j) {
                const bf16x8 bv = *(const bf16x8*)(lds + X_VT + (j * 16 + fr) * 144 + (ks * 32 + fq * 8) * 2);
                s3[j] = __builtin_amdgcn_mfma_f32_16x16x32_bf16(ak, bv, s3[j], 0, 0, 0);
            }
        }
        bf16_t* dsb = hg_ds(p) + (size_t)u * 16384;
#pragma unroll
        for (int j = 0; j < 8; ++j) st_bf4(dsb + (size_t)(j * 16 + fr) * 128 + wid * 16 + fq * 4, s3[j]);
    }
    __syncthreads();
}

__device__ __forceinline__ void hgchain_unit(const P& p, int item) {
    const int tid = tid_(), bh = item >> 2, eq = item & 3;
    const int e = eq * 32 + (tid >> 4), d0 = (tid & 15) * 8;
    float S[8];
#pragma unroll
    for (int i = 0; i < 8; ++i) S[i] = 0.f;
    uint4* ptr = (uint4*)(hg_ds(p) + ((size_t)(bh * NCH) * 128 + e) * 128 + d0);
    const f32x4* gp = (const f32x4*)(hg_g(p) + (size_t)(bh * NCH) * 128 + d0);
    uint4 wq[8]; f32x4 g0[8], g1[8];
#pragma unroll
    for (int k = 0; k < 8; ++k) { wq[k] = ptr[(size_t)k * 2048]; g0[k] = gp[k * 32]; g1[k] = gp[k * 32 + 1]; }
    for (int c0 = 0; c0 < NCH; c0 += 8) {
#pragma unroll
        for (int k = 0; k < 8; ++k) {
            const int c = c0 + k;
            if (c < NCH) {
                const uint4 w = wq[k]; const f32x4 ga = g0[k], gb = g1[k];
                if (c + 8 < NCH) { wq[k] = ptr[(size_t)(c + 8) * 2048]; g0[k] = gp[(c + 8) * 32]; g1[k] = gp[(c + 8) * 32 + 1]; }
                ptr[(size_t)c * 2048] = make_uint4(pack2(S[0], S[1]), pack2(S[2], S[3]), pack2(S[4], S[5]), pack2(S[6], S[7]));
                S[0] = ga[0] * S[0] + __uint_as_float(w.x << 16); S[1] = ga[1] * S[1] + __uint_as_float(w.x & 0xffff0000u);
                S[2] = ga[2] * S[2] + __uint_as_float(w.y << 16); S[3] = ga[3] * S[3] + __uint_as_float(w.y & 0xffff0000u);
                S[4] = gb[0] * S[4] + __uint_as_float(w.z << 16); S[5] = gb[1] * S[5] + __uint_as_float(w.z & 0xffff0000u);
                S[6] = gb[2] * S[6] + __uint_as_float(w.w << 16); S[7] = gb[3] * S[7] + __uint_as_float(w.w & 0xffff0000u);
            }
        }
    }
}

__device__ __forceinline__ void hgz_unit(const P& p, unsigned char* lds, int u) {
    const int tid = tid_(), lane = tid & 63, wid = tid >> 6, fr = lane & 15, fq = lane >> 4;
    const int c = u % NCH, bh = u / NCH, b = bh >> 2, h = bh & 3;
    const int tm = wid >> 1, en0 = (wid & 1) * 4;
    const size_t row = (size_t)(b * LP + c * 64 + tm * 16 + fr);
    const bf16_t* qrow = p.hq() + row * 512 + h * 128;
    const bf16_t* sT = hg_ds(p) + (size_t)u * 16384;
    f32x4 o[4];
#pragma unroll
    for (int j = 0; j < 4; ++j) o[j] = (f32x4){0.f, 0.f, 0.f, 0.f};
#pragma unroll
    for (int ks = 0; ks < 4; ++ks) {
        const bf16x8 aq = *(const bf16x8*)(qrow + ks * 32 + fq * 8);
#pragma unroll
        for (int j = 0; j < 4; ++j) {
            const bf16x8 bs = *(const bf16x8*)(sT + (size_t)((en0 + j) * 16 + fr) * 128 + ks * 32 + fq * 8);
            o[j] = __builtin_amdgcn_mfma_f32_16x16x32_bf16(bs, aq, o[j], 0, 0, 0);
        }
    }
    const bf16_t* oi = p.hf() + row * 512 + h * 128;
    float ss = 0.f;
#pragma unroll
    for (int j = 0; j < 4; ++j) {
        const uint2 w = *(const uint2*)(oi + (en0 + j) * 16 + fq * 4);
        o[j][0] += __uint_as_float(w.x << 16); o[j][1] += __uint_as_float(w.x & 0xffff0000u);
        o[j][2] += __uint_as_float(w.y << 16); o[j][3] += __uint_as_float(w.y & 0xffff0000u);
        ss += o[j][0] * o[j][0] + o[j][1] * o[j][1] + o[j][2] * o[j][2] + o[j][3] * o[j][3];
    }
    ss = xsum32(xsum16(ss));
    const bf16_t* hgp = p.hg() + row * 512 + h * 128;
    bf16_t* outp = p.hgr() + row * 512 + h * 128;
    f32x4 gnv[4]; uint2 hgv[4];
#pragma unroll
    for (int j = 0; j < 4; ++j) { const int e0 = (en0 + j) * 16 + fq * 4; gnv[j] = *(const f32x4*)(p.hgrn_g + h * 128 + e0); hgv[j] = *(const uint2*)(hgp + e0); }
    float* part = (float*)lds;
    if (fq == 0) part[(tm * 16 + fr) * 2 + (wid & 1)] = ss;
    __syncthreads();
    const float tot = part[(tm * 16 + fr) * 2] + part[(tm * 16 + fr) * 2 + 1];
    const float rs = rsqrtf(tot * (1.0f / 128.0f) + EPS);
#pragma unroll
    for (int j = 0; j < 4; ++j) {
        const int e0 = (en0 + j) * 16 + fq * 4;
        const f32x4 gn = gnv[j];
        const uint2 w = hgv[j];
        f32x4 r;
        r[0] = o[j][0] * rs * gn[0] * __uint_as_float(w.x << 16); r[1] = o[j][1] * rs * gn[1] * __uint_as_float(w.x & 0xffff0000u);
        r[2] = o[j][2] * rs * gn[2] * __uint_as_float(w.y << 16); r[3] = o[j][3] * rs * gn[3] * __uint_as_float(w.y & 0xffff0000u);
        st_bf4(outp + e0, r);
    }
    __syncthreads();
}

typedef float f32x16 __attribute__((ext_vector_type(16)));
typedef short s16x4 __attribute__((ext_vector_type(4)));

constexpr int NKMAX = 8224;
constexpr int NBIN = 1024;
constexpr int A_SC = 0, A_H1 = A_SC + 4 * NKMAX * 4, A_SEL = A_H1 + 4 * NBIN * 4, A_CAND = A_SEL + 2048, A_META = A_CAND + 1024, A_END = A_META + 256;
static_assert(A_END <= LDS_BYTES - 16, "attention LDS");
__device__ __forceinline__ uint32_t skey(float f) { const uint32_t u = __float_as_uint(f); return (u & 0x80000000u) ? ~u : (u | 0x80000000u); }
__device__ __forceinline__ float skey_inv(uint32_t k) { return __uint_as_float((k & 0x80000000u) ? (k & 0x7fffffffu) : ~k); }
__device__ __forceinline__ int bin1(float s, float lo, float scale) { return min(NBIN - 1, max(0, (int)((s - lo) * scale))); }
template <int OFF> __device__ __forceinline__ s16x4 tr_read(unsigned addr) {
    s16x4 r; asm volatile("ds_read_b64_tr_b16 %0, %1 offset:%2" : "=&v"(r) : "v"(addr), "i"(OFF) : "memory"); return r;
}
__device__ __forceinline__ void scan_top(const int* hist, int K, int* m, int lane) {
    int c[16];
#pragma unroll
    for (int i = 0; i < 4; ++i) { const int4 v = *(const int4*)(hist + 16 * lane + 4 * i); c[4 * i] = v.x; c[4 * i + 1] = v.y; c[4 * i + 2] = v.z; c[4 * i + 3] = v.w; }
    int tot = 0;
#pragma unroll
    for (int i = 0; i < 16; ++i) tot += c[i];
    int suf = tot;
#pragma unroll
    for (int o = 1; o < 64; o <<= 1) { const int t = __shfl_down(suf, o); if (lane + o < 64) suf += t; }
    int above = suf - tot;
#pragma unroll
    for (int i = 15; i >= 0; --i) {
        if (above < K && K <= above + c[i]) { m[0] = 16 * lane + i; m[1] = above; m[2] = c[i]; }
        above += c[i];
    }
}

__device__ __forceinline__ void attn4_unit(const P& p, unsigned char* lds, int b, int grp) {
    const int tid = tid_(), lane = tid & 63, wid = __builtin_amdgcn_readfirstlane(tid >> 6);
    const int t0 = NMETA + 4 * grp;
    const int brow = b * LP, row0 = brow + t0;
    float* sc = (float*)(lds + A_SC);
    int* h1 = (int*)(lds + A_H1);
    unsigned short* sel = (unsigned short*)(lds + A_SEL); unsigned short* cand = (unsigned short*)(lds + A_CAND);
    int* meta = (int*)(lds + A_META);
    const bool big = t0 + 1 > 256;
    for (int i = tid; i < 4 * NBIN; i += NTHREADS) h1[i] = 0;
    if (tid < 64) { const int w = tid & 15; meta[tid] = (w == 0) ? -1 : 0; }
    if (!big) { for (int i = tid; i < 1024; i += NTHREADS) { const int q = i >> 8, j = i & 255; sel[i] = (unsigned short)(j <= t0 + q ? j : 0); } }
    __syncthreads();
    if (big) {
        {
            const int hh = lane >> 5, c32 = lane & 31;
            const int g = c32 >> 3, h2a = (c32 >> 2) & 1, bq = c32 & 3, aq = 2 * h2a + (g >> 1), ah = 4 * (g & 1) + bq;
            const bf16_t* ap = p.iq() + (size_t)(row0 + aq) * 256 + ah * 32 + 8 * hh;
            const bf16x8 a0 = *(const bf16x8*)ap, a1 = *(const bf16x8*)(ap + 16);
            const f32x4 w00 = *(const f32x4*)(p.iw() + (size_t)(row0 + 2 * hh) * 8), w01 = *(const f32x4*)(p.iw() + (size_t)(row0 + 2 * hh) * 8 + 4);
            const f32x4 w10 = *(const f32x4*)(p.iw() + (size_t)(row0 + 2 * hh + 1) * 8), w11 = *(const f32x4*)(p.iw() + (size_t)(row0 + 2 * hh + 1) * 8 + 4);
            const int ntiles = (t0 + 4 + 31) >> 5;
            const int tq0 = t0 + 2 * hh;
            float mx0 = -INFINITY, mn0 = INFINITY, mx1 = -INFINITY, mn1 = INFINITY;
            const bf16_t* kbase = p.ik() + (size_t)brow * 32 + 8 * hh;
            for (int tile0 = wid; tile0 < ntiles; tile0 += 128) {
                bf16x8 b0[16], b1[16];
#pragma unroll
                for (int j = 0; j < 16; ++j) {
                    const int tile = min(tile0 + 8 * j, ntiles - 1);
                    const bf16_t* kp = kbase + (size_t)(tile * 32 + c32) * 32;
                    b0[j] = *(const bf16x8*)kp; b1[j] = *(const bf16x8*)(kp + 16);
                }
                __builtin_amdgcn_sched_barrier(0);
#pragma unroll
                for (int j = 0; j < 16; ++j) {
                    const int tile = tile0 + 8 * j;
                    if (tile < ntiles) {
                        const int key = tile * 32 + c32;
                        f32x16 acc;
#pragma unroll
                        for (int i = 0; i < 16; ++i) acc[i] = 0.f;
                        acc = __builtin_amdgcn_mfma_f32_32x32x16_bf16(a0, b0[j], acc, 0, 0, 0);
                        acc = __builtin_amdgcn_mfma_f32_32x32x16_bf16(a1, b1[j], acc, 0, 0, 0);
                        float s0 = 0.f, s1 = 0.f;
#pragma unroll
                        for (int i = 0; i < 4; ++i) {
                            s0 += w00[i] * fmaxf(acc[i], 0.f) + w01[i] * fmaxf(acc[4 + i], 0.f);
                            s1 += w10[i] * fmaxf(acc[8 + i], 0.f) + w11[i] * fmaxf(acc[12 + i], 0.f);
                        }
                        sc[(2 * hh) * NKMAX + key] = s0; sc[(2 * hh + 1) * NKMAX + key] = s1;
                        if (key <= tq0) { mx0 = fmaxf(mx0, s0); mn0 = fminf(mn0, s0); }
                        if (key <= tq0 + 1) { mx1 = fmaxf(mx1, s1); mn1 = fminf(mn1, s1); }
                    }
                }
            }
#pragma unroll
            for (int o = 16; o >= 1; o >>= 1) {
                mx0 = fmaxf(mx0, __shfl_xor(mx0, o)); mn0 = fminf(mn0, __shfl_xor(mn0, o));
                mx1 = fmaxf(mx1, __shfl_xor(mx1, o)); mn1 = fminf(mn1, __shfl_xor(mn1, o));
            }
            if (c32 == 0) {
                if (mx0 >= mn0) { atomicMin((unsigned*)&meta[(2 * hh) * 16 + 0], skey(mn0)); atomicMax((unsigned*)&meta[(2 * hh) * 16 + 1], skey(mx0)); }
                if (mx1 >= mn1) { atomicMin((unsigned*)&meta[(2 * hh + 1) * 16 + 0], skey(mn1)); atomicMax((unsigned*)&meta[(2 * hh + 1) * 16 + 1], skey(mx1)); }
            }
        }
        __syncthreads();
        const int q = wid & 3, part = wid >> 2, n = t0 + q + 1;
        const float lo = skey_inv((unsigned)meta[q * 16 + 0]), hi = skey_inv((unsigned)meta[q * 16 + 1]);
        const float scale = hi > lo ? (float)NBIN / (hi - lo) : 0.f;
        const float* scq = sc + q * NKMAX;
        for (int base = part * 256; base < n; base += 512) {
            const int idx0 = base + lane * 4;
            if (idx0 < n) {
                const f32x4 v = *(const f32x4*)(scq + idx0);
#pragma unroll
                for (int j = 0; j < 4; ++j) if (idx0 + j < n) atomicAdd(&h1[q * NBIN + bin1(v[j], lo, scale)], 1);
            }
        }
        __syncthreads();
        if (wid < 4) scan_top(h1 + wid * NBIN, 256, meta + wid * 16 + 4, lane);
        __syncthreads();
        const int B1 = meta[q * 16 + 4];
        for (int base = part * 256; base < n; base += 512) {
            const int idx0 = base + lane * 4;
            f32x4 v = (f32x4){0.f, 0.f, 0.f, 0.f};
            if (idx0 < n) v = *(const f32x4*)(scq + idx0);
            const unsigned long long lt = (1ull << lane) - 1ull;
#pragma unroll
            for (int j = 0; j < 4; ++j) {
                const int idx = idx0 + j;
                bool issel = false, iscand = false;
                if (idx < n) { const int b1 = bin1(v[j], lo, scale); issel = b1 > B1; iscand = b1 == B1; }
                const unsigned long long ms = __ballot(issel), mc = __ballot(iscand);
                if (ms) {
                    int bs = 0; if (lane == 0) bs = atomicAdd(&meta[q * 16 + 2], __popcll(ms));
                    bs = __shfl(bs, 0);
                    if (issel) sel[q * 256 + bs + __popcll(ms & lt)] = (unsigned short)idx;
                }
                if (mc) {
                    int bs = 0; if (lane == 0) bs = atomicAdd(&meta[q * 16 + 3], __popcll(mc));
                    bs = __shfl(bs, 0);
                    const int pos = bs + __popcll(mc & lt);
                    if (iscand && pos < 128) cand[q * 128 + pos] = (unsigned short)idx;
                }
            }
        }
        __syncthreads();
        if (wid < 4) {
            const int qq = wid; const float* scr = sc + qq * NKMAX;
            const int rq = 256 - meta[qq * 16 + 5], cq = meta[qq * 16 + 6], sbase = 256 - rq, nn = t0 + qq + 1;
            if (cq <= 128) {
                int taken = 0;
#pragma unroll
                for (int half = 0; half < 2; ++half) {
                    const int i = lane + 64 * half;
                    bool take = false; int myidx = 0;
                    if (i < cq) {
                        myidx = cand[qq * 128 + i]; const float mv = scr[myidx];
                        int rank = 0;
                        for (int j = 0; j < cq; ++j) { const int oj = cand[qq * 128 + j]; const float ov = scr[oj]; rank += (ov > mv) || (ov == mv && oj < myidx); }
                        take = rank < rq;
                    }
                    const unsigned long long mt = __ballot(take);
                    if (take) sel[qq * 256 + sbase + taken + __popcll(mt & ((1ull << lane) - 1ull))] = (unsigned short)myidx;
                    taken += __popcll(mt);
                }
            } else {
                const float lo_ = skey_inv((unsigned)meta[qq * 16 + 0]), hi_ = skey_inv((unsigned)meta[qq * 16 + 1]);
                const float sc_ = hi_ > lo_ ? (float)NBIN / (hi_ - lo_) : 0.f;
                const int B1_ = meta[qq * 16 + 4];
                int taken = 0;
                for (int base = 0; base < nn && taken < rq; base += 64) {
                    const int idx = base + lane; bool isc = false;
                    if (idx < nn) isc = bin1(scr[idx], lo_, sc_) == B1_;
                    const unsigned long long mc = __ballot(isc);
                    const int pos = taken + __popcll(mc & ((1ull << lane) - 1ull));
                    if (isc && pos < rq) sel[qq * 256 + sbase + pos] = (unsigned short)idx;
                    taken += __popcll(mc);
                }
            }
        }
        __syncthreads();
    }
    {
        const int q = wid >> 1, kvh = wid & 1, tq = t0 + q, nsel = min(tq + 1, 256);
        const int col = lane & 15, g4 = lane >> 4;
        const unsigned short* selq = sel + q * 256;
        bf16x8 qf0, qf1;
        {
            const bf16_t* qp = p.q() + (size_t)(row0 + q) * 512 + (kvh * 4 + (col & 3)) * 64 + g4 * 8;
            qf0 = *(const bf16x8*)qp; qf1 = *(const bf16x8*)(qp + 32);
            if (col >= 4) {
#pragma unroll
                for (int i = 0; i < 8; ++i) { qf0[i] = 0; qf1[i] = 0; }
            }
        }
        LAS unsigned char* vst = (LAS unsigned char*)lds + A_SC + wid * 16384;
        const bf16_t* vb = p.v() + (size_t)brow * 128 + kvh * 64 + (lane & 7) * 8;
        const unsigned rdbase = (unsigned)(uintptr_t)((LAS unsigned char*)lds + A_SC) + wid * 16384 + (4 * g4 + (col >> 2)) * 128 + (col & 3) * 8;
#define V_STAGE(s_, buf_) do { _Pragma("unroll") for (int i_ = 0; i_ < 4; ++i_) { \
            const int ksl_ = (s_) * 32 + i_ * 8 + (lane >> 3); const int key_ = selq[ksl_]; \
            __builtin_amdgcn_global_load_lds((const unsigned*)(vb + (size_t)key_ * 128), (LAS unsigned*)(vst + (buf_) * 4096 + i_ * 1024), 16, 0, 0); } } while (0)
        const bf16_t* kb = p.k() + (size_t)brow * 128 + kvh * 64 + g4 * 8;
        f32x4 lg[16];
        u32x4 vr[16];
        {
            bf16x8 k0[16], k1[16];
#pragma unroll
            for (int t = 0; t < 16; ++t) {
                const int key = selq[t * 16 + col];
                const bf16_t* kp = kb + (size_t)key * 128;
                k0[t] = *(const bf16x8*)kp; k1[t] = *(const bf16x8*)(kp + 32);
            }
#pragma unroll
            for (int s = 4; s < 8; ++s)
#pragma unroll
                for (int i = 0; i < 4; ++i) { const int key = selq[s * 32 + i * 8 + (lane >> 3)]; vr[(s - 4) * 4 + i] = *(const u32x4*)(vb + (size_t)key * 128); }
            V_STAGE(0, 0); V_STAGE(1, 1); V_STAGE(2, 2); V_STAGE(3, 3);
            __builtin_amdgcn_sched_barrier(0);
#pragma unroll
            for (int t = 0; t < 16; ++t) {
                f32x4 a = (f32x4){0.f, 0.f, 0.f, 0.f};
                a = __builtin_amdgcn_mfma_f32_16x16x32_bf16(k0[t], qf0, a, 0, 0, 0);
                a = __builtin_amdgcn_mfma_f32_16x16x32_bf16(k1[t], qf1, a, 0, 0, 0);
                lg[t] = a;
            }
            __builtin_amdgcn_sched_barrier(0);
        }
        float mx = -INFINITY;
#pragma unroll
        for (int t = 0; t < 16; ++t)
#pragma unroll
            for (int j = 0; j < 4; ++j) { if (t * 16 + g4 * 4 + j >= nsel) lg[t][j] = -INFINITY; mx = fmaxf(mx, lg[t][j]); }
        mx = fmaxf(mx, __shfl_xor(mx, 16)); mx = fmaxf(mx, __shfl_xor(mx, 32));
        float sm = 0.f;
#pragma unroll
        for (int t = 0; t < 16; ++t)
#pragma unroll
            for (int j = 0; j < 4; ++j) { const float e = __builtin_amdgcn_exp2f(lg[t][j] - mx); lg[t][j] = e; sm += e; }
        sm += __shfl_xor(sm, 16); sm += __shfl_xor(sm, 32);
        const float inv = 1.0f / sm;
        f32x4 o[4];
#pragma unroll
        for (int d = 0; d < 4; ++d) o[d] = (f32x4){0.f, 0.f, 0.f, 0.f};
        asm volatile("s_waitcnt vmcnt(0)" ::: "memory");
#pragma unroll
        for (int s = 0; s < 8; ++s) {
            if (s >= 4) {
#pragma unroll
                for (int i = 0; i < 4; ++i) *(LAS u32x4*)(vst + (s & 3) * 4096 + i * 1024 + lane * 16) = vr[(s - 4) * 4 + i];
                asm volatile("s_waitcnt lgkmcnt(0)" ::: "memory");
            }
            const unsigned rb = rdbase + (s & 3) * 4096;
            const s16x4 l0 = tr_read<0>(rb), h0 = tr_read<2048>(rb), l1 = tr_read<32>(rb), h1_ = tr_read<2048 + 32>(rb);
            const s16x4 l2 = tr_read<64>(rb), h2_ = tr_read<2048 + 64>(rb), l3 = tr_read<96>(rb), h3 = tr_read<2048 + 96>(rb);
            asm volatile("s_waitcnt lgkmcnt(0)" ::: "memory");
            __builtin_amdgcn_sched_barrier(0);
            bf16x8 pa;
            {
                const uint32_t w0 = pack2(lg[2 * s][0], lg[2 * s][1]), w1 = pack2(lg[2 * s][2], lg[2 * s][3]);
                const uint32_t w2 = pack2(lg[2 * s + 1][0], lg[2 * s + 1][1]), w3 = pack2(lg[2 * s + 1][2], lg[2 * s + 1][3]);
                pa[0] = (short)(w0 & 0xffff); pa[1] = (short)(w0 >> 16); pa[2] = (short)(w1 & 0xffff); pa[3] = (short)(w1 >> 16);
                pa[4] = (short)(w2 & 0xffff); pa[5] = (short)(w2 >> 16); pa[6] = (short)(w3 & 0xffff); pa[7] = (short)(w3 >> 16);
            }
#define PKV(L, H) (bf16x8){L[0], L[1], L[2], L[3], H[0], H[1], H[2], H[3]}
            o[0] = __builtin_amdgcn_mfma_f32_16x16x32_bf16(pa, PKV(l0, h0), o[0], 0, 0, 0);
            o[1] = __builtin_amdgcn_mfma_f32_16x16x32_bf16(pa, PKV(l1, h1_), o[1], 0, 0, 0);
            o[2] = __builtin_amdgcn_mfma_f32_16x16x32_bf16(pa, PKV(l2, h2_), o[2], 0, 0, 0);
            o[3] = __builtin_amdgcn_mfma_f32_16x16x32_bf16(pa, PKV(l3, h3), o[3], 0, 0, 0);
#undef PKV
        }
#undef V_STAGE
        const float i0 = __shfl(inv, 0), i1 = __shfl(inv, 1), i2 = __shfl(inv, 2), i3 = __shfl(inv, 3);
        if (g4 == 0) {
            bf16_t* op = p.att() + (size_t)(row0 + q) * 512 + kvh * 256 + col;
#pragma unroll
            for (int d = 0; d < 4; ++d) {
                op[0 * 64 + d * 16] = f2bf(o[d][0] * i0); op[1 * 64 + d * 16] = f2bf(o[d][1] * i1);
                op[2 * 64 + d * 16] = f2bf(o[d][2] * i2); op[3 * 64 + d * 16] = f2bf(o[d][3] * i3);
            }
        }
    }
    __syncthreads();
}

constexpr int NBW = 512;
constexpr int W_SC = 0, W_H = W_SC + NKMAX * 2, W_SEL = W_H + NBW * 4, W_CAND = W_SEL + 512, W_SZ = W_CAND + 256;
static_assert(8 * W_SZ <= LDS_BYTES - 32, "wave attention LDS");
__device__ __forceinline__ int binw(float s, float lo, float scale) { return min(NBW - 1, max(0, (int)((s - lo) * scale))); }

__device__ __forceinline__ void attn_wave(const P& p, unsigned char* lds, int wid, int lane, int b, int t) {
    unsigned char* wl = lds + wid * W_SZ;
    _Float16* sc = (_Float16*)(wl + W_SC);
    int* hist = (int*)(wl + W_H);
    unsigned short* sel = (unsigned short*)(wl + W_SEL);
    unsigned short* cand = (unsigned short*)(wl + W_CAND);
    const int brow = b * LP, row = brow + t, n = t + 1;
    const int col = lane & 15, g4 = lane >> 4;
    const unsigned long long lt = (1ull << lane) - 1ull;
    int nsel = 256;
    if (n > 256) {
        float mn, mx;
        {
            typedef _Float16 h2 __attribute__((ext_vector_type(2)));
            h2 hmx = {(_Float16)-65504.f, (_Float16)-65504.f}, hmn = {(_Float16)65504.f, (_Float16)65504.f};
            for (int base = 0; base < n; base += 256) {
                const int ia = base + lane * 4;
                if (ia + 3 < n) {
                    const uint2 ra = *(const uint2*)(sc + ia);
                    const h2 x0 = __builtin_bit_cast(h2, ra.x), x1 = __builtin_bit_cast(h2, ra.y);
                    hmx = __builtin_elementwise_max(hmx, __builtin_elementwise_max(x0, x1)); hmn = __builtin_elementwise_min(hmn, __builtin_elementwise_min(x0, x1));
                } else {
                    for (int j = 0; j < 3; ++j) if (ia + j < n) { const _Float16 x = sc[ia + j]; hmx[0] = x > hmx[0] ? x : hmx[0]; hmn[0] = x < hmn[0] ? x : hmn[0]; }
                }
            }
            float a = fmaxf((float)hmx[0], (float)hmx[1]), c = fminf((float)hmn[0], (float)hmn[1]);
            a = xmax32(xmax16(a)); c = fminf(c, lane_xor_f<32>(c)); c = xmin16(c);
            a = fmaxf(a, lane_xor_f<8>(a)); c = fminf(c, lane_xor_f<8>(c)); a = fmaxf(a, lane_xor_f<4>(a)); c = fminf(c, lane_xor_f<4>(c));
            a = fmaxf(a, lane_xor_f<2>(a)); c = fminf(c, lane_xor_f<2>(c)); a = fmaxf(a, lane_xor_f<1>(a)); c = fminf(c, lane_xor_f<1>(c));
            mx = a; mn = c;
        }
        const float scale = mx > mn ? (float)NBW / (mx - mn) : 0.f, nls = -mn * scale;
#define BINF(x) min(NBW - 1, max(0, (int)__builtin_fmaf((x), scale, nls)))
#define H2F(u16) ((float)__builtin_bit_cast(_Float16, (unsigned short)(u16)))
        for (int base = 0; base < n; base += 512) {
            const int ia = base + lane * 4, ib = ia + 256;
            uint2 ra = make_uint2(0u, 0u), rb2 = make_uint2(0u, 0u);
            if (ia < n) ra = *(const uint2*)(sc + ia);
            if (ib < n) rb2 = *(const uint2*)(sc + ib);
            const unsigned wa[4] = {ra.x & 0xffffu, ra.x >> 16, ra.y & 0xffffu, ra.y >> 16}, wb[4] = {rb2.x & 0xffffu, rb2.x >> 16, rb2.y & 0xffffu, rb2.y >> 16};
#pragma unroll
            for (int j = 0; j < 4; ++j) {
                if (ia + j < n) atomicAdd(&hist[BINF(H2F(wa[j]))], 1);
                if (ib + j < n) atomicAdd(&hist[BINF(H2F(wb[j]))], 1);
            }
        }
        int B1, above1, cnt1;
        {
            int c[8];
            const int4 v0 = *(const int4*)(hist + 8 * lane), v1 = *(const int4*)(hist + 8 * lane + 4);
            c[0] = v0.x; c[1] = v0.y; c[2] = v0.z; c[3] = v0.w; c[4] = v1.x; c[5] = v1.y; c[6] = v1.z; c[7] = v1.w;
            int tot = 0;
#pragma unroll
            for (int i = 0; i < 8; ++i) tot += c[i];
            const int pre = wave_incl_scan(tot);
            int above = __builtin_amdgcn_readlane(pre, 63) - pre;
            const bool mine = above < 256 && 256 <= above + tot;
            int bb = 0, ab = 0, cb = 0;
#pragma unroll
            for (int i = 7; i >= 0; --i) { if (above < 256 && 256 <= above + c[i]) { bb = 8 * lane + i; ab = above; cb = c[i]; } above += c[i]; }
            const int src = (int)__builtin_ctzll(__ballot(mine));
            B1 = __builtin_amdgcn_readlane(bb, src); above1 = __builtin_amdgcn_readlane(ab, src); cnt1 = __builtin_amdgcn_readlane(cb, src);
        }
        int selcnt = 0, candcnt = 0;
        for (int base = 0; base < n; base += 512) {
            const int ia = base + lane * 4, ib = ia + 256;
            uint2 ra = make_uint2(0u, 0u), rb2 = make_uint2(0u, 0u);
            if (ia < n) ra = *(const uint2*)(sc + ia);
            if (ib < n) rb2 = *(const uint2*)(sc + ib);
            const unsigned wv[8] = {ra.x & 0xffffu, ra.x >> 16, ra.y & 0xffffu, ra.y >> 16, rb2.x & 0xffffu, rb2.x >> 16, rb2.y & 0xffffu, rb2.y >> 16};
            unsigned smask = 0u, cmask = 0u;
#pragma unroll
            for (int j = 0; j < 8; ++j) {
                const int idx = (j < 4 ? ia : ib) + (j & 3);
                const int b1 = idx < n ? BINF(H2F(wv[j])) : -1;
                smask |= (b1 > B1 ? 1u : 0u) << j; cmask |= (b1 == B1 ? 1u : 0u) << j;
            }
            const int cnt = __popc(smask);
            const int inc = wave_incl_scan(cnt);
            int pos = selcnt + inc - cnt;
#pragma unroll
            for (int j = 0; j < 8; ++j) if ((smask >> j) & 1u) { sel[pos] = (unsigned short)((j < 4 ? ia : ib) + (j & 3)); ++pos; }
            selcnt += __builtin_amdgcn_readlane(inc, 63);
            if (__ballot(cmask != 0u)) {
#pragma unroll
                for (int j = 0; j < 8; ++j) {
                    const bool isc = (cmask >> j) & 1u;
                    const unsigned long long mc = __ballot(isc);
                    const int cp = candcnt + __popcll(mc & lt);
                    if (isc && cp < 128) cand[cp] = (unsigned short)((j < 4 ? ia : ib) + (j & 3));
                    candcnt += __popcll(mc);
                }
            }
        }
        {
            const int rq = 256 - above1, cq = cnt1, sbase = 256 - rq;
            if (cq <= 128) {
                const int i0 = lane, i1 = lane + 64;
                int ci0 = 0, ci1 = 0; float cv0 = -INFINITY, cv1 = -INFINITY;
                if (i0 < cq) { ci0 = cand[i0]; cv0 = (float)sc[ci0]; }
                if (i1 < cq) { ci1 = cand[i1]; cv1 = (float)sc[ci1]; }
                int rank0 = 0, rank1 = 0;
                const int c64 = cq < 64 ? cq : 64;
                for (int j = 0; j < c64; ++j) {
                    const int oj = __builtin_amdgcn_readlane(ci0, j); const float ov = readlane_f(cv0, j);
                    rank0 += (ov > cv0) || (ov == cv0 && oj < ci0); rank1 += (ov > cv1) || (ov == cv1 && oj < ci1);
                }
                for (int j = 64; j < cq; ++j) {
                    const int oj = __builtin_amdgcn_readlane(ci1, j - 64); const float ov = readlane_f(cv1, j - 64);
                    rank0 += (ov > cv0) || (ov == cv0 && oj < ci0); rank1 += (ov > cv1) || (ov == cv1 && oj < ci1);
                }
                int taken = 0;
                {
                    const bool take = i0 < cq && rank0 < rq;
                    const unsigned long long mt = __ballot(take);
                    if (take) sel[sbase + taken + __popcll(mt & lt)] = (unsigned short)ci0;
                    taken += __popcll(mt);
                }
                {
                    const bool take = i1 < cq && rank1 < rq;
                    const unsigned long long mt = __ballot(take);
                    if (take) sel[sbase + taken + __popcll(mt & lt)] = (unsigned short)ci1;
                    taken += __popcll(mt);
                }
            } else {
                int taken = 0;
                for (int base = 0; base < n && taken < rq; base += 64) {
                    const int idx = base + lane; bool isc = false;
                    if (idx < n) isc = BINF((float)sc[idx]) == B1;
                    const unsigned long long mc = __ballot(isc);
                    const int pos = taken + __popcll(mc & lt);
                    if (isc && pos < rq) sel[sbase + pos] = (unsigned short)idx;
                    taken += __popcll(mc);
                }
            }
        }
#undef BINF
#undef H2F
    } else {
        nsel = n;
#pragma unroll
        for (int i = 0; i < 4; ++i) { const int j = lane + 64 * i; sel[j] = (unsigned short)(j < n ? j : 0); }
    }
    LAS unsigned char* vst = (LAS unsigned char*)wl + W_SC;
    {
        long qf[4];
        {
            const unsigned char* qp = p.q8() + (size_t)row * 512 + (col & 7) * 64 + g4 * 8;
            const long q0 = *(const long*)qp, q1 = *(const long*)(qp + 32);
            const bool lo_grp = col < 4, hi_grp = col >= 4 && col < 8;
            qf[0] = lo_grp ? q0 : 0l; qf[1] = lo_grp ? q1 : 0l; qf[2] = hi_grp ? q0 : 0l; qf[3] = hi_grp ? q1 : 0l;
        }
#define A_WAITV(n_) do { if ((n_) >= 14) asm volatile("s_waitcnt vmcnt(14)" ::: "memory"); else if ((n_) == 12) asm volatile("s_waitcnt vmcnt(12)" ::: "memory"); \
            else if ((n_) == 10) asm volatile("s_waitcnt vmcnt(10)" ::: "memory"); else if ((n_) == 8) asm volatile("s_waitcnt vmcnt(8)" ::: "memory"); \
            else if ((n_) == 6) asm volatile("s_waitcnt vmcnt(6)" ::: "memory"); else if ((n_) == 4) asm volatile("s_waitcnt vmcnt(4)" ::: "memory"); \
            else if ((n_) == 2) asm volatile("s_waitcnt vmcnt(2)" ::: "memory"); else asm volatile("s_waitcnt vmcnt(0)" ::: "memory"); } while (0)
        const unsigned char* kg = p.k8() + (size_t)brow * 128;
#define K_STAGE(s_) do { _Pragma("unroll") for (int i_ = 0; i_ < 2; ++i_) { \
            const int kl_ = i_ * 8 + (lane >> 3); const int key_ = sel[(s_) * 16 + kl_]; \
            __builtin_amdgcn_global_load_lds((const unsigned*)(kg + (size_t)key_ * 128 + (((lane & 7) ^ (kl_ >> 1)) & 7) * 16), (LAS unsigned*)(vst + ((s_) & 7) * 2048 + i_ * 1024), 16, 0, 0); } } while (0)
        f32x4 lg[16];
        K_STAGE(0); K_STAGE(1); K_STAGE(2); K_STAGE(3); K_STAGE(4); K_STAGE(5); K_STAGE(6);
#pragma unroll
        for (int s = 0; s < 16; ++s) {
            if (s + 7 < 16) K_STAGE(s + 7);
            A_WAITV(2 * (15 - s < 7 ? 15 - s : 7));
            long kf[4];
#pragma unroll
            for (int ks = 0; ks < 4; ++ks) kf[ks] = *(const LAS long*)(vst + (s & 7) * 2048 + col * 128 + (((ks * 2 + (g4 >> 1)) ^ (col >> 1)) & 7) * 16 + (g4 & 1) * 8);
            asm volatile("s_waitcnt lgkmcnt(0)" ::: "memory");
            __builtin_amdgcn_sched_barrier(0);
            f32x4 a = (f32x4){0.f, 0.f, 0.f, 0.f};
#pragma unroll
            for (int ks = 0; ks < 4; ++ks) a = __builtin_amdgcn_mfma_f32_16x16x32_fp8_fp8(kf[ks], qf[ks], a, 0, 0, 0);
            lg[s] = a * 0.125f;
        }
#undef K_STAGE
        const unsigned char* vg = p.v8() + (size_t)brow * 128;
#define V_STAGE(s_) do { _Pragma("unroll") for (int i_ = 0; i_ < 2; ++i_) { \
            const int kl_ = i_ * 8 + (lane >> 3); const int key_ = sel[(s_) * 16 + kl_]; \
            __builtin_amdgcn_global_load_lds((const unsigned*)(vg + (size_t)key_ * 128 + ((lane & 7) ^ (((kl_ >> 1) & 3) | (((s_) & 1) << 2))) * 16), (LAS unsigned*)(vst + ((s_) & 7) * 2048 + i_ * 1024), 16, 0, 0); } } while (0)
        V_STAGE(0); V_STAGE(1); V_STAGE(2); V_STAGE(3); V_STAGE(4); V_STAGE(5);
        float mxl = -INFINITY;
#pragma unroll
        for (int tt = 0; tt < 16; ++tt)
#pragma unroll
            for (int j = 0; j < 4; ++j) { if (tt * 16 + g4 * 4 + j >= nsel) lg[tt][j] = -INFINITY; mxl = fmaxf(mxl, lg[tt][j]); }
        mxl = xmax32(xmax16(mxl));
        float sm = 0.f;
#pragma unroll
        for (int tt = 0; tt < 16; ++tt)
#pragma unroll
            for (int j = 0; j < 4; ++j) { const float e = __builtin_amdgcn_exp2f(lg[tt][j] - mxl); lg[tt][j] = e; sm += e; }
        sm = xsum32(xsum16(sm));
        const float inv = (1.0f / 256.0f) / sm;
        f32x4 o[8];
#pragma unroll
        for (int d = 0; d < 8; ++d) o[d] = (f32x4){0.f, 0.f, 0.f, 0.f};
        const int tq = col >> 1, trow = 4 * g4 + (tq & 3), tf = ((trow >> 1) & 3) | ((tq >> 2) << 2);
        const unsigned trb = (unsigned)(uintptr_t)vst + (tq >> 2) * 2048 + trow * 128 + (col & 1) * 8;
#pragma unroll
        for (int sp = 0; sp < 8; ++sp) {
            if (2 * sp + 7 < 16) { V_STAGE(2 * sp + 6); V_STAGE(2 * sp + 7); }
            A_WAITV(2 * (14 - 2 * sp < 6 ? 14 - 2 * sp : 6));
            const unsigned rb = trb + ((2 * sp) & 7) * 2048;
            long pa;
            {
                const uint32_t w0 = pk4_fp8(lg[2 * sp][0] * 256.0f, lg[2 * sp][1] * 256.0f, lg[2 * sp][2] * 256.0f, lg[2 * sp][3] * 256.0f);
                const uint32_t w1 = pk4_fp8(lg[2 * sp + 1][0] * 256.0f, lg[2 * sp + 1][1] * 256.0f, lg[2 * sp + 1][2] * 256.0f, lg[2 * sp + 1][3] * 256.0f);
                pa = (long)(((unsigned long long)w1 << 32) | (unsigned long long)w0);
            }
            long vf[8];
#pragma unroll
            for (int dt = 0; dt < 8; ++dt) asm volatile("ds_read_b64_tr_b8 %0, %1" : "=&v"(vf[dt]) : "v"(rb + ((dt ^ tf) * 16)) : "memory");
            asm volatile("s_waitcnt lgkmcnt(0)" ::: "memory");
            __builtin_amdgcn_sched_barrier(0);
#pragma unroll
            for (int dt = 0; dt < 8; ++dt) o[dt] = __builtin_amdgcn_mfma_f32_16x16x32_fp8_fp8(pa, vf[dt], o[dt], 0, 0, 0);
        }
#undef V_STAGE
#undef A_WAITV
        float ih[4];
#pragma unroll
        for (int jj = 0; jj < 4; ++jj) ih[jj] = (g4 & 1) ? readlane_f(inv, 4 + jj) : readlane_f(inv, jj);
        if (g4 < 2) {
            bf16_t* op = p.att() + (size_t)row * 512 + (g4 * 4) * 64 + col;
#pragma unroll
            for (int d = 0; d < 4; ++d) {
                const f32x4 oa_ = o[d], ob_ = o[4 + d]; f32x4 ov;
#pragma unroll
                for (int kk = 0; kk < 4; ++kk) ov[kk] = g4 == 0 ? oa_[kk] : ob_[kk];
                op[0 * 64 + d * 16] = f2bf(ov[0] * ih[0]); op[1 * 64 + d * 16] = f2bf(ov[1] * ih[1]);
                op[2 * 64 + d * 16] = f2bf(ov[2] * ih[2]); op[3 * 64 + d * 16] = f2bf(ov[3] * ih[3]);
            }
        }
    }
}

constexpr int A8_META = 8 * W_SZ;
static_assert(A8_META + 64 + 512 <= LDS_BYTES - 32, "attn8 meta");
__device__ __forceinline__ void attn8_unit(const P& p, unsigned char* lds, int b, int grp) {
    const int tid = tid_(), lane = tid & 63, wid = __builtin_amdgcn_readfirstlane(tid >> 6);
    const int t0 = NMETA + 8 * grp, brow = b * LP, row0 = brow + t0;
    unsigned* meta = (unsigned*)(lds + A8_META);
    const bool big = t0 + 1 > 256;
    bf16_t* uvec = (bf16_t*)(lds + A8_META + 64);
    const int hh = lane >> 5, c32 = lane & 31;
    const int g = c32 >> 3, h2a = (c32 >> 2) & 1, bq = c32 & 3, aq = 2 * h2a + (g >> 1), ah = 4 * (g & 1) + bq;
    bf16x8 a0[2], a1[2]; f32x4 w[2][2][2];
    if (big) {
#pragma unroll
        for (int r = 0; r < 2; ++r) {
            const bf16_t* ap = p.iq() + (size_t)(row0 + 4 * r + aq) * 256 + ah * 32 + 8 * hh;
            a0[r] = *(const bf16x8*)ap; a1[r] = *(const bf16x8*)(ap + 16);
#pragma unroll
            for (int qi = 0; qi < 2; ++qi) {
                const float* wp = p.iw() + (size_t)(row0 + 4 * r + 2 * hh + qi) * 8;
                w[r][qi][0] = *(const f32x4*)wp; w[r][qi][1] = *(const f32x4*)(wp + 4);
            }
        }
    }
    if (big && tid < 256) {
        const int q = tid >> 5, d = tid & 31;
        const bf16_t* ip = p.iq() + (size_t)(row0 + q) * 256 + d; const float* wp = p.iw() + (size_t)(row0 + q) * 8;
        float u = 0.f;
#pragma unroll
        for (int h = 0; h < 8; ++h) u += wp[h] * bf2f(ip[h * 32]);
        uvec[q * 32 + d] = f2bf(u);
    }
    for (int i = tid; i < 8 * NBW; i += NTHREADS) ((int*)(lds + (i / NBW) * W_SZ + W_H))[i % NBW] = 0;
    __syncthreads();
    if (big) {
        bf16x8 au0, au1;
        {
            const int uq = 4 * ((c32 & 3) >> 1) + 2 * ((c32 >> 2) & 1) + (c32 & 1);
            const bf16x8 v0 = *(const bf16x8*)(uvec + uq * 32 + 8 * hh), v1 = *(const bf16x8*)(uvec + uq * 32 + 8 * hh + 16);
#pragma unroll
            for (int i = 0; i < 8; ++i) { au0[i] = c32 < 8 ? v0[i] : (short)0; au1[i] = c32 < 8 ? v1[i] : (short)0; }
        }
        const int ntiles = (t0 + 8 + 31) >> 5;
        float mx[2][2], mn[2][2];
#pragma unroll
        for (int r = 0; r < 2; ++r)
#pragma unroll
            for (int qi = 0; qi < 2; ++qi) { mx[r][qi] = -INFINITY; mn[r][qi] = INFINITY; }
        const bf16_t* kbase = p.ik() + (size_t)brow * 32 + 8 * hh;
        bf16x8 b0[4], b1[4], c0[4], c1[4];
#define S_LOAD(B0, B1, T0) do { _Pragma("unroll") for (int j = 0; j < 4; ++j) { const int tile_ = min((T0) + 8 * j, ntiles - 1); \
            const bf16_t* kp_ = kbase + (size_t)(tile_ * 32 + c32) * 32; B0[j] = *(const bf16x8*)kp_; B1[j] = *(const bf16x8*)(kp_ + 16); } } while (0)
#define S_COMP(B0, B1, T0) do { _Pragma("unroll") for (int j = 0; j < 4; ++j) { const int tile = min((T0) + 8 * j, ntiles - 1); { const int key = tile * 32 + c32;   \
            f32x16 acu; _Pragma("unroll") for (int i = 0; i < 16; ++i) acu[i] = 0.f; \
            acu = __builtin_amdgcn_mfma_f32_32x32x16_bf16(au0, B0[j], acu, 0, 0, 0); acu = __builtin_amdgcn_mfma_f32_32x32x16_bf16(au1, B1[j], acu, 0, 0, 0); \
            _Pragma("unroll") for (int r = 0; r < 2; ++r) { f32x16 acc; _Pragma("unroll") for (int i = 0; i < 16; ++i) acc[i] = 0.f; \
                acc = __builtin_amdgcn_mfma_f32_32x32x16_bf16(a0[r], B0[j], acc, 0, 0, 0); acc = __builtin_amdgcn_mfma_f32_32x32x16_bf16(a1[r], B1[j], acc, 0, 0, 0); \
                _Pragma("unroll") for (int qi = 0; qi < 2; ++qi) { float s = acu[2 * r + qi], s1_ = 0.f; \
                    _Pragma("unroll") for (int i = 0; i < 4; ++i) { s = __builtin_fmaf(w[r][qi][0][i], __builtin_fabsf(acc[8 * qi + i]), s); s1_ = __builtin_fmaf(w[r][qi][1][i], __builtin_fabsf(acc[8 * qi + 4 + i]), s1_); } \
                    s += s1_; const int q = 4 * r + 2 * hh + qi; const _Float16 hs = (_Float16)fminf(fmaxf(s, -60000.f), 60000.f); \
                    ((_Float16*)(lds + q * W_SZ + W_SC))[key] = hs; } } } } } while (0)
        S_LOAD(b0, b1, wid);
        for (int tile0 = wid; tile0 < ntiles; tile0 += 64) {
            if (tile0 + 32 < ntiles) S_LOAD(c0, c1, tile0 + 32);
            __builtin_amdgcn_sched_barrier(0);
            S_COMP(b0, b1, tile0);
            __builtin_amdgcn_sched_barrier(0);
            if (tile0 + 64 < ntiles) S_LOAD(b0, b1, tile0 + 64);
            __builtin_amdgcn_sched_barrier(0);
            if (tile0 + 32 < ntiles) S_COMP(c0, c1, tile0 + 32);
            __builtin_amdgcn_sched_barrier(0);
        }
#undef S_LOAD
#undef S_COMP
    }
    __syncthreads();
    attn_wave(p, lds, wid, lane, b, t0 + wid);
    __syncthreads();
}

constexpr int NGRP8 = SEQ / 8, ATT_P1 = NGRP8 / 8, ATT_P2 = NGRP8 / 2;
template <int SUB>
__device__ __forceinline__ void ph_mixer(const P& p, unsigned char* lds) {
    int* bc = (int*)(lds + LDS_BYTES - 16);
    constexpr int nh = SUB == 1 ? 64 : NXU;
    constexpr int a0 = SUB == 0 ? 0 : (SUB == 1 ? ATT_P1 : ATT_P2), a1 = SUB == 0 ? ATT_P1 : (SUB == 1 ? ATT_P2 : NGRP8);
    const bool t0 = tid_() == 0;
    int nx = 0;
    if (t0) nx = atomicAdd(&p.ctr()[97 + SUB], 1);
    for (;;) {
        __syncthreads();
        if (t0) bc[0] = nx;
        __syncthreads();
        const int it = bc[0];
        if (it >= nh) break;
        if (t0) nx = atomicAdd(&p.ctr()[97 + SUB], 1);
        if (SUB == 0) hgx_unit(p, lds, it);
        else if (SUB == 1) hgchain_unit(p, it);
        else hgz_unit(p, lds, it);
    }
    const int b0 = (int)(xb_xcc_id() & 3u);
#pragma unroll 1
    for (int k = 0; k < 4; ++k) {
        const int b = (b0 + k) & 3;
        int* ctr = &p.ctr()[104 + SUB * 4 + b];
        if (t0) nx = atomicAdd(ctr, 1);
        for (;;) {
            __syncthreads();
            if (t0) bc[0] = nx;
            __syncthreads();
            const int it = bc[0];
            if (it >= a1 - a0) break;
            if (t0) nx = atomicAdd(ctr, 1);
            attn8_unit(p, lds, b, NGRP8 - 1 - (a0 + it));
        }
    }
}
__device__ __forceinline__ int tok_row(int tok) { return (tok >> 13) * LP + NMETA + (tok & 8191); }
__device__ __forceinline__ void ph_mix(const P& p, unsigned char* lds) {
    const int njobs = (NTOK / 256) * 4 * 2, G = gridDim.x, b0 = blockIdx.x;
    auto jobidx = [&](int i) __attribute__((always_inline)) { return (b0 + (i >> 1) * G) * 2 + (i & 1); };
    auto jobfn = [&](int i, GJob& j) __attribute__((always_inline)) -> bool {
        const int jb = jobidx(i); if (jb >= njobs) return false;
        const int which = jb & 1, u = jb >> 1, nt = u & 3, mt = u >> 2; const size_t r0 = (size_t)tok_row(mt * 256);
        j.A = (const char*)((which ? p.hgr() : p.att()) + r0 * 512); j.B = (const char*)((which ? p.wuhT() : p.wuaT()) + (size_t)nt * 256 * 512); return true; };
    auto epi = [&](f32x4 (&acc)[2][2][4][2], int i) __attribute__((always_inline)) {
        const int jb = jobidx(i), which = jb & 1, u = jb >> 1, nt = u & 3, mt = u >> 2; const size_t r0 = (size_t)tok_row(mt * 256);
        const int tid_e = tid_(), lane_e = tid_e & 63, wid_e = tid_e >> 6, wr = wid_e >> 2, wc = wid_e & 3, fr = lane_e & 15, fq = lane_e >> 4;
        const unsigned char* gsrc = which ? p.gh() : p.ga();
#pragma unroll
        for (int ai = 0; ai < 2; ++ai) {
            uint32_t g[4][2][2]; uint2 a[4][2][2];
#pragma unroll
            for (int m = 0; m < 4; ++m)
#pragma unroll
                for (int bj = 0; bj < 2; ++bj)
#pragma unroll
                    for (int n = 0; n < 2; ++n) {
                        const int row = ai * 128 + wr * 64 + m * 16 + fr, col = bj * 128 + wc * 32 + n * 16 + fq * 4;
                        g[m][bj][n] = *(const uint32_t*)(gsrc + (r0 + row) * 1024 + nt * 256 + col);
                        if (which) a[m][bj][n] = *(const uint2*)(p.mix() + (size_t)(mt * 256 + row) * 1024 + nt * 256 + col);
                    }
#pragma unroll
            for (int m = 0; m < 4; ++m)
#pragma unroll
                for (int bj = 0; bj < 2; ++bj) {
                    const int row = ai * 128 + wr * 64 + m * 16 + fr;
                    f32x4 rr[2];
#pragma unroll
                    for (int n = 0; n < 2; ++n) {
                        const f32x4 v = acc[ai][bj][m][n] * (1.0f / 255.0f); const uint32_t gg = g[m][bj][n];
                        rr[n][0] = v[0] * (float)(gg & 0xffu); rr[n][1] = v[1] * (float)((gg >> 8) & 0xffu);
                        rr[n][2] = v[2] * (float)((gg >> 16) & 0xffu); rr[n][3] = v[3] * (float)(gg >> 24);
                        if (which) {
                            const uint2 aa = a[m][bj][n];
                            rr[n][0] += __uint_as_float(aa.x << 16); rr[n][1] += __uint_as_float(aa.x & 0xffff0000u);
                            rr[n][2] += __uint_as_float(aa.y << 16); rr[n][3] += __uint_as_float(aa.y & 0xffff0000u);
                        }
                    }
                    st_bf4_pair(p.mix() + (size_t)(mt * 256 + row) * 1024 + nt * 256 + bj * 128 + wc * 32, fq, rr[0], rr[1]);
                }
        }
    };
    unsigned vbU[2]; gj_lin2(vbU, 512);
    gemm_stream<false>(lds, 512, 512, (size_t)128 * 512 * 2, vbU, jobfn, epi);
}

__device__ __forceinline__ void ph_out(const P& p, unsigned char* lds) {
    const int nunits = (NTOK / 256) * 4, G = gridDim.x, b0 = blockIdx.x;
    auto jobfn = [&](int i, GJob& j) __attribute__((always_inline)) -> bool {
        const int u = b0 + i * G; if (u >= nunits) return false;
        const int nt = u & 3, mt = u >> 2;
        j.A = (const char*)(p.mix() + (size_t)mt * 256 * D); j.B = (const char*)(p.woT() + (size_t)nt * 256 * D); return true; };
    auto epi = [&](f32x4 (&acc)[2][2][4][2], int i) __attribute__((always_inline)) {
        const int u = b0 + i * G, nt = u & 3, mt = u >> 2;
        const int tid_e = tid_(), lane_e = tid_e & 63, wid_e = tid_e >> 6, wr = wid_e >> 2, wc = wid_e & 3, fr = lane_e & 15, fq = lane_e >> 4;
#pragma unroll
        for (int ai = 0; ai < 2; ++ai) {
            f32x4 h0[4][2][2];
#pragma unroll
            for (int m = 0; m < 4; ++m)
#pragma unroll
                for (int bj = 0; bj < 2; ++bj)
#pragma unroll
                    for (int n = 0; n < 2; ++n)
                        h0[m][bj][n] = *(const f32x4*)(p.x + (size_t)(mt * 256 + ai * 128 + wr * 64 + m * 16 + fr) * D + nt * 256 + bj * 128 + wc * 32 + n * 16 + fq * 4);
#pragma unroll
            for (int m = 0; m < 4; ++m)
#pragma unroll
                for (int bj = 0; bj < 2; ++bj)
                    st_bf4_pair(p.h1b() + (size_t)(mt * 256 + ai * 128 + wr * 64 + m * 16 + fr) * D + nt * 256 + bj * 128 + wc * 32, fq, h0[m][bj][0] + acc[ai][bj][m][0], h0[m][bj][1] + acc[ai][bj][m][1]);
        }
    };
    unsigned vbU[2]; gj_lin2(vbU, D);
    gemm_stream<false>(lds, D, D, (size_t)128 * D * 2, vbU, jobfn, epi);
}

constexpr int XS_LD = 1025;
__device__ __forceinline__ void ph_route(const P& p, unsigned char* lds) {
    const int tid = tid_(), lane = tid & 63, wid = __builtin_amdgcn_readfirstlane(tid >> 6);
    const int gt = blockIdx.x * NTHREADS + tid, ntot = gridDim.x * NTHREADS;
    for (int i = gt; i < CAP; i += ntot) { p.slot_token()[i] = -1; p.slot_info()[i] = make_int2(-1, 0); }
    float* xs = (float*)lds;
    int* lhist = (int*)(lds + 32 * XS_LD * 4);
    for (int tb = blockIdx.x; tb < NTOK / 128; tb += gridDim.x) {
        if (tid < 32) lhist[tid] = 0;
        for (int tile = 0; tile < 4; ++tile) {
            const int tokt = tb * 128 + tile * 32;
            __syncthreads();
#pragma unroll
            for (int t = 0; t < 4; ++t) {
                const int tl = wid * 4 + t, tok = tokt + tl;
                const bf16_t* src = p.h1b() + (size_t)tok * D;
                f32x4 v[4]; float ss = 0.f;
#pragma unroll
                for (int i = 0; i < 4; ++i) {
                    const uint2 w = *(const uint2*)(src + lane * 4 + 256 * i);
                    v[i][0] = __uint_as_float(w.x << 16); v[i][1] = __uint_as_float(w.x & 0xffff0000u); v[i][2] = __uint_as_float(w.y << 16); v[i][3] = __uint_as_float(w.y & 0xffff0000u);
                    ss += v[i][0] * v[i][0] + v[i][1] * v[i][1] + v[i][2] * v[i][2] + v[i][3] * v[i][3];
                }
                ss = wave_sum(ss);
                const float rs = rsqrtf(ss * (1.0f / D) + EPS);
#pragma unroll
                for (int i = 0; i < 4; ++i) {
                    const f32x4 g = *(const f32x4*)(p.ffn_g + lane * 4 + 256 * i);
                    f32x4 xn; xn[0] = v[i][0] * rs * g[0]; xn[1] = v[i][1] * rs * g[1]; xn[2] = v[i][2] * rs * g[2]; xn[3] = v[i][3] * rs * g[3];
                    *(uint32_t*)(p.xn2() + (size_t)tok * D + lane * 4 + 256 * i) = pk4_fp8(xn[0], xn[1], xn[2], xn[3]);
#pragma unroll
                    for (int c = 0; c < 4; ++c) xs[tl * XS_LD + lane * 4 + 256 * i + c] = xn[c];
                }
            }
            __syncthreads();
            f32x16 acc;
#pragma unroll
            for (int i = 0; i < 16; ++i) acc[i] = 0.f;
            {
                const float* xr = xs + (lane & 31) * XS_LD + wid * 128 + (lane >> 5);
                const float* wp = p.router_w + (size_t)(wid * 128 + (lane >> 5)) * 32 + (lane & 31);
#pragma unroll 16
                for (int i = 0; i < 64; ++i) acc = __builtin_amdgcn_mfma_f32_32x32x2f32(xr[2 * i], wp[(size_t)(2 * i) * 32], acc, 0, 0, 0);
            }
            __syncthreads();
#pragma unroll
            for (int r = 0; r < 16; ++r) xs[wid * 1024 + ((r & 3) + 8 * (r >> 2) + 4 * (lane >> 5)) * 32 + (lane & 31)] = acc[r];
            __syncthreads();
            const int e = lane & 31, hh = lane >> 5;
            const float be = p.router_b[e];
#pragma unroll
            for (int it = 0; it < 2; ++it) {
                const int tl = wid * 4 + it * 2 + hh;
                float l = be;
#pragma unroll
                for (int w = 0; w < 8; ++w) l += xs[w * 1024 + tl * 32 + e];
                float bv[4]; int bi[4];
#pragma unroll
                for (int k = 0; k < 4; ++k) {
                    float m = l;
#pragma unroll
                    for (int o = 16; o >= 1; o >>= 1) m = fmaxf(m, __shfl_xor(m, o));
                    const unsigned long long bal = __ballot(l == m);
                    const unsigned half = hh ? (unsigned)(bal >> 32) : (unsigned)bal;
                    const int idx = __builtin_ctz(half);
                    bv[k] = m; bi[k] = idx;
                    if (e == idx) l = -INFINITY;
                }
                const float e1 = __expf(bv[1] - bv[0]), e2 = __expf(bv[2] - bv[0]), e3 = __expf(bv[3] - bv[0]);
                const float inv = 1.0f / (1.0f + e1 + e2 + e3);
                if (e == 0) {
                    const int tok = tokt + tl;
                    p.tok_exp()[tok * 4 + 0] = bi[0]; p.tok_exp()[tok * 4 + 1] = bi[1]; p.tok_exp()[tok * 4 + 2] = bi[2]; p.tok_exp()[tok * 4 + 3] = bi[3];
                    p.tok_gate()[tok * 4 + 0] = inv; p.tok_gate()[tok * 4 + 1] = e1 * inv; p.tok_gate()[tok * 4 + 2] = e2 * inv; p.tok_gate()[tok * 4 + 3] = e3 * inv;
                    atomicAdd(&lhist[bi[0]], 1); atomicAdd(&lhist[bi[1]], 1); atomicAdd(&lhist[bi[2]], 1); atomicAdd(&lhist[bi[3]], 1);
                }
            }
        }
        __syncthreads();
        if (tid < 32) p.wg_cnt()[tb * 32 + tid] = lhist[tid];
        __syncthreads();
    }
    __syncthreads();
    {
        constexpr int ROWB = 272;
        LAS unsigned char* wl = (LAS unsigned char*)lds + wid * (64 * ROWB);
        const int gw = blockIdx.x * 8 + wid, nw = gridDim.x * 8;
        for (int task = gw; task < 96 * 4 * 16; task += nw) {
            const int mat = task >> 6, kq4 = (task >> 4) & 3, nb = task & 15;
            const int which = mat >> 5, e = mat & 31;
            const float* W = (which == 0 ? p.w_gate : which == 1 ? p.w_up : p.w_down) + (size_t)e * 1048576 + (size_t)(kq4 * 256) * 1024 + nb * 64 + lane;
            unsigned char* outp = (which == 0 ? p.wgT() : which == 1 ? p.wuT() : p.wdT()) + (size_t)e * 1048576 + (size_t)(nb * 64) * 1024 + kq4 * 256;
#pragma unroll 1
            for (int q = 0; q < 4; ++q) {
                float v[64];
#pragma unroll
                for (int i = 0; i < 64; ++i) v[i] = W[(size_t)(q * 64 + i) * 1024] * 32.0f;
#pragma unroll
                for (int i = 0; i < 4; ++i) {
                    u32x4 t;
                    t.x = pk4_fp8(v[16 * i], v[16 * i + 1], v[16 * i + 2], v[16 * i + 3]); t.y = pk4_fp8(v[16 * i + 4], v[16 * i + 5], v[16 * i + 6], v[16 * i + 7]);
                    t.z = pk4_fp8(v[16 * i + 8], v[16 * i + 9], v[16 * i + 10], v[16 * i + 11]); t.w = pk4_fp8(v[16 * i + 12], v[16 * i + 13], v[16 * i + 14], v[16 * i + 15]);
                    *(LAS u32x4*)(wl + lane * ROWB + q * 64 + i * 16) = t;
                }
            }
#pragma unroll
            for (int j = 0; j < 16; ++j) {
                const int rr = j * 4 + (lane >> 4), c = lane & 15;
                const u32x4 t = *(const LAS u32x4*)(wl + rr * ROWB + c * 16);
                *(u32x4*)(outp + (size_t)rr * 1024 + c * 16) = t;
            }
        }
    }
}

__device__ __forceinline__ void ph_fill(const P& p, unsigned char* lds) {
    const int tid = tid_();
    int* tot = (int*)lds;
    int* pre = tot + 512;
    int* ps = pre + 512;
    int* lc = ps + 32;
    for (int tb = blockIdx.x; tb < NTOK / 128; tb += gridDim.x) {
        {
            const int e = tid & 31, part = tid >> 5;
            int t = 0, q = 0;
            for (int b2 = part; b2 < NTOK / 128; b2 += 16) { const int c = p.wg_cnt()[b2 * 32 + e]; t += c; if (b2 < tb) q += c; }
            tot[part * 32 + e] = t; pre[part * 32 + e] = q;
        }
        __syncthreads();
        if (tid == 0) {
            int acc = 0;
            for (int e = 0; e < NE; ++e) {
                int t = 0, q = 0;
                for (int i = 0; i < 16; ++i) { t += tot[i * 32 + e]; q += pre[i * 32 + e]; }
                ps[e] = acc + q; lc[e] = 0;
                const int nb = (t + 255) >> 8;
                if (tb == 0) for (int i = 0; i < nb; ++i) p.block_expert()[(acc >> 8) + i] = e;
                acc += nb * 256;
            }
            if (tb == 0) p.ctr()[96] = acc >> 8;
        }
        __syncthreads();
        {
            const int i = tb * 512 + tid;
            const int e = p.tok_exp()[i];
            const int dest = ps[e] + atomicAdd(&lc[e], 1);
            p.slot_token()[dest] = i >> 2;
            p.slot_rank()[dest] = i & 3;
            p.slot_gate()[dest] = p.tok_gate()[i];
            p.slot_info()[dest] = make_int2((i >> 2) | ((i & 3) << 16), __float_as_int(p.tok_gate()[i]));
        }
        __syncthreads();
    }
}

__device__ __forceinline__ void ph_moe1(const P& p, unsigned char* lds) {
    const int nblocks = p.ctr()[96], G = gridDim.x, b0 = blockIdx.x, bpx = (nblocks + 7) >> 3, bpi = G >> 6, xl = b0 >> 3, xbase = (b0 & 7) * bpx;
    const bool xcd_order = (G & 63) == 0;
    auto unit = [&](int i, int& rb, int& ct) __attribute__((always_inline)) -> bool {
        if (!xcd_order) { const int u = b0 + i * G; rb = u >> 3; ct = u & 7; return rb < nblocks; }
        const int k = i * bpi + (xl >> 3); rb = xbase + k; ct = xl & 7; return k < bpx && rb < nblocks && (xl >> 3) < bpi; };
    auto jobfn = [&](int i, G8Job& j) __attribute__((always_inline)) -> bool {
        int rb, ct; if (!unit(i, rb, ct)) return false;
        const int e = p.block_expert()[rb];
        j.A = (const char*)p.xn2(); j.B = (const char*)(p.wgT() + (size_t)e * 1048576 + (size_t)ct * 128 * 1024); j.aux = e;
        const int* st = p.slot_token() + rb * 256; unsigned v[4];
#pragma unroll
        for (int q = 0; q < 4; ++q) { int R, Cb; g8_rc(q, R, Cb); const int t = st[R]; v[q] = (unsigned)((t < 0 ? 0 : t) * 1024 + Cb); }
        j.va0 = v[0]; j.va1 = v[1]; j.va2 = v[2]; j.va3 = v[3]; return true; };
    auto epi = [&](f32x4 (&acc)[2][2][4][2], int i) __attribute__((always_inline)) {
        int rb, ct; unit(i, rb, ct);
        const int e = p.block_expert()[rb];
        const int tid_e = tid_(), lane_e = tid_e & 63, wid_e = tid_e >> 6, wr = wid_e >> 2, wc = wid_e & 3, fr = lane_e & 15, fq = lane_e >> 4;
        constexpr float SC = 0.03125f, KE = -1.702f * 1.4426950408889634f;
        constexpr int STG = 131072 + 4096, ROWP = 144;
        f32x2 bgp[2][2], bup[2][2], c2p[2][2];
#pragma unroll
        for (int n = 0; n < 2; ++n) {
            const LAS unsigned char* bl = (const LAS unsigned char*)lds + 131072 + (i & 1) * 2048 + (wc * 32 + n * 16 + fq * 4) * 4;
            const f32x4 bg = *(const LAS f32x4*)bl, bu = *(const LAS f32x4*)(bl + 512);
            bgp[n][0] = (f32x2){bg[0], bg[1]}; bgp[n][1] = (f32x2){bg[2], bg[3]};
            bup[n][0] = (f32x2){bu[0] + 1.0f, bu[1] + 1.0f}; bup[n][1] = (f32x2){bu[2] + 1.0f, bu[3] + 1.0f};
            c2p[n][0] = bgp[n][0] * KE; c2p[n][1] = bgp[n][1] * KE;
        }
#pragma unroll
        for (int ai = 0; ai < 2; ++ai) {
#pragma unroll
            for (int n = 0; n < 2; ++n)
#pragma unroll
                for (int m = 0; m < 4; ++m) {
                    const f32x4 ga = acc[ai][0][m][n], ua = acc[ai][1][m][n];
                    f32x2 o[2];
#pragma unroll
                    for (int hh = 0; hh < 2; ++hh) {
                        const f32x2 ag = {ga[2 * hh], ga[2 * hh + 1]}, au = {ua[2 * hh], ua[2 * hh + 1]};
                        const f32x2 t = ag * (SC * KE) + c2p[n][hh];
                        f32x2 d = {__builtin_amdgcn_exp2f(t[0]), __builtin_amdgcn_exp2f(t[1])};
                        d = d + 1.0f;
                        const f32x2 rc = {__builtin_amdgcn_rcpf(d[0]), __builtin_amdgcn_rcpf(d[1])};
                        f32x2 g = ag * SC + bgp[n][hh];
                        g[0] = fminf(g[0], 7.0f); g[1] = fminf(g[1], 7.0f);
                        f32x2 u1 = au * SC + bup[n][hh];
                        u1[0] = __builtin_amdgcn_fmed3f(u1[0], -6.0f, 8.0f); u1[1] = __builtin_amdgcn_fmed3f(u1[1], -6.0f, 8.0f);
                        o[hh] = (g * rc) * u1;
                    }
                    int w = __builtin_amdgcn_cvt_pk_fp8_f32(o[0][0], o[0][1], 0, false); w = __builtin_amdgcn_cvt_pk_fp8_f32(o[1][0], o[1][1], w, true);
                    *(LAS uint32_t*)((LAS unsigned char*)lds + STG + (wr * 64 + m * 16 + fr) * ROWP + wc * 32 + n * 16 + fq * 4) = (uint32_t)w;
                }
            __syncthreads();
#pragma unroll
            for (int t = 0; t < 2; ++t) {
                const int idx = t * NTHREADS + tid_e, rl = idx >> 3, ch = idx & 7;
                const u32x4 v4 = *(const LAS u32x4*)((LAS unsigned char*)lds + STG + rl * ROWP + ch * 16);
                *(u32x4*)(p.act() + (size_t)(rb * 256 + ai * 128 + rl) * DFF + ct * 128 + ch * 16) = v4;
            }
            __syncthreads();
        }
    };
    unsigned vbU[4];
#pragma unroll
    for (int q = 0; q < 4; ++q) { int R, Cb; g8_rc(q, R, Cb); vbU[q] = (unsigned)((size_t)(R >> 7) * WE8_B + (size_t)(R & 127) * 1024 + Cb); }
    auto pre = [&](int i, int e) __attribute__((always_inline)) {
        int rb, ct; unit(i, rb, ct);
        const int tid_p = tid_(), wid_p = __builtin_amdgcn_readfirstlane(tid_p >> 6), lane_p = tid_p & 63;
        if (wid_p < 4) {
            const float* src = (wid_p < 2 ? p.b_gate : p.b_up) + (size_t)e * DFF + ct * 128 + (wid_p & 1) * 64;
            const unsigned voff = (unsigned)lane_p * 4u, dst = (unsigned)(size_t)(LAS unsigned char*)lds + 131072u + (unsigned)(i & 1) * 2048u + (unsigned)wid_p * 256u;
            G8_PRE_DMA(uni_ptr8((const char*)src), voff, __builtin_amdgcn_readfirstlane(dst));
        }
    };
    gemm8_stream<true>(lds, vbU, jobfn, pre, epi);
}
__device__ __forceinline__ void ph_moe2(const P& p, unsigned char* lds) {
    const int nblocks = p.ctr()[96], G = gridDim.x, b0 = blockIdx.x, bpx = (nblocks + 7) >> 3, bpi = G >> 5, xl = b0 >> 3, xbase = (b0 & 7) * bpx;
    const bool xcd_order = (G & 31) == 0;
    auto unit = [&](int i, int& rb, int& nt) __attribute__((always_inline)) -> bool {
        if (!xcd_order) { const int u = b0 + i * G; rb = u >> 2; nt = u & 3; return rb < nblocks; }
        const int k = i * bpi + (xl >> 2); rb = xbase + k; nt = xl & 3; return k < bpx && rb < nblocks && (xl >> 2) < bpi; };
    unsigned vbU[4];
#pragma unroll
    for (int q = 0; q < 4; ++q) { int R, Cb; g8_rc(q, R, Cb); vbU[q] = (unsigned)(R * DFF + Cb); }
    auto jobfn = [&](int i, G8Job& j) __attribute__((always_inline)) -> bool {
        int rb, nt; if (!unit(i, rb, nt)) return false;
        const int e = p.block_expert()[rb];
        j.A = (const char*)(p.act() + (size_t)rb * 256 * DFF); j.B = (const char*)(p.wdT() + (size_t)e * 1048576 + (size_t)nt * 256 * DFF); j.aux = e; return true; };
    auto pre = [&](int i, int e) __attribute__((always_inline)) {
        int rb, nt; unit(i, rb, nt);
        const int tid_p = tid_(), wid_p = __builtin_amdgcn_readfirstlane(tid_p >> 6), lane_p = tid_p & 63;
        const unsigned voff = (unsigned)lane_p * 4u, base = (unsigned)(size_t)(LAS unsigned char*)lds + 131072u + (unsigned)(i & 1) * 3072u;
        G8_PRE_DMA(uni_ptr8((const char*)(p.slot_info() + rb * 256) + wid_p * 256), voff, __builtin_amdgcn_readfirstlane(base + 1024u + (unsigned)wid_p * 256u));
        if (wid_p < 4) G8_PRE_DMA(uni_ptr8((const char*)(p.b_down + (size_t)e * D + nt * 256 + wid_p * 64)), voff, __builtin_amdgcn_readfirstlane(base + (unsigned)wid_p * 256u));
    };
    auto epi = [&](f32x4 (&acc)[2][2][4][2], int i) __attribute__((always_inline)) {
        int rb, nt; unit(i, rb, nt);
        const int e = p.block_expert()[rb];
        const int tid_e = tid_(), lane_e = tid_e & 63, wid_e = tid_e >> 6, wr = wid_e >> 2, wc = wid_e & 3, fr = lane_e & 15, fq = lane_e >> 4;
        f32x4 bd[2][2];
#pragma unroll
        for (int bj = 0; bj < 2; ++bj)
#pragma unroll
            for (int n = 0; n < 2; ++n) bd[bj][n] = *(const LAS f32x4*)((const LAS unsigned char*)lds + 131072 + (i & 1) * 3072 + (bj * 128 + wc * 32 + n * 16 + fq * 4) * 4);
        typedef int i32x2_ __attribute__((ext_vector_type(2)));
        const LAS unsigned char* infl = (const LAS unsigned char*)lds + 131072 + (i & 1) * 3072 + 1024;
        LAS unsigned char* stg = (LAS unsigned char*)lds + 131072 + 6144;
#pragma unroll
        for (int ai = 0; ai < 2; ++ai) {
            float gate[4];
#pragma unroll
            for (int m = 0; m < 4; ++m) { const i32x2_ t_ = *(const LAS i32x2_*)(infl + (ai * 128 + wr * 64 + m * 16 + fr) * 8); gate[m] = __int_as_float(t_.y) * (16.0f * 0.03125f); }
#pragma unroll
            for (int bj = 0; bj < 2; ++bj) {
#pragma unroll
                for (int m = 0; m < 4; ++m)
#pragma unroll
                    for (int n = 0; n < 2; ++n) {
                        const f32x4 y = (acc[ai][bj][m][n] + bd[bj][n] * 32.0f) * gate[m];
                        const int rl = wr * 64 + m * 16 + fr, chunk = (wc * 2 + n) ^ (rl & 7);
                        *(LAS uint32_t*)(stg + rl * 128 + chunk * 16 + fq * 4) = pk4_fp8(y[0], y[1], y[2], y[3]);
                    }
                __syncthreads();
#pragma unroll
                for (int t = 0; t < 2; ++t) {
                    const int idx = t * NTHREADS + tid_e, rl = idx >> 3, ch = idx & 7;
                    const i32x2_ inf = *(const LAS i32x2_*)(infl + (ai * 128 + rl) * 8);
                    const u32x4 v4 = *(const LAS u32x4*)(stg + rl * 128 + ((ch ^ (rl & 7)) * 16));
                    const int ix = inf.x;
                    if (ix >= 0) {
                        const int rank = ix >> 16;
                        unsigned char* yb = (unsigned char*)(rank == 0 ? p.y0() : rank == 1 ? p.y1() : (rank == 2 ? p.y2() : p.y3()));
                        *(u32x4*)(yb + (size_t)(ix & 0xffff) * D + nt * 256 + bj * 128 + ch * 16) = v4;
                    }
                }
                __syncthreads();
            }
        }
    };
    gemm8_stream<false>(lds, vbU, jobfn, pre, epi);
}

__device__ __forceinline__ void ph_final(const P& p, unsigned char* lds) {
    const int tid = tid_(), lane = tid & 63, wid = tid >> 6;
    const int gw = blockIdx.x * 8 + wid, nw = gridDim.x * 8;
    for (int tok = gw; tok < NTOK; tok += nw) {
        float* dst = p.out + (size_t)tok * D;
        f32x4 v[4];
#pragma unroll
        for (int i = 0; i < 4; ++i) {
            const uint2 w = *(const uint2*)(p.h1b() + (size_t)tok * D + lane * 4 + 256 * i);
            v[i][0] = __uint_as_float(w.x << 16); v[i][1] = __uint_as_float(w.x & 0xffff0000u); v[i][2] = __uint_as_float(w.y << 16); v[i][3] = __uint_as_float(w.y & 0xffff0000u);
        }
#pragma unroll
        for (int j = 0; j < 4; ++j) {
            const unsigned char* yr = (const unsigned char*)(j == 0 ? p.y0() : j == 1 ? p.y1() : j == 2 ? p.y2() : p.y3()) + (size_t)tok * D;
#pragma unroll
            for (int i = 0; i < 4; ++i) {
                const int w = *(const int*)(yr + lane * 4 + 256 * i);
                const f32x2 lo = __builtin_amdgcn_cvt_pk_f32_fp8(w, false), hi = __builtin_amdgcn_cvt_pk_f32_fp8(w, true);
                v[i][0] += lo[0] * 0.0625f; v[i][1] += lo[1] * 0.0625f; v[i][2] += hi[0] * 0.0625f; v[i][3] += hi[1] * 0.0625f;
            }
        }
        float ss = 0.f;
#pragma unroll
        for (int i = 0; i < 4; ++i) ss += v[i][0] * v[i][0] + v[i][1] * v[i][1] + v[i][2] * v[i][2] + v[i][3] * v[i][3];
        ss = wave_sum(ss);
        const float rs = rsqrtf(ss * (1.0f / D) + EPS);
#pragma unroll
        for (int i = 0; i < 4; ++i) {
            const f32x4 g = *(const f32x4*)(p.final_g + lane * 4 + 256 * i);
            *(f32x4*)(dst + lane * 4 + 256 * i) = v[i] * rs * g;
        }
    }
}

typedef const __attribute__((address_space(4))) P* PK;
#define PHASE(call) do { PK q_ = pk; asm volatile("" : "+s"(q_)); const P& p = *(const P*)q_; call; } while (0)
__global__ void __launch_bounds__(NTHREADS) k_mega(P p_unused) {
    __shared__ __attribute__((aligned(16))) unsigned char lds[LDS_BYTES];
    cg::grid_group grid = cg::this_grid();
    const PK pk = (PK)__builtin_amdgcn_kernarg_segment_ptr();
    if (tid_() < 4) ((unsigned*)(lds + LDS_BYTES - 32))[tid_()] = 0u;
    __syncthreads();
    XcdBarrier xb;
    PHASE(xb = xcd_barrier_post((unsigned*)(p.ws + OFF_BAR), (volatile LAS unsigned*)(lds + LDS_BYTES - 32)));
    PHASE(if (p.ws == nullptr) grid.sync());
    PHASE(ph_prep(p, lds)); xcd_barrier(xb);
    PHASE(ph_inproj(p, lds)); xcd_barrier(xb);
    PHASE(ph_mixer<0>(p, lds)); xcd_barrier(xb);
    PHASE(ph_mixer<1>(p, lds)); xcd_barrier(xb);
    PHASE(ph_mixer<2>(p, lds)); xcd_barrier(xb);
    PHASE(ph_mix(p, lds)); xcd_barrier(xb);
    PHASE(ph_out(p, lds)); xcd_barrier(xb);
    PHASE(ph_route(p, lds)); xcd_barrier(xb);
    PHASE(ph_fill(p, lds)); xcd_barrier(xb);
    PHASE(ph_moe1(p, lds)); xcd_barrier(xb);
    PHASE(ph_moe2(p, lds)); xcd_barrier(xb);
    PHASE(ph_final(p, lds));
}

extern "C" void kernel_launch(void* const* d_in, const int* in_sizes, int n_in, void* d_out, int out_size, void* d_ws, size_t ws_size,
                              hipStream_t stream) {
    P p{};
    p.x = (const float*)d_in[0]; p.meta = (const float*)d_in[1]; p.attn_g = (const float*)d_in[2]; p.w_in = (const float*)d_in[3];
    p.hgrn_g = (const float*)d_in[4]; p.w_ua = (const float*)d_in[5]; p.w_uh = (const float*)d_in[6]; p.w_out = (const float*)d_in[7];
    p.lb_logits = (const float*)d_in[8]; p.ffn_g = (const float*)d_in[9]; p.router_w = (const float*)d_in[10]; p.router_b = (const float*)d_in[11];
    p.w_gate = (const float*)d_in[12]; p.b_gate = (const float*)d_in[13]; p.w_up = (const float*)d_in[14]; p.b_up = (const float*)d_in[15];
    p.w_down = (const float*)d_in[16]; p.b_down = (const float*)d_in[17]; p.final_g = (const float*)d_in[18];
    p.out = (float*)d_out;
    p.ws = (unsigned char*)d_ws;
    if (WS_NEED > ws_size) { fprintf(stderr, "workspace too small: need %zu have %zu\n", (size_t)WS_NEED, ws_size); return; }
    static int grid_blocks = 0;
    if (!grid_blocks) {
        int dev = 0, cus = 0, per_cu = 0;
        hipGetDevice(&dev);
        hipDeviceGetAttribute(&cus, hipDeviceAttributeMultiprocessorCount, dev);
        hipOccupancyMaxActiveBlocksPerMultiprocessor(&per_cu, k_mega, NTHREADS, 0);
        if (per_cu > 1) per_cu = 1;
        grid_blocks = cus * per_cu;
    }
    hipMemsetAsync(p.ws + OFF_BAR, 0, XCD_BAR_WORDS * 4, stream);
    void* args[] = {&p};
    hipError_t e = hipLaunchCooperativeKernel((void*)k_mega, dim3(grid_blocks), dim3(NTHREADS), args, 0, stream);
    if (e != hipSuccess) fprintf(stderr, "cooperative launch failed: %s (grid %d)\n", hipGetErrorString(e), grid_blocks);
}
```

```cpp
#include <hip/hip_runtime.h>
#include <hip/hip_cooperative_groups.h>
#include <stdint.h>
#include <cstdio>
namespace cg = cooperative_groups;

#ifndef MEGA
#define MEGA 1
#endif

typedef unsigned short bf16_t;
typedef short bf16x8 __attribute__((ext_vector_type(8)));
typedef float f32x4 __attribute__((ext_vector_type(4)));

constexpr int D = 1024, NB = 4, SEQ = 8192, NMETA = 16, L = SEQ + NMETA  , LP = 8320, T = NB * LP  ;
constexpr int NTOK = NB * SEQ;
constexpr int IN_COLS = 5160;
constexpr int NE = 32, TOPK = 4, DFF = 1024;
constexpr int CAP_BLOCKS = (NTOK * TOPK) / 256 + NE;
constexpr int CAP = CAP_BLOCKS * 256;
constexpr float EPS = 1e-5f;
constexpr int NTHREADS = 512;
constexpr int LDS_BYTES = 155648;
constexpr int NVC = 5376;
#define LAS __attribute__((address_space(3)))

typedef __bf16 hwbf16x2 __attribute__((ext_vector_type(2)));
typedef float f32x2 __attribute__((ext_vector_type(2)));
__device__ __forceinline__ uint32_t pack2(float a, float b) { const f32x2 v = {a, b}; return __builtin_bit_cast(uint32_t, __builtin_convertvector(v, hwbf16x2)); }
__device__ __forceinline__ bf16_t f2bf(float f) { return (bf16_t)(pack2(f, 0.f) & 0xffffu); }
__device__ __forceinline__ float bf2f(bf16_t h) { return __uint_as_float(((uint32_t)h) << 16); }
__device__ __forceinline__ uint32_t pk4_fp8(float a, float b, float c, float d) {
    a = fminf(fmaxf(a, -448.f), 448.f); b = fminf(fmaxf(b, -448.f), 448.f); c = fminf(fmaxf(c, -448.f), 448.f); d = fminf(fmaxf(d, -448.f), 448.f);
    int w = __builtin_amdgcn_cvt_pk_fp8_f32(a, b, 0, false); w = __builtin_amdgcn_cvt_pk_fp8_f32(c, d, w, true); return (uint32_t)w;
}
__device__ __forceinline__ float sigmoidf_(float x) { return __builtin_amdgcn_rcpf(1.0f + __builtin_amdgcn_exp2f(-1.4426950408889634f * x)); }
template <int CTRL, int RM = 0xf, bool BC = true>
__device__ __forceinline__ int dpp_mov(int v) { return __builtin_amdgcn_update_dpp(0, v, CTRL, RM, 0xf, BC); }
template <int O> __device__ __forceinline__ int lane_xor_i(int v) {
    if (O == 1) return dpp_mov<0xB1>(v);
    if (O == 2) return dpp_mov<0x4E>(v);
    if (O == 4) return dpp_mov<0x1B>(dpp_mov<0x141>(v));
    if (O == 8) return dpp_mov<0x128>(v);
    const int lane = (int)__builtin_amdgcn_mbcnt_hi(~0u, __builtin_amdgcn_mbcnt_lo(~0u, 0u));
    if (O == 16) { const auto r = __builtin_amdgcn_permlane16_swap((unsigned)v, (unsigned)v, false, false); return (lane & 16) ? (int)r[0] : (int)r[1]; }
    const auto r = __builtin_amdgcn_permlane32_swap((unsigned)v, (unsigned)v, false, false); return (lane & 32) ? (int)r[0] : (int)r[1];
}
template <int O> __device__ __forceinline__ float lane_xor_f(float v) { return __int_as_float(lane_xor_i<O>(__float_as_int(v))); }
__device__ __forceinline__ float xsum16(float v) { const auto r = __builtin_amdgcn_permlane16_swap(__float_as_uint(v), __float_as_uint(v), false, false); return __uint_as_float(r[0]) + __uint_as_float(r[1]); }
__device__ __forceinline__ float xsum32(float v) { const auto r = __builtin_amdgcn_permlane32_swap(__float_as_uint(v), __float_as_uint(v), false, false); return __uint_as_float(r[0]) + __uint_as_float(r[1]); }
__device__ __forceinline__ float xmax16(float v) { const auto r = __builtin_amdgcn_permlane16_swap(__float_as_uint(v), __float_as_uint(v), false, false); return fmaxf(__uint_as_float(r[0]), __uint_as_float(r[1])); }
__device__ __forceinline__ float xmax32(float v) { const auto r = __builtin_amdgcn_permlane32_swap(__float_as_uint(v), __float_as_uint(v), false, false); return fmaxf(__uint_as_float(r[0]), __uint_as_float(r[1])); }
__device__ __forceinline__ float xmin16(float v) { const auto r = __builtin_amdgcn_permlane16_swap(__float_as_uint(v), __float_as_uint(v), false, false); return fminf(__uint_as_float(r[0]), __uint_as_float(r[1])); }
__device__ __forceinline__ int wave_incl_scan(int x) {
    x += dpp_mov<0x111>(x); x += dpp_mov<0x112>(x); x += dpp_mov<0x114>(x); x += dpp_mov<0x118>(x);
    x += dpp_mov<0x142, 0xa, false>(x);
    x += dpp_mov<0x143, 0xc, false>(x);
    return x;
}
__device__ __forceinline__ float readlane_f(float v, int l) { return __int_as_float(__builtin_amdgcn_readlane(__float_as_int(v), l)); }
__device__ __forceinline__ float wave_sum(float v) {
#pragma unroll
    for (int o = 32; o >= 1; o >>= 1) v += __shfl_xor(v, o);
    return v;
}
__device__ __forceinline__ float wave_max(float v) {
#pragma unroll
    for (int o = 32; o >= 1; o >>= 1) v = fmaxf(v, __shfl_xor(v, o));
    return v;
}

constexpr size_t al256(size_t x) { return (x + 255) & ~(size_t)255; }
constexpr size_t TT = (size_t)T;
constexpr size_t MB1 = 1024 * 1024;
constexpr size_t WE8_B = (size_t)NE * 1024 * 1024;
constexpr size_t OFF_WGT = 0, OFF_WUT = WE8_B, OFF_WDT = 2 * WE8_B, OFF_XN2 = 3 * WE8_B, OFF_ACT = OFF_XN2 + (size_t)NTOK * D,
                 OFF_Y1 = OFF_ACT + (size_t)CAP * DFF, OFF_Y2 = OFF_Y1 + (size_t)NTOK * D, OFF_Y3 = OFF_Y2 + (size_t)NTOK * D,
                 OFF_H1B = OFF_Y3 + (size_t)NTOK * D,
                 OFF_S2_END = OFF_H1B + (size_t)NTOK * D * 2;
constexpr size_t OFF_WIN = 0, OFF_WUA = OFF_WIN + (size_t)NVC * 1024 * 2, OFF_WUH = OFF_WUA + MB1, OFF_WO = OFF_WUH + MB1, OFF_XN = OFF_WO + 2 * MB1,
                 OFF_Q = OFF_XN + TT * 2048, OFF_K = OFF_Q + TT * 1024, OFF_V = OFF_K + TT * 256, OFF_IQ = OFF_V + TT * 256, OFF_IK = OFF_IQ + TT * 512,
                 OFF_IW = OFF_IK + TT * 64, OFF_HQ = OFF_IW + TT * 32, OFF_HF = OFF_HQ + TT * 1024, OFF_HI = OFF_HF + TT * 1024, OFF_HG = OFF_HI + TT * 1024,
                 OFF_GA = OFF_HG + TT * 1024, OFF_GH = OFF_GA + TT * 2048, OFF_ATT = OFF_GH + TT * 2048, OFF_HGR = OFF_ATT + TT * 1024,
                 OFF_S1_END = OFF_HGR + TT * 1024;
static_assert(2 * WE8_B >= (size_t)NTOK * D * 2, "y0 does not fit over the gate/up weights");
constexpr size_t OFF_MIX = OFF_XN;
static_assert(OFF_H1B >= OFF_GA, "h1b (written by ph_out) must lie in stage-1 buffers that are dead by then");
constexpr size_t OFF_TAB = OFF_S1_END > OFF_S2_END ? OFF_S1_END : OFF_S2_END;
constexpr size_t OFF_ROPE = OFF_TAB, OFF_LB = OFF_ROPE + al256((size_t)LP * 24 * 4), OFF_CTR = OFF_LB + al256(512 * 4),
                 OFF_BEXP = OFF_CTR + al256(128 * 4), OFF_SLOT = OFF_BEXP + al256((size_t)CAP_BLOCKS * 4), OFF_SRANK = OFF_SLOT + al256((size_t)CAP * 4),
                 OFF_SGATE = OFF_SRANK + al256((size_t)CAP * 4), OFF_TEXP = OFF_SGATE + al256((size_t)CAP * 4), OFF_TGATE = OFF_TEXP + al256((size_t)NTOK * 16),
                 OFF_BAR = OFF_TGATE + al256((size_t)NTOK * 16), OFF_WGC = OFF_BAR + al256(3456 * 4), OFF_SINFO = OFF_WGC + al256(256 * 32 * 4), WS_NEED = OFF_SINFO + al256((size_t)CAP * 8);


__device__ __forceinline__ int tid_() { int t = threadIdx.x; asm volatile("" : "+v"(t)); return t; }

struct P {
    const float *x, *meta, *attn_g, *w_in, *hgrn_g, *w_ua, *w_uh, *w_out, *lb_logits, *ffn_g, *router_w, *router_b,
        *w_gate, *b_gate, *w_up, *b_up, *w_down, *b_down, *final_g;
    float* out;
    unsigned char* ws;
#define WSF(type, name, off) __device__ __forceinline__ type* name() const { return (type*)(ws + (off)); }
    WSF(bf16_t, xn, OFF_XN) WSF(unsigned char, xn8, OFF_ATT) WSF(unsigned char, winT8, OFF_WIN) WSF(bf16_t, winTb, OFF_WIN + 6 * MB1) WSF(bf16_t, q, OFF_Q) WSF(bf16_t, k, OFF_K) WSF(unsigned char, q8, OFF_Q) WSF(unsigned char, k8, OFF_K) WSF(unsigned char, v8, OFF_V)        WSF(bf16_t, v, OFF_V) WSF(bf16_t, iq, OFF_IQ) WSF(bf16_t, ik, OFF_IK)
    WSF(bf16_t, hq, OFF_HQ) WSF(bf16_t, hf, OFF_HF) WSF(bf16_t, hi, OFF_HI) WSF(bf16_t, hg, OFF_HG) WSF(unsigned char, ga, OFF_GA) WSF(unsigned char, gh, OFF_GH)
    WSF(bf16_t, att, OFF_ATT) WSF(bf16_t, hgr, OFF_HGR) WSF(bf16_t, mix, OFF_MIX) WSF(unsigned char, xn2, OFF_XN2) WSF(unsigned char, act, OFF_ACT)
    WSF(bf16_t, h1b, OFF_H1B) WSF(bf16_t, y0, OFF_WGT) WSF(bf16_t, y1, OFF_Y1) WSF(bf16_t, y2, OFF_Y2) WSF(bf16_t, y3, OFF_Y3)
    WSF(bf16_t, winT, OFF_WIN) WSF(bf16_t, wuaT, OFF_WUA) WSF(bf16_t, wuhT, OFF_WUH) WSF(bf16_t, woT, OFF_WO)
    WSF(unsigned char, wgT, OFF_WGT) WSF(unsigned char, wuT, OFF_WUT) WSF(unsigned char, wdT, OFF_WDT)
    WSF(float, iw, OFF_IW) WSF(float, rope, OFF_ROPE) WSF(float, lb, OFF_LB) WSF(float, tok_gate, OFF_TGATE) WSF(float, slot_gate, OFF_SGATE)
    WSF(int, ctr, OFF_CTR)
    WSF(int, wg_cnt, OFF_WGC) WSF(int2, slot_info, OFF_SINFO) WSF(int, block_expert, OFF_BEXP) WSF(int, slot_token, OFF_SLOT) WSF(int, slot_rank, OFF_SRANK) WSF(int, tok_exp, OFF_TEXP)
};

template <class ColMap>
__device__ __forceinline__ void convert_T8(const float* W, int ldw, unsigned char* out, int K, int N, const ColMap& cmap, float scale, int gt, int ntot) {
    const int kb = K / 64; const long ntask = (long)N * kb;
    for (long task = gt; task < ntask; task += ntot) {
        const int kq = (int)(task / N), n = (int)(task % N);
        const int c = cmap(n);
        uint32_t w[16];
        if (c >= 0) {
            const float* src = W + (size_t)(kq * 64) * ldw + c;
            float v[64];
#pragma unroll
            for (int i = 0; i < 64; ++i) v[i] = src[(size_t)i * ldw] * scale;
#pragma unroll
            for (int i = 0; i < 16; ++i) w[i] = pk4_fp8(v[4 * i], v[4 * i + 1], v[4 * i + 2], v[4 * i + 3]);
        } else {
#pragma unroll
            for (int i = 0; i < 16; ++i) w[i] = 0u;
        }
        uint4* dst = (uint4*)(out + (size_t)n * K + kq * 64);
#pragma unroll
        for (int i = 0; i < 4; ++i) dst[i] = make_uint4(w[4 * i], w[4 * i + 1], w[4 * i + 2], w[4 * i + 3]);
    }
}
template <class ColMap>
__device__ __forceinline__ void convert_T(const float* W, int ldw, bf16_t* out, int K, int N, const ColMap& cmap, int gt, int ntot) {
    const int kb = K / 64; const long ntask = (long)N * kb;
    for (long task = gt; task < ntask; task += ntot) {
        const int kq = (int)(task / N), n = (int)(task % N);
        const int c = cmap(n);
        uint32_t w[32];
        if (c >= 0) {
            const float* src = W + (size_t)(kq * 64) * ldw + c;
            float v[64];
#pragma unroll
            for (int i = 0; i < 64; ++i) v[i] = src[(size_t)i * ldw];
#pragma unroll
            for (int i = 0; i < 32; ++i) w[i] = pack2(v[2 * i], v[2 * i + 1]);
        } else {
#pragma unroll
            for (int i = 0; i < 32; ++i) w[i] = 0u;
        }
        uint4* dst = (uint4*)(out + (size_t)n * K + kq * 64);
#pragma unroll
        for (int i = 0; i < 8; ++i) dst[i] = make_uint4(w[4 * i], w[4 * i + 1], w[4 * i + 2], w[4 * i + 3]);
    }
}
struct IdMap { __device__ __forceinline__ int operator()(int n) const { return n; } };
struct WinMap { __device__ __forceinline__ int operator()(int n) const { return n < 1064 ? n : (n < 1280 ? -1 : n - 216); } };
struct WinMapIdx { __device__ __forceinline__ int operator()(int n) const { return WinMap{}(768 + n); } };

#define XB_TMO      128
#define XB_XCNT(j)  (256  + 64 * (j))
#define XB_XSUB(j)  (1280 + 64 * (j))
#define XB_XGEN(j)  (2304 + 64 * (j))
#define XB_TOP      3328
#define XB_TOPGEN   3392
#define XCD_BAR_WORDS 3456
#define XB_SPIN_CAP (1u << 22)
__device__ __forceinline__ unsigned xb_ld(unsigned* p)              { return __hip_atomic_load(p, __ATOMIC_RELAXED, __HIP_MEMORY_SCOPE_AGENT); }
__device__ __forceinline__ unsigned xb_add(unsigned* p, unsigned v) { return __hip_atomic_fetch_add(p, v, __ATOMIC_RELAXED, __HIP_MEMORY_SCOPE_AGENT); }
__device__ __forceinline__ unsigned xb_xcc_id() { return (unsigned)__builtin_amdgcn_s_getreg((3 << 11) | 20) & 0xFu; }
#define XB_SPIN(cond, bar) do { unsigned _sp = 0; while (cond) { __builtin_amdgcn_s_sleep(1); \
    if ((++_sp & 255u) == 0u) { if (xb_ld(&(bar)[XB_TMO])) break; if (_sp > XB_SPIN_CAP) { atomicAdd(&(bar)[XB_TMO], 1u); break; } } } } while (0)
struct XcdBarrier { unsigned* bar; unsigned x; volatile LAS unsigned* st; };
__device__ __forceinline__ XcdBarrier xcd_barrier_post(unsigned* bar, volatile LAS unsigned* st) {
    XcdBarrier b; b.bar = bar; b.x = xb_xcc_id(); b.st = st;
    if (threadIdx.x == 0) (void)xb_add(&bar[XB_XCNT(b.x)], 1u);
    return b;
}
__device__ __forceinline__ void xcd_barrier_complete(unsigned* bar, unsigned x, unsigned& nloc, unsigned& nx) {
    const unsigned G = gridDim.x * gridDim.y * gridDim.z;
    unsigned sum, cnt, mine, sp = 0u;
    for (;;) {
        sum = 0u; cnt = 0u; mine = 0u;
#pragma unroll
        for (unsigned j = 0; j < 16; ++j) { const unsigned c = xb_ld(&bar[XB_XCNT(j)]); sum += c; cnt += (c > 0u) ? 1u : 0u; mine = (j == x) ? c : mine; }
        if (sum == G) break;
        __builtin_amdgcn_s_sleep(1);
        if ((++sp & 255u) == 0u) { if (xb_ld(&bar[XB_TMO])) break; if (sp > XB_SPIN_CAP) { atomicAdd(&bar[XB_TMO], 1u); break; } }
    }
    nloc = mine > 0u ? mine : 1u; nx = cnt > 0u ? cnt : 1u;
}
__device__ __forceinline__ void xcd_barrier(const XcdBarrier& b) {
    asm volatile("s_waitcnt vmcnt(0)" ::: "memory");
    __syncthreads();
    if (threadIdx.x == 0) {
        unsigned* bar = b.bar;
        __builtin_amdgcn_s_waitcnt(0);
        unsigned nloc = b.st[0], nx = b.st[1];
        if (nloc == 0u) { xcd_barrier_complete(bar, b.x, nloc, nx); b.st[0] = nloc; b.st[1] = nx; }
        const unsigned old = xb_add(&bar[XB_XSUB(b.x)], 1u);
        const unsigned gen = old / nloc;
        if (old + 1u == (gen + 1u) * nloc) {
            __builtin_amdgcn_fence(__ATOMIC_RELEASE, "agent");
            asm volatile("s_waitcnt vmcnt(0)" ::: "memory");
            const unsigned og = xb_add(&bar[XB_TOP], 1u);
            const unsigned tg = og / nx;
            if (og + 1u == (tg + 1u) * nx) xb_add(&bar[XB_TOPGEN], 1u);
            else XB_SPIN(xb_ld(&bar[XB_TOPGEN]) == tg, bar);
            __builtin_amdgcn_fence(__ATOMIC_ACQUIRE, "agent");
            xb_add(&bar[XB_XGEN(b.x)], 1u);
            asm volatile("s_waitcnt vmcnt(0)" ::: "memory");
        } else {
            XB_SPIN(xb_ld(&bar[XB_XGEN(b.x)]) == gen, bar);
            __builtin_amdgcn_fence(__ATOMIC_ACQUIRE, "agent");
            asm volatile("s_waitcnt vmcnt(0)" ::: "memory");
        }
    }
    __syncthreads();
}

__device__ __forceinline__ void ph_prep(const P& p, unsigned char* lds) {
    const int tid = tid_(), lane = tid & 63, wid = tid >> 6;
    const int gw = blockIdx.x * 8 + wid, nw = gridDim.x * 8;
    for (int r = gw; r < T; r += nw) {
        const int b = r / LP, pos = r % LP;
        unsigned char* dst = p.xn8() + (size_t)r * D; bf16_t* dstb = p.xn() + (size_t)r * D;
        if (pos >= L) {
#pragma unroll
            for (int i = 0; i < 4; ++i) { *(uint32_t*)(dst + lane * 4 + 256 * i) = 0u; *(uint2*)(dstb + lane * 4 + 256 * i) = make_uint2(0u, 0u); }
            continue;
        }
        const float* src = pos < NMETA ? p.meta + (size_t)pos * D : p.x + ((size_t)b * SEQ + (pos - NMETA)) * D;
        f32x4 v[4]; float ss = 0.f;
#pragma unroll
        for (int i = 0; i < 4; ++i) { v[i] = *(const f32x4*)(src + lane * 4 + 256 * i); ss += v[i][0] * v[i][0] + v[i][1] * v[i][1] + v[i][2] * v[i][2] + v[i][3] * v[i][3]; }
        ss = wave_sum(ss);
        const float rs = rsqrtf(ss * (1.0f / D) + EPS);
#pragma unroll
        for (int i = 0; i < 4; ++i) {
            const f32x4 g = *(const f32x4*)(p.attn_g + lane * 4 + 256 * i);
            const float y0 = v[i][0] * rs * g[0], y1 = v[i][1] * rs * g[1], y2 = v[i][2] * rs * g[2], y3 = v[i][3] * rs * g[3];
            *(uint32_t*)(dst + lane * 4 + 256 * i) = pk4_fp8(y0, y1, y2, y3);
            uint2 o; o.x = pack2(y0, y1); o.y = pack2(y2, y3);
            *(uint2*)(dstb + lane * 4 + 256 * i) = o;
        }
    }
    const int gt = blockIdx.x * NTHREADS + tid, nt = gridDim.x * NTHREADS;
    for (int i = gt; i < LP * 12; i += nt) {
        const int pos = i / 12, f = i % 12;
        const double ex = f < 8 ? -(double)f / 8.0 : -(double)(f - 8) / 4.0;
        const double inv = exp(ex * log(500000.0));
        const double ang = (double)pos * inv;
        const double twopi = 6.283185307179586476925286766559;
        const double r = ang - twopi * rint(ang / twopi);
        const float rf = (float)r;
        const float c = cosf(rf), s = sinf(rf);
        float* row = p.rope() + (size_t)pos * 24;
        if (f < 8) { row[f] = c; row[8 + f] = s; } else { row[16 + f - 8] = c; row[20 + f - 8] = s; }
    }
    for (int i = gt; i < 512; i += nt) {
        const float a = p.lb_logits[i], b2 = p.lb_logits[512 + i];
        p.lb()[i] = 1.0f / (1.0f + expf(b2 - a));
    }
    for (int i = gt; i < 128; i += nt) p.ctr()[i] = 0;
    convert_T8(p.w_in, IN_COLS, p.winT8(), 1024, NVC, WinMap{}, 32.0f, gt, nt);
    convert_T(p.w_in, IN_COLS, p.winTb(), 1024, 512, WinMapIdx{}, gt, nt);
    convert_T(p.w_ua, 1024, p.wuaT(), 512, 1024, IdMap{}, gt, nt);
    convert_T(p.w_uh, 1024, p.wuhT(), 512, 1024, IdMap{}, gt, nt);
    convert_T(p.w_out, 1024, p.woT(), 1024, 1024, IdMap{}, gt, nt);
}
constexpr int G_TILE_B = 256 * 64 * 2, G_STAGE_B = 2 * G_TILE_B;
__device__ __forceinline__ int g_lds_byte(int r, int c) { const int st = (r >> 4) * 2 + (c >> 5), ob = (r & 15) * 64 + (c & 31) * 2; return st * 1024 + (ob ^ (((ob >> 9) & 1) << 5)); }
__device__ __forceinline__ void g_stage_rc(int b, int& R, int& C) { const int st = b >> 10, sb = b & 1023, swz = sb ^ (((sb >> 9) & 1) << 5); R = (st >> 1) * 16 + swz / 64; C = (st & 1) * 32 + (swz % 64) / 2; }

constexpr int HTB = 128 * 64 * 2;
struct GJob { const char* A; const char* B; unsigned va00, va01, va10, va11; };
__device__ __forceinline__ void gj_lin(unsigned (&v)[2][2], int ld) {
#pragma unroll
    for (int h = 0; h < 2; ++h)
#pragma unroll
        for (int i = 0; i < 2; ++i) { int R, C; g_stage_rc(tid_() * 16 + i * 8192, R, C); v[h][i] = (unsigned)(((h * 128 + R) * ld + C) * 2); }
}
template <class AOff>
__device__ __forceinline__ void gj_gather(unsigned (&v)[2][2], const AOff& aoff) {
#pragma unroll
    for (int h = 0; h < 2; ++h)
#pragma unroll
        for (int i = 0; i < 2; ++i) { int R, C; g_stage_rc(tid_() * 16 + i * 8192, R, C); v[h][i] = (unsigned)((aoff(h * 128 + R) + C) * 2); }
}
template <class AOff>
__device__ __forceinline__ void gj_gather_job(GJob& j, const AOff& aoff) {
    unsigned v[2][2]; gj_gather(v, aoff); j.va00 = v[0][0]; j.va01 = v[0][1]; j.va10 = v[1][0]; j.va11 = v[1][1];
}
template <bool GATHER, class JobFn, class Epi>
__device__ __forceinline__ void gemm_stream(unsigned char* lds_, int K, int lda, size_t hstepB, const unsigned (&vbU)[2], const JobFn& jobfn, const Epi& epi) {
    LAS unsigned char* lds = (LAS unsigned char*)lds_;
    const int tid = tid_(), wid = __builtin_amdgcn_readfirstlane(tid >> 6), lane = tid & 63, wr = wid >> 2, wc = wid & 3, fr = lane & 15, fq = lane >> 4;
    const int nt = K / 64;
    const size_t kstep = 128;
    const size_t hstepA = GATHER ? 0 : (size_t)128 * lda * 2;
    const unsigned ldsw = (unsigned)wid * 1024u;
    const int aoff = g_lds_byte(wr * 64 + fr, fq * 8), boff = g_lds_byte(wc * 32 + fr, fq * 8);
    unsigned vaU[2];
#pragma unroll
    for (int i = 0; i < 2; ++i) { int R, C; g_stage_rc(tid * 16 + i * 8192, R, C); vaU[i] = (unsigned)((R * lda + C) * 2); }
#define PG8_SA(b, h) (((b) * 2 + (h)) * HTB)
#define PG8_SB(b, h) ((4 + (b) * 2 + (h)) * HTB)
#define PG8_STAGE2(bufoff, gbase, v0, v1) do { \
        __builtin_amdgcn_global_load_lds((const unsigned*)((const char*)(gbase) + (v0)), (LAS unsigned*)(lds + (bufoff) + ldsw), 16, 0, 0); \
        __builtin_amdgcn_global_load_lds((const unsigned*)((const char*)(gbase) + (v1)), (LAS unsigned*)(lds + (bufoff) + ldsw + 8192), 16, 0, 0); } while (0)
#define STB(bufoff, gbase, h) PG8_STAGE2(bufoff, (gbase) + ((h) ? hstepB : 0), vbU[0], vbU[1])
#define STA_CUR(bufoff, gbase, h) do { if (GATHER) PG8_STAGE2(bufoff, gbase, (h) ? cur.va10 : cur.va00, (h) ? cur.va11 : cur.va01); else PG8_STAGE2(bufoff, (gbase) + ((h) ? hstepA : 0), vaU[0], vaU[1]); } while (0)
#define STA_SEL(bufoff, gbase, h) do { if (GATHER) PG8_STAGE2(bufoff, gbase, last ? ((h) ? nxt.va10 : nxt.va00) : ((h) ? cur.va10 : cur.va00), last ? ((h) ? nxt.va11 : nxt.va01) : ((h) ? cur.va11 : cur.va01)); \
        else PG8_STAGE2(bufoff, (gbase) + ((h) ? hstepA : 0), vaU[0], vaU[1]); } while (0)
#define PG8_LDA(dst, b, h) do { _Pragma("unroll") for (int m = 0; m < 4; ++m) _Pragma("unroll") for (int k = 0; k < 2; ++k) dst[m][k] = *(const LAS bf16x8*)(lds + PG8_SA(b, h) + aoff + m * 2048 + k * 1024); } while (0)
#define PG8_LDB(dst, b, h) do { _Pragma("unroll") for (int n = 0; n < 2; ++n) _Pragma("unroll") for (int k = 0; k < 2; ++k) dst[n][k] = *(const LAS bf16x8*)(lds + PG8_SB(b, h) + boff + n * 2048 + k * 1024); } while (0)
#define PG8_MMA(ai, bj, At, Bt) do { __builtin_amdgcn_s_setprio(1); _Pragma("unroll") for (int m = 0; m < 4; ++m) _Pragma("unroll") for (int n = 0; n < 2; ++n) _Pragma("unroll") for (int k = 0; k < 2; ++k) \
        acc[ai][bj][m][n] = __builtin_amdgcn_mfma_f32_16x16x32_bf16(Bt[n][k], At[m][k], acc[ai][bj][m][n], 0, 0, 0); __builtin_amdgcn_s_setprio(0); } while (0)
#define PG8_WAIT_V(n) asm volatile("s_waitcnt vmcnt(" #n ")" ::: "memory")
#define PG8_WAIT_L(n) asm volatile("s_waitcnt lgkmcnt(" #n ")" ::: "memory")
#define PG8_BAR __builtin_amdgcn_s_barrier()
#define PG8_SCHED __builtin_amdgcn_sched_barrier(0)
    GJob cur, nxt; int ui = 0;
    cur.A = nullptr; cur.B = nullptr; cur.va00 = cur.va01 = cur.va10 = cur.va11 = 0u; nxt = cur;
    if (!jobfn(0, cur)) return;
    f32x4 acc[2][2][4][2];
#pragma unroll
    for (int a = 0; a < 2; ++a)
#pragma unroll
        for (int b = 0; b < 2; ++b)
#pragma unroll
            for (int m = 0; m < 4; ++m)
#pragma unroll
                for (int n = 0; n < 2; ++n) acc[a][b][m][n] = (f32x4){0.f, 0.f, 0.f, 0.f};
    bf16x8 At[4][2], B0[2][2], B1[2][2];
    STB(PG8_SB(0, 0), cur.B, 0); STB(PG8_SB(0, 1), cur.B, 1); STA_CUR(PG8_SA(0, 0), cur.A, 0); STA_CUR(PG8_SA(0, 1), cur.A, 1);
    if (wr == 1) PG8_BAR;
    PG8_WAIT_V(2); PG8_BAR;
    STB(PG8_SB(1, 0), cur.B + kstep, 0); STA_CUR(PG8_SA(1, 0), cur.A + kstep, 0); STB(PG8_SB(1, 1), cur.B + kstep, 1);
    PG8_WAIT_V(6); PG8_BAR;
    for (;;) {
        bool has_next = false;
        for (int t = 0; t < nt; t += 2) {
            const bool last = (t == nt - 2);
            if (last) { has_next = jobfn(ui + 1, nxt); if (!has_next) nxt = cur; }
            const char* a1 = cur.A + (size_t)(t + 1) * kstep;
            const char* a2 = last ? nxt.A : cur.A + (size_t)(t + 2) * kstep; const char* b2 = last ? nxt.B : cur.B + (size_t)(t + 2) * kstep;
            const char* a3 = a2 + kstep; const char* b3 = b2 + kstep;
            PG8_LDB(B0, 0, 0); PG8_LDB(B1, 0, 1); PG8_SCHED; PG8_LDA(At, 0, 0); STA_CUR(PG8_SA(1, 1), a1, 1);
            PG8_WAIT_V(8); PG8_WAIT_L(0); PG8_BAR; PG8_MMA(0, 0, At, B0); PG8_MMA(0, 1, At, B1); PG8_BAR; PG8_SCHED;
            PG8_LDA(At, 0, 1); STB(PG8_SB(0, 0), b2, 0); STB(PG8_SB(0, 1), b2, 1); STA_SEL(PG8_SA(0, 0), a2, 0);
            PG8_WAIT_V(8); PG8_WAIT_L(0); PG8_BAR; PG8_MMA(1, 0, At, B0); PG8_MMA(1, 1, At, B1); PG8_BAR; PG8_SCHED;
            PG8_LDB(B0, 1, 0); PG8_LDB(B1, 1, 1); PG8_SCHED; PG8_LDA(At, 1, 0); STA_SEL(PG8_SA(0, 1), a2, 1);
            PG8_WAIT_V(8); PG8_WAIT_L(0); PG8_BAR; PG8_MMA(0, 0, At, B0); PG8_MMA(0, 1, At, B1); PG8_BAR; PG8_SCHED;
            PG8_LDA(At, 1, 1); STB(PG8_SB(1, 0), b3, 0); STB(PG8_SB(1, 1), b3, 1); STA_SEL(PG8_SA(1, 0), a3, 0);
            PG8_WAIT_V(8); PG8_WAIT_L(0); PG8_BAR; PG8_MMA(1, 0, At, B0); PG8_MMA(1, 1, At, B1); PG8_BAR; PG8_SCHED;
        }
        if (wr == 0) PG8_BAR;
        epi(acc, ui);
        if (!has_next) break;
#pragma unroll
        for (int a = 0; a < 2; ++a)
#pragma unroll
            for (int b = 0; b < 2; ++b)
#pragma unroll
                for (int m = 0; m < 4; ++m)
#pragma unroll
                    for (int n = 0; n < 2; ++n) acc[a][b][m][n] = (f32x4){0.f, 0.f, 0.f, 0.f};
        cur = nxt; ++ui;
        if (wr == 1) PG8_BAR;
    }
    PG8_WAIT_V(0);
    PG8_BAR;
#undef PG8_SA
#undef PG8_SB
#undef PG8_STAGE2
#undef STB
#undef STA_CUR
#undef STA_SEL
#undef PG8_LDA
#undef PG8_LDB
#undef PG8_MMA
#undef PG8_WAIT_V
#undef PG8_WAIT_L
#undef PG8_BAR
#undef PG8_SCHED
}
__device__ __forceinline__ void gj_lin2(unsigned (&v)[2], int ld) {
#pragma unroll
    for (int i = 0; i < 2; ++i) { int R, C; g_stage_rc(tid_() * 16 + i * 8192, R, C); v[i] = (unsigned)((R * ld + C) * 2); }
}
typedef int i32x8 __attribute__((ext_vector_type(8)));
typedef unsigned u32x4 __attribute__((ext_vector_type(4)));
struct G8Job { const char* A; const char* B; unsigned va0, va1, va2, va3; int aux; };
__device__ __forceinline__ void g8_rc(int i, int& R, int& Cb) { int C; g_stage_rc(tid_() * 16 + i * 8192, R, C); Cb = C * 2; }
__device__ __forceinline__ const char* uni_ptr8(const char* p) {
    const unsigned long long v = (unsigned long long)p;
    const unsigned lo = __builtin_amdgcn_readfirstlane((unsigned)v), hi = __builtin_amdgcn_readfirstlane((unsigned)(v >> 32));
    return (const char*)(((unsigned long long)hi << 32) | lo);
}
#define G8_PRE_DMA(gptr, voff, ldsaddr) asm volatile("s_mov_b32 m0, %2\n\ts_nop 0\n\tglobal_load_lds_dword %0, %1" :: "v"(voff), "s"(gptr), "s"(ldsaddr) : "memory", "m0")
template <bool GATHER, class JobFn, class Pre, class Epi>
__device__ __forceinline__ void gemm8_stream(unsigned char* lds_, const unsigned (&vbU)[4], const JobFn& jobfn, const Pre& pre, const Epi& epi) {
    LAS unsigned char* lds = (LAS unsigned char*)lds_;
    const int tid = tid_(), wid = __builtin_amdgcn_readfirstlane(tid >> 6), lane = tid & 63, wr = wid >> 2, wc = wid & 3, fr = lane & 15, fq = lane >> 4;
    LAS unsigned char* a0p = lds + g_lds_byte(wr * 64 + fr, fq * 8); LAS unsigned char* a1p = a0p + 65536;
    LAS unsigned char* b0p = lds + 32768 + g_lds_byte(wc * 32 + fr, fq * 8); LAS unsigned char* b1p = b0p + 65536;
    const unsigned ldsw_u = __builtin_amdgcn_readfirstlane((unsigned)(size_t)(lds + wid * 1024));
#define G8_GLDS(base, voff, ldsaddr) asm volatile("s_mov_b32 m0, %2\n\ts_nop 0\n\tglobal_load_lds_dwordx4 %0, %1" :: "v"(voff), "s"(base), "s"(ldsaddr) : "memory", "m0")
#define G8_DMA(JA, JB, v0, v1, v2, v3, buf, kt) do { \
        const char* pa_ = uni_ptr8(JA) + (kt) * 128; const char* pb_ = uni_ptr8(JB) + (kt) * 128; const unsigned d_ = ldsw_u + (buf) * 65536; \
        G8_GLDS(pa_, (GATHER ? v0 : vb0), d_); \
        G8_GLDS(pa_, (GATHER ? v1 : vb1), d_ + 8192); \
        G8_GLDS(pa_, (GATHER ? v2 : vb2), d_ + 16384); \
        G8_GLDS(pa_, (GATHER ? v3 : vb3), d_ + 24576); \
        G8_GLDS(pb_, vb0, d_ + 32768); \
        G8_GLDS(pb_, vb1, d_ + 32768 + 8192); \
        G8_GLDS(pb_, vb2, d_ + 32768 + 16384); \
        G8_GLDS(pb_, vb3, d_ + 32768 + 24576); } while (0)
#define G8_LD(dst, ptr) do { const u32x4 x0_ = *(const LAS u32x4*)(ptr), x1_ = *(const LAS u32x4*)((ptr) + 1024); \
        dst = (i32x8){(int)x0_.x, (int)x0_.y, (int)x0_.z, (int)x0_.w, (int)x1_.x, (int)x1_.y, (int)x1_.z, (int)x1_.w}; } while (0)
#define G8_LDA(dst, ap, ai, m0, m1) do { _Pragma("unroll") for (int m = m0; m < m1; ++m) G8_LD(dst[m], (ap) + (ai) * 16384 + m * 2048); } while (0)
#define G8_LDB(dst, bp, bj) do { _Pragma("unroll") for (int n = 0; n < 2; ++n) G8_LD(dst[n], (bp) + (bj) * 16384 + n * 2048); } while (0)
#define G8_MMA(ai, bj, At, Bt) do { __builtin_amdgcn_sched_barrier(0); __builtin_amdgcn_s_setprio(1); _Pragma("unroll") for (int m = 0; m < 4; ++m) _Pragma("unroll") for (int n = 0; n < 2; ++n) \
        asm("v_mfma_scale_f32_16x16x128_f8f6f4 %0, %1, %2, %0, %3, %3 op_sel_hi:[0,0,0]" : "+v"(acc[ai][bj][m][n]) : "v"(Bt[n]), "v"(At[m]), "v"(unit_scale)); \
        __builtin_amdgcn_s_setprio(0); __builtin_amdgcn_sched_barrier(0); } while (0)
#define G8_PF 2
#define G8_TILE(buf, ap, bp, apn, bpn, X, Y, kt) do { \
        G8_LDA(P, ap, 0, G8_PF, 4); G8_LDB(Y, bp, 1); G8_MMA(0, 0, P, X); \
        G8_LDA(Q, ap, 1, 0, 2);                       G8_MMA(0, 1, P, Y); \
        G8_LDA(Q, ap, 1, 2, 4);                       G8_MMA(1, 1, Q, Y); \
        asm volatile("" ::: "memory"); __builtin_amdgcn_s_waitcnt(0x0070); __builtin_amdgcn_s_barrier(); asm volatile("" ::: "memory"); \
        asm volatile("" : "+v"(vb0), "+v"(vb1), "+v"(vb2), "+v"(vb3), "+v"(cur.va0), "+v"(cur.va1), "+v"(cur.va2), "+v"(cur.va3)); \
        G8_DMA(selA, selB, cur.va0, cur.va1, cur.va2, cur.va3, buf, kt); \
        G8_LDA(P, apn, 0, 0, G8_PF); G8_LDB(Y, bpn, 0); \
        G8_MMA(1, 0, Q, X); } while (0)
    G8Job cur, nxt;
    cur.A = nullptr; cur.B = nullptr; cur.va0 = cur.va1 = cur.va2 = cur.va3 = 0u; cur.aux = 0; nxt = cur;
    if (!jobfn(0, cur)) return;
    cur.A = uni_ptr8(cur.A); cur.B = uni_ptr8(cur.B);
    unsigned vb0 = vbU[0], vb1 = vbU[1], vb2 = vbU[2], vb3 = vbU[3];
    G8_DMA(cur.A, cur.B, cur.va0, cur.va1, cur.va2, cur.va3, 0, 0); G8_DMA(cur.A, cur.B, cur.va0, cur.va1, cur.va2, cur.va3, 1, 1);
    asm volatile("s_waitcnt vmcnt(0)" ::: "memory");
    __syncthreads();
    int ui = 0;
    for (;;) {
        f32x4 acc[2][2][4][2];
#pragma unroll
        for (int a = 0; a < 2; ++a)
#pragma unroll
            for (int b = 0; b < 2; ++b)
#pragma unroll
                for (int m = 0; m < 4; ++m)
#pragma unroll
                    for (int n = 0; n < 2; ++n) acc[a][b][m][n] = (f32x4){0.f, 0.f, 0.f, 0.f};
        const bool has_next = jobfn(ui + 1, nxt);
        pre(ui, __builtin_amdgcn_readfirstlane(cur.aux));
        nxt.A = uni_ptr8(nxt.A); nxt.B = uni_ptr8(nxt.B);
        if (!has_next) nxt = cur;
        i32x8 P[4], Q[4], X[2], Y[2];
        const int unit_scale = 0x7f7f7f7f;
        G8_LDA(P, a0p, 0, 0, G8_PF); G8_LDB(X, b0p, 0);
#pragma unroll 1
        for (int t2 = 0; t2 < 4; ++t2) {
            const bool lastp = t2 == 3;
            const char* selA = lastp ? nxt.A : cur.A; const char* selB = lastp ? nxt.B : cur.B;
            if (GATHER) { cur.va0 = lastp ? nxt.va0 : cur.va0; cur.va1 = lastp ? nxt.va1 : cur.va1; cur.va2 = lastp ? nxt.va2 : cur.va2; cur.va3 = lastp ? nxt.va3 : cur.va3; }
            const int kt0 = lastp ? 0 : 2 * t2 + 2;
            asm volatile("" : "+v"(a0p), "+v"(a1p), "+v"(b0p), "+v"(b1p));
            G8_TILE(0, a0p, b0p, a1p, b1p, X, Y, kt0);
            G8_TILE(1, a1p, b1p, a0p, b0p, Y, X, kt0 + 1);
        }
        asm volatile("s_nop 15\n\ts_nop 15" ::: "memory");
        epi(acc, ui);
        if (!has_next) break;
        cur.A = nxt.A; cur.B = nxt.B; cur.aux = nxt.aux; ++ui;
    }
#undef G8_TILE
#undef G8_PF
#undef G8_MMA
#undef G8_LDB
#undef G8_LDA
#undef G8_LD
#undef G8_DMA
#undef G8_GLDS
    asm volatile("s_waitcnt vmcnt(0)" ::: "memory");
    __syncthreads();
}
struct RowLin { size_t base; int ld; __device__ __forceinline__ size_t operator()(int R) const { return base + (size_t)R * ld; } };

__device__ __forceinline__ void st_bf4(bf16_t* dst, f32x4 v) {
    uint2 o; o.x = pack2(v[0], v[1]); o.y = pack2(v[2], v[3]); *(uint2*)dst = o;
}
__device__ __forceinline__ int pair_col(int fq) { return 16 * (fq & 1) + 8 * (fq >> 1); }
__device__ __forceinline__ void st_bf4_pair(bf16_t* rowp_c0, int fq, const f32x4& v0, const f32x4& v1) {
    uint32_t ax = pack2(v0[0], v0[1]), ay = pack2(v0[2], v0[3]), bx = pack2(v1[0], v1[1]), by = pack2(v1[2], v1[3]);
    auto r = __builtin_amdgcn_permlane16_swap(ax, bx, false, false); ax = r[0]; bx = r[1];
    r = __builtin_amdgcn_permlane16_swap(ay, by, false, false); ay = r[0]; by = r[1];
    *(u32x4*)(rowp_c0 + pair_col(fq)) = (u32x4){ax, ay, bx, by};
}
#define EPI8(...) do { const int tid_e = tid_(), lane_e = tid_e & 63, wid_e = tid_e >> 6, wr = wid_e >> 2, wc = wid_e & 3, fr = lane_e & 15, fq = lane_e >> 4; \
    _Pragma("unroll") for (int ai = 0; ai < 2; ++ai) _Pragma("unroll") for (int m = 0; m < 4; ++m) _Pragma("unroll") for (int bj = 0; bj < 2; ++bj) _Pragma("unroll") for (int n = 0; n < 2; ++n) { \
        const int row = ai * 128 + wr * 64 + m * 16 + fr, col = bj * 128 + wc * 32 + n * 16 + fq * 4; const f32x4 v = acc[ai][bj][m][n]; __VA_ARGS__ } } while (0)

struct EpiInproj {
    const P* p; int nt;
    __device__ __forceinline__ f32x4 xf(int m, int n, int fq, f32x4 v) const {
        const P& P_ = *p;
        const int pos = m % LP;
        const float* rp = P_.rope() + (size_t)pos * 24;
        if (nt <= 2) {
            const bool isv = (nt == 2) && (n >= 128);
            if (!isv && (n & 48) == 0) {
                f32x4 pr;
#pragma unroll
                for (int j = 0; j < 4; ++j) pr[j] = __shfl_xor(v[j], 32);
                const int i0 = (fq & 1) * 4;
#pragma unroll
                for (int j = 0; j < 4; ++j) {
                    const float c = rp[i0 + j], s = rp[8 + i0 + j];
                    v[j] = fq < 2 ? v[j] * c - pr[j] * s : v[j] * c + pr[j] * s;
                }
            }
            return nt < 2 ? v * (0.125f * 1.4426950408889634f) : v;
        } else if (nt == 3 || nt == 4) {
            const bool ropeable = (nt == 3) ? ((n & 16) == 0) : (n < 16);
            if (ropeable) {
                f32x4 pr;
#pragma unroll
                for (int j = 0; j < 4; ++j) pr[j] = __shfl_xor(v[j], 16);
                if (fq < 2) {
#pragma unroll
                    for (int j = 0; j < 4; ++j) {
                        const float c = rp[16 + j], s = rp[20 + j];
                        v[j] = fq == 0 ? v[j] * c - pr[j] * s : v[j] * c + pr[j] * s;
                    }
                }
            }
            return v;
        } else if (nt <= 6) return v * 0.08838834764831845f;
        else if (nt <= 10) return v;
        f32x4 o;
        if (nt <= 12) {
#pragma unroll
            for (int j = 0; j < 4; ++j) o[j] = v[j] * sigmoidf_(v[j]);
        } else {
#pragma unroll
            for (int j = 0; j < 4; ++j) o[j] = sigmoidf_(v[j]);
        }
        return o;
    }
    __device__ __forceinline__ bf16_t* dst(int m, int c) const {
        const P& P_ = *p;
        if (nt < 2) return P_.q() + (size_t)m * 512 + nt * 256 + c;
        if (nt == 2) return c < 128 ? P_.k() + (size_t)m * 128 + c : P_.v() + (size_t)m * 128 + (c - 128);
        if (nt == 3) return P_.iq() + (size_t)m * 256 + c;
        if (nt <= 6) return P_.hq() + (size_t)m * 512 + (nt - 5) * 256 + c;
        if (nt <= 8) return P_.hf() + (size_t)m * 512 + (nt - 7) * 256 + c;
        if (nt <= 10) return P_.hi() + (size_t)m * 512 + (nt - 9) * 256 + c;
        return P_.hg() + (size_t)m * 512 + (nt - 11) * 256 + c;
    }
    __device__ __forceinline__ void pair(int m, int c0, int fq, const f32x4& a0, const f32x4& a1) const {
        const P& P_ = *p;
        const f32x4 v0 = xf(m, c0 + fq * 4, fq, a0), v1 = xf(m, c0 + 16 + fq * 4, fq, a1);
        if (nt == 4) {
            const int n0 = c0 + fq * 4, n1 = n0 + 16;
            if (n0 < 32) st_bf4(P_.ik() + (size_t)m * 32 + n0, v0); else if (n0 < 40) *(f32x4*)(P_.iw() + (size_t)m * 8 + (n0 - 32)) = v0;
            if (n1 < 32) st_bf4(P_.ik() + (size_t)m * 32 + n1, v1);
        } else if (nt <= 2) {
            const float sc = nt < 2 ? 8.0f : 1.0f;
            uint32_t w0 = pk4_fp8(v0[0] * sc, v0[1] * sc, v0[2] * sc, v0[3] * sc), w1 = pk4_fp8(v1[0] * sc, v1[1] * sc, v1[2] * sc, v1[3] * sc);
            const auto r = __builtin_amdgcn_permlane16_swap(w0, w1, false, false); w0 = r[0]; w1 = r[1];
            unsigned char* g = (nt < 2 ? P_.q8() + (size_t)m * 512 + nt * 256 + c0 : (c0 < 128 ? P_.k8() + (size_t)m * 128 + c0 : P_.v8() + (size_t)m * 128 + (c0 - 128))) + pair_col(fq);
            *(uint2*)g = make_uint2(w0, w1);
        } else if (nt >= 13) {
            uint32_t w0 = (uint32_t)(v0[0] * 255.0f + 0.5f) | ((uint32_t)(v0[1] * 255.0f + 0.5f) << 8) | ((uint32_t)(v0[2] * 255.0f + 0.5f) << 16) | ((uint32_t)(v0[3] * 255.0f + 0.5f) << 24);
            uint32_t w1 = (uint32_t)(v1[0] * 255.0f + 0.5f) | ((uint32_t)(v1[1] * 255.0f + 0.5f) << 8) | ((uint32_t)(v1[2] * 255.0f + 0.5f) << 16) | ((uint32_t)(v1[3] * 255.0f + 0.5f) << 24);
            const auto r = __builtin_amdgcn_permlane16_swap(w0, w1, false, false); w0 = r[0]; w1 = r[1];
            unsigned char* g = (nt <= 16 ? P_.ga() + (size_t)m * 1024 + (nt - 13) * 256 : P_.gh() + (size_t)m * 1024 + (nt - 17) * 256) + c0 + pair_col(fq);
            *(uint2*)g = make_uint2(w0, w1);
        } else st_bf4_pair(dst(m, c0), fq, v0, v1);
    }
};

__device__ __forceinline__ void inproj_epilogue(const P& p, int nt, int mt, f32x4 (&acc)[2][2][4][2], float scale) {
    const EpiInproj e{&p, nt};
    const int tid_e = tid_(), lane_e = tid_e & 63, wid_e = tid_e >> 6, wr = wid_e >> 2, wc = wid_e & 3, fr = lane_e & 15, fq = lane_e >> 4;
#pragma unroll
    for (int ai = 0; ai < 2; ++ai)
#pragma unroll
        for (int m = 0; m < 4; ++m)
#pragma unroll
            for (int bj = 0; bj < 2; ++bj)
                e.pair(mt * 256 + ai * 128 + wr * 64 + m * 16 + fr, bj * 128 + wc * 32, fq, acc[ai][bj][m][0] * scale, acc[ai][bj][m][1] * scale);
}

__device__ __forceinline__ void ph_inproj(const P& p, unsigned char* lds) {
    const int G = gridDim.x, b0 = blockIdx.x;
    {
        const int nunits = (T / 256) * 2;
        auto jobfn = [&](int i, GJob& j) __attribute__((always_inline)) -> bool {
            const int u = b0 + i * G; if (u >= nunits) return false;
            const int nt = 3 + (u & 1), mt = u >> 1;
            j.A = (const char*)(p.xn() + (size_t)mt * 256 * D); j.B = (const char*)(p.winTb() + (size_t)(nt - 3) * 256 * D); return true; };
        auto epi = [&](f32x4 (&acc)[2][2][4][2], int i) __attribute__((always_inline)) {
            const int u = b0 + i * G, nt = 3 + (u & 1), mt = u >> 1;
            inproj_epilogue(p, nt, mt, acc, 1.0f);
        };
        unsigned vbU[2]; gj_lin2(vbU, D);
        gemm_stream<false>(lds, D, D, (size_t)128 * D * 2, vbU, jobfn, epi);
    }
    {
        const int nunits = (T / 256) * 19, br = G - 1 - b0;
        auto jobfn = [&](int i, G8Job& j) __attribute__((always_inline)) -> bool {
            const int u = br + i * G; if (u >= nunits) return false;
            const int n19 = u % 19, nt = n19 < 3 ? n19 : n19 + 2, mt = u / 19;
            j.A = (const char*)(p.xn8() + (size_t)mt * 256 * D); j.B = (const char*)(p.winT8() + (size_t)nt * 256 * D); return true; };
        auto epi = [&](f32x4 (&acc)[2][2][4][2], int i) __attribute__((always_inline)) {
            const int u = br + i * G, n19 = u % 19, nt = n19 < 3 ? n19 : n19 + 2, mt = u / 19;
            inproj_epilogue(p, nt, mt, acc, 0.03125f);
        };
        unsigned vbU[4];
#pragma unroll
        for (int q = 0; q < 4; ++q) { int R, Cb; g8_rc(q, R, Cb); vbU[q] = (unsigned)(R * D + Cb); }
        gemm8_stream<false>(lds, vbU, jobfn, [](int, int) __attribute__((always_inline)) {}, epi);
    }
}
constexpr int NCH = 129, NXU = 16 * NCH;
constexpr int X_QT = 0, X_KT = X_QT + 64 * 272, X_KH = X_KT + 64 * 272, X_VT = X_KH + 128 * 144, X_AS = X_VT + 128 * 144, X_SEG = X_AS + 64 * 144;
__device__ __forceinline__ bf16_t* hg_ds(const P& p) { return (bf16_t*)p.out; }
__device__ __forceinline__ float* hg_g(const P& p) { return (float*)((unsigned char*)p.out + (size_t)NXU * 32768); }

__device__ __forceinline__ void hgx_unit(const P& p, unsigned char* lds, int u) {
    const int tid = tid_(), lane = tid & 63, wid = tid >> 6, fr = lane & 15, fq = lane >> 4;
    const int c = u % NCH, bh = u / NCH, b = bh >> 2, h = bh & 3;
    const int d = tid & 127, seg = tid >> 7;
    const size_t rowbase = (size_t)(b * LP + c * 64 + seg * 16) * 512 + h * 128 + d;
    bf16_t* hqp = p.hq() + rowbase; const bf16_t* hfp = p.hf() + rowbase; const bf16_t* hip = p.hi() + rowbase;
    const float lbv = p.lb()[h * 128 + d];
    float bb[16], qv[16], kk[16], vv[16];
    float cs = 0.f;
#pragma unroll
    for (int i = 0; i < 16; ++i) {
        const float f = lbv + (1.0f - lbv) * sigmoidf_(bf2f(hfp[(size_t)i * 512]));
        kk[i] = 1.0f - f; cs += __logf(f); bb[i] = cs;
        qv[i] = bf2f(hqp[(size_t)i * 512]); vv[i] = bf2f(hip[(size_t)i * 512]);
    }
    float* segs = (float*)(lds + X_SEG);
    segs[seg * 128 + d] = cs;
    __syncthreads();
    const float s0 = segs[d], s1 = segs[128 + d], s2 = segs[256 + d], s3 = segs[384 + d];
    const float off = seg == 0 ? 0.f : (seg == 1 ? s0 : (seg == 2 ? s0 + s1 : s0 + s1 + s2));
    const float rref = s0 + s1, blast = (s0 + s1) + (s2 + s3);
    uint32_t khp[8], vtp[8];
#pragma unroll
    for (int i = 0; i < 16; i += 2) {
        float khv[2];
#pragma unroll
        for (int j = 0; j < 2; ++j) {
            const float bt = bb[i + j] + off;
            const float eq = __expf(fminf(bt - rref, 80.f)), ek = __expf(fminf(rref - bt, 80.f));
            const int t = seg * 16 + i + j;
            *(bf16_t*)(lds + X_QT + t * 272 + d * 2) = f2bf(qv[i + j] * eq);
            *(bf16_t*)(lds + X_KT + t * 272 + d * 2) = f2bf(kk[i + j] * ek);
            hqp[(size_t)(i + j) * 512] = f2bf(qv[i + j] * __expf(bt));
            khv[j] = kk[i + j] * __expf(blast - bt);
        }
        khp[i >> 1] = pack2(khv[0], khv[1]); vtp[i >> 1] = pack2(vv[i], vv[i + 1]);
    }
    *(uint4*)(lds + X_KH + d * 144 + seg * 32) = make_uint4(khp[0], khp[1], khp[2], khp[3]);
    *(uint4*)(lds + X_KH + d * 144 + seg * 32 + 16) = make_uint4(khp[4], khp[5], khp[6], khp[7]);
    *(uint4*)(lds + X_VT + d * 144 + seg * 32) = make_uint4(vtp[0], vtp[1], vtp[2], vtp[3]);
    *(uint4*)(lds + X_VT + d * 144 + seg * 32 + 16) = make_uint4(vtp[4], vtp[5], vtp[6], vtp[7]);
    if (seg == 0) hg_g(p)[(size_t)u * 128 + d] = __expf(blast);
    __syncthreads();
    {
        const int tm = wid >> 1, tn0 = (wid & 1) * 2;
        f32x4 a1[2] = {(f32x4){0.f, 0.f, 0.f, 0.f}, (f32x4){0.f, 0.f, 0.f, 0.f}};
#pragma unroll
        for (int ks = 0; ks < 4; ++ks) {
            const bf16x8 aq = *(const bf16x8*)(lds + X_QT + (tm * 16 + fr) * 272 + (ks * 32 + fq * 8) * 2);
#pragma unroll
            for (int j = 0; j < 2; ++j) {
                const bf16x8 bk = *(const bf16x8*)(lds + X_KT + ((tn0 + j) * 16 + fr) * 272 + (ks * 32 + fq * 8) * 2);
                a1[j] = __builtin_amdgcn_mfma_f32_16x16x32_bf16(bk, aq, a1[j], 0, 0, 0);
            }
        }
#pragma unroll
        for (int j = 0; j < 2; ++j) {
            const int t = tm * 16 + fr, sb = (tn0 + j) * 16 + fq * 4;
            f32x4 v = a1[j];
#pragma unroll
            for (int jj = 0; jj < 4; ++jj) v[jj] = (sb + jj <= t) ? v[jj] : 0.f;
            uint2 o; o.x = pack2(v[0], v[1]); o.y = pack2(v[2], v[3]);
            *(uint2*)(lds + X_AS + t * 144 + sb * 2) = o;
        }
    }
    __syncthreads();
    {
        const int tm = wid >> 1, en0 = (wid & 1) * 4;
        f32x4 o2[4];
#pragma unroll
        for (int j = 0; j < 4; ++j) o2[j] = (f32x4){0.f, 0.f, 0.f, 0.f};
#pragma unroll
        for (int ks = 0; ks < 2; ++ks) {
            const bf16x8 aa = *(const bf16x8*)(lds + X_AS + (tm * 16 + fr) * 144 + (ks * 32 + fq * 8) * 2);
#pragma unroll
            for (int j = 0; j < 4; ++j) {
                const bf16x8 bv = *(const bf16x8*)(lds + X_VT + ((en0 + j) * 16 + fr) * 144 + (ks * 32 + fq * 8) * 2);
                o2[j] = __builtin_amdgcn_mfma_f32_16x16x32_bf16(bv, aa, o2[j], 0, 0, 0);
            }
        }
        bf16_t* orow = p.hf() + (size_t)(b * LP + c * 64 + tm * 16 + fr) * 512 + h * 128;
#pragma unroll
        for (int j = 0; j < 4; ++j) st_bf4(orow + (en0 + j) * 16 + fq * 4, o2[j]);
    }
    {
        f32x4 s3[8];
#pragma unroll
        for (int j = 0; j < 8; ++j) s3[j] = (f32x4){0.f, 0.f, 0.f, 0.f};
#pragma unroll
        for (int ks = 0; ks < 2; ++ks) {
            const bf16x8 ak = *(const bf16x8*)(lds + X_KH + (wid * 16 + fr) * 144 + (ks * 32 + fq * 8) * 2);
#pragma unroll
            for (int j = 0; j < 8; ++j) {
                const bf16x8 bv = *(const bf16x8*)(lds + X_VT + (j * 16 + fr) * 144 + (ks * 32 + fq * 8) * 2);
                s3[j] = __builtin_amdgcn_mfma_f32_16x16x32_bf16(ak, bv, s3[j], 0, 0, 0);
            }
        }
        bf16_t* dsb = hg_ds(p) + (size_t)u * 16384;
#pragma unroll
        for (int j = 0; j < 8; ++j) st_bf4(dsb + (size_t)(j * 16 + fr) * 128 + wid * 16 + fq * 4, s3[j]);
    }
    __syncthreads();
}

__device__ __forceinline__ void hgchain_unit(const P& p, int item) {
    const int tid = tid_(), bh = item >> 2, eq = item & 3;
    const int e = eq * 32 + (tid >> 4), d0 = (tid & 15) * 8;
    float S[8];
#pragma unroll
    for (int i = 0; i < 8; ++i) S[i] = 0.f;
    uint4* ptr = (uint4*)(hg_ds(p) + ((size_t)(bh * NCH) * 128 + e) * 128 + d0);
    const f32x4* gp = (const f32x4*)(hg_g(p) + (size_t)(bh * NCH) * 128 + d0);
    uint4 wq[8]; f32x4 g0[8], g1[8];
#pragma unroll
    for (int k = 0; k < 8; ++k) { wq[k] = ptr[(size_t)k * 2048]; g0[k] = gp[k * 32]; g1[k] = gp[k * 32 + 1]; }
    for (int c0 = 0; c0 < NCH; c0 += 8) {
#pragma unroll
        for (int k = 0; k < 8; ++k) {
            const int c = c0 + k;
            if (c < NCH) {
                const uint4 w = wq[k]; const f32x4 ga = g0[k], gb = g1[k];
                if (c + 8 < NCH) { wq[k] = ptr[(size_t)(c + 8) * 2048]; g0[k] = gp[(c + 8) * 32]; g1[k] = gp[(c + 8) * 32 + 1]; }
                ptr[(size_t)c * 2048] = make_uint4(pack2(S[0], S[1]), pack2(S[2], S[3]), pack2(S[4], S[5]), pack2(S[6], S[7]));
                S[0] = ga[0] * S[0] + __uint_as_float(w.x << 16); S[1] = ga[1] * S[1] + __uint_as_float(w.x & 0xffff0000u);
                S[2] = ga[2] * S[2] + __uint_as_float(w.y << 16); S[3] = ga[3] * S[3] + __uint_as_float(w.y & 0xffff0000u);
                S[4] = gb[0] * S[4] + __uint_as_float(w.z << 16); S[5] = gb[1] * S[5] + __uint_as_float(w.z & 0xffff0000u);
                S[6] = gb[2] * S[6] + __uint_as_float(w.w << 16); S[7] = gb[3] * S[7] + __uint_as_float(w.w & 0xffff0000u);
            }
        }
    }
}

__device__ __forceinline__ void hgz_unit(const P& p, unsigned char* lds, int u) {
    const int tid = tid_(), lane = tid & 63, wid = tid >> 6, fr = lane & 15, fq = lane >> 4;
    const int c = u % NCH, bh = u / NCH, b = bh >> 2, h = bh & 3;
    const int tm = wid >> 1, en0 = (wid & 1) * 4;
    const size_t row = (size_t)(b * LP + c * 64 + tm * 16 + fr);
    const bf16_t* qrow = p.hq() + row * 512 + h * 128;
    const bf16_t* sT = hg_ds(p) + (size_t)u * 16384;
    f32x4 o[4];
#pragma unroll
    for (int j = 0; j < 4; ++j) o[j] = (f32x4){0.f, 0.f, 0.f, 0.f};
#pragma unroll
    for (int ks = 0; ks < 4; ++ks) {
        const bf16x8 aq = *(const bf16x8*)(qrow + ks * 32 + fq * 8);
#pragma unroll
        for (int j = 0; j < 4; ++j) {
            const bf16x8 bs = *(const bf16x8*)(sT + (size_t)((en0 + j) * 16 + fr) * 128 + ks * 32 + fq * 8);
            o[j] = __builtin_amdgcn_mfma_f32_16x16x32_bf16(bs, aq, o[j], 0, 0, 0);
        }
    }
    const bf16_t* oi = p.hf() + row * 512 + h * 128;
    float ss = 0.f;
#pragma unroll
    for (int j = 0; j < 4; ++j) {
        const uint2 w = *(const uint2*)(oi + (en0 + j) * 16 + fq * 4);
        o[j][0] += __uint_as_float(w.x << 16); o[j][1] += __uint_as_float(w.x & 0xffff0000u);
        o[j][2] += __uint_as_float(w.y << 16); o[j][3] += __uint_as_float(w.y & 0xffff0000u);
        ss += o[j][0] * o[j][0] + o[j][1] * o[j][1] + o[j][2] * o[j][2] + o[j][3] * o[j][3];
    }
    ss = xsum32(xsum16(ss));
    const bf16_t* hgp = p.hg() + row * 512 + h * 128;
    bf16_t* outp = p.hgr() + row * 512 + h * 128;
    f32x4 gnv[4]; uint2 hgv[4];
#pragma unroll
    for (int j = 0; j < 4; ++j) { const int e0 = (en0 + j) * 16 + fq * 4; gnv[j] = *(const f32x4*)(p.hgrn_g + h * 128 + e0); hgv[j] = *(const uint2*)(hgp + e0); }
    float* part = (float*)lds;
    if (fq == 0) part[(tm * 16 + fr) * 2 + (wid & 1)] = ss;
    __syncthreads();
    const float tot = part[(tm * 16 + fr) * 2] + part[(tm * 16 + fr) * 2 + 1];
    const float rs = rsqrtf(tot * (1.0f / 128.0f) + EPS);
#pragma unroll
    for (int j = 0; j < 4; ++j) {
        const int e0 = (en0 + j) * 16 + fq * 4;
        const f32x4 gn = gnv[j];
        const uint2 w = hgv[j];
        f32x4 r;
        r[0] = o[j][0] * rs * gn[0] * __uint_as_float(w.x << 16); r[1] = o[j][1] * rs * gn[1] * __uint_as_float(w.x & 0xffff0000u);
        r[2] = o[j][2] * rs * gn[2] * __uint_as_float(w.y << 16); r[3] = o[j][3] * rs * gn[3] * __uint_as_float(w.y & 0xffff0000u);
        st_bf4(outp + e0, r);
    }
    __syncthreads();
}

typedef float f32x16 __attribute__((ext_vector_type(16)));
typedef short s16x4 __attribute__((ext_vector_type(4)));

constexpr int NKMAX = 8224;
constexpr int NBIN = 1024;
constexpr int A_SC = 0, A_H1 = A_SC + 4 * NKMAX * 4, A_SEL = A_H1 + 4 * NBIN * 4, A_CAND = A_SEL + 2048, A_META = A_CAND + 1024, A_END = A_META + 256;
static_assert(A_END <= LDS_BYTES - 16, "attention LDS");
__device__ __forceinline__ uint32_t skey(float f) { const uint32_t u = __float_as_uint(f); return (u & 0x80000000u) ? ~u : (u | 0x80000000u); }
__device__ __forceinline__ float skey_inv(uint32_t k) { return __uint_as_float((k & 0x80000000u) ? (k & 0x7fffffffu) : ~k); }
__device__ __forceinline__ int bin1(float s, float lo, float scale) { return min(NBIN - 1, max(0, (int)((s - lo) * scale))); }
template <int OFF> __device__ __forceinline__ s16x4 tr_read(unsigned addr) {
    s16x4 r; asm volatile("ds_read_b64_tr_b16 %0, %1 offset:%2" : "=&v"(r) : "v"(addr), "i"(OFF) : "memory"); return r;
}
__device__ __forceinline__ void scan_top(const int* hist, int K, int* m, int lane) {
    int c[16];
#pragma unroll
    for (int i = 0; i < 4; ++i) { const int4 v = *(const int4*)(hist + 16 * lane + 4 * i); c[4 * i] = v.x; c[4 * i + 1] = v.y; c[4 * i + 2] = v.z; c[4 * i + 3] = v.w; }
    int tot = 0;
#pragma unroll
    for (int i = 0; i < 16; ++i) tot += c[i];
    int suf = tot;
#pragma unroll
    for (int o = 1; o < 64; o <<= 1) { const int t = __shfl_down(suf, o); if (lane + o < 64) suf += t; }
    int above = suf - tot;
#pragma unroll
    for (int i = 15; i >= 0; --i) {
        if (above < K && K <= above + c[i]) { m[0] = 16 * lane + i; m[1] = above; m[2] = c[i]; }
        above += c[i];
    }
}

__device__ __forceinline__ void attn4_unit(const P& p, unsigned char* lds, int b, int grp) {
    const int tid = tid_(), lane = tid & 63, wid = __builtin_amdgcn_readfirstlane(tid >> 6);
    const int t0 = NMETA + 4 * grp;
    const int brow = b * LP, row0 = brow + t0;
    float* sc = (float*)(lds + A_SC);
    int* h1 = (int*)(lds + A_H1);
    unsigned short* sel = (unsigned short*)(lds + A_SEL); unsigned short* cand = (unsigned short*)(lds + A_CAND);
    int* meta = (int*)(lds + A_META);
    const bool big = t0 + 1 > 256;
    for (int i = tid; i < 4 * NBIN; i += NTHREADS) h1[i] = 0;
    if (tid < 64) { const int w = tid & 15; meta[tid] = (w == 0) ? -1 : 0; }
    if (!big) { for (int i = tid; i < 1024; i += NTHREADS) { const int q = i >> 8, j = i & 255; sel[i] = (unsigned short)(j <= t0 + q ? j : 0); } }
    __syncthreads();
    if (big) {
        {
            const int hh = lane >> 5, c32 = lane & 31;
            const int g = c32 >> 3, h2a = (c32 >> 2) & 1, bq = c32 & 3, aq = 2 * h2a + (g >> 1), ah = 4 * (g & 1) + bq;
            const bf16_t* ap = p.iq() + (size_t)(row0 + aq) * 256 + ah * 32 + 8 * hh;
            const bf16x8 a0 = *(const bf16x8*)ap, a1 = *(const bf16x8*)(ap + 16);
            const f32x4 w00 = *(const f32x4*)(p.iw() + (size_t)(row0 + 2 * hh) * 8), w01 = *(const f32x4*)(p.iw() + (size_t)(row0 + 2 * hh) * 8 + 4);
            const f32x4 w10 = *(const f32x4*)(p.iw() + (size_t)(row0 + 2 * hh + 1) * 8), w11 = *(const f32x4*)(p.iw() + (size_t)(row0 + 2 * hh + 1) * 8 + 4);
            const int ntiles = (t0 + 4 + 31) >> 5;
            const int tq0 = t0 + 2 * hh;
            float mx0 = -INFINITY, mn0 = INFINITY, mx1 = -INFINITY, mn1 = INFINITY;
            const bf16_t* kbase = p.ik() + (size_t)brow * 32 + 8 * hh;
            for (int tile0 = wid; tile0 < ntiles; tile0 += 128) {
                bf16x8 b0[16], b1[16];
#pragma unroll
                for (int j = 0; j < 16; ++j) {
                    const int tile = min(tile0 + 8 * j, ntiles - 1);
                    const bf16_t* kp = kbase + (size_t)(tile * 32 + c32) * 32;
                    b0[j] = *(const bf16x8*)kp; b1[j] = *(const bf16x8*)(kp + 16);
                }
                __builtin_amdgcn_sched_barrier(0);
#pragma unroll
                for (int j = 0; j < 16; ++j) {
                    const int tile = tile0 + 8 * j;
                    if (tile < ntiles) {
                        const int key = tile * 32 + c32;
                        f32x16 acc;
#pragma unroll
                        for (int i = 0; i < 16; ++i) acc[i] = 0.f;
                        acc = __builtin_amdgcn_mfma_f32_32x32x16_bf16(a0, b0[j], acc, 0, 0, 0);
                        acc = __builtin_amdgcn_mfma_f32_32x32x16_bf16(a1, b1[j], acc, 0, 0, 0);
                        float s0 = 0.f, s1 = 0.f;
#pragma unroll
                        for (int i = 0; i < 4; ++i) {
                            s0 += w00[i] * fmaxf(acc[i], 0.f) + w01[i] * fmaxf(acc[4 + i], 0.f);
                            s1 += w10[i] * fmaxf(acc[8 + i], 0.f) + w11[i] * fmaxf(acc[12 + i], 0.f);
                        }
                        sc[(2 * hh) * NKMAX + key] = s0; sc[(2 * hh + 1) * NKMAX + key] = s1;
                        if (key <= tq0) { mx0 = fmaxf(mx0, s0); mn0 = fminf(mn0, s0); }
                        if (key <= tq0 + 1) { mx1 = fmaxf(mx1, s1); mn1 = fminf(mn1, s1); }
                    }
                }
            }
#pragma unroll
            for (int o = 16; o >= 1; o >>= 1) {
                mx0 = fmaxf(mx0, __shfl_xor(mx0, o)); mn0 = fminf(mn0, __shfl_xor(mn0, o));
                mx1 = fmaxf(mx1, __shfl_xor(mx1, o)); mn1 = fminf(mn1, __shfl_xor(mn1, o));
            }
            if (c32 == 0) {
                if (mx0 >= mn0) { atomicMin((unsigned*)&meta[(2 * hh) * 16 + 0], skey(mn0)); atomicMax((unsigned*)&meta[(2 * hh) * 16 + 1], skey(mx0)); }
                if (mx1 >= mn1) { atomicMin((unsigned*)&meta[(2 * hh + 1) * 16 + 0], skey(mn1)); atomicMax((unsigned*)&meta[(2 * hh + 1) * 16 + 1], skey(mx1)); }
            }
        }
        __syncthreads();
        const int q = wid & 3, part = wid >> 2, n = t0 + q + 1;
        const float lo = skey_inv((unsigned)meta[q * 16 + 0]), hi = skey_inv((unsigned)meta[q * 16 + 1]);
        const float scale = hi > lo ? (float)NBIN / (hi - lo) : 0.f;
        const float* scq = sc + q * NKMAX;
        for (int base = part * 256; base < n; base += 512) {
            const int idx0 = base + lane * 4;
            if (idx0 < n) {
                const f32x4 v = *(const f32x4*)(scq + idx0);
#pragma unroll
                for (int j = 0; j < 4; ++j) if (idx0 + j < n) atomicAdd(&h1[q * NBIN + bin1(v[j], lo, scale)], 1);
            }
        }
        __syncthreads();
        if (wid < 4) scan_top(h1 + wid * NBIN, 256, meta + wid * 16 + 4, lane);
        __syncthreads();
        const int B1 = meta[q * 16 + 4];
        for (int base = part * 256; base < n; base += 512) {
            const int idx0 = base + lane * 4;
            f32x4 v = (f32x4){0.f, 0.f, 0.f, 0.f};
            if (idx0 < n) v = *(const f32x4*)(scq + idx0);
            const unsigned long long lt = (1ull << lane) - 1ull;
#pragma unroll
            for (int j = 0; j < 4; ++j) {
                const int idx = idx0 + j;
                bool issel = false, iscand = false;
                if (idx < n) { const int b1 = bin1(v[j], lo, scale); issel = b1 > B1; iscand = b1 == B1; }
                const unsigned long long ms = __ballot(issel), mc = __ballot(iscand);
                if (ms) {
                    int bs = 0; if (lane == 0) bs = atomicAdd(&meta[q * 16 + 2], __popcll(ms));
                    bs = __shfl(bs, 0);
                    if (issel) sel[q * 256 + bs + __popcll(ms & lt)] = (unsigned short)idx;
                }
                if (mc) {
                    int bs = 0; if (lane == 0) bs = atomicAdd(&meta[q * 16 + 3], __popcll(mc));
                    bs = __shfl(bs, 0);
                    const int pos = bs + __popcll(mc & lt);
                    if (iscand && pos < 128) cand[q * 128 + pos] = (unsigned short)idx;
                }
            }
        }
        __syncthreads();
        if (wid < 4) {
            const int qq = wid; const float* scr = sc + qq * NKMAX;
            const int rq = 256 - meta[qq * 16 + 5], cq = meta[qq * 16 + 6], sbase = 256 - rq, nn = t0 + qq + 1;
            if (cq <= 128) {
                int taken = 0;
#pragma unroll
                for (int half = 0; half < 2; ++half) {
                    const int i = lane + 64 * half;
                    bool take = false; int myidx = 0;
                    if (i < cq) {
                        myidx = cand[qq * 128 + i]; const float mv = scr[myidx];
                        int rank = 0;
                        for (int j = 0; j < cq; ++j) { const int oj = cand[qq * 128 + j]; const float ov = scr[oj]; rank += (ov > mv) || (ov == mv && oj < myidx); }
                        take = rank < rq;
                    }
                    const unsigned long long mt = __ballot(take);
                    if (take) sel[qq * 256 + sbase + taken + __popcll(mt & ((1ull << lane) - 1ull))] = (unsigned short)myidx;
                    taken += __popcll(mt);
                }
            } else {
                const float lo_ = skey_inv((unsigned)meta[qq * 16 + 0]), hi_ = skey_inv((unsigned)meta[qq * 16 + 1]);
                const float sc_ = hi_ > lo_ ? (float)NBIN / (hi_ - lo_) : 0.f;
                const int B1_ = meta[qq * 16 + 4];
                int taken = 0;
                for (int base = 0; base < nn && taken < rq; base += 64) {
                    const int idx = base + lane; bool isc = false;
                    if (idx < nn) isc = bin1(scr[idx], lo_, sc_) == B1_;
                    const unsigned long long mc = __ballot(isc);
                    const int pos = taken + __popcll(mc & ((1ull << lane) - 1ull));
                    if (isc && pos < rq) sel[qq * 256 + sbase + pos] = (unsigned short)idx;
                    taken += __popcll(mc);
                }
            }
        }
        __syncthreads();
    }
    {
        const int q = wid >> 1, kvh = wid & 1, tq = t0 + q, nsel = min(tq + 1, 256);
        const int col = lane & 15, g4 = lane >> 4;
        const unsigned short* selq = sel + q * 256;
        bf16x8 qf0, qf1;
        {
            const bf16_t* qp = p.q() + (size_t)(row0 + q) * 512 + (kvh * 4 + (col & 3)) * 64 + g4 * 8;
            qf0 = *(const bf16x8*)qp; qf1 = *(const bf16x8*)(qp + 32);
            if (col >= 4) {
#pragma unroll
                for (int i = 0; i < 8; ++i) { qf0[i] = 0; qf1[i] = 0; }
            }
        }
        LAS unsigned char* vst = (LAS unsigned char*)lds + A_SC + wid * 16384;
        const bf16_t* vb = p.v() + (size_t)brow * 128 + kvh * 64 + (lane & 7) * 8;
        const unsigned rdbase = (unsigned)(uintptr_t)((LAS unsigned char*)lds + A_SC) + wid * 16384 + (4 * g4 + (col >> 2)) * 128 + (col & 3) * 8;
#define V_STAGE(s_, buf_) do { _Pragma("unroll") for (int i_ = 0; i_ < 4; ++i_) { \
            const int ksl_ = (s_) * 32 + i_ * 8 + (lane >> 3); const int key_ = selq[ksl_]; \
            __builtin_amdgcn_global_load_lds((const unsigned*)(vb + (size_t)key_ * 128), (LAS unsigned*)(vst + (buf_) * 4096 + i_ * 1024), 16, 0, 0); } } while (0)
        const bf16_t* kb = p.k() + (size_t)brow * 128 + kvh * 64 + g4 * 8;
        f32x4 lg[16];
        u32x4 vr[16];
        {
            bf16x8 k0[16], k1[16];
#pragma unroll
            for (int t = 0; t < 16; ++t) {
                const int key = selq[t * 16 + col];
                const bf16_t* kp = kb + (size_t)key * 128;
                k0[t] = *(const bf16x8*)kp; k1[t] = *(const bf16x8*)(kp + 32);
            }
#pragma unroll
            for (int s = 4; s < 8; ++s)
#pragma unroll
                for (int i = 0; i < 4; ++i) { const int key = selq[s * 32 + i * 8 + (lane >> 3)]; vr[(s - 4) * 4 + i] = *(const u32x4*)(vb + (size_t)key * 128); }
            V_STAGE(0, 0); V_STAGE(1, 1); V_STAGE(2, 2); V_STAGE(3, 3);
            __builtin_amdgcn_sched_barrier(0);
#pragma unroll
            for (int t = 0; t < 16; ++t) {
                f32x4 a = (f32x4){0.f, 0.f, 0.f, 0.f};
                a = __builtin_amdgcn_mfma_f32_16x16x32_bf16(k0[t], qf0, a, 0, 0, 0);
                a = __builtin_amdgcn_mfma_f32_16x16x32_bf16(k1[t], qf1, a, 0, 0, 0);
                lg[t] = a;
            }
            __builtin_amdgcn_sched_barrier(0);
        }
        float mx = -INFINITY;
#pragma unroll
        for (int t = 0; t < 16; ++t)
#pragma unroll
            for (int j = 0; j < 4; ++j) { if (t * 16 + g4 * 4 + j >= nsel) lg[t][j] = -INFINITY; mx = fmaxf(mx, lg[t][j]); }
        mx = fmaxf(mx, __shfl_xor(mx, 16)); mx = fmaxf(mx, __shfl_xor(mx, 32));
        float sm = 0.f;
#pragma unroll
        for (int t = 0; t < 16; ++t)
#pragma unroll
            for (int j = 0; j < 4; ++j) { const float e = __builtin_amdgcn_exp2f(lg[t][j] - mx); lg[t][j] = e; sm += e; }
        sm += __shfl_xor(sm, 16); sm += __shfl_xor(sm, 32);
        const float inv = 1.0f / sm;
        f32x4 o[4];
#pragma unroll
        for (int d = 0; d < 4; ++d) o[d] = (f32x4){0.f, 0.f, 0.f, 0.f};
        asm volatile("s_waitcnt vmcnt(0)" ::: "memory");
#pragma unroll
        for (int s = 0; s < 8; ++s) {
            if (s >= 4) {
#pragma unroll
                for (int i = 0; i < 4; ++i) *(LAS u32x4*)(vst + (s & 3) * 4096 + i * 1024 + lane * 16) = vr[(s - 4) * 4 + i];
                asm volatile("s_waitcnt lgkmcnt(0)" ::: "memory");
            }
            const unsigned rb = rdbase + (s & 3) * 4096;
            const s16x4 l0 = tr_read<0>(rb), h0 = tr_read<2048>(rb), l1 = tr_read<32>(rb), h1_ = tr_read<2048 + 32>(rb);
            const s16x4 l2 = tr_read<64>(rb), h2_ = tr_read<2048 + 64>(rb), l3 = tr_read<96>(rb), h3 = tr_read<2048 + 96>(rb);
            asm volatile("s_waitcnt lgkmcnt(0)" ::: "memory");
            __builtin_amdgcn_sched_barrier(0);
            bf16x8 pa;
            {
                const uint32_t w0 = pack2(lg[2 * s][0], lg[2 * s][1]), w1 = pack2(lg[2 * s][2], lg[2 * s][3]);
                const uint32_t w2 = pack2(lg[2 * s + 1][0], lg[2 * s + 1][1]), w3 = pack2(lg[2 * s + 1][2], lg[2 * s + 1][3]);
                pa[0] = (short)(w0 & 0xffff); pa[1] = (short)(w0 >> 16); pa[2] = (short)(w1 & 0xffff); pa[3] = (short)(w1 >> 16);
                pa[4] = (short)(w2 & 0xffff); pa[5] = (short)(w2 >> 16); pa[6] = (short)(w3 & 0xffff); pa[7] = (short)(w3 >> 16);
            }
#define PKV(L, H) (bf16x8){L[0], L[1], L[2], L[3], H[0], H[1], H[2], H[3]}
            o[0] = __builtin_amdgcn_mfma_f32_16x16x32_bf16(pa, PKV(l0, h0), o[0], 0, 0, 0);
            o[1] = __builtin_amdgcn_mfma_f32_16x16x32_bf16(pa, PKV(l1, h1_), o[1], 0, 0, 0);
            o[2] = __builtin_amdgcn_mfma_f32_16x16x32_bf16(pa, PKV(l2, h2_), o[2], 0, 0, 0);
            o[3] = __builtin_amdgcn_mfma_f32_16x16x32_bf16(pa, PKV(l3, h3), o[3], 0, 0, 0);
#undef PKV
        }
#undef V_STAGE
        const float i0 = __shfl(inv, 0), i1 = __shfl(inv, 1), i2 = __shfl(inv, 2), i3 = __shfl(inv, 3);
        if (g4 == 0) {
            bf16_t* op = p.att() + (size_t)(row0 + q) * 512 + kvh * 256 + col;
#pragma unroll
            for (int d = 0; d < 4; ++d) {
                op[0 * 64 + d * 16] = f2bf(o[d][0] * i0); op[1 * 64 + d * 16] = f2bf(o[d][1] * i1);
                op[2 * 64 + d * 16] = f2bf(o[d][2] * i2); op[3 * 64 + d * 16] = f2bf(o[d][3] * i3);
            }
        }
    }
    __syncthreads();
}

constexpr int NBW = 512;
constexpr int W_SC = 0, W_H = W_SC + NKMAX * 2, W_SEL = W_H + NBW * 4, W_CAND = W_SEL + 512, W_SZ = W_CAND + 256;
static_assert(8 * W_SZ <= LDS_BYTES - 32, "wave attention LDS");
__device__ __forceinline__ int binw(float s, float lo, float scale) { return min(NBW - 1, max(0, (int)((s - lo) * scale))); }

__device__ __forceinline__ void attn_wave(const P& p, unsigned char* lds, int wid, int lane, int b, int t) {
    unsigned char* wl = lds + wid * W_SZ;
    _Float16* sc = (_Float16*)(wl + W_SC);
    int* hist = (int*)(wl + W_H);
    unsigned short* sel = (unsigned short*)(wl + W_SEL);
    unsigned short* cand = (unsigned short*)(wl + W_CAND);
    const int brow = b * LP, row = brow + t, n = t + 1;
    const int col = lane & 15, g4 = lane >> 4;
    const unsigned long long lt = (1ull << lane) - 1ull;
    int nsel = 256;
    if (n > 256) {
        float mn, mx;
        {
            typedef _Float16 h2 __attribute__((ext_vector_type(2)));
            h2 hmx = {(_Float16)-65504.f, (_Float16)-65504.f}, hmn = {(_Float16)65504.f, (_Float16)65504.f};
            for (int base = 0; base < n; base += 256) {
                const int ia = base + lane * 4;
                if (ia + 3 < n) {
                    const uint2 ra = *(const uint2*)(sc + ia);
                    const h2 x0 = __builtin_bit_cast(h2, ra.x), x1 = __builtin_bit_cast(h2, ra.y);
                    hmx = __builtin_elementwise_max(hmx, __builtin_elementwise_max(x0, x1)); hmn = __builtin_elementwise_min(hmn, __builtin_elementwise_min(x0, x1));
                } else {
                    for (int j = 0; j < 3; ++j) if (ia + j < n) { const _Float16 x = sc[ia + j]; hmx[0] = x > hmx[0] ? x : hmx[0]; hmn[0] = x < hmn[0] ? x : hmn[0]; }
                }
            }
            float a = fmaxf((float)hmx[0], (float)hmx[1]), c = fminf((float)hmn[0], (float)hmn[1]);
            a = xmax32(xmax16(a)); c = fminf(c, lane_xor_f<32>(c)); c = xmin16(c);
            a = fmaxf(a, lane_xor_f<8>(a)); c = fminf(c, lane_xor_f<8>(c)); a = fmaxf(a, lane_xor_f<4>(a)); c = fminf(c, lane_xor_f<4>(c));
            a = fmaxf(a, lane_xor_f<2>(a)); c = fminf(c, lane_xor_f<2>(c)); a = fmaxf(a, lane_xor_f<1>(a)); c = fminf(c, lane_xor_f<1>(c));
            mx = a; mn = c;
        }
        const float scale = mx > mn ? (float)NBW / (mx - mn) : 0.f, nls = -mn * scale;
#define BINF(x) min(NBW - 1, max(0, (int)__builtin_fmaf((x), scale, nls)))
#define H2F(u16) ((float)__builtin_bit_cast(_Float16, (unsigned short)(u16)))
        for (int base = 0; base < n; base += 512) {
            const int ia = base + lane * 4, ib = ia + 256;
            const uint2 ra = *(const uint2*)(sc + ia), rb2 = *(const uint2*)(sc + ib);
            const unsigned wa[4] = {ra.x & 0xffffu, ra.x >> 16, ra.y & 0xffffu, ra.y >> 16}, wb[4] = {rb2.x & 0xffffu, rb2.x >> 16, rb2.y & 0xffffu, rb2.y >> 16};
#pragma unroll
            for (int j = 0; j < 4; ++j) {
                atomicAdd(&hist[BINF(H2F(wa[j]))], ia + j < n ? 1 : 0);
                atomicAdd(&hist[BINF(H2F(wb[j]))], ib + j < n ? 1 : 0);
            }
        }
        int B1, above1, cnt1;
        {
            int c[8];
            const int4 v0 = *(const int4*)(hist + 8 * lane), v1 = *(const int4*)(hist + 8 * lane + 4);
            c[0] = v0.x; c[1] = v0.y; c[2] = v0.z; c[3] = v0.w; c[4] = v1.x; c[5] = v1.y; c[6] = v1.z; c[7] = v1.w;
            int tot = 0;
#pragma unroll
            for (int i = 0; i < 8; ++i) tot += c[i];
            const int pre = wave_incl_scan(tot);
            int above = __builtin_amdgcn_readlane(pre, 63) - pre;
            const bool mine = above < 256 && 256 <= above + tot;
            int bb = 0, ab = 0, cb = 0;
#pragma unroll
            for (int i = 7; i >= 0; --i) { if (above < 256 && 256 <= above + c[i]) { bb = 8 * lane + i; ab = above; cb = c[i]; } above += c[i]; }
            const int src = (int)__builtin_ctzll(__ballot(mine));
            B1 = __builtin_amdgcn_readlane(bb, src); above1 = __builtin_amdgcn_readlane(ab, src); cnt1 = __builtin_amdgcn_readlane(cb, src);
        }
        int selcnt = 0, candcnt = 0;
        for (int base = 0; base < n; base += 512) {
            const int ia = base + lane * 4, ib = ia + 256;
            const uint2 ra = *(const uint2*)(sc + ia), rb2 = *(const uint2*)(sc + ib);
            const unsigned wv[8] = {ra.x & 0xffffu, ra.x >> 16, ra.y & 0xffffu, ra.y >> 16, rb2.x & 0xffffu, rb2.x >> 16, rb2.y & 0xffffu, rb2.y >> 16};
            unsigned smask = 0u, cmask = 0u;
#pragma unroll
            for (int j = 0; j < 8; ++j) {
                const int idx = (j < 4 ? ia : ib) + (j & 3);
                const int b1 = idx < n ? BINF(H2F(wv[j])) : -1;
                smask |= (b1 > B1 ? 1u : 0u) << j; cmask |= (b1 == B1 ? 1u : 0u) << j;
            }
            const int cnt = __popc(smask);
            const int inc = wave_incl_scan(cnt);
            int pos = selcnt + inc - cnt;
#pragma unroll
            for (int j = 0; j < 8; ++j) {
                const unsigned sj = (smask >> j) & 1u;
                unsigned short* dst = sj ? sel + pos : (unsigned short*)hist + lane;
                *dst = (unsigned short)((j < 4 ? ia : ib) + (j & 3)); pos += (int)sj;
            }
            selcnt += __builtin_amdgcn_readlane(inc, 63);
            if (__ballot(cmask != 0u)) {
#pragma unroll
                for (int j = 0; j < 8; ++j) {
                    const bool isc = (cmask >> j) & 1u;
                    const unsigned long long mc = __ballot(isc);
                    const int cp = candcnt + __popcll(mc & lt);
                    if (isc && cp < 128) cand[cp] = (unsigned short)((j < 4 ? ia : ib) + (j & 3));
                    candcnt += __popcll(mc);
                }
            }
        }
        {
            const int rq = 256 - above1, cq = cnt1, sbase = 256 - rq;
            if (cq <= 128) {
                const int i0 = lane, i1 = lane + 64;
                int ci0 = 0, ci1 = 0; float cv0 = -INFINITY, cv1 = -INFINITY;
                if (i0 < cq) { ci0 = cand[i0]; cv0 = (float)sc[ci0]; }
                if (i1 < cq) { ci1 = cand[i1]; cv1 = (float)sc[ci1]; }
                int rank0 = 0, rank1 = 0;
                const int c64 = cq < 64 ? cq : 64;
                for (int j = 0; j < c64; ++j) {
                    const int oj = __builtin_amdgcn_readlane(ci0, j); const float ov = readlane_f(cv0, j);
                    rank0 += (ov > cv0) || (ov == cv0 && oj < ci0); rank1 += (ov > cv1) || (ov == cv1 && oj < ci1);
                }
                for (int j = 64; j < cq; ++j) {
                    const int oj = __builtin_amdgcn_readlane(ci1, j - 64); const float ov = readlane_f(cv1, j - 64);
                    rank0 += (ov > cv0) || (ov == cv0 && oj < ci0); rank1 += (ov > cv1) || (ov == cv1 && oj < ci1);
                }
                int taken = 0;
                {
                    const bool take = i0 < cq && rank0 < rq;
                    const unsigned long long mt = __ballot(take);
                    if (take) sel[sbase + taken + __popcll(mt & lt)] = (unsigned short)ci0;
                    taken += __popcll(mt);
                }
                {
                    const bool take = i1 < cq && rank1 < rq;
                    const unsigned long long mt = __ballot(take);
                    if (take) sel[sbase + taken + __popcll(mt & lt)] = (unsigned short)ci1;
                    taken += __popcll(mt);
                }
            } else {
                int taken = 0;
                for (int base = 0; base < n && taken < rq; base += 64) {
                    const int idx = base + lane; bool isc = false;
                    if (idx < n) isc = BINF((float)sc[idx]) == B1;
                    const unsigned long long mc = __ballot(isc);
                    const int pos = taken + __popcll(mc & lt);
                    if (isc && pos < rq) sel[sbase + pos] = (unsigned short)idx;
                    taken += __popcll(mc);
                }
            }
        }
#undef BINF
#undef H2F
    } else {
        nsel = n;
#pragma unroll
        for (int i = 0; i < 4; ++i) { const int j = lane + 64 * i; sel[j] = (unsigned short)(j < n ? j : 0); }
    }
    LAS unsigned char* vst = (LAS unsigned char*)wl + W_SC;
    {
        long qf[4];
        {
            const unsigned char* qp = p.q8() + (size_t)row * 512 + (col & 7) * 64 + g4 * 8;
            const long q0 = *(const long*)qp, q1 = *(const long*)(qp + 32);
            const bool lo_grp = col < 4, hi_grp = col >= 4 && col < 8;
            qf[0] = lo_grp ? q0 : 0l; qf[1] = lo_grp ? q1 : 0l; qf[2] = hi_grp ? q0 : 0l; qf[3] = hi_grp ? q1 : 0l;
        }
#define A_WAITV(n_) do { if ((n_) >= 14) asm volatile("s_waitcnt vmcnt(14)" ::: "memory"); else if ((n_) == 12) asm volatile("s_waitcnt vmcnt(12)" ::: "memory"); \
            else if ((n_) == 10) asm volatile("s_waitcnt vmcnt(10)" ::: "memory"); else if ((n_) == 8) asm volatile("s_waitcnt vmcnt(8)" ::: "memory"); \
            else if ((n_) == 6) asm volatile("s_waitcnt vmcnt(6)" ::: "memory"); else if ((n_) == 4) asm volatile("s_waitcnt vmcnt(4)" ::: "memory"); \
            else if ((n_) == 2) asm volatile("s_waitcnt vmcnt(2)" ::: "memory"); else asm volatile("s_waitcnt vmcnt(0)" ::: "memory"); } while (0)
        const unsigned char* kg = p.k8() + (size_t)brow * 128;
#define K_STAGE(s_) do { _Pragma("unroll") for (int i_ = 0; i_ < 2; ++i_) { \
            const int kl_ = i_ * 8 + (lane >> 3); const int key_ = sel[(s_) * 16 + kl_]; \
            __builtin_amdgcn_global_load_lds((const unsigned*)(kg + (size_t)key_ * 128 + (((lane & 7) ^ (kl_ >> 1)) & 7) * 16), (LAS unsigned*)(vst + ((s_) & 7) * 2048 + i_ * 1024), 16, 0, 0); } } while (0)
        f32x4 lg[16];
        K_STAGE(0); K_STAGE(1); K_STAGE(2); K_STAGE(3); K_STAGE(4); K_STAGE(5); K_STAGE(6);
#pragma unroll
        for (int s = 0; s < 16; ++s) {
            if (s + 7 < 16) K_STAGE(s + 7);
            A_WAITV(2 * (15 - s < 7 ? 15 - s : 7));
            long kf[4];
#pragma unroll
            for (int ks = 0; ks < 4; ++ks) kf[ks] = *(const LAS long*)(vst + (s & 7) * 2048 + col * 128 + (((ks * 2 + (g4 >> 1)) ^ (col >> 1)) & 7) * 16 + (g4 & 1) * 8);
            asm volatile("s_waitcnt lgkmcnt(0)" ::: "memory");
            __builtin_amdgcn_sched_barrier(0);
            f32x4 a = (f32x4){0.f, 0.f, 0.f, 0.f};
#pragma unroll
            for (int ks = 0; ks < 4; ++ks) a = __builtin_amdgcn_mfma_f32_16x16x32_fp8_fp8(kf[ks], qf[ks], a, 0, 0, 0);
            lg[s] = a * 0.125f;
        }
#undef K_STAGE
        const unsigned char* vg = p.v8() + (size_t)brow * 128;
#define V_STAGE(s_) do { _Pragma("unroll") for (int i_ = 0; i_ < 2; ++i_) { \
            const int kl_ = i_ * 8 + (lane >> 3); const int key_ = sel[(s_) * 16 + kl_]; \
            __builtin_amdgcn_global_load_lds((const unsigned*)(vg + (size_t)key_ * 128 + ((lane & 7) ^ (((kl_ >> 1) & 3) | (((s_) & 1) << 2))) * 16), (LAS unsigned*)(vst + ((s_) & 7) * 2048 + i_ * 1024), 16, 0, 0); } } while (0)
        V_STAGE(0); V_STAGE(1); V_STAGE(2); V_STAGE(3); V_STAGE(4); V_STAGE(5);
        float mxl = -INFINITY;
#pragma unroll
        for (int tt = 0; tt < 16; ++tt)
#pragma unroll
            for (int j = 0; j < 4; ++j) { if (tt * 16 + g4 * 4 + j >= nsel) lg[tt][j] = -INFINITY; mxl = fmaxf(mxl, lg[tt][j]); }
        mxl = xmax32(xmax16(mxl));
        float sm = 0.f;
#pragma unroll
        for (int tt = 0; tt < 16; ++tt)
#pragma unroll
            for (int j = 0; j < 4; ++j) { const float e = __builtin_amdgcn_exp2f(lg[tt][j] - mxl); lg[tt][j] = e; sm += e; }
        sm = xsum32(xsum16(sm));
        const float inv = (1.0f / 256.0f) / sm;
        f32x4 o[8];
#pragma unroll
        for (int d = 0; d < 8; ++d) o[d] = (f32x4){0.f, 0.f, 0.f, 0.f};
        const int tq = col >> 1, trow = 4 * g4 + (tq & 3), tf = ((trow >> 1) & 3) | ((tq >> 2) << 2);
        const unsigned trb = (unsigned)(uintptr_t)vst + (tq >> 2) * 2048 + trow * 128 + (col & 1) * 8;
#pragma unroll
        for (int sp = 0; sp < 8; ++sp) {
            if (2 * sp + 7 < 16) { V_STAGE(2 * sp + 6); V_STAGE(2 * sp + 7); }
            A_WAITV(2 * (14 - 2 * sp < 6 ? 14 - 2 * sp : 6));
            const unsigned rb = trb + ((2 * sp) & 7) * 2048;
            long pa;
            {
                const uint32_t w0 = pk4_fp8(lg[2 * sp][0] * 256.0f, lg[2 * sp][1] * 256.0f, lg[2 * sp][2] * 256.0f, lg[2 * sp][3] * 256.0f);
                const uint32_t w1 = pk4_fp8(lg[2 * sp + 1][0] * 256.0f, lg[2 * sp + 1][1] * 256.0f, lg[2 * sp + 1][2] * 256.0f, lg[2 * sp + 1][3] * 256.0f);
                pa = (long)(((unsigned long long)w1 << 32) | (unsigned long long)w0);
            }
            long vf[8];
#pragma unroll
            for (int dt = 0; dt < 8; ++dt) asm volatile("ds_read_b64_tr_b8 %0, %1" : "=&v"(vf[dt]) : "v"(rb + ((dt ^ tf) * 16)) : "memory");
            asm volatile("s_waitcnt lgkmcnt(0)" ::: "memory");
            __builtin_amdgcn_sched_barrier(0);
#pragma unroll
            for (int dt = 0; dt < 8; ++dt) o[dt] = __builtin_amdgcn_mfma_f32_16x16x32_fp8_fp8(pa, vf[dt], o[dt], 0, 0, 0);
        }
#undef V_STAGE
#undef A_WAITV
        float ih[4];
#pragma unroll
        for (int jj = 0; jj < 4; ++jj) ih[jj] = (g4 & 1) ? readlane_f(inv, 4 + jj) : readlane_f(inv, jj);
        if (g4 < 2) {
            bf16_t* op = p.att() + (size_t)row * 512 + (g4 * 4) * 64 + col;
#pragma unroll
            for (int d = 0; d < 4; ++d) {
                const f32x4 oa_ = o[d], ob_ = o[4 + d]; f32x4 ov;
#pragma unroll
                for (int kk = 0; kk < 4; ++kk) ov[kk] = g4 == 0 ? oa_[kk] : ob_[kk];
                op[0 * 64 + d * 16] = f2bf(ov[0] * ih[0]); op[1 * 64 + d * 16] = f2bf(ov[1] * ih[1]);
                op[2 * 64 + d * 16] = f2bf(ov[2] * ih[2]); op[3 * 64 + d * 16] = f2bf(ov[3] * ih[3]);
            }
        }
    }
}

constexpr int A8_META = 8 * W_SZ;
static_assert(A8_META + 64 + 512 <= LDS_BYTES - 32, "attn8 meta");
__device__ __forceinline__ void attn8_unit(const P& p, unsigned char* lds, int b, int grp) {
    const int tid = tid_(), lane = tid & 63, wid = __builtin_amdgcn_readfirstlane(tid >> 6);
    const int t0 = NMETA + 8 * grp, brow = b * LP, row0 = brow + t0;
    unsigned* meta = (unsigned*)(lds + A8_META);
    const bool big = t0 + 1 > 256;
    bf16_t* uvec = (bf16_t*)(lds + A8_META + 64);
    if (big && tid < 256) {
        const int q = tid >> 5, d = tid & 31;
        const bf16_t* ip = p.iq() + (size_t)(row0 + q) * 256 + d; const float* wp = p.iw() + (size_t)(row0 + q) * 8;
        float u = 0.f;
#pragma unroll
        for (int h = 0; h < 8; ++h) u += wp[h] * bf2f(ip[h * 32]);
        uvec[q * 32 + d] = f2bf(u);
    }
    for (int i = tid; i < 8 * NBW; i += NTHREADS) ((int*)(lds + (i / NBW) * W_SZ + W_H))[i % NBW] = 0;
    __syncthreads();
    if (big) {
        const int hh = lane >> 5, c32 = lane & 31;
        const int g = c32 >> 3, h2a = (c32 >> 2) & 1, bq = c32 & 3, aq = 2 * h2a + (g >> 1), ah = 4 * (g & 1) + bq;
        bf16x8 a0[2], a1[2]; f32x4 w[2][2][2];
#pragma unroll
        for (int r = 0; r < 2; ++r) {
            const bf16_t* ap = p.iq() + (size_t)(row0 + 4 * r + aq) * 256 + ah * 32 + 8 * hh;
            a0[r] = *(const bf16x8*)ap; a1[r] = *(const bf16x8*)(ap + 16);
#pragma unroll
            for (int qi = 0; qi < 2; ++qi) {
                const float* wp = p.iw() + (size_t)(row0 + 4 * r + 2 * hh + qi) * 8;
                w[r][qi][0] = *(const f32x4*)wp; w[r][qi][1] = *(const f32x4*)(wp + 4);
            }
        }
        bf16x8 au0, au1;
        {
            const int uq = 4 * ((c32 & 3) >> 1) + 2 * ((c32 >> 2) & 1) + (c32 & 1);
            const bf16x8 v0 = *(const bf16x8*)(uvec + uq * 32 + 8 * hh), v1 = *(const bf16x8*)(uvec + uq * 32 + 8 * hh + 16);
#pragma unroll
            for (int i = 0; i < 8; ++i) { au0[i] = c32 < 8 ? v0[i] : (short)0; au1[i] = c32 < 8 ? v1[i] : (short)0; }
        }
        const int ntiles = (t0 + 8 + 31) >> 5;
        float mx[2][2], mn[2][2];
#pragma unroll
        for (int r = 0; r < 2; ++r)
#pragma unroll
            for (int qi = 0; qi < 2; ++qi) { mx[r][qi] = -INFINITY; mn[r][qi] = INFINITY; }
        const bf16_t* kbase = p.ik() + (size_t)brow * 32 + 8 * hh;
        bf16x8 b0[4], b1[4], c0[4], c1[4];
#define S_LOAD(B0, B1, T0) do { _Pragma("unroll") for (int j = 0; j < 4; ++j) { const int tile_ = min((T0) + 8 * j, ntiles - 1); \
            const bf16_t* kp_ = kbase + (size_t)(tile_ * 32 + c32) * 32; B0[j] = *(const bf16x8*)kp_; B1[j] = *(const bf16x8*)(kp_ + 16); } } while (0)
#define S_COMP(B0, B1, T0) do { _Pragma("unroll") for (int j = 0; j < 4; ++j) { const int tile = min((T0) + 8 * j, ntiles - 1); { const int key = tile * 32 + c32;   \
            f32x16 acu; _Pragma("unroll") for (int i = 0; i < 16; ++i) acu[i] = 0.f; \
            acu = __builtin_amdgcn_mfma_f32_32x32x16_bf16(au0, B0[j], acu, 0, 0, 0); acu = __builtin_amdgcn_mfma_f32_32x32x16_bf16(au1, B1[j], acu, 0, 0, 0); \
            _Pragma("unroll") for (int r = 0; r < 2; ++r) { f32x16 acc; _Pragma("unroll") for (int i = 0; i < 16; ++i) acc[i] = 0.f; \
                acc = __builtin_amdgcn_mfma_f32_32x32x16_bf16(a0[r], B0[j], acc, 0, 0, 0); acc = __builtin_amdgcn_mfma_f32_32x32x16_bf16(a1[r], B1[j], acc, 0, 0, 0); \
                _Pragma("unroll") for (int qi = 0; qi < 2; ++qi) { float s = acu[2 * r + qi], s1_ = 0.f; \
                    _Pragma("unroll") for (int i = 0; i < 4; ++i) { s = __builtin_fmaf(w[r][qi][0][i], __builtin_fabsf(acc[8 * qi + i]), s); s1_ = __builtin_fmaf(w[r][qi][1][i], __builtin_fabsf(acc[8 * qi + 4 + i]), s1_); } \
                    s += s1_; const int q = 4 * r + 2 * hh + qi; const _Float16 hs = (_Float16)fminf(fmaxf(s, -60000.f), 60000.f); \
                    ((_Float16*)(lds + q * W_SZ + W_SC))[key] = hs; } } } } } while (0)
        S_LOAD(b0, b1, wid);
        for (int tile0 = wid; tile0 < ntiles; tile0 += 64) {
            if (tile0 + 32 < ntiles) S_LOAD(c0, c1, tile0 + 32);
            __builtin_amdgcn_sched_barrier(0);
            S_COMP(b0, b1, tile0);
            __builtin_amdgcn_sched_barrier(0);
            if (tile0 + 64 < ntiles) S_LOAD(b0, b1, tile0 + 64);
            __builtin_amdgcn_sched_barrier(0);
            if (tile0 + 32 < ntiles) S_COMP(c0, c1, tile0 + 32);
            __builtin_amdgcn_sched_barrier(0);
        }
#undef S_LOAD
#undef S_COMP
    }
    __syncthreads();
    attn_wave(p, lds, wid, lane, b, t0 + wid);
    __syncthreads();
}

constexpr int NGRP8 = SEQ / 8, ATT_P1 = NGRP8 / 8, ATT_P2 = NGRP8 / 2;
template <int SUB>
__device__ __forceinline__ void ph_mixer(const P& p, unsigned char* lds) {
    int* bc = (int*)(lds + LDS_BYTES - 16);
    constexpr int nh = SUB == 1 ? 64 : NXU;
    constexpr int a0 = SUB == 0 ? 0 : (SUB == 1 ? ATT_P1 : ATT_P2), a1 = SUB == 0 ? ATT_P1 : (SUB == 1 ? ATT_P2 : NGRP8);
    const bool t0 = tid_() == 0;
    int nx = 0;
    if (t0) nx = atomicAdd(&p.ctr()[97 + SUB], 1);
    for (;;) {
        __syncthreads();
        if (t0) bc[0] = nx;
        __syncthreads();
        const int it = bc[0];
        if (it >= nh) break;
        if (t0) nx = atomicAdd(&p.ctr()[97 + SUB], 1);
        if (SUB == 0) hgx_unit(p, lds, it);
        else if (SUB == 1) hgchain_unit(p, it);
        else hgz_unit(p, lds, it);
    }
    const int b0 = (int)(xb_xcc_id() & 3u);
#pragma unroll 1
    for (int k = 0; k < 4; ++k) {
        const int b = (b0 + k) & 3;
        int* ctr = &p.ctr()[104 + SUB * 4 + b];
        if (t0) nx = atomicAdd(ctr, 1);
        for (;;) {
            __syncthreads();
            if (t0) bc[0] = nx;
            __syncthreads();
            const int it = bc[0];
            if (it >= a1 - a0) break;
            if (t0) nx = atomicAdd(ctr, 1);
            attn8_unit(p, lds, b, NGRP8 - 1 - (a0 + it));
        }
    }
}
__device__ __forceinline__ int tok_row(int tok) { return (tok >> 13) * LP + NMETA + (tok & 8191); }
__device__ __forceinline__ void ph_mix(const P& p, unsigned char* lds) {
    const int njobs = (NTOK / 256) * 4 * 2, G = gridDim.x, b0 = blockIdx.x;
    auto jobidx = [&](int i) __attribute__((always_inline)) { return (b0 + (i >> 1) * G) * 2 + (i & 1); };
    auto jobfn = [&](int i, GJob& j) __attribute__((always_inline)) -> bool {
        const int jb = jobidx(i); if (jb >= njobs) return false;
        const int which = jb & 1, u = jb >> 1, nt = u & 3, mt = u >> 2; const size_t r0 = (size_t)tok_row(mt * 256);
        j.A = (const char*)((which ? p.hgr() : p.att()) + r0 * 512); j.B = (const char*)((which ? p.wuhT() : p.wuaT()) + (size_t)nt * 256 * 512); return true; };
    auto epi = [&](f32x4 (&acc)[2][2][4][2], int i) __attribute__((always_inline)) {
        const int jb = jobidx(i), which = jb & 1, u = jb >> 1, nt = u & 3, mt = u >> 2; const size_t r0 = (size_t)tok_row(mt * 256);
        const int tid_e = tid_(), lane_e = tid_e & 63, wid_e = tid_e >> 6, wr = wid_e >> 2, wc = wid_e & 3, fr = lane_e & 15, fq = lane_e >> 4;
        const unsigned char* gsrc = which ? p.gh() : p.ga();
#pragma unroll
        for (int ai = 0; ai < 2; ++ai) {
            uint32_t g[4][2][2]; uint2 a[4][2][2];
#pragma unroll
            for (int m = 0; m < 4; ++m)
#pragma unroll
                for (int bj = 0; bj < 2; ++bj)
#pragma unroll
                    for (int n = 0; n < 2; ++n) {
                        const int row = ai * 128 + wr * 64 + m * 16 + fr, col = bj * 128 + wc * 32 + n * 16 + fq * 4;
                        g[m][bj][n] = *(const uint32_t*)(gsrc + (r0 + row) * 1024 + nt * 256 + col);
                        if (which) a[m][bj][n] = *(const uint2*)(p.mix() + (size_t)(mt * 256 + row) * 1024 + nt * 256 + col);
                    }
#pragma unroll
            for (int m = 0; m < 4; ++m)
#pragma unroll
                for (int bj = 0; bj < 2; ++bj) {
                    const int row = ai * 128 + wr * 64 + m * 16 + fr;
                    f32x4 rr[2];
#pragma unroll
                    for (int n = 0; n < 2; ++n) {
                        const f32x4 v = acc[ai][bj][m][n] * (1.0f / 255.0f); const uint32_t gg = g[m][bj][n];
                        rr[n][0] = v[0] * (float)(gg & 0xffu); rr[n][1] = v[1] * (float)((gg >> 8) & 0xffu);
                        rr[n][2] = v[2] * (float)((gg >> 16) & 0xffu); rr[n][3] = v[3] * (float)(gg >> 24);
                        if (which) {
                            const uint2 aa = a[m][bj][n];
                            rr[n][0] += __uint_as_float(aa.x << 16); rr[n][1] += __uint_as_float(aa.x & 0xffff0000u);
                            rr[n][2] += __uint_as_float(aa.y << 16); rr[n][3] += __uint_as_float(aa.y & 0xffff0000u);
                        }
                    }
                    st_bf4_pair(p.mix() + (size_t)(mt * 256 + row) * 1024 + nt * 256 + bj * 128 + wc * 32, fq, rr[0], rr[1]);
                }
        }
    };
    unsigned vbU[2]; gj_lin2(vbU, 512);
    gemm_stream<false>(lds, 512, 512, (size_t)128 * 512 * 2, vbU, jobfn, epi);
}

__device__ __forceinline__ void ph_out(const P& p, unsigned char* lds) {
    const int nunits = (NTOK / 256) * 4, G = gridDim.x, b0 = blockIdx.x;
    auto jobfn = [&](int i, GJob& j) __attribute__((always_inline)) -> bool {
        const int u = b0 + i * G; if (u >= nunits) return false;
        const int nt = u & 3, mt = u >> 2;
        j.A = (const char*)(p.mix() + (size_t)mt * 256 * D); j.B = (const char*)(p.woT() + (size_t)nt * 256 * D); return true; };
    auto epi = [&](f32x4 (&acc)[2][2][4][2], int i) __attribute__((always_inline)) {
        const int u = b0 + i * G, nt = u & 3, mt = u >> 2;
        const int tid_e = tid_(), lane_e = tid_e & 63, wid_e = tid_e >> 6, wr = wid_e >> 2, wc = wid_e & 3, fr = lane_e & 15, fq = lane_e >> 4;
#pragma unroll
        for (int ai = 0; ai < 2; ++ai) {
            f32x4 h0[4][2][2];
#pragma unroll
            for (int m = 0; m < 4; ++m)
#pragma unroll
                for (int bj = 0; bj < 2; ++bj)
#pragma unroll
                    for (int n = 0; n < 2; ++n)
                        h0[m][bj][n] = *(const f32x4*)(p.x + (size_t)(mt * 256 + ai * 128 + wr * 64 + m * 16 + fr) * D + nt * 256 + bj * 128 + wc * 32 + n * 16 + fq * 4);
#pragma unroll
            for (int m = 0; m < 4; ++m)
#pragma unroll
                for (int bj = 0; bj < 2; ++bj)
                    st_bf4_pair(p.h1b() + (size_t)(mt * 256 + ai * 128 + wr * 64 + m * 16 + fr) * D + nt * 256 + bj * 128 + wc * 32, fq, h0[m][bj][0] + acc[ai][bj][m][0], h0[m][bj][1] + acc[ai][bj][m][1]);
        }
    };
    unsigned vbU[2]; gj_lin2(vbU, D);
    gemm_stream<false>(lds, D, D, (size_t)128 * D * 2, vbU, jobfn, epi);
}

constexpr int XS_LD = 1025;
__device__ __forceinline__ void ph_route(const P& p, unsigned char* lds) {
    const int tid = tid_(), lane = tid & 63, wid = __builtin_amdgcn_readfirstlane(tid >> 6);
    const int gt = blockIdx.x * NTHREADS + tid, ntot = gridDim.x * NTHREADS;
    for (int i = gt; i < CAP; i += ntot) { p.slot_token()[i] = -1; p.slot_info()[i] = make_int2(-1, 0); }
    float* xs = (float*)lds;
    int* lhist = (int*)(lds + 32 * XS_LD * 4);
    for (int tb = blockIdx.x; tb < NTOK / 128; tb += gridDim.x) {
        if (tid < 32) lhist[tid] = 0;
        for (int tile = 0; tile < 4; ++tile) {
            const int tokt = tb * 128 + tile * 32;
            __syncthreads();
#pragma unroll
            for (int t = 0; t < 4; ++t) {
                const int tl = wid * 4 + t, tok = tokt + tl;
                const bf16_t* src = p.h1b() + (size_t)tok * D;
                f32x4 v[4]; float ss = 0.f;
#pragma unroll
                for (int i = 0; i < 4; ++i) {
                    const uint2 w = *(const uint2*)(src + lane * 4 + 256 * i);
                    v[i][0] = __uint_as_float(w.x << 16); v[i][1] = __uint_as_float(w.x & 0xffff0000u); v[i][2] = __uint_as_float(w.y << 16); v[i][3] = __uint_as_float(w.y & 0xffff0000u);
                    ss += v[i][0] * v[i][0] + v[i][1] * v[i][1] + v[i][2] * v[i][2] + v[i][3] * v[i][3];
                }
                ss = wave_sum(ss);
                const float rs = rsqrtf(ss * (1.0f / D) + EPS);
#pragma unroll
                for (int i = 0; i < 4; ++i) {
                    const f32x4 g = *(const f32x4*)(p.ffn_g + lane * 4 + 256 * i);
                    f32x4 xn; xn[0] = v[i][0] * rs * g[0]; xn[1] = v[i][1] * rs * g[1]; xn[2] = v[i][2] * rs * g[2]; xn[3] = v[i][3] * rs * g[3];
                    *(uint32_t*)(p.xn2() + (size_t)tok * D + lane * 4 + 256 * i) = pk4_fp8(xn[0], xn[1], xn[2], xn[3]);
#pragma unroll
                    for (int c = 0; c < 4; ++c) xs[tl * XS_LD + lane * 4 + 256 * i + c] = xn[c];
                }
            }
            __syncthreads();
            f32x16 acc;
#pragma unroll
            for (int i = 0; i < 16; ++i) acc[i] = 0.f;
            {
                const float* xr = xs + (lane & 31) * XS_LD + wid * 128 + (lane >> 5);
                const float* wp = p.router_w + (size_t)(wid * 128 + (lane >> 5)) * 32 + (lane & 31);
#pragma unroll 16
                for (int i = 0; i < 64; ++i) acc = __builtin_amdgcn_mfma_f32_32x32x2f32(xr[2 * i], wp[(size_t)(2 * i) * 32], acc, 0, 0, 0);
            }
            __syncthreads();
#pragma unroll
            for (int r = 0; r < 16; ++r) xs[wid * 1024 + ((r & 3) + 8 * (r >> 2) + 4 * (lane >> 5)) * 32 + (lane & 31)] = acc[r];
            __syncthreads();
            const int e = lane & 31, hh = lane >> 5;
            const float be = p.router_b[e];
#pragma unroll
            for (int it = 0; it < 2; ++it) {
                const int tl = wid * 4 + it * 2 + hh;
                float l = be;
#pragma unroll
                for (int w = 0; w < 8; ++w) l += xs[w * 1024 + tl * 32 + e];
                float bv[4]; int bi[4];
#pragma unroll
                for (int k = 0; k < 4; ++k) {
                    float m = l;
#pragma unroll
                    for (int o = 16; o >= 1; o >>= 1) m = fmaxf(m, __shfl_xor(m, o));
                    const unsigned long long bal = __ballot(l == m);
                    const unsigned half = hh ? (unsigned)(bal >> 32) : (unsigned)bal;
                    const int idx = __builtin_ctz(half);
                    bv[k] = m; bi[k] = idx;
                    if (e == idx) l = -INFINITY;
                }
                const float e1 = __expf(bv[1] - bv[0]), e2 = __expf(bv[2] - bv[0]), e3 = __expf(bv[3] - bv[0]);
                const float inv = 1.0f / (1.0f + e1 + e2 + e3);
                if (e == 0) {
                    const int tok = tokt + tl;
                    p.tok_exp()[tok * 4 + 0] = bi[0]; p.tok_exp()[tok * 4 + 1] = bi[1]; p.tok_exp()[tok * 4 + 2] = bi[2]; p.tok_exp()[tok * 4 + 3] = bi[3];
                    p.tok_gate()[tok * 4 + 0] = inv; p.tok_gate()[tok * 4 + 1] = e1 * inv; p.tok_gate()[tok * 4 + 2] = e2 * inv; p.tok_gate()[tok * 4 + 3] = e3 * inv;
                    atomicAdd(&lhist[bi[0]], 1); atomicAdd(&lhist[bi[1]], 1); atomicAdd(&lhist[bi[2]], 1); atomicAdd(&lhist[bi[3]], 1);
                }
            }
        }
        __syncthreads();
        if (tid < 32) p.wg_cnt()[tb * 32 + tid] = lhist[tid];
        __syncthreads();
    }
    __syncthreads();
    {
        constexpr int ROWB = 272;
        LAS unsigned char* wl = (LAS unsigned char*)lds + wid * (64 * ROWB);
        const int gw = blockIdx.x * 8 + wid, nw = gridDim.x * 8;
        for (int task = gw; task < 96 * 4 * 16; task += nw) {
            const int mat = task >> 6, kq4 = (task >> 4) & 3, nb = task & 15;
            const int which = mat >> 5, e = mat & 31;
            const float* W = (which == 0 ? p.w_gate : which == 1 ? p.w_up : p.w_down) + (size_t)e * 1048576 + (size_t)(kq4 * 256) * 1024 + nb * 64 + lane;
            unsigned char* outp = (which == 0 ? p.wgT() : which == 1 ? p.wuT() : p.wdT()) + (size_t)e * 1048576 + (size_t)(nb * 64) * 1024 + kq4 * 256;
#pragma unroll 1
            for (int q = 0; q < 4; ++q) {
                float v[64];
#pragma unroll
                for (int i = 0; i < 64; ++i) v[i] = W[(size_t)(q * 64 + i) * 1024] * 32.0f;
#pragma unroll
                for (int i = 0; i < 4; ++i) {
                    u32x4 t;
                    t.x = pk4_fp8(v[16 * i], v[16 * i + 1], v[16 * i + 2], v[16 * i + 3]); t.y = pk4_fp8(v[16 * i + 4], v[16 * i + 5], v[16 * i + 6], v[16 * i + 7]);
                    t.z = pk4_fp8(v[16 * i + 8], v[16 * i + 9], v[16 * i + 10], v[16 * i + 11]); t.w = pk4_fp8(v[16 * i + 12], v[16 * i + 13], v[16 * i + 14], v[16 * i + 15]);
                    *(LAS u32x4*)(wl + lane * ROWB + q * 64 + i * 16) = t;
                }
            }
#pragma unroll
            for (int j = 0; j < 16; ++j) {
                const int rr = j * 4 + (lane >> 4), c = lane & 15;
                const u32x4 t = *(const LAS u32x4*)(wl + rr * ROWB + c * 16);
                *(u32x4*)(outp + (size_t)rr * 1024 + c * 16) = t;
            }
        }
    }
}

__device__ __forceinline__ void ph_fill(const P& p, unsigned char* lds) {
    const int tid = tid_();
    int* tot = (int*)lds;
    int* pre = tot + 512;
    int* ps = pre + 512;
    int* lc = ps + 32;
    for (int tb = blockIdx.x; tb < NTOK / 128; tb += gridDim.x) {
        {
            const int e = tid & 31, part = tid >> 5;
            int t = 0, q = 0;
            for (int b2 = part; b2 < NTOK / 128; b2 += 16) { const int c = p.wg_cnt()[b2 * 32 + e]; t += c; if (b2 < tb) q += c; }
            tot[part * 32 + e] = t; pre[part * 32 + e] = q;
        }
        __syncthreads();
        if (tid == 0) {
            int acc = 0;
            for (int e = 0; e < NE; ++e) {
                int t = 0, q = 0;
                for (int i = 0; i < 16; ++i) { t += tot[i * 32 + e]; q += pre[i * 32 + e]; }
                ps[e] = acc + q; lc[e] = 0;
                const int nb = (t + 255) >> 8;
                if (tb == 0) for (int i = 0; i < nb; ++i) p.block_expert()[(acc >> 8) + i] = e;
                acc += nb * 256;
            }
            if (tb == 0) p.ctr()[96] = acc >> 8;
        }
        __syncthreads();
        {
            const int i = tb * 512 + tid;
            const int e = p.tok_exp()[i];
            const int dest = ps[e] + atomicAdd(&lc[e], 1);
            p.slot_token()[dest] = i >> 2;
            p.slot_rank()[dest] = i & 3;
            p.slot_gate()[dest] = p.tok_gate()[i];
            p.slot_info()[dest] = make_int2((i >> 2) | ((i & 3) << 16), __float_as_int(p.tok_gate()[i]));
        }
        __syncthreads();
    }
}

__device__ __forceinline__ void ph_moe1(const P& p, unsigned char* lds) {
    const int nblocks = p.ctr()[96], G = gridDim.x, b0 = blockIdx.x, bpx = (nblocks + 7) >> 3, bpi = G >> 6, xl = b0 >> 3, xbase = (b0 & 7) * bpx;
    const bool xcd_order = (G & 63) == 0;
    auto unit = [&](int i, int& rb, int& ct) __attribute__((always_inline)) -> bool {
        if (!xcd_order) { const int u = b0 + i * G; rb = u >> 3; ct = u & 7; return rb < nblocks; }
        const int k = i * bpi + (xl >> 3); rb = xbase + k; ct = xl & 7; return k < bpx && rb < nblocks && (xl >> 3) < bpi; };
    auto jobfn = [&](int i, G8Job& j) __attribute__((always_inline)) -> bool {
        int rb, ct; if (!unit(i, rb, ct)) return false;
        const int e = p.block_expert()[rb];
        j.A = (const char*)p.xn2(); j.B = (const char*)(p.wgT() + (size_t)e * 1048576 + (size_t)ct * 128 * 1024); j.aux = e;
        const int* st = p.slot_token() + rb * 256; unsigned v[4];
#pragma unroll
        for (int q = 0; q < 4; ++q) { int R, Cb; g8_rc(q, R, Cb); const int t = st[R]; v[q] = (unsigned)((t < 0 ? 0 : t) * 1024 + Cb); }
        j.va0 = v[0]; j.va1 = v[1]; j.va2 = v[2]; j.va3 = v[3]; return true; };
    auto epi = [&](f32x4 (&acc)[2][2][4][2], int i) __attribute__((always_inline)) {
        int rb, ct; unit(i, rb, ct);
        const int e = p.block_expert()[rb];
        const int tid_e = tid_(), lane_e = tid_e & 63, wid_e = tid_e >> 6, wr = wid_e >> 2, wc = wid_e & 3, fr = lane_e & 15, fq = lane_e >> 4;
        constexpr float SC = 0.03125f, KE = -1.702f * 1.4426950408889634f;
        constexpr int STG = 131072 + 4096, ROWP = 144;
        f32x2 bgp[2][2], bup[2][2], c2p[2][2];
#pragma unroll
        for (int n = 0; n < 2; ++n) {
            const LAS unsigned char* bl = (const LAS unsigned char*)lds + 131072 + (i & 1) * 2048 + (wc * 32 + n * 16 + fq * 4) * 4;
            const f32x4 bg = *(const LAS f32x4*)bl, bu = *(const LAS f32x4*)(bl + 512);
            bgp[n][0] = (f32x2){bg[0], bg[1]}; bgp[n][1] = (f32x2){bg[2], bg[3]};
            bup[n][0] = (f32x2){bu[0] + 1.0f, bu[1] + 1.0f}; bup[n][1] = (f32x2){bu[2] + 1.0f, bu[3] + 1.0f};
            c2p[n][0] = bgp[n][0] * KE; c2p[n][1] = bgp[n][1] * KE;
        }
#pragma unroll
        for (int ai = 0; ai < 2; ++ai) {
#pragma unroll
            for (int n = 0; n < 2; ++n)
#pragma unroll
                for (int m = 0; m < 4; ++m) {
                    const f32x4 ga = acc[ai][0][m][n], ua = acc[ai][1][m][n];
                    f32x2 o[2];
#pragma unroll
                    for (int hh = 0; hh < 2; ++hh) {
                        const f32x2 ag = {ga[2 * hh], ga[2 * hh + 1]}, au = {ua[2 * hh], ua[2 * hh + 1]};
                        const f32x2 t = ag * (SC * KE) + c2p[n][hh];
                        f32x2 d = {__builtin_amdgcn_exp2f(t[0]), __builtin_amdgcn_exp2f(t[1])};
                        d = d + 1.0f;
                        const f32x2 rc = {__builtin_amdgcn_rcpf(d[0]), __builtin_amdgcn_rcpf(d[1])};
                        f32x2 g = ag * SC + bgp[n][hh];
                        g[0] = fminf(g[0], 7.0f); g[1] = fminf(g[1], 7.0f);
                        f32x2 u1 = au * SC + bup[n][hh];
                        u1[0] = __builtin_amdgcn_fmed3f(u1[0], -6.0f, 8.0f); u1[1] = __builtin_amdgcn_fmed3f(u1[1], -6.0f, 8.0f);
                        o[hh] = (g * rc) * u1;
                    }
                    int w = __builtin_amdgcn_cvt_pk_fp8_f32(o[0][0], o[0][1], 0, false); w = __builtin_amdgcn_cvt_pk_fp8_f32(o[1][0], o[1][1], w, true);
                    *(LAS uint32_t*)((LAS unsigned char*)lds + STG + (wr * 64 + m * 16 + fr) * ROWP + wc * 32 + n * 16 + fq * 4) = (uint32_t)w;
                }
            __syncthreads();
#pragma unroll
            for (int t = 0; t < 2; ++t) {
                const int idx = t * NTHREADS + tid_e, rl = idx >> 3, ch = idx & 7;
                const u32x4 v4 = *(const LAS u32x4*)((LAS unsigned char*)lds + STG + rl * ROWP + ch * 16);
                *(u32x4*)(p.act() + (size_t)(rb * 256 + ai * 128 + rl) * DFF + ct * 128 + ch * 16) = v4;
            }
            __syncthreads();
        }
    };
    unsigned vbU[4];
#pragma unroll
    for (int q = 0; q < 4; ++q) { int R, Cb; g8_rc(q, R, Cb); vbU[q] = (unsigned)((size_t)(R >> 7) * WE8_B + (size_t)(R & 127) * 1024 + Cb); }
    auto pre = [&](int i, int e) __attribute__((always_inline)) {
        int rb, ct; unit(i, rb, ct);
        const int tid_p = tid_(), wid_p = __builtin_amdgcn_readfirstlane(tid_p >> 6), lane_p = tid_p & 63;
        if (wid_p < 4) {
            const float* src = (wid_p < 2 ? p.b_gate : p.b_up) + (size_t)e * DFF + ct * 128 + (wid_p & 1) * 64;
            const unsigned voff = (unsigned)lane_p * 4u, dst = (unsigned)(size_t)(LAS unsigned char*)lds + 131072u + (unsigned)(i & 1) * 2048u + (unsigned)wid_p * 256u;
            G8_PRE_DMA(uni_ptr8((const char*)src), voff, __builtin_amdgcn_readfirstlane(dst));
        }
    };
    gemm8_stream<true>(lds, vbU, jobfn, pre, epi);
}
__device__ __forceinline__ void ph_moe2(const P& p, unsigned char* lds) {
    const int nblocks = p.ctr()[96], G = gridDim.x, b0 = blockIdx.x, bpx = (nblocks + 7) >> 3, bpi = G >> 5, xl = b0 >> 3, xbase = (b0 & 7) * bpx;
    const bool xcd_order = (G & 31) == 0;
    auto unit = [&](int i, int& rb, int& nt) __attribute__((always_inline)) -> bool {
        if (!xcd_order) { const int u = b0 + i * G; rb = u >> 2; nt = u & 3; return rb < nblocks; }
        const int k = i * bpi + (xl >> 2); rb = xbase + k; nt = xl & 3; return k < bpx && rb < nblocks && (xl >> 2) < bpi; };
    unsigned vbU[4];
#pragma unroll
    for (int q = 0; q < 4; ++q) { int R, Cb; g8_rc(q, R, Cb); vbU[q] = (unsigned)(R * DFF + Cb); }
    auto jobfn = [&](int i, G8Job& j) __attribute__((always_inline)) -> bool {
        int rb, nt; if (!unit(i, rb, nt)) return false;
        const int e = p.block_expert()[rb];
        j.A = (const char*)(p.act() + (size_t)rb * 256 * DFF); j.B = (const char*)(p.wdT() + (size_t)e * 1048576 + (size_t)nt * 256 * DFF); j.aux = e; return true; };
    auto pre = [&](int i, int e) __attribute__((always_inline)) {
        int rb, nt; unit(i, rb, nt);
        const int tid_p = tid_(), wid_p = __builtin_amdgcn_readfirstlane(tid_p >> 6), lane_p = tid_p & 63;
        const unsigned voff = (unsigned)lane_p * 4u, base = (unsigned)(size_t)(LAS unsigned char*)lds + 131072u + (unsigned)(i & 1) * 3072u;
        G8_PRE_DMA(uni_ptr8((const char*)(p.slot_info() + rb * 256) + wid_p * 256), voff, __builtin_amdgcn_readfirstlane(base + 1024u + (unsigned)wid_p * 256u));
        if (wid_p < 4) G8_PRE_DMA(uni_ptr8((const char*)(p.b_down + (size_t)e * D + nt * 256 + wid_p * 64)), voff, __builtin_amdgcn_readfirstlane(base + (unsigned)wid_p * 256u));
    };
    auto epi = [&](f32x4 (&acc)[2][2][4][2], int i) __attribute__((always_inline)) {
        int rb, nt; unit(i, rb, nt);
        const int e = p.block_expert()[rb];
        const int tid_e = tid_(), lane_e = tid_e & 63, wid_e = tid_e >> 6, wr = wid_e >> 2, wc = wid_e & 3, fr = lane_e & 15, fq = lane_e >> 4;
        f32x4 bd[2][2];
#pragma unroll
        for (int bj = 0; bj < 2; ++bj)
#pragma unroll
            for (int n = 0; n < 2; ++n) bd[bj][n] = *(const LAS f32x4*)((const LAS unsigned char*)lds + 131072 + (i & 1) * 3072 + (bj * 128 + wc * 32 + n * 16 + fq * 4) * 4);
        typedef int i32x2_ __attribute__((ext_vector_type(2)));
        const LAS unsigned char* infl = (const LAS unsigned char*)lds + 131072 + (i & 1) * 3072 + 1024;
        LAS unsigned char* stg = (LAS unsigned char*)lds + 131072 + 6144;
#pragma unroll
        for (int ai = 0; ai < 2; ++ai) {
            float gate[4];
#pragma unroll
            for (int m = 0; m < 4; ++m) { const i32x2_ t_ = *(const LAS i32x2_*)(infl + (ai * 128 + wr * 64 + m * 16 + fr) * 8); gate[m] = __int_as_float(t_.y) * (16.0f * 0.03125f); }
#pragma unroll
            for (int bj = 0; bj < 2; ++bj) {
#pragma unroll
                for (int m = 0; m < 4; ++m)
#pragma unroll
                    for (int n = 0; n < 2; ++n) {
                        const f32x4 y = (acc[ai][bj][m][n] + bd[bj][n] * 32.0f) * gate[m];
                        const int rl = wr * 64 + m * 16 + fr, chunk = (wc * 2 + n) ^ (rl & 7);
                        *(LAS uint32_t*)(stg + rl * 128 + chunk * 16 + fq * 4) = pk4_fp8(y[0], y[1], y[2], y[3]);
                    }
                __syncthreads();
#pragma unroll
                for (int t = 0; t < 2; ++t) {
                    const int idx = t * NTHREADS + tid_e, rl = idx >> 3, ch = idx & 7;
                    const i32x2_ inf = *(const LAS i32x2_*)(infl + (ai * 128 + rl) * 8);
                    const u32x4 v4 = *(const LAS u32x4*)(stg + rl * 128 + ((ch ^ (rl & 7)) * 16));
                    const int ix = inf.x;
                    if (ix >= 0) {
                        const int rank = ix >> 16;
                        unsigned char* yb = (unsigned char*)(rank == 0 ? p.y0() : rank == 1 ? p.y1() : (rank == 2 ? p.y2() : p.y3()));
                        *(u32x4*)(yb + (size_t)(ix & 0xffff) * D + nt * 256 + bj * 128 + ch * 16) = v4;
                    }
                }
                __syncthreads();
            }
        }
    };
    gemm8_stream<false>(lds, vbU, jobfn, pre, epi);
}

__device__ __forceinline__ void ph_final(const P& p, unsigned char* lds) {
    const int tid = tid_(), lane = tid & 63, wid = tid >> 6;
    const int gw = blockIdx.x * 8 + wid, nw = gridDim.x * 8;
    for (int tok = gw; tok < NTOK; tok += nw) {
        float* dst = p.out + (size_t)tok * D;
        f32x4 v[4];
#pragma unroll
        for (int i = 0; i < 4; ++i) {
            const uint2 w = *(const uint2*)(p.h1b() + (size_t)tok * D + lane * 4 + 256 * i);
            v[i][0] = __uint_as_float(w.x << 16); v[i][1] = __uint_as_float(w.x & 0xffff0000u); v[i][2] = __uint_as_float(w.y << 16); v[i][3] = __uint_as_float(w.y & 0xffff0000u);
        }
#pragma unroll
        for (int j = 0; j < 4; ++j) {
            const unsigned char* yr = (const unsigned char*)(j == 0 ? p.y0() : j == 1 ? p.y1() : j == 2 ? p.y2() : p.y3()) + (size_t)tok * D;
#pragma unroll
            for (int i = 0; i < 4; ++i) {
                const int w = *(const int*)(yr + lane * 4 + 256 * i);
                const f32x2 lo = __builtin_amdgcn_cvt_pk_f32_fp8(w, false), hi = __builtin_amdgcn_cvt_pk_f32_fp8(w, true);
                v[i][0] += lo[0] * 0.0625f; v[i][1] += lo[1] * 0.0625f; v[i][2] += hi[0] * 0.0625f; v[i][3] += hi[1] * 0.0625f;
            }
        }
        float ss = 0.f;
#pragma unroll
        for (int i = 0; i < 4; ++i) ss += v[i][0] * v[i][0] + v[i][1] * v[i][1] + v[i][2] * v[i][2] + v[i][3] * v[i][3];
        ss = wave_sum(ss);
        const float rs = rsqrtf(ss * (1.0f / D) + EPS);
#pragma unroll
        for (int i = 0; i < 4; ++i) {
            const f32x4 g = *(const f32x4*)(p.final_g + lane * 4 + 256 * i);
            *(f32x4*)(dst + lane * 4 + 256 * i) = v[i] * rs * g;
        }
    }
}

typedef const __attribute__((address_space(4))) P* PK;
#define PHASE(call) do { PK q_ = pk; asm volatile("" : "+s"(q_)); const P& p = *(const P*)q_; call; } while (0)
__global__ void __launch_bounds__(NTHREADS) k_mega(P p_unused) {
    __shared__ __attribute__((aligned(16))) unsigned char lds[LDS_BYTES];
    cg::grid_group grid = cg::this_grid();
    const PK pk = (PK)__builtin_amdgcn_kernarg_segment_ptr();
    if (tid_() < 4) ((unsigned*)(lds + LDS_BYTES - 32))[tid_()] = 0u;
    __syncthreads();
    XcdBarrier xb;
    PHASE(xb = xcd_barrier_post((unsigned*)(p.ws + OFF_BAR), (volatile LAS unsigned*)(lds + LDS_BYTES - 32)));
    PHASE(if (p.ws == nullptr) grid.sync());
    PHASE(ph_prep(p, lds)); xcd_barrier(xb);
    PHASE(ph_inproj(p, lds)); xcd_barrier(xb);
    PHASE(ph_mixer<0>(p, lds)); xcd_barrier(xb);
    PHASE(ph_mixer<1>(p, lds)); xcd_barrier(xb);
    PHASE(ph_mixer<2>(p, lds)); xcd_barrier(xb);
    PHASE(ph_mix(p, lds)); xcd_barrier(xb);
    PHASE(ph_out(p, lds)); xcd_barrier(xb);
    PHASE(ph_route(p, lds)); xcd_barrier(xb);
    PHASE(ph_fill(p, lds)); xcd_barrier(xb);
    PHASE(ph_moe1(p, lds)); xcd_barrier(xb);
    PHASE(ph_moe2(p, lds)); xcd_barrier(xb);
    PHASE(ph_final(p, lds));
}

extern "C" void kernel_launch(void* const* d_in, const int* in_sizes, int n_in, void* d_out, int out_size, void* d_ws, size_t ws_size,
                              hipStream_t stream) {
    P p{};
    p.x = (const float*)d_in[0]; p.meta = (const float*)d_in[1]; p.attn_g = (const float*)d_in[2]; p.w_in = (const float*)d_in[3];
    p.hgrn_g = (const float*)d_in[4]; p.w_ua = (const float*)d_in[5]; p.w_uh = (const float*)d_in[6]; p.w_out = (const float*)d_in[7];
    p.lb_logits = (const float*)d_in[8]; p.ffn_g = (const float*)d_in[9]; p.router_w = (const float*)d_in[10]; p.router_b = (const float*)d_in[11];
    p.w_gate = (const float*)d_in[12]; p.b_gate = (const float*)d_in[13]; p.w_up = (const float*)d_in[14]; p.b_up = (const float*)d_in[15];
    p.w_down = (const float*)d_in[16]; p.b_down = (const float*)d_in[17]; p.final_g = (const float*)d_in[18];
    p.out = (float*)d_out;
    p.ws = (unsigned char*)d_ws;
    if (WS_NEED > ws_size) { fprintf(stderr, "workspace too small: need %zu have %zu\n", (size_t)WS_NEED, ws_size); return; }
    static int grid_blocks = 0;
    if (!grid_blocks) {
        int dev = 0, cus = 0, per_cu = 0;
        hipGetDevice(&dev);
        hipDeviceGetAttribute(&cus, hipDeviceAttributeMultiprocessorCount, dev);
        hipOccupancyMaxActiveBlocksPerMultiprocessor(&per_cu, k_mega, NTHREADS, 0);
        if (per_cu > 1) per_cu = 1;
        grid_blocks = cus * per_cu;
    }
    hipMemsetAsync(p.ws + OFF_BAR, 0, XCD_BAR_WORDS * 4, stream);
    void* args[] = {&p};
    hipError_t e = hipLaunchCooperativeKernel((void*)k_mega, dim3(grid_blocks), dim3(NTHREADS), args, 0, stream);
    if (e != hipSuccess) fprintf(stderr, "cooperative launch failed: %s (grid %d)\n", hipGetErrorString(e), grid_blocks);
}
```

```cpp
#include <hip/hip_runtime.h>
#include <hip/hip_cooperative_groups.h>
#include <stdint.h>
#include <cstdio>
namespace cg = cooperative_groups;

#ifndef MEGA
#define MEGA 1
#endif

typedef unsigned short bf16_t;
typedef short bf16x8 __attribute__((ext_vector_type(8)));
typedef float f32x4 __attribute__((ext_vector_type(4)));

constexpr int D = 1024, NB = 4, SEQ = 8192, NMETA = 16, L = SEQ + NMETA  , LP = 8320, T = NB * LP  ;
constexpr int NTOK = NB * SEQ;
constexpr int IN_COLS = 5160;
constexpr int NE = 32, TOPK = 4, DFF = 1024;
constexpr int CAP_BLOCKS = (NTOK * TOPK) / 256 + NE;
constexpr int CAP = CAP_BLOCKS * 256;
constexpr float EPS = 1e-5f;
constexpr int NTHREADS = 512;
constexpr int LDS_BYTES = 155648;
constexpr int NVC = 5376;
#define LAS __attribute__((address_space(3)))

typedef __bf16 hwbf16x2 __attribute__((ext_vector_type(2)));
typedef float f32x2 __attribute__((ext_vector_type(2)));
__device__ __forceinline__ uint32_t pack2(float a, float b) { const f32x2 v = {a, b}; return __builtin_bit_cast(uint32_t, __builtin_convertvector(v, hwbf16x2)); }
__device__ __forceinline__ bf16_t f2bf(float f) { return (bf16_t)(pack2(f, 0.f) & 0xffffu); }
__device__ __forceinline__ float bf2f(bf16_t h) { return __uint_as_float(((uint32_t)h) << 16); }
__device__ __forceinline__ uint32_t pk4_fp8(float a, float b, float c, float d) {
    a = fminf(fmaxf(a, -448.f), 448.f); b = fminf(fmaxf(b, -448.f), 448.f); c = fminf(fmaxf(c, -448.f), 448.f); d = fminf(fmaxf(d, -448.f), 448.f);
    int w = __builtin_amdgcn_cvt_pk_fp8_f32(a, b, 0, false); w = __builtin_amdgcn_cvt_pk_fp8_f32(c, d, w, true); return (uint32_t)w;
}
__device__ __forceinline__ float sigmoidf_(float x) { return __builtin_amdgcn_rcpf(1.0f + __builtin_amdgcn_exp2f(-1.4426950408889634f * x)); }
template <int CTRL, int RM = 0xf, bool BC = true>
__device__ __forceinline__ int dpp_mov(int v) { return __builtin_amdgcn_update_dpp(0, v, CTRL, RM, 0xf, BC); }
template <int O> __device__ __forceinline__ int lane_xor_i(int v) {
    if (O == 1) return dpp_mov<0xB1>(v);
    if (O == 2) return dpp_mov<0x4E>(v);
    if (O == 4) return dpp_mov<0x1B>(dpp_mov<0x141>(v));
    if (O == 8) return dpp_mov<0x128>(v);
    const int lane = (int)__builtin_amdgcn_mbcnt_hi(~0u, __builtin_amdgcn_mbcnt_lo(~0u, 0u));
    if (O == 16) { const auto r = __builtin_amdgcn_permlane16_swap((unsigned)v, (unsigned)v, false, false); return (lane & 16) ? (int)r[0] : (int)r[1]; }
    const auto r = __builtin_amdgcn_permlane32_swap((unsigned)v, (unsigned)v, false, false); return (lane & 32) ? (int)r[0] : (int)r[1];
}
template <int O> __device__ __forceinline__ float lane_xor_f(float v) { return __int_as_float(lane_xor_i<O>(__float_as_int(v))); }
__device__ __forceinline__ float xsum16(float v) { const auto r = __builtin_amdgcn_permlane16_swap(__float_as_uint(v), __float_as_uint(v), false, false); return __uint_as_float(r[0]) + __uint_as_float(r[1]); }
__device__ __forceinline__ float xsum32(float v) { const auto r = __builtin_amdgcn_permlane32_swap(__float_as_uint(v), __float_as_uint(v), false, false); return __uint_as_float(r[0]) + __uint_as_float(r[1]); }
__device__ __forceinline__ float xmax16(float v) { const auto r = __builtin_amdgcn_permlane16_swap(__float_as_uint(v), __float_as_uint(v), false, false); return fmaxf(__uint_as_float(r[0]), __uint_as_float(r[1])); }
__device__ __forceinline__ float xmax32(float v) { const auto r = __builtin_amdgcn_permlane32_swap(__float_as_uint(v), __float_as_uint(v), false, false); return fmaxf(__uint_as_float(r[0]), __uint_as_float(r[1])); }
__device__ __forceinline__ float xmin16(float v) { const auto r = __builtin_amdgcn_permlane16_swap(__float_as_uint(v), __float_as_uint(v), false, false); return fminf(__uint_as_float(r[0]), __uint_as_float(r[1])); }
__device__ __forceinline__ int wave_incl_scan(int x) {
    x += dpp_mov<0x111>(x); x += dpp_mov<0x112>(x); x += dpp_mov<0x114>(x); x += dpp_mov<0x118>(x);
    x += dpp_mov<0x142, 0xa, false>(x);
    x += dpp_mov<0x143, 0xc, false>(x);
    return x;
}
__device__ __forceinline__ float readlane_f(float v, int l) { return __int_as_float(__builtin_amdgcn_readlane(__float_as_int(v), l)); }
__device__ __forceinline__ float wave_sum(float v) {
#pragma unroll
    for (int o = 32; o >= 1; o >>= 1) v += __shfl_xor(v, o);
    return v;
}
__device__ __forceinline__ float wave_max(float v) {
#pragma unroll
    for (int o = 32; o >= 1; o >>= 1) v = fmaxf(v, __shfl_xor(v, o));
    return v;
}

constexpr size_t al256(size_t x) { return (x + 255) & ~(size_t)255; }
constexpr size_t TT = (size_t)T;
constexpr size_t MB1 = 1024 * 1024;
constexpr size_t WE8_B = (size_t)NE * 1024 * 1024;
constexpr size_t OFF_WGT = 0, OFF_WUT = WE8_B, OFF_WDT = 2 * WE8_B, OFF_XN2 = 3 * WE8_B, OFF_ACT = OFF_XN2 + (size_t)NTOK * D,
                 OFF_Y1 = OFF_ACT + (size_t)CAP * DFF, OFF_Y2 = OFF_Y1 + (size_t)NTOK * D, OFF_Y3 = OFF_Y2 + (size_t)NTOK * D,
                 OFF_H1B = OFF_Y3 + (size_t)NTOK * D,
                 OFF_S2_END = OFF_H1B + (size_t)NTOK * D * 2;
constexpr size_t OFF_WIN = 0, OFF_WUA = OFF_WIN + (size_t)NVC * 1024 * 2, OFF_WUH = OFF_WUA + MB1, OFF_WO = OFF_WUH + MB1, OFF_XN = OFF_WO + 2 * MB1,
                 OFF_Q = OFF_XN + TT * 2048, OFF_K = OFF_Q + TT * 1024, OFF_V = OFF_K + TT * 256, OFF_IQ = OFF_V + TT * 256, OFF_IK = OFF_IQ + TT * 512,
                 OFF_IW = OFF_IK + TT * 64, OFF_HQ = OFF_IW + TT * 32, OFF_HF = OFF_HQ + TT * 1024, OFF_HI = OFF_HF + TT * 1024, OFF_HG = OFF_HI + TT * 1024,
                 OFF_GA = OFF_HG + TT * 1024, OFF_GH = OFF_GA + TT * 2048, OFF_ATT = OFF_GH + TT * 2048, OFF_HGR = OFF_ATT + TT * 1024,
                 OFF_S1_END = OFF_HGR + TT * 1024;
static_assert(2 * WE8_B >= (size_t)NTOK * D * 2, "y0 does not fit over the gate/up weights");
constexpr size_t OFF_MIX = OFF_XN;
static_assert(OFF_H1B >= OFF_GA, "h1b (written by ph_out) must lie in stage-1 buffers that are dead by then");
constexpr size_t OFF_TAB = OFF_S1_END > OFF_S2_END ? OFF_S1_END : OFF_S2_END;
constexpr size_t OFF_ROPE = OFF_TAB, OFF_LB = OFF_ROPE + al256((size_t)LP * 24 * 4), OFF_CTR = OFF_LB + al256(512 * 4),
                 OFF_BEXP = OFF_CTR + al256(128 * 4), OFF_SLOT = OFF_BEXP + al256((size_t)CAP_BLOCKS * 4), OFF_SRANK = OFF_SLOT + al256((size_t)CAP * 4),
                 OFF_SGATE = OFF_SRANK + al256((size_t)CAP * 4), OFF_TEXP = OFF_SGATE + al256((size_t)CAP * 4), OFF_TGATE = OFF_TEXP + al256((size_t)NTOK * 16),
                 OFF_BAR = OFF_TGATE + al256((size_t)NTOK * 16), OFF_WGC = OFF_BAR + al256(3456 * 4), OFF_SINFO = OFF_WGC + al256(256 * 32 * 4), WS_NEED = OFF_SINFO + al256((size_t)CAP * 8);


__device__ __forceinline__ int tid_() { int t = threadIdx.x; asm volatile("" : "+v"(t)); return t; }

struct P {
    const float *x, *meta, *attn_g, *w_in, *hgrn_g, *w_ua, *w_uh, *w_out, *lb_logits, *ffn_g, *router_w, *router_b,
        *w_gate, *b_gate, *w_up, *b_up, *w_down, *b_down, *final_g;
    float* out;
    unsigned char* ws;
#define WSF(type, name, off) __device__ __forceinline__ type* name() const { return (type*)(ws + (off)); }
    WSF(bf16_t, xn, OFF_XN) WSF(unsigned char, xn8, OFF_ATT) WSF(unsigned char, winT8, OFF_WIN) WSF(bf16_t, winTb, OFF_WIN + 6 * MB1) WSF(bf16_t, q, OFF_Q) WSF(bf16_t, k, OFF_K) WSF(unsigned char, q8, OFF_Q) WSF(unsigned char, k8, OFF_K) WSF(unsigned char, v8, OFF_V)        WSF(bf16_t, v, OFF_V) WSF(bf16_t, iq, OFF_IQ) WSF(bf16_t, ik, OFF_IK)
    WSF(bf16_t, hq, OFF_HQ) WSF(bf16_t, hf, OFF_HF) WSF(bf16_t, hi, OFF_HI) WSF(bf16_t, hg, OFF_HG) WSF(unsigned char, ga, OFF_GA) WSF(unsigned char, gh, OFF_GH)
    WSF(bf16_t, att, OFF_ATT) WSF(bf16_t, hgr, OFF_HGR) WSF(bf16_t, mix, OFF_MIX) WSF(unsigned char, xn2, OFF_XN2) WSF(unsigned char, act, OFF_ACT)
    WSF(bf16_t, h1b, OFF_H1B) WSF(bf16_t, y0, OFF_WGT) WSF(bf16_t, y1, OFF_Y1) WSF(bf16_t, y2, OFF_Y2) WSF(bf16_t, y3, OFF_Y3)
    WSF(bf16_t, winT, OFF_WIN) WSF(bf16_t, wuaT, OFF_WUA) WSF(bf16_t, wuhT, OFF_WUH) WSF(bf16_t, woT, OFF_WO)
    WSF(unsigned char, wgT, OFF_WGT) WSF(unsigned char, wuT, OFF_WUT) WSF(unsigned char, wdT, OFF_WDT)
    WSF(float, iw, OFF_IW) WSF(float, rope, OFF_ROPE) WSF(float, lb, OFF_LB) WSF(float, tok_gate, OFF_TGATE) WSF(float, slot_gate, OFF_SGATE)
    WSF(int, ctr, OFF_CTR)
    WSF(int, wg_cnt, OFF_WGC) WSF(int2, slot_info, OFF_SINFO) WSF(int, block_expert, OFF_BEXP) WSF(int, slot_token, OFF_SLOT) WSF(int, slot_rank, OFF_SRANK) WSF(int, tok_exp, OFF_TEXP)
};

template <class ColMap>
__device__ __forceinline__ void convert_T8(const float* W, int ldw, unsigned char* out, int K, int N, const ColMap& cmap, float scale, int gt, int ntot) {
    const int kb = K / 64; const long ntask = (long)N * kb;
    for (long task = gt; task < ntask; task += ntot) {
        const int kq = (int)(task / N), n = (int)(task % N);
        const int c = cmap(n);
        uint32_t w[16];
        if (c >= 0) {
            const float* src = W + (size_t)(kq * 64) * ldw + c;
            float v[64];
#pragma unroll
            for (int i = 0; i < 64; ++i) v[i] = src[(size_t)i * ldw] * scale;
#pragma unroll
            for (int i = 0; i < 16; ++i) w[i] = pk4_fp8(v[4 * i], v[4 * i + 1], v[4 * i + 2], v[4 * i + 3]);
        } else {
#pragma unroll
            for (int i = 0; i < 16; ++i) w[i] = 0u;
        }
        uint4* dst = (uint4*)(out + (size_t)n * K + kq * 64);
#pragma unroll
        for (int i = 0; i < 4; ++i) dst[i] = make_uint4(w[4 * i], w[4 * i + 1], w[4 * i + 2], w[4 * i + 3]);
    }
}
template <class ColMap>
__device__ __forceinline__ void convert_T(const float* W, int ldw, bf16_t* out, int K, int N, const ColMap& cmap, int gt, int ntot) {
    const int kb = K / 64; const long ntask = (long)N * kb;
    for (long task = gt; task < ntask; task += ntot) {
        const int kq = (int)(task / N), n = (int)(task % N);
        const int c = cmap(n);
        uint32_t w[32];
        if (c >= 0) {
            const float* src = W + (size_t)(kq * 64) * ldw + c;
            float v[64];
#pragma unroll
            for (int i = 0; i < 64; ++i) v[i] = src[(size_t)i * ldw];
#pragma unroll
            for (int i = 0; i < 32; ++i) w[i] = pack2(v[2 * i], v[2 * i + 1]);
        } else {
#pragma unroll
            for (int i = 0; i < 32; ++i) w[i] = 0u;
        }
        uint4* dst = (uint4*)(out + (size_t)n * K + kq * 64);
#pragma unroll
        for (int i = 0; i < 8; ++i) dst[i] = make_uint4(w[4 * i], w[4 * i + 1], w[4 * i + 2], w[4 * i + 3]);
    }
}
struct IdMap { __device__ __forceinline__ int operator()(int n) const { return n; } };
struct WinMap { __device__ __forceinline__ int operator()(int n) const { return n < 1064 ? n : (n < 1280 ? -1 : n - 216); } };
struct WinMapIdx { __device__ __forceinline__ int operator()(int n) const { return WinMap{}(768 + n); } };

#define XB_TMO      128
#define XB_XCNT(j)  (256  + 64 * (j))
#define XB_XSUB(j)  (1280 + 64 * (j))
#define XB_XGEN(j)  (2304 + 64 * (j))
#define XB_TOP      3328
#define XB_TOPGEN   3392
#define XCD_BAR_WORDS 3456
#define XB_SPIN_CAP (1u << 22)
__device__ __forceinline__ unsigned xb_ld(unsigned* p)              { return __hip_atomic_load(p, __ATOMIC_RELAXED, __HIP_MEMORY_SCOPE_AGENT); }
__device__ __forceinline__ unsigned xb_add(unsigned* p, unsigned v) { return __hip_atomic_fetch_add(p, v, __ATOMIC_RELAXED, __HIP_MEMORY_SCOPE_AGENT); }
__device__ __forceinline__ unsigned xb_xcc_id() { return (unsigned)__builtin_amdgcn_s_getreg((3 << 11) | 20) & 0xFu; }
#define XB_SPIN(cond, bar) do { unsigned _sp = 0; while (cond) { __builtin_amdgcn_s_sleep(1); \
    if ((++_sp & 255u) == 0u) { if (xb_ld(&(bar)[XB_TMO])) break; if (_sp > XB_SPIN_CAP) { atomicAdd(&(bar)[XB_TMO], 1u); break; } } } } while (0)
struct XcdBarrier { unsigned* bar; unsigned x; volatile LAS unsigned* st; };
__device__ __forceinline__ XcdBarrier xcd_barrier_post(unsigned* bar, volatile LAS unsigned* st) {
    XcdBarrier b; b.bar = bar; b.x = xb_xcc_id(); b.st = st;
    if (threadIdx.x == 0) (void)xb_add(&bar[XB_XCNT(b.x)], 1u);
    return b;
}
__device__ __forceinline__ void xcd_barrier_complete(unsigned* bar, unsigned x, unsigned& nloc, unsigned& nx) {
    const unsigned G = gridDim.x * gridDim.y * gridDim.z;
    unsigned sum, cnt, mine, sp = 0u;
    for (;;) {
        sum = 0u; cnt = 0u; mine = 0u;
#pragma unroll
        for (unsigned j = 0; j < 16; ++j) { const unsigned c = xb_ld(&bar[XB_XCNT(j)]); sum += c; cnt += (c > 0u) ? 1u : 0u; mine = (j == x) ? c : mine; }
        if (sum == G) break;
        __builtin_amdgcn_s_sleep(1);
        if ((++sp & 255u) == 0u) { if (xb_ld(&bar[XB_TMO])) break; if (sp > XB_SPIN_CAP) { atomicAdd(&bar[XB_TMO], 1u); break; } }
    }
    nloc = mine > 0u ? mine : 1u; nx = cnt > 0u ? cnt : 1u;
}
__device__ __forceinline__ void xcd_barrier(const XcdBarrier& b) {
    asm volatile("s_waitcnt vmcnt(0)" ::: "memory");
    __syncthreads();
    if (threadIdx.x == 0) {
        unsigned* bar = b.bar;
        __builtin_amdgcn_s_waitcnt(0);
        unsigned nloc = b.st[0], nx = b.st[1];
        if (nloc == 0u) { xcd_barrier_complete(bar, b.x, nloc, nx); b.st[0] = nloc; b.st[1] = nx; }
        const unsigned old = xb_add(&bar[XB_XSUB(b.x)], 1u);
        const unsigned gen = old / nloc;
        if (old + 1u == (gen + 1u) * nloc) {
            __builtin_amdgcn_fence(__ATOMIC_RELEASE, "agent");
            asm volatile("s_waitcnt vmcnt(0)" ::: "memory");
            const unsigned og = xb_add(&bar[XB_TOP], 1u);
            const unsigned tg = og / nx;
            if (og + 1u == (tg + 1u) * nx) xb_add(&bar[XB_TOPGEN], 1u);
            else XB_SPIN(xb_ld(&bar[XB_TOPGEN]) == tg, bar);
            __builtin_amdgcn_fence(__ATOMIC_ACQUIRE, "agent");
            xb_add(&bar[XB_XGEN(b.x)], 1u);
            asm volatile("s_waitcnt vmcnt(0)" ::: "memory");
        } else {
            XB_SPIN(xb_ld(&bar[XB_XGEN(b.x)]) == gen, bar);
            __builtin_amdgcn_fence(__ATOMIC_ACQUIRE, "agent");
            asm volatile("s_waitcnt vmcnt(0)" ::: "memory");
        }
    }
    __syncthreads();
}

__device__ __forceinline__ void ph_prep(const P& p, unsigned char* lds) {
    const int tid = tid_(), lane = tid & 63, wid = tid >> 6;
    const int gw = blockIdx.x * 8 + wid, nw = gridDim.x * 8;
    for (int r = gw; r < T; r += nw) {
        const int b = r / LP, pos = r % LP;
        unsigned char* dst = p.xn8() + (size_t)r * D; bf16_t* dstb = p.xn() + (size_t)r * D;
        if (pos >= L) {
#pragma unroll
            for (int i = 0; i < 4; ++i) { *(uint32_t*)(dst + lane * 4 + 256 * i) = 0u; *(uint2*)(dstb + lane * 4 + 256 * i) = make_uint2(0u, 0u); }
            continue;
        }
        const float* src = pos < NMETA ? p.meta + (size_t)pos * D : p.x + ((size_t)b * SEQ + (pos - NMETA)) * D;
        f32x4 v[4]; float ss = 0.f;
#pragma unroll
        for (int i = 0; i < 4; ++i) { v[i] = *(const f32x4*)(src + lane * 4 + 256 * i); ss += v[i][0] * v[i][0] + v[i][1] * v[i][1] + v[i][2] * v[i][2] + v[i][3] * v[i][3]; }
        ss = wave_sum(ss);
        const float rs = rsqrtf(ss * (1.0f / D) + EPS);
#pragma unroll
        for (int i = 0; i < 4; ++i) {
            const f32x4 g = *(const f32x4*)(p.attn_g + lane * 4 + 256 * i);
            const float y0 = v[i][0] * rs * g[0], y1 = v[i][1] * rs * g[1], y2 = v[i][2] * rs * g[2], y3 = v[i][3] * rs * g[3];
            *(uint32_t*)(dst + lane * 4 + 256 * i) = pk4_fp8(y0, y1, y2, y3);
            uint2 o; o.x = pack2(y0, y1); o.y = pack2(y2, y3);
            *(uint2*)(dstb + lane * 4 + 256 * i) = o;
        }
    }
    const int gt = blockIdx.x * NTHREADS + tid, nt = gridDim.x * NTHREADS;
    for (int i = gt; i < LP * 12; i += nt) {
        const int pos = i / 12, f = i % 12;
        const double ex = f < 8 ? -(double)f / 8.0 : -(double)(f - 8) / 4.0;
        const double inv = exp(ex * log(500000.0));
        const double ang = (double)pos * inv;
        const double twopi = 6.283185307179586476925286766559;
        const double r = ang - twopi * rint(ang / twopi);
        const float rf = (float)r;
        const float c = cosf(rf), s = sinf(rf);
        float* row = p.rope() + (size_t)pos * 24;
        if (f < 8) { row[f] = c; row[8 + f] = s; } else { row[16 + f - 8] = c; row[20 + f - 8] = s; }
    }
    for (int i = gt; i < 512; i += nt) {
        const float a = p.lb_logits[i], b2 = p.lb_logits[512 + i];
        p.lb()[i] = 1.0f / (1.0f + expf(b2 - a));
    }
    for (int i = gt; i < 128; i += nt) p.ctr()[i] = 0;
    convert_T8(p.w_in, IN_COLS, p.winT8(), 1024, NVC, WinMap{}, 32.0f, gt, nt);
    convert_T(p.w_in, IN_COLS, p.winTb(), 1024, 512, WinMapIdx{}, gt, nt);
    convert_T(p.w_ua, 1024, p.wuaT(), 512, 1024, IdMap{}, gt, nt);
    convert_T(p.w_uh, 1024, p.wuhT(), 512, 1024, IdMap{}, gt, nt);
    convert_T(p.w_out, 1024, p.woT(), 1024, 1024, IdMap{}, gt, nt);
}
constexpr int G_TILE_B = 256 * 64 * 2, G_STAGE_B = 2 * G_TILE_B;
__device__ __forceinline__ int g_lds_byte(int r, int c) { const int st = (r >> 4) * 2 + (c >> 5), ob = (r & 15) * 64 + (c & 31) * 2; return st * 1024 + (ob ^ (((ob >> 9) & 1) << 5)); }
__device__ __forceinline__ void g_stage_rc(int b, int& R, int& C) { const int st = b >> 10, sb = b & 1023, swz = sb ^ (((sb >> 9) & 1) << 5); R = (st >> 1) * 16 + swz / 64; C = (st & 1) * 32 + (swz % 64) / 2; }

constexpr int HTB = 128 * 64 * 2;
struct GJob { const char* A; const char* B; unsigned va00, va01, va10, va11; };
__device__ __forceinline__ void gj_lin(unsigned (&v)[2][2], int ld) {
#pragma unroll
    for (int h = 0; h < 2; ++h)
#pragma unroll
        for (int i = 0; i < 2; ++i) { int R, C; g_stage_rc(tid_() * 16 + i * 8192, R, C); v[h][i] = (unsigned)(((h * 128 + R) * ld + C) * 2); }
}
template <class AOff>
__device__ __forceinline__ void gj_gather(unsigned (&v)[2][2], const AOff& aoff) {
#pragma unroll
    for (int h = 0; h < 2; ++h)
#pragma unroll
        for (int i = 0; i < 2; ++i) { int R, C; g_stage_rc(tid_() * 16 + i * 8192, R, C); v[h][i] = (unsigned)((aoff(h * 128 + R) + C) * 2); }
}
template <class AOff>
__device__ __forceinline__ void gj_gather_job(GJob& j, const AOff& aoff) {
    unsigned v[2][2]; gj_gather(v, aoff); j.va00 = v[0][0]; j.va01 = v[0][1]; j.va10 = v[1][0]; j.va11 = v[1][1];
}
template <bool GATHER, class JobFn, class Epi>
__device__ __forceinline__ void gemm_stream(unsigned char* lds_, int K, int lda, size_t hstepB, const unsigned (&vbU)[2], const JobFn& jobfn, const Epi& epi) {
    LAS unsigned char* lds = (LAS unsigned char*)lds_;
    const int tid = tid_(), wid = __builtin_amdgcn_readfirstlane(tid >> 6), lane = tid & 63, wr = wid >> 2, wc = wid & 3, fr = lane & 15, fq = lane >> 4;
    const int nt = K / 64;
    const size_t kstep = 128;
    const size_t hstepA = GATHER ? 0 : (size_t)128 * lda * 2;
    const unsigned ldsw = (unsigned)wid * 1024u;
    const int aoff = g_lds_byte(wr * 64 + fr, fq * 8), boff = g_lds_byte(wc * 32 + fr, fq * 8);
    unsigned vaU[2];
#pragma unroll
    for (int i = 0; i < 2; ++i) { int R, C; g_stage_rc(tid * 16 + i * 8192, R, C); vaU[i] = (unsigned)((R * lda + C) * 2); }
#define PG8_SA(b, h) (((b) * 2 + (h)) * HTB)
#define PG8_SB(b, h) ((4 + (b) * 2 + (h)) * HTB)
#define PG8_STAGE2(bufoff, gbase, v0, v1) do { \
        __builtin_amdgcn_global_load_lds((const unsigned*)((const char*)(gbase) + (v0)), (LAS unsigned*)(lds + (bufoff) + ldsw), 16, 0, 0); \
        __builtin_amdgcn_global_load_lds((const unsigned*)((const char*)(gbase) + (v1)), (LAS unsigned*)(lds + (bufoff) + ldsw + 8192), 16, 0, 0); } while (0)
#define STB(bufoff, gbase, h) PG8_STAGE2(bufoff, (gbase) + ((h) ? hstepB : 0), vbU[0], vbU[1])
#define STA_CUR(bufoff, gbase, h) do { if (GATHER) PG8_STAGE2(bufoff, gbase, (h) ? cur.va10 : cur.va00, (h) ? cur.va11 : cur.va01); else PG8_STAGE2(bufoff, (gbase) + ((h) ? hstepA : 0), vaU[0], vaU[1]); } while (0)
#define STA_SEL(bufoff, gbase, h) do { if (GATHER) PG8_STAGE2(bufoff, gbase, last ? ((h) ? nxt.va10 : nxt.va00) : ((h) ? cur.va10 : cur.va00), last ? ((h) ? nxt.va11 : nxt.va01) : ((h) ? cur.va11 : cur.va01)); \
        else PG8_STAGE2(bufoff, (gbase) + ((h) ? hstepA : 0), vaU[0], vaU[1]); } while (0)
#define PG8_LDA(dst, b, h) do { _Pragma("unroll") for (int m = 0; m < 4; ++m) _Pragma("unroll") for (int k = 0; k < 2; ++k) dst[m][k] = *(const LAS bf16x8*)(lds + PG8_SA(b, h) + aoff + m * 2048 + k * 1024); } while (0)
#define PG8_LDB(dst, b, h) do { _Pragma("unroll") for (int n = 0; n < 2; ++n) _Pragma("unroll") for (int k = 0; k < 2; ++k) dst[n][k] = *(const LAS bf16x8*)(lds + PG8_SB(b, h) + boff + n * 2048 + k * 1024); } while (0)
#define PG8_MMA(ai, bj, At, Bt) do { __builtin_amdgcn_s_setprio(1); _Pragma("unroll") for (int m = 0; m < 4; ++m) _Pragma("unroll") for (int n = 0; n < 2; ++n) _Pragma("unroll") for (int k = 0; k < 2; ++k) \
        acc[ai][bj][m][n] = __builtin_amdgcn_mfma_f32_16x16x32_bf16(Bt[n][k], At[m][k], acc[ai][bj][m][n], 0, 0, 0); __builtin_amdgcn_s_setprio(0); } while (0)
#define PG8_WAIT_V(n) asm volatile("s_waitcnt vmcnt(" #n ")" ::: "memory")
#define PG8_WAIT_L(n) asm volatile("s_waitcnt lgkmcnt(" #n ")" ::: "memory")
#define PG8_BAR __builtin_amdgcn_s_barrier()
#define PG8_SCHED __builtin_amdgcn_sched_barrier(0)
    GJob cur, nxt; int ui = 0;
    cur.A = nullptr; cur.B = nullptr; cur.va00 = cur.va01 = cur.va10 = cur.va11 = 0u; nxt = cur;
    if (!jobfn(0, cur)) return;
    f32x4 acc[2][2][4][2];
#pragma unroll
    for (int a = 0; a < 2; ++a)
#pragma unroll
        for (int b = 0; b < 2; ++b)
#pragma unroll
            for (int m = 0; m < 4; ++m)
#pragma unroll
                for (int n = 0; n < 2; ++n) acc[a][b][m][n] = (f32x4){0.f, 0.f, 0.f, 0.f};
    bf16x8 At[4][2], B0[2][2], B1[2][2];
    STB(PG8_SB(0, 0), cur.B, 0); STB(PG8_SB(0, 1), cur.B, 1); STA_CUR(PG8_SA(0, 0), cur.A, 0); STA_CUR(PG8_SA(0, 1), cur.A, 1);
    if (wr == 1) PG8_BAR;
    PG8_WAIT_V(2); PG8_BAR;
    STB(PG8_SB(1, 0), cur.B + kstep, 0); STA_CUR(PG8_SA(1, 0), cur.A + kstep, 0); STB(PG8_SB(1, 1), cur.B + kstep, 1);
    PG8_WAIT_V(6); PG8_BAR;
    for (;;) {
        bool has_next = false;
        for (int t = 0; t < nt; t += 2) {
            const bool last = (t == nt - 2);
            if (last) { has_next = jobfn(ui + 1, nxt); if (!has_next) nxt = cur; }
            const char* a1 = cur.A + (size_t)(t + 1) * kstep;
            const char* a2 = last ? nxt.A : cur.A + (size_t)(t + 2) * kstep; const char* b2 = last ? nxt.B : cur.B + (size_t)(t + 2) * kstep;
            const char* a3 = a2 + kstep; const char* b3 = b2 + kstep;
            PG8_LDB(B0, 0, 0); PG8_LDB(B1, 0, 1); PG8_SCHED; PG8_LDA(At, 0, 0); STA_CUR(PG8_SA(1, 1), a1, 1);
            PG8_WAIT_V(8); PG8_WAIT_L(0); PG8_BAR; PG8_MMA(0, 0, At, B0); PG8_MMA(0, 1, At, B1); PG8_BAR; PG8_SCHED;
            PG8_LDA(At, 0, 1); STB(PG8_SB(0, 0), b2, 0); STB(PG8_SB(0, 1), b2, 1); STA_SEL(PG8_SA(0, 0), a2, 0);
            PG8_WAIT_V(8); PG8_WAIT_L(0); PG8_BAR; PG8_MMA(1, 0, At, B0); PG8_MMA(1, 1, At, B1); PG8_BAR; PG8_SCHED;
            PG8_LDB(B0, 1, 0); PG8_LDB(B1, 1, 1); PG8_SCHED; PG8_LDA(At, 1, 0); STA_SEL(PG8_SA(0, 1), a2, 1);
            PG8_WAIT_V(8); PG8_WAIT_L(0); PG8_BAR; PG8_MMA(0, 0, At, B0); PG8_MMA(0, 1, At, B1); PG8_BAR; PG8_SCHED;
            PG8_LDA(At, 1, 1); STB(PG8_SB(1, 0), b3, 0); STB(PG8_SB(1, 1), b3, 1); STA_SEL(PG8_SA(1, 0), a3, 0);
            PG8_WAIT_V(8); PG8_WAIT_L(0); PG8_BAR; PG8_MMA(1, 0, At, B0); PG8_MMA(1, 1, At, B1); PG8_BAR; PG8_SCHED;
        }
        if (wr == 0) PG8_BAR;
        epi(acc, ui);
        if (!has_next) break;
#pragma unroll
        for (int a = 0; a < 2; ++a)
#pragma unroll
            for (int b = 0; b < 2; ++b)
#pragma unroll
                for (int m = 0; m < 4; ++m)
#pragma unroll
                    for (int n = 0; n < 2; ++n) acc[a][b][m][n] = (f32x4){0.f, 0.f, 0.f, 0.f};
        cur = nxt; ++ui;
        if (wr == 1) PG8_BAR;
    }
    PG8_WAIT_V(0);
    PG8_BAR;
#undef PG8_SA
#undef PG8_SB
#undef PG8_STAGE2
#undef STB
#undef STA_CUR
#undef STA_SEL
#undef PG8_LDA
#undef PG8_LDB
#undef PG8_MMA
#undef PG8_WAIT_V
#undef PG8_WAIT_L
#undef PG8_BAR
#undef PG8_SCHED
}
__device__ __forceinline__ void gj_lin2(unsigned (&v)[2], int ld) {
#pragma unroll
    for (int i = 0; i < 2; ++i) { int R, C; g_stage_rc(tid_() * 16 + i * 8192, R, C); v[i] = (unsigned)((R * ld + C) * 2); }
}
typedef int i32x8 __attribute__((ext_vector_type(8)));
typedef unsigned u32x4 __attribute__((ext_vector_type(4)));
struct G8Job { const char* A; const char* B; unsigned va0, va1, va2, va3; int aux; };
__device__ __forceinline__ void g8_rc(int i, int& R, int& Cb) { int C; g_stage_rc(tid_() * 16 + i * 8192, R, C); Cb = C * 2; }
__device__ __forceinline__ const char* uni_ptr8(const char* p) {
    const unsigned long long v = (unsigned long long)p;
    const unsigned lo = __builtin_amdgcn_readfirstlane((unsigned)v), hi = __builtin_amdgcn_readfirstlane((unsigned)(v >> 32));
    return (const char*)(((unsigned long long)hi << 32) | lo);
}
#define G8_PRE_DMA(gptr, voff, ldsaddr) asm volatile("s_mov_b32 m0, %2\n\ts_nop 0\n\tglobal_load_lds_dword %0, %1" :: "v"(voff), "s"(gptr), "s"(ldsaddr) : "memory", "m0")
template <bool GATHER, class JobFn, class Pre, class Epi>
__device__ __forceinline__ void gemm8_stream(unsigned char* lds_, const unsigned (&vbU)[4], const JobFn& jobfn, const Pre& pre, const Epi& epi) {
    LAS unsigned char* lds = (LAS unsigned char*)lds_;
    const int tid = tid_(), wid = __builtin_amdgcn_readfirstlane(tid >> 6), lane = tid & 63, wr = wid >> 2, wc = wid & 3, fr = lane & 15, fq = lane >> 4;
    LAS unsigned char* a0p = lds + g_lds_byte(wr * 64 + fr, fq * 8); LAS unsigned char* a1p = a0p + 65536;
    LAS unsigned char* b0p = lds + 32768 + g_lds_byte(wc * 32 + fr, fq * 8); LAS unsigned char* b1p = b0p + 65536;
    const unsigned ldsw_u = __builtin_amdgcn_readfirstlane((unsigned)(size_t)(lds + wid * 1024));
#define G8_GLDS(base, voff, ldsaddr) asm volatile("s_mov_b32 m0, %2\n\ts_nop 0\n\tglobal_load_lds_dwordx4 %0, %1" :: "v"(voff), "s"(base), "s"(ldsaddr) : "memory", "m0")
#define G8_DMA(JA, JB, v0, v1, v2, v3, buf, kt) do { \
        const char* pa_ = uni_ptr8(JA) + (kt) * 128; const char* pb_ = uni_ptr8(JB) + (kt) * 128; const unsigned d_ = ldsw_u + (buf) * 65536; \
        G8_GLDS(pa_, (GATHER ? v0 : vb0), d_); \
        G8_GLDS(pa_, (GATHER ? v1 : vb1), d_ + 8192); \
        G8_GLDS(pa_, (GATHER ? v2 : vb2), d_ + 16384); \
        G8_GLDS(pa_, (GATHER ? v3 : vb3), d_ + 24576); \
        G8_GLDS(pb_, vb0, d_ + 32768); \
        G8_GLDS(pb_, vb1, d_ + 32768 + 8192); \
        G8_GLDS(pb_, vb2, d_ + 32768 + 16384); \
        G8_GLDS(pb_, vb3, d_ + 32768 + 24576); } while (0)
#define G8_LD(dst, ptr) do { const u32x4 x0_ = *(const LAS u32x4*)(ptr), x1_ = *(const LAS u32x4*)((ptr) + 1024); \
        dst = (i32x8){(int)x0_.x, (int)x0_.y, (int)x0_.z, (int)x0_.w, (int)x1_.x, (int)x1_.y, (int)x1_.z, (int)x1_.w}; } while (0)
#define G8_LDA(dst, ap, ai, m0, m1) do { _Pragma("unroll") for (int m = m0; m < m1; ++m) G8_LD(dst[m], (ap) + (ai) * 16384 + m * 2048); } while (0)
#define G8_LDB(dst, bp, bj) do { _Pragma("unroll") for (int n = 0; n < 2; ++n) G8_LD(dst[n], (bp) + (bj) * 16384 + n * 2048); } while (0)
#define G8_MMA(ai, bj, At, Bt) do { __builtin_amdgcn_sched_barrier(0); __builtin_amdgcn_s_setprio(1); _Pragma("unroll") for (int m = 0; m < 4; ++m) _Pragma("unroll") for (int n = 0; n < 2; ++n) \
        asm("v_mfma_scale_f32_16x16x128_f8f6f4 %0, %1, %2, %0, %3, %3 op_sel_hi:[0,0,0]" : "+v"(acc[ai][bj][m][n]) : "v"(Bt[n]), "v"(At[m]), "v"(unit_scale)); \
        __builtin_amdgcn_s_setprio(0); __builtin_amdgcn_sched_barrier(0); } while (0)
#define G8_PF 2
#define G8_TILE(buf, ap, bp, apn, bpn, X, Y, kt) do { \
        G8_LDA(P, ap, 0, G8_PF, 4); G8_LDB(Y, bp, 1); G8_MMA(0, 0, P, X); \
        G8_LDA(Q, ap, 1, 0, 2);                       G8_MMA(0, 1, P, Y); \
        G8_LDA(Q, ap, 1, 2, 4);                       G8_MMA(1, 1, Q, Y); \
        asm volatile("" ::: "memory"); __builtin_amdgcn_s_waitcnt(0x0070); __builtin_amdgcn_s_barrier(); asm volatile("" ::: "memory"); \
        asm volatile("" : "+v"(vb0), "+v"(vb1), "+v"(vb2), "+v"(vb3), "+v"(cur.va0), "+v"(cur.va1), "+v"(cur.va2), "+v"(cur.va3)); \
        G8_DMA(selA, selB, cur.va0, cur.va1, cur.va2, cur.va3, buf, kt); \
        G8_LDA(P, apn, 0, 0, G8_PF); G8_LDB(Y, bpn, 0); \
        G8_MMA(1, 0, Q, X); } while (0)
    G8Job cur, nxt;
    cur.A = nullptr; cur.B = nullptr; cur.va0 = cur.va1 = cur.va2 = cur.va3 = 0u; cur.aux = 0; nxt = cur;
    if (!jobfn(0, cur)) return;
    cur.A = uni_ptr8(cur.A); cur.B = uni_ptr8(cur.B);
    unsigned vb0 = vbU[0], vb1 = vbU[1], vb2 = vbU[2], vb3 = vbU[3];
    G8_DMA(cur.A, cur.B, cur.va0, cur.va1, cur.va2, cur.va3, 0, 0); G8_DMA(cur.A, cur.B, cur.va0, cur.va1, cur.va2, cur.va3, 1, 1);
    asm volatile("s_waitcnt vmcnt(0)" ::: "memory");
    __syncthreads();
    int ui = 0;
    for (;;) {
        f32x4 acc[2][2][4][2];
#pragma unroll
        for (int a = 0; a < 2; ++a)
#pragma unroll
            for (int b = 0; b < 2; ++b)
#pragma unroll
                for (int m = 0; m < 4; ++m)
#pragma unroll
                    for (int n = 0; n < 2; ++n) acc[a][b][m][n] = (f32x4){0.f, 0.f, 0.f, 0.f};
        const bool has_next = jobfn(ui + 1, nxt);
        pre(ui, __builtin_amdgcn_readfirstlane(cur.aux));
        nxt.A = uni_ptr8(nxt.A); nxt.B = uni_ptr8(nxt.B);
        if (!has_next) nxt = cur;
        i32x8 P[4], Q[4], X[2], Y[2];
        const int unit_scale = 0x7f7f7f7f;
        G8_LDA(P, a0p, 0, 0, G8_PF); G8_LDB(X, b0p, 0);
#pragma unroll 1
        for (int t2 = 0; t2 < 4; ++t2) {
            const bool lastp = t2 == 3;
            const char* selA = lastp ? nxt.A : cur.A; const char* selB = lastp ? nxt.B : cur.B;
            if (GATHER) { cur.va0 = lastp ? nxt.va0 : cur.va0; cur.va1 = lastp ? nxt.va1 : cur.va1; cur.va2 = lastp ? nxt.va2 : cur.va2; cur.va3 = lastp ? nxt.va3 : cur.va3; }
            const int kt0 = lastp ? 0 : 2 * t2 + 2;
            asm volatile("" : "+v"(a0p), "+v"(a1p), "+v"(b0p), "+v"(b1p));
            G8_TILE(0, a0p, b0p, a1p, b1p, X, Y, kt0);
            G8_TILE(1, a1p, b1p, a0p, b0p, Y, X, kt0 + 1);
        }
        asm volatile("s_nop 15\n\ts_nop 15" ::: "memory");
        epi(acc, ui);
        if (!has_next) break;
        cur.A = nxt.A; cur.B = nxt.B; cur.aux = nxt.aux; ++ui;
    }
#undef G8_TILE
#undef G8_PF
#undef G8_MMA
#undef G8_LDB
#undef G8_LDA
#undef G8_LD
#undef G8_DMA
#undef G8_GLDS
    asm volatile("s_waitcnt vmcnt(0)" ::: "memory");
    __syncthreads();
}
struct RowLin { size_t base; int ld; __device__ __forceinline__ size_t operator()(int R) const { return base + (size_t)R * ld; } };

__device__ __forceinline__ void st_bf4(bf16_t* dst, f32x4 v) {
    uint2 o; o.x = pack2(v[0], v[1]); o.y = pack2(v[2], v[3]); *(uint2*)dst = o;
}
__device__ __forceinline__ int pair_col(int fq) { return 16 * (fq & 1) + 8 * (fq >> 1); }
__device__ __forceinline__ void st_bf4_pair(bf16_t* rowp_c0, int fq, const f32x4& v0, const f32x4& v1) {
    uint32_t ax = pack2(v0[0], v0[1]), ay = pack2(v0[2], v0[3]), bx = pack2(v1[0], v1[1]), by = pack2(v1[2], v1[3]);
    auto r = __builtin_amdgcn_permlane16_swap(ax, bx, false, false); ax = r[0]; bx = r[1];
    r = __builtin_amdgcn_permlane16_swap(ay, by, false, false); ay = r[0]; by = r[1];
    *(u32x4*)(rowp_c0 + pair_col(fq)) = (u32x4){ax, ay, bx, by};
}
#define EPI8(...) do { const int tid_e = tid_(), lane_e = tid_e & 63, wid_e = tid_e >> 6, wr = wid_e >> 2, wc = wid_e & 3, fr = lane_e & 15, fq = lane_e >> 4; \
    _Pragma("unroll") for (int ai = 0; ai < 2; ++ai) _Pragma("unroll") for (int m = 0; m < 4; ++m) _Pragma("unroll") for (int bj = 0; bj < 2; ++bj) _Pragma("unroll") for (int n = 0; n < 2; ++n) { \
        const int row = ai * 128 + wr * 64 + m * 16 + fr, col = bj * 128 + wc * 32 + n * 16 + fq * 4; const f32x4 v = acc[ai][bj][m][n]; __VA_ARGS__ } } while (0)

struct EpiInproj {
    const P* p; int nt;
    __device__ __forceinline__ f32x4 xf(int m, int n, int fq, f32x4 v) const {
        const P& P_ = *p;
        const int pos = m % LP;
        const float* rp = P_.rope() + (size_t)pos * 24;
        if (nt <= 2) {
            const bool isv = (nt == 2) && (n >= 128);
            if (!isv && (n & 48) == 0) {
                f32x4 pr;
#pragma unroll
                for (int j = 0; j < 4; ++j) pr[j] = __shfl_xor(v[j], 32);
                const int i0 = (fq & 1) * 4;
#pragma unroll
                for (int j = 0; j < 4; ++j) {
                    const float c = rp[i0 + j], s = rp[8 + i0 + j];
                    v[j] = fq < 2 ? v[j] * c - pr[j] * s : v[j] * c + pr[j] * s;
                }
            }
            return nt < 2 ? v * (0.125f * 1.4426950408889634f) : v;
        } else if (nt == 3 || nt == 4) {
            const bool ropeable = (nt == 3) ? ((n & 16) == 0) : (n < 16);
            if (ropeable) {
                f32x4 pr;
#pragma unroll
                for (int j = 0; j < 4; ++j) pr[j] = __shfl_xor(v[j], 16);
                if (fq < 2) {
#pragma unroll
                    for (int j = 0; j < 4; ++j) {
                        const float c = rp[16 + j], s = rp[20 + j];
                        v[j] = fq == 0 ? v[j] * c - pr[j] * s : v[j] * c + pr[j] * s;
                    }
                }
            }
            return v;
        } else if (nt <= 6) return v * 0.08838834764831845f;
        else if (nt <= 10) return v;
        f32x4 o;
        if (nt <= 12) {
#pragma unroll
            for (int j = 0; j < 4; ++j) o[j] = v[j] * sigmoidf_(v[j]);
        } else {
#pragma unroll
            for (int j = 0; j < 4; ++j) o[j] = sigmoidf_(v[j]);
        }
        return o;
    }
    __device__ __forceinline__ bf16_t* dst(int m, int c) const {
        const P& P_ = *p;
        if (nt < 2) return P_.q() + (size_t)m * 512 + nt * 256 + c;
        if (nt == 2) return c < 128 ? P_.k() + (size_t)m * 128 + c : P_.v() + (size_t)m * 128 + (c - 128);
        if (nt == 3) return P_.iq() + (size_t)m * 256 + c;
        if (nt <= 6) return P_.hq() + (size_t)m * 512 + (nt - 5) * 256 + c;
        if (nt <= 8) return P_.hf() + (size_t)m * 512 + (nt - 7) * 256 + c;
        if (nt <= 10) return P_.hi() + (size_t)m * 512 + (nt - 9) * 256 + c;
        return P_.hg() + (size_t)m * 512 + (nt - 11) * 256 + c;
    }
    __device__ __forceinline__ void pair(int m, int c0, int fq, const f32x4& a0, const f32x4& a1) const {
        const P& P_ = *p;
        const f32x4 v0 = xf(m, c0 + fq * 4, fq, a0), v1 = xf(m, c0 + 16 + fq * 4, fq, a1);
        if (nt == 4) {
            const int n0 = c0 + fq * 4, n1 = n0 + 16;
            if (n0 < 32) st_bf4(P_.ik() + (size_t)m * 32 + n0, v0); else if (n0 < 40) *(f32x4*)(P_.iw() + (size_t)m * 8 + (n0 - 32)) = v0;
            if (n1 < 32) st_bf4(P_.ik() + (size_t)m * 32 + n1, v1);
        } else if (nt <= 2) {
            const float sc = nt < 2 ? 8.0f : 1.0f;
            uint32_t w0 = pk4_fp8(v0[0] * sc, v0[1] * sc, v0[2] * sc, v0[3] * sc), w1 = pk4_fp8(v1[0] * sc, v1[1] * sc, v1[2] * sc, v1[3] * sc);
            const auto r = __builtin_amdgcn_permlane16_swap(w0, w1, false, false); w0 = r[0]; w1 = r[1];
            unsigned char* g = (nt < 2 ? P_.q8() + (size_t)m * 512 + nt * 256 + c0 : (c0 < 128 ? P_.k8() + (size_t)m * 128 + c0 : P_.v8() + (size_t)m * 128 + (c0 - 128))) + pair_col(fq);
            *(uint2*)g = make_uint2(w0, w1);
        } else if (nt >= 13) {
            uint32_t w0 = (uint32_t)(v0[0] * 255.0f + 0.5f) | ((uint32_t)(v0[1] * 255.0f + 0.5f) << 8) | ((uint32_t)(v0[2] * 255.0f + 0.5f) << 16) | ((uint32_t)(v0[3] * 255.0f + 0.5f) << 24);
            uint32_t w1 = (uint32_t)(v1[0] * 255.0f + 0.5f) | ((uint32_t)(v1[1] * 255.0f + 0.5f) << 8) | ((uint32_t)(v1[2] * 255.0f + 0.5f) << 16) | ((uint32_t)(v1[3] * 255.0f + 0.5f) << 24);
            const auto r = __builtin_amdgcn_permlane16_swap(w0, w1, false, false); w0 = r[0]; w1 = r[1];
            unsigned char* g = (nt <= 16 ? P_.ga() + (size_t)m * 1024 + (nt - 13) * 256 : P_.gh() + (size_t)m * 1024 + (nt - 17) * 256) + c0 + pair_col(fq);
            *(uint2*)g = make_uint2(w0, w1);
        } else st_bf4_pair(dst(m, c0), fq, v0, v1);
    }
};

__device__ __forceinline__ void inproj_epilogue(const P& p, int nt, int mt, f32x4 (&acc)[2][2][4][2], float scale) {
    const EpiInproj e{&p, nt};
    const int tid_e = tid_(), lane_e = tid_e & 63, wid_e = tid_e >> 6, wr = wid_e >> 2, wc = wid_e & 3, fr = lane_e & 15, fq = lane_e >> 4;
#pragma unroll
    for (int ai = 0; ai < 2; ++ai)
#pragma unroll
        for (int m = 0; m < 4; ++m)
#pragma unroll
            for (int bj = 0; bj < 2; ++bj)
                e.pair(mt * 256 + ai * 128 + wr * 64 + m * 16 + fr, bj * 128 + wc * 32, fq, acc[ai][bj][m][0] * scale, acc[ai][bj][m][1] * scale);
}

__device__ __forceinline__ void ph_inproj(const P& p, unsigned char* lds) {
    const int G = gridDim.x, b0 = blockIdx.x;
    {
        const int nunits = (T / 256) * 2;
        auto jobfn = [&](int i, GJob& j) __attribute__((always_inline)) -> bool {
            const int u = b0 + i * G; if (u >= nunits) return false;
            const int nt = 3 + (u & 1), mt = u >> 1;
            j.A = (const char*)(p.xn() + (size_t)mt * 256 * D); j.B = (const char*)(p.winTb() + (size_t)(nt - 3) * 256 * D); return true; };
        auto epi = [&](f32x4 (&acc)[2][2][4][2], int i) __attribute__((always_inline)) {
            const int u = b0 + i * G, nt = 3 + (u & 1), mt = u >> 1;
            inproj_epilogue(p, nt, mt, acc, 1.0f);
        };
        unsigned vbU[2]; gj_lin2(vbU, D);
        gemm_stream<false>(lds, D, D, (size_t)128 * D * 2, vbU, jobfn, epi);
    }
    {
        const int nunits = (T / 256) * 19, br = G - 1 - b0;
        auto jobfn = [&](int i, G8Job& j) __attribute__((always_inline)) -> bool {
            const int u = br + i * G; if (u >= nunits) return false;
            const int n19 = u % 19, nt = n19 < 3 ? n19 : n19 + 2, mt = u / 19;
            j.A = (const char*)(p.xn8() + (size_t)mt * 256 * D); j.B = (const char*)(p.winT8() + (size_t)nt * 256 * D); return true; };
        auto epi = [&](f32x4 (&acc)[2][2][4][2], int i) __attribute__((always_inline)) {
            const int u = br + i * G, n19 = u % 19, nt = n19 < 3 ? n19 : n19 + 2, mt = u / 19;
            inproj_epilogue(p, nt, mt, acc, 0.03125f);
        };
        unsigned vbU[4];
#pragma unroll
        for (int q = 0; q < 4; ++q) { int R, Cb; g8_rc(q, R, Cb); vbU[q] = (unsigned)(R * D + Cb); }
        gemm8_stream<false>(lds, vbU, jobfn, [](int, int) __attribute__((always_inline)) {}, epi);
    }
}
constexpr int NCH = 129, NXU = 16 * NCH;
constexpr int X_QT = 0, X_KT = X_QT + 64 * 272, X_KH = X_KT + 64 * 272, X_VT = X_KH + 128 * 144, X_AS = X_VT + 128 * 144, X_SEG = X_AS + 64 * 144;
__device__ __forceinline__ bf16_t* hg_ds(const P& p) { return (bf16_t*)p.out; }
__device__ __forceinline__ float* hg_g(const P& p) { return (float*)((unsigned char*)p.out + (size_t)NXU * 32768); }

__device__ __forceinline__ void hgx_unit(const P& p, unsigned char* lds, int u) {
    const int tid = tid_(), lane = tid & 63, wid = tid >> 6, fr = lane & 15, fq = lane >> 4;
    const int c = u % NCH, bh = u / NCH, b = bh >> 2, h = bh & 3;
    const int d = tid & 127, seg = tid >> 7;
    const size_t rowbase = (size_t)(b * LP + c * 64 + seg * 16) * 512 + h * 128 + d;
    bf16_t* hqp = p.hq() + rowbase; const bf16_t* hfp = p.hf() + rowbase; const bf16_t* hip = p.hi() + rowbase;
    const float lbv = p.lb()[h * 128 + d];
    float bb[16], qv[16], kk[16], vv[16];
    float cs = 0.f;
#pragma unroll
    for (int i = 0; i < 16; ++i) {
        const float f = lbv + (1.0f - lbv) * sigmoidf_(bf2f(hfp[(size_t)i * 512]));
        kk[i] = 1.0f - f; cs += __logf(f); bb[i] = cs;
        qv[i] = bf2f(hqp[(size_t)i * 512]); vv[i] = bf2f(hip[(size_t)i * 512]);
    }
    float* segs = (float*)(lds + X_SEG);
    segs[seg * 128 + d] = cs;
    __syncthreads();
    const float s0 = segs[d], s1 = segs[128 + d], s2 = segs[256 + d], s3 = segs[384 + d];
    const float off = seg == 0 ? 0.f : (seg == 1 ? s0 : (seg == 2 ? s0 + s1 : s0 + s1 + s2));
    const float rref = s0 + s1, blast = (s0 + s1) + (s2 + s3);
    uint32_t khp[8], vtp[8];
#pragma unroll
    for (int i = 0; i < 16; i += 2) {
        float khv[2];
#pragma unroll
        for (int j = 0; j < 2; ++j) {
            const float bt = bb[i + j] + off;
            const float eq = __expf(fminf(bt - rref, 80.f)), ek = __expf(fminf(rref - bt, 80.f));
            const int t = seg * 16 + i + j;
            *(bf16_t*)(lds + X_QT + t * 272 + d * 2) = f2bf(qv[i + j] * eq);
            *(bf16_t*)(lds + X_KT + t * 272 + d * 2) = f2bf(kk[i + j] * ek);
            hqp[(size_t)(i + j) * 512] = f2bf(qv[i + j] * __expf(bt));
            khv[j] = kk[i + j] * __expf(blast - bt);
        }
        khp[i >> 1] = pack2(khv[0], khv[1]); vtp[i >> 1] = pack2(vv[i], vv[i + 1]);
    }
    *(uint4*)(lds + X_KH + d * 144 + seg * 32) = make_uint4(khp[0], khp[1], khp[2], khp[3]);
    *(uint4*)(lds + X_KH + d * 144 + seg * 32 + 16) = make_uint4(khp[4], khp[5], khp[6], khp[7]);
    *(uint4*)(lds + X_VT + d * 144 + seg * 32) = make_uint4(vtp[0], vtp[1], vtp[2], vtp[3]);
    *(uint4*)(lds + X_VT + d * 144 + seg * 32 + 16) = make_uint4(vtp[4], vtp[5], vtp[6], vtp[7]);
    if (seg == 0) hg_g(p)[(size_t)u * 128 + d] = __expf(blast);
    __syncthreads();
    {
        const int tm = wid >> 1, tn0 = (wid & 1) * 2;
        f32x4 a1[2] = {(f32x4){0.f, 0.f, 0.f, 0.f}, (f32x4){0.f, 0.f, 0.f, 0.f}};
#pragma unroll
        for (int ks = 0; ks < 4; ++ks) {
            const bf16x8 aq = *(const bf16x8*)(lds + X_QT + (tm * 16 + fr) * 272 + (ks * 32 + fq * 8) * 2);
#pragma unroll
            for (int j = 0; j < 2; ++j) {
                const bf16x8 bk = *(const bf16x8*)(lds + X_KT + ((tn0 + j) * 16 + fr) * 272 + (ks * 32 + fq * 8) * 2);
                a1[j] = __builtin_amdgcn_mfma_f32_16x16x32_bf16(bk, aq, a1[j], 0, 0, 0);
            }
        }
#pragma unroll
        for (int j = 0; j < 2; ++j) {
            const int t = tm * 16 + fr, sb = (tn0 + j) * 16 + fq * 4;
            f32x4 v = a1[j];
#pragma unroll
            for (int jj = 0; jj < 4; ++jj) v[jj] = (sb + jj <= t) ? v[jj] : 0.f;
            uint2 o; o.x = pack2(v[0], v[1]); o.y = pack2(v[2], v[3]);
            *(uint2*)(lds + X_AS + t * 144 + sb * 2) = o;
        }
    }
    __syncthreads();
    {
        const int tm = wid >> 1, en0 = (wid & 1) * 4;
        f32x4 o2[4];
#pragma unroll
        for (int j = 0; j < 4; ++j) o2[j] = (f32x4){0.f, 0.f, 0.f, 0.f};
#pragma unroll
        for (int ks = 0; ks < 2; ++ks) {
            const bf16x8 aa = *(const bf16x8*)(lds + X_AS + (tm * 16 + fr) * 144 + (ks * 32 + fq * 8) * 2);
#pragma unroll
            for (int j = 0; j < 4; ++j) {
                const bf16x8 bv = *(const bf16x8*)(lds + X_VT + ((en0 + j) * 16 + fr) * 144 + (ks * 32 + fq * 8) * 2);
                o2[j] = __builtin_amdgcn_mfma_f32_16x16x32_bf16(bv, aa, o2[j], 0, 0, 0);
            }
        }
        bf16_t* orow = p.hf() + (size_t)(b * LP + c * 64 + tm * 16 + fr) * 512 + h * 128;
#pragma unroll
        for (int j = 0; j < 4; ++j) st_bf4(orow + (en0 + j) * 16 + fq * 4, o2[j]);
    }
    {
        f32x4 s3[8];
#pragma unroll
        for (int j = 0; j < 8; ++j) s3[j] = (f32x4){0.f, 0.f, 0.f, 0.f};
#pragma unroll
        for (int ks = 0; ks < 2; ++ks) {
            const bf16x8 ak = *(const bf16x8*)(lds + X_KH + (wid * 16 + fr) * 144 + (ks * 32 + fq * 8) * 2);
#pragma unroll
            for (int j = 0; j < 8; ++j) {
                const bf16x8 bv = *(const bf16x8*)(lds + X_VT + (j * 16 + fr) * 144 + (ks * 32 + fq * 8) * 2);
                s3[j] = __builtin_amdgcn_mfma_f32_16x16x32_bf16(ak, bv, s3[j], 0, 0, 0);
            }
        }
        bf16_t* dsb = hg_ds(p) + (size_t)u * 16384;
#pragma unroll
        for (int j = 0; j < 8; ++j) st_bf4(dsb + (size_t)(j * 16 + fr) * 128 + wid * 16 + fq * 4, s3[j]);
    }
    __syncthreads();
}

__device__ __forceinline__ void hgchain_unit(const P& p, int item) {
    const int tid = tid_(), bh = item >> 2, eq = item & 3;
    const int e = eq * 32 + (tid >> 4), d0 = (tid & 15) * 8;
    float S[8];
#pragma unroll
    for (int i = 0; i < 8; ++i) S[i] = 0.f;
    uint4* ptr = (uint4*)(hg_ds(p) + ((size_t)(bh * NCH) * 128 + e) * 128 + d0);
    const f32x4* gp = (const f32x4*)(hg_g(p) + (size_t)(bh * NCH) * 128 + d0);
    uint4 wq[8]; f32x4 g0[8], g1[8];
#pragma unroll
    for (int k = 0; k < 8; ++k) { wq[k] = ptr[(size_t)k * 2048]; g0[k] = gp[k * 32]; g1[k] = gp[k * 32 + 1]; }
    for (int c0 = 0; c0 < NCH; c0 += 8) {
#pragma unroll
        for (int k = 0; k < 8; ++k) {
            const int c = c0 + k;
            if (c < NCH) {
                const uint4 w = wq[k]; const f32x4 ga = g0[k], gb = g1[k];
                if (c + 8 < NCH) { wq[k] = ptr[(size_t)(c + 8) * 2048]; g0[k] = gp[(c + 8) * 32]; g1[k] = gp[(c + 8) * 32 + 1]; }
                ptr[(size_t)c * 2048] = make_uint4(pack2(S[0], S[1]), pack2(S[2], S[3]), pack2(S[4], S[5]), pack2(S[6], S[7]));
                S[0] = ga[0] * S[0] + __uint_as_float(w.x << 16); S[1] = ga[1] * S[1] + __uint_as_float(w.x & 0xffff0000u);
                S[2] = ga[2] * S[2] + __uint_as_float(w.y << 16); S[3] = ga[3] * S[3] + __uint_as_float(w.y & 0xffff0000u);
                S[4] = gb[0] * S[4] + __uint_as_float(w.z << 16); S[5] = gb[1] * S[5] + __uint_as_float(w.z & 0xffff0000u);
                S[6] = gb[2] * S[6] + __uint_as_float(w.w << 16); S[7] = gb[3] * S[7] + __uint_as_float(w.w & 0xffff0000u);
            }
        }
    }
}

__device__ __forceinline__ void hgz_unit(const P& p, unsigned char* lds, int u) {
    const int tid = tid_(), lane = tid & 63, wid = tid >> 6, fr = lane & 15, fq = lane >> 4;
    const int c = u % NCH, bh = u / NCH, b = bh >> 2, h = bh & 3;
    const int tm = wid >> 1, en0 = (wid & 1) * 4;
    const size_t row = (size_t)(b * LP + c * 64 + tm * 16 + fr);
    const bf16_t* qrow = p.hq() + row * 512 + h * 128;
    const bf16_t* sT = hg_ds(p) + (size_t)u * 16384;
    f32x4 o[4];
#pragma unroll
    for (int j = 0; j < 4; ++j) o[j] = (f32x4){0.f, 0.f, 0.f, 0.f};
#pragma unroll
    for (int ks = 0; ks < 4; ++ks) {
        const bf16x8 aq = *(const bf16x8*)(qrow + ks * 32 + fq * 8);
#pragma unroll
        for (int j = 0; j < 4; ++j) {
            const bf16x8 bs = *(const bf16x8*)(sT + (size_t)((en0 + j) * 16 + fr) * 128 + ks * 32 + fq * 8);
            o[j] = __builtin_amdgcn_mfma_f32_16x16x32_bf16(bs, aq, o[j], 0, 0, 0);
        }
    }
    const bf16_t* oi = p.hf() + row * 512 + h * 128;
    float ss = 0.f;
#pragma unroll
    for (int j = 0; j < 4; ++j) {
        const uint2 w = *(const uint2*)(oi + (en0 + j) * 16 + fq * 4);
        o[j][0] += __uint_as_float(w.x << 16); o[j][1] += __uint_as_float(w.x & 0xffff0000u);
        o[j][2] += __uint_as_float(w.y << 16); o[j][3] += __uint_as_float(w.y & 0xffff0000u);
        ss += o[j][0] * o[j][0] + o[j][1] * o[j][1] + o[j][2] * o[j][2] + o[j][3] * o[j][3];
    }
    ss = xsum32(xsum16(ss));
    const bf16_t* hgp = p.hg() + row * 512 + h * 128;
    bf16_t* outp = p.hgr() + row * 512 + h * 128;
    f32x4 gnv[4]; uint2 hgv[4];
#pragma unroll
    for (int j = 0; j < 4; ++j) { const int e0 = (en0 + j) * 16 + fq * 4; gnv[j] = *(const f32x4*)(p.hgrn_g + h * 128 + e0); hgv[j] = *(const uint2*)(hgp + e0); }
    float* part = (float*)lds;
    if (fq == 0) part[(tm * 16 + fr) * 2 + (wid & 1)] = ss;
    __syncthreads();
    const float tot = part[(tm * 16 + fr) * 2] + part[(tm * 16 + fr) * 2 + 1];
    const float rs = rsqrtf(tot * (1.0f / 128.0f) + EPS);
#pragma unroll
    for (int j = 0; j < 4; ++j) {
        const int e0 = (en0 + j) * 16 + fq * 4;
        const f32x4 gn = gnv[j];
        const uint2 w = hgv[j];
        f32x4 r;
        r[0] = o[j][0] * rs * gn[0] * __uint_as_float(w.x << 16); r[1] = o[j][1] * rs * gn[1] * __uint_as_float(w.x & 0xffff0000u);
        r[2] = o[j][2] * rs * gn[2] * __uint_as_float(w.y << 16); r[3] = o[j][3] * rs * gn[3] * __uint_as_float(w.y & 0xffff0000u);
        st_bf4(outp + e0, r);
    }
    __syncthreads();
}

typedef float f32x16 __attribute__((ext_vector_type(16)));
typedef short s16x4 __attribute__((ext_vector_type(4)));

constexpr int NKMAX = 8224;
constexpr int NBIN = 1024;
constexpr int A_SC = 0, A_H1 = A_SC + 4 * NKMAX * 4, A_SEL = A_H1 + 4 * NBIN * 4, A_CAND = A_SEL + 2048, A_META = A_CAND + 1024, A_END = A_META + 256;
static_assert(A_END <= LDS_BYTES - 16, "attention LDS");
__device__ __forceinline__ uint32_t skey(float f) { const uint32_t u = __float_as_uint(f); return (u & 0x80000000u) ? ~u : (u | 0x80000000u); }
__device__ __forceinline__ float skey_inv(uint32_t k) { return __uint_as_float((k & 0x80000000u) ? (k & 0x7fffffffu) : ~k); }
__device__ __forceinline__ int bin1(float s, float lo, float scale) { return min(NBIN - 1, max(0, (int)((s - lo) * scale))); }
template <int OFF> __device__ __forceinline__ s16x4 tr_read(unsigned addr) {
    s16x4 r; asm volatile("ds_read_b64_tr_b16 %0, %1 offset:%2" : "=&v"(r) : "v"(addr), "i"(OFF) : "memory"); return r;
}
__device__ __forceinline__ void scan_top(const int* hist, int K, int* m, int lane) {
    int c[16];
#pragma unroll
    for (int i = 0; i < 4; ++i) { const int4 v = *(const int4*)(hist + 16 * lane + 4 * i); c[4 * i] = v.x; c[4 * i + 1] = v.y; c[4 * i + 2] = v.z; c[4 * i + 3] = v.w; }
    int tot = 0;
#pragma unroll
    for (int i = 0; i < 16; ++i) tot += c[i];
    int suf = tot;
#pragma unroll
    for (int o = 1; o < 64; o <<= 1) { const int t = __shfl_down(suf, o); if (lane + o < 64) suf += t; }
    int above = suf - tot;
#pragma unroll
    for (int i = 15; i >= 0; --i) {
        if (above < K && K <= above + c[i]) { m[0] = 16 * lane + i; m[1] = above; m[2] = c[i]; }
        above += c[i];
    }
}

__device__ __forceinline__ void attn4_unit(const P& p, unsigned char* lds, int b, int grp) {
    const int tid = tid_(), lane = tid & 63, wid = __builtin_amdgcn_readfirstlane(tid >> 6);
    const int t0 = NMETA + 4 * grp;
    const int brow = b * LP, row0 = brow + t0;
    float* sc = (float*)(lds + A_SC);
    int* h1 = (int*)(lds + A_H1);
    unsigned short* sel = (unsigned short*)(lds + A_SEL); unsigned short* cand = (unsigned short*)(lds + A_CAND);
    int* meta = (int*)(lds + A_META);
    const bool big = t0 + 1 > 256;
    for (int i = tid; i < 4 * NBIN; i += NTHREADS) h1[i] = 0;
    if (tid < 64) { const int w = tid & 15; meta[tid] = (w == 0) ? -1 : 0; }
    if (!big) { for (int i = tid; i < 1024; i += NTHREADS) { const int q = i >> 8, j = i & 255; sel[i] = (unsigned short)(j <= t0 + q ? j : 0); } }
    __syncthreads();
    if (big) {
        {
            const int hh = lane >> 5, c32 = lane & 31;
            const int g = c32 >> 3, h2a = (c32 >> 2) & 1, bq = c32 & 3, aq = 2 * h2a + (g >> 1), ah = 4 * (g & 1) + bq;
            const bf16_t* ap = p.iq() + (size_t)(row0 + aq) * 256 + ah * 32 + 8 * hh;
            const bf16x8 a0 = *(const bf16x8*)ap, a1 = *(const bf16x8*)(ap + 16);
            const f32x4 w00 = *(const f32x4*)(p.iw() + (size_t)(row0 + 2 * hh) * 8), w01 = *(const f32x4*)(p.iw() + (size_t)(row0 + 2 * hh) * 8 + 4);
            const f32x4 w10 = *(const f32x4*)(p.iw() + (size_t)(row0 + 2 * hh + 1) * 8), w11 = *(const f32x4*)(p.iw() + (size_t)(row0 + 2 * hh + 1) * 8 + 4);
            const int ntiles = (t0 + 4 + 31) >> 5;
            const int tq0 = t0 + 2 * hh;
            float mx0 = -INFINITY, mn0 = INFINITY, mx1 = -INFINITY, mn1 = INFINITY;
            const bf16_t* kbase = p.ik() + (size_t)brow * 32 + 8 * hh;
            for (int tile0 = wid; tile0 < ntiles; tile0 += 128) {
                bf16x8 b0[16], b1[16];
#pragma unroll
                for (int j = 0; j < 16; ++j) {
                    const int tile = min(tile0 + 8 * j, ntiles - 1);
                    const bf16_t* kp = kbase + (size_t)(tile * 32 + c32) * 32;
                    b0[j] = *(const bf16x8*)kp; b1[j] = *(const bf16x8*)(kp + 16);
                }
                __builtin_amdgcn_sched_barrier(0);
#pragma unroll
                for (int j = 0; j < 16; ++j) {
                    const int tile = tile0 + 8 * j;
                    if (tile < ntiles) {
                        const int key = tile * 32 + c32;
                        f32x16 acc;
#pragma unroll
                        for (int i = 0; i < 16; ++i) acc[i] = 0.f;
                        acc = __builtin_amdgcn_mfma_f32_32x32x16_bf16(a0, b0[j], acc, 0, 0, 0);
                        acc = __builtin_amdgcn_mfma_f32_32x32x16_bf16(a1, b1[j], acc, 0, 0, 0);
                        float s0 = 0.f, s1 = 0.f;
#pragma unroll
                        for (int i = 0; i < 4; ++i) {
                            s0 += w00[i] * fmaxf(acc[i], 0.f) + w01[i] * fmaxf(acc[4 + i], 0.f);
                            s1 += w10[i] * fmaxf(acc[8 + i], 0.f) + w11[i] * fmaxf(acc[12 + i], 0.f);
                        }
                        sc[(2 * hh) * NKMAX + key] = s0; sc[(2 * hh + 1) * NKMAX + key] = s1;
                        if (key <= tq0) { mx0 = fmaxf(mx0, s0); mn0 = fminf(mn0, s0); }
                        if (key <= tq0 + 1) { mx1 = fmaxf(mx1, s1); mn1 = fminf(mn1, s1); }
                    }
                }
            }
#pragma unroll
            for (int o = 16; o >= 1; o >>= 1) {
                mx0 = fmaxf(mx0, __shfl_xor(mx0, o)); mn0 = fminf(mn0, __shfl_xor(mn0, o));
                mx1 = fmaxf(mx1, __shfl_xor(mx1, o)); mn1 = fminf(mn1, __shfl_xor(mn1, o));
            }
            if (c32 == 0) {
                if (mx0 >= mn0) { atomicMin((unsigned*)&meta[(2 * hh) * 16 + 0], skey(mn0)); atomicMax((unsigned*)&meta[(2 * hh) * 16 + 1], skey(mx0)); }
                if (mx1 >= mn1) { atomicMin((unsigned*)&meta[(2 * hh + 1) * 16 + 0], skey(mn1)); atomicMax((unsigned*)&meta[(2 * hh + 1) * 16 + 1], skey(mx1)); }
            }
        }
        __syncthreads();
        const int q = wid & 3, part = wid >> 2, n = t0 + q + 1;
        const float lo = skey_inv((unsigned)meta[q * 16 + 0]), hi = skey_inv((unsigned)meta[q * 16 + 1]);
        const float scale = hi > lo ? (float)NBIN / (hi - lo) : 0.f;
        const float* scq = sc + q * NKMAX;
        for (int base = part * 256; base < n; base += 512) {
            const int idx0 = base + lane * 4;
            if (idx0 < n) {
                const f32x4 v = *(const f32x4*)(scq + idx0);
#pragma unroll
                for (int j = 0; j < 4; ++j) if (idx0 + j < n) atomicAdd(&h1[q * NBIN + bin1(v[j], lo, scale)], 1);
            }
        }
        __syncthreads();
        if (wid < 4) scan_top(h1 + wid * NBIN, 256, meta + wid * 16 + 4, lane);
        __syncthreads();
        const int B1 = meta[q * 16 + 4];
        for (int base = part * 256; base < n; base += 512) {
            const int idx0 = base + lane * 4;
            f32x4 v = (f32x4){0.f, 0.f, 0.f, 0.f};
            if (idx0 < n) v = *(const f32x4*)(scq + idx0);
            const unsigned long long lt = (1ull << lane) - 1ull;
#pragma unroll
            for (int j = 0; j < 4; ++j) {
                const int idx = idx0 + j;
                bool issel = false, iscand = false;
                if (idx < n) { const int b1 = bin1(v[j], lo, scale); issel = b1 > B1; iscand = b1 == B1; }
                const unsigned long long ms = __ballot(issel), mc = __ballot(iscand);
                if (ms) {
                    int bs = 0; if (lane == 0) bs = atomicAdd(&meta[q * 16 + 2], __popcll(ms));
                    bs = __shfl(bs, 0);
                    if (issel) sel[q * 256 + bs + __popcll(ms & lt)] = (unsigned short)idx;
                }
                if (mc) {
                    int bs = 0; if (lane == 0) bs = atomicAdd(&meta[q * 16 + 3], __popcll(mc));
                    bs = __shfl(bs, 0);
                    const int pos = bs + __popcll(mc & lt);
                    if (iscand && pos < 128) cand[q * 128 + pos] = (unsigned short)idx;
                }
            }
        }
        __syncthreads();
        if (wid < 4) {
            const int qq = wid; const float* scr = sc + qq * NKMAX;
            const int rq = 256 - meta[qq * 16 + 5], cq = meta[qq * 16 + 6], sbase = 256 - rq, nn = t0 + qq + 1;
            if (cq <= 128) {
                int taken = 0;
#pragma unroll
                for (int half = 0; half < 2; ++half) {
                    const int i = lane + 64 * half;
                    bool take = false; int myidx = 0;
                    if (i < cq) {
                        myidx = cand[qq * 128 + i]; const float mv = scr[myidx];
                        int rank = 0;
                        for (int j = 0; j < cq; ++j) { const int oj = cand[qq * 128 + j]; const float ov = scr[oj]; rank += (ov > mv) || (ov == mv && oj < myidx); }
                        take = rank < rq;
                    }
                    const unsigned long long mt = __ballot(take);
                    if (take) sel[qq * 256 + sbase + taken + __popcll(mt & ((1ull << lane) - 1ull))] = (unsigned short)myidx;
                    taken += __popcll(mt);
                }
            } else {
                const float lo_ = skey_inv((unsigned)meta[qq * 16 + 0]), hi_ = skey_inv((unsigned)meta[qq * 16 + 1]);
                const float sc_ = hi_ > lo_ ? (float)NBIN / (hi_ - lo_) : 0.f;
                const int B1_ = meta[qq * 16 + 4];
                int taken = 0;
                for (int base = 0; base < nn && taken < rq; base += 64) {
                    const int idx = base + lane; bool isc = false;
                    if (idx < nn) isc = bin1(scr[idx], lo_, sc_) == B1_;
                    const unsigned long long mc = __ballot(isc);
                    const int pos = taken + __popcll(mc & ((1ull << lane) - 1ull));
                    if (isc && pos < rq) sel[qq * 256 + sbase + pos] = (unsigned short)idx;
                    taken += __popcll(mc);
                }
            }
        }
        __syncthreads();
    }
    {
        const int q = wid >> 1, kvh = wid & 1, tq = t0 + q, nsel = min(tq + 1, 256);
        const int col = lane & 15, g4 = lane >> 4;
        const unsigned short* selq = sel + q * 256;
        bf16x8 qf0, qf1;
        {
            const bf16_t* qp = p.q() + (size_t)(row0 + q) * 512 + (kvh * 4 + (col & 3)) * 64 + g4 * 8;
            qf0 = *(const bf16x8*)qp; qf1 = *(const bf16x8*)(qp + 32);
            if (col >= 4) {
#pragma unroll
                for (int i = 0; i < 8; ++i) { qf0[i] = 0; qf1[i] = 0; }
            }
        }
        LAS unsigned char* vst = (LAS unsigned char*)lds + A_SC + wid * 16384;
        const bf16_t* vb = p.v() + (size_t)brow * 128 + kvh * 64 + (lane & 7) * 8;
        const unsigned rdbase = (unsigned)(uintptr_t)((LAS unsigned char*)lds + A_SC) + wid * 16384 + (4 * g4 + (col >> 2)) * 128 + (col & 3) * 8;
#define V_STAGE(s_, buf_) do { _Pragma("unroll") for (int i_ = 0; i_ < 4; ++i_) { \
            const int ksl_ = (s_) * 32 + i_ * 8 + (lane >> 3); const int key_ = selq[ksl_]; \
            __builtin_amdgcn_global_load_lds((const unsigned*)(vb + (size_t)key_ * 128), (LAS unsigned*)(vst + (buf_) * 4096 + i_ * 1024), 16, 0, 0); } } while (0)
        const bf16_t* kb = p.k() + (size_t)brow * 128 + kvh * 64 + g4 * 8;
        f32x4 lg[16];
        u32x4 vr[16];
        {
            bf16x8 k0[16], k1[16];
#pragma unroll
            for (int t = 0; t < 16; ++t) {
                const int key = selq[t * 16 + col];
                const bf16_t* kp = kb + (size_t)key * 128;
                k0[t] = *(const bf16x8*)kp; k1[t] = *(const bf16x8*)(kp + 32);
            }
#pragma unroll
            for (int s = 4; s < 8; ++s)
#pragma unroll
                for (int i = 0; i < 4; ++i) { const int key = selq[s * 32 + i * 8 + (lane >> 3)]; vr[(s - 4) * 4 + i] = *(const u32x4*)(vb + (size_t)key * 128); }
            V_STAGE(0, 0); V_STAGE(1, 1); V_STAGE(2, 2); V_STAGE(3, 3);
            __builtin_amdgcn_sched_barrier(0);
#pragma unroll
            for (int t = 0; t < 16; ++t) {
                f32x4 a = (f32x4){0.f, 0.f, 0.f, 0.f};
                a = __builtin_amdgcn_mfma_f32_16x16x32_bf16(k0[t], qf0, a, 0, 0, 0);
                a = __builtin_amdgcn_mfma_f32_16x16x32_bf16(k1[t], qf1, a, 0, 0, 0);
                lg[t] = a;
            }
            __builtin_amdgcn_sched_barrier(0);
        }
        float mx = -INFINITY;
#pragma unroll
        for (int t = 0; t < 16; ++t)
#pragma unroll
            for (int j = 0; j < 4; ++j) { if (t * 16 + g4 * 4 + j >= nsel) lg[t][j] = -INFINITY; mx = fmaxf(mx, lg[t][j]); }
        mx = fmaxf(mx, __shfl_xor(mx, 16)); mx = fmaxf(mx, __shfl_xor(mx, 32));
        float sm = 0.f;
#pragma unroll
        for (int t = 0; t < 16; ++t)
#pragma unroll
            for (int j = 0; j < 4; ++j) { const float e = __builtin_amdgcn_exp2f(lg[t][j] - mx); lg[t][j] = e; sm += e; }
        sm += __shfl_xor(sm, 16); sm += __shfl_xor(sm, 32);
        const float inv = 1.0f / sm;
        f32x4 o[4];
#pragma unroll
        for (int d = 0; d < 4; ++d) o[d] = (f32x4){0.f, 0.f, 0.f, 0.f};
        asm volatile("s_waitcnt vmcnt(0)" ::: "memory");
#pragma unroll
        for (int s = 0; s < 8; ++s) {
            if (s >= 4) {
#pragma unroll
                for (int i = 0; i < 4; ++i) *(LAS u32x4*)(vst + (s & 3) * 4096 + i * 1024 + lane * 16) = vr[(s - 4) * 4 + i];
                asm volatile("s_waitcnt lgkmcnt(0)" ::: "memory");
            }
            const unsigned rb = rdbase + (s & 3) * 4096;
            const s16x4 l0 = tr_read<0>(rb), h0 = tr_read<2048>(rb), l1 = tr_read<32>(rb), h1_ = tr_read<2048 + 32>(rb);
            const s16x4 l2 = tr_read<64>(rb), h2_ = tr_read<2048 + 64>(rb), l3 = tr_read<96>(rb), h3 = tr_read<2048 + 96>(rb);
            asm volatile("s_waitcnt lgkmcnt(0)" ::: "memory");
            __builtin_amdgcn_sched_barrier(0);
            bf16x8 pa;
            {
                const uint32_t w0 = pack2(lg[2 * s][0], lg[2 * s][1]), w1 = pack2(lg[2 * s][2], lg[2 * s][3]);
                const uint32_t w2 = pack2(lg[2 * s + 1][0], lg[2 * s + 1][1]), w3 = pack2(lg[2 * s + 1][2], lg[2 * s + 1][3]);
                pa[0] = (short)(w0 & 0xffff); pa[1] = (short)(w0 >> 16); pa[2] = (short)(w1 & 0xffff); pa[3] = (short)(w1 >> 16);
                pa[4] = (short)(w2 & 0xffff); pa[5] = (short)(w2 >> 16); pa[6] = (short)(w3 & 0xffff); pa[7] = (short)(w3 >> 16);
            }
#define PKV(L, H) (bf16x8){L[0], L[1], L[2], L[3], H[0], H[1], H[2], H[3]}
            o[0] = __builtin_amdgcn_mfma_f32_16x16x32_bf16(pa, PKV(l0, h0), o[0], 0, 0, 0);
            o[1] = __builtin_amdgcn_mfma_f32_16x16x32_bf16(pa, PKV(l1, h1_), o[1], 0, 0, 0);
            o[2] = __builtin_amdgcn_mfma_f32_16x16x32_bf16(pa, PKV(l2, h2_), o[2], 0, 0, 0);
            o[3] = __builtin_amdgcn_mfma_f32_16x16x32_bf16(pa, PKV(l3, h3), o[3], 0, 0, 0);
#undef PKV
        }
#undef V_STAGE
        const float i0 = __shfl(inv, 0), i1 = __shfl(inv, 1), i2 = __shfl(inv, 2), i3 = __shfl(inv, 3);
        if (g4 == 0) {
            bf16_t* op = p.att() + (size_t)(row0 + q) * 512 + kvh * 256 + col;
#pragma unroll
            for (int d = 0; d < 4; ++d) {
                op[0 * 64 + d * 16] = f2bf(o[d][0] * i0); op[1 * 64 + d * 16] = f2bf(o[d][1] * i1);
                op[2 * 64 + d * 16] = f2bf(o[d][2] * i2); op[3 * 64 + d * 16] = f2bf(o[d][3] * i3);
            }
        }
    }
    __syncthreads();
}

constexpr int NBW = 512;
constexpr int W_SC = 0, W_H = W_SC + NKMAX * 2, W_SEL = W_H + NBW * 4, W_CAND = W_SEL + 512, W_SZ = W_CAND + 256;
static_assert(8 * W_SZ <= LDS_BYTES - 32, "wave attention LDS");
__device__ __forceinline__ int binw(float s, float lo, float scale) { return min(NBW - 1, max(0, (int)((s - lo) * scale))); }

__device__ __forceinline__ void attn_wave(const P& p, unsigned char* lds, int wid, int lane, int b, int t) {
    unsigned char* wl = lds + wid * W_SZ;
    _Float16* sc = (_Float16*)(wl + W_SC);
    int* hist = (int*)(wl + W_H);
    unsigned short* sel = (unsigned short*)(wl + W_SEL);
    unsigned short* cand = (unsigned short*)(wl + W_CAND);
    const int brow = b * LP, row = brow + t, n = t + 1;
    const int col = lane & 15, g4 = lane >> 4;
    const unsigned long long lt = (1ull << lane) - 1ull;
    int nsel = 256;
    if (n > 256) {
        float mn, mx;
        {
            typedef _Float16 h2 __attribute__((ext_vector_type(2)));
            h2 hmx = {(_Float16)-65504.f, (_Float16)-65504.f}, hmn = {(_Float16)65504.f, (_Float16)65504.f};
            for (int base = 0; base < n; base += 256) {
                const int ia = base + lane * 4;
                if (ia + 3 < n) {
                    const uint2 ra = *(const uint2*)(sc + ia);
                    const h2 x0 = __builtin_bit_cast(h2, ra.x), x1 = __builtin_bit_cast(h2, ra.y);
                    hmx = __builtin_elementwise_max(hmx, __builtin_elementwise_max(x0, x1)); hmn = __builtin_elementwise_min(hmn, __builtin_elementwise_min(x0, x1));
                } else {
                    for (int j = 0; j < 3; ++j) if (ia + j < n) { const _Float16 x = sc[ia + j]; hmx[0] = x > hmx[0] ? x : hmx[0]; hmn[0] = x < hmn[0] ? x : hmn[0]; }
                }
            }
            float a = fmaxf((float)hmx[0], (float)hmx[1]), c = fminf((float)hmn[0], (float)hmn[1]);
            a = xmax32(xmax16(a)); c = fminf(c, lane_xor_f<32>(c)); c = xmin16(c);
            a = fmaxf(a, lane_xor_f<8>(a)); c = fminf(c, lane_xor_f<8>(c)); a = fmaxf(a, lane_xor_f<4>(a)); c = fminf(c, lane_xor_f<4>(c));
            a = fmaxf(a, lane_xor_f<2>(a)); c = fminf(c, lane_xor_f<2>(c)); a = fmaxf(a, lane_xor_f<1>(a)); c = fminf(c, lane_xor_f<1>(c));
            mx = a; mn = c;
        }
        const float scale = mx > mn ? (float)NBW / (mx - mn) : 0.f, nls = -mn * scale;
#define BINF(x) min(NBW - 1, max(0, (int)__builtin_fmaf((x), scale, nls)))
#define H2F(u16) ((float)__builtin_bit_cast(_Float16, (unsigned short)(u16)))
        {
            uint2 ra = *(const uint2*)(sc + lane * 4), rb2 = *(const uint2*)(sc + lane * 4 + 256);
            for (int base = 0; base < n; base += 512) {
                const int ia = base + lane * 4, ib = ia + 256;
                const unsigned wa[4] = {ra.x & 0xffffu, ra.x >> 16, ra.y & 0xffffu, ra.y >> 16}, wb[4] = {rb2.x & 0xffffu, rb2.x >> 16, rb2.y & 0xffffu, rb2.y >> 16};
                ra = *(const uint2*)(sc + ia + 512); rb2 = *(const uint2*)(sc + ib + 512);
#pragma unroll
                for (int j = 0; j < 4; ++j) {
                    atomicAdd(&hist[BINF(H2F(wa[j]))], ia + j < n ? 1 : 0);
                    atomicAdd(&hist[BINF(H2F(wb[j]))], ib + j < n ? 1 : 0);
                }
            }
        }
        int B1, above1, cnt1;
        {
            int c[8];
            const int4 v0 = *(const int4*)(hist + 8 * lane), v1 = *(const int4*)(hist + 8 * lane + 4);
            c[0] = v0.x; c[1] = v0.y; c[2] = v0.z; c[3] = v0.w; c[4] = v1.x; c[5] = v1.y; c[6] = v1.z; c[7] = v1.w;
            int tot = 0;
#pragma unroll
            for (int i = 0; i < 8; ++i) tot += c[i];
            const int pre = wave_incl_scan(tot);
            int above = __builtin_amdgcn_readlane(pre, 63) - pre;
            const bool mine = above < 256 && 256 <= above + tot;
            int bb = 0, ab = 0, cb = 0;
#pragma unroll
            for (int i = 7; i >= 0; --i) { if (above < 256 && 256 <= above + c[i]) { bb = 8 * lane + i; ab = above; cb = c[i]; } above += c[i]; }
            const int src = (int)__builtin_ctzll(__ballot(mine));
            B1 = __builtin_amdgcn_readlane(bb, src); above1 = __builtin_amdgcn_readlane(ab, src); cnt1 = __builtin_amdgcn_readlane(cb, src);
        }
        int selcnt = 0, candcnt = 0;
        const float hi_m = B1 < NBW - 1 ? __uint_as_float(__float_as_uint((float)(B1 + 1)) - 1u) : INFINITY;
        const float lo_m = B1 > 0 ? __uint_as_float(__float_as_uint((float)B1) - 1u) : -INFINITY;
        uint2 ra = *(const uint2*)(sc + lane * 4), rb2 = *(const uint2*)(sc + lane * 4 + 256);
        for (int base = 0; base < n; base += 512) {
            const int ia = base + lane * 4, ib = ia + 256;
            const unsigned wv[8] = {ra.x & 0xffffu, ra.x >> 16, ra.y & 0xffffu, ra.y >> 16, rb2.x & 0xffffu, rb2.x >> 16, rb2.y & 0xffffu, rb2.y >> 16};
            ra = *(const uint2*)(sc + ia + 512); rb2 = *(const uint2*)(sc + ib + 512);
            const int nva = min(max(n - ia, 0), 4), nvb = min(max(n - ib, 0), 4);
            const unsigned vm = ((1u << nva) - 1u) | (((1u << nvb) - 1u) << 4);
            unsigned sm = 0u, gm = 0u;
#pragma unroll
            for (int j = 7; j >= 0; --j) {
                const float y = __builtin_fmaf(H2F(wv[j]), scale, nls);
                sm = __builtin_amdgcn_alignbit(sm, __float_as_uint(hi_m - y), 31);
                gm = __builtin_amdgcn_alignbit(gm, __float_as_uint(lo_m - y), 31);
            }
            const unsigned smask = sm & vm, cmask = gm & ~sm & vm;
            const int cnt = __popc(smask);
            const int inc = wave_incl_scan(cnt);
            int pos = selcnt + inc - cnt;
#pragma unroll
            for (int j = 0; j < 8; ++j) {
                const unsigned sj = (smask >> j) & 1u;
                unsigned short* dst = sj ? sel + pos : (unsigned short*)hist + lane;
                *dst = (unsigned short)((j < 4 ? ia : ib) + (j & 3)); pos += (int)sj;
            }
            selcnt += __builtin_amdgcn_readlane(inc, 63);
            if (__ballot(cmask != 0u)) {
#pragma unroll
                for (int j = 0; j < 8; ++j) {
                    const bool isc = (cmask >> j) & 1u;
                    const unsigned long long mc = __ballot(isc);
                    const int cp = candcnt + __popcll(mc & lt);
                    if (isc && cp < 128) cand[cp] = (unsigned short)((j < 4 ? ia : ib) + (j & 3));
                    candcnt += __popcll(mc);
                }
            }
        }
        {
            const int rq = 256 - above1, cq = cnt1, sbase = 256 - rq;
            if (cq <= 128) {
                const int i0 = lane, i1 = lane + 64;
                int ci0 = 0, ci1 = 0; float cv0 = -INFINITY, cv1 = -INFINITY;
                if (i0 < cq) { ci0 = cand[i0]; cv0 = (float)sc[ci0]; }
                if (i1 < cq) { ci1 = cand[i1]; cv1 = (float)sc[ci1]; }
                int rank0 = 0, rank1 = 0;
                const int c64 = cq < 64 ? cq : 64;
                for (int j = 0; j < c64; ++j) {
                    const int oj = __builtin_amdgcn_readlane(ci0, j); const float ov = readlane_f(cv0, j);
                    rank0 += (ov > cv0) || (ov == cv0 && oj < ci0); rank1 += (ov > cv1) || (ov == cv1 && oj < ci1);
                }
                for (int j = 64; j < cq; ++j) {
                    const int oj = __builtin_amdgcn_readlane(ci1, j - 64); const float ov = readlane_f(cv1, j - 64);
                    rank0 += (ov > cv0) || (ov == cv0 && oj < ci0); rank1 += (ov > cv1) || (ov == cv1 && oj < ci1);
                }
                int taken = 0;
                {
                    const bool take = i0 < cq && rank0 < rq;
                    const unsigned long long mt = __ballot(take);
                    if (take) sel[sbase + taken + __popcll(mt & lt)] = (unsigned short)ci0;
                    taken += __popcll(mt);
                }
                {
                    const bool take = i1 < cq && rank1 < rq;
                    const unsigned long long mt = __ballot(take);
                    if (take) sel[sbase + taken + __popcll(mt & lt)] = (unsigned short)ci1;
                    taken += __popcll(mt);
                }
            } else {
                int taken = 0;
                for (int base = 0; base < n && taken < rq; base += 64) {
                    const int idx = base + lane; bool isc = false;
                    if (idx < n) isc = BINF((float)sc[idx]) == B1;
                    const unsigned long long mc = __ballot(isc);
                    const int pos = taken + __popcll(mc & lt);
                    if (isc && pos < rq) sel[sbase + pos] = (unsigned short)idx;
                    taken += __popcll(mc);
                }
            }
        }
#undef BINF
#undef H2F
    } else {
        nsel = n;
#pragma unroll
        for (int i = 0; i < 4; ++i) { const int j = lane + 64 * i; sel[j] = (unsigned short)(j < n ? j : 0); }
    }
    LAS unsigned char* vst = (LAS unsigned char*)wl + W_SC;
    {
        long qf[4];
        {
            const unsigned char* qp = p.q8() + (size_t)row * 512 + (col & 7) * 64 + g4 * 8;
            const long q0 = *(const long*)qp, q1 = *(const long*)(qp + 32);
            const bool lo_grp = col < 4, hi_grp = col >= 4 && col < 8;
            qf[0] = lo_grp ? q0 : 0l; qf[1] = lo_grp ? q1 : 0l; qf[2] = hi_grp ? q0 : 0l; qf[3] = hi_grp ? q1 : 0l;
        }
#define A_WAITV(n_) do { if ((n_) >= 14) asm volatile("s_waitcnt vmcnt(14)" ::: "memory"); else if ((n_) == 12) asm volatile("s_waitcnt vmcnt(12)" ::: "memory"); \
            else if ((n_) == 10) asm volatile("s_waitcnt vmcnt(10)" ::: "memory"); else if ((n_) == 8) asm volatile("s_waitcnt vmcnt(8)" ::: "memory"); \
            else if ((n_) == 6) asm volatile("s_waitcnt vmcnt(6)" ::: "memory"); else if ((n_) == 4) asm volatile("s_waitcnt vmcnt(4)" ::: "memory"); \
            else if ((n_) == 2) asm volatile("s_waitcnt vmcnt(2)" ::: "memory"); else asm volatile("s_waitcnt vmcnt(0)" ::: "memory"); } while (0)
        const unsigned char* kg = p.k8() + (size_t)brow * 128;
#define K_STAGE(s_) do { _Pragma("unroll") for (int i_ = 0; i_ < 2; ++i_) { \
            const int kl_ = i_ * 8 + (lane >> 3); const int key_ = sel[(s_) * 16 + kl_]; \
            __builtin_amdgcn_global_load_lds((const unsigned*)(kg + (size_t)key_ * 128 + (((lane & 7) ^ (kl_ >> 1)) & 7) * 16), (LAS unsigned*)(vst + ((s_) & 7) * 2048 + i_ * 1024), 16, 0, 0); } } while (0)
        f32x4 lg[16];
        K_STAGE(0); K_STAGE(1); K_STAGE(2); K_STAGE(3); K_STAGE(4); K_STAGE(5); K_STAGE(6);
#pragma unroll
        for (int s = 0; s < 16; ++s) {
            if (s + 7 < 16) K_STAGE(s + 7);
            A_WAITV(2 * (15 - s < 7 ? 15 - s : 7));
            long kf[4];
#pragma unroll
            for (int ks = 0; ks < 4; ++ks) kf[ks] = *(const LAS long*)(vst + (s & 7) * 2048 + col * 128 + (((ks * 2 + (g4 >> 1)) ^ (col >> 1)) & 7) * 16 + (g4 & 1) * 8);
            asm volatile("s_waitcnt lgkmcnt(0)" ::: "memory");
            __builtin_amdgcn_sched_barrier(0);
            f32x4 a = (f32x4){0.f, 0.f, 0.f, 0.f};
#pragma unroll
            for (int ks = 0; ks < 4; ++ks) a = __builtin_amdgcn_mfma_f32_16x16x32_fp8_fp8(kf[ks], qf[ks], a, 0, 0, 0);
            lg[s] = a * 0.125f;
        }
#undef K_STAGE
        const unsigned char* vg = p.v8() + (size_t)brow * 128;
#define V_STAGE(s_) do { _Pragma("unroll") for (int i_ = 0; i_ < 2; ++i_) { \
            const int kl_ = i_ * 8 + (lane >> 3); const int key_ = sel[(s_) * 16 + kl_]; \
            __builtin_amdgcn_global_load_lds((const unsigned*)(vg + (size_t)key_ * 128 + ((lane & 7) ^ (((kl_ >> 1) & 3) | (((s_) & 1) << 2))) * 16), (LAS unsigned*)(vst + ((s_) & 7) * 2048 + i_ * 1024), 16, 0, 0); } } while (0)
        V_STAGE(0); V_STAGE(1); V_STAGE(2); V_STAGE(3); V_STAGE(4); V_STAGE(5);
        float mxl = -INFINITY;
#pragma unroll
        for (int tt = 0; tt < 16; ++tt)
#pragma unroll
            for (int j = 0; j < 4; ++j) { if (tt * 16 + g4 * 4 + j >= nsel) lg[tt][j] = -INFINITY; mxl = fmaxf(mxl, lg[tt][j]); }
        mxl = xmax32(xmax16(mxl));
        float sm = 0.f;
#pragma unroll
        for (int tt = 0; tt < 16; ++tt)
#pragma unroll
            for (int j = 0; j < 4; ++j) { const float e = __builtin_amdgcn_exp2f(lg[tt][j] - mxl); lg[tt][j] = e; sm += e; }
        sm = xsum32(xsum16(sm));
        const float inv = (1.0f / 256.0f) / sm;
        f32x4 o[8];
#pragma unroll
        for (int d = 0; d < 8; ++d) o[d] = (f32x4){0.f, 0.f, 0.f, 0.f};
        const int tq = col >> 1, trow = 4 * g4 + (tq & 3), tf = ((trow >> 1) & 3) | ((tq >> 2) << 2);
        const unsigned trb = (unsigned)(uintptr_t)vst + (tq >> 2) * 2048 + trow * 128 + (col & 1) * 8;
#pragma unroll
        for (int sp = 0; sp < 8; ++sp) {
            if (2 * sp + 7 < 16) { V_STAGE(2 * sp + 6); V_STAGE(2 * sp + 7); }
            A_WAITV(2 * (14 - 2 * sp < 6 ? 14 - 2 * sp : 6));
            const unsigned rb = trb + ((2 * sp) & 7) * 2048;
            long pa;
            {
                const uint32_t w0 = pk4_fp8(lg[2 * sp][0] * 256.0f, lg[2 * sp][1] * 256.0f, lg[2 * sp][2] * 256.0f, lg[2 * sp][3] * 256.0f);
                const uint32_t w1 = pk4_fp8(lg[2 * sp + 1][0] * 256.0f, lg[2 * sp + 1][1] * 256.0f, lg[2 * sp + 1][2] * 256.0f, lg[2 * sp + 1][3] * 256.0f);
                pa = (long)(((unsigned long long)w1 << 32) | (unsigned long long)w0);
            }
            long vf[8];
#pragma unroll
            for (int dt = 0; dt < 8; ++dt) asm volatile("ds_read_b64_tr_b8 %0, %1" : "=&v"(vf[dt]) : "v"(rb + ((dt ^ tf) * 16)) : "memory");
            asm volatile("s_waitcnt lgkmcnt(0)" ::: "memory");
            __builtin_amdgcn_sched_barrier(0);
#pragma unroll
            for (int dt = 0; dt < 8; ++dt) o[dt] = __builtin_amdgcn_mfma_f32_16x16x32_fp8_fp8(pa, vf[dt], o[dt], 0, 0, 0);
        }
#undef V_STAGE
#undef A_WAITV
        float ih[4];
#pragma unroll
        for (int jj = 0; jj < 4; ++jj) ih[jj] = (g4 & 1) ? readlane_f(inv, 4 + jj) : readlane_f(inv, jj);
        if (g4 < 2) {
            bf16_t* op = p.att() + (size_t)row * 512 + (g4 * 4) * 64 + col;
#pragma unroll
            for (int d = 0; d < 4; ++d) {
                const f32x4 oa_ = o[d], ob_ = o[4 + d]; f32x4 ov;
#pragma unroll
                for (int kk = 0; kk < 4; ++kk) ov[kk] = g4 == 0 ? oa_[kk] : ob_[kk];
                op[0 * 64 + d * 16] = f2bf(ov[0] * ih[0]); op[1 * 64 + d * 16] = f2bf(ov[1] * ih[1]);
                op[2 * 64 + d * 16] = f2bf(ov[2] * ih[2]); op[3 * 64 + d * 16] = f2bf(ov[3] * ih[3]);
            }
        }
    }
}

constexpr int A8_META = 8 * W_SZ;
static_assert(A8_META + 64 + 512 <= LDS_BYTES - 32, "attn8 meta");
__device__ __forceinline__ void attn8_unit(const P& p, unsigned char* lds, int b, int grp) {
    const int tid = tid_(), lane = tid & 63, wid = __builtin_amdgcn_readfirstlane(tid >> 6);
    const int t0 = NMETA + 8 * grp, brow = b * LP, row0 = brow + t0;
    unsigned* meta = (unsigned*)(lds + A8_META);
    const bool big = t0 + 1 > 256;
    bf16_t* uvec = (bf16_t*)(lds + A8_META + 64);
    if (big && tid < 256) {
        const int q = tid >> 5, d = tid & 31;
        const bf16_t* ip = p.iq() + (size_t)(row0 + q) * 256 + d; const float* wp = p.iw() + (size_t)(row0 + q) * 8;
        float u = 0.f;
#pragma unroll
        for (int h = 0; h < 8; ++h) u += wp[h] * bf2f(ip[h * 32]);
        uvec[q * 32 + d] = f2bf(u);
    }
    for (int i = tid; i < 8 * NBW; i += NTHREADS) ((int*)(lds + (i / NBW) * W_SZ + W_H))[i % NBW] = 0;
    __syncthreads();
    if (big) {
        const int hh = lane >> 5, c32 = lane & 31;
        const int g = c32 >> 3, h2a = (c32 >> 2) & 1, bq = c32 & 3, aq = 2 * h2a + (g >> 1), ah = 4 * (g & 1) + bq;
        bf16x8 a0[2], a1[2]; f32x4 w[2][2][2];
#pragma unroll
        for (int r = 0; r < 2; ++r) {
            const bf16_t* ap = p.iq() + (size_t)(row0 + 4 * r + aq) * 256 + ah * 32 + 8 * hh;
            a0[r] = *(const bf16x8*)ap; a1[r] = *(const bf16x8*)(ap + 16);
#pragma unroll
            for (int qi = 0; qi < 2; ++qi) {
                const float* wp = p.iw() + (size_t)(row0 + 4 * r + 2 * hh + qi) * 8;
                w[r][qi][0] = *(const f32x4*)wp; w[r][qi][1] = *(const f32x4*)(wp + 4);
            }
        }
        bf16x8 au0, au1;
        {
            const int uq = 4 * ((c32 & 3) >> 1) + 2 * ((c32 >> 2) & 1) + (c32 & 1);
            const bf16x8 v0 = *(const bf16x8*)(uvec + uq * 32 + 8 * hh), v1 = *(const bf16x8*)(uvec + uq * 32 + 8 * hh + 16);
#pragma unroll
            for (int i = 0; i < 8; ++i) { au0[i] = c32 < 8 ? v0[i] : (short)0; au1[i] = c32 < 8 ? v1[i] : (short)0; }
        }
        const int ntiles = (t0 + 8 + 31) >> 5;
        float mx[2][2], mn[2][2];
#pragma unroll
        for (int r = 0; r < 2; ++r)
#pragma unroll
            for (int qi = 0; qi < 2; ++qi) { mx[r][qi] = -INFINITY; mn[r][qi] = INFINITY; }
        const bf16_t* kbase = p.ik() + (size_t)brow * 32 + 8 * hh;
        bf16x8 b0[4], b1[4], c0[4], c1[4];
#define S_LOAD(B0, B1, T0) do { _Pragma("unroll") for (int j = 0; j < 4; ++j) { const int tile_ = min((T0) + 8 * j, ntiles - 1); \
            const bf16_t* kp_ = kbase + (size_t)(tile_ * 32 + c32) * 32; B0[j] = *(const bf16x8*)kp_; B1[j] = *(const bf16x8*)(kp_ + 16); } } while (0)
#define S_COMP(B0, B1, T0) do { _Pragma("unroll") for (int j = 0; j < 4; ++j) { const int tile = min((T0) + 8 * j, ntiles - 1); { const int key = tile * 32 + c32;   \
            f32x16 acu; _Pragma("unroll") for (int i = 0; i < 16; ++i) acu[i] = 0.f; \
            acu = __builtin_amdgcn_mfma_f32_32x32x16_bf16(au0, B0[j], acu, 0, 0, 0); acu = __builtin_amdgcn_mfma_f32_32x32x16_bf16(au1, B1[j], acu, 0, 0, 0); \
            _Pragma("unroll") for (int r = 0; r < 2; ++r) { f32x16 acc; _Pragma("unroll") for (int i = 0; i < 16; ++i) acc[i] = 0.f; \
                acc = __builtin_amdgcn_mfma_f32_32x32x16_bf16(a0[r], B0[j], acc, 0, 0, 0); acc = __builtin_amdgcn_mfma_f32_32x32x16_bf16(a1[r], B1[j], acc, 0, 0, 0); \
                _Pragma("unroll") for (int qi = 0; qi < 2; ++qi) { float s = acu[2 * r + qi], s1_ = 0.f; \
                    _Pragma("unroll") for (int i = 0; i < 4; ++i) { s = __builtin_fmaf(w[r][qi][0][i], __builtin_fabsf(acc[8 * qi + i]), s); s1_ = __builtin_fmaf(w[r][qi][1][i], __builtin_fabsf(acc[8 * qi + 4 + i]), s1_); } \
                    s += s1_; const int q = 4 * r + 2 * hh + qi; const _Float16 hs = (_Float16)fminf(fmaxf(s, -60000.f), 60000.f); \
                    ((_Float16*)(lds + q * W_SZ + W_SC))[key] = hs; } } } } } while (0)
        S_LOAD(b0, b1, wid);
        for (int tile0 = wid; tile0 < ntiles; tile0 += 64) {
            if (tile0 + 32 < ntiles) S_LOAD(c0, c1, tile0 + 32);
            __builtin_amdgcn_sched_barrier(0);
            S_COMP(b0, b1, tile0);
            __builtin_amdgcn_sched_barrier(0);
            if (tile0 + 64 < ntiles) S_LOAD(b0, b1, tile0 + 64);
            __builtin_amdgcn_sched_barrier(0);
            if (tile0 + 32 < ntiles) S_COMP(c0, c1, tile0 + 32);
            __builtin_amdgcn_sched_barrier(0);
        }
#undef S_LOAD
#undef S_COMP
    }
    __syncthreads();
    attn_wave(p, lds, wid, lane, b, t0 + wid);
    __syncthreads();
}

constexpr int NGRP8 = SEQ / 8, ATT_P1 = NGRP8 / 8, ATT_P2 = NGRP8 / 2;
template <int SUB>
__device__ __forceinline__ void ph_mixer(const P& p, unsigned char* lds) {
    int* bc = (int*)(lds + LDS_BYTES - 16);
    constexpr int nh = SUB == 1 ? 64 : NXU;
    constexpr int a0 = SUB == 0 ? 0 : (SUB == 1 ? ATT_P1 : ATT_P2), a1 = SUB == 0 ? ATT_P1 : (SUB == 1 ? ATT_P2 : NGRP8);
    const bool t0 = tid_() == 0;
    int nx = 0;
    if (t0) nx = atomicAdd(&p.ctr()[97 + SUB], 1);
    for (;;) {
        __syncthreads();
        if (t0) bc[0] = nx;
        __syncthreads();
        const int it = bc[0];
        if (it >= nh) break;
        if (t0) nx = atomicAdd(&p.ctr()[97 + SUB], 1);
        if (SUB == 0) hgx_unit(p, lds, it);
        else if (SUB == 1) hgchain_unit(p, it);
        else hgz_unit(p, lds, it);
    }
    const int b0 = (int)(xb_xcc_id() & 3u);
#pragma unroll 1
    for (int k = 0; k < 4; ++k) {
        const int b = (b0 + k) & 3;
        int* ctr = &p.ctr()[104 + SUB * 4 + b];
        if (t0) nx = atomicAdd(ctr, 1);
        for (;;) {
            __syncthreads();
            if (t0) bc[0] = nx;
            __syncthreads();
            const int it = bc[0];
            if (it >= a1 - a0) break;
            if (t0) nx = atomicAdd(ctr, 1);
            attn8_unit(p, lds, b, NGRP8 - 1 - (a0 + it));
        }
    }
}
__device__ __forceinline__ int tok_row(int tok) { return (tok >> 13) * LP + NMETA + (tok & 8191); }
__device__ __forceinline__ void ph_mix(const P& p, unsigned char* lds) {
    const int njobs = (NTOK / 256) * 4 * 2, G = gridDim.x, b0 = blockIdx.x;
    auto jobidx = [&](int i) __attribute__((always_inline)) { return (b0 + (i >> 1) * G) * 2 + (i & 1); };
    auto jobfn = [&](int i, GJob& j) __attribute__((always_inline)) -> bool {
        const int jb = jobidx(i); if (jb >= njobs) return false;
        const int which = jb & 1, u = jb >> 1, nt = u & 3, mt = u >> 2; const size_t r0 = (size_t)tok_row(mt * 256);
        j.A = (const char*)((which ? p.hgr() : p.att()) + r0 * 512); j.B = (const char*)((which ? p.wuhT() : p.wuaT()) + (size_t)nt * 256 * 512); return true; };
    auto epi = [&](f32x4 (&acc)[2][2][4][2], int i) __attribute__((always_inline)) {
        const int jb = jobidx(i), which = jb & 1, u = jb >> 1, nt = u & 3, mt = u >> 2; const size_t r0 = (size_t)tok_row(mt * 256);
        const int tid_e = tid_(), lane_e = tid_e & 63, wid_e = tid_e >> 6, wr = wid_e >> 2, wc = wid_e & 3, fr = lane_e & 15, fq = lane_e >> 4;
        const unsigned char* gsrc = which ? p.gh() : p.ga();
#pragma unroll
        for (int ai = 0; ai < 2; ++ai) {
            uint32_t g[4][2][2]; uint2 a[4][2][2];
#pragma unroll
            for (int m = 0; m < 4; ++m)
#pragma unroll
                for (int bj = 0; bj < 2; ++bj)
#pragma unroll
                    for (int n = 0; n < 2; ++n) {
                        const int row = ai * 128 + wr * 64 + m * 16 + fr, col = bj * 128 + wc * 32 + n * 16 + fq * 4;
                        g[m][bj][n] = *(const uint32_t*)(gsrc + (r0 + row) * 1024 + nt * 256 + col);
                        if (which) a[m][bj][n] = *(const uint2*)(p.mix() + (size_t)(mt * 256 + row) * 1024 + nt * 256 + col);
                    }
#pragma unroll
            for (int m = 0; m < 4; ++m)
#pragma unroll
                for (int bj = 0; bj < 2; ++bj) {
                    const int row = ai * 128 + wr * 64 + m * 16 + fr;
                    f32x4 rr[2];
#pragma unroll
                    for (int n = 0; n < 2; ++n) {
                        const f32x4 v = acc[ai][bj][m][n] * (1.0f / 255.0f); const uint32_t gg = g[m][bj][n];
                        rr[n][0] = v[0] * (float)(gg & 0xffu); rr[n][1] = v[1] * (float)((gg >> 8) & 0xffu);
                        rr[n][2] = v[2] * (float)((gg >> 16) & 0xffu); rr[n][3] = v[3] * (float)(gg >> 24);
                        if (which) {
                            const uint2 aa = a[m][bj][n];
                            rr[n][0] += __uint_as_float(aa.x << 16); rr[n][1] += __uint_as_float(aa.x & 0xffff0000u);
                            rr[n][2] += __uint_as_float(aa.y << 16); rr[n][3] += __uint_as_float(aa.y & 0xffff0000u);
                        }
                    }
                    st_bf4_pair(p.mix() + (size_t)(mt * 256 + row) * 1024 + nt * 256 + bj * 128 + wc * 32, fq, rr[0], rr[1]);
                }
        }
    };
    unsigned vbU[2]; gj_lin2(vbU, 512);
    gemm_stream<false>(lds, 512, 512, (size_t)128 * 512 * 2, vbU, jobfn, epi);
}

__device__ __forceinline__ void ph_out(const P& p, unsigned char* lds) {
    const int nunits = (NTOK / 256) * 4, G = gridDim.x, b0 = blockIdx.x;
    auto jobfn = [&](int i, GJob& j) __attribute__((always_inline)) -> bool {
        const int u = b0 + i * G; if (u >= nunits) return false;
        const int nt = u & 3, mt = u >> 2;
        j.A = (const char*)(p.mix() + (size_t)mt * 256 * D); j.B = (const char*)(p.woT() + (size_t)nt * 256 * D); return true; };
    auto epi = [&](f32x4 (&acc)[2][2][4][2], int i) __attribute__((always_inline)) {
        const int u = b0 + i * G, nt = u & 3, mt = u >> 2;
        const int tid_e = tid_(), lane_e = tid_e & 63, wid_e = tid_e >> 6, wr = wid_e >> 2, wc = wid_e & 3, fr = lane_e & 15, fq = lane_e >> 4;
#pragma unroll
        for (int ai = 0; ai < 2; ++ai) {
            f32x4 h0[4][2][2];
#pragma unroll
            for (int m = 0; m < 4; ++m)
#pragma unroll
                for (int bj = 0; bj < 2; ++bj)
#pragma unroll
                    for (int n = 0; n < 2; ++n)
                        h0[m][bj][n] = *(const f32x4*)(p.x + (size_t)(mt * 256 + ai * 128 + wr * 64 + m * 16 + fr) * D + nt * 256 + bj * 128 + wc * 32 + n * 16 + fq * 4);
#pragma unroll
            for (int m = 0; m < 4; ++m)
#pragma unroll
                for (int bj = 0; bj < 2; ++bj)
                    st_bf4_pair(p.h1b() + (size_t)(mt * 256 + ai * 128 + wr * 64 + m * 16 + fr) * D + nt * 256 + bj * 128 + wc * 32, fq, h0[m][bj][0] + acc[ai][bj][m][0], h0[m][bj][1] + acc[ai][bj][m][1]);
        }
    };
    unsigned vbU[2]; gj_lin2(vbU, D);
    gemm_stream<false>(lds, D, D, (size_t)128 * D * 2, vbU, jobfn, epi);
}

constexpr int XS_LD = 1025;
__device__ __forceinline__ void ph_route(const P& p, unsigned char* lds) {
    const int tid = tid_(), lane = tid & 63, wid = __builtin_amdgcn_readfirstlane(tid >> 6);
    const int gt = blockIdx.x * NTHREADS + tid, ntot = gridDim.x * NTHREADS;
    for (int i = gt; i < CAP; i += ntot) { p.slot_token()[i] = -1; p.slot_info()[i] = make_int2(-1, 0); }
    float* xs = (float*)lds;
    int* lhist = (int*)(lds + 32 * XS_LD * 4);
    for (int tb = blockIdx.x; tb < NTOK / 128; tb += gridDim.x) {
        if (tid < 32) lhist[tid] = 0;
        for (int tile = 0; tile < 4; ++tile) {
            const int tokt = tb * 128 + tile * 32;
            __syncthreads();
#pragma unroll
            for (int t = 0; t < 4; ++t) {
                const int tl = wid * 4 + t, tok = tokt + tl;
                const bf16_t* src = p.h1b() + (size_t)tok * D;
                f32x4 v[4]; float ss = 0.f;
#pragma unroll
                for (int i = 0; i < 4; ++i) {
                    const uint2 w = *(const uint2*)(src + lane * 4 + 256 * i);
                    v[i][0] = __uint_as_float(w.x << 16); v[i][1] = __uint_as_float(w.x & 0xffff0000u); v[i][2] = __uint_as_float(w.y << 16); v[i][3] = __uint_as_float(w.y & 0xffff0000u);
                    ss += v[i][0] * v[i][0] + v[i][1] * v[i][1] + v[i][2] * v[i][2] + v[i][3] * v[i][3];
                }
                ss = wave_sum(ss);
                const float rs = rsqrtf(ss * (1.0f / D) + EPS);
#pragma unroll
                for (int i = 0; i < 4; ++i) {
                    const f32x4 g = *(const f32x4*)(p.ffn_g + lane * 4 + 256 * i);
                    f32x4 xn; xn[0] = v[i][0] * rs * g[0]; xn[1] = v[i][1] * rs * g[1]; xn[2] = v[i][2] * rs * g[2]; xn[3] = v[i][3] * rs * g[3];
                    *(uint32_t*)(p.xn2() + (size_t)tok * D + lane * 4 + 256 * i) = pk4_fp8(xn[0], xn[1], xn[2], xn[3]);
#pragma unroll
                    for (int c = 0; c < 4; ++c) xs[tl * XS_LD + lane * 4 + 256 * i + c] = xn[c];
                }
            }
            __syncthreads();
            f32x16 acc;
#pragma unroll
            for (int i = 0; i < 16; ++i) acc[i] = 0.f;
            {
                const float* xr = xs + (lane & 31) * XS_LD + wid * 128 + (lane >> 5);
                const float* wp = p.router_w + (size_t)(wid * 128 + (lane >> 5)) * 32 + (lane & 31);
#pragma unroll 16
                for (int i = 0; i < 64; ++i) acc = __builtin_amdgcn_mfma_f32_32x32x2f32(xr[2 * i], wp[(size_t)(2 * i) * 32], acc, 0, 0, 0);
            }
            __syncthreads();
#pragma unroll
            for (int r = 0; r < 16; ++r) xs[wid * 1024 + ((r & 3) + 8 * (r >> 2) + 4 * (lane >> 5)) * 32 + (lane & 31)] = acc[r];
            __syncthreads();
            const int e = lane & 31, hh = lane >> 5;
            const float be = p.router_b[e];
#pragma unroll
            for (int it = 0; it < 2; ++it) {
                const int tl = wid * 4 + it * 2 + hh;
                float l = be;
#pragma unroll
                for (int w = 0; w < 8; ++w) l += xs[w * 1024 + tl * 32 + e];
                float bv[4]; int bi[4];
#pragma unroll
                for (int k = 0; k < 4; ++k) {
                    float m = l;
#pragma unroll
                    for (int o = 16; o >= 1; o >>= 1) m = fmaxf(m, __shfl_xor(m, o));
                    const unsigned long long bal = __ballot(l == m);
                    const unsigned half = hh ? (unsigned)(bal >> 32) : (unsigned)bal;
                    const int idx = __builtin_ctz(half);
                    bv[k] = m; bi[k] = idx;
                    if (e == idx) l = -INFINITY;
                }
                const float e1 = __expf(bv[1] - bv[0]), e2 = __expf(bv[2] - bv[0]), e3 = __expf(bv[3] - bv[0]);
                const float inv = 1.0f / (1.0f + e1 + e2 + e3);
                if (e == 0) {
                    const int tok = tokt + tl;
                    p.tok_exp()[tok * 4 + 0] = bi[0]; p.tok_exp()[tok * 4 + 1] = bi[1]; p.tok_exp()[tok * 4 + 2] = bi[2]; p.tok_exp()[tok * 4 + 3] = bi[3];
                    p.tok_gate()[tok * 4 + 0] = inv; p.tok_gate()[tok * 4 + 1] = e1 * inv; p.tok_gate()[tok * 4 + 2] = e2 * inv; p.tok_gate()[tok * 4 + 3] = e3 * inv;
                    atomicAdd(&lhist[bi[0]], 1); atomicAdd(&lhist[bi[1]], 1); atomicAdd(&lhist[bi[2]], 1); atomicAdd(&lhist[bi[3]], 1);
                }
            }
        }
        __syncthreads();
        if (tid < 32) p.wg_cnt()[tb * 32 + tid] = lhist[tid];
        __syncthreads();
    }
    __syncthreads();
    {
        constexpr int ROWB = 272;
        LAS unsigned char* wl = (LAS unsigned char*)lds + wid * (64 * ROWB);
        const int gw = blockIdx.x * 8 + wid, nw = gridDim.x * 8;
        for (int task = gw; task < 96 * 4 * 16; task += nw) {
            const int mat = task >> 6, kq4 = (task >> 4) & 3, nb = task & 15;
            const int which = mat >> 5, e = mat & 31;
            const float* W = (which == 0 ? p.w_gate : which == 1 ? p.w_up : p.w_down) + (size_t)e * 1048576 + (size_t)(kq4 * 256) * 1024 + nb * 64 + lane;
            unsigned char* outp = (which == 0 ? p.wgT() : which == 1 ? p.wuT() : p.wdT()) + (size_t)e * 1048576 + (size_t)(nb * 64) * 1024 + kq4 * 256;
#pragma unroll 1
            for (int q = 0; q < 4; ++q) {
                float v[64];
#pragma unroll
                for (int i = 0; i < 64; ++i) v[i] = W[(size_t)(q * 64 + i) * 1024] * 32.0f;
#pragma unroll
                for (int i = 0; i < 4; ++i) {
                    u32x4 t;
                    t.x = pk4_fp8(v[16 * i], v[16 * i + 1], v[16 * i + 2], v[16 * i + 3]); t.y = pk4_fp8(v[16 * i + 4], v[16 * i + 5], v[16 * i + 6], v[16 * i + 7]);
                    t.z = pk4_fp8(v[16 * i + 8], v[16 * i + 9], v[16 * i + 10], v[16 * i + 11]); t.w = pk4_fp8(v[16 * i + 12], v[16 * i + 13], v[16 * i + 14], v[16 * i + 15]);
                    *(LAS u32x4*)(wl + lane * ROWB + q * 64 + i * 16) = t;
                }
            }
#pragma unroll
            for (int j = 0; j < 16; ++j) {
                const int rr = j * 4 + (lane >> 4), c = lane & 15;
                const u32x4 t = *(const LAS u32x4*)(wl + rr * ROWB + c * 16);
                *(u32x4*)(outp + (size_t)rr * 1024 + c * 16) = t;
            }
        }
    }
}

__device__ __forceinline__ void ph_fill(const P& p, unsigned char* lds) {
    const int tid = tid_();
    int* tot = (int*)lds;
    int* pre = tot + 512;
    int* ps = pre + 512;
    int* lc = ps + 32;
    for (int tb = blockIdx.x; tb < NTOK / 128; tb += gridDim.x) {
        {
            const int e = tid & 31, part = tid >> 5;
            int t = 0, q = 0;
            for (int b2 = part; b2 < NTOK / 128; b2 += 16) { const int c = p.wg_cnt()[b2 * 32 + e]; t += c; if (b2 < tb) q += c; }
            tot[part * 32 + e] = t; pre[part * 32 + e] = q;
        }
        __syncthreads();
        if (tid == 0) {
            int acc = 0;
            for (int e = 0; e < NE; ++e) {
                int t = 0, q = 0;
                for (int i = 0; i < 16; ++i) { t += tot[i * 32 + e]; q += pre[i * 32 + e]; }
                ps[e] = acc + q; lc[e] = 0;
                const int nb = (t + 255) >> 8;
                if (tb == 0) for (int i = 0; i < nb; ++i) p.block_expert()[(acc >> 8) + i] = e;
                acc += nb * 256;
            }
            if (tb == 0) p.ctr()[96] = acc >> 8;
        }
        __syncthreads();
        {
            const int i = tb * 512 + tid;
            const int e = p.tok_exp()[i];
            const int dest = ps[e] + atomicAdd(&lc[e], 1);
            p.slot_token()[dest] = i >> 2;
            p.slot_rank()[dest] = i & 3;
            p.slot_gate()[dest] = p.tok_gate()[i];
            p.slot_info()[dest] = make_int2((i >> 2) | ((i & 3) << 16), __float_as_int(p.tok_gate()[i]));
        }
        __syncthreads();
    }
}

__device__ __forceinline__ void ph_moe1(const P& p, unsigned char* lds) {
    const int nblocks = p.ctr()[96], G = gridDim.x, b0 = blockIdx.x, bpx = (nblocks + 7) >> 3, bpi = G >> 6, xl = b0 >> 3, xbase = (b0 & 7) * bpx;
    const bool xcd_order = (G & 63) == 0;
    auto unit = [&](int i, int& rb, int& ct) __attribute__((always_inline)) -> bool {
        if (!xcd_order) { const int u = b0 + i * G; rb = u >> 3; ct = u & 7; return rb < nblocks; }
        const int k = i * bpi + (xl >> 3); rb = xbase + k; ct = xl & 7; return k < bpx && rb < nblocks && (xl >> 3) < bpi; };
    auto jobfn = [&](int i, G8Job& j) __attribute__((always_inline)) -> bool {
        int rb, ct; if (!unit(i, rb, ct)) return false;
        const int e = p.block_expert()[rb];
        j.A = (const char*)p.xn2(); j.B = (const char*)(p.wgT() + (size_t)e * 1048576 + (size_t)ct * 128 * 1024); j.aux = e;
        const int* st = p.slot_token() + rb * 256; unsigned v[4];
#pragma unroll
        for (int q = 0; q < 4; ++q) { int R, Cb; g8_rc(q, R, Cb); const int t = st[R]; v[q] = (unsigned)((t < 0 ? 0 : t) * 1024 + Cb); }
        j.va0 = v[0]; j.va1 = v[1]; j.va2 = v[2]; j.va3 = v[3]; return true; };
    auto epi = [&](f32x4 (&acc)[2][2][4][2], int i) __attribute__((always_inline)) {
        int rb, ct; unit(i, rb, ct);
        const int e = p.block_expert()[rb];
        const int tid_e = tid_(), lane_e = tid_e & 63, wid_e = tid_e >> 6, wr = wid_e >> 2, wc = wid_e & 3, fr = lane_e & 15, fq = lane_e >> 4;
        constexpr float SC = 0.03125f, KE = -1.702f * 1.4426950408889634f;
        constexpr int STG = 131072 + 4096, ROWP = 144;
        f32x2 bgp[2][2], bup[2][2], c2p[2][2];
#pragma unroll
        for (int n = 0; n < 2; ++n) {
            const LAS unsigned char* bl = (const LAS unsigned char*)lds + 131072 + (i & 1) * 2048 + (wc * 32 + n * 16 + fq * 4) * 4;
            const f32x4 bg = *(const LAS f32x4*)bl, bu = *(const LAS f32x4*)(bl + 512);
            bgp[n][0] = (f32x2){bg[0], bg[1]}; bgp[n][1] = (f32x2){bg[2], bg[3]};
            bup[n][0] = (f32x2){bu[0] + 1.0f, bu[1] + 1.0f}; bup[n][1] = (f32x2){bu[2] + 1.0f, bu[3] + 1.0f};
            c2p[n][0] = bgp[n][0] * KE; c2p[n][1] = bgp[n][1] * KE;
        }
#pragma unroll
        for (int ai = 0; ai < 2; ++ai) {
#pragma unroll
            for (int n = 0; n < 2; ++n)
#pragma unroll
                for (int m = 0; m < 4; ++m) {
                    const f32x4 ga = acc[ai][0][m][n], ua = acc[ai][1][m][n];
                    f32x2 o[2];
#pragma unroll
                    for (int hh = 0; hh < 2; ++hh) {
                        const f32x2 ag = {ga[2 * hh], ga[2 * hh + 1]}, au = {ua[2 * hh], ua[2 * hh + 1]};
                        const f32x2 t = ag * (SC * KE) + c2p[n][hh];
                        f32x2 d = {__builtin_amdgcn_exp2f(t[0]), __builtin_amdgcn_exp2f(t[1])};
                        d = d + 1.0f;
                        const f32x2 rc = {__builtin_amdgcn_rcpf(d[0]), __builtin_amdgcn_rcpf(d[1])};
                        f32x2 g = ag * SC + bgp[n][hh];
                        g[0] = fminf(g[0], 7.0f); g[1] = fminf(g[1], 7.0f);
                        f32x2 u1 = au * SC + bup[n][hh];
                        u1[0] = __builtin_amdgcn_fmed3f(u1[0], -6.0f, 8.0f); u1[1] = __builtin_amdgcn_fmed3f(u1[1], -6.0f, 8.0f);
                        o[hh] = (g * rc) * u1;
                    }
                    int w = __builtin_amdgcn_cvt_pk_fp8_f32(o[0][0], o[0][1], 0, false); w = __builtin_amdgcn_cvt_pk_fp8_f32(o[1][0], o[1][1], w, true);
                    *(LAS uint32_t*)((LAS unsigned char*)lds + STG + (wr * 64 + m * 16 + fr) * ROWP + wc * 32 + n * 16 + fq * 4) = (uint32_t)w;
                }
            __syncthreads();
#pragma unroll
            for (int t = 0; t < 2; ++t) {
                const int idx = t * NTHREADS + tid_e, rl = idx >> 3, ch = idx & 7;
                const u32x4 v4 = *(const LAS u32x4*)((LAS unsigned char*)lds + STG + rl * ROWP + ch * 16);
                *(u32x4*)(p.act() + (size_t)(rb * 256 + ai * 128 + rl) * DFF + ct * 128 + ch * 16) = v4;
            }
            __syncthreads();
        }
    };
    unsigned vbU[4];
#pragma unroll
    for (int q = 0; q < 4; ++q) { int R, Cb; g8_rc(q, R, Cb); vbU[q] = (unsigned)((size_t)(R >> 7) * WE8_B + (size_t)(R & 127) * 1024 + Cb); }
    auto pre = [&](int i, int e) __attribute__((always_inline)) {
        int rb, ct; unit(i, rb, ct);
        const int tid_p = tid_(), wid_p = __builtin_amdgcn_readfirstlane(tid_p >> 6), lane_p = tid_p & 63;
        if (wid_p < 4) {
            const float* src = (wid_p < 2 ? p.b_gate : p.b_up) + (size_t)e * DFF + ct * 128 + (wid_p & 1) * 64;
            const unsigned voff = (unsigned)lane_p * 4u, dst = (unsigned)(size_t)(LAS unsigned char*)lds + 131072u + (unsigned)(i & 1) * 2048u + (unsigned)wid_p * 256u;
            G8_PRE_DMA(uni_ptr8((const char*)src), voff, __builtin_amdgcn_readfirstlane(dst));
        }
    };
    gemm8_stream<true>(lds, vbU, jobfn, pre, epi);
}
__device__ __forceinline__ void ph_moe2(const P& p, unsigned char* lds) {
    const int nblocks = p.ctr()[96], G = gridDim.x, b0 = blockIdx.x, bpx = (nblocks + 7) >> 3, bpi = G >> 5, xl = b0 >> 3, xbase = (b0 & 7) * bpx;
    const bool xcd_order = (G & 31) == 0;
    auto unit = [&](int i, int& rb, int& nt) __attribute__((always_inline)) -> bool {
        if (!xcd_order) { const int u = b0 + i * G; rb = u >> 2; nt = u & 3; return rb < nblocks; }
        const int k = i * bpi + (xl >> 2); rb = xbase + k; nt = xl & 3; return k < bpx && rb < nblocks && (xl >> 2) < bpi; };
    unsigned vbU[4];
#pragma unroll
    for (int q = 0; q < 4; ++q) { int R, Cb; g8_rc(q, R, Cb); vbU[q] = (unsigned)(R * DFF + Cb); }
    auto jobfn = [&](int i, G8Job& j) __attribute__((always_inline)) -> bool {
        int rb, nt; if (!unit(i, rb, nt)) return false;
        const int e = p.block_expert()[rb];
        j.A = (const char*)(p.act() + (size_t)rb * 256 * DFF); j.B = (const char*)(p.wdT() + (size_t)e * 1048576 + (size_t)nt * 256 * DFF); j.aux = e; return true; };
    auto pre = [&](int i, int e) __attribute__((always_inline)) {
        int rb, nt; unit(i, rb, nt);
        const int tid_p = tid_(), wid_p = __builtin_amdgcn_readfirstlane(tid_p >> 6), lane_p = tid_p & 63;
        const unsigned voff = (unsigned)lane_p * 4u, base = (unsigned)(size_t)(LAS unsigned char*)lds + 131072u + (unsigned)(i & 1) * 3072u;
        G8_PRE_DMA(uni_ptr8((const char*)(p.slot_info() + rb * 256) + wid_p * 256), voff, __builtin_amdgcn_readfirstlane(base + 1024u + (unsigned)wid_p * 256u));
        if (wid_p < 4) G8_PRE_DMA(uni_ptr8((const char*)(p.b_down + (size_t)e * D + nt * 256 + wid_p * 64)), voff, __builtin_amdgcn_readfirstlane(base + (unsigned)wid_p * 256u));
    };
    auto epi = [&](f32x4 (&acc)[2][2][4][2], int i) __attribute__((always_inline)) {
        int rb, nt; unit(i, rb, nt);
        const int e = p.block_expert()[rb];
        const int tid_e = tid_(), lane_e = tid_e & 63, wid_e = tid_e >> 6, wr = wid_e >> 2, wc = wid_e & 3, fr = lane_e & 15, fq = lane_e >> 4;
        f32x4 bd[2][2];
#pragma unroll
        for (int bj = 0; bj < 2; ++bj)
#pragma unroll
            for (int n = 0; n < 2; ++n) bd[bj][n] = *(const LAS f32x4*)((const LAS unsigned char*)lds + 131072 + (i & 1) * 3072 + (bj * 128 + wc * 32 + n * 16 + fq * 4) * 4);
        typedef int i32x2_ __attribute__((ext_vector_type(2)));
        const LAS unsigned char* infl = (const LAS unsigned char*)lds + 131072 + (i & 1) * 3072 + 1024;
        LAS unsigned char* stg = (LAS unsigned char*)lds + 131072 + 6144;
#pragma unroll
        for (int ai = 0; ai < 2; ++ai) {
            float gate[4];
#pragma unroll
            for (int m = 0; m < 4; ++m) { const i32x2_ t_ = *(const LAS i32x2_*)(infl + (ai * 128 + wr * 64 + m * 16 + fr) * 8); gate[m] = __int_as_float(t_.y) * (16.0f * 0.03125f); }
#pragma unroll
            for (int bj = 0; bj < 2; ++bj) {
#pragma unroll
                for (int m = 0; m < 4; ++m)
#pragma unroll
                    for (int n = 0; n < 2; ++n) {
                        const f32x4 y = (acc[ai][bj][m][n] + bd[bj][n] * 32.0f) * gate[m];
                        const int rl = wr * 64 + m * 16 + fr, chunk = (wc * 2 + n) ^ (rl & 7);
                        *(LAS uint32_t*)(stg + rl * 128 + chunk * 16 + fq * 4) = pk4_fp8(y[0], y[1], y[2], y[3]);
                    }
                __syncthreads();
#pragma unroll
                for (int t = 0; t < 2; ++t) {
                    const int idx = t * NTHREADS + tid_e, rl = idx >> 3, ch = idx & 7;
                    const i32x2_ inf = *(const LAS i32x2_*)(infl + (ai * 128 + rl) * 8);
                    const u32x4 v4 = *(const LAS u32x4*)(stg + rl * 128 + ((ch ^ (rl & 7)) * 16));
                    const int ix = inf.x;
                    if (ix >= 0) {
                        const int rank = ix >> 16;
                        unsigned char* yb = (unsigned char*)(rank == 0 ? p.y0() : rank == 1 ? p.y1() : (rank == 2 ? p.y2() : p.y3()));
                        *(u32x4*)(yb + (size_t)(ix & 0xffff) * D + nt * 256 + bj * 128 + ch * 16) = v4;
                    }
                }
                __syncthreads();
            }
        }
    };
    gemm8_stream<false>(lds, vbU, jobfn, pre, epi);
}

__device__ __forceinline__ void ph_final(const P& p, unsigned char* lds) {
    const int tid = tid_(), lane = tid & 63, wid = tid >> 6;
    const int gw = blockIdx.x * 8 + wid, nw = gridDim.x * 8;
    for (int tok = gw; tok < NTOK; tok += nw) {
        float* dst = p.out + (size_t)tok * D;
        f32x4 v[4];
#pragma unroll
        for (int i = 0; i < 4; ++i) {
            const uint2 w = *(const uint2*)(p.h1b() + (size_t)tok * D + lane * 4 + 256 * i);
            v[i][0] = __uint_as_float(w.x << 16); v[i][1] = __uint_as_float(w.x & 0xffff0000u); v[i][2] = __uint_as_float(w.y << 16); v[i][3] = __uint_as_float(w.y & 0xffff0000u);
        }
#pragma unroll
        for (int j = 0; j < 4; ++j) {
            const unsigned char* yr = (const unsigned char*)(j == 0 ? p.y0() : j == 1 ? p.y1() : j == 2 ? p.y2() : p.y3()) + (size_t)tok * D;
#pragma unroll
            for (int i = 0; i < 4; ++i) {
                const int w = *(const int*)(yr + lane * 4 + 256 * i);
                const f32x2 lo = __builtin_amdgcn_cvt_pk_f32_fp8(w, false), hi = __builtin_amdgcn_cvt_pk_f32_fp8(w, true);
                v[i][0] += lo[0] * 0.0625f; v[i][1] += lo[1] * 0.0625f; v[i][2] += hi[0] * 0.0625f; v[i][3] += hi[1] * 0.0625f;
            }
        }
        float ss = 0.f;
#pragma unroll
        for (int i = 0; i < 4; ++i) ss += v[i][0] * v[i][0] + v[i][1] * v[i][1] + v[i][2] * v[i][2] + v[i][3] * v[i][3];
        ss = wave_sum(ss);
        const float rs = rsqrtf(ss * (1.0f / D) + EPS);
#pragma unroll
        for (int i = 0; i < 4; ++i) {
            const f32x4 g = *(const f32x4*)(p.final_g + lane * 4 + 256 * i);
            *(f32x4*)(dst + lane * 4 + 256 * i) = v[i] * rs * g;
        }
    }
}

typedef const __attribute__((address_space(4))) P* PK;
#define PHASE(call) do { PK q_ = pk; asm volatile("" : "+s"(q_)); const P& p = *(const P*)q_; call; } while (0)
__global__ void __launch_bounds__(NTHREADS) k_mega(P p_unused) {
    __shared__ __attribute__((aligned(16))) unsigned char lds[LDS_BYTES];
    cg::grid_group grid = cg::this_grid();
    const PK pk = (PK)__builtin_amdgcn_kernarg_segment_ptr();
    if (tid_() < 4) ((unsigned*)(lds + LDS_BYTES - 32))[tid_()] = 0u;
    __syncthreads();
    XcdBarrier xb;
    PHASE(xb = xcd_barrier_post((unsigned*)(p.ws + OFF_BAR), (volatile LAS unsigned*)(lds + LDS_BYTES - 32)));
    PHASE(if (p.ws == nullptr) grid.sync());
    PHASE(ph_prep(p, lds)); xcd_barrier(xb);
    PHASE(ph_inproj(p, lds)); xcd_barrier(xb);
    PHASE(ph_mixer<0>(p, lds)); xcd_barrier(xb);
    PHASE(ph_mixer<1>(p, lds)); xcd_barrier(xb);
    PHASE(ph_mixer<2>(p, lds)); xcd_barrier(xb);
    PHASE(ph_mix(p, lds)); xcd_barrier(xb);
    PHASE(ph_out(p, lds)); xcd_barrier(xb);
    PHASE(ph_route(p, lds)); xcd_barrier(xb);
    PHASE(ph_fill(p, lds)); xcd_barrier(xb);
    PHASE(ph_moe1(p, lds)); xcd_barrier(xb);
    PHASE(ph_moe2(p, lds)); xcd_barrier(xb);
    PHASE(ph_final(p, lds));
}

extern "C" void kernel_launch(void* const* d_in, const int* in_sizes, int n_in, void* d_out, int out_size, void* d_ws, size_t ws_size,
                              hipStream_t stream) {
    P p{};
    p.x = (const float*)d_in[0]; p.meta = (const float*)d_in[1]; p.attn_g = (const float*)d_in[2]; p.w_in = (const float*)d_in[3];
    p.hgrn_g = (const float*)d_in[4]; p.w_ua = (const float*)d_in[5]; p.w_uh = (const float*)d_in[6]; p.w_out = (const float*)d_in[7];
    p.lb_logits = (const float*)d_in[8]; p.ffn_g = (const float*)d_in[9]; p.router_w = (const float*)d_in[10]; p.router_b = (const float*)d_in[11];
    p.w_gate = (const float*)d_in[12]; p.b_gate = (const float*)d_in[13]; p.w_up = (const float*)d_in[14]; p.b_up = (const float*)d_in[15];
    p.w_down = (const float*)d_in[16]; p.b_down = (const float*)d_in[17]; p.final_g = (const float*)d_in[18];
    p.out = (float*)d_out;
    p.ws = (unsigned char*)d_ws;
    if (WS_NEED > ws_size) { fprintf(stderr, "workspace too small: need %zu have %zu\n", (size_t)WS_NEED, ws_size); return; }
    static int grid_blocks = 0;
    if (!grid_blocks) {
        int dev = 0, cus = 0, per_cu = 0;
        hipGetDevice(&dev);
        hipDeviceGetAttribute(&cus, hipDeviceAttributeMultiprocessorCount, dev);
        hipOccupancyMaxActiveBlocksPerMultiprocessor(&per_cu, k_mega, NTHREADS, 0);
        if (per_cu > 1) per_cu = 1;
        grid_blocks = cus * per_cu;
    }
    hipMemsetAsync(p.ws + OFF_BAR, 0, XCD_BAR_WORDS * 4, stream);
    void* args[] = {&p};
    hipError_t e = hipLaunchCooperativeKernel((void*)k_mega, dim3(grid_blocks), dim3(NTHREADS), args, 0, stream);
    if (e != hipSuccess) fprintf(stderr, "cooperative launch failed: %s (grid %d)\n", hipGetErrorString(e), grid_blocks);
}
```

```cpp
#include <hip/hip_runtime.h>
#include <hip/hip_cooperative_groups.h>
#include <stdint.h>
#include <cstdio>
namespace cg = cooperative_groups;

#ifndef MEGA
#define MEGA 1
#endif

typedef unsigned short bf16_t;
typedef short bf16x8 __attribute__((ext_vector_type(8)));
typedef float f32x4 __attribute__((ext_vector_type(4)));

constexpr int D = 1024, NB = 4, SEQ = 8192, NMETA = 16, L = SEQ + NMETA  , LP = 8320, T = NB * LP  ;
constexpr int NTOK = NB * SEQ;
constexpr int IN_COLS = 5160;
constexpr int NE = 32, TOPK = 4, DFF = 1024;
constexpr int CAP_BLOCKS = (NTOK * TOPK) / 256 + NE;
constexpr int CAP = CAP_BLOCKS * 256;
constexpr float EPS = 1e-5f;
constexpr int NTHREADS = 512;
constexpr int LDS_BYTES = 155648;
constexpr int NVC = 5376;
#define LAS __attribute__((address_space(3)))

typedef __bf16 hwbf16x2 __attribute__((ext_vector_type(2)));
typedef float f32x2 __attribute__((ext_vector_type(2)));
__device__ __forceinline__ uint32_t pack2(float a, float b) { const f32x2 v = {a, b}; return __builtin_bit_cast(uint32_t, __builtin_convertvector(v, hwbf16x2)); }
__device__ __forceinline__ bf16_t f2bf(float f) { return (bf16_t)(pack2(f, 0.f) & 0xffffu); }
__device__ __forceinline__ float bf2f(bf16_t h) { return __uint_as_float(((uint32_t)h) << 16); }
__device__ __forceinline__ uint32_t pk4_fp8(float a, float b, float c, float d) {
    a = fminf(fmaxf(a, -448.f), 448.f); b = fminf(fmaxf(b, -448.f), 448.f); c = fminf(fmaxf(c, -448.f), 448.f); d = fminf(fmaxf(d, -448.f), 448.f);
    int w = __builtin_amdgcn_cvt_pk_fp8_f32(a, b, 0, false); w = __builtin_amdgcn_cvt_pk_fp8_f32(c, d, w, true); return (uint32_t)w;
}
__device__ __forceinline__ float sigmoidf_(float x) { return __builtin_amdgcn_rcpf(1.0f + __builtin_amdgcn_exp2f(-1.4426950408889634f * x)); }
template <int CTRL, int RM = 0xf, bool BC = true>
__device__ __forceinline__ int dpp_mov(int v) { return __builtin_amdgcn_update_dpp(0, v, CTRL, RM, 0xf, BC); }
template <int O> __device__ __forceinline__ int lane_xor_i(int v) {
    if (O == 1) return dpp_mov<0xB1>(v);
    if (O == 2) return dpp_mov<0x4E>(v);
    if (O == 4) return dpp_mov<0x1B>(dpp_mov<0x141>(v));
    if (O == 8) return dpp_mov<0x128>(v);
    const int lane = (int)__builtin_amdgcn_mbcnt_hi(~0u, __builtin_amdgcn_mbcnt_lo(~0u, 0u));
    if (O == 16) { const auto r = __builtin_amdgcn_permlane16_swap((unsigned)v, (unsigned)v, false, false); return (lane & 16) ? (int)r[0] : (int)r[1]; }
    const auto r = __builtin_amdgcn_permlane32_swap((unsigned)v, (unsigned)v, false, false); return (lane & 32) ? (int)r[0] : (int)r[1];
}
template <int O> __device__ __forceinline__ float lane_xor_f(float v) { return __int_as_float(lane_xor_i<O>(__float_as_int(v))); }
__device__ __forceinline__ float xsum16(float v) { const auto r = __builtin_amdgcn_permlane16_swap(__float_as_uint(v), __float_as_uint(v), false, false); return __uint_as_float(r[0]) + __uint_as_float(r[1]); }
__device__ __forceinline__ float xsum32(float v) { const auto r = __builtin_amdgcn_permlane32_swap(__float_as_uint(v), __float_as_uint(v), false, false); return __uint_as_float(r[0]) + __uint_as_float(r[1]); }
__device__ __forceinline__ float xmax16(float v) { const auto r = __builtin_amdgcn_permlane16_swap(__float_as_uint(v), __float_as_uint(v), false, false); return fmaxf(__uint_as_float(r[0]), __uint_as_float(r[1])); }
__device__ __forceinline__ float xmax32(float v) { const auto r = __builtin_amdgcn_permlane32_swap(__float_as_uint(v), __float_as_uint(v), false, false); return fmaxf(__uint_as_float(r[0]), __uint_as_float(r[1])); }
__device__ __forceinline__ float xmin16(float v) { const auto r = __builtin_amdgcn_permlane16_swap(__float_as_uint(v), __float_as_uint(v), false, false); return fminf(__uint_as_float(r[0]), __uint_as_float(r[1])); }
__device__ __forceinline__ int wave_incl_scan(int x) {
    x += dpp_mov<0x111>(x); x += dpp_mov<0x112>(x); x += dpp_mov<0x114>(x); x += dpp_mov<0x118>(x);
    x += dpp_mov<0x142, 0xa, false>(x);
    x += dpp_mov<0x143, 0xc, false>(x);
    return x;
}
__device__ __forceinline__ float readlane_f(float v, int l) { return __int_as_float(__builtin_amdgcn_readlane(__float_as_int(v), l)); }
__device__ __forceinline__ float wave_sum(float v) {
#pragma unroll
    for (int o = 32; o >= 1; o >>= 1) v += __shfl_xor(v, o);
    return v;
}
__device__ __forceinline__ float wave_max(float v) {
#pragma unroll
    for (int o = 32; o >= 1; o >>= 1) v = fmaxf(v, __shfl_xor(v, o));
    return v;
}

constexpr size_t al256(size_t x) { return (x + 255) & ~(size_t)255; }
constexpr size_t TT = (size_t)T;
constexpr size_t MB1 = 1024 * 1024;
constexpr size_t WE8_B = (size_t)NE * 1024 * 1024;
constexpr size_t OFF_WGT = 0, OFF_WUT = WE8_B, OFF_WDT = 2 * WE8_B, OFF_XN2 = 3 * WE8_B, OFF_ACT = OFF_XN2 + (size_t)NTOK * D,
                 OFF_Y1 = OFF_ACT + (size_t)CAP * DFF, OFF_Y2 = OFF_Y1 + (size_t)NTOK * D, OFF_Y3 = OFF_Y2 + (size_t)NTOK * D,
                 OFF_H1B = OFF_Y3 + (size_t)NTOK * D,
                 OFF_S2_END = OFF_H1B + (size_t)NTOK * D * 2;
constexpr size_t OFF_WIN = 0, OFF_WUA = OFF_WIN + (size_t)NVC * 1024 * 2, OFF_WUH = OFF_WUA + MB1, OFF_WO = OFF_WUH + MB1, OFF_XN = OFF_WO + 2 * MB1,
                 OFF_Q = OFF_XN + TT * 2048, OFF_K = OFF_Q + TT * 1024, OFF_V = OFF_K + TT * 256, OFF_IQ = OFF_V + TT * 256, OFF_IK = OFF_IQ + TT * 512,
                 OFF_IW = OFF_IK + TT * 64, OFF_HQ = OFF_IW + TT * 32, OFF_HF = OFF_HQ + TT * 1024, OFF_HI = OFF_HF + TT * 1024, OFF_HG = OFF_HI + TT * 1024,
                 OFF_GA = OFF_HG + TT * 1024, OFF_GH = OFF_GA + TT * 2048, OFF_ATT = OFF_GH + TT * 2048, OFF_HGR = OFF_ATT + TT * 1024,
                 OFF_S1_END = OFF_HGR + TT * 1024;
static_assert(2 * WE8_B >= (size_t)NTOK * D * 2, "y0 does not fit over the gate/up weights");
constexpr size_t OFF_MIX = OFF_XN;
static_assert(OFF_H1B >= OFF_GA, "h1b (written by ph_out) must lie in stage-1 buffers that are dead by then");
constexpr size_t OFF_TAB = OFF_S1_END > OFF_S2_END ? OFF_S1_END : OFF_S2_END;
constexpr size_t OFF_ROPE = OFF_TAB, OFF_LB = OFF_ROPE + al256((size_t)LP * 24 * 4), OFF_CTR = OFF_LB + al256(512 * 4),
                 OFF_BEXP = OFF_CTR + al256(128 * 4), OFF_SLOT = OFF_BEXP + al256((size_t)CAP_BLOCKS * 4), OFF_SRANK = OFF_SLOT + al256((size_t)CAP * 4),
                 OFF_SGATE = OFF_SRANK + al256((size_t)CAP * 4), OFF_TEXP = OFF_SGATE + al256((size_t)CAP * 4), OFF_TGATE = OFF_TEXP + al256((size_t)NTOK * 16),
                 OFF_BAR = OFF_TGATE + al256((size_t)NTOK * 16), OFF_WGC = OFF_BAR + al256(3456 * 4), OFF_SINFO = OFF_WGC + al256(256 * 32 * 4), WS_NEED = OFF_SINFO + al256((size_t)CAP * 8);


__device__ __forceinline__ int tid_() { int t = threadIdx.x; asm volatile("" : "+v"(t)); return t; }

struct P {
    const float *x, *meta, *attn_g, *w_in, *hgrn_g, *w_ua, *w_uh, *w_out, *lb_logits, *ffn_g, *router_w, *router_b,
        *w_gate, *b_gate, *w_up, *b_up, *w_down, *b_down, *final_g;
    float* out;
    unsigned char* ws;
#define WSF(type, name, off) __device__ __forceinline__ type* name() const { return (type*)(ws + (off)); }
    WSF(bf16_t, xn, OFF_XN) WSF(unsigned char, xn8, OFF_ATT) WSF(unsigned char, winT8, OFF_WIN) WSF(bf16_t, winTb, OFF_WIN + 6 * MB1) WSF(bf16_t, q, OFF_Q) WSF(bf16_t, k, OFF_K) WSF(unsigned char, q8, OFF_Q) WSF(unsigned char, k8, OFF_K) WSF(unsigned char, v8, OFF_V)        WSF(bf16_t, v, OFF_V) WSF(bf16_t, iq, OFF_IQ) WSF(bf16_t, ik, OFF_IK)
    WSF(bf16_t, hq, OFF_HQ) WSF(bf16_t, hf, OFF_HF) WSF(bf16_t, hi, OFF_HI) WSF(bf16_t, hg, OFF_HG) WSF(unsigned char, ga, OFF_GA) WSF(unsigned char, gh, OFF_GH)
    WSF(bf16_t, att, OFF_ATT) WSF(bf16_t, hgr, OFF_HGR) WSF(bf16_t, mix, OFF_MIX) WSF(unsigned char, xn2, OFF_XN2) WSF(unsigned char, act, OFF_ACT)
    WSF(bf16_t, h1b, OFF_H1B) WSF(bf16_t, y0, OFF_WGT) WSF(bf16_t, y1, OFF_Y1) WSF(bf16_t, y2, OFF_Y2) WSF(bf16_t, y3, OFF_Y3)
    WSF(bf16_t, winT, OFF_WIN) WSF(bf16_t, wuaT, OFF_WUA) WSF(bf16_t, wuhT, OFF_WUH) WSF(bf16_t, woT, OFF_WO)
    WSF(unsigned char, wgT, OFF_WGT) WSF(unsigned char, wuT, OFF_WUT) WSF(unsigned char, wdT, OFF_WDT)
    WSF(float, iw, OFF_IW) WSF(float, rope, OFF_ROPE) WSF(float, lb, OFF_LB) WSF(float, tok_gate, OFF_TGATE) WSF(float, slot_gate, OFF_SGATE)
    WSF(int, ctr, OFF_CTR)
    WSF(int, wg_cnt, OFF_WGC) WSF(int2, slot_info, OFF_SINFO) WSF(int, block_expert, OFF_BEXP) WSF(int, slot_token, OFF_SLOT) WSF(int, slot_rank, OFF_SRANK) WSF(int, tok_exp, OFF_TEXP)
};

template <class ColMap>
__device__ __forceinline__ void convert_T8(const float* W, int ldw, unsigned char* out, int K, int N, const ColMap& cmap, float scale, int gt, int ntot) {
    const int kb = K / 64; const long ntask = (long)N * kb;
    for (long task = gt; task < ntask; task += ntot) {
        const int kq = (int)(task / N), n = (int)(task % N);
        const int c = cmap(n);
        uint32_t w[16];
        if (c >= 0) {
            const float* src = W + (size_t)(kq * 64) * ldw + c;
            float v[64];
#pragma unroll
            for (int i = 0; i < 64; ++i) v[i] = src[(size_t)i * ldw] * scale;
#pragma unroll
            for (int i = 0; i < 16; ++i) w[i] = pk4_fp8(v[4 * i], v[4 * i + 1], v[4 * i + 2], v[4 * i + 3]);
        } else {
#pragma unroll
            for (int i = 0; i < 16; ++i) w[i] = 0u;
        }
        uint4* dst = (uint4*)(out + (size_t)n * K + kq * 64);
#pragma unroll
        for (int i = 0; i < 4; ++i) dst[i] = make_uint4(w[4 * i], w[4 * i + 1], w[4 * i + 2], w[4 * i + 3]);
    }
}
template <class ColMap>
__device__ __forceinline__ void convert_T(const float* W, int ldw, bf16_t* out, int K, int N, const ColMap& cmap, int gt, int ntot) {
    const int kb = K / 64; const long ntask = (long)N * kb;
    for (long task = gt; task < ntask; task += ntot) {
        const int kq = (int)(task / N), n = (int)(task % N);
        const int c = cmap(n);
        uint32_t w[32];
        if (c >= 0) {
            const float* src = W + (size_t)(kq * 64) * ldw + c;
            float v[64];
#pragma unroll
            for (int i = 0; i < 64; ++i) v[i] = src[(size_t)i * ldw];
#pragma unroll
            for (int i = 0; i < 32; ++i) w[i] = pack2(v[2 * i], v[2 * i + 1]);
        } else {
#pragma unroll
            for (int i = 0; i < 32; ++i) w[i] = 0u;
        }
        uint4* dst = (uint4*)(out + (size_t)n * K + kq * 64);
#pragma unroll
        for (int i = 0; i < 8; ++i) dst[i] = make_uint4(w[4 * i], w[4 * i + 1], w[4 * i + 2], w[4 * i + 3]);
    }
}
struct IdMap { __device__ __forceinline__ int operator()(int n) const { return n; } };
struct WinMap { __device__ __forceinline__ int operator()(int n) const { return n < 1064 ? n : (n < 1280 ? -1 : n - 216); } };
struct WinMapIdx { __device__ __forceinline__ int operator()(int n) const { return WinMap{}(768 + n); } };

#define XB_TMO      128
#define XB_XCNT(j)  (256  + 64 * (j))
#define XB_XSUB(j)  (1280 + 64 * (j))
#define XB_XGEN(j)  (2304 + 64 * (j))
#define XB_TOP      3328
#define XB_TOPGEN   3392
#define XCD_BAR_WORDS 3456
#define XB_SPIN_CAP (1u << 22)
__device__ __forceinline__ unsigned xb_ld(unsigned* p)              { return __hip_atomic_load(p, __ATOMIC_RELAXED, __HIP_MEMORY_SCOPE_AGENT); }
__device__ __forceinline__ unsigned xb_add(unsigned* p, unsigned v) { return __hip_atomic_fetch_add(p, v, __ATOMIC_RELAXED, __HIP_MEMORY_SCOPE_AGENT); }
__device__ __forceinline__ unsigned xb_xcc_id() { return (unsigned)__builtin_amdgcn_s_getreg((3 << 11) | 20) & 0xFu; }
#define XB_SPIN(cond, bar) do { unsigned _sp = 0; while (cond) { __builtin_amdgcn_s_sleep(1); \
    if ((++_sp & 255u) == 0u) { if (xb_ld(&(bar)[XB_TMO])) break; if (_sp > XB_SPIN_CAP) { atomicAdd(&(bar)[XB_TMO], 1u); break; } } } } while (0)
struct XcdBarrier { unsigned* bar; unsigned x; volatile LAS unsigned* st; };
__device__ __forceinline__ XcdBarrier xcd_barrier_post(unsigned* bar, volatile LAS unsigned* st) {
    XcdBarrier b; b.bar = bar; b.x = xb_xcc_id(); b.st = st;
    if (threadIdx.x == 0) (void)xb_add(&bar[XB_XCNT(b.x)], 1u);
    return b;
}
__device__ __forceinline__ void xcd_barrier_complete(unsigned* bar, unsigned x, unsigned& nloc, unsigned& nx) {
    const unsigned G = gridDim.x * gridDim.y * gridDim.z;
    unsigned sum, cnt, mine, sp = 0u;
    for (;;) {
        sum = 0u; cnt = 0u; mine = 0u;
#pragma unroll
        for (unsigned j = 0; j < 16; ++j) { const unsigned c = xb_ld(&bar[XB_XCNT(j)]); sum += c; cnt += (c > 0u) ? 1u : 0u; mine = (j == x) ? c : mine; }
        if (sum == G) break;
        __builtin_amdgcn_s_sleep(1);
        if ((++sp & 255u) == 0u) { if (xb_ld(&bar[XB_TMO])) break; if (sp > XB_SPIN_CAP) { atomicAdd(&bar[XB_TMO], 1u); break; } }
    }
    nloc = mine > 0u ? mine : 1u; nx = cnt > 0u ? cnt : 1u;
}
__device__ __forceinline__ void xcd_barrier(const XcdBarrier& b) {
    asm volatile("s_waitcnt vmcnt(0)" ::: "memory");
    __syncthreads();
    if (threadIdx.x == 0) {
        unsigned* bar = b.bar;
        __builtin_amdgcn_s_waitcnt(0);
        unsigned nloc = b.st[0], nx = b.st[1];
        if (nloc == 0u) { xcd_barrier_complete(bar, b.x, nloc, nx); b.st[0] = nloc; b.st[1] = nx; }
        const unsigned old = xb_add(&bar[XB_XSUB(b.x)], 1u);
        const unsigned gen = old / nloc;
        if (old + 1u == (gen + 1u) * nloc) {
            __builtin_amdgcn_fence(__ATOMIC_RELEASE, "agent");
            asm volatile("s_waitcnt vmcnt(0)" ::: "memory");
            const unsigned og = xb_add(&bar[XB_TOP], 1u);
            const unsigned tg = og / nx;
            if (og + 1u == (tg + 1u) * nx) xb_add(&bar[XB_TOPGEN], 1u);
            else XB_SPIN(xb_ld(&bar[XB_TOPGEN]) == tg, bar);
            __builtin_amdgcn_fence(__ATOMIC_ACQUIRE, "agent");
            xb_add(&bar[XB_XGEN(b.x)], 1u);
            asm volatile("s_waitcnt vmcnt(0)" ::: "memory");
        } else {
            XB_SPIN(xb_ld(&bar[XB_XGEN(b.x)]) == gen, bar);
            __builtin_amdgcn_fence(__ATOMIC_ACQUIRE, "agent");
            asm volatile("s_waitcnt vmcnt(0)" ::: "memory");
        }
    }
    __syncthreads();
}

__device__ __forceinline__ void ph_prep(const P& p, unsigned char* lds) {
    const int tid = tid_(), lane = tid & 63, wid = tid >> 6;
    const int gw = blockIdx.x * 8 + wid, nw = gridDim.x * 8;
    for (int r = gw; r < T; r += nw) {
        const int b = r / LP, pos = r % LP;
        unsigned char* dst = p.xn8() + (size_t)r * D; bf16_t* dstb = p.xn() + (size_t)r * D;
        if (pos >= L) {
#pragma unroll
            for (int i = 0; i < 4; ++i) { *(uint32_t*)(dst + lane * 4 + 256 * i) = 0u; *(uint2*)(dstb + lane * 4 + 256 * i) = make_uint2(0u, 0u); }
            continue;
        }
        const float* src = pos < NMETA ? p.meta + (size_t)pos * D : p.x + ((size_t)b * SEQ + (pos - NMETA)) * D;
        f32x4 v[4]; float ss = 0.f;
#pragma unroll
        for (int i = 0; i < 4; ++i) { v[i] = *(const f32x4*)(src + lane * 4 + 256 * i); ss += v[i][0] * v[i][0] + v[i][1] * v[i][1] + v[i][2] * v[i][2] + v[i][3] * v[i][3]; }
        ss = wave_sum(ss);
        const float rs = rsqrtf(ss * (1.0f / D) + EPS);
#pragma unroll
        for (int i = 0; i < 4; ++i) {
            const f32x4 g = *(const f32x4*)(p.attn_g + lane * 4 + 256 * i);
            const float y0 = v[i][0] * rs * g[0], y1 = v[i][1] * rs * g[1], y2 = v[i][2] * rs * g[2], y3 = v[i][3] * rs * g[3];
            *(uint32_t*)(dst + lane * 4 + 256 * i) = pk4_fp8(y0, y1, y2, y3);
            uint2 o; o.x = pack2(y0, y1); o.y = pack2(y2, y3);
            *(uint2*)(dstb + lane * 4 + 256 * i) = o;
        }
    }
    const int gt = blockIdx.x * NTHREADS + tid, nt = gridDim.x * NTHREADS;
    for (int i = gt; i < LP * 12; i += nt) {
        const int pos = i / 12, f = i % 12;
        const double ex = f < 8 ? -(double)f / 8.0 : -(double)(f - 8) / 4.0;
        const double inv = exp(ex * log(500000.0));
        const double ang = (double)pos * inv;
        const double twopi = 6.283185307179586476925286766559;
        const double r = ang - twopi * rint(ang / twopi);
        const float rf = (float)r;
        const float c = cosf(rf), s = sinf(rf);
        float* row = p.rope() + (size_t)pos * 24;
        if (f < 8) { row[f] = c; row[8 + f] = s; } else { row[16 + f - 8] = c; row[20 + f - 8] = s; }
    }
    for (int i = gt; i < 512; i += nt) {
        const float a = p.lb_logits[i], b2 = p.lb_logits[512 + i];
        p.lb()[i] = 1.0f / (1.0f + expf(b2 - a));
    }
    for (int i = gt; i < 128; i += nt) p.ctr()[i] = 0;
    convert_T8(p.w_in, IN_COLS, p.winT8(), 1024, NVC, WinMap{}, 32.0f, gt, nt);
    convert_T(p.w_in, IN_COLS, p.winTb(), 1024, 512, WinMapIdx{}, gt, nt);
    convert_T(p.w_ua, 1024, p.wuaT(), 512, 1024, IdMap{}, gt, nt);
    convert_T(p.w_uh, 1024, p.wuhT(), 512, 1024, IdMap{}, gt, nt);
    convert_T(p.w_out, 1024, p.woT(), 1024, 1024, IdMap{}, gt, nt);
}
constexpr int G_TILE_B = 256 * 64 * 2, G_STAGE_B = 2 * G_TILE_B;
__device__ __forceinline__ int g_lds_byte(int r, int c) { const int st = (r >> 4) * 2 + (c >> 5), ob = (r & 15) * 64 + (c & 31) * 2; return st * 1024 + (ob ^ (((ob >> 9) & 1) << 5)); }
__device__ __forceinline__ void g_stage_rc(int b, int& R, int& C) { const int st = b >> 10, sb = b & 1023, swz = sb ^ (((sb >> 9) & 1) << 5); R = (st >> 1) * 16 + swz / 64; C = (st & 1) * 32 + (swz % 64) / 2; }

constexpr int HTB = 128 * 64 * 2;
struct GJob { const char* A; const char* B; unsigned va00, va01, va10, va11; };
__device__ __forceinline__ void gj_lin(unsigned (&v)[2][2], int ld) {
#pragma unroll
    for (int h = 0; h < 2; ++h)
#pragma unroll
        for (int i = 0; i < 2; ++i) { int R, C; g_stage_rc(tid_() * 16 + i * 8192, R, C); v[h][i] = (unsigned)(((h * 128 + R) * ld + C) * 2); }
}
template <class AOff>
__device__ __forceinline__ void gj_gather(unsigned (&v)[2][2], const AOff& aoff) {
#pragma unroll
    for (int h = 0; h < 2; ++h)
#pragma unroll
        for (int i = 0; i < 2; ++i) { int R, C; g_stage_rc(tid_() * 16 + i * 8192, R, C); v[h][i] = (unsigned)((aoff(h * 128 + R) + C) * 2); }
}
template <class AOff>
__device__ __forceinline__ void gj_gather_job(GJob& j, const AOff& aoff) {
    unsigned v[2][2]; gj_gather(v, aoff); j.va00 = v[0][0]; j.va01 = v[0][1]; j.va10 = v[1][0]; j.va11 = v[1][1];
}
template <bool GATHER, class JobFn, class Epi>
__device__ __forceinline__ void gemm_stream(unsigned char* lds_, int K, int lda, size_t hstepB, const unsigned (&vbU)[2], const JobFn& jobfn, const Epi& epi) {
    LAS unsigned char* lds = (LAS unsigned char*)lds_;
    const int tid = tid_(), wid = __builtin_amdgcn_readfirstlane(tid >> 6), lane = tid & 63, wr = wid >> 2, wc = wid & 3, fr = lane & 15, fq = lane >> 4;
    const int nt = K / 64;
    const size_t kstep = 128;
    const size_t hstepA = GATHER ? 0 : (size_t)128 * lda * 2;
    const unsigned ldsw = (unsigned)wid * 1024u;
    const int aoff = g_lds_byte(wr * 64 + fr, fq * 8), boff = g_lds_byte(wc * 32 + fr, fq * 8);
    unsigned vaU[2];
#pragma unroll
    for (int i = 0; i < 2; ++i) { int R, C; g_stage_rc(tid * 16 + i * 8192, R, C); vaU[i] = (unsigned)((R * lda + C) * 2); }
#define PG8_SA(b, h) (((b) * 2 + (h)) * HTB)
#define PG8_SB(b, h) ((4 + (b) * 2 + (h)) * HTB)
#define PG8_STAGE2(bufoff, gbase, v0, v1) do { \
        __builtin_amdgcn_global_load_lds((const unsigned*)((const char*)(gbase) + (v0)), (LAS unsigned*)(lds + (bufoff) + ldsw), 16, 0, 0); \
        __builtin_amdgcn_global_load_lds((const unsigned*)((const char*)(gbase) + (v1)), (LAS unsigned*)(lds + (bufoff) + ldsw + 8192), 16, 0, 0); } while (0)
#define STB(bufoff, gbase, h) PG8_STAGE2(bufoff, (gbase) + ((h) ? hstepB : 0), vbU[0], vbU[1])
#define STA_CUR(bufoff, gbase, h) do { if (GATHER) PG8_STAGE2(bufoff, gbase, (h) ? cur.va10 : cur.va00, (h) ? cur.va11 : cur.va01); else PG8_STAGE2(bufoff, (gbase) + ((h) ? hstepA : 0), vaU[0], vaU[1]); } while (0)
#define STA_SEL(bufoff, gbase, h) do { if (GATHER) PG8_STAGE2(bufoff, gbase, last ? ((h) ? nxt.va10 : nxt.va00) : ((h) ? cur.va10 : cur.va00), last ? ((h) ? nxt.va11 : nxt.va01) : ((h) ? cur.va11 : cur.va01)); \
        else PG8_STAGE2(bufoff, (gbase) + ((h) ? hstepA : 0), vaU[0], vaU[1]); } while (0)
#define PG8_LDA(dst, b, h) do { _Pragma("unroll") for (int m = 0; m < 4; ++m) _Pragma("unroll") for (int k = 0; k < 2; ++k) dst[m][k] = *(const LAS bf16x8*)(lds + PG8_SA(b, h) + aoff + m * 2048 + k * 1024); } while (0)
#define PG8_LDB(dst, b, h) do { _Pragma("unroll") for (int n = 0; n < 2; ++n) _Pragma("unroll") for (int k = 0; k < 2; ++k) dst[n][k] = *(const LAS bf16x8*)(lds + PG8_SB(b, h) + boff + n * 2048 + k * 1024); } while (0)
#define PG8_MMA(ai, bj, At, Bt) do { __builtin_amdgcn_s_setprio(1); _Pragma("unroll") for (int m = 0; m < 4; ++m) _Pragma("unroll") for (int n = 0; n < 2; ++n) _Pragma("unroll") for (int k = 0; k < 2; ++k) \
        acc[ai][bj][m][n] = __builtin_amdgcn_mfma_f32_16x16x32_bf16(Bt[n][k], At[m][k], acc[ai][bj][m][n], 0, 0, 0); __builtin_amdgcn_s_setprio(0); } while (0)
#define PG8_WAIT_V(n) asm volatile("s_waitcnt vmcnt(" #n ")" ::: "memory")
#define PG8_WAIT_L(n) asm volatile("s_waitcnt lgkmcnt(" #n ")" ::: "memory")
#define PG8_BAR __builtin_amdgcn_s_barrier()
#define PG8_SCHED __builtin_amdgcn_sched_barrier(0)
    GJob cur, nxt; int ui = 0;
    cur.A = nullptr; cur.B = nullptr; cur.va00 = cur.va01 = cur.va10 = cur.va11 = 0u; nxt = cur;
    if (!jobfn(0, cur)) return;
    f32x4 acc[2][2][4][2];
#pragma unroll
    for (int a = 0; a < 2; ++a)
#pragma unroll
        for (int b = 0; b < 2; ++b)
#pragma unroll
            for (int m = 0; m < 4; ++m)
#pragma unroll
                for (int n = 0; n < 2; ++n) acc[a][b][m][n] = (f32x4){0.f, 0.f, 0.f, 0.f};
    bf16x8 At[4][2], B0[2][2], B1[2][2];
    STB(PG8_SB(0, 0), cur.B, 0); STB(PG8_SB(0, 1), cur.B, 1); STA_CUR(PG8_SA(0, 0), cur.A, 0); STA_CUR(PG8_SA(0, 1), cur.A, 1);
    if (wr == 1) PG8_BAR;
    PG8_WAIT_V(2); PG8_BAR;
    STB(PG8_SB(1, 0), cur.B + kstep, 0); STA_CUR(PG8_SA(1, 0), cur.A + kstep, 0); STB(PG8_SB(1, 1), cur.B + kstep, 1);
    PG8_WAIT_V(6); PG8_BAR;
    for (;;) {
        bool has_next = false;
        for (int t = 0; t < nt; t += 2) {
            const bool last = (t == nt - 2);
            if (last) { has_next = jobfn(ui + 1, nxt); if (!has_next) nxt = cur; }
            const char* a1 = cur.A + (size_t)(t + 1) * kstep;
            const char* a2 = last ? nxt.A : cur.A + (size_t)(t + 2) * kstep; const char* b2 = last ? nxt.B : cur.B + (size_t)(t + 2) * kstep;
            const char* a3 = a2 + kstep; const char* b3 = b2 + kstep;
            PG8_LDB(B0, 0, 0); PG8_LDB(B1, 0, 1); PG8_SCHED; PG8_LDA(At, 0, 0); STA_CUR(PG8_SA(1, 1), a1, 1);
            PG8_WAIT_V(8); PG8_WAIT_L(0); PG8_BAR; PG8_MMA(0, 0, At, B0); PG8_MMA(0, 1, At, B1); PG8_BAR; PG8_SCHED;
            PG8_LDA(At, 0, 1); STB(PG8_SB(0, 0), b2, 0); STB(PG8_SB(0, 1), b2, 1); STA_SEL(PG8_SA(0, 0), a2, 0);
            PG8_WAIT_V(8); PG8_WAIT_L(0); PG8_BAR; PG8_MMA(1, 0, At, B0); PG8_MMA(1, 1, At, B1); PG8_BAR; PG8_SCHED;
            PG8_LDB(B0, 1, 0); PG8_LDB(B1, 1, 1); PG8_SCHED; PG8_LDA(At, 1, 0); STA_SEL(PG8_SA(0, 1), a2, 1);
            PG8_WAIT_V(8); PG8_WAIT_L(0); PG8_BAR; PG8_MMA(0, 0, At, B0); PG8_MMA(0, 1, At, B1); PG8_BAR; PG8_SCHED;
            PG8_LDA(At, 1, 1); STB(PG8_SB(1, 0), b3, 0); STB(PG8_SB(1, 1), b3, 1); STA_SEL(PG8_SA(1, 0), a3, 0);
            PG8_WAIT_V(8); PG8_WAIT_L(0); PG8_BAR; PG8_MMA(1, 0, At, B0); PG8_MMA(1, 1, At, B1); PG8_BAR; PG8_SCHED;
        }
        if (wr == 0) PG8_BAR;
        epi(acc, ui);
        if (!has_next) break;
#pragma unroll
        for (int a = 0; a < 2; ++a)
#pragma unroll
            for (int b = 0; b < 2; ++b)
#pragma unroll
                for (int m = 0; m < 4; ++m)
#pragma unroll
                    for (int n = 0; n < 2; ++n) acc[a][b][m][n] = (f32x4){0.f, 0.f, 0.f, 0.f};
        cur = nxt; ++ui;
        if (wr == 1) PG8_BAR;
    }
    PG8_WAIT_V(0);
    PG8_BAR;
#undef PG8_SA
#undef PG8_SB
#undef PG8_STAGE2
#undef STB
#undef STA_CUR
#undef STA_SEL
#undef PG8_LDA
#undef PG8_LDB
#undef PG8_MMA
#undef PG8_WAIT_V
#undef PG8_WAIT_L
#undef PG8_BAR
#undef PG8_SCHED
}
__device__ __forceinline__ void gj_lin2(unsigned (&v)[2], int ld) {
#pragma unroll
    for (int i = 0; i < 2; ++i) { int R, C; g_stage_rc(tid_() * 16 + i * 8192, R, C); v[i] = (unsigned)((R * ld + C) * 2); }
}
typedef int i32x8 __attribute__((ext_vector_type(8)));
typedef unsigned u32x4 __attribute__((ext_vector_type(4)));
struct G8Job { const char* A; const char* B; unsigned va0, va1, va2, va3; int aux; };
__device__ __forceinline__ void g8_rc(int i, int& R, int& Cb) { int C; g_stage_rc(tid_() * 16 + i * 8192, R, C); Cb = C * 2; }
__device__ __forceinline__ const char* uni_ptr8(const char* p) {
    const unsigned long long v = (unsigned long long)p;
    const unsigned lo = __builtin_amdgcn_readfirstlane((unsigned)v), hi = __builtin_amdgcn_readfirstlane((unsigned)(v >> 32));
    return (const char*)(((unsigned long long)hi << 32) | lo);
}
#define G8_PRE_DMA(gptr, voff, ldsaddr) asm volatile("s_mov_b32 m0, %2\n\ts_nop 0\n\tglobal_load_lds_dword %0, %1" :: "v"(voff), "s"(gptr), "s"(ldsaddr) : "memory", "m0")
template <bool GATHER, class JobFn, class Pre, class Epi>
__device__ __forceinline__ void gemm8_stream(unsigned char* lds_, const unsigned (&vbU)[4], const JobFn& jobfn, const Pre& pre, const Epi& epi) {
    LAS unsigned char* lds = (LAS unsigned char*)lds_;
    const int tid = tid_(), wid = __builtin_amdgcn_readfirstlane(tid >> 6), lane = tid & 63, wr = wid >> 2, wc = wid & 3, fr = lane & 15, fq = lane >> 4;
    LAS unsigned char* a0p = lds + g_lds_byte(wr * 64 + fr, fq * 8); LAS unsigned char* a1p = a0p + 65536;
    LAS unsigned char* b0p = lds + 32768 + g_lds_byte(wc * 32 + fr, fq * 8); LAS unsigned char* b1p = b0p + 65536;
    const unsigned ldsw_u = __builtin_amdgcn_readfirstlane((unsigned)(size_t)(lds + wid * 1024));
#define G8_GLDS(base, voff, ldsaddr) asm volatile("s_mov_b32 m0, %2\n\ts_nop 0\n\tglobal_load_lds_dwordx4 %0, %1" :: "v"(voff), "s"(base), "s"(ldsaddr) : "memory", "m0")
#define G8_DMA(JA, JB, v0, v1, v2, v3, buf, kt) do { \
        const char* pa_ = uni_ptr8(JA) + (kt) * 128; const char* pb_ = uni_ptr8(JB) + (kt) * 128; const unsigned d_ = ldsw_u + (buf) * 65536; \
        G8_GLDS(pa_, (GATHER ? v0 : vb0), d_); \
        G8_GLDS(pa_, (GATHER ? v1 : vb1), d_ + 8192); \
        G8_GLDS(pa_, (GATHER ? v2 : vb2), d_ + 16384); \
        G8_GLDS(pa_, (GATHER ? v3 : vb3), d_ + 24576); \
        G8_GLDS(pb_, vb0, d_ + 32768); \
        G8_GLDS(pb_, vb1, d_ + 32768 + 8192); \
        G8_GLDS(pb_, vb2, d_ + 32768 + 16384); \
        G8_GLDS(pb_, vb3, d_ + 32768 + 24576); } while (0)
#define G8_LD(dst, ptr) do { const u32x4 x0_ = *(const LAS u32x4*)(ptr), x1_ = *(const LAS u32x4*)((ptr) + 1024); \
        dst = (i32x8){(int)x0_.x, (int)x0_.y, (int)x0_.z, (int)x0_.w, (int)x1_.x, (int)x1_.y, (int)x1_.z, (int)x1_.w}; } while (0)
#define G8_LDA(dst, ap, ai, m0, m1) do { _Pragma("unroll") for (int m = m0; m < m1; ++m) G8_LD(dst[m], (ap) + (ai) * 16384 + m * 2048); } while (0)
#define G8_LDB(dst, bp, bj) do { _Pragma("unroll") for (int n = 0; n < 2; ++n) G8_LD(dst[n], (bp) + (bj) * 16384 + n * 2048); } while (0)
#define G8_MMA(ai, bj, At, Bt) do { __builtin_amdgcn_sched_barrier(0); __builtin_amdgcn_s_setprio(1); _Pragma("unroll") for (int m = 0; m < 4; ++m) _Pragma("unroll") for (int n = 0; n < 2; ++n) \
        asm("v_mfma_scale_f32_16x16x128_f8f6f4 %0, %1, %2, %0, %3, %3 op_sel_hi:[0,0,0]" : "+v"(acc[ai][bj][m][n]) : "v"(Bt[n]), "v"(At[m]), "v"(unit_scale)); \
        __builtin_amdgcn_s_setprio(0); __builtin_amdgcn_sched_barrier(0); } while (0)
#define G8_PF 2
#define G8_TILE(buf, ap, bp, apn, bpn, X, Y, kt) do { \
        G8_LDA(P, ap, 0, G8_PF, 4); G8_LDB(Y, bp, 1); G8_MMA(0, 0, P, X); \
        G8_LDA(Q, ap, 1, 0, 2);                       G8_MMA(0, 1, P, Y); \
        G8_LDA(Q, ap, 1, 2, 4);                       G8_MMA(1, 1, Q, Y); \
        asm volatile("" ::: "memory"); __builtin_amdgcn_s_waitcnt(0x0070); __builtin_amdgcn_s_barrier(); asm volatile("" ::: "memory"); \
        asm volatile("" : "+v"(vb0), "+v"(vb1), "+v"(vb2), "+v"(vb3), "+v"(cur.va0), "+v"(cur.va1), "+v"(cur.va2), "+v"(cur.va3)); \
        G8_DMA(selA, selB, cur.va0, cur.va1, cur.va2, cur.va3, buf, kt); \
        G8_LDA(P, apn, 0, 0, G8_PF); G8_LDB(Y, bpn, 0); \
        G8_MMA(1, 0, Q, X); } while (0)
    G8Job cur, nxt;
    cur.A = nullptr; cur.B = nullptr; cur.va0 = cur.va1 = cur.va2 = cur.va3 = 0u; cur.aux = 0; nxt = cur;
    if (!jobfn(0, cur)) return;
    cur.A = uni_ptr8(cur.A); cur.B = uni_ptr8(cur.B);
    unsigned vb0 = vbU[0], vb1 = vbU[1], vb2 = vbU[2], vb3 = vbU[3];
    G8_DMA(cur.A, cur.B, cur.va0, cur.va1, cur.va2, cur.va3, 0, 0); G8_DMA(cur.A, cur.B, cur.va0, cur.va1, cur.va2, cur.va3, 1, 1);
    asm volatile("s_waitcnt vmcnt(0)" ::: "memory");
    __syncthreads();
    int ui = 0;
    for (;;) {
        f32x4 acc[2][2][4][2];
#pragma unroll
        for (int a = 0; a < 2; ++a)
#pragma unroll
            for (int b = 0; b < 2; ++b)
#pragma unroll
                for (int m = 0; m < 4; ++m)
#pragma unroll
                    for (int n = 0; n < 2; ++n) acc[a][b][m][n] = (f32x4){0.f, 0.f, 0.f, 0.f};
        const bool has_next = jobfn(ui + 1, nxt);
        pre(ui, __builtin_amdgcn_readfirstlane(cur.aux));
        nxt.A = uni_ptr8(nxt.A); nxt.B = uni_ptr8(nxt.B);
        if (!has_next) nxt = cur;
        i32x8 P[4], Q[4], X[2], Y[2];
        const int unit_scale = 0x7f7f7f7f;
        G8_LDA(P, a0p, 0, 0, G8_PF); G8_LDB(X, b0p, 0);
#pragma unroll 1
        for (int t2 = 0; t2 < 4; ++t2) {
            const bool lastp = t2 == 3;
            const char* selA = lastp ? nxt.A : cur.A; const char* selB = lastp ? nxt.B : cur.B;
            if (GATHER) { cur.va0 = lastp ? nxt.va0 : cur.va0; cur.va1 = lastp ? nxt.va1 : cur.va1; cur.va2 = lastp ? nxt.va2 : cur.va2; cur.va3 = lastp ? nxt.va3 : cur.va3; }
            const int kt0 = lastp ? 0 : 2 * t2 + 2;
            asm volatile("" : "+v"(a0p), "+v"(a1p), "+v"(b0p), "+v"(b1p));
            G8_TILE(0, a0p, b0p, a1p, b1p, X, Y, kt0);
            G8_TILE(1, a1p, b1p, a0p, b0p, Y, X, kt0 + 1);
        }
        asm volatile("s_nop 15\n\ts_nop 15" ::: "memory");
        epi(acc, ui);
        if (!has_next) break;
        cur.A = nxt.A; cur.B = nxt.B; cur.aux = nxt.aux; ++ui;
    }
#undef G8_TILE
#undef G8_PF
#undef G8_MMA
#undef G8_LDB
#undef G8_LDA
#undef G8_LD
#undef G8_DMA
#undef G8_GLDS
    asm volatile("s_waitcnt vmcnt(0)" ::: "memory");
    __syncthreads();
}
struct RowLin { size_t base; int ld; __device__ __forceinline__ size_t operator()(int R) const { return base + (size_t)R * ld; } };

__device__ __forceinline__ void st_bf4(bf16_t* dst, f32x4 v) {
    uint2 o; o.x = pack2(v[0], v[1]); o.y = pack2(v[2], v[3]); *(uint2*)dst = o;
}
__device__ __forceinline__ int pair_col(int fq) { return 16 * (fq & 1) + 8 * (fq >> 1); }
__device__ __forceinline__ void st_bf4_pair(bf16_t* rowp_c0, int fq, const f32x4& v0, const f32x4& v1) {
    uint32_t ax = pack2(v0[0], v0[1]), ay = pack2(v0[2], v0[3]), bx = pack2(v1[0], v1[1]), by = pack2(v1[2], v1[3]);
    auto r = __builtin_amdgcn_permlane16_swap(ax, bx, false, false); ax = r[0]; bx = r[1];
    r = __builtin_amdgcn_permlane16_swap(ay, by, false, false); ay = r[0]; by = r[1];
    *(u32x4*)(rowp_c0 + pair_col(fq)) = (u32x4){ax, ay, bx, by};
}
#define EPI8(...) do { const int tid_e = tid_(), lane_e = tid_e & 63, wid_e = tid_e >> 6, wr = wid_e >> 2, wc = wid_e & 3, fr = lane_e & 15, fq = lane_e >> 4; \
    _Pragma("unroll") for (int ai = 0; ai < 2; ++ai) _Pragma("unroll") for (int m = 0; m < 4; ++m) _Pragma("unroll") for (int bj = 0; bj < 2; ++bj) _Pragma("unroll") for (int n = 0; n < 2; ++n) { \
        const int row = ai * 128 + wr * 64 + m * 16 + fr, col = bj * 128 + wc * 32 + n * 16 + fq * 4; const f32x4 v = acc[ai][bj][m][n]; __VA_ARGS__ } } while (0)

struct EpiInproj {
    const P* p; int nt;
    __device__ __forceinline__ f32x4 xf(int m, int n, int fq, f32x4 v) const {
        const P& P_ = *p;
        const int pos = m % LP;
        const float* rp = P_.rope() + (size_t)pos * 24;
        if (nt <= 2) {
            const bool isv = (nt == 2) && (n >= 128);
            if (!isv && (n & 48) == 0) {
                f32x4 pr;
#pragma unroll
                for (int j = 0; j < 4; ++j) pr[j] = __shfl_xor(v[j], 32);
                const int i0 = (fq & 1) * 4;
#pragma unroll
                for (int j = 0; j < 4; ++j) {
                    const float c = rp[i0 + j], s = rp[8 + i0 + j];
                    v[j] = fq < 2 ? v[j] * c - pr[j] * s : v[j] * c + pr[j] * s;
                }
            }
            return nt < 2 ? v * (0.125f * 1.4426950408889634f) : v;
        } else if (nt == 3 || nt == 4) {
            const bool ropeable = (nt == 3) ? ((n & 16) == 0) : (n < 16);
            if (ropeable) {
                f32x4 pr;
#pragma unroll
                for (int j = 0; j < 4; ++j) pr[j] = __shfl_xor(v[j], 16);
                if (fq < 2) {
#pragma unroll
                    for (int j = 0; j < 4; ++j) {
                        const float c = rp[16 + j], s = rp[20 + j];
                        v[j] = fq == 0 ? v[j] * c - pr[j] * s : v[j] * c + pr[j] * s;
                    }
                }
            }
            return v;
        } else if (nt <= 6) return v * 0.08838834764831845f;
        else if (nt <= 10) return v;
        f32x4 o;
        if (nt <= 12) {
#pragma unroll
            for (int j = 0; j < 4; ++j) o[j] = v[j] * sigmoidf_(v[j]);
        } else {
#pragma unroll
            for (int j = 0; j < 4; ++j) o[j] = sigmoidf_(v[j]);
        }
        return o;
    }
    __device__ __forceinline__ bf16_t* dst(int m, int c) const {
        const P& P_ = *p;
        if (nt < 2) return P_.q() + (size_t)m * 512 + nt * 256 + c;
        if (nt == 2) return c < 128 ? P_.k() + (size_t)m * 128 + c : P_.v() + (size_t)m * 128 + (c - 128);
        if (nt == 3) return P_.iq() + (size_t)m * 256 + c;
        if (nt <= 6) return P_.hq() + (size_t)m * 512 + (nt - 5) * 256 + c;
        if (nt <= 8) return P_.hf() + (size_t)m * 512 + (nt - 7) * 256 + c;
        if (nt <= 10) return P_.hi() + (size_t)m * 512 + (nt - 9) * 256 + c;
        return P_.hg() + (size_t)m * 512 + (nt - 11) * 256 + c;
    }
    __device__ __forceinline__ void pair(int m, int c0, int fq, const f32x4& a0, const f32x4& a1) const {
        const P& P_ = *p;
        const f32x4 v0 = xf(m, c0 + fq * 4, fq, a0), v1 = xf(m, c0 + 16 + fq * 4, fq, a1);
        if (nt == 4) {
            const int n0 = c0 + fq * 4, n1 = n0 + 16;
            if (n0 < 32) st_bf4(P_.ik() + (size_t)m * 32 + n0, v0); else if (n0 < 40) *(f32x4*)(P_.iw() + (size_t)m * 8 + (n0 - 32)) = v0;
            if (n1 < 32) st_bf4(P_.ik() + (size_t)m * 32 + n1, v1);
        } else if (nt <= 2) {
            const float sc = nt < 2 ? 8.0f : 1.0f;
            uint32_t w0 = pk4_fp8(v0[0] * sc, v0[1] * sc, v0[2] * sc, v0[3] * sc), w1 = pk4_fp8(v1[0] * sc, v1[1] * sc, v1[2] * sc, v1[3] * sc);
            const auto r = __builtin_amdgcn_permlane16_swap(w0, w1, false, false); w0 = r[0]; w1 = r[1];
            unsigned char* g = (nt < 2 ? P_.q8() + (size_t)m * 512 + nt * 256 + c0 : (c0 < 128 ? P_.k8() + (size_t)m * 128 + c0 : P_.v8() + (size_t)m * 128 + (c0 - 128))) + pair_col(fq);
            *(uint2*)g = make_uint2(w0, w1);
        } else if (nt >= 13) {
            uint32_t w0 = (uint32_t)(v0[0] * 255.0f + 0.5f) | ((uint32_t)(v0[1] * 255.0f + 0.5f) << 8) | ((uint32_t)(v0[2] * 255.0f + 0.5f) << 16) | ((uint32_t)(v0[3] * 255.0f + 0.5f) << 24);
            uint32_t w1 = (uint32_t)(v1[0] * 255.0f + 0.5f) | ((uint32_t)(v1[1] * 255.0f + 0.5f) << 8) | ((uint32_t)(v1[2] * 255.0f + 0.5f) << 16) | ((uint32_t)(v1[3] * 255.0f + 0.5f) << 24);
            const auto r = __builtin_amdgcn_permlane16_swap(w0, w1, false, false); w0 = r[0]; w1 = r[1];
            unsigned char* g = (nt <= 16 ? P_.ga() + (size_t)m * 1024 + (nt - 13) * 256 : P_.gh() + (size_t)m * 1024 + (nt - 17) * 256) + c0 + pair_col(fq);
            *(uint2*)g = make_uint2(w0, w1);
        } else st_bf4_pair(dst(m, c0), fq, v0, v1);
    }
};

__device__ __forceinline__ void inproj_epilogue(const P& p, int nt, int mt, f32x4 (&acc)[2][2][4][2], float scale) {
    const EpiInproj e{&p, nt};
    const int tid_e = tid_(), lane_e = tid_e & 63, wid_e = tid_e >> 6, wr = wid_e >> 2, wc = wid_e & 3, fr = lane_e & 15, fq = lane_e >> 4;
#pragma unroll
    for (int ai = 0; ai < 2; ++ai)
#pragma unroll
        for (int m = 0; m < 4; ++m)
#pragma unroll
            for (int bj = 0; bj < 2; ++bj)
                e.pair(mt * 256 + ai * 128 + wr * 64 + m * 16 + fr, bj * 128 + wc * 32, fq, acc[ai][bj][m][0] * scale, acc[ai][bj][m][1] * scale);
}

__device__ __forceinline__ void ph_inproj(const P& p, unsigned char* lds) {
    const int G = gridDim.x, b0 = blockIdx.x;
    {
        const int nunits = (T / 256) * 2;
        auto jobfn = [&](int i, GJob& j) __attribute__((always_inline)) -> bool {
            const int u = b0 + i * G; if (u >= nunits) return false;
            const int nt = 3 + (u & 1), mt = u >> 1;
            j.A = (const char*)(p.xn() + (size_t)mt * 256 * D); j.B = (const char*)(p.winTb() + (size_t)(nt - 3) * 256 * D); return true; };
        auto epi = [&](f32x4 (&acc)[2][2][4][2], int i) __attribute__((always_inline)) {
            const int u = b0 + i * G, nt = 3 + (u & 1), mt = u >> 1;
            inproj_epilogue(p, nt, mt, acc, 1.0f);
        };
        unsigned vbU[2]; gj_lin2(vbU, D);
        gemm_stream<false>(lds, D, D, (size_t)128 * D * 2, vbU, jobfn, epi);
    }
    {
        const int nunits = (T / 256) * 19, br = G - 1 - b0;
        const int nfull = nunits / G, nrem = nunits - nfull * G, nb2 = (T / 256) * 2 - G;
        const bool balanced = nb2 > 0 && nb2 < G / 4 && nfull >= 1;
        auto unit_of = [&](int i) __attribute__((always_inline)) -> int {
            if (!balanced) { const int u = br + i * G; return u < nunits ? u : -1; }
            if (i < nfull - 1) return br + i * G;
            const int pool0 = (nfull - 1) * G, npool = nunits - pool0;
            const int idx = br;
            if (i == nfull - 1) return idx < G - nb2 ? pool0 + idx : -1;
            if (i == nfull) { const int k = pool0 + (G - nb2) + idx; return k < pool0 + npool ? k : -1; }
            return -1; };
        auto jobfn = [&](int i, G8Job& j) __attribute__((always_inline)) -> bool {
            const int u = unit_of(i); if (u < 0) return false;
            const int n19 = u % 19, nt = n19 < 3 ? n19 : n19 + 2, mt = u / 19;
            j.A = (const char*)(p.xn8() + (size_t)mt * 256 * D); j.B = (const char*)(p.winT8() + (size_t)nt * 256 * D); return true; };
        auto epi = [&](f32x4 (&acc)[2][2][4][2], int i) __attribute__((always_inline)) {
            const int u = unit_of(i), n19 = u % 19, nt = n19 < 3 ? n19 : n19 + 2, mt = u / 19;
            inproj_epilogue(p, nt, mt, acc, 0.03125f);
        };
        unsigned vbU[4];
#pragma unroll
        for (int q = 0; q < 4; ++q) { int R, Cb; g8_rc(q, R, Cb); vbU[q] = (unsigned)(R * D + Cb); }
        gemm8_stream<false>(lds, vbU, jobfn, [](int, int) __attribute__((always_inline)) {}, epi);
    }
}
constexpr int NCH = 129, NXU = 16 * NCH;
constexpr int X_QT = 0, X_KT = X_QT + 64 * 272, X_KH = X_KT + 64 * 272, X_VT = X_KH + 128 * 144, X_AS = X_VT + 128 * 144, X_SEG = X_AS + 64 * 144;
__device__ __forceinline__ bf16_t* hg_ds(const P& p) { return (bf16_t*)p.out; }
__device__ __forceinline__ float* hg_g(const P& p) { return (float*)((unsigned char*)p.out + (size_t)NXU * 32768); }

__device__ __forceinline__ void hgx_unit(const P& p, unsigned char* lds, int u) {
    const int tid = tid_(), lane = tid & 63, wid = tid >> 6, fr = lane & 15, fq = lane >> 4;
    const int c = u % NCH, bh = u / NCH, b = bh >> 2, h = bh & 3;
    const int d = tid & 127, seg = tid >> 7;
    const size_t rowbase = (size_t)(b * LP + c * 64 + seg * 16) * 512 + h * 128 + d;
    bf16_t* hqp = p.hq() + rowbase; const bf16_t* hfp = p.hf() + rowbase; const bf16_t* hip = p.hi() + rowbase;
    const float lbv = p.lb()[h * 128 + d];
    float bb[16], qv[16], kk[16], vv[16];
    float cs = 0.f;
#pragma unroll
    for (int i = 0; i < 16; ++i) {
        const float f = lbv + (1.0f - lbv) * sigmoidf_(bf2f(hfp[(size_t)i * 512]));
        kk[i] = 1.0f - f; cs += __logf(f); bb[i] = cs;
        qv[i] = bf2f(hqp[(size_t)i * 512]); vv[i] = bf2f(hip[(size_t)i * 512]);
    }
    float* segs = (float*)(lds + X_SEG);
    segs[seg * 128 + d] = cs;
    __syncthreads();
    const float s0 = segs[d], s1 = segs[128 + d], s2 = segs[256 + d], s3 = segs[384 + d];
    const float off = seg == 0 ? 0.f : (seg == 1 ? s0 : (seg == 2 ? s0 + s1 : s0 + s1 + s2));
    const float rref = s0 + s1, blast = (s0 + s1) + (s2 + s3);
    uint32_t khp[8], vtp[8];
#pragma unroll
    for (int i = 0; i < 16; i += 2) {
        float khv[2];
#pragma unroll
        for (int j = 0; j < 2; ++j) {
            const float bt = bb[i + j] + off;
            const float eq = __expf(fminf(bt - rref, 80.f)), ek = __expf(fminf(rref - bt, 80.f));
            const int t = seg * 16 + i + j;
            *(bf16_t*)(lds + X_QT + t * 272 + d * 2) = f2bf(qv[i + j] * eq);
            *(bf16_t*)(lds + X_KT + t * 272 + d * 2) = f2bf(kk[i + j] * ek);
            hqp[(size_t)(i + j) * 512] = f2bf(qv[i + j] * __expf(bt));
            khv[j] = kk[i + j] * __expf(blast - bt);
        }
        khp[i >> 1] = pack2(khv[0], khv[1]); vtp[i >> 1] = pack2(vv[i], vv[i + 1]);
    }
    *(uint4*)(lds + X_KH + d * 144 + seg * 32) = make_uint4(khp[0], khp[1], khp[2], khp[3]);
    *(uint4*)(lds + X_KH + d * 144 + seg * 32 + 16) = make_uint4(khp[4], khp[5], khp[6], khp[7]);
    *(uint4*)(lds + X_VT + d * 144 + seg * 32) = make_uint4(vtp[0], vtp[1], vtp[2], vtp[3]);
    *(uint4*)(lds + X_VT + d * 144 + seg * 32 + 16) = make_uint4(vtp[4], vtp[5], vtp[6], vtp[7]);
    if (seg == 0) hg_g(p)[(size_t)u * 128 + d] = __expf(blast);
    __syncthreads();
    {
        const int tm = wid >> 1, tn0 = (wid & 1) * 2;
        f32x4 a1[2] = {(f32x4){0.f, 0.f, 0.f, 0.f}, (f32x4){0.f, 0.f, 0.f, 0.f}};
#pragma unroll
        for (int ks = 0; ks < 4; ++ks) {
            const bf16x8 aq = *(const bf16x8*)(lds + X_QT + (tm * 16 + fr) * 272 + (ks * 32 + fq * 8) * 2);
#pragma unroll
            for (int j = 0; j < 2; ++j) {
                const bf16x8 bk = *(const bf16x8*)(lds + X_KT + ((tn0 + j) * 16 + fr) * 272 + (ks * 32 + fq * 8) * 2);
                a1[j] = __builtin_amdgcn_mfma_f32_16x16x32_bf16(bk, aq, a1[j], 0, 0, 0);
            }
        }
#pragma unroll
        for (int j = 0; j < 2; ++j) {
            const int t = tm * 16 + fr, sb = (tn0 + j) * 16 + fq * 4;
            f32x4 v = a1[j];
#pragma unroll
            for (int jj = 0; jj < 4; ++jj) v[jj] = (sb + jj <= t) ? v[jj] : 0.f;
            uint2 o; o.x = pack2(v[0], v[1]); o.y = pack2(v[2], v[3]);
            *(uint2*)(lds + X_AS + t * 144 + sb * 2) = o;
        }
    }
    __syncthreads();
    {
        const int tm = wid >> 1, en0 = (wid & 1) * 4;
        f32x4 o2[4];
#pragma unroll
        for (int j = 0; j < 4; ++j) o2[j] = (f32x4){0.f, 0.f, 0.f, 0.f};
#pragma unroll
        for (int ks = 0; ks < 2; ++ks) {
            const bf16x8 aa = *(const bf16x8*)(lds + X_AS + (tm * 16 + fr) * 144 + (ks * 32 + fq * 8) * 2);
#pragma unroll
            for (int j = 0; j < 4; ++j) {
                const bf16x8 bv = *(const bf16x8*)(lds + X_VT + ((en0 + j) * 16 + fr) * 144 + (ks * 32 + fq * 8) * 2);
                o2[j] = __builtin_amdgcn_mfma_f32_16x16x32_bf16(bv, aa, o2[j], 0, 0, 0);
            }
        }
        bf16_t* orow = p.hf() + (size_t)(b * LP + c * 64 + tm * 16 + fr) * 512 + h * 128;
#pragma unroll
        for (int j = 0; j < 4; ++j) st_bf4(orow + (en0 + j) * 16 + fq * 4, o2[j]);
    }
    {
        f32x4 s3[8];
#pragma unroll
        for (int j = 0; j < 8; ++j) s3[j] = (f32x4){0.f, 0.f, 0.f, 0.f};
#pragma unroll
        for (int ks = 0; ks < 2; ++ks) {
            const bf16x8 ak = *(const bf16x8*)(lds + X_KH + (wid * 16 + fr) * 144 + (ks * 32 + fq * 8) * 2);
#pragma unroll
            for (int j = 0; j < 8; ++j) {
                const bf16x8 bv = *(const bf16x8*)(lds + X_VT + (j * 16 + fr) * 144 + (ks * 32 + fq * 8) * 2);
                s3[j] = __builtin_amdgcn_mfma_f32_16x16x32_bf16(ak, bv, s3[j], 0, 0, 0);
            }
        }
        bf16_t* dsb = hg_ds(p) + (size_t)u * 16384;
#pragma unroll
        for (int j = 0; j < 8; ++j) st_bf4(dsb + (size_t)(j * 16 + fr) * 128 + wid * 16 + fq * 4, s3[j]);
    }
    __syncthreads();
}

__device__ __forceinline__ void hgchain_unit(const P& p, int item) {
    const int tid = tid_(), bh = item >> 2, eq = item & 3;
    const int e = eq * 32 + (tid >> 4), d0 = (tid & 15) * 8;
    float S[8];
#pragma unroll
    for (int i = 0; i < 8; ++i) S[i] = 0.f;
    uint4* ptr = (uint4*)(hg_ds(p) + ((size_t)(bh * NCH) * 128 + e) * 128 + d0);
    const f32x4* gp = (const f32x4*)(hg_g(p) + (size_t)(bh * NCH) * 128 + d0);
    uint4 wq[8]; f32x4 g0[8], g1[8];
#pragma unroll
    for (int k = 0; k < 8; ++k) { wq[k] = ptr[(size_t)k * 2048]; g0[k] = gp[k * 32]; g1[k] = gp[k * 32 + 1]; }
    for (int c0 = 0; c0 < NCH; c0 += 8) {
#pragma unroll
        for (int k = 0; k < 8; ++k) {
            const int c = c0 + k;
            if (c < NCH) {
                const uint4 w = wq[k]; const f32x4 ga = g0[k], gb = g1[k];
                if (c + 8 < NCH) { wq[k] = ptr[(size_t)(c + 8) * 2048]; g0[k] = gp[(c + 8) * 32]; g1[k] = gp[(c + 8) * 32 + 1]; }
                ptr[(size_t)c * 2048] = make_uint4(pack2(S[0], S[1]), pack2(S[2], S[3]), pack2(S[4], S[5]), pack2(S[6], S[7]));
                S[0] = ga[0] * S[0] + __uint_as_float(w.x << 16); S[1] = ga[1] * S[1] + __uint_as_float(w.x & 0xffff0000u);
                S[2] = ga[2] * S[2] + __uint_as_float(w.y << 16); S[3] = ga[3] * S[3] + __uint_as_float(w.y & 0xffff0000u);
                S[4] = gb[0] * S[4] + __uint_as_float(w.z << 16); S[5] = gb[1] * S[5] + __uint_as_float(w.z & 0xffff0000u);
                S[6] = gb[2] * S[6] + __uint_as_float(w.w << 16); S[7] = gb[3] * S[7] + __uint_as_float(w.w & 0xffff0000u);
            }
        }
    }
}

struct ZPre { bf16x8 aq[4]; bf16x8 bs[4][4]; };
__device__ __forceinline__ void hgz_prefetch(const P& p, int u, ZPre& z) {
    const int tid = tid_(), lane = tid & 63, wid = tid >> 6, fr = lane & 15, fq = lane >> 4;
    const int c = u % NCH, bh = u / NCH, b = bh >> 2, h = bh & 3;
    const int tm = wid >> 1, en0 = (wid & 1) * 4;
    const size_t row = (size_t)(b * LP + c * 64 + tm * 16 + fr);
    const bf16_t* qrow = p.hq() + row * 512 + h * 128;
    const bf16_t* sT = hg_ds(p) + (size_t)u * 16384;
#pragma unroll
    for (int ks = 0; ks < 4; ++ks) {
        z.aq[ks] = *(const bf16x8*)(qrow + ks * 32 + fq * 8);
#pragma unroll
        for (int j = 0; j < 4; ++j) z.bs[ks][j] = *(const bf16x8*)(sT + (size_t)((en0 + j) * 16 + fr) * 128 + ks * 32 + fq * 8);
    }
}
__device__ __forceinline__ void hgz_unit(const P& p, unsigned char* lds, int u, const ZPre& z) {
    const int tid = tid_(), lane = tid & 63, wid = tid >> 6, fr = lane & 15, fq = lane >> 4;
    const int c = u % NCH, bh = u / NCH, b = bh >> 2, h = bh & 3;
    const int tm = wid >> 1, en0 = (wid & 1) * 4;
    const size_t row = (size_t)(b * LP + c * 64 + tm * 16 + fr);
    f32x4 o[4];
#pragma unroll
    for (int j = 0; j < 4; ++j) o[j] = (f32x4){0.f, 0.f, 0.f, 0.f};
#pragma unroll
    for (int ks = 0; ks < 4; ++ks)
#pragma unroll
        for (int j = 0; j < 4; ++j) o[j] = __builtin_amdgcn_mfma_f32_16x16x32_bf16(z.bs[ks][j], z.aq[ks], o[j], 0, 0, 0);
    const bf16_t* oi = p.hf() + row * 512 + h * 128;
    float ss = 0.f;
#pragma unroll
    for (int j = 0; j < 4; ++j) {
        const uint2 w = *(const uint2*)(oi + (en0 + j) * 16 + fq * 4);
        o[j][0] += __uint_as_float(w.x << 16); o[j][1] += __uint_as_float(w.x & 0xffff0000u);
        o[j][2] += __uint_as_float(w.y << 16); o[j][3] += __uint_as_float(w.y & 0xffff0000u);
        ss += o[j][0] * o[j][0] + o[j][1] * o[j][1] + o[j][2] * o[j][2] + o[j][3] * o[j][3];
    }
    ss = xsum32(xsum16(ss));
    const bf16_t* hgp = p.hg() + row * 512 + h * 128;
    bf16_t* outp = p.hgr() + row * 512 + h * 128;
    f32x4 gnv[4]; uint2 hgv[4];
#pragma unroll
    for (int j = 0; j < 4; ++j) { const int e0 = (en0 + j) * 16 + fq * 4; gnv[j] = *(const f32x4*)(p.hgrn_g + h * 128 + e0); hgv[j] = *(const uint2*)(hgp + e0); }
    float* part = (float*)lds;
    if (fq == 0) part[(tm * 16 + fr) * 2 + (wid & 1)] = ss;
    __syncthreads();
    const float tot = part[(tm * 16 + fr) * 2] + part[(tm * 16 + fr) * 2 + 1];
    const float rs = rsqrtf(tot * (1.0f / 128.0f) + EPS);
#pragma unroll
    for (int j = 0; j < 4; ++j) {
        const int e0 = (en0 + j) * 16 + fq * 4;
        const f32x4 gn = gnv[j];
        const uint2 w = hgv[j];
        f32x4 r;
        r[0] = o[j][0] * rs * gn[0] * __uint_as_float(w.x << 16); r[1] = o[j][1] * rs * gn[1] * __uint_as_float(w.x & 0xffff0000u);
        r[2] = o[j][2] * rs * gn[2] * __uint_as_float(w.y << 16); r[3] = o[j][3] * rs * gn[3] * __uint_as_float(w.y & 0xffff0000u);
        st_bf4(outp + e0, r);
    }
    __syncthreads();
}

typedef float f32x16 __attribute__((ext_vector_type(16)));
typedef short s16x4 __attribute__((ext_vector_type(4)));

constexpr int NKMAX = 8224;
constexpr int NBIN = 1024;
constexpr int A_SC = 0, A_H1 = A_SC + 4 * NKMAX * 4, A_SEL = A_H1 + 4 * NBIN * 4, A_CAND = A_SEL + 2048, A_META = A_CAND + 1024, A_END = A_META + 256;
static_assert(A_END <= LDS_BYTES - 16, "attention LDS");
__device__ __forceinline__ uint32_t skey(float f) { const uint32_t u = __float_as_uint(f); return (u & 0x80000000u) ? ~u : (u | 0x80000000u); }
__device__ __forceinline__ float skey_inv(uint32_t k) { return __uint_as_float((k & 0x80000000u) ? (k & 0x7fffffffu) : ~k); }
__device__ __forceinline__ int bin1(float s, float lo, float scale) { return min(NBIN - 1, max(0, (int)((s - lo) * scale))); }
template <int OFF> __device__ __forceinline__ s16x4 tr_read(unsigned addr) {
    s16x4 r; asm volatile("ds_read_b64_tr_b16 %0, %1 offset:%2" : "=&v"(r) : "v"(addr), "i"(OFF) : "memory"); return r;
}
__device__ __forceinline__ void scan_top(const int* hist, int K, int* m, int lane) {
    int c[16];
#pragma unroll
    for (int i = 0; i < 4; ++i) { const int4 v = *(const int4*)(hist + 16 * lane + 4 * i); c[4 * i] = v.x; c[4 * i + 1] = v.y; c[4 * i + 2] = v.z; c[4 * i + 3] = v.w; }
    int tot = 0;
#pragma unroll
    for (int i = 0; i < 16; ++i) tot += c[i];
    int suf = tot;
#pragma unroll
    for (int o = 1; o < 64; o <<= 1) { const int t = __shfl_down(suf, o); if (lane + o < 64) suf += t; }
    int above = suf - tot;
#pragma unroll
    for (int i = 15; i >= 0; --i) {
        if (above < K && K <= above + c[i]) { m[0] = 16 * lane + i; m[1] = above; m[2] = c[i]; }
        above += c[i];
    }
}

__device__ __forceinline__ void attn4_unit(const P& p, unsigned char* lds, int b, int grp) {
    const int tid = tid_(), lane = tid & 63, wid = __builtin_amdgcn_readfirstlane(tid >> 6);
    const int t0 = NMETA + 4 * grp;
    const int brow = b * LP, row0 = brow + t0;
    float* sc = (float*)(lds + A_SC);
    int* h1 = (int*)(lds + A_H1);
    unsigned short* sel = (unsigned short*)(lds + A_SEL); unsigned short* cand = (unsigned short*)(lds + A_CAND);
    int* meta = (int*)(lds + A_META);
    const bool big = t0 + 1 > 256;
    for (int i = tid; i < 4 * NBIN; i += NTHREADS) h1[i] = 0;
    if (tid < 64) { const int w = tid & 15; meta[tid] = (w == 0) ? -1 : 0; }
    if (!big) { for (int i = tid; i < 1024; i += NTHREADS) { const int q = i >> 8, j = i & 255; sel[i] = (unsigned short)(j <= t0 + q ? j : 0); } }
    __syncthreads();
    if (big) {
        {
            const int hh = lane >> 5, c32 = lane & 31;
            const int g = c32 >> 3, h2a = (c32 >> 2) & 1, bq = c32 & 3, aq = 2 * h2a + (g >> 1), ah = 4 * (g & 1) + bq;
            const bf16_t* ap = p.iq() + (size_t)(row0 + aq) * 256 + ah * 32 + 8 * hh;
            const bf16x8 a0 = *(const bf16x8*)ap, a1 = *(const bf16x8*)(ap + 16);
            const f32x4 w00 = *(const f32x4*)(p.iw() + (size_t)(row0 + 2 * hh) * 8), w01 = *(const f32x4*)(p.iw() + (size_t)(row0 + 2 * hh) * 8 + 4);
            const f32x4 w10 = *(const f32x4*)(p.iw() + (size_t)(row0 + 2 * hh + 1) * 8), w11 = *(const f32x4*)(p.iw() + (size_t)(row0 + 2 * hh + 1) * 8 + 4);
            const int ntiles = (t0 + 4 + 31) >> 5;
            const int tq0 = t0 + 2 * hh;
            float mx0 = -INFINITY, mn0 = INFINITY, mx1 = -INFINITY, mn1 = INFINITY;
            const bf16_t* kbase = p.ik() + (size_t)brow * 32 + 8 * hh;
            for (int tile0 = wid; tile0 < ntiles; tile0 += 128) {
                bf16x8 b0[16], b1[16];
#pragma unroll
                for (int j = 0; j < 16; ++j) {
                    const int tile = min(tile0 + 8 * j, ntiles - 1);
                    const bf16_t* kp = kbase + (size_t)(tile * 32 + c32) * 32;
                    b0[j] = *(const bf16x8*)kp; b1[j] = *(const bf16x8*)(kp + 16);
                }
                __builtin_amdgcn_sched_barrier(0);
#pragma unroll
                for (int j = 0; j < 16; ++j) {
                    const int tile = tile0 + 8 * j;
                    if (tile < ntiles) {
                        const int key = tile * 32 + c32;
                        f32x16 acc;
#pragma unroll
                        for (int i = 0; i < 16; ++i) acc[i] = 0.f;
                        acc = __builtin_amdgcn_mfma_f32_32x32x16_bf16(a0, b0[j], acc, 0, 0, 0);
                        acc = __builtin_amdgcn_mfma_f32_32x32x16_bf16(a1, b1[j], acc, 0, 0, 0);
                        float s0 = 0.f, s1 = 0.f;
#pragma unroll
                        for (int i = 0; i < 4; ++i) {
                            s0 += w00[i] * fmaxf(acc[i], 0.f) + w01[i] * fmaxf(acc[4 + i], 0.f);
                            s1 += w10[i] * fmaxf(acc[8 + i], 0.f) + w11[i] * fmaxf(acc[12 + i], 0.f);
                        }
                        sc[(2 * hh) * NKMAX + key] = s0; sc[(2 * hh + 1) * NKMAX + key] = s1;
                        if (key <= tq0) { mx0 = fmaxf(mx0, s0); mn0 = fminf(mn0, s0); }
                        if (key <= tq0 + 1) { mx1 = fmaxf(mx1, s1); mn1 = fminf(mn1, s1); }
                    }
                }
            }
#pragma unroll
            for (int o = 16; o >= 1; o >>= 1) {
                mx0 = fmaxf(mx0, __shfl_xor(mx0, o)); mn0 = fminf(mn0, __shfl_xor(mn0, o));
                mx1 = fmaxf(mx1, __shfl_xor(mx1, o)); mn1 = fminf(mn1, __shfl_xor(mn1, o));
            }
            if (c32 == 0) {
                if (mx0 >= mn0) { atomicMin((unsigned*)&meta[(2 * hh) * 16 + 0], skey(mn0)); atomicMax((unsigned*)&meta[(2 * hh) * 16 + 1], skey(mx0)); }
                if (mx1 >= mn1) { atomicMin((unsigned*)&meta[(2 * hh + 1) * 16 + 0], skey(mn1)); atomicMax((unsigned*)&meta[(2 * hh + 1) * 16 + 1], skey(mx1)); }
            }
        }
        __syncthreads();
        const int q = wid & 3, part = wid >> 2, n = t0 + q + 1;
        const float lo = skey_inv((unsigned)meta[q * 16 + 0]), hi = skey_inv((unsigned)meta[q * 16 + 1]);
        const float scale = hi > lo ? (float)NBIN / (hi - lo) : 0.f;
        const float* scq = sc + q * NKMAX;
        for (int base = part * 256; base < n; base += 512) {
            const int idx0 = base + lane * 4;
            if (idx0 < n) {
                const f32x4 v = *(const f32x4*)(scq + idx0);
#pragma unroll
                for (int j = 0; j < 4; ++j) if (idx0 + j < n) atomicAdd(&h1[q * NBIN + bin1(v[j], lo, scale)], 1);
            }
        }
        __syncthreads();
        if (wid < 4) scan_top(h1 + wid * NBIN, 256, meta + wid * 16 + 4, lane);
        __syncthreads();
        const int B1 = meta[q * 16 + 4];
        for (int base = part * 256; base < n; base += 512) {
            const int idx0 = base + lane * 4;
            f32x4 v = (f32x4){0.f, 0.f, 0.f, 0.f};
            if (idx0 < n) v = *(const f32x4*)(scq + idx0);
            const unsigned long long lt = (1ull << lane) - 1ull;
#pragma unroll
            for (int j = 0; j < 4; ++j) {
                const int idx = idx0 + j;
                bool issel = false, iscand = false;
                if (idx < n) { const int b1 = bin1(v[j], lo, scale); issel = b1 > B1; iscand = b1 == B1; }
                const unsigned long long ms = __ballot(issel), mc = __ballot(iscand);
                if (ms) {
                    int bs = 0; if (lane == 0) bs = atomicAdd(&meta[q * 16 + 2], __popcll(ms));
                    bs = __shfl(bs, 0);
                    if (issel) sel[q * 256 + bs + __popcll(ms & lt)] = (unsigned short)idx;
                }
                if (mc) {
                    int bs = 0; if (lane == 0) bs = atomicAdd(&meta[q * 16 + 3], __popcll(mc));
                    bs = __shfl(bs, 0);
                    const int pos = bs + __popcll(mc & lt);
                    if (iscand && pos < 128) cand[q * 128 + pos] = (unsigned short)idx;
                }
            }
        }
        __syncthreads();
        if (wid < 4) {
            const int qq = wid; const float* scr = sc + qq * NKMAX;
            const int rq = 256 - meta[qq * 16 + 5], cq = meta[qq * 16 + 6], sbase = 256 - rq, nn = t0 + qq + 1;
            if (cq <= 128) {
                int taken = 0;
#pragma unroll
                for (int half = 0; half < 2; ++half) {
                    const int i = lane + 64 * half;
                    bool take = false; int myidx = 0;
                    if (i < cq) {
                        myidx = cand[qq * 128 + i]; const float mv = scr[myidx];
                        int rank = 0;
                        for (int j = 0; j < cq; ++j) { const int oj = cand[qq * 128 + j]; const float ov = scr[oj]; rank += (ov > mv) || (ov == mv && oj < myidx); }
                        take = rank < rq;
                    }
                    const unsigned long long mt = __ballot(take);
                    if (take) sel[qq * 256 + sbase + taken + __popcll(mt & ((1ull << lane) - 1ull))] = (unsigned short)myidx;
                    taken += __popcll(mt);
                }
            } else {
                const float lo_ = skey_inv((unsigned)meta[qq * 16 + 0]), hi_ = skey_inv((unsigned)meta[qq * 16 + 1]);
                const float sc_ = hi_ > lo_ ? (float)NBIN / (hi_ - lo_) : 0.f;
                const int B1_ = meta[qq * 16 + 4];
                int taken = 0;
                for (int base = 0; base < nn && taken < rq; base += 64) {
                    const int idx = base + lane; bool isc = false;
                    if (idx < nn) isc = bin1(scr[idx], lo_, sc_) == B1_;
                    const unsigned long long mc = __ballot(isc);
                    const int pos = taken + __popcll(mc & ((1ull << lane) - 1ull));
                    if (isc && pos < rq) sel[qq * 256 + sbase + pos] = (unsigned short)idx;
                    taken += __popcll(mc);
                }
            }
        }
        __syncthreads();
    }
    {
        const int q = wid >> 1, kvh = wid & 1, tq = t0 + q, nsel = min(tq + 1, 256);
        const int col = lane & 15, g4 = lane >> 4;
        const unsigned short* selq = sel + q * 256;
        bf16x8 qf0, qf1;
        {
            const bf16_t* qp = p.q() + (size_t)(row0 + q) * 512 + (kvh * 4 + (col & 3)) * 64 + g4 * 8;
            qf0 = *(const bf16x8*)qp; qf1 = *(const bf16x8*)(qp + 32);
            if (col >= 4) {
#pragma unroll
                for (int i = 0; i < 8; ++i) { qf0[i] = 0; qf1[i] = 0; }
            }
        }
        LAS unsigned char* vst = (LAS unsigned char*)lds + A_SC + wid * 16384;
        const bf16_t* vb = p.v() + (size_t)brow * 128 + kvh * 64 + (lane & 7) * 8;
        const unsigned rdbase = (unsigned)(uintptr_t)((LAS unsigned char*)lds + A_SC) + wid * 16384 + (4 * g4 + (col >> 2)) * 128 + (col & 3) * 8;
#define V_STAGE(s_, buf_) do { _Pragma("unroll") for (int i_ = 0; i_ < 4; ++i_) { \
            const int ksl_ = (s_) * 32 + i_ * 8 + (lane >> 3); const int key_ = selq[ksl_]; \
            __builtin_amdgcn_global_load_lds((const unsigned*)(vb + (size_t)key_ * 128), (LAS unsigned*)(vst + (buf_) * 4096 + i_ * 1024), 16, 0, 0); } } while (0)
        const bf16_t* kb = p.k() + (size_t)brow * 128 + kvh * 64 + g4 * 8;
        f32x4 lg[16];
        u32x4 vr[16];
        {
            bf16x8 k0[16], k1[16];
#pragma unroll
            for (int t = 0; t < 16; ++t) {
                const int key = selq[t * 16 + col];
                const bf16_t* kp = kb + (size_t)key * 128;
                k0[t] = *(const bf16x8*)kp; k1[t] = *(const bf16x8*)(kp + 32);
            }
#pragma unroll
            for (int s = 4; s < 8; ++s)
#pragma unroll
                for (int i = 0; i < 4; ++i) { const int key = selq[s * 32 + i * 8 + (lane >> 3)]; vr[(s - 4) * 4 + i] = *(const u32x4*)(vb + (size_t)key * 128); }
            V_STAGE(0, 0); V_STAGE(1, 1); V_STAGE(2, 2); V_STAGE(3, 3);
            __builtin_amdgcn_sched_barrier(0);
#pragma unroll
            for (int t = 0; t < 16; ++t) {
                f32x4 a = (f32x4){0.f, 0.f, 0.f, 0.f};
                a = __builtin_amdgcn_mfma_f32_16x16x32_bf16(k0[t], qf0, a, 0, 0, 0);
                a = __builtin_amdgcn_mfma_f32_16x16x32_bf16(k1[t], qf1, a, 0, 0, 0);
                lg[t] = a;
            }
            __builtin_amdgcn_sched_barrier(0);
        }
        float mx = -INFINITY;
#pragma unroll
        for (int t = 0; t < 16; ++t)
#pragma unroll
            for (int j = 0; j < 4; ++j) { if (t * 16 + g4 * 4 + j >= nsel) lg[t][j] = -INFINITY; mx = fmaxf(mx, lg[t][j]); }
        mx = fmaxf(mx, __shfl_xor(mx, 16)); mx = fmaxf(mx, __shfl_xor(mx, 32));
        float sm = 0.f;
#pragma unroll
        for (int t = 0; t < 16; ++t)
#pragma unroll
            for (int j = 0; j < 4; ++j) { const float e = __builtin_amdgcn_exp2f(lg[t][j] - mx); lg[t][j] = e; sm += e; }
        sm += __shfl_xor(sm, 16); sm += __shfl_xor(sm, 32);
        const float inv = 1.0f / sm;
        f32x4 o[4];
#pragma unroll
        for (int d = 0; d < 4; ++d) o[d] = (f32x4){0.f, 0.f, 0.f, 0.f};
        asm volatile("s_waitcnt vmcnt(0)" ::: "memory");
#pragma unroll
        for (int s = 0; s < 8; ++s) {
            if (s >= 4) {
#pragma unroll
                for (int i = 0; i < 4; ++i) *(LAS u32x4*)(vst + (s & 3) * 4096 + i * 1024 + lane * 16) = vr[(s - 4) * 4 + i];
                asm volatile("s_waitcnt lgkmcnt(0)" ::: "memory");
            }
            const unsigned rb = rdbase + (s & 3) * 4096;
            const s16x4 l0 = tr_read<0>(rb), h0 = tr_read<2048>(rb), l1 = tr_read<32>(rb), h1_ = tr_read<2048 + 32>(rb);
            const s16x4 l2 = tr_read<64>(rb), h2_ = tr_read<2048 + 64>(rb), l3 = tr_read<96>(rb), h3 = tr_read<2048 + 96>(rb);
            asm volatile("s_waitcnt lgkmcnt(0)" ::: "memory");
            __builtin_amdgcn_sched_barrier(0);
            bf16x8 pa;
            {
                const uint32_t w0 = pack2(lg[2 * s][0], lg[2 * s][1]), w1 = pack2(lg[2 * s][2], lg[2 * s][3]);
                const uint32_t w2 = pack2(lg[2 * s + 1][0], lg[2 * s + 1][1]), w3 = pack2(lg[2 * s + 1][2], lg[2 * s + 1][3]);
                pa[0] = (short)(w0 & 0xffff); pa[1] = (short)(w0 >> 16); pa[2] = (short)(w1 & 0xffff); pa[3] = (short)(w1 >> 16);
                pa[4] = (short)(w2 & 0xffff); pa[5] = (short)(w2 >> 16); pa[6] = (short)(w3 & 0xffff); pa[7] = (short)(w3 >> 16);
            }
#define PKV(L, H) (bf16x8){L[0], L[1], L[2], L[3], H[0], H[1], H[2], H[3]}
            o[0] = __builtin_amdgcn_mfma_f32_16x16x32_bf16(pa, PKV(l0, h0), o[0], 0, 0, 0);
            o[1] = __builtin_amdgcn_mfma_f32_16x16x32_bf16(pa, PKV(l1, h1_), o[1], 0, 0, 0);
            o[2] = __builtin_amdgcn_mfma_f32_16x16x32_bf16(pa, PKV(l2, h2_), o[2], 0, 0, 0);
            o[3] = __builtin_amdgcn_mfma_f32_16x16x32_bf16(pa, PKV(l3, h3), o[3], 0, 0, 0);
#undef PKV
        }
#undef V_STAGE
        const float i0 = __shfl(inv, 0), i1 = __shfl(inv, 1), i2 = __shfl(inv, 2), i3 = __shfl(inv, 3);
        if (g4 == 0) {
            bf16_t* op = p.att() + (size_t)(row0 + q) * 512 + kvh * 256 + col;
#pragma unroll
            for (int d = 0; d < 4; ++d) {
                op[0 * 64 + d * 16] = f2bf(o[d][0] * i0); op[1 * 64 + d * 16] = f2bf(o[d][1] * i1);
                op[2 * 64 + d * 16] = f2bf(o[d][2] * i2); op[3 * 64 + d * 16] = f2bf(o[d][3] * i3);
            }
        }
    }
    __syncthreads();
}

constexpr int NBW = 512;
constexpr int W_SC = 0, W_H = W_SC + NKMAX * 2, W_SEL = W_H + NBW * 4, W_CAND = W_SEL + 512, W_SZ = W_CAND + 256;
static_assert(8 * W_SZ <= LDS_BYTES - 32, "wave attention LDS");
__device__ __forceinline__ int binw(float s, float lo, float scale) { return min(NBW - 1, max(0, (int)((s - lo) * scale))); }

__device__ __forceinline__ void attn_wave(const P& p, unsigned char* lds, int wid, int lane, int b, int t) {
    unsigned char* wl = lds + wid * W_SZ;
    _Float16* sc = (_Float16*)(wl + W_SC);
    int* hist = (int*)(wl + W_H);
    unsigned short* sel = (unsigned short*)(wl + W_SEL);
    unsigned short* cand = (unsigned short*)(wl + W_CAND);
    const int brow = b * LP, row = brow + t, n = t + 1;
    const int col = lane & 15, g4 = lane >> 4;
    const unsigned long long lt = (1ull << lane) - 1ull;
    int nsel = 256;
    if (n > 256) {
        float mn, mx;
        {
            typedef _Float16 h2 __attribute__((ext_vector_type(2)));
            h2 hmx = {(_Float16)-65504.f, (_Float16)-65504.f}, hmn = {(_Float16)65504.f, (_Float16)65504.f};
            const int nfull = n & ~1023;
            for (int base = 0; base < nfull; base += 1024) {
                const uint2 r0 = *(const uint2*)(sc + base + lane * 4), r1 = *(const uint2*)(sc + base + lane * 4 + 256);
                const uint2 r2 = *(const uint2*)(sc + base + lane * 4 + 512), r3 = *(const uint2*)(sc + base + lane * 4 + 768);
                const h2 a0 = __builtin_bit_cast(h2, r0.x), a1 = __builtin_bit_cast(h2, r0.y), a2 = __builtin_bit_cast(h2, r1.x), a3 = __builtin_bit_cast(h2, r1.y);
                const h2 a4 = __builtin_bit_cast(h2, r2.x), a5 = __builtin_bit_cast(h2, r2.y), a6 = __builtin_bit_cast(h2, r3.x), a7 = __builtin_bit_cast(h2, r3.y);
                hmx = __builtin_elementwise_max(hmx, __builtin_elementwise_max(__builtin_elementwise_max(__builtin_elementwise_max(a0, a1), __builtin_elementwise_max(a2, a3)),
                                                                              __builtin_elementwise_max(__builtin_elementwise_max(a4, a5), __builtin_elementwise_max(a6, a7))));
                hmn = __builtin_elementwise_min(hmn, __builtin_elementwise_min(__builtin_elementwise_min(__builtin_elementwise_min(a0, a1), __builtin_elementwise_min(a2, a3)),
                                                                              __builtin_elementwise_min(__builtin_elementwise_min(a4, a5), __builtin_elementwise_min(a6, a7))));
            }
            for (int base = nfull; base < n; base += 256) {
                const int ia = base + lane * 4;
                if (ia + 3 < n) {
                    const uint2 ra = *(const uint2*)(sc + ia);
                    const h2 x0 = __builtin_bit_cast(h2, ra.x), x1 = __builtin_bit_cast(h2, ra.y);
                    hmx = __builtin_elementwise_max(hmx, __builtin_elementwise_max(x0, x1)); hmn = __builtin_elementwise_min(hmn, __builtin_elementwise_min(x0, x1));
                } else {
                    for (int j = 0; j < 3; ++j) if (ia + j < n) { const _Float16 x = sc[ia + j]; hmx[0] = x > hmx[0] ? x : hmx[0]; hmn[0] = x < hmn[0] ? x : hmn[0]; }
                }
            }
            float a = fmaxf((float)hmx[0], (float)hmx[1]), c = fminf((float)hmn[0], (float)hmn[1]);
            a = xmax32(xmax16(a)); c = fminf(c, lane_xor_f<32>(c)); c = xmin16(c);
            a = fmaxf(a, lane_xor_f<8>(a)); c = fminf(c, lane_xor_f<8>(c)); a = fmaxf(a, lane_xor_f<4>(a)); c = fminf(c, lane_xor_f<4>(c));
            a = fmaxf(a, lane_xor_f<2>(a)); c = fminf(c, lane_xor_f<2>(c)); a = fmaxf(a, lane_xor_f<1>(a)); c = fminf(c, lane_xor_f<1>(c));
            mx = a; mn = c;
        }
        const float scale = mx > mn ? (float)NBW / (mx - mn) : 0.f, nls = -mn * scale;
#define BINF(x) min(NBW - 1, max(0, (int)__builtin_fmaf((x), scale, nls)))
#define H2F(u16) ((float)__builtin_bit_cast(_Float16, (unsigned short)(u16)))
        {
            uint2 ra = *(const uint2*)(sc + lane * 4), rb2 = *(const uint2*)(sc + lane * 4 + 256);
            for (int base = 0; base < n; base += 512) {
                const int ia = base + lane * 4, ib = ia + 256;
                const unsigned wa[4] = {ra.x & 0xffffu, ra.x >> 16, ra.y & 0xffffu, ra.y >> 16}, wb[4] = {rb2.x & 0xffffu, rb2.x >> 16, rb2.y & 0xffffu, rb2.y >> 16};
                ra = *(const uint2*)(sc + ia + 512); rb2 = *(const uint2*)(sc + ib + 512);
#pragma unroll
                for (int j = 0; j < 4; ++j) {
                    atomicAdd(&hist[BINF(H2F(wa[j]))], ia + j < n ? 1 : 0);
                    atomicAdd(&hist[BINF(H2F(wb[j]))], ib + j < n ? 1 : 0);
                }
            }
        }
        int B1, above1, cnt1;
        {
            int c[8];
            const int4 v0 = *(const int4*)(hist + 8 * lane), v1 = *(const int4*)(hist + 8 * lane + 4);
            c[0] = v0.x; c[1] = v0.y; c[2] = v0.z; c[3] = v0.w; c[4] = v1.x; c[5] = v1.y; c[6] = v1.z; c[7] = v1.w;
            int tot = 0;
#pragma unroll
            for (int i = 0; i < 8; ++i) tot += c[i];
            const int pre = wave_incl_scan(tot);
            int above = __builtin_amdgcn_readlane(pre, 63) - pre;
            const bool mine = above < 256 && 256 <= above + tot;
            int bb = 0, ab = 0, cb = 0;
#pragma unroll
            for (int i = 7; i >= 0; --i) { if (above < 256 && 256 <= above + c[i]) { bb = 8 * lane + i; ab = above; cb = c[i]; } above += c[i]; }
            const int src = (int)__builtin_ctzll(__ballot(mine));
            B1 = __builtin_amdgcn_readlane(bb, src); above1 = __builtin_amdgcn_readlane(ab, src); cnt1 = __builtin_amdgcn_readlane(cb, src);
        }
        int selcnt = 0, candcnt = 0;
        const float hi_m = B1 < NBW - 1 ? __uint_as_float(__float_as_uint((float)(B1 + 1)) - 1u) : INFINITY;
        const float lo_m = B1 > 0 ? __uint_as_float(__float_as_uint((float)B1) - 1u) : -INFINITY;
        uint2 ra = *(const uint2*)(sc + lane * 4), rb2 = *(const uint2*)(sc + lane * 4 + 256);
        for (int base = 0; base < n; base += 512) {
            const int ia = base + lane * 4, ib = ia + 256;
            const unsigned wv[8] = {ra.x & 0xffffu, ra.x >> 16, ra.y & 0xffffu, ra.y >> 16, rb2.x & 0xffffu, rb2.x >> 16, rb2.y & 0xffffu, rb2.y >> 16};
            ra = *(const uint2*)(sc + ia + 512); rb2 = *(const uint2*)(sc + ib + 512);
            const int nva = min(max(n - ia, 0), 4), nvb = min(max(n - ib, 0), 4);
            const unsigned vm = ((1u << nva) - 1u) | (((1u << nvb) - 1u) << 4);
            unsigned sm = 0u, gm = 0u;
#pragma unroll
            for (int j = 7; j >= 0; --j) {
                const float y = __builtin_fmaf(H2F(wv[j]), scale, nls);
                sm = __builtin_amdgcn_alignbit(sm, __float_as_uint(hi_m - y), 31);
                gm = __builtin_amdgcn_alignbit(gm, __float_as_uint(lo_m - y), 31);
            }
            const unsigned smask = sm & vm, cmask = gm & ~sm & vm;
            const int cnt = __popc(smask);
            const int inc = wave_incl_scan(cnt);
            int pos = selcnt + inc - cnt;
#pragma unroll
            for (int j = 0; j < 8; ++j) {
                const unsigned sj = (smask >> j) & 1u;
                unsigned short* dst = sj ? sel + pos : (unsigned short*)hist + lane;
                *dst = (unsigned short)((j < 4 ? ia : ib) + (j & 3)); pos += (int)sj;
            }
            selcnt += __builtin_amdgcn_readlane(inc, 63);
            if (__ballot(cmask != 0u)) {
#pragma unroll
                for (int j = 0; j < 8; ++j) {
                    const bool isc = (cmask >> j) & 1u;
                    const unsigned long long mc = __ballot(isc);
                    const int cp = candcnt + __popcll(mc & lt);
                    if (isc && cp < 128) cand[cp] = (unsigned short)((j < 4 ? ia : ib) + (j & 3));
                    candcnt += __popcll(mc);
                }
            }
        }
        {
            const int rq = 256 - above1, cq = cnt1, sbase = 256 - rq;
            if (cq <= 128) {
                const int i0 = lane, i1 = lane + 64;
                int ci0 = 0, ci1 = 0; float cv0 = -INFINITY, cv1 = -INFINITY;
                if (i0 < cq) { ci0 = cand[i0]; cv0 = (float)sc[ci0]; }
                if (i1 < cq) { ci1 = cand[i1]; cv1 = (float)sc[ci1]; }
                int rank0 = 0, rank1 = 0;
                const int c64 = cq < 64 ? cq : 64;
                for (int j = 0; j < c64; ++j) {
                    const int oj = __builtin_amdgcn_readlane(ci0, j); const float ov = readlane_f(cv0, j);
                    rank0 += (ov > cv0) || (ov == cv0 && oj < ci0); rank1 += (ov > cv1) || (ov == cv1 && oj < ci1);
                }
                for (int j = 64; j < cq; ++j) {
                    const int oj = __builtin_amdgcn_readlane(ci1, j - 64); const float ov = readlane_f(cv1, j - 64);
                    rank0 += (ov > cv0) || (ov == cv0 && oj < ci0); rank1 += (ov > cv1) || (ov == cv1 && oj < ci1);
                }
                int taken = 0;
                {
                    const bool take = i0 < cq && rank0 < rq;
                    const unsigned long long mt = __ballot(take);
                    if (take) sel[sbase + taken + __popcll(mt & lt)] = (unsigned short)ci0;
                    taken += __popcll(mt);
                }
                {
                    const bool take = i1 < cq && rank1 < rq;
                    const unsigned long long mt = __ballot(take);
                    if (take) sel[sbase + taken + __popcll(mt & lt)] = (unsigned short)ci1;
                    taken += __popcll(mt);
                }
            } else {
                int taken = 0;
                for (int base = 0; base < n && taken < rq; base += 64) {
                    const int idx = base + lane; bool isc = false;
                    if (idx < n) isc = BINF((float)sc[idx]) == B1;
                    const unsigned long long mc = __ballot(isc);
                    const int pos = taken + __popcll(mc & lt);
                    if (isc && pos < rq) sel[sbase + pos] = (unsigned short)idx;
                    taken += __popcll(mc);
                }
            }
        }
#undef BINF
#undef H2F
    } else {
        nsel = n;
#pragma unroll
        for (int i = 0; i < 4; ++i) { const int j = lane + 64 * i; sel[j] = (unsigned short)(j < n ? j : 0); }
    }
    LAS unsigned char* vst = (LAS unsigned char*)wl + W_SC;
    {
        long qf[4];
        {
            const unsigned char* qp = p.q8() + (size_t)row * 512 + (col & 7) * 64 + g4 * 8;
            const long q0 = *(const long*)qp, q1 = *(const long*)(qp + 32);
            const bool lo_grp = col < 4, hi_grp = col >= 4 && col < 8;
            qf[0] = lo_grp ? q0 : 0l; qf[1] = lo_grp ? q1 : 0l; qf[2] = hi_grp ? q0 : 0l; qf[3] = hi_grp ? q1 : 0l;
        }
#define A_WAITV(n_) do { if ((n_) >= 14) asm volatile("s_waitcnt vmcnt(14)" ::: "memory"); else if ((n_) == 12) asm volatile("s_waitcnt vmcnt(12)" ::: "memory"); \
            else if ((n_) == 10) asm volatile("s_waitcnt vmcnt(10)" ::: "memory"); else if ((n_) == 8) asm volatile("s_waitcnt vmcnt(8)" ::: "memory"); \
            else if ((n_) == 6) asm volatile("s_waitcnt vmcnt(6)" ::: "memory"); else if ((n_) == 4) asm volatile("s_waitcnt vmcnt(4)" ::: "memory"); \
            else if ((n_) == 2) asm volatile("s_waitcnt vmcnt(2)" ::: "memory"); else asm volatile("s_waitcnt vmcnt(0)" ::: "memory"); } while (0)
        const unsigned char* kg = p.k8() + (size_t)brow * 128;
#define K_STAGE(s_) do { _Pragma("unroll") for (int i_ = 0; i_ < 2; ++i_) { \
            const int kl_ = i_ * 8 + (lane >> 3); const int key_ = sel[(s_) * 16 + kl_]; \
            __builtin_amdgcn_global_load_lds((const unsigned*)(kg + (size_t)key_ * 128 + (((lane & 7) ^ (kl_ >> 1)) & 7) * 16), (LAS unsigned*)(vst + ((s_) & 7) * 2048 + i_ * 1024), 16, 0, 0); } } while (0)
        f32x4 lg[16];
        K_STAGE(0); K_STAGE(1); K_STAGE(2); K_STAGE(3); K_STAGE(4); K_STAGE(5); K_STAGE(6);
#pragma unroll
        for (int s = 0; s < 16; ++s) {
            if (s + 7 < 16) K_STAGE(s + 7);
            A_WAITV(2 * (15 - s < 7 ? 15 - s : 7));
            long kf[4];
#pragma unroll
            for (int ks = 0; ks < 4; ++ks) kf[ks] = *(const LAS long*)(vst + (s & 7) * 2048 + col * 128 + (((ks * 2 + (g4 >> 1)) ^ (col >> 1)) & 7) * 16 + (g4 & 1) * 8);
            asm volatile("s_waitcnt lgkmcnt(0)" ::: "memory");
            __builtin_amdgcn_sched_barrier(0);
            f32x4 a = (f32x4){0.f, 0.f, 0.f, 0.f};
#pragma unroll
            for (int ks = 0; ks < 4; ++ks) a = __builtin_amdgcn_mfma_f32_16x16x32_fp8_fp8(kf[ks], qf[ks], a, 0, 0, 0);
            lg[s] = a;
        }
#undef K_STAGE
        const unsigned char* vg = p.v8() + (size_t)brow * 128;
#define V_STAGE(s_) do { _Pragma("unroll") for (int i_ = 0; i_ < 2; ++i_) { \
            const int kl_ = i_ * 8 + (lane >> 3); const int key_ = sel[(s_) * 16 + kl_]; \
            __builtin_amdgcn_global_load_lds((const unsigned*)(vg + (size_t)key_ * 128 + ((lane & 7) ^ (((kl_ >> 1) & 3) | (((s_) & 1) << 2))) * 16), (LAS unsigned*)(vst + ((s_) & 7) * 2048 + i_ * 1024), 16, 0, 0); } } while (0)
        V_STAGE(0); V_STAGE(1); V_STAGE(2); V_STAGE(3); V_STAGE(4); V_STAGE(5);
        float mxl = -INFINITY;
#pragma unroll
        for (int tt = 0; tt < 16; ++tt) {
#pragma unroll
            for (int j = 0; j < 4; ++j) if (tt * 16 + g4 * 4 + j >= nsel) lg[tt][j] = -INFINITY;
            mxl = __builtin_fmaxf(__builtin_fmaxf(mxl, lg[tt][0]), lg[tt][1]); mxl = __builtin_fmaxf(__builtin_fmaxf(mxl, lg[tt][2]), lg[tt][3]);
        }
        mxl = xmax32(xmax16(mxl));
        const float nmx = -0.125f * mxl;
        float sm = 0.f;
#pragma unroll
        for (int tt = 0; tt < 16; ++tt)
#pragma unroll
            for (int j = 0; j < 4; ++j) { const float e = __builtin_amdgcn_exp2f(__builtin_fmaf(lg[tt][j], 0.125f, nmx)); lg[tt][j] = e; sm += e; }
        sm = xsum32(xsum16(sm));
        const float inv = (1.0f / 256.0f) / sm;
        f32x4 o[8];
#pragma unroll
        for (int d = 0; d < 8; ++d) o[d] = (f32x4){0.f, 0.f, 0.f, 0.f};
        const int tq = col >> 1, trow = 4 * g4 + (tq & 3), tf = ((trow >> 1) & 3) | ((tq >> 2) << 2);
        const unsigned trb = (unsigned)(uintptr_t)vst + (tq >> 2) * 2048 + trow * 128 + (col & 1) * 8;
#pragma unroll
        for (int sp = 0; sp < 8; ++sp) {
            if (2 * sp + 7 < 16) { V_STAGE(2 * sp + 6); V_STAGE(2 * sp + 7); }
            A_WAITV(2 * (14 - 2 * sp < 6 ? 14 - 2 * sp : 6));
            const unsigned rb = trb + ((2 * sp) & 7) * 2048;
            long pa;
            {
                int w0 = __builtin_amdgcn_cvt_pk_fp8_f32(lg[2 * sp][0] * 256.0f, lg[2 * sp][1] * 256.0f, 0, false); w0 = __builtin_amdgcn_cvt_pk_fp8_f32(lg[2 * sp][2] * 256.0f, lg[2 * sp][3] * 256.0f, w0, true);
                int w1 = __builtin_amdgcn_cvt_pk_fp8_f32(lg[2 * sp + 1][0] * 256.0f, lg[2 * sp + 1][1] * 256.0f, 0, false); w1 = __builtin_amdgcn_cvt_pk_fp8_f32(lg[2 * sp + 1][2] * 256.0f, lg[2 * sp + 1][3] * 256.0f, w1, true);
                pa = (long)(((unsigned long long)(unsigned)w1 << 32) | (unsigned long long)(unsigned)w0);
            }
            long vf[8];
#pragma unroll
            for (int dt = 0; dt < 8; ++dt) asm volatile("ds_read_b64_tr_b8 %0, %1" : "=&v"(vf[dt]) : "v"(rb + ((dt ^ tf) * 16)) : "memory");
            asm volatile("s_waitcnt lgkmcnt(0)" ::: "memory");
            __builtin_amdgcn_sched_barrier(0);
#pragma unroll
            for (int dt = 0; dt < 8; ++dt) o[dt] = __builtin_amdgcn_mfma_f32_16x16x32_fp8_fp8(pa, vf[dt], o[dt], 0, 0, 0);
        }
#undef V_STAGE
#undef A_WAITV
        float ih[4];
#pragma unroll
        for (int jj = 0; jj < 4; ++jj) ih[jj] = (g4 & 1) ? readlane_f(inv, 4 + jj) : readlane_f(inv, jj);
        if (g4 < 2) {
            bf16_t* op = p.att() + (size_t)row * 512 + (g4 * 4) * 64 + col;
#pragma unroll
            for (int d = 0; d < 4; ++d) {
                const f32x4 oa_ = o[d], ob_ = o[4 + d]; f32x4 ov;
#pragma unroll
                for (int kk = 0; kk < 4; ++kk) ov[kk] = g4 == 0 ? oa_[kk] : ob_[kk];
                op[0 * 64 + d * 16] = f2bf(ov[0] * ih[0]); op[1 * 64 + d * 16] = f2bf(ov[1] * ih[1]);
                op[2 * 64 + d * 16] = f2bf(ov[2] * ih[2]); op[3 * 64 + d * 16] = f2bf(ov[3] * ih[3]);
            }
        }
    }
}

constexpr int A8_META = 8 * W_SZ;
static_assert(A8_META + 64 + 512 <= LDS_BYTES - 32, "attn8 meta");
__device__ __forceinline__ void attn8_unit(const P& p, unsigned char* lds, int b, int grp) {
    const int tid = tid_(), lane = tid & 63, wid = __builtin_amdgcn_readfirstlane(tid >> 6);
    const int t0 = NMETA + 8 * grp, brow = b * LP, row0 = brow + t0;
    unsigned* meta = (unsigned*)(lds + A8_META);
    const bool big = t0 + 1 > 256;
    bf16_t* uvec = (bf16_t*)(lds + A8_META + 64);
    const int hh = lane >> 5, c32 = lane & 31;
    const int g = c32 >> 3, h2a = (c32 >> 2) & 1, bq = c32 & 3, aq = 2 * h2a + (g >> 1), ah = 4 * (g & 1) + bq;
    bf16x8 a0[2], a1[2]; f32x4 w[2][2][2];
    if (big) {
#pragma unroll
        for (int r = 0; r < 2; ++r) {
            const bf16_t* ap = p.iq() + (size_t)(row0 + 4 * r + aq) * 256 + ah * 32 + 8 * hh;
            a0[r] = *(const bf16x8*)ap; a1[r] = *(const bf16x8*)(ap + 16);
#pragma unroll
            for (int qi = 0; qi < 2; ++qi) {
                const float* wp = p.iw() + (size_t)(row0 + 4 * r + 2 * hh + qi) * 8;
                w[r][qi][0] = *(const f32x4*)wp; w[r][qi][1] = *(const f32x4*)(wp + 4);
            }
        }
    }
    const int ntiles = (t0 + 8 + 31) >> 5;
    const bf16_t* kbase = p.ik() + (size_t)brow * 32 + 8 * hh;
    bf16x8 b0[4], b1[4], c0[4], c1[4];
#define S_LOAD(B0, B1, T0) do { _Pragma("unroll") for (int j = 0; j < 4; ++j) { const int tile_ = min((T0) + 8 * j, ntiles - 1); \
            const bf16_t* kp_ = kbase + (size_t)(tile_ * 32 + c32) * 32; B0[j] = *(const bf16x8*)kp_; B1[j] = *(const bf16x8*)(kp_ + 16); } } while (0)
    if (big) S_LOAD(b0, b1, wid);
    if (big && tid < 256) {
        const int q = tid >> 5, d = tid & 31;
        const bf16_t* ip = p.iq() + (size_t)(row0 + q) * 256 + d; const float* wp = p.iw() + (size_t)(row0 + q) * 8;
        float u = 0.f;
#pragma unroll
        for (int h = 0; h < 8; ++h) u += wp[h] * bf2f(ip[h * 32]);
        uvec[q * 32 + d] = f2bf(u);
    }
    for (int i = tid; i < 8 * NBW; i += NTHREADS) ((int*)(lds + (i / NBW) * W_SZ + W_H))[i % NBW] = 0;
    __syncthreads();
    if (big) {
        bf16x8 au0, au1;
        {
            const int uq = 4 * ((c32 & 3) >> 1) + 2 * ((c32 >> 2) & 1) + (c32 & 1);
            const bf16x8 v0 = *(const bf16x8*)(uvec + uq * 32 + 8 * hh), v1 = *(const bf16x8*)(uvec + uq * 32 + 8 * hh + 16);
#pragma unroll
            for (int i = 0; i < 8; ++i) { au0[i] = c32 < 8 ? v0[i] : (short)0; au1[i] = c32 < 8 ? v1[i] : (short)0; }
        }
#define S_COMP(B0, B1, T0) do { _Pragma("unroll") for (int j = 0; j < 4; ++j) { const int tile = min((T0) + 8 * j, ntiles - 1); { const int key = tile * 32 + c32;   \
            f32x16 acu; _Pragma("unroll") for (int i = 0; i < 16; ++i) acu[i] = 0.f; \
            acu = __builtin_amdgcn_mfma_f32_32x32x16_bf16(au0, B0[j], acu, 0, 0, 0); acu = __builtin_amdgcn_mfma_f32_32x32x16_bf16(au1, B1[j], acu, 0, 0, 0); \
            _Pragma("unroll") for (int r = 0; r < 2; ++r) { f32x16 acc; _Pragma("unroll") for (int i = 0; i < 16; ++i) acc[i] = 0.f; \
                acc = __builtin_amdgcn_mfma_f32_32x32x16_bf16(a0[r], B0[j], acc, 0, 0, 0); acc = __builtin_amdgcn_mfma_f32_32x32x16_bf16(a1[r], B1[j], acc, 0, 0, 0); \
                _Pragma("unroll") for (int qi = 0; qi < 2; ++qi) { float s = acu[2 * r + qi], s1_ = 0.f; \
                    _Pragma("unroll") for (int i = 0; i < 4; ++i) { s = __builtin_fmaf(w[r][qi][0][i], __builtin_fabsf(acc[8 * qi + i]), s); s1_ = __builtin_fmaf(w[r][qi][1][i], __builtin_fabsf(acc[8 * qi + 4 + i]), s1_); } \
                    s += s1_; const int q = 4 * r + 2 * hh + qi; const _Float16 hs = (_Float16)fminf(fmaxf(s, -60000.f), 60000.f); \
                    ((_Float16*)(lds + q * W_SZ + W_SC))[key] = hs; } } } } } while (0)
        for (int tile0 = wid; tile0 < ntiles; tile0 += 64) {
            if (tile0 + 32 < ntiles) S_LOAD(c0, c1, tile0 + 32);
            __builtin_amdgcn_sched_barrier(0);
            S_COMP(b0, b1, tile0);
            __builtin_amdgcn_sched_barrier(0);
            if (tile0 + 64 < ntiles) S_LOAD(b0, b1, tile0 + 64);
            __builtin_amdgcn_sched_barrier(0);
            if (tile0 + 32 < ntiles) S_COMP(c0, c1, tile0 + 32);
            __builtin_amdgcn_sched_barrier(0);
        }
#undef S_LOAD
#undef S_COMP
    }
    __syncthreads();
    attn_wave(p, lds, wid, lane, b, t0 + wid);
    __syncthreads();
}

constexpr int NGRP8 = SEQ / 8, ATT_P1 = NGRP8 / 8, ATT_P2 = NGRP8 / 2;
template <int SUB>
__device__ __forceinline__ void ph_mixer(const P& p, unsigned char* lds) {
    int* bc = (int*)(lds + LDS_BYTES - 16);
    constexpr int nh = SUB == 1 ? 64 : (SUB == 0 ? NXU : 0);
    constexpr int a0 = SUB == 0 ? 0 : (SUB == 1 ? ATT_P1 : ATT_P2), a1 = SUB == 0 ? ATT_P1 : (SUB == 1 ? ATT_P2 : NGRP8);
    const bool t0 = tid_() == 0;
    int nx = 0;
    if (t0) nx = atomicAdd(&p.ctr()[97 + SUB], 1);
    for (;;) {
        __syncthreads();
        if (t0) bc[0] = nx;
        __syncthreads();
        const int it = bc[0];
        if (it >= nh) break;
        if (t0) nx = atomicAdd(&p.ctr()[97 + SUB], 1);
        if (SUB == 0) hgx_unit(p, lds, it);
        else if (SUB == 1) hgchain_unit(p, it);
    }
    if (SUB == 2) {
        const int G = gridDim.x;
        int u = blockIdx.x;
        if (u < NXU) {
            ZPre cur, nxt;
            hgz_prefetch(p, u, cur);
            for (;;) {
                const int un = u + G;
                if (un < NXU) hgz_prefetch(p, un, nxt);
                hgz_unit(p, lds, u, cur);
                if (un >= NXU) break;
                cur = nxt; u = un;
            }
        }
    }
    const int b0 = (int)(xb_xcc_id() & 3u);
#pragma unroll 1
    for (int k = 0; k < 4; ++k) {
        const int b = (b0 + k) & 3;
        int* ctr = &p.ctr()[104 + SUB * 4 + b];
        if (t0) nx = atomicAdd(ctr, 1);
        for (;;) {
            __syncthreads();
            if (t0) bc[0] = nx;
            __syncthreads();
            const int it = bc[0];
            if (it >= a1 - a0) break;
            if (t0) nx = atomicAdd(ctr, 1);
            attn8_unit(p, lds, b, NGRP8 - 1 - (a0 + it));
        }
    }
}
__device__ __forceinline__ int tok_row(int tok) { return (tok >> 13) * LP + NMETA + (tok & 8191); }
__device__ __forceinline__ void ph_mix(const P& p, unsigned char* lds) {
    const int njobs = (NTOK / 256) * 4 * 2, G = gridDim.x, b0 = blockIdx.x;
    auto jobidx = [&](int i) __attribute__((always_inline)) { return (b0 + (i >> 1) * G) * 2 + (i & 1); };
    auto jobfn = [&](int i, GJob& j) __attribute__((always_inline)) -> bool {
        const int jb = jobidx(i); if (jb >= njobs) return false;
        const int which = jb & 1, u = jb >> 1, nt = u & 3, mt = u >> 2; const size_t r0 = (size_t)tok_row(mt * 256);
        j.A = (const char*)((which ? p.hgr() : p.att()) + r0 * 512); j.B = (const char*)((which ? p.wuhT() : p.wuaT()) + (size_t)nt * 256 * 512); return true; };
    auto epi = [&](f32x4 (&acc)[2][2][4][2], int i) __attribute__((always_inline)) {
        const int jb = jobidx(i), which = jb & 1, u = jb >> 1, nt = u & 3, mt = u >> 2; const size_t r0 = (size_t)tok_row(mt * 256);
        const int tid_e = tid_(), lane_e = tid_e & 63, wid_e = tid_e >> 6, wr = wid_e >> 2, wc = wid_e & 3, fr = lane_e & 15, fq = lane_e >> 4;
        const unsigned char* gsrc = which ? p.gh() : p.ga();
#pragma unroll
        for (int ai = 0; ai < 2; ++ai) {
            uint32_t g[4][2][2]; uint2 a[4][2][2];
#pragma unroll
            for (int m = 0; m < 4; ++m)
#pragma unroll
                for (int bj = 0; bj < 2; ++bj)
#pragma unroll
                    for (int n = 0; n < 2; ++n) {
                        const int row = ai * 128 + wr * 64 + m * 16 + fr, col = bj * 128 + wc * 32 + n * 16 + fq * 4;
                        g[m][bj][n] = *(const uint32_t*)(gsrc + (r0 + row) * 1024 + nt * 256 + col);
                        if (which) a[m][bj][n] = *(const uint2*)(p.mix() + (size_t)(mt * 256 + row) * 1024 + nt * 256 + col);
                    }
#pragma unroll
            for (int m = 0; m < 4; ++m)
#pragma unroll
                for (int bj = 0; bj < 2; ++bj) {
                    const int row = ai * 128 + wr * 64 + m * 16 + fr;
                    f32x4 rr[2];
#pragma unroll
                    for (int n = 0; n < 2; ++n) {
                        const f32x4 v = acc[ai][bj][m][n] * (1.0f / 255.0f); const uint32_t gg = g[m][bj][n];
                        rr[n][0] = v[0] * (float)(gg & 0xffu); rr[n][1] = v[1] * (float)((gg >> 8) & 0xffu);
                        rr[n][2] = v[2] * (float)((gg >> 16) & 0xffu); rr[n][3] = v[3] * (float)(gg >> 24);
                        if (which) {
                            const uint2 aa = a[m][bj][n];
                            rr[n][0] += __uint_as_float(aa.x << 16); rr[n][1] += __uint_as_float(aa.x & 0xffff0000u);
                            rr[n][2] += __uint_as_float(aa.y << 16); rr[n][3] += __uint_as_float(aa.y & 0xffff0000u);
                        }
                    }
                    st_bf4_pair(p.mix() + (size_t)(mt * 256 + row) * 1024 + nt * 256 + bj * 128 + wc * 32, fq, rr[0], rr[1]);
                }
        }
    };
    unsigned vbU[2]; gj_lin2(vbU, 512);
    gemm_stream<false>(lds, 512, 512, (size_t)128 * 512 * 2, vbU, jobfn, epi);
}

__device__ __forceinline__ void ph_out(const P& p, unsigned char* lds) {
    const int nunits = (NTOK / 256) * 4, G = gridDim.x, b0 = blockIdx.x;
    auto jobfn = [&](int i, GJob& j) __attribute__((always_inline)) -> bool {
        const int u = b0 + i * G; if (u >= nunits) return false;
        const int nt = u & 3, mt = u >> 2;
        j.A = (const char*)(p.mix() + (size_t)mt * 256 * D); j.B = (const char*)(p.woT() + (size_t)nt * 256 * D); return true; };
    auto epi = [&](f32x4 (&acc)[2][2][4][2], int i) __attribute__((always_inline)) {
        const int u = b0 + i * G, nt = u & 3, mt = u >> 2;
        const int tid_e = tid_(), lane_e = tid_e & 63, wid_e = tid_e >> 6, wr = wid_e >> 2, wc = wid_e & 3, fr = lane_e & 15, fq = lane_e >> 4;
#pragma unroll
        for (int ai = 0; ai < 2; ++ai) {
            f32x4 h0[4][2][2];
#pragma unroll
            for (int m = 0; m < 4; ++m)
#pragma unroll
                for (int bj = 0; bj < 2; ++bj)
#pragma unroll
                    for (int n = 0; n < 2; ++n)
                        h0[m][bj][n] = *(const f32x4*)(p.x + (size_t)(mt * 256 + ai * 128 + wr * 64 + m * 16 + fr) * D + nt * 256 + bj * 128 + wc * 32 + n * 16 + fq * 4);
#pragma unroll
            for (int m = 0; m < 4; ++m)
#pragma unroll
                for (int bj = 0; bj < 2; ++bj)
                    st_bf4_pair(p.h1b() + (size_t)(mt * 256 + ai * 128 + wr * 64 + m * 16 + fr) * D + nt * 256 + bj * 128 + wc * 32, fq, h0[m][bj][0] + acc[ai][bj][m][0], h0[m][bj][1] + acc[ai][bj][m][1]);
        }
    };
    unsigned vbU[2]; gj_lin2(vbU, D);
    gemm_stream<false>(lds, D, D, (size_t)128 * D * 2, vbU, jobfn, epi);
}

constexpr int XS_LD = 1025;
__device__ __forceinline__ void ph_route(const P& p, unsigned char* lds) {
    const int tid = tid_(), lane = tid & 63, wid = __builtin_amdgcn_readfirstlane(tid >> 6);
    const int gt = blockIdx.x * NTHREADS + tid, ntot = gridDim.x * NTHREADS;
    for (int i = gt; i < CAP; i += ntot) { p.slot_token()[i] = -1; p.slot_info()[i] = make_int2(-1, 0); }
    float* xs = (float*)lds;
    int* lhist = (int*)(lds + 32 * XS_LD * 4);
    float rwv[64];
    {
        const float* wp = p.router_w + (size_t)(wid * 128 + (lane >> 5)) * 32 + (lane & 31);
#pragma unroll
        for (int i = 0; i < 64; ++i) rwv[i] = wp[(size_t)(2 * i) * 32];
    }
    for (int tb = blockIdx.x; tb < NTOK / 128; tb += gridDim.x) {
        if (tid < 32) lhist[tid] = 0;
        for (int tile = 0; tile < 4; ++tile) {
            const int tokt = tb * 128 + tile * 32;
            __syncthreads();
#pragma unroll
            for (int t = 0; t < 4; ++t) {
                const int tl = wid * 4 + t, tok = tokt + tl;
                const bf16_t* src = p.h1b() + (size_t)tok * D;
                f32x4 v[4]; float ss = 0.f;
#pragma unroll
                for (int i = 0; i < 4; ++i) {
                    const uint2 w = *(const uint2*)(src + lane * 4 + 256 * i);
                    v[i][0] = __uint_as_float(w.x << 16); v[i][1] = __uint_as_float(w.x & 0xffff0000u); v[i][2] = __uint_as_float(w.y << 16); v[i][3] = __uint_as_float(w.y & 0xffff0000u);
                    ss += v[i][0] * v[i][0] + v[i][1] * v[i][1] + v[i][2] * v[i][2] + v[i][3] * v[i][3];
                }
                ss = wave_sum(ss);
                const float rs = rsqrtf(ss * (1.0f / D) + EPS);
#pragma unroll
                for (int i = 0; i < 4; ++i) {
                    const f32x4 g = *(const f32x4*)(p.ffn_g + lane * 4 + 256 * i);
                    f32x4 xn; xn[0] = v[i][0] * rs * g[0]; xn[1] = v[i][1] * rs * g[1]; xn[2] = v[i][2] * rs * g[2]; xn[3] = v[i][3] * rs * g[3];
                    *(uint32_t*)(p.xn2() + (size_t)tok * D + lane * 4 + 256 * i) = pk4_fp8(xn[0], xn[1], xn[2], xn[3]);
#pragma unroll
                    for (int c = 0; c < 4; ++c) xs[tl * XS_LD + lane * 4 + 256 * i + c] = xn[c];
                }
            }
            __syncthreads();
            f32x16 acc;
#pragma unroll
            for (int i = 0; i < 16; ++i) acc[i] = 0.f;
            {
                const float* xr = xs + (lane & 31) * XS_LD + wid * 128 + (lane >> 5);
#pragma unroll
                for (int i = 0; i < 64; ++i) acc = __builtin_amdgcn_mfma_f32_32x32x2f32(xr[2 * i], rwv[i], acc, 0, 0, 0);
            }
            __syncthreads();
#pragma unroll
            for (int r = 0; r < 16; ++r) xs[wid * 1024 + ((r & 3) + 8 * (r >> 2) + 4 * (lane >> 5)) * 32 + (lane & 31)] = acc[r];
            __syncthreads();
            const int e = lane & 31, hh = lane >> 5;
            const float be = p.router_b[e];
#pragma unroll
            for (int it = 0; it < 2; ++it) {
                const int tl = wid * 4 + it * 2 + hh;
                float l = be;
#pragma unroll
                for (int w = 0; w < 8; ++w) l += xs[w * 1024 + tl * 32 + e];
                float bv[4]; int bi[4];
#pragma unroll
                for (int k = 0; k < 4; ++k) {
                    float m = l;
#pragma unroll
                    for (int o = 16; o >= 1; o >>= 1) m = fmaxf(m, __shfl_xor(m, o));
                    const unsigned long long bal = __ballot(l == m);
                    const unsigned half = hh ? (unsigned)(bal >> 32) : (unsigned)bal;
                    const int idx = __builtin_ctz(half);
                    bv[k] = m; bi[k] = idx;
                    if (e == idx) l = -INFINITY;
                }
                const float e1 = __expf(bv[1] - bv[0]), e2 = __expf(bv[2] - bv[0]), e3 = __expf(bv[3] - bv[0]);
                const float inv = 1.0f / (1.0f + e1 + e2 + e3);
                if (e == 0) {
                    const int tok = tokt + tl;
                    p.tok_exp()[tok * 4 + 0] = bi[0]; p.tok_exp()[tok * 4 + 1] = bi[1]; p.tok_exp()[tok * 4 + 2] = bi[2]; p.tok_exp()[tok * 4 + 3] = bi[3];
                    p.tok_gate()[tok * 4 + 0] = inv; p.tok_gate()[tok * 4 + 1] = e1 * inv; p.tok_gate()[tok * 4 + 2] = e2 * inv; p.tok_gate()[tok * 4 + 3] = e3 * inv;
                    atomicAdd(&lhist[bi[0]], 1); atomicAdd(&lhist[bi[1]], 1); atomicAdd(&lhist[bi[2]], 1); atomicAdd(&lhist[bi[3]], 1);
                }
            }
        }
        __syncthreads();
        if (tid < 32) p.wg_cnt()[tb * 32 + tid] = lhist[tid];
        __syncthreads();
    }
    __syncthreads();
    {
        constexpr int ROWB = 272;
        LAS unsigned char* wl = (LAS unsigned char*)lds + wid * (64 * ROWB);
        const int gw = blockIdx.x * 8 + wid, nw = gridDim.x * 8;
        for (int task = gw; task < 96 * 4 * 16; task += nw) {
            const int mat = task >> 6, kq4 = (task >> 4) & 3, nb = task & 15;
            const int which = mat >> 5, e = mat & 31;
            const float* W = (which == 0 ? p.w_gate : which == 1 ? p.w_up : p.w_down) + (size_t)e * 1048576 + (size_t)(kq4 * 256) * 1024 + nb * 64 + lane;
            unsigned char* outp = (which == 0 ? p.wgT() : which == 1 ? p.wuT() : p.wdT()) + (size_t)e * 1048576 + (size_t)(nb * 64) * 1024 + kq4 * 256;
#pragma unroll 1
            for (int q = 0; q < 4; ++q) {
                float v[64];
#pragma unroll
                for (int i = 0; i < 64; ++i) v[i] = W[(size_t)(q * 64 + i) * 1024] * 32.0f;
#pragma unroll
                for (int i = 0; i < 4; ++i) {
                    u32x4 t;
                    t.x = pk4_fp8(v[16 * i], v[16 * i + 1], v[16 * i + 2], v[16 * i + 3]); t.y = pk4_fp8(v[16 * i + 4], v[16 * i + 5], v[16 * i + 6], v[16 * i + 7]);
                    t.z = pk4_fp8(v[16 * i + 8], v[16 * i + 9], v[16 * i + 10], v[16 * i + 11]); t.w = pk4_fp8(v[16 * i + 12], v[16 * i + 13], v[16 * i + 14], v[16 * i + 15]);
                    *(LAS u32x4*)(wl + lane * ROWB + q * 64 + i * 16) = t;
                }
            }
#pragma unroll
            for (int j = 0; j < 16; ++j) {
                const int rr = j * 4 + (lane >> 4), c = lane & 15;
                const u32x4 t = *(const LAS u32x4*)(wl + rr * ROWB + c * 16);
                *(u32x4*)(outp + (size_t)rr * 1024 + c * 16) = t;
            }
        }
    }
}

__device__ __forceinline__ void ph_fill(const P& p, unsigned char* lds) {
    const int tid = tid_();
    int* tot = (int*)lds;
    int* pre = tot + 512;
    int* ps = pre + 512;
    int* lc = ps + 32;
    for (int tb = blockIdx.x; tb < NTOK / 128; tb += gridDim.x) {
        {
            const int e = tid & 31, part = tid >> 5;
            int t = 0, q = 0;
#pragma unroll
            for (int k = 0; k < NTOK / 128 / 16; ++k) { const int b2 = part + 16 * k; const int c = p.wg_cnt()[b2 * 32 + e]; t += c; if (b2 < tb) q += c; }
            tot[part * 32 + e] = t; pre[part * 32 + e] = q;
        }
        __syncthreads();
        if (tid < 64) {
            const int e = tid & 31;
            int t = 0, q = 0;
#pragma unroll
            for (int i = 0; i < 16; ++i) { t += tot[i * 32 + e]; q += pre[i * 32 + e]; }
            const int nb = tid < 32 ? (t + 255) >> 8 : 0;
            const int incl = wave_incl_scan(nb), acc = (incl - nb) * 256;
            if (tid < 32) {
                ps[e] = acc + q; lc[e] = 0;
                if (tb == 0) for (int i = 0; i < nb; ++i) p.block_expert()[(acc >> 8) + i] = e;
            }
            if (tb == 0 && tid == 31) p.ctr()[96] = incl;
        }
        __syncthreads();
        {
            const int i = tb * 512 + tid;
            const int e = p.tok_exp()[i];
            const int dest = ps[e] + atomicAdd(&lc[e], 1);
            p.slot_token()[dest] = i >> 2;
            p.slot_info()[dest] = make_int2((i >> 2) | ((i & 3) << 16), __float_as_int(p.tok_gate()[i]));
        }
        __syncthreads();
    }
}

__device__ __forceinline__ void ph_moe1(const P& p, unsigned char* lds) {
    const int nblocks = p.ctr()[96], G = gridDim.x, b0 = blockIdx.x, bpx = (nblocks + 7) >> 3, bpi = G >> 6, xl = b0 >> 3, xbase = (b0 & 7) * bpx;
    const bool xcd_order = (G & 63) == 0;
    auto unit = [&](int i, int& rb, int& ct) __attribute__((always_inline)) -> bool {
        if (!xcd_order) { const int u = b0 + i * G; rb = u >> 3; ct = u & 7; return rb < nblocks; }
        const int k = i * bpi + (xl >> 3); rb = xbase + k; ct = xl & 7; return k < bpx && rb < nblocks && (xl >> 3) < bpi; };
    auto jobfn = [&](int i, G8Job& j) __attribute__((always_inline)) -> bool {
        int rb, ct; if (!unit(i, rb, ct)) return false;
        const int e = p.block_expert()[rb];
        j.A = (const char*)p.xn2(); j.B = (const char*)(p.wgT() + (size_t)e * 1048576 + (size_t)ct * 128 * 1024); j.aux = e;
        const int* st = p.slot_token() + rb * 256; unsigned v[4];
#pragma unroll
        for (int q = 0; q < 4; ++q) { int R, Cb; g8_rc(q, R, Cb); const int t = st[R]; v[q] = (unsigned)((t < 0 ? 0 : t) * 1024 + Cb); }
        j.va0 = v[0]; j.va1 = v[1]; j.va2 = v[2]; j.va3 = v[3]; return true; };
    auto epi = [&](f32x4 (&acc)[2][2][4][2], int i) __attribute__((always_inline)) {
        int rb, ct; unit(i, rb, ct);
        const int e = p.block_expert()[rb];
        const int tid_e = tid_(), lane_e = tid_e & 63, wid_e = tid_e >> 6, wr = wid_e >> 2, wc = wid_e & 3, fr = lane_e & 15, fq = lane_e >> 4;
        constexpr float SC = 0.03125f, KE = -1.702f * 1.4426950408889634f;
        constexpr int STG = 131072 + 4096, ROWP = 144;
        f32x2 bgp[2][2], bup[2][2], c2p[2][2];
#pragma unroll
        for (int n = 0; n < 2; ++n) {
            const LAS unsigned char* bl = (const LAS unsigned char*)lds + 131072 + (i & 1) * 2048 + (wc * 32 + n * 16 + fq * 4) * 4;
            const f32x4 bg = *(const LAS f32x4*)bl, bu = *(const LAS f32x4*)(bl + 512);
            bgp[n][0] = (f32x2){bg[0], bg[1]}; bgp[n][1] = (f32x2){bg[2], bg[3]};
            bup[n][0] = (f32x2){bu[0] + 1.0f, bu[1] + 1.0f}; bup[n][1] = (f32x2){bu[2] + 1.0f, bu[3] + 1.0f};
            c2p[n][0] = bgp[n][0] * KE; c2p[n][1] = bgp[n][1] * KE;
        }
#pragma unroll
        for (int ai = 0; ai < 2; ++ai) {
#pragma unroll
            for (int n = 0; n < 2; ++n)
#pragma unroll
                for (int m = 0; m < 4; ++m) {
                    const f32x4 ga = acc[ai][0][m][n], ua = acc[ai][1][m][n];
                    f32x2 o[2];
#pragma unroll
                    for (int hh = 0; hh < 2; ++hh) {
                        const f32x2 ag = {ga[2 * hh], ga[2 * hh + 1]}, au = {ua[2 * hh], ua[2 * hh + 1]};
                        const f32x2 t = ag * (SC * KE) + c2p[n][hh];
                        f32x2 d = {__builtin_amdgcn_exp2f(t[0]), __builtin_amdgcn_exp2f(t[1])};
                        d = d + 1.0f;
                        const f32x2 rc = {__builtin_amdgcn_rcpf(d[0]), __builtin_amdgcn_rcpf(d[1])};
                        f32x2 g = ag * SC + bgp[n][hh];
                        g[0] = fminf(g[0], 7.0f); g[1] = fminf(g[1], 7.0f);
                        f32x2 u1 = au * SC + bup[n][hh];
                        u1[0] = __builtin_amdgcn_fmed3f(u1[0], -6.0f, 8.0f); u1[1] = __builtin_amdgcn_fmed3f(u1[1], -6.0f, 8.0f);
                        o[hh] = (g * rc) * u1;
                    }
                    int w = __builtin_amdgcn_cvt_pk_fp8_f32(o[0][0], o[0][1], 0, false); w = __builtin_amdgcn_cvt_pk_fp8_f32(o[1][0], o[1][1], w, true);
                    *(LAS uint32_t*)((LAS unsigned char*)lds + STG + (wr * 64 + m * 16 + fr) * ROWP + wc * 32 + n * 16 + fq * 4) = (uint32_t)w;
                }
            __syncthreads();
#pragma unroll
            for (int t = 0; t < 2; ++t) {
                const int idx = t * NTHREADS + tid_e, rl = idx >> 3, ch = idx & 7;
                const u32x4 v4 = *(const LAS u32x4*)((LAS unsigned char*)lds + STG + rl * ROWP + ch * 16);
                *(u32x4*)(p.act() + (size_t)(rb * 256 + ai * 128 + rl) * DFF + ct * 128 + ch * 16) = v4;
            }
            __syncthreads();
        }
    };
    unsigned vbU[4];
#pragma unroll
    for (int q = 0; q < 4; ++q) { int R, Cb; g8_rc(q, R, Cb); vbU[q] = (unsigned)((size_t)(R >> 7) * WE8_B + (size_t)(R & 127) * 1024 + Cb); }
    auto pre = [&](int i, int e) __attribute__((always_inline)) {
        int rb, ct; unit(i, rb, ct);
        const int tid_p = tid_(), wid_p = __builtin_amdgcn_readfirstlane(tid_p >> 6), lane_p = tid_p & 63;
        if (wid_p < 4) {
            const float* src = (wid_p < 2 ? p.b_gate : p.b_up) + (size_t)e * DFF + ct * 128 + (wid_p & 1) * 64;
            const unsigned voff = (unsigned)lane_p * 4u, dst = (unsigned)(size_t)(LAS unsigned char*)lds + 131072u + (unsigned)(i & 1) * 2048u + (unsigned)wid_p * 256u;
            G8_PRE_DMA(uni_ptr8((const char*)src), voff, __builtin_amdgcn_readfirstlane(dst));
        }
    };
    gemm8_stream<true>(lds, vbU, jobfn, pre, epi);
}
__device__ __forceinline__ void ph_moe2(const P& p, unsigned char* lds) {
    const int nblocks = p.ctr()[96], G = gridDim.x, b0 = blockIdx.x, bpx = (nblocks + 7) >> 3, bpi = G >> 5, xl = b0 >> 3, xbase = (b0 & 7) * bpx;
    const bool xcd_order = (G & 31) == 0;
    auto unit = [&](int i, int& rb, int& nt) __attribute__((always_inline)) -> bool {
        if (!xcd_order) { const int u = b0 + i * G; rb = u >> 2; nt = u & 3; return rb < nblocks; }
        const int k = i * bpi + (xl >> 2); rb = xbase + k; nt = xl & 3; return k < bpx && rb < nblocks && (xl >> 2) < bpi; };
    unsigned vbU[4];
#pragma unroll
    for (int q = 0; q < 4; ++q) { int R, Cb; g8_rc(q, R, Cb); vbU[q] = (unsigned)(R * DFF + Cb); }
    auto jobfn = [&](int i, G8Job& j) __attribute__((always_inline)) -> bool {
        int rb, nt; if (!unit(i, rb, nt)) return false;
        const int e = p.block_expert()[rb];
        j.A = (const char*)(p.act() + (size_t)rb * 256 * DFF); j.B = (const char*)(p.wdT() + (size_t)e * 1048576 + (size_t)nt * 256 * DFF); j.aux = e; return true; };
    auto pre = [&](int i, int e) __attribute__((always_inline)) {
        int rb, nt; unit(i, rb, nt);
        const int tid_p = tid_(), wid_p = __builtin_amdgcn_readfirstlane(tid_p >> 6), lane_p = tid_p & 63;
        const unsigned voff = (unsigned)lane_p * 4u, base = (unsigned)(size_t)(LAS unsigned char*)lds + 131072u + (unsigned)(i & 1) * 3072u;
        G8_PRE_DMA(uni_ptr8((const char*)(p.slot_info() + rb * 256) + wid_p * 256), voff, __builtin_amdgcn_readfirstlane(base + 1024u + (unsigned)wid_p * 256u));
        if (wid_p < 4) G8_PRE_DMA(uni_ptr8((const char*)(p.b_down + (size_t)e * D + nt * 256 + wid_p * 64)), voff, __builtin_amdgcn_readfirstlane(base + (unsigned)wid_p * 256u));
    };
    auto epi = [&](f32x4 (&acc)[2][2][4][2], int i) __attribute__((always_inline)) {
        int rb, nt; unit(i, rb, nt);
        const int e = p.block_expert()[rb];
        const int tid_e = tid_(), lane_e = tid_e & 63, wid_e = tid_e >> 6, wr = wid_e >> 2, wc = wid_e & 3, fr = lane_e & 15, fq = lane_e >> 4;
        f32x4 bd[2][2];
#pragma unroll
        for (int bj = 0; bj < 2; ++bj)
#pragma unroll
            for (int n = 0; n < 2; ++n) bd[bj][n] = *(const LAS f32x4*)((const LAS unsigned char*)lds + 131072 + (i & 1) * 3072 + (bj * 128 + wc * 32 + n * 16 + fq * 4) * 4);
        typedef int i32x2_ __attribute__((ext_vector_type(2)));
        const LAS unsigned char* infl = (const LAS unsigned char*)lds + 131072 + (i & 1) * 3072 + 1024;
        LAS unsigned char* stg = (LAS unsigned char*)lds + 131072 + 6144;
#pragma unroll
        for (int ai = 0; ai < 2; ++ai) {
            float gate[4];
#pragma unroll
            for (int m = 0; m < 4; ++m) { const i32x2_ t_ = *(const LAS i32x2_*)(infl + (ai * 128 + wr * 64 + m * 16 + fr) * 8); gate[m] = __int_as_float(t_.y) * (16.0f * 0.03125f); }
#pragma unroll
            for (int bj = 0; bj < 2; ++bj) {
#pragma unroll
                for (int m = 0; m < 4; ++m)
#pragma unroll
                    for (int n = 0; n < 2; ++n) {
                        const f32x4 y = (acc[ai][bj][m][n] + bd[bj][n] * 32.0f) * gate[m];
                        const int rl = wr * 64 + m * 16 + fr, chunk = (wc * 2 + n) ^ (rl & 7);
                        *(LAS uint32_t*)(stg + rl * 128 + chunk * 16 + fq * 4) = pk4_fp8(y[0], y[1], y[2], y[3]);
                    }
                __syncthreads();
#pragma unroll
                for (int t = 0; t < 2; ++t) {
                    const int idx = t * NTHREADS + tid_e, rl = idx >> 3, ch = idx & 7;
                    const i32x2_ inf = *(const LAS i32x2_*)(infl + (ai * 128 + rl) * 8);
                    const u32x4 v4 = *(const LAS u32x4*)(stg + rl * 128 + ((ch ^ (rl & 7)) * 16));
                    const int ix = inf.x;
                    if (ix >= 0) {
                        const int rank = ix >> 16;
                        unsigned char* yb = (unsigned char*)(rank == 0 ? p.y0() : rank == 1 ? p.y1() : (rank == 2 ? p.y2() : p.y3()));
                        *(u32x4*)(yb + (size_t)(ix & 0xffff) * D + nt * 256 + bj * 128 + ch * 16) = v4;
                    }
                }
                __syncthreads();
            }
        }
    };
    gemm8_stream<false>(lds, vbU, jobfn, pre, epi);
}

__device__ __forceinline__ void ph_final(const P& p, unsigned char* lds) {
    const int tid = tid_(), lane = tid & 63, wid = tid >> 6;
    const int gw = blockIdx.x * 8 + wid, nw = gridDim.x * 8;
    for (int tok = gw; tok < NTOK; tok += nw) {
        float* dst = p.out + (size_t)tok * D;
        f32x4 v[4];
#pragma unroll
        for (int i = 0; i < 4; ++i) {
            const uint2 w = *(const uint2*)(p.h1b() + (size_t)tok * D + lane * 4 + 256 * i);
            v[i][0] = __uint_as_float(w.x << 16); v[i][1] = __uint_as_float(w.x & 0xffff0000u); v[i][2] = __uint_as_float(w.y << 16); v[i][3] = __uint_as_float(w.y & 0xffff0000u);
        }
#pragma unroll
        for (int j = 0; j < 4; ++j) {
            const unsigned char* yr = (const unsigned char*)(j == 0 ? p.y0() : j == 1 ? p.y1() : j == 2 ? p.y2() : p.y3()) + (size_t)tok * D;
#pragma unroll
            for (int i = 0; i < 4; ++i) {
                const int w = *(const int*)(yr + lane * 4 + 256 * i);
                const f32x2 lo = __builtin_amdgcn_cvt_pk_f32_fp8(w, false), hi = __builtin_amdgcn_cvt_pk_f32_fp8(w, true);
                v[i][0] += lo[0] * 0.0625f; v[i][1] += lo[1] * 0.0625f; v[i][2] += hi[0] * 0.0625f; v[i][3] += hi[1] * 0.0625f;
            }
        }
        float ss = 0.f;
#pragma unroll
        for (int i = 0; i < 4; ++i) ss += v[i][0] * v[i][0] + v[i][1] * v[i][1] + v[i][2] * v[i][2] + v[i][3] * v[i][3];
        ss = wave_sum(ss);
        const float rs = rsqrtf(ss * (1.0f / D) + EPS);
#pragma unroll
        for (int i = 0; i < 4; ++i) {
            const f32x4 g = *(const f32x4*)(p.final_g + lane * 4 + 256 * i);
            *(f32x4*)(dst + lane * 4 + 256 * i) = v[i] * rs * g;
        }
    }
}

typedef const __attribute__((address_space(4))) P* PK;
#define PHASE(call) do { PK q_ = pk; asm volatile("" : "+s"(q_)); const P& p = *(const P*)q_; call; } while (0)
__global__ void __launch_bounds__(NTHREADS) k_mega(P p_unused) {
    __shared__ __attribute__((aligned(16))) unsigned char lds[LDS_BYTES];
    cg::grid_group grid = cg::this_grid();
    const PK pk = (PK)__builtin_amdgcn_kernarg_segment_ptr();
    if (tid_() < 4) ((unsigned*)(lds + LDS_BYTES - 32))[tid_()] = 0u;
    __syncthreads();
    XcdBarrier xb;
    PHASE(xb = xcd_barrier_post((unsigned*)(p.ws + OFF_BAR), (volatile LAS unsigned*)(lds + LDS_BYTES - 32)));
    PHASE(if (p.ws == nullptr) grid.sync());
    PHASE(ph_prep(p, lds)); xcd_barrier(xb);
    PHASE(ph_inproj(p, lds)); xcd_barrier(xb);
    PHASE(ph_mixer<0>(p, lds)); xcd_barrier(xb);
    PHASE(ph_mixer<1>(p, lds)); xcd_barrier(xb);
    PHASE(ph_mixer<2>(p, lds)); xcd_barrier(xb);
    PHASE(ph_mix(p, lds)); xcd_barrier(xb);
    PHASE(ph_out(p, lds)); xcd_barrier(xb);
    PHASE(ph_route(p, lds)); xcd_barrier(xb);
    PHASE(ph_fill(p, lds)); xcd_barrier(xb);
    PHASE(ph_moe1(p, lds)); xcd_barrier(xb);
    PHASE(ph_moe2(p, lds)); xcd_barrier(xb);
    PHASE(ph_final(p, lds));
}

extern "C" void kernel_launch(void* const* d_in, const int* in_sizes, int n_in, void* d_out, int out_size, void* d_ws, size_t ws_size,
                              hipStream_t stream) {
    P p{};
    p.x = (const float*)d_in[0]; p.meta = (const float*)d_in[1]; p.attn_g = (const float*)d_in[2]; p.w_in = (const float*)d_in[3];
    p.hgrn_g = (const float*)d_in[4]; p.w_ua = (const float*)d_in[5]; p.w_uh = (const float*)d_in[6]; p.w_out = (const float*)d_in[7];
    p.lb_logits = (const float*)d_in[8]; p.ffn_g = (const float*)d_in[9]; p.router_w = (const float*)d_in[10]; p.router_b = (const float*)d_in[11];
    p.w_gate = (const float*)d_in[12]; p.b_gate = (const float*)d_in[13]; p.w_up = (const float*)d_in[14]; p.b_up = (const float*)d_in[15];
    p.w_down = (const float*)d_in[16]; p.b_down = (const float*)d_in[17]; p.final_g = (const float*)d_in[18];
    p.out = (float*)d_out;
    p.ws = (unsigned char*)d_ws;
    if (WS_NEED > ws_size) { fprintf(stderr, "workspace too small: need %zu have %zu\n", (size_t)WS_NEED, ws_size); return; }
    static int grid_blocks = 0;
    if (!grid_blocks) {
        int dev = 0, cus = 0, per_cu = 0;
        hipGetDevice(&dev);
        hipDeviceGetAttribute(&cus, hipDeviceAttributeMultiprocessorCount, dev);
        hipOccupancyMaxActiveBlocksPerMultiprocessor(&per_cu, k_mega, NTHREADS, 0);
        if (per_cu > 1) per_cu = 1;
        grid_blocks = cus * per_cu;
    }
    hipMemsetAsync(p.ws + OFF_BAR, 0, XCD_BAR_WORDS * 4, stream);
    void* args[] = {&p};
    hipError_t e = hipLaunchCooperativeKernel((void*)k_mega, dim3(grid_blocks), dim3(NTHREADS), args, 0, stream);
    if (e != hipSuccess) fprintf(stderr, "cooperative launch failed: %s (grid %d)\n", hipGetErrorString(e), grid_blocks);
}
```
